# Optimizing an MI355X kernel written in HIP

```python
import jax, jax.numpy as jnp
from jax import lax
import numpy as np

D_MODEL = 1024
BATCH = 8
SEQ = 2048
DEPTH = 2
DEC_BATCH = 32
DEC_SEQ = 8
PAST_LEN = 16384
PAGE_SIZE = 128

EPS = 1e-6
POOL_WINDOWS = (2, 4, 8, 16)
POOL_GROUPS = 4
POOL_GROUP_DIM = D_MODEL // 8
POOL_WIDTH = POOL_GROUPS * POOL_GROUP_DIM
POOL_BUF = 15
MLA_HEADS = 8
QK_NOPE = 64
QK_ROPE = 32
V_HEAD = 64
Q_LORA = 384
KV_LORA = 256
MLA_WIDTH = MLA_HEADS * V_HEAD
MLA_SCALE = (QK_NOPE + QK_ROPE) ** -0.5
ROPE_THETA = 10000.0
Q_BLOCK = 128
DN_HEADS = 8
DN_DK = 64
DN_DV = 64
DN_KEY_WIDTH = DN_HEADS * DN_DK
DN_WIDTH = DN_HEADS * DN_DV
CONV_W = 4
CONV_CH = 2 * DN_KEY_WIDTH + DN_WIDTH
DN_CHUNK = 64
N_BRANCH = 3
IN_SPLITS = (POOL_WIDTH, POOL_WIDTH,
             Q_LORA, KV_LORA, QK_ROPE, MLA_WIDTH,
             CONV_CH, DN_WIDTH, DN_HEADS, DN_HEADS,
             N_BRANCH * D_MODEL)
IN_WIDTH = sum(IN_SPLITS)

kernel_name = 'hybrid_pool_mla_gdn_step'


def _rmsnorm(x, g):
    xf = x.astype(jnp.float32)
    y = xf * lax.rsqrt(jnp.mean(xf * xf, axis=-1, keepdims=True) + EPS)
    return (y * g.astype(jnp.float32)).astype(x.dtype)


def _l2norm(x):
    xf = x.astype(jnp.float32)
    return xf * lax.rsqrt(jnp.sum(xf * xf, axis=-1, keepdims=True) + EPS)


def _rope(x, pos):
    half = QK_ROPE // 2
    inv = jnp.power(ROPE_THETA, -jnp.arange(half, dtype=jnp.float32) / half)
    ang = pos.astype(jnp.float32)[:, None] * inv[None, :]
    cos = jnp.cos(ang)[None, :, None, :]
    sin = jnp.sin(ang)[None, :, None, :]
    xf = x.astype(jnp.float32)
    x1, x2 = xf[..., :half], xf[..., half:]
    return jnp.concatenate([x1 * cos - x2 * sin, x2 * cos + x1 * sin], axis=-1).astype(x.dtype)


def _pool_mixer(u, buf, pos, mix, scale):
    B, L, _ = u.shape
    xx = jnp.concatenate([buf.astype(u.dtype), u], axis=1)
    xf = xx.astype(jnp.float32)
    prefix = jnp.concatenate([jnp.zeros_like(xf[:, :1]), lax.cumsum(xf, axis=1)], axis=1)
    hi = prefix[:, POOL_BUF + 1:]
    outs = []
    for gi, w in enumerate(POOL_WINDOWS):
        c0 = gi * POOL_GROUP_DIM
        c1 = c0 + POOL_GROUP_DIM
        lo = prefix[:, POOL_BUF + 1 - w:POOL_BUF + 1 - w + L, c0:c1]
        cnt = jnp.minimum(pos + 1, w).astype(jnp.float32)[None, :, None]
        outs.append((hi[..., c0:c1] - lo) / cnt)
    d = jnp.concatenate(outs, axis=-1) - u.astype(jnp.float32)
    d = d.reshape(B, L, POOL_GROUPS, POOL_GROUP_DIM).astype(u.dtype)
    y = jnp.einsum('blgc,gcd->blgd', d, mix).reshape(B, L, POOL_WIDTH) * scale
    return y, xx[:, -POOL_BUF:]


def _mla_attend(q_lat, q_rope, c_kv, k_rope, q_pos, k_pos):
    B, Lq, H, C = q_lat.shape
    qb = min(Q_BLOCK, Lq)
    nb = -(-Lq // qb)
    pad = nb * qb - Lq
    q_lat = jnp.pad(q_lat, ((0, 0), (0, pad), (0, 0), (0, 0)))
    q_rope = jnp.pad(q_rope, ((0, 0), (0, pad), (0, 0), (0, 0)))
    q_pos = jnp.pad(q_pos, (0, pad))
    to_blocks = lambda t: jnp.moveaxis(t.reshape(B, nb, qb, *t.shape[2:]), 1, 0)
    ql_b, qr_b = to_blocks(q_lat), to_blocks(q_rope)
    qp_b = q_pos.reshape(nb, qb)

    def block(args):
        ql, qr, qp = args
        s = (jnp.einsum('bqhc,bkc->bhqk', ql, c_kv, preferred_element_type=jnp.float32)
             + jnp.einsum('bqhr,bkr->bhqk', qr, k_rope, preferred_element_type=jnp.float32)) * MLA_SCALE
        mask = k_pos[None, :] <= qp[:, None]
        p = jax.nn.softmax(jnp.where(mask[None, None], s, -jnp.inf), axis=-1)
        o = jnp.einsum('bhqk,bkc->bqhc', p.astype(c_kv.dtype), c_kv, preferred_element_type=jnp.float32)
        return o.astype(c_kv.dtype)

    o = lax.map(block, (ql_b, qr_b, qp_b))
    return jnp.moveaxis(o, 0, 1).reshape(B, nb * qb, H, C)[:, :Lq]


def _short_conv(u, buf, w):
    L = u.shape[1]
    xx = jnp.concatenate([buf.astype(u.dtype), u], axis=1)
    y = xx[:, 0:L] * w[0]
    for j in range(1, CONV_W):
        y = y + xx[:, j:j + L] * w[j]
    return jax.nn.silu(y), xx[:, -(CONV_W - 1):]


def _gated_delta(q, k, v, g, beta, s0):
    B, L, H, DK = q.shape
    C = min(DN_CHUNK, L)
    n = -(-L // C)
    pad = n * C - L
    padf = lambda t: jnp.pad(t, [(0, 0), (0, pad)] + [(0, 0)] * (t.ndim - 2))
    chunks = lambda t: jnp.moveaxis(padf(t).reshape(B, n, C, *t.shape[2:]), (1, 3), (0, 2))
    q = chunks(q * (DK ** -0.5))
    k, v, g, beta = chunks(k), chunks(v), chunks(g), chunks(beta)
    gc = jnp.cumsum(g, axis=-1)
    tri_incl = jnp.tril(jnp.ones((C, C), dtype=bool))
    tri_strict = jnp.tril(jnp.ones((C, C), dtype=bool), -1)
    diff = gc[..., :, None] - gc[..., None, :]
    decay = jnp.where(tri_incl, jnp.exp(jnp.where(tri_incl, diff, 0.0)), 0.0)
    kb = k * beta[..., None]
    a_mat = jnp.where(tri_strict, jnp.einsum('...id,...jd->...ij', kb, k) * decay, 0.0)
    eye = jnp.eye(C, dtype=a_mat.dtype)
    t_inv = lax.linalg.triangular_solve(eye + a_mat, jnp.broadcast_to(eye, a_mat.shape),
                                        left_side=True, lower=True, unit_diagonal=True)
    u = t_inv @ (v * beta[..., None])
    w = t_inv @ (kb * jnp.exp(gc)[..., None])
    qk = jnp.where(tri_incl, jnp.einsum('...id,...jd->...ij', q, k) * decay, 0.0)

    def step(s, xs):
        q_i, k_i, u_i, w_i, gc_i, qk_i = xs
        v_new = u_i - w_i @ s
        o = (q_i * jnp.exp(gc_i)[..., None]) @ s + qk_i @ v_new
        g_last = gc_i[..., -1]
        s = s * jnp.exp(g_last)[..., None, None] + jnp.einsum(
            'bhcd,bhce->bhde', k_i * jnp.exp(g_last[..., None] - gc_i)[..., None], v_new)
        return s, o

    s_fin, o = lax.scan(step, s0, (q, k, u, w, gc, qk))
    o = jnp.moveaxis(o, (0, 2), (1, 3)).reshape(B, n * C, H, -1)[:, :L]
    return o, s_fin


def _layer(x, start, kv_past, kr_past, pool_buf, conv_buf, s0,
           norm_g, w_in, pool_mix, pool_scale, q_norm_g, w_uq, kv_norm_g, w_uk, w_uv,
           conv_w, a_log, dt_bias, dn_norm_g, w_br_pool, w_br_mla, w_br_dn, w_out):
    B, L, _ = x.shape
    f32 = jnp.float32
    pos = start + jnp.arange(L, dtype=jnp.int32)
    xn = _rmsnorm(x, norm_g)
    h = xn @ w_in
    split_pts = [int(c) for c in np.cumsum(IN_SPLITS)[:-1]]
    (h_pool, z_pool, h_q, h_kv, h_kr, z_mla, h_qkv, z_dn, h_beta, h_alpha, h_gate) = jnp.split(h, split_pts, axis=-1)

    y_pool, pool_buf_new = _pool_mixer(h_pool, pool_buf, pos, pool_mix, pool_scale)
    y_a = y_pool * jax.nn.silu(z_pool)

    c_q = _rmsnorm(h_q, q_norm_g)
    q = (c_q @ w_uq).reshape(B, L, MLA_HEADS, QK_NOPE + QK_ROPE)
    q_nope = q[..., :QK_NOPE]
    q_rope = _rope(q[..., QK_NOPE:], pos)
    c_kv = _rmsnorm(h_kv, kv_norm_g)
    k_r = _rope(h_kr[:, :, None, :], pos)[:, :, 0]
    q_lat = jnp.einsum('blhd,chd->blhc', q_nope, w_uk)
    keys_lat = jnp.concatenate([kv_past.astype(c_kv.dtype), c_kv], axis=1)
    keys_rope = jnp.concatenate([kr_past.astype(k_r.dtype), k_r], axis=1)
    k_pos = jnp.arange(keys_lat.shape[1], dtype=jnp.int32)
    o_lat = _mla_attend(q_lat, q_rope, keys_lat, keys_rope, pos, k_pos)
    o_mla = jnp.einsum('blhc,chd->blhd', o_lat, w_uv).reshape(B, L, MLA_WIDTH)
    y_b = o_mla * jax.nn.silu(z_mla)

    qkv, conv_buf_new = _short_conv(h_qkv, conv_buf, conv_w)
    q_d = _l2norm(qkv[..., :DN_KEY_WIDTH].reshape(B, L, DN_HEADS, DN_DK))
    k_d = _l2norm(qkv[..., DN_KEY_WIDTH:2 * DN_KEY_WIDTH].reshape(B, L, DN_HEADS, DN_DK))
    v_d = qkv[..., 2 * DN_KEY_WIDTH:].reshape(B, L, DN_HEADS, DN_DV).astype(f32)
    beta = jax.nn.sigmoid(h_beta.astype(f32))
    g = -jnp.exp(a_log.astype(f32)) * jax.nn.softplus(h_alpha.astype(f32) + dt_bias.astype(f32))
    o_dn, s_new = _gated_delta(q_d, k_d, v_d, g, beta, s0.astype(f32))
    y_c = _rmsnorm(o_dn, dn_norm_g).astype(x.dtype).reshape(B, L, DN_WIDTH) * jax.nn.silu(z_dn)

    gates = jax.nn.sigmoid(h_gate.astype(f32)).astype(x.dtype).reshape(B, L, N_BRANCH, D_MODEL)
    merged = (gates[:, :, 0] * (y_a @ w_br_pool) + gates[:, :, 1] * (y_b @ w_br_mla)
              + gates[:, :, 2] * (y_c @ w_br_dn))
    x = x + merged @ w_out
    return x, c_kv, k_r, pool_buf_new, conv_buf_new, s_new.astype(x.dtype)


def setup_inputs(seed: int = 0) -> dict:
    key = jax.random.key(seed)
    ks = jax.random.split(key, 32)
    f32 = jnp.float32
    nrm = lambda i, shape, scale: jax.random.normal(ks[i], shape, f32) * scale
    n_pages = PAST_LEN // PAGE_SIZE
    n_used = DEC_BATCH * n_pages
    n_pool = n_used + max(1, n_used // 4)
    perm = jax.random.permutation(ks[7], n_pool).astype(jnp.int32)
    page_table = perm[:n_used].reshape(DEC_BATCH, n_pages)
    dt = jnp.exp(jax.random.uniform(ks[19], (DEPTH, DN_HEADS), f32, np.log(1e-3), np.log(1e-1)))
    return {
        'x_prompt': nrm(0, (BATCH, SEQ, D_MODEL), 1.0),
        'x_sample': nrm(1, (DEC_BATCH, DEC_SEQ, D_MODEL), 1.0),
        'cache_kv_latent': nrm(2, (DEPTH, n_pool, PAGE_SIZE, KV_LORA), 1.0),
        'cache_k_rope': nrm(3, (DEPTH, n_pool, PAGE_SIZE, QK_ROPE), 1.0),
        'state_pool': nrm(4, (DEPTH, DEC_BATCH, POOL_BUF, POOL_WIDTH), 1.0),
        'state_conv': nrm(5, (DEPTH, DEC_BATCH, CONV_W - 1, CONV_CH), 1.0),
        'state_delta': nrm(6, (DEPTH, DEC_BATCH, DN_HEADS, DN_DK, DN_DV), 0.1),
        'page_table': page_table,
        'norm_g': 1.0 + nrm(8, (DEPTH, D_MODEL), 0.02),
        'w_in': nrm(9, (DEPTH, D_MODEL, IN_WIDTH), D_MODEL ** -0.5),
        'pool_mix': nrm(10, (DEPTH, POOL_GROUPS, POOL_GROUP_DIM, POOL_GROUP_DIM), POOL_GROUP_DIM ** -0.5),
        'pool_scale': 1.0 + nrm(11, (DEPTH, POOL_WIDTH), 0.1),
        'q_norm_g': 1.0 + nrm(12, (DEPTH, Q_LORA), 0.02),
        'w_uq': nrm(13, (DEPTH, Q_LORA, MLA_HEADS * (QK_NOPE + QK_ROPE)), Q_LORA ** -0.5),
        'kv_norm_g': 1.0 + nrm(14, (DEPTH, KV_LORA), 0.02),
        'w_uk': nrm(15, (DEPTH, KV_LORA, MLA_HEADS, QK_NOPE), KV_LORA ** -0.5),
        'w_uv': nrm(16, (DEPTH, KV_LORA, MLA_HEADS, V_HEAD), KV_LORA ** -0.5),
        'conv_w': nrm(17, (DEPTH, CONV_W, CONV_CH), CONV_W ** -0.5),
        'a_log': jnp.log(jax.random.uniform(ks[18], (DEPTH, DN_HEADS), f32, 1.0, 16.0)),
        'dt_bias': jnp.log(jnp.expm1(dt)),
        'dn_norm_g': 1.0 + nrm(20, (DEPTH, DN_DV), 0.02),
        'w_br_pool': nrm(21, (DEPTH, POOL_WIDTH, D_MODEL), POOL_WIDTH ** -0.5),
        'w_br_mla': nrm(22, (DEPTH, MLA_WIDTH, D_MODEL), MLA_WIDTH ** -0.5),
        'w_br_dn': nrm(23, (DEPTH, DN_WIDTH, D_MODEL), DN_WIDTH ** -0.5),
        'w_out': nrm(24, (DEPTH, D_MODEL, D_MODEL), D_MODEL ** -0.5),
        'final_norm_g': 1.0 + nrm(25, (D_MODEL,), 0.02),
    }


def reference(x_prompt, x_sample, cache_kv_latent, cache_k_rope, state_pool, state_conv, state_delta,
              page_table, norm_g, w_in, pool_mix, pool_scale, q_norm_g, w_uq, kv_norm_g, w_uk, w_uv,
              conv_w, a_log, dt_bias, dn_norm_g, w_br_pool, w_br_mla, w_br_dn, w_out, final_norm_g):
    bp = x_prompt.shape[0]
    db, n_pages = page_table.shape
    past_len = n_pages * PAGE_SIZE
    dt_ = x_prompt.dtype
    xp, xs = x_prompt, x_sample
    p_kv, p_kr, p_pool, p_conv, p_delta = [], [], [], [], []
    s_kv, s_kr, s_pool, s_conv, s_delta = [], [], [], [], []
    for l in range(DEPTH):
        params = (norm_g[l], w_in[l], pool_mix[l], pool_scale[l], q_norm_g[l], w_uq[l], kv_norm_g[l],
                  w_uk[l], w_uv[l], conv_w[l], a_log[l], dt_bias[l], dn_norm_g[l],
                  w_br_pool[l], w_br_mla[l], w_br_dn[l], w_out[l])
        xp, ckv, kr, pb, cb, sd = _layer(
            xp, 0,
            jnp.zeros((bp, 0, KV_LORA), dt_), jnp.zeros((bp, 0, QK_ROPE), dt_),
            jnp.zeros((bp, POOL_BUF, POOL_WIDTH), dt_), jnp.zeros((bp, CONV_W - 1, CONV_CH), dt_),
            jnp.zeros((bp, DN_HEADS, DN_DK, DN_DV), jnp.float32), *params)
        p_kv.append(ckv); p_kr.append(kr); p_pool.append(pb); p_conv.append(cb); p_delta.append(sd)
        kv_past = cache_kv_latent[l][page_table].reshape(db, past_len, KV_LORA)
        kr_past = cache_k_rope[l][page_table].reshape(db, past_len, QK_ROPE)
        xs, ckv, kr, pb, cb, sd = _layer(
            xs, past_len, kv_past, kr_past, state_pool[l], state_conv[l], state_delta[l], *params)
        s_kv.append(ckv); s_kr.append(kr); s_pool.append(pb); s_conv.append(cb); s_delta.append(sd)
    y_prompt = _rmsnorm(xp, final_norm_g)
    y_sample = _rmsnorm(xs, final_norm_g)
    return (y_prompt, y_sample,
            jnp.stack(p_kv), jnp.stack(p_kr), jnp.stack(p_pool), jnp.stack(p_conv), jnp.stack(p_delta),
            jnp.stack(s_kv), jnp.stack(s_kr), jnp.stack(s_pool), jnp.stack(s_conv), jnp.stack(s_delta))
```

```cpp
#include <hip/hip_runtime.h>
#include <stdint.h>

typedef unsigned short bf16_t;

#define D_MODEL 1024
#define TP 16384
#define TS 256
#define TT (TP + TS)
#define SEQ 2048
#define DEC_SEQ 8
#define DEC_BATCH 32
#define PAST_LEN 16384
#define PAGE 128
#define N_PAGES 128
#define N_POOL 5120
#define IN_W 7344
#define IN_WP 7424
#define C_POOL 0
#define C_ZPOOL 512
#define C_Q 1024
#define C_KV 1408
#define C_KR 1664
#define C_ZMLA 1696
#define C_QKV 2208
#define C_ZDN 3744
#define C_BETA 4256
#define C_ALPHA 4264
#define C_GATE 4272
#define EPS 1e-6f
#define MLA_SCALE 0.10206207261596577f

#define O_YP 0
#define O_YS (O_YP + 16777216)
#define O_PKV (O_YS + 262144)
#define O_PKR (O_PKV + 8388608)
#define O_PPOOL (O_PKR + 1048576)
#define O_PCONV (O_PPOOL + 122880)
#define O_PDELTA (O_PCONV + 73728)
#define O_SKV (O_PDELTA + 524288)
#define O_SKR (O_SKV + 131072)
#define O_SPOOL (O_SKR + 16384)
#define O_SCONV (O_SPOOL + 491520)
#define O_SDELTA (O_SCONV + 294912)
#define O_END (O_SDELTA + 2097152)

__device__ __forceinline__ float bf2f(bf16_t b) { return __uint_as_float(((unsigned)b) << 16); }
__device__ __forceinline__ bf16_t f2bf(float f) { unsigned u = __float_as_uint(f); u += 0x7FFFu + ((u >> 16) & 1u); return (bf16_t)(u >> 16); }
__device__ __forceinline__ float sigmoidf_(float v) { return 1.0f / (1.0f + __expf(-v)); }
__device__ __forceinline__ float siluf_(float v) { return v / (1.0f + __expf(-v)); }
__device__ __forceinline__ float wave_sum(float v) {
#pragma unroll
    for (int o = 32; o >= 1; o >>= 1) v += __shfl_xor(v, o);
    return v;
}

__global__ void k_tr(const float* __restrict__ src, bf16_t* __restrict__ dst, int K, int N, int Npad, int pad_) {
    __shared__ float tile[32][33];
    const int n0 = blockIdx.x * 32, k0 = blockIdx.y * 32, tx = threadIdx.x & 31, ty = threadIdx.x >> 5;
    for (int i = ty; i < 32; i += 8) { const int k = k0 + i, n = n0 + tx; tile[i][tx] = (n < N) ? src[(size_t)k * N + n] : 0.f; }
    __syncthreads();
    for (int i = ty; i < 32; i += 8) { const int n = n0 + i, k = k0 + tx; if (n < Npad) dst[(size_t)n * K + k] = f2bf(tile[tx][i]); }
}
__global__ void k_rope_tab(float2* tab) {
    const int idx = blockIdx.x * blockDim.x + threadIdx.x; if (idx >= (SEQ + DEC_SEQ) * 16) return;
    const int p = idx >> 4, i = idx & 15; const int pos = p < SEQ ? p : PAST_LEN + (p - SEQ);
    const float inv = powf(10000.0f, -(float)i / 16.0f);
    const float ang = (float)pos * inv;
    const double rev = (double)ang * 0.15915494309189533576888; const double fr = rev - floor(rev);
    const float f = (float)fr;
    tab[idx] = make_float2(__builtin_amdgcn_cosf(f), __builtin_amdgcn_sinf(f));
}

__global__ void k_rmsnorm(const float* __restrict__ xp, const float* __restrict__ xs, const float* __restrict__ g, bf16_t* __restrict__ xn, float* __restrict__ yp, float* __restrict__ ys) {
    const int t = blockIdx.x; const float* x = t < TP ? xp + (size_t)t * D_MODEL : xs + (size_t)(t - TP) * D_MODEL;
    __shared__ float red[4];
    float v[4]; float ss = 0.f;
#pragma unroll
    for (int i = 0; i < 4; ++i) { v[i] = x[threadIdx.x + 256 * i]; ss += v[i] * v[i]; }
    ss = wave_sum(ss); if ((threadIdx.x & 63) == 0) red[threadIdx.x >> 6] = ss; __syncthreads();
    const float tot = red[0] + red[1] + red[2] + red[3]; const float r = rsqrtf(tot * (1.0f / D_MODEL) + EPS);
#pragma unroll
    for (int i = 0; i < 4; ++i) { const int c = threadIdx.x + 256 * i; const float o = v[i] * r * g[c];
        if (xn) xn[(size_t)t * D_MODEL + c] = f2bf(o);
        else { if (t < TP) yp[(size_t)t * D_MODEL + c] = o; else ys[(size_t)(t - TP) * D_MODEL + c] = o; } }
}

template <class Epi> __global__ void k_gemm(const bf16_t* __restrict__ A, const bf16_t* __restrict__ Bt, int lda, int ldb, int M, int N, int K, int pad_, Epi epi) {
    __shared__ float As[16][68], Bs[16][68];
    const int tm = blockIdx.y * 64, tn = blockIdx.x * 64, tx = threadIdx.x & 15, ty = threadIdx.x >> 4;
    float acc[4][4];
#pragma unroll
    for (int i = 0; i < 4; ++i)
#pragma unroll
        for (int j = 0; j < 4; ++j) acc[i][j] = 0.f;
    for (int k0 = 0; k0 < K; k0 += 16) {
        for (int i = threadIdx.x; i < 1024; i += 256) { const int r = i >> 4, c = i & 15;
            As[c][r] = (tm + r < M) ? bf2f(A[(size_t)(tm + r) * lda + k0 + c]) : 0.f;
            Bs[c][r] = (tn + r < N) ? bf2f(Bt[(size_t)(tn + r) * ldb + k0 + c]) : 0.f; }
        __syncthreads();
#pragma unroll
        for (int kk = 0; kk < 16; ++kk) { float a[4], b[4];
#pragma unroll
            for (int i = 0; i < 4; ++i) { a[i] = As[kk][ty * 4 + i]; b[i] = Bs[kk][tx * 4 + i]; }
#pragma unroll
            for (int i = 0; i < 4; ++i)
#pragma unroll
                for (int j = 0; j < 4; ++j) acc[i][j] += a[i] * b[j]; }
        __syncthreads();
    }
#pragma unroll
    for (int i = 0; i < 4; ++i)
#pragma unroll
        for (int j = 0; j < 4; ++j) { const int m = tm + ty * 4 + i, n = tn + tx * 4 + j; if (m < M && n < N) epi(m, n, acc[i][j]); }
}
struct EpiH { bf16_t* H; float* BA;
    __device__ void operator()(int t, int n, float v) const {
        if (n >= C_BETA && n < C_GATE) BA[(size_t)t * 16 + (n - C_BETA)] = v;
        float o = v;
        if ((n >= C_ZPOOL && n < C_Q) || (n >= C_ZMLA && n < C_QKV) || (n >= C_ZDN && n < C_BETA)) o = siluf_(v);
        else if (n >= C_GATE) o = sigmoidf_(v);
        H[(size_t)t * IN_WP + n] = f2bf(o); } };
struct EpiF32 { float* C; int ldc; int pad_; __device__ void operator()(int t, int n, float v) const { C[(size_t)t * ldc + n] = v; } };
struct EpiKV { bf16_t* Kn; bf16_t* V; __device__ void operator()(int t, int n, float v) const { if (n < 512) Kn[(size_t)t * 512 + n] = f2bf(v); else V[(size_t)t * 512 + (n - 512)] = f2bf(v); } };
struct EpiMerge { const bf16_t* H; float* mf; bf16_t* mb; int br; int pad_;
    __device__ void operator()(int t, int n, float v) const { const float g = bf2f(H[(size_t)t * IN_WP + C_GATE + br * 1024 + n]); float o = g * v; const size_t i = (size_t)t * 1024 + n;
        if (br > 0) o += mf[i]; mf[i] = o; if (br == 2) mb[i] = f2bf(o); } };
struct EpiRes { const float* xp; const float* xs; float* xo;
    __device__ void operator()(int t, int n, float v) const { const float x = t < TP ? xp[(size_t)t * 1024 + n] : xs[(size_t)(t - TP) * 1024 + n]; xo[(size_t)t * 1024 + n] = x + v; } };

__global__ void k_tok_a(const bf16_t* __restrict__ H, const float* __restrict__ qg, const float* __restrict__ kvg, const float2* __restrict__ tab,
                        bf16_t* __restrict__ cq, bf16_t* __restrict__ ckv, bf16_t* __restrict__ Kr, float* __restrict__ out, int layer, int pad_) {
    const int t = blockIdx.x, lane = threadIdx.x; const bf16_t* h = H + (size_t)t * IN_WP;
    float q[6]; float ss = 0.f;
#pragma unroll
    for (int i = 0; i < 6; ++i) { q[i] = bf2f(h[C_Q + lane + 64 * i]); ss += q[i] * q[i]; }
    ss = wave_sum(ss); float r = rsqrtf(ss * (1.0f / 384.0f) + EPS);
#pragma unroll
    for (int i = 0; i < 6; ++i) cq[(size_t)t * 384 + lane + 64 * i] = f2bf(q[i] * r * qg[lane + 64 * i]);
    float kv[4]; ss = 0.f;
#pragma unroll
    for (int i = 0; i < 4; ++i) { kv[i] = bf2f(h[C_KV + lane + 64 * i]); ss += kv[i] * kv[i]; }
    ss = wave_sum(ss); r = rsqrtf(ss * (1.0f / 256.0f) + EPS);
    float* okv; float* okr; int p;
    if (t < TP) { okv = out + O_PKV + ((size_t)layer * TP + t) * 256; okr = out + O_PKR + ((size_t)layer * TP + t) * 32; p = t & (SEQ - 1); }
    else { const int ts = t - TP; okv = out + O_SKV + ((size_t)layer * TS + ts) * 256; okr = out + O_SKR + ((size_t)layer * TS + ts) * 32; p = SEQ + (ts & 7); }
#pragma unroll
    for (int i = 0; i < 4; ++i) { const float o = kv[i] * r * kvg[lane + 64 * i]; okv[lane + 64 * i] = o; ckv[(size_t)t * 256 + lane + 64 * i] = f2bf(o); }
    if (lane < 16) { const float x1 = bf2f(h[C_KR + lane]), x2 = bf2f(h[C_KR + 16 + lane]); const float2 cs = tab[p * 16 + lane];
        const float o1 = x1 * cs.x - x2 * cs.y, o2 = x2 * cs.x + x1 * cs.y;
        okr[lane] = o1; okr[16 + lane] = o2; Kr[(size_t)t * 32 + lane] = f2bf(o1); Kr[(size_t)t * 32 + 16 + lane] = f2bf(o2); }
}

__global__ void k_tok_conv(const bf16_t* __restrict__ H, const float* __restrict__ BA, const float* __restrict__ conv_w, const float* __restrict__ state_conv,
                           const float* __restrict__ a_log, const float* __restrict__ dt_bias, bf16_t* __restrict__ qd, bf16_t* __restrict__ kd, bf16_t* __restrict__ vd,
                           float* __restrict__ bg, float* __restrict__ out, int layer, int pad_) {
    const int t = blockIdx.x, tid = threadIdx.x;
    int i_seq, row0; const float* sc = nullptr;
    if (t < TP) { i_seq = t & (SEQ - 1); row0 = t - i_seq; }
    else { const int ts = t - TP; i_seq = ts & 7; row0 = t - i_seq; sc = state_conv + ((size_t)layer * DEC_BATCH + (ts >> 3)) * 3 * 1536; }
#pragma unroll
    for (int i = 0; i < 6; ++i) {
        const int c = tid + 256 * i; float y = 0.f;
#pragma unroll
        for (int j = 0; j < 4; ++j) { const int u = i_seq - 3 + j; float xv;
            if (u >= 0) xv = bf2f(H[(size_t)(row0 + u) * IN_WP + C_QKV + c]); else xv = sc ? sc[(size_t)(u + 3) * 1536 + c] : 0.f;
            y += xv * conv_w[j * 1536 + c]; }
        float v = siluf_(y);
        if (i < 4) { const float ss = wave_sum(v * v); v *= rsqrtf(ss + EPS); if (i < 2) v *= 0.125f; }
        const bf16_t o = f2bf(v);
        if (i < 2) qd[(size_t)t * 512 + c] = o; else if (i < 4) kd[(size_t)t * 512 + (c - 512)] = o; else vd[(size_t)t * 512 + (c - 1024)] = o;
        if (t < TP) { if (i_seq >= SEQ - 3) out[O_PCONV + (((size_t)layer * 8 + (t >> 11)) * 3 + (i_seq - (SEQ - 3))) * 1536 + c] = bf2f(H[(size_t)t * IN_WP + C_QKV + c]); }
        else { if (i_seq >= DEC_SEQ - 3) out[O_SCONV + (((size_t)layer * DEC_BATCH + ((t - TP) >> 3)) * 3 + (i_seq - (DEC_SEQ - 3))) * 1536 + c] = bf2f(H[(size_t)t * IN_WP + C_QKV + c]); }
    }
    if (tid < 8) { const float b = sigmoidf_(BA[(size_t)t * 16 + tid]); const float x = BA[(size_t)t * 16 + 8 + tid] + dt_bias[tid];
        const float sp = x > 20.f ? x : log1pf(expf(x)); const float g = -expf(a_log[tid]) * sp;
        bg[(size_t)t * 16 + tid] = b; bg[(size_t)t * 16 + 8 + tid] = g; }
}

__global__ void k_pool(const bf16_t* __restrict__ H, const float* __restrict__ state_pool, const float* __restrict__ mix, const float* __restrict__ scale,
                       bf16_t* __restrict__ ya, float* __restrict__ out, int layer, int pad_) {
    const int t = blockIdx.x, g = blockIdx.y, c = threadIdx.x, ch = g * 128 + c; const int w = 2 << g;
    __shared__ float d[128];
    int i_seq, row0; const float* sp = nullptr;
    if (t < TP) { i_seq = t & (SEQ - 1); row0 = t - i_seq; }
    else { const int ts = t - TP; i_seq = ts & 7; row0 = t - i_seq; sp = state_pool + ((size_t)layer * DEC_BATCH + (ts >> 3)) * 15 * 512; }
    float sum = 0.f;
    for (int k = 0; k < w; ++k) { const int u = i_seq - k; float xv;
        if (u >= 0) xv = bf2f(H[(size_t)(row0 + u) * IN_WP + C_POOL + ch]); else xv = sp ? sp[(size_t)(15 + u) * 512 + ch] : 0.f;
        sum += xv; }
    const float cur = bf2f(H[(size_t)t * IN_WP + C_POOL + ch]);
    const float cnt = t < TP ? (float)min(i_seq + 1, w) : (float)w;
    d[c] = sum / cnt - cur;
    __syncthreads();
    float y = 0.f; const float* m = mix + ((size_t)layer * 4 + g) * 128 * 128;
    for (int k = 0; k < 128; ++k) y += d[k] * m[k * 128 + c];
    y *= scale[layer * 512 + ch];
    y *= bf2f(H[(size_t)t * IN_WP + C_ZPOOL + ch]);
    ya[(size_t)t * 512 + ch] = f2bf(y);
    if (t < TP) { if (i_seq >= SEQ - 15) out[O_PPOOL + (((size_t)layer * 8 + (t >> 11)) * 15 + (i_seq - (SEQ - 15))) * 512 + ch] = cur; }
    else { const int s = (t - TP) >> 3; float* o = out + O_SPOOL + ((size_t)layer * DEC_BATCH + s) * 15 * 512;
        o[(size_t)(7 + i_seq) * 512 + ch] = cur;
        if (i_seq < 7) o[(size_t)i_seq * 512 + ch] = sp[(size_t)(8 + i_seq) * 512 + ch]; }
}

__global__ void k_qrope(const float* __restrict__ Qf, const float2* __restrict__ tab, bf16_t* __restrict__ Q) {
    const int t = blockIdx.x, tid = threadIdx.x;
    const int h = tid >> 5, j = tid & 31; const float* q = Qf + (size_t)t * 768 + h * 96; bf16_t* o = Q + (size_t)t * 768 + h * 96;
    o[j] = f2bf(q[j]); o[32 + j] = f2bf(q[32 + j]);
    const int p = t < TP ? (t & (SEQ - 1)) : SEQ + ((t - TP) & 7);
    if (j < 16) { const float x1 = q[64 + j], x2 = q[80 + j]; const float2 cs = tab[p * 16 + j]; o[64 + j] = f2bf(x1 * cs.x - x2 * cs.y); o[80 + j] = f2bf(x2 * cs.x + x1 * cs.y); }
}
__global__ void k_qlat(const bf16_t* __restrict__ Q, const float* __restrict__ w_uk, bf16_t* __restrict__ Qlat) {
    const int ts = blockIdx.x, h = blockIdx.y, c = threadIdx.x;
    const bf16_t* q = Q + (size_t)(TP + ts) * 768 + h * 96; float acc = 0.f;
    for (int d = 0; d < 64; ++d) acc += bf2f(q[d]) * w_uk[(size_t)c * 512 + h * 64 + d];
    bf16_t* o = Qlat + ((size_t)ts * 8 + h) * 288; o[c] = f2bf(acc); if (c < 32) o[256 + c] = q[64 + c];
}

__global__ void __launch_bounds__(64) k_attn_p(const bf16_t* __restrict__ Q, const bf16_t* __restrict__ Kn, const bf16_t* __restrict__ Kr, const bf16_t* __restrict__ V,
                                               const bf16_t* __restrict__ H, bf16_t* __restrict__ yb) {
    const int qb = blockIdx.x, h = blockIdx.y, b = blockIdx.z, lane = threadIdx.x; const int i = qb * 64 + lane, t = b * SEQ + i;
    float q[96];
#pragma unroll
    for (int d = 0; d < 96; ++d) q[d] = bf2f(Q[(size_t)t * 768 + h * 96 + d]) * MLA_SCALE;
    float o[64];
#pragma unroll
    for (int d = 0; d < 64; ++d) o[d] = 0.f;
    float m = -1e30f, l = 0.f;
    const int jmax = qb * 64 + 63;
    for (int j = 0; j <= jmax; ++j) {
        const size_t tk = (size_t)b * SEQ + j; const bf16_t* kn = Kn + tk * 512 + h * 64; const bf16_t* kr = Kr + tk * 32; const bf16_t* vv = V + tk * 512 + h * 64;
        float s = 0.f;
#pragma unroll
        for (int d = 0; d < 64; ++d) s += q[d] * bf2f(kn[d]);
#pragma unroll
        for (int d = 0; d < 32; ++d) s += q[64 + d] * bf2f(kr[d]);
        if (j <= i) {
            const float mn = fmaxf(m, s), al = __expf(m - mn), p = __expf(s - mn); l = l * al + p; m = mn;
#pragma unroll
            for (int d = 0; d < 64; ++d) o[d] = o[d] * al + p * bf2f(vv[d]);
        }
    }
    const float il = 1.0f / l;
#pragma unroll
    for (int d = 0; d < 64; ++d) yb[(size_t)t * 512 + h * 64 + d] = f2bf(o[d] * il * bf2f(H[(size_t)t * IN_WP + C_ZMLA + h * 64 + d]));
}

#define SA_CH 33
__global__ void __launch_bounds__(256) k_attn_s(const bf16_t* __restrict__ Qlat, const float* __restrict__ ckv_cache, const float* __restrict__ kr_cache, const int* __restrict__ page_table,
                                                const bf16_t* __restrict__ ckv_new, const bf16_t* __restrict__ kr_new, float* __restrict__ part, int layer, int pad_) {
    const int s = blockIdx.x, ch = blockIdx.y, tid = threadIdx.x, r = tid & 63, cq = tid >> 6;
    __shared__ bf16_t Ks[32][296];
    __shared__ float Ss[64][33];
    __shared__ bf16_t Qs[64][290];
    for (int i = tid; i < 64 * 288; i += 256) { const int rr = i / 288, c = i % 288; Qs[rr][c] = Qlat[((size_t)s * 64 + rr) * 288 + c]; }
    float o[64];
#pragma unroll
    for (int d = 0; d < 64; ++d) o[d] = 0.f;
    float m = -1e30f, l = 0.f;
    const int i_tok = r >> 3;
    const int ntile = ch < 32 ? 16 : 1;
    for (int tl = 0; tl < ntile; ++tl) {
        __syncthreads();
        if (ch < 32) { const int j0 = ch * 512 + tl * 32; const int page = page_table[s * N_PAGES + (j0 >> 7)]; const int prow = j0 & 127;
            const float* kvp = ckv_cache + (((size_t)layer * N_POOL + page) * PAGE + prow) * 256; const float* krp = kr_cache + (((size_t)layer * N_POOL + page) * PAGE + prow) * 32;
            for (int i = tid; i < 32 * 256; i += 256) Ks[i >> 8][i & 255] = f2bf(kvp[i]);
            for (int i = tid; i < 32 * 32; i += 256) Ks[i >> 5][256 + (i & 31)] = f2bf(krp[i]);
        } else {
            for (int i = tid; i < 32 * 256; i += 256) { const int k = i >> 8; Ks[k][i & 255] = k < 8 ? ckv_new[((size_t)TP + s * 8 + k) * 256 + (i & 255)] : (bf16_t)0; }
            for (int i = tid; i < 32 * 32; i += 256) { const int k = i >> 5; Ks[k][256 + (i & 31)] = k < 8 ? kr_new[((size_t)TP + s * 8 + k) * 32 + (i & 31)] : (bf16_t)0; }
        }
        __syncthreads();
#pragma unroll
        for (int kk = 0; kk < 8; ++kk) { const int k = cq * 8 + kk; float sc = 0.f;
            for (int c = 0; c < 288; ++c) sc += bf2f(Qs[r][c]) * bf2f(Ks[k][c]);
            sc *= MLA_SCALE; if (ch == 32 && k > i_tok) sc = -1e30f; Ss[r][k] = sc; }
        __syncthreads();
        float tm = -1e30f;
        for (int k = 0; k < 32; ++k) tm = fmaxf(tm, Ss[r][k]);
        const float mn = fmaxf(m, tm), al = __expf(m - mn); m = mn; l *= al;
#pragma unroll
        for (int d = 0; d < 64; ++d) o[d] *= al;
        for (int k = 0; k < 32; ++k) { const float sc = Ss[r][k]; const float p = sc <= -1e29f ? 0.f : __expf(sc - mn); l += p;
#pragma unroll
            for (int d = 0; d < 64; ++d) o[d] += p * bf2f(Ks[k][cq * 64 + d]); }
    }
    float* pp = part + (((size_t)s * SA_CH + ch) * 64 + r) * 258;
#pragma unroll
    for (int d = 0; d < 64; ++d) pp[cq * 64 + d] = o[d];
    if (cq == 0) { pp[256] = m; pp[257] = l; }
}
__global__ void k_attn_s_fin(const float* __restrict__ part, const float* __restrict__ w_uv, const bf16_t* __restrict__ H, bf16_t* __restrict__ yb) {
    const int ts = blockIdx.x, h = blockIdx.y, d = threadIdx.x; const int s = ts >> 3, r = (ts & 7) * 8 + h;
    __shared__ float ol[256]; __shared__ float wgt[SA_CH];
    float M = -1e30f;
    for (int ch = 0; ch < SA_CH; ++ch) M = fmaxf(M, part[(((size_t)s * SA_CH + ch) * 64 + r) * 258 + 256]);
    float L = 0.f;
    for (int ch = 0; ch < SA_CH; ++ch) { const float* pp = part + (((size_t)s * SA_CH + ch) * 64 + r) * 258; const float w = __expf(pp[256] - M); L += pp[257] * w; if (d == 0) wgt[ch] = w; }
    __syncthreads();
    for (int c = d; c < 256; c += 64) { float a = 0.f; for (int ch = 0; ch < SA_CH; ++ch) a += wgt[ch] * part[(((size_t)s * SA_CH + ch) * 64 + r) * 258 + c]; ol[c] = a / L; }
    __syncthreads();
    float a = 0.f;
    for (int c = 0; c < 256; ++c) a += ol[c] * w_uv[(size_t)c * 512 + h * 64 + d];
    const int t = TP + ts;
    yb[(size_t)t * 512 + h * 64 + d] = f2bf(a * bf2f(H[(size_t)t * IN_WP + C_ZMLA + h * 64 + d]));
}

__global__ void __launch_bounds__(64) k_delta(const bf16_t* __restrict__ qd, const bf16_t* __restrict__ kd, const bf16_t* __restrict__ vd, const float* __restrict__ bg,
                                              const float* __restrict__ state_delta, const float* __restrict__ dn_g, const bf16_t* __restrict__ H, bf16_t* __restrict__ yc,
                                              float* __restrict__ out, int layer, int pad_) {
    const int sq = blockIdx.x, h = blockIdx.y, dv = threadIdx.x;
    int row0, L; float* so; float S[64];
    if (sq < 8) { row0 = sq * SEQ; L = SEQ; so = out + O_PDELTA + (((size_t)layer * 8 + sq) * 8 + h) * 4096;
#pragma unroll
        for (int k = 0; k < 64; ++k) S[k] = 0.f; }
    else { const int s = sq - 8; row0 = TP + s * 8; L = DEC_SEQ; so = out + O_SDELTA + (((size_t)layer * DEC_BATCH + s) * 8 + h) * 4096;
        const float* s0 = state_delta + (((size_t)layer * DEC_BATCH + s) * 8 + h) * 4096;
#pragma unroll
        for (int k = 0; k < 64; ++k) S[k] = s0[k * 64 + dv]; }
    const float gn = dn_g[layer * 64 + dv];
    for (int i = 0; i < L; ++i) {
        const size_t t = (size_t)row0 + i; const bf16_t* kp = kd + t * 512 + h * 64; const bf16_t* qp = qd + t * 512 + h * 64;
        const float b = bg[t * 16 + h], a = __expf(bg[t * 16 + 8 + h]); const float v = bf2f(vd[t * 512 + h * 64 + dv]);
        float ks = 0.f;
#pragma unroll
        for (int k = 0; k < 64; ++k) ks += bf2f(kp[k]) * S[k];
        const float vn = b * (v - a * ks);
        float o = 0.f;
#pragma unroll
        for (int k = 0; k < 64; ++k) { S[k] = a * S[k] + bf2f(kp[k]) * vn; o += bf2f(qp[k]) * S[k]; }
        const float ss = wave_sum(o * o); const float y = o * rsqrtf(ss * (1.0f / 64.0f) + EPS) * gn;
        yc[t * 512 + h * 64 + dv] = f2bf(y * bf2f(H[t * IN_WP + C_ZDN + h * 64 + dv]));
    }
#pragma unroll
    for (int k = 0; k < 64; ++k) so[k * 64 + dv] = S[k];
}

static inline size_t al256(size_t x) { return (x + 255) & ~(size_t)255; }
extern "C" void kernel_launch(void* const* d_in, const int* in_sizes, int n_in, void* d_out, int out_size, void* d_ws, size_t ws_size, hipStream_t stream) {
    const float* x_prompt = (const float*)d_in[0]; const float* x_sample = (const float*)d_in[1];
    const float* cache_kv = (const float*)d_in[2]; const float* cache_kr = (const float*)d_in[3];
    const float* state_pool = (const float*)d_in[4]; const float* state_conv = (const float*)d_in[5]; const float* state_delta = (const float*)d_in[6];
    const int* page_table = (const int*)d_in[7];
    const float* norm_g = (const float*)d_in[8]; const float* w_in = (const float*)d_in[9]; const float* pool_mix = (const float*)d_in[10]; const float* pool_scale = (const float*)d_in[11];
    const float* q_norm_g = (const float*)d_in[12]; const float* w_uq = (const float*)d_in[13]; const float* kv_norm_g = (const float*)d_in[14]; const float* w_uk = (const float*)d_in[15];
    const float* w_uv = (const float*)d_in[16]; const float* conv_w = (const float*)d_in[17]; const float* a_log = (const float*)d_in[18]; const float* dt_bias = (const float*)d_in[19];
    const float* dn_norm_g = (const float*)d_in[20]; const float* w_br[3] = {(const float*)d_in[21], (const float*)d_in[22], (const float*)d_in[23]};
    const float* w_out = (const float*)d_in[24]; const float* final_norm_g = (const float*)d_in[25];
    float* out = (float*)d_out;
    char* w = (char*)d_ws; size_t off = 0;
    auto take = [&](size_t bytes) { char* p = w + off; off += al256(bytes); return p; };
    bf16_t* WinT = (bf16_t*)take((size_t)2 * IN_WP * 1024 * 2);
    bf16_t* WuqT = (bf16_t*)take((size_t)2 * 768 * 384 * 2);
    bf16_t* WkvT = (bf16_t*)take((size_t)2 * 1024 * 256 * 2);
    bf16_t* WbrT = (bf16_t*)take((size_t)2 * 3 * 1024 * 512 * 2);
    bf16_t* WoutT = (bf16_t*)take((size_t)2 * 1024 * 1024 * 2);
    float2* tab = (float2*)take((size_t)(SEQ + DEC_SEQ) * 16 * 8);
    float* xres = (float*)take((size_t)TT * 1024 * 4);
    bf16_t* xn = (bf16_t*)take((size_t)TT * 1024 * 2);
    bf16_t* H = (bf16_t*)take((size_t)TT * IN_WP * 2);
    float* BA = (float*)take((size_t)TT * 16 * 4);
    bf16_t* cq = (bf16_t*)take((size_t)TT * 384 * 2);
    bf16_t* ckv = (bf16_t*)take((size_t)TT * 256 * 2);
    bf16_t* Kr = (bf16_t*)take((size_t)TT * 32 * 2);
    float* Qf = (float*)take((size_t)TT * 768 * 4);
    bf16_t* Q = (bf16_t*)take((size_t)TT * 768 * 2);
    bf16_t* Qlat = (bf16_t*)take((size_t)TS * 8 * 288 * 2);
    bf16_t* Kn = (bf16_t*)take((size_t)TP * 512 * 2);
    bf16_t* V = (bf16_t*)take((size_t)TP * 512 * 2);
    bf16_t* qd = (bf16_t*)take((size_t)TT * 512 * 2);
    bf16_t* kd = (bf16_t*)take((size_t)TT * 512 * 2);
    bf16_t* vd = (bf16_t*)take((size_t)TT * 512 * 2);
    float* bg = (float*)take((size_t)TT * 16 * 4);
    bf16_t* ya = (bf16_t*)take((size_t)TT * 512 * 2);
    bf16_t* yb = (bf16_t*)take((size_t)TT * 512 * 2);
    bf16_t* yc = (bf16_t*)take((size_t)TT * 512 * 2);
    float* mf = (float*)take((size_t)TT * 1024 * 4);
    bf16_t* mb = (bf16_t*)take((size_t)TT * 1024 * 2);
    float* part = (float*)take((size_t)DEC_BATCH * SA_CH * 64 * 258 * 4);

    for (int l = 0; l < 2; ++l) {
        k_tr<<<dim3(IN_WP / 32, 1024 / 32), 256, 0, stream>>>(w_in + (size_t)l * 1024 * IN_W, WinT + (size_t)l * IN_WP * 1024, 1024, IN_W, IN_WP, 0);
        k_tr<<<dim3(768 / 32, 384 / 32), 256, 0, stream>>>(w_uq + (size_t)l * 384 * 768, WuqT + (size_t)l * 768 * 384, 384, 768, 768, 0);
        k_tr<<<dim3(512 / 32, 256 / 32), 256, 0, stream>>>(w_uk + (size_t)l * 256 * 512, WkvT + (size_t)l * 1024 * 256, 256, 512, 512, 0);
        k_tr<<<dim3(512 / 32, 256 / 32), 256, 0, stream>>>(w_uv + (size_t)l * 256 * 512, WkvT + (size_t)l * 1024 * 256 + (size_t)512 * 256, 256, 512, 512, 0);
        for (int b = 0; b < 3; ++b) k_tr<<<dim3(1024 / 32, 512 / 32), 256, 0, stream>>>(w_br[b] + (size_t)l * 512 * 1024, WbrT + ((size_t)l * 3 + b) * 1024 * 512, 512, 1024, 1024, 0);
        k_tr<<<dim3(1024 / 32, 1024 / 32), 256, 0, stream>>>(w_out + (size_t)l * 1024 * 1024, WoutT + (size_t)l * 1024 * 1024, 1024, 1024, 1024, 0);
    }
    k_rope_tab<<<((SEQ + DEC_SEQ) * 16 + 255) / 256, 256, 0, stream>>>(tab);

    for (int l = 0; l < 2; ++l) {
        const float* xp = l == 0 ? x_prompt : xres; const float* xs = l == 0 ? x_sample : xres + (size_t)TP * 1024;
        k_rmsnorm<<<TT, 256, 0, stream>>>(xp, xs, norm_g + l * 1024, xn, nullptr, nullptr);
        k_gemm<EpiH><<<dim3(IN_W / 64 + 1, TT / 64), 256, 0, stream>>>(xn, WinT + (size_t)l * IN_WP * 1024, 1024, 1024, TT, IN_W, 1024, 0, EpiH{H, BA});
        k_tok_a<<<TT, 64, 0, stream>>>(H, q_norm_g + l * 384, kv_norm_g + l * 256, tab, cq, ckv, Kr, out, l, 0);
        k_tok_conv<<<TT, 256, 0, stream>>>(H, BA, conv_w + (size_t)l * 4 * 1536, state_conv, a_log + l * 8, dt_bias + l * 8, qd, kd, vd, bg, out, l, 0);
        k_pool<<<dim3(TT, 4), 128, 0, stream>>>(H, state_pool, pool_mix, pool_scale, ya, out, l, 0);
        k_gemm<EpiF32><<<dim3(768 / 64, TT / 64), 256, 0, stream>>>(cq, WuqT + (size_t)l * 768 * 384, 384, 384, TT, 768, 384, 0, EpiF32{Qf, 768, 0});
        k_qrope<<<TT, 256, 0, stream>>>(Qf, tab, Q);
        k_qlat<<<dim3(TS, 8), 256, 0, stream>>>(Q, w_uk + (size_t)l * 256 * 512, Qlat);
        k_gemm<EpiKV><<<dim3(1024 / 64, TP / 64), 256, 0, stream>>>(ckv, WkvT + (size_t)l * 1024 * 256, 256, 256, TP, 1024, 256, 0, EpiKV{Kn, V});
        k_attn_p<<<dim3(SEQ / 64, 8, 8), 64, 0, stream>>>(Q, Kn, Kr, V, H, yb);
        k_attn_s<<<dim3(DEC_BATCH, SA_CH), 256, 0, stream>>>(Qlat, cache_kv, cache_kr, page_table, ckv, Kr, part, l, 0);
        k_attn_s_fin<<<dim3(TS, 8), 64, 0, stream>>>(part, w_uv + (size_t)l * 256 * 512, H, yb);
        k_delta<<<dim3(8 + DEC_BATCH, 8), 64, 0, stream>>>(qd, kd, vd, bg, state_delta, dn_norm_g, H, yc, out, l, 0);
        const bf16_t* ys[3] = {ya, yb, yc};
        for (int b = 0; b < 3; ++b)
            k_gemm<EpiMerge><<<dim3(1024 / 64, TT / 64), 256, 0, stream>>>(ys[b], WbrT + ((size_t)l * 3 + b) * 1024 * 512, 512, 512, TT, 1024, 512, 0, EpiMerge{H, mf, mb, b, 0});
        k_gemm<EpiRes><<<dim3(1024 / 64, TT / 64), 256, 0, stream>>>(mb, WoutT + (size_t)l * 1024 * 1024, 1024, 1024, TT, 1024, 1024, 0, EpiRes{xp, xs, xres});
    }
    k_rmsnorm<<<TT, 256, 0, stream>>>(xres, xres + (size_t)TP * 1024, final_norm_g, nullptr, out + O_YP, out + O_YS);
}
```

```cpp
#include <hip/hip_runtime.h>
#include <stdint.h>

typedef unsigned short bf16_t;

#define D_MODEL 1024
#define TP 16384
#define TS 256
#define TT (TP + TS)
#define SEQ 2048
#define DEC_SEQ 8
#define DEC_BATCH 32
#define PAST_LEN 16384
#define PAGE 128
#define N_PAGES 128
#define N_POOL 5120
#define IN_W 7344
#define IN_WP 7424
#define C_POOL 0
#define C_ZPOOL 512
#define C_Q 1024
#define C_KV 1408
#define C_KR 1664
#define C_ZMLA 1696
#define C_QKV 2208
#define C_ZDN 3744
#define C_BETA 4256
#define C_ALPHA 4264
#define C_GATE 4272
#define EPS 1e-6f
#define MLA_SCALE 0.10206207261596577f

#define O_YP 0
#define O_YS (O_YP + 16777216)
#define O_PKV (O_YS + 262144)
#define O_PKR (O_PKV + 8388608)
#define O_PPOOL (O_PKR + 1048576)
#define O_PCONV (O_PPOOL + 122880)
#define O_PDELTA (O_PCONV + 73728)
#define O_SKV (O_PDELTA + 524288)
#define O_SKR (O_SKV + 131072)
#define O_SPOOL (O_SKR + 16384)
#define O_SCONV (O_SPOOL + 491520)
#define O_SDELTA (O_SCONV + 294912)
#define O_END (O_SDELTA + 2097152)

__device__ __forceinline__ float bf2f(bf16_t b) { return __uint_as_float(((unsigned)b) << 16); }
__device__ __forceinline__ bf16_t f2bf(float f) { unsigned u = __float_as_uint(f); u += 0x7FFFu + ((u >> 16) & 1u); return (bf16_t)(u >> 16); }
__device__ __forceinline__ float sigmoidf_(float v) { return 1.0f / (1.0f + __expf(-v)); }
__device__ __forceinline__ float siluf_(float v) { return v / (1.0f + __expf(-v)); }
__device__ __forceinline__ float wave_sum(float v) {
#pragma unroll
    for (int o = 32; o >= 1; o >>= 1) v += __shfl_xor(v, o);
    return v;
}

__global__ void k_tr(const float* __restrict__ src, bf16_t* __restrict__ dst, int K, int N, int Npad, int pad_) {
    __shared__ float tile[32][33];
    const int n0 = blockIdx.x * 32, k0 = blockIdx.y * 32, tx = threadIdx.x & 31, ty = threadIdx.x >> 5;
    for (int i = ty; i < 32; i += 8) { const int k = k0 + i, n = n0 + tx; tile[i][tx] = (n < N) ? src[(size_t)k * N + n] : 0.f; }
    __syncthreads();
    for (int i = ty; i < 32; i += 8) { const int n = n0 + i, k = k0 + tx; if (n < Npad) dst[(size_t)n * K + k] = f2bf(tile[tx][i]); }
}
__global__ void k_rope_tab(float2* tab) {
    const int idx = blockIdx.x * blockDim.x + threadIdx.x; if (idx >= (SEQ + DEC_SEQ) * 16) return;
    const int p = idx >> 4, i = idx & 15; const int pos = p < SEQ ? p : PAST_LEN + (p - SEQ);
    const float inv = powf(10000.0f, -(float)i / 16.0f);
    const float ang = (float)pos * inv;
    const double rev = (double)ang * 0.15915494309189533576888; const double fr = rev - floor(rev);
    const float f = (float)fr;
    tab[idx] = make_float2(__builtin_amdgcn_cosf(f), __builtin_amdgcn_sinf(f));
}

__global__ void k_rmsnorm(const float* __restrict__ xp, const float* __restrict__ xs, const float* __restrict__ g, bf16_t* __restrict__ xn, float* __restrict__ yp, float* __restrict__ ys) {
    const int t = blockIdx.x; const float* x = t < TP ? xp + (size_t)t * D_MODEL : xs + (size_t)(t - TP) * D_MODEL;
    __shared__ float red[4];
    float v[4]; float ss = 0.f;
#pragma unroll
    for (int i = 0; i < 4; ++i) { v[i] = x[threadIdx.x + 256 * i]; ss += v[i] * v[i]; }
    ss = wave_sum(ss); if ((threadIdx.x & 63) == 0) red[threadIdx.x >> 6] = ss; __syncthreads();
    const float tot = red[0] + red[1] + red[2] + red[3]; const float r = rsqrtf(tot * (1.0f / D_MODEL) + EPS);
#pragma unroll
    for (int i = 0; i < 4; ++i) { const int c = threadIdx.x + 256 * i; const float o = v[i] * r * g[c];
        if (xn) xn[(size_t)t * D_MODEL + c] = f2bf(o);
        else { if (t < TP) yp[(size_t)t * D_MODEL + c] = o; else ys[(size_t)(t - TP) * D_MODEL + c] = o; } }
}

template <class Epi> __global__ void k_gemm(const bf16_t* __restrict__ A, const bf16_t* __restrict__ Bt, int lda, int ldb, int M, int N, int K, int pad_, Epi epi) {
    __shared__ float As[16][68], Bs[16][68];
    const int tm = blockIdx.y * 64, tn = blockIdx.x * 64, tx = threadIdx.x & 15, ty = threadIdx.x >> 4;
    float acc[4][4];
#pragma unroll
    for (int i = 0; i < 4; ++i)
#pragma unroll
        for (int j = 0; j < 4; ++j) acc[i][j] = 0.f;
    for (int k0 = 0; k0 < K; k0 += 16) {
        for (int i = threadIdx.x; i < 1024; i += 256) { const int r = i >> 4, c = i & 15;
            As[c][r] = (tm + r < M) ? bf2f(A[(size_t)(tm + r) * lda + k0 + c]) : 0.f;
            Bs[c][r] = (tn + r < N) ? bf2f(Bt[(size_t)(tn + r) * ldb + k0 + c]) : 0.f; }
        __syncthreads();
#pragma unroll
        for (int kk = 0; kk < 16; ++kk) { float a[4], b[4];
#pragma unroll
            for (int i = 0; i < 4; ++i) { a[i] = As[kk][ty * 4 + i]; b[i] = Bs[kk][tx * 4 + i]; }
#pragma unroll
            for (int i = 0; i < 4; ++i)
#pragma unroll
                for (int j = 0; j < 4; ++j) acc[i][j] += a[i] * b[j]; }
        __syncthreads();
    }
#pragma unroll
    for (int i = 0; i < 4; ++i)
#pragma unroll
        for (int j = 0; j < 4; ++j) { const int m = tm + ty * 4 + i, n = tn + tx * 4 + j; if (m < M && n < N) epi(m, n, acc[i][j]); }
}
struct EpiH { bf16_t* H; float* BA;
    __device__ void operator()(int t, int n, float v) const {
        if (n >= C_BETA && n < C_GATE) BA[(size_t)t * 16 + (n - C_BETA)] = v;
        float o = v;
        if ((n >= C_ZPOOL && n < C_Q) || (n >= C_ZMLA && n < C_QKV) || (n >= C_ZDN && n < C_BETA)) o = siluf_(v);
        else if (n >= C_GATE) o = sigmoidf_(v);
        H[(size_t)t * IN_WP + n] = f2bf(o); } };
struct EpiF32 { float* C; int ldc; int pad_; __device__ void operator()(int t, int n, float v) const { C[(size_t)t * ldc + n] = v; } };
struct EpiKV { bf16_t* Kn; bf16_t* V; __device__ void operator()(int t, int n, float v) const { if (n < 512) Kn[(size_t)t * 512 + n] = f2bf(v); else V[(size_t)t * 512 + (n - 512)] = f2bf(v); } };
struct EpiMerge { const bf16_t* H; float* mf; bf16_t* mb; int br; int pad_;
    __device__ void operator()(int t, int n, float v) const { const float g = bf2f(H[(size_t)t * IN_WP + C_GATE + br * 1024 + n]); float o = g * v; const size_t i = (size_t)t * 1024 + n;
        if (br > 0) o += mf[i]; mf[i] = o; if (br == 2) mb[i] = f2bf(o); } };
struct EpiRes { const float* xp; const float* xs; float* xo;
    __device__ void operator()(int t, int n, float v) const { const float x = t < TP ? xp[(size_t)t * 1024 + n] : xs[(size_t)(t - TP) * 1024 + n]; xo[(size_t)t * 1024 + n] = x + v; } };

__global__ void k_tok_a(const bf16_t* __restrict__ H, const float* __restrict__ qg, const float* __restrict__ kvg, const float2* __restrict__ tab,
                        bf16_t* __restrict__ cq, bf16_t* __restrict__ ckv, bf16_t* __restrict__ Kr, float* __restrict__ out, int layer, int pad_) {
    const int t = blockIdx.x, lane = threadIdx.x; const bf16_t* h = H + (size_t)t * IN_WP;
    float q[6]; float ss = 0.f;
#pragma unroll
    for (int i = 0; i < 6; ++i) { q[i] = bf2f(h[C_Q + lane + 64 * i]); ss += q[i] * q[i]; }
    ss = wave_sum(ss); float r = rsqrtf(ss * (1.0f / 384.0f) + EPS);
#pragma unroll
    for (int i = 0; i < 6; ++i) cq[(size_t)t * 384 + lane + 64 * i] = f2bf(q[i] * r * qg[lane + 64 * i]);
    float kv[4]; ss = 0.f;
#pragma unroll
    for (int i = 0; i < 4; ++i) { kv[i] = bf2f(h[C_KV + lane + 64 * i]); ss += kv[i] * kv[i]; }
    ss = wave_sum(ss); r = rsqrtf(ss * (1.0f / 256.0f) + EPS);
    float* okv; float* okr; int p;
    if (t < TP) { okv = out + O_PKV + ((size_t)layer * TP + t) * 256; okr = out + O_PKR + ((size_t)layer * TP + t) * 32; p = t & (SEQ - 1); }
    else { const int ts = t - TP; okv = out + O_SKV + ((size_t)layer * TS + ts) * 256; okr = out + O_SKR + ((size_t)layer * TS + ts) * 32; p = SEQ + (ts & 7); }
#pragma unroll
    for (int i = 0; i < 4; ++i) { const float o = kv[i] * r * kvg[lane + 64 * i]; okv[lane + 64 * i] = o; ckv[(size_t)t * 256 + lane + 64 * i] = f2bf(o); }
    if (lane < 16) { const float x1 = bf2f(h[C_KR + lane]), x2 = bf2f(h[C_KR + 16 + lane]); const float2 cs = tab[p * 16 + lane];
        const float o1 = x1 * cs.x - x2 * cs.y, o2 = x2 * cs.x + x1 * cs.y;
        okr[lane] = o1; okr[16 + lane] = o2; Kr[(size_t)t * 32 + lane] = f2bf(o1); Kr[(size_t)t * 32 + 16 + lane] = f2bf(o2); }
}

__global__ void k_tok_conv(const bf16_t* __restrict__ H, const float* __restrict__ BA, const float* __restrict__ conv_w, const float* __restrict__ state_conv,
                           const float* __restrict__ a_log, const float* __restrict__ dt_bias, bf16_t* __restrict__ qd, bf16_t* __restrict__ kd, bf16_t* __restrict__ vd,
                           float* __restrict__ bg, float* __restrict__ out, int layer, int pad_) {
    const int t = blockIdx.x, tid = threadIdx.x;
    int i_seq, row0; const float* sc = nullptr;
    if (t < TP) { i_seq = t & (SEQ - 1); row0 = t - i_seq; }
    else { const int ts = t - TP; i_seq = ts & 7; row0 = t - i_seq; sc = state_conv + ((size_t)layer * DEC_BATCH + (ts >> 3)) * 3 * 1536; }
#pragma unroll
    for (int i = 0; i < 6; ++i) {
        const int c = tid + 256 * i; float y = 0.f;
#pragma unroll
        for (int j = 0; j < 4; ++j) { const int u = i_seq - 3 + j; float xv;
            if (u >= 0) xv = bf2f(H[(size_t)(row0 + u) * IN_WP + C_QKV + c]); else xv = sc ? sc[(size_t)(u + 3) * 1536 + c] : 0.f;
            y += xv * conv_w[j * 1536 + c]; }
        float v = siluf_(y);
        if (i < 4) { const float ss = wave_sum(v * v); v *= rsqrtf(ss + EPS); if (i < 2) v *= 0.125f; }
        const bf16_t o = f2bf(v);
        if (i < 2) qd[(size_t)t * 512 + c] = o; else if (i < 4) kd[(size_t)t * 512 + (c - 512)] = o; else vd[(size_t)t * 512 + (c - 1024)] = o;
        if (t < TP) { if (i_seq >= SEQ - 3) out[O_PCONV + (((size_t)layer * 8 + (t >> 11)) * 3 + (i_seq - (SEQ - 3))) * 1536 + c] = bf2f(H[(size_t)t * IN_WP + C_QKV + c]); }
        else { if (i_seq >= DEC_SEQ - 3) out[O_SCONV + (((size_t)layer * DEC_BATCH + ((t - TP) >> 3)) * 3 + (i_seq - (DEC_SEQ - 3))) * 1536 + c] = bf2f(H[(size_t)t * IN_WP + C_QKV + c]); }
    }
    if (tid < 8) { const float b = sigmoidf_(BA[(size_t)t * 16 + tid]); const float x = BA[(size_t)t * 16 + 8 + tid] + dt_bias[tid];
        const float sp = x > 20.f ? x : log1pf(expf(x)); const float g = -expf(a_log[tid]) * sp;
        bg[(size_t)t * 16 + tid] = b; bg[(size_t)t * 16 + 8 + tid] = g; }
}

__global__ void k_pool(const bf16_t* __restrict__ H, const float* __restrict__ state_pool, const float* __restrict__ mix, const float* __restrict__ scale,
                       bf16_t* __restrict__ ya, float* __restrict__ out, int layer, int pad_) {
    const int t = blockIdx.x, g = blockIdx.y, c = threadIdx.x, ch = g * 128 + c; const int w = 2 << g;
    __shared__ float d[128];
    int i_seq, row0; const float* sp = nullptr;
    if (t < TP) { i_seq = t & (SEQ - 1); row0 = t - i_seq; }
    else { const int ts = t - TP; i_seq = ts & 7; row0 = t - i_seq; sp = state_pool + ((size_t)layer * DEC_BATCH + (ts >> 3)) * 15 * 512; }
    float sum = 0.f;
    for (int k = 0; k < w; ++k) { const int u = i_seq - k; float xv;
        if (u >= 0) xv = bf2f(H[(size_t)(row0 + u) * IN_WP + C_POOL + ch]); else xv = sp ? sp[(size_t)(15 + u) * 512 + ch] : 0.f;
        sum += xv; }
    const float cur = bf2f(H[(size_t)t * IN_WP + C_POOL + ch]);
    const float cnt = t < TP ? (float)min(i_seq + 1, w) : (float)w;
    d[c] = sum / cnt - cur;
    __syncthreads();
    float y = 0.f; const float* m = mix + ((size_t)layer * 4 + g) * 128 * 128;
    for (int k = 0; k < 128; ++k) y += d[k] * m[k * 128 + c];
    y *= scale[layer * 512 + ch];
    y *= bf2f(H[(size_t)t * IN_WP + C_ZPOOL + ch]);
    ya[(size_t)t * 512 + ch] = f2bf(y);
    if (t < TP) { if (i_seq >= SEQ - 15) out[O_PPOOL + (((size_t)layer * 8 + (t >> 11)) * 15 + (i_seq - (SEQ - 15))) * 512 + ch] = cur; }
    else { const int s = (t - TP) >> 3; float* o = out + O_SPOOL + ((size_t)layer * DEC_BATCH + s) * 15 * 512;
        o[(size_t)(7 + i_seq) * 512 + ch] = cur;
        if (i_seq < 7) o[(size_t)i_seq * 512 + ch] = sp[(size_t)(8 + i_seq) * 512 + ch]; }
}

__global__ void k_qrope(const float* __restrict__ Qf, const float2* __restrict__ tab, bf16_t* __restrict__ Q) {
    const int t = blockIdx.x, tid = threadIdx.x;
    const int h = tid >> 5, j = tid & 31; const float* q = Qf + (size_t)t * 768 + h * 96; bf16_t* o = Q + (size_t)t * 768 + h * 96;
    o[j] = f2bf(q[j]); o[32 + j] = f2bf(q[32 + j]);
    const int p = t < TP ? (t & (SEQ - 1)) : SEQ + ((t - TP) & 7);
    if (j < 16) { const float x1 = q[64 + j], x2 = q[80 + j]; const float2 cs = tab[p * 16 + j]; o[64 + j] = f2bf(x1 * cs.x - x2 * cs.y); o[80 + j] = f2bf(x2 * cs.x + x1 * cs.y); }
}
__global__ void k_qlat(const bf16_t* __restrict__ Q, const float* __restrict__ w_uk, bf16_t* __restrict__ Qlat) {
    const int ts = blockIdx.x, h = blockIdx.y, c = threadIdx.x;
    const bf16_t* q = Q + (size_t)(TP + ts) * 768 + h * 96; float acc = 0.f;
    for (int d = 0; d < 64; ++d) acc += bf2f(q[d]) * w_uk[(size_t)c * 512 + h * 64 + d];
    bf16_t* o = Qlat + ((size_t)ts * 8 + h) * 288; o[c] = f2bf(acc); if (c < 32) o[256 + c] = q[64 + c];
}

__global__ void __launch_bounds__(64) k_attn_p(const bf16_t* __restrict__ Q, const bf16_t* __restrict__ Kn, const bf16_t* __restrict__ Kr, const bf16_t* __restrict__ V,
                                               const bf16_t* __restrict__ H, bf16_t* __restrict__ yb) {
    const int qb = blockIdx.x, h = blockIdx.y, b = blockIdx.z, lane = threadIdx.x; const int i = qb * 64 + lane, t = b * SEQ + i;
    float q[96];
#pragma unroll
    for (int d = 0; d < 96; ++d) q[d] = bf2f(Q[(size_t)t * 768 + h * 96 + d]) * MLA_SCALE;
    float o[64];
#pragma unroll
    for (int d = 0; d < 64; ++d) o[d] = 0.f;
    float m = -1e30f, l = 0.f;
    const int jmax = qb * 64 + 63;
    for (int j = 0; j <= jmax; ++j) {
        const size_t tk = (size_t)b * SEQ + j; const bf16_t* kn = Kn + tk * 512 + h * 64; const bf16_t* kr = Kr + tk * 32; const bf16_t* vv = V + tk * 512 + h * 64;
        float s = 0.f;
#pragma unroll
        for (int d = 0; d < 64; ++d) s += q[d] * bf2f(kn[d]);
#pragma unroll
        for (int d = 0; d < 32; ++d) s += q[64 + d] * bf2f(kr[d]);
        if (j <= i) {
            const float mn = fmaxf(m, s), al = __expf(m - mn), p = __expf(s - mn); l = l * al + p; m = mn;
#pragma unroll
            for (int d = 0; d < 64; ++d) o[d] = o[d] * al + p * bf2f(vv[d]);
        }
    }
    const float il = 1.0f / l;
#pragma unroll
    for (int d = 0; d < 64; ++d) yb[(size_t)t * 512 + h * 64 + d] = f2bf(o[d] * il * bf2f(H[(size_t)t * IN_WP + C_ZMLA + h * 64 + d]));
}

#define SA_CH 33
__global__ void __launch_bounds__(256) k_attn_s(const bf16_t* __restrict__ Qlat, const float* __restrict__ ckv_cache, const float* __restrict__ kr_cache, const int* __restrict__ page_table,
                                                const bf16_t* __restrict__ ckv_new, const bf16_t* __restrict__ kr_new, float* __restrict__ part, int layer, int pad_) {
    const int s = blockIdx.x, ch = blockIdx.y, tid = threadIdx.x, r = tid & 63, cq = tid >> 6;
    __shared__ bf16_t Ks[32][296];
    __shared__ float Ss[64][33];
    __shared__ bf16_t Qs[64][290];
    for (int i = tid; i < 64 * 288; i += 256) { const int rr = i / 288, c = i % 288; Qs[rr][c] = Qlat[((size_t)s * 64 + rr) * 288 + c]; }
    float o[64];
#pragma unroll
    for (int d = 0; d < 64; ++d) o[d] = 0.f;
    float m = -1e30f, l = 0.f;
    const int i_tok = r >> 3;
    const int ntile = ch < 32 ? 16 : 1;
    for (int tl = 0; tl < ntile; ++tl) {
        __syncthreads();
        if (ch < 32) { const int j0 = ch * 512 + tl * 32; const int page = page_table[s * N_PAGES + (j0 >> 7)]; const int prow = j0 & 127;
            const float* kvp = ckv_cache + (((size_t)layer * N_POOL + page) * PAGE + prow) * 256; const float* krp = kr_cache + (((size_t)layer * N_POOL + page) * PAGE + prow) * 32;
            for (int i = tid; i < 32 * 256; i += 256) Ks[i >> 8][i & 255] = f2bf(kvp[i]);
            for (int i = tid; i < 32 * 32; i += 256) Ks[i >> 5][256 + (i & 31)] = f2bf(krp[i]);
        } else {
            for (int i = tid; i < 32 * 256; i += 256) { const int k = i >> 8; Ks[k][i & 255] = k < 8 ? ckv_new[((size_t)TP + s * 8 + k) * 256 + (i & 255)] : (bf16_t)0; }
            for (int i = tid; i < 32 * 32; i += 256) { const int k = i >> 5; Ks[k][256 + (i & 31)] = k < 8 ? kr_new[((size_t)TP + s * 8 + k) * 32 + (i & 31)] : (bf16_t)0; }
        }
        __syncthreads();
#pragma unroll
        for (int kk = 0; kk < 8; ++kk) { const int k = cq * 8 + kk; float sc = 0.f;
            for (int c = 0; c < 288; ++c) sc += bf2f(Qs[r][c]) * bf2f(Ks[k][c]);
            sc *= MLA_SCALE; if (ch == 32 && k > i_tok) sc = -1e30f; Ss[r][k] = sc; }
        __syncthreads();
        float tm = -1e30f;
        for (int k = 0; k < 32; ++k) tm = fmaxf(tm, Ss[r][k]);
        const float mn = fmaxf(m, tm), al = __expf(m - mn); m = mn; l *= al;
#pragma unroll
        for (int d = 0; d < 64; ++d) o[d] *= al;
        for (int k = 0; k < 32; ++k) { const float sc = Ss[r][k]; const float p = sc <= -1e29f ? 0.f : __expf(sc - mn); l += p;
#pragma unroll
            for (int d = 0; d < 64; ++d) o[d] += p * bf2f(Ks[k][cq * 64 + d]); }
    }
    float* pp = part + (((size_t)s * SA_CH + ch) * 64 + r) * 258;
#pragma unroll
    for (int d = 0; d < 64; ++d) pp[cq * 64 + d] = o[d];
    if (cq == 0) { pp[256] = m; pp[257] = l; }
}
__global__ void k_attn_s_fin(const float* __restrict__ part, const float* __restrict__ w_uv, const bf16_t* __restrict__ H, bf16_t* __restrict__ yb) {
    const int ts = blockIdx.x, h = blockIdx.y, d = threadIdx.x; const int s = ts >> 3, r = (ts & 7) * 8 + h;
    __shared__ float ol[256]; __shared__ float wgt[SA_CH];
    float M = -1e30f;
    for (int ch = 0; ch < SA_CH; ++ch) M = fmaxf(M, part[(((size_t)s * SA_CH + ch) * 64 + r) * 258 + 256]);
    float L = 0.f;
    for (int ch = 0; ch < SA_CH; ++ch) { const float* pp = part + (((size_t)s * SA_CH + ch) * 64 + r) * 258; const float w = __expf(pp[256] - M); L += pp[257] * w; if (d == 0) wgt[ch] = w; }
    __syncthreads();
    for (int c = d; c < 256; c += 64) { float a = 0.f; for (int ch = 0; ch < SA_CH; ++ch) a += wgt[ch] * part[(((size_t)s * SA_CH + ch) * 64 + r) * 258 + c]; ol[c] = a / L; }
    __syncthreads();
    float a = 0.f;
    for (int c = 0; c < 256; ++c) a += ol[c] * w_uv[(size_t)c * 512 + h * 64 + d];
    const int t = TP + ts;
    yb[(size_t)t * 512 + h * 64 + d] = f2bf(a * bf2f(H[(size_t)t * IN_WP + C_ZMLA + h * 64 + d]));
}

__global__ void __launch_bounds__(64) k_delta(const bf16_t* __restrict__ qd, const bf16_t* __restrict__ kd, const bf16_t* __restrict__ vd, const float* __restrict__ bg,
                                              const float* __restrict__ state_delta, const float* __restrict__ dn_g, const bf16_t* __restrict__ H, bf16_t* __restrict__ yc,
                                              float* __restrict__ out, int layer, int pad_) {
    const int sq = blockIdx.x, h = blockIdx.y, dv = threadIdx.x;
    int row0, L; float* so; float S[64];
    if (sq < 8) { row0 = sq * SEQ; L = SEQ; so = out + O_PDELTA + (((size_t)layer * 8 + sq) * 8 + h) * 4096;
#pragma unroll
        for (int k = 0; k < 64; ++k) S[k] = 0.f; }
    else { const int s = sq - 8; row0 = TP + s * 8; L = DEC_SEQ; so = out + O_SDELTA + (((size_t)layer * DEC_BATCH + s) * 8 + h) * 4096;
        const float* s0 = state_delta + (((size_t)layer * DEC_BATCH + s) * 8 + h) * 4096;
#pragma unroll
        for (int k = 0; k < 64; ++k) S[k] = s0[k * 64 + dv]; }
    const float gn = dn_g[layer * 64 + dv];
    for (int i = 0; i < L; ++i) {
        const size_t t = (size_t)row0 + i; const bf16_t* kp = kd + t * 512 + h * 64; const bf16_t* qp = qd + t * 512 + h * 64;
        const float b = bg[t * 16 + h], a = __expf(bg[t * 16 + 8 + h]); const float v = bf2f(vd[t * 512 + h * 64 + dv]);
        float ks = 0.f;
#pragma unroll
        for (int k = 0; k < 64; ++k) ks += bf2f(kp[k]) * S[k];
        const float vn = b * (v - a * ks);
        float o = 0.f;
#pragma unroll
        for (int k = 0; k < 64; ++k) { S[k] = a * S[k] + bf2f(kp[k]) * vn; o += bf2f(qp[k]) * S[k]; }
        const float ss = wave_sum(o * o); const float y = o * rsqrtf(ss * (1.0f / 64.0f) + EPS) * gn;
        yc[t * 512 + h * 64 + dv] = f2bf(y * bf2f(H[t * IN_WP + C_ZDN + h * 64 + dv]));
    }
#pragma unroll
    for (int k = 0; k < 64; ++k) so[k * 64 + dv] = S[k];
}

namespace pg8 {
#define PG8_LAS __attribute__((address_space(3)))
typedef unsigned short bf16_t;
typedef short bf16x8 __attribute__((ext_vector_type(8)));
typedef float f32x4 __attribute__((ext_vector_type(4)));
typedef unsigned u32x4 __attribute__((ext_vector_type(4)));
constexpr int BM = 256, BK = 64, HALF = 128, HTB = HALF * BK * 2  , STAGE_BYTES = 8 * HTB, NXCD = 8, WGM = 8;

__host__ __device__ __forceinline__ int lds_byte(int r, int c) { const int st = (r >> 4) * 2 + (c >> 5), rr = r & 15, cc = c & 31, ob = rr * 64 + cc * 2; return st * 1024 + (ob ^ (((ob >> 9) & 1) << 5)); }
__host__ __device__ __forceinline__ void stage_rc(int b, int& R, int& C) { const int st = b / 1024, sb = b % 1024, swz = sb ^ (((sb >> 9) & 1) << 5); R = (st >> 1) * 16 + swz / 64; C = (st & 1) * 32 + (swz % 64) / 2; }
__host__ __device__ __forceinline__ int perm32(int rho) { const int n = rho >> 4, i = rho & 15; return 8 * (i >> 2) + 4 * n + (i & 3); }

struct Unit { int pm, pn; };
struct Gemm { const bf16_t* A; const bf16_t* Bt; int M, N, K; };

struct StaticOrder {
    int nM, nN, nwg, G, c;
    __host__ __device__ void init(int M, int N, int G_, int c_) { nM = M / BM; nN = N / BM; nwg = nM * nN; G = G_; c = c_; }
    __host__ __device__ bool next(int i, Unit& u) const {
        const long L = (long)i * G + c; if (L >= nwg) return false;
        int wgid = (int)L; { const int q = nwg / NXCD, r = nwg % NXCD, xcd = wgid % NXCD, off = wgid / NXCD; wgid = (xcd < r ? xcd * (q + 1) : r * (q + 1) + (xcd - r) * q) + off; }
        const int nig = WGM * nN, gid = wgid / nig, fm = gid * WGM, gsz = (nM - fm) < WGM ? (nM - fm) : WGM;
        u.pm = fm + ((wgid % nig) % gsz); u.pn = (wgid % nig) / gsz; return true;
    }
    __device__ __forceinline__ void a_ready(const Unit&) const {}
    __device__ __forceinline__ void done(const Unit&) const {}
};
__device__ __forceinline__ unsigned cvt_pk_bf16(float lo, float hi) { unsigned r; asm volatile("v_cvt_pk_bf16_f32 %0, %1, %2" : "=v"(r) : "v"(lo), "v"(hi)); return r; }
typedef float f32x2 __attribute__((ext_vector_type(2)));
template <class Epi, class Sched, bool STAMP = false>
__device__ __forceinline__ void gemm_phase(PG8_LAS unsigned char* lds, const Gemm g, const Sched& S, const Epi& E, unsigned long long* stamps) {
    const int tid = threadIdx.x, wid = __builtin_amdgcn_readfirstlane(tid >> 6), lane = tid & 63, wr = wid >> 2, wc = wid & 3, fr = lane & 15, fq = lane >> 4;
    int K_ = g.K; asm volatile("" : "+s"(K_));
    const int K = K_, nt = K / BK;
    int ts_lo = 0, ts_hi = 0, nts = 0; const unsigned long long rt_entry = STAMP ? (unsigned long long)wall_clock64() : 0ull;
#define PG8_STAMP() do { if (STAMP && wid == 0 && nts < 64) { const unsigned long long _c = (unsigned long long)clock64(); \
        ts_lo = (lane == nts) ? (int)(unsigned)_c : ts_lo; ts_hi = (lane == nts) ? (int)(unsigned)(_c >> 32) : ts_hi; ++nts; } } while (0)
    PG8_STAMP();
    unsigned voffA[2], voffB[2];
#pragma unroll
    for (int i = 0; i < 2; ++i) { int R, C; stage_rc(tid * 16 + i * 8192, R, C); const int Rb = Epi::PERM ? ((R & ~31) + perm32(R & 31)) : R;
        voffA[i] = (unsigned)(R * K + C) * 2u; voffB[i] = (unsigned)(Rb * K + C) * 2u; }
    const size_t kstep = (size_t)(BK * 2);
    const size_t hstep = (size_t)HALF * K * 2;
    const size_t tstep = 2 * hstep;
    const unsigned ldsw = (unsigned)wid * 1024u;
    const int aoff = lds_byte(wr * 64 + fr, fq * 8), boff = lds_byte(wc * 32 + fr, fq * 8);
#define PG8_SA(b, h) (((b) * 2 + (h)) * HTB)
#define PG8_SB(b, h) ((4 + (b) * 2 + (h)) * HTB)
#define PG8_STAGE(bufoff, gbase, voff) do { _Pragma("unroll") for (int _i = 0; _i < 2; ++_i) \
        __builtin_amdgcn_global_load_lds((const unsigned*)((const char*)(gbase) + (voff)[_i]), (PG8_LAS unsigned*)(lds + (bufoff) + ldsw + _i * 8192), 16, 0, 0); } while (0)
#define PG8_LDA(dst, b, h) do { _Pragma("unroll") for (int m = 0; m < 4; ++m) _Pragma("unroll") for (int k = 0; k < 2; ++k) dst[m][k] = *(const PG8_LAS bf16x8*)(lds + PG8_SA(b, h) + aoff + m * 2048 + k * 1024); } while (0)
#define PG8_LDB(dst, b, h) do { _Pragma("unroll") for (int n = 0; n < 2; ++n) _Pragma("unroll") for (int k = 0; k < 2; ++k) dst[n][k] = *(const PG8_LAS bf16x8*)(lds + PG8_SB(b, h) + boff + n * 2048 + k * 1024); } while (0)
#define PG8_MMA(ai, bj, At, Bt) do { __builtin_amdgcn_s_setprio(1); _Pragma("unroll") for (int m = 0; m < 4; ++m) _Pragma("unroll") for (int n = 0; n < 2; ++n) _Pragma("unroll") for (int k = 0; k < 2; ++k) \
        acc[ai][bj][m][n] = __builtin_amdgcn_mfma_f32_16x16x32_bf16(Bt[n][k], At[m][k], acc[ai][bj][m][n], 0, 0, 0); __builtin_amdgcn_s_setprio(0); } while (0)
#define PG8_WAIT_V(n) asm volatile("s_waitcnt vmcnt(" #n ")" ::: "memory")
#define PG8_WAIT_L(n) asm volatile("s_waitcnt lgkmcnt(" #n ")" ::: "memory")
#define PG8_BAR __builtin_amdgcn_s_barrier()
#define PG8_SCHED __builtin_amdgcn_sched_barrier(0)
    Unit cur, nxt; int ui = 0;
    if (!S.next(0, cur)) return;
    f32x4 acc[2][2][4][2];
#pragma unroll
    for (int a = 0; a < 2; ++a)
#pragma unroll
        for (int b = 0; b < 2; ++b)
#pragma unroll
            for (int m = 0; m < 4; ++m)
#pragma unroll
                for (int n = 0; n < 2; ++n) acc[a][b][m][n] = (f32x4){0.f, 0.f, 0.f, 0.f};
    bf16x8 At[4][2], B0[2][2], B1[2][2];
    const char* cA = (const char*)g.A + (size_t)cur.pm * tstep; const char* cB = (const char*)g.Bt + (size_t)cur.pn * tstep;
    S.a_ready(cur);
    PG8_STAGE(PG8_SB(0, 0), cB, voffB); PG8_STAGE(PG8_SA(0, 0), cA, voffA); PG8_STAGE(PG8_SB(0, 1), cB + hstep, voffB); PG8_STAGE(PG8_SA(0, 1), cA + hstep, voffA);
    if (wr == 1) PG8_BAR;
    PG8_WAIT_V(4); PG8_BAR;
    PG8_STAGE(PG8_SB(1, 0), cB + kstep, voffB); PG8_STAGE(PG8_SA(1, 0), cA + kstep, voffA); PG8_STAGE(PG8_SB(1, 1), cB + hstep + kstep, voffB);
    PG8_WAIT_V(6); PG8_BAR;
    PG8_STAMP();
    for (;;) {
        const bool has_next = S.next(ui + 1, nxt);
        const char* nA = has_next ? (const char*)g.A + (size_t)nxt.pm * tstep : cA; const char* nB = has_next ? (const char*)g.Bt + (size_t)nxt.pn * tstep : cB;
_Pragma("nounroll")
        for (int t = 0; t < nt; t += 2) {
            const bool last = (t == nt - 2);
            const char* a1 = cA + (size_t)(t + 1) * kstep;
            const char* a2 = last ? nA : cA + (size_t)(t + 2) * kstep; const char* b2 = last ? nB : cB + (size_t)(t + 2) * kstep;
            const char* a3 = a2 + kstep; const char* b3 = b2 + kstep;
            if (last && has_next) S.a_ready(nxt);
            PG8_LDB(B0, 0, 0); PG8_SCHED; PG8_LDA(At, 0, 0); PG8_STAGE(PG8_SA(1, 1), a1 + hstep, voffA);
            PG8_WAIT_L(8); PG8_BAR; PG8_WAIT_L(0); PG8_MMA(0, 0, At, B0); PG8_BAR; PG8_SCHED;
            PG8_LDB(B1, 0, 1); PG8_STAGE(PG8_SB(0, 0), b2, voffB);
            PG8_BAR; PG8_WAIT_L(0); PG8_MMA(0, 1, At, B1); PG8_BAR;
            PG8_LDA(At, 0, 1); PG8_STAGE(PG8_SA(0, 0), a2, voffA);
            PG8_BAR; PG8_WAIT_L(0); PG8_MMA(1, 0, At, B0); PG8_BAR; PG8_SCHED;
            PG8_STAGE(PG8_SB(0, 1), b2 + hstep, voffB);
            PG8_WAIT_V(6); PG8_BAR; PG8_MMA(1, 1, At, B1); PG8_BAR;
            PG8_LDB(B0, 1, 0); PG8_SCHED; PG8_LDA(At, 1, 0); PG8_STAGE(PG8_SA(0, 1), a2 + hstep, voffA);
            PG8_WAIT_L(8); PG8_BAR; PG8_WAIT_L(0); PG8_MMA(0, 0, At, B0); PG8_BAR; PG8_SCHED;
            PG8_LDB(B1, 1, 1); PG8_STAGE(PG8_SB(1, 0), b3, voffB);
            PG8_BAR; PG8_WAIT_L(0); PG8_MMA(0, 1, At, B1); PG8_BAR;
            PG8_LDA(At, 1, 1); PG8_STAGE(PG8_SA(1, 0), a3, voffA);
            PG8_BAR; PG8_WAIT_L(0); PG8_MMA(1, 0, At, B0); PG8_BAR; PG8_SCHED;
            PG8_STAGE(PG8_SB(1, 1), b3 + hstep, voffB);
            PG8_WAIT_V(6); PG8_BAR; PG8_MMA(1, 1, At, B1); PG8_BAR;
        }
        PG8_STAMP();
        if constexpr (!Epi::AFTER_DRAIN) { E(acc, cur, wr, wc, fr, fq); S.done(cur); }
        PG8_STAMP();
        if (!has_next) break;
#pragma unroll
        for (int a = 0; a < 2; ++a)
#pragma unroll
            for (int b = 0; b < 2; ++b)
#pragma unroll
                for (int m = 0; m < 4; ++m)
#pragma unroll
                    for (int n = 0; n < 2; ++n) acc[a][b][m][n] = (f32x4){0.f, 0.f, 0.f, 0.f};
        cur = nxt; cA = nA; cB = nB; ++ui;
    }
    PG8_WAIT_V(0);
    if (wr == 0) PG8_BAR;
    PG8_BAR;
    if constexpr (Epi::AFTER_DRAIN) { E.fused(acc, cur, wr, wc, fr, fq, lds, wid, lane); S.done(cur); }
    PG8_STAMP();
    if (STAMP && wid == 0) { stamps[lane] = lane < nts ? (((unsigned long long)(unsigned)ts_hi << 32) | (unsigned)ts_lo) : 0ull;
        if (lane == 62) stamps[62] = rt_entry; if (lane == 63) stamps[63] = (unsigned long long)wall_clock64(); }
#undef PG8_STAMP
#undef PG8_SA
#undef PG8_SB
#undef PG8_STAGE
#undef PG8_LDA
#undef PG8_LDB
#undef PG8_MMA
#undef PG8_WAIT_V
#undef PG8_WAIT_L
#undef PG8_BAR
#undef PG8_SCHED
}

}
#define XB_TMO      128
#define XB_XCNT(j)  (256  + 64 * (j))
#define XB_XSUB(j)  (1280 + 64 * (j))
#define XB_XGEN(j)  (2304 + 64 * (j))
#define XB_TOP      3328
#define XB_TOPGEN   3392
#define XCD_BAR_WORDS 3456
#define XB_SPIN_CAP (1u << 18)
#define LAS __attribute__((address_space(3)))

__device__ __forceinline__ unsigned xb_ld(unsigned* p)              { return __hip_atomic_load(p, __ATOMIC_RELAXED, __HIP_MEMORY_SCOPE_AGENT); }
__device__ __forceinline__ unsigned xb_add(unsigned* p, unsigned v) { return __hip_atomic_fetch_add(p, v, __ATOMIC_RELAXED, __HIP_MEMORY_SCOPE_AGENT); }
__device__ __forceinline__ unsigned xb_xcc_id() { return (unsigned)__builtin_amdgcn_s_getreg((3 << 11) | 20) & 0xFu; }
#define XB_SPIN(cond, bar) do { unsigned _sp = 0; while (cond) { __builtin_amdgcn_s_sleep(1); \
    if ((++_sp & 255u) == 0u) { if (xb_ld(&(bar)[XB_TMO])) break; if (_sp > XB_SPIN_CAP) { atomicAdd(&(bar)[XB_TMO], 1u); break; } } } } while (0)

struct XcdBarrier {
    unsigned* bar; unsigned x;
    volatile LAS unsigned* st;
};

__device__ __forceinline__ XcdBarrier xcd_barrier_post(unsigned* bar, volatile LAS unsigned* st) {
    XcdBarrier b; b.bar = bar; b.x = xb_xcc_id(); b.st = st;
    if (threadIdx.x == 0) (void)xb_add(&bar[XB_XCNT(b.x)], 1u);
    return b;
}
__device__ __forceinline__ void xcd_barrier_complete(unsigned* bar, unsigned x, unsigned& nloc, unsigned& nx) {
    const unsigned G = gridDim.x * gridDim.y * gridDim.z;
    unsigned sum, cnt, mine, sp = 0u;
    for (;;) {
        sum = 0u; cnt = 0u; mine = 0u;
#pragma unroll
        for (unsigned j = 0; j < 16; ++j) { const unsigned c = xb_ld(&bar[XB_XCNT(j)]); sum += c; cnt += (c > 0u) ? 1u : 0u; mine = (j == x) ? c : mine; }
        if (sum == G) break;
        __builtin_amdgcn_s_sleep(1);
        if ((++sp & 255u) == 0u) { if (xb_ld(&bar[XB_TMO])) break; if (sp > XB_SPIN_CAP) { atomicAdd(&bar[XB_TMO], 1u); break; } }
    }
    nloc = mine > 0u ? mine : 1u; nx = cnt > 0u ? cnt : 1u;
}

__device__ __forceinline__ void xcd_barrier(const XcdBarrier& b) {
    asm volatile("s_waitcnt vmcnt(0)" ::: "memory");
    __syncthreads();
    if (threadIdx.x == 0) {
        unsigned* bar = b.bar;
        __builtin_amdgcn_s_waitcnt(0);
        unsigned nloc = b.st[0], nx = b.st[1];
        if (nloc == 0u) { xcd_barrier_complete(bar, b.x, nloc, nx); b.st[0] = nloc; b.st[1] = nx; }
        const unsigned old = xb_add(&bar[XB_XSUB(b.x)], 1u);
        const unsigned gen = old / nloc;
        if (old + 1u == (gen + 1u) * nloc) {
            __builtin_amdgcn_fence(__ATOMIC_RELEASE, "agent");
            asm volatile("s_waitcnt vmcnt(0)" ::: "memory");
            const unsigned og = xb_add(&bar[XB_TOP], 1u);
            const unsigned tg = og / nx;
            if (og + 1u == (tg + 1u) * nx) xb_add(&bar[XB_TOPGEN], 1u);
            else XB_SPIN(xb_ld(&bar[XB_TOPGEN]) == tg, bar);
            __builtin_amdgcn_fence(__ATOMIC_ACQUIRE, "agent");
            xb_add(&bar[XB_XGEN(b.x)], 1u);
            asm volatile("s_waitcnt vmcnt(0)" ::: "memory");
        } else {
            XB_SPIN(xb_ld(&bar[XB_XGEN(b.x)]) == gen, bar);
            __builtin_amdgcn_fence(__ATOMIC_ACQUIRE, "agent");
            asm volatile("s_waitcnt vmcnt(0)" ::: "memory");
        }
    }
    __syncthreads();
}


#define LAS __attribute__((address_space(3)))
typedef float f32x4 __attribute__((ext_vector_type(4)));
typedef unsigned u32x4 __attribute__((ext_vector_type(4)));
typedef unsigned u32x2 __attribute__((ext_vector_type(2)));
constexpr int NTHR = 512;
constexpr int LDS_BYTES = 147456;
constexpr int LDS_MISC = 131072;

struct Params {
    const float *x_prompt, *x_sample, *cache_kv, *cache_kr, *state_pool, *state_conv, *state_delta; const int* page_table;
    const float *norm_g, *w_in, *pool_mix, *pool_scale, *q_norm_g, *w_uq, *kv_norm_g, *w_uk, *w_uv, *conv_w, *a_log, *dt_bias, *dn_norm_g, *w_br0, *w_br1, *w_br2, *w_out, *final_norm_g;
    float* out;
    bf16_t *WinT, *WuqT, *WkvT, *WbrT, *WoutT; float2* tab;
    float* xres; bf16_t* xn; bf16_t* H; float* BA; bf16_t *cq, *ckv, *Kr, *Q, *Kn, *V, *qd, *kd, *vd; float* bg; bf16_t *ya, *yb, *yc; float* mf; bf16_t* mb; float* part;
    unsigned* bar;
    int ph_lo, ph_hi, li, pad;
};

constexpr int PH_PRO = 0;
constexpr int PH_L = 8;
constexpr int PH_GIN = 0, PH_TOK = 1, PH_GQ = 2, PH_ATT = 3, PH_FIN = 4, PH_MERGE = 5, PH_OUT = 6, PH_NORM = 7;
#define PHID(l, k) (1 + (l) * PH_L + (k))
constexpr int PH_END = 1 + 2 * PH_L;

struct MEpiH { static constexpr bool PERM = true, AFTER_DRAIN = false; bf16_t* H; float* BA;
    __device__ __forceinline__ void operator()(const f32x4 (&acc)[2][2][4][2], const pg8::Unit& u, int wr, int wc, int fr0, int fq0) const {
        int fr = fr0, fq = fq0; asm volatile("" : "+v"(fr), "+v"(fq));
        const int row0 = u.pm * 256 + wr * 64 + fr;
#pragma unroll
        for (int bj = 0; bj < 2; ++bj) {
            const int wcol = u.pn * 256 + bj * 128 + wc * 32, col0 = wcol + 8 * fq;
            const bool plain = (wcol + 32 <= C_ZPOOL) || (wcol >= C_Q && wcol + 32 <= C_ZMLA) || (wcol >= C_QKV && wcol + 32 <= C_ZDN);
            const int act = ((col0 >= C_ZPOOL && col0 < C_Q) || (col0 >= C_ZMLA && col0 < C_QKV) || (col0 >= C_ZDN && col0 < C_BETA)) ? 1 : (col0 >= C_GATE ? 2 : 0);
            const bool isba = (col0 == C_BETA) || (col0 == C_ALPHA);
#pragma unroll
            for (int ai = 0; ai < 2; ++ai)
#pragma unroll
                for (int m = 0; m < 4; ++m) { const int row = row0 + ai * 128 + m * 16; f32x4 v0 = acc[ai][bj][m][0], v1 = acc[ai][bj][m][1];
                    if (!plain) {
                        if (isba) { float* b = BA + (size_t)row * 16 + (col0 - C_BETA); *(f32x4*)b = v0; *(f32x4*)(b + 4) = v1; }
#pragma unroll
                        for (int e = 0; e < 4; ++e) { const float s0 = sigmoidf_(v0[e]), s1 = sigmoidf_(v1[e]);
                            v0[e] = act == 0 ? v0[e] : (act == 1 ? v0[e] * s0 : s0); v1[e] = act == 0 ? v1[e] : (act == 1 ? v1[e] * s1 : s1); }
                    }
                    u32x4 w; w.x = pg8::cvt_pk_bf16(v0[0], v0[1]); w.y = pg8::cvt_pk_bf16(v0[2], v0[3]); w.z = pg8::cvt_pk_bf16(v1[0], v1[1]); w.w = pg8::cvt_pk_bf16(v1[2], v1[3]);
                    *(u32x4*)(H + (size_t)row * IN_WP + col0) = w; }
        }
    } };
struct MEpiQ { static constexpr bool PERM = true, AFTER_DRAIN = false; bf16_t* Q; const float2* tab;
    __device__ __forceinline__ void operator()(const f32x4 (&acc)[2][2][4][2], const pg8::Unit& u, int wr, int wc, int fr0, int fq0) const {
        int fr = fr0, fq = fq0; asm volatile("" : "+v"(fr), "+v"(fq));
        const int row0 = u.pm * 256 + wr * 64 + fr;
#pragma unroll
        for (int bj = 0; bj < 2; ++bj) {
            const int wcol = u.pn * 256 + bj * 128 + wc * 32, col0 = wcol + 8 * fq;
            const bool rope = (wcol % 96) == 64;
#pragma unroll
            for (int ai = 0; ai < 2; ++ai)
#pragma unroll
                for (int m = 0; m < 4; ++m) { const int row = row0 + ai * 128 + m * 16; f32x4 v0 = acc[ai][bj][m][0], v1 = acc[ai][bj][m][1];
                    if (rope) { const int p = row < TP ? (row & (SEQ - 1)) : SEQ + ((row - TP) & 7); const float2* tp = tab + p * 16 + (fq & 1) * 8; const bool hi = fq >= 2;
#pragma unroll
                        for (int e = 0; e < 4; ++e) { const float o0 = __shfl_xor(v0[e], 32), o1 = __shfl_xor(v1[e], 32); const float2 c0 = tp[e], c1 = tp[4 + e];
                            v0[e] = hi ? (v0[e] * c0.x + o0 * c0.y) : (v0[e] * c0.x - o0 * c0.y); v1[e] = hi ? (v1[e] * c1.x + o1 * c1.y) : (v1[e] * c1.x - o1 * c1.y); } }
                    u32x4 w; w.x = pg8::cvt_pk_bf16(v0[0], v0[1]); w.y = pg8::cvt_pk_bf16(v0[2], v0[3]); w.z = pg8::cvt_pk_bf16(v1[0], v1[1]); w.w = pg8::cvt_pk_bf16(v1[2], v1[3]);
                    *(u32x4*)(Q + (size_t)row * 768 + col0) = w; asm volatile("" ::: "memory"); }
        }
    } };
struct MEpiKV { static constexpr bool PERM = true, AFTER_DRAIN = false; bf16_t* Kn; bf16_t* V;
    __device__ __forceinline__ void operator()(const f32x4 (&acc)[2][2][4][2], const pg8::Unit& u, int wr, int wc, int fr0, int fq0) const {
        int fr = fr0, fq = fq0; asm volatile("" : "+v"(fr), "+v"(fq));
        const int row0 = u.pm * 256 + wr * 64 + fr; bf16_t* base = u.pn < 2 ? Kn : V; const int cb = (u.pn & 1) * 256;
#pragma unroll
        for (int bj = 0; bj < 2; ++bj) { const int col0 = cb + bj * 128 + wc * 32 + 8 * fq;
#pragma unroll
            for (int ai = 0; ai < 2; ++ai)
#pragma unroll
                for (int m = 0; m < 4; ++m) { const int row = row0 + ai * 128 + m * 16; const f32x4 v0 = acc[ai][bj][m][0], v1 = acc[ai][bj][m][1];
                    u32x4 w; w.x = pg8::cvt_pk_bf16(v0[0], v0[1]); w.y = pg8::cvt_pk_bf16(v0[2], v0[3]); w.z = pg8::cvt_pk_bf16(v1[0], v1[1]); w.w = pg8::cvt_pk_bf16(v1[2], v1[3]);
                    *(u32x4*)(base + (size_t)row * 512 + col0) = w; } }
    } };
template <int BR> struct MEpiMerge { static constexpr bool PERM = true, AFTER_DRAIN = false; const bf16_t* H; float* mf; bf16_t* mb;
    __device__ __forceinline__ void operator()(const f32x4 (&acc)[2][2][4][2], const pg8::Unit& u, int wr, int wc, int fr0, int fq0) const {
        int fr = fr0, fq = fq0; asm volatile("" : "+v"(fr), "+v"(fq));
        const int row0 = u.pm * 256 + wr * 64 + fr;
#pragma unroll
        for (int bj = 0; bj < 2; ++bj) { const int col0 = u.pn * 256 + bj * 128 + wc * 32 + 8 * fq;
#pragma unroll
            for (int ai = 0; ai < 2; ++ai)
#pragma unroll
                for (int m = 0; m < 4; ++m) { const int row = row0 + ai * 128 + m * 16; f32x4 v0 = acc[ai][bj][m][0], v1 = acc[ai][bj][m][1];
                    const u32x4 g = *(const u32x4*)(H + (size_t)row * IN_WP + C_GATE + BR * 1024 + col0);
                    v0[0] *= __uint_as_float(g.x << 16); v0[1] *= __uint_as_float(g.x & 0xffff0000u); v0[2] *= __uint_as_float(g.y << 16); v0[3] *= __uint_as_float(g.y & 0xffff0000u);
                    v1[0] *= __uint_as_float(g.z << 16); v1[1] *= __uint_as_float(g.z & 0xffff0000u); v1[2] *= __uint_as_float(g.w << 16); v1[3] *= __uint_as_float(g.w & 0xffff0000u);
                    float* mp = mf + (size_t)row * 1024 + col0;
                    if (BR > 0) { v0 += *(const f32x4*)mp; v1 += *(const f32x4*)(mp + 4); }
                    if (BR < 2) { *(f32x4*)mp = v0; *(f32x4*)(mp + 4) = v1; }
                    else { u32x4 w; w.x = pg8::cvt_pk_bf16(v0[0], v0[1]); w.y = pg8::cvt_pk_bf16(v0[2], v0[3]); w.z = pg8::cvt_pk_bf16(v1[0], v1[1]); w.w = pg8::cvt_pk_bf16(v1[2], v1[3]);
                        *(u32x4*)(mb + (size_t)row * 1024 + col0) = w; } asm volatile("" ::: "memory"); } }
    } };
struct MEpiRes { static constexpr bool PERM = false, AFTER_DRAIN = false; const float* xp; const float* xs; float* xo;
    __device__ __forceinline__ void operator()(const f32x4 (&acc)[2][2][4][2], const pg8::Unit& u, int wr, int wc, int fr0, int fq0) const {
        int fr = fr0, fq = fq0; asm volatile("" : "+v"(fr), "+v"(fq));
        const int row0 = u.pm * 256 + wr * 64 + fr, col0 = u.pn * 256 + wc * 32 + 4 * fq;
#pragma unroll
        for (int ai = 0; ai < 2; ++ai)
#pragma unroll
            for (int m = 0; m < 4; ++m) { const int row = row0 + ai * 128 + m * 16; const float* xr = row < TP ? xp + (size_t)row * 1024 : xs + (size_t)(row - TP) * 1024; float* orow = xo + (size_t)row * 1024;
#pragma unroll
                for (int bj = 0; bj < 2; ++bj)
#pragma unroll
                    for (int n = 0; n < 2; ++n) { const int c = col0 + bj * 128 + n * 16; *(f32x4*)(orow + c) = *(const f32x4*)(xr + c) + acc[ai][bj][m][n]; } }
    } };

__device__ __forceinline__ void ph_tr(const float* __restrict__ src, bf16_t* __restrict__ dst, int K, int N, int Npad, LAS float* tile, int rot) {
    const int tid = threadIdx.x, G = gridDim.x; const int tn = Npad / 64, tk = K / 32, nt = tn * tk;
    const int first = (blockIdx.x + G - (rot % G)) % G;
    for (int t = first; t < nt; t += G) {
        const int n0 = (t % tn) * 64, k0 = (t / tn) * 32;
        { const int tx = tid & 63, ty = tid >> 6;
#pragma unroll
          for (int i = 0; i < 4; ++i) { const int k = ty + 8 * i, n = n0 + tx; tile[k * 65 + tx] = n < N ? src[(size_t)(k0 + k) * N + n] : 0.f; } }
        __syncthreads();
        { const int kx = tid & 31, ny = tid >> 5;
#pragma unroll
          for (int i = 0; i < 4; ++i) { const int n = ny + 16 * i; dst[(size_t)(n0 + n) * K + k0 + kx] = f2bf(tile[kx * 65 + n]); } }
        __syncthreads();
    }
}
__device__ __forceinline__ void ph_rope_tab(float2* tab) {
    for (int idx = blockIdx.x * NTHR + threadIdx.x; idx < (SEQ + DEC_SEQ) * 16; idx += gridDim.x * NTHR) {
        const int p = idx >> 4, i = idx & 15; const int pos = p < SEQ ? p : PAST_LEN + (p - SEQ);
        const float inv = powf(10000.0f, -(float)i / 16.0f); const float ang = (float)pos * inv;
        const double rev = (double)ang * 0.15915494309189533576888; const float f = (float)(rev - floor(rev));
        tab[idx] = make_float2(__builtin_amdgcn_cosf(f), __builtin_amdgcn_sinf(f)); }
}
__device__ __forceinline__ void ph_rmsnorm(const float* __restrict__ xp, const float* __restrict__ xs, const float* __restrict__ g, bf16_t* __restrict__ xn, float* __restrict__ yp, float* __restrict__ ys) {
    int lane = threadIdx.x & 63, wave = threadIdx.x >> 6; asm volatile("" : "+v"(lane), "+v"(wave));
    for (int t = blockIdx.x * 8 + wave; t < TT; t += gridDim.x * 8) {
        const float* x = t < TP ? xp + (size_t)t * 1024 : xs + (size_t)(t - TP) * 1024;
        f32x4 v[4]; float ss = 0.f;
#pragma unroll
        for (int i = 0; i < 4; ++i) { v[i] = *(const f32x4*)(x + i * 256 + lane * 4); ss += v[i][0] * v[i][0] + v[i][1] * v[i][1] + v[i][2] * v[i][2] + v[i][3] * v[i][3]; }
        ss = wave_sum(ss); const float r = rsqrtf(ss * (1.0f / 1024.0f) + EPS);
#pragma unroll
        for (int i = 0; i < 4; ++i) { const int c = i * 256 + lane * 4; const f32x4 gg = *(const f32x4*)(g + c); const f32x4 o = v[i] * r * gg;
            if (xn) { u32x2 w; w.x = pg8::cvt_pk_bf16(o[0], o[1]); w.y = pg8::cvt_pk_bf16(o[2], o[3]); *(u32x2*)(xn + (size_t)t * 1024 + c) = w; }
            else { float* y = t < TP ? yp + (size_t)t * 1024 : ys + (size_t)(t - TP) * 1024; *(f32x4*)(y + c) = o; } }
    }
}

__global__ void __launch_bounds__(NTHR, 2) k_mega(Params p) {
    extern __shared__ __attribute__((aligned(16))) unsigned char lds_raw[];
    LAS unsigned char* lds = (LAS unsigned char*)lds_raw;
    volatile LAS unsigned* misc = (volatile LAS unsigned*)(lds + LDS_MISC);
    for (int u = threadIdx.x; u < 64; u += NTHR) misc[u] = 0u;
    __syncthreads();
    const int lo = p.ph_lo, hi = p.ph_hi;
    XcdBarrier bar; bar.bar = p.bar + p.li * XCD_BAR_WORDS; bar.x = 0; bar.st = nullptr;
    if (hi - lo > 1) bar = xcd_barrier_post(p.bar + p.li * XCD_BAR_WORDS, misc + 8);
#define IN(k) (lo <= (k) && (k) < hi)
#define SEAM(k) do { if (IN(k) && IN((k) + 1)) xcd_barrier(bar); } while (0)

    if (IN(PH_PRO)) {
        LAS float* tile = (LAS float*)lds;
        for (int l = 0; l < 2; ++l) {
            ph_tr(p.w_in + (size_t)l * 1024 * IN_W, p.WinT + (size_t)l * IN_WP * 1024, 1024, IN_W, IN_WP, tile, 0);
            ph_tr(p.w_uq + (size_t)l * 384 * 768, p.WuqT + (size_t)l * 768 * 384, 384, 768, 768, tile, 0);
            ph_tr(p.w_uk + (size_t)l * 256 * 512, p.WkvT + (size_t)l * 1024 * 256, 256, 512, 512, tile, 144);
            ph_tr(p.w_uv + (size_t)l * 256 * 512, p.WkvT + (size_t)l * 1024 * 256 + (size_t)512 * 256, 256, 512, 512, tile, 208);
            ph_tr(p.w_br0 + (size_t)l * 512 * 1024, p.WbrT + ((size_t)l * 3 + 0) * 1024 * 512, 512, 1024, 1024, tile, 0);
            ph_tr(p.w_br1 + (size_t)l * 512 * 1024, p.WbrT + ((size_t)l * 3 + 1) * 1024 * 512, 512, 1024, 1024, tile, 0);
            ph_tr(p.w_br2 + (size_t)l * 512 * 1024, p.WbrT + ((size_t)l * 3 + 2) * 1024 * 512, 512, 1024, 1024, tile, 0);
            ph_tr(p.w_out + (size_t)l * 1024 * 1024, p.WoutT + (size_t)l * 1024 * 1024, 1024, 1024, 1024, tile, 0);
        }
        ph_rope_tab(p.tab);
        ph_rmsnorm(p.x_prompt, p.x_sample, p.norm_g, p.xn, nullptr, nullptr);
    }
    SEAM(PH_PRO);
    for (int l = 0; l < 2; ++l) {
        int G = gridDim.x, bid = blockIdx.x; asm volatile("" : "+s"(G), "+s"(bid));
        const float* xp = l == 0 ? p.x_prompt : p.xres; const float* xs = l == 0 ? p.x_sample : p.xres + (size_t)TP * 1024;
        if (IN(PHID(l, PH_GIN))) {
            pg8::Gemm g{p.xn, p.WinT + (size_t)l * IN_WP * 1024, TT, IN_WP, 1024}; pg8::StaticOrder S; S.init(TT, IN_WP, G, bid);
            MEpiH E{p.H, p.BA}; pg8::gemm_phase<MEpiH, pg8::StaticOrder, false>(lds, g, S, E, nullptr);
        }
        SEAM(PHID(l, PH_GIN));
        SEAM(PHID(l, PH_TOK));
        if (IN(PHID(l, PH_GQ))) {
            { pg8::Gemm g{p.cq, p.WuqT + (size_t)l * 768 * 384, TT, 768, 384}; pg8::StaticOrder S; S.init(TT, 768, G, bid);
              MEpiQ E{p.Q, p.tab}; pg8::gemm_phase<MEpiQ, pg8::StaticOrder, false>(lds, g, S, E, nullptr); }
        }
        if (IN(PHID(l, PH_GQ))) {
            { pg8::Gemm g{p.ckv, p.WkvT + (size_t)l * 1024 * 256, TP, 1024, 256}; pg8::StaticOrder S; S.init(TP, 1024, G, bid);
              MEpiKV E{p.Kn, p.V}; pg8::gemm_phase<MEpiKV, pg8::StaticOrder, false>(lds, g, S, E, nullptr); }
        }
        SEAM(PHID(l, PH_GQ));
        SEAM(PHID(l, PH_ATT));
        SEAM(PHID(l, PH_FIN));
        if (IN(PHID(l, PH_MERGE))) {
            { pg8::Gemm g{p.ya, p.WbrT + ((size_t)l * 3 + 0) * 1024 * 512, TT, 1024, 512}; pg8::StaticOrder S; S.init(TT, 1024, G, bid);
              MEpiMerge<0> E{p.H, p.mf, p.mb}; pg8::gemm_phase<MEpiMerge<0>, pg8::StaticOrder, false>(lds, g, S, E, nullptr); }
            { pg8::Gemm g{p.yb, p.WbrT + ((size_t)l * 3 + 1) * 1024 * 512, TT, 1024, 512}; pg8::StaticOrder S; S.init(TT, 1024, G, bid);
              MEpiMerge<1> E{p.H, p.mf, p.mb}; pg8::gemm_phase<MEpiMerge<1>, pg8::StaticOrder, false>(lds, g, S, E, nullptr); }
            { pg8::Gemm g{p.yc, p.WbrT + ((size_t)l * 3 + 2) * 1024 * 512, TT, 1024, 512}; pg8::StaticOrder S; S.init(TT, 1024, G, bid);
              MEpiMerge<2> E{p.H, p.mf, p.mb}; pg8::gemm_phase<MEpiMerge<2>, pg8::StaticOrder, false>(lds, g, S, E, nullptr); }
        }
        SEAM(PHID(l, PH_MERGE));
        if (IN(PHID(l, PH_OUT))) {
            pg8::Gemm g{p.mb, p.WoutT + (size_t)l * 1024 * 1024, TT, 1024, 1024}; pg8::StaticOrder S; S.init(TT, 1024, G, bid);
            MEpiRes E{xp, xs, p.xres}; pg8::gemm_phase<MEpiRes, pg8::StaticOrder, false>(lds, g, S, E, nullptr);
        }
        SEAM(PHID(l, PH_OUT));
        if (IN(PHID(l, PH_NORM))) {
            if (l == 0) ph_rmsnorm(p.xres, p.xres + (size_t)TP * 1024, p.norm_g + 1024, p.xn, nullptr, nullptr);
            else ph_rmsnorm(p.xres, p.xres + (size_t)TP * 1024, p.final_norm_g, nullptr, p.out + O_YP, p.out + O_YS);
        }
        SEAM(PHID(l, PH_NORM));
    }
#undef IN
#undef SEAM
}

static inline size_t al256(size_t x) { return (x + 255) & ~(size_t)255; }
extern "C" void kernel_launch(void* const* d_in, const int* in_sizes, int n_in, void* d_out, int out_size, void* d_ws, size_t ws_size, hipStream_t stream) {
    static int grid = 0;
    if (grid == 0) {
        int dev = 0, cus = 0; (void)hipGetDevice(&dev); (void)hipDeviceGetAttribute(&cus, hipDeviceAttributeMultiprocessorCount, dev);
        (void)hipFuncSetAttribute((const void*)k_mega, hipFuncAttributeMaxDynamicSharedMemorySize, LDS_BYTES);
        int per_cu = 0; (void)hipOccupancyMaxActiveBlocksPerMultiprocessor(&per_cu, (const void*)k_mega, NTHR, LDS_BYTES); (void)hipGetLastError();
        grid = cus > 0 ? cus : 256;
    }
    Params p{};
    p.x_prompt = (const float*)d_in[0]; p.x_sample = (const float*)d_in[1]; p.cache_kv = (const float*)d_in[2]; p.cache_kr = (const float*)d_in[3];
    p.state_pool = (const float*)d_in[4]; p.state_conv = (const float*)d_in[5]; p.state_delta = (const float*)d_in[6]; p.page_table = (const int*)d_in[7];
    p.norm_g = (const float*)d_in[8]; p.w_in = (const float*)d_in[9]; p.pool_mix = (const float*)d_in[10]; p.pool_scale = (const float*)d_in[11];
    p.q_norm_g = (const float*)d_in[12]; p.w_uq = (const float*)d_in[13]; p.kv_norm_g = (const float*)d_in[14]; p.w_uk = (const float*)d_in[15];
    p.w_uv = (const float*)d_in[16]; p.conv_w = (const float*)d_in[17]; p.a_log = (const float*)d_in[18]; p.dt_bias = (const float*)d_in[19];
    p.dn_norm_g = (const float*)d_in[20]; p.w_br0 = (const float*)d_in[21]; p.w_br1 = (const float*)d_in[22]; p.w_br2 = (const float*)d_in[23];
    p.w_out = (const float*)d_in[24]; p.final_norm_g = (const float*)d_in[25];
    p.out = (float*)d_out;
    char* w = (char*)d_ws; size_t off = 0;
    auto take = [&](size_t bytes) { char* q = w + off; off += al256(bytes); return q; };
    const size_t BAR_BYTES = (size_t)16 * XCD_BAR_WORDS * 4;
    p.bar = (unsigned*)take(BAR_BYTES);
    p.WinT = (bf16_t*)take((size_t)2 * IN_WP * 1024 * 2);
    p.WuqT = (bf16_t*)take((size_t)2 * 768 * 384 * 2);
    p.WkvT = (bf16_t*)take((size_t)2 * 1024 * 256 * 2);
    p.WbrT = (bf16_t*)take((size_t)2 * 3 * 1024 * 512 * 2);
    p.WoutT = (bf16_t*)take((size_t)2 * 1024 * 1024 * 2);
    p.tab = (float2*)take((size_t)(SEQ + DEC_SEQ) * 16 * 8);
    p.xres = (float*)take((size_t)TT * 1024 * 4);
    p.xn = (bf16_t*)take((size_t)TT * 1024 * 2);
    p.H = (bf16_t*)take((size_t)TT * IN_WP * 2);
    p.BA = (float*)take((size_t)TT * 16 * 4);
    p.cq = (bf16_t*)take((size_t)TT * 384 * 2);
    p.ckv = (bf16_t*)take((size_t)TT * 256 * 2);
    p.Kr = (bf16_t*)take((size_t)TT * 32 * 2);
    p.Q = (bf16_t*)take((size_t)TT * 768 * 2);
    bf16_t* Qlat = (bf16_t*)take((size_t)TS * 8 * 288 * 2);
    p.Kn = (bf16_t*)take((size_t)TP * 512 * 2);
    p.V = (bf16_t*)take((size_t)TP * 512 * 2);
    p.qd = (bf16_t*)take((size_t)TT * 512 * 2);
    p.kd = (bf16_t*)take((size_t)TT * 512 * 2);
    p.vd = (bf16_t*)take((size_t)TT * 512 * 2);
    p.bg = (float*)take((size_t)TT * 16 * 4);
    p.ya = (bf16_t*)take((size_t)TT * 512 * 2);
    p.yb = (bf16_t*)take((size_t)TT * 512 * 2);
    p.yc = (bf16_t*)take((size_t)TT * 512 * 2);
    p.mf = (float*)take((size_t)TT * 1024 * 4);
    p.mb = (bf16_t*)take((size_t)TT * 1024 * 2);
    p.part = (float*)take((size_t)DEC_BATCH * SA_CH * 64 * 258 * 4);

    (void)hipMemsetAsync(p.bar, 0, BAR_BYTES, stream);
    int li = 0;
    auto mega = [&](int lo, int hi) { Params q = p; q.ph_lo = lo; q.ph_hi = hi; q.li = li++; q.pad = 0; hipLaunchKernelGGL(k_mega, dim3(grid), dim3(NTHR), LDS_BYTES, stream, q); };
    mega(PH_PRO, PHID(0, PH_GIN) + 1);
    for (int l = 0; l < 2; ++l) {
        if (l == 1) mega(PHID(1, PH_GIN), PHID(1, PH_GIN) + 1);
        k_tok_a<<<TT, 64, 0, stream>>>(p.H, p.q_norm_g + l * 384, p.kv_norm_g + l * 256, p.tab, p.cq, p.ckv, p.Kr, p.out, l, 0);
        k_tok_conv<<<TT, 256, 0, stream>>>(p.H, p.BA, p.conv_w + (size_t)l * 4 * 1536, p.state_conv, p.a_log + l * 8, p.dt_bias + l * 8, p.qd, p.kd, p.vd, p.bg, p.out, l, 0);
        k_pool<<<dim3(TT, 4), 128, 0, stream>>>(p.H, p.state_pool, p.pool_mix, p.pool_scale, p.ya, p.out, l, 0);
        mega(PHID(l, PH_GQ), PHID(l, PH_GQ) + 1);
        k_qlat<<<dim3(TS, 8), 256, 0, stream>>>(p.Q, p.w_uk + (size_t)l * 256 * 512, Qlat);
        k_attn_p<<<dim3(SEQ / 64, 8, 8), 64, 0, stream>>>(p.Q, p.Kn, p.Kr, p.V, p.H, p.yb);
        k_attn_s<<<dim3(DEC_BATCH, SA_CH), 256, 0, stream>>>(Qlat, p.cache_kv, p.cache_kr, p.page_table, p.ckv, p.Kr, p.part, l, 0);
        k_attn_s_fin<<<dim3(TS, 8), 64, 0, stream>>>(p.part, p.w_uv + (size_t)l * 256 * 512, p.H, p.yb);
        k_delta<<<dim3(8 + DEC_BATCH, 8), 64, 0, stream>>>(p.qd, p.kd, p.vd, p.bg, p.state_delta, p.dn_norm_g, p.H, p.yc, p.out, l, 0);
        mega(PHID(l, PH_MERGE), PHID(l, PH_NORM) + 1);
    }
}
```

```cpp
#include <hip/hip_runtime.h>
#include <stdint.h>

typedef unsigned short bf16_t;

#define D_MODEL 1024
#define TP 16384
#define TS 256
#define TT (TP + TS)
#define SEQ 2048
#define DEC_SEQ 8
#define DEC_BATCH 32
#define PAST_LEN 16384
#define PAGE 128
#define N_PAGES 128
#define N_POOL 5120
#define IN_W 7344
#define IN_WP 7424
#define C_POOL 0
#define C_ZPOOL 512
#define C_Q 1024
#define C_KV 1408
#define C_KR 1664
#define C_ZMLA 1696
#define C_QKV 2208
#define C_ZDN 3744
#define C_BETA 4256
#define C_ALPHA 4264
#define C_GATE 4272
#define EPS 1e-6f
#define MLA_SCALE 0.10206207261596577f

#define O_YP 0
#define O_YS (O_YP + 16777216)
#define O_PKV (O_YS + 262144)
#define O_PKR (O_PKV + 8388608)
#define O_PPOOL (O_PKR + 1048576)
#define O_PCONV (O_PPOOL + 122880)
#define O_PDELTA (O_PCONV + 73728)
#define O_SKV (O_PDELTA + 524288)
#define O_SKR (O_SKV + 131072)
#define O_SPOOL (O_SKR + 16384)
#define O_SCONV (O_SPOOL + 491520)
#define O_SDELTA (O_SCONV + 294912)
#define O_END (O_SDELTA + 2097152)

__device__ __forceinline__ float bf2f(bf16_t b) { return __uint_as_float(((unsigned)b) << 16); }
__device__ __forceinline__ bf16_t f2bf(float f) { unsigned u = __float_as_uint(f); u += 0x7FFFu + ((u >> 16) & 1u); return (bf16_t)(u >> 16); }
__device__ __forceinline__ float sigmoidf_(float v) { return 1.0f / (1.0f + __expf(-v)); }
__device__ __forceinline__ float siluf_(float v) { return v / (1.0f + __expf(-v)); }
__device__ __forceinline__ float wave_sum(float v) {
#pragma unroll
    for (int o = 32; o >= 1; o >>= 1) v += __shfl_xor(v, o);
    return v;
}

__global__ void k_tr(const float* __restrict__ src, bf16_t* __restrict__ dst, int K, int N, int Npad, int pad_) {
    __shared__ float tile[32][33];
    const int n0 = blockIdx.x * 32, k0 = blockIdx.y * 32, tx = threadIdx.x & 31, ty = threadIdx.x >> 5;
    for (int i = ty; i < 32; i += 8) { const int k = k0 + i, n = n0 + tx; tile[i][tx] = (n < N) ? src[(size_t)k * N + n] : 0.f; }
    __syncthreads();
    for (int i = ty; i < 32; i += 8) { const int n = n0 + i, k = k0 + tx; if (n < Npad) dst[(size_t)n * K + k] = f2bf(tile[tx][i]); }
}
__global__ void k_rope_tab(float2* tab) {
    const int idx = blockIdx.x * blockDim.x + threadIdx.x; if (idx >= (SEQ + DEC_SEQ) * 16) return;
    const int p = idx >> 4, i = idx & 15; const int pos = p < SEQ ? p : PAST_LEN + (p - SEQ);
    const float inv = powf(10000.0f, -(float)i / 16.0f);
    const float ang = (float)pos * inv;
    const double rev = (double)ang * 0.15915494309189533576888; const double fr = rev - floor(rev);
    const float f = (float)fr;
    tab[idx] = make_float2(__builtin_amdgcn_cosf(f), __builtin_amdgcn_sinf(f));
}

__global__ void k_rmsnorm(const float* __restrict__ xp, const float* __restrict__ xs, const float* __restrict__ g, bf16_t* __restrict__ xn, float* __restrict__ yp, float* __restrict__ ys) {
    const int t = blockIdx.x; const float* x = t < TP ? xp + (size_t)t * D_MODEL : xs + (size_t)(t - TP) * D_MODEL;
    __shared__ float red[4];
    float v[4]; float ss = 0.f;
#pragma unroll
    for (int i = 0; i < 4; ++i) { v[i] = x[threadIdx.x + 256 * i]; ss += v[i] * v[i]; }
    ss = wave_sum(ss); if ((threadIdx.x & 63) == 0) red[threadIdx.x >> 6] = ss; __syncthreads();
    const float tot = red[0] + red[1] + red[2] + red[3]; const float r = rsqrtf(tot * (1.0f / D_MODEL) + EPS);
#pragma unroll
    for (int i = 0; i < 4; ++i) { const int c = threadIdx.x + 256 * i; const float o = v[i] * r * g[c];
        if (xn) xn[(size_t)t * D_MODEL + c] = f2bf(o);
        else { if (t < TP) yp[(size_t)t * D_MODEL + c] = o; else ys[(size_t)(t - TP) * D_MODEL + c] = o; } }
}

template <class Epi> __global__ void k_gemm(const bf16_t* __restrict__ A, const bf16_t* __restrict__ Bt, int lda, int ldb, int M, int N, int K, int pad_, Epi epi) {
    __shared__ float As[16][68], Bs[16][68];
    const int tm = blockIdx.y * 64, tn = blockIdx.x * 64, tx = threadIdx.x & 15, ty = threadIdx.x >> 4;
    float acc[4][4];
#pragma unroll
    for (int i = 0; i < 4; ++i)
#pragma unroll
        for (int j = 0; j < 4; ++j) acc[i][j] = 0.f;
    for (int k0 = 0; k0 < K; k0 += 16) {
        for (int i = threadIdx.x; i < 1024; i += 256) { const int r = i >> 4, c = i & 15;
            As[c][r] = (tm + r < M) ? bf2f(A[(size_t)(tm + r) * lda + k0 + c]) : 0.f;
            Bs[c][r] = (tn + r < N) ? bf2f(Bt[(size_t)(tn + r) * ldb + k0 + c]) : 0.f; }
        __syncthreads();
#pragma unroll
        for (int kk = 0; kk < 16; ++kk) { float a[4], b[4];
#pragma unroll
            for (int i = 0; i < 4; ++i) { a[i] = As[kk][ty * 4 + i]; b[i] = Bs[kk][tx * 4 + i]; }
#pragma unroll
            for (int i = 0; i < 4; ++i)
#pragma unroll
                for (int j = 0; j < 4; ++j) acc[i][j] += a[i] * b[j]; }
        __syncthreads();
    }
#pragma unroll
    for (int i = 0; i < 4; ++i)
#pragma unroll
        for (int j = 0; j < 4; ++j) { const int m = tm + ty * 4 + i, n = tn + tx * 4 + j; if (m < M && n < N) epi(m, n, acc[i][j]); }
}
struct EpiH { bf16_t* H; float* BA;
    __device__ void operator()(int t, int n, float v) const {
        if (n >= C_BETA && n < C_GATE) BA[(size_t)t * 16 + (n - C_BETA)] = v;
        float o = v;
        if ((n >= C_ZPOOL && n < C_Q) || (n >= C_ZMLA && n < C_QKV) || (n >= C_ZDN && n < C_BETA)) o = siluf_(v);
        else if (n >= C_GATE) o = sigmoidf_(v);
        H[(size_t)t * IN_WP + n] = f2bf(o); } };
struct EpiF32 { float* C; int ldc; int pad_; __device__ void operator()(int t, int n, float v) const { C[(size_t)t * ldc + n] = v; } };
struct EpiKV { bf16_t* Kn; bf16_t* V; __device__ void operator()(int t, int n, float v) const { if (n < 512) Kn[(size_t)t * 512 + n] = f2bf(v); else V[(size_t)t * 512 + (n - 512)] = f2bf(v); } };
struct EpiMerge { const bf16_t* H; float* mf; bf16_t* mb; int br; int pad_;
    __device__ void operator()(int t, int n, float v) const { const float g = bf2f(H[(size_t)t * IN_WP + C_GATE + br * 1024 + n]); float o = g * v; const size_t i = (size_t)t * 1024 + n;
        if (br > 0) o += mf[i]; mf[i] = o; if (br == 2) mb[i] = f2bf(o); } };
struct EpiRes { const float* xp; const float* xs; float* xo;
    __device__ void operator()(int t, int n, float v) const { const float x = t < TP ? xp[(size_t)t * 1024 + n] : xs[(size_t)(t - TP) * 1024 + n]; xo[(size_t)t * 1024 + n] = x + v; } };

__global__ void k_tok_a(const bf16_t* __restrict__ H, const float* __restrict__ qg, const float* __restrict__ kvg, const float2* __restrict__ tab,
                        bf16_t* __restrict__ cq, bf16_t* __restrict__ ckv, bf16_t* __restrict__ Kr, float* __restrict__ out, int layer, int pad_) {
    const int t = blockIdx.x, lane = threadIdx.x; const bf16_t* h = H + (size_t)t * IN_WP;
    float q[6]; float ss = 0.f;
#pragma unroll
    for (int i = 0; i < 6; ++i) { q[i] = bf2f(h[C_Q + lane + 64 * i]); ss += q[i] * q[i]; }
    ss = wave_sum(ss); float r = rsqrtf(ss * (1.0f / 384.0f) + EPS);
#pragma unroll
    for (int i = 0; i < 6; ++i) cq[(size_t)t * 384 + lane + 64 * i] = f2bf(q[i] * r * qg[lane + 64 * i]);
    float kv[4]; ss = 0.f;
#pragma unroll
    for (int i = 0; i < 4; ++i) { kv[i] = bf2f(h[C_KV + lane + 64 * i]); ss += kv[i] * kv[i]; }
    ss = wave_sum(ss); r = rsqrtf(ss * (1.0f / 256.0f) + EPS);
    float* okv; float* okr; int p;
    if (t < TP) { okv = out + O_PKV + ((size_t)layer * TP + t) * 256; okr = out + O_PKR + ((size_t)layer * TP + t) * 32; p = t & (SEQ - 1); }
    else { const int ts = t - TP; okv = out + O_SKV + ((size_t)layer * TS + ts) * 256; okr = out + O_SKR + ((size_t)layer * TS + ts) * 32; p = SEQ + (ts & 7); }
#pragma unroll
    for (int i = 0; i < 4; ++i) { const float o = kv[i] * r * kvg[lane + 64 * i]; okv[lane + 64 * i] = o; ckv[(size_t)t * 256 + lane + 64 * i] = f2bf(o); }
    if (lane < 16) { const float x1 = bf2f(h[C_KR + lane]), x2 = bf2f(h[C_KR + 16 + lane]); const float2 cs = tab[p * 16 + lane];
        const float o1 = x1 * cs.x - x2 * cs.y, o2 = x2 * cs.x + x1 * cs.y;
        okr[lane] = o1; okr[16 + lane] = o2; Kr[(size_t)t * 32 + lane] = f2bf(o1); Kr[(size_t)t * 32 + 16 + lane] = f2bf(o2); }
}

__global__ void k_tok_conv(const bf16_t* __restrict__ H, const float* __restrict__ BA, const float* __restrict__ conv_w, const float* __restrict__ state_conv,
                           const float* __restrict__ a_log, const float* __restrict__ dt_bias, bf16_t* __restrict__ qd, bf16_t* __restrict__ kd, bf16_t* __restrict__ vd,
                           float* __restrict__ bg, float* __restrict__ out, int layer, int pad_) {
    const int t = blockIdx.x, tid = threadIdx.x;
    int i_seq, row0; const float* sc = nullptr;
    if (t < TP) { i_seq = t & (SEQ - 1); row0 = t - i_seq; }
    else { const int ts = t - TP; i_seq = ts & 7; row0 = t - i_seq; sc = state_conv + ((size_t)layer * DEC_BATCH + (ts >> 3)) * 3 * 1536; }
#pragma unroll
    for (int i = 0; i < 6; ++i) {
        const int c = tid + 256 * i; float y = 0.f;
#pragma unroll
        for (int j = 0; j < 4; ++j) { const int u = i_seq - 3 + j; float xv;
            if (u >= 0) xv = bf2f(H[(size_t)(row0 + u) * IN_WP + C_QKV + c]); else xv = sc ? sc[(size_t)(u + 3) * 1536 + c] : 0.f;
            y += xv * conv_w[j * 1536 + c]; }
        float v = siluf_(y);
        if (i < 4) { const float ss = wave_sum(v * v); v *= rsqrtf(ss + EPS); if (i < 2) v *= 0.125f; }
        const bf16_t o = f2bf(v);
        if (i < 2) qd[(size_t)t * 512 + c] = o; else if (i < 4) kd[(size_t)t * 512 + (c - 512)] = o; else vd[(size_t)t * 512 + (c - 1024)] = o;
        if (t < TP) { if (i_seq >= SEQ - 3) out[O_PCONV + (((size_t)layer * 8 + (t >> 11)) * 3 + (i_seq - (SEQ - 3))) * 1536 + c] = bf2f(H[(size_t)t * IN_WP + C_QKV + c]); }
        else { if (i_seq >= DEC_SEQ - 3) out[O_SCONV + (((size_t)layer * DEC_BATCH + ((t - TP) >> 3)) * 3 + (i_seq - (DEC_SEQ - 3))) * 1536 + c] = bf2f(H[(size_t)t * IN_WP + C_QKV + c]); }
    }
    if (tid < 8) { const float b = sigmoidf_(BA[(size_t)t * 16 + tid]); const float x = BA[(size_t)t * 16 + 8 + tid] + dt_bias[tid];
        const float sp = x > 20.f ? x : log1pf(expf(x)); const float g = -expf(a_log[tid]) * sp;
        bg[(size_t)t * 16 + tid] = b; bg[(size_t)t * 16 + 8 + tid] = g; }
}

__global__ void k_pool(const bf16_t* __restrict__ H, const float* __restrict__ state_pool, const float* __restrict__ mix, const float* __restrict__ scale,
                       bf16_t* __restrict__ ya, float* __restrict__ out, int layer, int pad_) {
    const int t = blockIdx.x, g = blockIdx.y, c = threadIdx.x, ch = g * 128 + c; const int w = 2 << g;
    __shared__ float d[128];
    int i_seq, row0; const float* sp = nullptr;
    if (t < TP) { i_seq = t & (SEQ - 1); row0 = t - i_seq; }
    else { const int ts = t - TP; i_seq = ts & 7; row0 = t - i_seq; sp = state_pool + ((size_t)layer * DEC_BATCH + (ts >> 3)) * 15 * 512; }
    float sum = 0.f;
    for (int k = 0; k < w; ++k) { const int u = i_seq - k; float xv;
        if (u >= 0) xv = bf2f(H[(size_t)(row0 + u) * IN_WP + C_POOL + ch]); else xv = sp ? sp[(size_t)(15 + u) * 512 + ch] : 0.f;
        sum += xv; }
    const float cur = bf2f(H[(size_t)t * IN_WP + C_POOL + ch]);
    const float cnt = t < TP ? (float)min(i_seq + 1, w) : (float)w;
    d[c] = sum / cnt - cur;
    __syncthreads();
    float y = 0.f; const float* m = mix + ((size_t)layer * 4 + g) * 128 * 128;
    for (int k = 0; k < 128; ++k) y += d[k] * m[k * 128 + c];
    y *= scale[layer * 512 + ch];
    y *= bf2f(H[(size_t)t * IN_WP + C_ZPOOL + ch]);
    ya[(size_t)t * 512 + ch] = f2bf(y);
    if (t < TP) { if (i_seq >= SEQ - 15) out[O_PPOOL + (((size_t)layer * 8 + (t >> 11)) * 15 + (i_seq - (SEQ - 15))) * 512 + ch] = cur; }
    else { const int s = (t - TP) >> 3; float* o = out + O_SPOOL + ((size_t)layer * DEC_BATCH + s) * 15 * 512;
        o[(size_t)(7 + i_seq) * 512 + ch] = cur;
        if (i_seq < 7) o[(size_t)i_seq * 512 + ch] = sp[(size_t)(8 + i_seq) * 512 + ch]; }
}

__global__ void k_qrope(const float* __restrict__ Qf, const float2* __restrict__ tab, bf16_t* __restrict__ Q) {
    const int t = blockIdx.x, tid = threadIdx.x;
    const int h = tid >> 5, j = tid & 31; const float* q = Qf + (size_t)t * 768 + h * 96; bf16_t* o = Q + (size_t)t * 768 + h * 96;
    o[j] = f2bf(q[j]); o[32 + j] = f2bf(q[32 + j]);
    const int p = t < TP ? (t & (SEQ - 1)) : SEQ + ((t - TP) & 7);
    if (j < 16) { const float x1 = q[64 + j], x2 = q[80 + j]; const float2 cs = tab[p * 16 + j]; o[64 + j] = f2bf(x1 * cs.x - x2 * cs.y); o[80 + j] = f2bf(x2 * cs.x + x1 * cs.y); }
}
__global__ void k_qlat(const bf16_t* __restrict__ Q, const float* __restrict__ w_uk, bf16_t* __restrict__ Qlat) {
    const int ts = blockIdx.x, h = blockIdx.y, c = threadIdx.x;
    const bf16_t* q = Q + (size_t)(TP + ts) * 768 + h * 96; float acc = 0.f;
    for (int d = 0; d < 64; ++d) acc += bf2f(q[d]) * w_uk[(size_t)c * 512 + h * 64 + d];
    bf16_t* o = Qlat + ((size_t)ts * 8 + h) * 288; o[c] = f2bf(acc); if (c < 32) o[256 + c] = q[64 + c];
}

__global__ void __launch_bounds__(64) k_attn_p(const bf16_t* __restrict__ Q, const bf16_t* __restrict__ Kn, const bf16_t* __restrict__ Kr, const bf16_t* __restrict__ V,
                                               const bf16_t* __restrict__ H, bf16_t* __restrict__ yb) {
    const int qb = blockIdx.x, h = blockIdx.y, b = blockIdx.z, lane = threadIdx.x; const int i = qb * 64 + lane, t = b * SEQ + i;
    float q[96];
#pragma unroll
    for (int d = 0; d < 96; ++d) q[d] = bf2f(Q[(size_t)t * 768 + h * 96 + d]) * MLA_SCALE;
    float o[64];
#pragma unroll
    for (int d = 0; d < 64; ++d) o[d] = 0.f;
    float m = -1e30f, l = 0.f;
    const int jmax = qb * 64 + 63;
    for (int j = 0; j <= jmax; ++j) {
        const size_t tk = (size_t)b * SEQ + j; const bf16_t* kn = Kn + tk * 512 + h * 64; const bf16_t* kr = Kr + tk * 32; const bf16_t* vv = V + tk * 512 + h * 64;
        float s = 0.f;
#pragma unroll
        for (int d = 0; d < 64; ++d) s += q[d] * bf2f(kn[d]);
#pragma unroll
        for (int d = 0; d < 32; ++d) s += q[64 + d] * bf2f(kr[d]);
        if (j <= i) {
            const float mn = fmaxf(m, s), al = __expf(m - mn), p = __expf(s - mn); l = l * al + p; m = mn;
#pragma unroll
            for (int d = 0; d < 64; ++d) o[d] = o[d] * al + p * bf2f(vv[d]);
        }
    }
    const float il = 1.0f / l;
#pragma unroll
    for (int d = 0; d < 64; ++d) yb[(size_t)t * 512 + h * 64 + d] = f2bf(o[d] * il * bf2f(H[(size_t)t * IN_WP + C_ZMLA + h * 64 + d]));
}

#define SA_CH 33
__global__ void __launch_bounds__(256) k_attn_s(const bf16_t* __restrict__ Qlat, const float* __restrict__ ckv_cache, const float* __restrict__ kr_cache, const int* __restrict__ page_table,
                                                const bf16_t* __restrict__ ckv_new, const bf16_t* __restrict__ kr_new, float* __restrict__ part, int layer, int pad_) {
    const int s = blockIdx.x, ch = blockIdx.y, tid = threadIdx.x, r = tid & 63, cq = tid >> 6;
    __shared__ bf16_t Ks[32][296];
    __shared__ float Ss[64][33];
    __shared__ bf16_t Qs[64][290];
    for (int i = tid; i < 64 * 288; i += 256) { const int rr = i / 288, c = i % 288; Qs[rr][c] = Qlat[((size_t)s * 64 + rr) * 288 + c]; }
    float o[64];
#pragma unroll
    for (int d = 0; d < 64; ++d) o[d] = 0.f;
    float m = -1e30f, l = 0.f;
    const int i_tok = r >> 3;
    const int ntile = ch < 32 ? 16 : 1;
    for (int tl = 0; tl < ntile; ++tl) {
        __syncthreads();
        if (ch < 32) { const int j0 = ch * 512 + tl * 32; const int page = page_table[s * N_PAGES + (j0 >> 7)]; const int prow = j0 & 127;
            const float* kvp = ckv_cache + (((size_t)layer * N_POOL + page) * PAGE + prow) * 256; const float* krp = kr_cache + (((size_t)layer * N_POOL + page) * PAGE + prow) * 32;
            for (int i = tid; i < 32 * 256; i += 256) Ks[i >> 8][i & 255] = f2bf(kvp[i]);
            for (int i = tid; i < 32 * 32; i += 256) Ks[i >> 5][256 + (i & 31)] = f2bf(krp[i]);
        } else {
            for (int i = tid; i < 32 * 256; i += 256) { const int k = i >> 8; Ks[k][i & 255] = k < 8 ? ckv_new[((size_t)TP + s * 8 + k) * 256 + (i & 255)] : (bf16_t)0; }
            for (int i = tid; i < 32 * 32; i += 256) { const int k = i >> 5; Ks[k][256 + (i & 31)] = k < 8 ? kr_new[((size_t)TP + s * 8 + k) * 32 + (i & 31)] : (bf16_t)0; }
        }
        __syncthreads();
#pragma unroll
        for (int kk = 0; kk < 8; ++kk) { const int k = cq * 8 + kk; float sc = 0.f;
            for (int c = 0; c < 288; ++c) sc += bf2f(Qs[r][c]) * bf2f(Ks[k][c]);
            sc *= MLA_SCALE; if (ch == 32 && k > i_tok) sc = -1e30f; Ss[r][k] = sc; }
        __syncthreads();
        float tm = -1e30f;
        for (int k = 0; k < 32; ++k) tm = fmaxf(tm, Ss[r][k]);
        const float mn = fmaxf(m, tm), al = __expf(m - mn); m = mn; l *= al;
#pragma unroll
        for (int d = 0; d < 64; ++d) o[d] *= al;
        for (int k = 0; k < 32; ++k) { const float sc = Ss[r][k]; const float p = sc <= -1e29f ? 0.f : __expf(sc - mn); l += p;
#pragma unroll
            for (int d = 0; d < 64; ++d) o[d] += p * bf2f(Ks[k][cq * 64 + d]); }
    }
    float* pp = part + (((size_t)s * SA_CH + ch) * 64 + r) * 258;
#pragma unroll
    for (int d = 0; d < 64; ++d) pp[cq * 64 + d] = o[d];
    if (cq == 0) { pp[256] = m; pp[257] = l; }
}
__global__ void k_attn_s_fin(const float* __restrict__ part, const float* __restrict__ w_uv, const bf16_t* __restrict__ H, bf16_t* __restrict__ yb) {
    const int ts = blockIdx.x, h = blockIdx.y, d = threadIdx.x; const int s = ts >> 3, r = (ts & 7) * 8 + h;
    __shared__ float ol[256]; __shared__ float wgt[SA_CH];
    float M = -1e30f;
    for (int ch = 0; ch < SA_CH; ++ch) M = fmaxf(M, part[(((size_t)s * SA_CH + ch) * 64 + r) * 258 + 256]);
    float L = 0.f;
    for (int ch = 0; ch < SA_CH; ++ch) { const float* pp = part + (((size_t)s * SA_CH + ch) * 64 + r) * 258; const float w = __expf(pp[256] - M); L += pp[257] * w; if (d == 0) wgt[ch] = w; }
    __syncthreads();
    for (int c = d; c < 256; c += 64) { float a = 0.f; for (int ch = 0; ch < SA_CH; ++ch) a += wgt[ch] * part[(((size_t)s * SA_CH + ch) * 64 + r) * 258 + c]; ol[c] = a / L; }
    __syncthreads();
    float a = 0.f;
    for (int c = 0; c < 256; ++c) a += ol[c] * w_uv[(size_t)c * 512 + h * 64 + d];
    const int t = TP + ts;
    yb[(size_t)t * 512 + h * 64 + d] = f2bf(a * bf2f(H[(size_t)t * IN_WP + C_ZMLA + h * 64 + d]));
}

__global__ void __launch_bounds__(64) k_delta(const bf16_t* __restrict__ qd, const bf16_t* __restrict__ kd, const bf16_t* __restrict__ vd, const float* __restrict__ bg,
                                              const float* __restrict__ state_delta, const float* __restrict__ dn_g, const bf16_t* __restrict__ H, bf16_t* __restrict__ yc,
                                              float* __restrict__ out, int layer, int pad_) {
    const int sq = blockIdx.x, h = blockIdx.y, dv = threadIdx.x;
    int row0, L; float* so; float S[64];
    if (sq < 8) { row0 = sq * SEQ; L = SEQ; so = out + O_PDELTA + (((size_t)layer * 8 + sq) * 8 + h) * 4096;
#pragma unroll
        for (int k = 0; k < 64; ++k) S[k] = 0.f; }
    else { const int s = sq - 8; row0 = TP + s * 8; L = DEC_SEQ; so = out + O_SDELTA + (((size_t)layer * DEC_BATCH + s) * 8 + h) * 4096;
        const float* s0 = state_delta + (((size_t)layer * DEC_BATCH + s) * 8 + h) * 4096;
#pragma unroll
        for (int k = 0; k < 64; ++k) S[k] = s0[k * 64 + dv]; }
    const float gn = dn_g[layer * 64 + dv];
    for (int i = 0; i < L; ++i) {
        const size_t t = (size_t)row0 + i; const bf16_t* kp = kd + t * 512 + h * 64; const bf16_t* qp = qd + t * 512 + h * 64;
        const float b = bg[t * 16 + h], a = __expf(bg[t * 16 + 8 + h]); const float v = bf2f(vd[t * 512 + h * 64 + dv]);
        float ks = 0.f;
#pragma unroll
        for (int k = 0; k < 64; ++k) ks += bf2f(kp[k]) * S[k];
        const float vn = b * (v - a * ks);
        float o = 0.f;
#pragma unroll
        for (int k = 0; k < 64; ++k) { S[k] = a * S[k] + bf2f(kp[k]) * vn; o += bf2f(qp[k]) * S[k]; }
        const float ss = wave_sum(o * o); const float y = o * rsqrtf(ss * (1.0f / 64.0f) + EPS) * gn;
        yc[t * 512 + h * 64 + dv] = f2bf(y * bf2f(H[t * IN_WP + C_ZDN + h * 64 + dv]));
    }
#pragma unroll
    for (int k = 0; k < 64; ++k) so[k * 64 + dv] = S[k];
}

namespace pg8 {
#define PG8_LAS __attribute__((address_space(3)))
typedef unsigned short bf16_t;
typedef short bf16x8 __attribute__((ext_vector_type(8)));
typedef float f32x4 __attribute__((ext_vector_type(4)));
typedef unsigned u32x4 __attribute__((ext_vector_type(4)));
constexpr int BM = 256, BK = 64, HALF = 128, HTB = HALF * BK * 2  , STAGE_BYTES = 8 * HTB, NXCD = 8, WGM = 8;

__host__ __device__ __forceinline__ int lds_byte(int r, int c) { const int st = (r >> 4) * 2 + (c >> 5), rr = r & 15, cc = c & 31, ob = rr * 64 + cc * 2; return st * 1024 + (ob ^ (((ob >> 9) & 1) << 5)); }
__host__ __device__ __forceinline__ void stage_rc(int b, int& R, int& C) { const int st = b / 1024, sb = b % 1024, swz = sb ^ (((sb >> 9) & 1) << 5); R = (st >> 1) * 16 + swz / 64; C = (st & 1) * 32 + (swz % 64) / 2; }
__host__ __device__ __forceinline__ int perm32(int rho) { const int n = rho >> 4, i = rho & 15; return 8 * (i >> 2) + 4 * n + (i & 3); }

struct Unit { int pm, pn; };
struct Gemm { const bf16_t* A; const bf16_t* Bt; int M, N, K; };

struct StaticOrder {
    int nM, nN, nwg, G, c;
    __host__ __device__ void init(int M, int N, int G_, int c_) { nM = M / BM; nN = N / BM; nwg = nM * nN; G = G_; c = c_; }
    __host__ __device__ bool next(int i, Unit& u) const {
        const long L = (long)i * G + c; if (L >= nwg) return false;
        int wgid = (int)L; { const int q = nwg / NXCD, r = nwg % NXCD, xcd = wgid % NXCD, off = wgid / NXCD; wgid = (xcd < r ? xcd * (q + 1) : r * (q + 1) + (xcd - r) * q) + off; }
        const int nig = WGM * nN, gid = wgid / nig, fm = gid * WGM, gsz = (nM - fm) < WGM ? (nM - fm) : WGM;
        u.pm = fm + ((wgid % nig) % gsz); u.pn = (wgid % nig) / gsz; return true;
    }
    __device__ __forceinline__ void a_ready(const Unit&) const {}
    __device__ __forceinline__ void done(const Unit&) const {}
};
__device__ __forceinline__ unsigned cvt_pk_bf16(float lo, float hi) { unsigned r; asm volatile("v_cvt_pk_bf16_f32 %0, %1, %2" : "=v"(r) : "v"(lo), "v"(hi)); return r; }
typedef float f32x2 __attribute__((ext_vector_type(2)));
template <class Epi, class Sched, bool STAMP = false>
__device__ __forceinline__ void gemm_phase(PG8_LAS unsigned char* lds, const Gemm g, const Sched& S, const Epi& E, unsigned long long* stamps) {
    int tid_ = threadIdx.x; asm volatile("" : "+v"(tid_));
    const int tid = tid_, wid = __builtin_amdgcn_readfirstlane(tid >> 6), lane = tid & 63, wr = wid >> 2, wc = wid & 3, fr = lane & 15, fq = lane >> 4;
    int K_ = g.K; asm volatile("" : "+s"(K_));
    const int K = K_, nt = K / BK;
    int ts_lo = 0, ts_hi = 0, nts = 0; const unsigned long long rt_entry = STAMP ? (unsigned long long)wall_clock64() : 0ull;
#define PG8_STAMP() do { if (STAMP && wid == 0 && nts < 64) { const unsigned long long _c = (unsigned long long)clock64(); \
        ts_lo = (lane == nts) ? (int)(unsigned)_c : ts_lo; ts_hi = (lane == nts) ? (int)(unsigned)(_c >> 32) : ts_hi; ++nts; } } while (0)
    PG8_STAMP();
    unsigned voffA[2], voffB[2];
#pragma unroll
    for (int i = 0; i < 2; ++i) { int R, C; stage_rc(tid * 16 + i * 8192, R, C); const int Rb = Epi::PERM ? ((R & ~31) + perm32(R & 31)) : R;
        voffA[i] = (unsigned)(R * K + C) * 2u; voffB[i] = (unsigned)(Rb * K + C) * 2u; }
    const size_t kstep = (size_t)(BK * 2);
    const size_t hstep = (size_t)HALF * K * 2;
    const size_t tstep = 2 * hstep;
    const unsigned ldsw = (unsigned)wid * 1024u;
    const int aoff = lds_byte(wr * 64 + fr, fq * 8), boff = lds_byte(wc * 32 + fr, fq * 8);
#define PG8_SA(b, h) (((b) * 2 + (h)) * HTB)
#define PG8_SB(b, h) ((4 + (b) * 2 + (h)) * HTB)
#define PG8_STAGE(bufoff, gbase, voff) do { _Pragma("unroll") for (int _i = 0; _i < 2; ++_i) \
        __builtin_amdgcn_global_load_lds((const unsigned*)((const char*)(gbase) + (voff)[_i]), (PG8_LAS unsigned*)(lds + (bufoff) + ldsw + _i * 8192), 16, 0, 0); } while (0)
#define PG8_LDA(dst, b, h) do { _Pragma("unroll") for (int m = 0; m < 4; ++m) _Pragma("unroll") for (int k = 0; k < 2; ++k) dst[m][k] = *(const PG8_LAS bf16x8*)(lds + PG8_SA(b, h) + aoff + m * 2048 + k * 1024); } while (0)
#define PG8_LDB(dst, b, h) do { _Pragma("unroll") for (int n = 0; n < 2; ++n) _Pragma("unroll") for (int k = 0; k < 2; ++k) dst[n][k] = *(const PG8_LAS bf16x8*)(lds + PG8_SB(b, h) + boff + n * 2048 + k * 1024); } while (0)
#define PG8_MMA(ai, bj, At, Bt) do { __builtin_amdgcn_s_setprio(1); _Pragma("unroll") for (int m = 0; m < 4; ++m) _Pragma("unroll") for (int n = 0; n < 2; ++n) _Pragma("unroll") for (int k = 0; k < 2; ++k) \
        acc[ai][bj][m][n] = __builtin_amdgcn_mfma_f32_16x16x32_bf16(Bt[n][k], At[m][k], acc[ai][bj][m][n], 0, 0, 0); __builtin_amdgcn_s_setprio(0); } while (0)
#define PG8_WAIT_V(n) asm volatile("s_waitcnt vmcnt(" #n ")" ::: "memory")
#define PG8_WAIT_L(n) asm volatile("s_waitcnt lgkmcnt(" #n ")" ::: "memory")
#define PG8_BAR __builtin_amdgcn_s_barrier()
#define PG8_SCHED __builtin_amdgcn_sched_barrier(0)
    Unit cur, nxt; int ui = 0;
    if (!S.next(0, cur)) return;
    f32x4 acc[2][2][4][2];
#pragma unroll
    for (int a = 0; a < 2; ++a)
#pragma unroll
        for (int b = 0; b < 2; ++b)
#pragma unroll
            for (int m = 0; m < 4; ++m)
#pragma unroll
                for (int n = 0; n < 2; ++n) acc[a][b][m][n] = (f32x4){0.f, 0.f, 0.f, 0.f};
    bf16x8 At[4][2], B0[2][2], B1[2][2];
    const char* cA = (const char*)g.A + (size_t)cur.pm * tstep; const char* cB = (const char*)g.Bt + (size_t)cur.pn * tstep;
    S.a_ready(cur);
    PG8_STAGE(PG8_SB(0, 0), cB, voffB); PG8_STAGE(PG8_SA(0, 0), cA, voffA); PG8_STAGE(PG8_SB(0, 1), cB + hstep, voffB); PG8_STAGE(PG8_SA(0, 1), cA + hstep, voffA);
    if (wr == 1) PG8_BAR;
    PG8_WAIT_V(4); PG8_BAR;
    PG8_STAGE(PG8_SB(1, 0), cB + kstep, voffB); PG8_STAGE(PG8_SA(1, 0), cA + kstep, voffA); PG8_STAGE(PG8_SB(1, 1), cB + hstep + kstep, voffB);
    PG8_WAIT_V(6); PG8_BAR;
    PG8_STAMP();
    for (;;) {
        const bool has_next = S.next(ui + 1, nxt);
        const char* nA = has_next ? (const char*)g.A + (size_t)nxt.pm * tstep : cA; const char* nB = has_next ? (const char*)g.Bt + (size_t)nxt.pn * tstep : cB;
_Pragma("nounroll")
        for (int t = 0; t < nt; t += 2) {
            const bool last = (t == nt - 2);
            const char* a1 = cA + (size_t)(t + 1) * kstep;
            const char* a2 = last ? nA : cA + (size_t)(t + 2) * kstep; const char* b2 = last ? nB : cB + (size_t)(t + 2) * kstep;
            const char* a3 = a2 + kstep; const char* b3 = b2 + kstep;
            if (last && has_next) S.a_ready(nxt);
            PG8_LDB(B0, 0, 0); PG8_SCHED; PG8_LDA(At, 0, 0); PG8_STAGE(PG8_SA(1, 1), a1 + hstep, voffA);
            PG8_WAIT_L(8); PG8_BAR; PG8_WAIT_L(0); PG8_MMA(0, 0, At, B0); PG8_BAR; PG8_SCHED;
            PG8_LDB(B1, 0, 1); PG8_STAGE(PG8_SB(0, 0), b2, voffB);
            PG8_BAR; PG8_WAIT_L(0); PG8_MMA(0, 1, At, B1); PG8_BAR;
            PG8_LDA(At, 0, 1); PG8_STAGE(PG8_SA(0, 0), a2, voffA);
            PG8_BAR; PG8_WAIT_L(0); PG8_MMA(1, 0, At, B0); PG8_BAR; PG8_SCHED;
            PG8_STAGE(PG8_SB(0, 1), b2 + hstep, voffB);
            PG8_WAIT_V(6); PG8_BAR; PG8_MMA(1, 1, At, B1); PG8_BAR;
            PG8_LDB(B0, 1, 0); PG8_SCHED; PG8_LDA(At, 1, 0); PG8_STAGE(PG8_SA(0, 1), a2 + hstep, voffA);
            PG8_WAIT_L(8); PG8_BAR; PG8_WAIT_L(0); PG8_MMA(0, 0, At, B0); PG8_BAR; PG8_SCHED;
            PG8_LDB(B1, 1, 1); PG8_STAGE(PG8_SB(1, 0), b3, voffB);
            PG8_BAR; PG8_WAIT_L(0); PG8_MMA(0, 1, At, B1); PG8_BAR;
            PG8_LDA(At, 1, 1); PG8_STAGE(PG8_SA(1, 0), a3, voffA);
            PG8_BAR; PG8_WAIT_L(0); PG8_MMA(1, 0, At, B0); PG8_BAR; PG8_SCHED;
            PG8_STAGE(PG8_SB(1, 1), b3 + hstep, voffB);
            PG8_WAIT_V(6); PG8_BAR; PG8_MMA(1, 1, At, B1); PG8_BAR;
        }
        PG8_STAMP();
        if constexpr (!Epi::AFTER_DRAIN) { E(acc, cur, wr, wc, fr, fq); S.done(cur); }
        PG8_STAMP();
        if (!has_next) break;
#pragma unroll
        for (int a = 0; a < 2; ++a)
#pragma unroll
            for (int b = 0; b < 2; ++b)
#pragma unroll
                for (int m = 0; m < 4; ++m)
#pragma unroll
                    for (int n = 0; n < 2; ++n) acc[a][b][m][n] = (f32x4){0.f, 0.f, 0.f, 0.f};
        cur = nxt; cA = nA; cB = nB; ++ui;
    }
    PG8_WAIT_V(0);
    if (wr == 0) PG8_BAR;
    PG8_BAR;
    if constexpr (Epi::AFTER_DRAIN) { E.fused(acc, cur, wr, wc, fr, fq, lds, wid, lane); S.done(cur); }
    PG8_STAMP();
    if (STAMP && wid == 0) { stamps[lane] = lane < nts ? (((unsigned long long)(unsigned)ts_hi << 32) | (unsigned)ts_lo) : 0ull;
        if (lane == 62) stamps[62] = rt_entry; if (lane == 63) stamps[63] = (unsigned long long)wall_clock64(); }
#undef PG8_STAMP
#undef PG8_SA
#undef PG8_SB
#undef PG8_STAGE
#undef PG8_LDA
#undef PG8_LDB
#undef PG8_MMA
#undef PG8_WAIT_V
#undef PG8_WAIT_L
#undef PG8_BAR
#undef PG8_SCHED
}

}
#define XB_TMO      128
#define XB_XCNT(j)  (256  + 64 * (j))
#define XB_XSUB(j)  (1280 + 64 * (j))
#define XB_XGEN(j)  (2304 + 64 * (j))
#define XB_TOP      3328
#define XB_TOPGEN   3392
#define XCD_BAR_WORDS 3456
#define XB_SPIN_CAP (1u << 18)
#define LAS __attribute__((address_space(3)))

__device__ __forceinline__ unsigned xb_ld(unsigned* p)              { return __hip_atomic_load(p, __ATOMIC_RELAXED, __HIP_MEMORY_SCOPE_AGENT); }
__device__ __forceinline__ unsigned xb_add(unsigned* p, unsigned v) { return __hip_atomic_fetch_add(p, v, __ATOMIC_RELAXED, __HIP_MEMORY_SCOPE_AGENT); }
__device__ __forceinline__ unsigned xb_xcc_id() { return (unsigned)__builtin_amdgcn_s_getreg((3 << 11) | 20) & 0xFu; }
#define XB_SPIN(cond, bar) do { unsigned _sp = 0; while (cond) { __builtin_amdgcn_s_sleep(1); \
    if ((++_sp & 255u) == 0u) { if (xb_ld(&(bar)[XB_TMO])) break; if (_sp > XB_SPIN_CAP) { atomicAdd(&(bar)[XB_TMO], 1u); break; } } } } while (0)

struct XcdBarrier {
    unsigned* bar; unsigned x;
    volatile LAS unsigned* st;
};

__device__ __forceinline__ XcdBarrier xcd_barrier_post(unsigned* bar, volatile LAS unsigned* st) {
    XcdBarrier b; b.bar = bar; b.x = xb_xcc_id(); b.st = st;
    if (threadIdx.x == 0) (void)xb_add(&bar[XB_XCNT(b.x)], 1u);
    return b;
}
__device__ __forceinline__ void xcd_barrier_complete(unsigned* bar, unsigned x, unsigned& nloc, unsigned& nx) {
    const unsigned G = gridDim.x * gridDim.y * gridDim.z;
    unsigned sum, cnt, mine, sp = 0u;
    for (;;) {
        sum = 0u; cnt = 0u; mine = 0u;
#pragma unroll
        for (unsigned j = 0; j < 16; ++j) { const unsigned c = xb_ld(&bar[XB_XCNT(j)]); sum += c; cnt += (c > 0u) ? 1u : 0u; mine = (j == x) ? c : mine; }
        if (sum == G) break;
        __builtin_amdgcn_s_sleep(1);
        if ((++sp & 255u) == 0u) { if (xb_ld(&bar[XB_TMO])) break; if (sp > XB_SPIN_CAP) { atomicAdd(&bar[XB_TMO], 1u); break; } }
    }
    nloc = mine > 0u ? mine : 1u; nx = cnt > 0u ? cnt : 1u;
}

__device__ __forceinline__ void xcd_barrier(const XcdBarrier& b) {
    asm volatile("s_waitcnt vmcnt(0)" ::: "memory");
    __syncthreads();
    if (threadIdx.x == 0) {
        unsigned* bar = b.bar;
        __builtin_amdgcn_s_waitcnt(0);
        unsigned nloc = b.st[0], nx = b.st[1];
        if (nloc == 0u) { xcd_barrier_complete(bar, b.x, nloc, nx); b.st[0] = nloc; b.st[1] = nx; }
        const unsigned old = xb_add(&bar[XB_XSUB(b.x)], 1u);
        const unsigned gen = old / nloc;
        if (old + 1u == (gen + 1u) * nloc) {
            __builtin_amdgcn_fence(__ATOMIC_RELEASE, "agent");
            asm volatile("s_waitcnt vmcnt(0)" ::: "memory");
            const unsigned og = xb_add(&bar[XB_TOP], 1u);
            const unsigned tg = og / nx;
            if (og + 1u == (tg + 1u) * nx) xb_add(&bar[XB_TOPGEN], 1u);
            else XB_SPIN(xb_ld(&bar[XB_TOPGEN]) == tg, bar);
            __builtin_amdgcn_fence(__ATOMIC_ACQUIRE, "agent");
            xb_add(&bar[XB_XGEN(b.x)], 1u);
            asm volatile("s_waitcnt vmcnt(0)" ::: "memory");
        } else {
            XB_SPIN(xb_ld(&bar[XB_XGEN(b.x)]) == gen, bar);
            __builtin_amdgcn_fence(__ATOMIC_ACQUIRE, "agent");
            asm volatile("s_waitcnt vmcnt(0)" ::: "memory");
        }
    }
    __syncthreads();
}


#define LAS __attribute__((address_space(3)))
typedef float f32x4 __attribute__((ext_vector_type(4)));
typedef unsigned u32x4 __attribute__((ext_vector_type(4)));
typedef unsigned u32x2 __attribute__((ext_vector_type(2)));
constexpr int NTHR = 512;
constexpr int LDS_BYTES = 147456;
constexpr int LDS_MISC = 131072;

struct Params {
    const float *x_prompt, *x_sample, *cache_kv, *cache_kr, *state_pool, *state_conv, *state_delta; const int* page_table;
    const float *norm_g, *w_in, *pool_mix, *pool_scale, *q_norm_g, *w_uq, *kv_norm_g, *w_uk, *w_uv, *conv_w, *a_log, *dt_bias, *dn_norm_g, *w_br0, *w_br1, *w_br2, *w_out, *final_norm_g;
    float* out;
    bf16_t *WinT, *WuqT, *WkvT, *WbrT, *WoutT; float2* tab;
    float* xres; bf16_t* xn; bf16_t* H; float* BA; bf16_t *cq, *ckv, *Kr, *Q, *Kn, *V, *qd, *kd, *vd; float* bg; bf16_t *ya, *yb, *yc; float* mf; bf16_t* mb; float* part;
    unsigned* bar;
    int ph_lo, ph_hi, li, pad;
};

constexpr int PH_PRO = 0;
constexpr int PH_L = 8;
constexpr int PH_GIN = 0, PH_TOK = 1, PH_GQ = 2, PH_ATT = 3, PH_FIN = 4, PH_MERGE = 5, PH_OUT = 6, PH_NORM = 7;
#define PHID(l, k) (1 + (l) * PH_L + (k))
constexpr int PH_END = 1 + 2 * PH_L;

struct MEpiH { static constexpr bool PERM = true, AFTER_DRAIN = false; bf16_t* H; float* BA;
    __device__ __forceinline__ void operator()(const f32x4 (&acc)[2][2][4][2], const pg8::Unit& u, int wr, int wc, int fr0, int fq0) const {
        int fr = fr0, fq = fq0; asm volatile("" : "+v"(fr), "+v"(fq));
        const int row0 = u.pm * 256 + wr * 64 + fr;
#pragma unroll
        for (int bj = 0; bj < 2; ++bj) {
            const int wcol = u.pn * 256 + bj * 128 + wc * 32, col0 = wcol + 8 * fq;
            const bool plain = (wcol + 32 <= C_ZPOOL) || (wcol >= C_Q && wcol + 32 <= C_ZMLA) || (wcol >= C_QKV && wcol + 32 <= C_ZDN);
            const int act = ((col0 >= C_ZPOOL && col0 < C_Q) || (col0 >= C_ZMLA && col0 < C_QKV) || (col0 >= C_ZDN && col0 < C_BETA)) ? 1 : (col0 >= C_GATE ? 2 : 0);
            const bool isba = (col0 == C_BETA) || (col0 == C_ALPHA);
#pragma unroll
            for (int ai = 0; ai < 2; ++ai)
#pragma unroll
                for (int m = 0; m < 4; ++m) { const int row = row0 + ai * 128 + m * 16; f32x4 v0 = acc[ai][bj][m][0], v1 = acc[ai][bj][m][1];
                    if (!plain) {
                        if (isba) { float* b = BA + (size_t)row * 16 + (col0 - C_BETA); *(f32x4*)b = v0; *(f32x4*)(b + 4) = v1; }
#pragma unroll
                        for (int e = 0; e < 4; ++e) { const float s0 = sigmoidf_(v0[e]), s1 = sigmoidf_(v1[e]);
                            v0[e] = act == 0 ? v0[e] : (act == 1 ? v0[e] * s0 : s0); v1[e] = act == 0 ? v1[e] : (act == 1 ? v1[e] * s1 : s1); }
                    }
                    u32x4 w; w.x = pg8::cvt_pk_bf16(v0[0], v0[1]); w.y = pg8::cvt_pk_bf16(v0[2], v0[3]); w.z = pg8::cvt_pk_bf16(v1[0], v1[1]); w.w = pg8::cvt_pk_bf16(v1[2], v1[3]);
                    *(u32x4*)(H + (size_t)row * IN_WP + col0) = w; }
        }
    } };
struct MEpiQ { static constexpr bool PERM = true, AFTER_DRAIN = false; bf16_t* Q; const float2* tab;
    __device__ __forceinline__ void operator()(const f32x4 (&acc)[2][2][4][2], const pg8::Unit& u, int wr, int wc, int fr0, int fq0) const {
        int fr = fr0, fq = fq0; asm volatile("" : "+v"(fr), "+v"(fq));
        const int row0 = u.pm * 256 + wr * 64 + fr;
#pragma unroll
        for (int bj = 0; bj < 2; ++bj) {
            const int wcol = u.pn * 256 + bj * 128 + wc * 32, col0 = wcol + 8 * fq;
            const bool rope = (wcol % 96) == 64;
#pragma unroll
            for (int ai = 0; ai < 2; ++ai)
#pragma unroll
                for (int m = 0; m < 4; ++m) { const int row = row0 + ai * 128 + m * 16; f32x4 v0 = acc[ai][bj][m][0], v1 = acc[ai][bj][m][1];
                    if (rope) { const int p = row < TP ? (row & (SEQ - 1)) : SEQ + ((row - TP) & 7); const float2* tp = tab + p * 16 + (fq & 1) * 8; const bool hi = fq >= 2;
#pragma unroll
                        for (int e = 0; e < 4; ++e) { const float o0 = __shfl_xor(v0[e], 32), o1 = __shfl_xor(v1[e], 32); const float2 c0 = tp[e], c1 = tp[4 + e];
                            v0[e] = hi ? (v0[e] * c0.x + o0 * c0.y) : (v0[e] * c0.x - o0 * c0.y); v1[e] = hi ? (v1[e] * c1.x + o1 * c1.y) : (v1[e] * c1.x - o1 * c1.y); } }
                    u32x4 w; w.x = pg8::cvt_pk_bf16(v0[0], v0[1]); w.y = pg8::cvt_pk_bf16(v0[2], v0[3]); w.z = pg8::cvt_pk_bf16(v1[0], v1[1]); w.w = pg8::cvt_pk_bf16(v1[2], v1[3]);
                    *(u32x4*)(Q + (size_t)row * 768 + col0) = w; asm volatile("" ::: "memory"); }
        }
    } };
struct MEpiKV { static constexpr bool PERM = true, AFTER_DRAIN = false; bf16_t* Kn; bf16_t* V;
    __device__ __forceinline__ void operator()(const f32x4 (&acc)[2][2][4][2], const pg8::Unit& u, int wr, int wc, int fr0, int fq0) const {
        int fr = fr0, fq = fq0; asm volatile("" : "+v"(fr), "+v"(fq));
        const int row0 = u.pm * 256 + wr * 64 + fr; bf16_t* base = u.pn < 2 ? Kn : V; const int cb = (u.pn & 1) * 256;
#pragma unroll
        for (int bj = 0; bj < 2; ++bj) { const int col0 = cb + bj * 128 + wc * 32 + 8 * fq;
#pragma unroll
            for (int ai = 0; ai < 2; ++ai)
#pragma unroll
                for (int m = 0; m < 4; ++m) { const int row = row0 + ai * 128 + m * 16; const f32x4 v0 = acc[ai][bj][m][0], v1 = acc[ai][bj][m][1];
                    u32x4 w; w.x = pg8::cvt_pk_bf16(v0[0], v0[1]); w.y = pg8::cvt_pk_bf16(v0[2], v0[3]); w.z = pg8::cvt_pk_bf16(v1[0], v1[1]); w.w = pg8::cvt_pk_bf16(v1[2], v1[3]);
                    *(u32x4*)(base + (size_t)row * 512 + col0) = w; } }
    } };
template <int BR> struct MEpiMerge { static constexpr bool PERM = true, AFTER_DRAIN = false; const bf16_t* H; float* mf; bf16_t* mb;
    __device__ __forceinline__ void operator()(const f32x4 (&acc)[2][2][4][2], const pg8::Unit& u, int wr, int wc, int fr0, int fq0) const {
        int fr = fr0, fq = fq0; asm volatile("" : "+v"(fr), "+v"(fq));
        const int row0 = u.pm * 256 + wr * 64 + fr;
#pragma unroll
        for (int bj = 0; bj < 2; ++bj) { const int col0 = u.pn * 256 + bj * 128 + wc * 32 + 8 * fq;
#pragma unroll
            for (int ai = 0; ai < 2; ++ai)
#pragma unroll
                for (int m = 0; m < 4; ++m) { const int row = row0 + ai * 128 + m * 16; f32x4 v0 = acc[ai][bj][m][0], v1 = acc[ai][bj][m][1];
                    const u32x4 g = *(const u32x4*)(H + (size_t)row * IN_WP + C_GATE + BR * 1024 + col0);
                    v0[0] *= __uint_as_float(g.x << 16); v0[1] *= __uint_as_float(g.x & 0xffff0000u); v0[2] *= __uint_as_float(g.y << 16); v0[3] *= __uint_as_float(g.y & 0xffff0000u);
                    v1[0] *= __uint_as_float(g.z << 16); v1[1] *= __uint_as_float(g.z & 0xffff0000u); v1[2] *= __uint_as_float(g.w << 16); v1[3] *= __uint_as_float(g.w & 0xffff0000u);
                    float* mp = mf + (size_t)row * 1024 + col0;
                    if (BR > 0) { v0 += *(const f32x4*)mp; v1 += *(const f32x4*)(mp + 4); }
                    if (BR < 2) { *(f32x4*)mp = v0; *(f32x4*)(mp + 4) = v1; }
                    else { u32x4 w; w.x = pg8::cvt_pk_bf16(v0[0], v0[1]); w.y = pg8::cvt_pk_bf16(v0[2], v0[3]); w.z = pg8::cvt_pk_bf16(v1[0], v1[1]); w.w = pg8::cvt_pk_bf16(v1[2], v1[3]);
                        *(u32x4*)(mb + (size_t)row * 1024 + col0) = w; } asm volatile("" ::: "memory"); } }
    } };
struct MEpiRes { static constexpr bool PERM = false, AFTER_DRAIN = false; const float* xp; const float* xs; float* xo;
    __device__ __forceinline__ void operator()(const f32x4 (&acc)[2][2][4][2], const pg8::Unit& u, int wr, int wc, int fr0, int fq0) const {
        int fr = fr0, fq = fq0; asm volatile("" : "+v"(fr), "+v"(fq));
        const int row0 = u.pm * 256 + wr * 64 + fr, col0 = u.pn * 256 + wc * 32 + 4 * fq;
#pragma unroll
        for (int ai = 0; ai < 2; ++ai)
#pragma unroll
            for (int m = 0; m < 4; ++m) { const int row = row0 + ai * 128 + m * 16; const float* xr = row < TP ? xp + (size_t)row * 1024 : xs + (size_t)(row - TP) * 1024; float* orow = xo + (size_t)row * 1024;
#pragma unroll
                for (int bj = 0; bj < 2; ++bj)
#pragma unroll
                    for (int n = 0; n < 2; ++n) { const int c = col0 + bj * 128 + n * 16; *(f32x4*)(orow + c) = *(const f32x4*)(xr + c) + acc[ai][bj][m][n]; } }
    } };

__device__ __forceinline__ void ph_tr(const float* __restrict__ src, bf16_t* __restrict__ dst, int K, int N, int Npad, LAS float* tile, int rot) {
    const int tid = threadIdx.x, G = gridDim.x; const int tn = Npad / 64, tk = K / 32, nt = tn * tk;
    const int first = (blockIdx.x + G - (rot % G)) % G;
    for (int t = first; t < nt; t += G) {
        const int n0 = (t % tn) * 64, k0 = (t / tn) * 32;
        { const int tx = tid & 63, ty = tid >> 6;
#pragma unroll
          for (int i = 0; i < 4; ++i) { const int k = ty + 8 * i, n = n0 + tx; tile[k * 65 + tx] = n < N ? src[(size_t)(k0 + k) * N + n] : 0.f; } }
        __syncthreads();
        { const int kx = tid & 31, ny = tid >> 5;
#pragma unroll
          for (int i = 0; i < 4; ++i) { const int n = ny + 16 * i; dst[(size_t)(n0 + n) * K + k0 + kx] = f2bf(tile[kx * 65 + n]); } }
        __syncthreads();
    }
}
__device__ __forceinline__ void ph_rope_tab(float2* tab) {
    for (int idx = blockIdx.x * NTHR + threadIdx.x; idx < (SEQ + DEC_SEQ) * 16; idx += gridDim.x * NTHR) {
        const int p = idx >> 4, i = idx & 15; const int pos = p < SEQ ? p : PAST_LEN + (p - SEQ);
        const float inv = powf(10000.0f, -(float)i / 16.0f); const float ang = (float)pos * inv;
        const double rev = (double)ang * 0.15915494309189533576888; const float f = (float)(rev - floor(rev));
        tab[idx] = make_float2(__builtin_amdgcn_cosf(f), __builtin_amdgcn_sinf(f)); }
}
__device__ __forceinline__ void ph_rmsnorm(const float* __restrict__ xp, const float* __restrict__ xs, const float* __restrict__ g, bf16_t* __restrict__ xn, float* __restrict__ yp, float* __restrict__ ys) {
    int lane = threadIdx.x & 63, wave = threadIdx.x >> 6; asm volatile("" : "+v"(lane), "+v"(wave));
    for (int t = blockIdx.x * 8 + wave; t < TT; t += gridDim.x * 8) {
        const float* x = t < TP ? xp + (size_t)t * 1024 : xs + (size_t)(t - TP) * 1024;
        f32x4 v[4]; float ss = 0.f;
#pragma unroll
        for (int i = 0; i < 4; ++i) { v[i] = *(const f32x4*)(x + i * 256 + lane * 4); ss += v[i][0] * v[i][0] + v[i][1] * v[i][1] + v[i][2] * v[i][2] + v[i][3] * v[i][3]; }
        ss = wave_sum(ss); const float r = rsqrtf(ss * (1.0f / 1024.0f) + EPS);
#pragma unroll
        for (int i = 0; i < 4; ++i) { const int c = i * 256 + lane * 4; const f32x4 gg = *(const f32x4*)(g + c); const f32x4 o = v[i] * r * gg;
            if (xn) { u32x2 w; w.x = pg8::cvt_pk_bf16(o[0], o[1]); w.y = pg8::cvt_pk_bf16(o[2], o[3]); *(u32x2*)(xn + (size_t)t * 1024 + c) = w; }
            else { float* y = t < TP ? yp + (size_t)t * 1024 : ys + (size_t)(t - TP) * 1024; *(f32x4*)(y + c) = o; } }
    }
}

__device__ __forceinline__ void ph_tok(const Params& p, int l, LAS unsigned char* lds) {
    int lane = threadIdx.x & 63, wave = threadIdx.x >> 6; asm volatile("" : "+v"(lane), "+v"(wave));
    const bf16_t* __restrict__ H = p.H; float* __restrict__ out = p.out;
    const float* qg = p.q_norm_g + l * 384; const float* kvg = p.kv_norm_g + l * 256; const float* conv_w = p.conv_w + (size_t)l * 4 * 1536;
    LAS float* dl = (LAS float*)(lds + wave * 2048);
    for (int t = blockIdx.x * 8 + wave; t < TT; t += gridDim.x * 8) {
        const bf16_t* h = H + (size_t)t * IN_WP;
        int i_seq, row0, pidx; const bool smp = t >= TP; const int ts = t - TP;
        if (!smp) { i_seq = t & (SEQ - 1); row0 = t - i_seq; pidx = i_seq; } else { i_seq = ts & 7; row0 = t - i_seq; pidx = SEQ + i_seq; }
        { float q[6]; float ss = 0.f;
#pragma unroll
          for (int i = 0; i < 6; ++i) { q[i] = bf2f(h[C_Q + lane + 64 * i]); ss += q[i] * q[i]; }
          ss = wave_sum(ss); float r = rsqrtf(ss * (1.0f / 384.0f) + EPS);
#pragma unroll
          for (int i = 0; i < 6; ++i) p.cq[(size_t)t * 384 + lane + 64 * i] = f2bf(q[i] * r * qg[lane + 64 * i]);
          float kv[4]; ss = 0.f;
#pragma unroll
          for (int i = 0; i < 4; ++i) { kv[i] = bf2f(h[C_KV + lane + 64 * i]); ss += kv[i] * kv[i]; }
          ss = wave_sum(ss); r = rsqrtf(ss * (1.0f / 256.0f) + EPS);
          float* okv; float* okr;
          if (!smp) { okv = out + O_PKV + ((size_t)l * TP + t) * 256; okr = out + O_PKR + ((size_t)l * TP + t) * 32; }
          else { okv = out + O_SKV + ((size_t)l * TS + ts) * 256; okr = out + O_SKR + ((size_t)l * TS + ts) * 32; }
#pragma unroll
          for (int i = 0; i < 4; ++i) { const float o = kv[i] * r * kvg[lane + 64 * i]; okv[lane + 64 * i] = o; p.ckv[(size_t)t * 256 + lane + 64 * i] = f2bf(o); }
          if (lane < 16) { const float x1 = bf2f(h[C_KR + lane]), x2 = bf2f(h[C_KR + 16 + lane]); const float2 cs = p.tab[pidx * 16 + lane];
              const float o1 = x1 * cs.x - x2 * cs.y, o2 = x2 * cs.x + x1 * cs.y;
              okr[lane] = o1; okr[16 + lane] = o2; p.Kr[(size_t)t * 32 + lane] = f2bf(o1); p.Kr[(size_t)t * 32 + 16 + lane] = f2bf(o2); } }
        { const float* sc = smp ? p.state_conv + ((size_t)l * DEC_BATCH + (ts >> 3)) * 3 * 1536 : nullptr;
#pragma unroll 4
          for (int i = 0; i < 24; ++i) { const int c = lane + 64 * i; float y = 0.f;
#pragma unroll
              for (int j = 0; j < 4; ++j) { const int u = i_seq - 3 + j; float xv;
                  if (u >= 0) xv = bf2f(H[(size_t)(row0 + u) * IN_WP + C_QKV + c]); else xv = sc ? sc[(size_t)(u + 3) * 1536 + c] : 0.f;
                  y += xv * conv_w[j * 1536 + c]; }
              float v = siluf_(y);
              if (i < 16) { const float ss = wave_sum(v * v); v *= rsqrtf(ss + EPS); if (i < 8) v *= 0.125f; }
              const bf16_t o = f2bf(v);
              if (i < 8) p.qd[(size_t)t * 512 + c] = o; else if (i < 16) p.kd[(size_t)t * 512 + (c - 512)] = o; else p.vd[(size_t)t * 512 + (c - 1024)] = o;
              if (!smp) { if (i_seq >= SEQ - 3) out[O_PCONV + (((size_t)l * 8 + (t >> 11)) * 3 + (i_seq - (SEQ - 3))) * 1536 + c] = bf2f(h[C_QKV + c]); }
              else { if (i_seq >= DEC_SEQ - 3) out[O_SCONV + (((size_t)l * DEC_BATCH + (ts >> 3)) * 3 + (i_seq - (DEC_SEQ - 3))) * 1536 + c] = bf2f(h[C_QKV + c]); } }
          if (lane < 8) { const float b = sigmoidf_(p.BA[(size_t)t * 16 + lane]); const float x = p.BA[(size_t)t * 16 + 8 + lane] + p.dt_bias[l * 8 + lane];
              const float sp = x > 20.f ? x : log1pf(expf(x)); const float g = -expf(p.a_log[l * 8 + lane]) * sp;
              p.bg[(size_t)t * 16 + lane] = b; p.bg[(size_t)t * 16 + 8 + lane] = g; } }
        { const float* sp = smp ? p.state_pool + ((size_t)l * DEC_BATCH + (ts >> 3)) * 15 * 512 : nullptr;
          float* so = smp ? out + O_SPOOL + ((size_t)l * DEC_BATCH + (ts >> 3)) * 15 * 512 : nullptr;
#pragma unroll
          for (int j = 0; j < 8; ++j) { const int ch = lane + 64 * j, g = j >> 1, w = 2 << g; float sum = 0.f;
              for (int k = 0; k < w; ++k) { const int u = i_seq - k; float xv;
                  if (u >= 0) xv = bf2f(H[(size_t)(row0 + u) * IN_WP + C_POOL + ch]); else xv = sp ? sp[(size_t)(15 + u) * 512 + ch] : 0.f;
                  sum += xv; }
              const float cur = bf2f(h[C_POOL + ch]); const float cnt = !smp ? (float)min(i_seq + 1, w) : (float)w;
              dl[ch] = sum / cnt - cur;
              if (!smp) { if (i_seq >= SEQ - 15) out[O_PPOOL + (((size_t)l * 8 + (t >> 11)) * 15 + (i_seq - (SEQ - 15))) * 512 + ch] = cur; }
              else { so[(size_t)(7 + i_seq) * 512 + ch] = cur; if (i_seq < 7) so[(size_t)i_seq * 512 + ch] = sp[(size_t)(8 + i_seq) * 512 + ch]; } }
          asm volatile("s_waitcnt lgkmcnt(0)" ::: "memory");
#pragma unroll
          for (int j = 0; j < 8; ++j) { const int ch = lane + 64 * j, g = j >> 1, c = ch & 127; const float* m = p.pool_mix + ((size_t)l * 4 + g) * 128 * 128; float y = 0.f;
              for (int k = 0; k < 128; ++k) y += dl[g * 128 + k] * m[k * 128 + c];
              y *= p.pool_scale[l * 512 + ch]; y *= bf2f(h[C_ZPOOL + ch]); p.ya[(size_t)t * 512 + ch] = f2bf(y); }
          asm volatile("s_waitcnt lgkmcnt(0)" ::: "memory"); }
    }
}

__device__ __forceinline__ void ph_attn_s(const Params& p, int l, LAS unsigned char* lds) {
    int tid = threadIdx.x; asm volatile("" : "+v"(tid));
    const int r = tid & 63, cq = tid >> 6;
    LAS bf16_t* Ks = (LAS bf16_t*)lds;
    LAS float* Ss = (LAS float*)(lds + 18944);
    LAS bf16_t* Qs = (LAS bf16_t*)(lds + 18944 + 8448);
    const float* w_uk = p.w_uk + (size_t)l * 256 * 512;
    for (int u = blockIdx.x; u < DEC_BATCH * SA_CH; u += gridDim.x) {
        const int s = u / SA_CH, ch = u % SA_CH;
        __syncthreads();
        { const int c = tid & 255, hh = tid >> 8;
          for (int h = hh * 4; h < hh * 4 + 4; ++h) { float acc[8];
#pragma unroll
              for (int i = 0; i < 8; ++i) acc[i] = 0.f;
              const float* wr_ = w_uk + (size_t)c * 512 + h * 64;
              for (int d = 0; d < 64; d += 4) { const f32x4 wv = *(const f32x4*)(wr_ + d);
#pragma unroll
                  for (int i = 0; i < 8; ++i) { const bf16_t* q = p.Q + (size_t)(TP + s * 8 + i) * 768 + h * 96 + d;
                      acc[i] += bf2f(q[0]) * wv[0] + bf2f(q[1]) * wv[1] + bf2f(q[2]) * wv[2] + bf2f(q[3]) * wv[3]; } }
#pragma unroll
              for (int i = 0; i < 8; ++i) Qs[(i * 8 + h) * 290 + c] = f2bf(acc[i]); }
          for (int e = tid; e < 64 * 32; e += NTHR) { const int rr = e >> 5, j = e & 31; Qs[rr * 290 + 256 + j] = p.Q[(size_t)(TP + s * 8 + (rr >> 3)) * 768 + (rr & 7) * 96 + 64 + j]; } }
        float o[32];
#pragma unroll
        for (int d = 0; d < 32; ++d) o[d] = 0.f;
        float m = -1e30f, lsum = 0.f; const int i_tok = r >> 3; const int ntile = ch < 32 ? 16 : 1;
        for (int tl = 0; tl < ntile; ++tl) {
            __syncthreads();
            if (ch < 32) { const int j0 = ch * 512 + tl * 32; const int page = p.page_table[s * N_PAGES + (j0 >> 7)]; const int prow = j0 & 127;
                const float* kvp = p.cache_kv + (((size_t)l * N_POOL + page) * PAGE + prow) * 256; const float* krp = p.cache_kr + (((size_t)l * N_POOL + page) * PAGE + prow) * 32;
                for (int i = tid; i < 32 * 256; i += NTHR) Ks[(i >> 8) * 296 + (i & 255)] = f2bf(kvp[i]);
                for (int i = tid; i < 32 * 32; i += NTHR) Ks[(i >> 5) * 296 + 256 + (i & 31)] = f2bf(krp[i]);
            } else {
                for (int i = tid; i < 32 * 256; i += NTHR) { const int k = i >> 8; Ks[k * 296 + (i & 255)] = k < 8 ? p.ckv[((size_t)TP + s * 8 + k) * 256 + (i & 255)] : (bf16_t)0; }
                for (int i = tid; i < 32 * 32; i += NTHR) { const int k = i >> 5; Ks[k * 296 + 256 + (i & 31)] = k < 8 ? p.Kr[((size_t)TP + s * 8 + k) * 32 + (i & 31)] : (bf16_t)0; }
            }
            __syncthreads();
#pragma unroll
            for (int kk = 0; kk < 4; ++kk) { const int k = cq * 4 + kk; float sc = 0.f;
                for (int c = 0; c < 288; ++c) sc += bf2f(Qs[r * 290 + c]) * bf2f(Ks[k * 296 + c]);
                sc *= MLA_SCALE; if (ch == 32 && k > i_tok) sc = -1e30f; Ss[r * 33 + k] = sc; }
            __syncthreads();
            float tm = -1e30f;
            for (int k = 0; k < 32; ++k) tm = fmaxf(tm, Ss[r * 33 + k]);
            const float mn = fmaxf(m, tm), al = __expf(m - mn); m = mn; lsum *= al;
#pragma unroll
            for (int d = 0; d < 32; ++d) o[d] *= al;
            for (int k = 0; k < 32; ++k) { const float sc = Ss[r * 33 + k]; const float pr = sc <= -1e29f ? 0.f : __expf(sc - mn); lsum += pr;
#pragma unroll
                for (int d = 0; d < 32; ++d) o[d] += pr * bf2f(Ks[k * 296 + cq * 32 + d]); }
        }
        float* pp = p.part + (((size_t)s * SA_CH + ch) * 64 + r) * 258;
#pragma unroll
        for (int d = 0; d < 32; ++d) pp[cq * 32 + d] = o[d];
        if (cq == 0) { pp[256] = m; pp[257] = lsum; }
    }
    __syncthreads();
}

__device__ __forceinline__ void wu_attn_p(const Params& p, int b, int h, int qb, int lane) {
    const int i = qb * 64 + lane, t = b * SEQ + i;
    float q[96];
#pragma unroll
    for (int d = 0; d < 96; ++d) q[d] = bf2f(p.Q[(size_t)t * 768 + h * 96 + d]) * MLA_SCALE;
    float o[64];
#pragma unroll
    for (int d = 0; d < 64; ++d) o[d] = 0.f;
    float m = -1e30f, lsum = 0.f; const int jmax = qb * 64 + 63;
    for (int j = 0; j <= jmax; ++j) {
        const size_t tk = (size_t)b * SEQ + j; const bf16_t* kn = p.Kn + tk * 512 + h * 64; const bf16_t* kr = p.Kr + tk * 32; const bf16_t* vv = p.V + tk * 512 + h * 64;
        float s = 0.f;
#pragma unroll
        for (int d = 0; d < 64; ++d) s += q[d] * bf2f(kn[d]);
#pragma unroll
        for (int d = 0; d < 32; ++d) s += q[64 + d] * bf2f(kr[d]);
        if (j <= i) { const float mn = fmaxf(m, s), al = __expf(m - mn), pr = __expf(s - mn); lsum = lsum * al + pr; m = mn;
#pragma unroll
            for (int d = 0; d < 64; ++d) o[d] = o[d] * al + pr * bf2f(vv[d]); }
    }
    const float il = 1.0f / lsum;
#pragma unroll
    for (int d = 0; d < 64; ++d) p.yb[(size_t)t * 512 + h * 64 + d] = f2bf(o[d] * il * bf2f(p.H[(size_t)t * IN_WP + C_ZMLA + h * 64 + d]));
}
__device__ __forceinline__ void wu_delta(const Params& p, int l, int sq, int h, int dv) {
    int row0, L; float* so; float S[64];
    if (sq < 8) { row0 = sq * SEQ; L = SEQ; so = p.out + O_PDELTA + (((size_t)l * 8 + sq) * 8 + h) * 4096;
#pragma unroll
        for (int k = 0; k < 64; ++k) S[k] = 0.f; }
    else { const int s = sq - 8; row0 = TP + s * 8; L = DEC_SEQ; so = p.out + O_SDELTA + (((size_t)l * DEC_BATCH + s) * 8 + h) * 4096;
        const float* s0 = p.state_delta + (((size_t)l * DEC_BATCH + s) * 8 + h) * 4096;
#pragma unroll
        for (int k = 0; k < 64; ++k) S[k] = s0[k * 64 + dv]; }
    const float gn = p.dn_norm_g[l * 64 + dv];
    for (int i = 0; i < L; ++i) {
        const size_t t = (size_t)row0 + i; const u32x4* kp = (const u32x4*)(p.kd + t * 512 + h * 64); const u32x4* qp = (const u32x4*)(p.qd + t * 512 + h * 64);
        const float b = p.bg[t * 16 + h], a = __expf(p.bg[t * 16 + 8 + h]); const float v = bf2f(p.vd[t * 512 + h * 64 + dv]);
        u32x4 kk[8];
#pragma unroll
        for (int c = 0; c < 8; ++c) kk[c] = kp[c];
        float ks = 0.f;
#pragma unroll
        for (int c = 0; c < 8; ++c)
#pragma unroll
            for (int e = 0; e < 4; ++e) { const unsigned w = kk[c][e]; ks += __uint_as_float(w << 16) * S[c * 8 + 2 * e] + __uint_as_float(w & 0xffff0000u) * S[c * 8 + 2 * e + 1]; }
        const float vn = b * (v - a * ks); float o = 0.f;
#pragma unroll
        for (int c = 0; c < 8; ++c) { const u32x4 qv = qp[c];
#pragma unroll
            for (int e = 0; e < 4; ++e) { const unsigned w = kk[c][e], wq = qv[e]; const int k0 = c * 8 + 2 * e;
                S[k0] = a * S[k0] + __uint_as_float(w << 16) * vn; o += __uint_as_float(wq << 16) * S[k0];
                S[k0 + 1] = a * S[k0 + 1] + __uint_as_float(w & 0xffff0000u) * vn; o += __uint_as_float(wq & 0xffff0000u) * S[k0 + 1]; }
            asm volatile("" ::: "memory"); }
        const float ss = wave_sum(o * o); const float y = o * rsqrtf(ss * (1.0f / 64.0f) + EPS) * gn;
        p.yc[t * 512 + h * 64 + dv] = f2bf(y * bf2f(p.H[t * IN_WP + C_ZDN + h * 64 + dv]));
    }
#pragma unroll
    for (int k = 0; k < 64; ++k) so[k * 64 + dv] = S[k];
}
__device__ __forceinline__ void ph_att_waves(const Params& p, int l) {
    int lane = threadIdx.x & 63, wave = threadIdx.x >> 6; asm volatile("" : "+v"(lane), "+v"(wave));
    wave = __builtin_amdgcn_readfirstlane(wave);
    const int G = gridDim.x, NW = G * 8, gw = wave * G + blockIdx.x;
    for (int d = gw; d < 320; d += NW) { const int sq = d < 64 ? (d >> 3) : 8 + ((d - 64) >> 3), h = d & 7; wu_delta(p, l, sq, h, lane); }
    for (int j = NW - 1 - gw; j < 2048; j += NW) { const int qb = 31 - (j >> 6), bh = j & 63; wu_attn_p(p, bh >> 3, bh & 7, qb, lane); }
}
__device__ __forceinline__ void ph_fin(const Params& p, int l, LAS unsigned char* lds) {
    int lane = threadIdx.x & 63, wave = threadIdx.x >> 6; asm volatile("" : "+v"(lane), "+v"(wave));
    LAS float* ol = (LAS float*)(lds + wave * 2048); LAS float* wgt = ol + 256;
    const float* w_uv = p.w_uv + (size_t)l * 256 * 512;
    for (int u = blockIdx.x * 8 + wave; u < TS * 8; u += gridDim.x * 8) {
        const int ts = u >> 3, h = u & 7, s = ts >> 3, r = (ts & 7) * 8 + h; const int d = lane;
        float M = -1e30f;
        for (int ch = 0; ch < SA_CH; ++ch) M = fmaxf(M, p.part[(((size_t)s * SA_CH + ch) * 64 + r) * 258 + 256]);
        float L = 0.f;
        for (int ch = 0; ch < SA_CH; ++ch) { const float* pp = p.part + (((size_t)s * SA_CH + ch) * 64 + r) * 258; const float w = __expf(pp[256] - M); L += pp[257] * w; if (d == 0) wgt[ch] = w; }
        asm volatile("s_waitcnt lgkmcnt(0)" ::: "memory");
        for (int c = d; c < 256; c += 64) { float a = 0.f; for (int ch = 0; ch < SA_CH; ++ch) a += wgt[ch] * p.part[(((size_t)s * SA_CH + ch) * 64 + r) * 258 + c]; ol[c] = a / L; }
        asm volatile("s_waitcnt lgkmcnt(0)" ::: "memory");
        float a = 0.f;
        for (int c = 0; c < 256; ++c) a += ol[c] * w_uv[(size_t)c * 512 + h * 64 + d];
        const int t = TP + ts;
        p.yb[(size_t)t * 512 + h * 64 + d] = f2bf(a * bf2f(p.H[(size_t)t * IN_WP + C_ZMLA + h * 64 + d]));
        asm volatile("s_waitcnt lgkmcnt(0)" ::: "memory");
    }
}

__global__ void __launch_bounds__(NTHR, 2) k_mega(Params p) {
    extern __shared__ __attribute__((aligned(16))) unsigned char lds_raw[];
    LAS unsigned char* lds = (LAS unsigned char*)lds_raw;
    volatile LAS unsigned* misc = (volatile LAS unsigned*)(lds + LDS_MISC);
    for (int u = threadIdx.x; u < 64; u += NTHR) misc[u] = 0u;
    __syncthreads();
    const int lo = p.ph_lo, hi = p.ph_hi;
    XcdBarrier bar; bar.bar = p.bar + p.li * XCD_BAR_WORDS; bar.x = 0; bar.st = nullptr;
    if (hi - lo > 1) bar = xcd_barrier_post(p.bar + p.li * XCD_BAR_WORDS, misc + 8);
#define IN(k) (lo <= (k) && (k) < hi)
#define SEAM(k) do { if (IN(k) && IN((k) + 1)) xcd_barrier(bar); } while (0)

    if (IN(PH_PRO)) {
        LAS float* tile = (LAS float*)lds;
        for (int l = 0; l < 2; ++l) {
            ph_tr(p.w_in + (size_t)l * 1024 * IN_W, p.WinT + (size_t)l * IN_WP * 1024, 1024, IN_W, IN_WP, tile, 0);
            ph_tr(p.w_uq + (size_t)l * 384 * 768, p.WuqT + (size_t)l * 768 * 384, 384, 768, 768, tile, 0);
            ph_tr(p.w_uk + (size_t)l * 256 * 512, p.WkvT + (size_t)l * 1024 * 256, 256, 512, 512, tile, 144);
            ph_tr(p.w_uv + (size_t)l * 256 * 512, p.WkvT + (size_t)l * 1024 * 256 + (size_t)512 * 256, 256, 512, 512, tile, 208);
            ph_tr(p.w_br0 + (size_t)l * 512 * 1024, p.WbrT + ((size_t)l * 3 + 0) * 1024 * 512, 512, 1024, 1024, tile, 0);
            ph_tr(p.w_br1 + (size_t)l * 512 * 1024, p.WbrT + ((size_t)l * 3 + 1) * 1024 * 512, 512, 1024, 1024, tile, 0);
            ph_tr(p.w_br2 + (size_t)l * 512 * 1024, p.WbrT + ((size_t)l * 3 + 2) * 1024 * 512, 512, 1024, 1024, tile, 0);
            ph_tr(p.w_out + (size_t)l * 1024 * 1024, p.WoutT + (size_t)l * 1024 * 1024, 1024, 1024, 1024, tile, 0);
        }
        ph_rope_tab(p.tab);
        ph_rmsnorm(p.x_prompt, p.x_sample, p.norm_g, p.xn, nullptr, nullptr);
    }
    SEAM(PH_PRO);
    for (int l = 0; l < 2; ++l) {
        int G = gridDim.x, bid = blockIdx.x; asm volatile("" : "+s"(G), "+s"(bid));
        const float* xp = l == 0 ? p.x_prompt : p.xres; const float* xs = l == 0 ? p.x_sample : p.xres + (size_t)TP * 1024;
        if (IN(PHID(l, PH_GIN))) {
            pg8::Gemm g{p.xn, p.WinT + (size_t)l * IN_WP * 1024, TT, IN_WP, 1024}; pg8::StaticOrder S; S.init(TT, IN_WP, G, bid);
            MEpiH E{p.H, p.BA}; pg8::gemm_phase<MEpiH, pg8::StaticOrder, false>(lds, g, S, E, nullptr);
        }
        SEAM(PHID(l, PH_GIN));
        if (IN(PHID(l, PH_TOK))) ph_tok(p, l, lds);
        SEAM(PHID(l, PH_TOK));
        if (IN(PHID(l, PH_GQ))) {
            { pg8::Gemm g{p.cq, p.WuqT + (size_t)l * 768 * 384, TT, 768, 384}; pg8::StaticOrder S; S.init(TT, 768, G, bid);
              MEpiQ E{p.Q, p.tab}; pg8::gemm_phase<MEpiQ, pg8::StaticOrder, false>(lds, g, S, E, nullptr); }
        }
        if (IN(PHID(l, PH_GQ))) {
            { pg8::Gemm g{p.ckv, p.WkvT + (size_t)l * 1024 * 256, TP, 1024, 256}; pg8::StaticOrder S; S.init(TP, 1024, G, bid);
              MEpiKV E{p.Kn, p.V}; pg8::gemm_phase<MEpiKV, pg8::StaticOrder, false>(lds, g, S, E, nullptr); }
        }
        SEAM(PHID(l, PH_GQ));
        if (IN(PHID(l, PH_ATT))) { ph_attn_s(p, l, lds); ph_att_waves(p, l); }
        SEAM(PHID(l, PH_ATT));
        if (IN(PHID(l, PH_FIN))) ph_fin(p, l, lds);
        SEAM(PHID(l, PH_FIN));
        if (IN(PHID(l, PH_MERGE))) {
            { pg8::Gemm g{p.ya, p.WbrT + ((size_t)l * 3 + 0) * 1024 * 512, TT, 1024, 512}; pg8::StaticOrder S; S.init(TT, 1024, G, bid);
              MEpiMerge<0> E{p.H, p.mf, p.mb}; pg8::gemm_phase<MEpiMerge<0>, pg8::StaticOrder, false>(lds, g, S, E, nullptr); }
            { pg8::Gemm g{p.yb, p.WbrT + ((size_t)l * 3 + 1) * 1024 * 512, TT, 1024, 512}; pg8::StaticOrder S; S.init(TT, 1024, G, bid);
              MEpiMerge<1> E{p.H, p.mf, p.mb}; pg8::gemm_phase<MEpiMerge<1>, pg8::StaticOrder, false>(lds, g, S, E, nullptr); }
            { pg8::Gemm g{p.yc, p.WbrT + ((size_t)l * 3 + 2) * 1024 * 512, TT, 1024, 512}; pg8::StaticOrder S; S.init(TT, 1024, G, bid);
              MEpiMerge<2> E{p.H, p.mf, p.mb}; pg8::gemm_phase<MEpiMerge<2>, pg8::StaticOrder, false>(lds, g, S, E, nullptr); }
        }
        SEAM(PHID(l, PH_MERGE));
        if (IN(PHID(l, PH_OUT))) {
            pg8::Gemm g{p.mb, p.WoutT + (size_t)l * 1024 * 1024, TT, 1024, 1024}; pg8::StaticOrder S; S.init(TT, 1024, G, bid);
            MEpiRes E{xp, xs, p.xres}; pg8::gemm_phase<MEpiRes, pg8::StaticOrder, false>(lds, g, S, E, nullptr);
        }
        SEAM(PHID(l, PH_OUT));
        if (IN(PHID(l, PH_NORM))) {
            if (l == 0) ph_rmsnorm(p.xres, p.xres + (size_t)TP * 1024, p.norm_g + 1024, p.xn, nullptr, nullptr);
            else ph_rmsnorm(p.xres, p.xres + (size_t)TP * 1024, p.final_norm_g, nullptr, p.out + O_YP, p.out + O_YS);
        }
        SEAM(PHID(l, PH_NORM));
    }
#undef IN
#undef SEAM
}

static inline size_t al256(size_t x) { return (x + 255) & ~(size_t)255; }
extern "C" void kernel_launch(void* const* d_in, const int* in_sizes, int n_in, void* d_out, int out_size, void* d_ws, size_t ws_size, hipStream_t stream) {
    static int grid = 0;
    if (grid == 0) {
        int dev = 0, cus = 0; (void)hipGetDevice(&dev); (void)hipDeviceGetAttribute(&cus, hipDeviceAttributeMultiprocessorCount, dev);
        (void)hipFuncSetAttribute((const void*)k_mega, hipFuncAttributeMaxDynamicSharedMemorySize, LDS_BYTES);
        int per_cu = 0; (void)hipOccupancyMaxActiveBlocksPerMultiprocessor(&per_cu, (const void*)k_mega, NTHR, LDS_BYTES); (void)hipGetLastError();
        grid = cus > 0 ? cus : 256;
    }
    Params p{};
    p.x_prompt = (const float*)d_in[0]; p.x_sample = (const float*)d_in[1]; p.cache_kv = (const float*)d_in[2]; p.cache_kr = (const float*)d_in[3];
    p.state_pool = (const float*)d_in[4]; p.state_conv = (const float*)d_in[5]; p.state_delta = (const float*)d_in[6]; p.page_table = (const int*)d_in[7];
    p.norm_g = (const float*)d_in[8]; p.w_in = (const float*)d_in[9]; p.pool_mix = (const float*)d_in[10]; p.pool_scale = (const float*)d_in[11];
    p.q_norm_g = (const float*)d_in[12]; p.w_uq = (const float*)d_in[13]; p.kv_norm_g = (const float*)d_in[14]; p.w_uk = (const float*)d_in[15];
    p.w_uv = (const float*)d_in[16]; p.conv_w = (const float*)d_in[17]; p.a_log = (const float*)d_in[18]; p.dt_bias = (const float*)d_in[19];
    p.dn_norm_g = (const float*)d_in[20]; p.w_br0 = (const float*)d_in[21]; p.w_br1 = (const float*)d_in[22]; p.w_br2 = (const float*)d_in[23];
    p.w_out = (const float*)d_in[24]; p.final_norm_g = (const float*)d_in[25];
    p.out = (float*)d_out;
    char* w = (char*)d_ws; size_t off = 0;
    auto take = [&](size_t bytes) { char* q = w + off; off += al256(bytes); return q; };
    const size_t BAR_BYTES = (size_t)16 * XCD_BAR_WORDS * 4;
    p.bar = (unsigned*)take(BAR_BYTES);
    p.WinT = (bf16_t*)take((size_t)2 * IN_WP * 1024 * 2);
    p.WuqT = (bf16_t*)take((size_t)2 * 768 * 384 * 2);
    p.WkvT = (bf16_t*)take((size_t)2 * 1024 * 256 * 2);
    p.WbrT = (bf16_t*)take((size_t)2 * 3 * 1024 * 512 * 2);
    p.WoutT = (bf16_t*)take((size_t)2 * 1024 * 1024 * 2);
    p.tab = (float2*)take((size_t)(SEQ + DEC_SEQ) * 16 * 8);
    p.xres = (float*)take((size_t)TT * 1024 * 4);
    p.xn = (bf16_t*)take((size_t)TT * 1024 * 2);
    p.H = (bf16_t*)take((size_t)TT * IN_WP * 2);
    p.BA = (float*)take((size_t)TT * 16 * 4);
    p.cq = (bf16_t*)take((size_t)TT * 384 * 2);
    p.ckv = (bf16_t*)take((size_t)TT * 256 * 2);
    p.Kr = (bf16_t*)take((size_t)TT * 32 * 2);
    p.Q = (bf16_t*)take((size_t)TT * 768 * 2);
    bf16_t* Qlat = (bf16_t*)take((size_t)TS * 8 * 288 * 2);
    p.Kn = (bf16_t*)take((size_t)TP * 512 * 2);
    p.V = (bf16_t*)take((size_t)TP * 512 * 2);
    p.qd = (bf16_t*)take((size_t)TT * 512 * 2);
    p.kd = (bf16_t*)take((size_t)TT * 512 * 2);
    p.vd = (bf16_t*)take((size_t)TT * 512 * 2);
    p.bg = (float*)take((size_t)TT * 16 * 4);
    p.ya = (bf16_t*)take((size_t)TT * 512 * 2);
    p.yb = (bf16_t*)take((size_t)TT * 512 * 2);
    p.yc = (bf16_t*)take((size_t)TT * 512 * 2);
    p.mf = (float*)take((size_t)TT * 1024 * 4);
    p.mb = (bf16_t*)take((size_t)TT * 1024 * 2);
    p.part = (float*)take((size_t)DEC_BATCH * SA_CH * 64 * 258 * 4);

    (void)hipMemsetAsync(p.bar, 0, BAR_BYTES, stream);
    p.ph_lo = 0; p.ph_hi = PH_END; p.li = 0; p.pad = 0;
    hipLaunchKernelGGL(k_mega, dim3(grid), dim3(NTHR), LDS_BYTES, stream, p);
}
```

```cpp
#include <hip/hip_runtime.h>
#include <stdint.h>

typedef unsigned short bf16_t;

#define D_MODEL 1024
#define TP 16384
#define TS 256
#define TT (TP + TS)
#define SEQ 2048
#define DEC_SEQ 8
#define DEC_BATCH 32
#define PAST_LEN 16384
#define PAGE 128
#define N_PAGES 128
#define N_POOL 5120
#define IN_W 7344
#define IN_WP 7424
#define C_POOL 0
#define C_ZPOOL 512
#define C_Q 1024
#define C_KV 1408
#define C_KR 1664
#define C_ZMLA 1696
#define C_QKV 2208
#define C_ZDN 3744
#define C_BETA 4256
#define C_ALPHA 4264
#define C_GATE 4272
#define EPS 1e-6f
#define MLA_SCALE 0.10206207261596577f

#define O_YP 0
#define O_YS (O_YP + 16777216)
#define O_PKV (O_YS + 262144)
#define O_PKR (O_PKV + 8388608)
#define O_PPOOL (O_PKR + 1048576)
#define O_PCONV (O_PPOOL + 122880)
#define O_PDELTA (O_PCONV + 73728)
#define O_SKV (O_PDELTA + 524288)
#define O_SKR (O_SKV + 131072)
#define O_SPOOL (O_SKR + 16384)
#define O_SCONV (O_SPOOL + 491520)
#define O_SDELTA (O_SCONV + 294912)
#define O_END (O_SDELTA + 2097152)

__device__ __forceinline__ float bf2f(bf16_t b) { return __uint_as_float(((unsigned)b) << 16); }
__device__ __forceinline__ bf16_t f2bf(float f) { unsigned u = __float_as_uint(f); u += 0x7FFFu + ((u >> 16) & 1u); return (bf16_t)(u >> 16); }
__device__ __forceinline__ float sigmoidf_(float v) { return 1.0f / (1.0f + __expf(-v)); }
__device__ __forceinline__ float siluf_(float v) { return v / (1.0f + __expf(-v)); }
__device__ __forceinline__ float wave_sum(float v) {
#pragma unroll
    for (int o = 32; o >= 1; o >>= 1) v += __shfl_xor(v, o);
    return v;
}

__global__ void k_tr(const float* __restrict__ src, bf16_t* __restrict__ dst, int K, int N, int Npad, int pad_) {
    __shared__ float tile[32][33];
    const int n0 = blockIdx.x * 32, k0 = blockIdx.y * 32, tx = threadIdx.x & 31, ty = threadIdx.x >> 5;
    for (int i = ty; i < 32; i += 8) { const int k = k0 + i, n = n0 + tx; tile[i][tx] = (n < N) ? src[(size_t)k * N + n] : 0.f; }
    __syncthreads();
    for (int i = ty; i < 32; i += 8) { const int n = n0 + i, k = k0 + tx; if (n < Npad) dst[(size_t)n * K + k] = f2bf(tile[tx][i]); }
}
__global__ void k_rope_tab(float2* tab) {
    const int idx = blockIdx.x * blockDim.x + threadIdx.x; if (idx >= (SEQ + DEC_SEQ) * 16) return;
    const int p = idx >> 4, i = idx & 15; const int pos = p < SEQ ? p : PAST_LEN + (p - SEQ);
    const float inv = powf(10000.0f, -(float)i / 16.0f);
    const float ang = (float)pos * inv;
    const double rev = (double)ang * 0.15915494309189533576888; const double fr = rev - floor(rev);
    const float f = (float)fr;
    tab[idx] = make_float2(__builtin_amdgcn_cosf(f), __builtin_amdgcn_sinf(f));
}

__global__ void k_rmsnorm(const float* __restrict__ xp, const float* __restrict__ xs, const float* __restrict__ g, bf16_t* __restrict__ xn, float* __restrict__ yp, float* __restrict__ ys) {
    const int t = blockIdx.x; const float* x = t < TP ? xp + (size_t)t * D_MODEL : xs + (size_t)(t - TP) * D_MODEL;
    __shared__ float red[4];
    float v[4]; float ss = 0.f;
#pragma unroll
    for (int i = 0; i < 4; ++i) { v[i] = x[threadIdx.x + 256 * i]; ss += v[i] * v[i]; }
    ss = wave_sum(ss); if ((threadIdx.x & 63) == 0) red[threadIdx.x >> 6] = ss; __syncthreads();
    const float tot = red[0] + red[1] + red[2] + red[3]; const float r = rsqrtf(tot * (1.0f / D_MODEL) + EPS);
#pragma unroll
    for (int i = 0; i < 4; ++i) { const int c = threadIdx.x + 256 * i; const float o = v[i] * r * g[c];
        if (xn) xn[(size_t)t * D_MODEL + c] = f2bf(o);
        else { if (t < TP) yp[(size_t)t * D_MODEL + c] = o; else ys[(size_t)(t - TP) * D_MODEL + c] = o; } }
}

template <class Epi> __global__ void k_gemm(const bf16_t* __restrict__ A, const bf16_t* __restrict__ Bt, int lda, int ldb, int M, int N, int K, int pad_, Epi epi) {
    __shared__ float As[16][68], Bs[16][68];
    const int tm = blockIdx.y * 64, tn = blockIdx.x * 64, tx = threadIdx.x & 15, ty = threadIdx.x >> 4;
    float acc[4][4];
#pragma unroll
    for (int i = 0; i < 4; ++i)
#pragma unroll
        for (int j = 0; j < 4; ++j) acc[i][j] = 0.f;
    for (int k0 = 0; k0 < K; k0 += 16) {
        for (int i = threadIdx.x; i < 1024; i += 256) { const int r = i >> 4, c = i & 15;
            As[c][r] = (tm + r < M) ? bf2f(A[(size_t)(tm + r) * lda + k0 + c]) : 0.f;
            Bs[c][r] = (tn + r < N) ? bf2f(Bt[(size_t)(tn + r) * ldb + k0 + c]) : 0.f; }
        __syncthreads();
#pragma unroll
        for (int kk = 0; kk < 16; ++kk) { float a[4], b[4];
#pragma unroll
            for (int i = 0; i < 4; ++i) { a[i] = As[kk][ty * 4 + i]; b[i] = Bs[kk][tx * 4 + i]; }
#pragma unroll
            for (int i = 0; i < 4; ++i)
#pragma unroll
                for (int j = 0; j < 4; ++j) acc[i][j] += a[i] * b[j]; }
        __syncthreads();
    }
#pragma unroll
    for (int i = 0; i < 4; ++i)
#pragma unroll
        for (int j = 0; j < 4; ++j) { const int m = tm + ty * 4 + i, n = tn + tx * 4 + j; if (m < M && n < N) epi(m, n, acc[i][j]); }
}
struct EpiH { bf16_t* H; float* BA;
    __device__ void operator()(int t, int n, float v) const {
        if (n >= C_BETA && n < C_GATE) BA[(size_t)t * 16 + (n - C_BETA)] = v;
        float o = v;
        if ((n >= C_ZPOOL && n < C_Q) || (n >= C_ZMLA && n < C_QKV) || (n >= C_ZDN && n < C_BETA)) o = siluf_(v);
        else if (n >= C_GATE) o = sigmoidf_(v);
        H[(size_t)t * IN_WP + n] = f2bf(o); } };
struct EpiF32 { float* C; int ldc; int pad_; __device__ void operator()(int t, int n, float v) const { C[(size_t)t * ldc + n] = v; } };
struct EpiKV { bf16_t* Kn; bf16_t* V; __device__ void operator()(int t, int n, float v) const { if (n < 512) Kn[(size_t)t * 512 + n] = f2bf(v); else V[(size_t)t * 512 + (n - 512)] = f2bf(v); } };
struct EpiMerge { const bf16_t* H; float* mf; bf16_t* mb; int br; int pad_;
    __device__ void operator()(int t, int n, float v) const { const float g = bf2f(H[(size_t)t * IN_WP + C_GATE + br * 1024 + n]); float o = g * v; const size_t i = (size_t)t * 1024 + n;
        if (br > 0) o += mf[i]; mf[i] = o; if (br == 2) mb[i] = f2bf(o); } };
struct EpiRes { const float* xp; const float* xs; float* xo;
    __device__ void operator()(int t, int n, float v) const { const float x = t < TP ? xp[(size_t)t * 1024 + n] : xs[(size_t)(t - TP) * 1024 + n]; xo[(size_t)t * 1024 + n] = x + v; } };

__global__ void k_tok_a(const bf16_t* __restrict__ H, const float* __restrict__ qg, const float* __restrict__ kvg, const float2* __restrict__ tab,
                        bf16_t* __restrict__ cq, bf16_t* __restrict__ ckv, bf16_t* __restrict__ Kr, float* __restrict__ out, int layer, int pad_) {
    const int t = blockIdx.x, lane = threadIdx.x; const bf16_t* h = H + (size_t)t * IN_WP;
    float q[6]; float ss = 0.f;
#pragma unroll
    for (int i = 0; i < 6; ++i) { q[i] = bf2f(h[C_Q + lane + 64 * i]); ss += q[i] * q[i]; }
    ss = wave_sum(ss); float r = rsqrtf(ss * (1.0f / 384.0f) + EPS);
#pragma unroll
    for (int i = 0; i < 6; ++i) cq[(size_t)t * 384 + lane + 64 * i] = f2bf(q[i] * r * qg[lane + 64 * i]);
    float kv[4]; ss = 0.f;
#pragma unroll
    for (int i = 0; i < 4; ++i) { kv[i] = bf2f(h[C_KV + lane + 64 * i]); ss += kv[i] * kv[i]; }
    ss = wave_sum(ss); r = rsqrtf(ss * (1.0f / 256.0f) + EPS);
    float* okv; float* okr; int p;
    if (t < TP) { okv = out + O_PKV + ((size_t)layer * TP + t) * 256; okr = out + O_PKR + ((size_t)layer * TP + t) * 32; p = t & (SEQ - 1); }
    else { const int ts = t - TP; okv = out + O_SKV + ((size_t)layer * TS + ts) * 256; okr = out + O_SKR + ((size_t)layer * TS + ts) * 32; p = SEQ + (ts & 7); }
#pragma unroll
    for (int i = 0; i < 4; ++i) { const float o = kv[i] * r * kvg[lane + 64 * i]; okv[lane + 64 * i] = o; ckv[(size_t)t * 256 + lane + 64 * i] = f2bf(o); }
    if (lane < 16) { const float x1 = bf2f(h[C_KR + lane]), x2 = bf2f(h[C_KR + 16 + lane]); const float2 cs = tab[p * 16 + lane];
        const float o1 = x1 * cs.x - x2 * cs.y, o2 = x2 * cs.x + x1 * cs.y;
        okr[lane] = o1; okr[16 + lane] = o2; Kr[(size_t)t * 32 + lane] = f2bf(o1); Kr[(size_t)t * 32 + 16 + lane] = f2bf(o2); }
}

__global__ void k_tok_conv(const bf16_t* __restrict__ H, const float* __restrict__ BA, const float* __restrict__ conv_w, const float* __restrict__ state_conv,
                           const float* __restrict__ a_log, const float* __restrict__ dt_bias, bf16_t* __restrict__ qd, bf16_t* __restrict__ kd, bf16_t* __restrict__ vd,
                           float* __restrict__ bg, float* __restrict__ out, int layer, int pad_) {
    const int t = blockIdx.x, tid = threadIdx.x;
    int i_seq, row0; const float* sc = nullptr;
    if (t < TP) { i_seq = t & (SEQ - 1); row0 = t - i_seq; }
    else { const int ts = t - TP; i_seq = ts & 7; row0 = t - i_seq; sc = state_conv + ((size_t)layer * DEC_BATCH + (ts >> 3)) * 3 * 1536; }
#pragma unroll
    for (int i = 0; i < 6; ++i) {
        const int c = tid + 256 * i; float y = 0.f;
#pragma unroll
        for (int j = 0; j < 4; ++j) { const int u = i_seq - 3 + j; float xv;
            if (u >= 0) xv = bf2f(H[(size_t)(row0 + u) * IN_WP + C_QKV + c]); else xv = sc ? sc[(size_t)(u + 3) * 1536 + c] : 0.f;
            y += xv * conv_w[j * 1536 + c]; }
        float v = siluf_(y);
        if (i < 4) { const float ss = wave_sum(v * v); v *= rsqrtf(ss + EPS); if (i < 2) v *= 0.125f; }
        const bf16_t o = f2bf(v);
        if (i < 2) qd[(size_t)t * 512 + c] = o; else if (i < 4) kd[(size_t)t * 512 + (c - 512)] = o; else vd[(size_t)t * 512 + (c - 1024)] = o;
        if (t < TP) { if (i_seq >= SEQ - 3) out[O_PCONV + (((size_t)layer * 8 + (t >> 11)) * 3 + (i_seq - (SEQ - 3))) * 1536 + c] = bf2f(H[(size_t)t * IN_WP + C_QKV + c]); }
        else { if (i_seq >= DEC_SEQ - 3) out[O_SCONV + (((size_t)layer * DEC_BATCH + ((t - TP) >> 3)) * 3 + (i_seq - (DEC_SEQ - 3))) * 1536 + c] = bf2f(H[(size_t)t * IN_WP + C_QKV + c]); }
    }
    if (tid < 8) { const float b = sigmoidf_(BA[(size_t)t * 16 + tid]); const float x = BA[(size_t)t * 16 + 8 + tid] + dt_bias[tid];
        const float sp = x > 20.f ? x : log1pf(expf(x)); const float g = -expf(a_log[tid]) * sp;
        bg[(size_t)t * 16 + tid] = b; bg[(size_t)t * 16 + 8 + tid] = g; }
}

__global__ void k_pool(const bf16_t* __restrict__ H, const float* __restrict__ state_pool, const float* __restrict__ mix, const float* __restrict__ scale,
                       bf16_t* __restrict__ ya, float* __restrict__ out, int layer, int pad_) {
    const int t = blockIdx.x, g = blockIdx.y, c = threadIdx.x, ch = g * 128 + c; const int w = 2 << g;
    __shared__ float d[128];
    int i_seq, row0; const float* sp = nullptr;
    if (t < TP) { i_seq = t & (SEQ - 1); row0 = t - i_seq; }
    else { const int ts = t - TP; i_seq = ts & 7; row0 = t - i_seq; sp = state_pool + ((size_t)layer * DEC_BATCH + (ts >> 3)) * 15 * 512; }
    float sum = 0.f;
    for (int k = 0; k < w; ++k) { const int u = i_seq - k; float xv;
        if (u >= 0) xv = bf2f(H[(size_t)(row0 + u) * IN_WP + C_POOL + ch]); else xv = sp ? sp[(size_t)(15 + u) * 512 + ch] : 0.f;
        sum += xv; }
    const float cur = bf2f(H[(size_t)t * IN_WP + C_POOL + ch]);
    const float cnt = t < TP ? (float)min(i_seq + 1, w) : (float)w;
    d[c] = sum / cnt - cur;
    __syncthreads();
    float y = 0.f; const float* m = mix + ((size_t)layer * 4 + g) * 128 * 128;
    for (int k = 0; k < 128; ++k) y += d[k] * m[k * 128 + c];
    y *= scale[layer * 512 + ch];
    y *= bf2f(H[(size_t)t * IN_WP + C_ZPOOL + ch]);
    ya[(size_t)t * 512 + ch] = f2bf(y);
    if (t < TP) { if (i_seq >= SEQ - 15) out[O_PPOOL + (((size_t)layer * 8 + (t >> 11)) * 15 + (i_seq - (SEQ - 15))) * 512 + ch] = cur; }
    else { const int s = (t - TP) >> 3; float* o = out + O_SPOOL + ((size_t)layer * DEC_BATCH + s) * 15 * 512;
        o[(size_t)(7 + i_seq) * 512 + ch] = cur;
        if (i_seq < 7) o[(size_t)i_seq * 512 + ch] = sp[(size_t)(8 + i_seq) * 512 + ch]; }
}

__global__ void k_qrope(const float* __restrict__ Qf, const float2* __restrict__ tab, bf16_t* __restrict__ Q) {
    const int t = blockIdx.x, tid = threadIdx.x;
    const int h = tid >> 5, j = tid & 31; const float* q = Qf + (size_t)t * 768 + h * 96; bf16_t* o = Q + (size_t)t * 768 + h * 96;
    o[j] = f2bf(q[j]); o[32 + j] = f2bf(q[32 + j]);
    const int p = t < TP ? (t & (SEQ - 1)) : SEQ + ((t - TP) & 7);
    if (j < 16) { const float x1 = q[64 + j], x2 = q[80 + j]; const float2 cs = tab[p * 16 + j]; o[64 + j] = f2bf(x1 * cs.x - x2 * cs.y); o[80 + j] = f2bf(x2 * cs.x + x1 * cs.y); }
}
__global__ void k_qlat(const bf16_t* __restrict__ Q, const float* __restrict__ w_uk, bf16_t* __restrict__ Qlat) {
    const int ts = blockIdx.x, h = blockIdx.y, c = threadIdx.x;
    const bf16_t* q = Q + (size_t)(TP + ts) * 768 + h * 96; float acc = 0.f;
    for (int d = 0; d < 64; ++d) acc += bf2f(q[d]) * w_uk[(size_t)c * 512 + h * 64 + d];
    bf16_t* o = Qlat + ((size_t)ts * 8 + h) * 288; o[c] = f2bf(acc); if (c < 32) o[256 + c] = q[64 + c];
}

__global__ void __launch_bounds__(64) k_attn_p(const bf16_t* __restrict__ Q, const bf16_t* __restrict__ Kn, const bf16_t* __restrict__ Kr, const bf16_t* __restrict__ V,
                                               const bf16_t* __restrict__ H, bf16_t* __restrict__ yb) {
    const int qb = blockIdx.x, h = blockIdx.y, b = blockIdx.z, lane = threadIdx.x; const int i = qb * 64 + lane, t = b * SEQ + i;
    float q[96];
#pragma unroll
    for (int d = 0; d < 96; ++d) q[d] = bf2f(Q[(size_t)t * 768 + h * 96 + d]) * MLA_SCALE;
    float o[64];
#pragma unroll
    for (int d = 0; d < 64; ++d) o[d] = 0.f;
    float m = -1e30f, l = 0.f;
    const int jmax = qb * 64 + 63;
    for (int j = 0; j <= jmax; ++j) {
        const size_t tk = (size_t)b * SEQ + j; const bf16_t* kn = Kn + tk * 512 + h * 64; const bf16_t* kr = Kr + tk * 32; const bf16_t* vv = V + tk * 512 + h * 64;
        float s = 0.f;
#pragma unroll
        for (int d = 0; d < 64; ++d) s += q[d] * bf2f(kn[d]);
#pragma unroll
        for (int d = 0; d < 32; ++d) s += q[64 + d] * bf2f(kr[d]);
        if (j <= i) {
            const float mn = fmaxf(m, s), al = __expf(m - mn), p = __expf(s - mn); l = l * al + p; m = mn;
#pragma unroll
            for (int d = 0; d < 64; ++d) o[d] = o[d] * al + p * bf2f(vv[d]);
        }
    }
    const float il = 1.0f / l;
#pragma unroll
    for (int d = 0; d < 64; ++d) yb[(size_t)t * 512 + h * 64 + d] = f2bf(o[d] * il * bf2f(H[(size_t)t * IN_WP + C_ZMLA + h * 64 + d]));
}

#define SA_CH 33
__global__ void __launch_bounds__(256) k_attn_s(const bf16_t* __restrict__ Qlat, const float* __restrict__ ckv_cache, const float* __restrict__ kr_cache, const int* __restrict__ page_table,
                                                const bf16_t* __restrict__ ckv_new, const bf16_t* __restrict__ kr_new, float* __restrict__ part, int layer, int pad_) {
    const int s = blockIdx.x, ch = blockIdx.y, tid = threadIdx.x, r = tid & 63, cq = tid >> 6;
    __shared__ bf16_t Ks[32][296];
    __shared__ float Ss[64][33];
    __shared__ bf16_t Qs[64][290];
    for (int i = tid; i < 64 * 288; i += 256) { const int rr = i / 288, c = i % 288; Qs[rr][c] = Qlat[((size_t)s * 64 + rr) * 288 + c]; }
    float o[64];
#pragma unroll
    for (int d = 0; d < 64; ++d) o[d] = 0.f;
    float m = -1e30f, l = 0.f;
    const int i_tok = r >> 3;
    const int ntile = ch < 32 ? 16 : 1;
    for (int tl = 0; tl < ntile; ++tl) {
        __syncthreads();
        if (ch < 32) { const int j0 = ch * 512 + tl * 32; const int page = page_table[s * N_PAGES + (j0 >> 7)]; const int prow = j0 & 127;
            const float* kvp = ckv_cache + (((size_t)layer * N_POOL + page) * PAGE + prow) * 256; const float* krp = kr_cache + (((size_t)layer * N_POOL + page) * PAGE + prow) * 32;
            for (int i = tid; i < 32 * 256; i += 256) Ks[i >> 8][i & 255] = f2bf(kvp[i]);
            for (int i = tid; i < 32 * 32; i += 256) Ks[i >> 5][256 + (i & 31)] = f2bf(krp[i]);
        } else {
            for (int i = tid; i < 32 * 256; i += 256) { const int k = i >> 8; Ks[k][i & 255] = k < 8 ? ckv_new[((size_t)TP + s * 8 + k) * 256 + (i & 255)] : (bf16_t)0; }
            for (int i = tid; i < 32 * 32; i += 256) { const int k = i >> 5; Ks[k][256 + (i & 31)] = k < 8 ? kr_new[((size_t)TP + s * 8 + k) * 32 + (i & 31)] : (bf16_t)0; }
        }
        __syncthreads();
#pragma unroll
        for (int kk = 0; kk < 8; ++kk) { const int k = cq * 8 + kk; float sc = 0.f;
            for (int c = 0; c < 288; ++c) sc += bf2f(Qs[r][c]) * bf2f(Ks[k][c]);
            sc *= MLA_SCALE; if (ch == 32 && k > i_tok) sc = -1e30f; Ss[r][k] = sc; }
        __syncthreads();
        float tm = -1e30f;
        for (int k = 0; k < 32; ++k) tm = fmaxf(tm, Ss[r][k]);
        const float mn = fmaxf(m, tm), al = __expf(m - mn); m = mn; l *= al;
#pragma unroll
        for (int d = 0; d < 64; ++d) o[d] *= al;
        for (int k = 0; k < 32; ++k) { const float sc = Ss[r][k]; const float p = sc <= -1e29f ? 0.f : __expf(sc - mn); l += p;
#pragma unroll
            for (int d = 0; d < 64; ++d) o[d] += p * bf2f(Ks[k][cq * 64 + d]); }
    }
    float* pp = part + (((size_t)s * SA_CH + ch) * 64 + r) * 258;
#pragma unroll
    for (int d = 0; d < 64; ++d) pp[cq * 64 + d] = o[d];
    if (cq == 0) { pp[256] = m; pp[257] = l; }
}
__global__ void k_attn_s_fin(const float* __restrict__ part, const float* __restrict__ w_uv, const bf16_t* __restrict__ H, bf16_t* __restrict__ yb) {
    const int ts = blockIdx.x, h = blockIdx.y, d = threadIdx.x; const int s = ts >> 3, r = (ts & 7) * 8 + h;
    __shared__ float ol[256]; __shared__ float wgt[SA_CH];
    float M = -1e30f;
    for (int ch = 0; ch < SA_CH; ++ch) M = fmaxf(M, part[(((size_t)s * SA_CH + ch) * 64 + r) * 258 + 256]);
    float L = 0.f;
    for (int ch = 0; ch < SA_CH; ++ch) { const float* pp = part + (((size_t)s * SA_CH + ch) * 64 + r) * 258; const float w = __expf(pp[256] - M); L += pp[257] * w; if (d == 0) wgt[ch] = w; }
    __syncthreads();
    for (int c = d; c < 256; c += 64) { float a = 0.f; for (int ch = 0; ch < SA_CH; ++ch) a += wgt[ch] * part[(((size_t)s * SA_CH + ch) * 64 + r) * 258 + c]; ol[c] = a / L; }
    __syncthreads();
    float a = 0.f;
    for (int c = 0; c < 256; ++c) a += ol[c] * w_uv[(size_t)c * 512 + h * 64 + d];
    const int t = TP + ts;
    yb[(size_t)t * 512 + h * 64 + d] = f2bf(a * bf2f(H[(size_t)t * IN_WP + C_ZMLA + h * 64 + d]));
}

__global__ void __launch_bounds__(64) k_delta(const bf16_t* __restrict__ qd, const bf16_t* __restrict__ kd, const bf16_t* __restrict__ vd, const float* __restrict__ bg,
                                              const float* __restrict__ state_delta, const float* __restrict__ dn_g, const bf16_t* __restrict__ H, bf16_t* __restrict__ yc,
                                              float* __restrict__ out, int layer, int pad_) {
    const int sq = blockIdx.x, h = blockIdx.y, dv = threadIdx.x;
    int row0, L; float* so; float S[64];
    if (sq < 8) { row0 = sq * SEQ; L = SEQ; so = out + O_PDELTA + (((size_t)layer * 8 + sq) * 8 + h) * 4096;
#pragma unroll
        for (int k = 0; k < 64; ++k) S[k] = 0.f; }
    else { const int s = sq - 8; row0 = TP + s * 8; L = DEC_SEQ; so = out + O_SDELTA + (((size_t)layer * DEC_BATCH + s) * 8 + h) * 4096;
        const float* s0 = state_delta + (((size_t)layer * DEC_BATCH + s) * 8 + h) * 4096;
#pragma unroll
        for (int k = 0; k < 64; ++k) S[k] = s0[k * 64 + dv]; }
    const float gn = dn_g[layer * 64 + dv];
    for (int i = 0; i < L; ++i) {
        const size_t t = (size_t)row0 + i; const bf16_t* kp = kd + t * 512 + h * 64; const bf16_t* qp = qd + t * 512 + h * 64;
        const float b = bg[t * 16 + h], a = __expf(bg[t * 16 + 8 + h]); const float v = bf2f(vd[t * 512 + h * 64 + dv]);
        float ks = 0.f;
#pragma unroll
        for (int k = 0; k < 64; ++k) ks += bf2f(kp[k]) * S[k];
        const float vn = b * (v - a * ks);
        float o = 0.f;
#pragma unroll
        for (int k = 0; k < 64; ++k) { S[k] = a * S[k] + bf2f(kp[k]) * vn; o += bf2f(qp[k]) * S[k]; }
        const float ss = wave_sum(o * o); const float y = o * rsqrtf(ss * (1.0f / 64.0f) + EPS) * gn;
        yc[t * 512 + h * 64 + dv] = f2bf(y * bf2f(H[t * IN_WP + C_ZDN + h * 64 + dv]));
    }
#pragma unroll
    for (int k = 0; k < 64; ++k) so[k * 64 + dv] = S[k];
}

namespace pg8 {
#define PG8_LAS __attribute__((address_space(3)))
typedef unsigned short bf16_t;
typedef short bf16x8 __attribute__((ext_vector_type(8)));
typedef float f32x4 __attribute__((ext_vector_type(4)));
typedef unsigned u32x4 __attribute__((ext_vector_type(4)));
constexpr int BM = 256, BK = 64, HALF = 128, HTB = HALF * BK * 2  , STAGE_BYTES = 8 * HTB, NXCD = 8, WGM = 8;

__host__ __device__ __forceinline__ int lds_byte(int r, int c) { const int st = (r >> 4) * 2 + (c >> 5), rr = r & 15, cc = c & 31, ob = rr * 64 + cc * 2; return st * 1024 + (ob ^ (((ob >> 9) & 1) << 5)); }
__host__ __device__ __forceinline__ void stage_rc(int b, int& R, int& C) { const int st = b / 1024, sb = b % 1024, swz = sb ^ (((sb >> 9) & 1) << 5); R = (st >> 1) * 16 + swz / 64; C = (st & 1) * 32 + (swz % 64) / 2; }
__host__ __device__ __forceinline__ int perm32(int rho) { const int n = rho >> 4, i = rho & 15; return 8 * (i >> 2) + 4 * n + (i & 3); }

struct Unit { int pm, pn; };
struct Gemm { const bf16_t* A; const bf16_t* Bt; int M, N, K; };

struct StaticOrder {
    int nM, nN, nwg, G, c;
    __host__ __device__ void init(int M, int N, int G_, int c_) { nM = M / BM; nN = N / BM; nwg = nM * nN; G = G_; c = c_; }
    __host__ __device__ bool next(int i, Unit& u) const {
        const long L = (long)i * G + c; if (L >= nwg) return false;
        int wgid = (int)L; { const int q = nwg / NXCD, r = nwg % NXCD, xcd = wgid % NXCD, off = wgid / NXCD; wgid = (xcd < r ? xcd * (q + 1) : r * (q + 1) + (xcd - r) * q) + off; }
        const int nig = WGM * nN, gid = wgid / nig, fm = gid * WGM, gsz = (nM - fm) < WGM ? (nM - fm) : WGM;
        u.pm = fm + ((wgid % nig) % gsz); u.pn = (wgid % nig) / gsz; return true;
    }
    __device__ __forceinline__ void a_ready(const Unit&) const {}
    __device__ __forceinline__ void done(const Unit&) const {}
};
__device__ __forceinline__ unsigned cvt_pk_bf16(float lo, float hi) { unsigned r; asm volatile("v_cvt_pk_bf16_f32 %0, %1, %2" : "=v"(r) : "v"(lo), "v"(hi)); return r; }
typedef float f32x2 __attribute__((ext_vector_type(2)));
template <class Epi, class Sched, bool STAMP = false>
__device__ __forceinline__ void gemm_phase(PG8_LAS unsigned char* lds, const Gemm g, const Sched& S, const Epi& E, unsigned long long* stamps) {
    int tid_ = threadIdx.x; asm volatile("" : "+v"(tid_));
    const int tid = tid_, wid = __builtin_amdgcn_readfirstlane(tid >> 6), lane = tid & 63, wr = wid >> 2, wc = wid & 3, fr = lane & 15, fq = lane >> 4;
    int K_ = g.K; asm volatile("" : "+s"(K_));
    const int K = K_, nt = K / BK;
    int ts_lo = 0, ts_hi = 0, nts = 0; const unsigned long long rt_entry = STAMP ? (unsigned long long)wall_clock64() : 0ull;
#define PG8_STAMP() do { if (STAMP && wid == 0 && nts < 64) { const unsigned long long _c = (unsigned long long)clock64(); \
        ts_lo = (lane == nts) ? (int)(unsigned)_c : ts_lo; ts_hi = (lane == nts) ? (int)(unsigned)(_c >> 32) : ts_hi; ++nts; } } while (0)
    PG8_STAMP();
    unsigned voffA[2], voffB[2];
#pragma unroll
    for (int i = 0; i < 2; ++i) { int R, C; stage_rc(tid * 16 + i * 8192, R, C); const int Rb = Epi::PERM ? ((R & ~31) + perm32(R & 31)) : R;
        voffA[i] = (unsigned)(R * K + C) * 2u; voffB[i] = (unsigned)(Rb * K + C) * 2u; }
    const size_t kstep = (size_t)(BK * 2);
    const size_t hstep = (size_t)HALF * K * 2;
    const size_t tstep = 2 * hstep;
    const unsigned ldsw = (unsigned)wid * 1024u;
    const int aoff = lds_byte(wr * 64 + fr, fq * 8), boff = lds_byte(wc * 32 + fr, fq * 8);
#define PG8_SA(b, h) (((b) * 2 + (h)) * HTB)
#define PG8_SB(b, h) ((4 + (b) * 2 + (h)) * HTB)
#define PG8_STAGE(bufoff, gbase, voff) do { _Pragma("unroll") for (int _i = 0; _i < 2; ++_i) \
        __builtin_amdgcn_global_load_lds((const unsigned*)((const char*)(gbase) + (voff)[_i]), (PG8_LAS unsigned*)(lds + (bufoff) + ldsw + _i * 8192), 16, 0, 0); } while (0)
#define PG8_LDA(dst, b, h) do { _Pragma("unroll") for (int m = 0; m < 4; ++m) _Pragma("unroll") for (int k = 0; k < 2; ++k) dst[m][k] = *(const PG8_LAS bf16x8*)(lds + PG8_SA(b, h) + aoff + m * 2048 + k * 1024); } while (0)
#define PG8_LDB(dst, b, h) do { _Pragma("unroll") for (int n = 0; n < 2; ++n) _Pragma("unroll") for (int k = 0; k < 2; ++k) dst[n][k] = *(const PG8_LAS bf16x8*)(lds + PG8_SB(b, h) + boff + n * 2048 + k * 1024); } while (0)
#define PG8_MMA(ai, bj, At, Bt) do { __builtin_amdgcn_s_setprio(1); _Pragma("unroll") for (int m = 0; m < 4; ++m) _Pragma("unroll") for (int n = 0; n < 2; ++n) _Pragma("unroll") for (int k = 0; k < 2; ++k) \
        acc[ai][bj][m][n] = __builtin_amdgcn_mfma_f32_16x16x32_bf16(Bt[n][k], At[m][k], acc[ai][bj][m][n], 0, 0, 0); __builtin_amdgcn_s_setprio(0); } while (0)
#define PG8_WAIT_V(n) asm volatile("s_waitcnt vmcnt(" #n ")" ::: "memory")
#define PG8_WAIT_L(n) asm volatile("s_waitcnt lgkmcnt(" #n ")" ::: "memory")
#define PG8_BAR __builtin_amdgcn_s_barrier()
#define PG8_SCHED __builtin_amdgcn_sched_barrier(0)
    Unit cur, nxt; int ui = 0;
    if (!S.next(0, cur)) return;
    f32x4 acc[2][2][4][2];
#pragma unroll
    for (int a = 0; a < 2; ++a)
#pragma unroll
        for (int b = 0; b < 2; ++b)
#pragma unroll
            for (int m = 0; m < 4; ++m)
#pragma unroll
                for (int n = 0; n < 2; ++n) acc[a][b][m][n] = (f32x4){0.f, 0.f, 0.f, 0.f};
    bf16x8 At[4][2], B0[2][2], B1[2][2];
    const char* cA = (const char*)g.A + (size_t)cur.pm * tstep; const char* cB = (const char*)g.Bt + (size_t)cur.pn * tstep;
    S.a_ready(cur);
    PG8_STAGE(PG8_SB(0, 0), cB, voffB); PG8_STAGE(PG8_SA(0, 0), cA, voffA); PG8_STAGE(PG8_SB(0, 1), cB + hstep, voffB); PG8_STAGE(PG8_SA(0, 1), cA + hstep, voffA);
    if (wr == 1) PG8_BAR;
    PG8_WAIT_V(4); PG8_BAR;
    PG8_STAGE(PG8_SB(1, 0), cB + kstep, voffB); PG8_STAGE(PG8_SA(1, 0), cA + kstep, voffA); PG8_STAGE(PG8_SB(1, 1), cB + hstep + kstep, voffB);
    PG8_WAIT_V(6); PG8_BAR;
    PG8_STAMP();
    for (;;) {
        const bool has_next = S.next(ui + 1, nxt);
        const char* nA = has_next ? (const char*)g.A + (size_t)nxt.pm * tstep : cA; const char* nB = has_next ? (const char*)g.Bt + (size_t)nxt.pn * tstep : cB;
_Pragma("nounroll")
        for (int t = 0; t < nt; t += 2) {
            const bool last = (t == nt - 2);
            const char* a1 = cA + (size_t)(t + 1) * kstep;
            const char* a2 = last ? nA : cA + (size_t)(t + 2) * kstep; const char* b2 = last ? nB : cB + (size_t)(t + 2) * kstep;
            const char* a3 = a2 + kstep; const char* b3 = b2 + kstep;
            if (last && has_next) S.a_ready(nxt);
            PG8_LDB(B0, 0, 0); PG8_SCHED; PG8_LDA(At, 0, 0); PG8_STAGE(PG8_SA(1, 1), a1 + hstep, voffA);
            PG8_WAIT_L(8); PG8_BAR; PG8_WAIT_L(0); PG8_MMA(0, 0, At, B0); PG8_BAR; PG8_SCHED;
            PG8_LDB(B1, 0, 1); PG8_STAGE(PG8_SB(0, 0), b2, voffB);
            PG8_BAR; PG8_WAIT_L(0); PG8_MMA(0, 1, At, B1); PG8_BAR;
            PG8_LDA(At, 0, 1); PG8_STAGE(PG8_SA(0, 0), a2, voffA);
            PG8_BAR; PG8_WAIT_L(0); PG8_MMA(1, 0, At, B0); PG8_BAR; PG8_SCHED;
            PG8_STAGE(PG8_SB(0, 1), b2 + hstep, voffB);
            PG8_WAIT_V(6); PG8_BAR; PG8_MMA(1, 1, At, B1); PG8_BAR;
            PG8_LDB(B0, 1, 0); PG8_SCHED; PG8_LDA(At, 1, 0); PG8_STAGE(PG8_SA(0, 1), a2 + hstep, voffA);
            PG8_WAIT_L(8); PG8_BAR; PG8_WAIT_L(0); PG8_MMA(0, 0, At, B0); PG8_BAR; PG8_SCHED;
            PG8_LDB(B1, 1, 1); PG8_STAGE(PG8_SB(1, 0), b3, voffB);
            PG8_BAR; PG8_WAIT_L(0); PG8_MMA(0, 1, At, B1); PG8_BAR;
            PG8_LDA(At, 1, 1); PG8_STAGE(PG8_SA(1, 0), a3, voffA);
            PG8_BAR; PG8_WAIT_L(0); PG8_MMA(1, 0, At, B0); PG8_BAR; PG8_SCHED;
            PG8_STAGE(PG8_SB(1, 1), b3 + hstep, voffB);
            PG8_WAIT_V(6); PG8_BAR; PG8_MMA(1, 1, At, B1); PG8_BAR;
        }
        PG8_STAMP();
        if constexpr (!Epi::AFTER_DRAIN) { E(acc, cur, wr, wc, fr, fq); S.done(cur); }
        PG8_STAMP();
        if (!has_next) break;
#pragma unroll
        for (int a = 0; a < 2; ++a)
#pragma unroll
            for (int b = 0; b < 2; ++b)
#pragma unroll
                for (int m = 0; m < 4; ++m)
#pragma unroll
                    for (int n = 0; n < 2; ++n) acc[a][b][m][n] = (f32x4){0.f, 0.f, 0.f, 0.f};
        cur = nxt; cA = nA; cB = nB; ++ui;
    }
    PG8_WAIT_V(0);
    if (wr == 0) PG8_BAR;
    PG8_BAR;
    if constexpr (Epi::AFTER_DRAIN) { E.fused(acc, cur, wr, wc, fr, fq, lds, wid, lane); S.done(cur); }
    PG8_STAMP();
    if (STAMP && wid == 0) { stamps[lane] = lane < nts ? (((unsigned long long)(unsigned)ts_hi << 32) | (unsigned)ts_lo) : 0ull;
        if (lane == 62) stamps[62] = rt_entry; if (lane == 63) stamps[63] = (unsigned long long)wall_clock64(); }
#undef PG8_STAMP
#undef PG8_SA
#undef PG8_SB
#undef PG8_STAGE
#undef PG8_LDA
#undef PG8_LDB
#undef PG8_MMA
#undef PG8_WAIT_V
#undef PG8_WAIT_L
#undef PG8_BAR
#undef PG8_SCHED
}

}
#define XB_TMO      128
#define XB_XCNT(j)  (256  + 64 * (j))
#define XB_XSUB(j)  (1280 + 64 * (j))
#define XB_XGEN(j)  (2304 + 64 * (j))
#define XB_TOP      3328
#define XB_TOPGEN   3392
#define XCD_BAR_WORDS 3456
#define XB_SPIN_CAP (1u << 18)
#define LAS __attribute__((address_space(3)))

__device__ __forceinline__ unsigned xb_ld(unsigned* p)              { return __hip_atomic_load(p, __ATOMIC_RELAXED, __HIP_MEMORY_SCOPE_AGENT); }
__device__ __forceinline__ unsigned xb_add(unsigned* p, unsigned v) { return __hip_atomic_fetch_add(p, v, __ATOMIC_RELAXED, __HIP_MEMORY_SCOPE_AGENT); }
__device__ __forceinline__ unsigned xb_xcc_id() { return (unsigned)__builtin_amdgcn_s_getreg((3 << 11) | 20) & 0xFu; }
#define XB_SPIN(cond, bar) do { unsigned _sp = 0; while (cond) { __builtin_amdgcn_s_sleep(1); \
    if ((++_sp & 255u) == 0u) { if (xb_ld(&(bar)[XB_TMO])) break; if (_sp > XB_SPIN_CAP) { atomicAdd(&(bar)[XB_TMO], 1u); break; } } } } while (0)

struct XcdBarrier {
    unsigned* bar; unsigned x;
    volatile LAS unsigned* st;
};

__device__ __forceinline__ XcdBarrier xcd_barrier_post(unsigned* bar, volatile LAS unsigned* st) {
    XcdBarrier b; b.bar = bar; b.x = xb_xcc_id(); b.st = st;
    if (threadIdx.x == 0) (void)xb_add(&bar[XB_XCNT(b.x)], 1u);
    return b;
}
__device__ __forceinline__ void xcd_barrier_complete(unsigned* bar, unsigned x, unsigned& nloc, unsigned& nx) {
    const unsigned G = gridDim.x * gridDim.y * gridDim.z;
    unsigned sum, cnt, mine, sp = 0u;
    for (;;) {
        sum = 0u; cnt = 0u; mine = 0u;
#pragma unroll
        for (unsigned j = 0; j < 16; ++j) { const unsigned c = xb_ld(&bar[XB_XCNT(j)]); sum += c; cnt += (c > 0u) ? 1u : 0u; mine = (j == x) ? c : mine; }
        if (sum == G) break;
        __builtin_amdgcn_s_sleep(1);
        if ((++sp & 255u) == 0u) { if (xb_ld(&bar[XB_TMO])) break; if (sp > XB_SPIN_CAP) { atomicAdd(&bar[XB_TMO], 1u); break; } }
    }
    nloc = mine > 0u ? mine : 1u; nx = cnt > 0u ? cnt : 1u;
}

__device__ __forceinline__ void xcd_barrier(const XcdBarrier& b) {
    asm volatile("s_waitcnt vmcnt(0)" ::: "memory");
    __syncthreads();
    if (threadIdx.x == 0) {
        unsigned* bar = b.bar;
        __builtin_amdgcn_s_waitcnt(0);
        unsigned nloc = b.st[0], nx = b.st[1];
        if (nloc == 0u) { xcd_barrier_complete(bar, b.x, nloc, nx); b.st[0] = nloc; b.st[1] = nx; }
        const unsigned old = xb_add(&bar[XB_XSUB(b.x)], 1u);
        const unsigned gen = old / nloc;
        if (old + 1u == (gen + 1u) * nloc) {
            __builtin_amdgcn_fence(__ATOMIC_RELEASE, "agent");
            asm volatile("s_waitcnt vmcnt(0)" ::: "memory");
            const unsigned og = xb_add(&bar[XB_TOP], 1u);
            const unsigned tg = og / nx;
            if (og + 1u == (tg + 1u) * nx) xb_add(&bar[XB_TOPGEN], 1u);
            else XB_SPIN(xb_ld(&bar[XB_TOPGEN]) == tg, bar);
            __builtin_amdgcn_fence(__ATOMIC_ACQUIRE, "agent");
            xb_add(&bar[XB_XGEN(b.x)], 1u);
            asm volatile("s_waitcnt vmcnt(0)" ::: "memory");
        } else {
            XB_SPIN(xb_ld(&bar[XB_XGEN(b.x)]) == gen, bar);
            __builtin_amdgcn_fence(__ATOMIC_ACQUIRE, "agent");
            asm volatile("s_waitcnt vmcnt(0)" ::: "memory");
        }
    }
    __syncthreads();
}


#define LAS __attribute__((address_space(3)))
typedef float f32x4 __attribute__((ext_vector_type(4)));
typedef unsigned u32x4 __attribute__((ext_vector_type(4)));
typedef unsigned u32x2 __attribute__((ext_vector_type(2)));
constexpr int NTHR = 512;
constexpr int LDS_BYTES = 147456;
constexpr int LDS_MISC = 131072;

struct Params {
    const float *x_prompt, *x_sample, *cache_kv, *cache_kr, *state_pool, *state_conv, *state_delta; const int* page_table;
    const float *norm_g, *w_in, *pool_mix, *pool_scale, *q_norm_g, *w_uq, *kv_norm_g, *w_uk, *w_uv, *conv_w, *a_log, *dt_bias, *dn_norm_g, *w_br0, *w_br1, *w_br2, *w_out, *final_norm_g;
    float* out;
    bf16_t *WinT, *WuqT, *WkvT, *WbrT, *WoutT; float2* tab;
    float* xres; bf16_t* xn; bf16_t* H; float* BA; bf16_t *cq, *ckv, *Kr, *Q, *Kn, *V, *Vt, *qd, *kd, *vd; float* bg; bf16_t *ya, *yb, *yc; float* mf; bf16_t* mb; float* part;
    unsigned* bar;
    int ph_lo, ph_hi, li, pad;
};

constexpr int PH_PRO = 0;
constexpr int PH_L = 8;
constexpr int PH_GIN = 0, PH_TOK = 1, PH_GQ = 2, PH_ATT = 3, PH_FIN = 4, PH_MERGE = 5, PH_OUT = 6, PH_NORM = 7;
#define PHID(l, k) (1 + (l) * PH_L + (k))
constexpr int PH_END = 1 + 2 * PH_L;

struct MEpiH { static constexpr bool PERM = true, AFTER_DRAIN = false; bf16_t* H; float* BA;
    __device__ __forceinline__ void operator()(const f32x4 (&acc)[2][2][4][2], const pg8::Unit& u, int wr, int wc, int fr0, int fq0) const {
        int fr = fr0, fq = fq0; asm volatile("" : "+v"(fr), "+v"(fq));
        const int row0 = u.pm * 256 + wr * 64 + fr;
#pragma unroll
        for (int bj = 0; bj < 2; ++bj) {
            const int wcol = u.pn * 256 + bj * 128 + wc * 32, col0 = wcol + 8 * fq;
            const bool plain = (wcol + 32 <= C_ZPOOL) || (wcol >= C_Q && wcol + 32 <= C_ZMLA) || (wcol >= C_QKV && wcol + 32 <= C_ZDN);
            const int act = ((col0 >= C_ZPOOL && col0 < C_Q) || (col0 >= C_ZMLA && col0 < C_QKV) || (col0 >= C_ZDN && col0 < C_BETA)) ? 1 : (col0 >= C_GATE ? 2 : 0);
            const bool isba = (col0 == C_BETA) || (col0 == C_ALPHA);
#pragma unroll
            for (int ai = 0; ai < 2; ++ai)
#pragma unroll
                for (int m = 0; m < 4; ++m) { const int row = row0 + ai * 128 + m * 16; f32x4 v0 = acc[ai][bj][m][0], v1 = acc[ai][bj][m][1];
                    if (!plain) {
                        if (isba) { float* b = BA + (size_t)row * 16 + (col0 - C_BETA); *(f32x4*)b = v0; *(f32x4*)(b + 4) = v1; }
#pragma unroll
                        for (int e = 0; e < 4; ++e) { const float s0 = sigmoidf_(v0[e]), s1 = sigmoidf_(v1[e]);
                            v0[e] = act == 0 ? v0[e] : (act == 1 ? v0[e] * s0 : s0); v1[e] = act == 0 ? v1[e] : (act == 1 ? v1[e] * s1 : s1); }
                    }
                    u32x4 w; w.x = pg8::cvt_pk_bf16(v0[0], v0[1]); w.y = pg8::cvt_pk_bf16(v0[2], v0[3]); w.z = pg8::cvt_pk_bf16(v1[0], v1[1]); w.w = pg8::cvt_pk_bf16(v1[2], v1[3]);
                    *(u32x4*)(H + (size_t)row * IN_WP + col0) = w; }
        }
    } };
struct MEpiQ { static constexpr bool PERM = true, AFTER_DRAIN = false; bf16_t* Q; const float2* tab;
    __device__ __forceinline__ void operator()(const f32x4 (&acc)[2][2][4][2], const pg8::Unit& u, int wr, int wc, int fr0, int fq0) const {
        int fr = fr0, fq = fq0; asm volatile("" : "+v"(fr), "+v"(fq));
        const int row0 = u.pm * 256 + wr * 64 + fr;
#pragma unroll
        for (int bj = 0; bj < 2; ++bj) {
            const int wcol = u.pn * 256 + bj * 128 + wc * 32, col0 = wcol + 8 * fq;
            const bool rope = (wcol % 96) == 64;
#pragma unroll
            for (int ai = 0; ai < 2; ++ai)
#pragma unroll
                for (int m = 0; m < 4; ++m) { const int row = row0 + ai * 128 + m * 16; f32x4 v0 = acc[ai][bj][m][0], v1 = acc[ai][bj][m][1];
                    if (rope) { const int p = row < TP ? (row & (SEQ - 1)) : SEQ + ((row - TP) & 7); const float2* tp = tab + p * 16 + (fq & 1) * 8; const bool hi = fq >= 2;
#pragma unroll
                        for (int e = 0; e < 4; ++e) { const float o0 = __shfl_xor(v0[e], 32), o1 = __shfl_xor(v1[e], 32); const float2 c0 = tp[e], c1 = tp[4 + e];
                            v0[e] = hi ? (v0[e] * c0.x + o0 * c0.y) : (v0[e] * c0.x - o0 * c0.y); v1[e] = hi ? (v1[e] * c1.x + o1 * c1.y) : (v1[e] * c1.x - o1 * c1.y); } }
                    u32x4 w; w.x = pg8::cvt_pk_bf16(v0[0], v0[1]); w.y = pg8::cvt_pk_bf16(v0[2], v0[3]); w.z = pg8::cvt_pk_bf16(v1[0], v1[1]); w.w = pg8::cvt_pk_bf16(v1[2], v1[3]);
                    *(u32x4*)(Q + (size_t)row * 768 + col0) = w; asm volatile("" ::: "memory"); }
        }
    } };
struct MEpiKV { static constexpr bool PERM = true, AFTER_DRAIN = false; bf16_t* Kn; bf16_t* V;
    __device__ __forceinline__ void operator()(const f32x4 (&acc)[2][2][4][2], const pg8::Unit& u, int wr, int wc, int fr0, int fq0) const {
        int fr = fr0, fq = fq0; asm volatile("" : "+v"(fr), "+v"(fq));
        const int row0 = u.pm * 256 + wr * 64 + fr; bf16_t* base = u.pn < 2 ? Kn : V; const int cb = (u.pn & 1) * 256;
#pragma unroll
        for (int bj = 0; bj < 2; ++bj) { const int col0 = cb + bj * 128 + wc * 32 + 8 * fq;
#pragma unroll
            for (int ai = 0; ai < 2; ++ai)
#pragma unroll
                for (int m = 0; m < 4; ++m) { const int row = row0 + ai * 128 + m * 16; const f32x4 v0 = acc[ai][bj][m][0], v1 = acc[ai][bj][m][1];
                    u32x4 w; w.x = pg8::cvt_pk_bf16(v0[0], v0[1]); w.y = pg8::cvt_pk_bf16(v0[2], v0[3]); w.z = pg8::cvt_pk_bf16(v1[0], v1[1]); w.w = pg8::cvt_pk_bf16(v1[2], v1[3]);
                    *(u32x4*)(base + (size_t)row * 512 + col0) = w; } }
    } };
template <int BR> struct MEpiMerge { static constexpr bool PERM = true, AFTER_DRAIN = false; const bf16_t* H; float* mf; bf16_t* mb;
    __device__ __forceinline__ void operator()(const f32x4 (&acc)[2][2][4][2], const pg8::Unit& u, int wr, int wc, int fr0, int fq0) const {
        int fr = fr0, fq = fq0; asm volatile("" : "+v"(fr), "+v"(fq));
        const int row0 = u.pm * 256 + wr * 64 + fr;
#pragma unroll
        for (int bj = 0; bj < 2; ++bj) { const int col0 = u.pn * 256 + bj * 128 + wc * 32 + 8 * fq;
#pragma unroll
            for (int ai = 0; ai < 2; ++ai)
#pragma unroll
                for (int m = 0; m < 4; ++m) { const int row = row0 + ai * 128 + m * 16; f32x4 v0 = acc[ai][bj][m][0], v1 = acc[ai][bj][m][1];
                    const u32x4 g = *(const u32x4*)(H + (size_t)row * IN_WP + C_GATE + BR * 1024 + col0);
                    v0[0] *= __uint_as_float(g.x << 16); v0[1] *= __uint_as_float(g.x & 0xffff0000u); v0[2] *= __uint_as_float(g.y << 16); v0[3] *= __uint_as_float(g.y & 0xffff0000u);
                    v1[0] *= __uint_as_float(g.z << 16); v1[1] *= __uint_as_float(g.z & 0xffff0000u); v1[2] *= __uint_as_float(g.w << 16); v1[3] *= __uint_as_float(g.w & 0xffff0000u);
                    float* mp = mf + (size_t)row * 1024 + col0;
                    if (BR > 0) { v0 += *(const f32x4*)mp; v1 += *(const f32x4*)(mp + 4); }
                    if (BR < 2) { *(f32x4*)mp = v0; *(f32x4*)(mp + 4) = v1; }
                    else { u32x4 w; w.x = pg8::cvt_pk_bf16(v0[0], v0[1]); w.y = pg8::cvt_pk_bf16(v0[2], v0[3]); w.z = pg8::cvt_pk_bf16(v1[0], v1[1]); w.w = pg8::cvt_pk_bf16(v1[2], v1[3]);
                        *(u32x4*)(mb + (size_t)row * 1024 + col0) = w; } asm volatile("" ::: "memory"); } }
    } };
struct MEpiRes { static constexpr bool PERM = false, AFTER_DRAIN = false; const float* xp; const float* xs; float* xo;
    __device__ __forceinline__ void operator()(const f32x4 (&acc)[2][2][4][2], const pg8::Unit& u, int wr, int wc, int fr0, int fq0) const {
        int fr = fr0, fq = fq0; asm volatile("" : "+v"(fr), "+v"(fq));
        const int row0 = u.pm * 256 + wr * 64 + fr, col0 = u.pn * 256 + wc * 32 + 4 * fq;
#pragma unroll
        for (int ai = 0; ai < 2; ++ai)
#pragma unroll
            for (int m = 0; m < 4; ++m) { const int row = row0 + ai * 128 + m * 16; const float* xr = row < TP ? xp + (size_t)row * 1024 : xs + (size_t)(row - TP) * 1024; float* orow = xo + (size_t)row * 1024;
#pragma unroll
                for (int bj = 0; bj < 2; ++bj)
#pragma unroll
                    for (int n = 0; n < 2; ++n) { const int c = col0 + bj * 128 + n * 16; *(f32x4*)(orow + c) = *(const f32x4*)(xr + c) + acc[ai][bj][m][n]; } }
    } };

__device__ __forceinline__ void ph_tr(const float* __restrict__ src, bf16_t* __restrict__ dst, int K, int N, int Npad, LAS float* tile, int rot) {
    const int tid = threadIdx.x, G = gridDim.x; const int tn = Npad / 64, tk = K / 32, nt = tn * tk;
    const int first = (blockIdx.x + G - (rot % G)) % G;
    for (int t = first; t < nt; t += G) {
        const int n0 = (t % tn) * 64, k0 = (t / tn) * 32;
        { const int tx = tid & 63, ty = tid >> 6;
#pragma unroll
          for (int i = 0; i < 4; ++i) { const int k = ty + 8 * i, n = n0 + tx; tile[k * 65 + tx] = n < N ? src[(size_t)(k0 + k) * N + n] : 0.f; } }
        __syncthreads();
        { const int kx = tid & 31, ny = tid >> 5;
#pragma unroll
          for (int i = 0; i < 4; ++i) { const int n = ny + 16 * i; dst[(size_t)(n0 + n) * K + k0 + kx] = f2bf(tile[kx * 65 + n]); } }
        __syncthreads();
    }
}
__device__ __forceinline__ void ph_rope_tab(float2* tab) {
    for (int idx = blockIdx.x * NTHR + threadIdx.x; idx < (SEQ + DEC_SEQ) * 16; idx += gridDim.x * NTHR) {
        const int p = idx >> 4, i = idx & 15; const int pos = p < SEQ ? p : PAST_LEN + (p - SEQ);
        const float inv = powf(10000.0f, -(float)i / 16.0f); const float ang = (float)pos * inv;
        const double rev = (double)ang * 0.15915494309189533576888; const float f = (float)(rev - floor(rev));
        tab[idx] = make_float2(__builtin_amdgcn_cosf(f), __builtin_amdgcn_sinf(f)); }
}
__device__ __forceinline__ void ph_rmsnorm(const float* __restrict__ xp, const float* __restrict__ xs, const float* __restrict__ g, bf16_t* __restrict__ xn, float* __restrict__ yp, float* __restrict__ ys) {
    int lane = threadIdx.x & 63, wave = threadIdx.x >> 6; asm volatile("" : "+v"(lane), "+v"(wave));
    for (int t = blockIdx.x * 8 + wave; t < TT; t += gridDim.x * 8) {
        const float* x = t < TP ? xp + (size_t)t * 1024 : xs + (size_t)(t - TP) * 1024;
        f32x4 v[4]; float ss = 0.f;
#pragma unroll
        for (int i = 0; i < 4; ++i) { v[i] = *(const f32x4*)(x + i * 256 + lane * 4); ss += v[i][0] * v[i][0] + v[i][1] * v[i][1] + v[i][2] * v[i][2] + v[i][3] * v[i][3]; }
        ss = wave_sum(ss); const float r = rsqrtf(ss * (1.0f / 1024.0f) + EPS);
#pragma unroll
        for (int i = 0; i < 4; ++i) { const int c = i * 256 + lane * 4; const f32x4 gg = *(const f32x4*)(g + c); const f32x4 o = v[i] * r * gg;
            if (xn) { u32x2 w; w.x = pg8::cvt_pk_bf16(o[0], o[1]); w.y = pg8::cvt_pk_bf16(o[2], o[3]); *(u32x2*)(xn + (size_t)t * 1024 + c) = w; }
            else { float* y = t < TP ? yp + (size_t)t * 1024 : ys + (size_t)(t - TP) * 1024; *(f32x4*)(y + c) = o; } }
    }
}

__device__ __forceinline__ void ph_tok(const Params& p, int l, LAS unsigned char* lds) {
    int lane = threadIdx.x & 63, wave = threadIdx.x >> 6; asm volatile("" : "+v"(lane), "+v"(wave));
    const bf16_t* __restrict__ H = p.H; float* __restrict__ out = p.out;
    const float* qg = p.q_norm_g + l * 384; const float* kvg = p.kv_norm_g + l * 256; const float* conv_w = p.conv_w + (size_t)l * 4 * 1536;
    LAS float* dl = (LAS float*)(lds + wave * 2048);
    for (int t = blockIdx.x * 8 + wave; t < TT; t += gridDim.x * 8) {
        const bf16_t* h = H + (size_t)t * IN_WP;
        int i_seq, row0, pidx; const bool smp = t >= TP; const int ts = t - TP;
        if (!smp) { i_seq = t & (SEQ - 1); row0 = t - i_seq; pidx = i_seq; } else { i_seq = ts & 7; row0 = t - i_seq; pidx = SEQ + i_seq; }
        { float q[6]; float ss = 0.f;
#pragma unroll
          for (int i = 0; i < 6; ++i) { q[i] = bf2f(h[C_Q + lane + 64 * i]); ss += q[i] * q[i]; }
          ss = wave_sum(ss); float r = rsqrtf(ss * (1.0f / 384.0f) + EPS);
#pragma unroll
          for (int i = 0; i < 6; ++i) p.cq[(size_t)t * 384 + lane + 64 * i] = f2bf(q[i] * r * qg[lane + 64 * i]);
          float kv[4]; ss = 0.f;
#pragma unroll
          for (int i = 0; i < 4; ++i) { kv[i] = bf2f(h[C_KV + lane + 64 * i]); ss += kv[i] * kv[i]; }
          ss = wave_sum(ss); r = rsqrtf(ss * (1.0f / 256.0f) + EPS);
          float* okv; float* okr;
          if (!smp) { okv = out + O_PKV + ((size_t)l * TP + t) * 256; okr = out + O_PKR + ((size_t)l * TP + t) * 32; }
          else { okv = out + O_SKV + ((size_t)l * TS + ts) * 256; okr = out + O_SKR + ((size_t)l * TS + ts) * 32; }
#pragma unroll
          for (int i = 0; i < 4; ++i) { const float o = kv[i] * r * kvg[lane + 64 * i]; okv[lane + 64 * i] = o; p.ckv[(size_t)t * 256 + lane + 64 * i] = f2bf(o); }
          if (lane < 16) { const float x1 = bf2f(h[C_KR + lane]), x2 = bf2f(h[C_KR + 16 + lane]); const float2 cs = p.tab[pidx * 16 + lane];
              const float o1 = x1 * cs.x - x2 * cs.y, o2 = x2 * cs.x + x1 * cs.y;
              okr[lane] = o1; okr[16 + lane] = o2; p.Kr[(size_t)t * 32 + lane] = f2bf(o1); p.Kr[(size_t)t * 32 + 16 + lane] = f2bf(o2); } }
        { const float* sc = smp ? p.state_conv + ((size_t)l * DEC_BATCH + (ts >> 3)) * 3 * 1536 : nullptr;
#pragma unroll 4
          for (int i = 0; i < 24; ++i) { const int c = lane + 64 * i; float y = 0.f;
#pragma unroll
              for (int j = 0; j < 4; ++j) { const int u = i_seq - 3 + j; float xv;
                  if (u >= 0) xv = bf2f(H[(size_t)(row0 + u) * IN_WP + C_QKV + c]); else xv = sc ? sc[(size_t)(u + 3) * 1536 + c] : 0.f;
                  y += xv * conv_w[j * 1536 + c]; }
              float v = siluf_(y);
              if (i < 16) { const float ss = wave_sum(v * v); v *= rsqrtf(ss + EPS); if (i < 8) v *= 0.125f; }
              const bf16_t o = f2bf(v);
              if (i < 8) p.qd[(size_t)t * 512 + c] = o; else if (i < 16) p.kd[(size_t)t * 512 + (c - 512)] = o; else p.vd[(size_t)t * 512 + (c - 1024)] = o;
              if (!smp) { if (i_seq >= SEQ - 3) out[O_PCONV + (((size_t)l * 8 + (t >> 11)) * 3 + (i_seq - (SEQ - 3))) * 1536 + c] = bf2f(h[C_QKV + c]); }
              else { if (i_seq >= DEC_SEQ - 3) out[O_SCONV + (((size_t)l * DEC_BATCH + (ts >> 3)) * 3 + (i_seq - (DEC_SEQ - 3))) * 1536 + c] = bf2f(h[C_QKV + c]); } }
          if (lane < 8) { const float b = sigmoidf_(p.BA[(size_t)t * 16 + lane]); const float x = p.BA[(size_t)t * 16 + 8 + lane] + p.dt_bias[l * 8 + lane];
              const float sp = x > 20.f ? x : log1pf(expf(x)); const float g = -expf(p.a_log[l * 8 + lane]) * sp;
              p.bg[(size_t)t * 16 + lane] = b; p.bg[(size_t)t * 16 + 8 + lane] = g; } }
        { const float* sp = smp ? p.state_pool + ((size_t)l * DEC_BATCH + (ts >> 3)) * 15 * 512 : nullptr;
          float* so = smp ? out + O_SPOOL + ((size_t)l * DEC_BATCH + (ts >> 3)) * 15 * 512 : nullptr;
#pragma unroll
          for (int j = 0; j < 8; ++j) { const int ch = lane + 64 * j, g = j >> 1, w = 2 << g; float sum = 0.f;
              for (int k = 0; k < w; ++k) { const int u = i_seq - k; float xv;
                  if (u >= 0) xv = bf2f(H[(size_t)(row0 + u) * IN_WP + C_POOL + ch]); else xv = sp ? sp[(size_t)(15 + u) * 512 + ch] : 0.f;
                  sum += xv; }
              const float cur = bf2f(h[C_POOL + ch]); const float cnt = !smp ? (float)min(i_seq + 1, w) : (float)w;
              dl[ch] = sum / cnt - cur;
              if (!smp) { if (i_seq >= SEQ - 15) out[O_PPOOL + (((size_t)l * 8 + (t >> 11)) * 15 + (i_seq - (SEQ - 15))) * 512 + ch] = cur; }
              else { so[(size_t)(7 + i_seq) * 512 + ch] = cur; if (i_seq < 7) so[(size_t)i_seq * 512 + ch] = sp[(size_t)(8 + i_seq) * 512 + ch]; } }
          asm volatile("s_waitcnt lgkmcnt(0)" ::: "memory");
#pragma unroll
          for (int j = 0; j < 8; ++j) { const int ch = lane + 64 * j, g = j >> 1, c = ch & 127; const float* m = p.pool_mix + ((size_t)l * 4 + g) * 128 * 128; float y = 0.f;
              for (int k = 0; k < 128; ++k) y += dl[g * 128 + k] * m[k * 128 + c];
              y *= p.pool_scale[l * 512 + ch]; y *= bf2f(h[C_ZPOOL + ch]); p.ya[(size_t)t * 512 + ch] = f2bf(y); }
          asm volatile("s_waitcnt lgkmcnt(0)" ::: "memory"); }
    }
}

__device__ __forceinline__ void ph_attn_s(const Params& p, int l, LAS unsigned char* lds) {
    int tid = threadIdx.x; asm volatile("" : "+v"(tid));
    const int r = tid & 63, cq = tid >> 6;
    LAS bf16_t* Ks = (LAS bf16_t*)lds;
    LAS float* Ss = (LAS float*)(lds + 18944);
    LAS bf16_t* Qs = (LAS bf16_t*)(lds + 18944 + 8448);
    const float* w_uk = p.w_uk + (size_t)l * 256 * 512;
    for (int u = blockIdx.x; u < DEC_BATCH * SA_CH; u += gridDim.x) {
        const int s = u / SA_CH, ch = u % SA_CH;
        __syncthreads();
        { const int c = tid & 255, hh = tid >> 8;
          for (int h = hh * 4; h < hh * 4 + 4; ++h) { float acc[8];
#pragma unroll
              for (int i = 0; i < 8; ++i) acc[i] = 0.f;
              const float* wr_ = w_uk + (size_t)c * 512 + h * 64;
              for (int d = 0; d < 64; d += 4) { const f32x4 wv = *(const f32x4*)(wr_ + d);
#pragma unroll
                  for (int i = 0; i < 8; ++i) { const bf16_t* q = p.Q + (size_t)(TP + s * 8 + i) * 768 + h * 96 + d;
                      acc[i] += bf2f(q[0]) * wv[0] + bf2f(q[1]) * wv[1] + bf2f(q[2]) * wv[2] + bf2f(q[3]) * wv[3]; } }
#pragma unroll
              for (int i = 0; i < 8; ++i) Qs[(i * 8 + h) * 290 + c] = f2bf(acc[i]); }
          for (int e = tid; e < 64 * 32; e += NTHR) { const int rr = e >> 5, j = e & 31; Qs[rr * 290 + 256 + j] = p.Q[(size_t)(TP + s * 8 + (rr >> 3)) * 768 + (rr & 7) * 96 + 64 + j]; } }
        float o[32];
#pragma unroll
        for (int d = 0; d < 32; ++d) o[d] = 0.f;
        float m = -1e30f, lsum = 0.f; const int i_tok = r >> 3; const int ntile = ch < 32 ? 16 : 1;
        for (int tl = 0; tl < ntile; ++tl) {
            __syncthreads();
            if (ch < 32) { const int j0 = ch * 512 + tl * 32; const int page = p.page_table[s * N_PAGES + (j0 >> 7)]; const int prow = j0 & 127;
                const float* kvp = p.cache_kv + (((size_t)l * N_POOL + page) * PAGE + prow) * 256; const float* krp = p.cache_kr + (((size_t)l * N_POOL + page) * PAGE + prow) * 32;
                for (int i = tid; i < 32 * 256; i += NTHR) Ks[(i >> 8) * 296 + (i & 255)] = f2bf(kvp[i]);
                for (int i = tid; i < 32 * 32; i += NTHR) Ks[(i >> 5) * 296 + 256 + (i & 31)] = f2bf(krp[i]);
            } else {
                for (int i = tid; i < 32 * 256; i += NTHR) { const int k = i >> 8; Ks[k * 296 + (i & 255)] = k < 8 ? p.ckv[((size_t)TP + s * 8 + k) * 256 + (i & 255)] : (bf16_t)0; }
                for (int i = tid; i < 32 * 32; i += NTHR) { const int k = i >> 5; Ks[k * 296 + 256 + (i & 31)] = k < 8 ? p.Kr[((size_t)TP + s * 8 + k) * 32 + (i & 31)] : (bf16_t)0; }
            }
            __syncthreads();
#pragma unroll
            for (int kk = 0; kk < 4; ++kk) { const int k = cq * 4 + kk; float sc = 0.f;
                for (int c = 0; c < 288; ++c) sc += bf2f(Qs[r * 290 + c]) * bf2f(Ks[k * 296 + c]);
                sc *= MLA_SCALE; if (ch == 32 && k > i_tok) sc = -1e30f; Ss[r * 33 + k] = sc; }
            __syncthreads();
            float tm = -1e30f;
            for (int k = 0; k < 32; ++k) tm = fmaxf(tm, Ss[r * 33 + k]);
            const float mn = fmaxf(m, tm), al = __expf(m - mn); m = mn; lsum *= al;
#pragma unroll
            for (int d = 0; d < 32; ++d) o[d] *= al;
            for (int k = 0; k < 32; ++k) { const float sc = Ss[r * 33 + k]; const float pr = sc <= -1e29f ? 0.f : __expf(sc - mn); lsum += pr;
#pragma unroll
                for (int d = 0; d < 32; ++d) o[d] += pr * bf2f(Ks[k * 296 + cq * 32 + d]); }
        }
        float* pp = p.part + (((size_t)s * SA_CH + ch) * 64 + r) * 258;
#pragma unroll
        for (int d = 0; d < 32; ++d) pp[cq * 32 + d] = o[d];
        if (cq == 0) { pp[256] = m; pp[257] = lsum; }
    }
    __syncthreads();
}

__device__ __forceinline__ void wu_attn_p(const Params& p, int b, int h, int qb, int lane) {
    const int i = qb * 64 + lane, t = b * SEQ + i;
    float q[96];
#pragma unroll
    for (int d = 0; d < 96; ++d) q[d] = bf2f(p.Q[(size_t)t * 768 + h * 96 + d]) * MLA_SCALE;
    float o[64];
#pragma unroll
    for (int d = 0; d < 64; ++d) o[d] = 0.f;
    float m = -1e30f, lsum = 0.f; const int jmax = qb * 64 + 63;
    for (int j = 0; j <= jmax; ++j) {
        const size_t tk = (size_t)b * SEQ + j; const bf16_t* kn = p.Kn + tk * 512 + h * 64; const bf16_t* kr = p.Kr + tk * 32; const bf16_t* vv = p.V + tk * 512 + h * 64;
        float s = 0.f;
#pragma unroll
        for (int d = 0; d < 64; ++d) s += q[d] * bf2f(kn[d]);
#pragma unroll
        for (int d = 0; d < 32; ++d) s += q[64 + d] * bf2f(kr[d]);
        if (j <= i) { const float mn = fmaxf(m, s), al = __expf(m - mn), pr = __expf(s - mn); lsum = lsum * al + pr; m = mn;
#pragma unroll
            for (int d = 0; d < 64; ++d) o[d] = o[d] * al + pr * bf2f(vv[d]); }
    }
    const float il = 1.0f / lsum;
#pragma unroll
    for (int d = 0; d < 64; ++d) p.yb[(size_t)t * 512 + h * 64 + d] = f2bf(o[d] * il * bf2f(p.H[(size_t)t * IN_WP + C_ZMLA + h * 64 + d]));
}
__device__ __forceinline__ void wu_delta(const Params& p, int l, int sq, int h, int dv) {
    int row0, L; float* so; float S[64];
    if (sq < 8) { row0 = sq * SEQ; L = SEQ; so = p.out + O_PDELTA + (((size_t)l * 8 + sq) * 8 + h) * 4096;
#pragma unroll
        for (int k = 0; k < 64; ++k) S[k] = 0.f; }
    else { const int s = sq - 8; row0 = TP + s * 8; L = DEC_SEQ; so = p.out + O_SDELTA + (((size_t)l * DEC_BATCH + s) * 8 + h) * 4096;
        const float* s0 = p.state_delta + (((size_t)l * DEC_BATCH + s) * 8 + h) * 4096;
#pragma unroll
        for (int k = 0; k < 64; ++k) S[k] = s0[k * 64 + dv]; }
    const float gn = p.dn_norm_g[l * 64 + dv];
    for (int i = 0; i < L; ++i) {
        const size_t t = (size_t)row0 + i; const u32x4* kp = (const u32x4*)(p.kd + t * 512 + h * 64); const u32x4* qp = (const u32x4*)(p.qd + t * 512 + h * 64);
        const float b = p.bg[t * 16 + h], a = __expf(p.bg[t * 16 + 8 + h]); const float v = bf2f(p.vd[t * 512 + h * 64 + dv]);
        u32x4 kk[8];
#pragma unroll
        for (int c = 0; c < 8; ++c) kk[c] = kp[c];
        float ks = 0.f;
#pragma unroll
        for (int c = 0; c < 8; ++c)
#pragma unroll
            for (int e = 0; e < 4; ++e) { const unsigned w = kk[c][e]; ks += __uint_as_float(w << 16) * S[c * 8 + 2 * e] + __uint_as_float(w & 0xffff0000u) * S[c * 8 + 2 * e + 1]; }
        const float vn = b * (v - a * ks); float o = 0.f;
#pragma unroll
        for (int c = 0; c < 8; ++c) { const u32x4 qv = qp[c];
#pragma unroll
            for (int e = 0; e < 4; ++e) { const unsigned w = kk[c][e], wq = qv[e]; const int k0 = c * 8 + 2 * e;
                S[k0] = a * S[k0] + __uint_as_float(w << 16) * vn; o += __uint_as_float(wq << 16) * S[k0];
                S[k0 + 1] = a * S[k0 + 1] + __uint_as_float(w & 0xffff0000u) * vn; o += __uint_as_float(wq & 0xffff0000u) * S[k0 + 1]; }
            asm volatile("" ::: "memory"); }
        const float ss = wave_sum(o * o); const float y = o * rsqrtf(ss * (1.0f / 64.0f) + EPS) * gn;
        p.yc[t * 512 + h * 64 + dv] = f2bf(y * bf2f(p.H[t * IN_WP + C_ZDN + h * 64 + dv]));
    }
#pragma unroll
    for (int k = 0; k < 64; ++k) so[k * 64 + dv] = S[k];
}
__device__ __forceinline__ void ph_att_waves(const Params& p, int l) {
    int lane = threadIdx.x & 63, wave = threadIdx.x >> 6; asm volatile("" : "+v"(lane), "+v"(wave));
    wave = __builtin_amdgcn_readfirstlane(wave);
    const int G = gridDim.x, NW = G * 8, gw = wave * G + blockIdx.x;
    for (int d = gw; d < 320; d += NW) { const int sq = d < 64 ? (d >> 3) : 8 + ((d - 64) >> 3), h = d & 7; wu_delta(p, l, sq, h, lane); }
}
__device__ __forceinline__ void ph_fin(const Params& p, int l, LAS unsigned char* lds) {
    int lane = threadIdx.x & 63, wave = threadIdx.x >> 6; asm volatile("" : "+v"(lane), "+v"(wave));
    LAS float* ol = (LAS float*)(lds + wave * 2048); LAS float* wgt = ol + 256;
    const float* w_uv = p.w_uv + (size_t)l * 256 * 512;
    for (int u = blockIdx.x * 8 + wave; u < TS * 8; u += gridDim.x * 8) {
        const int ts = u >> 3, h = u & 7, s = ts >> 3, r = (ts & 7) * 8 + h; const int d = lane;
        float M = -1e30f;
        for (int ch = 0; ch < SA_CH; ++ch) M = fmaxf(M, p.part[(((size_t)s * SA_CH + ch) * 64 + r) * 258 + 256]);
        float L = 0.f;
        for (int ch = 0; ch < SA_CH; ++ch) { const float* pp = p.part + (((size_t)s * SA_CH + ch) * 64 + r) * 258; const float w = __expf(pp[256] - M); L += pp[257] * w; if (d == 0) wgt[ch] = w; }
        asm volatile("s_waitcnt lgkmcnt(0)" ::: "memory");
        for (int c = d; c < 256; c += 64) { float a = 0.f; for (int ch = 0; ch < SA_CH; ++ch) a += wgt[ch] * p.part[(((size_t)s * SA_CH + ch) * 64 + r) * 258 + c]; ol[c] = a / L; }
        asm volatile("s_waitcnt lgkmcnt(0)" ::: "memory");
        float a = 0.f;
        for (int c = 0; c < 256; ++c) a += ol[c] * w_uv[(size_t)c * 512 + h * 64 + d];
        const int t = TP + ts;
        p.yb[(size_t)t * 512 + h * 64 + d] = f2bf(a * bf2f(p.H[(size_t)t * IN_WP + C_ZMLA + h * 64 + d]));
        asm volatile("s_waitcnt lgkmcnt(0)" ::: "memory");
    }
}

typedef short bf16x8_t __attribute__((ext_vector_type(8)));
typedef float f32x16 __attribute__((ext_vector_type(16)));
constexpr int ATT_KS = 208, ATT_VS = 144, ATT_KB = 64 * ATT_KS, ATT_VB = 64 * ATT_VS, ATT_STAGE = ATT_KB + ATT_VB;
#define ATT_C 0.14724444831554004f
__device__ __forceinline__ void attn_unit(const Params& p, int b, int h, int qblk, LAS unsigned char* lds, int tid, int wave, int lane) {
    const int r = lane & 31, hh = lane >> 5;
    const int q0 = qblk * 256 + wave * 32;
    const size_t trow0 = (size_t)b * SEQ;
    bf16x8_t qf[6];
    { const bf16_t* qp = p.Q + (trow0 + q0 + r) * 768 + h * 96 + 8 * hh;
#pragma unroll
      for (int ks = 0; ks < 6; ++ks) qf[ks] = *(const bf16x8_t*)(qp + 16 * ks); }
    f32x16 o0, o1;
#pragma unroll
    for (int e = 0; e < 16; ++e) { o0[e] = 0.f; o1[e] = 0.f; }
    float m = -1e30f, lsum = 0.f;
    const int ntile = qblk * 4 + 4;
    const int cA = tid, keyA = cA / 12, partA = cA - keyA * 12; const int cB = 512 + (tid & 255), keyB = cB / 12, partB = cB - keyB * 12; const bool hasB = tid < 256;
    const bf16_t* gA = partA < 8 ? p.Kn + (trow0 + keyA) * 512 + h * 64 + partA * 8 : p.Kr + (trow0 + keyA) * 32 + (partA - 8) * 8; const int stepA = partA < 8 ? 64 * 512 : 64 * 32;
    const bf16_t* gB = partB < 8 ? p.Kn + (trow0 + keyB) * 512 + h * 64 + partB * 8 : p.Kr + (trow0 + keyB) * 32 + (partB - 8) * 8; const int stepB = partB < 8 ? 64 * 512 : 64 * 32;
    const bf16_t* gV = p.Vt + (size_t)(h * 64 + (tid >> 3)) * TP + trow0 + (tid & 7) * 8;
    const int lA = keyA * ATT_KS + partA * 16, lB = keyB * ATT_KS + partB * 16, lV = ATT_KB + (tid >> 3) * ATT_VS + (tid & 7) * 16;
    const int pr_ = (r & 0x13) | ((r & 4) << 1) | ((r & 8) >> 1);
    const int kOff = pr_ * ATT_KS + 16 * hh, vOff = ATT_KB + r * ATT_VS + 16 * hh;
    u32x4 rA = *(const u32x4*)gA, rB = hasB ? *(const u32x4*)gB : (u32x4){0u, 0u, 0u, 0u}, rV = *(const u32x4*)gV;
    for (int kt = 0; kt < ntile; ++kt) {
        LAS unsigned char* st = lds + (kt & 1) * ATT_STAGE;
        *(LAS u32x4*)(st + lA) = rA; if (hasB) *(LAS u32x4*)(st + lB) = rB; *(LAS u32x4*)(st + lV) = rV;
        __syncthreads();
        if (kt + 1 < ntile) { gA += stepA; gB += stepB; gV += 64; rA = *(const u32x4*)gA; if (hasB) rB = *(const u32x4*)gB; rV = *(const u32x4*)gV; }
        if (kt * 64 <= q0 + 31) {
            f32x16 s0, s1;
#pragma unroll
            for (int e = 0; e < 16; ++e) { s0[e] = 0.f; s1[e] = 0.f; }
#pragma unroll
            for (int ks = 0; ks < 6; ++ks) {
                const bf16x8_t a0 = *(const LAS bf16x8_t*)(st + kOff + ks * 32), a1 = *(const LAS bf16x8_t*)(st + kOff + 32 * ATT_KS + ks * 32);
                s0 = __builtin_amdgcn_mfma_f32_32x32x16_bf16(a0, qf[ks], s0, 0, 0, 0);
                s1 = __builtin_amdgcn_mfma_f32_32x32x16_bf16(a1, qf[ks], s1, 0, 0, 0);
            }
            if (kt * 64 + 63 > q0) {
                const int qrel = q0 + r - kt * 64;
#pragma unroll
                for (int e = 0; e < 16; ++e) { const int kl = (e & 3) + 4 * ((e >> 2) & 1) + 8 * hh + 16 * ((e >> 3) & 1);
                    if (kl > qrel) s0[e] = -1e30f; if (kl + 32 > qrel) s1[e] = -1e30f; }
            }
            float tm = fmaxf(s0[0], s1[0]);
#pragma unroll
            for (int e = 1; e < 16; ++e) tm = fmaxf(tm, fmaxf(s0[e], s1[e]));
            tm = fmaxf(tm, __shfl_xor(tm, 32));
            const float mn = fmaxf(m, tm), al = __builtin_amdgcn_exp2f((m - mn) * ATT_C), mc = mn * ATT_C; m = mn;
            float ps = 0.f;
#pragma unroll
            for (int e = 0; e < 16; ++e) { s0[e] = __builtin_amdgcn_exp2f(s0[e] * ATT_C - mc); s1[e] = __builtin_amdgcn_exp2f(s1[e] * ATT_C - mc); ps += s0[e] + s1[e]; }
            lsum = lsum * al + ps;
#pragma unroll
            for (int e = 0; e < 16; ++e) { o0[e] *= al; o1[e] *= al; }
#pragma unroll
            for (int kb = 0; kb < 2; ++kb)
#pragma unroll
                for (int sp = 0; sp < 2; ++sp) {
                    union { u32x4 u; bf16x8_t v; } pb;
                    if (kb == 0) { pb.u.x = pg8::cvt_pk_bf16(s0[8 * sp + 0], s0[8 * sp + 1]); pb.u.y = pg8::cvt_pk_bf16(s0[8 * sp + 2], s0[8 * sp + 3]); pb.u.z = pg8::cvt_pk_bf16(s0[8 * sp + 4], s0[8 * sp + 5]); pb.u.w = pg8::cvt_pk_bf16(s0[8 * sp + 6], s0[8 * sp + 7]); }
                    else         { pb.u.x = pg8::cvt_pk_bf16(s1[8 * sp + 0], s1[8 * sp + 1]); pb.u.y = pg8::cvt_pk_bf16(s1[8 * sp + 2], s1[8 * sp + 3]); pb.u.z = pg8::cvt_pk_bf16(s1[8 * sp + 4], s1[8 * sp + 5]); pb.u.w = pg8::cvt_pk_bf16(s1[8 * sp + 6], s1[8 * sp + 7]); }
                    const int ko = (32 * kb + 16 * sp) * 2;
                    const bf16x8_t v0 = *(const LAS bf16x8_t*)(st + vOff + ko), v1 = *(const LAS bf16x8_t*)(st + vOff + 32 * ATT_VS + ko);
                    o0 = __builtin_amdgcn_mfma_f32_32x32x16_bf16(v0, pb.v, o0, 0, 0, 0);
                    o1 = __builtin_amdgcn_mfma_f32_32x32x16_bf16(v1, pb.v, o1, 0, 0, 0);
                }
        }
    }
    lsum += __shfl_xor(lsum, 32);
    const float il = 1.0f / lsum;
    const size_t t = trow0 + q0 + r;
#pragma unroll
    for (int db = 0; db < 2; ++db)
#pragma unroll
        for (int g = 0; g < 4; ++g) { const int d0 = 32 * db + 8 * g + 4 * hh;
            const u32x2 gz = *(const u32x2*)(p.H + t * IN_WP + C_ZMLA + h * 64 + d0);
            float v[4];
#pragma unroll
            for (int e = 0; e < 4; ++e) v[e] = (db == 0 ? o0[4 * g + e] : o1[4 * g + e]) * il;
            v[0] *= __uint_as_float(gz.x << 16); v[1] *= __uint_as_float(gz.x & 0xffff0000u); v[2] *= __uint_as_float(gz.y << 16); v[3] *= __uint_as_float(gz.y & 0xffff0000u);
            u32x2 w; w.x = pg8::cvt_pk_bf16(v[0], v[1]); w.y = pg8::cvt_pk_bf16(v[2], v[3]);
            *(u32x2*)(p.yb + t * 512 + h * 64 + d0) = w; }
}
__device__ __forceinline__ void ph_attn_p(const Params& p, LAS unsigned char* lds) {
    int tid = threadIdx.x; asm volatile("" : "+v"(tid));
    const int lane = tid & 63, wave = __builtin_amdgcn_readfirstlane(tid >> 6);
    for (int pi = blockIdx.x; pi < 256; pi += gridDim.x) {
        const int xcd = pi & 7, k = pi >> 3, bh = xcd * 8 + (k >> 2), pr = k & 3;
        attn_unit(p, bh >> 3, bh & 7, 7 - pr, lds, tid, wave, lane);
        attn_unit(p, bh >> 3, bh & 7, pr, lds, tid, wave, lane);
    }
    __syncthreads();
}
struct MEpiVt { static constexpr bool PERM = true, AFTER_DRAIN = false; bf16_t* O; int ldc; int pad_;
    __device__ __forceinline__ void operator()(const f32x4 (&acc)[2][2][4][2], const pg8::Unit& u, int wr, int wc, int fr0, int fq0) const {
        int fr = fr0, fq = fq0; asm volatile("" : "+v"(fr), "+v"(fq));
        const int row0 = u.pm * 256 + wr * 64 + fr;
#pragma unroll
        for (int bj = 0; bj < 2; ++bj) { const int col0 = u.pn * 256 + bj * 128 + wc * 32 + 8 * fq;
#pragma unroll
            for (int ai = 0; ai < 2; ++ai)
#pragma unroll
                for (int m = 0; m < 4; ++m) { const int row = row0 + ai * 128 + m * 16; const f32x4 v0 = acc[ai][bj][m][0], v1 = acc[ai][bj][m][1];
                    u32x4 w; w.x = pg8::cvt_pk_bf16(v0[0], v0[1]); w.y = pg8::cvt_pk_bf16(v0[2], v0[3]); w.z = pg8::cvt_pk_bf16(v1[0], v1[1]); w.w = pg8::cvt_pk_bf16(v1[2], v1[3]);
                    *(u32x4*)(O + (size_t)row * ldc + col0) = w; } }
    } };

__global__ void __launch_bounds__(NTHR, 2) k_mega(Params p) {
    extern __shared__ __attribute__((aligned(16))) unsigned char lds_raw[];
    LAS unsigned char* lds = (LAS unsigned char*)lds_raw;
    volatile LAS unsigned* misc = (volatile LAS unsigned*)(lds + LDS_MISC);
    for (int u = threadIdx.x; u < 64; u += NTHR) misc[u] = 0u;
    __syncthreads();
    const int lo = p.ph_lo, hi = p.ph_hi;
    XcdBarrier bar; bar.bar = p.bar + p.li * XCD_BAR_WORDS; bar.x = 0; bar.st = nullptr;
    if (hi - lo > 1) bar = xcd_barrier_post(p.bar + p.li * XCD_BAR_WORDS, misc + 8);
#define IN(k) (lo <= (k) && (k) < hi)
#define SEAM(k) do { if (IN(k) && IN((k) + 1)) xcd_barrier(bar); } while (0)

    if (IN(PH_PRO)) {
        LAS float* tile = (LAS float*)lds;
        for (int l = 0; l < 2; ++l) {
            ph_tr(p.w_in + (size_t)l * 1024 * IN_W, p.WinT + (size_t)l * IN_WP * 1024, 1024, IN_W, IN_WP, tile, 0);
            ph_tr(p.w_uq + (size_t)l * 384 * 768, p.WuqT + (size_t)l * 768 * 384, 384, 768, 768, tile, 0);
            ph_tr(p.w_uk + (size_t)l * 256 * 512, p.WkvT + (size_t)l * 1024 * 256, 256, 512, 512, tile, 144);
            ph_tr(p.w_uv + (size_t)l * 256 * 512, p.WkvT + (size_t)l * 1024 * 256 + (size_t)512 * 256, 256, 512, 512, tile, 208);
            ph_tr(p.w_br0 + (size_t)l * 512 * 1024, p.WbrT + ((size_t)l * 3 + 0) * 1024 * 512, 512, 1024, 1024, tile, 0);
            ph_tr(p.w_br1 + (size_t)l * 512 * 1024, p.WbrT + ((size_t)l * 3 + 1) * 1024 * 512, 512, 1024, 1024, tile, 0);
            ph_tr(p.w_br2 + (size_t)l * 512 * 1024, p.WbrT + ((size_t)l * 3 + 2) * 1024 * 512, 512, 1024, 1024, tile, 0);
            ph_tr(p.w_out + (size_t)l * 1024 * 1024, p.WoutT + (size_t)l * 1024 * 1024, 1024, 1024, 1024, tile, 0);
        }
        ph_rope_tab(p.tab);
        ph_rmsnorm(p.x_prompt, p.x_sample, p.norm_g, p.xn, nullptr, nullptr);
    }
    SEAM(PH_PRO);
    for (int l = 0; l < 2; ++l) {
        int G = gridDim.x, bid = blockIdx.x; asm volatile("" : "+s"(G), "+s"(bid));
        const float* xp = l == 0 ? p.x_prompt : p.xres; const float* xs = l == 0 ? p.x_sample : p.xres + (size_t)TP * 1024;
        if (IN(PHID(l, PH_GIN))) {
            pg8::Gemm g{p.xn, p.WinT + (size_t)l * IN_WP * 1024, TT, IN_WP, 1024}; pg8::StaticOrder S; S.init(TT, IN_WP, G, bid);
            MEpiH E{p.H, p.BA}; pg8::gemm_phase<MEpiH, pg8::StaticOrder, false>(lds, g, S, E, nullptr);
        }
        SEAM(PHID(l, PH_GIN));
        if (IN(PHID(l, PH_TOK))) ph_tok(p, l, lds);
        SEAM(PHID(l, PH_TOK));
        if (IN(PHID(l, PH_GQ))) {
            { pg8::Gemm g{p.cq, p.WuqT + (size_t)l * 768 * 384, TT, 768, 384}; pg8::StaticOrder S; S.init(TT, 768, G, bid);
              MEpiQ E{p.Q, p.tab}; pg8::gemm_phase<MEpiQ, pg8::StaticOrder, false>(lds, g, S, E, nullptr); }
        }
        if (IN(PHID(l, PH_GQ))) {
            { pg8::Gemm g{p.ckv, p.WkvT + (size_t)l * 1024 * 256, TP, 512, 256}; pg8::StaticOrder S; S.init(TP, 512, G, bid);
              MEpiKV E{p.Kn, p.V}; pg8::gemm_phase<MEpiKV, pg8::StaticOrder, false>(lds, g, S, E, nullptr); }
        }
        if (IN(PHID(l, PH_GQ))) {
            { pg8::Gemm g{p.WkvT + (size_t)l * 1024 * 256 + (size_t)512 * 256, p.ckv, 512, TP, 256}; pg8::StaticOrder S; S.init(512, TP, G, bid);
              MEpiVt E{p.Vt, TP, 0}; pg8::gemm_phase<MEpiVt, pg8::StaticOrder, false>(lds, g, S, E, nullptr); }
        }
        SEAM(PHID(l, PH_GQ));
        if (IN(PHID(l, PH_ATT))) { ph_attn_s(p, l, lds); ph_attn_p(p, lds); ph_att_waves(p, l); }
        SEAM(PHID(l, PH_ATT));
        if (IN(PHID(l, PH_FIN))) ph_fin(p, l, lds);
        SEAM(PHID(l, PH_FIN));
        if (IN(PHID(l, PH_MERGE))) {
            { pg8::Gemm g{p.ya, p.WbrT + ((size_t)l * 3 + 0) * 1024 * 512, TT, 1024, 512}; pg8::StaticOrder S; S.init(TT, 1024, G, bid);
              MEpiMerge<0> E{p.H, p.mf, p.mb}; pg8::gemm_phase<MEpiMerge<0>, pg8::StaticOrder, false>(lds, g, S, E, nullptr); }
            { pg8::Gemm g{p.yb, p.WbrT + ((size_t)l * 3 + 1) * 1024 * 512, TT, 1024, 512}; pg8::StaticOrder S; S.init(TT, 1024, G, bid);
              MEpiMerge<1> E{p.H, p.mf, p.mb}; pg8::gemm_phase<MEpiMerge<1>, pg8::StaticOrder, false>(lds, g, S, E, nullptr); }
            { pg8::Gemm g{p.yc, p.WbrT + ((size_t)l * 3 + 2) * 1024 * 512, TT, 1024, 512}; pg8::StaticOrder S; S.init(TT, 1024, G, bid);
              MEpiMerge<2> E{p.H, p.mf, p.mb}; pg8::gemm_phase<MEpiMerge<2>, pg8::StaticOrder, false>(lds, g, S, E, nullptr); }
        }
        SEAM(PHID(l, PH_MERGE));
        if (IN(PHID(l, PH_OUT))) {
            pg8::Gemm g{p.mb, p.WoutT + (size_t)l * 1024 * 1024, TT, 1024, 1024}; pg8::StaticOrder S; S.init(TT, 1024, G, bid);
            MEpiRes E{xp, xs, p.xres}; pg8::gemm_phase<MEpiRes, pg8::StaticOrder, false>(lds, g, S, E, nullptr);
        }
        SEAM(PHID(l, PH_OUT));
        if (IN(PHID(l, PH_NORM))) {
            if (l == 0) ph_rmsnorm(p.xres, p.xres + (size_t)TP * 1024, p.norm_g + 1024, p.xn, nullptr, nullptr);
            else ph_rmsnorm(p.xres, p.xres + (size_t)TP * 1024, p.final_norm_g, nullptr, p.out + O_YP, p.out + O_YS);
        }
        SEAM(PHID(l, PH_NORM));
    }
#undef IN
#undef SEAM
}

static inline size_t al256(size_t x) { return (x + 255) & ~(size_t)255; }
extern "C" void kernel_launch(void* const* d_in, const int* in_sizes, int n_in, void* d_out, int out_size, void* d_ws, size_t ws_size, hipStream_t stream) {
    static int grid = 0;
    if (grid == 0) {
        int dev = 0, cus = 0; (void)hipGetDevice(&dev); (void)hipDeviceGetAttribute(&cus, hipDeviceAttributeMultiprocessorCount, dev);
        (void)hipFuncSetAttribute((const void*)k_mega, hipFuncAttributeMaxDynamicSharedMemorySize, LDS_BYTES);
        int per_cu = 0; (void)hipOccupancyMaxActiveBlocksPerMultiprocessor(&per_cu, (const void*)k_mega, NTHR, LDS_BYTES); (void)hipGetLastError();
        grid = cus > 0 ? cus : 256;
    }
    Params p{};
    p.x_prompt = (const float*)d_in[0]; p.x_sample = (const float*)d_in[1]; p.cache_kv = (const float*)d_in[2]; p.cache_kr = (const float*)d_in[3];
    p.state_pool = (const float*)d_in[4]; p.state_conv = (const float*)d_in[5]; p.state_delta = (const float*)d_in[6]; p.page_table = (const int*)d_in[7];
    p.norm_g = (const float*)d_in[8]; p.w_in = (const float*)d_in[9]; p.pool_mix = (const float*)d_in[10]; p.pool_scale = (const float*)d_in[11];
    p.q_norm_g = (const float*)d_in[12]; p.w_uq = (const float*)d_in[13]; p.kv_norm_g = (const float*)d_in[14]; p.w_uk = (const float*)d_in[15];
    p.w_uv = (const float*)d_in[16]; p.conv_w = (const float*)d_in[17]; p.a_log = (const float*)d_in[18]; p.dt_bias = (const float*)d_in[19];
    p.dn_norm_g = (const float*)d_in[20]; p.w_br0 = (const float*)d_in[21]; p.w_br1 = (const float*)d_in[22]; p.w_br2 = (const float*)d_in[23];
    p.w_out = (const float*)d_in[24]; p.final_norm_g = (const float*)d_in[25];
    p.out = (float*)d_out;
    char* w = (char*)d_ws; size_t off = 0;
    auto take = [&](size_t bytes) { char* q = w + off; off += al256(bytes); return q; };
    const size_t BAR_BYTES = (size_t)16 * XCD_BAR_WORDS * 4;
    p.bar = (unsigned*)take(BAR_BYTES);
    p.WinT = (bf16_t*)take((size_t)2 * IN_WP * 1024 * 2);
    p.WuqT = (bf16_t*)take((size_t)2 * 768 * 384 * 2);
    p.WkvT = (bf16_t*)take((size_t)2 * 1024 * 256 * 2);
    p.WbrT = (bf16_t*)take((size_t)2 * 3 * 1024 * 512 * 2);
    p.WoutT = (bf16_t*)take((size_t)2 * 1024 * 1024 * 2);
    p.tab = (float2*)take((size_t)(SEQ + DEC_SEQ) * 16 * 8);
    p.xres = (float*)take((size_t)TT * 1024 * 4);
    p.xn = (bf16_t*)take((size_t)TT * 1024 * 2);
    p.H = (bf16_t*)take((size_t)TT * IN_WP * 2);
    p.BA = (float*)take((size_t)TT * 16 * 4);
    p.cq = (bf16_t*)take((size_t)TT * 384 * 2);
    p.ckv = (bf16_t*)take((size_t)TT * 256 * 2);
    p.Kr = (bf16_t*)take((size_t)TT * 32 * 2);
    p.Q = (bf16_t*)take((size_t)TT * 768 * 2);
    bf16_t* Qlat = (bf16_t*)take((size_t)TS * 8 * 288 * 2);
    p.Kn = (bf16_t*)take((size_t)TP * 512 * 2);
    p.V = (bf16_t*)take((size_t)TP * 512 * 2);
    p.Vt = (bf16_t*)take((size_t)512 * TP * 2);
    p.qd = (bf16_t*)take((size_t)TT * 512 * 2);
    p.kd = (bf16_t*)take((size_t)TT * 512 * 2);
    p.vd = (bf16_t*)take((size_t)TT * 512 * 2);
    p.bg = (float*)take((size_t)TT * 16 * 4);
    p.ya = (bf16_t*)take((size_t)TT * 512 * 2);
    p.yb = (bf16_t*)take((size_t)TT * 512 * 2);
    p.yc = (bf16_t*)take((size_t)TT * 512 * 2);
    p.mf = (float*)take((size_t)TT * 1024 * 4);
    p.mb = (bf16_t*)take((size_t)TT * 1024 * 2);
    p.part = (float*)take((size_t)DEC_BATCH * SA_CH * 64 * 258 * 4);

    (void)hipMemsetAsync(p.bar, 0, BAR_BYTES, stream);
    p.ph_lo = 0; p.ph_hi = PH_END; p.li = 0; p.pad = 0;
    hipLaunchKernelGGL(k_mega, dim3(grid), dim3(NTHR), LDS_BYTES, stream, p);
}
```

```cpp
#include <hip/hip_runtime.h>
#include <stdint.h>

typedef unsigned short bf16_t;

#define D_MODEL 1024
#define TP 16384
#define TS 256
#define TT (TP + TS)
#define SEQ 2048
#define DEC_SEQ 8
#define DEC_BATCH 32
#define PAST_LEN 16384
#define PAGE 128
#define N_PAGES 128
#define N_POOL 5120
#define IN_W 7344
#define IN_WP 7424
#define C_POOL 0
#define C_ZPOOL 512
#define C_Q 1024
#define C_KV 1408
#define C_KR 1664
#define C_ZMLA 1696
#define C_QKV 2208
#define C_ZDN 3744
#define C_BETA 4256
#define C_ALPHA 4264
#define C_GATE 4272
#define EPS 1e-6f
#define MLA_SCALE 0.10206207261596577f

#define O_YP 0
#define O_YS (O_YP + 16777216)
#define O_PKV (O_YS + 262144)
#define O_PKR (O_PKV + 8388608)
#define O_PPOOL (O_PKR + 1048576)
#define O_PCONV (O_PPOOL + 122880)
#define O_PDELTA (O_PCONV + 73728)
#define O_SKV (O_PDELTA + 524288)
#define O_SKR (O_SKV + 131072)
#define O_SPOOL (O_SKR + 16384)
#define O_SCONV (O_SPOOL + 491520)
#define O_SDELTA (O_SCONV + 294912)
#define O_END (O_SDELTA + 2097152)

__device__ __forceinline__ float bf2f(bf16_t b) { return __uint_as_float(((unsigned)b) << 16); }
__device__ __forceinline__ bf16_t f2bf(float f) { unsigned u = __float_as_uint(f); u += 0x7FFFu + ((u >> 16) & 1u); return (bf16_t)(u >> 16); }
__device__ __forceinline__ float sigmoidf_(float v) { return 1.0f / (1.0f + __expf(-v)); }
__device__ __forceinline__ float siluf_(float v) { return v / (1.0f + __expf(-v)); }
__device__ __forceinline__ float wave_sum(float v) {
#pragma unroll
    for (int o = 32; o >= 1; o >>= 1) v += __shfl_xor(v, o);
    return v;
}

__global__ void k_tr(const float* __restrict__ src, bf16_t* __restrict__ dst, int K, int N, int Npad, int pad_) {
    __shared__ float tile[32][33];
    const int n0 = blockIdx.x * 32, k0 = blockIdx.y * 32, tx = threadIdx.x & 31, ty = threadIdx.x >> 5;
    for (int i = ty; i < 32; i += 8) { const int k = k0 + i, n = n0 + tx; tile[i][tx] = (n < N) ? src[(size_t)k * N + n] : 0.f; }
    __syncthreads();
    for (int i = ty; i < 32; i += 8) { const int n = n0 + i, k = k0 + tx; if (n < Npad) dst[(size_t)n * K + k] = f2bf(tile[tx][i]); }
}
__global__ void k_rope_tab(float2* tab) {
    const int idx = blockIdx.x * blockDim.x + threadIdx.x; if (idx >= (SEQ + DEC_SEQ) * 16) return;
    const int p = idx >> 4, i = idx & 15; const int pos = p < SEQ ? p : PAST_LEN + (p - SEQ);
    const float inv = powf(10000.0f, -(float)i / 16.0f);
    const float ang = (float)pos * inv;
    const double rev = (double)ang * 0.15915494309189533576888; const double fr = rev - floor(rev);
    const float f = (float)fr;
    tab[idx] = make_float2(__builtin_amdgcn_cosf(f), __builtin_amdgcn_sinf(f));
}

__global__ void k_rmsnorm(const float* __restrict__ xp, const float* __restrict__ xs, const float* __restrict__ g, bf16_t* __restrict__ xn, float* __restrict__ yp, float* __restrict__ ys) {
    const int t = blockIdx.x; const float* x = t < TP ? xp + (size_t)t * D_MODEL : xs + (size_t)(t - TP) * D_MODEL;
    __shared__ float red[4];
    float v[4]; float ss = 0.f;
#pragma unroll
    for (int i = 0; i < 4; ++i) { v[i] = x[threadIdx.x + 256 * i]; ss += v[i] * v[i]; }
    ss = wave_sum(ss); if ((threadIdx.x & 63) == 0) red[threadIdx.x >> 6] = ss; __syncthreads();
    const float tot = red[0] + red[1] + red[2] + red[3]; const float r = rsqrtf(tot * (1.0f / D_MODEL) + EPS);
#pragma unroll
    for (int i = 0; i < 4; ++i) { const int c = threadIdx.x + 256 * i; const float o = v[i] * r * g[c];
        if (xn) xn[(size_t)t * D_MODEL + c] = f2bf(o);
        else { if (t < TP) yp[(size_t)t * D_MODEL + c] = o; else ys[(size_t)(t - TP) * D_MODEL + c] = o; } }
}

template <class Epi> __global__ void k_gemm(const bf16_t* __restrict__ A, const bf16_t* __restrict__ Bt, int lda, int ldb, int M, int N, int K, int pad_, Epi epi) {
    __shared__ float As[16][68], Bs[16][68];
    const int tm = blockIdx.y * 64, tn = blockIdx.x * 64, tx = threadIdx.x & 15, ty = threadIdx.x >> 4;
    float acc[4][4];
#pragma unroll
    for (int i = 0; i < 4; ++i)
#pragma unroll
        for (int j = 0; j < 4; ++j) acc[i][j] = 0.f;
    for (int k0 = 0; k0 < K; k0 += 16) {
        for (int i = threadIdx.x; i < 1024; i += 256) { const int r = i >> 4, c = i & 15;
            As[c][r] = (tm + r < M) ? bf2f(A[(size_t)(tm + r) * lda + k0 + c]) : 0.f;
            Bs[c][r] = (tn + r < N) ? bf2f(Bt[(size_t)(tn + r) * ldb + k0 + c]) : 0.f; }
        __syncthreads();
#pragma unroll
        for (int kk = 0; kk < 16; ++kk) { float a[4], b[4];
#pragma unroll
            for (int i = 0; i < 4; ++i) { a[i] = As[kk][ty * 4 + i]; b[i] = Bs[kk][tx * 4 + i]; }
#pragma unroll
            for (int i = 0; i < 4; ++i)
#pragma unroll
                for (int j = 0; j < 4; ++j) acc[i][j] += a[i] * b[j]; }
        __syncthreads();
    }
#pragma unroll
    for (int i = 0; i < 4; ++i)
#pragma unroll
        for (int j = 0; j < 4; ++j) { const int m = tm + ty * 4 + i, n = tn + tx * 4 + j; if (m < M && n < N) epi(m, n, acc[i][j]); }
}
struct EpiH { bf16_t* H; float* BA;
    __device__ void operator()(int t, int n, float v) const {
        if (n >= C_BETA && n < C_GATE) BA[(size_t)t * 16 + (n - C_BETA)] = v;
        float o = v;
        if ((n >= C_ZPOOL && n < C_Q) || (n >= C_ZMLA && n < C_QKV) || (n >= C_ZDN && n < C_BETA)) o = siluf_(v);
        else if (n >= C_GATE) o = sigmoidf_(v);
        H[(size_t)t * IN_WP + n] = f2bf(o); } };
struct EpiF32 { float* C; int ldc; int pad_; __device__ void operator()(int t, int n, float v) const { C[(size_t)t * ldc + n] = v; } };
struct EpiKV { bf16_t* Kn; bf16_t* V; __device__ void operator()(int t, int n, float v) const { if (n < 512) Kn[(size_t)t * 512 + n] = f2bf(v); else V[(size_t)t * 512 + (n - 512)] = f2bf(v); } };
struct EpiMerge { const bf16_t* H; float* mf; bf16_t* mb; int br; int pad_;
    __device__ void operator()(int t, int n, float v) const { const float g = bf2f(H[(size_t)t * IN_WP + C_GATE + br * 1024 + n]); float o = g * v; const size_t i = (size_t)t * 1024 + n;
        if (br > 0) o += mf[i]; mf[i] = o; if (br == 2) mb[i] = f2bf(o); } };
struct EpiRes { const float* xp; const float* xs; float* xo;
    __device__ void operator()(int t, int n, float v) const { const float x = t < TP ? xp[(size_t)t * 1024 + n] : xs[(size_t)(t - TP) * 1024 + n]; xo[(size_t)t * 1024 + n] = x + v; } };

__global__ void k_tok_a(const bf16_t* __restrict__ H, const float* __restrict__ qg, const float* __restrict__ kvg, const float2* __restrict__ tab,
                        bf16_t* __restrict__ cq, bf16_t* __restrict__ ckv, bf16_t* __restrict__ Kr, float* __restrict__ out, int layer, int pad_) {
    const int t = blockIdx.x, lane = threadIdx.x; const bf16_t* h = H + (size_t)t * IN_WP;
    float q[6]; float ss = 0.f;
#pragma unroll
    for (int i = 0; i < 6; ++i) { q[i] = bf2f(h[C_Q + lane + 64 * i]); ss += q[i] * q[i]; }
    ss = wave_sum(ss); float r = rsqrtf(ss * (1.0f / 384.0f) + EPS);
#pragma unroll
    for (int i = 0; i < 6; ++i) cq[(size_t)t * 384 + lane + 64 * i] = f2bf(q[i] * r * qg[lane + 64 * i]);
    float kv[4]; ss = 0.f;
#pragma unroll
    for (int i = 0; i < 4; ++i) { kv[i] = bf2f(h[C_KV + lane + 64 * i]); ss += kv[i] * kv[i]; }
    ss = wave_sum(ss); r = rsqrtf(ss * (1.0f / 256.0f) + EPS);
    float* okv; float* okr; int p;
    if (t < TP) { okv = out + O_PKV + ((size_t)layer * TP + t) * 256; okr = out + O_PKR + ((size_t)layer * TP + t) * 32; p = t & (SEQ - 1); }
    else { const int ts = t - TP; okv = out + O_SKV + ((size_t)layer * TS + ts) * 256; okr = out + O_SKR + ((size_t)layer * TS + ts) * 32; p = SEQ + (ts & 7); }
#pragma unroll
    for (int i = 0; i < 4; ++i) { const float o = kv[i] * r * kvg[lane + 64 * i]; okv[lane + 64 * i] = o; ckv[(size_t)t * 256 + lane + 64 * i] = f2bf(o); }
    if (lane < 16) { const float x1 = bf2f(h[C_KR + lane]), x2 = bf2f(h[C_KR + 16 + lane]); const float2 cs = tab[p * 16 + lane];
        const float o1 = x1 * cs.x - x2 * cs.y, o2 = x2 * cs.x + x1 * cs.y;
        okr[lane] = o1; okr[16 + lane] = o2; Kr[(size_t)t * 32 + lane] = f2bf(o1); Kr[(size_t)t * 32 + 16 + lane] = f2bf(o2); }
}

__global__ void k_tok_conv(const bf16_t* __restrict__ H, const float* __restrict__ BA, const float* __restrict__ conv_w, const float* __restrict__ state_conv,
                           const float* __restrict__ a_log, const float* __restrict__ dt_bias, bf16_t* __restrict__ qd, bf16_t* __restrict__ kd, bf16_t* __restrict__ vd,
                           float* __restrict__ bg, float* __restrict__ out, int layer, int pad_) {
    const int t = blockIdx.x, tid = threadIdx.x;
    int i_seq, row0; const float* sc = nullptr;
    if (t < TP) { i_seq = t & (SEQ - 1); row0 = t - i_seq; }
    else { const int ts = t - TP; i_seq = ts & 7; row0 = t - i_seq; sc = state_conv + ((size_t)layer * DEC_BATCH + (ts >> 3)) * 3 * 1536; }
#pragma unroll
    for (int i = 0; i < 6; ++i) {
        const int c = tid + 256 * i; float y = 0.f;
#pragma unroll
        for (int j = 0; j < 4; ++j) { const int u = i_seq - 3 + j; float xv;
            if (u >= 0) xv = bf2f(H[(size_t)(row0 + u) * IN_WP + C_QKV + c]); else xv = sc ? sc[(size_t)(u + 3) * 1536 + c] : 0.f;
            y += xv * conv_w[j * 1536 + c]; }
        float v = siluf_(y);
        if (i < 4) { const float ss = wave_sum(v * v); v *= rsqrtf(ss + EPS); if (i < 2) v *= 0.125f; }
        const bf16_t o = f2bf(v);
        if (i < 2) qd[(size_t)t * 512 + c] = o; else if (i < 4) kd[(size_t)t * 512 + (c - 512)] = o; else vd[(size_t)t * 512 + (c - 1024)] = o;
        if (t < TP) { if (i_seq >= SEQ - 3) out[O_PCONV + (((size_t)layer * 8 + (t >> 11)) * 3 + (i_seq - (SEQ - 3))) * 1536 + c] = bf2f(H[(size_t)t * IN_WP + C_QKV + c]); }
        else { if (i_seq >= DEC_SEQ - 3) out[O_SCONV + (((size_t)layer * DEC_BATCH + ((t - TP) >> 3)) * 3 + (i_seq - (DEC_SEQ - 3))) * 1536 + c] = bf2f(H[(size_t)t * IN_WP + C_QKV + c]); }
    }
    if (tid < 8) { const float b = sigmoidf_(BA[(size_t)t * 16 + tid]); const float x = BA[(size_t)t * 16 + 8 + tid] + dt_bias[tid];
        const float sp = x > 20.f ? x : log1pf(expf(x)); const float g = -expf(a_log[tid]) * sp;
        bg[(size_t)t * 16 + tid] = b; bg[(size_t)t * 16 + 8 + tid] = g; }
}

__global__ void k_pool(const bf16_t* __restrict__ H, const float* __restrict__ state_pool, const float* __restrict__ mix, const float* __restrict__ scale,
                       bf16_t* __restrict__ ya, float* __restrict__ out, int layer, int pad_) {
    const int t = blockIdx.x, g = blockIdx.y, c = threadIdx.x, ch = g * 128 + c; const int w = 2 << g;
    __shared__ float d[128];
    int i_seq, row0; const float* sp = nullptr;
    if (t < TP) { i_seq = t & (SEQ - 1); row0 = t - i_seq; }
    else { const int ts = t - TP; i_seq = ts & 7; row0 = t - i_seq; sp = state_pool + ((size_t)layer * DEC_BATCH + (ts >> 3)) * 15 * 512; }
    float sum = 0.f;
    for (int k = 0; k < w; ++k) { const int u = i_seq - k; float xv;
        if (u >= 0) xv = bf2f(H[(size_t)(row0 + u) * IN_WP + C_POOL + ch]); else xv = sp ? sp[(size_t)(15 + u) * 512 + ch] : 0.f;
        sum += xv; }
    const float cur = bf2f(H[(size_t)t * IN_WP + C_POOL + ch]);
    const float cnt = t < TP ? (float)min(i_seq + 1, w) : (float)w;
    d[c] = sum / cnt - cur;
    __syncthreads();
    float y = 0.f; const float* m = mix + ((size_t)layer * 4 + g) * 128 * 128;
    for (int k = 0; k < 128; ++k) y += d[k] * m[k * 128 + c];
    y *= scale[layer * 512 + ch];
    y *= bf2f(H[(size_t)t * IN_WP + C_ZPOOL + ch]);
    ya[(size_t)t * 512 + ch] = f2bf(y);
    if (t < TP) { if (i_seq >= SEQ - 15) out[O_PPOOL + (((size_t)layer * 8 + (t >> 11)) * 15 + (i_seq - (SEQ - 15))) * 512 + ch] = cur; }
    else { const int s = (t - TP) >> 3; float* o = out + O_SPOOL + ((size_t)layer * DEC_BATCH + s) * 15 * 512;
        o[(size_t)(7 + i_seq) * 512 + ch] = cur;
        if (i_seq < 7) o[(size_t)i_seq * 512 + ch] = sp[(size_t)(8 + i_seq) * 512 + ch]; }
}

__global__ void k_qrope(const float* __restrict__ Qf, const float2* __restrict__ tab, bf16_t* __restrict__ Q) {
    const int t = blockIdx.x, tid = threadIdx.x;
    const int h = tid >> 5, j = tid & 31; const float* q = Qf + (size_t)t * 768 + h * 96; bf16_t* o = Q + (size_t)t * 768 + h * 96;
    o[j] = f2bf(q[j]); o[32 + j] = f2bf(q[32 + j]);
    const int p = t < TP ? (t & (SEQ - 1)) : SEQ + ((t - TP) & 7);
    if (j < 16) { const float x1 = q[64 + j], x2 = q[80 + j]; const float2 cs = tab[p * 16 + j]; o[64 + j] = f2bf(x1 * cs.x - x2 * cs.y); o[80 + j] = f2bf(x2 * cs.x + x1 * cs.y); }
}
__global__ void k_qlat(const bf16_t* __restrict__ Q, const float* __restrict__ w_uk, bf16_t* __restrict__ Qlat) {
    const int ts = blockIdx.x, h = blockIdx.y, c = threadIdx.x;
    const bf16_t* q = Q + (size_t)(TP + ts) * 768 + h * 96; float acc = 0.f;
    for (int d = 0; d < 64; ++d) acc += bf2f(q[d]) * w_uk[(size_t)c * 512 + h * 64 + d];
    bf16_t* o = Qlat + ((size_t)ts * 8 + h) * 288; o[c] = f2bf(acc); if (c < 32) o[256 + c] = q[64 + c];
}

__global__ void __launch_bounds__(64) k_attn_p(const bf16_t* __restrict__ Q, const bf16_t* __restrict__ Kn, const bf16_t* __restrict__ Kr, const bf16_t* __restrict__ V,
                                               const bf16_t* __restrict__ H, bf16_t* __restrict__ yb) {
    const int qb = blockIdx.x, h = blockIdx.y, b = blockIdx.z, lane = threadIdx.x; const int i = qb * 64 + lane, t = b * SEQ + i;
    float q[96];
#pragma unroll
    for (int d = 0; d < 96; ++d) q[d] = bf2f(Q[(size_t)t * 768 + h * 96 + d]) * MLA_SCALE;
    float o[64];
#pragma unroll
    for (int d = 0; d < 64; ++d) o[d] = 0.f;
    float m = -1e30f, l = 0.f;
    const int jmax = qb * 64 + 63;
    for (int j = 0; j <= jmax; ++j) {
        const size_t tk = (size_t)b * SEQ + j; const bf16_t* kn = Kn + tk * 512 + h * 64; const bf16_t* kr = Kr + tk * 32; const bf16_t* vv = V + tk * 512 + h * 64;
        float s = 0.f;
#pragma unroll
        for (int d = 0; d < 64; ++d) s += q[d] * bf2f(kn[d]);
#pragma unroll
        for (int d = 0; d < 32; ++d) s += q[64 + d] * bf2f(kr[d]);
        if (j <= i) {
            const float mn = fmaxf(m, s), al = __expf(m - mn), p = __expf(s - mn); l = l * al + p; m = mn;
#pragma unroll
            for (int d = 0; d < 64; ++d) o[d] = o[d] * al + p * bf2f(vv[d]);
        }
    }
    const float il = 1.0f / l;
#pragma unroll
    for (int d = 0; d < 64; ++d) yb[(size_t)t * 512 + h * 64 + d] = f2bf(o[d] * il * bf2f(H[(size_t)t * IN_WP + C_ZMLA + h * 64 + d]));
}

#define SA_CH 33
__global__ void __launch_bounds__(256) k_attn_s(const bf16_t* __restrict__ Qlat, const float* __restrict__ ckv_cache, const float* __restrict__ kr_cache, const int* __restrict__ page_table,
                                                const bf16_t* __restrict__ ckv_new, const bf16_t* __restrict__ kr_new, float* __restrict__ part, int layer, int pad_) {
    const int s = blockIdx.x, ch = blockIdx.y, tid = threadIdx.x, r = tid & 63, cq = tid >> 6;
    __shared__ bf16_t Ks[32][296];
    __shared__ float Ss[64][33];
    __shared__ bf16_t Qs[64][290];
    for (int i = tid; i < 64 * 288; i += 256) { const int rr = i / 288, c = i % 288; Qs[rr][c] = Qlat[((size_t)s * 64 + rr) * 288 + c]; }
    float o[64];
#pragma unroll
    for (int d = 0; d < 64; ++d) o[d] = 0.f;
    float m = -1e30f, l = 0.f;
    const int i_tok = r >> 3;
    const int ntile = ch < 32 ? 16 : 1;
    for (int tl = 0; tl < ntile; ++tl) {
        __syncthreads();
        if (ch < 32) { const int j0 = ch * 512 + tl * 32; const int page = page_table[s * N_PAGES + (j0 >> 7)]; const int prow = j0 & 127;
            const float* kvp = ckv_cache + (((size_t)layer * N_POOL + page) * PAGE + prow) * 256; const float* krp = kr_cache + (((size_t)layer * N_POOL + page) * PAGE + prow) * 32;
            for (int i = tid; i < 32 * 256; i += 256) Ks[i >> 8][i & 255] = f2bf(kvp[i]);
            for (int i = tid; i < 32 * 32; i += 256) Ks[i >> 5][256 + (i & 31)] = f2bf(krp[i]);
        } else {
            for (int i = tid; i < 32 * 256; i += 256) { const int k = i >> 8; Ks[k][i & 255] = k < 8 ? ckv_new[((size_t)TP + s * 8 + k) * 256 + (i & 255)] : (bf16_t)0; }
            for (int i = tid; i < 32 * 32; i += 256) { const int k = i >> 5; Ks[k][256 + (i & 31)] = k < 8 ? kr_new[((size_t)TP + s * 8 + k) * 32 + (i & 31)] : (bf16_t)0; }
        }
        __syncthreads();
#pragma unroll
        for (int kk = 0; kk < 8; ++kk) { const int k = cq * 8 + kk; float sc = 0.f;
            for (int c = 0; c < 288; ++c) sc += bf2f(Qs[r][c]) * bf2f(Ks[k][c]);
            sc *= MLA_SCALE; if (ch == 32 && k > i_tok) sc = -1e30f; Ss[r][k] = sc; }
        __syncthreads();
        float tm = -1e30f;
        for (int k = 0; k < 32; ++k) tm = fmaxf(tm, Ss[r][k]);
        const float mn = fmaxf(m, tm), al = __expf(m - mn); m = mn; l *= al;
#pragma unroll
        for (int d = 0; d < 64; ++d) o[d] *= al;
        for (int k = 0; k < 32; ++k) { const float sc = Ss[r][k]; const float p = sc <= -1e29f ? 0.f : __expf(sc - mn); l += p;
#pragma unroll
            for (int d = 0; d < 64; ++d) o[d] += p * bf2f(Ks[k][cq * 64 + d]); }
    }
    float* pp = part + (((size_t)s * SA_CH + ch) * 64 + r) * 258;
#pragma unroll
    for (int d = 0; d < 64; ++d) pp[cq * 64 + d] = o[d];
    if (cq == 0) { pp[256] = m; pp[257] = l; }
}
__global__ void k_attn_s_fin(const float* __restrict__ part, const float* __restrict__ w_uv, const bf16_t* __restrict__ H, bf16_t* __restrict__ yb) {
    const int ts = blockIdx.x, h = blockIdx.y, d = threadIdx.x; const int s = ts >> 3, r = (ts & 7) * 8 + h;
    __shared__ float ol[256]; __shared__ float wgt[SA_CH];
    float M = -1e30f;
    for (int ch = 0; ch < SA_CH; ++ch) M = fmaxf(M, part[(((size_t)s * SA_CH + ch) * 64 + r) * 258 + 256]);
    float L = 0.f;
    for (int ch = 0; ch < SA_CH; ++ch) { const float* pp = part + (((size_t)s * SA_CH + ch) * 64 + r) * 258; const float w = __expf(pp[256] - M); L += pp[257] * w; if (d == 0) wgt[ch] = w; }
    __syncthreads();
    for (int c = d; c < 256; c += 64) { float a = 0.f; for (int ch = 0; ch < SA_CH; ++ch) a += wgt[ch] * part[(((size_t)s * SA_CH + ch) * 64 + r) * 258 + c]; ol[c] = a / L; }
    __syncthreads();
    float a = 0.f;
    for (int c = 0; c < 256; ++c) a += ol[c] * w_uv[(size_t)c * 512 + h * 64 + d];
    const int t = TP + ts;
    yb[(size_t)t * 512 + h * 64 + d] = f2bf(a * bf2f(H[(size_t)t * IN_WP + C_ZMLA + h * 64 + d]));
}

__global__ void __launch_bounds__(64) k_delta(const bf16_t* __restrict__ qd, const bf16_t* __restrict__ kd, const bf16_t* __restrict__ vd, const float* __restrict__ bg,
                                              const float* __restrict__ state_delta, const float* __restrict__ dn_g, const bf16_t* __restrict__ H, bf16_t* __restrict__ yc,
                                              float* __restrict__ out, int layer, int pad_) {
    const int sq = blockIdx.x, h = blockIdx.y, dv = threadIdx.x;
    int row0, L; float* so; float S[64];
    if (sq < 8) { row0 = sq * SEQ; L = SEQ; so = out + O_PDELTA + (((size_t)layer * 8 + sq) * 8 + h) * 4096;
#pragma unroll
        for (int k = 0; k < 64; ++k) S[k] = 0.f; }
    else { const int s = sq - 8; row0 = TP + s * 8; L = DEC_SEQ; so = out + O_SDELTA + (((size_t)layer * DEC_BATCH + s) * 8 + h) * 4096;
        const float* s0 = state_delta + (((size_t)layer * DEC_BATCH + s) * 8 + h) * 4096;
#pragma unroll
        for (int k = 0; k < 64; ++k) S[k] = s0[k * 64 + dv]; }
    const float gn = dn_g[layer * 64 + dv];
    for (int i = 0; i < L; ++i) {
        const size_t t = (size_t)row0 + i; const bf16_t* kp = kd + t * 512 + h * 64; const bf16_t* qp = qd + t * 512 + h * 64;
        const float b = bg[t * 16 + h], a = __expf(bg[t * 16 + 8 + h]); const float v = bf2f(vd[t * 512 + h * 64 + dv]);
        float ks = 0.f;
#pragma unroll
        for (int k = 0; k < 64; ++k) ks += bf2f(kp[k]) * S[k];
        const float vn = b * (v - a * ks);
        float o = 0.f;
#pragma unroll
        for (int k = 0; k < 64; ++k) { S[k] = a * S[k] + bf2f(kp[k]) * vn; o += bf2f(qp[k]) * S[k]; }
        const float ss = wave_sum(o * o); const float y = o * rsqrtf(ss * (1.0f / 64.0f) + EPS) * gn;
        yc[t * 512 + h * 64 + dv] = f2bf(y * bf2f(H[t * IN_WP + C_ZDN + h * 64 + dv]));
    }
#pragma unroll
    for (int k = 0; k < 64; ++k) so[k * 64 + dv] = S[k];
}

namespace pg8 {
#define PG8_LAS __attribute__((address_space(3)))
typedef unsigned short bf16_t;
typedef short bf16x8 __attribute__((ext_vector_type(8)));
typedef float f32x4 __attribute__((ext_vector_type(4)));
typedef unsigned u32x4 __attribute__((ext_vector_type(4)));
constexpr int BM = 256, BK = 64, HALF = 128, HTB = HALF * BK * 2  , STAGE_BYTES = 8 * HTB, NXCD = 8, WGM = 8;

__host__ __device__ __forceinline__ int lds_byte(int r, int c) { const int st = (r >> 4) * 2 + (c >> 5), rr = r & 15, cc = c & 31, ob = rr * 64 + cc * 2; return st * 1024 + (ob ^ (((ob >> 9) & 1) << 5)); }
__host__ __device__ __forceinline__ void stage_rc(int b, int& R, int& C) { const int st = b / 1024, sb = b % 1024, swz = sb ^ (((sb >> 9) & 1) << 5); R = (st >> 1) * 16 + swz / 64; C = (st & 1) * 32 + (swz % 64) / 2; }
__host__ __device__ __forceinline__ int perm32(int rho) { const int n = rho >> 4, i = rho & 15; return 8 * (i >> 2) + 4 * n + (i & 3); }

struct Unit { int pm, pn; };
struct Gemm { const bf16_t* A; const bf16_t* Bt; int M, N, K; };

struct StaticOrder {
    int nM, nN, nwg, G, c;
    __host__ __device__ void init(int M, int N, int G_, int c_) { nM = M / BM; nN = N / BM; nwg = nM * nN; G = G_; c = c_; }
    __host__ __device__ bool next(int i, Unit& u) const {
        const long L = (long)i * G + c; if (L >= nwg) return false;
        int wgid = (int)L; { const int q = nwg / NXCD, r = nwg % NXCD, xcd = wgid % NXCD, off = wgid / NXCD; wgid = (xcd < r ? xcd * (q + 1) : r * (q + 1) + (xcd - r) * q) + off; }
        const int nig = WGM * nN, gid = wgid / nig, fm = gid * WGM, gsz = (nM - fm) < WGM ? (nM - fm) : WGM;
        u.pm = fm + ((wgid % nig) % gsz); u.pn = (wgid % nig) / gsz; return true;
    }
    __device__ __forceinline__ void a_ready(const Unit&) const {}
    __device__ __forceinline__ void done(const Unit&) const {}
};
typedef __bf16 bf16n2 __attribute__((ext_vector_type(2)));
__device__ __forceinline__ unsigned cvt_pk_bf16(float lo, float hi) { typedef float f2_ __attribute__((ext_vector_type(2))); const f2_ v = {lo, hi}; return __builtin_bit_cast(unsigned, __builtin_convertvector(v, bf16n2)); }
typedef float f32x2 __attribute__((ext_vector_type(2)));
template <class Epi, class Sched, bool STAMP = false>
__device__ __forceinline__ void gemm_phase(PG8_LAS unsigned char* lds, const Gemm g, const Sched& S, const Epi& E, unsigned long long* stamps) {
    int tid_ = threadIdx.x; asm volatile("" : "+v"(tid_));
    const int tid = tid_, wid = __builtin_amdgcn_readfirstlane(tid >> 6), lane = tid & 63, wr = wid >> 2, wc = wid & 3, fr = lane & 15, fq = lane >> 4;
    int K_ = g.K; asm volatile("" : "+s"(K_));
    const int K = K_, nt = K / BK;
    int ts_lo = 0, ts_hi = 0, nts = 0; const unsigned long long rt_entry = STAMP ? (unsigned long long)wall_clock64() : 0ull;
#define PG8_STAMP() do { if (STAMP && wid == 0 && nts < 64) { const unsigned long long _c = (unsigned long long)clock64(); \
        ts_lo = (lane == nts) ? (int)(unsigned)_c : ts_lo; ts_hi = (lane == nts) ? (int)(unsigned)(_c >> 32) : ts_hi; ++nts; } } while (0)
    PG8_STAMP();
    unsigned voffA[2], voffB[2];
#pragma unroll
    for (int i = 0; i < 2; ++i) { int R, C; stage_rc(tid * 16 + i * 8192, R, C); const int Rb = Epi::PERM ? ((R & ~31) + perm32(R & 31)) : R;
        voffA[i] = (unsigned)(R * K + C) * 2u; voffB[i] = (unsigned)(Rb * K + C) * 2u; }
    const size_t kstep = (size_t)(BK * 2);
    const size_t hstep = (size_t)HALF * K * 2;
    const size_t tstep = 2 * hstep;
    const unsigned ldsw = (unsigned)wid * 1024u;
    const int aoff = lds_byte(wr * 64 + fr, fq * 8), boff = lds_byte(wc * 32 + fr, fq * 8);
#define PG8_SA(b, h) (((b) * 2 + (h)) * HTB)
#define PG8_SB(b, h) ((4 + (b) * 2 + (h)) * HTB)
#define PG8_STAGE(bufoff, gbase, voff) do { _Pragma("unroll") for (int _i = 0; _i < 2; ++_i) \
        __builtin_amdgcn_global_load_lds((const unsigned*)((const char*)(gbase) + (voff)[_i]), (PG8_LAS unsigned*)(lds + (bufoff) + ldsw + _i * 8192), 16, 0, 0); } while (0)
#define PG8_LDA(dst, b, h) do { _Pragma("unroll") for (int m = 0; m < 4; ++m) _Pragma("unroll") for (int k = 0; k < 2; ++k) dst[m][k] = *(const PG8_LAS bf16x8*)(lds + PG8_SA(b, h) + aoff + m * 2048 + k * 1024); } while (0)
#define PG8_LDB(dst, b, h) do { _Pragma("unroll") for (int n = 0; n < 2; ++n) _Pragma("unroll") for (int k = 0; k < 2; ++k) dst[n][k] = *(const PG8_LAS bf16x8*)(lds + PG8_SB(b, h) + boff + n * 2048 + k * 1024); } while (0)
#define PG8_MMA(ai, bj, At, Bt) do { __builtin_amdgcn_s_setprio(1); _Pragma("unroll") for (int m = 0; m < 4; ++m) _Pragma("unroll") for (int n = 0; n < 2; ++n) _Pragma("unroll") for (int k = 0; k < 2; ++k) \
        acc[ai][bj][m][n] = __builtin_amdgcn_mfma_f32_16x16x32_bf16(Bt[n][k], At[m][k], acc[ai][bj][m][n], 0, 0, 0); __builtin_amdgcn_s_setprio(0); } while (0)
#define PG8_WAIT_V(n) asm volatile("s_waitcnt vmcnt(" #n ")" ::: "memory")
#define PG8_WAIT_L(n) asm volatile("s_waitcnt lgkmcnt(" #n ")" ::: "memory")
#define PG8_BAR __builtin_amdgcn_s_barrier()
#define PG8_SCHED __builtin_amdgcn_sched_barrier(0)
    Unit cur, nxt; int ui = 0;
    if (!S.next(0, cur)) return;
    f32x4 acc[2][2][4][2];
#pragma unroll
    for (int a = 0; a < 2; ++a)
#pragma unroll
        for (int b = 0; b < 2; ++b)
#pragma unroll
            for (int m = 0; m < 4; ++m)
#pragma unroll
                for (int n = 0; n < 2; ++n) acc[a][b][m][n] = (f32x4){0.f, 0.f, 0.f, 0.f};
    bf16x8 At[4][2], B0[2][2], B1[2][2];
    const char* cA = (const char*)g.A + (size_t)cur.pm * tstep; const char* cB = (const char*)g.Bt + (size_t)cur.pn * tstep;
    S.a_ready(cur);
    PG8_STAGE(PG8_SB(0, 0), cB, voffB); PG8_STAGE(PG8_SA(0, 0), cA, voffA); PG8_STAGE(PG8_SB(0, 1), cB + hstep, voffB); PG8_STAGE(PG8_SA(0, 1), cA + hstep, voffA);
    if (wr == 1) PG8_BAR;
    PG8_WAIT_V(4); PG8_BAR;
    PG8_STAGE(PG8_SB(1, 0), cB + kstep, voffB); PG8_STAGE(PG8_SA(1, 0), cA + kstep, voffA); PG8_STAGE(PG8_SB(1, 1), cB + hstep + kstep, voffB);
    PG8_WAIT_V(6); PG8_BAR;
    PG8_STAMP();
    for (;;) {
        const bool has_next = S.next(ui + 1, nxt);
        const char* nA = has_next ? (const char*)g.A + (size_t)nxt.pm * tstep : cA; const char* nB = has_next ? (const char*)g.Bt + (size_t)nxt.pn * tstep : cB;
_Pragma("nounroll")
        for (int t = 0; t < nt; t += 2) {
            const bool last = (t == nt - 2);
            const char* a1 = cA + (size_t)(t + 1) * kstep;
            const char* a2 = last ? nA : cA + (size_t)(t + 2) * kstep; const char* b2 = last ? nB : cB + (size_t)(t + 2) * kstep;
            const char* a3 = a2 + kstep; const char* b3 = b2 + kstep;
            if (last && has_next) S.a_ready(nxt);
            PG8_LDB(B0, 0, 0); PG8_SCHED; PG8_LDA(At, 0, 0); PG8_STAGE(PG8_SA(1, 1), a1 + hstep, voffA);
            PG8_WAIT_L(8); PG8_BAR; PG8_WAIT_L(0); PG8_MMA(0, 0, At, B0); PG8_BAR; PG8_SCHED;
            PG8_LDB(B1, 0, 1); PG8_STAGE(PG8_SB(0, 0), b2, voffB);
            PG8_BAR; PG8_WAIT_L(0); PG8_MMA(0, 1, At, B1); PG8_BAR;
            PG8_LDA(At, 0, 1); PG8_STAGE(PG8_SA(0, 0), a2, voffA);
            PG8_BAR; PG8_WAIT_L(0); PG8_MMA(1, 0, At, B0); PG8_BAR; PG8_SCHED;
            PG8_STAGE(PG8_SB(0, 1), b2 + hstep, voffB);
            PG8_WAIT_V(6); PG8_BAR; PG8_MMA(1, 1, At, B1); PG8_BAR;
            PG8_LDB(B0, 1, 0); PG8_SCHED; PG8_LDA(At, 1, 0); PG8_STAGE(PG8_SA(0, 1), a2 + hstep, voffA);
            PG8_WAIT_L(8); PG8_BAR; PG8_WAIT_L(0); PG8_MMA(0, 0, At, B0); PG8_BAR; PG8_SCHED;
            PG8_LDB(B1, 1, 1); PG8_STAGE(PG8_SB(1, 0), b3, voffB);
            PG8_BAR; PG8_WAIT_L(0); PG8_MMA(0, 1, At, B1); PG8_BAR;
            PG8_LDA(At, 1, 1); PG8_STAGE(PG8_SA(1, 0), a3, voffA);
            PG8_BAR; PG8_WAIT_L(0); PG8_MMA(1, 0, At, B0); PG8_BAR; PG8_SCHED;
            PG8_STAGE(PG8_SB(1, 1), b3 + hstep, voffB);
            PG8_WAIT_V(6); PG8_BAR; PG8_MMA(1, 1, At, B1); PG8_BAR;
        }
        PG8_STAMP();
        if constexpr (!Epi::AFTER_DRAIN) { E(acc, cur, wr, wc, fr, fq); S.done(cur); }
        PG8_STAMP();
        if (!has_next) break;
#pragma unroll
        for (int a = 0; a < 2; ++a)
#pragma unroll
            for (int b = 0; b < 2; ++b)
#pragma unroll
                for (int m = 0; m < 4; ++m)
#pragma unroll
                    for (int n = 0; n < 2; ++n) acc[a][b][m][n] = (f32x4){0.f, 0.f, 0.f, 0.f};
        cur = nxt; cA = nA; cB = nB; ++ui;
    }
    PG8_WAIT_V(0);
    if (wr == 0) PG8_BAR;
    PG8_BAR;
    if constexpr (Epi::AFTER_DRAIN) { E.fused(acc, cur, wr, wc, fr, fq, lds, wid, lane); S.done(cur); }
    PG8_STAMP();
    if (STAMP && wid == 0) { stamps[lane] = lane < nts ? (((unsigned long long)(unsigned)ts_hi << 32) | (unsigned)ts_lo) : 0ull;
        if (lane == 62) stamps[62] = rt_entry; if (lane == 63) stamps[63] = (unsigned long long)wall_clock64(); }
#undef PG8_STAMP
#undef PG8_SA
#undef PG8_SB
#undef PG8_STAGE
#undef PG8_LDA
#undef PG8_LDB
#undef PG8_MMA
#undef PG8_WAIT_V
#undef PG8_WAIT_L
#undef PG8_BAR
#undef PG8_SCHED
}

}
#define XB_TMO      128
#define XB_XCNT(j)  (256  + 64 * (j))
#define XB_XSUB(j)  (1280 + 64 * (j))
#define XB_XGEN(j)  (2304 + 64 * (j))
#define XB_TOP      3328
#define XB_TOPGEN   3392
#define XCD_BAR_WORDS 3456
#define XB_SPIN_CAP (1u << 18)
#define LAS __attribute__((address_space(3)))

__device__ __forceinline__ unsigned xb_ld(unsigned* p)              { return __hip_atomic_load(p, __ATOMIC_RELAXED, __HIP_MEMORY_SCOPE_AGENT); }
__device__ __forceinline__ unsigned xb_add(unsigned* p, unsigned v) { return __hip_atomic_fetch_add(p, v, __ATOMIC_RELAXED, __HIP_MEMORY_SCOPE_AGENT); }
__device__ __forceinline__ unsigned xb_xcc_id() { return (unsigned)__builtin_amdgcn_s_getreg((3 << 11) | 20) & 0xFu; }
#define XB_SPIN(cond, bar) do { unsigned _sp = 0; while (cond) { __builtin_amdgcn_s_sleep(1); \
    if ((++_sp & 255u) == 0u) { if (xb_ld(&(bar)[XB_TMO])) break; if (_sp > XB_SPIN_CAP) { atomicAdd(&(bar)[XB_TMO], 1u); break; } } } } while (0)

struct XcdBarrier {
    unsigned* bar; unsigned x;
    volatile LAS unsigned* st;
};

__device__ __forceinline__ XcdBarrier xcd_barrier_post(unsigned* bar, volatile LAS unsigned* st) {
    XcdBarrier b; b.bar = bar; b.x = xb_xcc_id(); b.st = st;
    if (threadIdx.x == 0) (void)xb_add(&bar[XB_XCNT(b.x)], 1u);
    return b;
}
__device__ __forceinline__ void xcd_barrier_complete(unsigned* bar, unsigned x, unsigned& nloc, unsigned& nx) {
    const unsigned G = gridDim.x * gridDim.y * gridDim.z;
    unsigned sum, cnt, mine, sp = 0u;
    for (;;) {
        sum = 0u; cnt = 0u; mine = 0u;
#pragma unroll
        for (unsigned j = 0; j < 16; ++j) { const unsigned c = xb_ld(&bar[XB_XCNT(j)]); sum += c; cnt += (c > 0u) ? 1u : 0u; mine = (j == x) ? c : mine; }
        if (sum == G) break;
        __builtin_amdgcn_s_sleep(1);
        if ((++sp & 255u) == 0u) { if (xb_ld(&bar[XB_TMO])) break; if (sp > XB_SPIN_CAP) { atomicAdd(&bar[XB_TMO], 1u); break; } }
    }
    nloc = mine > 0u ? mine : 1u; nx = cnt > 0u ? cnt : 1u;
}

__device__ __forceinline__ void xcd_barrier(const XcdBarrier& b) {
    asm volatile("s_waitcnt vmcnt(0)" ::: "memory");
    __syncthreads();
    if (threadIdx.x == 0) {
        unsigned* bar = b.bar;
        __builtin_amdgcn_s_waitcnt(0);
        unsigned nloc = b.st[0], nx = b.st[1];
        if (nloc == 0u) { xcd_barrier_complete(bar, b.x, nloc, nx); b.st[0] = nloc; b.st[1] = nx; }
        const unsigned old = xb_add(&bar[XB_XSUB(b.x)], 1u);
        const unsigned gen = old / nloc;
        if (old + 1u == (gen + 1u) * nloc) {
            __builtin_amdgcn_fence(__ATOMIC_RELEASE, "agent");
            asm volatile("s_waitcnt vmcnt(0)" ::: "memory");
            const unsigned og = xb_add(&bar[XB_TOP], 1u);
            const unsigned tg = og / nx;
            if (og + 1u == (tg + 1u) * nx) xb_add(&bar[XB_TOPGEN], 1u);
            else XB_SPIN(xb_ld(&bar[XB_TOPGEN]) == tg, bar);
            __builtin_amdgcn_fence(__ATOMIC_ACQUIRE, "agent");
            xb_add(&bar[XB_XGEN(b.x)], 1u);
            asm volatile("s_waitcnt vmcnt(0)" ::: "memory");
        } else {
            XB_SPIN(xb_ld(&bar[XB_XGEN(b.x)]) == gen, bar);
            __builtin_amdgcn_fence(__ATOMIC_ACQUIRE, "agent");
            asm volatile("s_waitcnt vmcnt(0)" ::: "memory");
        }
    }
    __syncthreads();
}


#define LAS __attribute__((address_space(3)))
typedef float f32x4 __attribute__((ext_vector_type(4)));
typedef unsigned u32x4 __attribute__((ext_vector_type(4)));
typedef unsigned u32x2 __attribute__((ext_vector_type(2)));
typedef short bf16x8_t __attribute__((ext_vector_type(8)));
typedef float f32x16 __attribute__((ext_vector_type(16)));
constexpr int NTHR = 512;
constexpr int LDS_BYTES = 147456;
constexpr int LDS_MISC = LDS_BYTES - 256;

struct Params {
    const float *x_prompt, *x_sample, *cache_kv, *cache_kr, *state_pool, *state_conv, *state_delta; const int* page_table;
    const float *norm_g, *w_in, *pool_mix, *pool_scale, *q_norm_g, *w_uq, *kv_norm_g, *w_uk, *w_uv, *conv_w, *a_log, *dt_bias, *dn_norm_g, *w_br0, *w_br1, *w_br2, *w_out, *final_norm_g;
    float* out;
    bf16_t *WinT, *WuqT, *WkvT, *WbrT, *WoutT; float2* tab;
    float* xres; bf16_t* xn; bf16_t* H; float* BA; bf16_t *cq, *ckv, *Kr, *Q, *Kn, *V, *Vt, *qd, *kd, *vd; float* bg; bf16_t *ya, *yb, *yc; float* mf; bf16_t* mb; float* part; bf16_t* DOP; float* DU; float* DG;
    unsigned* bar;
    int ph_lo, ph_hi, li, pad;
};

typedef const __attribute__((address_space(4))) Params* KP;

constexpr int PH_PRO = 0;
constexpr int PH_L = 8;
constexpr int PH_GIN = 0, PH_TOK = 1, PH_GQ = 2, PH_ATT = 3, PH_FIN = 4, PH_MERGE = 5, PH_OUT = 6, PH_NORM = 7;
#define PHID(l, k) (1 + (l) * PH_L + (k))
constexpr int PH_END = 1 + 2 * PH_L;

struct MEpiH { static constexpr bool PERM = true, AFTER_DRAIN = false; bf16_t* H; float* BA;
    __device__ __forceinline__ void operator()(const f32x4 (&acc)[2][2][4][2], const pg8::Unit& u, int wr, int wc, int fr0, int fq0) const {
        int fr = fr0, fq = fq0; asm volatile("" : "+v"(fr), "+v"(fq));
        const int row0 = u.pm * 256 + wr * 64 + fr;
#pragma unroll
        for (int bj = 0; bj < 2; ++bj) {
            const int wcol = u.pn * 256 + bj * 128 + wc * 32, col0 = wcol + 8 * fq;
            const bool plain = (wcol + 32 <= C_ZPOOL) || (wcol >= C_Q && wcol + 32 <= C_ZMLA) || (wcol >= C_QKV && wcol + 32 <= C_ZDN);
            const int act = ((col0 >= C_ZPOOL && col0 < C_Q) || (col0 >= C_ZMLA && col0 < C_QKV) || (col0 >= C_ZDN && col0 < C_BETA)) ? 1 : (col0 >= C_GATE ? 2 : 0);
            const bool isba = (col0 == C_BETA) || (col0 == C_ALPHA);
#pragma unroll
            for (int ai = 0; ai < 2; ++ai)
#pragma unroll
                for (int m = 0; m < 4; ++m) { const int row = row0 + ai * 128 + m * 16; f32x4 v0 = acc[ai][bj][m][0], v1 = acc[ai][bj][m][1];
                    if (!plain) {
                        if (isba) { float* b = BA + (size_t)row * 16 + (col0 - C_BETA); *(f32x4*)b = v0; *(f32x4*)(b + 4) = v1; }
#pragma unroll
                        for (int e = 0; e < 4; ++e) { const float s0 = sigmoidf_(v0[e]), s1 = sigmoidf_(v1[e]);
                            v0[e] = act == 0 ? v0[e] : (act == 1 ? v0[e] * s0 : s0); v1[e] = act == 0 ? v1[e] : (act == 1 ? v1[e] * s1 : s1); }
                    }
                    u32x4 w; w.x = pg8::cvt_pk_bf16(v0[0], v0[1]); w.y = pg8::cvt_pk_bf16(v0[2], v0[3]); w.z = pg8::cvt_pk_bf16(v1[0], v1[1]); w.w = pg8::cvt_pk_bf16(v1[2], v1[3]);
                    *(u32x4*)(H + (size_t)row * IN_WP + col0) = w; }
        }
    } };
struct MEpiQ { static constexpr bool PERM = true, AFTER_DRAIN = false; bf16_t* Q; const float2* tab;
    __device__ __forceinline__ void operator()(const f32x4 (&acc)[2][2][4][2], const pg8::Unit& u, int wr, int wc, int fr0, int fq0) const {
        int fr = fr0, fq = fq0; asm volatile("" : "+v"(fr), "+v"(fq));
        const int row0 = u.pm * 256 + wr * 64 + fr;
#pragma unroll
        for (int bj = 0; bj < 2; ++bj) {
            const int wcol = u.pn * 256 + bj * 128 + wc * 32, col0 = wcol + 8 * fq;
            const bool rope = (wcol % 96) == 64;
#pragma unroll
            for (int ai = 0; ai < 2; ++ai)
#pragma unroll
                for (int m = 0; m < 4; ++m) { const int row = row0 + ai * 128 + m * 16; f32x4 v0 = acc[ai][bj][m][0], v1 = acc[ai][bj][m][1];
                    if (rope) { const int p = row < TP ? (row & (SEQ - 1)) : SEQ + ((row - TP) & 7); const float2* tp = tab + p * 16 + (fq & 1) * 8; const bool hi = fq >= 2;
#pragma unroll
                        for (int e = 0; e < 4; ++e) { const float o0 = __shfl_xor(v0[e], 32), o1 = __shfl_xor(v1[e], 32); const float2 c0 = tp[e], c1 = tp[4 + e];
                            v0[e] = hi ? (v0[e] * c0.x + o0 * c0.y) : (v0[e] * c0.x - o0 * c0.y); v1[e] = hi ? (v1[e] * c1.x + o1 * c1.y) : (v1[e] * c1.x - o1 * c1.y); } }
                    u32x4 w; w.x = pg8::cvt_pk_bf16(v0[0], v0[1]); w.y = pg8::cvt_pk_bf16(v0[2], v0[3]); w.z = pg8::cvt_pk_bf16(v1[0], v1[1]); w.w = pg8::cvt_pk_bf16(v1[2], v1[3]);
                    *(u32x4*)(Q + (size_t)row * 768 + col0) = w; asm volatile("" ::: "memory"); }
        }
    } };
struct MEpiKV { static constexpr bool PERM = true, AFTER_DRAIN = false; bf16_t* Kn; bf16_t* V;
    __device__ __forceinline__ void operator()(const f32x4 (&acc)[2][2][4][2], const pg8::Unit& u, int wr, int wc, int fr0, int fq0) const {
        int fr = fr0, fq = fq0; asm volatile("" : "+v"(fr), "+v"(fq));
        const int row0 = u.pm * 256 + wr * 64 + fr; bf16_t* base = u.pn < 2 ? Kn : V; const int cb = (u.pn & 1) * 256;
#pragma unroll
        for (int bj = 0; bj < 2; ++bj) { const int col0 = cb + bj * 128 + wc * 32 + 8 * fq;
#pragma unroll
            for (int ai = 0; ai < 2; ++ai)
#pragma unroll
                for (int m = 0; m < 4; ++m) { const int row = row0 + ai * 128 + m * 16; const f32x4 v0 = acc[ai][bj][m][0], v1 = acc[ai][bj][m][1];
                    u32x4 w; w.x = pg8::cvt_pk_bf16(v0[0], v0[1]); w.y = pg8::cvt_pk_bf16(v0[2], v0[3]); w.z = pg8::cvt_pk_bf16(v1[0], v1[1]); w.w = pg8::cvt_pk_bf16(v1[2], v1[3]);
                    *(u32x4*)(base + (size_t)row * 512 + col0) = w; } }
    } };
template <int BR> struct MEpiMerge { static constexpr bool PERM = true, AFTER_DRAIN = false; const bf16_t* H; float* mf; bf16_t* mb;
    __device__ __forceinline__ void operator()(const f32x4 (&acc)[2][2][4][2], const pg8::Unit& u, int wr, int wc, int fr0, int fq0) const {
        int fr = fr0, fq = fq0; asm volatile("" : "+v"(fr), "+v"(fq));
        const int row0 = u.pm * 256 + wr * 64 + fr;
#pragma unroll
        for (int bj = 0; bj < 2; ++bj) { const int col0 = u.pn * 256 + bj * 128 + wc * 32 + 8 * fq;
#pragma unroll
            for (int ai = 0; ai < 2; ++ai)
#pragma unroll
                for (int m = 0; m < 4; ++m) { const int row = row0 + ai * 128 + m * 16; f32x4 v0 = acc[ai][bj][m][0], v1 = acc[ai][bj][m][1];
                    const u32x4 g = *(const u32x4*)(H + (size_t)row * IN_WP + C_GATE + BR * 1024 + col0);
                    v0[0] *= __uint_as_float(g.x << 16); v0[1] *= __uint_as_float(g.x & 0xffff0000u); v0[2] *= __uint_as_float(g.y << 16); v0[3] *= __uint_as_float(g.y & 0xffff0000u);
                    v1[0] *= __uint_as_float(g.z << 16); v1[1] *= __uint_as_float(g.z & 0xffff0000u); v1[2] *= __uint_as_float(g.w << 16); v1[3] *= __uint_as_float(g.w & 0xffff0000u);
                    float* mp = mf + (size_t)row * 1024 + col0;
                    if (BR > 0) { v0 += *(const f32x4*)mp; v1 += *(const f32x4*)(mp + 4); }
                    if (BR < 2) { *(f32x4*)mp = v0; *(f32x4*)(mp + 4) = v1; }
                    else { u32x4 w; w.x = pg8::cvt_pk_bf16(v0[0], v0[1]); w.y = pg8::cvt_pk_bf16(v0[2], v0[3]); w.z = pg8::cvt_pk_bf16(v1[0], v1[1]); w.w = pg8::cvt_pk_bf16(v1[2], v1[3]);
                        *(u32x4*)(mb + (size_t)row * 1024 + col0) = w; } asm volatile("" ::: "memory"); } }
    } };
struct MEpiRes { static constexpr bool PERM = false, AFTER_DRAIN = false; const float* xp; const float* xs; float* xo;
    __device__ __forceinline__ void operator()(const f32x4 (&acc)[2][2][4][2], const pg8::Unit& u, int wr, int wc, int fr0, int fq0) const {
        int fr = fr0, fq = fq0; asm volatile("" : "+v"(fr), "+v"(fq));
        const int row0 = u.pm * 256 + wr * 64 + fr, col0 = u.pn * 256 + wc * 32 + 4 * fq;
#pragma unroll
        for (int ai = 0; ai < 2; ++ai)
#pragma unroll
            for (int m = 0; m < 4; ++m) { const int row = row0 + ai * 128 + m * 16; const float* xr = row < TP ? xp + (size_t)row * 1024 : xs + (size_t)(row - TP) * 1024; float* orow = xo + (size_t)row * 1024;
#pragma unroll
                for (int bj = 0; bj < 2; ++bj)
#pragma unroll
                    for (int n = 0; n < 2; ++n) { const int c = col0 + bj * 128 + n * 16; *(f32x4*)(orow + c) = *(const f32x4*)(xr + c) + acc[ai][bj][m][n]; } }
    } };

__device__ __forceinline__ void ph_tr(const float* __restrict__ src, bf16_t* __restrict__ dst, int K, int N, int Npad, LAS float* tile, int rot) {
    int tid = threadIdx.x; asm volatile("" : "+v"(tid)); const int G = gridDim.x; const int tn = Npad / 64, tk = K / 32, nt = tn * tk;
    const int first = (blockIdx.x + G - (rot % G)) % G;
    for (int t = first; t < nt; t += G) {
        const int n0 = (t % tn) * 64, k0 = (t / tn) * 32;
        { const int tx = tid & 63, ty = tid >> 6;
#pragma unroll
          for (int i = 0; i < 4; ++i) { const int k = ty + 8 * i, n = n0 + tx; tile[k * 65 + tx] = n < N ? src[(size_t)(k0 + k) * N + n] : 0.f; } }
        __syncthreads();
        { const int kx = tid & 31, ny = tid >> 5;
#pragma unroll
          for (int i = 0; i < 4; ++i) { const int n = ny + 16 * i; dst[(size_t)(n0 + n) * K + k0 + kx] = f2bf(tile[kx * 65 + n]); } }
        __syncthreads();
    }
}
__device__ __forceinline__ void ph_rope_tab(float2* tab) {
    for (int idx = blockIdx.x * NTHR + threadIdx.x; idx < (SEQ + DEC_SEQ) * 16; idx += gridDim.x * NTHR) {
        const int p = idx >> 4, i = idx & 15; const int pos = p < SEQ ? p : PAST_LEN + (p - SEQ);
        const float inv = powf(10000.0f, -(float)i / 16.0f); const float ang = (float)pos * inv;
        const double rev = (double)ang * 0.15915494309189533576888; const float f = (float)(rev - floor(rev));
        tab[idx] = make_float2(__builtin_amdgcn_cosf(f), __builtin_amdgcn_sinf(f)); }
}
__device__ __forceinline__ void ph_rmsnorm(const float* __restrict__ xp, const float* __restrict__ xs, const float* __restrict__ g, bf16_t* __restrict__ xn, float* __restrict__ yp, float* __restrict__ ys) {
    int tid_o = threadIdx.x; asm volatile("" : "+v"(tid_o)); int lane = tid_o & 63, wave = tid_o >> 6;
    for (int t = blockIdx.x * 8 + wave; t < TT; t += gridDim.x * 8) {
        const float* x = t < TP ? xp + (size_t)t * 1024 : xs + (size_t)(t - TP) * 1024;
        f32x4 v[4]; float ss = 0.f;
#pragma unroll
        for (int i = 0; i < 4; ++i) { v[i] = *(const f32x4*)(x + i * 256 + lane * 4); ss += v[i][0] * v[i][0] + v[i][1] * v[i][1] + v[i][2] * v[i][2] + v[i][3] * v[i][3]; }
        ss = wave_sum(ss); const float r = rsqrtf(ss * (1.0f / 1024.0f) + EPS);
#pragma unroll
        for (int i = 0; i < 4; ++i) { const int c = i * 256 + lane * 4; const f32x4 gg = *(const f32x4*)(g + c); const f32x4 o = v[i] * r * gg;
            if (xn) { u32x2 w; w.x = pg8::cvt_pk_bf16(o[0], o[1]); w.y = pg8::cvt_pk_bf16(o[2], o[3]); *(u32x2*)(xn + (size_t)t * 1024 + c) = w; }
            else { float* y = t < TP ? yp + (size_t)t * 1024 : ys + (size_t)(t - TP) * 1024; *(f32x4*)(y + c) = o; } }
    }
}

__device__ __forceinline__ void ph_tok(KP p, int l, LAS unsigned char* lds) {
    int tid_o = threadIdx.x; asm volatile("" : "+v"(tid_o)); int lane = tid_o & 63, wave = tid_o >> 6;
    const bf16_t* __restrict__ H = p->H; float* __restrict__ out = p->out;
    const float* qg = p->q_norm_g + l * 384; const float* kvg = p->kv_norm_g + l * 256; const float* conv_w = p->conv_w + (size_t)l * 4 * 1536;
    LAS float* dl = (LAS float*)(lds + wave * 2048);
    for (int t = blockIdx.x * 8 + wave; t < TT; t += gridDim.x * 8) {
        const bf16_t* h = H + (size_t)t * IN_WP;
        int i_seq, row0, pidx; const bool smp = t >= TP; const int ts = t - TP;
        if (!smp) { i_seq = t & (SEQ - 1); row0 = t - i_seq; pidx = i_seq; } else { i_seq = ts & 7; row0 = t - i_seq; pidx = SEQ + i_seq; }
        { float q[6]; float ss = 0.f;
#pragma unroll
          for (int i = 0; i < 6; ++i) { q[i] = bf2f(h[C_Q + lane + 64 * i]); ss += q[i] * q[i]; }
          ss = wave_sum(ss); float r = rsqrtf(ss * (1.0f / 384.0f) + EPS);
#pragma unroll
          for (int i = 0; i < 6; ++i) p->cq[(size_t)t * 384 + lane + 64 * i] = f2bf(q[i] * r * qg[lane + 64 * i]);
          float kv[4]; ss = 0.f;
#pragma unroll
          for (int i = 0; i < 4; ++i) { kv[i] = bf2f(h[C_KV + lane + 64 * i]); ss += kv[i] * kv[i]; }
          ss = wave_sum(ss); r = rsqrtf(ss * (1.0f / 256.0f) + EPS);
          float* okv; float* okr;
          if (!smp) { okv = out + O_PKV + ((size_t)l * TP + t) * 256; okr = out + O_PKR + ((size_t)l * TP + t) * 32; }
          else { okv = out + O_SKV + ((size_t)l * TS + ts) * 256; okr = out + O_SKR + ((size_t)l * TS + ts) * 32; }
#pragma unroll
          for (int i = 0; i < 4; ++i) { const float o = kv[i] * r * kvg[lane + 64 * i]; okv[lane + 64 * i] = o; p->ckv[(size_t)t * 256 + lane + 64 * i] = f2bf(o); }
          if (lane < 16) { const float x1 = bf2f(h[C_KR + lane]), x2 = bf2f(h[C_KR + 16 + lane]); const float2 cs = p->tab[pidx * 16 + lane];
              const float o1 = x1 * cs.x - x2 * cs.y, o2 = x2 * cs.x + x1 * cs.y;
              okr[lane] = o1; okr[16 + lane] = o2; p->Kr[(size_t)t * 32 + lane] = f2bf(o1); p->Kr[(size_t)t * 32 + 16 + lane] = f2bf(o2); } }
        { const float* sc = smp ? p->state_conv + ((size_t)l * DEC_BATCH + (ts >> 3)) * 3 * 1536 : nullptr;
#pragma unroll 4
          for (int i = 0; i < 24; ++i) { const int c = lane + 64 * i; float y = 0.f;
#pragma unroll
              for (int j = 0; j < 4; ++j) { const int u = i_seq - 3 + j; float xv;
                  if (u >= 0) xv = bf2f(H[(size_t)(row0 + u) * IN_WP + C_QKV + c]); else xv = sc ? sc[(size_t)(u + 3) * 1536 + c] : 0.f;
                  y += xv * conv_w[j * 1536 + c]; }
              float v = siluf_(y);
              if (i < 16) { const float ss = wave_sum(v * v); v *= rsqrtf(ss + EPS); if (i < 8) v *= 0.125f; }
              const bf16_t o = f2bf(v);
              if (i < 8) p->qd[(size_t)t * 512 + c] = o; else if (i < 16) p->kd[(size_t)t * 512 + (c - 512)] = o; else p->vd[(size_t)t * 512 + (c - 1024)] = o;
              if (!smp) { if (i_seq >= SEQ - 3) out[O_PCONV + (((size_t)l * 8 + (t >> 11)) * 3 + (i_seq - (SEQ - 3))) * 1536 + c] = bf2f(h[C_QKV + c]); }
              else { if (i_seq >= DEC_SEQ - 3) out[O_SCONV + (((size_t)l * DEC_BATCH + (ts >> 3)) * 3 + (i_seq - (DEC_SEQ - 3))) * 1536 + c] = bf2f(h[C_QKV + c]); } }
          if (lane < 8) { const float b = sigmoidf_(p->BA[(size_t)t * 16 + lane]); const float x = p->BA[(size_t)t * 16 + 8 + lane] + p->dt_bias[l * 8 + lane];
              const float sp = x > 20.f ? x : log1pf(expf(x)); const float g = -expf(p->a_log[l * 8 + lane]) * sp;
              p->bg[(size_t)t * 16 + lane] = b; p->bg[(size_t)t * 16 + 8 + lane] = g; } }
        { const float* sp = smp ? p->state_pool + ((size_t)l * DEC_BATCH + (ts >> 3)) * 15 * 512 : nullptr;
          float* so = smp ? out + O_SPOOL + ((size_t)l * DEC_BATCH + (ts >> 3)) * 15 * 512 : nullptr;
#pragma unroll
          for (int j = 0; j < 8; ++j) { const int ch = lane + 64 * j, g = j >> 1, w = 2 << g; float sum = 0.f;
              for (int k = 0; k < w; ++k) { const int u = i_seq - k; float xv;
                  if (u >= 0) xv = bf2f(H[(size_t)(row0 + u) * IN_WP + C_POOL + ch]); else xv = sp ? sp[(size_t)(15 + u) * 512 + ch] : 0.f;
                  sum += xv; }
              const float cur = bf2f(h[C_POOL + ch]); const float cnt = !smp ? (float)min(i_seq + 1, w) : (float)w;
              dl[ch] = sum / cnt - cur;
              if (!smp) { if (i_seq >= SEQ - 15) out[O_PPOOL + (((size_t)l * 8 + (t >> 11)) * 15 + (i_seq - (SEQ - 15))) * 512 + ch] = cur; }
              else { so[(size_t)(7 + i_seq) * 512 + ch] = cur; if (i_seq < 7) so[(size_t)i_seq * 512 + ch] = sp[(size_t)(8 + i_seq) * 512 + ch]; } }
          asm volatile("s_waitcnt lgkmcnt(0)" ::: "memory");
#pragma unroll
          for (int j = 0; j < 8; ++j) { const int ch = lane + 64 * j, g = j >> 1, c = ch & 127; const float* m = p->pool_mix + ((size_t)l * 4 + g) * 128 * 128; float y = 0.f;
              for (int k = 0; k < 128; ++k) y += dl[g * 128 + k] * m[k * 128 + c];
              y *= p->pool_scale[l * 512 + ch]; y *= bf2f(h[C_ZPOOL + ch]); p->ya[(size_t)t * 512 + ch] = f2bf(y); }
          asm volatile("s_waitcnt lgkmcnt(0)" ::: "memory"); }
    }
}

__device__ __forceinline__ void ph_attn_s(KP p, int l, LAS unsigned char* lds) {
    int tid = threadIdx.x; asm volatile("" : "+v"(tid));
    const int r = tid & 63, cq = tid >> 6;
    LAS bf16_t* Ks = (LAS bf16_t*)lds;
    LAS float* Ss = (LAS float*)(lds + 18944);
    LAS bf16_t* Qs = (LAS bf16_t*)(lds + 18944 + 8448);
    const float* w_uk = p->w_uk + (size_t)l * 256 * 512;
    for (int u = blockIdx.x; u < DEC_BATCH * SA_CH; u += gridDim.x) {
        const int s = u / SA_CH, ch = u % SA_CH;
        __syncthreads();
        { const int c = tid & 255, hh = tid >> 8;
          for (int h = hh * 4; h < hh * 4 + 4; ++h) { float acc[8];
#pragma unroll
              for (int i = 0; i < 8; ++i) acc[i] = 0.f;
              const float* wr_ = w_uk + (size_t)c * 512 + h * 64;
              for (int d = 0; d < 64; d += 4) { const f32x4 wv = *(const f32x4*)(wr_ + d);
#pragma unroll
                  for (int i = 0; i < 8; ++i) { const bf16_t* q = p->Q + (size_t)(TP + s * 8 + i) * 768 + h * 96 + d;
                      acc[i] += bf2f(q[0]) * wv[0] + bf2f(q[1]) * wv[1] + bf2f(q[2]) * wv[2] + bf2f(q[3]) * wv[3]; } }
#pragma unroll
              for (int i = 0; i < 8; ++i) Qs[(i * 8 + h) * 290 + c] = f2bf(acc[i]); }
          for (int e = tid; e < 64 * 32; e += NTHR) { const int rr = e >> 5, j = e & 31; Qs[rr * 290 + 256 + j] = p->Q[(size_t)(TP + s * 8 + (rr >> 3)) * 768 + (rr & 7) * 96 + 64 + j]; } }
        float o[32];
#pragma unroll
        for (int d = 0; d < 32; ++d) o[d] = 0.f;
        float m = -1e30f, lsum = 0.f; const int i_tok = r >> 3; const int ntile = ch < 32 ? 16 : 1;
        for (int tl = 0; tl < ntile; ++tl) {
            __syncthreads();
            if (ch < 32) { const int j0 = ch * 512 + tl * 32; const int page = p->page_table[s * N_PAGES + (j0 >> 7)]; const int prow = j0 & 127;
                const float* kvp = p->cache_kv + (((size_t)l * N_POOL + page) * PAGE + prow) * 256; const float* krp = p->cache_kr + (((size_t)l * N_POOL + page) * PAGE + prow) * 32;
                for (int i = tid; i < 32 * 256; i += NTHR) Ks[(i >> 8) * 296 + (i & 255)] = f2bf(kvp[i]);
                for (int i = tid; i < 32 * 32; i += NTHR) Ks[(i >> 5) * 296 + 256 + (i & 31)] = f2bf(krp[i]);
            } else {
                for (int i = tid; i < 32 * 256; i += NTHR) { const int k = i >> 8; Ks[k * 296 + (i & 255)] = k < 8 ? p->ckv[((size_t)TP + s * 8 + k) * 256 + (i & 255)] : (bf16_t)0; }
                for (int i = tid; i < 32 * 32; i += NTHR) { const int k = i >> 5; Ks[k * 296 + 256 + (i & 31)] = k < 8 ? p->Kr[((size_t)TP + s * 8 + k) * 32 + (i & 31)] : (bf16_t)0; }
            }
            __syncthreads();
#pragma unroll
            for (int kk = 0; kk < 4; ++kk) { const int k = cq * 4 + kk; float sc = 0.f;
                for (int c = 0; c < 288; ++c) sc += bf2f(Qs[r * 290 + c]) * bf2f(Ks[k * 296 + c]);
                sc *= MLA_SCALE; if (ch == 32 && k > i_tok) sc = -1e30f; Ss[r * 33 + k] = sc; }
            __syncthreads();
            float tm = -1e30f;
            for (int k = 0; k < 32; ++k) tm = fmaxf(tm, Ss[r * 33 + k]);
            const float mn = fmaxf(m, tm), al = __expf(m - mn); m = mn; lsum *= al;
#pragma unroll
            for (int d = 0; d < 32; ++d) o[d] *= al;
            for (int k = 0; k < 32; ++k) { const float sc = Ss[r * 33 + k]; const float pr = sc <= -1e29f ? 0.f : __expf(sc - mn); lsum += pr;
#pragma unroll
                for (int d = 0; d < 32; ++d) o[d] += pr * bf2f(Ks[k * 296 + cq * 32 + d]); }
        }
        float* pp = p->part + (((size_t)s * SA_CH + ch) * 64 + r) * 258;
#pragma unroll
        for (int d = 0; d < 32; ++d) pp[cq * 32 + d] = o[d];
        if (cq == 0) { pp[256] = m; pp[257] = lsum; }
    }
    __syncthreads();
}

__device__ __forceinline__ void wu_delta(KP p, int l, int sq, int h, int dv) {
    int row0, L; float* so; float S[64];
    if (sq < 8) { row0 = sq * SEQ; L = SEQ; so = p->out + O_PDELTA + (((size_t)l * 8 + sq) * 8 + h) * 4096;
#pragma unroll
        for (int k = 0; k < 64; ++k) S[k] = 0.f; }
    else { const int s = sq - 8; row0 = TP + s * 8; L = DEC_SEQ; so = p->out + O_SDELTA + (((size_t)l * DEC_BATCH + s) * 8 + h) * 4096;
        const float* s0 = p->state_delta + (((size_t)l * DEC_BATCH + s) * 8 + h) * 4096;
#pragma unroll
        for (int k = 0; k < 64; ++k) S[k] = s0[k * 64 + dv]; }
    const float gn = p->dn_norm_g[l * 64 + dv];
    for (int i = 0; i < L; ++i) {
        const size_t t = (size_t)row0 + i; const u32x4* kp = (const u32x4*)(p->kd + t * 512 + h * 64); const u32x4* qp = (const u32x4*)(p->qd + t * 512 + h * 64);
        const float b = p->bg[t * 16 + h], a = __expf(p->bg[t * 16 + 8 + h]); const float v = bf2f(p->vd[t * 512 + h * 64 + dv]);
        u32x4 kk[8];
#pragma unroll
        for (int c = 0; c < 8; ++c) kk[c] = kp[c];
        float ks = 0.f;
#pragma unroll
        for (int c = 0; c < 8; ++c)
#pragma unroll
            for (int e = 0; e < 4; ++e) { const unsigned w = kk[c][e]; ks += __uint_as_float(w << 16) * S[c * 8 + 2 * e] + __uint_as_float(w & 0xffff0000u) * S[c * 8 + 2 * e + 1]; }
        const float vn = b * (v - a * ks); float o = 0.f;
#pragma unroll
        for (int c = 0; c < 8; ++c) { const u32x4 qv = qp[c];
#pragma unroll
            for (int e = 0; e < 4; ++e) { const unsigned w = kk[c][e], wq = qv[e]; const int k0 = c * 8 + 2 * e;
                S[k0] = a * S[k0] + __uint_as_float(w << 16) * vn; o += __uint_as_float(wq << 16) * S[k0];
                S[k0 + 1] = a * S[k0 + 1] + __uint_as_float(w & 0xffff0000u) * vn; o += __uint_as_float(wq & 0xffff0000u) * S[k0 + 1]; }
            asm volatile("" ::: "memory"); }
        const float ss = wave_sum(o * o); const float y = o * rsqrtf(ss * (1.0f / 64.0f) + EPS) * gn;
        p->yc[t * 512 + h * 64 + dv] = f2bf(y * bf2f(p->H[t * IN_WP + C_ZDN + h * 64 + dv]));
    }
#pragma unroll
    for (int k = 0; k < 64; ++k) so[k * 64 + dv] = S[k];
}
__device__ __forceinline__ int sig_inv(int rho) { return (rho & 32) | ((rho & 12) << 1) | ((rho & 16) >> 2) | (rho & 3); }
constexpr int DPRE_LDS = 64 * 64 * 4 + 512;
__device__ __forceinline__ void ph_delta_pre(KP p, LAS unsigned char* lds) {
    int tid_o = threadIdx.x; asm volatile("" : "+v"(tid_o)); int lane = tid_o & 63, wave = tid_o >> 6;
    wave = __builtin_amdgcn_readfirstlane(wave);
    LAS float* Am = (LAS float*)(lds + wave * DPRE_LDS); LAS float* gcs = Am + 4096; LAS float* bts = gcs + 64;
    for (int unit = wave * gridDim.x + blockIdx.x; unit < 2048; unit += gridDim.x * 8) {
        { int t_ = threadIdx.x; asm volatile("" : "+v"(t_)); lane = t_ & 63; }
        const int r = lane & 31, hh = lane >> 5;
        const int bh = unit >> 5, ch = unit & 31, b = bh >> 3, h = bh & 7;
        const size_t t0 = (size_t)b * SEQ + ch * 64;
        bf16_t* op = p->DOP + (size_t)unit * 4 * 4096; float* up = p->DU + (size_t)unit * 4096;
        const bf16_t* kdb = p->kd + t0 * 512 + h * 64; const bf16_t* qdb = p->qd + t0 * 512 + h * 64; const bf16_t* vdb = p->vd + t0 * 512 + h * 64;
        const float* bgb = p->bg + t0 * 16 + h;
        const float beta = bgb[lane * 16]; float gc = bgb[lane * 16 + 8];
#pragma unroll
        for (int d = 1; d < 64; d <<= 1) { const float x = __shfl_up(gc, d); if (lane >= d) gc += x; }
        const float gl = __shfl(gc, 63);
        gcs[lane] = gc; bts[lane] = beta;
        if (lane == 0) p->DG[unit] = __expf(gl);
        bf16x8_t kf[2][4], qf[2][4];
        { const int voff = r * 512 + 8 * hh;
#pragma unroll
          for (int rb = 0; rb < 2; ++rb)
#pragma unroll
            for (int ks = 0; ks < 4; ++ks) { kf[rb][ks] = *(const bf16x8_t*)(kdb + (32 * rb * 512 + 16 * ks) + voff); qf[rb][ks] = *(const bf16x8_t*)(qdb + (32 * rb * 512 + 16 * ks) + voff); } }
        {
#pragma unroll
            for (int rb = 0; rb < 2; ++rb) { const float sc = __expf(gl - __shfl(gc, 32 * rb + r)); const int voff = hh * 512 + sig_inv(32 * rb + r);
#pragma unroll
                for (int ks = 0; ks < 4; ++ks) {
#pragma unroll
                    for (int jj = 0; jj < 8; ++jj) (op + 3 * 4096 + (16 * ks + jj) * 64)[voff] = f2bf(bf2f((bf16_t)kf[rb][ks][jj]) * sc);
                    asm volatile("" ::: "memory"); } } }
        f32x16 kk00, kk10, kk11, qk00, qk10, qk11;
#pragma unroll
        for (int e = 0; e < 16; ++e) { kk00[e] = 0.f; kk10[e] = 0.f; kk11[e] = 0.f; qk00[e] = 0.f; qk10[e] = 0.f; qk11[e] = 0.f; }
#pragma unroll
        for (int ks = 0; ks < 4; ++ks) {
            kk00 = __builtin_amdgcn_mfma_f32_32x32x16_bf16(kf[0][ks], kf[0][ks], kk00, 0, 0, 0);
            kk10 = __builtin_amdgcn_mfma_f32_32x32x16_bf16(kf[1][ks], kf[0][ks], kk10, 0, 0, 0);
            kk11 = __builtin_amdgcn_mfma_f32_32x32x16_bf16(kf[1][ks], kf[1][ks], kk11, 0, 0, 0);
            qk00 = __builtin_amdgcn_mfma_f32_32x32x16_bf16(qf[0][ks], kf[0][ks], qk00, 0, 0, 0);
            qk10 = __builtin_amdgcn_mfma_f32_32x32x16_bf16(qf[1][ks], kf[0][ks], qk10, 0, 0, 0);
            qk11 = __builtin_amdgcn_mfma_f32_32x32x16_bf16(qf[1][ks], kf[1][ks], qk11, 0, 0, 0);
        }
        asm volatile("s_waitcnt lgkmcnt(0)" ::: "memory");
        {
            const float gcj0 = __shfl(gc, r), gcj1 = __shfl(gc, 32 + r);
            const int p0 = hh * 256 + sig_inv(r), p1 = hh * 256 + sig_inv(32 + r);
#pragma unroll
            for (int e = 0; e < 16; ++e) { const int ib = (e & 3) + 8 * (e >> 2), il = ib + 4 * hh;
                { const int i = il, j = r; const float gi = gcs[i], bi = bts[i]; const float dec = __expf(fminf(gi - gcj0, 0.f));
                  Am[i * 64 + j] = j < i ? bi * kk00[e] * dec : 0.f; (op + 2 * 4096 + ib * 64)[p0] = f2bf(j <= i ? qk00[e] * dec : 0.f); }
                { const int i = 32 + il, j = r; const float gi = gcs[i], bi = bts[i]; const float dec = __expf(fminf(gi - gcj0, 0.f));
                  Am[i * 64 + j] = bi * kk10[e] * dec; (op + 2 * 4096 + (32 + ib) * 64)[p0] = f2bf(qk10[e] * dec); }
                { const int i = 32 + il, j = 32 + r; const float gi = gcs[i], bi = bts[i]; const float dec = __expf(fminf(gi - gcj1, 0.f));
                  Am[i * 64 + j] = j < i ? bi * kk11[e] * dec : 0.f; (op + 2 * 4096 + (32 + ib) * 64)[p1] = f2bf(j <= i ? qk11[e] * dec : 0.f); }
                asm volatile("" ::: "memory");
            }
        }
        asm volatile("s_waitcnt lgkmcnt(0)" ::: "memory");
        {
            int c; { int t_ = threadIdx.x; asm volatile("" : "+v"(t_)); c = t_ & 63; } const int pc = sig_inv(c);
            const float egc = __expf(gc);
            const int beta_i = __float_as_int(beta), egc_i = __float_as_int(egc);
            { float u[64];
#pragma unroll
              for (int i = 0; i < 64; ++i) { const float bi = __int_as_float(__builtin_amdgcn_readlane(beta_i, i)); u[i] = bi * bf2f((vdb + i * 512)[c]); }
#pragma unroll
              for (int i = 1; i < 64; ++i) { float au = u[i];
#pragma unroll
                  for (int j4 = 0; j4 < i; j4 += 4) { const f32x4 a = *(const LAS f32x4*)(Am + i * 64 + j4);
#pragma unroll
                      for (int e = 0; e < 4; ++e) if (j4 + e < i) au -= a[e] * u[j4 + e]; }
                  u[i] = au; }
#pragma unroll
              for (int i = 0; i < 64; ++i) (up + i * 64)[c] = u[i]; }
            asm volatile("" ::: "memory");
            { float w[64];
#pragma unroll
              for (int i = 0; i < 64; ++i) { const float bi = __int_as_float(__builtin_amdgcn_readlane(beta_i, i)), ei = __int_as_float(__builtin_amdgcn_readlane(egc_i, i));
                  w[i] = bi * ei * bf2f((kdb + i * 512)[c]); (op + 1 * 4096 + i * 64)[pc] = f2bf(bf2f((qdb + i * 512)[c]) * ei); }
#pragma unroll
              for (int i = 1; i < 64; ++i) { float aw = w[i];
#pragma unroll
                  for (int j4 = 0; j4 < i; j4 += 4) { const f32x4 a = *(const LAS f32x4*)(Am + i * 64 + j4);
#pragma unroll
                      for (int e = 0; e < 4; ++e) if (j4 + e < i) aw -= a[e] * w[j4 + e]; }
                  w[i] = aw; }
#pragma unroll
              for (int i = 0; i < 64; ++i) (op + i * 64)[pc] = f2bf(-w[i]); }
        }
        asm volatile("s_waitcnt lgkmcnt(0)" ::: "memory");
    }
}
__device__ __forceinline__ bf16x8_t pack_b(const f32x4& lo, const f32x4& hi) { union { u32x4 u; bf16x8_t v; } x;
    x.u.x = pg8::cvt_pk_bf16(lo[0], lo[1]); x.u.y = pg8::cvt_pk_bf16(lo[2], lo[3]); x.u.z = pg8::cvt_pk_bf16(hi[0], hi[1]); x.u.w = pg8::cvt_pk_bf16(hi[2], hi[3]); return x.v; }
__device__ __forceinline__ void wu_scan(KP p, int l, int bh, int slice, int lane) {
    const int n = lane & 15, q = lane >> 4, n0 = slice * 16, b = bh >> 3, h = bh & 7;
    f32x4 S[4];
#pragma unroll
    for (int t = 0; t < 4; ++t) S[t] = (f32x4){0.f, 0.f, 0.f, 0.f};
    const int foff = n * 64 + 8 * q;
    for (int ch = 0; ch < 32; ++ch) {
        const size_t unit = (size_t)bh * 32 + ch;
        const bf16_t* op = p->DOP + unit * 4 * 4096 + foff; const float* up = p->DU + unit * 4096 + n0 + n;
        const float eg = p->DG[unit];
        f32x4 vn[4]; bf16x8_t wf[4][2], gf[4][2], kf[4][2], tf[4][2];
#pragma unroll
        for (int mt = 0; mt < 4; ++mt) {
#pragma unroll
            for (int e = 0; e < 4; ++e) vn[mt][e] = up[(16 * mt + 4 * q + e) * 64];
#pragma unroll
            for (int ks = 0; ks < 2; ++ks) { const int o = mt * 1024 + ks * 32;
                wf[mt][ks] = *(const bf16x8_t*)(op + o); gf[mt][ks] = *(const bf16x8_t*)(op + 4096 + o);
                kf[mt][ks] = *(const bf16x8_t*)(op + 2 * 4096 + o); tf[mt][ks] = *(const bf16x8_t*)(op + 3 * 4096 + o); } }
        const bf16x8_t sb0 = pack_b(S[0], S[1]), sb1 = pack_b(S[2], S[3]);
        f32x4 o[4];
#pragma unroll
        for (int mt = 0; mt < 4; ++mt) {
            vn[mt] = __builtin_amdgcn_mfma_f32_16x16x32_bf16(wf[mt][0], sb0, vn[mt], 0, 0, 0);
            vn[mt] = __builtin_amdgcn_mfma_f32_16x16x32_bf16(wf[mt][1], sb1, vn[mt], 0, 0, 0);
            o[mt] = __builtin_amdgcn_mfma_f32_16x16x32_bf16(gf[mt][0], sb0, (f32x4){0.f, 0.f, 0.f, 0.f}, 0, 0, 0);
            o[mt] = __builtin_amdgcn_mfma_f32_16x16x32_bf16(gf[mt][1], sb1, o[mt], 0, 0, 0);
        }
        const bf16x8_t vb0 = pack_b(vn[0], vn[1]), vb1 = pack_b(vn[2], vn[3]);
#pragma unroll
        for (int mt = 0; mt < 4; ++mt) {
            o[mt] = __builtin_amdgcn_mfma_f32_16x16x32_bf16(kf[mt][0], vb0, o[mt], 0, 0, 0);
            if (mt >= 2) o[mt] = __builtin_amdgcn_mfma_f32_16x16x32_bf16(kf[mt][1], vb1, o[mt], 0, 0, 0);
            S[mt] = S[mt] * eg;
            S[mt] = __builtin_amdgcn_mfma_f32_16x16x32_bf16(tf[mt][0], vb0, S[mt], 0, 0, 0);
            S[mt] = __builtin_amdgcn_mfma_f32_16x16x32_bf16(tf[mt][1], vb1, S[mt], 0, 0, 0);
        }
        bf16_t* yo = p->yc + ((size_t)b * SEQ + ch * 64) * 512 + h * 64 + n0 + n;
#pragma unroll
        for (int mt = 0; mt < 4; ++mt)
#pragma unroll
            for (int e = 0; e < 4; ++e) yo[(size_t)(16 * mt + 4 * q + e) * 512] = f2bf(o[mt][e]);
    }
    float* so = p->out + O_PDELTA + (((size_t)l * 8 + b) * 8 + h) * 4096 + n0 + n;
#pragma unroll
    for (int t = 0; t < 4; ++t)
#pragma unroll
        for (int e = 0; e < 4; ++e) so[(16 * t + 4 * q + e) * 64] = S[t][e];
}
__device__ __forceinline__ void ph_delta_fin(KP p, int l) {
    int tid_o = threadIdx.x; asm volatile("" : "+v"(tid_o)); int lane = tid_o & 63, wave = tid_o >> 6;
    const int h = lane >> 3, d0 = (lane & 7) * 8;
    for (int t = blockIdx.x * 8 + wave; t < TP; t += gridDim.x * 8) {
        bf16_t* yp = p->yc + (size_t)t * 512 + h * 64 + d0; const u32x4 raw = *(const u32x4*)yp; const u32x4 gz = *(const u32x4*)(p->H + (size_t)t * IN_WP + C_ZDN + h * 64 + d0);
        float v[8]; v[0] = __uint_as_float(raw.x << 16); v[1] = __uint_as_float(raw.x & 0xffff0000u); v[2] = __uint_as_float(raw.y << 16); v[3] = __uint_as_float(raw.y & 0xffff0000u);
        v[4] = __uint_as_float(raw.z << 16); v[5] = __uint_as_float(raw.z & 0xffff0000u); v[6] = __uint_as_float(raw.w << 16); v[7] = __uint_as_float(raw.w & 0xffff0000u);
        float z[8]; z[0] = __uint_as_float(gz.x << 16); z[1] = __uint_as_float(gz.x & 0xffff0000u); z[2] = __uint_as_float(gz.y << 16); z[3] = __uint_as_float(gz.y & 0xffff0000u);
        z[4] = __uint_as_float(gz.z << 16); z[5] = __uint_as_float(gz.z & 0xffff0000u); z[6] = __uint_as_float(gz.w << 16); z[7] = __uint_as_float(gz.w & 0xffff0000u);
        float ss = 0.f;
#pragma unroll
        for (int e = 0; e < 8; ++e) ss += v[e] * v[e];
        ss += __shfl_xor(ss, 1); ss += __shfl_xor(ss, 2); ss += __shfl_xor(ss, 4);
        const float rs = rsqrtf(ss * (1.0f / 64.0f) + EPS);
#pragma unroll
        for (int e = 0; e < 8; ++e) v[e] = v[e] * rs * p->dn_norm_g[l * 64 + d0 + e] * z[e];
        u32x4 w; w.x = pg8::cvt_pk_bf16(v[0], v[1]); w.y = pg8::cvt_pk_bf16(v[2], v[3]); w.z = pg8::cvt_pk_bf16(v[4], v[5]); w.w = pg8::cvt_pk_bf16(v[6], v[7]);
        *(u32x4*)yp = w;
    }
}

__device__ __forceinline__ void ph_att_waves(KP p, int l) {
    int tid_o = threadIdx.x; asm volatile("" : "+v"(tid_o)); int lane = tid_o & 63, wave = tid_o >> 6;
    wave = __builtin_amdgcn_readfirstlane(wave);
    const int G = gridDim.x, NW = G * 8, gw = wave * G + blockIdx.x;
    for (int d = gw; d < 256; d += NW) wu_scan(p, l, d >> 2, d & 3, lane);
    for (int d = NW - 1 - gw; d < 256; d += NW) wu_delta(p, l, 8 + (d >> 3), d & 7, lane);
}
__device__ __forceinline__ void ph_fin(KP p, int l, LAS unsigned char* lds) {
    int tid_o = threadIdx.x; asm volatile("" : "+v"(tid_o)); int lane = tid_o & 63, wave = tid_o >> 6;
    LAS float* ol = (LAS float*)(lds + wave * 2048); LAS float* wgt = ol + 256;
    const float* w_uv = p->w_uv + (size_t)l * 256 * 512;
    for (int u = blockIdx.x * 8 + wave; u < TS * 8; u += gridDim.x * 8) {
        const int ts = u >> 3, h = u & 7, s = ts >> 3, r = (ts & 7) * 8 + h; const int d = lane;
        float M = -1e30f;
        for (int ch = 0; ch < SA_CH; ++ch) M = fmaxf(M, p->part[(((size_t)s * SA_CH + ch) * 64 + r) * 258 + 256]);
        float L = 0.f;
        for (int ch = 0; ch < SA_CH; ++ch) { const float* pp = p->part + (((size_t)s * SA_CH + ch) * 64 + r) * 258; const float w = __expf(pp[256] - M); L += pp[257] * w; if (d == 0) wgt[ch] = w; }
        asm volatile("s_waitcnt lgkmcnt(0)" ::: "memory");
        for (int c = d; c < 256; c += 64) { float a = 0.f; for (int ch = 0; ch < SA_CH; ++ch) a += wgt[ch] * p->part[(((size_t)s * SA_CH + ch) * 64 + r) * 258 + c]; ol[c] = a / L; }
        asm volatile("s_waitcnt lgkmcnt(0)" ::: "memory");
        float a = 0.f;
        for (int c = 0; c < 256; ++c) a += ol[c] * w_uv[(size_t)c * 512 + h * 64 + d];
        const int t = TP + ts;
        p->yb[(size_t)t * 512 + h * 64 + d] = f2bf(a * bf2f(p->H[(size_t)t * IN_WP + C_ZMLA + h * 64 + d]));
        asm volatile("s_waitcnt lgkmcnt(0)" ::: "memory");
    }
}

constexpr int ATT_KS = 208, ATT_VS = 144, ATT_KB = 64 * ATT_KS, ATT_VB = 64 * ATT_VS, ATT_STAGE = ATT_KB + ATT_VB;
#define ATT_C 0.14724444831554004f
__device__ __forceinline__ void attn_unit(KP p, int b, int h, int qblk, LAS unsigned char* lds, int tid, int wave, int lane) {
    const int r = lane & 31, hh = lane >> 5;
    const int q0 = qblk * 256 + wave * 32;
    const size_t trow0 = (size_t)b * SEQ;
    bf16x8_t qf[6];
    { const bf16_t* qp = p->Q + (trow0 + q0 + r) * 768 + h * 96 + 8 * hh;
#pragma unroll
      for (int ks = 0; ks < 6; ++ks) qf[ks] = *(const bf16x8_t*)(qp + 16 * ks); }
    f32x16 o0, o1;
#pragma unroll
    for (int e = 0; e < 16; ++e) { o0[e] = 0.f; o1[e] = 0.f; }
    float m = -1e30f, lsum = 0.f;
    const int ntile = qblk * 4 + 4;
    const int cA = tid, keyA = cA / 12, partA = cA - keyA * 12; const int cB = 512 + (tid & 255), keyB = cB / 12, partB = cB - keyB * 12; const bool hasB = tid < 256;
    const bf16_t* gA = partA < 8 ? p->Kn + (trow0 + keyA) * 512 + h * 64 + partA * 8 : p->Kr + (trow0 + keyA) * 32 + (partA - 8) * 8; const int stepA = partA < 8 ? 64 * 512 : 64 * 32;
    const bf16_t* gB = partB < 8 ? p->Kn + (trow0 + keyB) * 512 + h * 64 + partB * 8 : p->Kr + (trow0 + keyB) * 32 + (partB - 8) * 8; const int stepB = partB < 8 ? 64 * 512 : 64 * 32;
    const bf16_t* gV = p->Vt + (size_t)(h * 64 + (tid >> 3)) * TP + trow0 + (tid & 7) * 8;
    const int lA = keyA * ATT_KS + partA * 16, lB = keyB * ATT_KS + partB * 16, lV = ATT_KB + (tid >> 3) * ATT_VS + (tid & 7) * 16;
    const int pr_ = (r & 0x13) | ((r & 4) << 1) | ((r & 8) >> 1);
    const int kOff = pr_ * ATT_KS + 16 * hh, vOff = ATT_KB + r * ATT_VS + 16 * hh;
    u32x4 rA = *(const u32x4*)gA, rB = hasB ? *(const u32x4*)gB : (u32x4){0u, 0u, 0u, 0u}, rV = *(const u32x4*)gV;
    for (int kt = 0; kt < ntile; ++kt) {
        LAS unsigned char* st = lds + (kt & 1) * ATT_STAGE;
        *(LAS u32x4*)(st + lA) = rA; if (hasB) *(LAS u32x4*)(st + lB) = rB; *(LAS u32x4*)(st + lV) = rV;
        __syncthreads();
        if (kt + 1 < ntile) { gA += stepA; gB += stepB; gV += 64; rA = *(const u32x4*)gA; if (hasB) rB = *(const u32x4*)gB; rV = *(const u32x4*)gV; }
        if (kt * 64 <= q0 + 31) {
            f32x16 s0, s1;
#pragma unroll
            for (int e = 0; e < 16; ++e) { s0[e] = 0.f; s1[e] = 0.f; }
#pragma unroll
            for (int ks = 0; ks < 6; ++ks) {
                const bf16x8_t a0 = *(const LAS bf16x8_t*)(st + kOff + ks * 32), a1 = *(const LAS bf16x8_t*)(st + kOff + 32 * ATT_KS + ks * 32);
                s0 = __builtin_amdgcn_mfma_f32_32x32x16_bf16(a0, qf[ks], s0, 0, 0, 0);
                s1 = __builtin_amdgcn_mfma_f32_32x32x16_bf16(a1, qf[ks], s1, 0, 0, 0);
            }
            if (kt * 64 + 63 > q0) {
                const int qrel = q0 + r - kt * 64;
#pragma unroll
                for (int e = 0; e < 16; ++e) { const int kl = (e & 3) + 4 * ((e >> 2) & 1) + 8 * hh + 16 * ((e >> 3) & 1);
                    if (kl > qrel) s0[e] = -1e30f; if (kl + 32 > qrel) s1[e] = -1e30f; }
            }
            float tm = fmaxf(s0[0], s1[0]);
#pragma unroll
            for (int e = 1; e < 16; ++e) tm = fmaxf(tm, fmaxf(s0[e], s1[e]));
            tm = fmaxf(tm, __shfl_xor(tm, 32));
            const float mn = fmaxf(m, tm), al = __builtin_amdgcn_exp2f((m - mn) * ATT_C), mc = mn * ATT_C; m = mn;
            float ps = 0.f;
#pragma unroll
            for (int e = 0; e < 16; ++e) { s0[e] = __builtin_amdgcn_exp2f(s0[e] * ATT_C - mc); s1[e] = __builtin_amdgcn_exp2f(s1[e] * ATT_C - mc); ps += s0[e] + s1[e]; }
            lsum = lsum * al + ps;
#pragma unroll
            for (int e = 0; e < 16; ++e) { o0[e] *= al; o1[e] *= al; }
#pragma unroll
            for (int kb = 0; kb < 2; ++kb)
#pragma unroll
                for (int sp = 0; sp < 2; ++sp) {
                    union { u32x4 u; bf16x8_t v; } pb;
                    if (kb == 0) { pb.u.x = pg8::cvt_pk_bf16(s0[8 * sp + 0], s0[8 * sp + 1]); pb.u.y = pg8::cvt_pk_bf16(s0[8 * sp + 2], s0[8 * sp + 3]); pb.u.z = pg8::cvt_pk_bf16(s0[8 * sp + 4], s0[8 * sp + 5]); pb.u.w = pg8::cvt_pk_bf16(s0[8 * sp + 6], s0[8 * sp + 7]); }
                    else         { pb.u.x = pg8::cvt_pk_bf16(s1[8 * sp + 0], s1[8 * sp + 1]); pb.u.y = pg8::cvt_pk_bf16(s1[8 * sp + 2], s1[8 * sp + 3]); pb.u.z = pg8::cvt_pk_bf16(s1[8 * sp + 4], s1[8 * sp + 5]); pb.u.w = pg8::cvt_pk_bf16(s1[8 * sp + 6], s1[8 * sp + 7]); }
                    const int ko = (32 * kb + 16 * sp) * 2;
                    const bf16x8_t v0 = *(const LAS bf16x8_t*)(st + vOff + ko), v1 = *(const LAS bf16x8_t*)(st + vOff + 32 * ATT_VS + ko);
                    o0 = __builtin_amdgcn_mfma_f32_32x32x16_bf16(v0, pb.v, o0, 0, 0, 0);
                    o1 = __builtin_amdgcn_mfma_f32_32x32x16_bf16(v1, pb.v, o1, 0, 0, 0);
                }
        }
    }
    lsum += __shfl_xor(lsum, 32);
    const float il = 1.0f / lsum;
    const size_t t = trow0 + q0 + r;
#pragma unroll
    for (int db = 0; db < 2; ++db)
#pragma unroll
        for (int g = 0; g < 4; ++g) { const int d0 = 32 * db + 8 * g + 4 * hh;
            const u32x2 gz = *(const u32x2*)(p->H + t * IN_WP + C_ZMLA + h * 64 + d0);
            float v[4];
#pragma unroll
            for (int e = 0; e < 4; ++e) v[e] = (db == 0 ? o0[4 * g + e] : o1[4 * g + e]) * il;
            v[0] *= __uint_as_float(gz.x << 16); v[1] *= __uint_as_float(gz.x & 0xffff0000u); v[2] *= __uint_as_float(gz.y << 16); v[3] *= __uint_as_float(gz.y & 0xffff0000u);
            u32x2 w; w.x = pg8::cvt_pk_bf16(v[0], v[1]); w.y = pg8::cvt_pk_bf16(v[2], v[3]);
            *(u32x2*)(p->yb + t * 512 + h * 64 + d0) = w; }
}
__device__ __forceinline__ void ph_attn_p(KP p, LAS unsigned char* lds) {
    int tid = threadIdx.x; asm volatile("" : "+v"(tid));
    const int lane = tid & 63, wave = __builtin_amdgcn_readfirstlane(tid >> 6);
    for (int pi = blockIdx.x; pi < 256; pi += gridDim.x) {
        const int xcd = pi & 7, k = pi >> 3, bh = xcd * 8 + (k >> 2), pr = k & 3;
        attn_unit(p, bh >> 3, bh & 7, 7 - pr, lds, tid, wave, lane);
        attn_unit(p, bh >> 3, bh & 7, pr, lds, tid, wave, lane);
    }
    __syncthreads();
}
struct MEpiVt { static constexpr bool PERM = true, AFTER_DRAIN = false; bf16_t* O; int ldc; int pad_;
    __device__ __forceinline__ void operator()(const f32x4 (&acc)[2][2][4][2], const pg8::Unit& u, int wr, int wc, int fr0, int fq0) const {
        int fr = fr0, fq = fq0; asm volatile("" : "+v"(fr), "+v"(fq));
        const int row0 = u.pm * 256 + wr * 64 + fr;
#pragma unroll
        for (int bj = 0; bj < 2; ++bj) { const int col0 = u.pn * 256 + bj * 128 + wc * 32 + 8 * fq;
#pragma unroll
            for (int ai = 0; ai < 2; ++ai)
#pragma unroll
                for (int m = 0; m < 4; ++m) { const int row = row0 + ai * 128 + m * 16; const f32x4 v0 = acc[ai][bj][m][0], v1 = acc[ai][bj][m][1];
                    u32x4 w; w.x = pg8::cvt_pk_bf16(v0[0], v0[1]); w.y = pg8::cvt_pk_bf16(v0[2], v0[3]); w.z = pg8::cvt_pk_bf16(v1[0], v1[1]); w.w = pg8::cvt_pk_bf16(v1[2], v1[3]);
                    *(u32x4*)(O + (size_t)row * ldc + col0) = w; } }
    } };


__global__ void __launch_bounds__(NTHR, 2) k_mega(Params p_unused) {
    const KP kp0 = (KP)__builtin_amdgcn_kernarg_segment_ptr();
#define PP() ({ KP q_ = kp0; asm volatile("" : "+s"(q_)); q_; })
    KP p = PP();
    extern __shared__ __attribute__((aligned(16))) unsigned char lds_raw[];
    LAS unsigned char* lds = (LAS unsigned char*)lds_raw;
    volatile LAS unsigned* misc = (volatile LAS unsigned*)(lds + LDS_MISC);
    for (int u = threadIdx.x; u < 64; u += NTHR) misc[u] = 0u;
    __syncthreads();
    const int lo = p->ph_lo, hi = p->ph_hi;
    XcdBarrier bar; bar.bar = p->bar + p->li * XCD_BAR_WORDS; bar.x = 0; bar.st = nullptr;
    if (hi - lo > 1) bar = xcd_barrier_post(p->bar + p->li * XCD_BAR_WORDS, misc + 8);
#define IN(k) (lo <= (k) && (k) < hi)
#define SEAM(k) do { if (IN(k) && IN((k) + 1)) xcd_barrier(bar); } while (0)

    if (IN(PH_PRO)) {
        LAS float* tile = (LAS float*)lds;
        for (int l = 0; l < 2; ++l) {
            KP p = PP();
            ph_tr(p->w_in + (size_t)l * 1024 * IN_W, p->WinT + (size_t)l * IN_WP * 1024, 1024, IN_W, IN_WP, tile, 0);
            ph_tr(p->w_uq + (size_t)l * 384 * 768, p->WuqT + (size_t)l * 768 * 384, 384, 768, 768, tile, 0);
            ph_tr(p->w_uk + (size_t)l * 256 * 512, p->WkvT + (size_t)l * 1024 * 256, 256, 512, 512, tile, 144);
            ph_tr(p->w_uv + (size_t)l * 256 * 512, p->WkvT + (size_t)l * 1024 * 256 + (size_t)512 * 256, 256, 512, 512, tile, 208);
            ph_tr(p->w_br0 + (size_t)l * 512 * 1024, p->WbrT + ((size_t)l * 3 + 0) * 1024 * 512, 512, 1024, 1024, tile, 0);
            ph_tr(p->w_br1 + (size_t)l * 512 * 1024, p->WbrT + ((size_t)l * 3 + 1) * 1024 * 512, 512, 1024, 1024, tile, 0);
            ph_tr(p->w_br2 + (size_t)l * 512 * 1024, p->WbrT + ((size_t)l * 3 + 2) * 1024 * 512, 512, 1024, 1024, tile, 0);
            ph_tr(p->w_out + (size_t)l * 1024 * 1024, p->WoutT + (size_t)l * 1024 * 1024, 1024, 1024, 1024, tile, 0);
        }
        { KP p = PP(); ph_rope_tab(p->tab); ph_rmsnorm(p->x_prompt, p->x_sample, p->norm_g, p->xn, nullptr, nullptr); }
    }
    SEAM(PH_PRO);
    for (int l = 0; l < 2; ++l) {
        int G = gridDim.x, bid = blockIdx.x; asm volatile("" : "+s"(G), "+s"(bid));
        if (IN(PHID(l, PH_GIN))) { KP p = PP();
            pg8::Gemm g{p->xn, p->WinT + (size_t)l * IN_WP * 1024, TT, IN_WP, 1024}; pg8::StaticOrder S; S.init(TT, IN_WP, G, bid);
            MEpiH E{p->H, p->BA}; pg8::gemm_phase<MEpiH, pg8::StaticOrder, false>(lds, g, S, E, nullptr);
        }
        SEAM(PHID(l, PH_GIN));
        if (IN(PHID(l, PH_TOK))) ph_tok(PP(), l, lds);
        SEAM(PHID(l, PH_TOK));
        if (IN(PHID(l, PH_GQ))) { KP p = PP();
            pg8::Gemm g{p->cq, p->WuqT + (size_t)l * 768 * 384, TT, 768, 384}; pg8::StaticOrder S; S.init(TT, 768, G, bid);
            MEpiQ E{p->Q, p->tab}; pg8::gemm_phase<MEpiQ, pg8::StaticOrder, false>(lds, g, S, E, nullptr);
        }
        if (IN(PHID(l, PH_GQ))) { KP p = PP();
            pg8::Gemm g{p->ckv, p->WkvT + (size_t)l * 1024 * 256, TP, 512, 256}; pg8::StaticOrder S; S.init(TP, 512, G, bid);
            MEpiKV E{p->Kn, p->V}; pg8::gemm_phase<MEpiKV, pg8::StaticOrder, false>(lds, g, S, E, nullptr);
        }
        if (IN(PHID(l, PH_GQ))) { KP p = PP();
            pg8::Gemm g{p->WkvT + (size_t)l * 1024 * 256 + (size_t)512 * 256, p->ckv, 512, TP, 256}; pg8::StaticOrder S; S.init(512, TP, G, bid);
            MEpiVt E{p->Vt, TP, 0}; pg8::gemm_phase<MEpiVt, pg8::StaticOrder, false>(lds, g, S, E, nullptr);
        }
        if (IN(PHID(l, PH_GQ))) ph_delta_pre(PP(), lds);
        SEAM(PHID(l, PH_GQ));
        if (IN(PHID(l, PH_ATT))) { ph_attn_s(PP(), l, lds); ph_attn_p(PP(), lds); ph_att_waves(PP(), l); }
        SEAM(PHID(l, PH_ATT));
        if (IN(PHID(l, PH_FIN))) { ph_fin(PP(), l, lds); ph_delta_fin(PP(), l); }
        SEAM(PHID(l, PH_FIN));
        if (IN(PHID(l, PH_MERGE))) {
            { KP p = PP(); pg8::Gemm g{p->ya, p->WbrT + ((size_t)l * 3 + 0) * 1024 * 512, TT, 1024, 512}; pg8::StaticOrder S; S.init(TT, 1024, G, bid);
              MEpiMerge<0> E{p->H, p->mf, p->mb}; pg8::gemm_phase<MEpiMerge<0>, pg8::StaticOrder, false>(lds, g, S, E, nullptr); }
            { KP p = PP(); pg8::Gemm g{p->yb, p->WbrT + ((size_t)l * 3 + 1) * 1024 * 512, TT, 1024, 512}; pg8::StaticOrder S; S.init(TT, 1024, G, bid);
              MEpiMerge<1> E{p->H, p->mf, p->mb}; pg8::gemm_phase<MEpiMerge<1>, pg8::StaticOrder, false>(lds, g, S, E, nullptr); }
            { KP p = PP(); pg8::Gemm g{p->yc, p->WbrT + ((size_t)l * 3 + 2) * 1024 * 512, TT, 1024, 512}; pg8::StaticOrder S; S.init(TT, 1024, G, bid);
              MEpiMerge<2> E{p->H, p->mf, p->mb}; pg8::gemm_phase<MEpiMerge<2>, pg8::StaticOrder, false>(lds, g, S, E, nullptr); }
        }
        SEAM(PHID(l, PH_MERGE));
        if (IN(PHID(l, PH_OUT))) { KP p = PP();
            const float* xp = l == 0 ? p->x_prompt : p->xres; const float* xs = l == 0 ? p->x_sample : p->xres + (size_t)TP * 1024;
            pg8::Gemm g{p->mb, p->WoutT + (size_t)l * 1024 * 1024, TT, 1024, 1024}; pg8::StaticOrder S; S.init(TT, 1024, G, bid);
            MEpiRes E{xp, xs, p->xres}; pg8::gemm_phase<MEpiRes, pg8::StaticOrder, false>(lds, g, S, E, nullptr);
        }
        SEAM(PHID(l, PH_OUT));
        if (IN(PHID(l, PH_NORM))) { KP p = PP();
            if (l == 0) ph_rmsnorm(p->xres, p->xres + (size_t)TP * 1024, p->norm_g + 1024, p->xn, nullptr, nullptr);
            else ph_rmsnorm(p->xres, p->xres + (size_t)TP * 1024, p->final_norm_g, nullptr, p->out + O_YP, p->out + O_YS);
        }
        SEAM(PHID(l, PH_NORM));
    }
#undef IN
#undef SEAM
}

static inline size_t al256(size_t x) { return (x + 255) & ~(size_t)255; }
extern "C" void kernel_launch(void* const* d_in, const int* in_sizes, int n_in, void* d_out, int out_size, void* d_ws, size_t ws_size, hipStream_t stream) {
    static int grid = 0;
    if (grid == 0) {
        int dev = 0, cus = 0; (void)hipGetDevice(&dev); (void)hipDeviceGetAttribute(&cus, hipDeviceAttributeMultiprocessorCount, dev);
        (void)hipFuncSetAttribute((const void*)k_mega, hipFuncAttributeMaxDynamicSharedMemorySize, LDS_BYTES);
        int per_cu = 0; (void)hipOccupancyMaxActiveBlocksPerMultiprocessor(&per_cu, (const void*)k_mega, NTHR, LDS_BYTES); (void)hipGetLastError();
        grid = cus > 0 ? cus : 256;
    }
    Params p{};
    p.x_prompt = (const float*)d_in[0]; p.x_sample = (const float*)d_in[1]; p.cache_kv = (const float*)d_in[2]; p.cache_kr = (const float*)d_in[3];
    p.state_pool = (const float*)d_in[4]; p.state_conv = (const float*)d_in[5]; p.state_delta = (const float*)d_in[6]; p.page_table = (const int*)d_in[7];
    p.norm_g = (const float*)d_in[8]; p.w_in = (const float*)d_in[9]; p.pool_mix = (const float*)d_in[10]; p.pool_scale = (const float*)d_in[11];
    p.q_norm_g = (const float*)d_in[12]; p.w_uq = (const float*)d_in[13]; p.kv_norm_g = (const float*)d_in[14]; p.w_uk = (const float*)d_in[15];
    p.w_uv = (const float*)d_in[16]; p.conv_w = (const float*)d_in[17]; p.a_log = (const float*)d_in[18]; p.dt_bias = (const float*)d_in[19];
    p.dn_norm_g = (const float*)d_in[20]; p.w_br0 = (const float*)d_in[21]; p.w_br1 = (const float*)d_in[22]; p.w_br2 = (const float*)d_in[23];
    p.w_out = (const float*)d_in[24]; p.final_norm_g = (const float*)d_in[25];
    p.out = (float*)d_out;
    char* w = (char*)d_ws; size_t off = 0;
    auto take = [&](size_t bytes) { char* q = w + off; off += al256(bytes); return q; };
    const size_t BAR_BYTES = (size_t)16 * XCD_BAR_WORDS * 4;
    p.bar = (unsigned*)take(BAR_BYTES);
    p.WinT = (bf16_t*)take((size_t)2 * IN_WP * 1024 * 2);
    p.WuqT = (bf16_t*)take((size_t)2 * 768 * 384 * 2);
    p.WkvT = (bf16_t*)take((size_t)2 * 1024 * 256 * 2);
    p.WbrT = (bf16_t*)take((size_t)2 * 3 * 1024 * 512 * 2);
    p.WoutT = (bf16_t*)take((size_t)2 * 1024 * 1024 * 2);
    p.tab = (float2*)take((size_t)(SEQ + DEC_SEQ) * 16 * 8);
    p.xres = (float*)take((size_t)TT * 1024 * 4);
    p.xn = (bf16_t*)take((size_t)TT * 1024 * 2);
    p.H = (bf16_t*)take((size_t)TT * IN_WP * 2);
    p.BA = (float*)take((size_t)TT * 16 * 4);
    p.cq = (bf16_t*)take((size_t)TT * 384 * 2);
    p.ckv = (bf16_t*)take((size_t)TT * 256 * 2);
    p.Kr = (bf16_t*)take((size_t)TT * 32 * 2);
    p.Q = (bf16_t*)take((size_t)TT * 768 * 2);
    bf16_t* Qlat = (bf16_t*)take((size_t)TS * 8 * 288 * 2);
    p.Kn = (bf16_t*)take((size_t)TP * 512 * 2);
    p.V = (bf16_t*)take((size_t)TP * 512 * 2);
    p.Vt = (bf16_t*)take((size_t)512 * TP * 2);
    p.qd = (bf16_t*)take((size_t)TT * 512 * 2);
    p.kd = (bf16_t*)take((size_t)TT * 512 * 2);
    p.vd = (bf16_t*)take((size_t)TT * 512 * 2);
    p.bg = (float*)take((size_t)TT * 16 * 4);
    p.ya = (bf16_t*)take((size_t)TT * 512 * 2);
    p.yb = (bf16_t*)take((size_t)TT * 512 * 2);
    p.yc = (bf16_t*)take((size_t)TT * 512 * 2);
    p.mf = (float*)take((size_t)TT * 1024 * 4);
    p.mb = (bf16_t*)take((size_t)TT * 1024 * 2);
    p.part = (float*)take((size_t)DEC_BATCH * SA_CH * 64 * 258 * 4);
    p.DOP = (bf16_t*)take((size_t)2048 * 4 * 4096 * 2);
    p.DU = (float*)take((size_t)2048 * 4096 * 4);
    p.DG = (float*)take((size_t)2048 * 4);

    (void)hipMemsetAsync(p.bar, 0, BAR_BYTES, stream);
    p.ph_lo = 0; p.ph_hi = PH_END; p.li = 0; p.pad = 0;
    hipLaunchKernelGGL(k_mega, dim3(grid), dim3(NTHR), LDS_BYTES, stream, p);
}
```

```cpp
#include <hip/hip_runtime.h>
#include <stdint.h>

typedef unsigned short bf16_t;

#define D_MODEL 1024
#define TP 16384
#define TS 256
#define TT (TP + TS)
#define SEQ 2048
#define DEC_SEQ 8
#define DEC_BATCH 32
#define PAST_LEN 16384
#define PAGE 128
#define N_PAGES 128
#define N_POOL 5120
#define IN_W 7344
#define IN_WP 7424
#define C_POOL 0
#define C_ZPOOL 512
#define C_Q 1024
#define C_KV 1408
#define C_KR 1664
#define C_ZMLA 1696
#define C_QKV 2208
#define C_ZDN 3744
#define C_BETA 4256
#define C_ALPHA 4264
#define C_GATE 4272
#define EPS 1e-6f
#define MLA_SCALE 0.10206207261596577f
#define ATT_C 0.14724444831554004f

#define O_YP 0
#define O_YS (O_YP + 16777216)
#define O_PKV (O_YS + 262144)
#define O_PKR (O_PKV + 8388608)
#define O_PPOOL (O_PKR + 1048576)
#define O_PCONV (O_PPOOL + 122880)
#define O_PDELTA (O_PCONV + 73728)
#define O_SKV (O_PDELTA + 524288)
#define O_SKR (O_SKV + 131072)
#define O_SPOOL (O_SKR + 16384)
#define O_SCONV (O_SPOOL + 491520)
#define O_SDELTA (O_SCONV + 294912)
#define O_END (O_SDELTA + 2097152)

__device__ __forceinline__ float bf2f(bf16_t b) { return __uint_as_float(((unsigned)b) << 16); }
__device__ __forceinline__ bf16_t f2bf(float f) { unsigned u = __float_as_uint(f); u += 0x7FFFu + ((u >> 16) & 1u); return (bf16_t)(u >> 16); }
__device__ __forceinline__ float sigmoidf_(float v) { return 1.0f / (1.0f + __expf(-v)); }
__device__ __forceinline__ float siluf_(float v) { return v / (1.0f + __expf(-v)); }
__device__ __forceinline__ float wave_sum(float v) {
#pragma unroll
    for (int o = 32; o >= 1; o >>= 1) v += __shfl_xor(v, o);
    return v;
}

#define SA_CH 9
namespace pg8 {
#define PG8_LAS __attribute__((address_space(3)))
typedef unsigned short bf16_t;
typedef short bf16x8 __attribute__((ext_vector_type(8)));
typedef float f32x4 __attribute__((ext_vector_type(4)));
typedef unsigned u32x4 __attribute__((ext_vector_type(4)));
constexpr int BM = 256, BK = 64, HALF = 128, HTB = HALF * BK * 2  , STAGE_BYTES = 8 * HTB, NXCD = 8, WGM = 8;

__host__ __device__ __forceinline__ int lds_byte(int r, int c) { const int st = (r >> 4) * 2 + (c >> 5), rr = r & 15, cc = c & 31, ob = rr * 64 + cc * 2; return st * 1024 + (ob ^ (((ob >> 9) & 1) << 5)); }
__host__ __device__ __forceinline__ void stage_rc(int b, int& R, int& C) { const int st = b / 1024, sb = b % 1024, swz = sb ^ (((sb >> 9) & 1) << 5); R = (st >> 1) * 16 + swz / 64; C = (st & 1) * 32 + (swz % 64) / 2; }
__host__ __device__ __forceinline__ int perm32(int rho) { const int n = rho >> 4, i = rho & 15; return 8 * (i >> 2) + 4 * n + (i & 3); }

struct Unit { int pm, pn; };
struct Gemm { const bf16_t* A; const bf16_t* Bt; int M, N, K; };

struct StaticOrder {
    int nM, nN, nwg, G, c;
    __host__ __device__ void init(int M, int N, int G_, int c_) { nM = M / BM; nN = N / BM; nwg = nM * nN; G = G_; c = c_; }
    __host__ __device__ bool next(int i, Unit& u) const {
        const long L = (long)i * G + c; if (L >= nwg) return false;
        int wgid = (int)L; { const int q = nwg / NXCD, r = nwg % NXCD, xcd = wgid % NXCD, off = wgid / NXCD; wgid = (xcd < r ? xcd * (q + 1) : r * (q + 1) + (xcd - r) * q) + off; }
        const int nig = WGM * nN, gid = wgid / nig, fm = gid * WGM, gsz = (nM - fm) < WGM ? (nM - fm) : WGM;
        u.pm = fm + ((wgid % nig) % gsz); u.pn = (wgid % nig) / gsz; return true;
    }
    __device__ __forceinline__ void a_ready(const Unit&) const {}
    __device__ __forceinline__ void done(const Unit&) const {}
};
typedef __bf16 bf16n2 __attribute__((ext_vector_type(2)));
__device__ __forceinline__ unsigned cvt_pk_bf16(float lo, float hi) { typedef float f2_ __attribute__((ext_vector_type(2))); const f2_ v = {lo, hi}; return __builtin_bit_cast(unsigned, __builtin_convertvector(v, bf16n2)); }
typedef float f32x2 __attribute__((ext_vector_type(2)));
template <class Epi, class Sched, bool STAMP = false>
__device__ __forceinline__ void gemm_phase(PG8_LAS unsigned char* lds, const Gemm g, const Sched& S, const Epi& E, unsigned long long* stamps) {
    int tid_ = threadIdx.x; asm volatile("" : "+v"(tid_));
    const int tid = tid_, wid = __builtin_amdgcn_readfirstlane(tid >> 6), lane = tid & 63, wr = wid >> 2, wc = wid & 3, fr = lane & 15, fq = lane >> 4;
    int K_ = g.K; asm volatile("" : "+s"(K_));
    const int K = K_, nt = K / BK;
    int ts_lo = 0, ts_hi = 0, nts = 0; const unsigned long long rt_entry = STAMP ? (unsigned long long)wall_clock64() : 0ull;
#define PG8_STAMP() do { if (STAMP && wid == 0 && nts < 64) { const unsigned long long _c = (unsigned long long)clock64(); \
        ts_lo = (lane == nts) ? (int)(unsigned)_c : ts_lo; ts_hi = (lane == nts) ? (int)(unsigned)(_c >> 32) : ts_hi; ++nts; } } while (0)
    PG8_STAMP();
    unsigned voffA[2], voffB[2];
#pragma unroll
    for (int i = 0; i < 2; ++i) { int R, C; stage_rc(tid * 16 + i * 8192, R, C); const int Rb = Epi::PERM ? ((R & ~31) + perm32(R & 31)) : R;
        voffA[i] = (unsigned)(R * K + C) * 2u; voffB[i] = (unsigned)(Rb * K + C) * 2u; }
    const size_t kstep = (size_t)(BK * 2);
    const size_t hstep = (size_t)HALF * K * 2;
    const size_t tstep = 2 * hstep;
    const unsigned ldsw = (unsigned)wid * 1024u;
    const int aoff = lds_byte(wr * 64 + fr, fq * 8), boff = lds_byte(wc * 32 + fr, fq * 8);
#define PG8_SA(b, h) (((b) * 2 + (h)) * HTB)
#define PG8_SB(b, h) ((4 + (b) * 2 + (h)) * HTB)
#define PG8_STAGE(bufoff, gbase, voff) do { _Pragma("unroll") for (int _i = 0; _i < 2; ++_i) \
        __builtin_amdgcn_global_load_lds((const unsigned*)((const char*)(gbase) + (voff)[_i]), (PG8_LAS unsigned*)(lds + (bufoff) + ldsw + _i * 8192), 16, 0, 0); } while (0)
#define PG8_LDA(dst, b, h) do { _Pragma("unroll") for (int m = 0; m < 4; ++m) _Pragma("unroll") for (int k = 0; k < 2; ++k) dst[m][k] = *(const PG8_LAS bf16x8*)(lds + PG8_SA(b, h) + aoff + m * 2048 + k * 1024); } while (0)
#define PG8_LDB(dst, b, h) do { _Pragma("unroll") for (int n = 0; n < 2; ++n) _Pragma("unroll") for (int k = 0; k < 2; ++k) dst[n][k] = *(const PG8_LAS bf16x8*)(lds + PG8_SB(b, h) + boff + n * 2048 + k * 1024); } while (0)
#define PG8_MMA(ai, bj, At, Bt) do { __builtin_amdgcn_s_setprio(1); _Pragma("unroll") for (int m = 0; m < 4; ++m) _Pragma("unroll") for (int n = 0; n < 2; ++n) _Pragma("unroll") for (int k = 0; k < 2; ++k) \
        acc[ai][bj][m][n] = __builtin_amdgcn_mfma_f32_16x16x32_bf16(Bt[n][k], At[m][k], acc[ai][bj][m][n], 0, 0, 0); __builtin_amdgcn_s_setprio(0); } while (0)
#define PG8_WAIT_V(n) asm volatile("s_waitcnt vmcnt(" #n ")" ::: "memory")
#define PG8_WAIT_L(n) asm volatile("s_waitcnt lgkmcnt(" #n ")" ::: "memory")
#define PG8_BAR __builtin_amdgcn_s_barrier()
#define PG8_SCHED __builtin_amdgcn_sched_barrier(0)
    Unit cur, nxt; int ui = 0;
    if (!S.next(0, cur)) return;
    f32x4 acc[2][2][4][2];
#pragma unroll
    for (int a = 0; a < 2; ++a)
#pragma unroll
        for (int b = 0; b < 2; ++b)
#pragma unroll
            for (int m = 0; m < 4; ++m)
#pragma unroll
                for (int n = 0; n < 2; ++n) acc[a][b][m][n] = (f32x4){0.f, 0.f, 0.f, 0.f};
    bf16x8 At[4][2], B0[2][2], B1[2][2];
    const char* cA = (const char*)g.A + (size_t)cur.pm * tstep; const char* cB = (const char*)g.Bt + (size_t)cur.pn * tstep;
    S.a_ready(cur);
    PG8_STAGE(PG8_SB(0, 0), cB, voffB); PG8_STAGE(PG8_SA(0, 0), cA, voffA); PG8_STAGE(PG8_SB(0, 1), cB + hstep, voffB); PG8_STAGE(PG8_SA(0, 1), cA + hstep, voffA);
    if (wr == 1) PG8_BAR;
    PG8_WAIT_V(4); PG8_BAR;
    PG8_STAGE(PG8_SB(1, 0), cB + kstep, voffB); PG8_STAGE(PG8_SA(1, 0), cA + kstep, voffA); PG8_STAGE(PG8_SB(1, 1), cB + hstep + kstep, voffB);
    PG8_WAIT_V(6); PG8_BAR;
    PG8_STAMP();
    for (;;) {
        const bool has_next = S.next(ui + 1, nxt);
        const char* nA = has_next ? (const char*)g.A + (size_t)nxt.pm * tstep : cA; const char* nB = has_next ? (const char*)g.Bt + (size_t)nxt.pn * tstep : cB;
_Pragma("nounroll")
        for (int t = 0; t < nt; t += 2) {
            const bool last = (t == nt - 2);
            const char* a1 = cA + (size_t)(t + 1) * kstep;
            const char* a2 = last ? nA : cA + (size_t)(t + 2) * kstep; const char* b2 = last ? nB : cB + (size_t)(t + 2) * kstep;
            const char* a3 = a2 + kstep; const char* b3 = b2 + kstep;
            if (last && has_next) S.a_ready(nxt);
            PG8_LDB(B0, 0, 0); PG8_SCHED; PG8_LDA(At, 0, 0); PG8_STAGE(PG8_SA(1, 1), a1 + hstep, voffA);
            PG8_WAIT_L(8); PG8_BAR; PG8_WAIT_L(0); PG8_MMA(0, 0, At, B0); PG8_BAR; PG8_SCHED;
            PG8_LDB(B1, 0, 1); PG8_STAGE(PG8_SB(0, 0), b2, voffB);
            PG8_BAR; PG8_WAIT_L(0); PG8_MMA(0, 1, At, B1); PG8_BAR;
            PG8_LDA(At, 0, 1); PG8_STAGE(PG8_SA(0, 0), a2, voffA);
            PG8_BAR; PG8_WAIT_L(0); PG8_MMA(1, 0, At, B0); PG8_BAR; PG8_SCHED;
            PG8_STAGE(PG8_SB(0, 1), b2 + hstep, voffB);
            PG8_WAIT_V(6); PG8_BAR; PG8_MMA(1, 1, At, B1); PG8_BAR;
            PG8_LDB(B0, 1, 0); PG8_SCHED; PG8_LDA(At, 1, 0); PG8_STAGE(PG8_SA(0, 1), a2 + hstep, voffA);
            PG8_WAIT_L(8); PG8_BAR; PG8_WAIT_L(0); PG8_MMA(0, 0, At, B0); PG8_BAR; PG8_SCHED;
            PG8_LDB(B1, 1, 1); PG8_STAGE(PG8_SB(1, 0), b3, voffB);
            PG8_BAR; PG8_WAIT_L(0); PG8_MMA(0, 1, At, B1); PG8_BAR;
            PG8_LDA(At, 1, 1); PG8_STAGE(PG8_SA(1, 0), a3, voffA);
            PG8_BAR; PG8_WAIT_L(0); PG8_MMA(1, 0, At, B0); PG8_BAR; PG8_SCHED;
            PG8_STAGE(PG8_SB(1, 1), b3 + hstep, voffB);
            PG8_WAIT_V(6); PG8_BAR; PG8_MMA(1, 1, At, B1); PG8_BAR;
        }
        PG8_STAMP();
        if constexpr (!Epi::AFTER_DRAIN) { E(acc, cur, wr, wc, fr, fq); S.done(cur); }
        PG8_STAMP();
        if (!has_next) break;
#pragma unroll
        for (int a = 0; a < 2; ++a)
#pragma unroll
            for (int b = 0; b < 2; ++b)
#pragma unroll
                for (int m = 0; m < 4; ++m)
#pragma unroll
                    for (int n = 0; n < 2; ++n) acc[a][b][m][n] = (f32x4){0.f, 0.f, 0.f, 0.f};
        cur = nxt; cA = nA; cB = nB; ++ui;
    }
    PG8_WAIT_V(0);
    if (wr == 0) PG8_BAR;
    PG8_BAR;
    if constexpr (Epi::AFTER_DRAIN) { E.fused(acc, cur, wr, wc, fr, fq, lds, wid, lane); S.done(cur); }
    PG8_STAMP();
    if (STAMP && wid == 0) { stamps[lane] = lane < nts ? (((unsigned long long)(unsigned)ts_hi << 32) | (unsigned)ts_lo) : 0ull;
        if (lane == 62) stamps[62] = rt_entry; if (lane == 63) stamps[63] = (unsigned long long)wall_clock64(); }
#undef PG8_STAMP
#undef PG8_SA
#undef PG8_SB
#undef PG8_STAGE
#undef PG8_LDA
#undef PG8_LDB
#undef PG8_MMA
#undef PG8_WAIT_V
#undef PG8_WAIT_L
#undef PG8_BAR
#undef PG8_SCHED
}

}
#define XB_TMO      128
#define XB_XCNT(j)  (256  + 64 * (j))
#define XB_XSUB(j)  (1280 + 64 * (j))
#define XB_XGEN(j)  (2304 + 64 * (j))
#define XB_TOP      3328
#define XB_TOPGEN   3392
#define XCD_BAR_WORDS 3456
#define XB_SPIN_CAP (1u << 18)
#define LAS __attribute__((address_space(3)))

__device__ __forceinline__ unsigned xb_ld(unsigned* p)              { return __hip_atomic_load(p, __ATOMIC_RELAXED, __HIP_MEMORY_SCOPE_AGENT); }
__device__ __forceinline__ unsigned xb_add(unsigned* p, unsigned v) { return __hip_atomic_fetch_add(p, v, __ATOMIC_RELAXED, __HIP_MEMORY_SCOPE_AGENT); }
__device__ __forceinline__ unsigned xb_xcc_id() { return (unsigned)__builtin_amdgcn_s_getreg((3 << 11) | 20) & 0xFu; }
#define XB_SPIN(cond, bar) do { unsigned _sp = 0; while (cond) { __builtin_amdgcn_s_sleep(1); \
    if ((++_sp & 255u) == 0u) { if (xb_ld(&(bar)[XB_TMO])) break; if (_sp > XB_SPIN_CAP) { atomicAdd(&(bar)[XB_TMO], 1u); break; } } } } while (0)

struct XcdBarrier {
    unsigned* bar; unsigned x;
    volatile LAS unsigned* st;
};

__device__ __forceinline__ XcdBarrier xcd_barrier_post(unsigned* bar, volatile LAS unsigned* st) {
    XcdBarrier b; b.bar = bar; b.x = xb_xcc_id(); b.st = st;
    if (threadIdx.x == 0) (void)xb_add(&bar[XB_XCNT(b.x)], 1u);
    return b;
}
__device__ __forceinline__ void xcd_barrier_complete(unsigned* bar, unsigned x, unsigned& nloc, unsigned& nx) {
    const unsigned G = gridDim.x * gridDim.y * gridDim.z;
    unsigned sum, cnt, mine, sp = 0u;
    for (;;) {
        sum = 0u; cnt = 0u; mine = 0u;
#pragma unroll
        for (unsigned j = 0; j < 16; ++j) { const unsigned c = xb_ld(&bar[XB_XCNT(j)]); sum += c; cnt += (c > 0u) ? 1u : 0u; mine = (j == x) ? c : mine; }
        if (sum == G) break;
        __builtin_amdgcn_s_sleep(1);
        if ((++sp & 255u) == 0u) { if (xb_ld(&bar[XB_TMO])) break; if (sp > XB_SPIN_CAP) { atomicAdd(&bar[XB_TMO], 1u); break; } }
    }
    nloc = mine > 0u ? mine : 1u; nx = cnt > 0u ? cnt : 1u;
}

__device__ __forceinline__ void xcd_barrier(const XcdBarrier& b) {
    asm volatile("s_waitcnt vmcnt(0)" ::: "memory");
    __syncthreads();
    if (threadIdx.x == 0) {
        unsigned* bar = b.bar;
        __builtin_amdgcn_s_waitcnt(0);
        unsigned nloc = b.st[0], nx = b.st[1];
        if (nloc == 0u) { xcd_barrier_complete(bar, b.x, nloc, nx); b.st[0] = nloc; b.st[1] = nx; }
        const unsigned old = xb_add(&bar[XB_XSUB(b.x)], 1u);
        const unsigned gen = old / nloc;
        if (old + 1u == (gen + 1u) * nloc) {
            __builtin_amdgcn_fence(__ATOMIC_RELEASE, "agent");
            asm volatile("s_waitcnt vmcnt(0)" ::: "memory");
            const unsigned og = xb_add(&bar[XB_TOP], 1u);
            const unsigned tg = og / nx;
            if (og + 1u == (tg + 1u) * nx) xb_add(&bar[XB_TOPGEN], 1u);
            else XB_SPIN(xb_ld(&bar[XB_TOPGEN]) == tg, bar);
            __builtin_amdgcn_fence(__ATOMIC_ACQUIRE, "agent");
            xb_add(&bar[XB_XGEN(b.x)], 1u);
            asm volatile("s_waitcnt vmcnt(0)" ::: "memory");
        } else {
            XB_SPIN(xb_ld(&bar[XB_XGEN(b.x)]) == gen, bar);
            __builtin_amdgcn_fence(__ATOMIC_ACQUIRE, "agent");
            asm volatile("s_waitcnt vmcnt(0)" ::: "memory");
        }
    }
    __syncthreads();
}


#define LAS __attribute__((address_space(3)))
typedef float f32x4 __attribute__((ext_vector_type(4)));
typedef unsigned u32x4 __attribute__((ext_vector_type(4)));
typedef unsigned u32x2 __attribute__((ext_vector_type(2)));
typedef float f32x2 __attribute__((ext_vector_type(2)));
typedef short bf16x8_t __attribute__((ext_vector_type(8)));
typedef float f32x16 __attribute__((ext_vector_type(16)));
constexpr int NTHR = 512;
constexpr int LDS_BYTES = 147456;
constexpr int LDS_MISC = LDS_BYTES - 256;

struct Params {
    const float *x_prompt, *x_sample, *cache_kv, *cache_kr, *state_pool, *state_conv, *state_delta; const int* page_table;
    const float *norm_g, *w_in, *pool_mix, *pool_scale, *q_norm_g, *w_uq, *kv_norm_g, *w_uk, *w_uv, *conv_w, *a_log, *dt_bias, *dn_norm_g, *w_br0, *w_br1, *w_br2, *w_out, *final_norm_g;
    float* out;
    bf16_t *WinT, *WuqT, *WkvT, *WbrT, *WoutT; float2* tab;
    float* xres; bf16_t* xn; bf16_t* H; float* BA; bf16_t *cq, *ckv, *Kr, *Q, *Kn, *V, *Vt, *qd, *kd, *vd; float* bg; bf16_t *ya, *yb, *yc; float* mf; bf16_t* mb; float* part; bf16_t* DOP; float* DU; float* DG;
    unsigned* bar;
    int ph_lo, ph_hi, li, pad;
};

typedef const __attribute__((address_space(4))) Params* KP;

constexpr int PH_PRO = 0;
constexpr int PH_L = 8;
constexpr int PH_GIN = 0, PH_TOK = 1, PH_GQ = 2, PH_ATT = 3, PH_FIN = 4, PH_MERGE = 5, PH_OUT = 6, PH_NORM = 7;
#define PHID(l, k) (1 + (l) * PH_L + (k))
constexpr int PH_END = 1 + 2 * PH_L;

struct MEpiH { static constexpr bool PERM = true, AFTER_DRAIN = false; bf16_t* H; float* BA;
    __device__ __forceinline__ void operator()(const f32x4 (&acc)[2][2][4][2], const pg8::Unit& u, int wr, int wc, int fr0, int fq0) const {
        int fr = fr0, fq = fq0; asm volatile("" : "+v"(fr), "+v"(fq));
        const int row0 = u.pm * 256 + wr * 64 + fr;
#pragma unroll
        for (int bj = 0; bj < 2; ++bj) {
            const int wcol = u.pn * 256 + bj * 128 + wc * 32, col0 = wcol + 8 * fq;
            const bool plain = (wcol + 32 <= C_ZPOOL) || (wcol >= C_Q && wcol + 32 <= C_ZMLA) || (wcol >= C_QKV && wcol + 32 <= C_ZDN);
            const int act = ((col0 >= C_ZPOOL && col0 < C_Q) || (col0 >= C_ZMLA && col0 < C_QKV) || (col0 >= C_ZDN && col0 < C_BETA)) ? 1 : (col0 >= C_GATE ? 2 : 0);
            const bool isba = (col0 == C_BETA) || (col0 == C_ALPHA);
#pragma unroll
            for (int ai = 0; ai < 2; ++ai)
#pragma unroll
                for (int m = 0; m < 4; ++m) { const int row = row0 + ai * 128 + m * 16; f32x4 v0 = acc[ai][bj][m][0], v1 = acc[ai][bj][m][1];
                    if (!plain) {
                        if (isba) { float* b = BA + (size_t)row * 16 + (col0 - C_BETA); *(f32x4*)b = v0; *(f32x4*)(b + 4) = v1; }
#pragma unroll
                        for (int e = 0; e < 4; ++e) { const float s0 = sigmoidf_(v0[e]), s1 = sigmoidf_(v1[e]);
                            v0[e] = act == 0 ? v0[e] : (act == 1 ? v0[e] * s0 : s0); v1[e] = act == 0 ? v1[e] : (act == 1 ? v1[e] * s1 : s1); }
                    }
                    u32x4 w; w.x = pg8::cvt_pk_bf16(v0[0], v0[1]); w.y = pg8::cvt_pk_bf16(v0[2], v0[3]); w.z = pg8::cvt_pk_bf16(v1[0], v1[1]); w.w = pg8::cvt_pk_bf16(v1[2], v1[3]);
                    *(u32x4*)(H + (size_t)row * IN_WP + col0) = w; }
        }
    } };
struct MEpiQ { static constexpr bool PERM = true, AFTER_DRAIN = false; bf16_t* Q; const float2* tab;
    __device__ __forceinline__ void operator()(const f32x4 (&acc)[2][2][4][2], const pg8::Unit& u, int wr, int wc, int fr0, int fq0) const {
        int fr = fr0, fq = fq0; asm volatile("" : "+v"(fr), "+v"(fq));
        const int row0 = u.pm * 256 + wr * 64 + fr;
#pragma unroll
        for (int bj = 0; bj < 2; ++bj) {
            const int wcol = u.pn * 256 + bj * 128 + wc * 32, col0 = wcol + 8 * fq;
            const bool rope = (wcol % 96) == 64;
#pragma unroll
            for (int ai = 0; ai < 2; ++ai)
#pragma unroll
                for (int m = 0; m < 4; ++m) { const int row = row0 + ai * 128 + m * 16; f32x4 v0 = acc[ai][bj][m][0], v1 = acc[ai][bj][m][1];
                    if (rope) { const int p = row < TP ? (row & (SEQ - 1)) : SEQ + ((row - TP) & 7); const float2* tp = tab + p * 16 + (fq & 1) * 8; const bool hi = fq >= 2;
#pragma unroll
                        for (int e = 0; e < 4; ++e) { const float o0 = __shfl_xor(v0[e], 32), o1 = __shfl_xor(v1[e], 32); const float2 c0 = tp[e], c1 = tp[4 + e];
                            v0[e] = hi ? (v0[e] * c0.x + o0 * c0.y) : (v0[e] * c0.x - o0 * c0.y); v1[e] = hi ? (v1[e] * c1.x + o1 * c1.y) : (v1[e] * c1.x - o1 * c1.y); } }
                    u32x4 w; w.x = pg8::cvt_pk_bf16(v0[0], v0[1]); w.y = pg8::cvt_pk_bf16(v0[2], v0[3]); w.z = pg8::cvt_pk_bf16(v1[0], v1[1]); w.w = pg8::cvt_pk_bf16(v1[2], v1[3]);
                    *(u32x4*)(Q + (size_t)row * 768 + col0) = w; asm volatile("" ::: "memory"); }
        }
    } };
struct MEpiKV { static constexpr bool PERM = true, AFTER_DRAIN = false; bf16_t* Kn; bf16_t* V;
    __device__ __forceinline__ void operator()(const f32x4 (&acc)[2][2][4][2], const pg8::Unit& u, int wr, int wc, int fr0, int fq0) const {
        int fr = fr0, fq = fq0; asm volatile("" : "+v"(fr), "+v"(fq));
        const int row0 = u.pm * 256 + wr * 64 + fr; bf16_t* base = u.pn < 2 ? Kn : V; const int cb = (u.pn & 1) * 256;
#pragma unroll
        for (int bj = 0; bj < 2; ++bj) { const int col0 = cb + bj * 128 + wc * 32 + 8 * fq;
#pragma unroll
            for (int ai = 0; ai < 2; ++ai)
#pragma unroll
                for (int m = 0; m < 4; ++m) { const int row = row0 + ai * 128 + m * 16; const f32x4 v0 = acc[ai][bj][m][0], v1 = acc[ai][bj][m][1];
                    u32x4 w; w.x = pg8::cvt_pk_bf16(v0[0], v0[1]); w.y = pg8::cvt_pk_bf16(v0[2], v0[3]); w.z = pg8::cvt_pk_bf16(v1[0], v1[1]); w.w = pg8::cvt_pk_bf16(v1[2], v1[3]);
                    *(u32x4*)(base + (size_t)row * 512 + col0) = w; } }
    } };
template <int BR> struct MEpiMerge { static constexpr bool PERM = true, AFTER_DRAIN = false; const bf16_t* H; float* mf; bf16_t* mb;
    __device__ __forceinline__ void operator()(const f32x4 (&acc)[2][2][4][2], const pg8::Unit& u, int wr, int wc, int fr0, int fq0) const {
        int fr = fr0, fq = fq0; asm volatile("" : "+v"(fr), "+v"(fq));
        const int row0 = u.pm * 256 + wr * 64 + fr;
#pragma unroll
        for (int bj = 0; bj < 2; ++bj) { const int col0 = u.pn * 256 + bj * 128 + wc * 32 + 8 * fq;
#pragma unroll
            for (int ai = 0; ai < 2; ++ai)
#pragma unroll
                for (int m = 0; m < 4; ++m) { const int row = row0 + ai * 128 + m * 16; f32x4 v0 = acc[ai][bj][m][0], v1 = acc[ai][bj][m][1];
                    const u32x4 g = *(const u32x4*)(H + (size_t)row * IN_WP + C_GATE + BR * 1024 + col0);
                    v0[0] *= __uint_as_float(g.x << 16); v0[1] *= __uint_as_float(g.x & 0xffff0000u); v0[2] *= __uint_as_float(g.y << 16); v0[3] *= __uint_as_float(g.y & 0xffff0000u);
                    v1[0] *= __uint_as_float(g.z << 16); v1[1] *= __uint_as_float(g.z & 0xffff0000u); v1[2] *= __uint_as_float(g.w << 16); v1[3] *= __uint_as_float(g.w & 0xffff0000u);
                    float* mp = mf + (size_t)row * 1024 + col0;
                    if (BR > 0) { v0 += *(const f32x4*)mp; v1 += *(const f32x4*)(mp + 4); }
                    if (BR < 2) { *(f32x4*)mp = v0; *(f32x4*)(mp + 4) = v1; }
                    else { u32x4 w; w.x = pg8::cvt_pk_bf16(v0[0], v0[1]); w.y = pg8::cvt_pk_bf16(v0[2], v0[3]); w.z = pg8::cvt_pk_bf16(v1[0], v1[1]); w.w = pg8::cvt_pk_bf16(v1[2], v1[3]);
                        *(u32x4*)(mb + (size_t)row * 1024 + col0) = w; } asm volatile("" ::: "memory"); } }
    } };
struct MEpiRes { static constexpr bool PERM = false, AFTER_DRAIN = false; const float* xp; const float* xs; float* xo;
    __device__ __forceinline__ void operator()(const f32x4 (&acc)[2][2][4][2], const pg8::Unit& u, int wr, int wc, int fr0, int fq0) const {
        int fr = fr0, fq = fq0; asm volatile("" : "+v"(fr), "+v"(fq));
        const int row0 = u.pm * 256 + wr * 64 + fr, col0 = u.pn * 256 + wc * 32 + 4 * fq;
#pragma unroll
        for (int ai = 0; ai < 2; ++ai)
#pragma unroll
            for (int m = 0; m < 4; ++m) { const int row = row0 + ai * 128 + m * 16; const float* xr = row < TP ? xp + (size_t)row * 1024 : xs + (size_t)(row - TP) * 1024; float* orow = xo + (size_t)row * 1024;
#pragma unroll
                for (int bj = 0; bj < 2; ++bj)
#pragma unroll
                    for (int n = 0; n < 2; ++n) { const int c = col0 + bj * 128 + n * 16; *(f32x4*)(orow + c) = *(const f32x4*)(xr + c) + acc[ai][bj][m][n]; } }
    } };

__device__ __forceinline__ void ph_tr(const float* __restrict__ src, bf16_t* __restrict__ dst, int K, int N, int Npad, LAS float* tile, int rot) {
    int tid = threadIdx.x; asm volatile("" : "+v"(tid)); const int G = gridDim.x; const int tn = Npad / 64, tk = K / 32, nt = tn * tk;
    const int first = (blockIdx.x + G - (rot % G)) % G;
    for (int t = first; t < nt; t += G) {
        const int n0 = (t % tn) * 64, k0 = (t / tn) * 32;
        { const int tx = tid & 63, ty = tid >> 6;
#pragma unroll
          for (int i = 0; i < 4; ++i) { const int k = ty + 8 * i, n = n0 + tx; tile[k * 65 + tx] = n < N ? src[(size_t)(k0 + k) * N + n] : 0.f; } }
        __syncthreads();
        { const int kx = tid & 31, ny = tid >> 5;
#pragma unroll
          for (int i = 0; i < 4; ++i) { const int n = ny + 16 * i; dst[(size_t)(n0 + n) * K + k0 + kx] = f2bf(tile[kx * 65 + n]); } }
        __syncthreads();
    }
}
__device__ __forceinline__ void ph_rope_tab(float2* tab) {
    for (int idx = blockIdx.x * NTHR + threadIdx.x; idx < (SEQ + DEC_SEQ) * 16; idx += gridDim.x * NTHR) {
        const int p = idx >> 4, i = idx & 15; const int pos = p < SEQ ? p : PAST_LEN + (p - SEQ);
        const float inv = powf(10000.0f, -(float)i / 16.0f); const float ang = (float)pos * inv;
        const double rev = (double)ang * 0.15915494309189533576888; const float f = (float)(rev - floor(rev));
        tab[idx] = make_float2(__builtin_amdgcn_cosf(f), __builtin_amdgcn_sinf(f)); }
}
__device__ __forceinline__ void ph_rmsnorm(const float* __restrict__ xp, const float* __restrict__ xs, const float* __restrict__ g, bf16_t* __restrict__ xn, float* __restrict__ yp, float* __restrict__ ys) {
    int tid_o = threadIdx.x; asm volatile("" : "+v"(tid_o)); int lane = tid_o & 63, wave = tid_o >> 6;
    for (int t = blockIdx.x * 8 + wave; t < TT; t += gridDim.x * 8) {
        const float* x = t < TP ? xp + (size_t)t * 1024 : xs + (size_t)(t - TP) * 1024;
        f32x4 v[4]; float ss = 0.f;
#pragma unroll
        for (int i = 0; i < 4; ++i) { v[i] = *(const f32x4*)(x + i * 256 + lane * 4); ss += v[i][0] * v[i][0] + v[i][1] * v[i][1] + v[i][2] * v[i][2] + v[i][3] * v[i][3]; }
        ss = wave_sum(ss); const float r = rsqrtf(ss * (1.0f / 1024.0f) + EPS);
#pragma unroll
        for (int i = 0; i < 4; ++i) { const int c = i * 256 + lane * 4; const f32x4 gg = *(const f32x4*)(g + c); const f32x4 o = v[i] * r * gg;
            if (xn) { u32x2 w; w.x = pg8::cvt_pk_bf16(o[0], o[1]); w.y = pg8::cvt_pk_bf16(o[2], o[3]); *(u32x2*)(xn + (size_t)t * 1024 + c) = w; }
            else { float* y = t < TP ? yp + (size_t)t * 1024 : ys + (size_t)(t - TP) * 1024; *(f32x4*)(y + c) = o; } }
    }
}

__device__ __forceinline__ void ph_tok(KP p, int l, LAS unsigned char* lds) {
    int tid_o = threadIdx.x; asm volatile("" : "+v"(tid_o)); int lane = tid_o & 63, wave = tid_o >> 6;
    const bf16_t* __restrict__ H = p->H; float* __restrict__ out = p->out;
    const float* qg = p->q_norm_g + l * 384; const float* kvg = p->kv_norm_g + l * 256; const float* conv_w = p->conv_w + (size_t)l * 4 * 1536;
    LAS float* dl = (LAS float*)(lds + wave * 2048);
    for (int t = blockIdx.x * 8 + wave; t < TT; t += gridDim.x * 8) {
        const bf16_t* h = H + (size_t)t * IN_WP;
        int i_seq, row0, pidx; const bool smp = t >= TP; const int ts = t - TP;
        if (!smp) { i_seq = t & (SEQ - 1); row0 = t - i_seq; pidx = i_seq; } else { i_seq = ts & 7; row0 = t - i_seq; pidx = SEQ + i_seq; }
        { float q[6]; float ss = 0.f;
#pragma unroll
          for (int i = 0; i < 6; ++i) { q[i] = bf2f(h[C_Q + lane + 64 * i]); ss += q[i] * q[i]; }
          ss = wave_sum(ss); float r = rsqrtf(ss * (1.0f / 384.0f) + EPS);
#pragma unroll
          for (int i = 0; i < 6; ++i) p->cq[(size_t)t * 384 + lane + 64 * i] = f2bf(q[i] * r * qg[lane + 64 * i]);
          float kv[4]; ss = 0.f;
#pragma unroll
          for (int i = 0; i < 4; ++i) { kv[i] = bf2f(h[C_KV + lane + 64 * i]); ss += kv[i] * kv[i]; }
          ss = wave_sum(ss); r = rsqrtf(ss * (1.0f / 256.0f) + EPS);
          float* okv; float* okr;
          if (!smp) { okv = out + O_PKV + ((size_t)l * TP + t) * 256; okr = out + O_PKR + ((size_t)l * TP + t) * 32; }
          else { okv = out + O_SKV + ((size_t)l * TS + ts) * 256; okr = out + O_SKR + ((size_t)l * TS + ts) * 32; }
#pragma unroll
          for (int i = 0; i < 4; ++i) { const float o = kv[i] * r * kvg[lane + 64 * i]; okv[lane + 64 * i] = o; p->ckv[(size_t)t * 256 + lane + 64 * i] = f2bf(o); }
          if (lane < 16) { const float x1 = bf2f(h[C_KR + lane]), x2 = bf2f(h[C_KR + 16 + lane]); const float2 cs = p->tab[pidx * 16 + lane];
              const float o1 = x1 * cs.x - x2 * cs.y, o2 = x2 * cs.x + x1 * cs.y;
              okr[lane] = o1; okr[16 + lane] = o2; p->Kr[(size_t)t * 32 + lane] = f2bf(o1); p->Kr[(size_t)t * 32 + 16 + lane] = f2bf(o2); } }
        { const float* sc = smp ? p->state_conv + ((size_t)l * DEC_BATCH + (ts >> 3)) * 3 * 1536 : nullptr;
#pragma unroll 4
          for (int i = 0; i < 24; ++i) { const int c = lane + 64 * i; float y = 0.f;
#pragma unroll
              for (int j = 0; j < 4; ++j) { const int u = i_seq - 3 + j; float xv;
                  if (u >= 0) xv = bf2f(H[(size_t)(row0 + u) * IN_WP + C_QKV + c]); else xv = sc ? sc[(size_t)(u + 3) * 1536 + c] : 0.f;
                  y += xv * conv_w[j * 1536 + c]; }
              float v = siluf_(y);
              if (i < 16) { const float ss = wave_sum(v * v); v *= rsqrtf(ss + EPS); if (i < 8) v *= 0.125f; }
              const bf16_t o = f2bf(v);
              if (i < 8) p->qd[(size_t)t * 512 + c] = o; else if (i < 16) p->kd[(size_t)t * 512 + (c - 512)] = o; else p->vd[(size_t)t * 512 + (c - 1024)] = o;
              if (!smp) { if (i_seq >= SEQ - 3) out[O_PCONV + (((size_t)l * 8 + (t >> 11)) * 3 + (i_seq - (SEQ - 3))) * 1536 + c] = bf2f(h[C_QKV + c]); }
              else { if (i_seq >= DEC_SEQ - 3) out[O_SCONV + (((size_t)l * DEC_BATCH + (ts >> 3)) * 3 + (i_seq - (DEC_SEQ - 3))) * 1536 + c] = bf2f(h[C_QKV + c]); } }
          if (lane < 8) { const float b = sigmoidf_(p->BA[(size_t)t * 16 + lane]); const float x = p->BA[(size_t)t * 16 + 8 + lane] + p->dt_bias[l * 8 + lane];
              const float sp = x > 20.f ? x : log1pf(expf(x)); const float g = -expf(p->a_log[l * 8 + lane]) * sp;
              p->bg[(size_t)t * 16 + lane] = b; p->bg[(size_t)t * 16 + 8 + lane] = g; } }
        { const float* sp = smp ? p->state_pool + ((size_t)l * DEC_BATCH + (ts >> 3)) * 15 * 512 : nullptr;
          float* so = smp ? out + O_SPOOL + ((size_t)l * DEC_BATCH + (ts >> 3)) * 15 * 512 : nullptr;
#pragma unroll
          for (int j = 0; j < 8; ++j) { const int ch = lane + 64 * j, g = j >> 1, w = 2 << g; float sum = 0.f;
              for (int k = 0; k < w; ++k) { const int u = i_seq - k; float xv;
                  if (u >= 0) xv = bf2f(H[(size_t)(row0 + u) * IN_WP + C_POOL + ch]); else xv = sp ? sp[(size_t)(15 + u) * 512 + ch] : 0.f;
                  sum += xv; }
              const float cur = bf2f(h[C_POOL + ch]); const float cnt = !smp ? (float)min(i_seq + 1, w) : (float)w;
              dl[ch] = sum / cnt - cur;
              if (!smp) { if (i_seq >= SEQ - 15) out[O_PPOOL + (((size_t)l * 8 + (t >> 11)) * 15 + (i_seq - (SEQ - 15))) * 512 + ch] = cur; }
              else { so[(size_t)(7 + i_seq) * 512 + ch] = cur; if (i_seq < 7) so[(size_t)i_seq * 512 + ch] = sp[(size_t)(8 + i_seq) * 512 + ch]; } }
          asm volatile("s_waitcnt lgkmcnt(0)" ::: "memory");
#pragma unroll
          for (int j = 0; j < 8; ++j) { const int ch = lane + 64 * j, g = j >> 1, c = ch & 127; const float* m = p->pool_mix + ((size_t)l * 4 + g) * 128 * 128; float y = 0.f;
              for (int k = 0; k < 128; ++k) y += dl[g * 128 + k] * m[k * 128 + c];
              y *= p->pool_scale[l * 512 + ch]; y *= bf2f(h[C_ZPOOL + ch]); p->ya[(size_t)t * 512 + ch] = f2bf(y); }
          asm volatile("s_waitcnt lgkmcnt(0)" ::: "memory"); }
    }
}

__device__ __forceinline__ void ph_attn_s(KP p, int l, LAS unsigned char* lds) {
    int tid = threadIdx.x; asm volatile("" : "+v"(tid));
    const int r = tid & 63, cq = tid >> 6;
    LAS bf16_t* Ks = (LAS bf16_t*)lds;
    LAS float* Ss = (LAS float*)(lds + 18944);
    LAS bf16_t* Qs = (LAS bf16_t*)(lds + 18944 + 8448);
    const float* w_uk = p->w_uk + (size_t)l * 256 * 512;
    for (int u = blockIdx.x; u < DEC_BATCH; u += gridDim.x) {
        const int s = u, ch = 32;
        __syncthreads();
        { const int c = tid & 255, hh = tid >> 8;
          for (int h = hh * 4; h < hh * 4 + 4; ++h) { float acc[8];
#pragma unroll
              for (int i = 0; i < 8; ++i) acc[i] = 0.f;
              const float* wr_ = w_uk + (size_t)c * 512 + h * 64;
              for (int d = 0; d < 64; d += 4) { const f32x4 wv = *(const f32x4*)(wr_ + d);
#pragma unroll
                  for (int i = 0; i < 8; ++i) { const bf16_t* q = p->Q + (size_t)(TP + s * 8 + i) * 768 + h * 96 + d;
                      acc[i] += bf2f(q[0]) * wv[0] + bf2f(q[1]) * wv[1] + bf2f(q[2]) * wv[2] + bf2f(q[3]) * wv[3]; } }
#pragma unroll
              for (int i = 0; i < 8; ++i) Qs[(i * 8 + h) * 290 + c] = f2bf(acc[i]); }
          for (int e = tid; e < 64 * 32; e += NTHR) { const int rr = e >> 5, j = e & 31; Qs[rr * 290 + 256 + j] = p->Q[(size_t)(TP + s * 8 + (rr >> 3)) * 768 + (rr & 7) * 96 + 64 + j]; } }
        float o[32];
#pragma unroll
        for (int d = 0; d < 32; ++d) o[d] = 0.f;
        float m = -1e30f, lsum = 0.f; const int i_tok = r >> 3; const int ntile = ch < 32 ? 16 : 1;
        for (int tl = 0; tl < ntile; ++tl) {
            __syncthreads();
            if (ch < 32) { const int j0 = ch * 512 + tl * 32; const int page = p->page_table[s * N_PAGES + (j0 >> 7)]; const int prow = j0 & 127;
                const float* kvp = p->cache_kv + (((size_t)l * N_POOL + page) * PAGE + prow) * 256; const float* krp = p->cache_kr + (((size_t)l * N_POOL + page) * PAGE + prow) * 32;
                for (int i = tid; i < 32 * 256; i += NTHR) Ks[(i >> 8) * 296 + (i & 255)] = f2bf(kvp[i]);
                for (int i = tid; i < 32 * 32; i += NTHR) Ks[(i >> 5) * 296 + 256 + (i & 31)] = f2bf(krp[i]);
            } else {
                for (int i = tid; i < 32 * 256; i += NTHR) { const int k = i >> 8; Ks[k * 296 + (i & 255)] = k < 8 ? p->ckv[((size_t)TP + s * 8 + k) * 256 + (i & 255)] : (bf16_t)0; }
                for (int i = tid; i < 32 * 32; i += NTHR) { const int k = i >> 5; Ks[k * 296 + 256 + (i & 31)] = k < 8 ? p->Kr[((size_t)TP + s * 8 + k) * 32 + (i & 31)] : (bf16_t)0; }
            }
            __syncthreads();
#pragma unroll
            for (int kk = 0; kk < 4; ++kk) { const int k = cq * 4 + kk; float sc = 0.f;
                for (int c = 0; c < 288; ++c) sc += bf2f(Qs[r * 290 + c]) * bf2f(Ks[k * 296 + c]);
                sc *= MLA_SCALE; if (ch == 32 && k > i_tok) sc = -1e30f; Ss[r * 33 + k] = sc; }
            __syncthreads();
            float tm = -1e30f;
            for (int k = 0; k < 32; ++k) tm = fmaxf(tm, Ss[r * 33 + k]);
            const float mn = fmaxf(m, tm), al = __expf(m - mn); m = mn; lsum *= al;
#pragma unroll
            for (int d = 0; d < 32; ++d) o[d] *= al;
            for (int k = 0; k < 32; ++k) { const float sc = Ss[r * 33 + k]; const float pr = sc <= -1e29f ? 0.f : __expf(sc - mn); lsum += pr;
#pragma unroll
                for (int d = 0; d < 32; ++d) o[d] += pr * bf2f(Ks[k * 296 + cq * 32 + d]); }
        }
        float* pp = p->part + (((size_t)s * SA_CH + 8) * 64 + r) * 258;
#pragma unroll
        for (int d = 0; d < 32; ++d) pp[cq * 32 + d] = o[d];
        if (cq == 0) { pp[256] = m; pp[257] = lsum; }
    }
    __syncthreads();
}

__device__ __forceinline__ void wu_delta(KP p, int l, int sq, int h, int dv) {
    int row0, L; float* so; float S[64];
    if (sq < 8) { row0 = sq * SEQ; L = SEQ; so = p->out + O_PDELTA + (((size_t)l * 8 + sq) * 8 + h) * 4096;
#pragma unroll
        for (int k = 0; k < 64; ++k) S[k] = 0.f; }
    else { const int s = sq - 8; row0 = TP + s * 8; L = DEC_SEQ; so = p->out + O_SDELTA + (((size_t)l * DEC_BATCH + s) * 8 + h) * 4096;
        const float* s0 = p->state_delta + (((size_t)l * DEC_BATCH + s) * 8 + h) * 4096;
#pragma unroll
        for (int k = 0; k < 64; ++k) S[k] = s0[k * 64 + dv]; }
    const float gn = p->dn_norm_g[l * 64 + dv];
    for (int i = 0; i < L; ++i) {
        const size_t t = (size_t)row0 + i; const u32x4* kp = (const u32x4*)(p->kd + t * 512 + h * 64); const u32x4* qp = (const u32x4*)(p->qd + t * 512 + h * 64);
        const float b = p->bg[t * 16 + h], a = __expf(p->bg[t * 16 + 8 + h]); const float v = bf2f(p->vd[t * 512 + h * 64 + dv]);
        u32x4 kk[8];
#pragma unroll
        for (int c = 0; c < 8; ++c) kk[c] = kp[c];
        float ks = 0.f;
#pragma unroll
        for (int c = 0; c < 8; ++c)
#pragma unroll
            for (int e = 0; e < 4; ++e) { const unsigned w = kk[c][e]; ks += __uint_as_float(w << 16) * S[c * 8 + 2 * e] + __uint_as_float(w & 0xffff0000u) * S[c * 8 + 2 * e + 1]; }
        const float vn = b * (v - a * ks); float o = 0.f;
#pragma unroll
        for (int c = 0; c < 8; ++c) { const u32x4 qv = qp[c];
#pragma unroll
            for (int e = 0; e < 4; ++e) { const unsigned w = kk[c][e], wq = qv[e]; const int k0 = c * 8 + 2 * e;
                S[k0] = a * S[k0] + __uint_as_float(w << 16) * vn; o += __uint_as_float(wq << 16) * S[k0];
                S[k0 + 1] = a * S[k0 + 1] + __uint_as_float(w & 0xffff0000u) * vn; o += __uint_as_float(wq & 0xffff0000u) * S[k0 + 1]; }
            asm volatile("" ::: "memory"); }
        const float ss = wave_sum(o * o); const float y = o * rsqrtf(ss * (1.0f / 64.0f) + EPS) * gn;
        p->yc[t * 512 + h * 64 + dv] = f2bf(y * bf2f(p->H[t * IN_WP + C_ZDN + h * 64 + dv]));
    }
#pragma unroll
    for (int k = 0; k < 64; ++k) so[k * 64 + dv] = S[k];
}
__device__ __forceinline__ int sig_inv(int rho) { return (rho & 32) | ((rho & 12) << 1) | ((rho & 16) >> 2) | (rho & 3); }
constexpr int DPRE_LDS = 64 * 64 * 4 + 512;
__device__ __forceinline__ void ph_delta_pre(KP p, LAS unsigned char* lds) {
    int tid_o = threadIdx.x; asm volatile("" : "+v"(tid_o)); int lane = tid_o & 63, wave = tid_o >> 6;
    wave = __builtin_amdgcn_readfirstlane(wave);
    LAS float* Am = (LAS float*)(lds + wave * DPRE_LDS); LAS float* gcs = Am + 4096; LAS float* bts = gcs + 64;
    for (int unit = wave * gridDim.x + blockIdx.x; unit < 2048; unit += gridDim.x * 8) {
        { int t_ = threadIdx.x; asm volatile("" : "+v"(t_)); lane = t_ & 63; }
        const int r = lane & 31, hh = lane >> 5;
        const int bh = unit >> 5, ch = unit & 31, b = bh >> 3, h = bh & 7;
        const size_t t0 = (size_t)b * SEQ + ch * 64;
        bf16_t* op = p->DOP + (size_t)unit * 4 * 4096; float* up = p->DU + (size_t)unit * 4096;
        const bf16_t* kdb = p->kd + t0 * 512 + h * 64; const bf16_t* qdb = p->qd + t0 * 512 + h * 64; const bf16_t* vdb = p->vd + t0 * 512 + h * 64;
        const float* bgb = p->bg + t0 * 16 + h;
        const float beta = bgb[lane * 16]; float gc = bgb[lane * 16 + 8];
#pragma unroll
        for (int d = 1; d < 64; d <<= 1) { const float x = __shfl_up(gc, d); if (lane >= d) gc += x; }
        const float gl = __shfl(gc, 63);
        gcs[lane] = gc; bts[lane] = beta;
        if (lane == 0) p->DG[unit] = __expf(gl);
        bf16x8_t kf[2][4], qf[2][4];
        { const int voff = r * 512 + 8 * hh;
#pragma unroll
          for (int rb = 0; rb < 2; ++rb)
#pragma unroll
            for (int ks = 0; ks < 4; ++ks) { kf[rb][ks] = *(const bf16x8_t*)(kdb + (32 * rb * 512 + 16 * ks) + voff); qf[rb][ks] = *(const bf16x8_t*)(qdb + (32 * rb * 512 + 16 * ks) + voff); } }
        {
#pragma unroll
            for (int rb = 0; rb < 2; ++rb) { const float sc = __expf(gl - __shfl(gc, 32 * rb + r)); const int voff = hh * 512 + sig_inv(32 * rb + r);
#pragma unroll
                for (int ks = 0; ks < 4; ++ks) {
#pragma unroll
                    for (int jj = 0; jj < 8; ++jj) (op + 3 * 4096 + (16 * ks + jj) * 64)[voff] = f2bf(bf2f((bf16_t)kf[rb][ks][jj]) * sc);
                    asm volatile("" ::: "memory"); } } }
        f32x16 kk00, kk10, kk11, qk00, qk10, qk11;
#pragma unroll
        for (int e = 0; e < 16; ++e) { kk00[e] = 0.f; kk10[e] = 0.f; kk11[e] = 0.f; qk00[e] = 0.f; qk10[e] = 0.f; qk11[e] = 0.f; }
#pragma unroll
        for (int ks = 0; ks < 4; ++ks) {
            kk00 = __builtin_amdgcn_mfma_f32_32x32x16_bf16(kf[0][ks], kf[0][ks], kk00, 0, 0, 0);
            kk10 = __builtin_amdgcn_mfma_f32_32x32x16_bf16(kf[1][ks], kf[0][ks], kk10, 0, 0, 0);
            kk11 = __builtin_amdgcn_mfma_f32_32x32x16_bf16(kf[1][ks], kf[1][ks], kk11, 0, 0, 0);
            qk00 = __builtin_amdgcn_mfma_f32_32x32x16_bf16(qf[0][ks], kf[0][ks], qk00, 0, 0, 0);
            qk10 = __builtin_amdgcn_mfma_f32_32x32x16_bf16(qf[1][ks], kf[0][ks], qk10, 0, 0, 0);
            qk11 = __builtin_amdgcn_mfma_f32_32x32x16_bf16(qf[1][ks], kf[1][ks], qk11, 0, 0, 0);
        }
        asm volatile("s_waitcnt lgkmcnt(0)" ::: "memory");
        {
            const float gcj0 = __shfl(gc, r), gcj1 = __shfl(gc, 32 + r);
            const int p0 = hh * 256 + sig_inv(r), p1 = hh * 256 + sig_inv(32 + r);
#pragma unroll
            for (int e = 0; e < 16; ++e) { const int ib = (e & 3) + 8 * (e >> 2), il = ib + 4 * hh;
                { const int i = il, j = r; const float gi = gcs[i], bi = bts[i]; const float dec = __expf(fminf(gi - gcj0, 0.f));
                  Am[i * 64 + j] = j < i ? bi * kk00[e] * dec : 0.f; (op + 2 * 4096 + ib * 64)[p0] = f2bf(j <= i ? qk00[e] * dec : 0.f); }
                { const int i = 32 + il, j = r; const float gi = gcs[i], bi = bts[i]; const float dec = __expf(fminf(gi - gcj0, 0.f));
                  Am[i * 64 + j] = bi * kk10[e] * dec; (op + 2 * 4096 + (32 + ib) * 64)[p0] = f2bf(qk10[e] * dec); }
                { const int i = 32 + il, j = 32 + r; const float gi = gcs[i], bi = bts[i]; const float dec = __expf(fminf(gi - gcj1, 0.f));
                  Am[i * 64 + j] = j < i ? bi * kk11[e] * dec : 0.f; (op + 2 * 4096 + (32 + ib) * 64)[p1] = f2bf(j <= i ? qk11[e] * dec : 0.f); }
                asm volatile("" ::: "memory");
            }
        }
        asm volatile("s_waitcnt lgkmcnt(0)" ::: "memory");
        {
            int c; { int t_ = threadIdx.x; asm volatile("" : "+v"(t_)); c = t_ & 63; } const int pc = sig_inv(c);
            const float egc = __expf(gc);
            const int beta_i = __float_as_int(beta), egc_i = __float_as_int(egc);
            { float u[64];
#pragma unroll
              for (int i = 0; i < 64; ++i) { const float bi = __int_as_float(__builtin_amdgcn_readlane(beta_i, i)); u[i] = bi * bf2f((vdb + i * 512)[c]); }
#pragma unroll
              for (int i = 1; i < 64; ++i) { float au = u[i];
#pragma unroll
                  for (int j4 = 0; j4 < i; j4 += 4) { const f32x4 a = *(const LAS f32x4*)(Am + i * 64 + j4);
#pragma unroll
                      for (int e = 0; e < 4; ++e) if (j4 + e < i) au -= a[e] * u[j4 + e]; }
                  u[i] = au; }
#pragma unroll
              for (int i = 0; i < 64; ++i) (up + i * 64)[c] = u[i]; }
            asm volatile("" ::: "memory");
            { float w[64];
#pragma unroll
              for (int i = 0; i < 64; ++i) { const float bi = __int_as_float(__builtin_amdgcn_readlane(beta_i, i)), ei = __int_as_float(__builtin_amdgcn_readlane(egc_i, i));
                  w[i] = bi * ei * bf2f((kdb + i * 512)[c]); (op + 1 * 4096 + i * 64)[pc] = f2bf(bf2f((qdb + i * 512)[c]) * ei); }
#pragma unroll
              for (int i = 1; i < 64; ++i) { float aw = w[i];
#pragma unroll
                  for (int j4 = 0; j4 < i; j4 += 4) { const f32x4 a = *(const LAS f32x4*)(Am + i * 64 + j4);
#pragma unroll
                      for (int e = 0; e < 4; ++e) if (j4 + e < i) aw -= a[e] * w[j4 + e]; }
                  w[i] = aw; }
#pragma unroll
              for (int i = 0; i < 64; ++i) (op + i * 64)[pc] = f2bf(-w[i]); }
        }
        asm volatile("s_waitcnt lgkmcnt(0)" ::: "memory");
    }
}
__device__ __forceinline__ bf16x8_t pack_b(const f32x4& lo, const f32x4& hi) { union { u32x4 u; bf16x8_t v; } x;
    x.u.x = pg8::cvt_pk_bf16(lo[0], lo[1]); x.u.y = pg8::cvt_pk_bf16(lo[2], lo[3]); x.u.z = pg8::cvt_pk_bf16(hi[0], hi[1]); x.u.w = pg8::cvt_pk_bf16(hi[2], hi[3]); return x.v; }
__device__ __forceinline__ void wu_scan(KP p, int l, int bh, int slice, int lane) {
    const int n = lane & 15, q = lane >> 4, n0 = slice * 16, b = bh >> 3, h = bh & 7;
    f32x4 S[4];
#pragma unroll
    for (int t = 0; t < 4; ++t) S[t] = (f32x4){0.f, 0.f, 0.f, 0.f};
    const int foff = n * 64 + 8 * q;
    for (int ch = 0; ch < 32; ++ch) {
        const size_t unit = (size_t)bh * 32 + ch;
        const bf16_t* op = p->DOP + unit * 4 * 4096 + foff; const float* up = p->DU + unit * 4096 + n0 + n;
        const float eg = p->DG[unit];
        f32x4 vn[4]; bf16x8_t wf[4][2], gf[4][2], kf[4][2], tf[4][2];
#pragma unroll
        for (int mt = 0; mt < 4; ++mt) {
#pragma unroll
            for (int e = 0; e < 4; ++e) vn[mt][e] = up[(16 * mt + 4 * q + e) * 64];
#pragma unroll
            for (int ks = 0; ks < 2; ++ks) { const int o = mt * 1024 + ks * 32;
                wf[mt][ks] = *(const bf16x8_t*)(op + o); gf[mt][ks] = *(const bf16x8_t*)(op + 4096 + o);
                kf[mt][ks] = *(const bf16x8_t*)(op + 2 * 4096 + o); tf[mt][ks] = *(const bf16x8_t*)(op + 3 * 4096 + o); } }
        const bf16x8_t sb0 = pack_b(S[0], S[1]), sb1 = pack_b(S[2], S[3]);
        f32x4 o[4];
#pragma unroll
        for (int mt = 0; mt < 4; ++mt) {
            vn[mt] = __builtin_amdgcn_mfma_f32_16x16x32_bf16(wf[mt][0], sb0, vn[mt], 0, 0, 0);
            vn[mt] = __builtin_amdgcn_mfma_f32_16x16x32_bf16(wf[mt][1], sb1, vn[mt], 0, 0, 0);
            o[mt] = __builtin_amdgcn_mfma_f32_16x16x32_bf16(gf[mt][0], sb0, (f32x4){0.f, 0.f, 0.f, 0.f}, 0, 0, 0);
            o[mt] = __builtin_amdgcn_mfma_f32_16x16x32_bf16(gf[mt][1], sb1, o[mt], 0, 0, 0);
        }
        const bf16x8_t vb0 = pack_b(vn[0], vn[1]), vb1 = pack_b(vn[2], vn[3]);
#pragma unroll
        for (int mt = 0; mt < 4; ++mt) {
            o[mt] = __builtin_amdgcn_mfma_f32_16x16x32_bf16(kf[mt][0], vb0, o[mt], 0, 0, 0);
            if (mt >= 2) o[mt] = __builtin_amdgcn_mfma_f32_16x16x32_bf16(kf[mt][1], vb1, o[mt], 0, 0, 0);
            S[mt] = S[mt] * eg;
            S[mt] = __builtin_amdgcn_mfma_f32_16x16x32_bf16(tf[mt][0], vb0, S[mt], 0, 0, 0);
            S[mt] = __builtin_amdgcn_mfma_f32_16x16x32_bf16(tf[mt][1], vb1, S[mt], 0, 0, 0);
        }
        bf16_t* yo = p->yc + ((size_t)b * SEQ + ch * 64) * 512 + h * 64 + n0 + n;
#pragma unroll
        for (int mt = 0; mt < 4; ++mt)
#pragma unroll
            for (int e = 0; e < 4; ++e) yo[(size_t)(16 * mt + 4 * q + e) * 512] = f2bf(o[mt][e]);
    }
    float* so = p->out + O_PDELTA + (((size_t)l * 8 + b) * 8 + h) * 4096 + n0 + n;
#pragma unroll
    for (int t = 0; t < 4; ++t)
#pragma unroll
        for (int e = 0; e < 4; ++e) so[(16 * t + 4 * q + e) * 64] = S[t][e];
}
__device__ __forceinline__ void ph_delta_fin(KP p, int l) {
    int tid_o = threadIdx.x; asm volatile("" : "+v"(tid_o)); int lane = tid_o & 63, wave = tid_o >> 6;
    const int h = lane >> 3, d0 = (lane & 7) * 8;
    for (int t = blockIdx.x * 8 + wave; t < TP; t += gridDim.x * 8) {
        bf16_t* yp = p->yc + (size_t)t * 512 + h * 64 + d0; const u32x4 raw = *(const u32x4*)yp; const u32x4 gz = *(const u32x4*)(p->H + (size_t)t * IN_WP + C_ZDN + h * 64 + d0);
        float v[8]; v[0] = __uint_as_float(raw.x << 16); v[1] = __uint_as_float(raw.x & 0xffff0000u); v[2] = __uint_as_float(raw.y << 16); v[3] = __uint_as_float(raw.y & 0xffff0000u);
        v[4] = __uint_as_float(raw.z << 16); v[5] = __uint_as_float(raw.z & 0xffff0000u); v[6] = __uint_as_float(raw.w << 16); v[7] = __uint_as_float(raw.w & 0xffff0000u);
        float z[8]; z[0] = __uint_as_float(gz.x << 16); z[1] = __uint_as_float(gz.x & 0xffff0000u); z[2] = __uint_as_float(gz.y << 16); z[3] = __uint_as_float(gz.y & 0xffff0000u);
        z[4] = __uint_as_float(gz.z << 16); z[5] = __uint_as_float(gz.z & 0xffff0000u); z[6] = __uint_as_float(gz.w << 16); z[7] = __uint_as_float(gz.w & 0xffff0000u);
        float ss = 0.f;
#pragma unroll
        for (int e = 0; e < 8; ++e) ss += v[e] * v[e];
        ss += __shfl_xor(ss, 1); ss += __shfl_xor(ss, 2); ss += __shfl_xor(ss, 4);
        const float rs = rsqrtf(ss * (1.0f / 64.0f) + EPS);
#pragma unroll
        for (int e = 0; e < 8; ++e) v[e] = v[e] * rs * p->dn_norm_g[l * 64 + d0 + e] * z[e];
        u32x4 w; w.x = pg8::cvt_pk_bf16(v[0], v[1]); w.y = pg8::cvt_pk_bf16(v[2], v[3]); w.z = pg8::cvt_pk_bf16(v[4], v[5]); w.w = pg8::cvt_pk_bf16(v[6], v[7]);
        *(u32x4*)yp = w;
    }
}

__device__ __forceinline__ void ph_att_waves(KP p, int l) {
    int tid_o = threadIdx.x; asm volatile("" : "+v"(tid_o)); int lane = tid_o & 63, wave = tid_o >> 6;
    wave = __builtin_amdgcn_readfirstlane(wave);
    const int G = gridDim.x, NW = G * 8, gw = wave * G + blockIdx.x;
    for (int d = gw; d < 256; d += NW) wu_scan(p, l, d >> 2, d & 3, lane);
    for (int d = NW - 1 - gw; d < 256; d += NW) wu_delta(p, l, 8 + (d >> 3), d & 7, lane);
}
__device__ __forceinline__ void ph_fin(KP p, int l, LAS unsigned char* lds) {
    int tid_o = threadIdx.x; asm volatile("" : "+v"(tid_o)); int lane = tid_o & 63, wave = tid_o >> 6;
    LAS float* ol = (LAS float*)(lds + wave * 2048); LAS float* wgt = ol + 256;
    const float* w_uv = p->w_uv + (size_t)l * 256 * 512;
    for (int u = blockIdx.x * 8 + wave; u < TS * 8; u += gridDim.x * 8) {
        const int ts = u >> 3, h = u & 7, s = ts >> 3, r = (ts & 7) * 8 + h; const int d = lane;
        float M = -1e30f;
        for (int ch = 0; ch < SA_CH; ++ch) M = fmaxf(M, p->part[(((size_t)s * SA_CH + ch) * 64 + r) * 258 + 256]);
        float L = 0.f;
        for (int ch = 0; ch < SA_CH; ++ch) { const float* pp = p->part + (((size_t)s * SA_CH + ch) * 64 + r) * 258; const float w = __expf(pp[256] - M); L += pp[257] * w; if (d == 0) wgt[ch] = w; }
        asm volatile("s_waitcnt lgkmcnt(0)" ::: "memory");
        for (int c = d; c < 256; c += 64) { float a = 0.f; for (int ch = 0; ch < SA_CH; ++ch) a += wgt[ch] * p->part[(((size_t)s * SA_CH + ch) * 64 + r) * 258 + c]; ol[c] = a / L; }
        asm volatile("s_waitcnt lgkmcnt(0)" ::: "memory");
        float a = 0.f;
        for (int c = 0; c < 256; ++c) a += ol[c] * w_uv[(size_t)c * 512 + h * 64 + d];
        const int t = TP + ts;
        p->yb[(size_t)t * 512 + h * 64 + d] = f2bf(a * bf2f(p->H[(size_t)t * IN_WP + C_ZMLA + h * 64 + d]));
        asm volatile("s_waitcnt lgkmcnt(0)" ::: "memory");
    }
}

constexpr int SA_QS = 592, SA_KS = 576, SA_PS = 272;
constexpr int SA_OFF_Q = 0, SA_OFF_K = 64 * SA_QS, SA_OFF_P = SA_OFF_K + 128 * SA_KS, SA_OFF_M = SA_OFF_P + 64 * SA_PS, SA_OFF_L = SA_OFF_M + 1024, SA_LDS = SA_OFF_L + 1024;
typedef short s16x4 __attribute__((ext_vector_type(4)));
__device__ __forceinline__ void sa_unit(KP p, int l, int s, int ch, LAS unsigned char* lds, int tid) {
    const int lane = tid & 63, wave = __builtin_amdgcn_readfirstlane(tid >> 6), r = lane & 31, hh = lane >> 5;
    const int qb = wave & 1, kb = wave >> 1, cg = wave >> 1;
    LAS unsigned char* Qs = lds + SA_OFF_Q; LAS unsigned char* Kt = lds + SA_OFF_K; LAS unsigned char* Pt = lds + SA_OFF_P;
    LAS float* mloc = (LAS float*)(lds + SA_OFF_M); LAS float* lred = (LAS float*)(lds + SA_OFF_L);
    __syncthreads();
    { const float* w_uk = p->w_uk + (size_t)l * 256 * 512; const bf16_t* Qg = p->Q + (size_t)(TP + s * 8) * 768;
      const int c = tid & 255, h2 = tid >> 8;
      for (int h = h2 * 4; h < h2 * 4 + 4; ++h) { float acc[8];
#pragma unroll
          for (int i = 0; i < 8; ++i) acc[i] = 0.f;
          const float* wr_ = w_uk + (size_t)c * 512 + h * 64;
          for (int d = 0; d < 64; d += 4) { const f32x4 wv = *(const f32x4*)(wr_ + d);
#pragma unroll
              for (int i = 0; i < 8; ++i) { const bf16_t* q = Qg + i * 768 + h * 96 + d;
                  acc[i] += bf2f(q[0]) * wv[0] + bf2f(q[1]) * wv[1] + bf2f(q[2]) * wv[2] + bf2f(q[3]) * wv[3]; } }
#pragma unroll
          for (int i = 0; i < 8; ++i) *(LAS bf16_t*)(Qs + (i * 8 + h) * SA_QS + c * 2) = f2bf(acc[i]); }
      for (int e = tid; e < 64 * 32; e += NTHR) { const int rr = e >> 5, j = e & 31; *(LAS bf16_t*)(Qs + rr * SA_QS + (256 + j) * 2) = Qg[(rr >> 3) * 768 + (rr & 7) * 96 + 64 + j]; } }
    const int* pt = p->page_table + s * N_PAGES + ch * 16;
    const float* ckv_base = p->cache_kv + (size_t)l * N_POOL * PAGE * 256; const float* ckr_base = p->cache_kr + (size_t)l * N_POOL * PAGE * 32;
    f32x4 rk[16], rr2[2];
    { const int page = pt[0]; const float* kvp = ckv_base + (size_t)page * PAGE * 256; const float* krp = ckr_base + (size_t)page * PAGE * 32;
#pragma unroll
      for (int i = 0; i < 16; ++i) rk[i] = __builtin_nontemporal_load((const f32x4*)(kvp + (size_t)(tid + 512 * i) * 4));
#pragma unroll
      for (int i = 0; i < 2; ++i) rr2[i] = __builtin_nontemporal_load((const f32x4*)(krp + (size_t)(tid + 512 * i) * 4)); }
    f32x16 o0, o1;
#pragma unroll
    for (int e = 0; e < 16; ++e) { o0[e] = 0.f; o1[e] = 0.f; }
    float m = -1e30f, lw = 0.f;
    const int li = lane & 15, g1 = (lane >> 4) & 1;
    const int trOff = (8 * hh + (li >> 2)) * SA_KS + (16 * g1 + 4 * (li & 3)) * 2;
    for (int t = 0; t < 16; ++t) {
        __syncthreads();
#pragma unroll
        for (int i = 0; i < 16; ++i) { const int ci = tid + 512 * i, key = ci >> 6, c4 = ci & 63; u32x2 w; w.x = pg8::cvt_pk_bf16(rk[i][0], rk[i][1]); w.y = pg8::cvt_pk_bf16(rk[i][2], rk[i][3]);
            *(LAS u32x2*)(Kt + key * SA_KS + c4 * 8) = w; }
#pragma unroll
        for (int i = 0; i < 2; ++i) { const int ci = tid + 512 * i, key = ci >> 3, c4 = ci & 7; u32x2 w; w.x = pg8::cvt_pk_bf16(rr2[i][0], rr2[i][1]); w.y = pg8::cvt_pk_bf16(rr2[i][2], rr2[i][3]);
            *(LAS u32x2*)(Kt + key * SA_KS + 512 + c4 * 8) = w; }
        __syncthreads();
        if (t + 1 < 16) { const int page = pt[t + 1]; const float* kvp = ckv_base + (size_t)page * PAGE * 256; const float* krp = ckr_base + (size_t)page * PAGE * 32;
#pragma unroll
            for (int i = 0; i < 16; ++i) rk[i] = __builtin_nontemporal_load((const f32x4*)(kvp + (size_t)(tid + 512 * i) * 4));
#pragma unroll
            for (int i = 0; i < 2; ++i) rr2[i] = __builtin_nontemporal_load((const f32x4*)(krp + (size_t)(tid + 512 * i) * 4)); }
        f32x16 sa;
#pragma unroll
        for (int e = 0; e < 16; ++e) sa[e] = 0.f;
        { const LAS unsigned char* ka = Kt + (32 * kb + r) * SA_KS + 16 * hh; const LAS unsigned char* qa = Qs + (32 * qb + r) * SA_QS + 16 * hh;
#pragma unroll
          for (int ks = 0; ks < 18; ++ks) sa = __builtin_amdgcn_mfma_f32_32x32x16_bf16(*(const LAS bf16x8_t*)(ka + ks * 32), *(const LAS bf16x8_t*)(qa + ks * 32), sa, 0, 0, 0); }
        float tm = sa[0];
#pragma unroll
        for (int e = 1; e < 16; ++e) tm = fmaxf(tm, sa[e]);
        tm = fmaxf(tm, __shfl_xor(tm, 32));
        if (hh == 0) mloc[kb * 64 + 32 * qb + r] = tm;
        __syncthreads();
        { const int q = 32 * qb + r; const float tmx = fmaxf(fmaxf(mloc[q], mloc[64 + q]), fmaxf(mloc[128 + q], mloc[192 + q]));
          const float mn = fmaxf(m, tmx), al = __builtin_amdgcn_exp2f((m - mn) * ATT_C), mc = mn * ATT_C; m = mn;
          float ps = 0.f;
#pragma unroll
          for (int e = 0; e < 16; ++e) { sa[e] = __builtin_amdgcn_exp2f(sa[e] * ATT_C - mc); ps += sa[e]; }
          lw = lw * al + ps;
#pragma unroll
          for (int g4 = 0; g4 < 4; ++g4) { u32x2 w; w.x = pg8::cvt_pk_bf16(sa[4 * g4], sa[4 * g4 + 1]); w.y = pg8::cvt_pk_bf16(sa[4 * g4 + 2], sa[4 * g4 + 3]);
              *(LAS u32x2*)(Pt + q * SA_PS + (32 * kb + 8 * g4 + 4 * hh) * 2) = w; }
#pragma unroll
          for (int e = 0; e < 16; ++e) { o0[e] *= al; o1[e] *= al; } }
        __syncthreads();
        { const LAS unsigned char* pa = Pt + (32 * qb + r) * SA_PS + 16 * hh; const LAS unsigned char* va = Kt + trOff + (64 * cg) * 2;
#pragma unroll
          for (int ks = 0; ks < 8; ++ks) { const bf16x8_t pb = *(const LAS bf16x8_t*)(pa + ks * 32);
              union { struct { s16x4 lo, hi; } h; bf16x8_t v; } a0, a1;
              a0.h.lo = __builtin_amdgcn_ds_read_tr16_b64_v4i16((LAS s16x4*)(va + ks * 16 * SA_KS)); a0.h.hi = __builtin_amdgcn_ds_read_tr16_b64_v4i16((LAS s16x4*)(va + ks * 16 * SA_KS + 4 * SA_KS));
              a1.h.lo = __builtin_amdgcn_ds_read_tr16_b64_v4i16((LAS s16x4*)(va + ks * 16 * SA_KS + 64)); a1.h.hi = __builtin_amdgcn_ds_read_tr16_b64_v4i16((LAS s16x4*)(va + ks * 16 * SA_KS + 4 * SA_KS + 64));
              o0 = __builtin_amdgcn_mfma_f32_32x32x16_bf16(a0.v, pb, o0, 0, 0, 0);
              o1 = __builtin_amdgcn_mfma_f32_32x32x16_bf16(a1.v, pb, o1, 0, 0, 0); } }
    }
    lw += __shfl_xor(lw, 32);
    if (hh == 0) lred[kb * 64 + 32 * qb + r] = lw;
    __syncthreads();
    { const int q = 32 * qb + r; float* pp = p->part + (((size_t)s * SA_CH + ch) * 64 + q) * 258;
#pragma unroll
      for (int cb2 = 0; cb2 < 2; ++cb2)
#pragma unroll
          for (int g4 = 0; g4 < 4; ++g4) { const int c = 32 * (2 * cg + cb2) + 8 * g4 + 4 * hh; f32x4 v;
#pragma unroll
              for (int e = 0; e < 4; ++e) v[e] = cb2 == 0 ? o0[4 * g4 + e] : o1[4 * g4 + e];
              *(f32x2*)(pp + c) = (f32x2){v[0], v[1]}; *(f32x2*)(pp + c + 2) = (f32x2){v[2], v[3]}; }
      if (cg == 0 && hh == 0) { pp[256] = m * MLA_SCALE; pp[257] = lred[q] + lred[64 + q] + lred[128 + q] + lred[192 + q]; } }
}
__device__ __forceinline__ void ph_attn_s2(KP p, int l, LAS unsigned char* lds) {
    int tid = threadIdx.x; asm volatile("" : "+v"(tid));
    for (int u = blockIdx.x; u < DEC_BATCH * 8; u += gridDim.x) sa_unit(p, l, u >> 3, u & 7, lds, tid);
    __syncthreads();
}

constexpr int ATT_KS = 208, ATT_VS = 144, ATT_KB = 64 * ATT_KS, ATT_VB = 64 * ATT_VS, ATT_STAGE = ATT_KB + ATT_VB;
__device__ __forceinline__ void attn_unit(KP p, int b, int h, int qblk, LAS unsigned char* lds, int tid, int wave, int lane) {
    const int r = lane & 31, hh = lane >> 5;
    const int q0 = qblk * 256 + wave * 32;
    const size_t trow0 = (size_t)b * SEQ;
    bf16x8_t qf[6];
    { const bf16_t* qp = p->Q + (trow0 + q0 + r) * 768 + h * 96 + 8 * hh;
#pragma unroll
      for (int ks = 0; ks < 6; ++ks) qf[ks] = *(const bf16x8_t*)(qp + 16 * ks); }
    f32x16 o0, o1;
#pragma unroll
    for (int e = 0; e < 16; ++e) { o0[e] = 0.f; o1[e] = 0.f; }
    float m = -1e30f, lsum = 0.f;
    const int ntile = qblk * 4 + 4;
    const int cA = tid, keyA = cA / 12, partA = cA - keyA * 12; const int cB = 512 + (tid & 255), keyB = cB / 12, partB = cB - keyB * 12; const bool hasB = tid < 256;
    const bf16_t* gA = partA < 8 ? p->Kn + (trow0 + keyA) * 512 + h * 64 + partA * 8 : p->Kr + (trow0 + keyA) * 32 + (partA - 8) * 8; const int stepA = partA < 8 ? 64 * 512 : 64 * 32;
    const bf16_t* gB = partB < 8 ? p->Kn + (trow0 + keyB) * 512 + h * 64 + partB * 8 : p->Kr + (trow0 + keyB) * 32 + (partB - 8) * 8; const int stepB = partB < 8 ? 64 * 512 : 64 * 32;
    const bf16_t* gV = p->Vt + (size_t)(h * 64 + (tid >> 3)) * TP + trow0 + (tid & 7) * 8;
    const int lA = keyA * ATT_KS + partA * 16, lB = keyB * ATT_KS + partB * 16, lV = ATT_KB + (tid >> 3) * ATT_VS + (tid & 7) * 16;
    const int pr_ = (r & 0x13) | ((r & 4) << 1) | ((r & 8) >> 1);
    const int kOff = pr_ * ATT_KS + 16 * hh, vOff = ATT_KB + r * ATT_VS + 16 * hh;
    u32x4 rA = *(const u32x4*)gA, rB = hasB ? *(const u32x4*)gB : (u32x4){0u, 0u, 0u, 0u}, rV = *(const u32x4*)gV;
    for (int kt = 0; kt < ntile; ++kt) {
        LAS unsigned char* st = lds + (kt & 1) * ATT_STAGE;
        *(LAS u32x4*)(st + lA) = rA; if (hasB) *(LAS u32x4*)(st + lB) = rB; *(LAS u32x4*)(st + lV) = rV;
        __syncthreads();
        if (kt + 1 < ntile) { gA += stepA; gB += stepB; gV += 64; rA = *(const u32x4*)gA; if (hasB) rB = *(const u32x4*)gB; rV = *(const u32x4*)gV; }
        if (kt * 64 <= q0 + 31) {
            f32x16 s0, s1;
#pragma unroll
            for (int e = 0; e < 16; ++e) { s0[e] = 0.f; s1[e] = 0.f; }
#pragma unroll
            for (int ks = 0; ks < 6; ++ks) {
                const bf16x8_t a0 = *(const LAS bf16x8_t*)(st + kOff + ks * 32), a1 = *(const LAS bf16x8_t*)(st + kOff + 32 * ATT_KS + ks * 32);
                s0 = __builtin_amdgcn_mfma_f32_32x32x16_bf16(a0, qf[ks], s0, 0, 0, 0);
                s1 = __builtin_amdgcn_mfma_f32_32x32x16_bf16(a1, qf[ks], s1, 0, 0, 0);
            }
            if (kt * 64 + 63 > q0) {
                const int qrel = q0 + r - kt * 64;
#pragma unroll
                for (int e = 0; e < 16; ++e) { const int kl = (e & 3) + 4 * ((e >> 2) & 1) + 8 * hh + 16 * ((e >> 3) & 1);
                    if (kl > qrel) s0[e] = -1e30f; if (kl + 32 > qrel) s1[e] = -1e30f; }
            }
            float tm = fmaxf(s0[0], s1[0]);
#pragma unroll
            for (int e = 1; e < 16; ++e) tm = fmaxf(tm, fmaxf(s0[e], s1[e]));
            tm = fmaxf(tm, __shfl_xor(tm, 32));
            const float mn = fmaxf(m, tm), al = __builtin_amdgcn_exp2f((m - mn) * ATT_C), mc = mn * ATT_C; m = mn;
            float ps = 0.f;
#pragma unroll
            for (int e = 0; e < 16; ++e) { s0[e] = __builtin_amdgcn_exp2f(s0[e] * ATT_C - mc); s1[e] = __builtin_amdgcn_exp2f(s1[e] * ATT_C - mc); ps += s0[e] + s1[e]; }
            lsum = lsum * al + ps;
#pragma unroll
            for (int e = 0; e < 16; ++e) { o0[e] *= al; o1[e] *= al; }
#pragma unroll
            for (int kb = 0; kb < 2; ++kb)
#pragma unroll
                for (int sp = 0; sp < 2; ++sp) {
                    union { u32x4 u; bf16x8_t v; } pb;
                    if (kb == 0) { pb.u.x = pg8::cvt_pk_bf16(s0[8 * sp + 0], s0[8 * sp + 1]); pb.u.y = pg8::cvt_pk_bf16(s0[8 * sp + 2], s0[8 * sp + 3]); pb.u.z = pg8::cvt_pk_bf16(s0[8 * sp + 4], s0[8 * sp + 5]); pb.u.w = pg8::cvt_pk_bf16(s0[8 * sp + 6], s0[8 * sp + 7]); }
                    else         { pb.u.x = pg8::cvt_pk_bf16(s1[8 * sp + 0], s1[8 * sp + 1]); pb.u.y = pg8::cvt_pk_bf16(s1[8 * sp + 2], s1[8 * sp + 3]); pb.u.z = pg8::cvt_pk_bf16(s1[8 * sp + 4], s1[8 * sp + 5]); pb.u.w = pg8::cvt_pk_bf16(s1[8 * sp + 6], s1[8 * sp + 7]); }
                    const int ko = (32 * kb + 16 * sp) * 2;
                    const bf16x8_t v0 = *(const LAS bf16x8_t*)(st + vOff + ko), v1 = *(const LAS bf16x8_t*)(st + vOff + 32 * ATT_VS + ko);
                    o0 = __builtin_amdgcn_mfma_f32_32x32x16_bf16(v0, pb.v, o0, 0, 0, 0);
                    o1 = __builtin_amdgcn_mfma_f32_32x32x16_bf16(v1, pb.v, o1, 0, 0, 0);
                }
        }
    }
    lsum += __shfl_xor(lsum, 32);
    const float il = 1.0f / lsum;
    const size_t t = trow0 + q0 + r;
#pragma unroll
    for (int db = 0; db < 2; ++db)
#pragma unroll
        for (int g = 0; g < 4; ++g) { const int d0 = 32 * db + 8 * g + 4 * hh;
            const u32x2 gz = *(const u32x2*)(p->H + t * IN_WP + C_ZMLA + h * 64 + d0);
            float v[4];
#pragma unroll
            for (int e = 0; e < 4; ++e) v[e] = (db == 0 ? o0[4 * g + e] : o1[4 * g + e]) * il;
            v[0] *= __uint_as_float(gz.x << 16); v[1] *= __uint_as_float(gz.x & 0xffff0000u); v[2] *= __uint_as_float(gz.y << 16); v[3] *= __uint_as_float(gz.y & 0xffff0000u);
            u32x2 w; w.x = pg8::cvt_pk_bf16(v[0], v[1]); w.y = pg8::cvt_pk_bf16(v[2], v[3]);
            *(u32x2*)(p->yb + t * 512 + h * 64 + d0) = w; }
}
__device__ __forceinline__ void ph_attn_p(KP p, LAS unsigned char* lds) {
    int tid = threadIdx.x; asm volatile("" : "+v"(tid));
    const int lane = tid & 63, wave = __builtin_amdgcn_readfirstlane(tid >> 6);
    for (int pi = blockIdx.x; pi < 256; pi += gridDim.x) {
        const int xcd = pi & 7, k = pi >> 3, bh = xcd * 8 + (k >> 2), pr = k & 3;
        attn_unit(p, bh >> 3, bh & 7, 7 - pr, lds, tid, wave, lane);
        attn_unit(p, bh >> 3, bh & 7, pr, lds, tid, wave, lane);
    }
    __syncthreads();
}
struct MEpiVt { static constexpr bool PERM = true, AFTER_DRAIN = false; bf16_t* O; int ldc; int pad_;
    __device__ __forceinline__ void operator()(const f32x4 (&acc)[2][2][4][2], const pg8::Unit& u, int wr, int wc, int fr0, int fq0) const {
        int fr = fr0, fq = fq0; asm volatile("" : "+v"(fr), "+v"(fq));
        const int row0 = u.pm * 256 + wr * 64 + fr;
#pragma unroll
        for (int bj = 0; bj < 2; ++bj) { const int col0 = u.pn * 256 + bj * 128 + wc * 32 + 8 * fq;
#pragma unroll
            for (int ai = 0; ai < 2; ++ai)
#pragma unroll
                for (int m = 0; m < 4; ++m) { const int row = row0 + ai * 128 + m * 16; const f32x4 v0 = acc[ai][bj][m][0], v1 = acc[ai][bj][m][1];
                    u32x4 w; w.x = pg8::cvt_pk_bf16(v0[0], v0[1]); w.y = pg8::cvt_pk_bf16(v0[2], v0[3]); w.z = pg8::cvt_pk_bf16(v1[0], v1[1]); w.w = pg8::cvt_pk_bf16(v1[2], v1[3]);
                    *(u32x4*)(O + (size_t)row * ldc + col0) = w; } }
    } };


__global__ void __launch_bounds__(NTHR, 2) k_mega(Params p_unused) {
    const KP kp0 = (KP)__builtin_amdgcn_kernarg_segment_ptr();
#define PP() ({ KP q_ = kp0; asm volatile("" : "+s"(q_)); q_; })
    KP p = PP();
    extern __shared__ __attribute__((aligned(16))) unsigned char lds_raw[];
    LAS unsigned char* lds = (LAS unsigned char*)lds_raw;
    volatile LAS unsigned* misc = (volatile LAS unsigned*)(lds + LDS_MISC);
    for (int u = threadIdx.x; u < 64; u += NTHR) misc[u] = 0u;
    __syncthreads();
    const int lo = p->ph_lo, hi = p->ph_hi;
    XcdBarrier bar; bar.bar = p->bar + p->li * XCD_BAR_WORDS; bar.x = 0; bar.st = nullptr;
    if (hi - lo > 1) bar = xcd_barrier_post(p->bar + p->li * XCD_BAR_WORDS, misc + 8);
#define IN(k) (lo <= (k) && (k) < hi)
#define SEAM(k) do { if (IN(k) && IN((k) + 1)) xcd_barrier(bar); } while (0)

    if (IN(PH_PRO)) {
        LAS float* tile = (LAS float*)lds;
        for (int l = 0; l < 2; ++l) {
            KP p = PP();
            ph_tr(p->w_in + (size_t)l * 1024 * IN_W, p->WinT + (size_t)l * IN_WP * 1024, 1024, IN_W, IN_WP, tile, 0);
            ph_tr(p->w_uq + (size_t)l * 384 * 768, p->WuqT + (size_t)l * 768 * 384, 384, 768, 768, tile, 0);
            ph_tr(p->w_uk + (size_t)l * 256 * 512, p->WkvT + (size_t)l * 1024 * 256, 256, 512, 512, tile, 144);
            ph_tr(p->w_uv + (size_t)l * 256 * 512, p->WkvT + (size_t)l * 1024 * 256 + (size_t)512 * 256, 256, 512, 512, tile, 208);
            ph_tr(p->w_br0 + (size_t)l * 512 * 1024, p->WbrT + ((size_t)l * 3 + 0) * 1024 * 512, 512, 1024, 1024, tile, 0);
            ph_tr(p->w_br1 + (size_t)l * 512 * 1024, p->WbrT + ((size_t)l * 3 + 1) * 1024 * 512, 512, 1024, 1024, tile, 0);
            ph_tr(p->w_br2 + (size_t)l * 512 * 1024, p->WbrT + ((size_t)l * 3 + 2) * 1024 * 512, 512, 1024, 1024, tile, 0);
            ph_tr(p->w_out + (size_t)l * 1024 * 1024, p->WoutT + (size_t)l * 1024 * 1024, 1024, 1024, 1024, tile, 0);
        }
        { KP p = PP(); ph_rope_tab(p->tab); ph_rmsnorm(p->x_prompt, p->x_sample, p->norm_g, p->xn, nullptr, nullptr); }
    }
    SEAM(PH_PRO);
    for (int l = 0; l < 2; ++l) {
        int G = gridDim.x, bid = blockIdx.x; asm volatile("" : "+s"(G), "+s"(bid));
        if (IN(PHID(l, PH_GIN))) { KP p = PP();
            pg8::Gemm g{p->xn, p->WinT + (size_t)l * IN_WP * 1024, TT, IN_WP, 1024}; pg8::StaticOrder S; S.init(TT, IN_WP, G, bid);
            MEpiH E{p->H, p->BA}; pg8::gemm_phase<MEpiH, pg8::StaticOrder, false>(lds, g, S, E, nullptr);
        }
        SEAM(PHID(l, PH_GIN));
        if (IN(PHID(l, PH_TOK))) ph_tok(PP(), l, lds);
        SEAM(PHID(l, PH_TOK));
        if (IN(PHID(l, PH_GQ))) { KP p = PP();
            pg8::Gemm g{p->cq, p->WuqT + (size_t)l * 768 * 384, TT, 768, 384}; pg8::StaticOrder S; S.init(TT, 768, G, bid);
            MEpiQ E{p->Q, p->tab}; pg8::gemm_phase<MEpiQ, pg8::StaticOrder, false>(lds, g, S, E, nullptr);
        }
        if (IN(PHID(l, PH_GQ))) { KP p = PP();
            pg8::Gemm g{p->ckv, p->WkvT + (size_t)l * 1024 * 256, TP, 512, 256}; pg8::StaticOrder S; S.init(TP, 512, G, bid);
            MEpiKV E{p->Kn, p->V}; pg8::gemm_phase<MEpiKV, pg8::StaticOrder, false>(lds, g, S, E, nullptr);
        }
        if (IN(PHID(l, PH_GQ))) { KP p = PP();
            pg8::Gemm g{p->WkvT + (size_t)l * 1024 * 256 + (size_t)512 * 256, p->ckv, 512, TP, 256}; pg8::StaticOrder S; S.init(512, TP, G, bid);
            MEpiVt E{p->Vt, TP, 0}; pg8::gemm_phase<MEpiVt, pg8::StaticOrder, false>(lds, g, S, E, nullptr);
        }
        if (IN(PHID(l, PH_GQ))) ph_delta_pre(PP(), lds);
        SEAM(PHID(l, PH_GQ));
        if (IN(PHID(l, PH_ATT))) { ph_attn_s2(PP(), l, lds); ph_attn_s(PP(), l, lds); ph_attn_p(PP(), lds); ph_att_waves(PP(), l); }
        SEAM(PHID(l, PH_ATT));
        if (IN(PHID(l, PH_FIN))) { ph_fin(PP(), l, lds); ph_delta_fin(PP(), l); }
        SEAM(PHID(l, PH_FIN));
        if (IN(PHID(l, PH_MERGE))) {
            { KP p = PP(); pg8::Gemm g{p->ya, p->WbrT + ((size_t)l * 3 + 0) * 1024 * 512, TT, 1024, 512}; pg8::StaticOrder S; S.init(TT, 1024, G, bid);
              MEpiMerge<0> E{p->H, p->mf, p->mb}; pg8::gemm_phase<MEpiMerge<0>, pg8::StaticOrder, false>(lds, g, S, E, nullptr); }
            { KP p = PP(); pg8::Gemm g{p->yb, p->WbrT + ((size_t)l * 3 + 1) * 1024 * 512, TT, 1024, 512}; pg8::StaticOrder S; S.init(TT, 1024, G, bid);
              MEpiMerge<1> E{p->H, p->mf, p->mb}; pg8::gemm_phase<MEpiMerge<1>, pg8::StaticOrder, false>(lds, g, S, E, nullptr); }
            { KP p = PP(); pg8::Gemm g{p->yc, p->WbrT + ((size_t)l * 3 + 2) * 1024 * 512, TT, 1024, 512}; pg8::StaticOrder S; S.init(TT, 1024, G, bid);
              MEpiMerge<2> E{p->H, p->mf, p->mb}; pg8::gemm_phase<MEpiMerge<2>, pg8::StaticOrder, false>(lds, g, S, E, nullptr); }
        }
        SEAM(PHID(l, PH_MERGE));
        if (IN(PHID(l, PH_OUT))) { KP p = PP();
            const float* xp = l == 0 ? p->x_prompt : p->xres; const float* xs = l == 0 ? p->x_sample : p->xres + (size_t)TP * 1024;
            pg8::Gemm g{p->mb, p->WoutT + (size_t)l * 1024 * 1024, TT, 1024, 1024}; pg8::StaticOrder S; S.init(TT, 1024, G, bid);
            MEpiRes E{xp, xs, p->xres}; pg8::gemm_phase<MEpiRes, pg8::StaticOrder, false>(lds, g, S, E, nullptr);
        }
        SEAM(PHID(l, PH_OUT));
        if (IN(PHID(l, PH_NORM))) { KP p = PP();
            if (l == 0) ph_rmsnorm(p->xres, p->xres + (size_t)TP * 1024, p->norm_g + 1024, p->xn, nullptr, nullptr);
            else ph_rmsnorm(p->xres, p->xres + (size_t)TP * 1024, p->final_norm_g, nullptr, p->out + O_YP, p->out + O_YS);
        }
        SEAM(PHID(l, PH_NORM));
    }
#undef IN
#undef SEAM
}

static inline size_t al256(size_t x) { return (x + 255) & ~(size_t)255; }
extern "C" void kernel_launch(void* const* d_in, const int* in_sizes, int n_in, void* d_out, int out_size, void* d_ws, size_t ws_size, hipStream_t stream) {
    static int grid = 0;
    if (grid == 0) {
        int dev = 0, cus = 0; (void)hipGetDevice(&dev); (void)hipDeviceGetAttribute(&cus, hipDeviceAttributeMultiprocessorCount, dev);
        (void)hipFuncSetAttribute((const void*)k_mega, hipFuncAttributeMaxDynamicSharedMemorySize, LDS_BYTES);
        int per_cu = 0; (void)hipOccupancyMaxActiveBlocksPerMultiprocessor(&per_cu, (const void*)k_mega, NTHR, LDS_BYTES); (void)hipGetLastError();
        grid = cus > 0 ? cus : 256;
    }
    Params p{};
    p.x_prompt = (const float*)d_in[0]; p.x_sample = (const float*)d_in[1]; p.cache_kv = (const float*)d_in[2]; p.cache_kr = (const float*)d_in[3];
    p.state_pool = (const float*)d_in[4]; p.state_conv = (const float*)d_in[5]; p.state_delta = (const float*)d_in[6]; p.page_table = (const int*)d_in[7];
    p.norm_g = (const float*)d_in[8]; p.w_in = (const float*)d_in[9]; p.pool_mix = (const float*)d_in[10]; p.pool_scale = (const float*)d_in[11];
    p.q_norm_g = (const float*)d_in[12]; p.w_uq = (const float*)d_in[13]; p.kv_norm_g = (const float*)d_in[14]; p.w_uk = (const float*)d_in[15];
    p.w_uv = (const float*)d_in[16]; p.conv_w = (const float*)d_in[17]; p.a_log = (const float*)d_in[18]; p.dt_bias = (const float*)d_in[19];
    p.dn_norm_g = (const float*)d_in[20]; p.w_br0 = (const float*)d_in[21]; p.w_br1 = (const float*)d_in[22]; p.w_br2 = (const float*)d_in[23];
    p.w_out = (const float*)d_in[24]; p.final_norm_g = (const float*)d_in[25];
    p.out = (float*)d_out;
    char* w = (char*)d_ws; size_t off = 0;
    auto take = [&](size_t bytes) { char* q = w + off; off += al256(bytes); return q; };
    const size_t BAR_BYTES = (size_t)16 * XCD_BAR_WORDS * 4;
    p.bar = (unsigned*)take(BAR_BYTES);
    p.WinT = (bf16_t*)take((size_t)2 * IN_WP * 1024 * 2);
    p.WuqT = (bf16_t*)take((size_t)2 * 768 * 384 * 2);
    p.WkvT = (bf16_t*)take((size_t)2 * 1024 * 256 * 2);
    p.WbrT = (bf16_t*)take((size_t)2 * 3 * 1024 * 512 * 2);
    p.WoutT = (bf16_t*)take((size_t)2 * 1024 * 1024 * 2);
    p.tab = (float2*)take((size_t)(SEQ + DEC_SEQ) * 16 * 8);
    p.xres = (float*)take((size_t)TT * 1024 * 4);
    p.xn = (bf16_t*)take((size_t)TT * 1024 * 2);
    p.H = (bf16_t*)take((size_t)TT * IN_WP * 2);
    p.BA = (float*)take((size_t)TT * 16 * 4);
    p.cq = (bf16_t*)take((size_t)TT * 384 * 2);
    p.ckv = (bf16_t*)take((size_t)TT * 256 * 2);
    p.Kr = (bf16_t*)take((size_t)TT * 32 * 2);
    p.Q = (bf16_t*)take((size_t)TT * 768 * 2);
    bf16_t* Qlat = (bf16_t*)take((size_t)TS * 8 * 288 * 2);
    p.Kn = (bf16_t*)take((size_t)TP * 512 * 2);
    p.V = (bf16_t*)take((size_t)TP * 512 * 2);
    p.Vt = (bf16_t*)take((size_t)512 * TP * 2);
    p.qd = (bf16_t*)take((size_t)TT * 512 * 2);
    p.kd = (bf16_t*)take((size_t)TT * 512 * 2);
    p.vd = (bf16_t*)take((size_t)TT * 512 * 2);
    p.bg = (float*)take((size_t)TT * 16 * 4);
    p.ya = (bf16_t*)take((size_t)TT * 512 * 2);
    p.yb = (bf16_t*)take((size_t)TT * 512 * 2);
    p.yc = (bf16_t*)take((size_t)TT * 512 * 2);
    p.mf = (float*)take((size_t)TT * 1024 * 4);
    p.mb = (bf16_t*)take((size_t)TT * 1024 * 2);
    p.part = (float*)take((size_t)DEC_BATCH * SA_CH * 64 * 258 * 4);
    p.DOP = (bf16_t*)take((size_t)2048 * 4 * 4096 * 2);
    p.DU = (float*)take((size_t)2048 * 4096 * 4);
    p.DG = (float*)take((size_t)2048 * 4);

    (void)hipMemsetAsync(p.bar, 0, BAR_BYTES, stream);
    p.ph_lo = 0; p.ph_hi = PH_END; p.li = 0; p.pad = 0;
    hipLaunchKernelGGL(k_mega, dim3(grid), dim3(NTHR), LDS_BYTES, stream, p);
}
```

```cpp
#include <hip/hip_runtime.h>
#include <stdint.h>

typedef unsigned short bf16_t;

#define D_MODEL 1024
#define TP 16384
#define TS 256
#define TT (TP + TS)
#define SEQ 2048
#define DEC_SEQ 8
#define DEC_BATCH 32
#define PAST_LEN 16384
#define PAGE 128
#define N_PAGES 128
#define N_POOL 5120
#define IN_W 7344
#define IN_WP 7424
#define C_POOL 0
#define C_ZPOOL 512
#define C_Q 1024
#define C_KV 1408
#define C_KR 1664
#define C_ZMLA 1696
#define C_QKV 2208
#define C_ZDN 3744
#define C_BETA 4256
#define C_ALPHA 4264
#define C_GATE 4272
#define EPS 1e-6f
#define MLA_SCALE 0.10206207261596577f
#define ATT_C 0.14724444831554004f

#define O_YP 0
#define O_YS (O_YP + 16777216)
#define O_PKV (O_YS + 262144)
#define O_PKR (O_PKV + 8388608)
#define O_PPOOL (O_PKR + 1048576)
#define O_PCONV (O_PPOOL + 122880)
#define O_PDELTA (O_PCONV + 73728)
#define O_SKV (O_PDELTA + 524288)
#define O_SKR (O_SKV + 131072)
#define O_SPOOL (O_SKR + 16384)
#define O_SCONV (O_SPOOL + 491520)
#define O_SDELTA (O_SCONV + 294912)
#define O_END (O_SDELTA + 2097152)

__device__ __forceinline__ float bf2f(bf16_t b) { return __uint_as_float(((unsigned)b) << 16); }
__device__ __forceinline__ bf16_t f2bf(float f) { unsigned u = __float_as_uint(f); u += 0x7FFFu + ((u >> 16) & 1u); return (bf16_t)(u >> 16); }
__device__ __forceinline__ float sigmoidf_(float v) { return 1.0f / (1.0f + __expf(-v)); }
__device__ __forceinline__ float siluf_(float v) { return v / (1.0f + __expf(-v)); }
__device__ __forceinline__ float wave_sum(float v) {
#pragma unroll
    for (int o = 32; o >= 1; o >>= 1) v += __shfl_xor(v, o);
    return v;
}

#define SA_CH 9
namespace pg8 {
#define PG8_LAS __attribute__((address_space(3)))
typedef unsigned short bf16_t;
typedef short bf16x8 __attribute__((ext_vector_type(8)));
typedef float f32x4 __attribute__((ext_vector_type(4)));
typedef unsigned u32x4 __attribute__((ext_vector_type(4)));
constexpr int BM = 256, BK = 64, HALF = 128, HTB = HALF * BK * 2  , STAGE_BYTES = 8 * HTB, NXCD = 8, WGM = 8;

__host__ __device__ __forceinline__ int lds_byte(int r, int c) { const int st = (r >> 4) * 2 + (c >> 5), rr = r & 15, cc = c & 31, ob = rr * 64 + cc * 2; return st * 1024 + (ob ^ (((ob >> 9) & 1) << 5)); }
__host__ __device__ __forceinline__ void stage_rc(int b, int& R, int& C) { const int st = b / 1024, sb = b % 1024, swz = sb ^ (((sb >> 9) & 1) << 5); R = (st >> 1) * 16 + swz / 64; C = (st & 1) * 32 + (swz % 64) / 2; }
__host__ __device__ __forceinline__ int perm32(int rho) { const int n = rho >> 4, i = rho & 15; return 8 * (i >> 2) + 4 * n + (i & 3); }

struct Unit { int pm, pn; };
struct Gemm { const bf16_t* A; const bf16_t* Bt; int M, N, K; };

struct StaticOrder {
    int nM, nN, nwg, G, c;
    __host__ __device__ void init(int M, int N, int G_, int c_) { nM = M / BM; nN = N / BM; nwg = nM * nN; G = G_; c = c_; }
    __host__ __device__ bool next(int i, Unit& u) const {
        const long L = (long)i * G + c; if (L >= nwg) return false;
        int wgid = (int)L; { const int q = nwg / NXCD, r = nwg % NXCD, xcd = wgid % NXCD, off = wgid / NXCD; wgid = (xcd < r ? xcd * (q + 1) : r * (q + 1) + (xcd - r) * q) + off; }
        const int nig = WGM * nN, gid = wgid / nig, fm = gid * WGM, gsz = (nM - fm) < WGM ? (nM - fm) : WGM;
        u.pm = fm + ((wgid % nig) % gsz); u.pn = (wgid % nig) / gsz; return true;
    }
    __device__ __forceinline__ void a_ready(const Unit&) const {}
    __device__ __forceinline__ void done(const Unit&) const {}
};
typedef __bf16 bf16n2 __attribute__((ext_vector_type(2)));
__device__ __forceinline__ unsigned cvt_pk_bf16(float lo, float hi) { typedef float f2_ __attribute__((ext_vector_type(2))); const f2_ v = {lo, hi}; return __builtin_bit_cast(unsigned, __builtin_convertvector(v, bf16n2)); }
typedef float f32x2 __attribute__((ext_vector_type(2)));
template <class Epi, class Sched, bool STAMP = false>
__device__ __forceinline__ void gemm_phase(PG8_LAS unsigned char* lds, const Gemm g, const Sched& S, const Epi& E, unsigned long long* stamps) {
    int tid_ = threadIdx.x; asm volatile("" : "+v"(tid_));
    const int tid = tid_, wid = __builtin_amdgcn_readfirstlane(tid >> 6), lane = tid & 63, wr = wid >> 2, wc = wid & 3, fr = lane & 15, fq = lane >> 4;
    int K_ = g.K; asm volatile("" : "+s"(K_));
    const int K = K_, nt = K / BK;
    int ts_lo = 0, ts_hi = 0, nts = 0; const unsigned long long rt_entry = STAMP ? (unsigned long long)wall_clock64() : 0ull;
#define PG8_STAMP() do { if (STAMP && wid == 0 && nts < 64) { const unsigned long long _c = (unsigned long long)clock64(); \
        ts_lo = (lane == nts) ? (int)(unsigned)_c : ts_lo; ts_hi = (lane == nts) ? (int)(unsigned)(_c >> 32) : ts_hi; ++nts; } } while (0)
    PG8_STAMP();
    unsigned voffA[2], voffB[2];
#pragma unroll
    for (int i = 0; i < 2; ++i) { int R, C; stage_rc(tid * 16 + i * 8192, R, C); const int Rb = Epi::PERM ? ((R & ~31) + perm32(R & 31)) : R;
        voffA[i] = (unsigned)(R * K + C) * 2u; voffB[i] = (unsigned)(Rb * K + C) * 2u; }
    const size_t kstep = (size_t)(BK * 2);
    const size_t hstep = (size_t)HALF * K * 2;
    const size_t tstep = 2 * hstep;
    const unsigned ldsw = (unsigned)wid * 1024u;
    const int aoff = lds_byte(wr * 64 + fr, fq * 8), boff = lds_byte(wc * 32 + fr, fq * 8);
#define PG8_SA(b, h) (((b) * 2 + (h)) * HTB)
#define PG8_SB(b, h) ((4 + (b) * 2 + (h)) * HTB)
#define PG8_STAGE(bufoff, gbase, voff) do { _Pragma("unroll") for (int _i = 0; _i < 2; ++_i) \
        __builtin_amdgcn_global_load_lds((const unsigned*)((const char*)(gbase) + (voff)[_i]), (PG8_LAS unsigned*)(lds + (bufoff) + ldsw + _i * 8192), 16, 0, 0); } while (0)
#define PG8_LDA(dst, b, h) do { _Pragma("unroll") for (int m = 0; m < 4; ++m) _Pragma("unroll") for (int k = 0; k < 2; ++k) dst[m][k] = *(const PG8_LAS bf16x8*)(lds + PG8_SA(b, h) + aoff + m * 2048 + k * 1024); } while (0)
#define PG8_LDB(dst, b, h) do { _Pragma("unroll") for (int n = 0; n < 2; ++n) _Pragma("unroll") for (int k = 0; k < 2; ++k) dst[n][k] = *(const PG8_LAS bf16x8*)(lds + PG8_SB(b, h) + boff + n * 2048 + k * 1024); } while (0)
#define PG8_MMA(ai, bj, At, Bt) do { __builtin_amdgcn_s_setprio(1); _Pragma("unroll") for (int m = 0; m < 4; ++m) _Pragma("unroll") for (int n = 0; n < 2; ++n) _Pragma("unroll") for (int k = 0; k < 2; ++k) \
        acc[ai][bj][m][n] = __builtin_amdgcn_mfma_f32_16x16x32_bf16(Bt[n][k], At[m][k], acc[ai][bj][m][n], 0, 0, 0); __builtin_amdgcn_s_setprio(0); } while (0)
#define PG8_WAIT_V(n) asm volatile("s_waitcnt vmcnt(" #n ")" ::: "memory")
#define PG8_WAIT_L(n) asm volatile("s_waitcnt lgkmcnt(" #n ")" ::: "memory")
#define PG8_BAR __builtin_amdgcn_s_barrier()
#define PG8_SCHED __builtin_amdgcn_sched_barrier(0)
    Unit cur, nxt; int ui = 0;
    if (!S.next(0, cur)) return;
    f32x4 acc[2][2][4][2];
#pragma unroll
    for (int a = 0; a < 2; ++a)
#pragma unroll
        for (int b = 0; b < 2; ++b)
#pragma unroll
            for (int m = 0; m < 4; ++m)
#pragma unroll
                for (int n = 0; n < 2; ++n) acc[a][b][m][n] = (f32x4){0.f, 0.f, 0.f, 0.f};
    bf16x8 At[4][2], B0[2][2], B1[2][2];
    const char* cA = (const char*)g.A + (size_t)cur.pm * tstep; const char* cB = (const char*)g.Bt + (size_t)cur.pn * tstep;
    S.a_ready(cur);
    PG8_STAGE(PG8_SB(0, 0), cB, voffB); PG8_STAGE(PG8_SA(0, 0), cA, voffA); PG8_STAGE(PG8_SB(0, 1), cB + hstep, voffB); PG8_STAGE(PG8_SA(0, 1), cA + hstep, voffA);
    if (wr == 1) PG8_BAR;
    PG8_WAIT_V(4); PG8_BAR;
    PG8_STAGE(PG8_SB(1, 0), cB + kstep, voffB); PG8_STAGE(PG8_SA(1, 0), cA + kstep, voffA); PG8_STAGE(PG8_SB(1, 1), cB + hstep + kstep, voffB);
    PG8_WAIT_V(6); PG8_BAR;
    PG8_STAMP();
    for (;;) {
        const bool has_next = S.next(ui + 1, nxt);
        const char* nA = has_next ? (const char*)g.A + (size_t)nxt.pm * tstep : cA; const char* nB = has_next ? (const char*)g.Bt + (size_t)nxt.pn * tstep : cB;
_Pragma("nounroll")
        for (int t = 0; t < nt; t += 2) {
            const bool last = (t == nt - 2);
            const char* a1 = cA + (size_t)(t + 1) * kstep;
            const char* a2 = last ? nA : cA + (size_t)(t + 2) * kstep; const char* b2 = last ? nB : cB + (size_t)(t + 2) * kstep;
            const char* a3 = a2 + kstep; const char* b3 = b2 + kstep;
            if (last && has_next) S.a_ready(nxt);
            PG8_LDB(B0, 0, 0); PG8_SCHED; PG8_LDA(At, 0, 0); PG8_STAGE(PG8_SA(1, 1), a1 + hstep, voffA);
            PG8_WAIT_L(8); PG8_BAR; PG8_WAIT_L(0); PG8_MMA(0, 0, At, B0); PG8_BAR; PG8_SCHED;
            PG8_LDB(B1, 0, 1); PG8_STAGE(PG8_SB(0, 0), b2, voffB);
            PG8_BAR; PG8_WAIT_L(0); PG8_MMA(0, 1, At, B1); PG8_BAR;
            PG8_LDA(At, 0, 1); PG8_STAGE(PG8_SA(0, 0), a2, voffA);
            PG8_BAR; PG8_WAIT_L(0); PG8_MMA(1, 0, At, B0); PG8_BAR; PG8_SCHED;
            PG8_STAGE(PG8_SB(0, 1), b2 + hstep, voffB);
            PG8_WAIT_V(6); PG8_BAR; PG8_MMA(1, 1, At, B1); PG8_BAR;
            PG8_LDB(B0, 1, 0); PG8_SCHED; PG8_LDA(At, 1, 0); PG8_STAGE(PG8_SA(0, 1), a2 + hstep, voffA);
            PG8_WAIT_L(8); PG8_BAR; PG8_WAIT_L(0); PG8_MMA(0, 0, At, B0); PG8_BAR; PG8_SCHED;
            PG8_LDB(B1, 1, 1); PG8_STAGE(PG8_SB(1, 0), b3, voffB);
            PG8_BAR; PG8_WAIT_L(0); PG8_MMA(0, 1, At, B1); PG8_BAR;
            PG8_LDA(At, 1, 1); PG8_STAGE(PG8_SA(1, 0), a3, voffA);
            PG8_BAR; PG8_WAIT_L(0); PG8_MMA(1, 0, At, B0); PG8_BAR; PG8_SCHED;
            PG8_STAGE(PG8_SB(1, 1), b3 + hstep, voffB);
            PG8_WAIT_V(6); PG8_BAR; PG8_MMA(1, 1, At, B1); PG8_BAR;
        }
        PG8_STAMP();
        if constexpr (!Epi::AFTER_DRAIN) { E(acc, cur, wr, wc, fr, fq); S.done(cur); }
        PG8_STAMP();
        if (!has_next) break;
#pragma unroll
        for (int a = 0; a < 2; ++a)
#pragma unroll
            for (int b = 0; b < 2; ++b)
#pragma unroll
                for (int m = 0; m < 4; ++m)
#pragma unroll
                    for (int n = 0; n < 2; ++n) acc[a][b][m][n] = (f32x4){0.f, 0.f, 0.f, 0.f};
        cur = nxt; cA = nA; cB = nB; ++ui;
    }
    PG8_WAIT_V(0);
    if (wr == 0) PG8_BAR;
    PG8_BAR;
    if constexpr (Epi::AFTER_DRAIN) { E.fused(acc, cur, wr, wc, fr, fq, lds, wid, lane); S.done(cur); }
    PG8_STAMP();
    if (STAMP && wid == 0) { stamps[lane] = lane < nts ? (((unsigned long long)(unsigned)ts_hi << 32) | (unsigned)ts_lo) : 0ull;
        if (lane == 62) stamps[62] = rt_entry; if (lane == 63) stamps[63] = (unsigned long long)wall_clock64(); }
#undef PG8_STAMP
#undef PG8_SA
#undef PG8_SB
#undef PG8_STAGE
#undef PG8_LDA
#undef PG8_LDB
#undef PG8_MMA
#undef PG8_WAIT_V
#undef PG8_WAIT_L
#undef PG8_BAR
#undef PG8_SCHED
}

}
#define XB_TMO      128
#define XB_XCNT(j)  (256  + 64 * (j))
#define XB_XSUB(j)  (1280 + 64 * (j))
#define XB_XGEN(j)  (2304 + 64 * (j))
#define XB_TOP      3328
#define XB_TOPGEN   3392
#define XCD_BAR_WORDS 3456
#define XB_SPIN_CAP (1u << 18)
#define LAS __attribute__((address_space(3)))

__device__ __forceinline__ unsigned xb_ld(unsigned* p)              { return __hip_atomic_load(p, __ATOMIC_RELAXED, __HIP_MEMORY_SCOPE_AGENT); }
__device__ __forceinline__ unsigned xb_add(unsigned* p, unsigned v) { return __hip_atomic_fetch_add(p, v, __ATOMIC_RELAXED, __HIP_MEMORY_SCOPE_AGENT); }
__device__ __forceinline__ unsigned xb_xcc_id() { return (unsigned)__builtin_amdgcn_s_getreg((3 << 11) | 20) & 0xFu; }
#define XB_SPIN(cond, bar) do { unsigned _sp = 0; while (cond) { __builtin_amdgcn_s_sleep(1); \
    if ((++_sp & 255u) == 0u) { if (xb_ld(&(bar)[XB_TMO])) break; if (_sp > XB_SPIN_CAP) { atomicAdd(&(bar)[XB_TMO], 1u); break; } } } } while (0)

struct XcdBarrier {
    unsigned* bar; unsigned x;
    volatile LAS unsigned* st;
};

__device__ __forceinline__ XcdBarrier xcd_barrier_post(unsigned* bar, volatile LAS unsigned* st) {
    XcdBarrier b; b.bar = bar; b.x = xb_xcc_id(); b.st = st;
    if (threadIdx.x == 0) (void)xb_add(&bar[XB_XCNT(b.x)], 1u);
    return b;
}
__device__ __forceinline__ void xcd_barrier_complete(unsigned* bar, unsigned x, unsigned& nloc, unsigned& nx) {
    const unsigned G = gridDim.x * gridDim.y * gridDim.z;
    unsigned sum, cnt, mine, sp = 0u;
    for (;;) {
        sum = 0u; cnt = 0u; mine = 0u;
#pragma unroll
        for (unsigned j = 0; j < 16; ++j) { const unsigned c = xb_ld(&bar[XB_XCNT(j)]); sum += c; cnt += (c > 0u) ? 1u : 0u; mine = (j == x) ? c : mine; }
        if (sum == G) break;
        __builtin_amdgcn_s_sleep(1);
        if ((++sp & 255u) == 0u) { if (xb_ld(&bar[XB_TMO])) break; if (sp > XB_SPIN_CAP) { atomicAdd(&bar[XB_TMO], 1u); break; } }
    }
    nloc = mine > 0u ? mine : 1u; nx = cnt > 0u ? cnt : 1u;
}

__device__ __forceinline__ void xcd_barrier(const XcdBarrier& b) {
    asm volatile("s_waitcnt vmcnt(0)" ::: "memory");
    __syncthreads();
    if (threadIdx.x == 0) {
        unsigned* bar = b.bar;
        __builtin_amdgcn_s_waitcnt(0);
        unsigned nloc = b.st[0], nx = b.st[1];
        if (nloc == 0u) { xcd_barrier_complete(bar, b.x, nloc, nx); b.st[0] = nloc; b.st[1] = nx; }
        const unsigned old = xb_add(&bar[XB_XSUB(b.x)], 1u);
        const unsigned gen = old / nloc;
        if (old + 1u == (gen + 1u) * nloc) {
            __builtin_amdgcn_fence(__ATOMIC_RELEASE, "agent");
            asm volatile("s_waitcnt vmcnt(0)" ::: "memory");
            const unsigned og = xb_add(&bar[XB_TOP], 1u);
            const unsigned tg = og / nx;
            if (og + 1u == (tg + 1u) * nx) xb_add(&bar[XB_TOPGEN], 1u);
            else XB_SPIN(xb_ld(&bar[XB_TOPGEN]) == tg, bar);
            __builtin_amdgcn_fence(__ATOMIC_ACQUIRE, "agent");
            xb_add(&bar[XB_XGEN(b.x)], 1u);
            asm volatile("s_waitcnt vmcnt(0)" ::: "memory");
        } else {
            XB_SPIN(xb_ld(&bar[XB_XGEN(b.x)]) == gen, bar);
            __builtin_amdgcn_fence(__ATOMIC_ACQUIRE, "agent");
            asm volatile("s_waitcnt vmcnt(0)" ::: "memory");
        }
    }
    __syncthreads();
}


#define LAS __attribute__((address_space(3)))
typedef float f32x4 __attribute__((ext_vector_type(4)));
typedef unsigned u32x4 __attribute__((ext_vector_type(4)));
typedef unsigned u32x2 __attribute__((ext_vector_type(2)));
typedef float f32x2 __attribute__((ext_vector_type(2)));
typedef short bf16x8_t __attribute__((ext_vector_type(8)));
typedef float f32x16 __attribute__((ext_vector_type(16)));
constexpr int NTHR = 512;
constexpr int LDS_BYTES = 147456;
constexpr int LDS_MISC = LDS_BYTES - 256;

struct Params {
    const float *x_prompt, *x_sample, *cache_kv, *cache_kr, *state_pool, *state_conv, *state_delta; const int* page_table;
    const float *norm_g, *w_in, *pool_mix, *pool_scale, *q_norm_g, *w_uq, *kv_norm_g, *w_uk, *w_uv, *conv_w, *a_log, *dt_bias, *dn_norm_g, *w_br0, *w_br1, *w_br2, *w_out, *final_norm_g;
    float* out;
    bf16_t *WinT, *WuqT, *WkvT, *WbrT, *WoutT, *PmixT; float2* tab;
    float* xres; bf16_t* xn; bf16_t* H; float* BA; bf16_t *cq, *ckv, *Kr, *Q, *Kn, *V, *Vt, *qd, *kd, *vd; float* bg; bf16_t *ya, *yb, *yc; float* mf; bf16_t* mb; float* part; bf16_t* DOP; float* DU; float* DG;
    unsigned* bar;
    int ph_lo, ph_hi, li, pad;
};

typedef const __attribute__((address_space(4))) Params* KP;

constexpr int PH_PRO = 0;
constexpr int PH_L = 8;
constexpr int PH_GIN = 0, PH_TOK = 1, PH_GQ = 2, PH_ATT = 3, PH_FIN = 4, PH_MERGE = 5, PH_OUT = 6, PH_NORM = 7;
#define PHID(l, k) (1 + (l) * PH_L + (k))
constexpr int PH_END = 1 + 2 * PH_L;

struct MEpiH { static constexpr bool PERM = true, AFTER_DRAIN = false; bf16_t* H; float* BA;
    __device__ __forceinline__ void operator()(const f32x4 (&acc)[2][2][4][2], const pg8::Unit& u, int wr, int wc, int fr0, int fq0) const {
        int fr = fr0, fq = fq0; asm volatile("" : "+v"(fr), "+v"(fq));
        const int row0 = u.pm * 256 + wr * 64 + fr;
#pragma unroll
        for (int bj = 0; bj < 2; ++bj) {
            const int wcol = u.pn * 256 + bj * 128 + wc * 32, col0 = wcol + 8 * fq;
            const bool plain = (wcol + 32 <= C_ZPOOL) || (wcol >= C_Q && wcol + 32 <= C_ZMLA) || (wcol >= C_QKV && wcol + 32 <= C_ZDN);
            const int act = ((col0 >= C_ZPOOL && col0 < C_Q) || (col0 >= C_ZMLA && col0 < C_QKV) || (col0 >= C_ZDN && col0 < C_BETA)) ? 1 : (col0 >= C_GATE ? 2 : 0);
            const bool isba = (col0 == C_BETA) || (col0 == C_ALPHA);
#pragma unroll
            for (int ai = 0; ai < 2; ++ai)
#pragma unroll
                for (int m = 0; m < 4; ++m) { const int row = row0 + ai * 128 + m * 16; f32x4 v0 = acc[ai][bj][m][0], v1 = acc[ai][bj][m][1];
                    if (!plain) {
                        if (isba) { float* b = BA + (size_t)row * 16 + (col0 - C_BETA); *(f32x4*)b = v0; *(f32x4*)(b + 4) = v1; }
#pragma unroll
                        for (int e = 0; e < 4; ++e) { const float s0 = sigmoidf_(v0[e]), s1 = sigmoidf_(v1[e]);
                            v0[e] = act == 0 ? v0[e] : (act == 1 ? v0[e] * s0 : s0); v1[e] = act == 0 ? v1[e] : (act == 1 ? v1[e] * s1 : s1); }
                    }
                    u32x4 w; w.x = pg8::cvt_pk_bf16(v0[0], v0[1]); w.y = pg8::cvt_pk_bf16(v0[2], v0[3]); w.z = pg8::cvt_pk_bf16(v1[0], v1[1]); w.w = pg8::cvt_pk_bf16(v1[2], v1[3]);
                    *(u32x4*)(H + (size_t)row * IN_WP + col0) = w; }
        }
    } };
struct MEpiQ { static constexpr bool PERM = true, AFTER_DRAIN = false; bf16_t* Q; const float2* tab;
    __device__ __forceinline__ void operator()(const f32x4 (&acc)[2][2][4][2], const pg8::Unit& u, int wr, int wc, int fr0, int fq0) const {
        int fr = fr0, fq = fq0; asm volatile("" : "+v"(fr), "+v"(fq));
        const int row0 = u.pm * 256 + wr * 64 + fr;
#pragma unroll
        for (int bj = 0; bj < 2; ++bj) {
            const int wcol = u.pn * 256 + bj * 128 + wc * 32, col0 = wcol + 8 * fq;
            const bool rope = (wcol % 96) == 64;
#pragma unroll
            for (int ai = 0; ai < 2; ++ai)
#pragma unroll
                for (int m = 0; m < 4; ++m) { const int row = row0 + ai * 128 + m * 16; f32x4 v0 = acc[ai][bj][m][0], v1 = acc[ai][bj][m][1];
                    if (rope) { const int p = row < TP ? (row & (SEQ - 1)) : SEQ + ((row - TP) & 7); const float2* tp = tab + p * 16 + (fq & 1) * 8; const bool hi = fq >= 2;
#pragma unroll
                        for (int e = 0; e < 4; ++e) { const float o0 = __shfl_xor(v0[e], 32), o1 = __shfl_xor(v1[e], 32); const float2 c0 = tp[e], c1 = tp[4 + e];
                            v0[e] = hi ? (v0[e] * c0.x + o0 * c0.y) : (v0[e] * c0.x - o0 * c0.y); v1[e] = hi ? (v1[e] * c1.x + o1 * c1.y) : (v1[e] * c1.x - o1 * c1.y); } }
                    u32x4 w; w.x = pg8::cvt_pk_bf16(v0[0], v0[1]); w.y = pg8::cvt_pk_bf16(v0[2], v0[3]); w.z = pg8::cvt_pk_bf16(v1[0], v1[1]); w.w = pg8::cvt_pk_bf16(v1[2], v1[3]);
                    *(u32x4*)(Q + (size_t)row * 768 + col0) = w; asm volatile("" ::: "memory"); }
        }
    } };
struct MEpiKV { static constexpr bool PERM = true, AFTER_DRAIN = false; bf16_t* Kn; bf16_t* V;
    __device__ __forceinline__ void operator()(const f32x4 (&acc)[2][2][4][2], const pg8::Unit& u, int wr, int wc, int fr0, int fq0) const {
        int fr = fr0, fq = fq0; asm volatile("" : "+v"(fr), "+v"(fq));
        const int row0 = u.pm * 256 + wr * 64 + fr; bf16_t* base = u.pn < 2 ? Kn : V; const int cb = (u.pn & 1) * 256;
#pragma unroll
        for (int bj = 0; bj < 2; ++bj) { const int col0 = cb + bj * 128 + wc * 32 + 8 * fq;
#pragma unroll
            for (int ai = 0; ai < 2; ++ai)
#pragma unroll
                for (int m = 0; m < 4; ++m) { const int row = row0 + ai * 128 + m * 16; const f32x4 v0 = acc[ai][bj][m][0], v1 = acc[ai][bj][m][1];
                    u32x4 w; w.x = pg8::cvt_pk_bf16(v0[0], v0[1]); w.y = pg8::cvt_pk_bf16(v0[2], v0[3]); w.z = pg8::cvt_pk_bf16(v1[0], v1[1]); w.w = pg8::cvt_pk_bf16(v1[2], v1[3]);
                    *(u32x4*)(base + (size_t)row * 512 + col0) = w; } }
    } };
template <int BR> struct MEpiMerge { static constexpr bool PERM = true, AFTER_DRAIN = false; const bf16_t* H; float* mf; bf16_t* mb;
    __device__ __forceinline__ void operator()(const f32x4 (&acc)[2][2][4][2], const pg8::Unit& u, int wr, int wc, int fr0, int fq0) const {
        int fr = fr0, fq = fq0; asm volatile("" : "+v"(fr), "+v"(fq));
        const int row0 = u.pm * 256 + wr * 64 + fr;
#pragma unroll
        for (int bj = 0; bj < 2; ++bj) { const int col0 = u.pn * 256 + bj * 128 + wc * 32 + 8 * fq;
#pragma unroll
            for (int ai = 0; ai < 2; ++ai)
#pragma unroll
                for (int m = 0; m < 4; ++m) { const int row = row0 + ai * 128 + m * 16; f32x4 v0 = acc[ai][bj][m][0], v1 = acc[ai][bj][m][1];
                    const u32x4 g = *(const u32x4*)(H + (size_t)row * IN_WP + C_GATE + BR * 1024 + col0);
                    v0[0] *= __uint_as_float(g.x << 16); v0[1] *= __uint_as_float(g.x & 0xffff0000u); v0[2] *= __uint_as_float(g.y << 16); v0[3] *= __uint_as_float(g.y & 0xffff0000u);
                    v1[0] *= __uint_as_float(g.z << 16); v1[1] *= __uint_as_float(g.z & 0xffff0000u); v1[2] *= __uint_as_float(g.w << 16); v1[3] *= __uint_as_float(g.w & 0xffff0000u);
                    float* mp = mf + (size_t)row * 1024 + col0;
                    if (BR > 0) { v0 += *(const f32x4*)mp; v1 += *(const f32x4*)(mp + 4); }
                    if (BR < 2) { *(f32x4*)mp = v0; *(f32x4*)(mp + 4) = v1; }
                    else { u32x4 w; w.x = pg8::cvt_pk_bf16(v0[0], v0[1]); w.y = pg8::cvt_pk_bf16(v0[2], v0[3]); w.z = pg8::cvt_pk_bf16(v1[0], v1[1]); w.w = pg8::cvt_pk_bf16(v1[2], v1[3]);
                        *(u32x4*)(mb + (size_t)row * 1024 + col0) = w; } asm volatile("" ::: "memory"); } }
    } };
struct MEpiRes { static constexpr bool PERM = false, AFTER_DRAIN = false; const float* xp; const float* xs; float* xo;
    __device__ __forceinline__ void operator()(const f32x4 (&acc)[2][2][4][2], const pg8::Unit& u, int wr, int wc, int fr0, int fq0) const {
        int fr = fr0, fq = fq0; asm volatile("" : "+v"(fr), "+v"(fq));
        const int row0 = u.pm * 256 + wr * 64 + fr, col0 = u.pn * 256 + wc * 32 + 4 * fq;
#pragma unroll
        for (int ai = 0; ai < 2; ++ai)
#pragma unroll
            for (int m = 0; m < 4; ++m) { const int row = row0 + ai * 128 + m * 16; const float* xr = row < TP ? xp + (size_t)row * 1024 : xs + (size_t)(row - TP) * 1024; float* orow = xo + (size_t)row * 1024;
#pragma unroll
                for (int bj = 0; bj < 2; ++bj)
#pragma unroll
                    for (int n = 0; n < 2; ++n) { const int c = col0 + bj * 128 + n * 16; *(f32x4*)(orow + c) = *(const f32x4*)(xr + c) + acc[ai][bj][m][n]; } }
    } };

__device__ __forceinline__ void ph_tr(const float* __restrict__ src, bf16_t* __restrict__ dst, int K, int N, int Npad, LAS float* tile, int rot) {
    int tid = threadIdx.x; asm volatile("" : "+v"(tid)); const int G = gridDim.x; const int tn = Npad / 64, tk = K / 32, nt = tn * tk;
    const int first = (blockIdx.x + G - (rot % G)) % G;
    for (int t = first; t < nt; t += G) {
        const int n0 = (t % tn) * 64, k0 = (t / tn) * 32;
        { const int tx = tid & 63, ty = tid >> 6;
#pragma unroll
          for (int i = 0; i < 4; ++i) { const int k = ty + 8 * i, n = n0 + tx; tile[k * 65 + tx] = n < N ? src[(size_t)(k0 + k) * N + n] : 0.f; } }
        __syncthreads();
        { const int kx = tid & 31, ny = tid >> 5;
#pragma unroll
          for (int i = 0; i < 4; ++i) { const int n = ny + 16 * i; dst[(size_t)(n0 + n) * K + k0 + kx] = f2bf(tile[kx * 65 + n]); } }
        __syncthreads();
    }
}
__device__ __forceinline__ void ph_rope_tab(float2* tab) {
    for (int idx = blockIdx.x * NTHR + threadIdx.x; idx < (SEQ + DEC_SEQ) * 16; idx += gridDim.x * NTHR) {
        const int p = idx >> 4, i = idx & 15; const int pos = p < SEQ ? p : PAST_LEN + (p - SEQ);
        const float inv = powf(10000.0f, -(float)i / 16.0f); const float ang = (float)pos * inv;
        const double rev = (double)ang * 0.15915494309189533576888; const float f = (float)(rev - floor(rev));
        tab[idx] = make_float2(__builtin_amdgcn_cosf(f), __builtin_amdgcn_sinf(f)); }
}
__device__ __forceinline__ void ph_rmsnorm(const float* __restrict__ xp, const float* __restrict__ xs, const float* __restrict__ g, bf16_t* __restrict__ xn, float* __restrict__ yp, float* __restrict__ ys) {
    int tid_o = threadIdx.x; asm volatile("" : "+v"(tid_o)); int lane = tid_o & 63, wave = tid_o >> 6;
    for (int t = blockIdx.x * 8 + wave; t < TT; t += gridDim.x * 8) {
        const float* x = t < TP ? xp + (size_t)t * 1024 : xs + (size_t)(t - TP) * 1024;
        f32x4 v[4]; float ss = 0.f;
#pragma unroll
        for (int i = 0; i < 4; ++i) { v[i] = *(const f32x4*)(x + i * 256 + lane * 4); ss += v[i][0] * v[i][0] + v[i][1] * v[i][1] + v[i][2] * v[i][2] + v[i][3] * v[i][3]; }
        ss = wave_sum(ss); const float r = rsqrtf(ss * (1.0f / 1024.0f) + EPS);
#pragma unroll
        for (int i = 0; i < 4; ++i) { const int c = i * 256 + lane * 4; const f32x4 gg = *(const f32x4*)(g + c); const f32x4 o = v[i] * r * gg;
            if (xn) { u32x2 w; w.x = pg8::cvt_pk_bf16(o[0], o[1]); w.y = pg8::cvt_pk_bf16(o[2], o[3]); *(u32x2*)(xn + (size_t)t * 1024 + c) = w; }
            else { float* y = t < TP ? yp + (size_t)t * 1024 : ys + (size_t)(t - TP) * 1024; *(f32x4*)(y + c) = o; } }
    }
}

constexpr int TK_RS = 1040;
__device__ __forceinline__ void unpack8(const u32x4 v, float (&f)[8]) {
    f[0] = __uint_as_float(v.x << 16); f[1] = __uint_as_float(v.x & 0xffff0000u); f[2] = __uint_as_float(v.y << 16); f[3] = __uint_as_float(v.y & 0xffff0000u);
    f[4] = __uint_as_float(v.z << 16); f[5] = __uint_as_float(v.z & 0xffff0000u); f[6] = __uint_as_float(v.w << 16); f[7] = __uint_as_float(v.w & 0xffff0000u); }
__device__ __forceinline__ u32x4 pack8(const float (&f)[8]) { u32x4 w; w.x = pg8::cvt_pk_bf16(f[0], f[1]); w.y = pg8::cvt_pk_bf16(f[2], f[3]); w.z = pg8::cvt_pk_bf16(f[4], f[5]); w.w = pg8::cvt_pk_bf16(f[6], f[7]); return w; }
__device__ __forceinline__ void ph_tok_prompt(KP p, int l, LAS unsigned char* lds) {
    int tid = threadIdx.x; asm volatile("" : "+v"(tid));
    const int lane = tid & 63, wave = __builtin_amdgcn_readfirstlane(tid >> 6), r = lane & 31, hh = lane >> 5;
    const bf16_t* __restrict__ H = p->H; float* __restrict__ out = p->out;
    for (int tile = blockIdx.x; tile < TP / 64; tile += gridDim.x) {
        const int t0 = tile * 64, i0 = t0 & (SEQ - 1), b = t0 >> 11;
        __syncthreads();
        for (int c = tid; c < 79 * 64; c += NTHR) { const int row = c >> 6, ch16 = c & 63; u32x4 v = (u32x4){0u, 0u, 0u, 0u};
            if (i0 - 15 + row >= 0) v = *(const u32x4*)(H + (size_t)(t0 - 15 + row) * IN_WP + C_POOL + ch16 * 8);
            *(LAS u32x4*)(lds + row * TK_RS + ch16 * 16) = v; }
        __syncthreads();
        { const int g = wave >> 1, th = wave & 1, w = 2 << g, tk = 32 * th + r, pos = i0 + tk; const float inv = 1.0f / (float)min(pos + 1, w);
          const bf16_t* mixT = p->PmixT + ((size_t)l * 4 + g) * 128 * 128;
          f32x16 acc[4];
#pragma unroll
          for (int nt = 0; nt < 4; ++nt)
#pragma unroll
              for (int e = 0; e < 16; ++e) acc[nt][e] = 0.f;
#pragma unroll 2
          for (int ks = 0; ks < 8; ++ks) {
              const LAS unsigned char* base = lds + (15 + tk) * TK_RS + (128 * g + 16 * ks + 8 * hh) * 2;
              float cur[8], sum[8]; unpack8(*(const LAS u32x4*)base, cur);
#pragma unroll
              for (int e = 0; e < 8; ++e) sum[e] = cur[e];
              for (int k = 1; k < w; ++k) { float x[8]; unpack8(*(const LAS u32x4*)(base - k * TK_RS), x);
#pragma unroll
                  for (int e = 0; e < 8; ++e) sum[e] += x[e]; }
#pragma unroll
              for (int e = 0; e < 8; ++e) sum[e] = sum[e] * inv - cur[e];
              union { u32x4 u; bf16x8_t v; } bfr; bfr.u = pack8(sum);
#pragma unroll
              for (int nt = 0; nt < 4; ++nt) { const bf16x8_t a = *(const bf16x8_t*)(mixT + (size_t)(32 * nt + r) * 128 + 16 * ks + 8 * hh);
                  acc[nt] = __builtin_amdgcn_mfma_f32_32x32x16_bf16(a, bfr.v, acc[nt], 0, 0, 0); } }
          const size_t t = (size_t)t0 + tk; const float* scl = p->pool_scale + l * 512 + 128 * g;
#pragma unroll
          for (int nt = 0; nt < 4; ++nt)
#pragma unroll
              for (int gg = 0; gg < 4; ++gg) { const int dd0 = 32 * nt + 8 * gg + 4 * hh; const u32x2 z = *(const u32x2*)(H + t * IN_WP + C_ZPOOL + 128 * g + dd0); const f32x4 sc = *(const f32x4*)(scl + dd0);
                  float v0 = acc[nt][4 * gg + 0] * sc[0] * __uint_as_float(z.x << 16), v1 = acc[nt][4 * gg + 1] * sc[1] * __uint_as_float(z.x & 0xffff0000u);
                  float v2 = acc[nt][4 * gg + 2] * sc[2] * __uint_as_float(z.y << 16), v3 = acc[nt][4 * gg + 3] * sc[3] * __uint_as_float(z.y & 0xffff0000u);
                  u32x2 o; o.x = pg8::cvt_pk_bf16(v0, v1); o.y = pg8::cvt_pk_bf16(v2, v3); *(u32x2*)(p->ya + t * 512 + 128 * g + dd0) = o; } }
        if (i0 == SEQ - 64) { for (int c = tid; c < 15 * 512; c += NTHR) { const int rr = c >> 9, ch = c & 511;
              out[O_PPOOL + (((size_t)l * 8 + b) * 15 + rr) * 512 + ch] = bf2f(*(const LAS bf16_t*)(lds + (15 + 49 + rr) * TK_RS + ch * 2)); } }
        const float* qg = p->q_norm_g + l * 384; const float* kvg = p->kv_norm_g + l * 256; const float* conv_w = p->conv_w + (size_t)l * 4 * 1536;
        for (int tt = 0; tt < 8; ++tt) {
            const int t = t0 + wave * 8 + tt, i_seq = t & (SEQ - 1); const bf16_t* h = H + (size_t)t * IN_WP;
            { float q[8]; float ss = 0.f; const bool on = lane < 48;
              if (on) unpack8(*(const u32x4*)(h + C_Q + lane * 8), q); else {
#pragma unroll
                  for (int e = 0; e < 8; ++e) q[e] = 0.f; }
#pragma unroll
              for (int e = 0; e < 8; ++e) ss += q[e] * q[e];
              ss = wave_sum(ss); const float rq = rsqrtf(ss * (1.0f / 384.0f) + EPS);
              if (on) { const f32x4 g0 = *(const f32x4*)(qg + lane * 8), g1 = *(const f32x4*)(qg + lane * 8 + 4);
#pragma unroll
                  for (int e = 0; e < 4; ++e) { q[e] *= rq * g0[e]; q[4 + e] *= rq * g1[e]; }
                  *(u32x4*)(p->cq + (size_t)t * 384 + lane * 8) = pack8(q); }
              float kv[8]; ss = 0.f; const bool on2 = lane < 32;
              if (on2) unpack8(*(const u32x4*)(h + C_KV + lane * 8), kv); else {
#pragma unroll
                  for (int e = 0; e < 8; ++e) kv[e] = 0.f; }
#pragma unroll
              for (int e = 0; e < 8; ++e) ss += kv[e] * kv[e];
              ss = wave_sum(ss); const float rk = rsqrtf(ss * (1.0f / 256.0f) + EPS);
              if (on2) { const f32x4 g0 = *(const f32x4*)(kvg + lane * 8), g1 = *(const f32x4*)(kvg + lane * 8 + 4);
#pragma unroll
                  for (int e = 0; e < 4; ++e) { kv[e] *= rk * g0[e]; kv[4 + e] *= rk * g1[e]; }
                  float* okv = out + O_PKV + ((size_t)l * TP + t) * 256 + lane * 8;
                  *(f32x4*)okv = (f32x4){kv[0], kv[1], kv[2], kv[3]}; *(f32x4*)(okv + 4) = (f32x4){kv[4], kv[5], kv[6], kv[7]};
                  *(u32x4*)(p->ckv + (size_t)t * 256 + lane * 8) = pack8(kv); }
              if (lane < 16) { const float x1 = bf2f(h[C_KR + lane]), x2 = bf2f(h[C_KR + 16 + lane]); const float2 cs = p->tab[i_seq * 16 + lane];
                  const float o1 = x1 * cs.x - x2 * cs.y, o2 = x2 * cs.x + x1 * cs.y; float* okr = out + O_PKR + ((size_t)l * TP + t) * 32;
                  okr[lane] = o1; okr[16 + lane] = o2; p->Kr[(size_t)t * 32 + lane] = f2bf(o1); p->Kr[(size_t)t * 32 + 16 + lane] = f2bf(o2); } }
#pragma unroll
            for (int pi = 0; pi < 3; ++pi) { const int c0 = (pi * 64 + lane) * 8; float y[8];
#pragma unroll
                for (int e = 0; e < 8; ++e) y[e] = 0.f;
                u32x4 rawc = (u32x4){0u, 0u, 0u, 0u};
#pragma unroll
                for (int j = 0; j < 4; ++j) { const int u = i_seq - 3 + j; u32x4 raw = (u32x4){0u, 0u, 0u, 0u};
                    if (u >= 0) raw = *(const u32x4*)(h + (ptrdiff_t)(j - 3) * IN_WP + C_QKV + c0);
                    if (j == 3) rawc = raw;
                    float x[8]; unpack8(raw, x); const f32x4 w0 = *(const f32x4*)(conv_w + j * 1536 + c0), w1 = *(const f32x4*)(conv_w + j * 1536 + c0 + 4);
#pragma unroll
                    for (int e = 0; e < 4; ++e) { y[e] += x[e] * w0[e]; y[4 + e] += x[4 + e] * w1[e]; } }
                float ss = 0.f;
#pragma unroll
                for (int e = 0; e < 8; ++e) { y[e] = siluf_(y[e]); ss += y[e] * y[e]; }
                if (pi < 2) { ss += __shfl_xor(ss, 1); ss += __shfl_xor(ss, 2); ss += __shfl_xor(ss, 4); const float rn = rsqrtf(ss + EPS) * (pi == 0 ? 0.125f : 1.0f);
#pragma unroll
                    for (int e = 0; e < 8; ++e) y[e] *= rn; }
                bf16_t* dst = pi == 0 ? p->qd : (pi == 1 ? p->kd : p->vd);
                *(u32x4*)(dst + (size_t)t * 512 + lane * 8) = pack8(y);
                if (i_seq >= SEQ - 3) { float x[8]; unpack8(rawc, x); float* oc = out + O_PCONV + (((size_t)l * 8 + (t >> 11)) * 3 + (i_seq - (SEQ - 3))) * 1536 + c0;
                    *(f32x4*)oc = (f32x4){x[0], x[1], x[2], x[3]}; *(f32x4*)(oc + 4) = (f32x4){x[4], x[5], x[6], x[7]}; } }
            if (lane < 8) { const float bb = sigmoidf_(p->BA[(size_t)t * 16 + lane]); const float x = p->BA[(size_t)t * 16 + 8 + lane] + p->dt_bias[l * 8 + lane];
                const float sp = x > 20.f ? x : log1pf(expf(x)); const float gg = -expf(p->a_log[l * 8 + lane]) * sp;
                p->bg[(size_t)t * 16 + lane] = bb; p->bg[(size_t)t * 16 + 8 + lane] = gg; }
        }
    }
    __syncthreads();
}

__device__ __forceinline__ void ph_tok(KP p, int l, LAS unsigned char* lds) {
    int tid_o = threadIdx.x; asm volatile("" : "+v"(tid_o)); int lane = tid_o & 63, wave = tid_o >> 6;
    const bf16_t* __restrict__ H = p->H; float* __restrict__ out = p->out;
    const float* qg = p->q_norm_g + l * 384; const float* kvg = p->kv_norm_g + l * 256; const float* conv_w = p->conv_w + (size_t)l * 4 * 1536;
    LAS float* dl = (LAS float*)(lds + wave * 2048);
    for (int t = TP + blockIdx.x * 8 + wave; t < TT; t += gridDim.x * 8) {
        const bf16_t* h = H + (size_t)t * IN_WP;
        int i_seq, row0, pidx; const bool smp = t >= TP; const int ts = t - TP;
        if (!smp) { i_seq = t & (SEQ - 1); row0 = t - i_seq; pidx = i_seq; } else { i_seq = ts & 7; row0 = t - i_seq; pidx = SEQ + i_seq; }
        { float q[6]; float ss = 0.f;
#pragma unroll
          for (int i = 0; i < 6; ++i) { q[i] = bf2f(h[C_Q + lane + 64 * i]); ss += q[i] * q[i]; }
          ss = wave_sum(ss); float r = rsqrtf(ss * (1.0f / 384.0f) + EPS);
#pragma unroll
          for (int i = 0; i < 6; ++i) p->cq[(size_t)t * 384 + lane + 64 * i] = f2bf(q[i] * r * qg[lane + 64 * i]);
          float kv[4]; ss = 0.f;
#pragma unroll
          for (int i = 0; i < 4; ++i) { kv[i] = bf2f(h[C_KV + lane + 64 * i]); ss += kv[i] * kv[i]; }
          ss = wave_sum(ss); r = rsqrtf(ss * (1.0f / 256.0f) + EPS);
          float* okv; float* okr;
          if (!smp) { okv = out + O_PKV + ((size_t)l * TP + t) * 256; okr = out + O_PKR + ((size_t)l * TP + t) * 32; }
          else { okv = out + O_SKV + ((size_t)l * TS + ts) * 256; okr = out + O_SKR + ((size_t)l * TS + ts) * 32; }
#pragma unroll
          for (int i = 0; i < 4; ++i) { const float o = kv[i] * r * kvg[lane + 64 * i]; okv[lane + 64 * i] = o; p->ckv[(size_t)t * 256 + lane + 64 * i] = f2bf(o); }
          if (lane < 16) { const float x1 = bf2f(h[C_KR + lane]), x2 = bf2f(h[C_KR + 16 + lane]); const float2 cs = p->tab[pidx * 16 + lane];
              const float o1 = x1 * cs.x - x2 * cs.y, o2 = x2 * cs.x + x1 * cs.y;
              okr[lane] = o1; okr[16 + lane] = o2; p->Kr[(size_t)t * 32 + lane] = f2bf(o1); p->Kr[(size_t)t * 32 + 16 + lane] = f2bf(o2); } }
        { const float* sc = smp ? p->state_conv + ((size_t)l * DEC_BATCH + (ts >> 3)) * 3 * 1536 : nullptr;
#pragma unroll 4
          for (int i = 0; i < 24; ++i) { const int c = lane + 64 * i; float y = 0.f;
#pragma unroll
              for (int j = 0; j < 4; ++j) { const int u = i_seq - 3 + j; float xv;
                  if (u >= 0) xv = bf2f(H[(size_t)(row0 + u) * IN_WP + C_QKV + c]); else xv = sc ? sc[(size_t)(u + 3) * 1536 + c] : 0.f;
                  y += xv * conv_w[j * 1536 + c]; }
              float v = siluf_(y);
              if (i < 16) { const float ss = wave_sum(v * v); v *= rsqrtf(ss + EPS); if (i < 8) v *= 0.125f; }
              const bf16_t o = f2bf(v);
              if (i < 8) p->qd[(size_t)t * 512 + c] = o; else if (i < 16) p->kd[(size_t)t * 512 + (c - 512)] = o; else p->vd[(size_t)t * 512 + (c - 1024)] = o;
              if (!smp) { if (i_seq >= SEQ - 3) out[O_PCONV + (((size_t)l * 8 + (t >> 11)) * 3 + (i_seq - (SEQ - 3))) * 1536 + c] = bf2f(h[C_QKV + c]); }
              else { if (i_seq >= DEC_SEQ - 3) out[O_SCONV + (((size_t)l * DEC_BATCH + (ts >> 3)) * 3 + (i_seq - (DEC_SEQ - 3))) * 1536 + c] = bf2f(h[C_QKV + c]); } }
          if (lane < 8) { const float b = sigmoidf_(p->BA[(size_t)t * 16 + lane]); const float x = p->BA[(size_t)t * 16 + 8 + lane] + p->dt_bias[l * 8 + lane];
              const float sp = x > 20.f ? x : log1pf(expf(x)); const float g = -expf(p->a_log[l * 8 + lane]) * sp;
              p->bg[(size_t)t * 16 + lane] = b; p->bg[(size_t)t * 16 + 8 + lane] = g; } }
        { const float* sp = smp ? p->state_pool + ((size_t)l * DEC_BATCH + (ts >> 3)) * 15 * 512 : nullptr;
          float* so = smp ? out + O_SPOOL + ((size_t)l * DEC_BATCH + (ts >> 3)) * 15 * 512 : nullptr;
#pragma unroll
          for (int j = 0; j < 8; ++j) { const int ch = lane + 64 * j, g = j >> 1, w = 2 << g; float sum = 0.f;
              for (int k = 0; k < w; ++k) { const int u = i_seq - k; float xv;
                  if (u >= 0) xv = bf2f(H[(size_t)(row0 + u) * IN_WP + C_POOL + ch]); else xv = sp ? sp[(size_t)(15 + u) * 512 + ch] : 0.f;
                  sum += xv; }
              const float cur = bf2f(h[C_POOL + ch]); const float cnt = !smp ? (float)min(i_seq + 1, w) : (float)w;
              dl[ch] = sum / cnt - cur;
              if (!smp) { if (i_seq >= SEQ - 15) out[O_PPOOL + (((size_t)l * 8 + (t >> 11)) * 15 + (i_seq - (SEQ - 15))) * 512 + ch] = cur; }
              else { so[(size_t)(7 + i_seq) * 512 + ch] = cur; if (i_seq < 7) so[(size_t)i_seq * 512 + ch] = sp[(size_t)(8 + i_seq) * 512 + ch]; } }
          asm volatile("s_waitcnt lgkmcnt(0)" ::: "memory");
#pragma unroll
          for (int j = 0; j < 8; ++j) { const int ch = lane + 64 * j, g = j >> 1, c = ch & 127; const float* m = p->pool_mix + ((size_t)l * 4 + g) * 128 * 128; float y = 0.f;
              for (int k = 0; k < 128; ++k) y += dl[g * 128 + k] * m[k * 128 + c];
              y *= p->pool_scale[l * 512 + ch]; y *= bf2f(h[C_ZPOOL + ch]); p->ya[(size_t)t * 512 + ch] = f2bf(y); }
          asm volatile("s_waitcnt lgkmcnt(0)" ::: "memory"); }
    }
}

__device__ __forceinline__ void ph_attn_s(KP p, int l, LAS unsigned char* lds) {
    int tid = threadIdx.x; asm volatile("" : "+v"(tid));
    const int r = tid & 63, cq = tid >> 6;
    LAS bf16_t* Ks = (LAS bf16_t*)lds;
    LAS float* Ss = (LAS float*)(lds + 18944);
    LAS bf16_t* Qs = (LAS bf16_t*)(lds + 18944 + 8448);
    const float* w_uk = p->w_uk + (size_t)l * 256 * 512;
    for (int u = blockIdx.x; u < DEC_BATCH; u += gridDim.x) {
        const int s = u, ch = 32;
        __syncthreads();
        { const int c = tid & 255, hh = tid >> 8;
          for (int h = hh * 4; h < hh * 4 + 4; ++h) { float acc[8];
#pragma unroll
              for (int i = 0; i < 8; ++i) acc[i] = 0.f;
              const float* wr_ = w_uk + (size_t)c * 512 + h * 64;
              for (int d = 0; d < 64; d += 4) { const f32x4 wv = *(const f32x4*)(wr_ + d);
#pragma unroll
                  for (int i = 0; i < 8; ++i) { const bf16_t* q = p->Q + (size_t)(TP + s * 8 + i) * 768 + h * 96 + d;
                      acc[i] += bf2f(q[0]) * wv[0] + bf2f(q[1]) * wv[1] + bf2f(q[2]) * wv[2] + bf2f(q[3]) * wv[3]; } }
#pragma unroll
              for (int i = 0; i < 8; ++i) Qs[(i * 8 + h) * 290 + c] = f2bf(acc[i]); }
          for (int e = tid; e < 64 * 32; e += NTHR) { const int rr = e >> 5, j = e & 31; Qs[rr * 290 + 256 + j] = p->Q[(size_t)(TP + s * 8 + (rr >> 3)) * 768 + (rr & 7) * 96 + 64 + j]; } }
        float o[32];
#pragma unroll
        for (int d = 0; d < 32; ++d) o[d] = 0.f;
        float m = -1e30f, lsum = 0.f; const int i_tok = r >> 3; const int ntile = ch < 32 ? 16 : 1;
        for (int tl = 0; tl < ntile; ++tl) {
            __syncthreads();
            if (ch < 32) { const int j0 = ch * 512 + tl * 32; const int page = p->page_table[s * N_PAGES + (j0 >> 7)]; const int prow = j0 & 127;
                const float* kvp = p->cache_kv + (((size_t)l * N_POOL + page) * PAGE + prow) * 256; const float* krp = p->cache_kr + (((size_t)l * N_POOL + page) * PAGE + prow) * 32;
                for (int i = tid; i < 32 * 256; i += NTHR) Ks[(i >> 8) * 296 + (i & 255)] = f2bf(kvp[i]);
                for (int i = tid; i < 32 * 32; i += NTHR) Ks[(i >> 5) * 296 + 256 + (i & 31)] = f2bf(krp[i]);
            } else {
                for (int i = tid; i < 32 * 256; i += NTHR) { const int k = i >> 8; Ks[k * 296 + (i & 255)] = k < 8 ? p->ckv[((size_t)TP + s * 8 + k) * 256 + (i & 255)] : (bf16_t)0; }
                for (int i = tid; i < 32 * 32; i += NTHR) { const int k = i >> 5; Ks[k * 296 + 256 + (i & 31)] = k < 8 ? p->Kr[((size_t)TP + s * 8 + k) * 32 + (i & 31)] : (bf16_t)0; }
            }
            __syncthreads();
#pragma unroll
            for (int kk = 0; kk < 4; ++kk) { const int k = cq * 4 + kk; float sc = 0.f;
                for (int c = 0; c < 288; ++c) sc += bf2f(Qs[r * 290 + c]) * bf2f(Ks[k * 296 + c]);
                sc *= MLA_SCALE; if (ch == 32 && k > i_tok) sc = -1e30f; Ss[r * 33 + k] = sc; }
            __syncthreads();
            float tm = -1e30f;
            for (int k = 0; k < 32; ++k) tm = fmaxf(tm, Ss[r * 33 + k]);
            const float mn = fmaxf(m, tm), al = __expf(m - mn); m = mn; lsum *= al;
#pragma unroll
            for (int d = 0; d < 32; ++d) o[d] *= al;
            for (int k = 0; k < 32; ++k) { const float sc = Ss[r * 33 + k]; const float pr = sc <= -1e29f ? 0.f : __expf(sc - mn); lsum += pr;
#pragma unroll
                for (int d = 0; d < 32; ++d) o[d] += pr * bf2f(Ks[k * 296 + cq * 32 + d]); }
        }
        float* pp = p->part + (((size_t)s * SA_CH + 8) * 64 + r) * 258;
#pragma unroll
        for (int d = 0; d < 32; ++d) pp[cq * 32 + d] = o[d];
        if (cq == 0) { pp[256] = m; pp[257] = lsum; }
    }
    __syncthreads();
}

__device__ __forceinline__ void wu_delta(KP p, int l, int sq, int h, int dv) {
    int row0, L; float* so; float S[64];
    if (sq < 8) { row0 = sq * SEQ; L = SEQ; so = p->out + O_PDELTA + (((size_t)l * 8 + sq) * 8 + h) * 4096;
#pragma unroll
        for (int k = 0; k < 64; ++k) S[k] = 0.f; }
    else { const int s = sq - 8; row0 = TP + s * 8; L = DEC_SEQ; so = p->out + O_SDELTA + (((size_t)l * DEC_BATCH + s) * 8 + h) * 4096;
        const float* s0 = p->state_delta + (((size_t)l * DEC_BATCH + s) * 8 + h) * 4096;
#pragma unroll
        for (int k = 0; k < 64; ++k) S[k] = s0[k * 64 + dv]; }
    const float gn = p->dn_norm_g[l * 64 + dv];
    for (int i = 0; i < L; ++i) {
        const size_t t = (size_t)row0 + i; const u32x4* kp = (const u32x4*)(p->kd + t * 512 + h * 64); const u32x4* qp = (const u32x4*)(p->qd + t * 512 + h * 64);
        const float b = p->bg[t * 16 + h], a = __expf(p->bg[t * 16 + 8 + h]); const float v = bf2f(p->vd[t * 512 + h * 64 + dv]);
        u32x4 kk[8];
#pragma unroll
        for (int c = 0; c < 8; ++c) kk[c] = kp[c];
        float ks = 0.f;
#pragma unroll
        for (int c = 0; c < 8; ++c)
#pragma unroll
            for (int e = 0; e < 4; ++e) { const unsigned w = kk[c][e]; ks += __uint_as_float(w << 16) * S[c * 8 + 2 * e] + __uint_as_float(w & 0xffff0000u) * S[c * 8 + 2 * e + 1]; }
        const float vn = b * (v - a * ks); float o = 0.f;
#pragma unroll
        for (int c = 0; c < 8; ++c) { const u32x4 qv = qp[c];
#pragma unroll
            for (int e = 0; e < 4; ++e) { const unsigned w = kk[c][e], wq = qv[e]; const int k0 = c * 8 + 2 * e;
                S[k0] = a * S[k0] + __uint_as_float(w << 16) * vn; o += __uint_as_float(wq << 16) * S[k0];
                S[k0 + 1] = a * S[k0 + 1] + __uint_as_float(w & 0xffff0000u) * vn; o += __uint_as_float(wq & 0xffff0000u) * S[k0 + 1]; }
            asm volatile("" ::: "memory"); }
        const float ss = wave_sum(o * o); const float y = o * rsqrtf(ss * (1.0f / 64.0f) + EPS) * gn;
        p->yc[t * 512 + h * 64 + dv] = f2bf(y * bf2f(p->H[t * IN_WP + C_ZDN + h * 64 + dv]));
    }
#pragma unroll
    for (int k = 0; k < 64; ++k) so[k * 64 + dv] = S[k];
}
__device__ __forceinline__ int sig_inv(int rho) { return (rho & 32) | ((rho & 12) << 1) | ((rho & 16) >> 2) | (rho & 3); }
constexpr int DPRE_LDS = 64 * 64 * 4 + 512;
__device__ __forceinline__ void ph_delta_pre(KP p, LAS unsigned char* lds) {
    int tid_o = threadIdx.x; asm volatile("" : "+v"(tid_o)); int lane = tid_o & 63, wave = tid_o >> 6;
    wave = __builtin_amdgcn_readfirstlane(wave);
    LAS float* Am = (LAS float*)(lds + wave * DPRE_LDS); LAS float* gcs = Am + 4096; LAS float* bts = gcs + 64;
    for (int unit = wave * gridDim.x + blockIdx.x; unit < 2048; unit += gridDim.x * 8) {
        { int t_ = threadIdx.x; asm volatile("" : "+v"(t_)); lane = t_ & 63; }
        const int r = lane & 31, hh = lane >> 5;
        const int bh = unit >> 5, ch = unit & 31, b = bh >> 3, h = bh & 7;
        const size_t t0 = (size_t)b * SEQ + ch * 64;
        bf16_t* op = p->DOP + (size_t)unit * 4 * 4096; float* up = p->DU + (size_t)unit * 4096;
        const bf16_t* kdb = p->kd + t0 * 512 + h * 64; const bf16_t* qdb = p->qd + t0 * 512 + h * 64; const bf16_t* vdb = p->vd + t0 * 512 + h * 64;
        const float* bgb = p->bg + t0 * 16 + h;
        const float beta = bgb[lane * 16]; float gc = bgb[lane * 16 + 8];
#pragma unroll
        for (int d = 1; d < 64; d <<= 1) { const float x = __shfl_up(gc, d); if (lane >= d) gc += x; }
        const float gl = __shfl(gc, 63);
        gcs[lane] = gc; bts[lane] = beta;
        if (lane == 0) p->DG[unit] = __expf(gl);
        bf16x8_t kf[2][4], qf[2][4];
        { const int voff = r * 512 + 8 * hh;
#pragma unroll
          for (int rb = 0; rb < 2; ++rb)
#pragma unroll
            for (int ks = 0; ks < 4; ++ks) { kf[rb][ks] = *(const bf16x8_t*)(kdb + (32 * rb * 512 + 16 * ks) + voff); qf[rb][ks] = *(const bf16x8_t*)(qdb + (32 * rb * 512 + 16 * ks) + voff); } }
        {
#pragma unroll
            for (int rb = 0; rb < 2; ++rb) { const float sc = __expf(gl - __shfl(gc, 32 * rb + r)); const int voff = hh * 512 + sig_inv(32 * rb + r);
#pragma unroll
                for (int ks = 0; ks < 4; ++ks) {
#pragma unroll
                    for (int jj = 0; jj < 8; ++jj) (op + 3 * 4096 + (16 * ks + jj) * 64)[voff] = f2bf(bf2f((bf16_t)kf[rb][ks][jj]) * sc);
                    asm volatile("" ::: "memory"); } } }
        f32x16 kk00, kk10, kk11, qk00, qk10, qk11;
#pragma unroll
        for (int e = 0; e < 16; ++e) { kk00[e] = 0.f; kk10[e] = 0.f; kk11[e] = 0.f; qk00[e] = 0.f; qk10[e] = 0.f; qk11[e] = 0.f; }
#pragma unroll
        for (int ks = 0; ks < 4; ++ks) {
            kk00 = __builtin_amdgcn_mfma_f32_32x32x16_bf16(kf[0][ks], kf[0][ks], kk00, 0, 0, 0);
            kk10 = __builtin_amdgcn_mfma_f32_32x32x16_bf16(kf[1][ks], kf[0][ks], kk10, 0, 0, 0);
            kk11 = __builtin_amdgcn_mfma_f32_32x32x16_bf16(kf[1][ks], kf[1][ks], kk11, 0, 0, 0);
            qk00 = __builtin_amdgcn_mfma_f32_32x32x16_bf16(qf[0][ks], kf[0][ks], qk00, 0, 0, 0);
            qk10 = __builtin_amdgcn_mfma_f32_32x32x16_bf16(qf[1][ks], kf[0][ks], qk10, 0, 0, 0);
            qk11 = __builtin_amdgcn_mfma_f32_32x32x16_bf16(qf[1][ks], kf[1][ks], qk11, 0, 0, 0);
        }
        asm volatile("s_waitcnt lgkmcnt(0)" ::: "memory");
        {
            const float gcj0 = __shfl(gc, r), gcj1 = __shfl(gc, 32 + r);
            const int p0 = hh * 256 + sig_inv(r), p1 = hh * 256 + sig_inv(32 + r);
#pragma unroll
            for (int e = 0; e < 16; ++e) { const int ib = (e & 3) + 8 * (e >> 2), il = ib + 4 * hh;
                { const int i = il, j = r; const float gi = gcs[i], bi = bts[i]; const float dec = __expf(fminf(gi - gcj0, 0.f));
                  Am[i * 64 + j] = j < i ? bi * kk00[e] * dec : 0.f; (op + 2 * 4096 + ib * 64)[p0] = f2bf(j <= i ? qk00[e] * dec : 0.f); }
                { const int i = 32 + il, j = r; const float gi = gcs[i], bi = bts[i]; const float dec = __expf(fminf(gi - gcj0, 0.f));
                  Am[i * 64 + j] = bi * kk10[e] * dec; (op + 2 * 4096 + (32 + ib) * 64)[p0] = f2bf(qk10[e] * dec); }
                { const int i = 32 + il, j = 32 + r; const float gi = gcs[i], bi = bts[i]; const float dec = __expf(fminf(gi - gcj1, 0.f));
                  Am[i * 64 + j] = j < i ? bi * kk11[e] * dec : 0.f; (op + 2 * 4096 + (32 + ib) * 64)[p1] = f2bf(j <= i ? qk11[e] * dec : 0.f); }
                asm volatile("" ::: "memory");
            }
        }
        asm volatile("s_waitcnt lgkmcnt(0)" ::: "memory");
        {
            int c; { int t_ = threadIdx.x; asm volatile("" : "+v"(t_)); c = t_ & 63; } const int pc = sig_inv(c);
            const float egc = __expf(gc);
            const int beta_i = __float_as_int(beta), egc_i = __float_as_int(egc);
            { float u[64];
#pragma unroll
              for (int i = 0; i < 64; ++i) { const float bi = __int_as_float(__builtin_amdgcn_readlane(beta_i, i)); u[i] = bi * bf2f((vdb + i * 512)[c]); }
#pragma unroll
              for (int i = 1; i < 64; ++i) { float au = u[i];
#pragma unroll
                  for (int j4 = 0; j4 < i; j4 += 4) { const f32x4 a = *(const LAS f32x4*)(Am + i * 64 + j4);
#pragma unroll
                      for (int e = 0; e < 4; ++e) if (j4 + e < i) au -= a[e] * u[j4 + e]; }
                  u[i] = au; }
#pragma unroll
              for (int i = 0; i < 64; ++i) (up + i * 64)[c] = u[i]; }
            asm volatile("" ::: "memory");
            { float w[64];
#pragma unroll
              for (int i = 0; i < 64; ++i) { const float bi = __int_as_float(__builtin_amdgcn_readlane(beta_i, i)), ei = __int_as_float(__builtin_amdgcn_readlane(egc_i, i));
                  w[i] = bi * ei * bf2f((kdb + i * 512)[c]); (op + 1 * 4096 + i * 64)[pc] = f2bf(bf2f((qdb + i * 512)[c]) * ei); }
#pragma unroll
              for (int i = 1; i < 64; ++i) { float aw = w[i];
#pragma unroll
                  for (int j4 = 0; j4 < i; j4 += 4) { const f32x4 a = *(const LAS f32x4*)(Am + i * 64 + j4);
#pragma unroll
                      for (int e = 0; e < 4; ++e) if (j4 + e < i) aw -= a[e] * w[j4 + e]; }
                  w[i] = aw; }
#pragma unroll
              for (int i = 0; i < 64; ++i) (op + i * 64)[pc] = f2bf(-w[i]); }
        }
        asm volatile("s_waitcnt lgkmcnt(0)" ::: "memory");
    }
}
__device__ __forceinline__ bf16x8_t pack_b(const f32x4& lo, const f32x4& hi) { union { u32x4 u; bf16x8_t v; } x;
    x.u.x = pg8::cvt_pk_bf16(lo[0], lo[1]); x.u.y = pg8::cvt_pk_bf16(lo[2], lo[3]); x.u.z = pg8::cvt_pk_bf16(hi[0], hi[1]); x.u.w = pg8::cvt_pk_bf16(hi[2], hi[3]); return x.v; }
__device__ __forceinline__ void wu_scan(KP p, int l, int bh, int slice, int lane) {
    const int n = lane & 15, q = lane >> 4, n0 = slice * 16, b = bh >> 3, h = bh & 7;
    f32x4 S[4];
#pragma unroll
    for (int t = 0; t < 4; ++t) S[t] = (f32x4){0.f, 0.f, 0.f, 0.f};
    const int foff = n * 64 + 8 * q;
    for (int ch = 0; ch < 32; ++ch) {
        const size_t unit = (size_t)bh * 32 + ch;
        const bf16_t* op = p->DOP + unit * 4 * 4096 + foff; const float* up = p->DU + unit * 4096 + n0 + n;
        const float eg = p->DG[unit];
        f32x4 vn[4]; bf16x8_t wf[4][2], gf[4][2], kf[4][2], tf[4][2];
#pragma unroll
        for (int mt = 0; mt < 4; ++mt) {
#pragma unroll
            for (int e = 0; e < 4; ++e) vn[mt][e] = up[(16 * mt + 4 * q + e) * 64];
#pragma unroll
            for (int ks = 0; ks < 2; ++ks) { const int o = mt * 1024 + ks * 32;
                wf[mt][ks] = *(const bf16x8_t*)(op + o); gf[mt][ks] = *(const bf16x8_t*)(op + 4096 + o);
                kf[mt][ks] = *(const bf16x8_t*)(op + 2 * 4096 + o); tf[mt][ks] = *(const bf16x8_t*)(op + 3 * 4096 + o); } }
        const bf16x8_t sb0 = pack_b(S[0], S[1]), sb1 = pack_b(S[2], S[3]);
        f32x4 o[4];
#pragma unroll
        for (int mt = 0; mt < 4; ++mt) {
            vn[mt] = __builtin_amdgcn_mfma_f32_16x16x32_bf16(wf[mt][0], sb0, vn[mt], 0, 0, 0);
            vn[mt] = __builtin_amdgcn_mfma_f32_16x16x32_bf16(wf[mt][1], sb1, vn[mt], 0, 0, 0);
            o[mt] = __builtin_amdgcn_mfma_f32_16x16x32_bf16(gf[mt][0], sb0, (f32x4){0.f, 0.f, 0.f, 0.f}, 0, 0, 0);
            o[mt] = __builtin_amdgcn_mfma_f32_16x16x32_bf16(gf[mt][1], sb1, o[mt], 0, 0, 0);
        }
        const bf16x8_t vb0 = pack_b(vn[0], vn[1]), vb1 = pack_b(vn[2], vn[3]);
#pragma unroll
        for (int mt = 0; mt < 4; ++mt) {
            o[mt] = __builtin_amdgcn_mfma_f32_16x16x32_bf16(kf[mt][0], vb0, o[mt], 0, 0, 0);
            if (mt >= 2) o[mt] = __builtin_amdgcn_mfma_f32_16x16x32_bf16(kf[mt][1], vb1, o[mt], 0, 0, 0);
            S[mt] = S[mt] * eg;
            S[mt] = __builtin_amdgcn_mfma_f32_16x16x32_bf16(tf[mt][0], vb0, S[mt], 0, 0, 0);
            S[mt] = __builtin_amdgcn_mfma_f32_16x16x32_bf16(tf[mt][1], vb1, S[mt], 0, 0, 0);
        }
        bf16_t* yo = p->yc + ((size_t)b * SEQ + ch * 64) * 512 + h * 64 + n0 + n;
#pragma unroll
        for (int mt = 0; mt < 4; ++mt)
#pragma unroll
            for (int e = 0; e < 4; ++e) yo[(size_t)(16 * mt + 4 * q + e) * 512] = f2bf(o[mt][e]);
    }
    float* so = p->out + O_PDELTA + (((size_t)l * 8 + b) * 8 + h) * 4096 + n0 + n;
#pragma unroll
    for (int t = 0; t < 4; ++t)
#pragma unroll
        for (int e = 0; e < 4; ++e) so[(16 * t + 4 * q + e) * 64] = S[t][e];
}
__device__ __forceinline__ void ph_delta_fin(KP p, int l) {
    int tid_o = threadIdx.x; asm volatile("" : "+v"(tid_o)); int lane = tid_o & 63, wave = tid_o >> 6;
    const int h = lane >> 3, d0 = (lane & 7) * 8;
    for (int t = blockIdx.x * 8 + wave; t < TP; t += gridDim.x * 8) {
        bf16_t* yp = p->yc + (size_t)t * 512 + h * 64 + d0; const u32x4 raw = *(const u32x4*)yp; const u32x4 gz = *(const u32x4*)(p->H + (size_t)t * IN_WP + C_ZDN + h * 64 + d0);
        float v[8]; v[0] = __uint_as_float(raw.x << 16); v[1] = __uint_as_float(raw.x & 0xffff0000u); v[2] = __uint_as_float(raw.y << 16); v[3] = __uint_as_float(raw.y & 0xffff0000u);
        v[4] = __uint_as_float(raw.z << 16); v[5] = __uint_as_float(raw.z & 0xffff0000u); v[6] = __uint_as_float(raw.w << 16); v[7] = __uint_as_float(raw.w & 0xffff0000u);
        float z[8]; z[0] = __uint_as_float(gz.x << 16); z[1] = __uint_as_float(gz.x & 0xffff0000u); z[2] = __uint_as_float(gz.y << 16); z[3] = __uint_as_float(gz.y & 0xffff0000u);
        z[4] = __uint_as_float(gz.z << 16); z[5] = __uint_as_float(gz.z & 0xffff0000u); z[6] = __uint_as_float(gz.w << 16); z[7] = __uint_as_float(gz.w & 0xffff0000u);
        float ss = 0.f;
#pragma unroll
        for (int e = 0; e < 8; ++e) ss += v[e] * v[e];
        ss += __shfl_xor(ss, 1); ss += __shfl_xor(ss, 2); ss += __shfl_xor(ss, 4);
        const float rs = rsqrtf(ss * (1.0f / 64.0f) + EPS);
#pragma unroll
        for (int e = 0; e < 8; ++e) v[e] = v[e] * rs * p->dn_norm_g[l * 64 + d0 + e] * z[e];
        u32x4 w; w.x = pg8::cvt_pk_bf16(v[0], v[1]); w.y = pg8::cvt_pk_bf16(v[2], v[3]); w.z = pg8::cvt_pk_bf16(v[4], v[5]); w.w = pg8::cvt_pk_bf16(v[6], v[7]);
        *(u32x4*)yp = w;
    }
}

__device__ __forceinline__ void ph_att_waves(KP p, int l) {
    int tid_o = threadIdx.x; asm volatile("" : "+v"(tid_o)); int lane = tid_o & 63, wave = tid_o >> 6;
    wave = __builtin_amdgcn_readfirstlane(wave);
    const int G = gridDim.x, NW = G * 8, gw = wave * G + blockIdx.x;
    for (int d = gw; d < 256; d += NW) wu_scan(p, l, d >> 2, d & 3, lane);
    for (int d = NW - 1 - gw; d < 256; d += NW) wu_delta(p, l, 8 + (d >> 3), d & 7, lane);
}
__device__ __forceinline__ void ph_fin(KP p, int l, LAS unsigned char* lds) {
    int tid_o = threadIdx.x; asm volatile("" : "+v"(tid_o)); int lane = tid_o & 63, wave = tid_o >> 6;
    LAS float* ol = (LAS float*)(lds + wave * 2048); LAS float* wgt = ol + 256;
    const float* w_uv = p->w_uv + (size_t)l * 256 * 512;
    for (int u = blockIdx.x * 8 + wave; u < TS * 8; u += gridDim.x * 8) {
        const int ts = u >> 3, h = u & 7, s = ts >> 3, r = (ts & 7) * 8 + h; const int d = lane;
        float M = -1e30f;
        for (int ch = 0; ch < SA_CH; ++ch) M = fmaxf(M, p->part[(((size_t)s * SA_CH + ch) * 64 + r) * 258 + 256]);
        float L = 0.f;
        for (int ch = 0; ch < SA_CH; ++ch) { const float* pp = p->part + (((size_t)s * SA_CH + ch) * 64 + r) * 258; const float w = __expf(pp[256] - M); L += pp[257] * w; if (d == 0) wgt[ch] = w; }
        asm volatile("s_waitcnt lgkmcnt(0)" ::: "memory");
        for (int c = d; c < 256; c += 64) { float a = 0.f; for (int ch = 0; ch < SA_CH; ++ch) a += wgt[ch] * p->part[(((size_t)s * SA_CH + ch) * 64 + r) * 258 + c]; ol[c] = a / L; }
        asm volatile("s_waitcnt lgkmcnt(0)" ::: "memory");
        float a = 0.f;
        for (int c = 0; c < 256; ++c) a += ol[c] * w_uv[(size_t)c * 512 + h * 64 + d];
        const int t = TP + ts;
        p->yb[(size_t)t * 512 + h * 64 + d] = f2bf(a * bf2f(p->H[(size_t)t * IN_WP + C_ZMLA + h * 64 + d]));
        asm volatile("s_waitcnt lgkmcnt(0)" ::: "memory");
    }
}

constexpr int SA_QS = 592, SA_KS = 576, SA_PS = 272;
constexpr int SA_OFF_Q = 0, SA_OFF_K = 64 * SA_QS, SA_OFF_P = SA_OFF_K + 128 * SA_KS, SA_OFF_M = SA_OFF_P + 64 * SA_PS, SA_OFF_L = SA_OFF_M + 1024, SA_LDS = SA_OFF_L + 1024;
typedef short s16x4 __attribute__((ext_vector_type(4)));
__device__ __forceinline__ void sa_unit(KP p, int l, int s, int ch, LAS unsigned char* lds, int tid) {
    const int lane = tid & 63, wave = __builtin_amdgcn_readfirstlane(tid >> 6), r = lane & 31, hh = lane >> 5;
    const int qb = wave & 1, kb = wave >> 1, cg = wave >> 1;
    LAS unsigned char* Qs = lds + SA_OFF_Q; LAS unsigned char* Kt = lds + SA_OFF_K; LAS unsigned char* Pt = lds + SA_OFF_P;
    LAS float* mloc = (LAS float*)(lds + SA_OFF_M); LAS float* lred = (LAS float*)(lds + SA_OFF_L);
    __syncthreads();
    { const float* w_uk = p->w_uk + (size_t)l * 256 * 512; const bf16_t* Qg = p->Q + (size_t)(TP + s * 8) * 768;
      const int c = tid & 255, h2 = tid >> 8;
      for (int h = h2 * 4; h < h2 * 4 + 4; ++h) { float acc[8];
#pragma unroll
          for (int i = 0; i < 8; ++i) acc[i] = 0.f;
          const float* wr_ = w_uk + (size_t)c * 512 + h * 64;
          for (int d = 0; d < 64; d += 4) { const f32x4 wv = *(const f32x4*)(wr_ + d);
#pragma unroll
              for (int i = 0; i < 8; ++i) { const bf16_t* q = Qg + i * 768 + h * 96 + d;
                  acc[i] += bf2f(q[0]) * wv[0] + bf2f(q[1]) * wv[1] + bf2f(q[2]) * wv[2] + bf2f(q[3]) * wv[3]; } }
#pragma unroll
          for (int i = 0; i < 8; ++i) *(LAS bf16_t*)(Qs + (i * 8 + h) * SA_QS + c * 2) = f2bf(acc[i]); }
      for (int e = tid; e < 64 * 32; e += NTHR) { const int rr = e >> 5, j = e & 31; *(LAS bf16_t*)(Qs + rr * SA_QS + (256 + j) * 2) = Qg[(rr >> 3) * 768 + (rr & 7) * 96 + 64 + j]; } }
    const int* pt = p->page_table + s * N_PAGES + ch * 16;
    const float* ckv_base = p->cache_kv + (size_t)l * N_POOL * PAGE * 256; const float* ckr_base = p->cache_kr + (size_t)l * N_POOL * PAGE * 32;
    f32x4 rk[16], rr2[2];
    { const int page = pt[0]; const float* kvp = ckv_base + (size_t)page * PAGE * 256; const float* krp = ckr_base + (size_t)page * PAGE * 32;
#pragma unroll
      for (int i = 0; i < 16; ++i) rk[i] = __builtin_nontemporal_load((const f32x4*)(kvp + (size_t)(tid + 512 * i) * 4));
#pragma unroll
      for (int i = 0; i < 2; ++i) rr2[i] = __builtin_nontemporal_load((const f32x4*)(krp + (size_t)(tid + 512 * i) * 4)); }
    f32x16 o0, o1;
#pragma unroll
    for (int e = 0; e < 16; ++e) { o0[e] = 0.f; o1[e] = 0.f; }
    float m = -1e30f, lw = 0.f;
    const int li = lane & 15, g1 = (lane >> 4) & 1;
    const int trOff = (8 * hh + (li >> 2)) * SA_KS + (16 * g1 + 4 * (li & 3)) * 2;
    for (int t = 0; t < 16; ++t) {
        __syncthreads();
#pragma unroll
        for (int i = 0; i < 16; ++i) { const int ci = tid + 512 * i, key = ci >> 6, c4 = ci & 63; u32x2 w; w.x = pg8::cvt_pk_bf16(rk[i][0], rk[i][1]); w.y = pg8::cvt_pk_bf16(rk[i][2], rk[i][3]);
            *(LAS u32x2*)(Kt + key * SA_KS + c4 * 8) = w; }
#pragma unroll
        for (int i = 0; i < 2; ++i) { const int ci = tid + 512 * i, key = ci >> 3, c4 = ci & 7; u32x2 w; w.x = pg8::cvt_pk_bf16(rr2[i][0], rr2[i][1]); w.y = pg8::cvt_pk_bf16(rr2[i][2], rr2[i][3]);
            *(LAS u32x2*)(Kt + key * SA_KS + 512 + c4 * 8) = w; }
        __syncthreads();
        if (t + 1 < 16) { const int page = pt[t + 1]; const float* kvp = ckv_base + (size_t)page * PAGE * 256; const float* krp = ckr_base + (size_t)page * PAGE * 32;
#pragma unroll
            for (int i = 0; i < 16; ++i) rk[i] = __builtin_nontemporal_load((const f32x4*)(kvp + (size_t)(tid + 512 * i) * 4));
#pragma unroll
            for (int i = 0; i < 2; ++i) rr2[i] = __builtin_nontemporal_load((const f32x4*)(krp + (size_t)(tid + 512 * i) * 4)); }
        f32x16 sa;
#pragma unroll
        for (int e = 0; e < 16; ++e) sa[e] = 0.f;
        { const LAS unsigned char* ka = Kt + (32 * kb + r) * SA_KS + 16 * hh; const LAS unsigned char* qa = Qs + (32 * qb + r) * SA_QS + 16 * hh;
#pragma unroll
          for (int ks = 0; ks < 18; ++ks) sa = __builtin_amdgcn_mfma_f32_32x32x16_bf16(*(const LAS bf16x8_t*)(ka + ks * 32), *(const LAS bf16x8_t*)(qa + ks * 32), sa, 0, 0, 0); }
        float tm = sa[0];
#pragma unroll
        for (int e = 1; e < 16; ++e) tm = fmaxf(tm, sa[e]);
        tm = fmaxf(tm, __shfl_xor(tm, 32));
        if (hh == 0) mloc[kb * 64 + 32 * qb + r] = tm;
        __syncthreads();
        { const int q = 32 * qb + r; const float tmx = fmaxf(fmaxf(mloc[q], mloc[64 + q]), fmaxf(mloc[128 + q], mloc[192 + q]));
          const float mn = fmaxf(m, tmx), al = __builtin_amdgcn_exp2f((m - mn) * ATT_C), mc = mn * ATT_C; m = mn;
          float ps = 0.f;
#pragma unroll
          for (int e = 0; e < 16; ++e) { sa[e] = __builtin_amdgcn_exp2f(sa[e] * ATT_C - mc); ps += sa[e]; }
          lw = lw * al + ps;
#pragma unroll
          for (int g4 = 0; g4 < 4; ++g4) { u32x2 w; w.x = pg8::cvt_pk_bf16(sa[4 * g4], sa[4 * g4 + 1]); w.y = pg8::cvt_pk_bf16(sa[4 * g4 + 2], sa[4 * g4 + 3]);
              *(LAS u32x2*)(Pt + q * SA_PS + (32 * kb + 8 * g4 + 4 * hh) * 2) = w; }
#pragma unroll
          for (int e = 0; e < 16; ++e) { o0[e] *= al; o1[e] *= al; } }
        __syncthreads();
        { const LAS unsigned char* pa = Pt + (32 * qb + r) * SA_PS + 16 * hh; const LAS unsigned char* va = Kt + trOff + (64 * cg) * 2;
#pragma unroll
          for (int ks = 0; ks < 8; ++ks) { const bf16x8_t pb = *(const LAS bf16x8_t*)(pa + ks * 32);
              union { struct { s16x4 lo, hi; } h; bf16x8_t v; } a0, a1;
              a0.h.lo = __builtin_amdgcn_ds_read_tr16_b64_v4i16((LAS s16x4*)(va + ks * 16 * SA_KS)); a0.h.hi = __builtin_amdgcn_ds_read_tr16_b64_v4i16((LAS s16x4*)(va + ks * 16 * SA_KS + 4 * SA_KS));
              a1.h.lo = __builtin_amdgcn_ds_read_tr16_b64_v4i16((LAS s16x4*)(va + ks * 16 * SA_KS + 64)); a1.h.hi = __builtin_amdgcn_ds_read_tr16_b64_v4i16((LAS s16x4*)(va + ks * 16 * SA_KS + 4 * SA_KS + 64));
              o0 = __builtin_amdgcn_mfma_f32_32x32x16_bf16(a0.v, pb, o0, 0, 0, 0);
              o1 = __builtin_amdgcn_mfma_f32_32x32x16_bf16(a1.v, pb, o1, 0, 0, 0); } }
    }
    lw += __shfl_xor(lw, 32);
    if (hh == 0) lred[kb * 64 + 32 * qb + r] = lw;
    __syncthreads();
    { const int q = 32 * qb + r; float* pp = p->part + (((size_t)s * SA_CH + ch) * 64 + q) * 258;
#pragma unroll
      for (int cb2 = 0; cb2 < 2; ++cb2)
#pragma unroll
          for (int g4 = 0; g4 < 4; ++g4) { const int c = 32 * (2 * cg + cb2) + 8 * g4 + 4 * hh; f32x4 v;
#pragma unroll
              for (int e = 0; e < 4; ++e) v[e] = cb2 == 0 ? o0[4 * g4 + e] : o1[4 * g4 + e];
              *(f32x2*)(pp + c) = (f32x2){v[0], v[1]}; *(f32x2*)(pp + c + 2) = (f32x2){v[2], v[3]}; }
      if (cg == 0 && hh == 0) { pp[256] = m * MLA_SCALE; pp[257] = lred[q] + lred[64 + q] + lred[128 + q] + lred[192 + q]; } }
}
__device__ __forceinline__ void ph_attn_s2(KP p, int l, LAS unsigned char* lds) {
    int tid = threadIdx.x; asm volatile("" : "+v"(tid));
    for (int u = blockIdx.x; u < DEC_BATCH * 8; u += gridDim.x) sa_unit(p, l, u >> 3, u & 7, lds, tid);
    __syncthreads();
}

constexpr int ATT_KS = 208, ATT_VS = 144, ATT_KB = 64 * ATT_KS, ATT_VB = 64 * ATT_VS, ATT_STAGE = ATT_KB + ATT_VB;
__device__ __forceinline__ void attn_unit(KP p, int b, int h, int qblk, LAS unsigned char* lds, int tid, int wave, int lane) {
    const int r = lane & 31, hh = lane >> 5;
    const int q0 = qblk * 256 + wave * 32;
    const size_t trow0 = (size_t)b * SEQ;
    bf16x8_t qf[6];
    { const bf16_t* qp = p->Q + (trow0 + q0 + r) * 768 + h * 96 + 8 * hh;
#pragma unroll
      for (int ks = 0; ks < 6; ++ks) qf[ks] = *(const bf16x8_t*)(qp + 16 * ks); }
    f32x16 o0, o1;
#pragma unroll
    for (int e = 0; e < 16; ++e) { o0[e] = 0.f; o1[e] = 0.f; }
    float m = -1e30f, lsum = 0.f;
    const int ntile = qblk * 4 + 4;
    const int cA = tid, keyA = cA / 12, partA = cA - keyA * 12; const int cB = 512 + (tid & 255), keyB = cB / 12, partB = cB - keyB * 12; const bool hasB = tid < 256;
    const bf16_t* gA = partA < 8 ? p->Kn + (trow0 + keyA) * 512 + h * 64 + partA * 8 : p->Kr + (trow0 + keyA) * 32 + (partA - 8) * 8; const int stepA = partA < 8 ? 64 * 512 : 64 * 32;
    const bf16_t* gB = partB < 8 ? p->Kn + (trow0 + keyB) * 512 + h * 64 + partB * 8 : p->Kr + (trow0 + keyB) * 32 + (partB - 8) * 8; const int stepB = partB < 8 ? 64 * 512 : 64 * 32;
    const bf16_t* gV = p->Vt + (size_t)(h * 64 + (tid >> 3)) * TP + trow0 + (tid & 7) * 8;
    const int lA = keyA * ATT_KS + partA * 16, lB = keyB * ATT_KS + partB * 16, lV = ATT_KB + (tid >> 3) * ATT_VS + (tid & 7) * 16;
    const int pr_ = (r & 0x13) | ((r & 4) << 1) | ((r & 8) >> 1);
    const int kOff = pr_ * ATT_KS + 16 * hh, vOff = ATT_KB + r * ATT_VS + 16 * hh;
    u32x4 rA = *(const u32x4*)gA, rB = hasB ? *(const u32x4*)gB : (u32x4){0u, 0u, 0u, 0u}, rV = *(const u32x4*)gV;
    for (int kt = 0; kt < ntile; ++kt) {
        LAS unsigned char* st = lds + (kt & 1) * ATT_STAGE;
        *(LAS u32x4*)(st + lA) = rA; if (hasB) *(LAS u32x4*)(st + lB) = rB; *(LAS u32x4*)(st + lV) = rV;
        __syncthreads();
        if (kt + 1 < ntile) { gA += stepA; gB += stepB; gV += 64; rA = *(const u32x4*)gA; if (hasB) rB = *(const u32x4*)gB; rV = *(const u32x4*)gV; }
        if (kt * 64 <= q0 + 31) {
            f32x16 s0, s1;
#pragma unroll
            for (int e = 0; e < 16; ++e) { s0[e] = 0.f; s1[e] = 0.f; }
#pragma unroll
            for (int ks = 0; ks < 6; ++ks) {
                const bf16x8_t a0 = *(const LAS bf16x8_t*)(st + kOff + ks * 32), a1 = *(const LAS bf16x8_t*)(st + kOff + 32 * ATT_KS + ks * 32);
                s0 = __builtin_amdgcn_mfma_f32_32x32x16_bf16(a0, qf[ks], s0, 0, 0, 0);
                s1 = __builtin_amdgcn_mfma_f32_32x32x16_bf16(a1, qf[ks], s1, 0, 0, 0);
            }
            if (kt * 64 + 63 > q0) {
                const int qrel = q0 + r - kt * 64;
#pragma unroll
                for (int e = 0; e < 16; ++e) { const int kl = (e & 3) + 4 * ((e >> 2) & 1) + 8 * hh + 16 * ((e >> 3) & 1);
                    if (kl > qrel) s0[e] = -1e30f; if (kl + 32 > qrel) s1[e] = -1e30f; }
            }
            float tm = fmaxf(s0[0], s1[0]);
#pragma unroll
            for (int e = 1; e < 16; ++e) tm = fmaxf(tm, fmaxf(s0[e], s1[e]));
            tm = fmaxf(tm, __shfl_xor(tm, 32));
            const float mn = fmaxf(m, tm), al = __builtin_amdgcn_exp2f((m - mn) * ATT_C), mc = mn * ATT_C; m = mn;
            float ps = 0.f;
#pragma unroll
            for (int e = 0; e < 16; ++e) { s0[e] = __builtin_amdgcn_exp2f(s0[e] * ATT_C - mc); s1[e] = __builtin_amdgcn_exp2f(s1[e] * ATT_C - mc); ps += s0[e] + s1[e]; }
            lsum = lsum * al + ps;
#pragma unroll
            for (int e = 0; e < 16; ++e) { o0[e] *= al; o1[e] *= al; }
#pragma unroll
            for (int kb = 0; kb < 2; ++kb)
#pragma unroll
                for (int sp = 0; sp < 2; ++sp) {
                    union { u32x4 u; bf16x8_t v; } pb;
                    if (kb == 0) { pb.u.x = pg8::cvt_pk_bf16(s0[8 * sp + 0], s0[8 * sp + 1]); pb.u.y = pg8::cvt_pk_bf16(s0[8 * sp + 2], s0[8 * sp + 3]); pb.u.z = pg8::cvt_pk_bf16(s0[8 * sp + 4], s0[8 * sp + 5]); pb.u.w = pg8::cvt_pk_bf16(s0[8 * sp + 6], s0[8 * sp + 7]); }
                    else         { pb.u.x = pg8::cvt_pk_bf16(s1[8 * sp + 0], s1[8 * sp + 1]); pb.u.y = pg8::cvt_pk_bf16(s1[8 * sp + 2], s1[8 * sp + 3]); pb.u.z = pg8::cvt_pk_bf16(s1[8 * sp + 4], s1[8 * sp + 5]); pb.u.w = pg8::cvt_pk_bf16(s1[8 * sp + 6], s1[8 * sp + 7]); }
                    const int ko = (32 * kb + 16 * sp) * 2;
                    const bf16x8_t v0 = *(const LAS bf16x8_t*)(st + vOff + ko), v1 = *(const LAS bf16x8_t*)(st + vOff + 32 * ATT_VS + ko);
                    o0 = __builtin_amdgcn_mfma_f32_32x32x16_bf16(v0, pb.v, o0, 0, 0, 0);
                    o1 = __builtin_amdgcn_mfma_f32_32x32x16_bf16(v1, pb.v, o1, 0, 0, 0);
                }
        }
    }
    lsum += __shfl_xor(lsum, 32);
    const float il = 1.0f / lsum;
    const size_t t = trow0 + q0 + r;
#pragma unroll
    for (int db = 0; db < 2; ++db)
#pragma unroll
        for (int g = 0; g < 4; ++g) { const int d0 = 32 * db + 8 * g + 4 * hh;
            const u32x2 gz = *(const u32x2*)(p->H + t * IN_WP + C_ZMLA + h * 64 + d0);
            float v[4];
#pragma unroll
            for (int e = 0; e < 4; ++e) v[e] = (db == 0 ? o0[4 * g + e] : o1[4 * g + e]) * il;
            v[0] *= __uint_as_float(gz.x << 16); v[1] *= __uint_as_float(gz.x & 0xffff0000u); v[2] *= __uint_as_float(gz.y << 16); v[3] *= __uint_as_float(gz.y & 0xffff0000u);
            u32x2 w; w.x = pg8::cvt_pk_bf16(v[0], v[1]); w.y = pg8::cvt_pk_bf16(v[2], v[3]);
            *(u32x2*)(p->yb + t * 512 + h * 64 + d0) = w; }
}
__device__ __forceinline__ void ph_attn_p(KP p, LAS unsigned char* lds) {
    int tid = threadIdx.x; asm volatile("" : "+v"(tid));
    const int lane = tid & 63, wave = __builtin_amdgcn_readfirstlane(tid >> 6);
    for (int pi = blockIdx.x; pi < 256; pi += gridDim.x) {
        const int xcd = pi & 7, k = pi >> 3, bh = xcd * 8 + (k >> 2), pr = k & 3;
        attn_unit(p, bh >> 3, bh & 7, 7 - pr, lds, tid, wave, lane);
        attn_unit(p, bh >> 3, bh & 7, pr, lds, tid, wave, lane);
    }
    __syncthreads();
}
struct MEpiVt { static constexpr bool PERM = true, AFTER_DRAIN = false; bf16_t* O; int ldc; int pad_;
    __device__ __forceinline__ void operator()(const f32x4 (&acc)[2][2][4][2], const pg8::Unit& u, int wr, int wc, int fr0, int fq0) const {
        int fr = fr0, fq = fq0; asm volatile("" : "+v"(fr), "+v"(fq));
        const int row0 = u.pm * 256 + wr * 64 + fr;
#pragma unroll
        for (int bj = 0; bj < 2; ++bj) { const int col0 = u.pn * 256 + bj * 128 + wc * 32 + 8 * fq;
#pragma unroll
            for (int ai = 0; ai < 2; ++ai)
#pragma unroll
                for (int m = 0; m < 4; ++m) { const int row = row0 + ai * 128 + m * 16; const f32x4 v0 = acc[ai][bj][m][0], v1 = acc[ai][bj][m][1];
                    u32x4 w; w.x = pg8::cvt_pk_bf16(v0[0], v0[1]); w.y = pg8::cvt_pk_bf16(v0[2], v0[3]); w.z = pg8::cvt_pk_bf16(v1[0], v1[1]); w.w = pg8::cvt_pk_bf16(v1[2], v1[3]);
                    *(u32x4*)(O + (size_t)row * ldc + col0) = w; } }
    } };


__global__ void __launch_bounds__(NTHR, 2) k_mega(Params p_unused) {
    const KP kp0 = (KP)__builtin_amdgcn_kernarg_segment_ptr();
#define PP() ({ KP q_ = kp0; asm volatile("" : "+s"(q_)); q_; })
    KP p = PP();
    extern __shared__ __attribute__((aligned(16))) unsigned char lds_raw[];
    LAS unsigned char* lds = (LAS unsigned char*)lds_raw;
    volatile LAS unsigned* misc = (volatile LAS unsigned*)(lds + LDS_MISC);
    for (int u = threadIdx.x; u < 64; u += NTHR) misc[u] = 0u;
    __syncthreads();
    const int lo = p->ph_lo, hi = p->ph_hi;
    XcdBarrier bar; bar.bar = p->bar + p->li * XCD_BAR_WORDS; bar.x = 0; bar.st = nullptr;
    if (hi - lo > 1) bar = xcd_barrier_post(p->bar + p->li * XCD_BAR_WORDS, misc + 8);
#define IN(k) (lo <= (k) && (k) < hi)
#define SEAM(k) do { if (IN(k) && IN((k) + 1)) xcd_barrier(bar); } while (0)

    if (IN(PH_PRO)) {
        LAS float* tile = (LAS float*)lds;
        for (int l = 0; l < 2; ++l) {
            KP p = PP();
            ph_tr(p->w_in + (size_t)l * 1024 * IN_W, p->WinT + (size_t)l * IN_WP * 1024, 1024, IN_W, IN_WP, tile, 0);
            ph_tr(p->w_uq + (size_t)l * 384 * 768, p->WuqT + (size_t)l * 768 * 384, 384, 768, 768, tile, 0);
            ph_tr(p->w_uk + (size_t)l * 256 * 512, p->WkvT + (size_t)l * 1024 * 256, 256, 512, 512, tile, 144);
            ph_tr(p->w_uv + (size_t)l * 256 * 512, p->WkvT + (size_t)l * 1024 * 256 + (size_t)512 * 256, 256, 512, 512, tile, 208);
            ph_tr(p->w_br0 + (size_t)l * 512 * 1024, p->WbrT + ((size_t)l * 3 + 0) * 1024 * 512, 512, 1024, 1024, tile, 0);
            ph_tr(p->w_br1 + (size_t)l * 512 * 1024, p->WbrT + ((size_t)l * 3 + 1) * 1024 * 512, 512, 1024, 1024, tile, 0);
            ph_tr(p->w_br2 + (size_t)l * 512 * 1024, p->WbrT + ((size_t)l * 3 + 2) * 1024 * 512, 512, 1024, 1024, tile, 0);
            ph_tr(p->w_out + (size_t)l * 1024 * 1024, p->WoutT + (size_t)l * 1024 * 1024, 1024, 1024, 1024, tile, 0);
            for (int g = 0; g < 4; ++g) ph_tr(p->pool_mix + ((size_t)l * 4 + g) * 128 * 128, p->PmixT + ((size_t)l * 4 + g) * 128 * 128, 128, 128, 128, tile, 64 + 8 * g);
        }
        { KP p = PP(); ph_rope_tab(p->tab); ph_rmsnorm(p->x_prompt, p->x_sample, p->norm_g, p->xn, nullptr, nullptr); }
    }
    SEAM(PH_PRO);
    for (int l = 0; l < 2; ++l) {
        int G = gridDim.x, bid = blockIdx.x; asm volatile("" : "+s"(G), "+s"(bid));
        if (IN(PHID(l, PH_GIN))) { KP p = PP();
            pg8::Gemm g{p->xn, p->WinT + (size_t)l * IN_WP * 1024, TT, IN_WP, 1024}; pg8::StaticOrder S; S.init(TT, IN_WP, G, bid);
            MEpiH E{p->H, p->BA}; pg8::gemm_phase<MEpiH, pg8::StaticOrder, false>(lds, g, S, E, nullptr);
        }
        SEAM(PHID(l, PH_GIN));
        if (IN(PHID(l, PH_TOK))) { ph_tok_prompt(PP(), l, lds); ph_tok(PP(), l, lds); }
        SEAM(PHID(l, PH_TOK));
        if (IN(PHID(l, PH_GQ))) { KP p = PP();
            pg8::Gemm g{p->cq, p->WuqT + (size_t)l * 768 * 384, TT, 768, 384}; pg8::StaticOrder S; S.init(TT, 768, G, bid);
            MEpiQ E{p->Q, p->tab}; pg8::gemm_phase<MEpiQ, pg8::StaticOrder, false>(lds, g, S, E, nullptr);
        }
        if (IN(PHID(l, PH_GQ))) { KP p = PP();
            pg8::Gemm g{p->ckv, p->WkvT + (size_t)l * 1024 * 256, TP, 512, 256}; pg8::StaticOrder S; S.init(TP, 512, G, bid);
            MEpiKV E{p->Kn, p->V}; pg8::gemm_phase<MEpiKV, pg8::StaticOrder, false>(lds, g, S, E, nullptr);
        }
        if (IN(PHID(l, PH_GQ))) { KP p = PP();
            pg8::Gemm g{p->WkvT + (size_t)l * 1024 * 256 + (size_t)512 * 256, p->ckv, 512, TP, 256}; pg8::StaticOrder S; S.init(512, TP, G, bid);
            MEpiVt E{p->Vt, TP, 0}; pg8::gemm_phase<MEpiVt, pg8::StaticOrder, false>(lds, g, S, E, nullptr);
        }
        if (IN(PHID(l, PH_GQ))) ph_delta_pre(PP(), lds);
        SEAM(PHID(l, PH_GQ));
        if (IN(PHID(l, PH_ATT))) { const int am = PP()->pad;
            if (am & 1) ph_attn_s2(PP(), l, lds); if (am & 2) ph_attn_s(PP(), l, lds); if (am & 4) ph_attn_p(PP(), lds); if (am & 8) ph_att_waves(PP(), l); }
        SEAM(PHID(l, PH_ATT));
        if (IN(PHID(l, PH_FIN))) { ph_fin(PP(), l, lds); ph_delta_fin(PP(), l); }
        SEAM(PHID(l, PH_FIN));
        if (IN(PHID(l, PH_MERGE))) {
            { KP p = PP(); pg8::Gemm g{p->ya, p->WbrT + ((size_t)l * 3 + 0) * 1024 * 512, TT, 1024, 512}; pg8::StaticOrder S; S.init(TT, 1024, G, bid);
              MEpiMerge<0> E{p->H, p->mf, p->mb}; pg8::gemm_phase<MEpiMerge<0>, pg8::StaticOrder, false>(lds, g, S, E, nullptr); }
            { KP p = PP(); pg8::Gemm g{p->yb, p->WbrT + ((size_t)l * 3 + 1) * 1024 * 512, TT, 1024, 512}; pg8::StaticOrder S; S.init(TT, 1024, G, bid);
              MEpiMerge<1> E{p->H, p->mf, p->mb}; pg8::gemm_phase<MEpiMerge<1>, pg8::StaticOrder, false>(lds, g, S, E, nullptr); }
            { KP p = PP(); pg8::Gemm g{p->yc, p->WbrT + ((size_t)l * 3 + 2) * 1024 * 512, TT, 1024, 512}; pg8::StaticOrder S; S.init(TT, 1024, G, bid);
              MEpiMerge<2> E{p->H, p->mf, p->mb}; pg8::gemm_phase<MEpiMerge<2>, pg8::StaticOrder, false>(lds, g, S, E, nullptr); }
        }
        SEAM(PHID(l, PH_MERGE));
        if (IN(PHID(l, PH_OUT))) { KP p = PP();
            const float* xp = l == 0 ? p->x_prompt : p->xres; const float* xs = l == 0 ? p->x_sample : p->xres + (size_t)TP * 1024;
            pg8::Gemm g{p->mb, p->WoutT + (size_t)l * 1024 * 1024, TT, 1024, 1024}; pg8::StaticOrder S; S.init(TT, 1024, G, bid);
            MEpiRes E{xp, xs, p->xres}; pg8::gemm_phase<MEpiRes, pg8::StaticOrder, false>(lds, g, S, E, nullptr);
        }
        SEAM(PHID(l, PH_OUT));
        if (IN(PHID(l, PH_NORM))) { KP p = PP();
            if (l == 0) ph_rmsnorm(p->xres, p->xres + (size_t)TP * 1024, p->norm_g + 1024, p->xn, nullptr, nullptr);
            else ph_rmsnorm(p->xres, p->xres + (size_t)TP * 1024, p->final_norm_g, nullptr, p->out + O_YP, p->out + O_YS);
        }
        SEAM(PHID(l, PH_NORM));
    }
#undef IN
#undef SEAM
}

static inline size_t al256(size_t x) { return (x + 255) & ~(size_t)255; }
extern "C" void kernel_launch(void* const* d_in, const int* in_sizes, int n_in, void* d_out, int out_size, void* d_ws, size_t ws_size, hipStream_t stream) {
    static int grid = 0;
    if (grid == 0) {
        int dev = 0, cus = 0; (void)hipGetDevice(&dev); (void)hipDeviceGetAttribute(&cus, hipDeviceAttributeMultiprocessorCount, dev);
        (void)hipFuncSetAttribute((const void*)k_mega, hipFuncAttributeMaxDynamicSharedMemorySize, LDS_BYTES);
        int per_cu = 0; (void)hipOccupancyMaxActiveBlocksPerMultiprocessor(&per_cu, (const void*)k_mega, NTHR, LDS_BYTES); (void)hipGetLastError();
        grid = cus > 0 ? cus : 256;
    }
    Params p{};
    p.x_prompt = (const float*)d_in[0]; p.x_sample = (const float*)d_in[1]; p.cache_kv = (const float*)d_in[2]; p.cache_kr = (const float*)d_in[3];
    p.state_pool = (const float*)d_in[4]; p.state_conv = (const float*)d_in[5]; p.state_delta = (const float*)d_in[6]; p.page_table = (const int*)d_in[7];
    p.norm_g = (const float*)d_in[8]; p.w_in = (const float*)d_in[9]; p.pool_mix = (const float*)d_in[10]; p.pool_scale = (const float*)d_in[11];
    p.q_norm_g = (const float*)d_in[12]; p.w_uq = (const float*)d_in[13]; p.kv_norm_g = (const float*)d_in[14]; p.w_uk = (const float*)d_in[15];
    p.w_uv = (const float*)d_in[16]; p.conv_w = (const float*)d_in[17]; p.a_log = (const float*)d_in[18]; p.dt_bias = (const float*)d_in[19];
    p.dn_norm_g = (const float*)d_in[20]; p.w_br0 = (const float*)d_in[21]; p.w_br1 = (const float*)d_in[22]; p.w_br2 = (const float*)d_in[23];
    p.w_out = (const float*)d_in[24]; p.final_norm_g = (const float*)d_in[25];
    p.out = (float*)d_out;
    char* w = (char*)d_ws; size_t off = 0;
    auto take = [&](size_t bytes) { char* q = w + off; off += al256(bytes); return q; };
    const size_t BAR_BYTES = (size_t)16 * XCD_BAR_WORDS * 4;
    p.bar = (unsigned*)take(BAR_BYTES);
    p.WinT = (bf16_t*)take((size_t)2 * IN_WP * 1024 * 2);
    p.WuqT = (bf16_t*)take((size_t)2 * 768 * 384 * 2);
    p.WkvT = (bf16_t*)take((size_t)2 * 1024 * 256 * 2);
    p.WbrT = (bf16_t*)take((size_t)2 * 3 * 1024 * 512 * 2);
    p.WoutT = (bf16_t*)take((size_t)2 * 1024 * 1024 * 2);
    p.PmixT = (bf16_t*)take((size_t)2 * 4 * 128 * 128 * 2);
    p.tab = (float2*)take((size_t)(SEQ + DEC_SEQ) * 16 * 8);
    p.xres = (float*)take((size_t)TT * 1024 * 4);
    p.xn = (bf16_t*)take((size_t)TT * 1024 * 2);
    p.H = (bf16_t*)take((size_t)TT * IN_WP * 2);
    p.BA = (float*)take((size_t)TT * 16 * 4);
    p.cq = (bf16_t*)take((size_t)TT * 384 * 2);
    p.ckv = (bf16_t*)take((size_t)TT * 256 * 2);
    p.Kr = (bf16_t*)take((size_t)TT * 32 * 2);
    p.Q = (bf16_t*)take((size_t)TT * 768 * 2);
    bf16_t* Qlat = (bf16_t*)take((size_t)TS * 8 * 288 * 2);
    p.Kn = (bf16_t*)take((size_t)TP * 512 * 2);
    p.V = (bf16_t*)take((size_t)TP * 512 * 2);
    p.Vt = (bf16_t*)take((size_t)512 * TP * 2);
    p.qd = (bf16_t*)take((size_t)TT * 512 * 2);
    p.kd = (bf16_t*)take((size_t)TT * 512 * 2);
    p.vd = (bf16_t*)take((size_t)TT * 512 * 2);
    p.bg = (float*)take((size_t)TT * 16 * 4);
    p.ya = (bf16_t*)take((size_t)TT * 512 * 2);
    p.yb = (bf16_t*)take((size_t)TT * 512 * 2);
    p.yc = (bf16_t*)take((size_t)TT * 512 * 2);
    p.mf = (float*)take((size_t)TT * 1024 * 4);
    p.mb = (bf16_t*)take((size_t)TT * 1024 * 2);
    p.part = (float*)take((size_t)DEC_BATCH * SA_CH * 64 * 258 * 4);
    p.DOP = (bf16_t*)take((size_t)2048 * 4 * 4096 * 2);
    p.DU = (float*)take((size_t)2048 * 4096 * 4);
    p.DG = (float*)take((size_t)2048 * 4);

    (void)hipMemsetAsync(p.bar, 0, BAR_BYTES, stream);
    p.ph_lo = 0; p.ph_hi = PH_END; p.li = 0; p.pad = 15;
    hipLaunchKernelGGL(k_mega, dim3(grid), dim3(NTHR), LDS_BYTES, stream, p);
#if defined(PROBE_REP) && PROBE_REP > 0
    for (int i = 0; i < PROBE_REP; ++i) { Params q = p; q.ph_lo = PROBE_LO; q.ph_hi = PROBE_HI; q.li = 1 + i; q.pad = PROBE_MASK; hipLaunchKernelGGL(k_mega, dim3(grid), dim3(NTHR), LDS_BYTES, stream, q); }
#endif
}
```

```cpp
#include <hip/hip_runtime.h>
#include <stdint.h>

typedef unsigned short bf16_t;

#define D_MODEL 1024
#define TP 16384
#define TS 256
#define TT (TP + TS)
#define SEQ 2048
#define DEC_SEQ 8
#define DEC_BATCH 32
#define PAST_LEN 16384
#define PAGE 128
#define N_PAGES 128
#define N_POOL 5120
#define IN_W 7344
#define IN_WP 7424
#define C_POOL 0
#define C_ZPOOL 512
#define C_Q 1024
#define C_KV 1408
#define C_KR 1664
#define C_ZMLA 1696
#define C_QKV 2208
#define C_ZDN 3744
#define C_BETA 4256
#define C_ALPHA 4264
#define C_GATE 4272
#define EPS 1e-6f
#define MLA_SCALE 0.10206207261596577f
#define ATT_C 0.14724444831554004f

#define O_YP 0
#define O_YS (O_YP + 16777216)
#define O_PKV (O_YS + 262144)
#define O_PKR (O_PKV + 8388608)
#define O_PPOOL (O_PKR + 1048576)
#define O_PCONV (O_PPOOL + 122880)
#define O_PDELTA (O_PCONV + 73728)
#define O_SKV (O_PDELTA + 524288)
#define O_SKR (O_SKV + 131072)
#define O_SPOOL (O_SKR + 16384)
#define O_SCONV (O_SPOOL + 491520)
#define O_SDELTA (O_SCONV + 294912)
#define O_END (O_SDELTA + 2097152)

__device__ __forceinline__ float bf2f(bf16_t b) { return __uint_as_float(((unsigned)b) << 16); }
__device__ __forceinline__ bf16_t f2bf(float f) { unsigned u = __float_as_uint(f); u += 0x7FFFu + ((u >> 16) & 1u); return (bf16_t)(u >> 16); }
__device__ __forceinline__ float sigmoidf_(float v) { return 1.0f / (1.0f + __expf(-v)); }
__device__ __forceinline__ float siluf_(float v) { return v / (1.0f + __expf(-v)); }
__device__ __forceinline__ float wave_sum(float v) {
#pragma unroll
    for (int o = 32; o >= 1; o >>= 1) v += __shfl_xor(v, o);
    return v;
}

#define SA_CH 8
namespace pg8 {
#define PG8_LAS __attribute__((address_space(3)))
typedef unsigned short bf16_t;
typedef short bf16x8 __attribute__((ext_vector_type(8)));
typedef float f32x4 __attribute__((ext_vector_type(4)));
typedef unsigned u32x4 __attribute__((ext_vector_type(4)));
constexpr int BM = 256, BK = 64, HALF = 128, HTB = HALF * BK * 2  , STAGE_BYTES = 8 * HTB, NXCD = 8, WGM = 8;

__host__ __device__ __forceinline__ int lds_byte(int r, int c) { const int st = (r >> 4) * 2 + (c >> 5), rr = r & 15, cc = c & 31, ob = rr * 64 + cc * 2; return st * 1024 + (ob ^ (((ob >> 9) & 1) << 5)); }
__host__ __device__ __forceinline__ void stage_rc(int b, int& R, int& C) { const int st = b / 1024, sb = b % 1024, swz = sb ^ (((sb >> 9) & 1) << 5); R = (st >> 1) * 16 + swz / 64; C = (st & 1) * 32 + (swz % 64) / 2; }
__host__ __device__ __forceinline__ int perm32(int rho) { const int n = rho >> 4, i = rho & 15; return 8 * (i >> 2) + 4 * n + (i & 3); }

struct Unit { int pm, pn; };
struct Gemm { const bf16_t* A; const bf16_t* Bt; int M, N, K; };

struct StaticOrder {
    int nM, nN, nwg, G, c;
    __host__ __device__ void init(int M, int N, int G_, int c_) { nM = M / BM; nN = N / BM; nwg = nM * nN; G = G_; c = c_; }
    __host__ __device__ bool next(int i, Unit& u) const {
        const long L = (long)i * G + c; if (L >= nwg) return false;
        int wgid = (int)L; { const int q = nwg / NXCD, r = nwg % NXCD, xcd = wgid % NXCD, off = wgid / NXCD; wgid = (xcd < r ? xcd * (q + 1) : r * (q + 1) + (xcd - r) * q) + off; }
        const int nig = WGM * nN, gid = wgid / nig, fm = gid * WGM, gsz = (nM - fm) < WGM ? (nM - fm) : WGM;
        u.pm = fm + ((wgid % nig) % gsz); u.pn = (wgid % nig) / gsz; return true;
    }
    __device__ __forceinline__ void a_ready(const Unit&) const {}
    __device__ __forceinline__ void done(const Unit&) const {}
};
typedef __bf16 bf16n2 __attribute__((ext_vector_type(2)));
__device__ __forceinline__ unsigned cvt_pk_bf16(float lo, float hi) { typedef float f2_ __attribute__((ext_vector_type(2))); const f2_ v = {lo, hi}; return __builtin_bit_cast(unsigned, __builtin_convertvector(v, bf16n2)); }
typedef float f32x2 __attribute__((ext_vector_type(2)));
template <class Epi, class Sched, bool STAMP = false>
__device__ __forceinline__ void gemm_phase(PG8_LAS unsigned char* lds, const Gemm g, const Sched& S, const Epi& E, unsigned long long* stamps) {
    int tid_ = threadIdx.x; asm volatile("" : "+v"(tid_));
    const int tid = tid_, wid = __builtin_amdgcn_readfirstlane(tid >> 6), lane = tid & 63, wr = wid >> 2, wc = wid & 3, fr = lane & 15, fq = lane >> 4;
    int K_ = g.K; asm volatile("" : "+s"(K_));
    const int K = K_, nt = K / BK;
    int ts_lo = 0, ts_hi = 0, nts = 0; const unsigned long long rt_entry = STAMP ? (unsigned long long)wall_clock64() : 0ull;
#define PG8_STAMP() do { if (STAMP && wid == 0 && nts < 64) { const unsigned long long _c = (unsigned long long)clock64(); \
        ts_lo = (lane == nts) ? (int)(unsigned)_c : ts_lo; ts_hi = (lane == nts) ? (int)(unsigned)(_c >> 32) : ts_hi; ++nts; } } while (0)
    PG8_STAMP();
    unsigned voffA[2], voffB[2];
#pragma unroll
    for (int i = 0; i < 2; ++i) { int R, C; stage_rc(tid * 16 + i * 8192, R, C); const int Rb = Epi::PERM ? ((R & ~31) + perm32(R & 31)) : R;
        voffA[i] = (unsigned)(R * K + C) * 2u; voffB[i] = (unsigned)(Rb * K + C) * 2u; }
    const size_t kstep = (size_t)(BK * 2);
    const size_t hstep = (size_t)HALF * K * 2;
    const size_t tstep = 2 * hstep;
    const unsigned ldsw = (unsigned)wid * 1024u;
    const int aoff = lds_byte(wr * 64 + fr, fq * 8), boff = lds_byte(wc * 32 + fr, fq * 8);
#define PG8_SA(b, h) (((b) * 2 + (h)) * HTB)
#define PG8_SB(b, h) ((4 + (b) * 2 + (h)) * HTB)
#define PG8_STAGE(bufoff, gbase, voff) do { _Pragma("unroll") for (int _i = 0; _i < 2; ++_i) \
        __builtin_amdgcn_global_load_lds((const unsigned*)((const char*)(gbase) + (voff)[_i]), (PG8_LAS unsigned*)(lds + (bufoff) + ldsw + _i * 8192), 16, 0, 0); } while (0)
#define PG8_LDA(dst, b, h) do { _Pragma("unroll") for (int m = 0; m < 4; ++m) _Pragma("unroll") for (int k = 0; k < 2; ++k) dst[m][k] = *(const PG8_LAS bf16x8*)(lds + PG8_SA(b, h) + aoff + m * 2048 + k * 1024); } while (0)
#define PG8_LDB(dst, b, h) do { _Pragma("unroll") for (int n = 0; n < 2; ++n) _Pragma("unroll") for (int k = 0; k < 2; ++k) dst[n][k] = *(const PG8_LAS bf16x8*)(lds + PG8_SB(b, h) + boff + n * 2048 + k * 1024); } while (0)
#define PG8_MMA(ai, bj, At, Bt) do { __builtin_amdgcn_s_setprio(1); _Pragma("unroll") for (int m = 0; m < 4; ++m) _Pragma("unroll") for (int n = 0; n < 2; ++n) _Pragma("unroll") for (int k = 0; k < 2; ++k) \
        acc[ai][bj][m][n] = __builtin_amdgcn_mfma_f32_16x16x32_bf16(Bt[n][k], At[m][k], acc[ai][bj][m][n], 0, 0, 0); __builtin_amdgcn_s_setprio(0); } while (0)
#define PG8_WAIT_V(n) asm volatile("s_waitcnt vmcnt(" #n ")" ::: "memory")
#define PG8_WAIT_L(n) asm volatile("s_waitcnt lgkmcnt(" #n ")" ::: "memory")
#define PG8_BAR __builtin_amdgcn_s_barrier()
#define PG8_SCHED __builtin_amdgcn_sched_barrier(0)
    Unit cur, nxt; int ui = 0;
    if (!S.next(0, cur)) return;
    f32x4 acc[2][2][4][2];
#pragma unroll
    for (int a = 0; a < 2; ++a)
#pragma unroll
        for (int b = 0; b < 2; ++b)
#pragma unroll
            for (int m = 0; m < 4; ++m)
#pragma unroll
                for (int n = 0; n < 2; ++n) acc[a][b][m][n] = (f32x4){0.f, 0.f, 0.f, 0.f};
    bf16x8 At[4][2], B0[2][2], B1[2][2];
    const char* cA = (const char*)g.A + (size_t)cur.pm * tstep; const char* cB = (const char*)g.Bt + (size_t)cur.pn * tstep;
    S.a_ready(cur);
    PG8_STAGE(PG8_SB(0, 0), cB, voffB); PG8_STAGE(PG8_SA(0, 0), cA, voffA); PG8_STAGE(PG8_SB(0, 1), cB + hstep, voffB); PG8_STAGE(PG8_SA(0, 1), cA + hstep, voffA);
    if (wr == 1) PG8_BAR;
    PG8_WAIT_V(4); PG8_BAR;
    PG8_STAGE(PG8_SB(1, 0), cB + kstep, voffB); PG8_STAGE(PG8_SA(1, 0), cA + kstep, voffA); PG8_STAGE(PG8_SB(1, 1), cB + hstep + kstep, voffB);
    PG8_WAIT_V(6); PG8_BAR;
    PG8_STAMP();
    for (;;) {
        const bool has_next = S.next(ui + 1, nxt);
        const char* nA = has_next ? (const char*)g.A + (size_t)nxt.pm * tstep : cA; const char* nB = has_next ? (const char*)g.Bt + (size_t)nxt.pn * tstep : cB;
_Pragma("nounroll")
        for (int t = 0; t < nt; t += 2) {
            const bool last = (t == nt - 2);
            const char* a1 = cA + (size_t)(t + 1) * kstep;
            const char* a2 = last ? nA : cA + (size_t)(t + 2) * kstep; const char* b2 = last ? nB : cB + (size_t)(t + 2) * kstep;
            const char* a3 = a2 + kstep; const char* b3 = b2 + kstep;
            if (last && has_next) S.a_ready(nxt);
            if constexpr (Epi::SEG > 0) { if (t != 0 && (t % Epi::SEG) == 0) E.mid(acc, cur, wr, wc, fr, fq, t / Epi::SEG); }
            PG8_LDB(B0, 0, 0); PG8_SCHED; PG8_LDA(At, 0, 0); PG8_STAGE(PG8_SA(1, 1), a1 + hstep, voffA);
            PG8_WAIT_L(8); PG8_BAR; PG8_WAIT_L(0); PG8_MMA(0, 0, At, B0); PG8_BAR; PG8_SCHED;
            PG8_LDB(B1, 0, 1); PG8_STAGE(PG8_SB(0, 0), b2, voffB);
            PG8_BAR; PG8_WAIT_L(0); PG8_MMA(0, 1, At, B1); PG8_BAR;
            PG8_LDA(At, 0, 1); PG8_STAGE(PG8_SA(0, 0), a2, voffA);
            PG8_BAR; PG8_WAIT_L(0); PG8_MMA(1, 0, At, B0); PG8_BAR; PG8_SCHED;
            PG8_STAGE(PG8_SB(0, 1), b2 + hstep, voffB);
            PG8_WAIT_V(6); PG8_BAR; PG8_MMA(1, 1, At, B1); PG8_BAR;
            PG8_LDB(B0, 1, 0); PG8_SCHED; PG8_LDA(At, 1, 0); PG8_STAGE(PG8_SA(0, 1), a2 + hstep, voffA);
            PG8_WAIT_L(8); PG8_BAR; PG8_WAIT_L(0); PG8_MMA(0, 0, At, B0); PG8_BAR; PG8_SCHED;
            PG8_LDB(B1, 1, 1); PG8_STAGE(PG8_SB(1, 0), b3, voffB);
            PG8_BAR; PG8_WAIT_L(0); PG8_MMA(0, 1, At, B1); PG8_BAR;
            PG8_LDA(At, 1, 1); PG8_STAGE(PG8_SA(1, 0), a3, voffA);
            PG8_BAR; PG8_WAIT_L(0); PG8_MMA(1, 0, At, B0); PG8_BAR; PG8_SCHED;
            PG8_STAGE(PG8_SB(1, 1), b3 + hstep, voffB);
            PG8_WAIT_V(6); PG8_BAR; PG8_MMA(1, 1, At, B1); PG8_BAR;
        }
        PG8_STAMP();
        if constexpr (!Epi::AFTER_DRAIN) { E(acc, cur, wr, wc, fr, fq); S.done(cur); }
        PG8_STAMP();
        if (!has_next) break;
#pragma unroll
        for (int a = 0; a < 2; ++a)
#pragma unroll
            for (int b = 0; b < 2; ++b)
#pragma unroll
                for (int m = 0; m < 4; ++m)
#pragma unroll
                    for (int n = 0; n < 2; ++n) acc[a][b][m][n] = (f32x4){0.f, 0.f, 0.f, 0.f};
        cur = nxt; cA = nA; cB = nB; ++ui;
    }
    PG8_WAIT_V(0);
    if (wr == 0) PG8_BAR;
    PG8_BAR;
    if constexpr (Epi::AFTER_DRAIN) { E.fused(acc, cur, wr, wc, fr, fq, lds, wid, lane); S.done(cur); }
    PG8_STAMP();
    if (STAMP && wid == 0) { stamps[lane] = lane < nts ? (((unsigned long long)(unsigned)ts_hi << 32) | (unsigned)ts_lo) : 0ull;
        if (lane == 62) stamps[62] = rt_entry; if (lane == 63) stamps[63] = (unsigned long long)wall_clock64(); }
#undef PG8_STAMP
#undef PG8_SA
#undef PG8_SB
#undef PG8_STAGE
#undef PG8_LDA
#undef PG8_LDB
#undef PG8_MMA
#undef PG8_WAIT_V
#undef PG8_WAIT_L
#undef PG8_BAR
#undef PG8_SCHED
}

}
#define XB_TMO      128
#define XB_XCNT(j)  (256  + 64 * (j))
#define XB_XSUB(j)  (1280 + 64 * (j))
#define XB_XGEN(j)  (2304 + 64 * (j))
#define XB_TOP      3328
#define XB_TOPGEN   3392
#define XCD_BAR_WORDS 3456
#define XB_SPIN_CAP (1u << 18)
#define LAS __attribute__((address_space(3)))

__device__ __forceinline__ unsigned xb_ld(unsigned* p)              { return __hip_atomic_load(p, __ATOMIC_RELAXED, __HIP_MEMORY_SCOPE_AGENT); }
__device__ __forceinline__ unsigned xb_add(unsigned* p, unsigned v) { return __hip_atomic_fetch_add(p, v, __ATOMIC_RELAXED, __HIP_MEMORY_SCOPE_AGENT); }
__device__ __forceinline__ unsigned xb_xcc_id() { return (unsigned)__builtin_amdgcn_s_getreg((3 << 11) | 20) & 0xFu; }
#define XB_SPIN(cond, bar) do { unsigned _sp = 0; while (cond) { __builtin_amdgcn_s_sleep(1); \
    if ((++_sp & 255u) == 0u) { if (xb_ld(&(bar)[XB_TMO])) break; if (_sp > XB_SPIN_CAP) { atomicAdd(&(bar)[XB_TMO], 1u); break; } } } } while (0)

struct XcdBarrier {
    unsigned* bar; unsigned x;
    volatile LAS unsigned* st;
};

__device__ __forceinline__ XcdBarrier xcd_barrier_post(unsigned* bar, volatile LAS unsigned* st) {
    XcdBarrier b; b.bar = bar; b.x = xb_xcc_id(); b.st = st;
    if (threadIdx.x == 0) (void)xb_add(&bar[XB_XCNT(b.x)], 1u);
    return b;
}
__device__ __forceinline__ void xcd_barrier_complete(unsigned* bar, unsigned x, unsigned& nloc, unsigned& nx) {
    const unsigned G = gridDim.x * gridDim.y * gridDim.z;
    unsigned sum, cnt, mine, sp = 0u;
    for (;;) {
        sum = 0u; cnt = 0u; mine = 0u;
#pragma unroll
        for (unsigned j = 0; j < 16; ++j) { const unsigned c = xb_ld(&bar[XB_XCNT(j)]); sum += c; cnt += (c > 0u) ? 1u : 0u; mine = (j == x) ? c : mine; }
        if (sum == G) break;
        __builtin_amdgcn_s_sleep(1);
        if ((++sp & 255u) == 0u) { if (xb_ld(&bar[XB_TMO])) break; if (sp > XB_SPIN_CAP) { atomicAdd(&bar[XB_TMO], 1u); break; } }
    }
    nloc = mine > 0u ? mine : 1u; nx = cnt > 0u ? cnt : 1u;
}

__device__ __forceinline__ void xcd_barrier(const XcdBarrier& b) {
    asm volatile("s_waitcnt vmcnt(0)" ::: "memory");
    __syncthreads();
    if (threadIdx.x == 0) {
        unsigned* bar = b.bar;
        __builtin_amdgcn_s_waitcnt(0);
        unsigned nloc = b.st[0], nx = b.st[1];
        if (nloc == 0u) { xcd_barrier_complete(bar, b.x, nloc, nx); b.st[0] = nloc; b.st[1] = nx; }
        const unsigned old = xb_add(&bar[XB_XSUB(b.x)], 1u);
        const unsigned gen = old / nloc;
        if (old + 1u == (gen + 1u) * nloc) {
            __builtin_amdgcn_fence(__ATOMIC_RELEASE, "agent");
            asm volatile("s_waitcnt vmcnt(0)" ::: "memory");
            const unsigned og = xb_add(&bar[XB_TOP], 1u);
            const unsigned tg = og / nx;
            if (og + 1u == (tg + 1u) * nx) xb_add(&bar[XB_TOPGEN], 1u);
            else XB_SPIN(xb_ld(&bar[XB_TOPGEN]) == tg, bar);
            __builtin_amdgcn_fence(__ATOMIC_ACQUIRE, "agent");
            xb_add(&bar[XB_XGEN(b.x)], 1u);
            asm volatile("s_waitcnt vmcnt(0)" ::: "memory");
        } else {
            XB_SPIN(xb_ld(&bar[XB_XGEN(b.x)]) == gen, bar);
            __builtin_amdgcn_fence(__ATOMIC_ACQUIRE, "agent");
            asm volatile("s_waitcnt vmcnt(0)" ::: "memory");
        }
    }
    __syncthreads();
}


#define LAS __attribute__((address_space(3)))
typedef float f32x4 __attribute__((ext_vector_type(4)));
typedef unsigned u32x4 __attribute__((ext_vector_type(4)));
typedef unsigned u32x2 __attribute__((ext_vector_type(2)));
typedef float f32x2 __attribute__((ext_vector_type(2)));
typedef short bf16x8_t __attribute__((ext_vector_type(8)));
typedef float f32x16 __attribute__((ext_vector_type(16)));
constexpr int NTHR = 512;
constexpr int LDS_BYTES = 147456;
constexpr int LDS_MISC = LDS_BYTES - 256;

struct Params {
    const float *x_prompt, *x_sample, *cache_kv, *cache_kr, *state_pool, *state_conv, *state_delta; const int* page_table;
    const float *norm_g, *w_in, *pool_mix, *pool_scale, *q_norm_g, *w_uq, *kv_norm_g, *w_uk, *w_uv, *conv_w, *a_log, *dt_bias, *dn_norm_g, *w_br0, *w_br1, *w_br2, *w_out, *final_norm_g;
    float* out;
    bf16_t *WinT, *WuqT, *WkvT, *WbrT, *WoutT, *PmixT; float2* tab;
    float* xres; bf16_t* xn; bf16_t* H; float* BA; bf16_t *cq, *ckv, *Kr, *Q, *Kn, *V, *Vt, *qd, *kd, *vd; float* bg; bf16_t *ya, *yb, *yc; float* mf; bf16_t* mb; float* part; bf16_t* DOP; float* DU; float* DG;
    unsigned* bar;
    int ph_lo, ph_hi, li, pad;
};

typedef const __attribute__((address_space(4))) Params* KP;

constexpr int PH_PRO = 0;
constexpr int PH_L = 8;
constexpr int PH_GIN = 0, PH_TOK = 1, PH_GQ = 2, PH_ATT = 3, PH_FIN = 4, PH_MERGE = 5, PH_OUT = 6, PH_NORM = 7;
#define PHID(l, k) (1 + (l) * PH_L + (k))
constexpr int PH_END = 1 + 2 * PH_L;

__device__ __forceinline__ void unpack8(const u32x4 v, float (&f)[8]) {
    f[0] = __uint_as_float(v.x << 16); f[1] = __uint_as_float(v.x & 0xffff0000u); f[2] = __uint_as_float(v.y << 16); f[3] = __uint_as_float(v.y & 0xffff0000u);
    f[4] = __uint_as_float(v.z << 16); f[5] = __uint_as_float(v.z & 0xffff0000u); f[6] = __uint_as_float(v.w << 16); f[7] = __uint_as_float(v.w & 0xffff0000u); }
__device__ __forceinline__ u32x4 pack8(const float (&f)[8]) { u32x4 w; w.x = pg8::cvt_pk_bf16(f[0], f[1]); w.y = pg8::cvt_pk_bf16(f[2], f[3]); w.z = pg8::cvt_pk_bf16(f[4], f[5]); w.w = pg8::cvt_pk_bf16(f[6], f[7]); return w; }
struct MEpiH { static constexpr bool PERM = true, AFTER_DRAIN = false; static constexpr int SEG = 0; bf16_t* H; float* BA;
    __device__ __forceinline__ void operator()(const f32x4 (&acc)[2][2][4][2], const pg8::Unit& u, int wr, int wc, int fr0, int fq0) const {
        int fr = fr0, fq = fq0; asm volatile("" : "+v"(fr), "+v"(fq));
        const int row0 = u.pm * 256 + wr * 64 + fr;
#pragma unroll
        for (int bj = 0; bj < 2; ++bj) {
            const int wcol = u.pn * 256 + bj * 128 + wc * 32, col0 = wcol + 8 * fq;
            const bool plain = (wcol + 32 <= C_ZPOOL) || (wcol >= C_Q && wcol + 32 <= C_ZMLA) || (wcol >= C_QKV && wcol + 32 <= C_ZDN);
            const int act = ((col0 >= C_ZPOOL && col0 < C_Q) || (col0 >= C_ZMLA && col0 < C_QKV) || (col0 >= C_ZDN && col0 < C_BETA)) ? 1 : (col0 >= C_GATE ? 2 : 0);
            const bool isba = (col0 == C_BETA) || (col0 == C_ALPHA);
#pragma unroll
            for (int ai = 0; ai < 2; ++ai)
#pragma unroll
                for (int m = 0; m < 4; ++m) { const int row = row0 + ai * 128 + m * 16; f32x4 v0 = acc[ai][bj][m][0], v1 = acc[ai][bj][m][1];
                    if (!plain) {
                        if (isba) { float* b = BA + (size_t)row * 16 + (col0 - C_BETA); *(f32x4*)b = v0; *(f32x4*)(b + 4) = v1; }
#pragma unroll
                        for (int e = 0; e < 4; ++e) { const float s0 = sigmoidf_(v0[e]), s1 = sigmoidf_(v1[e]);
                            v0[e] = act == 0 ? v0[e] : (act == 1 ? v0[e] * s0 : s0); v1[e] = act == 0 ? v1[e] : (act == 1 ? v1[e] * s1 : s1); }
                    }
                    u32x4 w; w.x = pg8::cvt_pk_bf16(v0[0], v0[1]); w.y = pg8::cvt_pk_bf16(v0[2], v0[3]); w.z = pg8::cvt_pk_bf16(v1[0], v1[1]); w.w = pg8::cvt_pk_bf16(v1[2], v1[3]);
                    *(u32x4*)(H + (size_t)row * IN_WP + col0) = w; }
        }
    } };
struct MEpiQ { static constexpr bool PERM = true, AFTER_DRAIN = false; static constexpr int SEG = 0; bf16_t* Q; const float2* tab;
    __device__ __forceinline__ void operator()(const f32x4 (&acc)[2][2][4][2], const pg8::Unit& u, int wr, int wc, int fr0, int fq0) const {
        int fr = fr0, fq = fq0; asm volatile("" : "+v"(fr), "+v"(fq));
        const int row0 = u.pm * 256 + wr * 64 + fr;
#pragma unroll
        for (int bj = 0; bj < 2; ++bj) {
            const int wcol = u.pn * 256 + bj * 128 + wc * 32, col0 = wcol + 8 * fq;
            const bool rope = (wcol % 96) == 64;
#pragma unroll
            for (int ai = 0; ai < 2; ++ai)
#pragma unroll
                for (int m = 0; m < 4; ++m) { const int row = row0 + ai * 128 + m * 16; f32x4 v0 = acc[ai][bj][m][0], v1 = acc[ai][bj][m][1];
                    if (rope) { const int p = row < TP ? (row & (SEQ - 1)) : SEQ + ((row - TP) & 7); const float2* tp = tab + p * 16 + (fq & 1) * 8; const bool hi = fq >= 2;
#pragma unroll
                        for (int e = 0; e < 4; ++e) { const float o0 = __shfl_xor(v0[e], 32), o1 = __shfl_xor(v1[e], 32); const float2 c0 = tp[e], c1 = tp[4 + e];
                            v0[e] = hi ? (v0[e] * c0.x + o0 * c0.y) : (v0[e] * c0.x - o0 * c0.y); v1[e] = hi ? (v1[e] * c1.x + o1 * c1.y) : (v1[e] * c1.x - o1 * c1.y); } }
                    u32x4 w; w.x = pg8::cvt_pk_bf16(v0[0], v0[1]); w.y = pg8::cvt_pk_bf16(v0[2], v0[3]); w.z = pg8::cvt_pk_bf16(v1[0], v1[1]); w.w = pg8::cvt_pk_bf16(v1[2], v1[3]);
                    *(u32x4*)(Q + (size_t)row * 768 + col0) = w; asm volatile("" ::: "memory"); }
        }
    } };
struct MEpiKV { static constexpr bool PERM = true, AFTER_DRAIN = false; static constexpr int SEG = 0; bf16_t* Kn; bf16_t* V;
    __device__ __forceinline__ void operator()(const f32x4 (&acc)[2][2][4][2], const pg8::Unit& u, int wr, int wc, int fr0, int fq0) const {
        int fr = fr0, fq = fq0; asm volatile("" : "+v"(fr), "+v"(fq));
        const int row0 = u.pm * 256 + wr * 64 + fr; bf16_t* base = u.pn < 2 ? Kn : V; const int cb = (u.pn & 1) * 256;
#pragma unroll
        for (int bj = 0; bj < 2; ++bj) { const int col0 = cb + bj * 128 + wc * 32 + 8 * fq;
#pragma unroll
            for (int ai = 0; ai < 2; ++ai)
#pragma unroll
                for (int m = 0; m < 4; ++m) { const int row = row0 + ai * 128 + m * 16; const f32x4 v0 = acc[ai][bj][m][0], v1 = acc[ai][bj][m][1];
                    u32x4 w; w.x = pg8::cvt_pk_bf16(v0[0], v0[1]); w.y = pg8::cvt_pk_bf16(v0[2], v0[3]); w.z = pg8::cvt_pk_bf16(v1[0], v1[1]); w.w = pg8::cvt_pk_bf16(v1[2], v1[3]);
                    *(u32x4*)(base + (size_t)row * 512 + col0) = w; } }
    } };
template <int BR> struct MEpiMerge { static constexpr bool PERM = true, AFTER_DRAIN = false; static constexpr int SEG = 0; const bf16_t* H; float* mf; bf16_t* mb;
    __device__ __forceinline__ void operator()(const f32x4 (&acc)[2][2][4][2], const pg8::Unit& u, int wr, int wc, int fr0, int fq0) const {
        int fr = fr0, fq = fq0; asm volatile("" : "+v"(fr), "+v"(fq));
        const int row0 = u.pm * 256 + wr * 64 + fr;
#pragma unroll
        for (int bj = 0; bj < 2; ++bj) { const int col0 = u.pn * 256 + bj * 128 + wc * 32 + 8 * fq;
#pragma unroll
            for (int ai = 0; ai < 2; ++ai)
#pragma unroll
                for (int m = 0; m < 4; ++m) { const int row = row0 + ai * 128 + m * 16; f32x4 v0 = acc[ai][bj][m][0], v1 = acc[ai][bj][m][1];
                    const u32x4 g = *(const u32x4*)(H + (size_t)row * IN_WP + C_GATE + BR * 1024 + col0);
                    v0[0] *= __uint_as_float(g.x << 16); v0[1] *= __uint_as_float(g.x & 0xffff0000u); v0[2] *= __uint_as_float(g.y << 16); v0[3] *= __uint_as_float(g.y & 0xffff0000u);
                    v1[0] *= __uint_as_float(g.z << 16); v1[1] *= __uint_as_float(g.z & 0xffff0000u); v1[2] *= __uint_as_float(g.w << 16); v1[3] *= __uint_as_float(g.w & 0xffff0000u);
                    float* mp = mf + (size_t)row * 1024 + col0;
                    if (BR > 0) { v0 += *(const f32x4*)mp; v1 += *(const f32x4*)(mp + 4); }
                    if (BR < 2) { *(f32x4*)mp = v0; *(f32x4*)(mp + 4) = v1; }
                    else { u32x4 w; w.x = pg8::cvt_pk_bf16(v0[0], v0[1]); w.y = pg8::cvt_pk_bf16(v0[2], v0[3]); w.z = pg8::cvt_pk_bf16(v1[0], v1[1]); w.w = pg8::cvt_pk_bf16(v1[2], v1[3]);
                        *(u32x4*)(mb + (size_t)row * 1024 + col0) = w; } asm volatile("" ::: "memory"); } }
    } };
struct MEpiRes { static constexpr bool PERM = false, AFTER_DRAIN = false; static constexpr int SEG = 0; const float* xp; const float* xs; float* xo;
    __device__ __forceinline__ void operator()(const f32x4 (&acc)[2][2][4][2], const pg8::Unit& u, int wr, int wc, int fr0, int fq0) const {
        int fr = fr0, fq = fq0; asm volatile("" : "+v"(fr), "+v"(fq));
        const int row0 = u.pm * 256 + wr * 64 + fr, col0 = u.pn * 256 + wc * 32 + 4 * fq;
#pragma unroll
        for (int ai = 0; ai < 2; ++ai)
#pragma unroll
            for (int m = 0; m < 4; ++m) { const int row = row0 + ai * 128 + m * 16; const float* xr = row < TP ? xp + (size_t)row * 1024 : xs + (size_t)(row - TP) * 1024; float* orow = xo + (size_t)row * 1024;
#pragma unroll
                for (int bj = 0; bj < 2; ++bj)
#pragma unroll
                    for (int n = 0; n < 2; ++n) { const int c = col0 + bj * 128 + n * 16; *(f32x4*)(orow + c) = *(const f32x4*)(xr + c) + acc[ai][bj][m][n]; } }
    } };

template <int NSEG, class Epi>
__device__ __forceinline__ void tail_gemm(const bf16_t* __restrict__ A, int lda, const bf16_t* __restrict__ Bt, int K, int N, const Epi& epi, LAS unsigned char* lds) {
    int tid = threadIdx.x; asm volatile("" : "+v"(tid));
    const int lane = tid & 63, wave = __builtin_amdgcn_readfirstlane(tid >> 6), rt = wave & 3, kh = wave >> 2, n = lane & 15, q = lane >> 4;
    const int ntile = 4 * (N / 16), kseg = K / NSEG, khalf = kseg / 2;
    LAS f32x4* red = (LAS f32x4*)lds;
    for (int tile = blockIdx.x; tile < ntile; tile += gridDim.x) {
        const int r0 = 64 * (tile & 3) + 16 * rt, c0 = 16 * (tile >> 2);
        const bf16_t* ap = A + (size_t)(r0 + n) * lda + 8 * q; const bf16_t* bp = Bt + (size_t)(c0 + n) * K + 8 * q;
        f32x4 acc[NSEG];
#pragma unroll
        for (int sg = 0; sg < NSEG; ++sg) { acc[sg] = (f32x4){0.f, 0.f, 0.f, 0.f};
            const int kb = sg * kseg + kh * khalf;
#pragma unroll 4
            for (int k = 0; k < khalf; k += 32) acc[sg] = __builtin_amdgcn_mfma_f32_16x16x32_bf16(*(const bf16x8_t*)(ap + kb + k), *(const bf16x8_t*)(bp + kb + k), acc[sg], 0, 0, 0); }
        __syncthreads();
        if (kh == 1) {
#pragma unroll
            for (int sg = 0; sg < NSEG; ++sg) red[(rt * NSEG + sg) * 64 + lane] = acc[sg]; }
        __syncthreads();
        if (kh == 0) {
#pragma unroll
            for (int sg = 0; sg < NSEG; ++sg) acc[sg] += red[(rt * NSEG + sg) * 64 + lane];
#pragma unroll
            for (int e = 0; e < 4; ++e) { float v[NSEG];
#pragma unroll
                for (int sg = 0; sg < NSEG; ++sg) v[sg] = acc[sg][e];
                epi(r0 + 4 * q + e, c0 + n, v); } }
    }
    __syncthreads();
}
struct TEpiMerge { const bf16_t* H; bf16_t* mb;
    __device__ __forceinline__ void operator()(int row, int col, const float (&v)[3]) const { const size_t t = (size_t)TP + row; const bf16_t* g = H + t * IN_WP + C_GATE + col;
        mb[t * 1024 + col] = f2bf(bf2f(g[0]) * v[0] + bf2f(g[1024]) * v[1] + bf2f(g[2048]) * v[2]); } };
struct TEpiRes { const float* xs; float* xo;
    __device__ __forceinline__ void operator()(int row, int col, const float (&v)[1]) const { xo[((size_t)TP + row) * 1024 + col] = xs[(size_t)row * 1024 + col] + v[0]; } };
struct MEpiMergeS { static constexpr bool PERM = true, AFTER_DRAIN = false; static constexpr int SEG = 8; const bf16_t* H; bf16_t* mb;
    __device__ __forceinline__ void mid(f32x4 (&acc)[2][2][4][2], const pg8::Unit& u, int wr, int wc, int fr0, int fq0, int seg) const {
        int fr = fr0, fq = fq0; asm volatile("" : "+v"(fr), "+v"(fq));
        const int row0 = u.pm * 256 + wr * 64 + fr;
#pragma unroll
        for (int bj = 0; bj < 2; ++bj) { const int col0 = u.pn * 256 + bj * 128 + wc * 32 + 8 * fq;
#pragma unroll
            for (int ai = 0; ai < 2; ++ai)
#pragma unroll
                for (int m = 0; m < 4; ++m) { const int row = row0 + ai * 128 + m * 16; const bf16_t* gp = H + (size_t)row * IN_WP + C_GATE + (seg - 1) * 1024 + col0;
                    float ga[8], gb[8]; unpack8(*(const u32x4*)gp, ga); unpack8(*(const u32x4*)(gp + 1024), gb);
#pragma unroll
                    for (int e = 0; e < 4; ++e) { acc[ai][bj][m][0][e] *= ga[e] * __builtin_amdgcn_rcpf(fmaxf(gb[e], 1e-30f)); acc[ai][bj][m][1][e] *= ga[4 + e] * __builtin_amdgcn_rcpf(fmaxf(gb[4 + e], 1e-30f)); }
                    asm volatile("" ::: "memory"); } }
    }
    __device__ __forceinline__ void operator()(const f32x4 (&acc)[2][2][4][2], const pg8::Unit& u, int wr, int wc, int fr0, int fq0) const {
        int fr = fr0, fq = fq0; asm volatile("" : "+v"(fr), "+v"(fq));
        const int row0 = u.pm * 256 + wr * 64 + fr;
#pragma unroll
        for (int bj = 0; bj < 2; ++bj) { const int col0 = u.pn * 256 + bj * 128 + wc * 32 + 8 * fq;
#pragma unroll
            for (int ai = 0; ai < 2; ++ai)
#pragma unroll
                for (int m = 0; m < 4; ++m) { const int row = row0 + ai * 128 + m * 16; float g[8]; unpack8(*(const u32x4*)(H + (size_t)row * IN_WP + C_GATE + 2048 + col0), g);
                    const f32x4 v0 = acc[ai][bj][m][0], v1 = acc[ai][bj][m][1];
                    u32x4 w; w.x = pg8::cvt_pk_bf16(v0[0] * g[0], v0[1] * g[1]); w.y = pg8::cvt_pk_bf16(v0[2] * g[2], v0[3] * g[3]); w.z = pg8::cvt_pk_bf16(v1[0] * g[4], v1[1] * g[5]); w.w = pg8::cvt_pk_bf16(v1[2] * g[6], v1[3] * g[7]);
                    *(u32x4*)(mb + (size_t)row * 1024 + col0) = w; asm volatile("" ::: "memory"); } }
    } };

__device__ __forceinline__ void ph_tr(const float* __restrict__ src, bf16_t* __restrict__ dst, int K, int N, int Npad, LAS float* tile, int rot, int ldd = 0) {
    if (ldd == 0) ldd = K;
    int tid = threadIdx.x; asm volatile("" : "+v"(tid)); const int G = gridDim.x; const int tn = Npad / 64, tk = K / 32, nt = tn * tk;
    const int first = (blockIdx.x + G - (rot % G)) % G;
    for (int t = first; t < nt; t += G) {
        const int n0 = (t % tn) * 64, k0 = (t / tn) * 32;
        { const int tx = tid & 63, ty = tid >> 6;
#pragma unroll
          for (int i = 0; i < 4; ++i) { const int k = ty + 8 * i, n = n0 + tx; tile[k * 65 + tx] = n < N ? src[(size_t)(k0 + k) * N + n] : 0.f; } }
        __syncthreads();
        { const int kx = tid & 31, ny = tid >> 5;
#pragma unroll
          for (int i = 0; i < 4; ++i) { const int n = ny + 16 * i; dst[(size_t)(n0 + n) * ldd + k0 + kx] = f2bf(tile[kx * 65 + n]); } }
        __syncthreads();
    }
}
__device__ __forceinline__ void ph_rope_tab(float2* tab) {
    for (int idx = blockIdx.x * NTHR + threadIdx.x; idx < (SEQ + DEC_SEQ) * 16; idx += gridDim.x * NTHR) {
        const int p = idx >> 4, i = idx & 15; const int pos = p < SEQ ? p : PAST_LEN + (p - SEQ);
        const float inv = powf(10000.0f, -(float)i / 16.0f); const float ang = (float)pos * inv;
        const double rev = (double)ang * 0.15915494309189533576888; const float f = (float)(rev - floor(rev));
        tab[idx] = make_float2(__builtin_amdgcn_cosf(f), __builtin_amdgcn_sinf(f)); }
}
__device__ __forceinline__ void ph_rmsnorm(const float* __restrict__ xp, const float* __restrict__ xs, const float* __restrict__ g, bf16_t* __restrict__ xn, float* __restrict__ yp, float* __restrict__ ys) {
    int tid_o = threadIdx.x; asm volatile("" : "+v"(tid_o)); int lane = tid_o & 63, wave = tid_o >> 6;
    for (int t = blockIdx.x * 8 + wave; t < TT; t += gridDim.x * 8) {
        const float* x = t < TP ? xp + (size_t)t * 1024 : xs + (size_t)(t - TP) * 1024;
        f32x4 v[4]; float ss = 0.f;
#pragma unroll
        for (int i = 0; i < 4; ++i) { v[i] = *(const f32x4*)(x + i * 256 + lane * 4); ss += v[i][0] * v[i][0] + v[i][1] * v[i][1] + v[i][2] * v[i][2] + v[i][3] * v[i][3]; }
        ss = wave_sum(ss); const float r = rsqrtf(ss * (1.0f / 1024.0f) + EPS);
#pragma unroll
        for (int i = 0; i < 4; ++i) { const int c = i * 256 + lane * 4; const f32x4 gg = *(const f32x4*)(g + c); const f32x4 o = v[i] * r * gg;
            if (xn) { u32x2 w; w.x = pg8::cvt_pk_bf16(o[0], o[1]); w.y = pg8::cvt_pk_bf16(o[2], o[3]); *(u32x2*)(xn + (size_t)t * 1024 + c) = w; }
            else { float* y = t < TP ? yp + (size_t)t * 1024 : ys + (size_t)(t - TP) * 1024; *(f32x4*)(y + c) = o; } }
    }
}

constexpr int TK_RS = 1040;
__device__ __forceinline__ void ph_tok_prompt(KP p, int l, LAS unsigned char* lds) {
    int tid = threadIdx.x; asm volatile("" : "+v"(tid));
    const int lane = tid & 63, wave = __builtin_amdgcn_readfirstlane(tid >> 6), r = lane & 31, hh = lane >> 5;
    const bf16_t* __restrict__ H = p->H; float* __restrict__ out = p->out;
    for (int tile = blockIdx.x; tile < TP / 64; tile += gridDim.x) {
        const int t0 = tile * 64, i0 = t0 & (SEQ - 1), b = t0 >> 11;
        __syncthreads();
        for (int c = tid; c < 79 * 64; c += NTHR) { const int row = c >> 6, ch16 = c & 63; u32x4 v = (u32x4){0u, 0u, 0u, 0u};
            if (i0 - 15 + row >= 0) v = *(const u32x4*)(H + (size_t)(t0 - 15 + row) * IN_WP + C_POOL + ch16 * 8);
            *(LAS u32x4*)(lds + row * TK_RS + ch16 * 16) = v; }
        __syncthreads();
        { const int g = wave >> 1, th = wave & 1, w = 2 << g, tk = 32 * th + r, pos = i0 + tk; const float inv = 1.0f / (float)min(pos + 1, w);
          const bf16_t* mixT = p->PmixT + ((size_t)l * 4 + g) * 128 * 128;
          f32x16 acc[4];
#pragma unroll
          for (int nt = 0; nt < 4; ++nt)
#pragma unroll
              for (int e = 0; e < 16; ++e) acc[nt][e] = 0.f;
#pragma unroll 2
          for (int ks = 0; ks < 8; ++ks) {
              const LAS unsigned char* base = lds + (15 + tk) * TK_RS + (128 * g + 16 * ks + 8 * hh) * 2;
              float cur[8], sum[8]; unpack8(*(const LAS u32x4*)base, cur);
#pragma unroll
              for (int e = 0; e < 8; ++e) sum[e] = cur[e];
              for (int k = 1; k < w; ++k) { float x[8]; unpack8(*(const LAS u32x4*)(base - k * TK_RS), x);
#pragma unroll
                  for (int e = 0; e < 8; ++e) sum[e] += x[e]; }
#pragma unroll
              for (int e = 0; e < 8; ++e) sum[e] = sum[e] * inv - cur[e];
              union { u32x4 u; bf16x8_t v; } bfr; bfr.u = pack8(sum);
#pragma unroll
              for (int nt = 0; nt < 4; ++nt) { const bf16x8_t a = *(const bf16x8_t*)(mixT + (size_t)(32 * nt + r) * 128 + 16 * ks + 8 * hh);
                  acc[nt] = __builtin_amdgcn_mfma_f32_32x32x16_bf16(a, bfr.v, acc[nt], 0, 0, 0); } }
          const size_t t = (size_t)t0 + tk; const float* scl = p->pool_scale + l * 512 + 128 * g;
#pragma unroll
          for (int nt = 0; nt < 4; ++nt)
#pragma unroll
              for (int gg = 0; gg < 4; ++gg) { const int dd0 = 32 * nt + 8 * gg + 4 * hh; const u32x2 z = *(const u32x2*)(H + t * IN_WP + C_ZPOOL + 128 * g + dd0); const f32x4 sc = *(const f32x4*)(scl + dd0);
                  float v0 = acc[nt][4 * gg + 0] * sc[0] * __uint_as_float(z.x << 16), v1 = acc[nt][4 * gg + 1] * sc[1] * __uint_as_float(z.x & 0xffff0000u);
                  float v2 = acc[nt][4 * gg + 2] * sc[2] * __uint_as_float(z.y << 16), v3 = acc[nt][4 * gg + 3] * sc[3] * __uint_as_float(z.y & 0xffff0000u);
                  u32x2 o; o.x = pg8::cvt_pk_bf16(v0, v1); o.y = pg8::cvt_pk_bf16(v2, v3); *(u32x2*)(p->ya + t * 1536 + 128 * g + dd0) = o; } }
        if (i0 == SEQ - 64) { for (int c = tid; c < 15 * 512; c += NTHR) { const int rr = c >> 9, ch = c & 511;
              out[O_PPOOL + (((size_t)l * 8 + b) * 15 + rr) * 512 + ch] = bf2f(*(const LAS bf16_t*)(lds + (15 + 49 + rr) * TK_RS + ch * 2)); } }
        const float* qg = p->q_norm_g + l * 384; const float* kvg = p->kv_norm_g + l * 256; const float* conv_w = p->conv_w + (size_t)l * 4 * 1536;
        for (int tt = 0; tt < 8; ++tt) {
            const int t = t0 + wave * 8 + tt, i_seq = t & (SEQ - 1); const bf16_t* h = H + (size_t)t * IN_WP;
            { float q[8]; float ss = 0.f; const bool on = lane < 48;
              if (on) unpack8(*(const u32x4*)(h + C_Q + lane * 8), q); else {
#pragma unroll
                  for (int e = 0; e < 8; ++e) q[e] = 0.f; }
#pragma unroll
              for (int e = 0; e < 8; ++e) ss += q[e] * q[e];
              ss = wave_sum(ss); const float rq = rsqrtf(ss * (1.0f / 384.0f) + EPS);
              if (on) { const f32x4 g0 = *(const f32x4*)(qg + lane * 8), g1 = *(const f32x4*)(qg + lane * 8 + 4);
#pragma unroll
                  for (int e = 0; e < 4; ++e) { q[e] *= rq * g0[e]; q[4 + e] *= rq * g1[e]; }
                  *(u32x4*)(p->cq + (size_t)t * 384 + lane * 8) = pack8(q); }
              float kv[8]; ss = 0.f; const bool on2 = lane < 32;
              if (on2) unpack8(*(const u32x4*)(h + C_KV + lane * 8), kv); else {
#pragma unroll
                  for (int e = 0; e < 8; ++e) kv[e] = 0.f; }
#pragma unroll
              for (int e = 0; e < 8; ++e) ss += kv[e] * kv[e];
              ss = wave_sum(ss); const float rk = rsqrtf(ss * (1.0f / 256.0f) + EPS);
              if (on2) { const f32x4 g0 = *(const f32x4*)(kvg + lane * 8), g1 = *(const f32x4*)(kvg + lane * 8 + 4);
#pragma unroll
                  for (int e = 0; e < 4; ++e) { kv[e] *= rk * g0[e]; kv[4 + e] *= rk * g1[e]; }
                  float* okv = out + O_PKV + ((size_t)l * TP + t) * 256 + lane * 8;
                  *(f32x4*)okv = (f32x4){kv[0], kv[1], kv[2], kv[3]}; *(f32x4*)(okv + 4) = (f32x4){kv[4], kv[5], kv[6], kv[7]};
                  *(u32x4*)(p->ckv + (size_t)t * 256 + lane * 8) = pack8(kv); }
              if (lane < 16) { const float x1 = bf2f(h[C_KR + lane]), x2 = bf2f(h[C_KR + 16 + lane]); const float2 cs = p->tab[i_seq * 16 + lane];
                  const float o1 = x1 * cs.x - x2 * cs.y, o2 = x2 * cs.x + x1 * cs.y; float* okr = out + O_PKR + ((size_t)l * TP + t) * 32;
                  okr[lane] = o1; okr[16 + lane] = o2; p->Kr[(size_t)t * 32 + lane] = f2bf(o1); p->Kr[(size_t)t * 32 + 16 + lane] = f2bf(o2); } }
#pragma unroll
            for (int pi = 0; pi < 3; ++pi) { const int c0 = (pi * 64 + lane) * 8; float y[8];
#pragma unroll
                for (int e = 0; e < 8; ++e) y[e] = 0.f;
                u32x4 rawc = (u32x4){0u, 0u, 0u, 0u};
#pragma unroll
                for (int j = 0; j < 4; ++j) { const int u = i_seq - 3 + j; u32x4 raw = (u32x4){0u, 0u, 0u, 0u};
                    if (u >= 0) raw = *(const u32x4*)(h + (ptrdiff_t)(j - 3) * IN_WP + C_QKV + c0);
                    if (j == 3) rawc = raw;
                    float x[8]; unpack8(raw, x); const f32x4 w0 = *(const f32x4*)(conv_w + j * 1536 + c0), w1 = *(const f32x4*)(conv_w + j * 1536 + c0 + 4);
#pragma unroll
                    for (int e = 0; e < 4; ++e) { y[e] += x[e] * w0[e]; y[4 + e] += x[4 + e] * w1[e]; } }
                float ss = 0.f;
#pragma unroll
                for (int e = 0; e < 8; ++e) { y[e] = siluf_(y[e]); ss += y[e] * y[e]; }
                if (pi < 2) { ss += __shfl_xor(ss, 1); ss += __shfl_xor(ss, 2); ss += __shfl_xor(ss, 4); const float rn = rsqrtf(ss + EPS) * (pi == 0 ? 0.125f : 1.0f);
#pragma unroll
                    for (int e = 0; e < 8; ++e) y[e] *= rn; }
                bf16_t* dst = pi == 0 ? p->qd : (pi == 1 ? p->kd : p->vd);
                *(u32x4*)(dst + (size_t)t * 512 + lane * 8) = pack8(y);
                if (i_seq >= SEQ - 3) { float x[8]; unpack8(rawc, x); float* oc = out + O_PCONV + (((size_t)l * 8 + (t >> 11)) * 3 + (i_seq - (SEQ - 3))) * 1536 + c0;
                    *(f32x4*)oc = (f32x4){x[0], x[1], x[2], x[3]}; *(f32x4*)(oc + 4) = (f32x4){x[4], x[5], x[6], x[7]}; } }
            if (lane < 8) { const float bb = sigmoidf_(p->BA[(size_t)t * 16 + lane]); const float x = p->BA[(size_t)t * 16 + 8 + lane] + p->dt_bias[l * 8 + lane];
                const float sp = x > 20.f ? x : log1pf(expf(x)); const float gg = -expf(p->a_log[l * 8 + lane]) * sp;
                p->bg[(size_t)t * 16 + lane] = bb; p->bg[(size_t)t * 16 + 8 + lane] = gg; }
        }
    }
    __syncthreads();
}

__device__ __forceinline__ void ph_tok(KP p, int l, LAS unsigned char* lds) {
    int tid_o = threadIdx.x; asm volatile("" : "+v"(tid_o)); int lane = tid_o & 63, wave = tid_o >> 6;
    const bf16_t* __restrict__ H = p->H; float* __restrict__ out = p->out;
    const float* qg = p->q_norm_g + l * 384; const float* kvg = p->kv_norm_g + l * 256; const float* conv_w = p->conv_w + (size_t)l * 4 * 1536;
    LAS float* dl = (LAS float*)(lds + wave * 2048);
    for (int t = TP + blockIdx.x * 8 + wave; t < TT; t += gridDim.x * 8) {
        const bf16_t* h = H + (size_t)t * IN_WP;
        int i_seq, row0, pidx; const bool smp = t >= TP; const int ts = t - TP;
        if (!smp) { i_seq = t & (SEQ - 1); row0 = t - i_seq; pidx = i_seq; } else { i_seq = ts & 7; row0 = t - i_seq; pidx = SEQ + i_seq; }
        { float q[6]; float ss = 0.f;
#pragma unroll
          for (int i = 0; i < 6; ++i) { q[i] = bf2f(h[C_Q + lane + 64 * i]); ss += q[i] * q[i]; }
          ss = wave_sum(ss); float r = rsqrtf(ss * (1.0f / 384.0f) + EPS);
#pragma unroll
          for (int i = 0; i < 6; ++i) p->cq[(size_t)t * 384 + lane + 64 * i] = f2bf(q[i] * r * qg[lane + 64 * i]);
          float kv[4]; ss = 0.f;
#pragma unroll
          for (int i = 0; i < 4; ++i) { kv[i] = bf2f(h[C_KV + lane + 64 * i]); ss += kv[i] * kv[i]; }
          ss = wave_sum(ss); r = rsqrtf(ss * (1.0f / 256.0f) + EPS);
          float* okv; float* okr;
          if (!smp) { okv = out + O_PKV + ((size_t)l * TP + t) * 256; okr = out + O_PKR + ((size_t)l * TP + t) * 32; }
          else { okv = out + O_SKV + ((size_t)l * TS + ts) * 256; okr = out + O_SKR + ((size_t)l * TS + ts) * 32; }
#pragma unroll
          for (int i = 0; i < 4; ++i) { const float o = kv[i] * r * kvg[lane + 64 * i]; okv[lane + 64 * i] = o; p->ckv[(size_t)t * 256 + lane + 64 * i] = f2bf(o); }
          if (lane < 16) { const float x1 = bf2f(h[C_KR + lane]), x2 = bf2f(h[C_KR + 16 + lane]); const float2 cs = p->tab[pidx * 16 + lane];
              const float o1 = x1 * cs.x - x2 * cs.y, o2 = x2 * cs.x + x1 * cs.y;
              okr[lane] = o1; okr[16 + lane] = o2; p->Kr[(size_t)t * 32 + lane] = f2bf(o1); p->Kr[(size_t)t * 32 + 16 + lane] = f2bf(o2); } }
        { const float* sc = smp ? p->state_conv + ((size_t)l * DEC_BATCH + (ts >> 3)) * 3 * 1536 : nullptr;
#pragma unroll 4
          for (int i = 0; i < 24; ++i) { const int c = lane + 64 * i; float y = 0.f;
#pragma unroll
              for (int j = 0; j < 4; ++j) { const int u = i_seq - 3 + j; float xv;
                  if (u >= 0) xv = bf2f(H[(size_t)(row0 + u) * IN_WP + C_QKV + c]); else xv = sc ? sc[(size_t)(u + 3) * 1536 + c] : 0.f;
                  y += xv * conv_w[j * 1536 + c]; }
              float v = siluf_(y);
              if (i < 16) { const float ss = wave_sum(v * v); v *= rsqrtf(ss + EPS); if (i < 8) v *= 0.125f; }
              const bf16_t o = f2bf(v);
              if (i < 8) p->qd[(size_t)t * 512 + c] = o; else if (i < 16) p->kd[(size_t)t * 512 + (c - 512)] = o; else p->vd[(size_t)t * 512 + (c - 1024)] = o;
              if (!smp) { if (i_seq >= SEQ - 3) out[O_PCONV + (((size_t)l * 8 + (t >> 11)) * 3 + (i_seq - (SEQ - 3))) * 1536 + c] = bf2f(h[C_QKV + c]); }
              else { if (i_seq >= DEC_SEQ - 3) out[O_SCONV + (((size_t)l * DEC_BATCH + (ts >> 3)) * 3 + (i_seq - (DEC_SEQ - 3))) * 1536 + c] = bf2f(h[C_QKV + c]); } }
          if (lane < 8) { const float b = sigmoidf_(p->BA[(size_t)t * 16 + lane]); const float x = p->BA[(size_t)t * 16 + 8 + lane] + p->dt_bias[l * 8 + lane];
              const float sp = x > 20.f ? x : log1pf(expf(x)); const float g = -expf(p->a_log[l * 8 + lane]) * sp;
              p->bg[(size_t)t * 16 + lane] = b; p->bg[(size_t)t * 16 + 8 + lane] = g; } }
        { const float* sp = smp ? p->state_pool + ((size_t)l * DEC_BATCH + (ts >> 3)) * 15 * 512 : nullptr;
          float* so = smp ? out + O_SPOOL + ((size_t)l * DEC_BATCH + (ts >> 3)) * 15 * 512 : nullptr;
#pragma unroll
          for (int j = 0; j < 8; ++j) { const int ch = lane + 64 * j, g = j >> 1, w = 2 << g; float sum = 0.f;
              for (int k = 0; k < w; ++k) { const int u = i_seq - k; float xv;
                  if (u >= 0) xv = bf2f(H[(size_t)(row0 + u) * IN_WP + C_POOL + ch]); else xv = sp ? sp[(size_t)(15 + u) * 512 + ch] : 0.f;
                  sum += xv; }
              const float cur = bf2f(h[C_POOL + ch]); const float cnt = !smp ? (float)min(i_seq + 1, w) : (float)w;
              dl[ch] = sum / cnt - cur;
              if (!smp) { if (i_seq >= SEQ - 15) out[O_PPOOL + (((size_t)l * 8 + (t >> 11)) * 15 + (i_seq - (SEQ - 15))) * 512 + ch] = cur; }
              else { so[(size_t)(7 + i_seq) * 512 + ch] = cur; if (i_seq < 7) so[(size_t)i_seq * 512 + ch] = sp[(size_t)(8 + i_seq) * 512 + ch]; } }
          asm volatile("s_waitcnt lgkmcnt(0)" ::: "memory");
#pragma unroll
          for (int j = 0; j < 8; ++j) { const int ch = lane + 64 * j, g = j >> 1, c = ch & 127; const float* m = p->pool_mix + ((size_t)l * 4 + g) * 128 * 128; float y = 0.f;
              for (int k = 0; k < 128; ++k) y += dl[g * 128 + k] * m[k * 128 + c];
              y *= p->pool_scale[l * 512 + ch]; y *= bf2f(h[C_ZPOOL + ch]); p->ya[(size_t)t * 1536 + ch] = f2bf(y); }
          asm volatile("s_waitcnt lgkmcnt(0)" ::: "memory"); }
    }
}

__device__ __forceinline__ void wu_delta(KP p, int l, int sq, int h, int dv) {
    int row0, L; float* so; float S[64];
    if (sq < 8) { row0 = sq * SEQ; L = SEQ; so = p->out + O_PDELTA + (((size_t)l * 8 + sq) * 8 + h) * 4096;
#pragma unroll
        for (int k = 0; k < 64; ++k) S[k] = 0.f; }
    else { const int s = sq - 8; row0 = TP + s * 8; L = DEC_SEQ; so = p->out + O_SDELTA + (((size_t)l * DEC_BATCH + s) * 8 + h) * 4096;
        const float* s0 = p->state_delta + (((size_t)l * DEC_BATCH + s) * 8 + h) * 4096;
#pragma unroll
        for (int k = 0; k < 64; ++k) S[k] = s0[k * 64 + dv]; }
    const float gn = p->dn_norm_g[l * 64 + dv];
    for (int i = 0; i < L; ++i) {
        const size_t t = (size_t)row0 + i; const u32x4* kp = (const u32x4*)(p->kd + t * 512 + h * 64); const u32x4* qp = (const u32x4*)(p->qd + t * 512 + h * 64);
        const float b = p->bg[t * 16 + h], a = __expf(p->bg[t * 16 + 8 + h]); const float v = bf2f(p->vd[t * 512 + h * 64 + dv]);
        u32x4 kk[8];
#pragma unroll
        for (int c = 0; c < 8; ++c) kk[c] = kp[c];
        float ks = 0.f;
#pragma unroll
        for (int c = 0; c < 8; ++c)
#pragma unroll
            for (int e = 0; e < 4; ++e) { const unsigned w = kk[c][e]; ks += __uint_as_float(w << 16) * S[c * 8 + 2 * e] + __uint_as_float(w & 0xffff0000u) * S[c * 8 + 2 * e + 1]; }
        const float vn = b * (v - a * ks); float o = 0.f;
#pragma unroll
        for (int c = 0; c < 8; ++c) { const u32x4 qv = qp[c];
#pragma unroll
            for (int e = 0; e < 4; ++e) { const unsigned w = kk[c][e], wq = qv[e]; const int k0 = c * 8 + 2 * e;
                S[k0] = a * S[k0] + __uint_as_float(w << 16) * vn; o += __uint_as_float(wq << 16) * S[k0];
                S[k0 + 1] = a * S[k0 + 1] + __uint_as_float(w & 0xffff0000u) * vn; o += __uint_as_float(wq & 0xffff0000u) * S[k0 + 1]; }
            asm volatile("" ::: "memory"); }
        const float ss = wave_sum(o * o); const float y = o * rsqrtf(ss * (1.0f / 64.0f) + EPS) * gn;
        p->yc[t * 1536 + h * 64 + dv] = f2bf(y * bf2f(p->H[t * IN_WP + C_ZDN + h * 64 + dv]));
    }
#pragma unroll
    for (int k = 0; k < 64; ++k) so[k * 64 + dv] = S[k];
}
__device__ __forceinline__ int sig_inv(int rho) { return (rho & 32) | ((rho & 12) << 1) | ((rho & 16) >> 2) | (rho & 3); }
constexpr int DPRE_LDS = 64 * 64 * 4 + 512;
__device__ __forceinline__ void ph_delta_pre(KP p, LAS unsigned char* lds) {
    int tid_o = threadIdx.x; asm volatile("" : "+v"(tid_o)); int lane = tid_o & 63, wave = tid_o >> 6;
    wave = __builtin_amdgcn_readfirstlane(wave);
    LAS float* Am = (LAS float*)(lds + wave * DPRE_LDS); LAS float* gcs = Am + 4096; LAS float* bts = gcs + 64;
    for (int unit = wave * gridDim.x + blockIdx.x; unit < 2048; unit += gridDim.x * 8) {
        { int t_ = threadIdx.x; asm volatile("" : "+v"(t_)); lane = t_ & 63; }
        const int r = lane & 31, hh = lane >> 5;
        const int bh = unit >> 5, ch = unit & 31, b = bh >> 3, h = bh & 7;
        const size_t t0 = (size_t)b * SEQ + ch * 64;
        bf16_t* op = p->DOP + (size_t)unit * 4 * 4096; float* up = p->DU + (size_t)unit * 4096;
        const bf16_t* kdb = p->kd + t0 * 512 + h * 64; const bf16_t* qdb = p->qd + t0 * 512 + h * 64; const bf16_t* vdb = p->vd + t0 * 512 + h * 64;
        const float* bgb = p->bg + t0 * 16 + h;
        const float beta = bgb[lane * 16]; float gc = bgb[lane * 16 + 8];
#pragma unroll
        for (int d = 1; d < 64; d <<= 1) { const float x = __shfl_up(gc, d); if (lane >= d) gc += x; }
        const float gl = __shfl(gc, 63);
        gcs[lane] = gc; bts[lane] = beta;
        if (lane == 0) p->DG[unit] = __expf(gl);
        bf16x8_t kf[2][4], qf[2][4];
        { const int voff = r * 512 + 8 * hh;
#pragma unroll
          for (int rb = 0; rb < 2; ++rb)
#pragma unroll
            for (int ks = 0; ks < 4; ++ks) { kf[rb][ks] = *(const bf16x8_t*)(kdb + (32 * rb * 512 + 16 * ks) + voff); qf[rb][ks] = *(const bf16x8_t*)(qdb + (32 * rb * 512 + 16 * ks) + voff); } }
        {
#pragma unroll
            for (int rb = 0; rb < 2; ++rb) { const float sc = __expf(gl - __shfl(gc, 32 * rb + r)); const int voff = hh * 512 + sig_inv(32 * rb + r);
#pragma unroll
                for (int ks = 0; ks < 4; ++ks) {
#pragma unroll
                    for (int jj = 0; jj < 8; ++jj) (op + 3 * 4096 + (16 * ks + jj) * 64)[voff] = f2bf(bf2f((bf16_t)kf[rb][ks][jj]) * sc);
                    asm volatile("" ::: "memory"); } } }
        f32x16 kk00, kk10, kk11, qk00, qk10, qk11;
#pragma unroll
        for (int e = 0; e < 16; ++e) { kk00[e] = 0.f; kk10[e] = 0.f; kk11[e] = 0.f; qk00[e] = 0.f; qk10[e] = 0.f; qk11[e] = 0.f; }
#pragma unroll
        for (int ks = 0; ks < 4; ++ks) {
            kk00 = __builtin_amdgcn_mfma_f32_32x32x16_bf16(kf[0][ks], kf[0][ks], kk00, 0, 0, 0);
            kk10 = __builtin_amdgcn_mfma_f32_32x32x16_bf16(kf[1][ks], kf[0][ks], kk10, 0, 0, 0);
            kk11 = __builtin_amdgcn_mfma_f32_32x32x16_bf16(kf[1][ks], kf[1][ks], kk11, 0, 0, 0);
            qk00 = __builtin_amdgcn_mfma_f32_32x32x16_bf16(qf[0][ks], kf[0][ks], qk00, 0, 0, 0);
            qk10 = __builtin_amdgcn_mfma_f32_32x32x16_bf16(qf[1][ks], kf[0][ks], qk10, 0, 0, 0);
            qk11 = __builtin_amdgcn_mfma_f32_32x32x16_bf16(qf[1][ks], kf[1][ks], qk11, 0, 0, 0);
        }
        asm volatile("s_waitcnt lgkmcnt(0)" ::: "memory");
        {
            const float gcj0 = __shfl(gc, r), gcj1 = __shfl(gc, 32 + r);
            const int p0 = hh * 256 + sig_inv(r), p1 = hh * 256 + sig_inv(32 + r);
#pragma unroll
            for (int e = 0; e < 16; ++e) { const int ib = (e & 3) + 8 * (e >> 2), il = ib + 4 * hh;
                { const int i = il, j = r; const float gi = gcs[i], bi = bts[i]; const float dec = __expf(fminf(gi - gcj0, 0.f));
                  Am[i * 64 + j] = j < i ? bi * kk00[e] * dec : 0.f; (op + 2 * 4096 + ib * 64)[p0] = f2bf(j <= i ? qk00[e] * dec : 0.f); }
                { const int i = 32 + il, j = r; const float gi = gcs[i], bi = bts[i]; const float dec = __expf(fminf(gi - gcj0, 0.f));
                  Am[i * 64 + j] = bi * kk10[e] * dec; (op + 2 * 4096 + (32 + ib) * 64)[p0] = f2bf(qk10[e] * dec); }
                { const int i = 32 + il, j = 32 + r; const float gi = gcs[i], bi = bts[i]; const float dec = __expf(fminf(gi - gcj1, 0.f));
                  Am[i * 64 + j] = j < i ? bi * kk11[e] * dec : 0.f; (op + 2 * 4096 + (32 + ib) * 64)[p1] = f2bf(j <= i ? qk11[e] * dec : 0.f); }
                asm volatile("" ::: "memory");
            }
        }
        asm volatile("s_waitcnt lgkmcnt(0)" ::: "memory");
        {
            int c; { int t_ = threadIdx.x; asm volatile("" : "+v"(t_)); c = t_ & 63; } const int pc = sig_inv(c);
            const float egc = __expf(gc);
            const int beta_i = __float_as_int(beta), egc_i = __float_as_int(egc);
            { float u[64];
#pragma unroll
              for (int i = 0; i < 64; ++i) { const float bi = __int_as_float(__builtin_amdgcn_readlane(beta_i, i)); u[i] = bi * bf2f((vdb + i * 512)[c]); }
#pragma unroll
              for (int i = 1; i < 64; ++i) { float au = u[i];
#pragma unroll
                  for (int j4 = 0; j4 < i; j4 += 4) { const f32x4 a = *(const LAS f32x4*)(Am + i * 64 + j4);
#pragma unroll
                      for (int e = 0; e < 4; ++e) if (j4 + e < i) au -= a[e] * u[j4 + e]; }
                  u[i] = au; }
#pragma unroll
              for (int i = 0; i < 64; ++i) (up + i * 64)[c] = u[i]; }
            asm volatile("" ::: "memory");
            { float w[64];
#pragma unroll
              for (int i = 0; i < 64; ++i) { const float bi = __int_as_float(__builtin_amdgcn_readlane(beta_i, i)), ei = __int_as_float(__builtin_amdgcn_readlane(egc_i, i));
                  w[i] = bi * ei * bf2f((kdb + i * 512)[c]); (op + 1 * 4096 + i * 64)[pc] = f2bf(bf2f((qdb + i * 512)[c]) * ei); }
#pragma unroll
              for (int i = 1; i < 64; ++i) { float aw = w[i];
#pragma unroll
                  for (int j4 = 0; j4 < i; j4 += 4) { const f32x4 a = *(const LAS f32x4*)(Am + i * 64 + j4);
#pragma unroll
                      for (int e = 0; e < 4; ++e) if (j4 + e < i) aw -= a[e] * w[j4 + e]; }
                  w[i] = aw; }
#pragma unroll
              for (int i = 0; i < 64; ++i) (op + i * 64)[pc] = f2bf(-w[i]); }
        }
        asm volatile("s_waitcnt lgkmcnt(0)" ::: "memory");
    }
}
__device__ __forceinline__ bf16x8_t pack_b(const f32x4& lo, const f32x4& hi) { union { u32x4 u; bf16x8_t v; } x;
    x.u.x = pg8::cvt_pk_bf16(lo[0], lo[1]); x.u.y = pg8::cvt_pk_bf16(lo[2], lo[3]); x.u.z = pg8::cvt_pk_bf16(hi[0], hi[1]); x.u.w = pg8::cvt_pk_bf16(hi[2], hi[3]); return x.v; }
__device__ __forceinline__ void wu_scan(KP p, int l, int bh, int slice, int lane) {
    const int n = lane & 15, q = lane >> 4, n0 = slice * 16, b = bh >> 3, h = bh & 7;
    f32x4 S[4];
#pragma unroll
    for (int t = 0; t < 4; ++t) S[t] = (f32x4){0.f, 0.f, 0.f, 0.f};
    const int foff = n * 64 + 8 * q;
    for (int ch = 0; ch < 32; ++ch) {
        const size_t unit = (size_t)bh * 32 + ch;
        const bf16_t* op = p->DOP + unit * 4 * 4096 + foff; const float* up = p->DU + unit * 4096 + n0 + n;
        const float eg = p->DG[unit];
        f32x4 vn[4]; bf16x8_t wf[4][2], gf[4][2], kf[4][2], tf[4][2];
#pragma unroll
        for (int mt = 0; mt < 4; ++mt) {
#pragma unroll
            for (int e = 0; e < 4; ++e) vn[mt][e] = up[(16 * mt + 4 * q + e) * 64];
#pragma unroll
            for (int ks = 0; ks < 2; ++ks) { const int o = mt * 1024 + ks * 32;
                wf[mt][ks] = *(const bf16x8_t*)(op + o); gf[mt][ks] = *(const bf16x8_t*)(op + 4096 + o);
                kf[mt][ks] = *(const bf16x8_t*)(op + 2 * 4096 + o); tf[mt][ks] = *(const bf16x8_t*)(op + 3 * 4096 + o); } }
        const bf16x8_t sb0 = pack_b(S[0], S[1]), sb1 = pack_b(S[2], S[3]);
        f32x4 o[4];
#pragma unroll
        for (int mt = 0; mt < 4; ++mt) {
            vn[mt] = __builtin_amdgcn_mfma_f32_16x16x32_bf16(wf[mt][0], sb0, vn[mt], 0, 0, 0);
            vn[mt] = __builtin_amdgcn_mfma_f32_16x16x32_bf16(wf[mt][1], sb1, vn[mt], 0, 0, 0);
            o[mt] = __builtin_amdgcn_mfma_f32_16x16x32_bf16(gf[mt][0], sb0, (f32x4){0.f, 0.f, 0.f, 0.f}, 0, 0, 0);
            o[mt] = __builtin_amdgcn_mfma_f32_16x16x32_bf16(gf[mt][1], sb1, o[mt], 0, 0, 0);
        }
        const bf16x8_t vb0 = pack_b(vn[0], vn[1]), vb1 = pack_b(vn[2], vn[3]);
#pragma unroll
        for (int mt = 0; mt < 4; ++mt) {
            o[mt] = __builtin_amdgcn_mfma_f32_16x16x32_bf16(kf[mt][0], vb0, o[mt], 0, 0, 0);
            if (mt >= 2) o[mt] = __builtin_amdgcn_mfma_f32_16x16x32_bf16(kf[mt][1], vb1, o[mt], 0, 0, 0);
            S[mt] = S[mt] * eg;
            S[mt] = __builtin_amdgcn_mfma_f32_16x16x32_bf16(tf[mt][0], vb0, S[mt], 0, 0, 0);
            S[mt] = __builtin_amdgcn_mfma_f32_16x16x32_bf16(tf[mt][1], vb1, S[mt], 0, 0, 0);
        }
        bf16_t* yo = p->yc + ((size_t)b * SEQ + ch * 64) * 1536 + h * 64 + n0 + n;
#pragma unroll
        for (int mt = 0; mt < 4; ++mt)
#pragma unroll
            for (int e = 0; e < 4; ++e) yo[(size_t)(16 * mt + 4 * q + e) * 1536] = f2bf(o[mt][e]);
    }
    float* so = p->out + O_PDELTA + (((size_t)l * 8 + b) * 8 + h) * 4096 + n0 + n;
#pragma unroll
    for (int t = 0; t < 4; ++t)
#pragma unroll
        for (int e = 0; e < 4; ++e) so[(16 * t + 4 * q + e) * 64] = S[t][e];
}
__device__ __forceinline__ void ph_delta_fin(KP p, int l) {
    int tid_o = threadIdx.x; asm volatile("" : "+v"(tid_o)); int lane = tid_o & 63, wave = tid_o >> 6;
    const int h = lane >> 3, d0 = (lane & 7) * 8;
    for (int t = blockIdx.x * 8 + wave; t < TP; t += gridDim.x * 8) {
        bf16_t* yp = p->yc + (size_t)t * 1536 + h * 64 + d0; const u32x4 raw = *(const u32x4*)yp; const u32x4 gz = *(const u32x4*)(p->H + (size_t)t * IN_WP + C_ZDN + h * 64 + d0);
        float v[8]; v[0] = __uint_as_float(raw.x << 16); v[1] = __uint_as_float(raw.x & 0xffff0000u); v[2] = __uint_as_float(raw.y << 16); v[3] = __uint_as_float(raw.y & 0xffff0000u);
        v[4] = __uint_as_float(raw.z << 16); v[5] = __uint_as_float(raw.z & 0xffff0000u); v[6] = __uint_as_float(raw.w << 16); v[7] = __uint_as_float(raw.w & 0xffff0000u);
        float z[8]; z[0] = __uint_as_float(gz.x << 16); z[1] = __uint_as_float(gz.x & 0xffff0000u); z[2] = __uint_as_float(gz.y << 16); z[3] = __uint_as_float(gz.y & 0xffff0000u);
        z[4] = __uint_as_float(gz.z << 16); z[5] = __uint_as_float(gz.z & 0xffff0000u); z[6] = __uint_as_float(gz.w << 16); z[7] = __uint_as_float(gz.w & 0xffff0000u);
        float ss = 0.f;
#pragma unroll
        for (int e = 0; e < 8; ++e) ss += v[e] * v[e];
        ss += __shfl_xor(ss, 1); ss += __shfl_xor(ss, 2); ss += __shfl_xor(ss, 4);
        const float rs = rsqrtf(ss * (1.0f / 64.0f) + EPS);
#pragma unroll
        for (int e = 0; e < 8; ++e) v[e] = v[e] * rs * p->dn_norm_g[l * 64 + d0 + e] * z[e];
        u32x4 w; w.x = pg8::cvt_pk_bf16(v[0], v[1]); w.y = pg8::cvt_pk_bf16(v[2], v[3]); w.z = pg8::cvt_pk_bf16(v[4], v[5]); w.w = pg8::cvt_pk_bf16(v[6], v[7]);
        *(u32x4*)yp = w;
    }
}

__device__ __forceinline__ void ph_att_waves(KP p, int l) {
    int tid_o = threadIdx.x; asm volatile("" : "+v"(tid_o)); int lane = tid_o & 63, wave = tid_o >> 6;
    wave = __builtin_amdgcn_readfirstlane(wave);
    const int G = gridDim.x, NW = G * 8, gw = wave * G + blockIdx.x;
    for (int d = gw; d < 256; d += NW) wu_scan(p, l, d >> 2, d & 3, lane);
    for (int d = NW - 1 - gw; d < 256; d += NW) wu_delta(p, l, 8 + (d >> 3), d & 7, lane);
}
__device__ __forceinline__ void ph_fin(KP p, int l, LAS unsigned char* lds) {
    int tid_o = threadIdx.x; asm volatile("" : "+v"(tid_o)); int lane = tid_o & 63, wave = tid_o >> 6;
    LAS float* ol = (LAS float*)(lds + wave * 2048); LAS float* wgt = ol + 256;
    const float* w_uv = p->w_uv + (size_t)l * 256 * 512;
    for (int u = blockIdx.x * 8 + wave; u < TS * 8; u += gridDim.x * 8) {
        const int ts = u >> 3, h = u & 7, s = ts >> 3, r = (ts & 7) * 8 + h; const int d = lane;
        float M = -1e30f;
        for (int ch = 0; ch < SA_CH; ++ch) M = fmaxf(M, p->part[(((size_t)s * SA_CH + ch) * 64 + r) * 258 + 256]);
        float L = 0.f;
        for (int ch = 0; ch < SA_CH; ++ch) { const float* pp = p->part + (((size_t)s * SA_CH + ch) * 64 + r) * 258; const float w = __expf(pp[256] - M); L += pp[257] * w; if (d == 0) wgt[ch] = w; }
        asm volatile("s_waitcnt lgkmcnt(0)" ::: "memory");
        for (int c = d; c < 256; c += 64) { float a = 0.f; for (int ch = 0; ch < SA_CH; ++ch) a += wgt[ch] * p->part[(((size_t)s * SA_CH + ch) * 64 + r) * 258 + c]; ol[c] = a / L; }
        asm volatile("s_waitcnt lgkmcnt(0)" ::: "memory");
        float a = 0.f;
        for (int c = 0; c < 256; ++c) a += ol[c] * w_uv[(size_t)c * 512 + h * 64 + d];
        const int t = TP + ts;
        p->yb[(size_t)t * 1536 + h * 64 + d] = f2bf(a * bf2f(p->H[(size_t)t * IN_WP + C_ZMLA + h * 64 + d]));
        asm volatile("s_waitcnt lgkmcnt(0)" ::: "memory");
    }
}

constexpr int SA_QS = 592, SA_KS = 576, SA_PS = 272;
constexpr int SA_OFF_Q = 0, SA_OFF_K = 64 * SA_QS, SA_OFF_P = SA_OFF_K + 128 * SA_KS, SA_OFF_M = SA_OFF_P + 64 * SA_PS, SA_OFF_L = SA_OFF_M + 1024, SA_LDS = SA_OFF_L + 1024;
typedef short s16x4 __attribute__((ext_vector_type(4)));
__device__ __forceinline__ void sa_unit(KP p, int l, int s, int ch, LAS unsigned char* lds, int tid) {
    const int lane = tid & 63, wave = __builtin_amdgcn_readfirstlane(tid >> 6), r = lane & 31, hh = lane >> 5;
    const int qb = wave & 1, kb = wave >> 1, cg = wave >> 1;
    LAS unsigned char* Qs = lds + SA_OFF_Q; LAS unsigned char* Kt = lds + SA_OFF_K; LAS unsigned char* Pt = lds + SA_OFF_P;
    LAS float* mloc = (LAS float*)(lds + SA_OFF_M); LAS float* lred = (LAS float*)(lds + SA_OFF_L);
    __syncthreads();
    { const float* w_uk = p->w_uk + (size_t)l * 256 * 512; const bf16_t* Qg = p->Q + (size_t)(TP + s * 8) * 768;
      const int c = tid & 255, h2 = tid >> 8;
      for (int h = h2 * 4; h < h2 * 4 + 4; ++h) { float acc[8];
#pragma unroll
          for (int i = 0; i < 8; ++i) acc[i] = 0.f;
          const float* wr_ = w_uk + (size_t)c * 512 + h * 64;
          for (int d = 0; d < 64; d += 4) { const f32x4 wv = *(const f32x4*)(wr_ + d);
#pragma unroll
              for (int i = 0; i < 8; ++i) { const bf16_t* q = Qg + i * 768 + h * 96 + d;
                  acc[i] += bf2f(q[0]) * wv[0] + bf2f(q[1]) * wv[1] + bf2f(q[2]) * wv[2] + bf2f(q[3]) * wv[3]; } }
#pragma unroll
          for (int i = 0; i < 8; ++i) *(LAS bf16_t*)(Qs + (i * 8 + h) * SA_QS + c * 2) = f2bf(acc[i]); }
      for (int e = tid; e < 64 * 32; e += NTHR) { const int rr = e >> 5, j = e & 31; *(LAS bf16_t*)(Qs + rr * SA_QS + (256 + j) * 2) = Qg[(rr >> 3) * 768 + (rr & 7) * 96 + 64 + j]; } }
    const int* pt = p->page_table + s * N_PAGES + ch * 16;
    const float* ckv_base = p->cache_kv + (size_t)l * N_POOL * PAGE * 256; const float* ckr_base = p->cache_kr + (size_t)l * N_POOL * PAGE * 32;
    f32x4 rk[16], rr2[2];
    { const int page = pt[0]; const float* kvp = ckv_base + (size_t)page * PAGE * 256; const float* krp = ckr_base + (size_t)page * PAGE * 32;
#pragma unroll
      for (int i = 0; i < 16; ++i) rk[i] = __builtin_nontemporal_load((const f32x4*)(kvp + (size_t)(tid + 512 * i) * 4));
#pragma unroll
      for (int i = 0; i < 2; ++i) rr2[i] = __builtin_nontemporal_load((const f32x4*)(krp + (size_t)(tid + 512 * i) * 4)); }
    f32x16 o0, o1;
#pragma unroll
    for (int e = 0; e < 16; ++e) { o0[e] = 0.f; o1[e] = 0.f; }
    float m = -1e30f, lw = 0.f;
    const int li = lane & 15, g1 = (lane >> 4) & 1;
    const int trOff = (8 * hh + (li >> 2)) * SA_KS + (16 * g1 + 4 * (li & 3)) * 2;
    const int ntile = ch == 7 ? 17 : 16;
    for (int t = 0; t < ntile; ++t) {
        __syncthreads();
        if (t < 16) {
#pragma unroll
            for (int i = 0; i < 16; ++i) { const int ci = tid + 512 * i, key = ci >> 6, c4 = ci & 63; u32x2 w; w.x = pg8::cvt_pk_bf16(rk[i][0], rk[i][1]); w.y = pg8::cvt_pk_bf16(rk[i][2], rk[i][3]);
                *(LAS u32x2*)(Kt + key * SA_KS + c4 * 8) = w; }
#pragma unroll
            for (int i = 0; i < 2; ++i) { const int ci = tid + 512 * i, key = ci >> 3, c4 = ci & 7; u32x2 w; w.x = pg8::cvt_pk_bf16(rr2[i][0], rr2[i][1]); w.y = pg8::cvt_pk_bf16(rr2[i][2], rr2[i][3]);
                *(LAS u32x2*)(Kt + key * SA_KS + 512 + c4 * 8) = w; }
        } else {
            for (int e = tid; e < 128 * 36; e += NTHR) { const int key = e / 36, c16 = e - key * 36; u32x4 v = (u32x4){0u, 0u, 0u, 0u};
                if (key < 8) v = c16 < 32 ? *(const u32x4*)(p->ckv + ((size_t)TP + s * 8 + key) * 256 + c16 * 8) : *(const u32x4*)(p->Kr + ((size_t)TP + s * 8 + key) * 32 + (c16 - 32) * 8);
                *(LAS u32x4*)(Kt + key * SA_KS + c16 * 16) = v; }
        }
        __syncthreads();
        if (t + 1 < 16) { const int page = pt[t + 1]; const float* kvp = ckv_base + (size_t)page * PAGE * 256; const float* krp = ckr_base + (size_t)page * PAGE * 32;
#pragma unroll
            for (int i = 0; i < 16; ++i) rk[i] = __builtin_nontemporal_load((const f32x4*)(kvp + (size_t)(tid + 512 * i) * 4));
#pragma unroll
            for (int i = 0; i < 2; ++i) rr2[i] = __builtin_nontemporal_load((const f32x4*)(krp + (size_t)(tid + 512 * i) * 4)); }
        f32x16 sa;
#pragma unroll
        for (int e = 0; e < 16; ++e) sa[e] = 0.f;
        { const LAS unsigned char* ka = Kt + (32 * kb + r) * SA_KS + 16 * hh; const LAS unsigned char* qa = Qs + (32 * qb + r) * SA_QS + 16 * hh;
#pragma unroll
          for (int ks = 0; ks < 18; ++ks) sa = __builtin_amdgcn_mfma_f32_32x32x16_bf16(*(const LAS bf16x8_t*)(ka + ks * 32), *(const LAS bf16x8_t*)(qa + ks * 32), sa, 0, 0, 0); }
        if (t == 16) { const int itok = (32 * qb + r) >> 3;
#pragma unroll
            for (int e = 0; e < 16; ++e) { const int key = 32 * kb + (e & 3) + 8 * (e >> 2) + 4 * hh; if (key > itok) sa[e] = -1e30f; } }
        float tm = sa[0];
#pragma unroll
        for (int e = 1; e < 16; ++e) tm = fmaxf(tm, sa[e]);
        tm = fmaxf(tm, __shfl_xor(tm, 32));
        if (hh == 0) mloc[kb * 64 + 32 * qb + r] = tm;
        __syncthreads();
        { const int q = 32 * qb + r; const float tmx = fmaxf(fmaxf(mloc[q], mloc[64 + q]), fmaxf(mloc[128 + q], mloc[192 + q]));
          const float mn = fmaxf(m, tmx), al = __builtin_amdgcn_exp2f((m - mn) * ATT_C), mc = mn * ATT_C; m = mn;
          float ps = 0.f;
#pragma unroll
          for (int e = 0; e < 16; ++e) { sa[e] = __builtin_amdgcn_exp2f(sa[e] * ATT_C - mc); ps += sa[e]; }
          lw = lw * al + ps;
#pragma unroll
          for (int g4 = 0; g4 < 4; ++g4) { u32x2 w; w.x = pg8::cvt_pk_bf16(sa[4 * g4], sa[4 * g4 + 1]); w.y = pg8::cvt_pk_bf16(sa[4 * g4 + 2], sa[4 * g4 + 3]);
              *(LAS u32x2*)(Pt + q * SA_PS + (32 * kb + 8 * g4 + 4 * hh) * 2) = w; }
#pragma unroll
          for (int e = 0; e < 16; ++e) { o0[e] *= al; o1[e] *= al; } }
        __syncthreads();
        { const LAS unsigned char* pa = Pt + (32 * qb + r) * SA_PS + 16 * hh; const LAS unsigned char* va = Kt + trOff + (64 * cg) * 2;
#pragma unroll
          for (int ks = 0; ks < 8; ++ks) { const bf16x8_t pb = *(const LAS bf16x8_t*)(pa + ks * 32);
              union { struct { s16x4 lo, hi; } h; bf16x8_t v; } a0, a1;
              a0.h.lo = __builtin_amdgcn_ds_read_tr16_b64_v4i16((LAS s16x4*)(va + ks * 16 * SA_KS)); a0.h.hi = __builtin_amdgcn_ds_read_tr16_b64_v4i16((LAS s16x4*)(va + ks * 16 * SA_KS + 4 * SA_KS));
              a1.h.lo = __builtin_amdgcn_ds_read_tr16_b64_v4i16((LAS s16x4*)(va + ks * 16 * SA_KS + 64)); a1.h.hi = __builtin_amdgcn_ds_read_tr16_b64_v4i16((LAS s16x4*)(va + ks * 16 * SA_KS + 4 * SA_KS + 64));
              o0 = __builtin_amdgcn_mfma_f32_32x32x16_bf16(a0.v, pb, o0, 0, 0, 0);
              o1 = __builtin_amdgcn_mfma_f32_32x32x16_bf16(a1.v, pb, o1, 0, 0, 0); } }
    }
    lw += __shfl_xor(lw, 32);
    if (hh == 0) lred[kb * 64 + 32 * qb + r] = lw;
    __syncthreads();
    { const int q = 32 * qb + r; float* pp = p->part + (((size_t)s * SA_CH + ch) * 64 + q) * 258;
#pragma unroll
      for (int cb2 = 0; cb2 < 2; ++cb2)
#pragma unroll
          for (int g4 = 0; g4 < 4; ++g4) { const int c = 32 * (2 * cg + cb2) + 8 * g4 + 4 * hh; f32x4 v;
#pragma unroll
              for (int e = 0; e < 4; ++e) v[e] = cb2 == 0 ? o0[4 * g4 + e] : o1[4 * g4 + e];
              *(f32x2*)(pp + c) = (f32x2){v[0], v[1]}; *(f32x2*)(pp + c + 2) = (f32x2){v[2], v[3]}; }
      if (cg == 0 && hh == 0) { pp[256] = m * MLA_SCALE; pp[257] = lred[q] + lred[64 + q] + lred[128 + q] + lred[192 + q]; } }
}
__device__ __forceinline__ void ph_attn_s2(KP p, int l, LAS unsigned char* lds) {
    int tid = threadIdx.x; asm volatile("" : "+v"(tid));
    for (int u = blockIdx.x; u < DEC_BATCH * 8; u += gridDim.x) sa_unit(p, l, u >> 3, u & 7, lds, tid);
    __syncthreads();
}

constexpr int ATT_KS = 208, ATT_VS = 144, ATT_KB = 64 * ATT_KS, ATT_VB = 64 * ATT_VS, ATT_STAGE = ATT_KB + ATT_VB;
__device__ __forceinline__ void attn_unit(KP p, int b, int h, int qblk, LAS unsigned char* lds, int tid, int wave, int lane) {
    const int r = lane & 31, hh = lane >> 5;
    const int q0 = qblk * 256 + wave * 32;
    const size_t trow0 = (size_t)b * SEQ;
    bf16x8_t qf[6];
    { const bf16_t* qp = p->Q + (trow0 + q0 + r) * 768 + h * 96 + 8 * hh;
#pragma unroll
      for (int ks = 0; ks < 6; ++ks) qf[ks] = *(const bf16x8_t*)(qp + 16 * ks); }
    f32x16 o0, o1;
#pragma unroll
    for (int e = 0; e < 16; ++e) { o0[e] = 0.f; o1[e] = 0.f; }
    float m = -1e30f, lsum = 0.f;
    const int ntile = qblk * 4 + 4;
    const int cA = tid, keyA = cA / 12, partA = cA - keyA * 12; const int cB = 512 + (tid & 255), keyB = cB / 12, partB = cB - keyB * 12; const bool hasB = tid < 256;
    const bf16_t* gA = partA < 8 ? p->Kn + (trow0 + keyA) * 512 + h * 64 + partA * 8 : p->Kr + (trow0 + keyA) * 32 + (partA - 8) * 8; const int stepA = partA < 8 ? 64 * 512 : 64 * 32;
    const bf16_t* gB = partB < 8 ? p->Kn + (trow0 + keyB) * 512 + h * 64 + partB * 8 : p->Kr + (trow0 + keyB) * 32 + (partB - 8) * 8; const int stepB = partB < 8 ? 64 * 512 : 64 * 32;
    const bf16_t* gV = p->Vt + (size_t)(h * 64 + (tid >> 3)) * TP + trow0 + (tid & 7) * 8;
    const int lA = keyA * ATT_KS + partA * 16, lB = keyB * ATT_KS + partB * 16, lV = ATT_KB + (tid >> 3) * ATT_VS + (tid & 7) * 16;
    const int pr_ = (r & 0x13) | ((r & 4) << 1) | ((r & 8) >> 1);
    const int kOff = pr_ * ATT_KS + 16 * hh, vOff = ATT_KB + r * ATT_VS + 16 * hh;
    u32x4 rA = *(const u32x4*)gA, rB = hasB ? *(const u32x4*)gB : (u32x4){0u, 0u, 0u, 0u}, rV = *(const u32x4*)gV;
    for (int kt = 0; kt < ntile; ++kt) {
        LAS unsigned char* st = lds + (kt & 1) * ATT_STAGE;
        *(LAS u32x4*)(st + lA) = rA; if (hasB) *(LAS u32x4*)(st + lB) = rB; *(LAS u32x4*)(st + lV) = rV;
        __syncthreads();
        if (kt + 1 < ntile) { gA += stepA; gB += stepB; gV += 64; rA = *(const u32x4*)gA; if (hasB) rB = *(const u32x4*)gB; rV = *(const u32x4*)gV; }
        if (kt * 64 <= q0 + 31) {
            f32x16 s0, s1;
#pragma unroll
            for (int e = 0; e < 16; ++e) { s0[e] = 0.f; s1[e] = 0.f; }
#pragma unroll
            for (int ks = 0; ks < 6; ++ks) {
                const bf16x8_t a0 = *(const LAS bf16x8_t*)(st + kOff + ks * 32), a1 = *(const LAS bf16x8_t*)(st + kOff + 32 * ATT_KS + ks * 32);
                s0 = __builtin_amdgcn_mfma_f32_32x32x16_bf16(a0, qf[ks], s0, 0, 0, 0);
                s1 = __builtin_amdgcn_mfma_f32_32x32x16_bf16(a1, qf[ks], s1, 0, 0, 0);
            }
            if (kt * 64 + 63 > q0) {
                const int qrel = q0 + r - kt * 64;
#pragma unroll
                for (int e = 0; e < 16; ++e) { const int kl = (e & 3) + 4 * ((e >> 2) & 1) + 8 * hh + 16 * ((e >> 3) & 1);
                    if (kl > qrel) s0[e] = -1e30f; if (kl + 32 > qrel) s1[e] = -1e30f; }
            }
            float tm = fmaxf(s0[0], s1[0]);
#pragma unroll
            for (int e = 1; e < 16; ++e) tm = fmaxf(tm, fmaxf(s0[e], s1[e]));
            tm = fmaxf(tm, __shfl_xor(tm, 32));
            const float mn = fmaxf(m, tm), al = __builtin_amdgcn_exp2f((m - mn) * ATT_C), mc = mn * ATT_C; m = mn;
            float ps = 0.f;
#pragma unroll
            for (int e = 0; e < 16; ++e) { s0[e] = __builtin_amdgcn_exp2f(s0[e] * ATT_C - mc); s1[e] = __builtin_amdgcn_exp2f(s1[e] * ATT_C - mc); ps += s0[e] + s1[e]; }
            lsum = lsum * al + ps;
#pragma unroll
            for (int e = 0; e < 16; ++e) { o0[e] *= al; o1[e] *= al; }
#pragma unroll
            for (int kb = 0; kb < 2; ++kb)
#pragma unroll
                for (int sp = 0; sp < 2; ++sp) {
                    union { u32x4 u; bf16x8_t v; } pb;
                    if (kb == 0) { pb.u.x = pg8::cvt_pk_bf16(s0[8 * sp + 0], s0[8 * sp + 1]); pb.u.y = pg8::cvt_pk_bf16(s0[8 * sp + 2], s0[8 * sp + 3]); pb.u.z = pg8::cvt_pk_bf16(s0[8 * sp + 4], s0[8 * sp + 5]); pb.u.w = pg8::cvt_pk_bf16(s0[8 * sp + 6], s0[8 * sp + 7]); }
                    else         { pb.u.x = pg8::cvt_pk_bf16(s1[8 * sp + 0], s1[8 * sp + 1]); pb.u.y = pg8::cvt_pk_bf16(s1[8 * sp + 2], s1[8 * sp + 3]); pb.u.z = pg8::cvt_pk_bf16(s1[8 * sp + 4], s1[8 * sp + 5]); pb.u.w = pg8::cvt_pk_bf16(s1[8 * sp + 6], s1[8 * sp + 7]); }
                    const int ko = (32 * kb + 16 * sp) * 2;
                    const bf16x8_t v0 = *(const LAS bf16x8_t*)(st + vOff + ko), v1 = *(const LAS bf16x8_t*)(st + vOff + 32 * ATT_VS + ko);
                    o0 = __builtin_amdgcn_mfma_f32_32x32x16_bf16(v0, pb.v, o0, 0, 0, 0);
                    o1 = __builtin_amdgcn_mfma_f32_32x32x16_bf16(v1, pb.v, o1, 0, 0, 0);
                }
        }
    }
    lsum += __shfl_xor(lsum, 32);
    const float il = 1.0f / lsum;
    const size_t t = trow0 + q0 + r;
#pragma unroll
    for (int db = 0; db < 2; ++db)
#pragma unroll
        for (int g = 0; g < 4; ++g) { const int d0 = 32 * db + 8 * g + 4 * hh;
            const u32x2 gz = *(const u32x2*)(p->H + t * IN_WP + C_ZMLA + h * 64 + d0);
            float v[4];
#pragma unroll
            for (int e = 0; e < 4; ++e) v[e] = (db == 0 ? o0[4 * g + e] : o1[4 * g + e]) * il;
            v[0] *= __uint_as_float(gz.x << 16); v[1] *= __uint_as_float(gz.x & 0xffff0000u); v[2] *= __uint_as_float(gz.y << 16); v[3] *= __uint_as_float(gz.y & 0xffff0000u);
            u32x2 w; w.x = pg8::cvt_pk_bf16(v[0], v[1]); w.y = pg8::cvt_pk_bf16(v[2], v[3]);
            *(u32x2*)(p->yb + t * 1536 + h * 64 + d0) = w; }
}
__device__ __forceinline__ void ph_attn_p(KP p, LAS unsigned char* lds) {
    int tid = threadIdx.x; asm volatile("" : "+v"(tid));
    const int lane = tid & 63, wave = __builtin_amdgcn_readfirstlane(tid >> 6);
    for (int pi = blockIdx.x; pi < 256; pi += gridDim.x) {
        const int xcd = pi & 7, k = pi >> 3, bh = xcd * 8 + (k >> 2), pr = k & 3;
        attn_unit(p, bh >> 3, bh & 7, 7 - pr, lds, tid, wave, lane);
        attn_unit(p, bh >> 3, bh & 7, pr, lds, tid, wave, lane);
    }
    __syncthreads();
}
struct MEpiVt { static constexpr bool PERM = true, AFTER_DRAIN = false; static constexpr int SEG = 0; bf16_t* O; int ldc; int pad_;
    __device__ __forceinline__ void operator()(const f32x4 (&acc)[2][2][4][2], const pg8::Unit& u, int wr, int wc, int fr0, int fq0) const {
        int fr = fr0, fq = fq0; asm volatile("" : "+v"(fr), "+v"(fq));
        const int row0 = u.pm * 256 + wr * 64 + fr;
#pragma unroll
        for (int bj = 0; bj < 2; ++bj) { const int col0 = u.pn * 256 + bj * 128 + wc * 32 + 8 * fq;
#pragma unroll
            for (int ai = 0; ai < 2; ++ai)
#pragma unroll
                for (int m = 0; m < 4; ++m) { const int row = row0 + ai * 128 + m * 16; const f32x4 v0 = acc[ai][bj][m][0], v1 = acc[ai][bj][m][1];
                    u32x4 w; w.x = pg8::cvt_pk_bf16(v0[0], v0[1]); w.y = pg8::cvt_pk_bf16(v0[2], v0[3]); w.z = pg8::cvt_pk_bf16(v1[0], v1[1]); w.w = pg8::cvt_pk_bf16(v1[2], v1[3]);
                    *(u32x4*)(O + (size_t)row * ldc + col0) = w; } }
    } };


__global__ void __launch_bounds__(NTHR, 2) k_mega(Params p_unused) {
    const KP kp0 = (KP)__builtin_amdgcn_kernarg_segment_ptr();
#define PP() ({ KP q_ = kp0; asm volatile("" : "+s"(q_)); q_; })
    KP p = PP();
    extern __shared__ __attribute__((aligned(16))) unsigned char lds_raw[];
    LAS unsigned char* lds = (LAS unsigned char*)lds_raw;
    volatile LAS unsigned* misc = (volatile LAS unsigned*)(lds + LDS_MISC);
    for (int u = threadIdx.x; u < 64; u += NTHR) misc[u] = 0u;
    __syncthreads();
    const int lo = p->ph_lo, hi = p->ph_hi;
    XcdBarrier bar; bar.bar = p->bar + p->li * XCD_BAR_WORDS; bar.x = 0; bar.st = nullptr;
    if (hi - lo > 1) bar = xcd_barrier_post(p->bar + p->li * XCD_BAR_WORDS, misc + 8);
#define IN(k) (lo <= (k) && (k) < hi)
#define SEAM(k) do { if (IN(k) && IN((k) + 1)) xcd_barrier(bar); } while (0)

    if (IN(PH_PRO)) {
        LAS float* tile = (LAS float*)lds;
        for (int l = 0; l < 2; ++l) {
            KP p = PP();
            ph_tr(p->w_in + (size_t)l * 1024 * IN_W, p->WinT + (size_t)l * IN_WP * 1024, 1024, IN_W, IN_WP, tile, 0);
            ph_tr(p->w_uq + (size_t)l * 384 * 768, p->WuqT + (size_t)l * 768 * 384, 384, 768, 768, tile, 0);
            ph_tr(p->w_uk + (size_t)l * 256 * 512, p->WkvT + (size_t)l * 1024 * 256, 256, 512, 512, tile, 144);
            ph_tr(p->w_uv + (size_t)l * 256 * 512, p->WkvT + (size_t)l * 1024 * 256 + (size_t)512 * 256, 256, 512, 512, tile, 208);
            ph_tr(p->w_br0 + (size_t)l * 512 * 1024, p->WbrT + (size_t)l * 1024 * 1536 + 0 * 512, 512, 1024, 1024, tile, 0, 1536);
            ph_tr(p->w_br1 + (size_t)l * 512 * 1024, p->WbrT + (size_t)l * 1024 * 1536 + 1 * 512, 512, 1024, 1024, tile, 0, 1536);
            ph_tr(p->w_br2 + (size_t)l * 512 * 1024, p->WbrT + (size_t)l * 1024 * 1536 + 2 * 512, 512, 1024, 1024, tile, 0, 1536);
            ph_tr(p->w_out + (size_t)l * 1024 * 1024, p->WoutT + (size_t)l * 1024 * 1024, 1024, 1024, 1024, tile, 0);
            for (int g = 0; g < 4; ++g) ph_tr(p->pool_mix + ((size_t)l * 4 + g) * 128 * 128, p->PmixT + ((size_t)l * 4 + g) * 128 * 128, 128, 128, 128, tile, 64 + 8 * g);
        }
        { KP p = PP(); ph_rope_tab(p->tab); ph_rmsnorm(p->x_prompt, p->x_sample, p->norm_g, p->xn, nullptr, nullptr); }
    }
    SEAM(PH_PRO);
    for (int l = 0; l < 2; ++l) {
        int G = gridDim.x, bid = blockIdx.x; asm volatile("" : "+s"(G), "+s"(bid));
        if (IN(PHID(l, PH_GIN))) { KP p = PP();
            pg8::Gemm g{p->xn, p->WinT + (size_t)l * IN_WP * 1024, TT, IN_WP, 1024}; pg8::StaticOrder S; S.init(TT, IN_WP, G, bid);
            MEpiH E{p->H, p->BA}; pg8::gemm_phase<MEpiH, pg8::StaticOrder, false>(lds, g, S, E, nullptr);
        }
        SEAM(PHID(l, PH_GIN));
        if (IN(PHID(l, PH_TOK))) { ph_tok_prompt(PP(), l, lds); ph_tok(PP(), l, lds); }
        SEAM(PHID(l, PH_TOK));
        if (IN(PHID(l, PH_GQ))) { KP p = PP();
            pg8::Gemm g{p->cq, p->WuqT + (size_t)l * 768 * 384, TT, 768, 384}; pg8::StaticOrder S; S.init(TT, 768, G, bid);
            MEpiQ E{p->Q, p->tab}; pg8::gemm_phase<MEpiQ, pg8::StaticOrder, false>(lds, g, S, E, nullptr);
        }
        if (IN(PHID(l, PH_GQ))) { KP p = PP();
            pg8::Gemm g{p->ckv, p->WkvT + (size_t)l * 1024 * 256, TP, 512, 256}; pg8::StaticOrder S; S.init(TP, 512, G / 2, bid < G / 2 ? bid : G);
            MEpiKV E{p->Kn, p->V}; pg8::gemm_phase<MEpiKV, pg8::StaticOrder, false>(lds, g, S, E, nullptr);
        }
        if (IN(PHID(l, PH_GQ))) { KP p = PP();
            pg8::Gemm g{p->WkvT + (size_t)l * 1024 * 256 + (size_t)512 * 256, p->ckv, 512, TP, 256}; pg8::StaticOrder S; S.init(512, TP, G / 2, bid >= G / 2 ? bid - G / 2 : G);
            MEpiVt E{p->Vt, TP, 0}; pg8::gemm_phase<MEpiVt, pg8::StaticOrder, false>(lds, g, S, E, nullptr);
        }
        if (IN(PHID(l, PH_GQ))) ph_delta_pre(PP(), lds);
        SEAM(PHID(l, PH_GQ));
        if (IN(PHID(l, PH_ATT))) { const int am = PP()->pad;
            if (am & 1) ph_attn_s2(PP(), l, lds); if (am & 4) ph_attn_p(PP(), lds); if (am & 8) ph_att_waves(PP(), l); }
        SEAM(PHID(l, PH_ATT));
        if (IN(PHID(l, PH_FIN))) { ph_fin(PP(), l, lds); ph_delta_fin(PP(), l); }
        SEAM(PHID(l, PH_FIN));
        if (IN(PHID(l, PH_MERGE))) { KP p = PP();
            pg8::Gemm g{p->ya, p->WbrT + (size_t)l * 1024 * 1536, TP, 1024, 1536}; pg8::StaticOrder S; S.init(TP, 1024, G, bid);
            MEpiMergeS E{p->H, p->mb}; pg8::gemm_phase<MEpiMergeS, pg8::StaticOrder, false>(lds, g, S, E, nullptr);
        }
        if (IN(PHID(l, PH_MERGE))) { KP p = PP(); TEpiMerge E{p->H, p->mb}; tail_gemm<3, TEpiMerge>(p->ya + (size_t)TP * 1536, 1536, p->WbrT + (size_t)l * 1024 * 1536, 1536, 1024, E, lds); }
        SEAM(PHID(l, PH_MERGE));
        if (IN(PHID(l, PH_OUT))) { KP p = PP();
            const float* xp = l == 0 ? p->x_prompt : p->xres; const float* xs = l == 0 ? p->x_sample : p->xres + (size_t)TP * 1024;
            pg8::Gemm g{p->mb, p->WoutT + (size_t)l * 1024 * 1024, TP, 1024, 1024}; pg8::StaticOrder S; S.init(TP, 1024, G, bid);
            MEpiRes E{xp, xs, p->xres}; pg8::gemm_phase<MEpiRes, pg8::StaticOrder, false>(lds, g, S, E, nullptr);
        }
        if (IN(PHID(l, PH_OUT))) { KP p = PP(); TEpiRes E{l == 0 ? p->x_sample : p->xres + (size_t)TP * 1024, p->xres}; tail_gemm<1, TEpiRes>(p->mb + (size_t)TP * 1024, 1024, p->WoutT + (size_t)l * 1024 * 1024, 1024, 1024, E, lds); }
        SEAM(PHID(l, PH_OUT));
        if (IN(PHID(l, PH_NORM))) { KP p = PP();
            if (l == 0) ph_rmsnorm(p->xres, p->xres + (size_t)TP * 1024, p->norm_g + 1024, p->xn, nullptr, nullptr);
            else ph_rmsnorm(p->xres, p->xres + (size_t)TP * 1024, p->final_norm_g, nullptr, p->out + O_YP, p->out + O_YS);
        }
        SEAM(PHID(l, PH_NORM));
    }
#undef IN
#undef SEAM
}

static inline size_t al256(size_t x) { return (x + 255) & ~(size_t)255; }
extern "C" void kernel_launch(void* const* d_in, const int* in_sizes, int n_in, void* d_out, int out_size, void* d_ws, size_t ws_size, hipStream_t stream) {
    static int grid = 0;
    if (grid == 0) {
        int dev = 0, cus = 0; (void)hipGetDevice(&dev); (void)hipDeviceGetAttribute(&cus, hipDeviceAttributeMultiprocessorCount, dev);
        (void)hipFuncSetAttribute((const void*)k_mega, hipFuncAttributeMaxDynamicSharedMemorySize, LDS_BYTES);
        int per_cu = 0; (void)hipOccupancyMaxActiveBlocksPerMultiprocessor(&per_cu, (const void*)k_mega, NTHR, LDS_BYTES); (void)hipGetLastError();
        grid = cus > 0 ? cus : 256;
    }
    Params p{};
    p.x_prompt = (const float*)d_in[0]; p.x_sample = (const float*)d_in[1]; p.cache_kv = (const float*)d_in[2]; p.cache_kr = (const float*)d_in[3];
    p.state_pool = (const float*)d_in[4]; p.state_conv = (const float*)d_in[5]; p.state_delta = (const float*)d_in[6]; p.page_table = (const int*)d_in[7];
    p.norm_g = (const float*)d_in[8]; p.w_in = (const float*)d_in[9]; p.pool_mix = (const float*)d_in[10]; p.pool_scale = (const float*)d_in[11];
    p.q_norm_g = (const float*)d_in[12]; p.w_uq = (const float*)d_in[13]; p.kv_norm_g = (const float*)d_in[14]; p.w_uk = (const float*)d_in[15];
    p.w_uv = (const float*)d_in[16]; p.conv_w = (const float*)d_in[17]; p.a_log = (const float*)d_in[18]; p.dt_bias = (const float*)d_in[19];
    p.dn_norm_g = (const float*)d_in[20]; p.w_br0 = (const float*)d_in[21]; p.w_br1 = (const float*)d_in[22]; p.w_br2 = (const float*)d_in[23];
    p.w_out = (const float*)d_in[24]; p.final_norm_g = (const float*)d_in[25];
    p.out = (float*)d_out;
    char* w = (char*)d_ws; size_t off = 0;
    auto take = [&](size_t bytes) { char* q = w + off; off += al256(bytes); return q; };
    const size_t BAR_BYTES = (size_t)16 * XCD_BAR_WORDS * 4;
    p.bar = (unsigned*)take(BAR_BYTES);
    p.WinT = (bf16_t*)take((size_t)2 * IN_WP * 1024 * 2);
    p.WuqT = (bf16_t*)take((size_t)2 * 768 * 384 * 2);
    p.WkvT = (bf16_t*)take((size_t)2 * 1024 * 256 * 2);
    p.WbrT = (bf16_t*)take((size_t)2 * 3 * 1024 * 512 * 2);
    p.WoutT = (bf16_t*)take((size_t)2 * 1024 * 1024 * 2);
    p.PmixT = (bf16_t*)take((size_t)2 * 4 * 128 * 128 * 2);
    p.tab = (float2*)take((size_t)(SEQ + DEC_SEQ) * 16 * 8);
    p.xres = (float*)take((size_t)TT * 1024 * 4);
    p.xn = (bf16_t*)take((size_t)TT * 1024 * 2);
    p.H = (bf16_t*)take((size_t)TT * IN_WP * 2);
    p.BA = (float*)take((size_t)TT * 16 * 4);
    p.cq = (bf16_t*)take((size_t)TT * 384 * 2);
    p.ckv = (bf16_t*)take((size_t)TT * 256 * 2);
    p.Kr = (bf16_t*)take((size_t)TT * 32 * 2);
    p.Q = (bf16_t*)take((size_t)TT * 768 * 2);
    bf16_t* Qlat = (bf16_t*)take((size_t)TS * 8 * 288 * 2);
    p.Kn = (bf16_t*)take((size_t)TP * 512 * 2);
    p.V = (bf16_t*)take((size_t)TP * 512 * 2);
    p.Vt = (bf16_t*)take((size_t)512 * TP * 2);
    p.qd = (bf16_t*)take((size_t)TT * 512 * 2);
    p.kd = (bf16_t*)take((size_t)TT * 512 * 2);
    p.vd = (bf16_t*)take((size_t)TT * 512 * 2);
    p.bg = (float*)take((size_t)TT * 16 * 4);
    p.ya = (bf16_t*)take((size_t)TT * 1536 * 2); p.yb = p.ya + 512; p.yc = p.ya + 1024;
    p.mf = (float*)take((size_t)TT * 1024 * 4);
    p.mb = (bf16_t*)take((size_t)TT * 1024 * 2);
    p.part = (float*)take((size_t)DEC_BATCH * SA_CH * 64 * 258 * 4);
    p.DOP = (bf16_t*)take((size_t)2048 * 4 * 4096 * 2);
    p.DU = (float*)take((size_t)2048 * 4096 * 4);
    p.DG = (float*)take((size_t)2048 * 4);

    (void)hipMemsetAsync(p.bar, 0, BAR_BYTES, stream);
    p.ph_lo = 0; p.ph_hi = PH_END; p.li = 0; p.pad = 15;
    hipLaunchKernelGGL(k_mega, dim3(grid), dim3(NTHR), LDS_BYTES, stream, p);
#if defined(PROBE_REP) && PROBE_REP > 0
    for (int i = 0; i < PROBE_REP; ++i) { Params q = p; q.ph_lo = PROBE_LO; q.ph_hi = PROBE_HI; q.li = 1 + i; q.pad = PROBE_MASK; hipLaunchKernelGGL(k_mega, dim3(grid), dim3(NTHR), LDS_BYTES, stream, q); }
#endif
}
```

```cpp
#include <hip/hip_runtime.h>
#include <stdint.h>

typedef unsigned short bf16_t;

#define D_MODEL 1024
#define TP 16384
#define TS 256
#define TT (TP + TS)
#define SEQ 2048
#define DEC_SEQ 8
#define DEC_BATCH 32
#define PAST_LEN 16384
#define PAGE 128
#define N_PAGES 128
#define N_POOL 5120
#define IN_W 7344
#define IN_WP 7424
#define C_POOL 0
#define C_ZPOOL 512
#define C_Q 1024
#define C_KV 1408
#define C_KR 1664
#define C_ZMLA 1696
#define C_QKV 2208
#define C_ZDN 3744
#define C_BETA 4256
#define C_ALPHA 4264
#define C_GATE 4272
#define EPS 1e-6f
#define MLA_SCALE 0.10206207261596577f
#define ATT_C 0.14724444831554004f

#define O_YP 0
#define O_YS (O_YP + 16777216)
#define O_PKV (O_YS + 262144)
#define O_PKR (O_PKV + 8388608)
#define O_PPOOL (O_PKR + 1048576)
#define O_PCONV (O_PPOOL + 122880)
#define O_PDELTA (O_PCONV + 73728)
#define O_SKV (O_PDELTA + 524288)
#define O_SKR (O_SKV + 131072)
#define O_SPOOL (O_SKR + 16384)
#define O_SCONV (O_SPOOL + 491520)
#define O_SDELTA (O_SCONV + 294912)
#define O_END (O_SDELTA + 2097152)

__device__ __forceinline__ float bf2f(bf16_t b) { return __uint_as_float(((unsigned)b) << 16); }
__device__ __forceinline__ bf16_t f2bf(float f) { unsigned u = __float_as_uint(f); u += 0x7FFFu + ((u >> 16) & 1u); return (bf16_t)(u >> 16); }
__device__ __forceinline__ float sigmoidf_(float v) { return 1.0f / (1.0f + __expf(-v)); }
__device__ __forceinline__ float siluf_(float v) { return v / (1.0f + __expf(-v)); }
__device__ __forceinline__ float wave_sum(float v) {
#pragma unroll
    for (int o = 32; o >= 1; o >>= 1) v += __shfl_xor(v, o);
    return v;
}

#define SA_CH 8
namespace pg8 {
#define PG8_LAS __attribute__((address_space(3)))
typedef unsigned short bf16_t;
typedef short bf16x8 __attribute__((ext_vector_type(8)));
typedef float f32x4 __attribute__((ext_vector_type(4)));
typedef unsigned u32x4 __attribute__((ext_vector_type(4)));
constexpr int BM = 256, BK = 64, HALF = 128, HTB = HALF * BK * 2  , STAGE_BYTES = 8 * HTB, NXCD = 8, WGM = 8;

__host__ __device__ __forceinline__ int lds_byte(int r, int c) { const int st = (r >> 4) * 2 + (c >> 5), rr = r & 15, cc = c & 31, ob = rr * 64 + cc * 2; return st * 1024 + (ob ^ (((ob >> 9) & 1) << 5)); }
__host__ __device__ __forceinline__ void stage_rc(int b, int& R, int& C) { const int st = b / 1024, sb = b % 1024, swz = sb ^ (((sb >> 9) & 1) << 5); R = (st >> 1) * 16 + swz / 64; C = (st & 1) * 32 + (swz % 64) / 2; }
__host__ __device__ __forceinline__ int perm32(int rho) { const int n = rho >> 4, i = rho & 15; return 8 * (i >> 2) + 4 * n + (i & 3); }

struct Unit { int pm, pn; };
struct Gemm { const bf16_t* A; const bf16_t* Bt; int M, N, K; };

struct StaticOrder {
    int nM, nN, nwg, G, c;
    __host__ __device__ void init(int M, int N, int G_, int c_) { nM = M / BM; nN = N / BM; nwg = nM * nN; G = G_; c = c_; }
    __host__ __device__ bool next(int i, Unit& u) const {
        const long L = (long)i * G + c; if (L >= nwg) return false;
        int wgid = (int)L; { const int q = nwg / NXCD, r = nwg % NXCD, xcd = wgid % NXCD, off = wgid / NXCD; wgid = (xcd < r ? xcd * (q + 1) : r * (q + 1) + (xcd - r) * q) + off; }
        const int nig = WGM * nN, gid = wgid / nig, fm = gid * WGM, gsz = (nM - fm) < WGM ? (nM - fm) : WGM;
        u.pm = fm + ((wgid % nig) % gsz); u.pn = (wgid % nig) / gsz; return true;
    }
    __device__ __forceinline__ void a_ready(const Unit&) const {}
    __device__ __forceinline__ void done(const Unit&) const {}
};
typedef __bf16 bf16n2 __attribute__((ext_vector_type(2)));
__device__ __forceinline__ unsigned cvt_pk_bf16(float lo, float hi) { typedef float f2_ __attribute__((ext_vector_type(2))); const f2_ v = {lo, hi}; return __builtin_bit_cast(unsigned, __builtin_convertvector(v, bf16n2)); }
typedef float f32x2 __attribute__((ext_vector_type(2)));
template <class Epi, class Sched, bool STAMP = false>
__device__ __forceinline__ void gemm_phase(PG8_LAS unsigned char* lds, const Gemm g, const Sched& S, const Epi& E, unsigned long long* stamps) {
    int tid_ = threadIdx.x; asm volatile("" : "+v"(tid_));
    const int tid = tid_, wid = __builtin_amdgcn_readfirstlane(tid >> 6), lane = tid & 63, wr = wid >> 2, wc = wid & 3, fr = lane & 15, fq = lane >> 4;
    int K_ = g.K; asm volatile("" : "+s"(K_));
    const int K = K_, nt = K / BK;
    int ts_lo = 0, ts_hi = 0, nts = 0; const unsigned long long rt_entry = STAMP ? (unsigned long long)wall_clock64() : 0ull;
#define PG8_STAMP() do { if (STAMP && wid == 0 && nts < 64) { const unsigned long long _c = (unsigned long long)clock64(); \
        ts_lo = (lane == nts) ? (int)(unsigned)_c : ts_lo; ts_hi = (lane == nts) ? (int)(unsigned)(_c >> 32) : ts_hi; ++nts; } } while (0)
    PG8_STAMP();
    unsigned voffA[2], voffB[2];
#pragma unroll
    for (int i = 0; i < 2; ++i) { int R, C; stage_rc(tid * 16 + i * 8192, R, C); const int Rb = Epi::PERM ? ((R & ~31) + perm32(R & 31)) : R;
        voffA[i] = (unsigned)(R * K + C) * 2u; voffB[i] = (unsigned)(Rb * K + C) * 2u; }
    const size_t kstep = (size_t)(BK * 2);
    const size_t hstep = (size_t)HALF * K * 2;
    const size_t tstep = 2 * hstep;
    const unsigned ldsw = (unsigned)wid * 1024u;
    const int aoff = lds_byte(wr * 64 + fr, fq * 8), boff = lds_byte(wc * 32 + fr, fq * 8);
#define PG8_SA(b, h) (((b) * 2 + (h)) * HTB)
#define PG8_SB(b, h) ((4 + (b) * 2 + (h)) * HTB)
#define PG8_STAGE(bufoff, gbase, voff) do { _Pragma("unroll") for (int _i = 0; _i < 2; ++_i) \
        __builtin_amdgcn_global_load_lds((const unsigned*)((const char*)(gbase) + (voff)[_i]), (PG8_LAS unsigned*)(lds + (bufoff) + ldsw + _i * 8192), 16, 0, 0); } while (0)
#define PG8_LDA(dst, b, h) do { _Pragma("unroll") for (int m = 0; m < 4; ++m) _Pragma("unroll") for (int k = 0; k < 2; ++k) dst[m][k] = *(const PG8_LAS bf16x8*)(lds + PG8_SA(b, h) + aoff + m * 2048 + k * 1024); } while (0)
#define PG8_LDB(dst, b, h) do { _Pragma("unroll") for (int n = 0; n < 2; ++n) _Pragma("unroll") for (int k = 0; k < 2; ++k) dst[n][k] = *(const PG8_LAS bf16x8*)(lds + PG8_SB(b, h) + boff + n * 2048 + k * 1024); } while (0)
#define PG8_MMA(ai, bj, At, Bt) do { __builtin_amdgcn_s_setprio(1); _Pragma("unroll") for (int m = 0; m < 4; ++m) _Pragma("unroll") for (int n = 0; n < 2; ++n) _Pragma("unroll") for (int k = 0; k < 2; ++k) \
        acc[ai][bj][m][n] = __builtin_amdgcn_mfma_f32_16x16x32_bf16(Bt[n][k], At[m][k], acc[ai][bj][m][n], 0, 0, 0); __builtin_amdgcn_s_setprio(0); } while (0)
#define PG8_WAIT_V(n) asm volatile("s_waitcnt vmcnt(" #n ")" ::: "memory")
#define PG8_WAIT_L(n) asm volatile("s_waitcnt lgkmcnt(" #n ")" ::: "memory")
#define PG8_BAR __builtin_amdgcn_s_barrier()
#define PG8_SCHED __builtin_amdgcn_sched_barrier(0)
    Unit cur, nxt; int ui = 0;
    if (!S.next(0, cur)) return;
    f32x4 acc[2][2][4][2];
#pragma unroll
    for (int a = 0; a < 2; ++a)
#pragma unroll
        for (int b = 0; b < 2; ++b)
#pragma unroll
            for (int m = 0; m < 4; ++m)
#pragma unroll
                for (int n = 0; n < 2; ++n) acc[a][b][m][n] = (f32x4){0.f, 0.f, 0.f, 0.f};
    bf16x8 At[4][2], B0[2][2], B1[2][2];
    const char* cA = (const char*)g.A + (size_t)cur.pm * tstep; const char* cB = (const char*)g.Bt + (size_t)cur.pn * tstep;
    S.a_ready(cur);
    PG8_STAGE(PG8_SB(0, 0), cB, voffB); PG8_STAGE(PG8_SA(0, 0), cA, voffA); PG8_STAGE(PG8_SB(0, 1), cB + hstep, voffB); PG8_STAGE(PG8_SA(0, 1), cA + hstep, voffA);
    if (wr == 1) PG8_BAR;
    PG8_WAIT_V(4); PG8_BAR;
    PG8_STAGE(PG8_SB(1, 0), cB + kstep, voffB); PG8_STAGE(PG8_SA(1, 0), cA + kstep, voffA); PG8_STAGE(PG8_SB(1, 1), cB + hstep + kstep, voffB);
    PG8_WAIT_V(6); PG8_BAR;
    PG8_STAMP();
    for (;;) {
        const bool has_next = S.next(ui + 1, nxt);
        const char* nA = has_next ? (const char*)g.A + (size_t)nxt.pm * tstep : cA; const char* nB = has_next ? (const char*)g.Bt + (size_t)nxt.pn * tstep : cB;
_Pragma("nounroll")
        for (int t = 0; t < nt; t += 2) {
            const bool last = (t == nt - 2);
            const char* a1 = cA + (size_t)(t + 1) * kstep;
            const char* a2 = last ? nA : cA + (size_t)(t + 2) * kstep; const char* b2 = last ? nB : cB + (size_t)(t + 2) * kstep;
            const char* a3 = a2 + kstep; const char* b3 = b2 + kstep;
            if (last && has_next) S.a_ready(nxt);
            if constexpr (Epi::SEG > 0) { if (t != 0 && (t % Epi::SEG) == 0) E.mid(acc, cur, wr, wc, fr, fq, t / Epi::SEG); }
            PG8_LDB(B0, 0, 0); PG8_SCHED; PG8_LDA(At, 0, 0); PG8_STAGE(PG8_SA(1, 1), a1 + hstep, voffA);
            PG8_WAIT_L(8); PG8_BAR; PG8_WAIT_L(0); PG8_MMA(0, 0, At, B0); PG8_BAR; PG8_SCHED;
            PG8_LDB(B1, 0, 1); PG8_STAGE(PG8_SB(0, 0), b2, voffB);
            PG8_BAR; PG8_WAIT_L(0); PG8_MMA(0, 1, At, B1); PG8_BAR;
            PG8_LDA(At, 0, 1); PG8_STAGE(PG8_SA(0, 0), a2, voffA);
            PG8_BAR; PG8_WAIT_L(0); PG8_MMA(1, 0, At, B0); PG8_BAR; PG8_SCHED;
            PG8_STAGE(PG8_SB(0, 1), b2 + hstep, voffB);
            PG8_WAIT_V(6); PG8_BAR; PG8_MMA(1, 1, At, B1); PG8_BAR;
            PG8_LDB(B0, 1, 0); PG8_SCHED; PG8_LDA(At, 1, 0); PG8_STAGE(PG8_SA(0, 1), a2 + hstep, voffA);
            PG8_WAIT_L(8); PG8_BAR; PG8_WAIT_L(0); PG8_MMA(0, 0, At, B0); PG8_BAR; PG8_SCHED;
            PG8_LDB(B1, 1, 1); PG8_STAGE(PG8_SB(1, 0), b3, voffB);
            PG8_BAR; PG8_WAIT_L(0); PG8_MMA(0, 1, At, B1); PG8_BAR;
            PG8_LDA(At, 1, 1); PG8_STAGE(PG8_SA(1, 0), a3, voffA);
            PG8_BAR; PG8_WAIT_L(0); PG8_MMA(1, 0, At, B0); PG8_BAR; PG8_SCHED;
            PG8_STAGE(PG8_SB(1, 1), b3 + hstep, voffB);
            PG8_WAIT_V(6); PG8_BAR; PG8_MMA(1, 1, At, B1); PG8_BAR;
        }
        PG8_STAMP();
        if constexpr (!Epi::AFTER_DRAIN) { E(acc, cur, wr, wc, fr, fq); S.done(cur); }
        PG8_STAMP();
        if (!has_next) break;
#pragma unroll
        for (int a = 0; a < 2; ++a)
#pragma unroll
            for (int b = 0; b < 2; ++b)
#pragma unroll
                for (int m = 0; m < 4; ++m)
#pragma unroll
                    for (int n = 0; n < 2; ++n) acc[a][b][m][n] = (f32x4){0.f, 0.f, 0.f, 0.f};
        cur = nxt; cA = nA; cB = nB; ++ui;
    }
    PG8_WAIT_V(0);
    if (wr == 0) PG8_BAR;
    PG8_BAR;
    if constexpr (Epi::AFTER_DRAIN) { E.fused(acc, cur, wr, wc, fr, fq, lds, wid, lane); S.done(cur); }
    PG8_STAMP();
    if (STAMP && wid == 0) { stamps[lane] = lane < nts ? (((unsigned long long)(unsigned)ts_hi << 32) | (unsigned)ts_lo) : 0ull;
        if (lane == 62) stamps[62] = rt_entry; if (lane == 63) stamps[63] = (unsigned long long)wall_clock64(); }
#undef PG8_STAMP
#undef PG8_SA
#undef PG8_SB
#undef PG8_STAGE
#undef PG8_LDA
#undef PG8_LDB
#undef PG8_MMA
#undef PG8_WAIT_V
#undef PG8_WAIT_L
#undef PG8_BAR
#undef PG8_SCHED
}

}
#define XB_TMO      128
#define XB_XCNT(j)  (256  + 64 * (j))
#define XB_XSUB(j)  (1280 + 64 * (j))
#define XB_XGEN(j)  (2304 + 64 * (j))
#define XB_TOP      3328
#define XB_TOPGEN   3392
#define XCD_BAR_WORDS 3456
#define XB_SPIN_CAP (1u << 18)
#define LAS __attribute__((address_space(3)))

__device__ __forceinline__ unsigned xb_ld(unsigned* p)              { return __hip_atomic_load(p, __ATOMIC_RELAXED, __HIP_MEMORY_SCOPE_AGENT); }
__device__ __forceinline__ unsigned xb_add(unsigned* p, unsigned v) { return __hip_atomic_fetch_add(p, v, __ATOMIC_RELAXED, __HIP_MEMORY_SCOPE_AGENT); }
__device__ __forceinline__ unsigned xb_xcc_id() { return (unsigned)__builtin_amdgcn_s_getreg((3 << 11) | 20) & 0xFu; }
#define XB_SPIN(cond, bar) do { unsigned _sp = 0; while (cond) { __builtin_amdgcn_s_sleep(1); \
    if ((++_sp & 255u) == 0u) { if (xb_ld(&(bar)[XB_TMO])) break; if (_sp > XB_SPIN_CAP) { atomicAdd(&(bar)[XB_TMO], 1u); break; } } } } while (0)

struct XcdBarrier {
    unsigned* bar; unsigned x;
    volatile LAS unsigned* st;
};

__device__ __forceinline__ XcdBarrier xcd_barrier_post(unsigned* bar, volatile LAS unsigned* st) {
    XcdBarrier b; b.bar = bar; b.x = xb_xcc_id(); b.st = st;
    if (threadIdx.x == 0) (void)xb_add(&bar[XB_XCNT(b.x)], 1u);
    return b;
}
__device__ __forceinline__ void xcd_barrier_complete(unsigned* bar, unsigned x, unsigned& nloc, unsigned& nx) {
    const unsigned G = gridDim.x * gridDim.y * gridDim.z;
    unsigned sum, cnt, mine, sp = 0u;
    for (;;) {
        sum = 0u; cnt = 0u; mine = 0u;
#pragma unroll
        for (unsigned j = 0; j < 16; ++j) { const unsigned c = xb_ld(&bar[XB_XCNT(j)]); sum += c; cnt += (c > 0u) ? 1u : 0u; mine = (j == x) ? c : mine; }
        if (sum == G) break;
        __builtin_amdgcn_s_sleep(1);
        if ((++sp & 255u) == 0u) { if (xb_ld(&bar[XB_TMO])) break; if (sp > XB_SPIN_CAP) { atomicAdd(&bar[XB_TMO], 1u); break; } }
    }
    nloc = mine > 0u ? mine : 1u; nx = cnt > 0u ? cnt : 1u;
}

__device__ __forceinline__ void xcd_barrier(const XcdBarrier& b) {
    asm volatile("s_waitcnt vmcnt(0)" ::: "memory");
    __syncthreads();
    if (threadIdx.x == 0) {
        unsigned* bar = b.bar;
        __builtin_amdgcn_s_waitcnt(0);
        unsigned nloc = b.st[0], nx = b.st[1];
        if (nloc == 0u) { xcd_barrier_complete(bar, b.x, nloc, nx); b.st[0] = nloc; b.st[1] = nx; }
        const unsigned old = xb_add(&bar[XB_XSUB(b.x)], 1u);
        const unsigned gen = old / nloc;
        if (old + 1u == (gen + 1u) * nloc) {
            __builtin_amdgcn_fence(__ATOMIC_RELEASE, "agent");
            asm volatile("s_waitcnt vmcnt(0)" ::: "memory");
            const unsigned og = xb_add(&bar[XB_TOP], 1u);
            const unsigned tg = og / nx;
            if (og + 1u == (tg + 1u) * nx) xb_add(&bar[XB_TOPGEN], 1u);
            else XB_SPIN(xb_ld(&bar[XB_TOPGEN]) == tg, bar);
            __builtin_amdgcn_fence(__ATOMIC_ACQUIRE, "agent");
            xb_add(&bar[XB_XGEN(b.x)], 1u);
            asm volatile("s_waitcnt vmcnt(0)" ::: "memory");
        } else {
            XB_SPIN(xb_ld(&bar[XB_XGEN(b.x)]) == gen, bar);
            __builtin_amdgcn_fence(__ATOMIC_ACQUIRE, "agent");
            asm volatile("s_waitcnt vmcnt(0)" ::: "memory");
        }
    }
    __syncthreads();
}


#define LAS __attribute__((address_space(3)))
typedef float f32x4 __attribute__((ext_vector_type(4)));
typedef unsigned u32x4 __attribute__((ext_vector_type(4)));
typedef unsigned u32x2 __attribute__((ext_vector_type(2)));
typedef float f32x2 __attribute__((ext_vector_type(2)));
typedef short bf16x8_t __attribute__((ext_vector_type(8)));
typedef float f32x16 __attribute__((ext_vector_type(16)));
constexpr int NTHR = 512;
constexpr int LDS_BYTES = 147456;
constexpr int LDS_MISC = LDS_BYTES - 256;

struct Params {
    const float *x_prompt, *x_sample, *cache_kv, *cache_kr, *state_pool, *state_conv, *state_delta; const int* page_table;
    const float *norm_g, *w_in, *pool_mix, *pool_scale, *q_norm_g, *w_uq, *kv_norm_g, *w_uk, *w_uv, *conv_w, *a_log, *dt_bias, *dn_norm_g, *w_br0, *w_br1, *w_br2, *w_out, *final_norm_g;
    float* out;
    bf16_t *WinT, *WuqT, *WkvT, *WbrT, *WoutT, *PmixT; float2* tab;
    float* xres; bf16_t* xn; bf16_t* H; float* BA; bf16_t *cq, *ckv, *Kr, *Q, *Kn, *V, *Vt, *qd, *kd, *vd; float* bg; bf16_t *ya, *yb, *yc; float* mf; bf16_t* mb; float* part; bf16_t* DOP; float* DU; float* DG;
    unsigned* bar;
    int ph_lo, ph_hi, li, pad;
};

typedef const __attribute__((address_space(4))) Params* KP;

constexpr int PH_PRO = 0;
constexpr int PH_L = 8;
constexpr int PH_GIN = 0, PH_TOK = 1, PH_GQ = 2, PH_ATT = 3, PH_FIN = 4, PH_MERGE = 5, PH_OUT = 6, PH_NORM = 7;
#define PHID(l, k) (1 + (l) * PH_L + (k))
constexpr int PH_END = 1 + 2 * PH_L;

__device__ __forceinline__ void unpack8(const u32x4 v, float (&f)[8]) {
    f[0] = __uint_as_float(v.x << 16); f[1] = __uint_as_float(v.x & 0xffff0000u); f[2] = __uint_as_float(v.y << 16); f[3] = __uint_as_float(v.y & 0xffff0000u);
    f[4] = __uint_as_float(v.z << 16); f[5] = __uint_as_float(v.z & 0xffff0000u); f[6] = __uint_as_float(v.w << 16); f[7] = __uint_as_float(v.w & 0xffff0000u); }
__device__ __forceinline__ u32x4 pack8(const float (&f)[8]) { u32x4 w; w.x = pg8::cvt_pk_bf16(f[0], f[1]); w.y = pg8::cvt_pk_bf16(f[2], f[3]); w.z = pg8::cvt_pk_bf16(f[4], f[5]); w.w = pg8::cvt_pk_bf16(f[6], f[7]); return w; }
struct MEpiH { static constexpr bool PERM = true, AFTER_DRAIN = false; static constexpr int SEG = 0; bf16_t* H; float* BA;
    __device__ __forceinline__ void operator()(const f32x4 (&acc)[2][2][4][2], const pg8::Unit& u, int wr, int wc, int fr0, int fq0) const {
        int fr = fr0, fq = fq0; asm volatile("" : "+v"(fr), "+v"(fq));
        const int row0 = u.pm * 256 + wr * 64 + fr;
#pragma unroll
        for (int bj = 0; bj < 2; ++bj) {
            const int wcol = u.pn * 256 + bj * 128 + wc * 32, col0 = wcol + 8 * fq;
            const bool plain = (wcol + 32 <= C_ZPOOL) || (wcol >= C_Q && wcol + 32 <= C_ZMLA) || (wcol >= C_QKV && wcol + 32 <= C_ZDN);
            const int act = ((col0 >= C_ZPOOL && col0 < C_Q) || (col0 >= C_ZMLA && col0 < C_QKV) || (col0 >= C_ZDN && col0 < C_BETA)) ? 1 : (col0 >= C_GATE ? 2 : 0);
            const bool isba = (col0 == C_BETA) || (col0 == C_ALPHA);
#pragma unroll
            for (int ai = 0; ai < 2; ++ai)
#pragma unroll
                for (int m = 0; m < 4; ++m) { const int row = row0 + ai * 128 + m * 16; f32x4 v0 = acc[ai][bj][m][0], v1 = acc[ai][bj][m][1];
                    if (!plain) {
                        if (isba) { float* b = BA + (size_t)row * 16 + (col0 - C_BETA); *(f32x4*)b = v0; *(f32x4*)(b + 4) = v1; }
#pragma unroll
                        for (int e = 0; e < 4; ++e) { const float s0 = sigmoidf_(v0[e]), s1 = sigmoidf_(v1[e]);
                            v0[e] = act == 0 ? v0[e] : (act == 1 ? v0[e] * s0 : s0); v1[e] = act == 0 ? v1[e] : (act == 1 ? v1[e] * s1 : s1); }
                    }
                    u32x4 w; w.x = pg8::cvt_pk_bf16(v0[0], v0[1]); w.y = pg8::cvt_pk_bf16(v0[2], v0[3]); w.z = pg8::cvt_pk_bf16(v1[0], v1[1]); w.w = pg8::cvt_pk_bf16(v1[2], v1[3]);
                    *(u32x4*)(H + (size_t)row * IN_WP + col0) = w; }
        }
    } };
struct MEpiQ { static constexpr bool PERM = true, AFTER_DRAIN = false; static constexpr int SEG = 0; bf16_t* Q; const float2* tab;
    __device__ __forceinline__ void operator()(const f32x4 (&acc)[2][2][4][2], const pg8::Unit& u, int wr, int wc, int fr0, int fq0) const {
        int fr = fr0, fq = fq0; asm volatile("" : "+v"(fr), "+v"(fq));
        const int row0 = u.pm * 256 + wr * 64 + fr;
#pragma unroll
        for (int bj = 0; bj < 2; ++bj) {
            const int wcol = u.pn * 256 + bj * 128 + wc * 32, col0 = wcol + 8 * fq;
            const bool rope = (wcol % 96) == 64;
#pragma unroll
            for (int ai = 0; ai < 2; ++ai)
#pragma unroll
                for (int m = 0; m < 4; ++m) { const int row = row0 + ai * 128 + m * 16; f32x4 v0 = acc[ai][bj][m][0], v1 = acc[ai][bj][m][1];
                    if (rope) { const int p = row < TP ? (row & (SEQ - 1)) : SEQ + ((row - TP) & 7); const float2* tp = tab + p * 16 + (fq & 1) * 8; const bool hi = fq >= 2;
#pragma unroll
                        for (int e = 0; e < 4; ++e) { const float o0 = __shfl_xor(v0[e], 32), o1 = __shfl_xor(v1[e], 32); const float2 c0 = tp[e], c1 = tp[4 + e];
                            v0[e] = hi ? (v0[e] * c0.x + o0 * c0.y) : (v0[e] * c0.x - o0 * c0.y); v1[e] = hi ? (v1[e] * c1.x + o1 * c1.y) : (v1[e] * c1.x - o1 * c1.y); } }
                    u32x4 w; w.x = pg8::cvt_pk_bf16(v0[0], v0[1]); w.y = pg8::cvt_pk_bf16(v0[2], v0[3]); w.z = pg8::cvt_pk_bf16(v1[0], v1[1]); w.w = pg8::cvt_pk_bf16(v1[2], v1[3]);
                    *(u32x4*)(Q + (size_t)row * 768 + col0) = w; asm volatile("" ::: "memory"); }
        }
    } };
struct MEpiKV { static constexpr bool PERM = true, AFTER_DRAIN = false; static constexpr int SEG = 0; bf16_t* Kn; bf16_t* V;
    __device__ __forceinline__ void operator()(const f32x4 (&acc)[2][2][4][2], const pg8::Unit& u, int wr, int wc, int fr0, int fq0) const {
        int fr = fr0, fq = fq0; asm volatile("" : "+v"(fr), "+v"(fq));
        const int row0 = u.pm * 256 + wr * 64 + fr; bf16_t* base = u.pn < 2 ? Kn : V; const int cb = (u.pn & 1) * 256;
#pragma unroll
        for (int bj = 0; bj < 2; ++bj) { const int col0 = cb + bj * 128 + wc * 32 + 8 * fq;
#pragma unroll
            for (int ai = 0; ai < 2; ++ai)
#pragma unroll
                for (int m = 0; m < 4; ++m) { const int row = row0 + ai * 128 + m * 16; const f32x4 v0 = acc[ai][bj][m][0], v1 = acc[ai][bj][m][1];
                    u32x4 w; w.x = pg8::cvt_pk_bf16(v0[0], v0[1]); w.y = pg8::cvt_pk_bf16(v0[2], v0[3]); w.z = pg8::cvt_pk_bf16(v1[0], v1[1]); w.w = pg8::cvt_pk_bf16(v1[2], v1[3]);
                    *(u32x4*)(base + (size_t)row * 512 + col0) = w; } }
    } };
template <int BR> struct MEpiMerge { static constexpr bool PERM = true, AFTER_DRAIN = false; static constexpr int SEG = 0; const bf16_t* H; float* mf; bf16_t* mb;
    __device__ __forceinline__ void operator()(const f32x4 (&acc)[2][2][4][2], const pg8::Unit& u, int wr, int wc, int fr0, int fq0) const {
        int fr = fr0, fq = fq0; asm volatile("" : "+v"(fr), "+v"(fq));
        const int row0 = u.pm * 256 + wr * 64 + fr;
#pragma unroll
        for (int bj = 0; bj < 2; ++bj) { const int col0 = u.pn * 256 + bj * 128 + wc * 32 + 8 * fq;
#pragma unroll
            for (int ai = 0; ai < 2; ++ai)
#pragma unroll
                for (int m = 0; m < 4; ++m) { const int row = row0 + ai * 128 + m * 16; f32x4 v0 = acc[ai][bj][m][0], v1 = acc[ai][bj][m][1];
                    const u32x4 g = *(const u32x4*)(H + (size_t)row * IN_WP + C_GATE + BR * 1024 + col0);
                    v0[0] *= __uint_as_float(g.x << 16); v0[1] *= __uint_as_float(g.x & 0xffff0000u); v0[2] *= __uint_as_float(g.y << 16); v0[3] *= __uint_as_float(g.y & 0xffff0000u);
                    v1[0] *= __uint_as_float(g.z << 16); v1[1] *= __uint_as_float(g.z & 0xffff0000u); v1[2] *= __uint_as_float(g.w << 16); v1[3] *= __uint_as_float(g.w & 0xffff0000u);
                    float* mp = mf + (size_t)row * 1024 + col0;
                    if (BR > 0) { v0 += *(const f32x4*)mp; v1 += *(const f32x4*)(mp + 4); }
                    if (BR < 2) { *(f32x4*)mp = v0; *(f32x4*)(mp + 4) = v1; }
                    else { u32x4 w; w.x = pg8::cvt_pk_bf16(v0[0], v0[1]); w.y = pg8::cvt_pk_bf16(v0[2], v0[3]); w.z = pg8::cvt_pk_bf16(v1[0], v1[1]); w.w = pg8::cvt_pk_bf16(v1[2], v1[3]);
                        *(u32x4*)(mb + (size_t)row * 1024 + col0) = w; } asm volatile("" ::: "memory"); } }
    } };
struct MEpiRes { static constexpr bool PERM = false, AFTER_DRAIN = false; static constexpr int SEG = 0; const float* xp; const float* xs; float* xo;
    __device__ __forceinline__ void operator()(const f32x4 (&acc)[2][2][4][2], const pg8::Unit& u, int wr, int wc, int fr0, int fq0) const {
        int fr = fr0, fq = fq0; asm volatile("" : "+v"(fr), "+v"(fq));
        const int row0 = u.pm * 256 + wr * 64 + fr, col0 = u.pn * 256 + wc * 32 + 4 * fq;
#pragma unroll
        for (int ai = 0; ai < 2; ++ai)
#pragma unroll
            for (int m = 0; m < 4; ++m) { const int row = row0 + ai * 128 + m * 16; const float* xr = row < TP ? xp + (size_t)row * 1024 : xs + (size_t)(row - TP) * 1024; float* orow = xo + (size_t)row * 1024;
#pragma unroll
                for (int bj = 0; bj < 2; ++bj)
#pragma unroll
                    for (int n = 0; n < 2; ++n) { const int c = col0 + bj * 128 + n * 16; *(f32x4*)(orow + c) = *(const f32x4*)(xr + c) + acc[ai][bj][m][n]; } }
    } };

template <int NSEG, class Epi>
__device__ __forceinline__ void tail_gemm(const bf16_t* __restrict__ A, int lda, const bf16_t* __restrict__ Bt, int K, int N, const Epi& epi, LAS unsigned char* lds) {
    int tid = threadIdx.x; asm volatile("" : "+v"(tid));
    const int lane = tid & 63, wave = __builtin_amdgcn_readfirstlane(tid >> 6), rt = wave & 3, kh = wave >> 2, n = lane & 15, q = lane >> 4;
    const int ntile = 4 * (N / 16), kseg = K / NSEG, khalf = kseg / 2;
    LAS f32x4* red = (LAS f32x4*)lds;
    for (int tile = blockIdx.x; tile < ntile; tile += gridDim.x) {
        const int r0 = 64 * (tile & 3) + 16 * rt, c0 = 16 * (tile >> 2);
        const bf16_t* ap = A + (size_t)(r0 + n) * lda + 8 * q; const bf16_t* bp = Bt + (size_t)(c0 + n) * K + 8 * q;
        f32x4 acc[NSEG];
#pragma unroll
        for (int sg = 0; sg < NSEG; ++sg) { acc[sg] = (f32x4){0.f, 0.f, 0.f, 0.f};
            const int kb = sg * kseg + kh * khalf;
#pragma unroll 4
            for (int k = 0; k < khalf; k += 32) acc[sg] = __builtin_amdgcn_mfma_f32_16x16x32_bf16(*(const bf16x8_t*)(ap + kb + k), *(const bf16x8_t*)(bp + kb + k), acc[sg], 0, 0, 0); }
        __syncthreads();
        if (kh == 1) {
#pragma unroll
            for (int sg = 0; sg < NSEG; ++sg) red[(rt * NSEG + sg) * 64 + lane] = acc[sg]; }
        __syncthreads();
        if (kh == 0) {
#pragma unroll
            for (int sg = 0; sg < NSEG; ++sg) acc[sg] += red[(rt * NSEG + sg) * 64 + lane];
#pragma unroll
            for (int e = 0; e < 4; ++e) { float v[NSEG];
#pragma unroll
                for (int sg = 0; sg < NSEG; ++sg) v[sg] = acc[sg][e];
                epi(r0 + 4 * q + e, c0 + n, v); } }
    }
    __syncthreads();
}
struct TEpiMerge { const bf16_t* H; bf16_t* mb;
    __device__ __forceinline__ void operator()(int row, int col, const float (&v)[3]) const { const size_t t = (size_t)TP + row; const bf16_t* g = H + t * IN_WP + C_GATE + col;
        mb[t * 1024 + col] = f2bf(bf2f(g[0]) * v[0] + bf2f(g[1024]) * v[1] + bf2f(g[2048]) * v[2]); } };
struct TEpiRes { const float* xs; float* xo;
    __device__ __forceinline__ void operator()(int row, int col, const float (&v)[1]) const { xo[((size_t)TP + row) * 1024 + col] = xs[(size_t)row * 1024 + col] + v[0]; } };
struct MEpiMergeS { static constexpr bool PERM = true, AFTER_DRAIN = false; static constexpr int SEG = 8; const bf16_t* H; bf16_t* mb;
    __device__ __forceinline__ void mid(f32x4 (&acc)[2][2][4][2], const pg8::Unit& u, int wr, int wc, int fr0, int fq0, int seg) const {
        int fr = fr0, fq = fq0; asm volatile("" : "+v"(fr), "+v"(fq));
        const int row0 = u.pm * 256 + wr * 64 + fr;
#pragma unroll
        for (int bj = 0; bj < 2; ++bj) { const int col0 = u.pn * 256 + bj * 128 + wc * 32 + 8 * fq;
#pragma unroll
            for (int ai = 0; ai < 2; ++ai)
#pragma unroll
                for (int m = 0; m < 4; ++m) { const int row = row0 + ai * 128 + m * 16; const bf16_t* gp = H + (size_t)row * IN_WP + C_GATE + (seg - 1) * 1024 + col0;
                    float ga[8], gb[8]; unpack8(*(const u32x4*)gp, ga); unpack8(*(const u32x4*)(gp + 1024), gb);
#pragma unroll
                    for (int e = 0; e < 4; ++e) { acc[ai][bj][m][0][e] *= ga[e] * __builtin_amdgcn_rcpf(fmaxf(gb[e], 1e-30f)); acc[ai][bj][m][1][e] *= ga[4 + e] * __builtin_amdgcn_rcpf(fmaxf(gb[4 + e], 1e-30f)); }
                    asm volatile("" ::: "memory"); } }
    }
    __device__ __forceinline__ void operator()(const f32x4 (&acc)[2][2][4][2], const pg8::Unit& u, int wr, int wc, int fr0, int fq0) const {
        int fr = fr0, fq = fq0; asm volatile("" : "+v"(fr), "+v"(fq));
        const int row0 = u.pm * 256 + wr * 64 + fr;
#pragma unroll
        for (int bj = 0; bj < 2; ++bj) { const int col0 = u.pn * 256 + bj * 128 + wc * 32 + 8 * fq;
#pragma unroll
            for (int ai = 0; ai < 2; ++ai)
#pragma unroll
                for (int m = 0; m < 4; ++m) { const int row = row0 + ai * 128 + m * 16; float g[8]; unpack8(*(const u32x4*)(H + (size_t)row * IN_WP + C_GATE + 2048 + col0), g);
                    const f32x4 v0 = acc[ai][bj][m][0], v1 = acc[ai][bj][m][1];
                    u32x4 w; w.x = pg8::cvt_pk_bf16(v0[0] * g[0], v0[1] * g[1]); w.y = pg8::cvt_pk_bf16(v0[2] * g[2], v0[3] * g[3]); w.z = pg8::cvt_pk_bf16(v1[0] * g[4], v1[1] * g[5]); w.w = pg8::cvt_pk_bf16(v1[2] * g[6], v1[3] * g[7]);
                    *(u32x4*)(mb + (size_t)row * 1024 + col0) = w; asm volatile("" ::: "memory"); } }
    } };

__device__ __forceinline__ void ph_tr(const float* __restrict__ src, bf16_t* __restrict__ dst, int K, int N, int Npad, LAS float* tile, int rot, int ldd = 0) {
    if (ldd == 0) ldd = K;
    int tid = threadIdx.x; asm volatile("" : "+v"(tid)); const int G = gridDim.x; const int tn = Npad / 64, tk = K / 32, nt = tn * tk;
    const int first = (blockIdx.x + G - (rot % G)) % G;
    for (int t = first; t < nt; t += G) {
        const int n0 = (t % tn) * 64, k0 = (t / tn) * 32;
        { const int tx = tid & 63, ty = tid >> 6;
#pragma unroll
          for (int i = 0; i < 4; ++i) { const int k = ty + 8 * i, n = n0 + tx; tile[k * 65 + tx] = n < N ? src[(size_t)(k0 + k) * N + n] : 0.f; } }
        __syncthreads();
        { const int kx = tid & 31, ny = tid >> 5;
#pragma unroll
          for (int i = 0; i < 4; ++i) { const int n = ny + 16 * i; dst[(size_t)(n0 + n) * ldd + k0 + kx] = f2bf(tile[kx * 65 + n]); } }
        __syncthreads();
    }
}
__device__ __forceinline__ void ph_rope_tab(float2* tab) {
    for (int idx = blockIdx.x * NTHR + threadIdx.x; idx < (SEQ + DEC_SEQ) * 16; idx += gridDim.x * NTHR) {
        const int p = idx >> 4, i = idx & 15; const int pos = p < SEQ ? p : PAST_LEN + (p - SEQ);
        const float inv = powf(10000.0f, -(float)i / 16.0f); const float ang = (float)pos * inv;
        const double rev = (double)ang * 0.15915494309189533576888; const float f = (float)(rev - floor(rev));
        tab[idx] = make_float2(__builtin_amdgcn_cosf(f), __builtin_amdgcn_sinf(f)); }
}
__device__ __forceinline__ void ph_rmsnorm(const float* __restrict__ xp, const float* __restrict__ xs, const float* __restrict__ g, bf16_t* __restrict__ xn, float* __restrict__ yp, float* __restrict__ ys) {
    int tid_o = threadIdx.x; asm volatile("" : "+v"(tid_o)); int lane = tid_o & 63, wave = tid_o >> 6;
    for (int t = blockIdx.x * 8 + wave; t < TT; t += gridDim.x * 8) {
        const float* x = t < TP ? xp + (size_t)t * 1024 : xs + (size_t)(t - TP) * 1024;
        f32x4 v[4]; float ss = 0.f;
#pragma unroll
        for (int i = 0; i < 4; ++i) { v[i] = *(const f32x4*)(x + i * 256 + lane * 4); ss += v[i][0] * v[i][0] + v[i][1] * v[i][1] + v[i][2] * v[i][2] + v[i][3] * v[i][3]; }
        ss = wave_sum(ss); const float r = rsqrtf(ss * (1.0f / 1024.0f) + EPS);
#pragma unroll
        for (int i = 0; i < 4; ++i) { const int c = i * 256 + lane * 4; const f32x4 gg = *(const f32x4*)(g + c); const f32x4 o = v[i] * r * gg;
            if (xn) { u32x2 w; w.x = pg8::cvt_pk_bf16(o[0], o[1]); w.y = pg8::cvt_pk_bf16(o[2], o[3]); *(u32x2*)(xn + (size_t)t * 1024 + c) = w; }
            else { float* y = t < TP ? yp + (size_t)t * 1024 : ys + (size_t)(t - TP) * 1024; *(f32x4*)(y + c) = o; } }
    }
}

constexpr int TK_RS = 1040;
__device__ __forceinline__ void tok8(KP p, int l, int tbase, int iseq0, bool smp, int sq, int lane) {
    const bf16_t* __restrict__ H = p->H; float* __restrict__ out = p->out;
    { const float* qg = p->q_norm_g + l * 384; const float* kvg = p->kv_norm_g + l * 256;
      u32x4 rq[8], rk[8];
#pragma unroll
      for (int e = 0; e < 8; ++e) { const bf16_t* h = H + (size_t)(tbase + e) * IN_WP;
          rq[e] = lane < 48 ? *(const u32x4*)(h + C_Q + lane * 8) : (u32x4){0u, 0u, 0u, 0u}; rk[e] = lane < 32 ? *(const u32x4*)(h + C_KV + lane * 8) : (u32x4){0u, 0u, 0u, 0u}; }
      f32x4 gq0 = (f32x4){0.f, 0.f, 0.f, 0.f}, gq1 = gq0, gk0 = gq0, gk1 = gq0;
      if (lane < 48) { gq0 = *(const f32x4*)(qg + lane * 8); gq1 = *(const f32x4*)(qg + lane * 8 + 4); }
      if (lane < 32) { gk0 = *(const f32x4*)(kvg + lane * 8); gk1 = *(const f32x4*)(kvg + lane * 8 + 4); }
#pragma unroll
      for (int e = 0; e < 8; ++e) { const int t = tbase + e; float q[8], kv[8]; unpack8(rq[e], q); unpack8(rk[e], kv); float s1 = 0.f, s2 = 0.f;
#pragma unroll
          for (int j = 0; j < 8; ++j) { s1 += q[j] * q[j]; s2 += kv[j] * kv[j]; }
          s1 = wave_sum(s1); s2 = wave_sum(s2); const float r1 = rsqrtf(s1 * (1.0f / 384.0f) + EPS), r2 = rsqrtf(s2 * (1.0f / 256.0f) + EPS);
#pragma unroll
          for (int j = 0; j < 4; ++j) { q[j] *= r1 * gq0[j]; q[4 + j] *= r1 * gq1[j]; kv[j] *= r2 * gk0[j]; kv[4 + j] *= r2 * gk1[j]; }
          if (lane < 48) *(u32x4*)(p->cq + (size_t)t * 384 + lane * 8) = pack8(q);
          if (lane < 32) { float* okv = (smp ? out + O_SKV + ((size_t)l * TS + (t - TP)) * 256 : out + O_PKV + ((size_t)l * TP + t) * 256) + lane * 8;
              *(f32x4*)okv = (f32x4){kv[0], kv[1], kv[2], kv[3]}; *(f32x4*)(okv + 4) = (f32x4){kv[4], kv[5], kv[6], kv[7]};
              *(u32x4*)(p->ckv + (size_t)t * 256 + lane * 8) = pack8(kv); } }
#pragma unroll
      for (int ps = 0; ps < 2; ++ps) { const int e = (lane >> 4) + 4 * ps, j = lane & 15, t = tbase + e; const bf16_t* h = H + (size_t)t * IN_WP;
          const float x1 = bf2f(h[C_KR + j]), x2 = bf2f(h[C_KR + 16 + j]); const float2 cs = p->tab[((smp ? SEQ : 0) + iseq0 + e) * 16 + j];
          const float o1 = x1 * cs.x - x2 * cs.y, o2 = x2 * cs.x + x1 * cs.y; float* okr = smp ? out + O_SKR + ((size_t)l * TS + (t - TP)) * 32 : out + O_PKR + ((size_t)l * TP + t) * 32;
          okr[j] = o1; okr[16 + j] = o2; p->Kr[(size_t)t * 32 + j] = f2bf(o1); p->Kr[(size_t)t * 32 + 16 + j] = f2bf(o2); } }
    { const float* conv_w = p->conv_w + (size_t)l * 4 * 1536; const bool last = smp || (iseq0 == SEQ - 8);
#pragma unroll 1
      for (int pi = 0; pi < 3; ++pi) { const int c0 = (pi * 64 + lane) * 8;
          u32x4 rows[11];
#pragma unroll
          for (int j = 0; j < 11; ++j) { const int u = iseq0 - 3 + j;
              if (u >= 0) rows[j] = *(const u32x4*)(H + (size_t)(tbase - 3 + j) * IN_WP + C_QKV + c0);
              else if (smp) { const float* sc = p->state_conv + (((size_t)l * DEC_BATCH + sq) * 3 + (u + 3)) * 1536 + c0; const f32x4 a = *(const f32x4*)sc, b = *(const f32x4*)(sc + 4);
                  rows[j].x = pg8::cvt_pk_bf16(a[0], a[1]); rows[j].y = pg8::cvt_pk_bf16(a[2], a[3]); rows[j].z = pg8::cvt_pk_bf16(b[0], b[1]); rows[j].w = pg8::cvt_pk_bf16(b[2], b[3]); }
              else rows[j] = (u32x4){0u, 0u, 0u, 0u}; }
          f32x4 w0[4], w1[4];
#pragma unroll
          for (int j = 0; j < 4; ++j) { w0[j] = *(const f32x4*)(conv_w + j * 1536 + c0); w1[j] = *(const f32x4*)(conv_w + j * 1536 + c0 + 4); }
          bf16_t* dst = pi == 0 ? p->qd : (pi == 1 ? p->kd : p->vd);
#pragma unroll
          for (int e = 0; e < 8; ++e) { float y[8];
#pragma unroll
              for (int k = 0; k < 8; ++k) y[k] = 0.f;
#pragma unroll
              for (int j = 0; j < 4; ++j) { float x[8]; unpack8(rows[e + j], x);
#pragma unroll
                  for (int k = 0; k < 4; ++k) { y[k] += x[k] * w0[j][k]; y[4 + k] += x[4 + k] * w1[j][k]; } }
              float ss = 0.f;
#pragma unroll
              for (int k = 0; k < 8; ++k) { y[k] = siluf_(y[k]); ss += y[k] * y[k]; }
              if (pi < 2) { ss += __shfl_xor(ss, 1); ss += __shfl_xor(ss, 2); ss += __shfl_xor(ss, 4); const float rn = rsqrtf(ss + EPS) * (pi == 0 ? 0.125f : 1.0f);
#pragma unroll
                  for (int k = 0; k < 8; ++k) y[k] *= rn; }
              *(u32x4*)(dst + (size_t)(tbase + e) * 512 + lane * 8) = pack8(y); }
          if (last) {
#pragma unroll
              for (int rr = 0; rr < 3; ++rr) { float x[8]; unpack8(rows[8 + rr], x);
                  float* oc = (smp ? out + O_SCONV + (((size_t)l * DEC_BATCH + sq) * 3 + rr) * 1536 : out + O_PCONV + (((size_t)l * 8 + (tbase >> 11)) * 3 + rr) * 1536) + c0;
                  *(f32x4*)oc = (f32x4){x[0], x[1], x[2], x[3]}; *(f32x4*)(oc + 4) = (f32x4){x[4], x[5], x[6], x[7]}; } } } }
    { const int t = tbase + (lane >> 3), hd = lane & 7; const float bb = sigmoidf_(p->BA[(size_t)t * 16 + hd]); const float x = p->BA[(size_t)t * 16 + 8 + hd] + p->dt_bias[l * 8 + hd];
      const float sp = x > 20.f ? x : log1pf(expf(x)); const float gg = -expf(p->a_log[l * 8 + hd]) * sp;
      p->bg[(size_t)t * 16 + hd] = bb; p->bg[(size_t)t * 16 + 8 + hd] = gg; }
}
__device__ __forceinline__ void ph_tok(KP p, int l, LAS unsigned char* lds) {
    int tid = threadIdx.x; asm volatile("" : "+v"(tid));
    const int lane = tid & 63, wave = __builtin_amdgcn_readfirstlane(tid >> 6), r = lane & 31, hh = lane >> 5;
    const bf16_t* __restrict__ H = p->H; float* __restrict__ out = p->out;
    for (int tile = blockIdx.x; tile < TP / 64 + 8; tile += gridDim.x) {
        const bool smp = tile >= TP / 64; const int s0 = smp ? (tile - TP / 64) * 4 : 0;
        const int t0 = smp ? TP + s0 * 8 : tile * 64, i0 = smp ? 0 : (t0 & (SEQ - 1)), b = t0 >> 11;
        __syncthreads();
        if (!smp) {
            for (int c = tid; c < 79 * 64; c += NTHR) { const int row = c >> 6, ch16 = c & 63; u32x4 v = (u32x4){0u, 0u, 0u, 0u};
                if (i0 - 15 + row >= 0) v = *(const u32x4*)(H + (size_t)(t0 - 15 + row) * IN_WP + C_POOL + ch16 * 8);
                *(LAS u32x4*)(lds + row * TK_RS + ch16 * 16) = v; }
        } else {
            for (int c = tid; c < 92 * 64; c += NTHR) { const int row = c >> 6, ch16 = c & 63, sq = row / 23, j = row - sq * 23; u32x4 v;
                if (j >= 15) v = *(const u32x4*)(H + (size_t)(t0 + sq * 8 + (j - 15)) * IN_WP + C_POOL + ch16 * 8);
                else { const float* sp = p->state_pool + (((size_t)l * DEC_BATCH + s0 + sq) * 15 + j) * 512 + ch16 * 8; const f32x4 a = *(const f32x4*)sp, bq = *(const f32x4*)(sp + 4);
                    v.x = pg8::cvt_pk_bf16(a[0], a[1]); v.y = pg8::cvt_pk_bf16(a[2], a[3]); v.z = pg8::cvt_pk_bf16(bq[0], bq[1]); v.w = pg8::cvt_pk_bf16(bq[2], bq[3]);
                    if (j >= 8) { float* so = out + O_SPOOL + (((size_t)l * DEC_BATCH + s0 + sq) * 15 + (j - 8)) * 512 + ch16 * 8; *(f32x4*)so = a; *(f32x4*)(so + 4) = bq; } }
                *(LAS u32x4*)(lds + row * TK_RS + ch16 * 16) = v; }
        }
        __syncthreads();
        if (!(smp && (wave & 1))) { const int g = wave >> 1, th = wave & 1, w = 2 << g, tk = 32 * th + r;
          const int brow = smp ? (tk >> 3) * 23 + 15 + (tk & 7) : 15 + tk; const float inv = 1.0f / (float)(smp ? w : min(i0 + tk + 1, w));
          const bf16_t* mixT = p->PmixT + ((size_t)l * 4 + g) * 128 * 128;
          f32x16 acc[4];
#pragma unroll
          for (int nt = 0; nt < 4; ++nt)
#pragma unroll
              for (int e = 0; e < 16; ++e) acc[nt][e] = 0.f;
#pragma unroll 2
          for (int ks = 0; ks < 8; ++ks) {
              const LAS unsigned char* base = lds + brow * TK_RS + (128 * g + 16 * ks + 8 * hh) * 2;
              float cur[8], sum[8]; unpack8(*(const LAS u32x4*)base, cur);
#pragma unroll
              for (int e = 0; e < 8; ++e) sum[e] = cur[e];
              for (int k = 1; k < w; ++k) { float x[8]; unpack8(*(const LAS u32x4*)(base - k * TK_RS), x);
#pragma unroll
                  for (int e = 0; e < 8; ++e) sum[e] += x[e]; }
#pragma unroll
              for (int e = 0; e < 8; ++e) sum[e] = sum[e] * inv - cur[e];
              union { u32x4 u; bf16x8_t v; } bfr; bfr.u = pack8(sum);
#pragma unroll
              for (int nt = 0; nt < 4; ++nt) { const bf16x8_t a = *(const bf16x8_t*)(mixT + (size_t)(32 * nt + r) * 128 + 16 * ks + 8 * hh);
                  acc[nt] = __builtin_amdgcn_mfma_f32_32x32x16_bf16(a, bfr.v, acc[nt], 0, 0, 0); } }
          const size_t t = (size_t)t0 + tk; const float* scl = p->pool_scale + l * 512 + 128 * g;
#pragma unroll
          for (int nt = 0; nt < 4; ++nt)
#pragma unroll
              for (int gg = 0; gg < 4; ++gg) { const int dd0 = 32 * nt + 8 * gg + 4 * hh; const u32x2 z = *(const u32x2*)(H + t * IN_WP + C_ZPOOL + 128 * g + dd0); const f32x4 sc = *(const f32x4*)(scl + dd0);
                  float v0 = acc[nt][4 * gg + 0] * sc[0] * __uint_as_float(z.x << 16), v1 = acc[nt][4 * gg + 1] * sc[1] * __uint_as_float(z.x & 0xffff0000u);
                  float v2 = acc[nt][4 * gg + 2] * sc[2] * __uint_as_float(z.y << 16), v3 = acc[nt][4 * gg + 3] * sc[3] * __uint_as_float(z.y & 0xffff0000u);
                  u32x2 o; o.x = pg8::cvt_pk_bf16(v0, v1); o.y = pg8::cvt_pk_bf16(v2, v3); *(u32x2*)(p->ya + t * 1536 + 128 * g + dd0) = o; } }
        if (!smp) { if (i0 == SEQ - 64) { for (int c = tid; c < 15 * 512; c += NTHR) { const int rr = c >> 9, ch = c & 511;
              out[O_PPOOL + (((size_t)l * 8 + b) * 15 + rr) * 512 + ch] = bf2f(*(const LAS bf16_t*)(lds + (15 + 49 + rr) * TK_RS + ch * 2)); } } }
        else { for (int c = tid; c < 4 * 8 * 512; c += NTHR) { const int sq = c >> 12, i = (c >> 9) & 7, ch = c & 511;
              out[O_SPOOL + (((size_t)l * DEC_BATCH + s0 + sq) * 15 + 7 + i) * 512 + ch] = bf2f(*(const LAS bf16_t*)(lds + (sq * 23 + 15 + i) * TK_RS + ch * 2)); } }
        if (!smp) tok8(p, l, t0 + wave * 8, i0 + wave * 8, false, 0, lane);
        else if (wave < 4) tok8(p, l, t0 + wave * 8, 0, true, s0 + wave, lane);
    }
    __syncthreads();
}

__device__ __forceinline__ void wu_delta(KP p, int l, int sq, int h, int dv) {
    int row0, L; float* so; float S[64];
    if (sq < 8) { row0 = sq * SEQ; L = SEQ; so = p->out + O_PDELTA + (((size_t)l * 8 + sq) * 8 + h) * 4096;
#pragma unroll
        for (int k = 0; k < 64; ++k) S[k] = 0.f; }
    else { const int s = sq - 8; row0 = TP + s * 8; L = DEC_SEQ; so = p->out + O_SDELTA + (((size_t)l * DEC_BATCH + s) * 8 + h) * 4096;
        const float* s0 = p->state_delta + (((size_t)l * DEC_BATCH + s) * 8 + h) * 4096;
#pragma unroll
        for (int k = 0; k < 64; ++k) S[k] = s0[k * 64 + dv]; }
    const float gn = p->dn_norm_g[l * 64 + dv];
    for (int i = 0; i < L; ++i) {
        const size_t t = (size_t)row0 + i; const u32x4* kp = (const u32x4*)(p->kd + t * 512 + h * 64); const u32x4* qp = (const u32x4*)(p->qd + t * 512 + h * 64);
        const float b = p->bg[t * 16 + h], a = __expf(p->bg[t * 16 + 8 + h]); const float v = bf2f(p->vd[t * 512 + h * 64 + dv]);
        u32x4 kk[8];
#pragma unroll
        for (int c = 0; c < 8; ++c) kk[c] = kp[c];
        float ks = 0.f;
#pragma unroll
        for (int c = 0; c < 8; ++c)
#pragma unroll
            for (int e = 0; e < 4; ++e) { const unsigned w = kk[c][e]; ks += __uint_as_float(w << 16) * S[c * 8 + 2 * e] + __uint_as_float(w & 0xffff0000u) * S[c * 8 + 2 * e + 1]; }
        const float vn = b * (v - a * ks); float o = 0.f;
#pragma unroll
        for (int c = 0; c < 8; ++c) { const u32x4 qv = qp[c];
#pragma unroll
            for (int e = 0; e < 4; ++e) { const unsigned w = kk[c][e], wq = qv[e]; const int k0 = c * 8 + 2 * e;
                S[k0] = a * S[k0] + __uint_as_float(w << 16) * vn; o += __uint_as_float(wq << 16) * S[k0];
                S[k0 + 1] = a * S[k0 + 1] + __uint_as_float(w & 0xffff0000u) * vn; o += __uint_as_float(wq & 0xffff0000u) * S[k0 + 1]; }
            asm volatile("" ::: "memory"); }
        const float ss = wave_sum(o * o); const float y = o * rsqrtf(ss * (1.0f / 64.0f) + EPS) * gn;
        p->yc[t * 1536 + h * 64 + dv] = f2bf(y * bf2f(p->H[t * IN_WP + C_ZDN + h * 64 + dv]));
    }
#pragma unroll
    for (int k = 0; k < 64; ++k) so[k * 64 + dv] = S[k];
}
__device__ __forceinline__ int sig_inv(int rho) { return (rho & 32) | ((rho & 12) << 1) | ((rho & 16) >> 2) | (rho & 3); }
constexpr int DPRE_LDS = 64 * 64 * 4 + 512;
__device__ __forceinline__ void ph_delta_pre(KP p, LAS unsigned char* lds) {
    int tid_o = threadIdx.x; asm volatile("" : "+v"(tid_o)); int lane = tid_o & 63, wave = tid_o >> 6;
    wave = __builtin_amdgcn_readfirstlane(wave);
    LAS float* Am = (LAS float*)(lds + wave * DPRE_LDS); LAS float* gcs = Am + 4096; LAS float* bts = gcs + 64;
    for (int unit = wave * gridDim.x + blockIdx.x; unit < 2048; unit += gridDim.x * 8) {
        { int t_ = threadIdx.x; asm volatile("" : "+v"(t_)); lane = t_ & 63; }
        const int r = lane & 31, hh = lane >> 5;
        const int bh = unit >> 5, ch = unit & 31, b = bh >> 3, h = bh & 7;
        const size_t t0 = (size_t)b * SEQ + ch * 64;
        bf16_t* op = p->DOP + (size_t)unit * 4 * 4096; float* up = p->DU + (size_t)unit * 4096;
        const bf16_t* kdb = p->kd + t0 * 512 + h * 64; const bf16_t* qdb = p->qd + t0 * 512 + h * 64; const bf16_t* vdb = p->vd + t0 * 512 + h * 64;
        const float* bgb = p->bg + t0 * 16 + h;
        const float beta = bgb[lane * 16]; float gc = bgb[lane * 16 + 8];
#pragma unroll
        for (int d = 1; d < 64; d <<= 1) { const float x = __shfl_up(gc, d); if (lane >= d) gc += x; }
        const float gl = __shfl(gc, 63);
        gcs[lane] = gc; bts[lane] = beta;
        if (lane == 0) p->DG[unit] = __expf(gl);
        bf16x8_t kf[2][4], qf[2][4];
        { const int voff = r * 512 + 8 * hh;
#pragma unroll
          for (int rb = 0; rb < 2; ++rb)
#pragma unroll
            for (int ks = 0; ks < 4; ++ks) { kf[rb][ks] = *(const bf16x8_t*)(kdb + (32 * rb * 512 + 16 * ks) + voff); qf[rb][ks] = *(const bf16x8_t*)(qdb + (32 * rb * 512 + 16 * ks) + voff); } }
        {
#pragma unroll
            for (int rb = 0; rb < 2; ++rb) { const float sc = __expf(gl - __shfl(gc, 32 * rb + r)); const int voff = hh * 512 + sig_inv(32 * rb + r);
#pragma unroll
                for (int ks = 0; ks < 4; ++ks) {
#pragma unroll
                    for (int jj = 0; jj < 8; ++jj) (op + 3 * 4096 + (16 * ks + jj) * 64)[voff] = f2bf(bf2f((bf16_t)kf[rb][ks][jj]) * sc);
                    asm volatile("" ::: "memory"); } } }
        f32x16 kk00, kk10, kk11, qk00, qk10, qk11;
#pragma unroll
        for (int e = 0; e < 16; ++e) { kk00[e] = 0.f; kk10[e] = 0.f; kk11[e] = 0.f; qk00[e] = 0.f; qk10[e] = 0.f; qk11[e] = 0.f; }
#pragma unroll
        for (int ks = 0; ks < 4; ++ks) {
            kk00 = __builtin_amdgcn_mfma_f32_32x32x16_bf16(kf[0][ks], kf[0][ks], kk00, 0, 0, 0);
            kk10 = __builtin_amdgcn_mfma_f32_32x32x16_bf16(kf[1][ks], kf[0][ks], kk10, 0, 0, 0);
            kk11 = __builtin_amdgcn_mfma_f32_32x32x16_bf16(kf[1][ks], kf[1][ks], kk11, 0, 0, 0);
            qk00 = __builtin_amdgcn_mfma_f32_32x32x16_bf16(qf[0][ks], kf[0][ks], qk00, 0, 0, 0);
            qk10 = __builtin_amdgcn_mfma_f32_32x32x16_bf16(qf[1][ks], kf[0][ks], qk10, 0, 0, 0);
            qk11 = __builtin_amdgcn_mfma_f32_32x32x16_bf16(qf[1][ks], kf[1][ks], qk11, 0, 0, 0);
        }
        asm volatile("s_waitcnt lgkmcnt(0)" ::: "memory");
        {
            const float gcj0 = __shfl(gc, r), gcj1 = __shfl(gc, 32 + r);
            const int p0 = hh * 256 + sig_inv(r), p1 = hh * 256 + sig_inv(32 + r);
#pragma unroll
            for (int e = 0; e < 16; ++e) { const int ib = (e & 3) + 8 * (e >> 2), il = ib + 4 * hh;
                { const int i = il, j = r; const float gi = gcs[i], bi = bts[i]; const float dec = __expf(fminf(gi - gcj0, 0.f));
                  Am[i * 64 + j] = j < i ? bi * kk00[e] * dec : 0.f; (op + 2 * 4096 + ib * 64)[p0] = f2bf(j <= i ? qk00[e] * dec : 0.f); }
                { const int i = 32 + il, j = r; const float gi = gcs[i], bi = bts[i]; const float dec = __expf(fminf(gi - gcj0, 0.f));
                  Am[i * 64 + j] = bi * kk10[e] * dec; (op + 2 * 4096 + (32 + ib) * 64)[p0] = f2bf(qk10[e] * dec); }
                { const int i = 32 + il, j = 32 + r; const float gi = gcs[i], bi = bts[i]; const float dec = __expf(fminf(gi - gcj1, 0.f));
                  Am[i * 64 + j] = j < i ? bi * kk11[e] * dec : 0.f; (op + 2 * 4096 + (32 + ib) * 64)[p1] = f2bf(j <= i ? qk11[e] * dec : 0.f); }
                asm volatile("" ::: "memory");
            }
        }
        asm volatile("s_waitcnt lgkmcnt(0)" ::: "memory");
        {
            int c; { int t_ = threadIdx.x; asm volatile("" : "+v"(t_)); c = t_ & 63; } const int pc = sig_inv(c);
            const float egc = __expf(gc);
            const int beta_i = __float_as_int(beta), egc_i = __float_as_int(egc);
            { float u[64];
#pragma unroll
              for (int i = 0; i < 64; ++i) { const float bi = __int_as_float(__builtin_amdgcn_readlane(beta_i, i)); u[i] = bi * bf2f((vdb + i * 512)[c]); }
#pragma unroll
              for (int i = 1; i < 64; ++i) { float au = u[i];
#pragma unroll
                  for (int j4 = 0; j4 < i; j4 += 4) { const f32x4 a = *(const LAS f32x4*)(Am + i * 64 + j4);
#pragma unroll
                      for (int e = 0; e < 4; ++e) if (j4 + e < i) au -= a[e] * u[j4 + e]; }
                  u[i] = au; }
#pragma unroll
              for (int i = 0; i < 64; ++i) (up + i * 64)[c] = u[i]; }
            asm volatile("" ::: "memory");
            { float w[64];
#pragma unroll
              for (int i = 0; i < 64; ++i) { const float bi = __int_as_float(__builtin_amdgcn_readlane(beta_i, i)), ei = __int_as_float(__builtin_amdgcn_readlane(egc_i, i));
                  w[i] = bi * ei * bf2f((kdb + i * 512)[c]); (op + 1 * 4096 + i * 64)[pc] = f2bf(bf2f((qdb + i * 512)[c]) * ei); }
#pragma unroll
              for (int i = 1; i < 64; ++i) { float aw = w[i];
#pragma unroll
                  for (int j4 = 0; j4 < i; j4 += 4) { const f32x4 a = *(const LAS f32x4*)(Am + i * 64 + j4);
#pragma unroll
                      for (int e = 0; e < 4; ++e) if (j4 + e < i) aw -= a[e] * w[j4 + e]; }
                  w[i] = aw; }
#pragma unroll
              for (int i = 0; i < 64; ++i) (op + i * 64)[pc] = f2bf(-w[i]); }
        }
        asm volatile("s_waitcnt lgkmcnt(0)" ::: "memory");
    }
}
__device__ __forceinline__ bf16x8_t pack_b(const f32x4& lo, const f32x4& hi) { union { u32x4 u; bf16x8_t v; } x;
    x.u.x = pg8::cvt_pk_bf16(lo[0], lo[1]); x.u.y = pg8::cvt_pk_bf16(lo[2], lo[3]); x.u.z = pg8::cvt_pk_bf16(hi[0], hi[1]); x.u.w = pg8::cvt_pk_bf16(hi[2], hi[3]); return x.v; }
__device__ __forceinline__ void wu_scan(KP p, int l, int bh, int slice, int lane) {
    const int n = lane & 15, q = lane >> 4, n0 = slice * 16, b = bh >> 3, h = bh & 7;
    f32x4 S[4];
#pragma unroll
    for (int t = 0; t < 4; ++t) S[t] = (f32x4){0.f, 0.f, 0.f, 0.f};
    const int foff = n * 64 + 8 * q;
    for (int ch = 0; ch < 32; ++ch) {
        const size_t unit = (size_t)bh * 32 + ch;
        const bf16_t* op = p->DOP + unit * 4 * 4096 + foff; const float* up = p->DU + unit * 4096 + n0 + n;
        const float eg = p->DG[unit];
        f32x4 vn[4]; bf16x8_t wf[4][2], gf[4][2], kf[4][2], tf[4][2];
#pragma unroll
        for (int mt = 0; mt < 4; ++mt) {
#pragma unroll
            for (int e = 0; e < 4; ++e) vn[mt][e] = up[(16 * mt + 4 * q + e) * 64];
#pragma unroll
            for (int ks = 0; ks < 2; ++ks) { const int o = mt * 1024 + ks * 32;
                wf[mt][ks] = *(const bf16x8_t*)(op + o); gf[mt][ks] = *(const bf16x8_t*)(op + 4096 + o);
                kf[mt][ks] = *(const bf16x8_t*)(op + 2 * 4096 + o); tf[mt][ks] = *(const bf16x8_t*)(op + 3 * 4096 + o); } }
        const bf16x8_t sb0 = pack_b(S[0], S[1]), sb1 = pack_b(S[2], S[3]);
        f32x4 o[4];
#pragma unroll
        for (int mt = 0; mt < 4; ++mt) {
            vn[mt] = __builtin_amdgcn_mfma_f32_16x16x32_bf16(wf[mt][0], sb0, vn[mt], 0, 0, 0);
            vn[mt] = __builtin_amdgcn_mfma_f32_16x16x32_bf16(wf[mt][1], sb1, vn[mt], 0, 0, 0);
            o[mt] = __builtin_amdgcn_mfma_f32_16x16x32_bf16(gf[mt][0], sb0, (f32x4){0.f, 0.f, 0.f, 0.f}, 0, 0, 0);
            o[mt] = __builtin_amdgcn_mfma_f32_16x16x32_bf16(gf[mt][1], sb1, o[mt], 0, 0, 0);
        }
        const bf16x8_t vb0 = pack_b(vn[0], vn[1]), vb1 = pack_b(vn[2], vn[3]);
#pragma unroll
        for (int mt = 0; mt < 4; ++mt) {
            o[mt] = __builtin_amdgcn_mfma_f32_16x16x32_bf16(kf[mt][0], vb0, o[mt], 0, 0, 0);
            if (mt >= 2) o[mt] = __builtin_amdgcn_mfma_f32_16x16x32_bf16(kf[mt][1], vb1, o[mt], 0, 0, 0);
            S[mt] = S[mt] * eg;
            S[mt] = __builtin_amdgcn_mfma_f32_16x16x32_bf16(tf[mt][0], vb0, S[mt], 0, 0, 0);
            S[mt] = __builtin_amdgcn_mfma_f32_16x16x32_bf16(tf[mt][1], vb1, S[mt], 0, 0, 0);
        }
        bf16_t* yo = p->yc + ((size_t)b * SEQ + ch * 64) * 1536 + h * 64 + n0 + n;
#pragma unroll
        for (int mt = 0; mt < 4; ++mt)
#pragma unroll
            for (int e = 0; e < 4; ++e) yo[(size_t)(16 * mt + 4 * q + e) * 1536] = f2bf(o[mt][e]);
    }
    float* so = p->out + O_PDELTA + (((size_t)l * 8 + b) * 8 + h) * 4096 + n0 + n;
#pragma unroll
    for (int t = 0; t < 4; ++t)
#pragma unroll
        for (int e = 0; e < 4; ++e) so[(16 * t + 4 * q + e) * 64] = S[t][e];
}
__device__ __forceinline__ void ph_delta_fin(KP p, int l) {
    int tid_o = threadIdx.x; asm volatile("" : "+v"(tid_o)); int lane = tid_o & 63, wave = tid_o >> 6;
    const int h = lane >> 3, d0 = (lane & 7) * 8;
    for (int t = blockIdx.x * 8 + wave; t < TP; t += gridDim.x * 8) {
        bf16_t* yp = p->yc + (size_t)t * 1536 + h * 64 + d0; const u32x4 raw = *(const u32x4*)yp; const u32x4 gz = *(const u32x4*)(p->H + (size_t)t * IN_WP + C_ZDN + h * 64 + d0);
        float v[8]; v[0] = __uint_as_float(raw.x << 16); v[1] = __uint_as_float(raw.x & 0xffff0000u); v[2] = __uint_as_float(raw.y << 16); v[3] = __uint_as_float(raw.y & 0xffff0000u);
        v[4] = __uint_as_float(raw.z << 16); v[5] = __uint_as_float(raw.z & 0xffff0000u); v[6] = __uint_as_float(raw.w << 16); v[7] = __uint_as_float(raw.w & 0xffff0000u);
        float z[8]; z[0] = __uint_as_float(gz.x << 16); z[1] = __uint_as_float(gz.x & 0xffff0000u); z[2] = __uint_as_float(gz.y << 16); z[3] = __uint_as_float(gz.y & 0xffff0000u);
        z[4] = __uint_as_float(gz.z << 16); z[5] = __uint_as_float(gz.z & 0xffff0000u); z[6] = __uint_as_float(gz.w << 16); z[7] = __uint_as_float(gz.w & 0xffff0000u);
        float ss = 0.f;
#pragma unroll
        for (int e = 0; e < 8; ++e) ss += v[e] * v[e];
        ss += __shfl_xor(ss, 1); ss += __shfl_xor(ss, 2); ss += __shfl_xor(ss, 4);
        const float rs = rsqrtf(ss * (1.0f / 64.0f) + EPS);
#pragma unroll
        for (int e = 0; e < 8; ++e) v[e] = v[e] * rs * p->dn_norm_g[l * 64 + d0 + e] * z[e];
        u32x4 w; w.x = pg8::cvt_pk_bf16(v[0], v[1]); w.y = pg8::cvt_pk_bf16(v[2], v[3]); w.z = pg8::cvt_pk_bf16(v[4], v[5]); w.w = pg8::cvt_pk_bf16(v[6], v[7]);
        *(u32x4*)yp = w;
    }
}

__device__ __forceinline__ void ph_att_waves(KP p, int l) {
    int tid_o = threadIdx.x; asm volatile("" : "+v"(tid_o)); int lane = tid_o & 63, wave = tid_o >> 6;
    wave = __builtin_amdgcn_readfirstlane(wave);
    const int G = gridDim.x, NW = G * 8, gw = wave * G + blockIdx.x;
    for (int d = gw; d < 256; d += NW) wu_scan(p, l, d >> 2, d & 3, lane);
    for (int d = NW - 1 - gw; d < 256; d += NW) wu_delta(p, l, 8 + (d >> 3), d & 7, lane);
}
__device__ __forceinline__ void ph_fin(KP p, int l, LAS unsigned char* lds) {
    int tid_o = threadIdx.x; asm volatile("" : "+v"(tid_o)); int lane = tid_o & 63, wave = tid_o >> 6;
    LAS float* ol = (LAS float*)(lds + wave * 2048); LAS float* wgt = ol + 256;
    const float* w_uv = p->w_uv + (size_t)l * 256 * 512;
    for (int u = blockIdx.x * 8 + wave; u < TS * 8; u += gridDim.x * 8) {
        const int ts = u >> 3, h = u & 7, s = ts >> 3, r = (ts & 7) * 8 + h; const int d = lane;
        float M = -1e30f;
        for (int ch = 0; ch < SA_CH; ++ch) M = fmaxf(M, p->part[(((size_t)s * SA_CH + ch) * 64 + r) * 258 + 256]);
        float L = 0.f;
        for (int ch = 0; ch < SA_CH; ++ch) { const float* pp = p->part + (((size_t)s * SA_CH + ch) * 64 + r) * 258; const float w = __expf(pp[256] - M); L += pp[257] * w; if (d == 0) wgt[ch] = w; }
        asm volatile("s_waitcnt lgkmcnt(0)" ::: "memory");
        for (int c = d; c < 256; c += 64) { float a = 0.f; for (int ch = 0; ch < SA_CH; ++ch) a += wgt[ch] * p->part[(((size_t)s * SA_CH + ch) * 64 + r) * 258 + c]; ol[c] = a / L; }
        asm volatile("s_waitcnt lgkmcnt(0)" ::: "memory");
        float a = 0.f;
        for (int c = 0; c < 256; ++c) a += ol[c] * w_uv[(size_t)c * 512 + h * 64 + d];
        const int t = TP + ts;
        p->yb[(size_t)t * 1536 + h * 64 + d] = f2bf(a * bf2f(p->H[(size_t)t * IN_WP + C_ZMLA + h * 64 + d]));
        asm volatile("s_waitcnt lgkmcnt(0)" ::: "memory");
    }
}

constexpr int SA_QS = 592, SA_KS = 576, SA_PS = 272;
constexpr int SA_OFF_Q = 0, SA_OFF_K = 64 * SA_QS, SA_OFF_P = SA_OFF_K + 128 * SA_KS, SA_OFF_M = SA_OFF_P + 64 * SA_PS, SA_OFF_L = SA_OFF_M + 1024, SA_LDS = SA_OFF_L + 1024;
typedef short s16x4 __attribute__((ext_vector_type(4)));
__device__ __forceinline__ void sa_unit(KP p, int l, int s, int ch, LAS unsigned char* lds, int tid) {
    const int lane = tid & 63, wave = __builtin_amdgcn_readfirstlane(tid >> 6), r = lane & 31, hh = lane >> 5;
    const int qb = wave & 1, kb = wave >> 1, cg = wave >> 1;
    LAS unsigned char* Qs = lds + SA_OFF_Q; LAS unsigned char* Kt = lds + SA_OFF_K; LAS unsigned char* Pt = lds + SA_OFF_P;
    LAS float* mloc = (LAS float*)(lds + SA_OFF_M); LAS float* lred = (LAS float*)(lds + SA_OFF_L);
    __syncthreads();
    { const float* w_uk = p->w_uk + (size_t)l * 256 * 512; const bf16_t* Qg = p->Q + (size_t)(TP + s * 8) * 768;
      const int c = tid & 255, h2 = tid >> 8;
      for (int h = h2 * 4; h < h2 * 4 + 4; ++h) { float acc[8];
#pragma unroll
          for (int i = 0; i < 8; ++i) acc[i] = 0.f;
          const float* wr_ = w_uk + (size_t)c * 512 + h * 64;
          for (int d = 0; d < 64; d += 4) { const f32x4 wv = *(const f32x4*)(wr_ + d);
#pragma unroll
              for (int i = 0; i < 8; ++i) { const bf16_t* q = Qg + i * 768 + h * 96 + d;
                  acc[i] += bf2f(q[0]) * wv[0] + bf2f(q[1]) * wv[1] + bf2f(q[2]) * wv[2] + bf2f(q[3]) * wv[3]; } }
#pragma unroll
          for (int i = 0; i < 8; ++i) *(LAS bf16_t*)(Qs + (i * 8 + h) * SA_QS + c * 2) = f2bf(acc[i]); }
      for (int e = tid; e < 64 * 32; e += NTHR) { const int rr = e >> 5, j = e & 31; *(LAS bf16_t*)(Qs + rr * SA_QS + (256 + j) * 2) = Qg[(rr >> 3) * 768 + (rr & 7) * 96 + 64 + j]; } }
    const int* pt = p->page_table + s * N_PAGES + ch * 16;
    const float* ckv_base = p->cache_kv + (size_t)l * N_POOL * PAGE * 256; const float* ckr_base = p->cache_kr + (size_t)l * N_POOL * PAGE * 32;
    f32x4 rk[16], rr2[2];
    { const int page = pt[0]; const float* kvp = ckv_base + (size_t)page * PAGE * 256; const float* krp = ckr_base + (size_t)page * PAGE * 32;
#pragma unroll
      for (int i = 0; i < 16; ++i) rk[i] = __builtin_nontemporal_load((const f32x4*)(kvp + (size_t)(tid + 512 * i) * 4));
#pragma unroll
      for (int i = 0; i < 2; ++i) rr2[i] = __builtin_nontemporal_load((const f32x4*)(krp + (size_t)(tid + 512 * i) * 4)); }
    f32x16 o0, o1;
#pragma unroll
    for (int e = 0; e < 16; ++e) { o0[e] = 0.f; o1[e] = 0.f; }
    float m = -1e30f, lw = 0.f;
    const int li = lane & 15, g1 = (lane >> 4) & 1;
    const int trOff = (8 * hh + (li >> 2)) * SA_KS + (16 * g1 + 4 * (li & 3)) * 2;
    const int ntile = ch == 7 ? 17 : 16;
    for (int t = 0; t < ntile; ++t) {
        __syncthreads();
        if (t < 16) {
#pragma unroll
            for (int i = 0; i < 16; ++i) { const int ci = tid + 512 * i, key = ci >> 6, c4 = ci & 63; u32x2 w; w.x = pg8::cvt_pk_bf16(rk[i][0], rk[i][1]); w.y = pg8::cvt_pk_bf16(rk[i][2], rk[i][3]);
                *(LAS u32x2*)(Kt + key * SA_KS + c4 * 8) = w; }
#pragma unroll
            for (int i = 0; i < 2; ++i) { const int ci = tid + 512 * i, key = ci >> 3, c4 = ci & 7; u32x2 w; w.x = pg8::cvt_pk_bf16(rr2[i][0], rr2[i][1]); w.y = pg8::cvt_pk_bf16(rr2[i][2], rr2[i][3]);
                *(LAS u32x2*)(Kt + key * SA_KS + 512 + c4 * 8) = w; }
        } else {
            for (int e = tid; e < 128 * 36; e += NTHR) { const int key = e / 36, c16 = e - key * 36; u32x4 v = (u32x4){0u, 0u, 0u, 0u};
                if (key < 8) v = c16 < 32 ? *(const u32x4*)(p->ckv + ((size_t)TP + s * 8 + key) * 256 + c16 * 8) : *(const u32x4*)(p->Kr + ((size_t)TP + s * 8 + key) * 32 + (c16 - 32) * 8);
                *(LAS u32x4*)(Kt + key * SA_KS + c16 * 16) = v; }
        }
        __syncthreads();
        if (t + 1 < 16) { const int page = pt[t + 1]; const float* kvp = ckv_base + (size_t)page * PAGE * 256; const float* krp = ckr_base + (size_t)page * PAGE * 32;
#pragma unroll
            for (int i = 0; i < 16; ++i) rk[i] = __builtin_nontemporal_load((const f32x4*)(kvp + (size_t)(tid + 512 * i) * 4));
#pragma unroll
            for (int i = 0; i < 2; ++i) rr2[i] = __builtin_nontemporal_load((const f32x4*)(krp + (size_t)(tid + 512 * i) * 4)); }
        f32x16 sa;
#pragma unroll
        for (int e = 0; e < 16; ++e) sa[e] = 0.f;
        { const LAS unsigned char* ka = Kt + (32 * kb + r) * SA_KS + 16 * hh; const LAS unsigned char* qa = Qs + (32 * qb + r) * SA_QS + 16 * hh;
#pragma unroll
          for (int ks = 0; ks < 18; ++ks) sa = __builtin_amdgcn_mfma_f32_32x32x16_bf16(*(const LAS bf16x8_t*)(ka + ks * 32), *(const LAS bf16x8_t*)(qa + ks * 32), sa, 0, 0, 0); }
        if (t == 16) { const int itok = (32 * qb + r) >> 3;
#pragma unroll
            for (int e = 0; e < 16; ++e) { const int key = 32 * kb + (e & 3) + 8 * (e >> 2) + 4 * hh; if (key > itok) sa[e] = -1e30f; } }
        float tm = sa[0];
#pragma unroll
        for (int e = 1; e < 16; ++e) tm = fmaxf(tm, sa[e]);
        tm = fmaxf(tm, __shfl_xor(tm, 32));
        if (hh == 0) mloc[kb * 64 + 32 * qb + r] = tm;
        __syncthreads();
        { const int q = 32 * qb + r; const float tmx = fmaxf(fmaxf(mloc[q], mloc[64 + q]), fmaxf(mloc[128 + q], mloc[192 + q]));
          const float mn = fmaxf(m, tmx), al = __builtin_amdgcn_exp2f((m - mn) * ATT_C), mc = mn * ATT_C; m = mn;
          float ps = 0.f;
#pragma unroll
          for (int e = 0; e < 16; ++e) { sa[e] = __builtin_amdgcn_exp2f(sa[e] * ATT_C - mc); ps += sa[e]; }
          lw = lw * al + ps;
#pragma unroll
          for (int g4 = 0; g4 < 4; ++g4) { u32x2 w; w.x = pg8::cvt_pk_bf16(sa[4 * g4], sa[4 * g4 + 1]); w.y = pg8::cvt_pk_bf16(sa[4 * g4 + 2], sa[4 * g4 + 3]);
              *(LAS u32x2*)(Pt + q * SA_PS + (32 * kb + 8 * g4 + 4 * hh) * 2) = w; }
#pragma unroll
          for (int e = 0; e < 16; ++e) { o0[e] *= al; o1[e] *= al; } }
        __syncthreads();
        { const LAS unsigned char* pa = Pt + (32 * qb + r) * SA_PS + 16 * hh; const LAS unsigned char* va = Kt + trOff + (64 * cg) * 2;
#pragma unroll
          for (int ks = 0; ks < 8; ++ks) { const bf16x8_t pb = *(const LAS bf16x8_t*)(pa + ks * 32);
              union { struct { s16x4 lo, hi; } h; bf16x8_t v; } a0, a1;
              a0.h.lo = __builtin_amdgcn_ds_read_tr16_b64_v4i16((LAS s16x4*)(va + ks * 16 * SA_KS)); a0.h.hi = __builtin_amdgcn_ds_read_tr16_b64_v4i16((LAS s16x4*)(va + ks * 16 * SA_KS + 4 * SA_KS));
              a1.h.lo = __builtin_amdgcn_ds_read_tr16_b64_v4i16((LAS s16x4*)(va + ks * 16 * SA_KS + 64)); a1.h.hi = __builtin_amdgcn_ds_read_tr16_b64_v4i16((LAS s16x4*)(va + ks * 16 * SA_KS + 4 * SA_KS + 64));
              o0 = __builtin_amdgcn_mfma_f32_32x32x16_bf16(a0.v, pb, o0, 0, 0, 0);
              o1 = __builtin_amdgcn_mfma_f32_32x32x16_bf16(a1.v, pb, o1, 0, 0, 0); } }
    }
    lw += __shfl_xor(lw, 32);
    if (hh == 0) lred[kb * 64 + 32 * qb + r] = lw;
    __syncthreads();
    { const int q = 32 * qb + r; float* pp = p->part + (((size_t)s * SA_CH + ch) * 64 + q) * 258;
#pragma unroll
      for (int cb2 = 0; cb2 < 2; ++cb2)
#pragma unroll
          for (int g4 = 0; g4 < 4; ++g4) { const int c = 32 * (2 * cg + cb2) + 8 * g4 + 4 * hh; f32x4 v;
#pragma unroll
              for (int e = 0; e < 4; ++e) v[e] = cb2 == 0 ? o0[4 * g4 + e] : o1[4 * g4 + e];
              *(f32x2*)(pp + c) = (f32x2){v[0], v[1]}; *(f32x2*)(pp + c + 2) = (f32x2){v[2], v[3]}; }
      if (cg == 0 && hh == 0) { pp[256] = m * MLA_SCALE; pp[257] = lred[q] + lred[64 + q] + lred[128 + q] + lred[192 + q]; } }
}
__device__ __forceinline__ void ph_attn_s2(KP p, int l, LAS unsigned char* lds) {
    int tid = threadIdx.x; asm volatile("" : "+v"(tid));
    for (int u = blockIdx.x; u < DEC_BATCH * 8; u += gridDim.x) sa_unit(p, l, u >> 3, u & 7, lds, tid);
    __syncthreads();
}

constexpr int ATT_KS = 208, ATT_VS = 144, ATT_KB = 64 * ATT_KS, ATT_VB = 64 * ATT_VS, ATT_STAGE = ATT_KB + ATT_VB;
__device__ __forceinline__ void attn_unit(KP p, int b, int h, int qblk, LAS unsigned char* lds, int tid, int wave, int lane) {
    const int r = lane & 31, hh = lane >> 5;
    const int q0 = qblk * 256 + wave * 32;
    const size_t trow0 = (size_t)b * SEQ;
    bf16x8_t qf[6];
    { const bf16_t* qp = p->Q + (trow0 + q0 + r) * 768 + h * 96 + 8 * hh;
#pragma unroll
      for (int ks = 0; ks < 6; ++ks) qf[ks] = *(const bf16x8_t*)(qp + 16 * ks); }
    f32x16 o0, o1;
#pragma unroll
    for (int e = 0; e < 16; ++e) { o0[e] = 0.f; o1[e] = 0.f; }
    float m = -1e30f, lsum = 0.f;
    const int ntile = qblk * 4 + 4;
    const int cA = tid, keyA = cA / 12, partA = cA - keyA * 12; const int cB = 512 + (tid & 255), keyB = cB / 12, partB = cB - keyB * 12; const bool hasB = tid < 256;
    const bf16_t* gA = partA < 8 ? p->Kn + (trow0 + keyA) * 512 + h * 64 + partA * 8 : p->Kr + (trow0 + keyA) * 32 + (partA - 8) * 8; const int stepA = partA < 8 ? 64 * 512 : 64 * 32;
    const bf16_t* gB = partB < 8 ? p->Kn + (trow0 + keyB) * 512 + h * 64 + partB * 8 : p->Kr + (trow0 + keyB) * 32 + (partB - 8) * 8; const int stepB = partB < 8 ? 64 * 512 : 64 * 32;
    const bf16_t* gV = p->Vt + (size_t)(h * 64 + (tid >> 3)) * TP + trow0 + (tid & 7) * 8;
    const int lA = keyA * ATT_KS + partA * 16, lB = keyB * ATT_KS + partB * 16, lV = ATT_KB + (tid >> 3) * ATT_VS + (tid & 7) * 16;
    const int pr_ = (r & 0x13) | ((r & 4) << 1) | ((r & 8) >> 1);
    const int kOff = pr_ * ATT_KS + 16 * hh, vOff = ATT_KB + r * ATT_VS + 16 * hh;
    u32x4 rA = *(const u32x4*)gA, rB = hasB ? *(const u32x4*)gB : (u32x4){0u, 0u, 0u, 0u}, rV = *(const u32x4*)gV;
    for (int kt = 0; kt < ntile; ++kt) {
        LAS unsigned char* st = lds + (kt & 1) * ATT_STAGE;
        *(LAS u32x4*)(st + lA) = rA; if (hasB) *(LAS u32x4*)(st + lB) = rB; *(LAS u32x4*)(st + lV) = rV;
        __syncthreads();
        if (kt + 1 < ntile) { gA += stepA; gB += stepB; gV += 64; rA = *(const u32x4*)gA; if (hasB) rB = *(const u32x4*)gB; rV = *(const u32x4*)gV; }
        if (kt * 64 <= q0 + 31) {
            f32x16 s0, s1;
#pragma unroll
            for (int e = 0; e < 16; ++e) { s0[e] = 0.f; s1[e] = 0.f; }
#pragma unroll
            for (int ks = 0; ks < 6; ++ks) {
                const bf16x8_t a0 = *(const LAS bf16x8_t*)(st + kOff + ks * 32), a1 = *(const LAS bf16x8_t*)(st + kOff + 32 * ATT_KS + ks * 32);
                s0 = __builtin_amdgcn_mfma_f32_32x32x16_bf16(a0, qf[ks], s0, 0, 0, 0);
                s1 = __builtin_amdgcn_mfma_f32_32x32x16_bf16(a1, qf[ks], s1, 0, 0, 0);
            }
            if (kt * 64 + 63 > q0) {
                const int qrel = q0 + r - kt * 64;
#pragma unroll
                for (int e = 0; e < 16; ++e) { const int kl = (e & 3) + 4 * ((e >> 2) & 1) + 8 * hh + 16 * ((e >> 3) & 1);
                    if (kl > qrel) s0[e] = -1e30f; if (kl + 32 > qrel) s1[e] = -1e30f; }
            }
            float tm = fmaxf(s0[0], s1[0]);
#pragma unroll
            for (int e = 1; e < 16; ++e) tm = fmaxf(tm, fmaxf(s0[e], s1[e]));
            tm = fmaxf(tm, __shfl_xor(tm, 32));
            const float mn = fmaxf(m, tm), al = __builtin_amdgcn_exp2f((m - mn) * ATT_C), mc = mn * ATT_C; m = mn;
            float ps = 0.f;
#pragma unroll
            for (int e = 0; e < 16; ++e) { s0[e] = __builtin_amdgcn_exp2f(s0[e] * ATT_C - mc); s1[e] = __builtin_amdgcn_exp2f(s1[e] * ATT_C - mc); ps += s0[e] + s1[e]; }
            lsum = lsum * al + ps;
#pragma unroll
            for (int e = 0; e < 16; ++e) { o0[e] *= al; o1[e] *= al; }
#pragma unroll
            for (int kb = 0; kb < 2; ++kb)
#pragma unroll
                for (int sp = 0; sp < 2; ++sp) {
                    union { u32x4 u; bf16x8_t v; } pb;
                    if (kb == 0) { pb.u.x = pg8::cvt_pk_bf16(s0[8 * sp + 0], s0[8 * sp + 1]); pb.u.y = pg8::cvt_pk_bf16(s0[8 * sp + 2], s0[8 * sp + 3]); pb.u.z = pg8::cvt_pk_bf16(s0[8 * sp + 4], s0[8 * sp + 5]); pb.u.w = pg8::cvt_pk_bf16(s0[8 * sp + 6], s0[8 * sp + 7]); }
                    else         { pb.u.x = pg8::cvt_pk_bf16(s1[8 * sp + 0], s1[8 * sp + 1]); pb.u.y = pg8::cvt_pk_bf16(s1[8 * sp + 2], s1[8 * sp + 3]); pb.u.z = pg8::cvt_pk_bf16(s1[8 * sp + 4], s1[8 * sp + 5]); pb.u.w = pg8::cvt_pk_bf16(s1[8 * sp + 6], s1[8 * sp + 7]); }
                    const int ko = (32 * kb + 16 * sp) * 2;
                    const bf16x8_t v0 = *(const LAS bf16x8_t*)(st + vOff + ko), v1 = *(const LAS bf16x8_t*)(st + vOff + 32 * ATT_VS + ko);
                    o0 = __builtin_amdgcn_mfma_f32_32x32x16_bf16(v0, pb.v, o0, 0, 0, 0);
                    o1 = __builtin_amdgcn_mfma_f32_32x32x16_bf16(v1, pb.v, o1, 0, 0, 0);
                }
        }
    }
    lsum += __shfl_xor(lsum, 32);
    const float il = 1.0f / lsum;
    const size_t t = trow0 + q0 + r;
#pragma unroll
    for (int db = 0; db < 2; ++db)
#pragma unroll
        for (int g = 0; g < 4; ++g) { const int d0 = 32 * db + 8 * g + 4 * hh;
            const u32x2 gz = *(const u32x2*)(p->H + t * IN_WP + C_ZMLA + h * 64 + d0);
            float v[4];
#pragma unroll
            for (int e = 0; e < 4; ++e) v[e] = (db == 0 ? o0[4 * g + e] : o1[4 * g + e]) * il;
            v[0] *= __uint_as_float(gz.x << 16); v[1] *= __uint_as_float(gz.x & 0xffff0000u); v[2] *= __uint_as_float(gz.y << 16); v[3] *= __uint_as_float(gz.y & 0xffff0000u);
            u32x2 w; w.x = pg8::cvt_pk_bf16(v[0], v[1]); w.y = pg8::cvt_pk_bf16(v[2], v[3]);
            *(u32x2*)(p->yb + t * 1536 + h * 64 + d0) = w; }
}
__device__ __forceinline__ void ph_attn_p(KP p, LAS unsigned char* lds) {
    int tid = threadIdx.x; asm volatile("" : "+v"(tid));
    const int lane = tid & 63, wave = __builtin_amdgcn_readfirstlane(tid >> 6);
    for (int pi = blockIdx.x; pi < 256; pi += gridDim.x) {
        const int xcd = pi & 7, k = pi >> 3, bh = xcd * 8 + (k >> 2), pr = k & 3;
        attn_unit(p, bh >> 3, bh & 7, 7 - pr, lds, tid, wave, lane);
        attn_unit(p, bh >> 3, bh & 7, pr, lds, tid, wave, lane);
    }
    __syncthreads();
}
struct MEpiVt { static constexpr bool PERM = true, AFTER_DRAIN = false; static constexpr int SEG = 0; bf16_t* O; int ldc; int pad_;
    __device__ __forceinline__ void operator()(const f32x4 (&acc)[2][2][4][2], const pg8::Unit& u, int wr, int wc, int fr0, int fq0) const {
        int fr = fr0, fq = fq0; asm volatile("" : "+v"(fr), "+v"(fq));
        const int row0 = u.pm * 256 + wr * 64 + fr;
#pragma unroll
        for (int bj = 0; bj < 2; ++bj) { const int col0 = u.pn * 256 + bj * 128 + wc * 32 + 8 * fq;
#pragma unroll
            for (int ai = 0; ai < 2; ++ai)
#pragma unroll
                for (int m = 0; m < 4; ++m) { const int row = row0 + ai * 128 + m * 16; const f32x4 v0 = acc[ai][bj][m][0], v1 = acc[ai][bj][m][1];
                    u32x4 w; w.x = pg8::cvt_pk_bf16(v0[0], v0[1]); w.y = pg8::cvt_pk_bf16(v0[2], v0[3]); w.z = pg8::cvt_pk_bf16(v1[0], v1[1]); w.w = pg8::cvt_pk_bf16(v1[2], v1[3]);
                    *(u32x4*)(O + (size_t)row * ldc + col0) = w; } }
    } };


__global__ void __launch_bounds__(NTHR, 2) k_mega(Params p_unused) {
    const KP kp0 = (KP)__builtin_amdgcn_kernarg_segment_ptr();
#define PP() ({ KP q_ = kp0; asm volatile("" : "+s"(q_)); q_; })
    KP p = PP();
    extern __shared__ __attribute__((aligned(16))) unsigned char lds_raw[];
    LAS unsigned char* lds = (LAS unsigned char*)lds_raw;
    volatile LAS unsigned* misc = (volatile LAS unsigned*)(lds + LDS_MISC);
    for (int u = threadIdx.x; u < 64; u += NTHR) misc[u] = 0u;
    __syncthreads();
    const int lo = p->ph_lo, hi = p->ph_hi;
    XcdBarrier bar; bar.bar = p->bar + p->li * XCD_BAR_WORDS; bar.x = 0; bar.st = nullptr;
    if (hi - lo > 1) bar = xcd_barrier_post(p->bar + p->li * XCD_BAR_WORDS, misc + 8);
#define IN(k) (lo <= (k) && (k) < hi)
#define SEAM(k) do { if (IN(k) && IN((k) + 1)) xcd_barrier(bar); } while (0)

    if (IN(PH_PRO)) {
        LAS float* tile = (LAS float*)lds;
        for (int l = 0; l < 2; ++l) {
            KP p = PP();
            ph_tr(p->w_in + (size_t)l * 1024 * IN_W, p->WinT + (size_t)l * IN_WP * 1024, 1024, IN_W, IN_WP, tile, 0);
            ph_tr(p->w_uq + (size_t)l * 384 * 768, p->WuqT + (size_t)l * 768 * 384, 384, 768, 768, tile, 0);
            ph_tr(p->w_uk + (size_t)l * 256 * 512, p->WkvT + (size_t)l * 1024 * 256, 256, 512, 512, tile, 144);
            ph_tr(p->w_uv + (size_t)l * 256 * 512, p->WkvT + (size_t)l * 1024 * 256 + (size_t)512 * 256, 256, 512, 512, tile, 208);
            ph_tr(p->w_br0 + (size_t)l * 512 * 1024, p->WbrT + (size_t)l * 1024 * 1536 + 0 * 512, 512, 1024, 1024, tile, 0, 1536);
            ph_tr(p->w_br1 + (size_t)l * 512 * 1024, p->WbrT + (size_t)l * 1024 * 1536 + 1 * 512, 512, 1024, 1024, tile, 0, 1536);
            ph_tr(p->w_br2 + (size_t)l * 512 * 1024, p->WbrT + (size_t)l * 1024 * 1536 + 2 * 512, 512, 1024, 1024, tile, 0, 1536);
            ph_tr(p->w_out + (size_t)l * 1024 * 1024, p->WoutT + (size_t)l * 1024 * 1024, 1024, 1024, 1024, tile, 0);
            for (int g = 0; g < 4; ++g) ph_tr(p->pool_mix + ((size_t)l * 4 + g) * 128 * 128, p->PmixT + ((size_t)l * 4 + g) * 128 * 128, 128, 128, 128, tile, 64 + 8 * g);
        }
        { KP p = PP(); ph_rope_tab(p->tab); ph_rmsnorm(p->x_prompt, p->x_sample, p->norm_g, p->xn, nullptr, nullptr); }
    }
    SEAM(PH_PRO);
    for (int l = 0; l < 2; ++l) {
        int G = gridDim.x, bid = blockIdx.x; asm volatile("" : "+s"(G), "+s"(bid));
        if (IN(PHID(l, PH_GIN))) { KP p = PP();
            pg8::Gemm g{p->xn, p->WinT + (size_t)l * IN_WP * 1024, TT, IN_WP, 1024}; pg8::StaticOrder S; S.init(TT, IN_WP, G, bid);
            MEpiH E{p->H, p->BA}; pg8::gemm_phase<MEpiH, pg8::StaticOrder, false>(lds, g, S, E, nullptr);
        }
        SEAM(PHID(l, PH_GIN));
        if (IN(PHID(l, PH_TOK))) ph_tok(PP(), l, lds);
        SEAM(PHID(l, PH_TOK));
        if (IN(PHID(l, PH_GQ))) { KP p = PP();
            pg8::Gemm g{p->cq, p->WuqT + (size_t)l * 768 * 384, TT, 768, 384}; pg8::StaticOrder S; S.init(TT, 768, G, bid);
            MEpiQ E{p->Q, p->tab}; pg8::gemm_phase<MEpiQ, pg8::StaticOrder, false>(lds, g, S, E, nullptr);
        }
        if (IN(PHID(l, PH_GQ))) { KP p = PP();
            pg8::Gemm g{p->ckv, p->WkvT + (size_t)l * 1024 * 256, TP, 512, 256}; pg8::StaticOrder S; S.init(TP, 512, G / 2, bid < G / 2 ? bid : G);
            MEpiKV E{p->Kn, p->V}; pg8::gemm_phase<MEpiKV, pg8::StaticOrder, false>(lds, g, S, E, nullptr);
        }
        if (IN(PHID(l, PH_GQ))) { KP p = PP();
            pg8::Gemm g{p->WkvT + (size_t)l * 1024 * 256 + (size_t)512 * 256, p->ckv, 512, TP, 256}; pg8::StaticOrder S; S.init(512, TP, G / 2, bid >= G / 2 ? bid - G / 2 : G);
            MEpiVt E{p->Vt, TP, 0}; pg8::gemm_phase<MEpiVt, pg8::StaticOrder, false>(lds, g, S, E, nullptr);
        }
        if (IN(PHID(l, PH_GQ))) ph_delta_pre(PP(), lds);
        SEAM(PHID(l, PH_GQ));
        if (IN(PHID(l, PH_ATT))) { const int am = PP()->pad;
            if (am & 1) ph_attn_s2(PP(), l, lds); if (am & 4) ph_attn_p(PP(), lds); if (am & 8) ph_att_waves(PP(), l); }
        SEAM(PHID(l, PH_ATT));
        if (IN(PHID(l, PH_FIN))) { ph_fin(PP(), l, lds); ph_delta_fin(PP(), l); }
        SEAM(PHID(l, PH_FIN));
        if (IN(PHID(l, PH_MERGE))) { KP p = PP();
            pg8::Gemm g{p->ya, p->WbrT + (size_t)l * 1024 * 1536, TP, 1024, 1536}; pg8::StaticOrder S; S.init(TP, 1024, G, bid);
            MEpiMergeS E{p->H, p->mb}; pg8::gemm_phase<MEpiMergeS, pg8::StaticOrder, false>(lds, g, S, E, nullptr);
        }
        if (IN(PHID(l, PH_MERGE))) { KP p = PP(); TEpiMerge E{p->H, p->mb}; tail_gemm<3, TEpiMerge>(p->ya + (size_t)TP * 1536, 1536, p->WbrT + (size_t)l * 1024 * 1536, 1536, 1024, E, lds); }
        SEAM(PHID(l, PH_MERGE));
        if (IN(PHID(l, PH_OUT))) { KP p = PP();
            const float* xp = l == 0 ? p->x_prompt : p->xres; const float* xs = l == 0 ? p->x_sample : p->xres + (size_t)TP * 1024;
            pg8::Gemm g{p->mb, p->WoutT + (size_t)l * 1024 * 1024, TP, 1024, 1024}; pg8::StaticOrder S; S.init(TP, 1024, G, bid);
            MEpiRes E{xp, xs, p->xres}; pg8::gemm_phase<MEpiRes, pg8::StaticOrder, false>(lds, g, S, E, nullptr);
        }
        if (IN(PHID(l, PH_OUT))) { KP p = PP(); TEpiRes E{l == 0 ? p->x_sample : p->xres + (size_t)TP * 1024, p->xres}; tail_gemm<1, TEpiRes>(p->mb + (size_t)TP * 1024, 1024, p->WoutT + (size_t)l * 1024 * 1024, 1024, 1024, E, lds); }
        SEAM(PHID(l, PH_OUT));
        if (IN(PHID(l, PH_NORM))) { KP p = PP();
            if (l == 0) ph_rmsnorm(p->xres, p->xres + (size_t)TP * 1024, p->norm_g + 1024, p->xn, nullptr, nullptr);
            else ph_rmsnorm(p->xres, p->xres + (size_t)TP * 1024, p->final_norm_g, nullptr, p->out + O_YP, p->out + O_YS);
        }
        SEAM(PHID(l, PH_NORM));
    }
#undef IN
#undef SEAM
}

static inline size_t al256(size_t x) { return (x + 255) & ~(size_t)255; }
extern "C" void kernel_launch(void* const* d_in, const int* in_sizes, int n_in, void* d_out, int out_size, void* d_ws, size_t ws_size, hipStream_t stream) {
    static int grid = 0;
    if (grid == 0) {
        int dev = 0, cus = 0; (void)hipGetDevice(&dev); (void)hipDeviceGetAttribute(&cus, hipDeviceAttributeMultiprocessorCount, dev);
        (void)hipFuncSetAttribute((const void*)k_mega, hipFuncAttributeMaxDynamicSharedMemorySize, LDS_BYTES);
        int per_cu = 0; (void)hipOccupancyMaxActiveBlocksPerMultiprocessor(&per_cu, (const void*)k_mega, NTHR, LDS_BYTES); (void)hipGetLastError();
        grid = cus > 0 ? cus : 256;
    }
    Params p{};
    p.x_prompt = (const float*)d_in[0]; p.x_sample = (const float*)d_in[1]; p.cache_kv = (const float*)d_in[2]; p.cache_kr = (const float*)d_in[3];
    p.state_pool = (const float*)d_in[4]; p.state_conv = (const float*)d_in[5]; p.state_delta = (const float*)d_in[6]; p.page_table = (const int*)d_in[7];
    p.norm_g = (const float*)d_in[8]; p.w_in = (const float*)d_in[9]; p.pool_mix = (const float*)d_in[10]; p.pool_scale = (const float*)d_in[11];
    p.q_norm_g = (const float*)d_in[12]; p.w_uq = (const float*)d_in[13]; p.kv_norm_g = (const float*)d_in[14]; p.w_uk = (const float*)d_in[15];
    p.w_uv = (const float*)d_in[16]; p.conv_w = (const float*)d_in[17]; p.a_log = (const float*)d_in[18]; p.dt_bias = (const float*)d_in[19];
    p.dn_norm_g = (const float*)d_in[20]; p.w_br0 = (const float*)d_in[21]; p.w_br1 = (const float*)d_in[22]; p.w_br2 = (const float*)d_in[23];
    p.w_out = (const float*)d_in[24]; p.final_norm_g = (const float*)d_in[25];
    p.out = (float*)d_out;
    char* w = (char*)d_ws; size_t off = 0;
    auto take = [&](size_t bytes) { char* q = w + off; off += al256(bytes); return q; };
    const size_t BAR_BYTES = (size_t)16 * XCD_BAR_WORDS * 4;
    p.bar = (unsigned*)take(BAR_BYTES);
    p.WinT = (bf16_t*)take((size_t)2 * IN_WP * 1024 * 2);
    p.WuqT = (bf16_t*)take((size_t)2 * 768 * 384 * 2);
    p.WkvT = (bf16_t*)take((size_t)2 * 1024 * 256 * 2);
    p.WbrT = (bf16_t*)take((size_t)2 * 3 * 1024 * 512 * 2);
    p.WoutT = (bf16_t*)take((size_t)2 * 1024 * 1024 * 2);
    p.PmixT = (bf16_t*)take((size_t)2 * 4 * 128 * 128 * 2);
    p.tab = (float2*)take((size_t)(SEQ + DEC_SEQ) * 16 * 8);
    p.xres = (float*)take((size_t)TT * 1024 * 4);
    p.xn = (bf16_t*)take((size_t)TT * 1024 * 2);
    p.H = (bf16_t*)take((size_t)TT * IN_WP * 2);
    p.BA = (float*)take((size_t)TT * 16 * 4);
    p.cq = (bf16_t*)take((size_t)TT * 384 * 2);
    p.ckv = (bf16_t*)take((size_t)TT * 256 * 2);
    p.Kr = (bf16_t*)take((size_t)TT * 32 * 2);
    p.Q = (bf16_t*)take((size_t)TT * 768 * 2);
    bf16_t* Qlat = (bf16_t*)take((size_t)TS * 8 * 288 * 2);
    p.Kn = (bf16_t*)take((size_t)TP * 512 * 2);
    p.V = (bf16_t*)take((size_t)TP * 512 * 2);
    p.Vt = (bf16_t*)take((size_t)512 * TP * 2);
    p.qd = (bf16_t*)take((size_t)TT * 512 * 2);
    p.kd = (bf16_t*)take((size_t)TT * 512 * 2);
    p.vd = (bf16_t*)take((size_t)TT * 512 * 2);
    p.bg = (float*)take((size_t)TT * 16 * 4);
    p.ya = (bf16_t*)take((size_t)TT * 1536 * 2); p.yb = p.ya + 512; p.yc = p.ya + 1024;
    p.mf = (float*)take((size_t)TT * 1024 * 4);
    p.mb = (bf16_t*)take((size_t)TT * 1024 * 2);
    p.part = (float*)take((size_t)DEC_BATCH * SA_CH * 64 * 258 * 4);
    p.DOP = (bf16_t*)take((size_t)2048 * 4 * 4096 * 2);
    p.DU = (float*)take((size_t)2048 * 4096 * 4);
    p.DG = (float*)take((size_t)2048 * 4);

    (void)hipMemsetAsync(p.bar, 0, BAR_BYTES, stream);
    p.ph_lo = 0; p.ph_hi = PH_END; p.li = 0; p.pad = 15;
    hipLaunchKernelGGL(k_mega, dim3(grid), dim3(NTHR), LDS_BYTES, stream, p);
#if defined(PROBE_REP) && PROBE_REP > 0
    for (int i = 0; i < PROBE_REP; ++i) { Params q = p; q.ph_lo = PROBE_LO; q.ph_hi = PROBE_HI; q.li = 1 + i; q.pad = PROBE_MASK; hipLaunchKernelGGL(k_mega, dim3(grid), dim3(NTHR), LDS_BYTES, stream, q); }
#endif
}
```

```cpp
#include <hip/hip_runtime.h>
#include <stdint.h>

typedef unsigned short bf16_t;

#define D_MODEL 1024
#define TP 16384
#define TS 256
#define TT (TP + TS)
#define SEQ 2048
#define DEC_SEQ 8
#define DEC_BATCH 32
#define PAST_LEN 16384
#define PAGE 128
#define N_PAGES 128
#define N_POOL 5120
#define IN_W 7344
#define IN_WP 7424
#define C_POOL 0
#define C_ZPOOL 512
#define C_Q 1024
#define C_KV 1408
#define C_KR 1664
#define C_ZMLA 1696
#define C_QKV 2208
#define C_ZDN 3744
#define C_BETA 4256
#define C_ALPHA 4264
#define C_GATE 4272
#define EPS 1e-6f
#define MLA_SCALE 0.10206207261596577f
#define ATT_C 0.14724444831554004f

#define O_YP 0
#define O_YS (O_YP + 16777216)
#define O_PKV (O_YS + 262144)
#define O_PKR (O_PKV + 8388608)
#define O_PPOOL (O_PKR + 1048576)
#define O_PCONV (O_PPOOL + 122880)
#define O_PDELTA (O_PCONV + 73728)
#define O_SKV (O_PDELTA + 524288)
#define O_SKR (O_SKV + 131072)
#define O_SPOOL (O_SKR + 16384)
#define O_SCONV (O_SPOOL + 491520)
#define O_SDELTA (O_SCONV + 294912)
#define O_END (O_SDELTA + 2097152)

__device__ __forceinline__ float bf2f(bf16_t b) { return __uint_as_float(((unsigned)b) << 16); }
__device__ __forceinline__ bf16_t f2bf(float f) { unsigned u = __float_as_uint(f); u += 0x7FFFu + ((u >> 16) & 1u); return (bf16_t)(u >> 16); }
__device__ __forceinline__ float sigmoidf_(float v) { return 1.0f / (1.0f + __expf(-v)); }
__device__ __forceinline__ float siluf_(float v) { return v / (1.0f + __expf(-v)); }
__device__ __forceinline__ float wave_sum(float v) {
#pragma unroll
    for (int o = 32; o >= 1; o >>= 1) v += __shfl_xor(v, o);
    return v;
}

#define SA_CH 8
namespace pg8 {
#define PG8_LAS __attribute__((address_space(3)))
typedef unsigned short bf16_t;
typedef short bf16x8 __attribute__((ext_vector_type(8)));
typedef float f32x4 __attribute__((ext_vector_type(4)));
typedef unsigned u32x4 __attribute__((ext_vector_type(4)));
constexpr int BM = 256, BK = 64, HALF = 128, HTB = HALF * BK * 2  , STAGE_BYTES = 8 * HTB, NXCD = 8, WGM = 8;

__host__ __device__ __forceinline__ int lds_byte(int r, int c) { const int st = (r >> 4) * 2 + (c >> 5), rr = r & 15, cc = c & 31, ob = rr * 64 + cc * 2; return st * 1024 + (ob ^ (((ob >> 9) & 1) << 5)); }
__host__ __device__ __forceinline__ void stage_rc(int b, int& R, int& C) { const int st = b / 1024, sb = b % 1024, swz = sb ^ (((sb >> 9) & 1) << 5); R = (st >> 1) * 16 + swz / 64; C = (st & 1) * 32 + (swz % 64) / 2; }
__host__ __device__ __forceinline__ int perm32(int rho) { const int n = rho >> 4, i = rho & 15; return 8 * (i >> 2) + 4 * n + (i & 3); }

struct Unit { int pm, pn; };
struct Gemm { const bf16_t* A; const bf16_t* Bt; int M, N, K; };

struct StaticOrder {
    int nM, nN, nwg, G, c;
    __host__ __device__ void init(int M, int N, int G_, int c_) { nM = M / BM; nN = N / BM; nwg = nM * nN; G = G_; c = c_; }
    __host__ __device__ bool next(int i, Unit& u) const {
        const long L = (long)i * G + c; if (L >= nwg) return false;
        int wgid = (int)L; { const int q = nwg / NXCD, r = nwg % NXCD, xcd = wgid % NXCD, off = wgid / NXCD; wgid = (xcd < r ? xcd * (q + 1) : r * (q + 1) + (xcd - r) * q) + off; }
        const int nig = WGM * nN, gid = wgid / nig, fm = gid * WGM, gsz = (nM - fm) < WGM ? (nM - fm) : WGM;
        u.pm = fm + ((wgid % nig) % gsz); u.pn = (wgid % nig) / gsz; return true;
    }
    __device__ __forceinline__ void a_ready(const Unit&) const {}
    __device__ __forceinline__ void done(const Unit&) const {}
};
typedef __bf16 bf16n2 __attribute__((ext_vector_type(2)));
__device__ __forceinline__ unsigned cvt_pk_bf16(float lo, float hi) { typedef float f2_ __attribute__((ext_vector_type(2))); const f2_ v = {lo, hi}; return __builtin_bit_cast(unsigned, __builtin_convertvector(v, bf16n2)); }
typedef float f32x2 __attribute__((ext_vector_type(2)));
template <class Epi, class Sched, bool STAMP = false>
__device__ __forceinline__ void gemm_phase(PG8_LAS unsigned char* lds, const Gemm g, const Sched& S, const Epi& E, unsigned long long* stamps) {
    int tid_ = threadIdx.x; asm volatile("" : "+v"(tid_));
    const int tid = tid_, wid = __builtin_amdgcn_readfirstlane(tid >> 6), lane = tid & 63, wr = wid >> 2, wc = wid & 3, fr = lane & 15, fq = lane >> 4;
    int K_ = g.K; asm volatile("" : "+s"(K_));
    const int K = K_, nt = K / BK;
    int ts_lo = 0, ts_hi = 0, nts = 0; const unsigned long long rt_entry = STAMP ? (unsigned long long)wall_clock64() : 0ull;
#define PG8_STAMP() do { if (STAMP && wid == 0 && nts < 64) { const unsigned long long _c = (unsigned long long)clock64(); \
        ts_lo = (lane == nts) ? (int)(unsigned)_c : ts_lo; ts_hi = (lane == nts) ? (int)(unsigned)(_c >> 32) : ts_hi; ++nts; } } while (0)
    PG8_STAMP();
    unsigned voffA[2], voffB[2];
#pragma unroll
    for (int i = 0; i < 2; ++i) { int R, C; stage_rc(tid * 16 + i * 8192, R, C); const int Rb = Epi::PERM ? ((R & ~31) + perm32(R & 31)) : R;
        voffA[i] = (unsigned)(R * K + C) * 2u; voffB[i] = (unsigned)(Rb * K + C) * 2u; }
    const size_t kstep = (size_t)(BK * 2);
    const size_t hstep = (size_t)HALF * K * 2;
    const size_t tstep = 2 * hstep;
    const unsigned ldsw = (unsigned)wid * 1024u;
    const int aoff = lds_byte(wr * 64 + fr, fq * 8), boff = lds_byte(wc * 32 + fr, fq * 8);
#define PG8_SA(b, h) (((b) * 2 + (h)) * HTB)
#define PG8_SB(b, h) ((4 + (b) * 2 + (h)) * HTB)
#define PG8_STAGE(bufoff, gbase, voff) do { _Pragma("unroll") for (int _i = 0; _i < 2; ++_i) \
        __builtin_amdgcn_global_load_lds((const unsigned*)((const char*)(gbase) + (voff)[_i]), (PG8_LAS unsigned*)(lds + (bufoff) + ldsw + _i * 8192), 16, 0, 0); } while (0)
#define PG8_LDA(dst, b, h) do { _Pragma("unroll") for (int m = 0; m < 4; ++m) _Pragma("unroll") for (int k = 0; k < 2; ++k) dst[m][k] = *(const PG8_LAS bf16x8*)(lds + PG8_SA(b, h) + aoff + m * 2048 + k * 1024); } while (0)
#define PG8_LDB(dst, b, h) do { _Pragma("unroll") for (int n = 0; n < 2; ++n) _Pragma("unroll") for (int k = 0; k < 2; ++k) dst[n][k] = *(const PG8_LAS bf16x8*)(lds + PG8_SB(b, h) + boff + n * 2048 + k * 1024); } while (0)
#define PG8_MMA(ai, bj, At, Bt) do { __builtin_amdgcn_s_setprio(1); _Pragma("unroll") for (int m = 0; m < 4; ++m) _Pragma("unroll") for (int n = 0; n < 2; ++n) _Pragma("unroll") for (int k = 0; k < 2; ++k) \
        acc[ai][bj][m][n] = __builtin_amdgcn_mfma_f32_16x16x32_bf16(Bt[n][k], At[m][k], acc[ai][bj][m][n], 0, 0, 0); __builtin_amdgcn_s_setprio(0); } while (0)
#define PG8_WAIT_V(n) asm volatile("s_waitcnt vmcnt(" #n ")" ::: "memory")
#define PG8_WAIT_L(n) asm volatile("s_waitcnt lgkmcnt(" #n ")" ::: "memory")
#define PG8_BAR __builtin_amdgcn_s_barrier()
#define PG8_SCHED __builtin_amdgcn_sched_barrier(0)
    Unit cur, nxt; int ui = 0;
    if (!S.next(0, cur)) return;
    f32x4 acc[2][2][4][2];
#pragma unroll
    for (int a = 0; a < 2; ++a)
#pragma unroll
        for (int b = 0; b < 2; ++b)
#pragma unroll
            for (int m = 0; m < 4; ++m)
#pragma unroll
                for (int n = 0; n < 2; ++n) acc[a][b][m][n] = (f32x4){0.f, 0.f, 0.f, 0.f};
    bf16x8 At[4][2], B0[2][2], B1[2][2];
    const char* cA = (const char*)g.A + (size_t)cur.pm * tstep; const char* cB = (const char*)g.Bt + (size_t)cur.pn * tstep;
    S.a_ready(cur);
    PG8_STAGE(PG8_SB(0, 0), cB, voffB); PG8_STAGE(PG8_SA(0, 0), cA, voffA); PG8_STAGE(PG8_SB(0, 1), cB + hstep, voffB); PG8_STAGE(PG8_SA(0, 1), cA + hstep, voffA);
    if (wr == 1) PG8_BAR;
    PG8_WAIT_V(4); PG8_BAR;
    PG8_STAGE(PG8_SB(1, 0), cB + kstep, voffB); PG8_STAGE(PG8_SA(1, 0), cA + kstep, voffA); PG8_STAGE(PG8_SB(1, 1), cB + hstep + kstep, voffB);
    PG8_WAIT_V(6); PG8_BAR;
    PG8_STAMP();
    for (;;) {
        const bool has_next = S.next(ui + 1, nxt);
        const char* nA = has_next ? (const char*)g.A + (size_t)nxt.pm * tstep : cA; const char* nB = has_next ? (const char*)g.Bt + (size_t)nxt.pn * tstep : cB;
_Pragma("nounroll")
        for (int t = 0; t < nt; t += 2) {
            const bool last = (t == nt - 2);
            const char* a1 = cA + (size_t)(t + 1) * kstep;
            const char* a2 = last ? nA : cA + (size_t)(t + 2) * kstep; const char* b2 = last ? nB : cB + (size_t)(t + 2) * kstep;
            const char* a3 = a2 + kstep; const char* b3 = b2 + kstep;
            if (last && has_next) S.a_ready(nxt);
            if constexpr (Epi::SEG > 0) { if (t != 0 && (t % Epi::SEG) == 0) E.mid(acc, cur, wr, wc, fr, fq, t / Epi::SEG); }
            PG8_LDB(B0, 0, 0); PG8_SCHED; PG8_LDA(At, 0, 0); PG8_STAGE(PG8_SA(1, 1), a1 + hstep, voffA);
            PG8_WAIT_L(8); PG8_BAR; PG8_WAIT_L(0); PG8_MMA(0, 0, At, B0); PG8_BAR; PG8_SCHED;
            PG8_LDB(B1, 0, 1); PG8_STAGE(PG8_SB(0, 0), b2, voffB);
            PG8_BAR; PG8_WAIT_L(0); PG8_MMA(0, 1, At, B1); PG8_BAR;
            PG8_LDA(At, 0, 1); PG8_STAGE(PG8_SA(0, 0), a2, voffA);
            PG8_BAR; PG8_WAIT_L(0); PG8_MMA(1, 0, At, B0); PG8_BAR; PG8_SCHED;
            PG8_STAGE(PG8_SB(0, 1), b2 + hstep, voffB);
            PG8_WAIT_V(6); PG8_BAR; PG8_MMA(1, 1, At, B1); PG8_BAR;
            PG8_LDB(B0, 1, 0); PG8_SCHED; PG8_LDA(At, 1, 0); PG8_STAGE(PG8_SA(0, 1), a2 + hstep, voffA);
            PG8_WAIT_L(8); PG8_BAR; PG8_WAIT_L(0); PG8_MMA(0, 0, At, B0); PG8_BAR; PG8_SCHED;
            PG8_LDB(B1, 1, 1); PG8_STAGE(PG8_SB(1, 0), b3, voffB);
            PG8_BAR; PG8_WAIT_L(0); PG8_MMA(0, 1, At, B1); PG8_BAR;
            PG8_LDA(At, 1, 1); PG8_STAGE(PG8_SA(1, 0), a3, voffA);
            PG8_BAR; PG8_WAIT_L(0); PG8_MMA(1, 0, At, B0); PG8_BAR; PG8_SCHED;
            PG8_STAGE(PG8_SB(1, 1), b3 + hstep, voffB);
            PG8_WAIT_V(6); PG8_BAR; PG8_MMA(1, 1, At, B1); PG8_BAR;
        }
        PG8_STAMP();
        if constexpr (!Epi::AFTER_DRAIN) { E(acc, cur, wr, wc, fr, fq); S.done(cur); }
        PG8_STAMP();
        if (!has_next) break;
#pragma unroll
        for (int a = 0; a < 2; ++a)
#pragma unroll
            for (int b = 0; b < 2; ++b)
#pragma unroll
                for (int m = 0; m < 4; ++m)
#pragma unroll
                    for (int n = 0; n < 2; ++n) acc[a][b][m][n] = (f32x4){0.f, 0.f, 0.f, 0.f};
        cur = nxt; cA = nA; cB = nB; ++ui;
    }
    PG8_WAIT_V(0);
    if (wr == 0) PG8_BAR;
    PG8_BAR;
    if constexpr (Epi::AFTER_DRAIN) { E.fused(acc, cur, wr, wc, fr, fq, lds, wid, lane); S.done(cur); }
    PG8_STAMP();
    if (STAMP && wid == 0) { stamps[lane] = lane < nts ? (((unsigned long long)(unsigned)ts_hi << 32) | (unsigned)ts_lo) : 0ull;
        if (lane == 62) stamps[62] = rt_entry; if (lane == 63) stamps[63] = (unsigned long long)wall_clock64(); }
#undef PG8_STAMP
#undef PG8_SA
#undef PG8_SB
#undef PG8_STAGE
#undef PG8_LDA
#undef PG8_LDB
#undef PG8_MMA
#undef PG8_WAIT_V
#undef PG8_WAIT_L
#undef PG8_BAR
#undef PG8_SCHED
}

}
#define XB_TMO      128
#define XB_XCNT(j)  (256  + 64 * (j))
#define XB_XSUB(j)  (1280 + 64 * (j))
#define XB_XGEN(j)  (2304 + 64 * (j))
#define XB_TOP      3328
#define XB_TOPGEN   3392
#define XCD_BAR_WORDS 3456
#define XB_SPIN_CAP (1u << 18)
#define LAS __attribute__((address_space(3)))

__device__ __forceinline__ unsigned xb_ld(unsigned* p)              { return __hip_atomic_load(p, __ATOMIC_RELAXED, __HIP_MEMORY_SCOPE_AGENT); }
__device__ __forceinline__ unsigned xb_add(unsigned* p, unsigned v) { return __hip_atomic_fetch_add(p, v, __ATOMIC_RELAXED, __HIP_MEMORY_SCOPE_AGENT); }
__device__ __forceinline__ unsigned xb_xcc_id() { return (unsigned)__builtin_amdgcn_s_getreg((3 << 11) | 20) & 0xFu; }
#define XB_SPIN(cond, bar) do { unsigned _sp = 0; while (cond) { __builtin_amdgcn_s_sleep(1); \
    if ((++_sp & 255u) == 0u) { if (xb_ld(&(bar)[XB_TMO])) break; if (_sp > XB_SPIN_CAP) { atomicAdd(&(bar)[XB_TMO], 1u); break; } } } } while (0)

struct XcdBarrier {
    unsigned* bar; unsigned x;
    volatile LAS unsigned* st;
};

__device__ __forceinline__ XcdBarrier xcd_barrier_post(unsigned* bar, volatile LAS unsigned* st) {
    XcdBarrier b; b.bar = bar; b.x = xb_xcc_id(); b.st = st;
    if (threadIdx.x == 0) (void)xb_add(&bar[XB_XCNT(b.x)], 1u);
    return b;
}
__device__ __forceinline__ void xcd_barrier_complete(unsigned* bar, unsigned x, unsigned& nloc, unsigned& nx) {
    const unsigned G = gridDim.x * gridDim.y * gridDim.z;
    unsigned sum, cnt, mine, sp = 0u;
    for (;;) {
        sum = 0u; cnt = 0u; mine = 0u;
#pragma unroll
        for (unsigned j = 0; j < 16; ++j) { const unsigned c = xb_ld(&bar[XB_XCNT(j)]); sum += c; cnt += (c > 0u) ? 1u : 0u; mine = (j == x) ? c : mine; }
        if (sum == G) break;
        __builtin_amdgcn_s_sleep(1);
        if ((++sp & 255u) == 0u) { if (xb_ld(&bar[XB_TMO])) break; if (sp > XB_SPIN_CAP) { atomicAdd(&bar[XB_TMO], 1u); break; } }
    }
    nloc = mine > 0u ? mine : 1u; nx = cnt > 0u ? cnt : 1u;
}

__device__ __forceinline__ void xcd_barrier(const XcdBarrier& b) {
    asm volatile("s_waitcnt vmcnt(0)" ::: "memory");
    __syncthreads();
    if (threadIdx.x == 0) {
        unsigned* bar = b.bar;
        __builtin_amdgcn_s_waitcnt(0);
        unsigned nloc = b.st[0], nx = b.st[1];
        if (nloc == 0u) { xcd_barrier_complete(bar, b.x, nloc, nx); b.st[0] = nloc; b.st[1] = nx; }
        const unsigned old = xb_add(&bar[XB_XSUB(b.x)], 1u);
        const unsigned gen = old / nloc;
        if (old + 1u == (gen + 1u) * nloc) {
            __builtin_amdgcn_fence(__ATOMIC_RELEASE, "agent");
            asm volatile("s_waitcnt vmcnt(0)" ::: "memory");
            const unsigned og = xb_add(&bar[XB_TOP], 1u);
            const unsigned tg = og / nx;
            if (og + 1u == (tg + 1u) * nx) xb_add(&bar[XB_TOPGEN], 1u);
            else XB_SPIN(xb_ld(&bar[XB_TOPGEN]) == tg, bar);
            __builtin_amdgcn_fence(__ATOMIC_ACQUIRE, "agent");
            xb_add(&bar[XB_XGEN(b.x)], 1u);
            asm volatile("s_waitcnt vmcnt(0)" ::: "memory");
        } else {
            XB_SPIN(xb_ld(&bar[XB_XGEN(b.x)]) == gen, bar);
            __builtin_amdgcn_fence(__ATOMIC_ACQUIRE, "agent");
            asm volatile("s_waitcnt vmcnt(0)" ::: "memory");
        }
    }
    __syncthreads();
}


#define LAS __attribute__((address_space(3)))
typedef float f32x4 __attribute__((ext_vector_type(4)));
typedef unsigned u32x4 __attribute__((ext_vector_type(4)));
typedef unsigned u32x2 __attribute__((ext_vector_type(2)));
typedef float f32x2 __attribute__((ext_vector_type(2)));
typedef short bf16x8_t __attribute__((ext_vector_type(8)));
typedef float f32x16 __attribute__((ext_vector_type(16)));
constexpr int NTHR = 512;
constexpr int LDS_BYTES = 147456;
constexpr int LDS_MISC = LDS_BYTES - 256;

struct Params {
    const float *x_prompt, *x_sample, *cache_kv, *cache_kr, *state_pool, *state_conv, *state_delta; const int* page_table;
    const float *norm_g, *w_in, *pool_mix, *pool_scale, *q_norm_g, *w_uq, *kv_norm_g, *w_uk, *w_uv, *conv_w, *a_log, *dt_bias, *dn_norm_g, *w_br0, *w_br1, *w_br2, *w_out, *final_norm_g;
    float* out;
    bf16_t *WinT, *WuqT, *WkvT, *WbrT, *WoutT, *PmixT; float2* tab;
    float* xres; bf16_t* xn; bf16_t* H; float* BA; bf16_t *cq, *ckv, *Kr, *Q, *Kn, *V, *Vt, *qd, *kd, *vd; float* bg; bf16_t *ya, *yb, *yc; float* mf; bf16_t* mb; float* part; bf16_t* DOP; float* DU; float* DG;
    unsigned* bar;
    int ph_lo, ph_hi, li, pad;
};

typedef const __attribute__((address_space(4))) Params* KP;

constexpr int PH_PRO = 0;
constexpr int PH_L = 8;
constexpr int PH_GIN = 0, PH_TOK = 1, PH_GQ = 2, PH_ATT = 3, PH_FIN = 4, PH_MERGE = 5, PH_OUT = 6, PH_NORM = 7;
#define PHID(l, k) (1 + (l) * PH_L + (k))
constexpr int PH_END = 1 + 2 * PH_L;

__device__ __forceinline__ void unpack8(const u32x4 v, float (&f)[8]) {
    f[0] = __uint_as_float(v.x << 16); f[1] = __uint_as_float(v.x & 0xffff0000u); f[2] = __uint_as_float(v.y << 16); f[3] = __uint_as_float(v.y & 0xffff0000u);
    f[4] = __uint_as_float(v.z << 16); f[5] = __uint_as_float(v.z & 0xffff0000u); f[6] = __uint_as_float(v.w << 16); f[7] = __uint_as_float(v.w & 0xffff0000u); }
__device__ __forceinline__ u32x4 pack8(const float (&f)[8]) { u32x4 w; w.x = pg8::cvt_pk_bf16(f[0], f[1]); w.y = pg8::cvt_pk_bf16(f[2], f[3]); w.z = pg8::cvt_pk_bf16(f[4], f[5]); w.w = pg8::cvt_pk_bf16(f[6], f[7]); return w; }
struct MEpiH { static constexpr bool PERM = true, AFTER_DRAIN = false; static constexpr int SEG = 0; bf16_t* H; float* BA;
    __device__ __forceinline__ void operator()(const f32x4 (&acc)[2][2][4][2], const pg8::Unit& u, int wr, int wc, int fr0, int fq0) const {
        int fr = fr0, fq = fq0; asm volatile("" : "+v"(fr), "+v"(fq));
        const int row0 = u.pm * 256 + wr * 64 + fr;
#pragma unroll
        for (int bj = 0; bj < 2; ++bj) {
            const int wcol = u.pn * 256 + bj * 128 + wc * 32, col0 = wcol + 8 * fq;
            const bool plain = (wcol + 32 <= C_ZPOOL) || (wcol >= C_Q && wcol + 32 <= C_ZMLA) || (wcol >= C_QKV && wcol + 32 <= C_ZDN);
            const int act = ((col0 >= C_ZPOOL && col0 < C_Q) || (col0 >= C_ZMLA && col0 < C_QKV) || (col0 >= C_ZDN && col0 < C_BETA)) ? 1 : (col0 >= C_GATE ? 2 : 0);
            const bool isba = (col0 == C_BETA) || (col0 == C_ALPHA);
#pragma unroll
            for (int ai = 0; ai < 2; ++ai)
#pragma unroll
                for (int m = 0; m < 4; ++m) { const int row = row0 + ai * 128 + m * 16; f32x4 v0 = acc[ai][bj][m][0], v1 = acc[ai][bj][m][1];
                    if (!plain) {
                        if (isba) { float* b = BA + (size_t)row * 16 + (col0 - C_BETA); *(f32x4*)b = v0; *(f32x4*)(b + 4) = v1; }
#pragma unroll
                        for (int e = 0; e < 4; ++e) { const float s0 = sigmoidf_(v0[e]), s1 = sigmoidf_(v1[e]);
                            v0[e] = act == 0 ? v0[e] : (act == 1 ? v0[e] * s0 : s0); v1[e] = act == 0 ? v1[e] : (act == 1 ? v1[e] * s1 : s1); }
                    }
                    u32x4 w; w.x = pg8::cvt_pk_bf16(v0[0], v0[1]); w.y = pg8::cvt_pk_bf16(v0[2], v0[3]); w.z = pg8::cvt_pk_bf16(v1[0], v1[1]); w.w = pg8::cvt_pk_bf16(v1[2], v1[3]);
                    *(u32x4*)(H + (size_t)row * IN_WP + col0) = w; }
        }
    } };
struct MEpiQ { static constexpr bool PERM = true, AFTER_DRAIN = false; static constexpr int SEG = 0; bf16_t* Q; const float2* tab;
    __device__ __forceinline__ void operator()(const f32x4 (&acc)[2][2][4][2], const pg8::Unit& u, int wr, int wc, int fr0, int fq0) const {
        int fr = fr0, fq = fq0; asm volatile("" : "+v"(fr), "+v"(fq));
        const int row0 = u.pm * 256 + wr * 64 + fr;
#pragma unroll
        for (int bj = 0; bj < 2; ++bj) {
            const int wcol = u.pn * 256 + bj * 128 + wc * 32, col0 = wcol + 8 * fq;
            const bool rope = (wcol % 96) == 64;
#pragma unroll
            for (int ai = 0; ai < 2; ++ai)
#pragma unroll
                for (int m = 0; m < 4; ++m) { const int row = row0 + ai * 128 + m * 16; f32x4 v0 = acc[ai][bj][m][0], v1 = acc[ai][bj][m][1];
                    if (rope) { const int p = row < TP ? (row & (SEQ - 1)) : SEQ + ((row - TP) & 7); const float2* tp = tab + p * 16 + (fq & 1) * 8; const bool hi = fq >= 2;
#pragma unroll
                        for (int e = 0; e < 4; ++e) { const float o0 = __shfl_xor(v0[e], 32), o1 = __shfl_xor(v1[e], 32); const float2 c0 = tp[e], c1 = tp[4 + e];
                            v0[e] = hi ? (v0[e] * c0.x + o0 * c0.y) : (v0[e] * c0.x - o0 * c0.y); v1[e] = hi ? (v1[e] * c1.x + o1 * c1.y) : (v1[e] * c1.x - o1 * c1.y); } }
                    u32x4 w; w.x = pg8::cvt_pk_bf16(v0[0], v0[1]); w.y = pg8::cvt_pk_bf16(v0[2], v0[3]); w.z = pg8::cvt_pk_bf16(v1[0], v1[1]); w.w = pg8::cvt_pk_bf16(v1[2], v1[3]);
                    *(u32x4*)(Q + (size_t)row * 768 + col0) = w; asm volatile("" ::: "memory"); }
        }
    } };
struct MEpiKV { static constexpr bool PERM = true, AFTER_DRAIN = false; static constexpr int SEG = 0; bf16_t* Kn; bf16_t* V;
    __device__ __forceinline__ void operator()(const f32x4 (&acc)[2][2][4][2], const pg8::Unit& u, int wr, int wc, int fr0, int fq0) const {
        int fr = fr0, fq = fq0; asm volatile("" : "+v"(fr), "+v"(fq));
        const int row0 = u.pm * 256 + wr * 64 + fr; bf16_t* base = u.pn < 2 ? Kn : V; const int cb = (u.pn & 1) * 256;
#pragma unroll
        for (int bj = 0; bj < 2; ++bj) { const int col0 = cb + bj * 128 + wc * 32 + 8 * fq;
#pragma unroll
            for (int ai = 0; ai < 2; ++ai)
#pragma unroll
                for (int m = 0; m < 4; ++m) { const int row = row0 + ai * 128 + m * 16; const f32x4 v0 = acc[ai][bj][m][0], v1 = acc[ai][bj][m][1];
                    u32x4 w; w.x = pg8::cvt_pk_bf16(v0[0], v0[1]); w.y = pg8::cvt_pk_bf16(v0[2], v0[3]); w.z = pg8::cvt_pk_bf16(v1[0], v1[1]); w.w = pg8::cvt_pk_bf16(v1[2], v1[3]);
                    *(u32x4*)(base + (size_t)row * 512 + col0) = w; } }
    } };
template <int BR> struct MEpiMerge { static constexpr bool PERM = true, AFTER_DRAIN = false; static constexpr int SEG = 0; const bf16_t* H; float* mf; bf16_t* mb;
    __device__ __forceinline__ void operator()(const f32x4 (&acc)[2][2][4][2], const pg8::Unit& u, int wr, int wc, int fr0, int fq0) const {
        int fr = fr0, fq = fq0; asm volatile("" : "+v"(fr), "+v"(fq));
        const int row0 = u.pm * 256 + wr * 64 + fr;
#pragma unroll
        for (int bj = 0; bj < 2; ++bj) { const int col0 = u.pn * 256 + bj * 128 + wc * 32 + 8 * fq;
#pragma unroll
            for (int ai = 0; ai < 2; ++ai)
#pragma unroll
                for (int m = 0; m < 4; ++m) { const int row = row0 + ai * 128 + m * 16; f32x4 v0 = acc[ai][bj][m][0], v1 = acc[ai][bj][m][1];
                    const u32x4 g = *(const u32x4*)(H + (size_t)row * IN_WP + C_GATE + BR * 1024 + col0);
                    v0[0] *= __uint_as_float(g.x << 16); v0[1] *= __uint_as_float(g.x & 0xffff0000u); v0[2] *= __uint_as_float(g.y << 16); v0[3] *= __uint_as_float(g.y & 0xffff0000u);
                    v1[0] *= __uint_as_float(g.z << 16); v1[1] *= __uint_as_float(g.z & 0xffff0000u); v1[2] *= __uint_as_float(g.w << 16); v1[3] *= __uint_as_float(g.w & 0xffff0000u);
                    float* mp = mf + (size_t)row * 1024 + col0;
                    if (BR > 0) { v0 += *(const f32x4*)mp; v1 += *(const f32x4*)(mp + 4); }
                    if (BR < 2) { *(f32x4*)mp = v0; *(f32x4*)(mp + 4) = v1; }
                    else { u32x4 w; w.x = pg8::cvt_pk_bf16(v0[0], v0[1]); w.y = pg8::cvt_pk_bf16(v0[2], v0[3]); w.z = pg8::cvt_pk_bf16(v1[0], v1[1]); w.w = pg8::cvt_pk_bf16(v1[2], v1[3]);
                        *(u32x4*)(mb + (size_t)row * 1024 + col0) = w; } asm volatile("" ::: "memory"); } }
    } };
struct MEpiRes { static constexpr bool PERM = false, AFTER_DRAIN = false; static constexpr int SEG = 0; const float* xp; const float* xs; float* xo;
    __device__ __forceinline__ void operator()(const f32x4 (&acc)[2][2][4][2], const pg8::Unit& u, int wr, int wc, int fr0, int fq0) const {
        int fr = fr0, fq = fq0; asm volatile("" : "+v"(fr), "+v"(fq));
        const int row0 = u.pm * 256 + wr * 64 + fr, col0 = u.pn * 256 + wc * 32 + 4 * fq;
#pragma unroll
        for (int ai = 0; ai < 2; ++ai)
#pragma unroll
            for (int m = 0; m < 4; ++m) { const int row = row0 + ai * 128 + m * 16; const float* xr = row < TP ? xp + (size_t)row * 1024 : xs + (size_t)(row - TP) * 1024; float* orow = xo + (size_t)row * 1024;
#pragma unroll
                for (int bj = 0; bj < 2; ++bj)
#pragma unroll
                    for (int n = 0; n < 2; ++n) { const int c = col0 + bj * 128 + n * 16; *(f32x4*)(orow + c) = *(const f32x4*)(xr + c) + acc[ai][bj][m][n]; } }
    } };

template <int NSEG, class Epi>
__device__ __forceinline__ void tail_gemm(const bf16_t* __restrict__ A, int lda, const bf16_t* __restrict__ Bt, int K, int N, const Epi& epi, LAS unsigned char* lds) {
    int tid = threadIdx.x; asm volatile("" : "+v"(tid));
    const int lane = tid & 63, wave = __builtin_amdgcn_readfirstlane(tid >> 6), rt = wave & 3, kh = wave >> 2, n = lane & 15, q = lane >> 4;
    const int ntile = 4 * (N / 16), kseg = K / NSEG, khalf = kseg / 2;
    LAS f32x4* red = (LAS f32x4*)lds;
    for (int tile = blockIdx.x; tile < ntile; tile += gridDim.x) {
        const int r0 = 64 * (tile & 3) + 16 * rt, c0 = 16 * (tile >> 2);
        const bf16_t* ap = A + (size_t)(r0 + n) * lda + 8 * q; const bf16_t* bp = Bt + (size_t)(c0 + n) * K + 8 * q;
        f32x4 acc[NSEG];
#pragma unroll
        for (int sg = 0; sg < NSEG; ++sg) { acc[sg] = (f32x4){0.f, 0.f, 0.f, 0.f};
            const int kb = sg * kseg + kh * khalf;
#pragma unroll 4
            for (int k = 0; k < khalf; k += 32) acc[sg] = __builtin_amdgcn_mfma_f32_16x16x32_bf16(*(const bf16x8_t*)(ap + kb + k), *(const bf16x8_t*)(bp + kb + k), acc[sg], 0, 0, 0); }
        __syncthreads();
        if (kh == 1) {
#pragma unroll
            for (int sg = 0; sg < NSEG; ++sg) red[(rt * NSEG + sg) * 64 + lane] = acc[sg]; }
        __syncthreads();
        if (kh == 0) {
#pragma unroll
            for (int sg = 0; sg < NSEG; ++sg) acc[sg] += red[(rt * NSEG + sg) * 64 + lane];
#pragma unroll
            for (int e = 0; e < 4; ++e) { float v[NSEG];
#pragma unroll
                for (int sg = 0; sg < NSEG; ++sg) v[sg] = acc[sg][e];
                epi(r0 + 4 * q + e, c0 + n, v); } }
    }
    __syncthreads();
}
struct TEpiMerge { const bf16_t* H; bf16_t* mb;
    __device__ __forceinline__ void operator()(int row, int col, const float (&v)[3]) const { const size_t t = (size_t)TP + row; const bf16_t* g = H + t * IN_WP + C_GATE + col;
        mb[t * 1024 + col] = f2bf(bf2f(g[0]) * v[0] + bf2f(g[1024]) * v[1] + bf2f(g[2048]) * v[2]); } };
struct TEpiRes { const float* xs; float* xo;
    __device__ __forceinline__ void operator()(int row, int col, const float (&v)[1]) const { xo[((size_t)TP + row) * 1024 + col] = xs[(size_t)row * 1024 + col] + v[0]; } };
struct MEpiMergeS { static constexpr bool PERM = true, AFTER_DRAIN = false; static constexpr int SEG = 8; const bf16_t* H; bf16_t* mb;
    __device__ __forceinline__ void mid(f32x4 (&acc)[2][2][4][2], const pg8::Unit& u, int wr, int wc, int fr0, int fq0, int seg) const {
        int fr = fr0, fq = fq0; asm volatile("" : "+v"(fr), "+v"(fq));
        const int row0 = u.pm * 256 + wr * 64 + fr;
#pragma unroll
        for (int bj = 0; bj < 2; ++bj) { const int col0 = u.pn * 256 + bj * 128 + wc * 32 + 8 * fq;
#pragma unroll
            for (int ai = 0; ai < 2; ++ai)
#pragma unroll
                for (int m = 0; m < 4; ++m) { const int row = row0 + ai * 128 + m * 16; const bf16_t* gp = H + (size_t)row * IN_WP + C_GATE + (seg - 1) * 1024 + col0;
                    float ga[8], gb[8]; unpack8(*(const u32x4*)gp, ga); unpack8(*(const u32x4*)(gp + 1024), gb);
#pragma unroll
                    for (int e = 0; e < 4; ++e) { acc[ai][bj][m][0][e] *= ga[e] * __builtin_amdgcn_rcpf(fmaxf(gb[e], 1e-30f)); acc[ai][bj][m][1][e] *= ga[4 + e] * __builtin_amdgcn_rcpf(fmaxf(gb[4 + e], 1e-30f)); }
                    asm volatile("" ::: "memory"); } }
    }
    __device__ __forceinline__ void operator()(const f32x4 (&acc)[2][2][4][2], const pg8::Unit& u, int wr, int wc, int fr0, int fq0) const {
        int fr = fr0, fq = fq0; asm volatile("" : "+v"(fr), "+v"(fq));
        const int row0 = u.pm * 256 + wr * 64 + fr;
#pragma unroll
        for (int bj = 0; bj < 2; ++bj) { const int col0 = u.pn * 256 + bj * 128 + wc * 32 + 8 * fq;
#pragma unroll
            for (int ai = 0; ai < 2; ++ai)
#pragma unroll
                for (int m = 0; m < 4; ++m) { const int row = row0 + ai * 128 + m * 16; float g[8]; unpack8(*(const u32x4*)(H + (size_t)row * IN_WP + C_GATE + 2048 + col0), g);
                    const f32x4 v0 = acc[ai][bj][m][0], v1 = acc[ai][bj][m][1];
                    u32x4 w; w.x = pg8::cvt_pk_bf16(v0[0] * g[0], v0[1] * g[1]); w.y = pg8::cvt_pk_bf16(v0[2] * g[2], v0[3] * g[3]); w.z = pg8::cvt_pk_bf16(v1[0] * g[4], v1[1] * g[5]); w.w = pg8::cvt_pk_bf16(v1[2] * g[6], v1[3] * g[7]);
                    *(u32x4*)(mb + (size_t)row * 1024 + col0) = w; asm volatile("" ::: "memory"); } }
    } };

__device__ __forceinline__ void ph_tr(const float* __restrict__ src, bf16_t* __restrict__ dst, int K, int N, int Npad, LAS float* tile, int rot, int ldd = 0) {
    if (ldd == 0) ldd = K;
    int tid = threadIdx.x; asm volatile("" : "+v"(tid)); const int G = gridDim.x; const int tn = Npad / 64, tk = K / 32, nt = tn * tk;
    const int first = (blockIdx.x + G - (rot % G)) % G;
    const bool al4 = (N & 3) == 0;
    for (int t = first; t < nt; t += G) {
        const int n0 = (t % tn) * 64, k0 = (t / tn) * 32;
        { const int k = tid >> 4, n4 = (tid & 15) * 4, n = n0 + n4; f32x4 v = (f32x4){0.f, 0.f, 0.f, 0.f};
          const float* sp = src + (size_t)(k0 + k) * N + n;
          if (al4 && n + 3 < N) v = *(const f32x4*)sp; else {
#pragma unroll
              for (int e = 0; e < 4; ++e) if (n + e < N) v[e] = sp[e]; }
#pragma unroll
          for (int e = 0; e < 4; ++e) tile[k * 65 + n4 + e] = v[e]; }
        __syncthreads();
        if (tid < 256) { const int n = tid >> 2, kq = (tid & 3) * 8; float f[8];
#pragma unroll
            for (int j = 0; j < 8; ++j) f[j] = tile[(kq + j) * 65 + n];
            *(u32x4*)(dst + (size_t)(n0 + n) * ldd + k0 + kq) = pack8(f); }
        __syncthreads();
    }
}
__device__ __forceinline__ void ph_rope_tab(float2* tab) {
    for (int idx = blockIdx.x * NTHR + threadIdx.x; idx < (SEQ + DEC_SEQ) * 16; idx += gridDim.x * NTHR) {
        const int p = idx >> 4, i = idx & 15; const int pos = p < SEQ ? p : PAST_LEN + (p - SEQ);
        const float inv = powf(10000.0f, -(float)i / 16.0f); const float ang = (float)pos * inv;
        const double rev = (double)ang * 0.15915494309189533576888; const float f = (float)(rev - floor(rev));
        tab[idx] = make_float2(__builtin_amdgcn_cosf(f), __builtin_amdgcn_sinf(f)); }
}
__device__ __forceinline__ void ph_rmsnorm(const float* __restrict__ xp, const float* __restrict__ xs, const float* __restrict__ g, bf16_t* __restrict__ xn, float* __restrict__ yp, float* __restrict__ ys) {
    int tid_o = threadIdx.x; asm volatile("" : "+v"(tid_o)); int lane = tid_o & 63, wave = tid_o >> 6;
    for (int t = blockIdx.x * 8 + wave; t < TT; t += gridDim.x * 8) {
        const float* x = t < TP ? xp + (size_t)t * 1024 : xs + (size_t)(t - TP) * 1024;
        f32x4 v[4]; float ss = 0.f;
#pragma unroll
        for (int i = 0; i < 4; ++i) { v[i] = *(const f32x4*)(x + i * 256 + lane * 4); ss += v[i][0] * v[i][0] + v[i][1] * v[i][1] + v[i][2] * v[i][2] + v[i][3] * v[i][3]; }
        ss = wave_sum(ss); const float r = rsqrtf(ss * (1.0f / 1024.0f) + EPS);
#pragma unroll
        for (int i = 0; i < 4; ++i) { const int c = i * 256 + lane * 4; const f32x4 gg = *(const f32x4*)(g + c); const f32x4 o = v[i] * r * gg;
            if (xn) { u32x2 w; w.x = pg8::cvt_pk_bf16(o[0], o[1]); w.y = pg8::cvt_pk_bf16(o[2], o[3]); *(u32x2*)(xn + (size_t)t * 1024 + c) = w; }
            else { float* y = t < TP ? yp + (size_t)t * 1024 : ys + (size_t)(t - TP) * 1024; *(f32x4*)(y + c) = o; } }
    }
}

constexpr int TK_RS = 1040;
__device__ __forceinline__ void tok8(KP p, int l, int tbase, int iseq0, bool smp, int sq, int lane) {
    const bf16_t* __restrict__ H = p->H; float* __restrict__ out = p->out;
    { const float* qg = p->q_norm_g + l * 384; const float* kvg = p->kv_norm_g + l * 256;
      u32x4 rq[8], rk[8];
#pragma unroll
      for (int e = 0; e < 8; ++e) { const bf16_t* h = H + (size_t)(tbase + e) * IN_WP;
          rq[e] = lane < 48 ? *(const u32x4*)(h + C_Q + lane * 8) : (u32x4){0u, 0u, 0u, 0u}; rk[e] = lane < 32 ? *(const u32x4*)(h + C_KV + lane * 8) : (u32x4){0u, 0u, 0u, 0u}; }
      f32x4 gq0 = (f32x4){0.f, 0.f, 0.f, 0.f}, gq1 = gq0, gk0 = gq0, gk1 = gq0;
      if (lane < 48) { gq0 = *(const f32x4*)(qg + lane * 8); gq1 = *(const f32x4*)(qg + lane * 8 + 4); }
      if (lane < 32) { gk0 = *(const f32x4*)(kvg + lane * 8); gk1 = *(const f32x4*)(kvg + lane * 8 + 4); }
#pragma unroll
      for (int e = 0; e < 8; ++e) { const int t = tbase + e; float q[8], kv[8]; unpack8(rq[e], q); unpack8(rk[e], kv); float s1 = 0.f, s2 = 0.f;
#pragma unroll
          for (int j = 0; j < 8; ++j) { s1 += q[j] * q[j]; s2 += kv[j] * kv[j]; }
          s1 = wave_sum(s1); s2 = wave_sum(s2); const float r1 = rsqrtf(s1 * (1.0f / 384.0f) + EPS), r2 = rsqrtf(s2 * (1.0f / 256.0f) + EPS);
#pragma unroll
          for (int j = 0; j < 4; ++j) { q[j] *= r1 * gq0[j]; q[4 + j] *= r1 * gq1[j]; kv[j] *= r2 * gk0[j]; kv[4 + j] *= r2 * gk1[j]; }
          if (lane < 48) *(u32x4*)(p->cq + (size_t)t * 384 + lane * 8) = pack8(q);
          if (lane < 32) { float* okv = (smp ? out + O_SKV + ((size_t)l * TS + (t - TP)) * 256 : out + O_PKV + ((size_t)l * TP + t) * 256) + lane * 8;
              *(f32x4*)okv = (f32x4){kv[0], kv[1], kv[2], kv[3]}; *(f32x4*)(okv + 4) = (f32x4){kv[4], kv[5], kv[6], kv[7]};
              *(u32x4*)(p->ckv + (size_t)t * 256 + lane * 8) = pack8(kv); } }
#pragma unroll
      for (int ps = 0; ps < 2; ++ps) { const int e = (lane >> 4) + 4 * ps, j = lane & 15, t = tbase + e; const bf16_t* h = H + (size_t)t * IN_WP;
          const float x1 = bf2f(h[C_KR + j]), x2 = bf2f(h[C_KR + 16 + j]); const float2 cs = p->tab[((smp ? SEQ : 0) + iseq0 + e) * 16 + j];
          const float o1 = x1 * cs.x - x2 * cs.y, o2 = x2 * cs.x + x1 * cs.y; float* okr = smp ? out + O_SKR + ((size_t)l * TS + (t - TP)) * 32 : out + O_PKR + ((size_t)l * TP + t) * 32;
          okr[j] = o1; okr[16 + j] = o2; p->Kr[(size_t)t * 32 + j] = f2bf(o1); p->Kr[(size_t)t * 32 + 16 + j] = f2bf(o2); } }
    { const float* conv_w = p->conv_w + (size_t)l * 4 * 1536; const bool last = smp || (iseq0 == SEQ - 8);
#pragma unroll 1
      for (int pi = 0; pi < 3; ++pi) { const int c0 = (pi * 64 + lane) * 8;
          u32x4 rows[11];
#pragma unroll
          for (int j = 0; j < 11; ++j) { const int u = iseq0 - 3 + j;
              if (u >= 0) rows[j] = *(const u32x4*)(H + (size_t)(tbase - 3 + j) * IN_WP + C_QKV + c0);
              else if (smp) { const float* sc = p->state_conv + (((size_t)l * DEC_BATCH + sq) * 3 + (u + 3)) * 1536 + c0; const f32x4 a = *(const f32x4*)sc, b = *(const f32x4*)(sc + 4);
                  rows[j].x = pg8::cvt_pk_bf16(a[0], a[1]); rows[j].y = pg8::cvt_pk_bf16(a[2], a[3]); rows[j].z = pg8::cvt_pk_bf16(b[0], b[1]); rows[j].w = pg8::cvt_pk_bf16(b[2], b[3]); }
              else rows[j] = (u32x4){0u, 0u, 0u, 0u}; }
          f32x4 w0[4], w1[4];
#pragma unroll
          for (int j = 0; j < 4; ++j) { w0[j] = *(const f32x4*)(conv_w + j * 1536 + c0); w1[j] = *(const f32x4*)(conv_w + j * 1536 + c0 + 4); }
          bf16_t* dst = pi == 0 ? p->qd : (pi == 1 ? p->kd : p->vd);
#pragma unroll
          for (int e = 0; e < 8; ++e) { float y[8];
#pragma unroll
              for (int k = 0; k < 8; ++k) y[k] = 0.f;
#pragma unroll
              for (int j = 0; j < 4; ++j) { float x[8]; unpack8(rows[e + j], x);
#pragma unroll
                  for (int k = 0; k < 4; ++k) { y[k] += x[k] * w0[j][k]; y[4 + k] += x[4 + k] * w1[j][k]; } }
              float ss = 0.f;
#pragma unroll
              for (int k = 0; k < 8; ++k) { y[k] = siluf_(y[k]); ss += y[k] * y[k]; }
              if (pi < 2) { ss += __shfl_xor(ss, 1); ss += __shfl_xor(ss, 2); ss += __shfl_xor(ss, 4); const float rn = rsqrtf(ss + EPS) * (pi == 0 ? 0.125f : 1.0f);
#pragma unroll
                  for (int k = 0; k < 8; ++k) y[k] *= rn; }
              *(u32x4*)(dst + (size_t)(tbase + e) * 512 + lane * 8) = pack8(y); }
          if (last) {
#pragma unroll
              for (int rr = 0; rr < 3; ++rr) { float x[8]; unpack8(rows[8 + rr], x);
                  float* oc = (smp ? out + O_SCONV + (((size_t)l * DEC_BATCH + sq) * 3 + rr) * 1536 : out + O_PCONV + (((size_t)l * 8 + (tbase >> 11)) * 3 + rr) * 1536) + c0;
                  *(f32x4*)oc = (f32x4){x[0], x[1], x[2], x[3]}; *(f32x4*)(oc + 4) = (f32x4){x[4], x[5], x[6], x[7]}; } } } }
    { const int t = tbase + (lane >> 3), hd = lane & 7; const float bb = sigmoidf_(p->BA[(size_t)t * 16 + hd]); const float x = p->BA[(size_t)t * 16 + 8 + hd] + p->dt_bias[l * 8 + hd];
      const float sp = x > 20.f ? x : log1pf(expf(x)); const float gg = -expf(p->a_log[l * 8 + hd]) * sp;
      p->bg[(size_t)t * 16 + hd] = bb; p->bg[(size_t)t * 16 + 8 + hd] = gg; }
}
__device__ __forceinline__ void ph_tok(KP p, int l, LAS unsigned char* lds) {
    int tid = threadIdx.x; asm volatile("" : "+v"(tid));
    const int lane = tid & 63, wave = __builtin_amdgcn_readfirstlane(tid >> 6), r = lane & 31, hh = lane >> 5;
    const bf16_t* __restrict__ H = p->H; float* __restrict__ out = p->out;
    for (int tile = blockIdx.x; tile < TP / 64 + 8; tile += gridDim.x) {
        const bool smp = tile >= TP / 64; const int s0 = smp ? (tile - TP / 64) * 4 : 0;
        const int t0 = smp ? TP + s0 * 8 : tile * 64, i0 = smp ? 0 : (t0 & (SEQ - 1)), b = t0 >> 11;
        __syncthreads();
        if (!smp) {
            for (int c = tid; c < 79 * 64; c += NTHR) { const int row = c >> 6, ch16 = c & 63; u32x4 v = (u32x4){0u, 0u, 0u, 0u};
                if (i0 - 15 + row >= 0) v = *(const u32x4*)(H + (size_t)(t0 - 15 + row) * IN_WP + C_POOL + ch16 * 8);
                *(LAS u32x4*)(lds + row * TK_RS + ch16 * 16) = v; }
        } else {
            for (int c = tid; c < 92 * 64; c += NTHR) { const int row = c >> 6, ch16 = c & 63, sq = row / 23, j = row - sq * 23; u32x4 v;
                if (j >= 15) v = *(const u32x4*)(H + (size_t)(t0 + sq * 8 + (j - 15)) * IN_WP + C_POOL + ch16 * 8);
                else { const float* sp = p->state_pool + (((size_t)l * DEC_BATCH + s0 + sq) * 15 + j) * 512 + ch16 * 8; const f32x4 a = *(const f32x4*)sp, bq = *(const f32x4*)(sp + 4);
                    v.x = pg8::cvt_pk_bf16(a[0], a[1]); v.y = pg8::cvt_pk_bf16(a[2], a[3]); v.z = pg8::cvt_pk_bf16(bq[0], bq[1]); v.w = pg8::cvt_pk_bf16(bq[2], bq[3]);
                    if (j >= 8) { float* so = out + O_SPOOL + (((size_t)l * DEC_BATCH + s0 + sq) * 15 + (j - 8)) * 512 + ch16 * 8; *(f32x4*)so = a; *(f32x4*)(so + 4) = bq; } }
                *(LAS u32x4*)(lds + row * TK_RS + ch16 * 16) = v; }
        }
        __syncthreads();
        if (!(smp && (wave & 1))) { const int g = wave >> 1, th = wave & 1, w = 2 << g, tk = 32 * th + r;
          const int brow = smp ? (tk >> 3) * 23 + 15 + (tk & 7) : 15 + tk; const float inv = 1.0f / (float)(smp ? w : min(i0 + tk + 1, w));
          const bf16_t* mixT = p->PmixT + ((size_t)l * 4 + g) * 128 * 128;
          f32x16 acc[4];
#pragma unroll
          for (int nt = 0; nt < 4; ++nt)
#pragma unroll
              for (int e = 0; e < 16; ++e) acc[nt][e] = 0.f;
#pragma unroll 2
          for (int ks = 0; ks < 8; ++ks) {
              const LAS unsigned char* base = lds + brow * TK_RS + (128 * g + 16 * ks + 8 * hh) * 2;
              float cur[8], sum[8]; unpack8(*(const LAS u32x4*)base, cur);
#pragma unroll
              for (int e = 0; e < 8; ++e) sum[e] = cur[e];
              for (int k = 1; k < w; ++k) { float x[8]; unpack8(*(const LAS u32x4*)(base - k * TK_RS), x);
#pragma unroll
                  for (int e = 0; e < 8; ++e) sum[e] += x[e]; }
#pragma unroll
              for (int e = 0; e < 8; ++e) sum[e] = sum[e] * inv - cur[e];
              union { u32x4 u; bf16x8_t v; } bfr; bfr.u = pack8(sum);
#pragma unroll
              for (int nt = 0; nt < 4; ++nt) { const bf16x8_t a = *(const bf16x8_t*)(mixT + (size_t)(32 * nt + r) * 128 + 16 * ks + 8 * hh);
                  acc[nt] = __builtin_amdgcn_mfma_f32_32x32x16_bf16(a, bfr.v, acc[nt], 0, 0, 0); } }
          const size_t t = (size_t)t0 + tk; const float* scl = p->pool_scale + l * 512 + 128 * g;
#pragma unroll
          for (int nt = 0; nt < 4; ++nt)
#pragma unroll
              for (int gg = 0; gg < 4; ++gg) { const int dd0 = 32 * nt + 8 * gg + 4 * hh; const u32x2 z = *(const u32x2*)(H + t * IN_WP + C_ZPOOL + 128 * g + dd0); const f32x4 sc = *(const f32x4*)(scl + dd0);
                  float v0 = acc[nt][4 * gg + 0] * sc[0] * __uint_as_float(z.x << 16), v1 = acc[nt][4 * gg + 1] * sc[1] * __uint_as_float(z.x & 0xffff0000u);
                  float v2 = acc[nt][4 * gg + 2] * sc[2] * __uint_as_float(z.y << 16), v3 = acc[nt][4 * gg + 3] * sc[3] * __uint_as_float(z.y & 0xffff0000u);
                  u32x2 o; o.x = pg8::cvt_pk_bf16(v0, v1); o.y = pg8::cvt_pk_bf16(v2, v3); *(u32x2*)(p->ya + t * 1536 + 128 * g + dd0) = o; } }
        if (!smp) { if (i0 == SEQ - 64) { for (int c = tid; c < 15 * 512; c += NTHR) { const int rr = c >> 9, ch = c & 511;
              out[O_PPOOL + (((size_t)l * 8 + b) * 15 + rr) * 512 + ch] = bf2f(*(const LAS bf16_t*)(lds + (15 + 49 + rr) * TK_RS + ch * 2)); } } }
        else { for (int c = tid; c < 4 * 8 * 512; c += NTHR) { const int sq = c >> 12, i = (c >> 9) & 7, ch = c & 511;
              out[O_SPOOL + (((size_t)l * DEC_BATCH + s0 + sq) * 15 + 7 + i) * 512 + ch] = bf2f(*(const LAS bf16_t*)(lds + (sq * 23 + 15 + i) * TK_RS + ch * 2)); } }
        if (!smp) tok8(p, l, t0 + wave * 8, i0 + wave * 8, false, 0, lane);
        else if (wave < 4) tok8(p, l, t0 + wave * 8, 0, true, s0 + wave, lane);
    }
    __syncthreads();
}

__device__ __forceinline__ void wu_delta(KP p, int l, int sq, int h, int dv) {
    int row0, L; float* so; float S[64];
    if (sq < 8) { row0 = sq * SEQ; L = SEQ; so = p->out + O_PDELTA + (((size_t)l * 8 + sq) * 8 + h) * 4096;
#pragma unroll
        for (int k = 0; k < 64; ++k) S[k] = 0.f; }
    else { const int s = sq - 8; row0 = TP + s * 8; L = DEC_SEQ; so = p->out + O_SDELTA + (((size_t)l * DEC_BATCH + s) * 8 + h) * 4096;
        const float* s0 = p->state_delta + (((size_t)l * DEC_BATCH + s) * 8 + h) * 4096;
#pragma unroll
        for (int k = 0; k < 64; ++k) S[k] = s0[k * 64 + dv]; }
    const float gn = p->dn_norm_g[l * 64 + dv];
    for (int i = 0; i < L; ++i) {
        const size_t t = (size_t)row0 + i; const u32x4* kp = (const u32x4*)(p->kd + t * 512 + h * 64); const u32x4* qp = (const u32x4*)(p->qd + t * 512 + h * 64);
        const float b = p->bg[t * 16 + h], a = __expf(p->bg[t * 16 + 8 + h]); const float v = bf2f(p->vd[t * 512 + h * 64 + dv]);
        u32x4 kk[8];
#pragma unroll
        for (int c = 0; c < 8; ++c) kk[c] = kp[c];
        float ks = 0.f;
#pragma unroll
        for (int c = 0; c < 8; ++c)
#pragma unroll
            for (int e = 0; e < 4; ++e) { const unsigned w = kk[c][e]; ks += __uint_as_float(w << 16) * S[c * 8 + 2 * e] + __uint_as_float(w & 0xffff0000u) * S[c * 8 + 2 * e + 1]; }
        const float vn = b * (v - a * ks); float o = 0.f;
#pragma unroll
        for (int c = 0; c < 8; ++c) { const u32x4 qv = qp[c];
#pragma unroll
            for (int e = 0; e < 4; ++e) { const unsigned w = kk[c][e], wq = qv[e]; const int k0 = c * 8 + 2 * e;
                S[k0] = a * S[k0] + __uint_as_float(w << 16) * vn; o += __uint_as_float(wq << 16) * S[k0];
                S[k0 + 1] = a * S[k0 + 1] + __uint_as_float(w & 0xffff0000u) * vn; o += __uint_as_float(wq & 0xffff0000u) * S[k0 + 1]; }
            asm volatile("" ::: "memory"); }
        const float ss = wave_sum(o * o); const float y = o * rsqrtf(ss * (1.0f / 64.0f) + EPS) * gn;
        p->yc[t * 1536 + h * 64 + dv] = f2bf(y * bf2f(p->H[t * IN_WP + C_ZDN + h * 64 + dv]));
    }
#pragma unroll
    for (int k = 0; k < 64; ++k) so[k * 64 + dv] = S[k];
}
__device__ __forceinline__ int sig_inv(int rho) { return (rho & 32) | ((rho & 12) << 1) | ((rho & 16) >> 2) | (rho & 3); }
constexpr int DPRE_LDS = 64 * 64 * 4 + 512;
__device__ __forceinline__ void ph_delta_pre(KP p, LAS unsigned char* lds) {
    int tid_o = threadIdx.x; asm volatile("" : "+v"(tid_o)); int lane = tid_o & 63, wave = tid_o >> 6;
    wave = __builtin_amdgcn_readfirstlane(wave);
    LAS float* Am = (LAS float*)(lds + wave * DPRE_LDS); LAS float* gcs = Am + 4096; LAS float* bts = gcs + 64;
    for (int unit = wave * gridDim.x + blockIdx.x; unit < 2048; unit += gridDim.x * 8) {
        { int t_ = threadIdx.x; asm volatile("" : "+v"(t_)); lane = t_ & 63; }
        const int r = lane & 31, hh = lane >> 5;
        const int bh = unit >> 5, ch = unit & 31, b = bh >> 3, h = bh & 7;
        const size_t t0 = (size_t)b * SEQ + ch * 64;
        bf16_t* op = p->DOP + (size_t)unit * 4 * 4096; float* up = p->DU + (size_t)unit * 4096;
        const bf16_t* kdb = p->kd + t0 * 512 + h * 64; const bf16_t* qdb = p->qd + t0 * 512 + h * 64; const bf16_t* vdb = p->vd + t0 * 512 + h * 64;
        const float* bgb = p->bg + t0 * 16 + h;
        const float beta = bgb[lane * 16]; float gc = bgb[lane * 16 + 8];
#pragma unroll
        for (int d = 1; d < 64; d <<= 1) { const float x = __shfl_up(gc, d); if (lane >= d) gc += x; }
        const float gl = __shfl(gc, 63);
        gcs[lane] = gc; bts[lane] = beta;
        if (lane == 0) p->DG[unit] = __expf(gl);
        bf16x8_t kf[2][4], qf[2][4];
        { const int voff = r * 512 + 8 * hh;
#pragma unroll
          for (int rb = 0; rb < 2; ++rb)
#pragma unroll
            for (int ks = 0; ks < 4; ++ks) { kf[rb][ks] = *(const bf16x8_t*)(kdb + (32 * rb * 512 + 16 * ks) + voff); qf[rb][ks] = *(const bf16x8_t*)(qdb + (32 * rb * 512 + 16 * ks) + voff); } }
        {
#pragma unroll
            for (int rb = 0; rb < 2; ++rb) { const float sc = __expf(gl - __shfl(gc, 32 * rb + r)); const int voff = hh * 512 + sig_inv(32 * rb + r);
#pragma unroll
                for (int ks = 0; ks < 4; ++ks) {
#pragma unroll
                    for (int jj = 0; jj < 8; ++jj) (op + 3 * 4096 + (16 * ks + jj) * 64)[voff] = f2bf(bf2f((bf16_t)kf[rb][ks][jj]) * sc);
                    asm volatile("" ::: "memory"); } } }
        f32x16 kk00, kk10, kk11, qk00, qk10, qk11;
#pragma unroll
        for (int e = 0; e < 16; ++e) { kk00[e] = 0.f; kk10[e] = 0.f; kk11[e] = 0.f; qk00[e] = 0.f; qk10[e] = 0.f; qk11[e] = 0.f; }
#pragma unroll
        for (int ks = 0; ks < 4; ++ks) {
            kk00 = __builtin_amdgcn_mfma_f32_32x32x16_bf16(kf[0][ks], kf[0][ks], kk00, 0, 0, 0);
            kk10 = __builtin_amdgcn_mfma_f32_32x32x16_bf16(kf[1][ks], kf[0][ks], kk10, 0, 0, 0);
            kk11 = __builtin_amdgcn_mfma_f32_32x32x16_bf16(kf[1][ks], kf[1][ks], kk11, 0, 0, 0);
            qk00 = __builtin_amdgcn_mfma_f32_32x32x16_bf16(qf[0][ks], kf[0][ks], qk00, 0, 0, 0);
            qk10 = __builtin_amdgcn_mfma_f32_32x32x16_bf16(qf[1][ks], kf[0][ks], qk10, 0, 0, 0);
            qk11 = __builtin_amdgcn_mfma_f32_32x32x16_bf16(qf[1][ks], kf[1][ks], qk11, 0, 0, 0);
        }
        asm volatile("s_waitcnt lgkmcnt(0)" ::: "memory");
        {
            const float gcj0 = __shfl(gc, r), gcj1 = __shfl(gc, 32 + r);
            const int p0 = hh * 256 + sig_inv(r), p1 = hh * 256 + sig_inv(32 + r);
#pragma unroll
            for (int e = 0; e < 16; ++e) { const int ib = (e & 3) + 8 * (e >> 2), il = ib + 4 * hh;
                { const int i = il, j = r; const float gi = gcs[i], bi = bts[i]; const float dec = __expf(fminf(gi - gcj0, 0.f));
                  Am[i * 64 + j] = j < i ? bi * kk00[e] * dec : 0.f; (op + 2 * 4096 + ib * 64)[p0] = f2bf(j <= i ? qk00[e] * dec : 0.f); }
                { const int i = 32 + il, j = r; const float gi = gcs[i], bi = bts[i]; const float dec = __expf(fminf(gi - gcj0, 0.f));
                  Am[i * 64 + j] = bi * kk10[e] * dec; (op + 2 * 4096 + (32 + ib) * 64)[p0] = f2bf(qk10[e] * dec); }
                { const int i = 32 + il, j = 32 + r; const float gi = gcs[i], bi = bts[i]; const float dec = __expf(fminf(gi - gcj1, 0.f));
                  Am[i * 64 + j] = j < i ? bi * kk11[e] * dec : 0.f; (op + 2 * 4096 + (32 + ib) * 64)[p1] = f2bf(j <= i ? qk11[e] * dec : 0.f); }
                asm volatile("" ::: "memory");
            }
        }
        asm volatile("s_waitcnt lgkmcnt(0)" ::: "memory");
        {
            int c; { int t_ = threadIdx.x; asm volatile("" : "+v"(t_)); c = t_ & 63; } const int pc = sig_inv(c);
            const float egc = __expf(gc);
            const int beta_i = __float_as_int(beta), egc_i = __float_as_int(egc);
            { float u[64];
#pragma unroll
              for (int i = 0; i < 64; ++i) { const float bi = __int_as_float(__builtin_amdgcn_readlane(beta_i, i)); u[i] = bi * bf2f((vdb + i * 512)[c]); }
#pragma unroll
              for (int i = 1; i < 64; ++i) { float au = u[i];
#pragma unroll
                  for (int j4 = 0; j4 < i; j4 += 4) { const f32x4 a = *(const LAS f32x4*)(Am + i * 64 + j4);
#pragma unroll
                      for (int e = 0; e < 4; ++e) if (j4 + e < i) au -= a[e] * u[j4 + e]; }
                  u[i] = au; }
#pragma unroll
              for (int i = 0; i < 64; ++i) (up + i * 64)[c] = u[i]; }
            asm volatile("" ::: "memory");
            { float w[64];
#pragma unroll
              for (int i = 0; i < 64; ++i) { const float bi = __int_as_float(__builtin_amdgcn_readlane(beta_i, i)), ei = __int_as_float(__builtin_amdgcn_readlane(egc_i, i));
                  w[i] = bi * ei * bf2f((kdb + i * 512)[c]); (op + 1 * 4096 + i * 64)[pc] = f2bf(bf2f((qdb + i * 512)[c]) * ei); }
#pragma unroll
              for (int i = 1; i < 64; ++i) { float aw = w[i];
#pragma unroll
                  for (int j4 = 0; j4 < i; j4 += 4) { const f32x4 a = *(const LAS f32x4*)(Am + i * 64 + j4);
#pragma unroll
                      for (int e = 0; e < 4; ++e) if (j4 + e < i) aw -= a[e] * w[j4 + e]; }
                  w[i] = aw; }
#pragma unroll
              for (int i = 0; i < 64; ++i) (op + i * 64)[pc] = f2bf(-w[i]); }
        }
        asm volatile("s_waitcnt lgkmcnt(0)" ::: "memory");
    }
}
__device__ __forceinline__ bf16x8_t pack_b(const f32x4& lo, const f32x4& hi) { union { u32x4 u; bf16x8_t v; } x;
    x.u.x = pg8::cvt_pk_bf16(lo[0], lo[1]); x.u.y = pg8::cvt_pk_bf16(lo[2], lo[3]); x.u.z = pg8::cvt_pk_bf16(hi[0], hi[1]); x.u.w = pg8::cvt_pk_bf16(hi[2], hi[3]); return x.v; }
__device__ __forceinline__ void wu_scan(KP p, int l, int bh, int slice, int lane) {
    const int n = lane & 15, q = lane >> 4, n0 = slice * 16, b = bh >> 3, h = bh & 7;
    f32x4 S[4];
#pragma unroll
    for (int t = 0; t < 4; ++t) S[t] = (f32x4){0.f, 0.f, 0.f, 0.f};
    const int foff = n * 64 + 8 * q;
    for (int ch = 0; ch < 32; ++ch) {
        const size_t unit = (size_t)bh * 32 + ch;
        const bf16_t* op = p->DOP + unit * 4 * 4096 + foff; const float* up = p->DU + unit * 4096 + n0 + n;
        const float eg = p->DG[unit];
        f32x4 vn[4]; bf16x8_t wf[4][2], gf[4][2], kf[4][2], tf[4][2];
#pragma unroll
        for (int mt = 0; mt < 4; ++mt) {
#pragma unroll
            for (int e = 0; e < 4; ++e) vn[mt][e] = up[(16 * mt + 4 * q + e) * 64];
#pragma unroll
            for (int ks = 0; ks < 2; ++ks) { const int o = mt * 1024 + ks * 32;
                wf[mt][ks] = *(const bf16x8_t*)(op + o); gf[mt][ks] = *(const bf16x8_t*)(op + 4096 + o);
                kf[mt][ks] = *(const bf16x8_t*)(op + 2 * 4096 + o); tf[mt][ks] = *(const bf16x8_t*)(op + 3 * 4096 + o); } }
        const bf16x8_t sb0 = pack_b(S[0], S[1]), sb1 = pack_b(S[2], S[3]);
        f32x4 o[4];
#pragma unroll
        for (int mt = 0; mt < 4; ++mt) {
            vn[mt] = __builtin_amdgcn_mfma_f32_16x16x32_bf16(wf[mt][0], sb0, vn[mt], 0, 0, 0);
            vn[mt] = __builtin_amdgcn_mfma_f32_16x16x32_bf16(wf[mt][1], sb1, vn[mt], 0, 0, 0);
            o[mt] = __builtin_amdgcn_mfma_f32_16x16x32_bf16(gf[mt][0], sb0, (f32x4){0.f, 0.f, 0.f, 0.f}, 0, 0, 0);
            o[mt] = __builtin_amdgcn_mfma_f32_16x16x32_bf16(gf[mt][1], sb1, o[mt], 0, 0, 0);
        }
        const bf16x8_t vb0 = pack_b(vn[0], vn[1]), vb1 = pack_b(vn[2], vn[3]);
#pragma unroll
        for (int mt = 0; mt < 4; ++mt) {
            o[mt] = __builtin_amdgcn_mfma_f32_16x16x32_bf16(kf[mt][0], vb0, o[mt], 0, 0, 0);
            if (mt >= 2) o[mt] = __builtin_amdgcn_mfma_f32_16x16x32_bf16(kf[mt][1], vb1, o[mt], 0, 0, 0);
            S[mt] = S[mt] * eg;
            S[mt] = __builtin_amdgcn_mfma_f32_16x16x32_bf16(tf[mt][0], vb0, S[mt], 0, 0, 0);
            S[mt] = __builtin_amdgcn_mfma_f32_16x16x32_bf16(tf[mt][1], vb1, S[mt], 0, 0, 0);
        }
        bf16_t* yo = p->yc + ((size_t)b * SEQ + ch * 64) * 1536 + h * 64 + n0 + n;
#pragma unroll
        for (int mt = 0; mt < 4; ++mt)
#pragma unroll
            for (int e = 0; e < 4; ++e) yo[(size_t)(16 * mt + 4 * q + e) * 1536] = f2bf(o[mt][e]);
    }
    float* so = p->out + O_PDELTA + (((size_t)l * 8 + b) * 8 + h) * 4096 + n0 + n;
#pragma unroll
    for (int t = 0; t < 4; ++t)
#pragma unroll
        for (int e = 0; e < 4; ++e) so[(16 * t + 4 * q + e) * 64] = S[t][e];
}
__device__ __forceinline__ void ph_delta_fin(KP p, int l) {
    int tid_o = threadIdx.x; asm volatile("" : "+v"(tid_o)); int lane = tid_o & 63, wave = tid_o >> 6;
    const int h = lane >> 3, d0 = (lane & 7) * 8;
    for (int t = blockIdx.x * 8 + wave; t < TP; t += gridDim.x * 8) {
        bf16_t* yp = p->yc + (size_t)t * 1536 + h * 64 + d0; const u32x4 raw = *(const u32x4*)yp; const u32x4 gz = *(const u32x4*)(p->H + (size_t)t * IN_WP + C_ZDN + h * 64 + d0);
        float v[8]; v[0] = __uint_as_float(raw.x << 16); v[1] = __uint_as_float(raw.x & 0xffff0000u); v[2] = __uint_as_float(raw.y << 16); v[3] = __uint_as_float(raw.y & 0xffff0000u);
        v[4] = __uint_as_float(raw.z << 16); v[5] = __uint_as_float(raw.z & 0xffff0000u); v[6] = __uint_as_float(raw.w << 16); v[7] = __uint_as_float(raw.w & 0xffff0000u);
        float z[8]; z[0] = __uint_as_float(gz.x << 16); z[1] = __uint_as_float(gz.x & 0xffff0000u); z[2] = __uint_as_float(gz.y << 16); z[3] = __uint_as_float(gz.y & 0xffff0000u);
        z[4] = __uint_as_float(gz.z << 16); z[5] = __uint_as_float(gz.z & 0xffff0000u); z[6] = __uint_as_float(gz.w << 16); z[7] = __uint_as_float(gz.w & 0xffff0000u);
        float ss = 0.f;
#pragma unroll
        for (int e = 0; e < 8; ++e) ss += v[e] * v[e];
        ss += __shfl_xor(ss, 1); ss += __shfl_xor(ss, 2); ss += __shfl_xor(ss, 4);
        const float rs = rsqrtf(ss * (1.0f / 64.0f) + EPS);
#pragma unroll
        for (int e = 0; e < 8; ++e) v[e] = v[e] * rs * p->dn_norm_g[l * 64 + d0 + e] * z[e];
        u32x4 w; w.x = pg8::cvt_pk_bf16(v[0], v[1]); w.y = pg8::cvt_pk_bf16(v[2], v[3]); w.z = pg8::cvt_pk_bf16(v[4], v[5]); w.w = pg8::cvt_pk_bf16(v[6], v[7]);
        *(u32x4*)yp = w;
    }
}

__device__ __forceinline__ void ph_att_waves(KP p, int l) {
    int tid_o = threadIdx.x; asm volatile("" : "+v"(tid_o)); int lane = tid_o & 63, wave = tid_o >> 6;
    wave = __builtin_amdgcn_readfirstlane(wave);
    const int G = gridDim.x, NW = G * 8, gw = wave * G + blockIdx.x;
    for (int d = gw; d < 256; d += NW) wu_scan(p, l, d >> 2, d & 3, lane);
    for (int d = NW - 1 - gw; d < 256; d += NW) wu_delta(p, l, 8 + (d >> 3), d & 7, lane);
}
__device__ __forceinline__ void ph_fin(KP p, int l, LAS unsigned char* lds) {
    int tid_o = threadIdx.x; asm volatile("" : "+v"(tid_o)); int lane = tid_o & 63, wave = tid_o >> 6;
    LAS float* ol = (LAS float*)(lds + wave * 1024);
    const float* w_uv = p->w_uv + (size_t)l * 256 * 512;
    const int cq = lane >> 4, d4 = lane & 15;
    for (int u = blockIdx.x * 8 + wave; u < TS * 8; u += gridDim.x * 8) {
        const int ts = u >> 3, h = u & 7, s = ts >> 3, r = (ts & 7) * 8 + h;
        const float* pb = p->part + ((size_t)s * SA_CH * 64 + r) * 258;
        float mc = -1e30f, lc = 0.f;
        if (lane < SA_CH) { mc = pb[(size_t)lane * 64 * 258 + 256]; lc = pb[(size_t)lane * 64 * 258 + 257]; }
        float M = mc;
#pragma unroll
        for (int o = 1; o < 8; o <<= 1) M = fmaxf(M, __shfl_xor(M, o));
        const float wc = lane < SA_CH ? __expf(mc - M) : 0.f; float L = lc * wc;
#pragma unroll
        for (int o = 1; o < 8; o <<= 1) L += __shfl_xor(L, o);
        const float iL = 1.0f / __int_as_float(__builtin_amdgcn_readlane(__float_as_int(L), 0));
        f32x4 acc = (f32x4){0.f, 0.f, 0.f, 0.f};
#pragma unroll
        for (int ch = 0; ch < SA_CH; ++ch) { const float w = __int_as_float(__builtin_amdgcn_readlane(__float_as_int(wc), ch)); const float* pp = pb + (size_t)ch * 64 * 258 + 4 * lane;
            const f32x2 a0 = *(const f32x2*)pp, a1 = *(const f32x2*)(pp + 2); acc[0] += w * a0[0]; acc[1] += w * a0[1]; acc[2] += w * a1[0]; acc[3] += w * a1[1]; }
        *(LAS f32x4*)(ol + 4 * lane) = acc * iL;
        asm volatile("s_waitcnt lgkmcnt(0)" ::: "memory");
        f32x4 o = (f32x4){0.f, 0.f, 0.f, 0.f}; const float* wp = w_uv + (size_t)(cq * 64) * 512 + h * 64 + 4 * d4;
#pragma unroll 16
        for (int c = 0; c < 64; ++c) { const f32x4 wv = *(const f32x4*)(wp + (size_t)c * 512); const float x = ol[cq * 64 + c]; o += wv * x; }
#pragma unroll
        for (int e = 0; e < 4; ++e) { o[e] += __shfl_xor(o[e], 16); o[e] += __shfl_xor(o[e], 32); }
        if (cq == 0) { const int t = TP + ts; const u32x2 gz = *(const u32x2*)(p->H + (size_t)t * IN_WP + C_ZMLA + h * 64 + 4 * d4);
            u32x2 w; w.x = pg8::cvt_pk_bf16(o[0] * __uint_as_float(gz.x << 16), o[1] * __uint_as_float(gz.x & 0xffff0000u)); w.y = pg8::cvt_pk_bf16(o[2] * __uint_as_float(gz.y << 16), o[3] * __uint_as_float(gz.y & 0xffff0000u));
            *(u32x2*)(p->yb + (size_t)t * 1536 + h * 64 + 4 * d4) = w; }
        asm volatile("s_waitcnt lgkmcnt(0)" ::: "memory");
    }
}

constexpr int SA_QS = 592, SA_KS = 576, SA_PS = 272;
constexpr int SA_OFF_Q = 0, SA_OFF_K = 64 * SA_QS, SA_OFF_P = SA_OFF_K + 128 * SA_KS, SA_OFF_M = SA_OFF_P + 64 * SA_PS, SA_OFF_L = SA_OFF_M + 1024, SA_LDS = SA_OFF_L + 1024;
typedef short s16x4 __attribute__((ext_vector_type(4)));
__device__ __forceinline__ void sa_unit(KP p, int l, int s, int ch, LAS unsigned char* lds, int tid) {
    const int lane = tid & 63, wave = __builtin_amdgcn_readfirstlane(tid >> 6), r = lane & 31, hh = lane >> 5;
    const int qb = wave & 1, kb = wave >> 1, cg = wave >> 1;
    LAS unsigned char* Qs = lds + SA_OFF_Q; LAS unsigned char* Kt = lds + SA_OFF_K; LAS unsigned char* Pt = lds + SA_OFF_P;
    LAS float* mloc = (LAS float*)(lds + SA_OFF_M); LAS float* lred = (LAS float*)(lds + SA_OFF_L);
    __syncthreads();
    { const float* w_uk = p->w_uk + (size_t)l * 256 * 512; const bf16_t* Qg = p->Q + (size_t)(TP + s * 8) * 768;
      const int c = tid & 255, h2 = tid >> 8;
      for (int h = h2 * 4; h < h2 * 4 + 4; ++h) { float acc[8];
#pragma unroll
          for (int i = 0; i < 8; ++i) acc[i] = 0.f;
          const float* wr_ = w_uk + (size_t)c * 512 + h * 64;
          for (int d = 0; d < 64; d += 4) { const f32x4 wv = *(const f32x4*)(wr_ + d);
#pragma unroll
              for (int i = 0; i < 8; ++i) { const bf16_t* q = Qg + i * 768 + h * 96 + d;
                  acc[i] += bf2f(q[0]) * wv[0] + bf2f(q[1]) * wv[1] + bf2f(q[2]) * wv[2] + bf2f(q[3]) * wv[3]; } }
#pragma unroll
          for (int i = 0; i < 8; ++i) *(LAS bf16_t*)(Qs + (i * 8 + h) * SA_QS + c * 2) = f2bf(acc[i]); }
      for (int e = tid; e < 64 * 32; e += NTHR) { const int rr = e >> 5, j = e & 31; *(LAS bf16_t*)(Qs + rr * SA_QS + (256 + j) * 2) = Qg[(rr >> 3) * 768 + (rr & 7) * 96 + 64 + j]; } }
    const int* pt = p->page_table + s * N_PAGES + ch * 16;
    const float* ckv_base = p->cache_kv + (size_t)l * N_POOL * PAGE * 256; const float* ckr_base = p->cache_kr + (size_t)l * N_POOL * PAGE * 32;
    f32x4 rk[16], rr2[2];
    { const int page = pt[0]; const float* kvp = ckv_base + (size_t)page * PAGE * 256; const float* krp = ckr_base + (size_t)page * PAGE * 32;
#pragma unroll
      for (int i = 0; i < 16; ++i) rk[i] = __builtin_nontemporal_load((const f32x4*)(kvp + (size_t)(tid + 512 * i) * 4));
#pragma unroll
      for (int i = 0; i < 2; ++i) rr2[i] = __builtin_nontemporal_load((const f32x4*)(krp + (size_t)(tid + 512 * i) * 4)); }
    f32x16 o0, o1;
#pragma unroll
    for (int e = 0; e < 16; ++e) { o0[e] = 0.f; o1[e] = 0.f; }
    float m = -1e30f, lw = 0.f;
    const int li = lane & 15, g1 = (lane >> 4) & 1;
    const int trOff = (8 * hh + (li >> 2)) * SA_KS + (16 * g1 + 4 * (li & 3)) * 2;
    const int ntile = ch == 7 ? 17 : 16;
    for (int t = 0; t < ntile; ++t) {
        __syncthreads();
        if (t < 16) {
#pragma unroll
            for (int i = 0; i < 16; ++i) { const int ci = tid + 512 * i, key = ci >> 6, c4 = ci & 63; u32x2 w; w.x = pg8::cvt_pk_bf16(rk[i][0], rk[i][1]); w.y = pg8::cvt_pk_bf16(rk[i][2], rk[i][3]);
                *(LAS u32x2*)(Kt + key * SA_KS + c4 * 8) = w; }
#pragma unroll
            for (int i = 0; i < 2; ++i) { const int ci = tid + 512 * i, key = ci >> 3, c4 = ci & 7; u32x2 w; w.x = pg8::cvt_pk_bf16(rr2[i][0], rr2[i][1]); w.y = pg8::cvt_pk_bf16(rr2[i][2], rr2[i][3]);
                *(LAS u32x2*)(Kt + key * SA_KS + 512 + c4 * 8) = w; }
        } else {
            for (int e = tid; e < 128 * 36; e += NTHR) { const int key = e / 36, c16 = e - key * 36; u32x4 v = (u32x4){0u, 0u, 0u, 0u};
                if (key < 8) v = c16 < 32 ? *(const u32x4*)(p->ckv + ((size_t)TP + s * 8 + key) * 256 + c16 * 8) : *(const u32x4*)(p->Kr + ((size_t)TP + s * 8 + key) * 32 + (c16 - 32) * 8);
                *(LAS u32x4*)(Kt + key * SA_KS + c16 * 16) = v; }
        }
        __syncthreads();
        if (t + 1 < 16) { const int page = pt[t + 1]; const float* kvp = ckv_base + (size_t)page * PAGE * 256; const float* krp = ckr_base + (size_t)page * PAGE * 32;
#pragma unroll
            for (int i = 0; i < 16; ++i) rk[i] = __builtin_nontemporal_load((const f32x4*)(kvp + (size_t)(tid + 512 * i) * 4));
#pragma unroll
            for (int i = 0; i < 2; ++i) rr2[i] = __builtin_nontemporal_load((const f32x4*)(krp + (size_t)(tid + 512 * i) * 4)); }
        f32x16 sa;
#pragma unroll
        for (int e = 0; e < 16; ++e) sa[e] = 0.f;
        { const LAS unsigned char* ka = Kt + (32 * kb + r) * SA_KS + 16 * hh; const LAS unsigned char* qa = Qs + (32 * qb + r) * SA_QS + 16 * hh;
#pragma unroll
          for (int ks = 0; ks < 18; ++ks) sa = __builtin_amdgcn_mfma_f32_32x32x16_bf16(*(const LAS bf16x8_t*)(ka + ks * 32), *(const LAS bf16x8_t*)(qa + ks * 32), sa, 0, 0, 0); }
        if (t == 16) { const int itok = (32 * qb + r) >> 3;
#pragma unroll
            for (int e = 0; e < 16; ++e) { const int key = 32 * kb + (e & 3) + 8 * (e >> 2) + 4 * hh; if (key > itok) sa[e] = -1e30f; } }
        float tm = sa[0];
#pragma unroll
        for (int e = 1; e < 16; ++e) tm = fmaxf(tm, sa[e]);
        tm = fmaxf(tm, __shfl_xor(tm, 32));
        if (hh == 0) mloc[kb * 64 + 32 * qb + r] = tm;
        __syncthreads();
        { const int q = 32 * qb + r; const float tmx = fmaxf(fmaxf(mloc[q], mloc[64 + q]), fmaxf(mloc[128 + q], mloc[192 + q]));
          const float mn = fmaxf(m, tmx), al = __builtin_amdgcn_exp2f((m - mn) * ATT_C), mc = mn * ATT_C; m = mn;
          float ps = 0.f;
#pragma unroll
          for (int e = 0; e < 16; ++e) { sa[e] = __builtin_amdgcn_exp2f(sa[e] * ATT_C - mc); ps += sa[e]; }
          lw = lw * al + ps;
#pragma unroll
          for (int g4 = 0; g4 < 4; ++g4) { u32x2 w; w.x = pg8::cvt_pk_bf16(sa[4 * g4], sa[4 * g4 + 1]); w.y = pg8::cvt_pk_bf16(sa[4 * g4 + 2], sa[4 * g4 + 3]);
              *(LAS u32x2*)(Pt + q * SA_PS + (32 * kb + 8 * g4 + 4 * hh) * 2) = w; }
#pragma unroll
          for (int e = 0; e < 16; ++e) { o0[e] *= al; o1[e] *= al; } }
        __syncthreads();
        { const LAS unsigned char* pa = Pt + (32 * qb + r) * SA_PS + 16 * hh; const LAS unsigned char* va = Kt + trOff + (64 * cg) * 2;
#pragma unroll
          for (int ks = 0; ks < 8; ++ks) { const bf16x8_t pb = *(const LAS bf16x8_t*)(pa + ks * 32);
              union { struct { s16x4 lo, hi; } h; bf16x8_t v; } a0, a1;
              a0.h.lo = __builtin_amdgcn_ds_read_tr16_b64_v4i16((LAS s16x4*)(va + ks * 16 * SA_KS)); a0.h.hi = __builtin_amdgcn_ds_read_tr16_b64_v4i16((LAS s16x4*)(va + ks * 16 * SA_KS + 4 * SA_KS));
              a1.h.lo = __builtin_amdgcn_ds_read_tr16_b64_v4i16((LAS s16x4*)(va + ks * 16 * SA_KS + 64)); a1.h.hi = __builtin_amdgcn_ds_read_tr16_b64_v4i16((LAS s16x4*)(va + ks * 16 * SA_KS + 4 * SA_KS + 64));
              o0 = __builtin_amdgcn_mfma_f32_32x32x16_bf16(a0.v, pb, o0, 0, 0, 0);
              o1 = __builtin_amdgcn_mfma_f32_32x32x16_bf16(a1.v, pb, o1, 0, 0, 0); } }
    }
    lw += __shfl_xor(lw, 32);
    if (hh == 0) lred[kb * 64 + 32 * qb + r] = lw;
    __syncthreads();
    { const int q = 32 * qb + r; float* pp = p->part + (((size_t)s * SA_CH + ch) * 64 + q) * 258;
#pragma unroll
      for (int cb2 = 0; cb2 < 2; ++cb2)
#pragma unroll
          for (int g4 = 0; g4 < 4; ++g4) { const int c = 32 * (2 * cg + cb2) + 8 * g4 + 4 * hh; f32x4 v;
#pragma unroll
              for (int e = 0; e < 4; ++e) v[e] = cb2 == 0 ? o0[4 * g4 + e] : o1[4 * g4 + e];
              *(f32x2*)(pp + c) = (f32x2){v[0], v[1]}; *(f32x2*)(pp + c + 2) = (f32x2){v[2], v[3]}; }
      if (cg == 0 && hh == 0) { pp[256] = m * MLA_SCALE; pp[257] = lred[q] + lred[64 + q] + lred[128 + q] + lred[192 + q]; } }
}
__device__ __forceinline__ void ph_attn_s2(KP p, int l, LAS unsigned char* lds) {
    int tid = threadIdx.x; asm volatile("" : "+v"(tid));
    for (int u = blockIdx.x; u < DEC_BATCH * 8; u += gridDim.x) sa_unit(p, l, u >> 3, u & 7, lds, tid);
    __syncthreads();
}

constexpr int ATT_KS = 208, ATT_VS = 144, ATT_KB = 64 * ATT_KS, ATT_VB = 64 * ATT_VS, ATT_STAGE = ATT_KB + ATT_VB;
__device__ __forceinline__ void attn_unit(KP p, int b, int h, int qblk, LAS unsigned char* lds, int tid, int wave, int lane) {
    const int r = lane & 31, hh = lane >> 5;
    const int q0 = qblk * 256 + wave * 32;
    const size_t trow0 = (size_t)b * SEQ;
    bf16x8_t qf[6];
    { const bf16_t* qp = p->Q + (trow0 + q0 + r) * 768 + h * 96 + 8 * hh;
#pragma unroll
      for (int ks = 0; ks < 6; ++ks) qf[ks] = *(const bf16x8_t*)(qp + 16 * ks); }
    f32x16 o0, o1;
#pragma unroll
    for (int e = 0; e < 16; ++e) { o0[e] = 0.f; o1[e] = 0.f; }
    float m = -1e30f, lsum = 0.f;
    const int ntile = qblk * 4 + 4;
    const int cA = tid, keyA = cA / 12, partA = cA - keyA * 12; const int cB = 512 + (tid & 255), keyB = cB / 12, partB = cB - keyB * 12; const bool hasB = tid < 256;
    const bf16_t* gA = partA < 8 ? p->Kn + (trow0 + keyA) * 512 + h * 64 + partA * 8 : p->Kr + (trow0 + keyA) * 32 + (partA - 8) * 8; const int stepA = partA < 8 ? 64 * 512 : 64 * 32;
    const bf16_t* gB = partB < 8 ? p->Kn + (trow0 + keyB) * 512 + h * 64 + partB * 8 : p->Kr + (trow0 + keyB) * 32 + (partB - 8) * 8; const int stepB = partB < 8 ? 64 * 512 : 64 * 32;
    const bf16_t* gV = p->Vt + (size_t)(h * 64 + (tid >> 3)) * TP + trow0 + (tid & 7) * 8;
    const int lA = keyA * ATT_KS + partA * 16, lB = keyB * ATT_KS + partB * 16, lV = ATT_KB + (tid >> 3) * ATT_VS + (tid & 7) * 16;
    const int pr_ = (r & 0x13) | ((r & 4) << 1) | ((r & 8) >> 1);
    const int kOff = pr_ * ATT_KS + 16 * hh, vOff = ATT_KB + r * ATT_VS + 16 * hh;
    u32x4 rA = *(const u32x4*)gA, rB = hasB ? *(const u32x4*)gB : (u32x4){0u, 0u, 0u, 0u}, rV = *(const u32x4*)gV;
    for (int kt = 0; kt < ntile; ++kt) {
        LAS unsigned char* st = lds + (kt & 1) * ATT_STAGE;
        *(LAS u32x4*)(st + lA) = rA; if (hasB) *(LAS u32x4*)(st + lB) = rB; *(LAS u32x4*)(st + lV) = rV;
        __syncthreads();
        if (kt + 1 < ntile) { gA += stepA; gB += stepB; gV += 64; rA = *(const u32x4*)gA; if (hasB) rB = *(const u32x4*)gB; rV = *(const u32x4*)gV; }
        if (kt * 64 <= q0 + 31) {
            f32x16 s0, s1;
#pragma unroll
            for (int e = 0; e < 16; ++e) { s0[e] = 0.f; s1[e] = 0.f; }
#pragma unroll
            for (int ks = 0; ks < 6; ++ks) {
                const bf16x8_t a0 = *(const LAS bf16x8_t*)(st + kOff + ks * 32), a1 = *(const LAS bf16x8_t*)(st + kOff + 32 * ATT_KS + ks * 32);
                s0 = __builtin_amdgcn_mfma_f32_32x32x16_bf16(a0, qf[ks], s0, 0, 0, 0);
                s1 = __builtin_amdgcn_mfma_f32_32x32x16_bf16(a1, qf[ks], s1, 0, 0, 0);
            }
            if (kt * 64 + 63 > q0) {
                const int qrel = q0 + r - kt * 64;
#pragma unroll
                for (int e = 0; e < 16; ++e) { const int kl = (e & 3) + 4 * ((e >> 2) & 1) + 8 * hh + 16 * ((e >> 3) & 1);
                    if (kl > qrel) s0[e] = -1e30f; if (kl + 32 > qrel) s1[e] = -1e30f; }
            }
            float tm = fmaxf(s0[0], s1[0]);
#pragma unroll
            for (int e = 1; e < 16; ++e) tm = fmaxf(tm, fmaxf(s0[e], s1[e]));
            tm = fmaxf(tm, __shfl_xor(tm, 32));
            const float mn = fmaxf(m, tm), al = __builtin_amdgcn_exp2f((m - mn) * ATT_C), mc = mn * ATT_C; m = mn;
            float ps = 0.f;
#pragma unroll
            for (int e = 0; e < 16; ++e) { s0[e] = __builtin_amdgcn_exp2f(s0[e] * ATT_C - mc); s1[e] = __builtin_amdgcn_exp2f(s1[e] * ATT_C - mc); ps += s0[e] + s1[e]; }
            lsum = lsum * al + ps;
#pragma unroll
            for (int e = 0; e < 16; ++e) { o0[e] *= al; o1[e] *= al; }
#pragma unroll
            for (int kb = 0; kb < 2; ++kb)
#pragma unroll
                for (int sp = 0; sp < 2; ++sp) {
                    union { u32x4 u; bf16x8_t v; } pb;
                    if (kb == 0) { pb.u.x = pg8::cvt_pk_bf16(s0[8 * sp + 0], s0[8 * sp + 1]); pb.u.y = pg8::cvt_pk_bf16(s0[8 * sp + 2], s0[8 * sp + 3]); pb.u.z = pg8::cvt_pk_bf16(s0[8 * sp + 4], s0[8 * sp + 5]); pb.u.w = pg8::cvt_pk_bf16(s0[8 * sp + 6], s0[8 * sp + 7]); }
                    else         { pb.u.x = pg8::cvt_pk_bf16(s1[8 * sp + 0], s1[8 * sp + 1]); pb.u.y = pg8::cvt_pk_bf16(s1[8 * sp + 2], s1[8 * sp + 3]); pb.u.z = pg8::cvt_pk_bf16(s1[8 * sp + 4], s1[8 * sp + 5]); pb.u.w = pg8::cvt_pk_bf16(s1[8 * sp + 6], s1[8 * sp + 7]); }
                    const int ko = (32 * kb + 16 * sp) * 2;
                    const bf16x8_t v0 = *(const LAS bf16x8_t*)(st + vOff + ko), v1 = *(const LAS bf16x8_t*)(st + vOff + 32 * ATT_VS + ko);
                    o0 = __builtin_amdgcn_mfma_f32_32x32x16_bf16(v0, pb.v, o0, 0, 0, 0);
                    o1 = __builtin_amdgcn_mfma_f32_32x32x16_bf16(v1, pb.v, o1, 0, 0, 0);
                }
        }
    }
    lsum += __shfl_xor(lsum, 32);
    const float il = 1.0f / lsum;
    const size_t t = trow0 + q0 + r;
#pragma unroll
    for (int db = 0; db < 2; ++db)
#pragma unroll
        for (int g = 0; g < 4; ++g) { const int d0 = 32 * db + 8 * g + 4 * hh;
            const u32x2 gz = *(const u32x2*)(p->H + t * IN_WP + C_ZMLA + h * 64 + d0);
            float v[4];
#pragma unroll
            for (int e = 0; e < 4; ++e) v[e] = (db == 0 ? o0[4 * g + e] : o1[4 * g + e]) * il;
            v[0] *= __uint_as_float(gz.x << 16); v[1] *= __uint_as_float(gz.x & 0xffff0000u); v[2] *= __uint_as_float(gz.y << 16); v[3] *= __uint_as_float(gz.y & 0xffff0000u);
            u32x2 w; w.x = pg8::cvt_pk_bf16(v[0], v[1]); w.y = pg8::cvt_pk_bf16(v[2], v[3]);
            *(u32x2*)(p->yb + t * 1536 + h * 64 + d0) = w; }
}
__device__ __forceinline__ void ph_attn_p(KP p, LAS unsigned char* lds) {
    int tid = threadIdx.x; asm volatile("" : "+v"(tid));
    const int lane = tid & 63, wave = __builtin_amdgcn_readfirstlane(tid >> 6);
    for (int pi = blockIdx.x; pi < 256; pi += gridDim.x) {
        const int xcd = pi & 7, k = pi >> 3, bh = xcd * 8 + (k >> 2), pr = k & 3;
        attn_unit(p, bh >> 3, bh & 7, 7 - pr, lds, tid, wave, lane);
        attn_unit(p, bh >> 3, bh & 7, pr, lds, tid, wave, lane);
    }
    __syncthreads();
}
struct MEpiVt { static constexpr bool PERM = true, AFTER_DRAIN = false; static constexpr int SEG = 0; bf16_t* O; int ldc; int pad_;
    __device__ __forceinline__ void operator()(const f32x4 (&acc)[2][2][4][2], const pg8::Unit& u, int wr, int wc, int fr0, int fq0) const {
        int fr = fr0, fq = fq0; asm volatile("" : "+v"(fr), "+v"(fq));
        const int row0 = u.pm * 256 + wr * 64 + fr;
#pragma unroll
        for (int bj = 0; bj < 2; ++bj) { const int col0 = u.pn * 256 + bj * 128 + wc * 32 + 8 * fq;
#pragma unroll
            for (int ai = 0; ai < 2; ++ai)
#pragma unroll
                for (int m = 0; m < 4; ++m) { const int row = row0 + ai * 128 + m * 16; const f32x4 v0 = acc[ai][bj][m][0], v1 = acc[ai][bj][m][1];
                    u32x4 w; w.x = pg8::cvt_pk_bf16(v0[0], v0[1]); w.y = pg8::cvt_pk_bf16(v0[2], v0[3]); w.z = pg8::cvt_pk_bf16(v1[0], v1[1]); w.w = pg8::cvt_pk_bf16(v1[2], v1[3]);
                    *(u32x4*)(O + (size_t)row * ldc + col0) = w; } }
    } };


__global__ void __launch_bounds__(NTHR, 2) k_mega(Params p_unused) {
    const KP kp0 = (KP)__builtin_amdgcn_kernarg_segment_ptr();
#define PP() ({ KP q_ = kp0; asm volatile("" : "+s"(q_)); q_; })
    KP p = PP();
    extern __shared__ __attribute__((aligned(16))) unsigned char lds_raw[];
    LAS unsigned char* lds = (LAS unsigned char*)lds_raw;
    volatile LAS unsigned* misc = (volatile LAS unsigned*)(lds + LDS_MISC);
    for (int u = threadIdx.x; u < 64; u += NTHR) misc[u] = 0u;
    __syncthreads();
    const int lo = p->ph_lo, hi = p->ph_hi;
    XcdBarrier bar; bar.bar = p->bar + p->li * XCD_BAR_WORDS; bar.x = 0; bar.st = nullptr;
    if (hi - lo > 1) bar = xcd_barrier_post(p->bar + p->li * XCD_BAR_WORDS, misc + 8);
#define IN(k) (lo <= (k) && (k) < hi)
#define SEAM(k) do { if (IN(k) && IN((k) + 1)) xcd_barrier(bar); } while (0)

    if (IN(PH_PRO)) {
        LAS float* tile = (LAS float*)lds;
        for (int l = 0; l < 2; ++l) {
            KP p = PP();
            ph_tr(p->w_in + (size_t)l * 1024 * IN_W, p->WinT + (size_t)l * IN_WP * 1024, 1024, IN_W, IN_WP, tile, 0);
            ph_tr(p->w_uq + (size_t)l * 384 * 768, p->WuqT + (size_t)l * 768 * 384, 384, 768, 768, tile, 0);
            ph_tr(p->w_uk + (size_t)l * 256 * 512, p->WkvT + (size_t)l * 1024 * 256, 256, 512, 512, tile, 144);
            ph_tr(p->w_uv + (size_t)l * 256 * 512, p->WkvT + (size_t)l * 1024 * 256 + (size_t)512 * 256, 256, 512, 512, tile, 208);
            ph_tr(p->w_br0 + (size_t)l * 512 * 1024, p->WbrT + (size_t)l * 1024 * 1536 + 0 * 512, 512, 1024, 1024, tile, 0, 1536);
            ph_tr(p->w_br1 + (size_t)l * 512 * 1024, p->WbrT + (size_t)l * 1024 * 1536 + 1 * 512, 512, 1024, 1024, tile, 0, 1536);
            ph_tr(p->w_br2 + (size_t)l * 512 * 1024, p->WbrT + (size_t)l * 1024 * 1536 + 2 * 512, 512, 1024, 1024, tile, 0, 1536);
            ph_tr(p->w_out + (size_t)l * 1024 * 1024, p->WoutT + (size_t)l * 1024 * 1024, 1024, 1024, 1024, tile, 0);
            for (int g = 0; g < 4; ++g) ph_tr(p->pool_mix + ((size_t)l * 4 + g) * 128 * 128, p->PmixT + ((size_t)l * 4 + g) * 128 * 128, 128, 128, 128, tile, 64 + 8 * g);
        }
        { KP p = PP(); ph_rope_tab(p->tab); ph_rmsnorm(p->x_prompt, p->x_sample, p->norm_g, p->xn, nullptr, nullptr); }
    }
    SEAM(PH_PRO);
    for (int l = 0; l < 2; ++l) {
        int G = gridDim.x, bid = blockIdx.x; asm volatile("" : "+s"(G), "+s"(bid));
        if (IN(PHID(l, PH_GIN))) { KP p = PP();
            pg8::Gemm g{p->xn, p->WinT + (size_t)l * IN_WP * 1024, TT, IN_WP, 1024}; pg8::StaticOrder S; S.init(TT, IN_WP, G, bid);
            MEpiH E{p->H, p->BA}; pg8::gemm_phase<MEpiH, pg8::StaticOrder, false>(lds, g, S, E, nullptr);
        }
        SEAM(PHID(l, PH_GIN));
        if (IN(PHID(l, PH_TOK))) ph_tok(PP(), l, lds);
        SEAM(PHID(l, PH_TOK));
        if (IN(PHID(l, PH_GQ))) { KP p = PP();
            pg8::Gemm g{p->cq, p->WuqT + (size_t)l * 768 * 384, TT, 768, 384}; pg8::StaticOrder S; S.init(TT, 768, G, bid);
            MEpiQ E{p->Q, p->tab}; pg8::gemm_phase<MEpiQ, pg8::StaticOrder, false>(lds, g, S, E, nullptr);
        }
        if (IN(PHID(l, PH_GQ))) { KP p = PP();
            pg8::Gemm g{p->ckv, p->WkvT + (size_t)l * 1024 * 256, TP, 512, 256}; pg8::StaticOrder S; S.init(TP, 512, G / 2, bid < G / 2 ? bid : G);
            MEpiKV E{p->Kn, p->V}; pg8::gemm_phase<MEpiKV, pg8::StaticOrder, false>(lds, g, S, E, nullptr);
        }
        if (IN(PHID(l, PH_GQ))) { KP p = PP();
            pg8::Gemm g{p->WkvT + (size_t)l * 1024 * 256 + (size_t)512 * 256, p->ckv, 512, TP, 256}; pg8::StaticOrder S; S.init(512, TP, G / 2, bid >= G / 2 ? bid - G / 2 : G);
            MEpiVt E{p->Vt, TP, 0}; pg8::gemm_phase<MEpiVt, pg8::StaticOrder, false>(lds, g, S, E, nullptr);
        }
        if (IN(PHID(l, PH_GQ))) ph_delta_pre(PP(), lds);
        SEAM(PHID(l, PH_GQ));
        if (IN(PHID(l, PH_ATT))) { const int am = PP()->pad;
            if (am & 1) ph_attn_s2(PP(), l, lds); if (am & 4) ph_attn_p(PP(), lds); if (am & 8) ph_att_waves(PP(), l); }
        SEAM(PHID(l, PH_ATT));
        if (IN(PHID(l, PH_FIN))) { ph_fin(PP(), l, lds); ph_delta_fin(PP(), l); }
        SEAM(PHID(l, PH_FIN));
        if (IN(PHID(l, PH_MERGE))) { KP p = PP();
            pg8::Gemm g{p->ya, p->WbrT + (size_t)l * 1024 * 1536, TP, 1024, 1536}; pg8::StaticOrder S; S.init(TP, 1024, G, bid);
            MEpiMergeS E{p->H, p->mb}; pg8::gemm_phase<MEpiMergeS, pg8::StaticOrder, false>(lds, g, S, E, nullptr);
        }
        if (IN(PHID(l, PH_MERGE))) { KP p = PP(); TEpiMerge E{p->H, p->mb}; tail_gemm<3, TEpiMerge>(p->ya + (size_t)TP * 1536, 1536, p->WbrT + (size_t)l * 1024 * 1536, 1536, 1024, E, lds); }
        SEAM(PHID(l, PH_MERGE));
        if (IN(PHID(l, PH_OUT))) { KP p = PP();
            const float* xp = l == 0 ? p->x_prompt : p->xres; const float* xs = l == 0 ? p->x_sample : p->xres + (size_t)TP * 1024;
            pg8::Gemm g{p->mb, p->WoutT + (size_t)l * 1024 * 1024, TP, 1024, 1024}; pg8::StaticOrder S; S.init(TP, 1024, G, bid);
            MEpiRes E{xp, xs, p->xres}; pg8::gemm_phase<MEpiRes, pg8::StaticOrder, false>(lds, g, S, E, nullptr);
        }
        if (IN(PHID(l, PH_OUT))) { KP p = PP(); TEpiRes E{l == 0 ? p->x_sample : p->xres + (size_t)TP * 1024, p->xres}; tail_gemm<1, TEpiRes>(p->mb + (size_t)TP * 1024, 1024, p->WoutT + (size_t)l * 1024 * 1024, 1024, 1024, E, lds); }
        SEAM(PHID(l, PH_OUT));
        if (IN(PHID(l, PH_NORM))) { KP p = PP();
            if (l == 0) ph_rmsnorm(p->xres, p->xres + (size_t)TP * 1024, p->norm_g + 1024, p->xn, nullptr, nullptr);
            else ph_rmsnorm(p->xres, p->xres + (size_t)TP * 1024, p->final_norm_g, nullptr, p->out + O_YP, p->out + O_YS);
        }
        SEAM(PHID(l, PH_NORM));
    }
#undef IN
#undef SEAM
}

static inline size_t al256(size_t x) { return (x + 255) & ~(size_t)255; }
extern "C" void kernel_launch(void* const* d_in, const int* in_sizes, int n_in, void* d_out, int out_size, void* d_ws, size_t ws_size, hipStream_t stream) {
    static int grid = 0;
    if (grid == 0) {
        int dev = 0, cus = 0; (void)hipGetDevice(&dev); (void)hipDeviceGetAttribute(&cus, hipDeviceAttributeMultiprocessorCount, dev);
        (void)hipFuncSetAttribute((const void*)k_mega, hipFuncAttributeMaxDynamicSharedMemorySize, LDS_BYTES);
        int per_cu = 0; (void)hipOccupancyMaxActiveBlocksPerMultiprocessor(&per_cu, (const void*)k_mega, NTHR, LDS_BYTES); (void)hipGetLastError();
        grid = cus > 0 ? cus : 256;
    }
    Params p{};
    p.x_prompt = (const float*)d_in[0]; p.x_sample = (const float*)d_in[1]; p.cache_kv = (const float*)d_in[2]; p.cache_kr = (const float*)d_in[3];
    p.state_pool = (const float*)d_in[4]; p.state_conv = (const float*)d_in[5]; p.state_delta = (const float*)d_in[6]; p.page_table = (const int*)d_in[7];
    p.norm_g = (const float*)d_in[8]; p.w_in = (const float*)d_in[9]; p.pool_mix = (const float*)d_in[10]; p.pool_scale = (const float*)d_in[11];
    p.q_norm_g = (const float*)d_in[12]; p.w_uq = (const float*)d_in[13]; p.kv_norm_g = (const float*)d_in[14]; p.w_uk = (const float*)d_in[15];
    p.w_uv = (const float*)d_in[16]; p.conv_w = (const float*)d_in[17]; p.a_log = (const float*)d_in[18]; p.dt_bias = (const float*)d_in[19];
    p.dn_norm_g = (const float*)d_in[20]; p.w_br0 = (const float*)d_in[21]; p.w_br1 = (const float*)d_in[22]; p.w_br2 = (const float*)d_in[23];
    p.w_out = (const float*)d_in[24]; p.final_norm_g = (const float*)d_in[25];
    p.out = (float*)d_out;
    char* w = (char*)d_ws; size_t off = 0;
    auto take = [&](size_t bytes) { char* q = w + off; off += al256(bytes); return q; };
    const size_t BAR_BYTES = (size_t)16 * XCD_BAR_WORDS * 4;
    p.bar = (unsigned*)take(BAR_BYTES);
    p.WinT = (bf16_t*)take((size_t)2 * IN_WP * 1024 * 2);
    p.WuqT = (bf16_t*)take((size_t)2 * 768 * 384 * 2);
    p.WkvT = (bf16_t*)take((size_t)2 * 1024 * 256 * 2);
    p.WbrT = (bf16_t*)take((size_t)2 * 3 * 1024 * 512 * 2);
    p.WoutT = (bf16_t*)take((size_t)2 * 1024 * 1024 * 2);
    p.PmixT = (bf16_t*)take((size_t)2 * 4 * 128 * 128 * 2);
    p.tab = (float2*)take((size_t)(SEQ + DEC_SEQ) * 16 * 8);
    p.xres = (float*)take((size_t)TT * 1024 * 4);
    p.xn = (bf16_t*)take((size_t)TT * 1024 * 2);
    p.H = (bf16_t*)take((size_t)TT * IN_WP * 2);
    p.BA = (float*)take((size_t)TT * 16 * 4);
    p.cq = (bf16_t*)take((size_t)TT * 384 * 2);
    p.ckv = (bf16_t*)take((size_t)TT * 256 * 2);
    p.Kr = (bf16_t*)take((size_t)TT * 32 * 2);
    p.Q = (bf16_t*)take((size_t)TT * 768 * 2);
    bf16_t* Qlat = (bf16_t*)take((size_t)TS * 8 * 288 * 2);
    p.Kn = (bf16_t*)take((size_t)TP * 512 * 2);
    p.V = (bf16_t*)take((size_t)TP * 512 * 2);
    p.Vt = (bf16_t*)take((size_t)512 * TP * 2);
    p.qd = (bf16_t*)take((size_t)TT * 512 * 2);
    p.kd = (bf16_t*)take((size_t)TT * 512 * 2);
    p.vd = (bf16_t*)take((size_t)TT * 512 * 2);
    p.bg = (float*)take((size_t)TT * 16 * 4);
    p.ya = (bf16_t*)take((size_t)TT * 1536 * 2); p.yb = p.ya + 512; p.yc = p.ya + 1024;
    p.mf = (float*)take((size_t)TT * 1024 * 4);
    p.mb = (bf16_t*)take((size_t)TT * 1024 * 2);
    p.part = (float*)take((size_t)DEC_BATCH * SA_CH * 64 * 258 * 4);
    p.DOP = (bf16_t*)take((size_t)2048 * 4 * 4096 * 2);
    p.DU = (float*)take((size_t)2048 * 4096 * 4);
    p.DG = (float*)take((size_t)2048 * 4);

    (void)hipMemsetAsync(p.bar, 0, BAR_BYTES, stream);
    p.ph_lo = 0; p.ph_hi = PH_END; p.li = 0; p.pad = 15;
    hipLaunchKernelGGL(k_mega, dim3(grid), dim3(NTHR), LDS_BYTES, stream, p);
#if defined(PROBE_REP) && PROBE_REP > 0
    for (int i = 0; i < PROBE_REP; ++i) { Params q = p; q.ph_lo = PROBE_LO; q.ph_hi = PROBE_HI; q.li = 1 + i; q.pad = PROBE_MASK; hipLaunchKernelGGL(k_mega, dim3(grid), dim3(NTHR), LDS_BYTES, stream, q); }
#endif
}
```

```cpp
#include <hip/hip_runtime.h>
#include <stdint.h>

typedef unsigned short bf16_t;

#define D_MODEL 1024
#define TP 16384
#define TS 256
#define TT (TP + TS)
#define SEQ 2048
#define DEC_SEQ 8
#define DEC_BATCH 32
#define PAST_LEN 16384
#define PAGE 128
#define N_PAGES 128
#define N_POOL 5120
#define IN_W 7344
#define IN_WP 7424
#define C_POOL 0
#define C_ZPOOL 512
#define C_Q 1024
#define C_KV 1408
#define C_KR 1664
#define C_ZMLA 1696
#define C_QKV 2208
#define C_ZDN 3744
#define C_BETA 4256
#define C_ALPHA 4264
#define C_GATE 4272
#define EPS 1e-6f
#define MLA_SCALE 0.10206207261596577f
#define ATT_C 0.14724444831554004f

#define O_YP 0
#define O_YS (O_YP + 16777216)
#define O_PKV (O_YS + 262144)
#define O_PKR (O_PKV + 8388608)
#define O_PPOOL (O_PKR + 1048576)
#define O_PCONV (O_PPOOL + 122880)
#define O_PDELTA (O_PCONV + 73728)
#define O_SKV (O_PDELTA + 524288)
#define O_SKR (O_SKV + 131072)
#define O_SPOOL (O_SKR + 16384)
#define O_SCONV (O_SPOOL + 491520)
#define O_SDELTA (O_SCONV + 294912)
#define O_END (O_SDELTA + 2097152)

__device__ __forceinline__ float bf2f(bf16_t b) { return __uint_as_float(((unsigned)b) << 16); }
__device__ __forceinline__ bf16_t f2bf(float f) { unsigned u = __float_as_uint(f); u += 0x7FFFu + ((u >> 16) & 1u); return (bf16_t)(u >> 16); }
__device__ __forceinline__ float sigmoidf_(float v) { return 1.0f / (1.0f + __expf(-v)); }
__device__ __forceinline__ float siluf_(float v) { return v / (1.0f + __expf(-v)); }
__device__ __forceinline__ float wave_sum(float v) {
#pragma unroll
    for (int o = 32; o >= 1; o >>= 1) v += __shfl_xor(v, o);
    return v;
}

#define SA_CH 8
namespace pg8 {
#define PG8_LAS __attribute__((address_space(3)))
typedef unsigned short bf16_t;
typedef short bf16x8 __attribute__((ext_vector_type(8)));
typedef float f32x4 __attribute__((ext_vector_type(4)));
typedef unsigned u32x4 __attribute__((ext_vector_type(4)));
constexpr int BM = 256, BK = 64, HALF = 128, HTB = HALF * BK * 2  , STAGE_BYTES = 8 * HTB, NXCD = 8, WGM = 8;

__host__ __device__ __forceinline__ int lds_byte(int r, int c) { const int st = (r >> 4) * 2 + (c >> 5), rr = r & 15, cc = c & 31, ob = rr * 64 + cc * 2; return st * 1024 + (ob ^ (((ob >> 9) & 1) << 5)); }
__host__ __device__ __forceinline__ void stage_rc(int b, int& R, int& C) { const int st = b / 1024, sb = b % 1024, swz = sb ^ (((sb >> 9) & 1) << 5); R = (st >> 1) * 16 + swz / 64; C = (st & 1) * 32 + (swz % 64) / 2; }
__host__ __device__ __forceinline__ int perm32(int rho) { const int n = rho >> 4, i = rho & 15; return 8 * (i >> 2) + 4 * n + (i & 3); }

struct Unit { int pm, pn; };
struct Gemm { const bf16_t* A; const bf16_t* Bt; int M, N, K; };

struct StaticOrder {
    int nM, nN, nwg, G, c;
    __host__ __device__ void init(int M, int N, int G_, int c_) { nM = M / BM; nN = N / BM; nwg = nM * nN; G = G_; c = c_; }
    __host__ __device__ bool next(int i, Unit& u) const {
        const long L = (long)i * G + c; if (L >= nwg) return false;
        int wgid = (int)L; { const int q = nwg / NXCD, r = nwg % NXCD, xcd = wgid % NXCD, off = wgid / NXCD; wgid = (xcd < r ? xcd * (q + 1) : r * (q + 1) + (xcd - r) * q) + off; }
        const int nig = WGM * nN, gid = wgid / nig, fm = gid * WGM, gsz = (nM - fm) < WGM ? (nM - fm) : WGM;
        u.pm = fm + ((wgid % nig) % gsz); u.pn = (wgid % nig) / gsz; return true;
    }
    __device__ __forceinline__ void a_ready(const Unit&) const {}
    __device__ __forceinline__ void done(const Unit&) const {}
};
typedef __bf16 bf16n2 __attribute__((ext_vector_type(2)));
__device__ __forceinline__ unsigned cvt_pk_bf16(float lo, float hi) { typedef float f2_ __attribute__((ext_vector_type(2))); const f2_ v = {lo, hi}; return __builtin_bit_cast(unsigned, __builtin_convertvector(v, bf16n2)); }
typedef float f32x2 __attribute__((ext_vector_type(2)));
template <class Epi, class Sched, bool STAMP = false>
__device__ __forceinline__ void gemm_phase(PG8_LAS unsigned char* lds, const Gemm g, const Sched& S, const Epi& E, unsigned long long* stamps) {
    int tid_ = threadIdx.x; asm volatile("" : "+v"(tid_));
    const int tid = tid_, wid = __builtin_amdgcn_readfirstlane(tid >> 6), lane = tid & 63, wr = wid >> 2, wc = wid & 3, fr = lane & 15, fq = lane >> 4;
    int K_ = g.K; asm volatile("" : "+s"(K_));
    const int K = K_, nt = K / BK;
    int ts_lo = 0, ts_hi = 0, nts = 0; const unsigned long long rt_entry = STAMP ? (unsigned long long)wall_clock64() : 0ull;
#define PG8_STAMP() do { if (STAMP && wid == 0 && nts < 64) { const unsigned long long _c = (unsigned long long)clock64(); \
        ts_lo = (lane == nts) ? (int)(unsigned)_c : ts_lo; ts_hi = (lane == nts) ? (int)(unsigned)(_c >> 32) : ts_hi; ++nts; } } while (0)
    PG8_STAMP();
    unsigned voffA[2], voffB[2];
#pragma unroll
    for (int i = 0; i < 2; ++i) { int R, C; stage_rc(tid * 16 + i * 8192, R, C); const int Rb = Epi::PERM ? ((R & ~31) + perm32(R & 31)) : R;
        voffA[i] = (unsigned)(R * K + C) * 2u; voffB[i] = (unsigned)(Rb * K + C) * 2u; }
    const size_t kstep = (size_t)(BK * 2);
    const size_t hstep = (size_t)HALF * K * 2;
    const size_t tstep = 2 * hstep;
    const unsigned ldsw = (unsigned)wid * 1024u;
    const int aoff = lds_byte(wr * 64 + fr, fq * 8), boff = lds_byte(wc * 32 + fr, fq * 8);
#define PG8_SA(b, h) (((b) * 2 + (h)) * HTB)
#define PG8_SB(b, h) ((4 + (b) * 2 + (h)) * HTB)
#define PG8_STAGE(bufoff, gbase, voff) do { _Pragma("unroll") for (int _i = 0; _i < 2; ++_i) \
        __builtin_amdgcn_global_load_lds((const unsigned*)((const char*)(gbase) + (voff)[_i]), (PG8_LAS unsigned*)(lds + (bufoff) + ldsw + _i * 8192), 16, 0, 0); } while (0)
#define PG8_LDA(dst, b, h) do { _Pragma("unroll") for (int m = 0; m < 4; ++m) _Pragma("unroll") for (int k = 0; k < 2; ++k) dst[m][k] = *(const PG8_LAS bf16x8*)(lds + PG8_SA(b, h) + aoff + m * 2048 + k * 1024); } while (0)
#define PG8_LDB(dst, b, h) do { _Pragma("unroll") for (int n = 0; n < 2; ++n) _Pragma("unroll") for (int k = 0; k < 2; ++k) dst[n][k] = *(const PG8_LAS bf16x8*)(lds + PG8_SB(b, h) + boff + n * 2048 + k * 1024); } while (0)
#define PG8_MMA(ai, bj, At, Bt) do { __builtin_amdgcn_s_setprio(1); _Pragma("unroll") for (int m = 0; m < 4; ++m) _Pragma("unroll") for (int n = 0; n < 2; ++n) _Pragma("unroll") for (int k = 0; k < 2; ++k) \
        acc[ai][bj][m][n] = __builtin_amdgcn_mfma_f32_16x16x32_bf16(Bt[n][k], At[m][k], acc[ai][bj][m][n], 0, 0, 0); __builtin_amdgcn_s_setprio(0); } while (0)
#define PG8_WAIT_V(n) asm volatile("s_waitcnt vmcnt(" #n ")" ::: "memory")
#define PG8_WAIT_L(n) asm volatile("s_waitcnt lgkmcnt(" #n ")" ::: "memory")
#define PG8_BAR __builtin_amdgcn_s_barrier()
#define PG8_SCHED __builtin_amdgcn_sched_barrier(0)
    Unit cur, nxt; int ui = 0;
    if (!S.next(0, cur)) return;
    f32x4 acc[2][2][4][2];
#pragma unroll
    for (int a = 0; a < 2; ++a)
#pragma unroll
        for (int b = 0; b < 2; ++b)
#pragma unroll
            for (int m = 0; m < 4; ++m)
#pragma unroll
                for (int n = 0; n < 2; ++n) acc[a][b][m][n] = (f32x4){0.f, 0.f, 0.f, 0.f};
    bf16x8 At[4][2], B0[2][2], B1[2][2];
    const char* cA = (const char*)g.A + (size_t)cur.pm * tstep; const char* cB = (const char*)g.Bt + (size_t)cur.pn * tstep;
    S.a_ready(cur);
    PG8_STAGE(PG8_SB(0, 0), cB, voffB); PG8_STAGE(PG8_SA(0, 0), cA, voffA); PG8_STAGE(PG8_SB(0, 1), cB + hstep, voffB); PG8_STAGE(PG8_SA(0, 1), cA + hstep, voffA);
    if (wr == 1) PG8_BAR;
    PG8_WAIT_V(4); PG8_BAR;
    PG8_STAGE(PG8_SB(1, 0), cB + kstep, voffB); PG8_STAGE(PG8_SA(1, 0), cA + kstep, voffA); PG8_STAGE(PG8_SB(1, 1), cB + hstep + kstep, voffB);
    PG8_WAIT_V(6); PG8_BAR;
    PG8_STAMP();
    for (;;) {
        const bool has_next = S.next(ui + 1, nxt);
        const char* nA = has_next ? (const char*)g.A + (size_t)nxt.pm * tstep : cA; const char* nB = has_next ? (const char*)g.Bt + (size_t)nxt.pn * tstep : cB;
_Pragma("nounroll")
        for (int t = 0; t < nt; t += 2) {
            const bool last = (t == nt - 2);
            const char* a1 = cA + (size_t)(t + 1) * kstep;
            const char* a2 = last ? nA : cA + (size_t)(t + 2) * kstep; const char* b2 = last ? nB : cB + (size_t)(t + 2) * kstep;
            const char* a3 = a2 + kstep; const char* b3 = b2 + kstep;
            if (last && has_next) S.a_ready(nxt);
            if constexpr (Epi::SEG > 0) { if (t != 0 && (t % Epi::SEG) == 0) E.mid(acc, cur, wr, wc, fr, fq, t / Epi::SEG); }
            PG8_LDB(B0, 0, 0); PG8_SCHED; PG8_LDA(At, 0, 0); PG8_STAGE(PG8_SA(1, 1), a1 + hstep, voffA);
            PG8_WAIT_L(8); PG8_BAR; PG8_WAIT_L(0); PG8_MMA(0, 0, At, B0); PG8_BAR; PG8_SCHED;
            PG8_LDB(B1, 0, 1); PG8_STAGE(PG8_SB(0, 0), b2, voffB);
            PG8_BAR; PG8_WAIT_L(0); PG8_MMA(0, 1, At, B1); PG8_BAR;
            PG8_LDA(At, 0, 1); PG8_STAGE(PG8_SA(0, 0), a2, voffA);
            PG8_BAR; PG8_WAIT_L(0); PG8_MMA(1, 0, At, B0); PG8_BAR; PG8_SCHED;
            PG8_STAGE(PG8_SB(0, 1), b2 + hstep, voffB);
            PG8_WAIT_V(6); PG8_BAR; PG8_MMA(1, 1, At, B1); PG8_BAR;
            PG8_LDB(B0, 1, 0); PG8_SCHED; PG8_LDA(At, 1, 0); PG8_STAGE(PG8_SA(0, 1), a2 + hstep, voffA);
            PG8_WAIT_L(8); PG8_BAR; PG8_WAIT_L(0); PG8_MMA(0, 0, At, B0); PG8_BAR; PG8_SCHED;
            PG8_LDB(B1, 1, 1); PG8_STAGE(PG8_SB(1, 0), b3, voffB);
            PG8_BAR; PG8_WAIT_L(0); PG8_MMA(0, 1, At, B1); PG8_BAR;
            PG8_LDA(At, 1, 1); PG8_STAGE(PG8_SA(1, 0), a3, voffA);
            PG8_BAR; PG8_WAIT_L(0); PG8_MMA(1, 0, At, B0); PG8_BAR; PG8_SCHED;
            PG8_STAGE(PG8_SB(1, 1), b3 + hstep, voffB);
            PG8_WAIT_V(6); PG8_BAR; PG8_MMA(1, 1, At, B1); PG8_BAR;
        }
        PG8_STAMP();
        if constexpr (!Epi::AFTER_DRAIN) { E(acc, cur, wr, wc, fr, fq); S.done(cur); }
        PG8_STAMP();
        if (!has_next) break;
#pragma unroll
        for (int a = 0; a < 2; ++a)
#pragma unroll
            for (int b = 0; b < 2; ++b)
#pragma unroll
                for (int m = 0; m < 4; ++m)
#pragma unroll
                    for (int n = 0; n < 2; ++n) acc[a][b][m][n] = (f32x4){0.f, 0.f, 0.f, 0.f};
        cur = nxt; cA = nA; cB = nB; ++ui;
    }
    PG8_WAIT_V(0);
    if (wr == 0) PG8_BAR;
    PG8_BAR;
    if constexpr (Epi::AFTER_DRAIN) { E.fused(acc, cur, wr, wc, fr, fq, lds, wid, lane); S.done(cur); }
    PG8_STAMP();
    if (STAMP && wid == 0) { stamps[lane] = lane < nts ? (((unsigned long long)(unsigned)ts_hi << 32) | (unsigned)ts_lo) : 0ull;
        if (lane == 62) stamps[62] = rt_entry; if (lane == 63) stamps[63] = (unsigned long long)wall_clock64(); }
#undef PG8_STAMP
#undef PG8_SA
#undef PG8_SB
#undef PG8_STAGE
#undef PG8_LDA
#undef PG8_LDB
#undef PG8_MMA
#undef PG8_WAIT_V
#undef PG8_WAIT_L
#undef PG8_BAR
#undef PG8_SCHED
}

}
#define XB_TMO      128
#define XB_XCNT(j)  (256  + 64 * (j))
#define XB_XSUB(j)  (1280 + 64 * (j))
#define XB_XGEN(j)  (2304 + 64 * (j))
#define XB_TOP      3328
#define XB_TOPGEN   3392
#define XCD_BAR_WORDS 3456
#define XB_SPIN_CAP (1u << 18)
#define LAS __attribute__((address_space(3)))

__device__ __forceinline__ unsigned xb_ld(unsigned* p)              { return __hip_atomic_load(p, __ATOMIC_RELAXED, __HIP_MEMORY_SCOPE_AGENT); }
__device__ __forceinline__ unsigned xb_add(unsigned* p, unsigned v) { return __hip_atomic_fetch_add(p, v, __ATOMIC_RELAXED, __HIP_MEMORY_SCOPE_AGENT); }
__device__ __forceinline__ unsigned xb_xcc_id() { return (unsigned)__builtin_amdgcn_s_getreg((3 << 11) | 20) & 0xFu; }
#define XB_SPIN(cond, bar) do { unsigned _sp = 0; while (cond) { __builtin_amdgcn_s_sleep(1); \
    if ((++_sp & 255u) == 0u) { if (xb_ld(&(bar)[XB_TMO])) break; if (_sp > XB_SPIN_CAP) { atomicAdd(&(bar)[XB_TMO], 1u); break; } } } } while (0)

struct XcdBarrier {
    unsigned* bar; unsigned x;
    volatile LAS unsigned* st;
};

__device__ __forceinline__ XcdBarrier xcd_barrier_post(unsigned* bar, volatile LAS unsigned* st) {
    XcdBarrier b; b.bar = bar; b.x = xb_xcc_id(); b.st = st;
    if (threadIdx.x == 0) (void)xb_add(&bar[XB_XCNT(b.x)], 1u);
    return b;
}
__device__ __forceinline__ void xcd_barrier_complete(unsigned* bar, unsigned x, unsigned& nloc, unsigned& nx) {
    const unsigned G = gridDim.x * gridDim.y * gridDim.z;
    unsigned sum, cnt, mine, sp = 0u;
    for (;;) {
        sum = 0u; cnt = 0u; mine = 0u;
#pragma unroll
        for (unsigned j = 0; j < 16; ++j) { const unsigned c = xb_ld(&bar[XB_XCNT(j)]); sum += c; cnt += (c > 0u) ? 1u : 0u; mine = (j == x) ? c : mine; }
        if (sum == G) break;
        __builtin_amdgcn_s_sleep(1);
        if ((++sp & 255u) == 0u) { if (xb_ld(&bar[XB_TMO])) break; if (sp > XB_SPIN_CAP) { atomicAdd(&bar[XB_TMO], 1u); break; } }
    }
    nloc = mine > 0u ? mine : 1u; nx = cnt > 0u ? cnt : 1u;
}

__device__ __forceinline__ void xcd_barrier(const XcdBarrier& b) {
    asm volatile("s_waitcnt vmcnt(0)" ::: "memory");
    __syncthreads();
    if (threadIdx.x == 0) {
        unsigned* bar = b.bar;
        __builtin_amdgcn_s_waitcnt(0);
        unsigned nloc = b.st[0], nx = b.st[1];
        if (nloc == 0u) { xcd_barrier_complete(bar, b.x, nloc, nx); b.st[0] = nloc; b.st[1] = nx; }
        const unsigned old = xb_add(&bar[XB_XSUB(b.x)], 1u);
        const unsigned gen = old / nloc;
        if (old + 1u == (gen + 1u) * nloc) {
            __builtin_amdgcn_fence(__ATOMIC_RELEASE, "agent");
            asm volatile("s_waitcnt vmcnt(0)" ::: "memory");
            const unsigned og = xb_add(&bar[XB_TOP], 1u);
            const unsigned tg = og / nx;
            if (og + 1u == (tg + 1u) * nx) xb_add(&bar[XB_TOPGEN], 1u);
            else XB_SPIN(xb_ld(&bar[XB_TOPGEN]) == tg, bar);
            __builtin_amdgcn_fence(__ATOMIC_ACQUIRE, "agent");
            xb_add(&bar[XB_XGEN(b.x)], 1u);
            asm volatile("s_waitcnt vmcnt(0)" ::: "memory");
        } else {
            XB_SPIN(xb_ld(&bar[XB_XGEN(b.x)]) == gen, bar);
            __builtin_amdgcn_fence(__ATOMIC_ACQUIRE, "agent");
            asm volatile("s_waitcnt vmcnt(0)" ::: "memory");
        }
    }
    __syncthreads();
}


#define LAS __attribute__((address_space(3)))
typedef float f32x4 __attribute__((ext_vector_type(4)));
typedef unsigned u32x4 __attribute__((ext_vector_type(4)));
typedef unsigned u32x2 __attribute__((ext_vector_type(2)));
typedef float f32x2 __attribute__((ext_vector_type(2)));
typedef short bf16x8_t __attribute__((ext_vector_type(8)));
typedef float f32x16 __attribute__((ext_vector_type(16)));
constexpr int NTHR = 512;
constexpr int LDS_BYTES = 147456;
constexpr int LDS_MISC = LDS_BYTES - 256;

struct Params {
    const float *x_prompt, *x_sample, *cache_kv, *cache_kr, *state_pool, *state_conv, *state_delta; const int* page_table;
    const float *norm_g, *w_in, *pool_mix, *pool_scale, *q_norm_g, *w_uq, *kv_norm_g, *w_uk, *w_uv, *conv_w, *a_log, *dt_bias, *dn_norm_g, *w_br0, *w_br1, *w_br2, *w_out, *final_norm_g;
    float* out;
    bf16_t *WinT, *WuqT, *WkvT, *WbrT, *WoutT, *PmixT; float2* tab;
    float* xres; bf16_t* xn; bf16_t* H; float* BA; bf16_t *cq, *ckv, *Kr, *Q, *Kn, *V, *Vt, *qd, *kd, *vd; float* bg; bf16_t *ya, *yb, *yc; float* mf; bf16_t* mb; float* part; bf16_t* DOP; float* DU; float* DG;
    unsigned* bar;
    int ph_lo, ph_hi, li, pad;
};

typedef const __attribute__((address_space(4))) Params* KP;

constexpr int PH_PRO = 0;
constexpr int PH_L = 8;
constexpr int PH_GIN = 0, PH_TOK = 1, PH_GQ = 2, PH_ATT = 3, PH_FIN = 4, PH_MERGE = 5, PH_OUT = 6, PH_NORM = 7;
#define PHID(l, k) (1 + (l) * PH_L + (k))
constexpr int PH_END = 1 + 2 * PH_L;

__device__ __forceinline__ void unpack8(const u32x4 v, float (&f)[8]) {
    f[0] = __uint_as_float(v.x << 16); f[1] = __uint_as_float(v.x & 0xffff0000u); f[2] = __uint_as_float(v.y << 16); f[3] = __uint_as_float(v.y & 0xffff0000u);
    f[4] = __uint_as_float(v.z << 16); f[5] = __uint_as_float(v.z & 0xffff0000u); f[6] = __uint_as_float(v.w << 16); f[7] = __uint_as_float(v.w & 0xffff0000u); }
__device__ __forceinline__ u32x4 pack8(const float (&f)[8]) { u32x4 w; w.x = pg8::cvt_pk_bf16(f[0], f[1]); w.y = pg8::cvt_pk_bf16(f[2], f[3]); w.z = pg8::cvt_pk_bf16(f[4], f[5]); w.w = pg8::cvt_pk_bf16(f[6], f[7]); return w; }
struct MEpiH { static constexpr bool PERM = true, AFTER_DRAIN = false; static constexpr int SEG = 0; bf16_t* H; float* BA;
    __device__ __forceinline__ void operator()(const f32x4 (&acc)[2][2][4][2], const pg8::Unit& u, int wr, int wc, int fr0, int fq0) const {
        int fr = fr0, fq = fq0; asm volatile("" : "+v"(fr), "+v"(fq));
        const int row0 = u.pm * 256 + wr * 64 + fr;
#pragma unroll
        for (int bj = 0; bj < 2; ++bj) {
            const int wcol = u.pn * 256 + bj * 128 + wc * 32, col0 = wcol + 8 * fq;
            const bool plain = (wcol + 32 <= C_ZPOOL) || (wcol >= C_Q && wcol + 32 <= C_ZMLA) || (wcol >= C_QKV && wcol + 32 <= C_ZDN);
            const int act = ((col0 >= C_ZPOOL && col0 < C_Q) || (col0 >= C_ZMLA && col0 < C_QKV) || (col0 >= C_ZDN && col0 < C_BETA)) ? 1 : (col0 >= C_GATE ? 2 : 0);
            const bool isba = (col0 == C_BETA) || (col0 == C_ALPHA);
#pragma unroll
            for (int ai = 0; ai < 2; ++ai)
#pragma unroll
                for (int m = 0; m < 4; ++m) { const int row = row0 + ai * 128 + m * 16; f32x4 v0 = acc[ai][bj][m][0], v1 = acc[ai][bj][m][1];
                    if (!plain) {
                        if (isba) { float* b = BA + (size_t)row * 16 + (col0 - C_BETA); *(f32x4*)b = v0; *(f32x4*)(b + 4) = v1; }
#pragma unroll
                        for (int e = 0; e < 4; ++e) { const float s0 = sigmoidf_(v0[e]), s1 = sigmoidf_(v1[e]);
                            v0[e] = act == 0 ? v0[e] : (act == 1 ? v0[e] * s0 : s0); v1[e] = act == 0 ? v1[e] : (act == 1 ? v1[e] * s1 : s1); }
                    }
                    u32x4 w; w.x = pg8::cvt_pk_bf16(v0[0], v0[1]); w.y = pg8::cvt_pk_bf16(v0[2], v0[3]); w.z = pg8::cvt_pk_bf16(v1[0], v1[1]); w.w = pg8::cvt_pk_bf16(v1[2], v1[3]);
                    *(u32x4*)(H + (size_t)row * IN_WP + col0) = w; }
        }
    } };
struct MEpiQ { static constexpr bool PERM = true, AFTER_DRAIN = false; static constexpr int SEG = 0; bf16_t* Q; const float2* tab;
    __device__ __forceinline__ void operator()(const f32x4 (&acc)[2][2][4][2], const pg8::Unit& u, int wr, int wc, int fr0, int fq0) const {
        int fr = fr0, fq = fq0; asm volatile("" : "+v"(fr), "+v"(fq));
        const int row0 = u.pm * 256 + wr * 64 + fr;
#pragma unroll
        for (int bj = 0; bj < 2; ++bj) {
            const int wcol = u.pn * 256 + bj * 128 + wc * 32, col0 = wcol + 8 * fq;
            const bool rope = (wcol % 96) == 64;
#pragma unroll
            for (int ai = 0; ai < 2; ++ai)
#pragma unroll
                for (int m = 0; m < 4; ++m) { const int row = row0 + ai * 128 + m * 16; f32x4 v0 = acc[ai][bj][m][0], v1 = acc[ai][bj][m][1];
                    if (rope) { const int p = row < TP ? (row & (SEQ - 1)) : SEQ + ((row - TP) & 7); const float2* tp = tab + p * 16 + (fq & 1) * 8; const bool hi = fq >= 2;
#pragma unroll
                        for (int e = 0; e < 4; ++e) { const float o0 = __shfl_xor(v0[e], 32), o1 = __shfl_xor(v1[e], 32); const float2 c0 = tp[e], c1 = tp[4 + e];
                            v0[e] = hi ? (v0[e] * c0.x + o0 * c0.y) : (v0[e] * c0.x - o0 * c0.y); v1[e] = hi ? (v1[e] * c1.x + o1 * c1.y) : (v1[e] * c1.x - o1 * c1.y); } }
                    u32x4 w; w.x = pg8::cvt_pk_bf16(v0[0], v0[1]); w.y = pg8::cvt_pk_bf16(v0[2], v0[3]); w.z = pg8::cvt_pk_bf16(v1[0], v1[1]); w.w = pg8::cvt_pk_bf16(v1[2], v1[3]);
                    *(u32x4*)(Q + (size_t)row * 768 + col0) = w; asm volatile("" ::: "memory"); }
        }
    } };
struct MEpiKV { static constexpr bool PERM = true, AFTER_DRAIN = false; static constexpr int SEG = 0; bf16_t* Kn; bf16_t* V;
    __device__ __forceinline__ void operator()(const f32x4 (&acc)[2][2][4][2], const pg8::Unit& u, int wr, int wc, int fr0, int fq0) const {
        int fr = fr0, fq = fq0; asm volatile("" : "+v"(fr), "+v"(fq));
        const int row0 = u.pm * 256 + wr * 64 + fr; bf16_t* base = u.pn < 2 ? Kn : V; const int cb = (u.pn & 1) * 256;
#pragma unroll
        for (int bj = 0; bj < 2; ++bj) { const int col0 = cb + bj * 128 + wc * 32 + 8 * fq;
#pragma unroll
            for (int ai = 0; ai < 2; ++ai)
#pragma unroll
                for (int m = 0; m < 4; ++m) { const int row = row0 + ai * 128 + m * 16; const f32x4 v0 = acc[ai][bj][m][0], v1 = acc[ai][bj][m][1];
                    u32x4 w; w.x = pg8::cvt_pk_bf16(v0[0], v0[1]); w.y = pg8::cvt_pk_bf16(v0[2], v0[3]); w.z = pg8::cvt_pk_bf16(v1[0], v1[1]); w.w = pg8::cvt_pk_bf16(v1[2], v1[3]);
                    *(u32x4*)(base + (size_t)row * 512 + col0) = w; } }
    } };
template <int BR> struct MEpiMerge { static constexpr bool PERM = true, AFTER_DRAIN = false; static constexpr int SEG = 0; const bf16_t* H; float* mf; bf16_t* mb;
    __device__ __forceinline__ void operator()(const f32x4 (&acc)[2][2][4][2], const pg8::Unit& u, int wr, int wc, int fr0, int fq0) const {
        int fr = fr0, fq = fq0; asm volatile("" : "+v"(fr), "+v"(fq));
        const int row0 = u.pm * 256 + wr * 64 + fr;
#pragma unroll
        for (int bj = 0; bj < 2; ++bj) { const int col0 = u.pn * 256 + bj * 128 + wc * 32 + 8 * fq;
#pragma unroll
            for (int ai = 0; ai < 2; ++ai)
#pragma unroll
                for (int m = 0; m < 4; ++m) { const int row = row0 + ai * 128 + m * 16; f32x4 v0 = acc[ai][bj][m][0], v1 = acc[ai][bj][m][1];
                    const u32x4 g = *(const u32x4*)(H + (size_t)row * IN_WP + C_GATE + BR * 1024 + col0);
                    v0[0] *= __uint_as_float(g.x << 16); v0[1] *= __uint_as_float(g.x & 0xffff0000u); v0[2] *= __uint_as_float(g.y << 16); v0[3] *= __uint_as_float(g.y & 0xffff0000u);
                    v1[0] *= __uint_as_float(g.z << 16); v1[1] *= __uint_as_float(g.z & 0xffff0000u); v1[2] *= __uint_as_float(g.w << 16); v1[3] *= __uint_as_float(g.w & 0xffff0000u);
                    float* mp = mf + (size_t)row * 1024 + col0;
                    if (BR > 0) { v0 += *(const f32x4*)mp; v1 += *(const f32x4*)(mp + 4); }
                    if (BR < 2) { *(f32x4*)mp = v0; *(f32x4*)(mp + 4) = v1; }
                    else { u32x4 w; w.x = pg8::cvt_pk_bf16(v0[0], v0[1]); w.y = pg8::cvt_pk_bf16(v0[2], v0[3]); w.z = pg8::cvt_pk_bf16(v1[0], v1[1]); w.w = pg8::cvt_pk_bf16(v1[2], v1[3]);
                        *(u32x4*)(mb + (size_t)row * 1024 + col0) = w; } asm volatile("" ::: "memory"); } }
    } };
struct MEpiRes { static constexpr bool PERM = false, AFTER_DRAIN = false; static constexpr int SEG = 0; const float* xp; const float* xs; float* xo;
    __device__ __forceinline__ void operator()(const f32x4 (&acc)[2][2][4][2], const pg8::Unit& u, int wr, int wc, int fr0, int fq0) const {
        int fr = fr0, fq = fq0; asm volatile("" : "+v"(fr), "+v"(fq));
        const int row0 = u.pm * 256 + wr * 64 + fr, col0 = u.pn * 256 + wc * 32 + 4 * fq;
#pragma unroll
        for (int ai = 0; ai < 2; ++ai)
#pragma unroll
            for (int m = 0; m < 4; ++m) { const int row = row0 + ai * 128 + m * 16; const float* xr = row < TP ? xp + (size_t)row * 1024 : xs + (size_t)(row - TP) * 1024; float* orow = xo + (size_t)row * 1024;
#pragma unroll
                for (int bj = 0; bj < 2; ++bj)
#pragma unroll
                    for (int n = 0; n < 2; ++n) { const int c = col0 + bj * 128 + n * 16; *(f32x4*)(orow + c) = *(const f32x4*)(xr + c) + acc[ai][bj][m][n]; } }
    } };

template <int NSEG, class Epi>
__device__ __forceinline__ void tail_gemm(const bf16_t* __restrict__ A, int lda, const bf16_t* __restrict__ Bt, int K, int N, const Epi& epi, LAS unsigned char* lds) {
    int tid = threadIdx.x; asm volatile("" : "+v"(tid));
    const int lane = tid & 63, wave = __builtin_amdgcn_readfirstlane(tid >> 6), rt = wave & 3, kh = wave >> 2, n = lane & 15, q = lane >> 4;
    const int ntile = 4 * (N / 16), kseg = K / NSEG, khalf = kseg / 2;
    LAS f32x4* red = (LAS f32x4*)lds;
    for (int tile = blockIdx.x; tile < ntile; tile += gridDim.x) {
        const int r0 = 64 * (tile & 3) + 16 * rt, c0 = 16 * (tile >> 2);
        const bf16_t* ap = A + (size_t)(r0 + n) * lda + 8 * q; const bf16_t* bp = Bt + (size_t)(c0 + n) * K + 8 * q;
        f32x4 acc[NSEG];
#pragma unroll
        for (int sg = 0; sg < NSEG; ++sg) { acc[sg] = (f32x4){0.f, 0.f, 0.f, 0.f};
            const int kb = sg * kseg + kh * khalf;
#pragma unroll 4
            for (int k = 0; k < khalf; k += 32) acc[sg] = __builtin_amdgcn_mfma_f32_16x16x32_bf16(*(const bf16x8_t*)(ap + kb + k), *(const bf16x8_t*)(bp + kb + k), acc[sg], 0, 0, 0); }
        __syncthreads();
        if (kh == 1) {
#pragma unroll
            for (int sg = 0; sg < NSEG; ++sg) red[(rt * NSEG + sg) * 64 + lane] = acc[sg]; }
        __syncthreads();
        if (kh == 0) {
#pragma unroll
            for (int sg = 0; sg < NSEG; ++sg) acc[sg] += red[(rt * NSEG + sg) * 64 + lane];
#pragma unroll
            for (int e = 0; e < 4; ++e) { float v[NSEG];
#pragma unroll
                for (int sg = 0; sg < NSEG; ++sg) v[sg] = acc[sg][e];
                epi(r0 + 4 * q + e, c0 + n, v); } }
    }
    __syncthreads();
}
struct TEpiMerge { const bf16_t* H; bf16_t* mb;
    __device__ __forceinline__ void operator()(int row, int col, const float (&v)[3]) const { const size_t t = (size_t)TP + row; const bf16_t* g = H + t * IN_WP + C_GATE + col;
        mb[t * 1024 + col] = f2bf(bf2f(g[0]) * v[0] + bf2f(g[1024]) * v[1] + bf2f(g[2048]) * v[2]); } };
struct TEpiRes { const float* xs; float* xo;
    __device__ __forceinline__ void operator()(int row, int col, const float (&v)[1]) const { xo[((size_t)TP + row) * 1024 + col] = xs[(size_t)row * 1024 + col] + v[0]; } };
struct MEpiMergeS { static constexpr bool PERM = true, AFTER_DRAIN = false; static constexpr int SEG = 8; const bf16_t* H; bf16_t* mb;
    __device__ __forceinline__ void mid(f32x4 (&acc)[2][2][4][2], const pg8::Unit& u, int wr, int wc, int fr0, int fq0, int seg) const {
        int fr = fr0, fq = fq0; asm volatile("" : "+v"(fr), "+v"(fq));
        const int row0 = u.pm * 256 + wr * 64 + fr;
#pragma unroll
        for (int bj = 0; bj < 2; ++bj) { const int col0 = u.pn * 256 + bj * 128 + wc * 32 + 8 * fq;
#pragma unroll
            for (int ai = 0; ai < 2; ++ai)
#pragma unroll
                for (int m = 0; m < 4; ++m) { const int row = row0 + ai * 128 + m * 16; const bf16_t* gp = H + (size_t)row * IN_WP + C_GATE + (seg - 1) * 1024 + col0;
                    float ga[8], gb[8]; unpack8(*(const u32x4*)gp, ga); unpack8(*(const u32x4*)(gp + 1024), gb);
#pragma unroll
                    for (int e = 0; e < 4; ++e) { acc[ai][bj][m][0][e] *= ga[e] * __builtin_amdgcn_rcpf(fmaxf(gb[e], 1e-30f)); acc[ai][bj][m][1][e] *= ga[4 + e] * __builtin_amdgcn_rcpf(fmaxf(gb[4 + e], 1e-30f)); }
                    asm volatile("" ::: "memory"); } }
    }
    __device__ __forceinline__ void operator()(const f32x4 (&acc)[2][2][4][2], const pg8::Unit& u, int wr, int wc, int fr0, int fq0) const {
        int fr = fr0, fq = fq0; asm volatile("" : "+v"(fr), "+v"(fq));
        const int row0 = u.pm * 256 + wr * 64 + fr;
#pragma unroll
        for (int bj = 0; bj < 2; ++bj) { const int col0 = u.pn * 256 + bj * 128 + wc * 32 + 8 * fq;
#pragma unroll
            for (int ai = 0; ai < 2; ++ai)
#pragma unroll
                for (int m = 0; m < 4; ++m) { const int row = row0 + ai * 128 + m * 16; float g[8]; unpack8(*(const u32x4*)(H + (size_t)row * IN_WP + C_GATE + 2048 + col0), g);
                    const f32x4 v0 = acc[ai][bj][m][0], v1 = acc[ai][bj][m][1];
                    u32x4 w; w.x = pg8::cvt_pk_bf16(v0[0] * g[0], v0[1] * g[1]); w.y = pg8::cvt_pk_bf16(v0[2] * g[2], v0[3] * g[3]); w.z = pg8::cvt_pk_bf16(v1[0] * g[4], v1[1] * g[5]); w.w = pg8::cvt_pk_bf16(v1[2] * g[6], v1[3] * g[7]);
                    *(u32x4*)(mb + (size_t)row * 1024 + col0) = w; asm volatile("" ::: "memory"); } }
    } };

__device__ __forceinline__ void ph_tr(const float* __restrict__ src, bf16_t* __restrict__ dst, int K, int N, int Npad, LAS float* tile, int rot, int ldd = 0) {
    if (ldd == 0) ldd = K;
    int tid = threadIdx.x; asm volatile("" : "+v"(tid)); const int G = gridDim.x; const int tn = Npad / 64, tk = K / 32, nt = tn * tk;
    const int first = (blockIdx.x + G - (rot % G)) % G;
    const bool al4 = (N & 3) == 0;
    for (int t = first; t < nt; t += G) {
        const int n0 = (t % tn) * 64, k0 = (t / tn) * 32;
        { const int k = tid >> 4, n4 = (tid & 15) * 4, n = n0 + n4; f32x4 v = (f32x4){0.f, 0.f, 0.f, 0.f};
          const float* sp = src + (size_t)(k0 + k) * N + n;
          if (al4 && n + 3 < N) v = *(const f32x4*)sp; else {
#pragma unroll
              for (int e = 0; e < 4; ++e) if (n + e < N) v[e] = sp[e]; }
#pragma unroll
          for (int e = 0; e < 4; ++e) tile[k * 65 + n4 + e] = v[e]; }
        __syncthreads();
        if (tid < 256) { const int n = tid >> 2, kq = (tid & 3) * 8; float f[8];
#pragma unroll
            for (int j = 0; j < 8; ++j) f[j] = tile[(kq + j) * 65 + n];
            *(u32x4*)(dst + (size_t)(n0 + n) * ldd + k0 + kq) = pack8(f); }
        __syncthreads();
    }
}
__device__ __forceinline__ void ph_rope_tab(float2* tab) {
    for (int idx = blockIdx.x * NTHR + threadIdx.x; idx < (SEQ + DEC_SEQ) * 16; idx += gridDim.x * NTHR) {
        const int p = idx >> 4, i = idx & 15; const int pos = p < SEQ ? p : PAST_LEN + (p - SEQ);
        const float inv = powf(10000.0f, -(float)i / 16.0f); const float ang = (float)pos * inv;
        const double rev = (double)ang * 0.15915494309189533576888; const float f = (float)(rev - floor(rev));
        tab[idx] = make_float2(__builtin_amdgcn_cosf(f), __builtin_amdgcn_sinf(f)); }
}
__device__ __forceinline__ void ph_rmsnorm(const float* __restrict__ xp, const float* __restrict__ xs, const float* __restrict__ g, bf16_t* __restrict__ xn, float* __restrict__ yp, float* __restrict__ ys) {
    int tid_o = threadIdx.x; asm volatile("" : "+v"(tid_o)); int lane = tid_o & 63, wave = tid_o >> 6;
    for (int t = blockIdx.x * 8 + wave; t < TT; t += gridDim.x * 8) {
        const float* x = t < TP ? xp + (size_t)t * 1024 : xs + (size_t)(t - TP) * 1024;
        f32x4 v[4]; float ss = 0.f;
#pragma unroll
        for (int i = 0; i < 4; ++i) { v[i] = *(const f32x4*)(x + i * 256 + lane * 4); ss += v[i][0] * v[i][0] + v[i][1] * v[i][1] + v[i][2] * v[i][2] + v[i][3] * v[i][3]; }
        ss = wave_sum(ss); const float r = rsqrtf(ss * (1.0f / 1024.0f) + EPS);
#pragma unroll
        for (int i = 0; i < 4; ++i) { const int c = i * 256 + lane * 4; const f32x4 gg = *(const f32x4*)(g + c); const f32x4 o = v[i] * r * gg;
            if (xn) { u32x2 w; w.x = pg8::cvt_pk_bf16(o[0], o[1]); w.y = pg8::cvt_pk_bf16(o[2], o[3]); *(u32x2*)(xn + (size_t)t * 1024 + c) = w; }
            else { float* y = t < TP ? yp + (size_t)t * 1024 : ys + (size_t)(t - TP) * 1024; *(f32x4*)(y + c) = o; } }
    }
}

constexpr int TK_RS = 1040;
__device__ __forceinline__ void tok8(KP p, int l, int tbase, int iseq0, bool smp, int sq, int lane) {
    const bf16_t* __restrict__ H = p->H; float* __restrict__ out = p->out;
    { const float* qg = p->q_norm_g + l * 384; const float* kvg = p->kv_norm_g + l * 256;
      u32x4 rq[8], rk[8];
#pragma unroll
      for (int e = 0; e < 8; ++e) { const bf16_t* h = H + (size_t)(tbase + e) * IN_WP;
          rq[e] = lane < 48 ? *(const u32x4*)(h + C_Q + lane * 8) : (u32x4){0u, 0u, 0u, 0u}; rk[e] = lane < 32 ? *(const u32x4*)(h + C_KV + lane * 8) : (u32x4){0u, 0u, 0u, 0u}; }
      f32x4 gq0 = (f32x4){0.f, 0.f, 0.f, 0.f}, gq1 = gq0, gk0 = gq0, gk1 = gq0;
      if (lane < 48) { gq0 = *(const f32x4*)(qg + lane * 8); gq1 = *(const f32x4*)(qg + lane * 8 + 4); }
      if (lane < 32) { gk0 = *(const f32x4*)(kvg + lane * 8); gk1 = *(const f32x4*)(kvg + lane * 8 + 4); }
#pragma unroll
      for (int e = 0; e < 8; ++e) { const int t = tbase + e; float q[8], kv[8]; unpack8(rq[e], q); unpack8(rk[e], kv); float s1 = 0.f, s2 = 0.f;
#pragma unroll
          for (int j = 0; j < 8; ++j) { s1 += q[j] * q[j]; s2 += kv[j] * kv[j]; }
          s1 = wave_sum(s1); s2 = wave_sum(s2); const float r1 = rsqrtf(s1 * (1.0f / 384.0f) + EPS), r2 = rsqrtf(s2 * (1.0f / 256.0f) + EPS);
#pragma unroll
          for (int j = 0; j < 4; ++j) { q[j] *= r1 * gq0[j]; q[4 + j] *= r1 * gq1[j]; kv[j] *= r2 * gk0[j]; kv[4 + j] *= r2 * gk1[j]; }
          if (lane < 48) *(u32x4*)(p->cq + (size_t)t * 384 + lane * 8) = pack8(q);
          if (lane < 32) { float* okv = (smp ? out + O_SKV + ((size_t)l * TS + (t - TP)) * 256 : out + O_PKV + ((size_t)l * TP + t) * 256) + lane * 8;
              *(f32x4*)okv = (f32x4){kv[0], kv[1], kv[2], kv[3]}; *(f32x4*)(okv + 4) = (f32x4){kv[4], kv[5], kv[6], kv[7]};
              *(u32x4*)(p->ckv + (size_t)t * 256 + lane * 8) = pack8(kv); } }
#pragma unroll
      for (int ps = 0; ps < 2; ++ps) { const int e = (lane >> 4) + 4 * ps, j = lane & 15, t = tbase + e; const bf16_t* h = H + (size_t)t * IN_WP;
          const float x1 = bf2f(h[C_KR + j]), x2 = bf2f(h[C_KR + 16 + j]); const float2 cs = p->tab[((smp ? SEQ : 0) + iseq0 + e) * 16 + j];
          const float o1 = x1 * cs.x - x2 * cs.y, o2 = x2 * cs.x + x1 * cs.y; float* okr = smp ? out + O_SKR + ((size_t)l * TS + (t - TP)) * 32 : out + O_PKR + ((size_t)l * TP + t) * 32;
          okr[j] = o1; okr[16 + j] = o2; p->Kr[(size_t)t * 32 + j] = f2bf(o1); p->Kr[(size_t)t * 32 + 16 + j] = f2bf(o2); } }
    { const float* conv_w = p->conv_w + (size_t)l * 4 * 1536; const bool last = smp || (iseq0 == SEQ - 8);
#pragma unroll 1
      for (int pi = 0; pi < 3; ++pi) { const int c0 = (pi * 64 + lane) * 8;
          u32x4 rows[11];
#pragma unroll
          for (int j = 0; j < 11; ++j) { const int u = iseq0 - 3 + j;
              if (u >= 0) rows[j] = *(const u32x4*)(H + (size_t)(tbase - 3 + j) * IN_WP + C_QKV + c0);
              else if (smp) { const float* sc = p->state_conv + (((size_t)l * DEC_BATCH + sq) * 3 + (u + 3)) * 1536 + c0; const f32x4 a = *(const f32x4*)sc, b = *(const f32x4*)(sc + 4);
                  rows[j].x = pg8::cvt_pk_bf16(a[0], a[1]); rows[j].y = pg8::cvt_pk_bf16(a[2], a[3]); rows[j].z = pg8::cvt_pk_bf16(b[0], b[1]); rows[j].w = pg8::cvt_pk_bf16(b[2], b[3]); }
              else rows[j] = (u32x4){0u, 0u, 0u, 0u}; }
          f32x4 w0[4], w1[4];
#pragma unroll
          for (int j = 0; j < 4; ++j) { w0[j] = *(const f32x4*)(conv_w + j * 1536 + c0); w1[j] = *(const f32x4*)(conv_w + j * 1536 + c0 + 4); }
          bf16_t* dst = pi == 0 ? p->qd : (pi == 1 ? p->kd : p->vd);
#pragma unroll
          for (int e = 0; e < 8; ++e) { float y[8];
#pragma unroll
              for (int k = 0; k < 8; ++k) y[k] = 0.f;
#pragma unroll
              for (int j = 0; j < 4; ++j) { float x[8]; unpack8(rows[e + j], x);
#pragma unroll
                  for (int k = 0; k < 4; ++k) { y[k] += x[k] * w0[j][k]; y[4 + k] += x[4 + k] * w1[j][k]; } }
              float ss = 0.f;
#pragma unroll
              for (int k = 0; k < 8; ++k) { y[k] = siluf_(y[k]); ss += y[k] * y[k]; }
              if (pi < 2) { ss += __shfl_xor(ss, 1); ss += __shfl_xor(ss, 2); ss += __shfl_xor(ss, 4); const float rn = rsqrtf(ss + EPS) * (pi == 0 ? 0.125f : 1.0f);
#pragma unroll
                  for (int k = 0; k < 8; ++k) y[k] *= rn; }
              *(u32x4*)(dst + (size_t)(tbase + e) * 512 + lane * 8) = pack8(y); }
          if (last) {
#pragma unroll
              for (int rr = 0; rr < 3; ++rr) { float x[8]; unpack8(rows[8 + rr], x);
                  float* oc = (smp ? out + O_SCONV + (((size_t)l * DEC_BATCH + sq) * 3 + rr) * 1536 : out + O_PCONV + (((size_t)l * 8 + (tbase >> 11)) * 3 + rr) * 1536) + c0;
                  *(f32x4*)oc = (f32x4){x[0], x[1], x[2], x[3]}; *(f32x4*)(oc + 4) = (f32x4){x[4], x[5], x[6], x[7]}; } } } }
    { const int t = tbase + (lane >> 3), hd = lane & 7; const float bb = sigmoidf_(p->BA[(size_t)t * 16 + hd]); const float x = p->BA[(size_t)t * 16 + 8 + hd] + p->dt_bias[l * 8 + hd];
      const float sp = x > 20.f ? x : log1pf(expf(x)); const float gg = -expf(p->a_log[l * 8 + hd]) * sp;
      p->bg[(size_t)t * 16 + hd] = bb; p->bg[(size_t)t * 16 + 8 + hd] = gg; }
}
__device__ __forceinline__ void ph_tok(KP p, int l, LAS unsigned char* lds) {
    int tid = threadIdx.x; asm volatile("" : "+v"(tid));
    const int lane = tid & 63, wave = __builtin_amdgcn_readfirstlane(tid >> 6), r = lane & 31, hh = lane >> 5;
    const bf16_t* __restrict__ H = p->H; float* __restrict__ out = p->out;
    for (int tile = blockIdx.x; tile < TP / 64 + 8; tile += gridDim.x) {
        const bool smp = tile >= TP / 64; const int s0 = smp ? (tile - TP / 64) * 4 : 0;
        const int t0 = smp ? TP + s0 * 8 : tile * 64, i0 = smp ? 0 : (t0 & (SEQ - 1)), b = t0 >> 11;
        __syncthreads();
        if (!smp) {
            for (int c = tid; c < 79 * 64; c += NTHR) { const int row = c >> 6, ch16 = c & 63; u32x4 v = (u32x4){0u, 0u, 0u, 0u};
                if (i0 - 15 + row >= 0) v = *(const u32x4*)(H + (size_t)(t0 - 15 + row) * IN_WP + C_POOL + ch16 * 8);
                *(LAS u32x4*)(lds + row * TK_RS + ch16 * 16) = v; }
        } else {
            for (int c = tid; c < 92 * 64; c += NTHR) { const int row = c >> 6, ch16 = c & 63, sq = row / 23, j = row - sq * 23; u32x4 v;
                if (j >= 15) v = *(const u32x4*)(H + (size_t)(t0 + sq * 8 + (j - 15)) * IN_WP + C_POOL + ch16 * 8);
                else { const float* sp = p->state_pool + (((size_t)l * DEC_BATCH + s0 + sq) * 15 + j) * 512 + ch16 * 8; const f32x4 a = *(const f32x4*)sp, bq = *(const f32x4*)(sp + 4);
                    v.x = pg8::cvt_pk_bf16(a[0], a[1]); v.y = pg8::cvt_pk_bf16(a[2], a[3]); v.z = pg8::cvt_pk_bf16(bq[0], bq[1]); v.w = pg8::cvt_pk_bf16(bq[2], bq[3]);
                    if (j >= 8) { float* so = out + O_SPOOL + (((size_t)l * DEC_BATCH + s0 + sq) * 15 + (j - 8)) * 512 + ch16 * 8; *(f32x4*)so = a; *(f32x4*)(so + 4) = bq; } }
                *(LAS u32x4*)(lds + row * TK_RS + ch16 * 16) = v; }
        }
        __syncthreads();
        if (!(smp && (wave & 1))) { const int g = wave >> 1, th = wave & 1, w = 2 << g, tk = 32 * th + r;
          const int brow = smp ? (tk >> 3) * 23 + 15 + (tk & 7) : 15 + tk; const float inv = 1.0f / (float)(smp ? w : min(i0 + tk + 1, w));
          const bf16_t* mixT = p->PmixT + ((size_t)l * 4 + g) * 128 * 128;
          f32x16 acc[4];
#pragma unroll
          for (int nt = 0; nt < 4; ++nt)
#pragma unroll
              for (int e = 0; e < 16; ++e) acc[nt][e] = 0.f;
#pragma unroll 2
          for (int ks = 0; ks < 8; ++ks) {
              const LAS unsigned char* base = lds + brow * TK_RS + (128 * g + 16 * ks + 8 * hh) * 2;
              float cur[8], sum[8]; unpack8(*(const LAS u32x4*)base, cur);
#pragma unroll
              for (int e = 0; e < 8; ++e) sum[e] = cur[e];
              for (int k = 1; k < w; ++k) { float x[8]; unpack8(*(const LAS u32x4*)(base - k * TK_RS), x);
#pragma unroll
                  for (int e = 0; e < 8; ++e) sum[e] += x[e]; }
#pragma unroll
              for (int e = 0; e < 8; ++e) sum[e] = sum[e] * inv - cur[e];
              union { u32x4 u; bf16x8_t v; } bfr; bfr.u = pack8(sum);
#pragma unroll
              for (int nt = 0; nt < 4; ++nt) { const bf16x8_t a = *(const bf16x8_t*)(mixT + (size_t)(32 * nt + r) * 128 + 16 * ks + 8 * hh);
                  acc[nt] = __builtin_amdgcn_mfma_f32_32x32x16_bf16(a, bfr.v, acc[nt], 0, 0, 0); } }
          const size_t t = (size_t)t0 + tk; const float* scl = p->pool_scale + l * 512 + 128 * g;
#pragma unroll
          for (int nt = 0; nt < 4; ++nt)
#pragma unroll
              for (int gg = 0; gg < 4; ++gg) { const int dd0 = 32 * nt + 8 * gg + 4 * hh; const u32x2 z = *(const u32x2*)(H + t * IN_WP + C_ZPOOL + 128 * g + dd0); const f32x4 sc = *(const f32x4*)(scl + dd0);
                  float v0 = acc[nt][4 * gg + 0] * sc[0] * __uint_as_float(z.x << 16), v1 = acc[nt][4 * gg + 1] * sc[1] * __uint_as_float(z.x & 0xffff0000u);
                  float v2 = acc[nt][4 * gg + 2] * sc[2] * __uint_as_float(z.y << 16), v3 = acc[nt][4 * gg + 3] * sc[3] * __uint_as_float(z.y & 0xffff0000u);
                  u32x2 o; o.x = pg8::cvt_pk_bf16(v0, v1); o.y = pg8::cvt_pk_bf16(v2, v3); *(u32x2*)(p->ya + t * 1536 + 128 * g + dd0) = o; } }
        if (!smp) { if (i0 == SEQ - 64) { for (int c = tid; c < 15 * 512; c += NTHR) { const int rr = c >> 9, ch = c & 511;
              out[O_PPOOL + (((size_t)l * 8 + b) * 15 + rr) * 512 + ch] = bf2f(*(const LAS bf16_t*)(lds + (15 + 49 + rr) * TK_RS + ch * 2)); } } }
        else { for (int c = tid; c < 4 * 8 * 512; c += NTHR) { const int sq = c >> 12, i = (c >> 9) & 7, ch = c & 511;
              out[O_SPOOL + (((size_t)l * DEC_BATCH + s0 + sq) * 15 + 7 + i) * 512 + ch] = bf2f(*(const LAS bf16_t*)(lds + (sq * 23 + 15 + i) * TK_RS + ch * 2)); } }
        if (!smp) tok8(p, l, t0 + wave * 8, i0 + wave * 8, false, 0, lane);
        else if (wave < 4) tok8(p, l, t0 + wave * 8, 0, true, s0 + wave, lane);
    }
    __syncthreads();
}

__device__ __forceinline__ void wu_delta(KP p, int l, int sq, int h, int dv) {
    int row0, L; float* so; float S[64];
    if (sq < 8) { row0 = sq * SEQ; L = SEQ; so = p->out + O_PDELTA + (((size_t)l * 8 + sq) * 8 + h) * 4096;
#pragma unroll
        for (int k = 0; k < 64; ++k) S[k] = 0.f; }
    else { const int s = sq - 8; row0 = TP + s * 8; L = DEC_SEQ; so = p->out + O_SDELTA + (((size_t)l * DEC_BATCH + s) * 8 + h) * 4096;
        const float* s0 = p->state_delta + (((size_t)l * DEC_BATCH + s) * 8 + h) * 4096;
#pragma unroll
        for (int k = 0; k < 64; ++k) S[k] = s0[k * 64 + dv]; }
    const float gn = p->dn_norm_g[l * 64 + dv];
    for (int i = 0; i < L; ++i) {
        const size_t t = (size_t)row0 + i; const u32x4* kp = (const u32x4*)(p->kd + t * 512 + h * 64); const u32x4* qp = (const u32x4*)(p->qd + t * 512 + h * 64);
        const float b = p->bg[t * 16 + h], a = __expf(p->bg[t * 16 + 8 + h]); const float v = bf2f(p->vd[t * 512 + h * 64 + dv]);
        u32x4 kk[8];
#pragma unroll
        for (int c = 0; c < 8; ++c) kk[c] = kp[c];
        float ks = 0.f;
#pragma unroll
        for (int c = 0; c < 8; ++c)
#pragma unroll
            for (int e = 0; e < 4; ++e) { const unsigned w = kk[c][e]; ks += __uint_as_float(w << 16) * S[c * 8 + 2 * e] + __uint_as_float(w & 0xffff0000u) * S[c * 8 + 2 * e + 1]; }
        const float vn = b * (v - a * ks); float o = 0.f;
#pragma unroll
        for (int c = 0; c < 8; ++c) { const u32x4 qv = qp[c];
#pragma unroll
            for (int e = 0; e < 4; ++e) { const unsigned w = kk[c][e], wq = qv[e]; const int k0 = c * 8 + 2 * e;
                S[k0] = a * S[k0] + __uint_as_float(w << 16) * vn; o += __uint_as_float(wq << 16) * S[k0];
                S[k0 + 1] = a * S[k0 + 1] + __uint_as_float(w & 0xffff0000u) * vn; o += __uint_as_float(wq & 0xffff0000u) * S[k0 + 1]; }
            asm volatile("" ::: "memory"); }
        const float ss = wave_sum(o * o); const float y = o * rsqrtf(ss * (1.0f / 64.0f) + EPS) * gn;
        p->yc[t * 1536 + h * 64 + dv] = f2bf(y * bf2f(p->H[t * IN_WP + C_ZDN + h * 64 + dv]));
    }
#pragma unroll
    for (int k = 0; k < 64; ++k) so[k * 64 + dv] = S[k];
}
__device__ __forceinline__ int sig_inv(int rho) { return (rho & 32) | ((rho & 12) << 1) | ((rho & 16) >> 2) | (rho & 3); }
constexpr int DPRE_LDS = 64 * 64 * 4 + 512;
constexpr int DST = 72;
__device__ __forceinline__ void dpre_flush(const LAS bf16_t* St, bf16_t* gdst, int lane) {
    asm volatile("s_waitcnt lgkmcnt(0)" ::: "memory");
#pragma unroll
    for (int it = 0; it < 8; ++it) { const int row = (lane >> 3) + 8 * it, chunk = lane & 7; *(u32x4*)(gdst + row * 64 + chunk * 8) = *(const LAS u32x4*)(St + row * DST + chunk * 8); }
    asm volatile("s_waitcnt lgkmcnt(0)" ::: "memory");
}
__device__ __forceinline__ void ph_delta_pre(KP p, LAS unsigned char* lds) {
    int tid_o = threadIdx.x; asm volatile("" : "+v"(tid_o)); int lane = tid_o & 63, wave = tid_o >> 6;
    wave = __builtin_amdgcn_readfirstlane(wave);
    LAS float* Am = (LAS float*)(lds + wave * DPRE_LDS); LAS float* gcs = Am + 4096; LAS float* bts = gcs + 64; LAS bf16_t* St = (LAS bf16_t*)Am;
    for (int unit = wave * gridDim.x + blockIdx.x; unit < 2048; unit += gridDim.x * 8) {
        { int t_ = threadIdx.x; asm volatile("" : "+v"(t_)); lane = t_ & 63; }
        const int r = lane & 31, hh = lane >> 5;
        const int bh = unit >> 5, ch = unit & 31, b = bh >> 3, h = bh & 7;
        const size_t t0 = (size_t)b * SEQ + ch * 64;
        bf16_t* op = p->DOP + (size_t)unit * 4 * 4096; float* up = p->DU + (size_t)unit * 4096;
        const bf16_t* kdb = p->kd + t0 * 512 + h * 64; const bf16_t* qdb = p->qd + t0 * 512 + h * 64; const bf16_t* vdb = p->vd + t0 * 512 + h * 64;
        const float* bgb = p->bg + t0 * 16 + h;
        const float beta = bgb[lane * 16]; float gc = bgb[lane * 16 + 8];
#pragma unroll
        for (int d = 1; d < 64; d <<= 1) { const float x = __shfl_up(gc, d); if (lane >= d) gc += x; }
        const float gl = __shfl(gc, 63); const float egc = __expf(gc);
        gcs[lane] = gc; bts[lane] = beta;
        if (lane == 0) p->DG[unit] = __expf(gl);
        bf16x8_t kf[2][4], qf[2][4];
        { const int voff = r * 512 + 8 * hh;
#pragma unroll
          for (int rb = 0; rb < 2; ++rb)
#pragma unroll
            for (int ks = 0; ks < 4; ++ks) { kf[rb][ks] = *(const bf16x8_t*)(kdb + (32 * rb * 512 + 16 * ks) + voff); qf[rb][ks] = *(const bf16x8_t*)(qdb + (32 * rb * 512 + 16 * ks) + voff); } }
        {
#pragma unroll
            for (int rb = 0; rb < 2; ++rb) { const float sc = __expf(gl - __shfl(gc, 32 * rb + r)); const int pos = sig_inv(32 * rb + r);
#pragma unroll
                for (int ks = 0; ks < 4; ++ks)
#pragma unroll
                    for (int jj = 0; jj < 8; ++jj) St[(16 * ks + 8 * hh + jj) * DST + pos] = f2bf(bf2f((bf16_t)kf[rb][ks][jj]) * sc); }
            dpre_flush(St, op + 3 * 4096, lane);
#pragma unroll
            for (int rb = 0; rb < 2; ++rb) { const float sc = __shfl(egc, 32 * rb + r);
#pragma unroll
                for (int ks = 0; ks < 4; ++ks)
#pragma unroll
                    for (int jj = 0; jj < 8; ++jj) St[(32 * rb + r) * DST + sig_inv(16 * ks + 8 * hh + jj)] = f2bf(bf2f((bf16_t)qf[rb][ks][jj]) * sc); }
            dpre_flush(St, op + 1 * 4096, lane);
        }
        float xu[64];
        {
#pragma unroll
            for (int it = 0; it < 8; ++it) { const int row = (lane >> 3) + 8 * it, chunk = lane & 7; *(LAS u32x4*)(St + row * DST + chunk * 8) = *(const u32x4*)(vdb + row * 512 + chunk * 8); }
            asm volatile("s_waitcnt lgkmcnt(0)" ::: "memory");
            const int beta_i = __float_as_int(beta);
#pragma unroll
            for (int i = 0; i < 64; ++i) xu[i] = __int_as_float(__builtin_amdgcn_readlane(beta_i, i)) * bf2f(St[i * DST + lane]);
            asm volatile("s_waitcnt lgkmcnt(0)" ::: "memory");
        }
        {
            const float gcj0 = __shfl(gc, r), gcj1 = __shfl(gc, 32 + r);
            const int p0 = sig_inv(r), p1 = sig_inv(32 + r);
            { f32x16 t00, t10, t11;
#pragma unroll
              for (int e = 0; e < 16; ++e) { t00[e] = 0.f; t10[e] = 0.f; t11[e] = 0.f; }
#pragma unroll
              for (int ks = 0; ks < 4; ++ks) {
                  t00 = __builtin_amdgcn_mfma_f32_32x32x16_bf16(qf[0][ks], kf[0][ks], t00, 0, 0, 0);
                  t10 = __builtin_amdgcn_mfma_f32_32x32x16_bf16(qf[1][ks], kf[0][ks], t10, 0, 0, 0);
                  t11 = __builtin_amdgcn_mfma_f32_32x32x16_bf16(qf[1][ks], kf[1][ks], t11, 0, 0, 0); }
#pragma unroll
              for (int e = 0; e < 16; ++e) { const int il = (e & 3) + 8 * (e >> 2) + 4 * hh;
                  { const int i = il, j = r; St[i * DST + p0] = f2bf(j <= i ? t00[e] * __expf(fminf(gcs[i] - gcj0, 0.f)) : 0.f); St[i * DST + p1] = 0; }
                  { const int i = 32 + il; St[i * DST + p0] = f2bf(t10[e] * __expf(fminf(gcs[i] - gcj0, 0.f))); }
                  { const int i = 32 + il, j = 32 + r; St[i * DST + p1] = f2bf(j <= i ? t11[e] * __expf(fminf(gcs[i] - gcj1, 0.f)) : 0.f); } }
              dpre_flush(St, op + 2 * 4096, lane); }
            { f32x16 t00, t10, t11;
#pragma unroll
              for (int e = 0; e < 16; ++e) { t00[e] = 0.f; t10[e] = 0.f; t11[e] = 0.f; }
#pragma unroll
              for (int ks = 0; ks < 4; ++ks) {
                  t00 = __builtin_amdgcn_mfma_f32_32x32x16_bf16(kf[0][ks], kf[0][ks], t00, 0, 0, 0);
                  t10 = __builtin_amdgcn_mfma_f32_32x32x16_bf16(kf[1][ks], kf[0][ks], t10, 0, 0, 0);
                  t11 = __builtin_amdgcn_mfma_f32_32x32x16_bf16(kf[1][ks], kf[1][ks], t11, 0, 0, 0); }
#pragma unroll
              for (int e = 0; e < 16; ++e) { const int il = (e & 3) + 8 * (e >> 2) + 4 * hh;
                  { const int i = il, j = r; Am[i * 64 + j] = j < i ? bts[i] * t00[e] * __expf(fminf(gcs[i] - gcj0, 0.f)) : 0.f; }
                  { const int i = 32 + il, j = r; Am[i * 64 + j] = bts[i] * t10[e] * __expf(fminf(gcs[i] - gcj0, 0.f)); }
                  { const int i = 32 + il, j = 32 + r; Am[i * 64 + j] = j < i ? bts[i] * t11[e] * __expf(fminf(gcs[i] - gcj1, 0.f)) : 0.f; } } }
        }
        asm volatile("s_waitcnt lgkmcnt(0)" ::: "memory");
        {
            int c; { int t_ = threadIdx.x; asm volatile("" : "+v"(t_)); c = t_ & 63; } const int pc = sig_inv(c);
            const int beta_i = __float_as_int(beta), egc_i = __float_as_int(egc);
#pragma unroll
            for (int i = 1; i < 64; ++i) { float au = xu[i];
#pragma unroll
                for (int j4 = 0; j4 < i; j4 += 4) { const f32x4 a = *(const LAS f32x4*)(Am + i * 64 + j4);
#pragma unroll
                    for (int e = 0; e < 4; ++e) if (j4 + e < i) au -= a[e] * xu[j4 + e]; }
                xu[i] = au; }
#pragma unroll
            for (int i = 0; i < 64; ++i) (up + i * 64)[c] = xu[i];
            asm volatile("" ::: "memory");
            { float w[64];
#pragma unroll
              for (int i = 0; i < 64; ++i) w[i] = __int_as_float(__builtin_amdgcn_readlane(beta_i, i)) * __int_as_float(__builtin_amdgcn_readlane(egc_i, i)) * bf2f((kdb + i * 512)[c]);
#pragma unroll
              for (int i = 1; i < 64; ++i) { float aw = w[i];
#pragma unroll
                  for (int j4 = 0; j4 < i; j4 += 4) { const f32x4 a = *(const LAS f32x4*)(Am + i * 64 + j4);
#pragma unroll
                      for (int e = 0; e < 4; ++e) if (j4 + e < i) aw -= a[e] * w[j4 + e]; }
                  w[i] = aw; }
              asm volatile("s_waitcnt lgkmcnt(0)" ::: "memory");
#pragma unroll
              for (int i = 0; i < 64; ++i) St[i * DST + pc] = f2bf(-w[i]); }
            dpre_flush(St, op, lane);
        }
    }
}
__device__ __forceinline__ bf16x8_t pack_b(const f32x4& lo, const f32x4& hi) { union { u32x4 u; bf16x8_t v; } x;
    x.u.x = pg8::cvt_pk_bf16(lo[0], lo[1]); x.u.y = pg8::cvt_pk_bf16(lo[2], lo[3]); x.u.z = pg8::cvt_pk_bf16(hi[0], hi[1]); x.u.w = pg8::cvt_pk_bf16(hi[2], hi[3]); return x.v; }
__device__ __forceinline__ void wu_scan(KP p, int l, int bh, int slice, int lane) {
    const int n = lane & 15, q = lane >> 4, n0 = slice * 16, b = bh >> 3, h = bh & 7;
    f32x4 S[4];
#pragma unroll
    for (int t = 0; t < 4; ++t) S[t] = (f32x4){0.f, 0.f, 0.f, 0.f};
    const int foff = n * 64 + 8 * q;
    for (int ch = 0; ch < 32; ++ch) {
        const size_t unit = (size_t)bh * 32 + ch;
        const bf16_t* op = p->DOP + unit * 4 * 4096 + foff; const float* up = p->DU + unit * 4096 + n0 + n;
        const float eg = p->DG[unit];
        f32x4 vn[4]; bf16x8_t wf[4][2], gf[4][2], kf[4][2], tf[4][2];
#pragma unroll
        for (int mt = 0; mt < 4; ++mt) {
#pragma unroll
            for (int e = 0; e < 4; ++e) vn[mt][e] = up[(16 * mt + 4 * q + e) * 64];
#pragma unroll
            for (int ks = 0; ks < 2; ++ks) { const int o = mt * 1024 + ks * 32;
                wf[mt][ks] = *(const bf16x8_t*)(op + o); gf[mt][ks] = *(const bf16x8_t*)(op + 4096 + o);
                kf[mt][ks] = *(const bf16x8_t*)(op + 2 * 4096 + o); tf[mt][ks] = *(const bf16x8_t*)(op + 3 * 4096 + o); } }
        const bf16x8_t sb0 = pack_b(S[0], S[1]), sb1 = pack_b(S[2], S[3]);
        f32x4 o[4];
#pragma unroll
        for (int mt = 0; mt < 4; ++mt) {
            vn[mt] = __builtin_amdgcn_mfma_f32_16x16x32_bf16(wf[mt][0], sb0, vn[mt], 0, 0, 0);
            vn[mt] = __builtin_amdgcn_mfma_f32_16x16x32_bf16(wf[mt][1], sb1, vn[mt], 0, 0, 0);
            o[mt] = __builtin_amdgcn_mfma_f32_16x16x32_bf16(gf[mt][0], sb0, (f32x4){0.f, 0.f, 0.f, 0.f}, 0, 0, 0);
            o[mt] = __builtin_amdgcn_mfma_f32_16x16x32_bf16(gf[mt][1], sb1, o[mt], 0, 0, 0);
        }
        const bf16x8_t vb0 = pack_b(vn[0], vn[1]), vb1 = pack_b(vn[2], vn[3]);
#pragma unroll
        for (int mt = 0; mt < 4; ++mt) {
            o[mt] = __builtin_amdgcn_mfma_f32_16x16x32_bf16(kf[mt][0], vb0, o[mt], 0, 0, 0);
            if (mt >= 2) o[mt] = __builtin_amdgcn_mfma_f32_16x16x32_bf16(kf[mt][1], vb1, o[mt], 0, 0, 0);
            S[mt] = S[mt] * eg;
            S[mt] = __builtin_amdgcn_mfma_f32_16x16x32_bf16(tf[mt][0], vb0, S[mt], 0, 0, 0);
            S[mt] = __builtin_amdgcn_mfma_f32_16x16x32_bf16(tf[mt][1], vb1, S[mt], 0, 0, 0);
        }
        bf16_t* yo = p->yc + ((size_t)b * SEQ + ch * 64) * 1536 + h * 64 + n0 + n;
#pragma unroll
        for (int mt = 0; mt < 4; ++mt)
#pragma unroll
            for (int e = 0; e < 4; ++e) yo[(size_t)(16 * mt + 4 * q + e) * 1536] = f2bf(o[mt][e]);
    }
    float* so = p->out + O_PDELTA + (((size_t)l * 8 + b) * 8 + h) * 4096 + n0 + n;
#pragma unroll
    for (int t = 0; t < 4; ++t)
#pragma unroll
        for (int e = 0; e < 4; ++e) so[(16 * t + 4 * q + e) * 64] = S[t][e];
}
__device__ __forceinline__ void ph_delta_fin(KP p, int l) {
    int tid_o = threadIdx.x; asm volatile("" : "+v"(tid_o)); int lane = tid_o & 63, wave = tid_o >> 6;
    const int h = lane >> 3, d0 = (lane & 7) * 8;
    for (int t = blockIdx.x * 8 + wave; t < TP; t += gridDim.x * 8) {
        bf16_t* yp = p->yc + (size_t)t * 1536 + h * 64 + d0; const u32x4 raw = *(const u32x4*)yp; const u32x4 gz = *(const u32x4*)(p->H + (size_t)t * IN_WP + C_ZDN + h * 64 + d0);
        float v[8]; v[0] = __uint_as_float(raw.x << 16); v[1] = __uint_as_float(raw.x & 0xffff0000u); v[2] = __uint_as_float(raw.y << 16); v[3] = __uint_as_float(raw.y & 0xffff0000u);
        v[4] = __uint_as_float(raw.z << 16); v[5] = __uint_as_float(raw.z & 0xffff0000u); v[6] = __uint_as_float(raw.w << 16); v[7] = __uint_as_float(raw.w & 0xffff0000u);
        float z[8]; z[0] = __uint_as_float(gz.x << 16); z[1] = __uint_as_float(gz.x & 0xffff0000u); z[2] = __uint_as_float(gz.y << 16); z[3] = __uint_as_float(gz.y & 0xffff0000u);
        z[4] = __uint_as_float(gz.z << 16); z[5] = __uint_as_float(gz.z & 0xffff0000u); z[6] = __uint_as_float(gz.w << 16); z[7] = __uint_as_float(gz.w & 0xffff0000u);
        float ss = 0.f;
#pragma unroll
        for (int e = 0; e < 8; ++e) ss += v[e] * v[e];
        ss += __shfl_xor(ss, 1); ss += __shfl_xor(ss, 2); ss += __shfl_xor(ss, 4);
        const float rs = rsqrtf(ss * (1.0f / 64.0f) + EPS);
#pragma unroll
        for (int e = 0; e < 8; ++e) v[e] = v[e] * rs * p->dn_norm_g[l * 64 + d0 + e] * z[e];
        u32x4 w; w.x = pg8::cvt_pk_bf16(v[0], v[1]); w.y = pg8::cvt_pk_bf16(v[2], v[3]); w.z = pg8::cvt_pk_bf16(v[4], v[5]); w.w = pg8::cvt_pk_bf16(v[6], v[7]);
        *(u32x4*)yp = w;
    }
}

__device__ __forceinline__ void ph_att_waves(KP p, int l) {
    int tid_o = threadIdx.x; asm volatile("" : "+v"(tid_o)); int lane = tid_o & 63, wave = tid_o >> 6;
    wave = __builtin_amdgcn_readfirstlane(wave);
    const int G = gridDim.x, NW = G * 8, gw = wave * G + blockIdx.x;
    for (int d = gw; d < 256; d += NW) wu_scan(p, l, d >> 2, d & 3, lane);
    for (int d = NW - 1 - gw; d < 256; d += NW) wu_delta(p, l, 8 + (d >> 3), d & 7, lane);
}
__device__ __forceinline__ void ph_fin(KP p, int l, LAS unsigned char* lds) {
    int tid_o = threadIdx.x; asm volatile("" : "+v"(tid_o)); int lane = tid_o & 63, wave = tid_o >> 6;
    LAS float* ol = (LAS float*)(lds + wave * 1024);
    const float* w_uv = p->w_uv + (size_t)l * 256 * 512;
    const int cq = lane >> 4, d4 = lane & 15;
    for (int u = blockIdx.x * 8 + wave; u < TS * 8; u += gridDim.x * 8) {
        const int ts = u >> 3, h = u & 7, s = ts >> 3, r = (ts & 7) * 8 + h;
        const float* pb = p->part + ((size_t)s * SA_CH * 64 + r) * 258;
        float mc = -1e30f, lc = 0.f;
        if (lane < SA_CH) { mc = pb[(size_t)lane * 64 * 258 + 256]; lc = pb[(size_t)lane * 64 * 258 + 257]; }
        float M = mc;
#pragma unroll
        for (int o = 1; o < 8; o <<= 1) M = fmaxf(M, __shfl_xor(M, o));
        const float wc = lane < SA_CH ? __expf(mc - M) : 0.f; float L = lc * wc;
#pragma unroll
        for (int o = 1; o < 8; o <<= 1) L += __shfl_xor(L, o);
        const float iL = 1.0f / __int_as_float(__builtin_amdgcn_readlane(__float_as_int(L), 0));
        f32x4 acc = (f32x4){0.f, 0.f, 0.f, 0.f};
#pragma unroll
        for (int ch = 0; ch < SA_CH; ++ch) { const float w = __int_as_float(__builtin_amdgcn_readlane(__float_as_int(wc), ch)); const float* pp = pb + (size_t)ch * 64 * 258 + 4 * lane;
            const f32x2 a0 = *(const f32x2*)pp, a1 = *(const f32x2*)(pp + 2); acc[0] += w * a0[0]; acc[1] += w * a0[1]; acc[2] += w * a1[0]; acc[3] += w * a1[1]; }
        *(LAS f32x4*)(ol + 4 * lane) = acc * iL;
        asm volatile("s_waitcnt lgkmcnt(0)" ::: "memory");
        f32x4 o = (f32x4){0.f, 0.f, 0.f, 0.f}; const float* wp = w_uv + (size_t)(cq * 64) * 512 + h * 64 + 4 * d4;
#pragma unroll 16
        for (int c = 0; c < 64; ++c) { const f32x4 wv = *(const f32x4*)(wp + (size_t)c * 512); const float x = ol[cq * 64 + c]; o += wv * x; }
#pragma unroll
        for (int e = 0; e < 4; ++e) { o[e] += __shfl_xor(o[e], 16); o[e] += __shfl_xor(o[e], 32); }
        if (cq == 0) { const int t = TP + ts; const u32x2 gz = *(const u32x2*)(p->H + (size_t)t * IN_WP + C_ZMLA + h * 64 + 4 * d4);
            u32x2 w; w.x = pg8::cvt_pk_bf16(o[0] * __uint_as_float(gz.x << 16), o[1] * __uint_as_float(gz.x & 0xffff0000u)); w.y = pg8::cvt_pk_bf16(o[2] * __uint_as_float(gz.y << 16), o[3] * __uint_as_float(gz.y & 0xffff0000u));
            *(u32x2*)(p->yb + (size_t)t * 1536 + h * 64 + 4 * d4) = w; }
        asm volatile("s_waitcnt lgkmcnt(0)" ::: "memory");
    }
}

constexpr int SA_QS = 592, SA_KS = 576, SA_PS = 272;
constexpr int SA_OFF_Q = 0, SA_OFF_K = 64 * SA_QS, SA_OFF_P = SA_OFF_K + 128 * SA_KS, SA_OFF_M = SA_OFF_P + 64 * SA_PS, SA_OFF_L = SA_OFF_M + 1024, SA_LDS = SA_OFF_L + 1024;
typedef short s16x4 __attribute__((ext_vector_type(4)));
__device__ __forceinline__ void sa_unit(KP p, int l, int s, int ch, LAS unsigned char* lds, int tid) {
    const int lane = tid & 63, wave = __builtin_amdgcn_readfirstlane(tid >> 6), r = lane & 31, hh = lane >> 5;
    const int qb = wave & 1, kb = wave >> 1, cg = wave >> 1;
    LAS unsigned char* Qs = lds + SA_OFF_Q; LAS unsigned char* Kt = lds + SA_OFF_K; LAS unsigned char* Pt = lds + SA_OFF_P;
    LAS float* mloc = (LAS float*)(lds + SA_OFF_M); LAS float* lred = (LAS float*)(lds + SA_OFF_L);
    __syncthreads();
    { const float* w_uk = p->w_uk + (size_t)l * 256 * 512; const bf16_t* Qg = p->Q + (size_t)(TP + s * 8) * 768;
      const int c = tid & 255, h2 = tid >> 8;
      for (int h = h2 * 4; h < h2 * 4 + 4; ++h) { float acc[8];
#pragma unroll
          for (int i = 0; i < 8; ++i) acc[i] = 0.f;
          const float* wr_ = w_uk + (size_t)c * 512 + h * 64;
          for (int d = 0; d < 64; d += 4) { const f32x4 wv = *(const f32x4*)(wr_ + d);
#pragma unroll
              for (int i = 0; i < 8; ++i) { const bf16_t* q = Qg + i * 768 + h * 96 + d;
                  acc[i] += bf2f(q[0]) * wv[0] + bf2f(q[1]) * wv[1] + bf2f(q[2]) * wv[2] + bf2f(q[3]) * wv[3]; } }
#pragma unroll
          for (int i = 0; i < 8; ++i) *(LAS bf16_t*)(Qs + (i * 8 + h) * SA_QS + c * 2) = f2bf(acc[i]); }
      for (int e = tid; e < 64 * 32; e += NTHR) { const int rr = e >> 5, j = e & 31; *(LAS bf16_t*)(Qs + rr * SA_QS + (256 + j) * 2) = Qg[(rr >> 3) * 768 + (rr & 7) * 96 + 64 + j]; } }
    const int* pt = p->page_table + s * N_PAGES + ch * 16;
    const float* ckv_base = p->cache_kv + (size_t)l * N_POOL * PAGE * 256; const float* ckr_base = p->cache_kr + (size_t)l * N_POOL * PAGE * 32;
    f32x4 rk[16], rr2[2];
    { const int page = pt[0]; const float* kvp = ckv_base + (size_t)page * PAGE * 256; const float* krp = ckr_base + (size_t)page * PAGE * 32;
#pragma unroll
      for (int i = 0; i < 16; ++i) rk[i] = __builtin_nontemporal_load((const f32x4*)(kvp + (size_t)(tid + 512 * i) * 4));
#pragma unroll
      for (int i = 0; i < 2; ++i) rr2[i] = __builtin_nontemporal_load((const f32x4*)(krp + (size_t)(tid + 512 * i) * 4)); }
    f32x16 o0, o1;
#pragma unroll
    for (int e = 0; e < 16; ++e) { o0[e] = 0.f; o1[e] = 0.f; }
    float m = -1e30f, lw = 0.f;
    const int li = lane & 15, g1 = (lane >> 4) & 1;
    const int trOff = (8 * hh + (li >> 2)) * SA_KS + (16 * g1 + 4 * (li & 3)) * 2;
    const int ntile = ch == 7 ? 17 : 16;
    for (int t = 0; t < ntile; ++t) {
        __syncthreads();
        if (t < 16) {
#pragma unroll
            for (int i = 0; i < 16; ++i) { const int ci = tid + 512 * i, key = ci >> 6, c4 = ci & 63; u32x2 w; w.x = pg8::cvt_pk_bf16(rk[i][0], rk[i][1]); w.y = pg8::cvt_pk_bf16(rk[i][2], rk[i][3]);
                *(LAS u32x2*)(Kt + key * SA_KS + c4 * 8) = w; }
#pragma unroll
            for (int i = 0; i < 2; ++i) { const int ci = tid + 512 * i, key = ci >> 3, c4 = ci & 7; u32x2 w; w.x = pg8::cvt_pk_bf16(rr2[i][0], rr2[i][1]); w.y = pg8::cvt_pk_bf16(rr2[i][2], rr2[i][3]);
                *(LAS u32x2*)(Kt + key * SA_KS + 512 + c4 * 8) = w; }
        } else {
            for (int e = tid; e < 128 * 36; e += NTHR) { const int key = e / 36, c16 = e - key * 36; u32x4 v = (u32x4){0u, 0u, 0u, 0u};
                if (key < 8) v = c16 < 32 ? *(const u32x4*)(p->ckv + ((size_t)TP + s * 8 + key) * 256 + c16 * 8) : *(const u32x4*)(p->Kr + ((size_t)TP + s * 8 + key) * 32 + (c16 - 32) * 8);
                *(LAS u32x4*)(Kt + key * SA_KS + c16 * 16) = v; }
        }
        __syncthreads();
        if (t + 1 < 16) { const int page = pt[t + 1]; const float* kvp = ckv_base + (size_t)page * PAGE * 256; const float* krp = ckr_base + (size_t)page * PAGE * 32;
#pragma unroll
            for (int i = 0; i < 16; ++i) rk[i] = __builtin_nontemporal_load((const f32x4*)(kvp + (size_t)(tid + 512 * i) * 4));
#pragma unroll
            for (int i = 0; i < 2; ++i) rr2[i] = __builtin_nontemporal_load((const f32x4*)(krp + (size_t)(tid + 512 * i) * 4)); }
        f32x16 sa;
#pragma unroll
        for (int e = 0; e < 16; ++e) sa[e] = 0.f;
        { const LAS unsigned char* ka = Kt + (32 * kb + r) * SA_KS + 16 * hh; const LAS unsigned char* qa = Qs + (32 * qb + r) * SA_QS + 16 * hh;
#pragma unroll
          for (int ks = 0; ks < 18; ++ks) sa = __builtin_amdgcn_mfma_f32_32x32x16_bf16(*(const LAS bf16x8_t*)(ka + ks * 32), *(const LAS bf16x8_t*)(qa + ks * 32), sa, 0, 0, 0); }
        if (t == 16) { const int itok = (32 * qb + r) >> 3;
#pragma unroll
            for (int e = 0; e < 16; ++e) { const int key = 32 * kb + (e & 3) + 8 * (e >> 2) + 4 * hh; if (key > itok) sa[e] = -1e30f; } }
        float tm = sa[0];
#pragma unroll
        for (int e = 1; e < 16; ++e) tm = fmaxf(tm, sa[e]);
        tm = fmaxf(tm, __shfl_xor(tm, 32));
        if (hh == 0) mloc[kb * 64 + 32 * qb + r] = tm;
        __syncthreads();
        { const int q = 32 * qb + r; const float tmx = fmaxf(fmaxf(mloc[q], mloc[64 + q]), fmaxf(mloc[128 + q], mloc[192 + q]));
          const float mn = fmaxf(m, tmx), al = __builtin_amdgcn_exp2f((m - mn) * ATT_C), mc = mn * ATT_C; m = mn;
          float ps = 0.f;
#pragma unroll
          for (int e = 0; e < 16; ++e) { sa[e] = __builtin_amdgcn_exp2f(sa[e] * ATT_C - mc); ps += sa[e]; }
          lw = lw * al + ps;
#pragma unroll
          for (int g4 = 0; g4 < 4; ++g4) { u32x2 w; w.x = pg8::cvt_pk_bf16(sa[4 * g4], sa[4 * g4 + 1]); w.y = pg8::cvt_pk_bf16(sa[4 * g4 + 2], sa[4 * g4 + 3]);
              *(LAS u32x2*)(Pt + q * SA_PS + (32 * kb + 8 * g4 + 4 * hh) * 2) = w; }
#pragma unroll
          for (int e = 0; e < 16; ++e) { o0[e] *= al; o1[e] *= al; } }
        __syncthreads();
        { const LAS unsigned char* pa = Pt + (32 * qb + r) * SA_PS + 16 * hh; const LAS unsigned char* va = Kt + trOff + (64 * cg) * 2;
#pragma unroll
          for (int ks = 0; ks < 8; ++ks) { const bf16x8_t pb = *(const LAS bf16x8_t*)(pa + ks * 32);
              union { struct { s16x4 lo, hi; } h; bf16x8_t v; } a0, a1;
              a0.h.lo = __builtin_amdgcn_ds_read_tr16_b64_v4i16((LAS s16x4*)(va + ks * 16 * SA_KS)); a0.h.hi = __builtin_amdgcn_ds_read_tr16_b64_v4i16((LAS s16x4*)(va + ks * 16 * SA_KS + 4 * SA_KS));
              a1.h.lo = __builtin_amdgcn_ds_read_tr16_b64_v4i16((LAS s16x4*)(va + ks * 16 * SA_KS + 64)); a1.h.hi = __builtin_amdgcn_ds_read_tr16_b64_v4i16((LAS s16x4*)(va + ks * 16 * SA_KS + 4 * SA_KS + 64));
              o0 = __builtin_amdgcn_mfma_f32_32x32x16_bf16(a0.v, pb, o0, 0, 0, 0);
              o1 = __builtin_amdgcn_mfma_f32_32x32x16_bf16(a1.v, pb, o1, 0, 0, 0); } }
    }
    lw += __shfl_xor(lw, 32);
    if (hh == 0) lred[kb * 64 + 32 * qb + r] = lw;
    __syncthreads();
    { const int q = 32 * qb + r; float* pp = p->part + (((size_t)s * SA_CH + ch) * 64 + q) * 258;
#pragma unroll
      for (int cb2 = 0; cb2 < 2; ++cb2)
#pragma unroll
          for (int g4 = 0; g4 < 4; ++g4) { const int c = 32 * (2 * cg + cb2) + 8 * g4 + 4 * hh; f32x4 v;
#pragma unroll
              for (int e = 0; e < 4; ++e) v[e] = cb2 == 0 ? o0[4 * g4 + e] : o1[4 * g4 + e];
              *(f32x2*)(pp + c) = (f32x2){v[0], v[1]}; *(f32x2*)(pp + c + 2) = (f32x2){v[2], v[3]}; }
      if (cg == 0 && hh == 0) { pp[256] = m * MLA_SCALE; pp[257] = lred[q] + lred[64 + q] + lred[128 + q] + lred[192 + q]; } }
}
__device__ __forceinline__ void ph_attn_s2(KP p, int l, LAS unsigned char* lds) {
    int tid = threadIdx.x; asm volatile("" : "+v"(tid));
    for (int u = blockIdx.x; u < DEC_BATCH * 8; u += gridDim.x) sa_unit(p, l, u >> 3, u & 7, lds, tid);
    __syncthreads();
}

constexpr int ATT_KS = 208, ATT_VS = 144, ATT_KB = 64 * ATT_KS, ATT_VB = 64 * ATT_VS, ATT_STAGE = ATT_KB + ATT_VB;
__device__ __forceinline__ void attn_unit(KP p, int b, int h, int qblk, LAS unsigned char* lds, int tid, int wave, int lane) {
    const int r = lane & 31, hh = lane >> 5;
    const int q0 = qblk * 256 + wave * 32;
    const size_t trow0 = (size_t)b * SEQ;
    bf16x8_t qf[6];
    { const bf16_t* qp = p->Q + (trow0 + q0 + r) * 768 + h * 96 + 8 * hh;
#pragma unroll
      for (int ks = 0; ks < 6; ++ks) qf[ks] = *(const bf16x8_t*)(qp + 16 * ks); }
    f32x16 o0, o1;
#pragma unroll
    for (int e = 0; e < 16; ++e) { o0[e] = 0.f; o1[e] = 0.f; }
    float m = -1e30f, lsum = 0.f;
    const int ntile = qblk * 4 + 4;
    const int cA = tid, keyA = cA / 12, partA = cA - keyA * 12; const int cB = 512 + (tid & 255), keyB = cB / 12, partB = cB - keyB * 12; const bool hasB = tid < 256;
    const bf16_t* gA = partA < 8 ? p->Kn + (trow0 + keyA) * 512 + h * 64 + partA * 8 : p->Kr + (trow0 + keyA) * 32 + (partA - 8) * 8; const int stepA = partA < 8 ? 64 * 512 : 64 * 32;
    const bf16_t* gB = partB < 8 ? p->Kn + (trow0 + keyB) * 512 + h * 64 + partB * 8 : p->Kr + (trow0 + keyB) * 32 + (partB - 8) * 8; const int stepB = partB < 8 ? 64 * 512 : 64 * 32;
    const bf16_t* gV = p->Vt + (size_t)(h * 64 + (tid >> 3)) * TP + trow0 + (tid & 7) * 8;
    const int lA = keyA * ATT_KS + partA * 16, lB = keyB * ATT_KS + partB * 16, lV = ATT_KB + (tid >> 3) * ATT_VS + (tid & 7) * 16;
    const int pr_ = (r & 0x13) | ((r & 4) << 1) | ((r & 8) >> 1);
    const int kOff = pr_ * ATT_KS + 16 * hh, vOff = ATT_KB + r * ATT_VS + 16 * hh;
    u32x4 rA = *(const u32x4*)gA, rB = hasB ? *(const u32x4*)gB : (u32x4){0u, 0u, 0u, 0u}, rV = *(const u32x4*)gV;
    for (int kt = 0; kt < ntile; ++kt) {
        LAS unsigned char* st = lds + (kt & 1) * ATT_STAGE;
        *(LAS u32x4*)(st + lA) = rA; if (hasB) *(LAS u32x4*)(st + lB) = rB; *(LAS u32x4*)(st + lV) = rV;
        __syncthreads();
        if (kt + 1 < ntile) { gA += stepA; gB += stepB; gV += 64; rA = *(const u32x4*)gA; if (hasB) rB = *(const u32x4*)gB; rV = *(const u32x4*)gV; }
        if (kt * 64 <= q0 + 31) {
            f32x16 s0, s1;
#pragma unroll
            for (int e = 0; e < 16; ++e) { s0[e] = 0.f; s1[e] = 0.f; }
#pragma unroll
            for (int ks = 0; ks < 6; ++ks) {
                const bf16x8_t a0 = *(const LAS bf16x8_t*)(st + kOff + ks * 32), a1 = *(const LAS bf16x8_t*)(st + kOff + 32 * ATT_KS + ks * 32);
                s0 = __builtin_amdgcn_mfma_f32_32x32x16_bf16(a0, qf[ks], s0, 0, 0, 0);
                s1 = __builtin_amdgcn_mfma_f32_32x32x16_bf16(a1, qf[ks], s1, 0, 0, 0);
            }
            if (kt * 64 + 63 > q0) {
                const int qrel = q0 + r - kt * 64;
#pragma unroll
                for (int e = 0; e < 16; ++e) { const int kl = (e & 3) + 4 * ((e >> 2) & 1) + 8 * hh + 16 * ((e >> 3) & 1);
                    if (kl > qrel) s0[e] = -1e30f; if (kl + 32 > qrel) s1[e] = -1e30f; }
            }
            float tm = fmaxf(s0[0], s1[0]);
#pragma unroll
            for (int e = 1; e < 16; ++e) tm = fmaxf(tm, fmaxf(s0[e], s1[e]));
            tm = fmaxf(tm, __shfl_xor(tm, 32));
            const float mn = fmaxf(m, tm), al = __builtin_amdgcn_exp2f((m - mn) * ATT_C), mc = mn * ATT_C; m = mn;
            float ps = 0.f;
#pragma unroll
            for (int e = 0; e < 16; ++e) { s0[e] = __builtin_amdgcn_exp2f(s0[e] * ATT_C - mc); s1[e] = __builtin_amdgcn_exp2f(s1[e] * ATT_C - mc); ps += s0[e] + s1[e]; }
            lsum = lsum * al + ps;
#pragma unroll
            for (int e = 0; e < 16; ++e) { o0[e] *= al; o1[e] *= al; }
#pragma unroll
            for (int kb = 0; kb < 2; ++kb)
#pragma unroll
                for (int sp = 0; sp < 2; ++sp) {
                    union { u32x4 u; bf16x8_t v; } pb;
                    if (kb == 0) { pb.u.x = pg8::cvt_pk_bf16(s0[8 * sp + 0], s0[8 * sp + 1]); pb.u.y = pg8::cvt_pk_bf16(s0[8 * sp + 2], s0[8 * sp + 3]); pb.u.z = pg8::cvt_pk_bf16(s0[8 * sp + 4], s0[8 * sp + 5]); pb.u.w = pg8::cvt_pk_bf16(s0[8 * sp + 6], s0[8 * sp + 7]); }
                    else         { pb.u.x = pg8::cvt_pk_bf16(s1[8 * sp + 0], s1[8 * sp + 1]); pb.u.y = pg8::cvt_pk_bf16(s1[8 * sp + 2], s1[8 * sp + 3]); pb.u.z = pg8::cvt_pk_bf16(s1[8 * sp + 4], s1[8 * sp + 5]); pb.u.w = pg8::cvt_pk_bf16(s1[8 * sp + 6], s1[8 * sp + 7]); }
                    const int ko = (32 * kb + 16 * sp) * 2;
                    const bf16x8_t v0 = *(const LAS bf16x8_t*)(st + vOff + ko), v1 = *(const LAS bf16x8_t*)(st + vOff + 32 * ATT_VS + ko);
                    o0 = __builtin_amdgcn_mfma_f32_32x32x16_bf16(v0, pb.v, o0, 0, 0, 0);
                    o1 = __builtin_amdgcn_mfma_f32_32x32x16_bf16(v1, pb.v, o1, 0, 0, 0);
                }
        }
    }
    lsum += __shfl_xor(lsum, 32);
    const float il = 1.0f / lsum;
    const size_t t = trow0 + q0 + r;
#pragma unroll
    for (int db = 0; db < 2; ++db)
#pragma unroll
        for (int g = 0; g < 4; ++g) { const int d0 = 32 * db + 8 * g + 4 * hh;
            const u32x2 gz = *(const u32x2*)(p->H + t * IN_WP + C_ZMLA + h * 64 + d0);
            float v[4];
#pragma unroll
            for (int e = 0; e < 4; ++e) v[e] = (db == 0 ? o0[4 * g + e] : o1[4 * g + e]) * il;
            v[0] *= __uint_as_float(gz.x << 16); v[1] *= __uint_as_float(gz.x & 0xffff0000u); v[2] *= __uint_as_float(gz.y << 16); v[3] *= __uint_as_float(gz.y & 0xffff0000u);
            u32x2 w; w.x = pg8::cvt_pk_bf16(v[0], v[1]); w.y = pg8::cvt_pk_bf16(v[2], v[3]);
            *(u32x2*)(p->yb + t * 1536 + h * 64 + d0) = w; }
}
__device__ __forceinline__ void ph_attn_p(KP p, LAS unsigned char* lds) {
    int tid = threadIdx.x; asm volatile("" : "+v"(tid));
    const int lane = tid & 63, wave = __builtin_amdgcn_readfirstlane(tid >> 6);
    for (int pi = blockIdx.x; pi < 256; pi += gridDim.x) {
        const int xcd = pi & 7, k = pi >> 3, bh = xcd * 8 + (k >> 2), pr = k & 3;
        attn_unit(p, bh >> 3, bh & 7, 7 - pr, lds, tid, wave, lane);
        attn_unit(p, bh >> 3, bh & 7, pr, lds, tid, wave, lane);
    }
    __syncthreads();
}
struct MEpiVt { static constexpr bool PERM = true, AFTER_DRAIN = false; static constexpr int SEG = 0; bf16_t* O; int ldc; int pad_;
    __device__ __forceinline__ void operator()(const f32x4 (&acc)[2][2][4][2], const pg8::Unit& u, int wr, int wc, int fr0, int fq0) const {
        int fr = fr0, fq = fq0; asm volatile("" : "+v"(fr), "+v"(fq));
        const int row0 = u.pm * 256 + wr * 64 + fr;
#pragma unroll
        for (int bj = 0; bj < 2; ++bj) { const int col0 = u.pn * 256 + bj * 128 + wc * 32 + 8 * fq;
#pragma unroll
            for (int ai = 0; ai < 2; ++ai)
#pragma unroll
                for (int m = 0; m < 4; ++m) { const int row = row0 + ai * 128 + m * 16; const f32x4 v0 = acc[ai][bj][m][0], v1 = acc[ai][bj][m][1];
                    u32x4 w; w.x = pg8::cvt_pk_bf16(v0[0], v0[1]); w.y = pg8::cvt_pk_bf16(v0[2], v0[3]); w.z = pg8::cvt_pk_bf16(v1[0], v1[1]); w.w = pg8::cvt_pk_bf16(v1[2], v1[3]);
                    *(u32x4*)(O + (size_t)row * ldc + col0) = w; } }
    } };


__global__ void __launch_bounds__(NTHR, 2) k_mega(Params p_unused) {
    const KP kp0 = (KP)__builtin_amdgcn_kernarg_segment_ptr();
#define PP() ({ KP q_ = kp0; asm volatile("" : "+s"(q_)); q_; })
    KP p = PP();
    extern __shared__ __attribute__((aligned(16))) unsigned char lds_raw[];
    LAS unsigned char* lds = (LAS unsigned char*)lds_raw;
    volatile LAS unsigned* misc = (volatile LAS unsigned*)(lds + LDS_MISC);
    for (int u = threadIdx.x; u < 64; u += NTHR) misc[u] = 0u;
    __syncthreads();
    const int lo = p->ph_lo, hi = p->ph_hi;
    XcdBarrier bar; bar.bar = p->bar + p->li * XCD_BAR_WORDS; bar.x = 0; bar.st = nullptr;
    if (hi - lo > 1) bar = xcd_barrier_post(p->bar + p->li * XCD_BAR_WORDS, misc + 8);
#define IN(k) (lo <= (k) && (k) < hi)
#define SEAM(k) do { if (IN(k) && IN((k) + 1)) xcd_barrier(bar); } while (0)

    if (IN(PH_PRO)) {
        LAS float* tile = (LAS float*)lds;
        for (int l = 0; l < 2; ++l) {
            KP p = PP();
            ph_tr(p->w_in + (size_t)l * 1024 * IN_W, p->WinT + (size_t)l * IN_WP * 1024, 1024, IN_W, IN_WP, tile, 0);
            ph_tr(p->w_uq + (size_t)l * 384 * 768, p->WuqT + (size_t)l * 768 * 384, 384, 768, 768, tile, 0);
            ph_tr(p->w_uk + (size_t)l * 256 * 512, p->WkvT + (size_t)l * 1024 * 256, 256, 512, 512, tile, 144);
            ph_tr(p->w_uv + (size_t)l * 256 * 512, p->WkvT + (size_t)l * 1024 * 256 + (size_t)512 * 256, 256, 512, 512, tile, 208);
            ph_tr(p->w_br0 + (size_t)l * 512 * 1024, p->WbrT + (size_t)l * 1024 * 1536 + 0 * 512, 512, 1024, 1024, tile, 0, 1536);
            ph_tr(p->w_br1 + (size_t)l * 512 * 1024, p->WbrT + (size_t)l * 1024 * 1536 + 1 * 512, 512, 1024, 1024, tile, 0, 1536);
            ph_tr(p->w_br2 + (size_t)l * 512 * 1024, p->WbrT + (size_t)l * 1024 * 1536 + 2 * 512, 512, 1024, 1024, tile, 0, 1536);
            ph_tr(p->w_out + (size_t)l * 1024 * 1024, p->WoutT + (size_t)l * 1024 * 1024, 1024, 1024, 1024, tile, 0);
            for (int g = 0; g < 4; ++g) ph_tr(p->pool_mix + ((size_t)l * 4 + g) * 128 * 128, p->PmixT + ((size_t)l * 4 + g) * 128 * 128, 128, 128, 128, tile, 64 + 8 * g);
        }
        { KP p = PP(); ph_rope_tab(p->tab); ph_rmsnorm(p->x_prompt, p->x_sample, p->norm_g, p->xn, nullptr, nullptr); }
    }
    SEAM(PH_PRO);
    for (int l = 0; l < 2; ++l) {
        int G = gridDim.x, bid = blockIdx.x; asm volatile("" : "+s"(G), "+s"(bid));
        if (IN(PHID(l, PH_GIN))) { KP p = PP();
            pg8::Gemm g{p->xn, p->WinT + (size_t)l * IN_WP * 1024, TT, IN_WP, 1024}; pg8::StaticOrder S; S.init(TT, IN_WP, G, bid);
            MEpiH E{p->H, p->BA}; pg8::gemm_phase<MEpiH, pg8::StaticOrder, false>(lds, g, S, E, nullptr);
        }
        SEAM(PHID(l, PH_GIN));
        if (IN(PHID(l, PH_TOK))) ph_tok(PP(), l, lds);
        SEAM(PHID(l, PH_TOK));
        if (IN(PHID(l, PH_GQ))) { KP p = PP();
            pg8::Gemm g{p->cq, p->WuqT + (size_t)l * 768 * 384, TT, 768, 384}; pg8::StaticOrder S; S.init(TT, 768, G, bid);
            MEpiQ E{p->Q, p->tab}; pg8::gemm_phase<MEpiQ, pg8::StaticOrder, false>(lds, g, S, E, nullptr);
        }
        if (IN(PHID(l, PH_GQ))) { KP p = PP();
            pg8::Gemm g{p->ckv, p->WkvT + (size_t)l * 1024 * 256, TP, 512, 256}; pg8::StaticOrder S; S.init(TP, 512, G / 2, bid < G / 2 ? bid : G);
            MEpiKV E{p->Kn, p->V}; pg8::gemm_phase<MEpiKV, pg8::StaticOrder, false>(lds, g, S, E, nullptr);
        }
        if (IN(PHID(l, PH_GQ))) { KP p = PP();
            pg8::Gemm g{p->WkvT + (size_t)l * 1024 * 256 + (size_t)512 * 256, p->ckv, 512, TP, 256}; pg8::StaticOrder S; S.init(512, TP, G / 2, bid >= G / 2 ? bid - G / 2 : G);
            MEpiVt E{p->Vt, TP, 0}; pg8::gemm_phase<MEpiVt, pg8::StaticOrder, false>(lds, g, S, E, nullptr);
        }
        if (IN(PHID(l, PH_GQ))) ph_delta_pre(PP(), lds);
        SEAM(PHID(l, PH_GQ));
        if (IN(PHID(l, PH_ATT))) { const int am = PP()->pad;
            if (am & 1) ph_attn_s2(PP(), l, lds); if (am & 4) ph_attn_p(PP(), lds); if (am & 8) ph_att_waves(PP(), l); }
        SEAM(PHID(l, PH_ATT));
        if (IN(PHID(l, PH_FIN))) { ph_fin(PP(), l, lds); ph_delta_fin(PP(), l); }
        SEAM(PHID(l, PH_FIN));
        if (IN(PHID(l, PH_MERGE))) { KP p = PP();
            pg8::Gemm g{p->ya, p->WbrT + (size_t)l * 1024 * 1536, TP, 1024, 1536}; pg8::StaticOrder S; S.init(TP, 1024, G, bid);
            MEpiMergeS E{p->H, p->mb}; pg8::gemm_phase<MEpiMergeS, pg8::StaticOrder, false>(lds, g, S, E, nullptr);
        }
        if (IN(PHID(l, PH_MERGE))) { KP p = PP(); TEpiMerge E{p->H, p->mb}; tail_gemm<3, TEpiMerge>(p->ya + (size_t)TP * 1536, 1536, p->WbrT + (size_t)l * 1024 * 1536, 1536, 1024, E, lds); }
        SEAM(PHID(l, PH_MERGE));
        if (IN(PHID(l, PH_OUT))) { KP p = PP();
            const float* xp = l == 0 ? p->x_prompt : p->xres; const float* xs = l == 0 ? p->x_sample : p->xres + (size_t)TP * 1024;
            pg8::Gemm g{p->mb, p->WoutT + (size_t)l * 1024 * 1024, TP, 1024, 1024}; pg8::StaticOrder S; S.init(TP, 1024, G, bid);
            MEpiRes E{xp, xs, p->xres}; pg8::gemm_phase<MEpiRes, pg8::StaticOrder, false>(lds, g, S, E, nullptr);
        }
        if (IN(PHID(l, PH_OUT))) { KP p = PP(); TEpiRes E{l == 0 ? p->x_sample : p->xres + (size_t)TP * 1024, p->xres}; tail_gemm<1, TEpiRes>(p->mb + (size_t)TP * 1024, 1024, p->WoutT + (size_t)l * 1024 * 1024, 1024, 1024, E, lds); }
        SEAM(PHID(l, PH_OUT));
        if (IN(PHID(l, PH_NORM))) { KP p = PP();
            if (l == 0) ph_rmsnorm(p->xres, p->xres + (size_t)TP * 1024, p->norm_g + 1024, p->xn, nullptr, nullptr);
            else ph_rmsnorm(p->xres, p->xres + (size_t)TP * 1024, p->final_norm_g, nullptr, p->out + O_YP, p->out + O_YS);
        }
        SEAM(PHID(l, PH_NORM));
    }
#undef IN
#undef SEAM
}

static inline size_t al256(size_t x) { return (x + 255) & ~(size_t)255; }
extern "C" void kernel_launch(void* const* d_in, const int* in_sizes, int n_in, void* d_out, int out_size, void* d_ws, size_t ws_size, hipStream_t stream) {
    static int grid = 0;
    if (grid == 0) {
        int dev = 0, cus = 0; (void)hipGetDevice(&dev); (void)hipDeviceGetAttribute(&cus, hipDeviceAttributeMultiprocessorCount, dev);
        (void)hipFuncSetAttribute((const void*)k_mega, hipFuncAttributeMaxDynamicSharedMemorySize, LDS_BYTES);
        int per_cu = 0; (void)hipOccupancyMaxActiveBlocksPerMultiprocessor(&per_cu, (const void*)k_mega, NTHR, LDS_BYTES); (void)hipGetLastError();
        grid = cus > 0 ? cus : 256;
    }
    Params p{};
    p.x_prompt = (const float*)d_in[0]; p.x_sample = (const float*)d_in[1]; p.cache_kv = (const float*)d_in[2]; p.cache_kr = (const float*)d_in[3];
    p.state_pool = (const float*)d_in[4]; p.state_conv = (const float*)d_in[5]; p.state_delta = (const float*)d_in[6]; p.page_table = (const int*)d_in[7];
    p.norm_g = (const float*)d_in[8]; p.w_in = (const float*)d_in[9]; p.pool_mix = (const float*)d_in[10]; p.pool_scale = (const float*)d_in[11];
    p.q_norm_g = (const float*)d_in[12]; p.w_uq = (const float*)d_in[13]; p.kv_norm_g = (const float*)d_in[14]; p.w_uk = (const float*)d_in[15];
    p.w_uv = (const float*)d_in[16]; p.conv_w = (const float*)d_in[17]; p.a_log = (const float*)d_in[18]; p.dt_bias = (const float*)d_in[19];
    p.dn_norm_g = (const float*)d_in[20]; p.w_br0 = (const float*)d_in[21]; p.w_br1 = (const float*)d_in[22]; p.w_br2 = (const float*)d_in[23];
    p.w_out = (const float*)d_in[24]; p.final_norm_g = (const float*)d_in[25];
    p.out = (float*)d_out;
    char* w = (char*)d_ws; size_t off = 0;
    auto take = [&](size_t bytes) { char* q = w + off; off += al256(bytes); return q; };
    const size_t BAR_BYTES = (size_t)16 * XCD_BAR_WORDS * 4;
    p.bar = (unsigned*)take(BAR_BYTES);
    p.WinT = (bf16_t*)take((size_t)2 * IN_WP * 1024 * 2);
    p.WuqT = (bf16_t*)take((size_t)2 * 768 * 384 * 2);
    p.WkvT = (bf16_t*)take((size_t)2 * 1024 * 256 * 2);
    p.WbrT = (bf16_t*)take((size_t)2 * 3 * 1024 * 512 * 2);
    p.WoutT = (bf16_t*)take((size_t)2 * 1024 * 1024 * 2);
    p.PmixT = (bf16_t*)take((size_t)2 * 4 * 128 * 128 * 2);
    p.tab = (float2*)take((size_t)(SEQ + DEC_SEQ) * 16 * 8);
    p.xres = (float*)take((size_t)TT * 1024 * 4);
    p.xn = (bf16_t*)take((size_t)TT * 1024 * 2);
    p.H = (bf16_t*)take((size_t)TT * IN_WP * 2);
    p.BA = (float*)take((size_t)TT * 16 * 4);
    p.cq = (bf16_t*)take((size_t)TT * 384 * 2);
    p.ckv = (bf16_t*)take((size_t)TT * 256 * 2);
    p.Kr = (bf16_t*)take((size_t)TT * 32 * 2);
    p.Q = (bf16_t*)take((size_t)TT * 768 * 2);
    bf16_t* Qlat = (bf16_t*)take((size_t)TS * 8 * 288 * 2);
    p.Kn = (bf16_t*)take((size_t)TP * 512 * 2);
    p.V = (bf16_t*)take((size_t)TP * 512 * 2);
    p.Vt = (bf16_t*)take((size_t)512 * TP * 2);
    p.qd = (bf16_t*)take((size_t)TT * 512 * 2);
    p.kd = (bf16_t*)take((size_t)TT * 512 * 2);
    p.vd = (bf16_t*)take((size_t)TT * 512 * 2);
    p.bg = (float*)take((size_t)TT * 16 * 4);
    p.ya = (bf16_t*)take((size_t)TT * 1536 * 2); p.yb = p.ya + 512; p.yc = p.ya + 1024;
    p.mf = (float*)take((size_t)TT * 1024 * 4);
    p.mb = (bf16_t*)take((size_t)TT * 1024 * 2);
    p.part = (float*)take((size_t)DEC_BATCH * SA_CH * 64 * 258 * 4);
    p.DOP = (bf16_t*)take((size_t)2048 * 4 * 4096 * 2);
    p.DU = (float*)take((size_t)2048 * 4096 * 4);
    p.DG = (float*)take((size_t)2048 * 4);

    (void)hipMemsetAsync(p.bar, 0, BAR_BYTES, stream);
    p.ph_lo = 0; p.ph_hi = PH_END; p.li = 0; p.pad = 15;
    hipLaunchKernelGGL(k_mega, dim3(grid), dim3(NTHR), LDS_BYTES, stream, p);
#if defined(PROBE_REP) && PROBE_REP > 0
    for (int i = 0; i < PROBE_REP; ++i) { Params q = p; q.ph_lo = PROBE_LO; q.ph_hi = PROBE_HI; q.li = 1 + i; q.pad = PROBE_MASK; hipLaunchKernelGGL(k_mega, dim3(grid), dim3(NTHR), LDS_BYTES, stream, q); }
#endif
}
```

```cpp
#include <hip/hip_runtime.h>
#include <stdint.h>

typedef unsigned short bf16_t;

#define D_MODEL 1024
#define TP 16384
#define TS 256
#define TT (TP + TS)
#define SEQ 2048
#define DEC_SEQ 8
#define DEC_BATCH 32
#define PAST_LEN 16384
#define PAGE 128
#define N_PAGES 128
#define N_POOL 5120
#define IN_W 7344
#define IN_WP 7424
#define C_POOL 0
#define C_ZPOOL 512
#define C_Q 1024
#define C_KV 1408
#define C_KR 1664
#define C_ZMLA 1696
#define C_QKV 2208
#define C_ZDN 3744
#define C_BETA 4256
#define C_ALPHA 4264
#define C_GATE 4272
#define EPS 1e-6f
#define MLA_SCALE 0.10206207261596577f
#define ATT_C 0.14724444831554004f

#define O_YP 0
#define O_YS (O_YP + 16777216)
#define O_PKV (O_YS + 262144)
#define O_PKR (O_PKV + 8388608)
#define O_PPOOL (O_PKR + 1048576)
#define O_PCONV (O_PPOOL + 122880)
#define O_PDELTA (O_PCONV + 73728)
#define O_SKV (O_PDELTA + 524288)
#define O_SKR (O_SKV + 131072)
#define O_SPOOL (O_SKR + 16384)
#define O_SCONV (O_SPOOL + 491520)
#define O_SDELTA (O_SCONV + 294912)
#define O_END (O_SDELTA + 2097152)

__device__ __forceinline__ float bf2f(bf16_t b) { return __uint_as_float(((unsigned)b) << 16); }
__device__ __forceinline__ bf16_t f2bf(float f) { unsigned u = __float_as_uint(f); u += 0x7FFFu + ((u >> 16) & 1u); return (bf16_t)(u >> 16); }
__device__ __forceinline__ float sigmoidf_(float v) { return __builtin_amdgcn_rcpf(1.0f + __builtin_amdgcn_exp2f(-1.4426950408889634f * v)); }
__device__ __forceinline__ float siluf_(float v) { return v * __builtin_amdgcn_rcpf(1.0f + __builtin_amdgcn_exp2f(-1.4426950408889634f * v)); }
__device__ __forceinline__ float wave_sum(float v) {
#pragma unroll
    for (int o = 32; o >= 1; o >>= 1) v += __shfl_xor(v, o);
    return v;
}

#define SA_CH 8
namespace pg8 {
#define PG8_LAS __attribute__((address_space(3)))
typedef unsigned short bf16_t;
typedef short bf16x8 __attribute__((ext_vector_type(8)));
typedef float f32x4 __attribute__((ext_vector_type(4)));
typedef unsigned u32x4 __attribute__((ext_vector_type(4)));
constexpr int BM = 256, BK = 64, HALF = 128, HTB = HALF * BK * 2  , STAGE_BYTES = 8 * HTB, NXCD = 8, WGM = 8;

__host__ __device__ __forceinline__ int lds_byte(int r, int c) { const int st = (r >> 4) * 2 + (c >> 5), rr = r & 15, cc = c & 31, ob = rr * 64 + cc * 2; return st * 1024 + (ob ^ (((ob >> 9) & 1) << 5)); }
__host__ __device__ __forceinline__ void stage_rc(int b, int& R, int& C) { const int st = b / 1024, sb = b % 1024, swz = sb ^ (((sb >> 9) & 1) << 5); R = (st >> 1) * 16 + swz / 64; C = (st & 1) * 32 + (swz % 64) / 2; }
__host__ __device__ __forceinline__ int perm32(int rho) { const int n = rho >> 4, i = rho & 15; return 8 * (i >> 2) + 4 * n + (i & 3); }

struct Unit { int pm, pn, sg; };
struct Gemm { const bf16_t* A; const bf16_t* Bt; int M, N, K; int ld; };

struct StaticOrder {
    int nM, nN, nwg, G, c;
    __host__ __device__ void init(int M, int N, int G_, int c_) { nM = M / BM; nN = N / BM; nwg = nM * nN; G = G_; c = c_; }
    __host__ __device__ bool next(int i, Unit& u) const {
        const long L = (long)i * G + c; if (L >= nwg) return false;
        int wgid = (int)L; { const int q = nwg / NXCD, r = nwg % NXCD, xcd = wgid % NXCD, off = wgid / NXCD; wgid = (xcd < r ? xcd * (q + 1) : r * (q + 1) + (xcd - r) * q) + off; }
        const int nig = WGM * nN, gid = wgid / nig, fm = gid * WGM, gsz = (nM - fm) < WGM ? (nM - fm) : WGM;
        u.pm = fm + ((wgid % nig) % gsz); u.pn = (wgid % nig) / gsz; u.sg = 0; return true;
    }
    __device__ __forceinline__ void a_ready(const Unit&) const {}
    __device__ __forceinline__ void done(const Unit&) const {}
};
template <int NSEG> struct SegOrder : StaticOrder {
    __host__ __device__ bool next(int i, Unit& u) const { const bool ok = StaticOrder::next(i / NSEG, u); u.sg = i % NSEG; return ok; }
};
typedef __bf16 bf16n2 __attribute__((ext_vector_type(2)));
__device__ __forceinline__ unsigned cvt_pk_bf16(float lo, float hi) { typedef float f2_ __attribute__((ext_vector_type(2))); const f2_ v = {lo, hi}; return __builtin_bit_cast(unsigned, __builtin_convertvector(v, bf16n2)); }
typedef float f32x2 __attribute__((ext_vector_type(2)));
template <class Epi, class Sched, bool STAMP = false>
__device__ __forceinline__ void gemm_phase(PG8_LAS unsigned char* lds, const Gemm g, const Sched& S, const Epi& E, unsigned long long* stamps) {
    int tid_ = threadIdx.x; asm volatile("" : "+v"(tid_));
    const int tid = tid_, wid = __builtin_amdgcn_readfirstlane(tid >> 6), lane = tid & 63, wr = wid >> 2, wc = wid & 3, fr = lane & 15, fq = lane >> 4;
    int K_ = g.K; asm volatile("" : "+s"(K_));
    int LD_ = g.ld ? g.ld : g.K; asm volatile("" : "+s"(LD_));
    const int K = K_, nt = K / BK, LD = LD_;
    int ts_lo = 0, ts_hi = 0, nts = 0; const unsigned long long rt_entry = STAMP ? (unsigned long long)wall_clock64() : 0ull;
#define PG8_STAMP() do { if (STAMP && wid == 0 && nts < 64) { const unsigned long long _c = (unsigned long long)clock64(); \
        ts_lo = (lane == nts) ? (int)(unsigned)_c : ts_lo; ts_hi = (lane == nts) ? (int)(unsigned)(_c >> 32) : ts_hi; ++nts; } } while (0)
    PG8_STAMP();
    unsigned voffA[2], voffB[2];
#pragma unroll
    for (int i = 0; i < 2; ++i) { int R, C; stage_rc(tid * 16 + i * 8192, R, C); const int Rb = Epi::PERM ? ((R & ~31) + perm32(R & 31)) : R;
        voffA[i] = (unsigned)(R * LD + C) * 2u; voffB[i] = (unsigned)(Rb * LD + C) * 2u; }
    const size_t kstep = (size_t)(BK * 2);
    const size_t hstep = (size_t)HALF * LD * 2;
    const size_t tstep = 2 * hstep;
    const unsigned ldsw = (unsigned)wid * 1024u;
    const int aoff = lds_byte(wr * 64 + fr, fq * 8), boff = lds_byte(wc * 32 + fr, fq * 8);
#define PG8_SA(b, h) (((b) * 2 + (h)) * HTB)
#define PG8_SB(b, h) ((4 + (b) * 2 + (h)) * HTB)
#define PG8_STAGE(bufoff, gbase, voff) do { _Pragma("unroll") for (int _i = 0; _i < 2; ++_i) \
        __builtin_amdgcn_global_load_lds((const unsigned*)((const char*)(gbase) + (voff)[_i]), (PG8_LAS unsigned*)(lds + (bufoff) + ldsw + _i * 8192), 16, 0, 0); } while (0)
#define PG8_LDA(dst, b, h) do { _Pragma("unroll") for (int m = 0; m < 4; ++m) _Pragma("unroll") for (int k = 0; k < 2; ++k) dst[m][k] = *(const PG8_LAS bf16x8*)(lds + PG8_SA(b, h) + aoff + m * 2048 + k * 1024); } while (0)
#define PG8_LDB(dst, b, h) do { _Pragma("unroll") for (int n = 0; n < 2; ++n) _Pragma("unroll") for (int k = 0; k < 2; ++k) dst[n][k] = *(const PG8_LAS bf16x8*)(lds + PG8_SB(b, h) + boff + n * 2048 + k * 1024); } while (0)
#define PG8_MMA(ai, bj, At, Bt) do { __builtin_amdgcn_s_setprio(1); _Pragma("unroll") for (int m = 0; m < 4; ++m) _Pragma("unroll") for (int n = 0; n < 2; ++n) _Pragma("unroll") for (int k = 0; k < 2; ++k) \
        acc[ai][bj][m][n] = __builtin_amdgcn_mfma_f32_16x16x32_bf16(Bt[n][k], At[m][k], acc[ai][bj][m][n], 0, 0, 0); __builtin_amdgcn_s_setprio(0); } while (0)
#define PG8_WAIT_V(n) asm volatile("s_waitcnt vmcnt(" #n ")" ::: "memory")
#define PG8_WAIT_L(n) asm volatile("s_waitcnt lgkmcnt(" #n ")" ::: "memory")
#define PG8_BAR __builtin_amdgcn_s_barrier()
#define PG8_SCHED __builtin_amdgcn_sched_barrier(0)
    Unit cur, nxt; int ui = 0;
    if (!S.next(0, cur)) return;
    f32x4 acc[2][2][4][2];
#pragma unroll
    for (int a = 0; a < 2; ++a)
#pragma unroll
        for (int b = 0; b < 2; ++b)
#pragma unroll
            for (int m = 0; m < 4; ++m)
#pragma unroll
                for (int n = 0; n < 2; ++n) acc[a][b][m][n] = (f32x4){0.f, 0.f, 0.f, 0.f};
    bf16x8 At[4][2], B0[2][2], B1[2][2];
    const size_t sstep = (size_t)K * 2;
    const char* cA = (const char*)g.A + (size_t)cur.pm * tstep + cur.sg * sstep; const char* cB = (const char*)g.Bt + (size_t)cur.pn * tstep + cur.sg * sstep;
    S.a_ready(cur);
    PG8_STAGE(PG8_SB(0, 0), cB, voffB); PG8_STAGE(PG8_SA(0, 0), cA, voffA); PG8_STAGE(PG8_SB(0, 1), cB + hstep, voffB); PG8_STAGE(PG8_SA(0, 1), cA + hstep, voffA);
    if (wr == 1) PG8_BAR;
    PG8_WAIT_V(4); PG8_BAR;
    PG8_STAGE(PG8_SB(1, 0), cB + kstep, voffB); PG8_STAGE(PG8_SA(1, 0), cA + kstep, voffA); PG8_STAGE(PG8_SB(1, 1), cB + hstep + kstep, voffB);
    PG8_WAIT_V(6); PG8_BAR;
    PG8_STAMP();
    for (;;) {
        const bool has_next = S.next(ui + 1, nxt);
        const char* nA = has_next ? (const char*)g.A + (size_t)nxt.pm * tstep + nxt.sg * sstep : cA; const char* nB = has_next ? (const char*)g.Bt + (size_t)nxt.pn * tstep + nxt.sg * sstep : cB;
_Pragma("nounroll")
        for (int t = 0; t < nt; t += 2) {
            const bool last = (t == nt - 2);
            const char* a1 = cA + (size_t)(t + 1) * kstep;
            const char* a2 = last ? nA : cA + (size_t)(t + 2) * kstep; const char* b2 = last ? nB : cB + (size_t)(t + 2) * kstep;
            const char* a3 = a2 + kstep; const char* b3 = b2 + kstep;
            if (last && has_next) S.a_ready(nxt);
            PG8_LDB(B0, 0, 0); PG8_SCHED; PG8_LDA(At, 0, 0); PG8_STAGE(PG8_SA(1, 1), a1 + hstep, voffA);
            PG8_WAIT_L(8); PG8_BAR; PG8_WAIT_L(0); PG8_MMA(0, 0, At, B0); PG8_BAR; PG8_SCHED;
            PG8_LDB(B1, 0, 1); PG8_STAGE(PG8_SB(0, 0), b2, voffB);
            PG8_BAR; PG8_WAIT_L(0); PG8_MMA(0, 1, At, B1); PG8_BAR;
            PG8_LDA(At, 0, 1); PG8_STAGE(PG8_SA(0, 0), a2, voffA);
            PG8_BAR; PG8_WAIT_L(0); PG8_MMA(1, 0, At, B0); PG8_BAR; PG8_SCHED;
            PG8_STAGE(PG8_SB(0, 1), b2 + hstep, voffB);
            PG8_WAIT_V(6); PG8_BAR; PG8_MMA(1, 1, At, B1); PG8_BAR;
            PG8_LDB(B0, 1, 0); PG8_SCHED; PG8_LDA(At, 1, 0); PG8_STAGE(PG8_SA(0, 1), a2 + hstep, voffA);
            PG8_WAIT_L(8); PG8_BAR; PG8_WAIT_L(0); PG8_MMA(0, 0, At, B0); PG8_BAR; PG8_SCHED;
            PG8_LDB(B1, 1, 1); PG8_STAGE(PG8_SB(1, 0), b3, voffB);
            PG8_BAR; PG8_WAIT_L(0); PG8_MMA(0, 1, At, B1); PG8_BAR;
            PG8_LDA(At, 1, 1); PG8_STAGE(PG8_SA(1, 0), a3, voffA);
            PG8_BAR; PG8_WAIT_L(0); PG8_MMA(1, 0, At, B0); PG8_BAR; PG8_SCHED;
            PG8_STAGE(PG8_SB(1, 1), b3 + hstep, voffB);
            PG8_WAIT_V(6); PG8_BAR; PG8_MMA(1, 1, At, B1); PG8_BAR;
        }
        PG8_STAMP();
        bool fin_ = true; if constexpr (Epi::SEG > 0) fin_ = (cur.sg == Epi::SEG - 1);
        if constexpr (!Epi::AFTER_DRAIN) { if (fin_) { E(acc, cur, wr, wc, fr, fq); S.done(cur); } }
        if constexpr (Epi::SEG > 0) E.mid(acc, cur, wr, wc, fr, fq, fin_ ? 1 : cur.sg + 1, fin_ ? 0.f : 1.f);
        PG8_STAMP();
        if (!has_next) break;
        if constexpr (Epi::SEG == 0)
#pragma unroll
        for (int a = 0; a < 2; ++a)
#pragma unroll
            for (int b = 0; b < 2; ++b)
#pragma unroll
                for (int m = 0; m < 4; ++m)
#pragma unroll
                    for (int n = 0; n < 2; ++n) acc[a][b][m][n] = (f32x4){0.f, 0.f, 0.f, 0.f};
        cur = nxt; cA = nA; cB = nB; ++ui;
    }
    PG8_WAIT_V(0);
    if (wr == 0) PG8_BAR;
    PG8_BAR;
    if constexpr (Epi::AFTER_DRAIN) { E.fused(acc, cur, wr, wc, fr, fq, lds, wid, lane); S.done(cur); }
    PG8_STAMP();
    if (STAMP && wid == 0) { stamps[lane] = lane < nts ? (((unsigned long long)(unsigned)ts_hi << 32) | (unsigned)ts_lo) : 0ull;
        if (lane == 62) stamps[62] = rt_entry; if (lane == 63) stamps[63] = (unsigned long long)wall_clock64(); }
#undef PG8_STAMP
#undef PG8_SA
#undef PG8_SB
#undef PG8_STAGE
#undef PG8_LDA
#undef PG8_LDB
#undef PG8_MMA
#undef PG8_WAIT_V
#undef PG8_WAIT_L
#undef PG8_BAR
#undef PG8_SCHED
}

}
#define XB_TMO      128
#define XB_XCNT(j)  (256  + 64 * (j))
#define XB_XSUB(j)  (1280 + 64 * (j))
#define XB_XGEN(j)  (2304 + 64 * (j))
#define XB_TOP      3328
#define XB_TOPGEN   3392
#define XCD_BAR_WORDS 3456
#define XB_SPIN_CAP (1u << 18)
#define LAS __attribute__((address_space(3)))

__device__ __forceinline__ unsigned xb_ld(unsigned* p)              { return __hip_atomic_load(p, __ATOMIC_RELAXED, __HIP_MEMORY_SCOPE_AGENT); }
__device__ __forceinline__ unsigned xb_add(unsigned* p, unsigned v) { return __hip_atomic_fetch_add(p, v, __ATOMIC_RELAXED, __HIP_MEMORY_SCOPE_AGENT); }
__device__ __forceinline__ unsigned xb_xcc_id() { return (unsigned)__builtin_amdgcn_s_getreg((3 << 11) | 20) & 0xFu; }
#define XB_SPIN(cond, bar) do { unsigned _sp = 0; while (cond) { __builtin_amdgcn_s_sleep(1); \
    if ((++_sp & 255u) == 0u) { if (xb_ld(&(bar)[XB_TMO])) break; if (_sp > XB_SPIN_CAP) { atomicAdd(&(bar)[XB_TMO], 1u); break; } } } } while (0)

struct XcdBarrier {
    unsigned* bar; unsigned x;
    volatile LAS unsigned* st;
};

__device__ __forceinline__ XcdBarrier xcd_barrier_post(unsigned* bar, volatile LAS unsigned* st) {
    XcdBarrier b; b.bar = bar; b.x = xb_xcc_id(); b.st = st;
    if (threadIdx.x == 0) (void)xb_add(&bar[XB_XCNT(b.x)], 1u);
    return b;
}
__device__ __forceinline__ void xcd_barrier_complete(unsigned* bar, unsigned x, unsigned& nloc, unsigned& nx) {
    const unsigned G = gridDim.x * gridDim.y * gridDim.z;
    unsigned sum, cnt, mine, sp = 0u;
    for (;;) {
        sum = 0u; cnt = 0u; mine = 0u;
#pragma unroll
        for (unsigned j = 0; j < 16; ++j) { const unsigned c = xb_ld(&bar[XB_XCNT(j)]); sum += c; cnt += (c > 0u) ? 1u : 0u; mine = (j == x) ? c : mine; }
        if (sum == G) break;
        __builtin_amdgcn_s_sleep(1);
        if ((++sp & 255u) == 0u) { if (xb_ld(&bar[XB_TMO])) break; if (sp > XB_SPIN_CAP) { atomicAdd(&bar[XB_TMO], 1u); break; } }
    }
    nloc = mine > 0u ? mine : 1u; nx = cnt > 0u ? cnt : 1u;
}

__device__ __forceinline__ void xcd_barrier(const XcdBarrier& b) {
    asm volatile("s_waitcnt vmcnt(0)" ::: "memory");
    __syncthreads();
    if (threadIdx.x == 0) {
        unsigned* bar = b.bar;
        __builtin_amdgcn_s_waitcnt(0);
        unsigned nloc = b.st[0], nx = b.st[1];
        if (nloc == 0u) { xcd_barrier_complete(bar, b.x, nloc, nx); b.st[0] = nloc; b.st[1] = nx; }
        const unsigned old = xb_add(&bar[XB_XSUB(b.x)], 1u);
        const unsigned gen = old / nloc;
        if (old + 1u == (gen + 1u) * nloc) {
            __builtin_amdgcn_fence(__ATOMIC_RELEASE, "agent");
            asm volatile("s_waitcnt vmcnt(0)" ::: "memory");
            const unsigned og = xb_add(&bar[XB_TOP], 1u);
            const unsigned tg = og / nx;
            if (og + 1u == (tg + 1u) * nx) xb_add(&bar[XB_TOPGEN], 1u);
            else XB_SPIN(xb_ld(&bar[XB_TOPGEN]) == tg, bar);
            __builtin_amdgcn_fence(__ATOMIC_ACQUIRE, "agent");
            xb_add(&bar[XB_XGEN(b.x)], 1u);
            asm volatile("s_waitcnt vmcnt(0)" ::: "memory");
        } else {
            XB_SPIN(xb_ld(&bar[XB_XGEN(b.x)]) == gen, bar);
            __builtin_amdgcn_fence(__ATOMIC_ACQUIRE, "agent");
            asm volatile("s_waitcnt vmcnt(0)" ::: "memory");
        }
    }
    __syncthreads();
}


#define LAS __attribute__((address_space(3)))
typedef float f32x4 __attribute__((ext_vector_type(4)));
typedef unsigned u32x4 __attribute__((ext_vector_type(4)));
typedef unsigned u32x2 __attribute__((ext_vector_type(2)));
typedef float f32x2 __attribute__((ext_vector_type(2)));
typedef short bf16x8_t __attribute__((ext_vector_type(8)));
typedef float f32x16 __attribute__((ext_vector_type(16)));
constexpr int NTHR = 512;
constexpr int LDS_BYTES = 147456;
constexpr int LDS_MISC = LDS_BYTES - 256;

struct Params {
    const float *x_prompt, *x_sample, *cache_kv, *cache_kr, *state_pool, *state_conv, *state_delta; const int* page_table;
    const float *norm_g, *w_in, *pool_mix, *pool_scale, *q_norm_g, *w_uq, *kv_norm_g, *w_uk, *w_uv, *conv_w, *a_log, *dt_bias, *dn_norm_g, *w_br0, *w_br1, *w_br2, *w_out, *final_norm_g;
    float* out;
    bf16_t *WinT, *WuqT, *WkvT, *WbrT, *WoutT, *PmixT; float2* tab;
    float* xres; bf16_t* xn; bf16_t* H; float* BA; bf16_t *cq, *ckv, *Kr, *Q, *Kn, *V, *Vt, *qd, *kd, *vd; float* bg; bf16_t *ya, *yb, *yc; float* mf; bf16_t* mb; float* part; bf16_t* DOP; float* DU; float* DG;
    unsigned* bar;
    int ph_lo, ph_hi, li, pad;
};

typedef const __attribute__((address_space(4))) Params* KP;

constexpr int PH_PRO = 0;
constexpr int PH_L = 8;
constexpr int PH_GIN = 0, PH_TOK = 1, PH_GQ = 2, PH_ATT = 3, PH_FIN = 4, PH_MERGE = 5, PH_OUT = 6, PH_NORM = 7;
#define PHID(l, k) (1 + (l) * PH_L + (k))
constexpr int PH_END = 1 + 2 * PH_L;

__device__ __forceinline__ void unpack8(const u32x4 v, float (&f)[8]) {
    f[0] = __uint_as_float(v.x << 16); f[1] = __uint_as_float(v.x & 0xffff0000u); f[2] = __uint_as_float(v.y << 16); f[3] = __uint_as_float(v.y & 0xffff0000u);
    f[4] = __uint_as_float(v.z << 16); f[5] = __uint_as_float(v.z & 0xffff0000u); f[6] = __uint_as_float(v.w << 16); f[7] = __uint_as_float(v.w & 0xffff0000u); }
__device__ __forceinline__ u32x4 pack8(const float (&f)[8]) { u32x4 w; w.x = pg8::cvt_pk_bf16(f[0], f[1]); w.y = pg8::cvt_pk_bf16(f[2], f[3]); w.z = pg8::cvt_pk_bf16(f[4], f[5]); w.w = pg8::cvt_pk_bf16(f[6], f[7]); return w; }
struct MEpiH { static constexpr bool PERM = true, AFTER_DRAIN = false; static constexpr int SEG = 0; bf16_t* H; float* BA;
    __device__ __forceinline__ void operator()(const f32x4 (&acc)[2][2][4][2], const pg8::Unit& u, int wr, int wc, int fr0, int fq0) const {
        int fr = fr0, fq = fq0; asm volatile("" : "+v"(fr), "+v"(fq));
        const int row0 = u.pm * 256 + wr * 64 + fr;
#pragma unroll
        for (int bj = 0; bj < 2; ++bj) {
            const int wcol = u.pn * 256 + bj * 128 + wc * 32, col0 = wcol + 8 * fq;
            const bool plain = (wcol + 32 <= C_ZPOOL) || (wcol >= C_Q && wcol + 32 <= C_ZMLA) || (wcol >= C_QKV && wcol + 32 <= C_ZDN);
            const int act = ((col0 >= C_ZPOOL && col0 < C_Q) || (col0 >= C_ZMLA && col0 < C_QKV) || (col0 >= C_ZDN && col0 < C_BETA)) ? 1 : (col0 >= C_GATE ? 2 : 0);
            const bool isba = (col0 == C_BETA) || (col0 == C_ALPHA);
#pragma unroll
            for (int ai = 0; ai < 2; ++ai)
#pragma unroll
                for (int m = 0; m < 4; ++m) { const int row = row0 + ai * 128 + m * 16; f32x4 v0 = acc[ai][bj][m][0], v1 = acc[ai][bj][m][1];
                    if (!plain) {
                        if (isba) { float* b = BA + (size_t)row * 16 + (col0 - C_BETA); *(f32x4*)b = v0; *(f32x4*)(b + 4) = v1; }
#pragma unroll
                        for (int e = 0; e < 4; ++e) { const float s0 = sigmoidf_(v0[e]), s1 = sigmoidf_(v1[e]);
                            v0[e] = act == 0 ? v0[e] : (act == 1 ? v0[e] * s0 : s0); v1[e] = act == 0 ? v1[e] : (act == 1 ? v1[e] * s1 : s1); }
                    }
                    u32x4 w; w.x = pg8::cvt_pk_bf16(v0[0], v0[1]); w.y = pg8::cvt_pk_bf16(v0[2], v0[3]); w.z = pg8::cvt_pk_bf16(v1[0], v1[1]); w.w = pg8::cvt_pk_bf16(v1[2], v1[3]);
                    *(u32x4*)(H + (size_t)row * IN_WP + col0) = w; }
        }
    } };
struct MEpiQ { static constexpr bool PERM = true, AFTER_DRAIN = false; static constexpr int SEG = 0; bf16_t* Q; const float2* tab;
    __device__ __forceinline__ void operator()(const f32x4 (&acc)[2][2][4][2], const pg8::Unit& u, int wr, int wc, int fr0, int fq0) const {
        int fr = fr0, fq = fq0; asm volatile("" : "+v"(fr), "+v"(fq));
        const int row0 = u.pm * 256 + wr * 64 + fr;
#pragma unroll
        for (int bj = 0; bj < 2; ++bj) {
            const int wcol = u.pn * 256 + bj * 128 + wc * 32, col0 = wcol + 8 * fq;
            const bool rope = (wcol % 96) == 64;
#pragma unroll
            for (int ai = 0; ai < 2; ++ai)
#pragma unroll
                for (int m = 0; m < 4; ++m) { const int row = row0 + ai * 128 + m * 16; f32x4 v0 = acc[ai][bj][m][0], v1 = acc[ai][bj][m][1];
                    if (rope) { const int p = row < TP ? (row & (SEQ - 1)) : SEQ + ((row - TP) & 7); const float2* tp = tab + p * 16 + (fq & 1) * 8; const bool hi = fq >= 2;
#pragma unroll
                        for (int e = 0; e < 4; ++e) { const float o0 = __shfl_xor(v0[e], 32), o1 = __shfl_xor(v1[e], 32); const float2 c0 = tp[e], c1 = tp[4 + e];
                            v0[e] = hi ? (v0[e] * c0.x + o0 * c0.y) : (v0[e] * c0.x - o0 * c0.y); v1[e] = hi ? (v1[e] * c1.x + o1 * c1.y) : (v1[e] * c1.x - o1 * c1.y); } }
                    u32x4 w; w.x = pg8::cvt_pk_bf16(v0[0], v0[1]); w.y = pg8::cvt_pk_bf16(v0[2], v0[3]); w.z = pg8::cvt_pk_bf16(v1[0], v1[1]); w.w = pg8::cvt_pk_bf16(v1[2], v1[3]);
                    *(u32x4*)(Q + (size_t)row * 768 + col0) = w; asm volatile("" ::: "memory"); }
        }
    } };
struct MEpiKV { static constexpr bool PERM = true, AFTER_DRAIN = false; static constexpr int SEG = 0; bf16_t* Kn; bf16_t* V;
    __device__ __forceinline__ void operator()(const f32x4 (&acc)[2][2][4][2], const pg8::Unit& u, int wr, int wc, int fr0, int fq0) const {
        int fr = fr0, fq = fq0; asm volatile("" : "+v"(fr), "+v"(fq));
        const int row0 = u.pm * 256 + wr * 64 + fr; bf16_t* base = u.pn < 2 ? Kn : V; const int cb = (u.pn & 1) * 256;
#pragma unroll
        for (int bj = 0; bj < 2; ++bj) { const int col0 = cb + bj * 128 + wc * 32 + 8 * fq;
#pragma unroll
            for (int ai = 0; ai < 2; ++ai)
#pragma unroll
                for (int m = 0; m < 4; ++m) { const int row = row0 + ai * 128 + m * 16; const f32x4 v0 = acc[ai][bj][m][0], v1 = acc[ai][bj][m][1];
                    u32x4 w; w.x = pg8::cvt_pk_bf16(v0[0], v0[1]); w.y = pg8::cvt_pk_bf16(v0[2], v0[3]); w.z = pg8::cvt_pk_bf16(v1[0], v1[1]); w.w = pg8::cvt_pk_bf16(v1[2], v1[3]);
                    *(u32x4*)(base + (size_t)row * 512 + col0) = w; } }
    } };
template <int BR> struct MEpiMerge { static constexpr bool PERM = true, AFTER_DRAIN = false; static constexpr int SEG = 0; const bf16_t* H; float* mf; bf16_t* mb;
    __device__ __forceinline__ void operator()(const f32x4 (&acc)[2][2][4][2], const pg8::Unit& u, int wr, int wc, int fr0, int fq0) const {
        int fr = fr0, fq = fq0; asm volatile("" : "+v"(fr), "+v"(fq));
        const int row0 = u.pm * 256 + wr * 64 + fr;
#pragma unroll
        for (int bj = 0; bj < 2; ++bj) { const int col0 = u.pn * 256 + bj * 128 + wc * 32 + 8 * fq;
#pragma unroll
            for (int ai = 0; ai < 2; ++ai)
#pragma unroll
                for (int m = 0; m < 4; ++m) { const int row = row0 + ai * 128 + m * 16; f32x4 v0 = acc[ai][bj][m][0], v1 = acc[ai][bj][m][1];
                    const u32x4 g = *(const u32x4*)(H + (size_t)row * IN_WP + C_GATE + BR * 1024 + col0);
                    v0[0] *= __uint_as_float(g.x << 16); v0[1] *= __uint_as_float(g.x & 0xffff0000u); v0[2] *= __uint_as_float(g.y << 16); v0[3] *= __uint_as_float(g.y & 0xffff0000u);
                    v1[0] *= __uint_as_float(g.z << 16); v1[1] *= __uint_as_float(g.z & 0xffff0000u); v1[2] *= __uint_as_float(g.w << 16); v1[3] *= __uint_as_float(g.w & 0xffff0000u);
                    float* mp = mf + (size_t)row * 1024 + col0;
                    if (BR > 0) { v0 += *(const f32x4*)mp; v1 += *(const f32x4*)(mp + 4); }
                    if (BR < 2) { *(f32x4*)mp = v0; *(f32x4*)(mp + 4) = v1; }
                    else { u32x4 w; w.x = pg8::cvt_pk_bf16(v0[0], v0[1]); w.y = pg8::cvt_pk_bf16(v0[2], v0[3]); w.z = pg8::cvt_pk_bf16(v1[0], v1[1]); w.w = pg8::cvt_pk_bf16(v1[2], v1[3]);
                        *(u32x4*)(mb + (size_t)row * 1024 + col0) = w; } asm volatile("" ::: "memory"); } }
    } };
struct MEpiRes { static constexpr bool PERM = false, AFTER_DRAIN = false; static constexpr int SEG = 0; const float* xp; const float* xs; float* xo;
    __device__ __forceinline__ void operator()(const f32x4 (&acc)[2][2][4][2], const pg8::Unit& u, int wr, int wc, int fr0, int fq0) const {
        int fr = fr0, fq = fq0; asm volatile("" : "+v"(fr), "+v"(fq));
        const int row0 = u.pm * 256 + wr * 64 + fr, col0 = u.pn * 256 + wc * 32 + 4 * fq;
#pragma unroll
        for (int ai = 0; ai < 2; ++ai)
#pragma unroll
            for (int m = 0; m < 4; ++m) { const int row = row0 + ai * 128 + m * 16; const float* xr = row < TP ? xp + (size_t)row * 1024 : xs + (size_t)(row - TP) * 1024; float* orow = xo + (size_t)row * 1024;
#pragma unroll
                for (int bj = 0; bj < 2; ++bj)
#pragma unroll
                    for (int n = 0; n < 2; ++n) { const int c = col0 + bj * 128 + n * 16; *(f32x4*)(orow + c) = *(const f32x4*)(xr + c) + acc[ai][bj][m][n]; } }
    } };

template <int NSEG, class Epi>
__device__ __forceinline__ void tail_gemm(const bf16_t* __restrict__ A, int lda, const bf16_t* __restrict__ Bt, int K, int N, const Epi& epi, LAS unsigned char* lds) {
    int tid = threadIdx.x; asm volatile("" : "+v"(tid));
    const int lane = tid & 63, wave = __builtin_amdgcn_readfirstlane(tid >> 6), rt = wave & 3, kh = wave >> 2, n = lane & 15, q = lane >> 4;
    const int ntile = 4 * (N / 16), kseg = K / NSEG, khalf = kseg / 2;
    LAS f32x4* red = (LAS f32x4*)lds;
    for (int tile = blockIdx.x; tile < ntile; tile += gridDim.x) {
        const int r0 = 64 * (tile & 3) + 16 * rt, c0 = 16 * (tile >> 2);
        const bf16_t* ap = A + (size_t)(r0 + n) * lda + 8 * q; const bf16_t* bp = Bt + (size_t)(c0 + n) * K + 8 * q;
        f32x4 acc[NSEG];
#pragma unroll
        for (int sg = 0; sg < NSEG; ++sg) { acc[sg] = (f32x4){0.f, 0.f, 0.f, 0.f};
            const int kb = sg * kseg + kh * khalf;
#pragma unroll 4
            for (int k = 0; k < khalf; k += 32) acc[sg] = __builtin_amdgcn_mfma_f32_16x16x32_bf16(*(const bf16x8_t*)(ap + kb + k), *(const bf16x8_t*)(bp + kb + k), acc[sg], 0, 0, 0); }
        __syncthreads();
        if (kh == 1) {
#pragma unroll
            for (int sg = 0; sg < NSEG; ++sg) red[(rt * NSEG + sg) * 64 + lane] = acc[sg]; }
        __syncthreads();
        if (kh == 0) {
#pragma unroll
            for (int sg = 0; sg < NSEG; ++sg) acc[sg] += red[(rt * NSEG + sg) * 64 + lane];
#pragma unroll
            for (int e = 0; e < 4; ++e) { float v[NSEG];
#pragma unroll
                for (int sg = 0; sg < NSEG; ++sg) v[sg] = acc[sg][e];
                epi(r0 + 4 * q + e, c0 + n, v); } }
    }
    __syncthreads();
}
struct TEpiMerge { const bf16_t* H; bf16_t* mb;
    __device__ __forceinline__ void operator()(int row, int col, const float (&v)[3]) const { const size_t t = (size_t)TP + row; const bf16_t* g = H + t * IN_WP + C_GATE + col;
        mb[t * 1024 + col] = f2bf(bf2f(g[0]) * v[0] + bf2f(g[1024]) * v[1] + bf2f(g[2048]) * v[2]); } };
struct TEpiRes { const float* xs; float* xo;
    __device__ __forceinline__ void operator()(int row, int col, const float (&v)[1]) const { xo[((size_t)TP + row) * 1024 + col] = xs[(size_t)row * 1024 + col] + v[0]; } };
struct MEpiMergeS { static constexpr bool PERM = true, AFTER_DRAIN = false; static constexpr int SEG = 3; const bf16_t* H; bf16_t* mb;
    __device__ __forceinline__ void mid(f32x4 (&acc)[2][2][4][2], const pg8::Unit& u, int wr, int wc, int fr0, int fq0, int seg, float keep) const {
        int fr = fr0, fq = fq0; asm volatile("" : "+v"(fr), "+v"(fq));
        const int row0 = u.pm * 256 + wr * 64 + fr;
#pragma unroll
        for (int bj = 0; bj < 2; ++bj) { const int col0 = u.pn * 256 + bj * 128 + wc * 32 + 8 * fq;
#pragma unroll
            for (int ai = 0; ai < 2; ++ai) {
                u32x4 ga[4], gb[4];
#pragma unroll
                for (int m = 0; m < 4; ++m) { const bf16_t* gp = H + (size_t)(row0 + ai * 128 + m * 16) * IN_WP + C_GATE + (seg - 1) * 1024 + col0; ga[m] = *(const u32x4*)gp; gb[m] = *(const u32x4*)(gp + 1024); }
#pragma unroll
                for (int m = 0; m < 4; ++m) { float a[8], b[8]; unpack8(ga[m], a); unpack8(gb[m], b);
#pragma unroll
                    for (int e = 0; e < 4; ++e) { acc[ai][bj][m][0][e] *= keep * a[e] * __builtin_amdgcn_rcpf(fmaxf(b[e], 1e-30f)); acc[ai][bj][m][1][e] *= keep * a[4 + e] * __builtin_amdgcn_rcpf(fmaxf(b[4 + e], 1e-30f)); } }
                asm volatile("" ::: "memory"); } }
    }
    __device__ __forceinline__ void operator()(const f32x4 (&acc)[2][2][4][2], const pg8::Unit& u, int wr, int wc, int fr0, int fq0) const {
        int fr = fr0, fq = fq0; asm volatile("" : "+v"(fr), "+v"(fq));
        const int row0 = u.pm * 256 + wr * 64 + fr;
#pragma unroll
        for (int bj = 0; bj < 2; ++bj) { const int col0 = u.pn * 256 + bj * 128 + wc * 32 + 8 * fq;
#pragma unroll
            for (int ai = 0; ai < 2; ++ai) {
                u32x4 gg[4];
#pragma unroll
                for (int m = 0; m < 4; ++m) gg[m] = *(const u32x4*)(H + (size_t)(row0 + ai * 128 + m * 16) * IN_WP + C_GATE + 2048 + col0);
#pragma unroll
                for (int m = 0; m < 4; ++m) { const int row = row0 + ai * 128 + m * 16; float g[8]; unpack8(gg[m], g);
                    const f32x4 v0 = acc[ai][bj][m][0], v1 = acc[ai][bj][m][1];
                    u32x4 w; w.x = pg8::cvt_pk_bf16(v0[0] * g[0], v0[1] * g[1]); w.y = pg8::cvt_pk_bf16(v0[2] * g[2], v0[3] * g[3]); w.z = pg8::cvt_pk_bf16(v1[0] * g[4], v1[1] * g[5]); w.w = pg8::cvt_pk_bf16(v1[2] * g[6], v1[3] * g[7]);
                    *(u32x4*)(mb + (size_t)row * 1024 + col0) = w; }
                asm volatile("" ::: "memory"); } }
    } };

__device__ __forceinline__ void ph_tr(const float* __restrict__ src, bf16_t* __restrict__ dst, int K, int N, int Npad, LAS float* tile, int rot, int ldd = 0) {
    if (ldd == 0) ldd = K;
    int tid = threadIdx.x; asm volatile("" : "+v"(tid)); const int G = gridDim.x; const int tn = Npad / 64, tk = K / 32, nt = tn * tk;
    const int first = (blockIdx.x + G - (rot % G)) % G;
    const bool al4 = (N & 3) == 0;
    for (int t = first; t < nt; t += G) {
        const int n0 = (t % tn) * 64, k0 = (t / tn) * 32;
        { const int k = tid >> 4, n4 = (tid & 15) * 4, n = n0 + n4; f32x4 v = (f32x4){0.f, 0.f, 0.f, 0.f};
          const float* sp = src + (size_t)(k0 + k) * N + n;
          if (al4 && n + 3 < N) v = *(const f32x4*)sp; else {
#pragma unroll
              for (int e = 0; e < 4; ++e) if (n + e < N) v[e] = sp[e]; }
#pragma unroll
          for (int e = 0; e < 4; ++e) tile[k * 65 + n4 + e] = v[e]; }
        __syncthreads();
        if (tid < 256) { const int n = tid >> 2, kq = (tid & 3) * 8; float f[8];
#pragma unroll
            for (int j = 0; j < 8; ++j) f[j] = tile[(kq + j) * 65 + n];
            *(u32x4*)(dst + (size_t)(n0 + n) * ldd + k0 + kq) = pack8(f); }
        __syncthreads();
    }
}
__device__ __forceinline__ void ph_rope_tab(float2* tab) {
    for (int idx = blockIdx.x * NTHR + threadIdx.x; idx < (SEQ + DEC_SEQ) * 16; idx += gridDim.x * NTHR) {
        const int p = idx >> 4, i = idx & 15; const int pos = p < SEQ ? p : PAST_LEN + (p - SEQ);
        const float inv = powf(10000.0f, -(float)i / 16.0f); const float ang = (float)pos * inv;
        const double rev = (double)ang * 0.15915494309189533576888; const float f = (float)(rev - floor(rev));
        tab[idx] = make_float2(__builtin_amdgcn_cosf(f), __builtin_amdgcn_sinf(f)); }
}
__device__ __forceinline__ void ph_rmsnorm(const float* __restrict__ xp, const float* __restrict__ xs, const float* __restrict__ g, bf16_t* __restrict__ xn, float* __restrict__ yp, float* __restrict__ ys) {
    int tid_o = threadIdx.x; asm volatile("" : "+v"(tid_o)); int lane = tid_o & 63, wave = tid_o >> 6;
    for (int t = blockIdx.x * 8 + wave; t < TT; t += gridDim.x * 8) {
        const float* x = t < TP ? xp + (size_t)t * 1024 : xs + (size_t)(t - TP) * 1024;
        f32x4 v[4]; float ss = 0.f;
#pragma unroll
        for (int i = 0; i < 4; ++i) { v[i] = *(const f32x4*)(x + i * 256 + lane * 4); ss += v[i][0] * v[i][0] + v[i][1] * v[i][1] + v[i][2] * v[i][2] + v[i][3] * v[i][3]; }
        ss = wave_sum(ss); const float r = rsqrtf(ss * (1.0f / 1024.0f) + EPS);
#pragma unroll
        for (int i = 0; i < 4; ++i) { const int c = i * 256 + lane * 4; const f32x4 gg = *(const f32x4*)(g + c); const f32x4 o = v[i] * r * gg;
            if (xn) { u32x2 w; w.x = pg8::cvt_pk_bf16(o[0], o[1]); w.y = pg8::cvt_pk_bf16(o[2], o[3]); *(u32x2*)(xn + (size_t)t * 1024 + c) = w; }
            else { float* y = t < TP ? yp + (size_t)t * 1024 : ys + (size_t)(t - TP) * 1024; *(f32x4*)(y + c) = o; } }
    }
}

constexpr int TK_RS = 1040;
__device__ __forceinline__ void tok8(KP p, int l, int tbase, int iseq0, bool smp, int sq, int lane) {
    const bf16_t* __restrict__ H = p->H; float* __restrict__ out = p->out;
    { const float* qg = p->q_norm_g + l * 384; const float* kvg = p->kv_norm_g + l * 256;
      u32x4 rq[8], rk[8];
#pragma unroll
      for (int e = 0; e < 8; ++e) { const bf16_t* h = H + (size_t)(tbase + e) * IN_WP;
          rq[e] = lane < 48 ? *(const u32x4*)(h + C_Q + lane * 8) : (u32x4){0u, 0u, 0u, 0u}; rk[e] = lane < 32 ? *(const u32x4*)(h + C_KV + lane * 8) : (u32x4){0u, 0u, 0u, 0u}; }
      f32x4 gq0 = (f32x4){0.f, 0.f, 0.f, 0.f}, gq1 = gq0, gk0 = gq0, gk1 = gq0;
      if (lane < 48) { gq0 = *(const f32x4*)(qg + lane * 8); gq1 = *(const f32x4*)(qg + lane * 8 + 4); }
      if (lane < 32) { gk0 = *(const f32x4*)(kvg + lane * 8); gk1 = *(const f32x4*)(kvg + lane * 8 + 4); }
#pragma unroll
      for (int e = 0; e < 8; ++e) { const int t = tbase + e; float q[8], kv[8]; unpack8(rq[e], q); unpack8(rk[e], kv); float s1 = 0.f, s2 = 0.f;
#pragma unroll
          for (int j = 0; j < 8; ++j) { s1 += q[j] * q[j]; s2 += kv[j] * kv[j]; }
          s1 = wave_sum(s1); s2 = wave_sum(s2); const float r1 = rsqrtf(s1 * (1.0f / 384.0f) + EPS), r2 = rsqrtf(s2 * (1.0f / 256.0f) + EPS);
#pragma unroll
          for (int j = 0; j < 4; ++j) { q[j] *= r1 * gq0[j]; q[4 + j] *= r1 * gq1[j]; kv[j] *= r2 * gk0[j]; kv[4 + j] *= r2 * gk1[j]; }
          if (lane < 48) *(u32x4*)(p->cq + (size_t)t * 384 + lane * 8) = pack8(q);
          if (lane < 32) { float* okv = (smp ? out + O_SKV + ((size_t)l * TS + (t - TP)) * 256 : out + O_PKV + ((size_t)l * TP + t) * 256) + lane * 8;
              *(f32x4*)okv = (f32x4){kv[0], kv[1], kv[2], kv[3]}; *(f32x4*)(okv + 4) = (f32x4){kv[4], kv[5], kv[6], kv[7]};
              *(u32x4*)(p->ckv + (size_t)t * 256 + lane * 8) = pack8(kv); } }
#pragma unroll
      for (int ps = 0; ps < 2; ++ps) { const int e = (lane >> 4) + 4 * ps, j = lane & 15, t = tbase + e; const bf16_t* h = H + (size_t)t * IN_WP;
          const float x1 = bf2f(h[C_KR + j]), x2 = bf2f(h[C_KR + 16 + j]); const float2 cs = p->tab[((smp ? SEQ : 0) + iseq0 + e) * 16 + j];
          const float o1 = x1 * cs.x - x2 * cs.y, o2 = x2 * cs.x + x1 * cs.y; float* okr = smp ? out + O_SKR + ((size_t)l * TS + (t - TP)) * 32 : out + O_PKR + ((size_t)l * TP + t) * 32;
          okr[j] = o1; okr[16 + j] = o2; p->Kr[(size_t)t * 32 + j] = f2bf(o1); p->Kr[(size_t)t * 32 + 16 + j] = f2bf(o2); } }
    { const float* conv_w = p->conv_w + (size_t)l * 4 * 1536; const bool last = smp || (iseq0 == SEQ - 8);
#pragma unroll 1
      for (int pi = 0; pi < 3; ++pi) { const int c0 = (pi * 64 + lane) * 8;
          u32x4 rows[11];
#pragma unroll
          for (int j = 0; j < 11; ++j) { const int u = iseq0 - 3 + j;
              if (u >= 0) rows[j] = *(const u32x4*)(H + (size_t)(tbase - 3 + j) * IN_WP + C_QKV + c0);
              else if (smp) { const float* sc = p->state_conv + (((size_t)l * DEC_BATCH + sq) * 3 + (u + 3)) * 1536 + c0; const f32x4 a = *(const f32x4*)sc, b = *(const f32x4*)(sc + 4);
                  rows[j].x = pg8::cvt_pk_bf16(a[0], a[1]); rows[j].y = pg8::cvt_pk_bf16(a[2], a[3]); rows[j].z = pg8::cvt_pk_bf16(b[0], b[1]); rows[j].w = pg8::cvt_pk_bf16(b[2], b[3]); }
              else rows[j] = (u32x4){0u, 0u, 0u, 0u}; }
          f32x4 w0[4], w1[4];
#pragma unroll
          for (int j = 0; j < 4; ++j) { w0[j] = *(const f32x4*)(conv_w + j * 1536 + c0); w1[j] = *(const f32x4*)(conv_w + j * 1536 + c0 + 4); }
          bf16_t* dst = pi == 0 ? p->qd : (pi == 1 ? p->kd : p->vd);
#pragma unroll
          for (int e = 0; e < 8; ++e) { float y[8];
#pragma unroll
              for (int k = 0; k < 8; ++k) y[k] = 0.f;
#pragma unroll
              for (int j = 0; j < 4; ++j) { float x[8]; unpack8(rows[e + j], x);
#pragma unroll
                  for (int k = 0; k < 4; ++k) { y[k] += x[k] * w0[j][k]; y[4 + k] += x[4 + k] * w1[j][k]; } }
              float ss = 0.f;
#pragma unroll
              for (int k = 0; k < 8; ++k) { y[k] = siluf_(y[k]); ss += y[k] * y[k]; }
              if (pi < 2) { ss += __shfl_xor(ss, 1); ss += __shfl_xor(ss, 2); ss += __shfl_xor(ss, 4); const float rn = rsqrtf(ss + EPS) * (pi == 0 ? 0.125f : 1.0f);
#pragma unroll
                  for (int k = 0; k < 8; ++k) y[k] *= rn; }
              *(u32x4*)(dst + (size_t)(tbase + e) * 512 + lane * 8) = pack8(y); }
          if (last) {
#pragma unroll
              for (int rr = 0; rr < 3; ++rr) { float x[8]; unpack8(rows[8 + rr], x);
                  float* oc = (smp ? out + O_SCONV + (((size_t)l * DEC_BATCH + sq) * 3 + rr) * 1536 : out + O_PCONV + (((size_t)l * 8 + (tbase >> 11)) * 3 + rr) * 1536) + c0;
                  *(f32x4*)oc = (f32x4){x[0], x[1], x[2], x[3]}; *(f32x4*)(oc + 4) = (f32x4){x[4], x[5], x[6], x[7]}; } } } }
    { const int t = tbase + (lane >> 3), hd = lane & 7; const float bb = sigmoidf_(p->BA[(size_t)t * 16 + hd]); const float x = p->BA[(size_t)t * 16 + 8 + hd] + p->dt_bias[l * 8 + hd];
      const float sp = x > 20.f ? x : log1pf(expf(x)); const float gg = -expf(p->a_log[l * 8 + hd]) * sp;
      p->bg[(size_t)t * 16 + hd] = bb; p->bg[(size_t)t * 16 + 8 + hd] = gg; }
}
__device__ __forceinline__ void ph_tok(KP p, int l, LAS unsigned char* lds) {
    int tid = threadIdx.x; asm volatile("" : "+v"(tid));
    const int lane = tid & 63, wave = __builtin_amdgcn_readfirstlane(tid >> 6), r = lane & 31, hh = lane >> 5;
    const bf16_t* __restrict__ H = p->H; float* __restrict__ out = p->out;
    for (int tile = blockIdx.x; tile < TP / 64 + 8; tile += gridDim.x) {
        const bool smp = tile >= TP / 64; const int s0 = smp ? (tile - TP / 64) * 4 : 0;
        const int t0 = smp ? TP + s0 * 8 : tile * 64, i0 = smp ? 0 : (t0 & (SEQ - 1)), b = t0 >> 11;
        __syncthreads();
        if (!smp) {
            for (int c = tid; c < 79 * 64; c += NTHR) { const int row = c >> 6, ch16 = c & 63; u32x4 v = (u32x4){0u, 0u, 0u, 0u};
                if (i0 - 15 + row >= 0) v = *(const u32x4*)(H + (size_t)(t0 - 15 + row) * IN_WP + C_POOL + ch16 * 8);
                *(LAS u32x4*)(lds + row * TK_RS + ch16 * 16) = v; }
        } else {
            for (int c = tid; c < 92 * 64; c += NTHR) { const int row = c >> 6, ch16 = c & 63, sq = row / 23, j = row - sq * 23; u32x4 v;
                if (j >= 15) v = *(const u32x4*)(H + (size_t)(t0 + sq * 8 + (j - 15)) * IN_WP + C_POOL + ch16 * 8);
                else { const float* sp = p->state_pool + (((size_t)l * DEC_BATCH + s0 + sq) * 15 + j) * 512 + ch16 * 8; const f32x4 a = *(const f32x4*)sp, bq = *(const f32x4*)(sp + 4);
                    v.x = pg8::cvt_pk_bf16(a[0], a[1]); v.y = pg8::cvt_pk_bf16(a[2], a[3]); v.z = pg8::cvt_pk_bf16(bq[0], bq[1]); v.w = pg8::cvt_pk_bf16(bq[2], bq[3]);
                    if (j >= 8) { float* so = out + O_SPOOL + (((size_t)l * DEC_BATCH + s0 + sq) * 15 + (j - 8)) * 512 + ch16 * 8; *(f32x4*)so = a; *(f32x4*)(so + 4) = bq; } }
                *(LAS u32x4*)(lds + row * TK_RS + ch16 * 16) = v; }
        }
        __syncthreads();
        if (!(smp && (wave & 1))) { const int g = wave >> 1, th = wave & 1, w = 2 << g, tk = 32 * th + r;
          const int brow = smp ? (tk >> 3) * 23 + 15 + (tk & 7) : 15 + tk; const float inv = 1.0f / (float)(smp ? w : min(i0 + tk + 1, w));
          const bf16_t* mixT = p->PmixT + ((size_t)l * 4 + g) * 128 * 128;
          f32x16 acc[4];
#pragma unroll
          for (int nt = 0; nt < 4; ++nt)
#pragma unroll
              for (int e = 0; e < 16; ++e) acc[nt][e] = 0.f;
#pragma unroll 2
          for (int ks = 0; ks < 8; ++ks) {
              const LAS unsigned char* base = lds + brow * TK_RS + (128 * g + 16 * ks + 8 * hh) * 2;
              float cur[8], sum[8]; unpack8(*(const LAS u32x4*)base, cur);
#pragma unroll
              for (int e = 0; e < 8; ++e) sum[e] = cur[e];
              for (int k = 1; k < w; ++k) { float x[8]; unpack8(*(const LAS u32x4*)(base - k * TK_RS), x);
#pragma unroll
                  for (int e = 0; e < 8; ++e) sum[e] += x[e]; }
#pragma unroll
              for (int e = 0; e < 8; ++e) sum[e] = sum[e] * inv - cur[e];
              union { u32x4 u; bf16x8_t v; } bfr; bfr.u = pack8(sum);
#pragma unroll
              for (int nt = 0; nt < 4; ++nt) { const bf16x8_t a = *(const bf16x8_t*)(mixT + (size_t)(32 * nt + r) * 128 + 16 * ks + 8 * hh);
                  acc[nt] = __builtin_amdgcn_mfma_f32_32x32x16_bf16(a, bfr.v, acc[nt], 0, 0, 0); } }
          const size_t t = (size_t)t0 + tk; const float* scl = p->pool_scale + l * 512 + 128 * g;
#pragma unroll
          for (int nt = 0; nt < 4; ++nt)
#pragma unroll
              for (int gg = 0; gg < 4; ++gg) { const int dd0 = 32 * nt + 8 * gg + 4 * hh; const u32x2 z = *(const u32x2*)(H + t * IN_WP + C_ZPOOL + 128 * g + dd0); const f32x4 sc = *(const f32x4*)(scl + dd0);
                  float v0 = acc[nt][4 * gg + 0] * sc[0] * __uint_as_float(z.x << 16), v1 = acc[nt][4 * gg + 1] * sc[1] * __uint_as_float(z.x & 0xffff0000u);
                  float v2 = acc[nt][4 * gg + 2] * sc[2] * __uint_as_float(z.y << 16), v3 = acc[nt][4 * gg + 3] * sc[3] * __uint_as_float(z.y & 0xffff0000u);
                  u32x2 o; o.x = pg8::cvt_pk_bf16(v0, v1); o.y = pg8::cvt_pk_bf16(v2, v3); *(u32x2*)(p->ya + t * 1536 + 128 * g + dd0) = o; } }
        if (!smp) { if (i0 == SEQ - 64) { for (int c = tid; c < 15 * 512; c += NTHR) { const int rr = c >> 9, ch = c & 511;
              out[O_PPOOL + (((size_t)l * 8 + b) * 15 + rr) * 512 + ch] = bf2f(*(const LAS bf16_t*)(lds + (15 + 49 + rr) * TK_RS + ch * 2)); } } }
        else { for (int c = tid; c < 4 * 8 * 512; c += NTHR) { const int sq = c >> 12, i = (c >> 9) & 7, ch = c & 511;
              out[O_SPOOL + (((size_t)l * DEC_BATCH + s0 + sq) * 15 + 7 + i) * 512 + ch] = bf2f(*(const LAS bf16_t*)(lds + (sq * 23 + 15 + i) * TK_RS + ch * 2)); } }
        if (!smp) tok8(p, l, t0 + wave * 8, i0 + wave * 8, false, 0, lane);
        else if (wave < 4) tok8(p, l, t0 + wave * 8, 0, true, s0 + wave, lane);
    }
    __syncthreads();
}

__device__ __forceinline__ void wu_delta(KP p, int l, int sq, int h, int dv) {
    int row0, L; float* so; float S[64];
    if (sq < 8) { row0 = sq * SEQ; L = SEQ; so = p->out + O_PDELTA + (((size_t)l * 8 + sq) * 8 + h) * 4096;
#pragma unroll
        for (int k = 0; k < 64; ++k) S[k] = 0.f; }
    else { const int s = sq - 8; row0 = TP + s * 8; L = DEC_SEQ; so = p->out + O_SDELTA + (((size_t)l * DEC_BATCH + s) * 8 + h) * 4096;
        const float* s0 = p->state_delta + (((size_t)l * DEC_BATCH + s) * 8 + h) * 4096;
#pragma unroll
        for (int k = 0; k < 64; ++k) S[k] = s0[k * 64 + dv]; }
    const float gn = p->dn_norm_g[l * 64 + dv];
    for (int i = 0; i < L; ++i) {
        const size_t t = (size_t)row0 + i; const u32x4* kp = (const u32x4*)(p->kd + t * 512 + h * 64); const u32x4* qp = (const u32x4*)(p->qd + t * 512 + h * 64);
        const float b = p->bg[t * 16 + h], a = __expf(p->bg[t * 16 + 8 + h]); const float v = bf2f(p->vd[t * 512 + h * 64 + dv]);
        u32x4 kk[8];
#pragma unroll
        for (int c = 0; c < 8; ++c) kk[c] = kp[c];
        float ks = 0.f;
#pragma unroll
        for (int c = 0; c < 8; ++c)
#pragma unroll
            for (int e = 0; e < 4; ++e) { const unsigned w = kk[c][e]; ks += __uint_as_float(w << 16) * S[c * 8 + 2 * e] + __uint_as_float(w & 0xffff0000u) * S[c * 8 + 2 * e + 1]; }
        const float vn = b * (v - a * ks); float o = 0.f;
#pragma unroll
        for (int c = 0; c < 8; ++c) { const u32x4 qv = qp[c];
#pragma unroll
            for (int e = 0; e < 4; ++e) { const unsigned w = kk[c][e], wq = qv[e]; const int k0 = c * 8 + 2 * e;
                S[k0] = a * S[k0] + __uint_as_float(w << 16) * vn; o += __uint_as_float(wq << 16) * S[k0];
                S[k0 + 1] = a * S[k0 + 1] + __uint_as_float(w & 0xffff0000u) * vn; o += __uint_as_float(wq & 0xffff0000u) * S[k0 + 1]; }
            asm volatile("" ::: "memory"); }
        const float ss = wave_sum(o * o); const float y = o * rsqrtf(ss * (1.0f / 64.0f) + EPS) * gn;
        p->yc[t * 1536 + h * 64 + dv] = f2bf(y * bf2f(p->H[t * IN_WP + C_ZDN + h * 64 + dv]));
    }
#pragma unroll
    for (int k = 0; k < 64; ++k) so[k * 64 + dv] = S[k];
}
__device__ __forceinline__ int sig_inv(int rho) { return (rho & 32) | ((rho & 12) << 1) | ((rho & 16) >> 2) | (rho & 3); }
constexpr int DPRE_LDS = 64 * 64 * 4 + 512;
constexpr int DST = 72;
__device__ __forceinline__ void dpre_flush(const LAS bf16_t* St, bf16_t* gdst, int lane) {
    asm volatile("s_waitcnt lgkmcnt(0)" ::: "memory");
#pragma unroll
    for (int it = 0; it < 8; ++it) { const int row = (lane >> 3) + 8 * it, chunk = lane & 7; *(u32x4*)(gdst + row * 64 + chunk * 8) = *(const LAS u32x4*)(St + row * DST + chunk * 8); }
    asm volatile("s_waitcnt lgkmcnt(0)" ::: "memory");
}
__device__ __forceinline__ void ph_delta_pre(KP p, LAS unsigned char* lds) {
    int tid_o = threadIdx.x; asm volatile("" : "+v"(tid_o)); int lane = tid_o & 63, wave = tid_o >> 6;
    wave = __builtin_amdgcn_readfirstlane(wave);
    LAS float* Am = (LAS float*)(lds + wave * DPRE_LDS); LAS float* gcs = Am + 4096; LAS float* bts = gcs + 64; LAS bf16_t* St = (LAS bf16_t*)Am;
    for (int unit = wave * gridDim.x + blockIdx.x; unit < 2048; unit += gridDim.x * 8) {
        { int t_ = threadIdx.x; asm volatile("" : "+v"(t_)); lane = t_ & 63; }
        const int r = lane & 31, hh = lane >> 5;
        const int bh = unit >> 5, ch = unit & 31, b = bh >> 3, h = bh & 7;
        const size_t t0 = (size_t)b * SEQ + ch * 64;
        bf16_t* op = p->DOP + (size_t)unit * 4 * 4096; float* up = p->DU + (size_t)unit * 4096;
        const bf16_t* kdb = p->kd + t0 * 512 + h * 64; const bf16_t* qdb = p->qd + t0 * 512 + h * 64; const bf16_t* vdb = p->vd + t0 * 512 + h * 64;
        const float* bgb = p->bg + t0 * 16 + h;
        const float beta = bgb[lane * 16]; float gc = bgb[lane * 16 + 8];
#pragma unroll
        for (int d = 1; d < 64; d <<= 1) { const float x = __shfl_up(gc, d); if (lane >= d) gc += x; }
        const float gl = __shfl(gc, 63); const float egc = __expf(gc);
        gcs[lane] = gc; bts[lane] = beta;
        if (lane == 0) p->DG[unit] = __expf(gl);
        bf16x8_t kf[2][4], qf[2][4];
        { const int voff = r * 512 + 8 * hh;
#pragma unroll
          for (int rb = 0; rb < 2; ++rb)
#pragma unroll
            for (int ks = 0; ks < 4; ++ks) { kf[rb][ks] = *(const bf16x8_t*)(kdb + (32 * rb * 512 + 16 * ks) + voff); qf[rb][ks] = *(const bf16x8_t*)(qdb + (32 * rb * 512 + 16 * ks) + voff); } }
        {
#pragma unroll
            for (int rb = 0; rb < 2; ++rb) { const float sc = __expf(gl - __shfl(gc, 32 * rb + r)); const int pos = sig_inv(32 * rb + r);
#pragma unroll
                for (int ks = 0; ks < 4; ++ks)
#pragma unroll
                    for (int jj = 0; jj < 8; ++jj) St[(16 * ks + 8 * hh + jj) * DST + pos] = f2bf(bf2f((bf16_t)kf[rb][ks][jj]) * sc); }
            dpre_flush(St, op + 3 * 4096, lane);
#pragma unroll
            for (int rb = 0; rb < 2; ++rb) { const float sc = __shfl(egc, 32 * rb + r);
#pragma unroll
                for (int ks = 0; ks < 4; ++ks)
#pragma unroll
                    for (int jj = 0; jj < 8; ++jj) St[(32 * rb + r) * DST + sig_inv(16 * ks + 8 * hh + jj)] = f2bf(bf2f((bf16_t)qf[rb][ks][jj]) * sc); }
            dpre_flush(St, op + 1 * 4096, lane);
        }
        float xu[64];
        {
#pragma unroll
            for (int it = 0; it < 8; ++it) { const int row = (lane >> 3) + 8 * it, chunk = lane & 7; *(LAS u32x4*)(St + row * DST + chunk * 8) = *(const u32x4*)(vdb + row * 512 + chunk * 8); }
            asm volatile("s_waitcnt lgkmcnt(0)" ::: "memory");
            const int beta_i = __float_as_int(beta);
#pragma unroll
            for (int i = 0; i < 64; ++i) xu[i] = __int_as_float(__builtin_amdgcn_readlane(beta_i, i)) * bf2f(St[i * DST + lane]);
            asm volatile("s_waitcnt lgkmcnt(0)" ::: "memory");
        }
        {
            const float gcj0 = __shfl(gc, r), gcj1 = __shfl(gc, 32 + r);
            const int p0 = sig_inv(r), p1 = sig_inv(32 + r);
            { f32x16 t00, t10, t11;
#pragma unroll
              for (int e = 0; e < 16; ++e) { t00[e] = 0.f; t10[e] = 0.f; t11[e] = 0.f; }
#pragma unroll
              for (int ks = 0; ks < 4; ++ks) {
                  t00 = __builtin_amdgcn_mfma_f32_32x32x16_bf16(qf[0][ks], kf[0][ks], t00, 0, 0, 0);
                  t10 = __builtin_amdgcn_mfma_f32_32x32x16_bf16(qf[1][ks], kf[0][ks], t10, 0, 0, 0);
                  t11 = __builtin_amdgcn_mfma_f32_32x32x16_bf16(qf[1][ks], kf[1][ks], t11, 0, 0, 0); }
#pragma unroll
              for (int e = 0; e < 16; ++e) { const int il = (e & 3) + 8 * (e >> 2) + 4 * hh;
                  { const int i = il, j = r; St[i * DST + p0] = f2bf(j <= i ? t00[e] * __expf(fminf(gcs[i] - gcj0, 0.f)) : 0.f); St[i * DST + p1] = 0; }
                  { const int i = 32 + il; St[i * DST + p0] = f2bf(t10[e] * __expf(fminf(gcs[i] - gcj0, 0.f))); }
                  { const int i = 32 + il, j = 32 + r; St[i * DST + p1] = f2bf(j <= i ? t11[e] * __expf(fminf(gcs[i] - gcj1, 0.f)) : 0.f); } }
              dpre_flush(St, op + 2 * 4096, lane); }
            { f32x16 t00, t10, t11;
#pragma unroll
              for (int e = 0; e < 16; ++e) { t00[e] = 0.f; t10[e] = 0.f; t11[e] = 0.f; }
#pragma unroll
              for (int ks = 0; ks < 4; ++ks) {
                  t00 = __builtin_amdgcn_mfma_f32_32x32x16_bf16(kf[0][ks], kf[0][ks], t00, 0, 0, 0);
                  t10 = __builtin_amdgcn_mfma_f32_32x32x16_bf16(kf[1][ks], kf[0][ks], t10, 0, 0, 0);
                  t11 = __builtin_amdgcn_mfma_f32_32x32x16_bf16(kf[1][ks], kf[1][ks], t11, 0, 0, 0); }
#pragma unroll
              for (int e = 0; e < 16; ++e) { const int il = (e & 3) + 8 * (e >> 2) + 4 * hh;
                  { const int i = il, j = r; Am[i * 64 + j] = j < i ? bts[i] * t00[e] * __expf(fminf(gcs[i] - gcj0, 0.f)) : 0.f; }
                  { const int i = 32 + il, j = r; Am[i * 64 + j] = bts[i] * t10[e] * __expf(fminf(gcs[i] - gcj0, 0.f)); }
                  { const int i = 32 + il, j = 32 + r; Am[i * 64 + j] = j < i ? bts[i] * t11[e] * __expf(fminf(gcs[i] - gcj1, 0.f)) : 0.f; } } }
        }
        asm volatile("s_waitcnt lgkmcnt(0)" ::: "memory");
        {
            int c; { int t_ = threadIdx.x; asm volatile("" : "+v"(t_)); c = t_ & 63; } const int pc = sig_inv(c);
            const int beta_i = __float_as_int(beta), egc_i = __float_as_int(egc);
#pragma unroll
            for (int i = 1; i < 64; ++i) { float au = xu[i];
#pragma unroll
                for (int j4 = 0; j4 < i; j4 += 4) { const f32x4 a = *(const LAS f32x4*)(Am + i * 64 + j4);
#pragma unroll
                    for (int e = 0; e < 4; ++e) if (j4 + e < i) au -= a[e] * xu[j4 + e]; }
                xu[i] = au; }
#pragma unroll
            for (int i = 0; i < 64; ++i) (up + i * 64)[c] = xu[i];
            asm volatile("" ::: "memory");
            { float w[64];
#pragma unroll
              for (int i = 0; i < 64; ++i) w[i] = __int_as_float(__builtin_amdgcn_readlane(beta_i, i)) * __int_as_float(__builtin_amdgcn_readlane(egc_i, i)) * bf2f((kdb + i * 512)[c]);
#pragma unroll
              for (int i = 1; i < 64; ++i) { float aw = w[i];
#pragma unroll
                  for (int j4 = 0; j4 < i; j4 += 4) { const f32x4 a = *(const LAS f32x4*)(Am + i * 64 + j4);
#pragma unroll
                      for (int e = 0; e < 4; ++e) if (j4 + e < i) aw -= a[e] * w[j4 + e]; }
                  w[i] = aw; }
              asm volatile("s_waitcnt lgkmcnt(0)" ::: "memory");
#pragma unroll
              for (int i = 0; i < 64; ++i) St[i * DST + pc] = f2bf(-w[i]); }
            dpre_flush(St, op, lane);
        }
    }
}
__device__ __forceinline__ bf16x8_t pack_b(const f32x4& lo, const f32x4& hi) { union { u32x4 u; bf16x8_t v; } x;
    x.u.x = pg8::cvt_pk_bf16(lo[0], lo[1]); x.u.y = pg8::cvt_pk_bf16(lo[2], lo[3]); x.u.z = pg8::cvt_pk_bf16(hi[0], hi[1]); x.u.w = pg8::cvt_pk_bf16(hi[2], hi[3]); return x.v; }
__device__ __forceinline__ void wu_scan(KP p, int l, int bh, int slice, int lane) {
    const int n = lane & 15, q = lane >> 4, n0 = slice * 16, b = bh >> 3, h = bh & 7;
    f32x4 S[4];
#pragma unroll
    for (int t = 0; t < 4; ++t) S[t] = (f32x4){0.f, 0.f, 0.f, 0.f};
    const int foff = n * 64 + 8 * q;
    for (int ch = 0; ch < 32; ++ch) {
        const size_t unit = (size_t)bh * 32 + ch;
        const bf16_t* op = p->DOP + unit * 4 * 4096 + foff; const float* up = p->DU + unit * 4096 + n0 + n;
        const float eg = p->DG[unit];
        f32x4 vn[4]; bf16x8_t wf[4][2], gf[4][2], kf[4][2], tf[4][2];
#pragma unroll
        for (int mt = 0; mt < 4; ++mt) {
#pragma unroll
            for (int e = 0; e < 4; ++e) vn[mt][e] = up[(16 * mt + 4 * q + e) * 64];
#pragma unroll
            for (int ks = 0; ks < 2; ++ks) { const int o = mt * 1024 + ks * 32;
                wf[mt][ks] = *(const bf16x8_t*)(op + o); gf[mt][ks] = *(const bf16x8_t*)(op + 4096 + o);
                kf[mt][ks] = *(const bf16x8_t*)(op + 2 * 4096 + o); tf[mt][ks] = *(const bf16x8_t*)(op + 3 * 4096 + o); } }
        const bf16x8_t sb0 = pack_b(S[0], S[1]), sb1 = pack_b(S[2], S[3]);
        f32x4 o[4];
#pragma unroll
        for (int mt = 0; mt < 4; ++mt) {
            vn[mt] = __builtin_amdgcn_mfma_f32_16x16x32_bf16(wf[mt][0], sb0, vn[mt], 0, 0, 0);
            vn[mt] = __builtin_amdgcn_mfma_f32_16x16x32_bf16(wf[mt][1], sb1, vn[mt], 0, 0, 0);
            o[mt] = __builtin_amdgcn_mfma_f32_16x16x32_bf16(gf[mt][0], sb0, (f32x4){0.f, 0.f, 0.f, 0.f}, 0, 0, 0);
            o[mt] = __builtin_amdgcn_mfma_f32_16x16x32_bf16(gf[mt][1], sb1, o[mt], 0, 0, 0);
        }
        const bf16x8_t vb0 = pack_b(vn[0], vn[1]), vb1 = pack_b(vn[2], vn[3]);
#pragma unroll
        for (int mt = 0; mt < 4; ++mt) {
            o[mt] = __builtin_amdgcn_mfma_f32_16x16x32_bf16(kf[mt][0], vb0, o[mt], 0, 0, 0);
            if (mt >= 2) o[mt] = __builtin_amdgcn_mfma_f32_16x16x32_bf16(kf[mt][1], vb1, o[mt], 0, 0, 0);
            S[mt] = S[mt] * eg;
            S[mt] = __builtin_amdgcn_mfma_f32_16x16x32_bf16(tf[mt][0], vb0, S[mt], 0, 0, 0);
            S[mt] = __builtin_amdgcn_mfma_f32_16x16x32_bf16(tf[mt][1], vb1, S[mt], 0, 0, 0);
        }
        bf16_t* yo = p->yc + ((size_t)b * SEQ + ch * 64) * 1536 + h * 64 + n0 + n;
#pragma unroll
        for (int mt = 0; mt < 4; ++mt)
#pragma unroll
            for (int e = 0; e < 4; ++e) yo[(size_t)(16 * mt + 4 * q + e) * 1536] = f2bf(o[mt][e]);
    }
    float* so = p->out + O_PDELTA + (((size_t)l * 8 + b) * 8 + h) * 4096 + n0 + n;
#pragma unroll
    for (int t = 0; t < 4; ++t)
#pragma unroll
        for (int e = 0; e < 4; ++e) so[(16 * t + 4 * q + e) * 64] = S[t][e];
}
__device__ __forceinline__ void ph_delta_fin(KP p, int l) {
    int tid_o = threadIdx.x; asm volatile("" : "+v"(tid_o)); int lane = tid_o & 63, wave = tid_o >> 6;
    const int h = lane >> 3, d0 = (lane & 7) * 8;
    for (int t = blockIdx.x * 8 + wave; t < TP; t += gridDim.x * 8) {
        bf16_t* yp = p->yc + (size_t)t * 1536 + h * 64 + d0; const u32x4 raw = *(const u32x4*)yp; const u32x4 gz = *(const u32x4*)(p->H + (size_t)t * IN_WP + C_ZDN + h * 64 + d0);
        float v[8]; v[0] = __uint_as_float(raw.x << 16); v[1] = __uint_as_float(raw.x & 0xffff0000u); v[2] = __uint_as_float(raw.y << 16); v[3] = __uint_as_float(raw.y & 0xffff0000u);
        v[4] = __uint_as_float(raw.z << 16); v[5] = __uint_as_float(raw.z & 0xffff0000u); v[6] = __uint_as_float(raw.w << 16); v[7] = __uint_as_float(raw.w & 0xffff0000u);
        float z[8]; z[0] = __uint_as_float(gz.x << 16); z[1] = __uint_as_float(gz.x & 0xffff0000u); z[2] = __uint_as_float(gz.y << 16); z[3] = __uint_as_float(gz.y & 0xffff0000u);
        z[4] = __uint_as_float(gz.z << 16); z[5] = __uint_as_float(gz.z & 0xffff0000u); z[6] = __uint_as_float(gz.w << 16); z[7] = __uint_as_float(gz.w & 0xffff0000u);
        float ss = 0.f;
#pragma unroll
        for (int e = 0; e < 8; ++e) ss += v[e] * v[e];
        ss += __shfl_xor(ss, 1); ss += __shfl_xor(ss, 2); ss += __shfl_xor(ss, 4);
        const float rs = rsqrtf(ss * (1.0f / 64.0f) + EPS);
#pragma unroll
        for (int e = 0; e < 8; ++e) v[e] = v[e] * rs * p->dn_norm_g[l * 64 + d0 + e] * z[e];
        u32x4 w; w.x = pg8::cvt_pk_bf16(v[0], v[1]); w.y = pg8::cvt_pk_bf16(v[2], v[3]); w.z = pg8::cvt_pk_bf16(v[4], v[5]); w.w = pg8::cvt_pk_bf16(v[6], v[7]);
        *(u32x4*)yp = w;
    }
}

__device__ __forceinline__ void ph_att_waves(KP p, int l) {
    int tid_o = threadIdx.x; asm volatile("" : "+v"(tid_o)); int lane = tid_o & 63, wave = tid_o >> 6;
    wave = __builtin_amdgcn_readfirstlane(wave);
    const int G = gridDim.x, NW = G * 8, gw = wave * G + blockIdx.x;
    for (int d = gw; d < 256; d += NW) wu_scan(p, l, d >> 2, d & 3, lane);
    for (int d = NW - 1 - gw; d < 256; d += NW) wu_delta(p, l, 8 + (d >> 3), d & 7, lane);
}
__device__ __forceinline__ void ph_fin(KP p, int l, LAS unsigned char* lds) {
    int tid_o = threadIdx.x; asm volatile("" : "+v"(tid_o)); int lane = tid_o & 63, wave = tid_o >> 6;
    LAS float* ol = (LAS float*)(lds + wave * 1024);
    const float* w_uv = p->w_uv + (size_t)l * 256 * 512;
    const int cq = lane >> 4, d4 = lane & 15;
    for (int u = blockIdx.x * 8 + wave; u < TS * 8; u += gridDim.x * 8) {
        const int ts = u >> 3, h = u & 7, s = ts >> 3, r = (ts & 7) * 8 + h;
        const float* pb = p->part + ((size_t)s * SA_CH * 64 + r) * 258;
        float mc = -1e30f, lc = 0.f;
        if (lane < SA_CH) { mc = pb[(size_t)lane * 64 * 258 + 256]; lc = pb[(size_t)lane * 64 * 258 + 257]; }
        float M = mc;
#pragma unroll
        for (int o = 1; o < 8; o <<= 1) M = fmaxf(M, __shfl_xor(M, o));
        const float wc = lane < SA_CH ? __expf(mc - M) : 0.f; float L = lc * wc;
#pragma unroll
        for (int o = 1; o < 8; o <<= 1) L += __shfl_xor(L, o);
        const float iL = 1.0f / __int_as_float(__builtin_amdgcn_readlane(__float_as_int(L), 0));
        f32x4 acc = (f32x4){0.f, 0.f, 0.f, 0.f};
#pragma unroll
        for (int ch = 0; ch < SA_CH; ++ch) { const float w = __int_as_float(__builtin_amdgcn_readlane(__float_as_int(wc), ch)); const float* pp = pb + (size_t)ch * 64 * 258 + 4 * lane;
            const f32x2 a0 = *(const f32x2*)pp, a1 = *(const f32x2*)(pp + 2); acc[0] += w * a0[0]; acc[1] += w * a0[1]; acc[2] += w * a1[0]; acc[3] += w * a1[1]; }
        *(LAS f32x4*)(ol + 4 * lane) = acc * iL;
        asm volatile("s_waitcnt lgkmcnt(0)" ::: "memory");
        f32x4 o = (f32x4){0.f, 0.f, 0.f, 0.f}; const float* wp = w_uv + (size_t)(cq * 64) * 512 + h * 64 + 4 * d4;
#pragma unroll 16
        for (int c = 0; c < 64; ++c) { const f32x4 wv = *(const f32x4*)(wp + (size_t)c * 512); const float x = ol[cq * 64 + c]; o += wv * x; }
#pragma unroll
        for (int e = 0; e < 4; ++e) { o[e] += __shfl_xor(o[e], 16); o[e] += __shfl_xor(o[e], 32); }
        if (cq == 0) { const int t = TP + ts; const u32x2 gz = *(const u32x2*)(p->H + (size_t)t * IN_WP + C_ZMLA + h * 64 + 4 * d4);
            u32x2 w; w.x = pg8::cvt_pk_bf16(o[0] * __uint_as_float(gz.x << 16), o[1] * __uint_as_float(gz.x & 0xffff0000u)); w.y = pg8::cvt_pk_bf16(o[2] * __uint_as_float(gz.y << 16), o[3] * __uint_as_float(gz.y & 0xffff0000u));
            *(u32x2*)(p->yb + (size_t)t * 1536 + h * 64 + 4 * d4) = w; }
        asm volatile("s_waitcnt lgkmcnt(0)" ::: "memory");
    }
}

constexpr int SA_QS = 592, SA_KS = 576, SA_PS = 272;
constexpr int SA_OFF_Q = 0, SA_OFF_K = 64 * SA_QS, SA_OFF_P = SA_OFF_K + 128 * SA_KS, SA_OFF_M = SA_OFF_P + 64 * SA_PS, SA_OFF_L = SA_OFF_M + 1024, SA_LDS = SA_OFF_L + 1024;
typedef short s16x4 __attribute__((ext_vector_type(4)));
__device__ __forceinline__ void sa_unit(KP p, int l, int s, int ch, LAS unsigned char* lds, int tid) {
    const int lane = tid & 63, wave = __builtin_amdgcn_readfirstlane(tid >> 6), r = lane & 31, hh = lane >> 5;
    const int qb = wave & 1, kb = wave >> 1, cg = wave >> 1;
    LAS unsigned char* Qs = lds + SA_OFF_Q; LAS unsigned char* Kt = lds + SA_OFF_K; LAS unsigned char* Pt = lds + SA_OFF_P;
    LAS float* mloc = (LAS float*)(lds + SA_OFF_M); LAS float* lred = (LAS float*)(lds + SA_OFF_L);
    __syncthreads();
    { const float* w_uk = p->w_uk + (size_t)l * 256 * 512; const bf16_t* Qg = p->Q + (size_t)(TP + s * 8) * 768;
      const int c = tid & 255, h2 = tid >> 8;
      for (int h = h2 * 4; h < h2 * 4 + 4; ++h) { float acc[8];
#pragma unroll
          for (int i = 0; i < 8; ++i) acc[i] = 0.f;
          const float* wr_ = w_uk + (size_t)c * 512 + h * 64;
          for (int d = 0; d < 64; d += 4) { const f32x4 wv = *(const f32x4*)(wr_ + d);
#pragma unroll
              for (int i = 0; i < 8; ++i) { const bf16_t* q = Qg + i * 768 + h * 96 + d;
                  acc[i] += bf2f(q[0]) * wv[0] + bf2f(q[1]) * wv[1] + bf2f(q[2]) * wv[2] + bf2f(q[3]) * wv[3]; } }
#pragma unroll
          for (int i = 0; i < 8; ++i) *(LAS bf16_t*)(Qs + (i * 8 + h) * SA_QS + c * 2) = f2bf(acc[i]); }
      for (int e = tid; e < 64 * 32; e += NTHR) { const int rr = e >> 5, j = e & 31; *(LAS bf16_t*)(Qs + rr * SA_QS + (256 + j) * 2) = Qg[(rr >> 3) * 768 + (rr & 7) * 96 + 64 + j]; } }
    const int* pt = p->page_table + s * N_PAGES + ch * 16;
    const float* ckv_base = p->cache_kv + (size_t)l * N_POOL * PAGE * 256; const float* ckr_base = p->cache_kr + (size_t)l * N_POOL * PAGE * 32;
    f32x4 rk[16], rr2[2];
    { const int page = pt[0]; const float* kvp = ckv_base + (size_t)page * PAGE * 256; const float* krp = ckr_base + (size_t)page * PAGE * 32;
#pragma unroll
      for (int i = 0; i < 16; ++i) rk[i] = __builtin_nontemporal_load((const f32x4*)(kvp + (size_t)(tid + 512 * i) * 4));
#pragma unroll
      for (int i = 0; i < 2; ++i) rr2[i] = __builtin_nontemporal_load((const f32x4*)(krp + (size_t)(tid + 512 * i) * 4)); }
    f32x16 o0, o1;
#pragma unroll
    for (int e = 0; e < 16; ++e) { o0[e] = 0.f; o1[e] = 0.f; }
    float m = -1e30f, lw = 0.f;
    const int li = lane & 15, g1 = (lane >> 4) & 1;
    const int trOff = (8 * hh + (li >> 2)) * SA_KS + (16 * g1 + 4 * (li & 3)) * 2;
    const int ntile = ch == 7 ? 17 : 16;
    for (int t = 0; t < ntile; ++t) {
        __syncthreads();
        if (t < 16) {
#pragma unroll
            for (int i = 0; i < 16; ++i) { const int ci = tid + 512 * i, key = ci >> 6, c4 = ci & 63; u32x2 w; w.x = pg8::cvt_pk_bf16(rk[i][0], rk[i][1]); w.y = pg8::cvt_pk_bf16(rk[i][2], rk[i][3]);
                *(LAS u32x2*)(Kt + key * SA_KS + c4 * 8) = w; }
#pragma unroll
            for (int i = 0; i < 2; ++i) { const int ci = tid + 512 * i, key = ci >> 3, c4 = ci & 7; u32x2 w; w.x = pg8::cvt_pk_bf16(rr2[i][0], rr2[i][1]); w.y = pg8::cvt_pk_bf16(rr2[i][2], rr2[i][3]);
                *(LAS u32x2*)(Kt + key * SA_KS + 512 + c4 * 8) = w; }
        } else {
            for (int e = tid; e < 128 * 36; e += NTHR) { const int key = e / 36, c16 = e - key * 36; u32x4 v = (u32x4){0u, 0u, 0u, 0u};
                if (key < 8) v = c16 < 32 ? *(const u32x4*)(p->ckv + ((size_t)TP + s * 8 + key) * 256 + c16 * 8) : *(const u32x4*)(p->Kr + ((size_t)TP + s * 8 + key) * 32 + (c16 - 32) * 8);
                *(LAS u32x4*)(Kt + key * SA_KS + c16 * 16) = v; }
        }
        __syncthreads();
        if (t + 1 < 16) { const int page = pt[t + 1]; const float* kvp = ckv_base + (size_t)page * PAGE * 256; const float* krp = ckr_base + (size_t)page * PAGE * 32;
#pragma unroll
            for (int i = 0; i < 16; ++i) rk[i] = __builtin_nontemporal_load((const f32x4*)(kvp + (size_t)(tid + 512 * i) * 4));
#pragma unroll
            for (int i = 0; i < 2; ++i) rr2[i] = __builtin_nontemporal_load((const f32x4*)(krp + (size_t)(tid + 512 * i) * 4)); }
        f32x16 sa;
#pragma unroll
        for (int e = 0; e < 16; ++e) sa[e] = 0.f;
        { const LAS unsigned char* ka = Kt + (32 * kb + r) * SA_KS + 16 * hh; const LAS unsigned char* qa = Qs + (32 * qb + r) * SA_QS + 16 * hh;
#pragma unroll
          for (int ks = 0; ks < 18; ++ks) sa = __builtin_amdgcn_mfma_f32_32x32x16_bf16(*(const LAS bf16x8_t*)(ka + ks * 32), *(const LAS bf16x8_t*)(qa + ks * 32), sa, 0, 0, 0); }
        if (t == 16) { const int itok = (32 * qb + r) >> 3;
#pragma unroll
            for (int e = 0; e < 16; ++e) { const int key = 32 * kb + (e & 3) + 8 * (e >> 2) + 4 * hh; if (key > itok) sa[e] = -1e30f; } }
        float tm = sa[0];
#pragma unroll
        for (int e = 1; e < 16; ++e) tm = fmaxf(tm, sa[e]);
        tm = fmaxf(tm, __shfl_xor(tm, 32));
        if (hh == 0) mloc[kb * 64 + 32 * qb + r] = tm;
        __syncthreads();
        { const int q = 32 * qb + r; const float tmx = fmaxf(fmaxf(mloc[q], mloc[64 + q]), fmaxf(mloc[128 + q], mloc[192 + q]));
          const float mn = fmaxf(m, tmx), al = __builtin_amdgcn_exp2f((m - mn) * ATT_C), mc = mn * ATT_C; m = mn;
          float ps = 0.f;
#pragma unroll
          for (int e = 0; e < 16; ++e) { sa[e] = __builtin_amdgcn_exp2f(sa[e] * ATT_C - mc); ps += sa[e]; }
          lw = lw * al + ps;
#pragma unroll
          for (int g4 = 0; g4 < 4; ++g4) { u32x2 w; w.x = pg8::cvt_pk_bf16(sa[4 * g4], sa[4 * g4 + 1]); w.y = pg8::cvt_pk_bf16(sa[4 * g4 + 2], sa[4 * g4 + 3]);
              *(LAS u32x2*)(Pt + q * SA_PS + (32 * kb + 8 * g4 + 4 * hh) * 2) = w; }
#pragma unroll
          for (int e = 0; e < 16; ++e) { o0[e] *= al; o1[e] *= al; } }
        __syncthreads();
        { const LAS unsigned char* pa = Pt + (32 * qb + r) * SA_PS + 16 * hh; const LAS unsigned char* va = Kt + trOff + (64 * cg) * 2;
#pragma unroll
          for (int ks = 0; ks < 8; ++ks) { const bf16x8_t pb = *(const LAS bf16x8_t*)(pa + ks * 32);
              union { struct { s16x4 lo, hi; } h; bf16x8_t v; } a0, a1;
              a0.h.lo = __builtin_amdgcn_ds_read_tr16_b64_v4i16((LAS s16x4*)(va + ks * 16 * SA_KS)); a0.h.hi = __builtin_amdgcn_ds_read_tr16_b64_v4i16((LAS s16x4*)(va + ks * 16 * SA_KS + 4 * SA_KS));
              a1.h.lo = __builtin_amdgcn_ds_read_tr16_b64_v4i16((LAS s16x4*)(va + ks * 16 * SA_KS + 64)); a1.h.hi = __builtin_amdgcn_ds_read_tr16_b64_v4i16((LAS s16x4*)(va + ks * 16 * SA_KS + 4 * SA_KS + 64));
              o0 = __builtin_amdgcn_mfma_f32_32x32x16_bf16(a0.v, pb, o0, 0, 0, 0);
              o1 = __builtin_amdgcn_mfma_f32_32x32x16_bf16(a1.v, pb, o1, 0, 0, 0); } }
    }
    lw += __shfl_xor(lw, 32);
    if (hh == 0) lred[kb * 64 + 32 * qb + r] = lw;
    __syncthreads();
    { const int q = 32 * qb + r; float* pp = p->part + (((size_t)s * SA_CH + ch) * 64 + q) * 258;
#pragma unroll
      for (int cb2 = 0; cb2 < 2; ++cb2)
#pragma unroll
          for (int g4 = 0; g4 < 4; ++g4) { const int c = 32 * (2 * cg + cb2) + 8 * g4 + 4 * hh; f32x4 v;
#pragma unroll
              for (int e = 0; e < 4; ++e) v[e] = cb2 == 0 ? o0[4 * g4 + e] : o1[4 * g4 + e];
              *(f32x2*)(pp + c) = (f32x2){v[0], v[1]}; *(f32x2*)(pp + c + 2) = (f32x2){v[2], v[3]}; }
      if (cg == 0 && hh == 0) { pp[256] = m * MLA_SCALE; pp[257] = lred[q] + lred[64 + q] + lred[128 + q] + lred[192 + q]; } }
}
__device__ __forceinline__ void ph_attn_s2(KP p, int l, LAS unsigned char* lds) {
    int tid = threadIdx.x; asm volatile("" : "+v"(tid));
    for (int u = blockIdx.x; u < DEC_BATCH * 8; u += gridDim.x) sa_unit(p, l, u >> 3, u & 7, lds, tid);
    __syncthreads();
}

constexpr int ATT_KS = 208, ATT_VS = 144, ATT_KB = 64 * ATT_KS, ATT_VB = 64 * ATT_VS, ATT_STAGE = ATT_KB + ATT_VB;
__device__ __forceinline__ void attn_unit(KP p, int b, int h, int qblk, LAS unsigned char* lds, int tid, int wave, int lane) {
    const int r = lane & 31, hh = lane >> 5;
    const int q0 = qblk * 256 + wave * 32;
    const size_t trow0 = (size_t)b * SEQ;
    bf16x8_t qf[6];
    { const bf16_t* qp = p->Q + (trow0 + q0 + r) * 768 + h * 96 + 8 * hh;
#pragma unroll
      for (int ks = 0; ks < 6; ++ks) qf[ks] = *(const bf16x8_t*)(qp + 16 * ks); }
    f32x16 o0, o1;
#pragma unroll
    for (int e = 0; e < 16; ++e) { o0[e] = 0.f; o1[e] = 0.f; }
    float m = -1e30f, lsum = 0.f;
    const int ntile = qblk * 4 + 4;
    const int cA = tid, keyA = cA / 12, partA = cA - keyA * 12; const int cB = 512 + (tid & 255), keyB = cB / 12, partB = cB - keyB * 12; const bool hasB = tid < 256;
    const bf16_t* gA = partA < 8 ? p->Kn + (trow0 + keyA) * 512 + h * 64 + partA * 8 : p->Kr + (trow0 + keyA) * 32 + (partA - 8) * 8; const int stepA = partA < 8 ? 64 * 512 : 64 * 32;
    const bf16_t* gB = partB < 8 ? p->Kn + (trow0 + keyB) * 512 + h * 64 + partB * 8 : p->Kr + (trow0 + keyB) * 32 + (partB - 8) * 8; const int stepB = partB < 8 ? 64 * 512 : 64 * 32;
    const bf16_t* gV = p->Vt + (size_t)(h * 64 + (tid >> 3)) * TP + trow0 + (tid & 7) * 8;
    const int lA = keyA * ATT_KS + partA * 16, lB = keyB * ATT_KS + partB * 16, lV = ATT_KB + (tid >> 3) * ATT_VS + (tid & 7) * 16;
    const int pr_ = (r & 0x13) | ((r & 4) << 1) | ((r & 8) >> 1);
    const int kOff = pr_ * ATT_KS + 16 * hh, vOff = ATT_KB + r * ATT_VS + 16 * hh;
    u32x4 rA = *(const u32x4*)gA, rB = hasB ? *(const u32x4*)gB : (u32x4){0u, 0u, 0u, 0u}, rV = *(const u32x4*)gV;
    for (int kt = 0; kt < ntile; ++kt) {
        LAS unsigned char* st = lds + (kt & 1) * ATT_STAGE;
        *(LAS u32x4*)(st + lA) = rA; if (hasB) *(LAS u32x4*)(st + lB) = rB; *(LAS u32x4*)(st + lV) = rV;
        __syncthreads();
        if (kt + 1 < ntile) { gA += stepA; gB += stepB; gV += 64; rA = *(const u32x4*)gA; if (hasB) rB = *(const u32x4*)gB; rV = *(const u32x4*)gV; }
        if (kt * 64 <= q0 + 31) {
            f32x16 s0, s1;
#pragma unroll
            for (int e = 0; e < 16; ++e) { s0[e] = 0.f; s1[e] = 0.f; }
#pragma unroll
            for (int ks = 0; ks < 6; ++ks) {
                const bf16x8_t a0 = *(const LAS bf16x8_t*)(st + kOff + ks * 32), a1 = *(const LAS bf16x8_t*)(st + kOff + 32 * ATT_KS + ks * 32);
                s0 = __builtin_amdgcn_mfma_f32_32x32x16_bf16(a0, qf[ks], s0, 0, 0, 0);
                s1 = __builtin_amdgcn_mfma_f32_32x32x16_bf16(a1, qf[ks], s1, 0, 0, 0);
            }
            if (kt * 64 + 63 > q0) {
                const int qrel = q0 + r - kt * 64;
#pragma unroll
                for (int e = 0; e < 16; ++e) { const int kl = (e & 3) + 4 * ((e >> 2) & 1) + 8 * hh + 16 * ((e >> 3) & 1);
                    if (kl > qrel) s0[e] = -1e30f; if (kl + 32 > qrel) s1[e] = -1e30f; }
            }
            float tm = fmaxf(s0[0], s1[0]);
#pragma unroll
            for (int e = 1; e < 16; ++e) tm = fmaxf(tm, fmaxf(s0[e], s1[e]));
            tm = fmaxf(tm, __shfl_xor(tm, 32));
            const float mn = fmaxf(m, tm), al = __builtin_amdgcn_exp2f((m - mn) * ATT_C), mc = mn * ATT_C; m = mn;
            float ps = 0.f;
#pragma unroll
            for (int e = 0; e < 16; ++e) { s0[e] = __builtin_amdgcn_exp2f(s0[e] * ATT_C - mc); s1[e] = __builtin_amdgcn_exp2f(s1[e] * ATT_C - mc); ps += s0[e] + s1[e]; }
            lsum = lsum * al + ps;
#pragma unroll
            for (int e = 0; e < 16; ++e) { o0[e] *= al; o1[e] *= al; }
#pragma unroll
            for (int kb = 0; kb < 2; ++kb)
#pragma unroll
                for (int sp = 0; sp < 2; ++sp) {
                    union { u32x4 u; bf16x8_t v; } pb;
                    if (kb == 0) { pb.u.x = pg8::cvt_pk_bf16(s0[8 * sp + 0], s0[8 * sp + 1]); pb.u.y = pg8::cvt_pk_bf16(s0[8 * sp + 2], s0[8 * sp + 3]); pb.u.z = pg8::cvt_pk_bf16(s0[8 * sp + 4], s0[8 * sp + 5]); pb.u.w = pg8::cvt_pk_bf16(s0[8 * sp + 6], s0[8 * sp + 7]); }
                    else         { pb.u.x = pg8::cvt_pk_bf16(s1[8 * sp + 0], s1[8 * sp + 1]); pb.u.y = pg8::cvt_pk_bf16(s1[8 * sp + 2], s1[8 * sp + 3]); pb.u.z = pg8::cvt_pk_bf16(s1[8 * sp + 4], s1[8 * sp + 5]); pb.u.w = pg8::cvt_pk_bf16(s1[8 * sp + 6], s1[8 * sp + 7]); }
                    const int ko = (32 * kb + 16 * sp) * 2;
                    const bf16x8_t v0 = *(const LAS bf16x8_t*)(st + vOff + ko), v1 = *(const LAS bf16x8_t*)(st + vOff + 32 * ATT_VS + ko);
                    o0 = __builtin_amdgcn_mfma_f32_32x32x16_bf16(v0, pb.v, o0, 0, 0, 0);
                    o1 = __builtin_amdgcn_mfma_f32_32x32x16_bf16(v1, pb.v, o1, 0, 0, 0);
                }
        }
    }
    lsum += __shfl_xor(lsum, 32);
    const float il = 1.0f / lsum;
    const size_t t = trow0 + q0 + r;
#pragma unroll
    for (int db = 0; db < 2; ++db)
#pragma unroll
        for (int g = 0; g < 4; ++g) { const int d0 = 32 * db + 8 * g + 4 * hh;
            const u32x2 gz = *(const u32x2*)(p->H + t * IN_WP + C_ZMLA + h * 64 + d0);
            float v[4];
#pragma unroll
            for (int e = 0; e < 4; ++e) v[e] = (db == 0 ? o0[4 * g + e] : o1[4 * g + e]) * il;
            v[0] *= __uint_as_float(gz.x << 16); v[1] *= __uint_as_float(gz.x & 0xffff0000u); v[2] *= __uint_as_float(gz.y << 16); v[3] *= __uint_as_float(gz.y & 0xffff0000u);
            u32x2 w; w.x = pg8::cvt_pk_bf16(v[0], v[1]); w.y = pg8::cvt_pk_bf16(v[2], v[3]);
            *(u32x2*)(p->yb + t * 1536 + h * 64 + d0) = w; }
}
__device__ __forceinline__ void ph_attn_p(KP p, LAS unsigned char* lds) {
    int tid = threadIdx.x; asm volatile("" : "+v"(tid));
    const int lane = tid & 63, wave = __builtin_amdgcn_readfirstlane(tid >> 6);
    for (int pi = blockIdx.x; pi < 256; pi += gridDim.x) {
        const int xcd = pi & 7, k = pi >> 3, bh = xcd * 8 + (k >> 2), pr = k & 3;
        attn_unit(p, bh >> 3, bh & 7, 7 - pr, lds, tid, wave, lane);
        attn_unit(p, bh >> 3, bh & 7, pr, lds, tid, wave, lane);
    }
    __syncthreads();
}
struct MEpiVt { static constexpr bool PERM = true, AFTER_DRAIN = false; static constexpr int SEG = 0; bf16_t* O; int ldc; int pad_;
    __device__ __forceinline__ void operator()(const f32x4 (&acc)[2][2][4][2], const pg8::Unit& u, int wr, int wc, int fr0, int fq0) const {
        int fr = fr0, fq = fq0; asm volatile("" : "+v"(fr), "+v"(fq));
        const int row0 = u.pm * 256 + wr * 64 + fr;
#pragma unroll
        for (int bj = 0; bj < 2; ++bj) { const int col0 = u.pn * 256 + bj * 128 + wc * 32 + 8 * fq;
#pragma unroll
            for (int ai = 0; ai < 2; ++ai)
#pragma unroll
                for (int m = 0; m < 4; ++m) { const int row = row0 + ai * 128 + m * 16; const f32x4 v0 = acc[ai][bj][m][0], v1 = acc[ai][bj][m][1];
                    u32x4 w; w.x = pg8::cvt_pk_bf16(v0[0], v0[1]); w.y = pg8::cvt_pk_bf16(v0[2], v0[3]); w.z = pg8::cvt_pk_bf16(v1[0], v1[1]); w.w = pg8::cvt_pk_bf16(v1[2], v1[3]);
                    *(u32x4*)(O + (size_t)row * ldc + col0) = w; } }
    } };


__global__ void __launch_bounds__(NTHR, 2) k_mega(Params p_unused) {
    const KP kp0 = (KP)__builtin_amdgcn_kernarg_segment_ptr();
#define PP() ({ KP q_ = kp0; asm volatile("" : "+s"(q_)); q_; })
    KP p = PP();
    extern __shared__ __attribute__((aligned(16))) unsigned char lds_raw[];
    LAS unsigned char* lds = (LAS unsigned char*)lds_raw;
    volatile LAS unsigned* misc = (volatile LAS unsigned*)(lds + LDS_MISC);
    for (int u = threadIdx.x; u < 64; u += NTHR) misc[u] = 0u;
    __syncthreads();
    const int lo = p->ph_lo, hi = p->ph_hi;
    XcdBarrier bar; bar.bar = p->bar + p->li * XCD_BAR_WORDS; bar.x = 0; bar.st = nullptr;
    if (hi - lo > 1) bar = xcd_barrier_post(p->bar + p->li * XCD_BAR_WORDS, misc + 8);
#define IN(k) (lo <= (k) && (k) < hi)
#define SEAM(k) do { if (IN(k) && IN((k) + 1)) xcd_barrier(bar); } while (0)

    if (IN(PH_PRO)) {
        LAS float* tile = (LAS float*)lds;
        for (int l = 0; l < 2; ++l) {
            KP p = PP();
            ph_tr(p->w_in + (size_t)l * 1024 * IN_W, p->WinT + (size_t)l * IN_WP * 1024, 1024, IN_W, IN_WP, tile, 0);
            ph_tr(p->w_uq + (size_t)l * 384 * 768, p->WuqT + (size_t)l * 768 * 384, 384, 768, 768, tile, 0);
            ph_tr(p->w_uk + (size_t)l * 256 * 512, p->WkvT + (size_t)l * 1024 * 256, 256, 512, 512, tile, 144);
            ph_tr(p->w_uv + (size_t)l * 256 * 512, p->WkvT + (size_t)l * 1024 * 256 + (size_t)512 * 256, 256, 512, 512, tile, 208);
            ph_tr(p->w_br0 + (size_t)l * 512 * 1024, p->WbrT + (size_t)l * 1024 * 1536 + 0 * 512, 512, 1024, 1024, tile, 0, 1536);
            ph_tr(p->w_br1 + (size_t)l * 512 * 1024, p->WbrT + (size_t)l * 1024 * 1536 + 1 * 512, 512, 1024, 1024, tile, 0, 1536);
            ph_tr(p->w_br2 + (size_t)l * 512 * 1024, p->WbrT + (size_t)l * 1024 * 1536 + 2 * 512, 512, 1024, 1024, tile, 0, 1536);
            ph_tr(p->w_out + (size_t)l * 1024 * 1024, p->WoutT + (size_t)l * 1024 * 1024, 1024, 1024, 1024, tile, 0);
            for (int g = 0; g < 4; ++g) ph_tr(p->pool_mix + ((size_t)l * 4 + g) * 128 * 128, p->PmixT + ((size_t)l * 4 + g) * 128 * 128, 128, 128, 128, tile, 64 + 8 * g);
        }
        { KP p = PP(); ph_rope_tab(p->tab); ph_rmsnorm(p->x_prompt, p->x_sample, p->norm_g, p->xn, nullptr, nullptr); }
    }
    SEAM(PH_PRO);
    for (int l = 0; l < 2; ++l) {
        int G = gridDim.x, bid = blockIdx.x; asm volatile("" : "+s"(G), "+s"(bid));
        if (IN(PHID(l, PH_GIN))) { KP p = PP();
            pg8::Gemm g{p->xn, p->WinT + (size_t)l * IN_WP * 1024, TT, IN_WP, 1024, 0}; pg8::StaticOrder S; S.init(TT, IN_WP, G, bid);
            MEpiH E{p->H, p->BA}; pg8::gemm_phase<MEpiH, pg8::StaticOrder, false>(lds, g, S, E, nullptr);
        }
        SEAM(PHID(l, PH_GIN));
        if (IN(PHID(l, PH_TOK))) ph_tok(PP(), l, lds);
        SEAM(PHID(l, PH_TOK));
        if (IN(PHID(l, PH_GQ)) && (PP()->pad & 16)) { KP p = PP();
            pg8::Gemm g{p->cq, p->WuqT + (size_t)l * 768 * 384, TT, 768, 384, 0}; pg8::StaticOrder S; S.init(TT, 768, G, bid);
            MEpiQ E{p->Q, p->tab}; pg8::gemm_phase<MEpiQ, pg8::StaticOrder, false>(lds, g, S, E, nullptr);
        }
        if (IN(PHID(l, PH_GQ)) && (PP()->pad & 32)) { KP p = PP();
            pg8::Gemm g{p->ckv, p->WkvT + (size_t)l * 1024 * 256, TP, 512, 256, 0}; pg8::StaticOrder S; S.init(TP, 512, G / 2, bid < G / 2 ? bid : G);
            MEpiKV E{p->Kn, p->V}; pg8::gemm_phase<MEpiKV, pg8::StaticOrder, false>(lds, g, S, E, nullptr);
        }
        if (IN(PHID(l, PH_GQ)) && (PP()->pad & 32)) { KP p = PP();
            pg8::Gemm g{p->WkvT + (size_t)l * 1024 * 256 + (size_t)512 * 256, p->ckv, 512, TP, 256, 0}; pg8::StaticOrder S; S.init(512, TP, G / 2, bid >= G / 2 ? bid - G / 2 : G);
            MEpiVt E{p->Vt, TP, 0}; pg8::gemm_phase<MEpiVt, pg8::StaticOrder, false>(lds, g, S, E, nullptr);
        }
        if (IN(PHID(l, PH_GQ)) && (PP()->pad & 64)) ph_delta_pre(PP(), lds);
        SEAM(PHID(l, PH_GQ));
        if (IN(PHID(l, PH_ATT))) { const int am = PP()->pad;
            if (am & 1) ph_attn_s2(PP(), l, lds); if (am & 4) ph_attn_p(PP(), lds); if (am & 8) ph_att_waves(PP(), l); }
        SEAM(PHID(l, PH_ATT));
        if (IN(PHID(l, PH_FIN))) { const int fm = PP()->pad; if (fm & 128) ph_fin(PP(), l, lds); if (fm & 256) ph_delta_fin(PP(), l); }
        SEAM(PHID(l, PH_FIN));
        if (IN(PHID(l, PH_MERGE)) && (PP()->pad & 512)) { KP p = PP();
            pg8::Gemm g{p->ya, p->WbrT + (size_t)l * 1024 * 1536, TP, 1024, 512, 1536}; pg8::SegOrder<3> S; S.init(TP, 1024, G, bid);
            MEpiMergeS E{p->H, p->mb}; pg8::gemm_phase<MEpiMergeS, pg8::SegOrder<3>, false>(lds, g, S, E, nullptr);
        }
        if (IN(PHID(l, PH_MERGE)) && (PP()->pad & 1024)) { KP p = PP(); TEpiMerge E{p->H, p->mb}; tail_gemm<3, TEpiMerge>(p->ya + (size_t)TP * 1536, 1536, p->WbrT + (size_t)l * 1024 * 1536, 1536, 1024, E, lds); }
        SEAM(PHID(l, PH_MERGE));
        if (IN(PHID(l, PH_OUT)) && (PP()->pad & 2048)) { KP p = PP();
            const float* xp = l == 0 ? p->x_prompt : p->xres; const float* xs = l == 0 ? p->x_sample : p->xres + (size_t)TP * 1024;
            pg8::Gemm g{p->mb, p->WoutT + (size_t)l * 1024 * 1024, TP, 1024, 1024, 0}; pg8::StaticOrder S; S.init(TP, 1024, G, bid);
            MEpiRes E{xp, xs, p->xres}; pg8::gemm_phase<MEpiRes, pg8::StaticOrder, false>(lds, g, S, E, nullptr);
        }
        if (IN(PHID(l, PH_OUT)) && (PP()->pad & 4096)) { KP p = PP(); TEpiRes E{l == 0 ? p->x_sample : p->xres + (size_t)TP * 1024, p->xres}; tail_gemm<1, TEpiRes>(p->mb + (size_t)TP * 1024, 1024, p->WoutT + (size_t)l * 1024 * 1024, 1024, 1024, E, lds); }
        SEAM(PHID(l, PH_OUT));
        if (IN(PHID(l, PH_NORM))) { KP p = PP();
            if (l == 0) ph_rmsnorm(p->xres, p->xres + (size_t)TP * 1024, p->norm_g + 1024, p->xn, nullptr, nullptr);
            else ph_rmsnorm(p->xres, p->xres + (size_t)TP * 1024, p->final_norm_g, nullptr, p->out + O_YP, p->out + O_YS);
        }
        SEAM(PHID(l, PH_NORM));
    }
#undef IN
#undef SEAM
}

static inline size_t al256(size_t x) { return (x + 255) & ~(size_t)255; }
extern "C" void kernel_launch(void* const* d_in, const int* in_sizes, int n_in, void* d_out, int out_size, void* d_ws, size_t ws_size, hipStream_t stream) {
    static int grid = 0;
    if (grid == 0) {
        int dev = 0, cus = 0; (void)hipGetDevice(&dev); (void)hipDeviceGetAttribute(&cus, hipDeviceAttributeMultiprocessorCount, dev);
        (void)hipFuncSetAttribute((const void*)k_mega, hipFuncAttributeMaxDynamicSharedMemorySize, LDS_BYTES);
        int per_cu = 0; (void)hipOccupancyMaxActiveBlocksPerMultiprocessor(&per_cu, (const void*)k_mega, NTHR, LDS_BYTES); (void)hipGetLastError();
        grid = cus > 0 ? cus : 256;
    }
    Params p{};
    p.x_prompt = (const float*)d_in[0]; p.x_sample = (const float*)d_in[1]; p.cache_kv = (const float*)d_in[2]; p.cache_kr = (const float*)d_in[3];
    p.state_pool = (const float*)d_in[4]; p.state_conv = (const float*)d_in[5]; p.state_delta = (const float*)d_in[6]; p.page_table = (const int*)d_in[7];
    p.norm_g = (const float*)d_in[8]; p.w_in = (const float*)d_in[9]; p.pool_mix = (const float*)d_in[10]; p.pool_scale = (const float*)d_in[11];
    p.q_norm_g = (const float*)d_in[12]; p.w_uq = (const float*)d_in[13]; p.kv_norm_g = (const float*)d_in[14]; p.w_uk = (const float*)d_in[15];
    p.w_uv = (const float*)d_in[16]; p.conv_w = (const float*)d_in[17]; p.a_log = (const float*)d_in[18]; p.dt_bias = (const float*)d_in[19];
    p.dn_norm_g = (const float*)d_in[20]; p.w_br0 = (const float*)d_in[21]; p.w_br1 = (const float*)d_in[22]; p.w_br2 = (const float*)d_in[23];
    p.w_out = (const float*)d_in[24]; p.final_norm_g = (const float*)d_in[25];
    p.out = (float*)d_out;
    char* w = (char*)d_ws; size_t off = 0;
    auto take = [&](size_t bytes) { char* q = w + off; off += al256(bytes); return q; };
    const size_t BAR_BYTES = (size_t)16 * XCD_BAR_WORDS * 4;
    p.bar = (unsigned*)take(BAR_BYTES);
    p.WinT = (bf16_t*)take((size_t)2 * IN_WP * 1024 * 2);
    p.WuqT = (bf16_t*)take((size_t)2 * 768 * 384 * 2);
    p.WkvT = (bf16_t*)take((size_t)2 * 1024 * 256 * 2);
    p.WbrT = (bf16_t*)take((size_t)2 * 3 * 1024 * 512 * 2);
    p.WoutT = (bf16_t*)take((size_t)2 * 1024 * 1024 * 2);
    p.PmixT = (bf16_t*)take((size_t)2 * 4 * 128 * 128 * 2);
    p.tab = (float2*)take((size_t)(SEQ + DEC_SEQ) * 16 * 8);
    p.xres = (float*)take((size_t)TT * 1024 * 4);
    p.xn = (bf16_t*)take((size_t)TT * 1024 * 2);
    p.H = (bf16_t*)take((size_t)TT * IN_WP * 2);
    p.BA = (float*)take((size_t)TT * 16 * 4);
    p.cq = (bf16_t*)take((size_t)TT * 384 * 2);
    p.ckv = (bf16_t*)take((size_t)TT * 256 * 2);
    p.Kr = (bf16_t*)take((size_t)TT * 32 * 2);
    p.Q = (bf16_t*)take((size_t)TT * 768 * 2);
    bf16_t* Qlat = (bf16_t*)take((size_t)TS * 8 * 288 * 2);
    p.Kn = (bf16_t*)take((size_t)TP * 512 * 2);
    p.V = (bf16_t*)take((size_t)TP * 512 * 2);
    p.Vt = (bf16_t*)take((size_t)512 * TP * 2);
    p.qd = (bf16_t*)take((size_t)TT * 512 * 2);
    p.kd = (bf16_t*)take((size_t)TT * 512 * 2);
    p.vd = (bf16_t*)take((size_t)TT * 512 * 2);
    p.bg = (float*)take((size_t)TT * 16 * 4);
    p.ya = (bf16_t*)take((size_t)TT * 1536 * 2); p.yb = p.ya + 512; p.yc = p.ya + 1024;
    p.mf = (float*)take((size_t)TT * 1024 * 4);
    p.mb = (bf16_t*)take((size_t)TT * 1024 * 2);
    p.part = (float*)take((size_t)DEC_BATCH * SA_CH * 64 * 258 * 4);
    p.DOP = (bf16_t*)take((size_t)2048 * 4 * 4096 * 2);
    p.DU = (float*)take((size_t)2048 * 4096 * 4);
    p.DG = (float*)take((size_t)2048 * 4);

    (void)hipMemsetAsync(p.bar, 0, BAR_BYTES, stream);
    p.ph_lo = 0; p.ph_hi = PH_END; p.li = 0; p.pad = 0x1fff;
    hipLaunchKernelGGL(k_mega, dim3(grid), dim3(NTHR), LDS_BYTES, stream, p);
#if defined(PROBE_REP) && PROBE_REP > 0
    for (int i = 0; i < PROBE_REP; ++i) { Params q = p; q.ph_lo = PROBE_LO; q.ph_hi = PROBE_HI; q.li = 1 + i; q.pad = PROBE_MASK; hipLaunchKernelGGL(k_mega, dim3(grid), dim3(NTHR), LDS_BYTES, stream, q); }
#endif
}
```

```cpp
#include <hip/hip_runtime.h>
#include <stdint.h>

typedef unsigned short bf16_t;

#define D_MODEL 1024
#define TP 16384
#define TS 256
#define TT (TP + TS)
#define SEQ 2048
#define DEC_SEQ 8
#define DEC_BATCH 32
#define PAST_LEN 16384
#define PAGE 128
#define N_PAGES 128
#define N_POOL 5120
#define IN_W 7344
#define IN_WP 7424
#define C_POOL 0
#define C_ZPOOL 512
#define C_Q 1024
#define C_KV 1408
#define C_KR 1664
#define C_ZMLA 1696
#define C_QKV 2208
#define C_ZDN 3744
#define C_BETA 4256
#define C_ALPHA 4264
#define C_GATE 4272
#define EPS 1e-6f
#define MLA_SCALE 0.10206207261596577f
#define ATT_C 0.14724444831554004f

#define O_YP 0
#define O_YS (O_YP + 16777216)
#define O_PKV (O_YS + 262144)
#define O_PKR (O_PKV + 8388608)
#define O_PPOOL (O_PKR + 1048576)
#define O_PCONV (O_PPOOL + 122880)
#define O_PDELTA (O_PCONV + 73728)
#define O_SKV (O_PDELTA + 524288)
#define O_SKR (O_SKV + 131072)
#define O_SPOOL (O_SKR + 16384)
#define O_SCONV (O_SPOOL + 491520)
#define O_SDELTA (O_SCONV + 294912)
#define O_END (O_SDELTA + 2097152)

__device__ __forceinline__ float bf2f(bf16_t b) { return __uint_as_float(((unsigned)b) << 16); }
__device__ __forceinline__ bf16_t f2bf(float f) { unsigned u = __float_as_uint(f); u += 0x7FFFu + ((u >> 16) & 1u); return (bf16_t)(u >> 16); }
__device__ __forceinline__ float sigmoidf_(float v) { return __builtin_amdgcn_rcpf(1.0f + __builtin_amdgcn_exp2f(-1.4426950408889634f * v)); }
__device__ __forceinline__ float siluf_(float v) { return v * __builtin_amdgcn_rcpf(1.0f + __builtin_amdgcn_exp2f(-1.4426950408889634f * v)); }
__device__ __forceinline__ float wave_sum(float v) {
#pragma unroll
    for (int o = 32; o >= 1; o >>= 1) v += __shfl_xor(v, o);
    return v;
}

#define SA_CH 8
namespace pg8 {
#define PG8_LAS __attribute__((address_space(3)))
typedef unsigned short bf16_t;
typedef short bf16x8 __attribute__((ext_vector_type(8)));
typedef float f32x4 __attribute__((ext_vector_type(4)));
typedef unsigned u32x4 __attribute__((ext_vector_type(4)));
constexpr int BM = 256, BK = 64, HALF = 128, HTB = HALF * BK * 2  , STAGE_BYTES = 8 * HTB, NXCD = 8, WGM = 8;

__host__ __device__ __forceinline__ int lds_byte(int r, int c) { const int st = (r >> 4) * 2 + (c >> 5), rr = r & 15, cc = c & 31, ob = rr * 64 + cc * 2; return st * 1024 + (ob ^ (((ob >> 9) & 1) << 5)); }
__host__ __device__ __forceinline__ void stage_rc(int b, int& R, int& C) { const int st = b / 1024, sb = b % 1024, swz = sb ^ (((sb >> 9) & 1) << 5); R = (st >> 1) * 16 + swz / 64; C = (st & 1) * 32 + (swz % 64) / 2; }
__host__ __device__ __forceinline__ int perm32(int rho) { const int n = rho >> 4, i = rho & 15; return 8 * (i >> 2) + 4 * n + (i & 3); }

struct Unit { int pm, pn, sg; };
struct Gemm { const bf16_t* A; const bf16_t* Bt; int M, N, K; int ld; };

struct StaticOrder {
    int nM, nN, nwg, G, c;
    __host__ __device__ void init(int M, int N, int G_, int c_) { nM = M / BM; nN = N / BM; nwg = nM * nN; G = G_; c = c_; }
    __host__ __device__ bool next(int i, Unit& u) const {
        const long L = (long)i * G + c; if (L >= nwg) return false;
        int wgid = (int)L; { const int q = nwg / NXCD, r = nwg % NXCD, xcd = wgid % NXCD, off = wgid / NXCD; wgid = (xcd < r ? xcd * (q + 1) : r * (q + 1) + (xcd - r) * q) + off; }
        const int nig = WGM * nN, gid = wgid / nig, fm = gid * WGM, gsz = (nM - fm) < WGM ? (nM - fm) : WGM;
        u.pm = fm + ((wgid % nig) % gsz); u.pn = (wgid % nig) / gsz; u.sg = 0; return true;
    }
    __device__ __forceinline__ void a_ready(const Unit&) const {}
    __device__ __forceinline__ void done(const Unit&) const {}
};
template <int NSEG> struct SegOrder : StaticOrder {
    __host__ __device__ bool next(int i, Unit& u) const { const bool ok = StaticOrder::next(i / NSEG, u); u.sg = i % NSEG; return ok; }
};
typedef __bf16 bf16n2 __attribute__((ext_vector_type(2)));
__device__ __forceinline__ unsigned cvt_pk_bf16(float lo, float hi) { typedef float f2_ __attribute__((ext_vector_type(2))); const f2_ v = {lo, hi}; return __builtin_bit_cast(unsigned, __builtin_convertvector(v, bf16n2)); }
typedef float f32x2 __attribute__((ext_vector_type(2)));
template <class Epi, class Sched, bool STAMP = false>
__device__ __forceinline__ void gemm_phase(PG8_LAS unsigned char* lds, const Gemm g, const Sched& S, const Epi& E, unsigned long long* stamps) {
    int tid_ = threadIdx.x; asm volatile("" : "+v"(tid_));
    const int tid = tid_, wid = __builtin_amdgcn_readfirstlane(tid >> 6), lane = tid & 63, wr = wid >> 2, wc = wid & 3, fr = lane & 15, fq = lane >> 4;
    int K_ = g.K; asm volatile("" : "+s"(K_));
    int LD_ = g.ld ? g.ld : g.K; asm volatile("" : "+s"(LD_));
    const int K = K_, nt = K / BK, LD = LD_;
    int ts_lo = 0, ts_hi = 0, nts = 0; const unsigned long long rt_entry = STAMP ? (unsigned long long)wall_clock64() : 0ull;
#define PG8_STAMP() do { if (STAMP && wid == 0 && nts < 64) { const unsigned long long _c = (unsigned long long)clock64(); \
        ts_lo = (lane == nts) ? (int)(unsigned)_c : ts_lo; ts_hi = (lane == nts) ? (int)(unsigned)(_c >> 32) : ts_hi; ++nts; } } while (0)
    PG8_STAMP();
    unsigned voffA[2], voffB[2];
#pragma unroll
    for (int i = 0; i < 2; ++i) { int R, C; stage_rc(tid * 16 + i * 8192, R, C); const int Rb = Epi::PERM ? ((R & ~31) + perm32(R & 31)) : R;
        voffA[i] = (unsigned)(R * LD + C) * 2u; voffB[i] = (unsigned)(Rb * LD + C) * 2u; }
    const size_t kstep = (size_t)(BK * 2);
    const size_t hstep = (size_t)HALF * LD * 2;
    const size_t tstep = 2 * hstep;
    const unsigned ldsw = (unsigned)wid * 1024u;
    const int aoff = lds_byte(wr * 64 + fr, fq * 8), boff = lds_byte(wc * 32 + fr, fq * 8);
#define PG8_SA(b, h) (((b) * 2 + (h)) * HTB)
#define PG8_SB(b, h) ((4 + (b) * 2 + (h)) * HTB)
#define PG8_STAGE(bufoff, gbase, voff) do { _Pragma("unroll") for (int _i = 0; _i < 2; ++_i) \
        __builtin_amdgcn_global_load_lds((const unsigned*)((const char*)(gbase) + (voff)[_i]), (PG8_LAS unsigned*)(lds + (bufoff) + ldsw + _i * 8192), 16, 0, 0); } while (0)
#define PG8_LDA(dst, b, h) do { _Pragma("unroll") for (int m = 0; m < 4; ++m) _Pragma("unroll") for (int k = 0; k < 2; ++k) dst[m][k] = *(const PG8_LAS bf16x8*)(lds + PG8_SA(b, h) + aoff + m * 2048 + k * 1024); } while (0)
#define PG8_LDB(dst, b, h) do { _Pragma("unroll") for (int n = 0; n < 2; ++n) _Pragma("unroll") for (int k = 0; k < 2; ++k) dst[n][k] = *(const PG8_LAS bf16x8*)(lds + PG8_SB(b, h) + boff + n * 2048 + k * 1024); } while (0)
#define PG8_MMA(ai, bj, At, Bt) do { __builtin_amdgcn_s_setprio(1); _Pragma("unroll") for (int m = 0; m < 4; ++m) _Pragma("unroll") for (int n = 0; n < 2; ++n) _Pragma("unroll") for (int k = 0; k < 2; ++k) \
        acc[ai][bj][m][n] = __builtin_amdgcn_mfma_f32_16x16x32_bf16(Bt[n][k], At[m][k], acc[ai][bj][m][n], 0, 0, 0); __builtin_amdgcn_s_setprio(0); } while (0)
#define PG8_WAIT_V(n) asm volatile("s_waitcnt vmcnt(" #n ")" ::: "memory")
#define PG8_WAIT_L(n) asm volatile("s_waitcnt lgkmcnt(" #n ")" ::: "memory")
#define PG8_BAR __builtin_amdgcn_s_barrier()
#define PG8_SCHED __builtin_amdgcn_sched_barrier(0)
    Unit cur, nxt; int ui = 0;
    if (!S.next(0, cur)) return;
    f32x4 acc[2][2][4][2];
#pragma unroll
    for (int a = 0; a < 2; ++a)
#pragma unroll
        for (int b = 0; b < 2; ++b)
#pragma unroll
            for (int m = 0; m < 4; ++m)
#pragma unroll
                for (int n = 0; n < 2; ++n) acc[a][b][m][n] = (f32x4){0.f, 0.f, 0.f, 0.f};
    bf16x8 At[4][2], B0[2][2], B1[2][2];
    const size_t sstep = (size_t)K * 2;
    const char* cA = (const char*)g.A + (size_t)cur.pm * tstep + cur.sg * sstep; const char* cB = (const char*)g.Bt + (size_t)cur.pn * tstep + cur.sg * sstep;
    S.a_ready(cur);
    PG8_STAGE(PG8_SB(0, 0), cB, voffB); PG8_STAGE(PG8_SA(0, 0), cA, voffA); PG8_STAGE(PG8_SB(0, 1), cB + hstep, voffB); PG8_STAGE(PG8_SA(0, 1), cA + hstep, voffA);
    if (wr == 1) PG8_BAR;
    PG8_WAIT_V(4); PG8_BAR;
    PG8_STAGE(PG8_SB(1, 0), cB + kstep, voffB); PG8_STAGE(PG8_SA(1, 0), cA + kstep, voffA); PG8_STAGE(PG8_SB(1, 1), cB + hstep + kstep, voffB);
    PG8_WAIT_V(6); PG8_BAR;
    PG8_STAMP();
    for (;;) {
        const bool has_next = S.next(ui + 1, nxt);
        const char* nA = has_next ? (const char*)g.A + (size_t)nxt.pm * tstep + nxt.sg * sstep : cA; const char* nB = has_next ? (const char*)g.Bt + (size_t)nxt.pn * tstep + nxt.sg * sstep : cB;
_Pragma("nounroll")
        for (int t = 0; t < nt; t += 2) {
            const bool last = (t == nt - 2);
            const char* a1 = cA + (size_t)(t + 1) * kstep;
            const char* a2 = last ? nA : cA + (size_t)(t + 2) * kstep; const char* b2 = last ? nB : cB + (size_t)(t + 2) * kstep;
            const char* a3 = a2 + kstep; const char* b3 = b2 + kstep;
            if (last && has_next) S.a_ready(nxt);
            PG8_LDB(B0, 0, 0); PG8_SCHED; PG8_LDA(At, 0, 0); PG8_STAGE(PG8_SA(1, 1), a1 + hstep, voffA);
            PG8_WAIT_L(8); PG8_BAR; PG8_WAIT_L(0); PG8_MMA(0, 0, At, B0); PG8_BAR; PG8_SCHED;
            PG8_LDB(B1, 0, 1); PG8_STAGE(PG8_SB(0, 0), b2, voffB);
            PG8_BAR; PG8_WAIT_L(0); PG8_MMA(0, 1, At, B1); PG8_BAR;
            PG8_LDA(At, 0, 1); PG8_STAGE(PG8_SA(0, 0), a2, voffA);
            PG8_BAR; PG8_WAIT_L(0); PG8_MMA(1, 0, At, B0); PG8_BAR; PG8_SCHED;
            PG8_STAGE(PG8_SB(0, 1), b2 + hstep, voffB);
            PG8_WAIT_V(6); PG8_BAR; PG8_MMA(1, 1, At, B1); PG8_BAR;
            PG8_LDB(B0, 1, 0); PG8_SCHED; PG8_LDA(At, 1, 0); PG8_STAGE(PG8_SA(0, 1), a2 + hstep, voffA);
            PG8_WAIT_L(8); PG8_BAR; PG8_WAIT_L(0); PG8_MMA(0, 0, At, B0); PG8_BAR; PG8_SCHED;
            PG8_LDB(B1, 1, 1); PG8_STAGE(PG8_SB(1, 0), b3, voffB);
            PG8_BAR; PG8_WAIT_L(0); PG8_MMA(0, 1, At, B1); PG8_BAR;
            PG8_LDA(At, 1, 1); PG8_STAGE(PG8_SA(1, 0), a3, voffA);
            PG8_BAR; PG8_WAIT_L(0); PG8_MMA(1, 0, At, B0); PG8_BAR; PG8_SCHED;
            PG8_STAGE(PG8_SB(1, 1), b3 + hstep, voffB);
            PG8_WAIT_V(6); PG8_BAR; PG8_MMA(1, 1, At, B1); PG8_BAR;
        }
        PG8_STAMP();
        bool fin_ = true; if constexpr (Epi::SEG > 0) fin_ = (cur.sg == Epi::SEG - 1);
        if constexpr (!Epi::AFTER_DRAIN) { if (fin_) { E(acc, cur, wr, wc, fr, fq); S.done(cur); } }
        if constexpr (Epi::SEG > 0) E.mid(acc, cur, wr, wc, fr, fq, fin_ ? 1 : cur.sg + 1, fin_ ? 0.f : 1.f);
        PG8_STAMP();
        if (!has_next) break;
        if constexpr (Epi::SEG == 0)
#pragma unroll
        for (int a = 0; a < 2; ++a)
#pragma unroll
            for (int b = 0; b < 2; ++b)
#pragma unroll
                for (int m = 0; m < 4; ++m)
#pragma unroll
                    for (int n = 0; n < 2; ++n) acc[a][b][m][n] = (f32x4){0.f, 0.f, 0.f, 0.f};
        cur = nxt; cA = nA; cB = nB; ++ui;
    }
    PG8_WAIT_V(0);
    if (wr == 0) PG8_BAR;
    PG8_BAR;
    if constexpr (Epi::AFTER_DRAIN) { E.fused(acc, cur, wr, wc, fr, fq, lds, wid, lane); S.done(cur); }
    PG8_STAMP();
    if (STAMP && wid == 0) { stamps[lane] = lane < nts ? (((unsigned long long)(unsigned)ts_hi << 32) | (unsigned)ts_lo) : 0ull;
        if (lane == 62) stamps[62] = rt_entry; if (lane == 63) stamps[63] = (unsigned long long)wall_clock64(); }
#undef PG8_STAMP
#undef PG8_SA
#undef PG8_SB
#undef PG8_STAGE
#undef PG8_LDA
#undef PG8_LDB
#undef PG8_MMA
#undef PG8_WAIT_V
#undef PG8_WAIT_L
#undef PG8_BAR
#undef PG8_SCHED
}

}
#define XB_TMO      128
#define XB_XCNT(j)  (256  + 64 * (j))
#define XB_XSUB(j)  (1280 + 64 * (j))
#define XB_XGEN(j)  (2304 + 64 * (j))
#define XB_TOP      3328
#define XB_TOPGEN   3392
#define XCD_BAR_WORDS 3456
#define XB_SPIN_CAP (1u << 18)
#define LAS __attribute__((address_space(3)))

__device__ __forceinline__ unsigned xb_ld(unsigned* p)              { return __hip_atomic_load(p, __ATOMIC_RELAXED, __HIP_MEMORY_SCOPE_AGENT); }
__device__ __forceinline__ unsigned xb_add(unsigned* p, unsigned v) { return __hip_atomic_fetch_add(p, v, __ATOMIC_RELAXED, __HIP_MEMORY_SCOPE_AGENT); }
__device__ __forceinline__ unsigned xb_xcc_id() { return (unsigned)__builtin_amdgcn_s_getreg((3 << 11) | 20) & 0xFu; }
#define XB_SPIN(cond, bar) do { unsigned _sp = 0; while (cond) { __builtin_amdgcn_s_sleep(1); \
    if ((++_sp & 255u) == 0u) { if (xb_ld(&(bar)[XB_TMO])) break; if (_sp > XB_SPIN_CAP) { atomicAdd(&(bar)[XB_TMO], 1u); break; } } } } while (0)

struct XcdBarrier {
    unsigned* bar; unsigned x;
    volatile LAS unsigned* st;
};

__device__ __forceinline__ XcdBarrier xcd_barrier_post(unsigned* bar, volatile LAS unsigned* st) {
    XcdBarrier b; b.bar = bar; b.x = xb_xcc_id(); b.st = st;
    if (threadIdx.x == 0) (void)xb_add(&bar[XB_XCNT(b.x)], 1u);
    return b;
}
__device__ __forceinline__ void xcd_barrier_complete(unsigned* bar, unsigned x, unsigned& nloc, unsigned& nx) {
    const unsigned G = gridDim.x * gridDim.y * gridDim.z;
    unsigned sum, cnt, mine, sp = 0u;
    for (;;) {
        sum = 0u; cnt = 0u; mine = 0u;
#pragma unroll
        for (unsigned j = 0; j < 16; ++j) { const unsigned c = xb_ld(&bar[XB_XCNT(j)]); sum += c; cnt += (c > 0u) ? 1u : 0u; mine = (j == x) ? c : mine; }
        if (sum == G) break;
        __builtin_amdgcn_s_sleep(1);
        if ((++sp & 255u) == 0u) { if (xb_ld(&bar[XB_TMO])) break; if (sp > XB_SPIN_CAP) { atomicAdd(&bar[XB_TMO], 1u); break; } }
    }
    nloc = mine > 0u ? mine : 1u; nx = cnt > 0u ? cnt : 1u;
}

__device__ __forceinline__ void xcd_barrier(const XcdBarrier& b) {
    asm volatile("s_waitcnt vmcnt(0)" ::: "memory");
    __syncthreads();
    if (threadIdx.x == 0) {
        unsigned* bar = b.bar;
        __builtin_amdgcn_s_waitcnt(0);
        unsigned nloc = b.st[0], nx = b.st[1];
        if (nloc == 0u) { xcd_barrier_complete(bar, b.x, nloc, nx); b.st[0] = nloc; b.st[1] = nx; }
        const unsigned old = xb_add(&bar[XB_XSUB(b.x)], 1u);
        const unsigned gen = old / nloc;
        if (old + 1u == (gen + 1u) * nloc) {
            __builtin_amdgcn_fence(__ATOMIC_RELEASE, "agent");
            asm volatile("s_waitcnt vmcnt(0)" ::: "memory");
            const unsigned og = xb_add(&bar[XB_TOP], 1u);
            const unsigned tg = og / nx;
            if (og + 1u == (tg + 1u) * nx) xb_add(&bar[XB_TOPGEN], 1u);
            else XB_SPIN(xb_ld(&bar[XB_TOPGEN]) == tg, bar);
            __builtin_amdgcn_fence(__ATOMIC_ACQUIRE, "agent");
            xb_add(&bar[XB_XGEN(b.x)], 1u);
            asm volatile("s_waitcnt vmcnt(0)" ::: "memory");
        } else {
            XB_SPIN(xb_ld(&bar[XB_XGEN(b.x)]) == gen, bar);
            __builtin_amdgcn_fence(__ATOMIC_ACQUIRE, "agent");
            asm volatile("s_waitcnt vmcnt(0)" ::: "memory");
        }
    }
    __syncthreads();
}


#define LAS __attribute__((address_space(3)))
typedef float f32x4 __attribute__((ext_vector_type(4)));
typedef unsigned u32x4 __attribute__((ext_vector_type(4)));
typedef unsigned u32x2 __attribute__((ext_vector_type(2)));
typedef float f32x2 __attribute__((ext_vector_type(2)));
typedef short bf16x8_t __attribute__((ext_vector_type(8)));
typedef float f32x16 __attribute__((ext_vector_type(16)));
constexpr int NTHR = 512;
constexpr int LDS_BYTES = 147456;
constexpr int LDS_MISC = LDS_BYTES - 256;

struct Params {
    const float *x_prompt, *x_sample, *cache_kv, *cache_kr, *state_pool, *state_conv, *state_delta; const int* page_table;
    const float *norm_g, *w_in, *pool_mix, *pool_scale, *q_norm_g, *w_uq, *kv_norm_g, *w_uk, *w_uv, *conv_w, *a_log, *dt_bias, *dn_norm_g, *w_br0, *w_br1, *w_br2, *w_out, *final_norm_g;
    float* out;
    bf16_t *WinT, *WuqT, *WkvT, *WbrT, *WoutT, *PmixT; float2* tab;
    float* xres; bf16_t* xn; bf16_t* H; float* BA; bf16_t *cq, *ckv, *Kr, *Q, *Kn, *V, *Vt, *qd, *kd, *vd; float* bg; bf16_t *ya, *yb, *yc; float* mf; bf16_t* mb; float* part; bf16_t* DOP; float* DU; float* DG;
    unsigned* bar;
    int ph_lo, ph_hi, li, pad;
};

typedef const __attribute__((address_space(4))) Params* KP;

constexpr int PH_PRO = 0;
constexpr int PH_L = 8;
constexpr int PH_GIN = 0, PH_TOK = 1, PH_GQ = 2, PH_ATT = 3, PH_FIN = 4, PH_MERGE = 5, PH_OUT = 6, PH_NORM = 7;
#define PHID(l, k) (1 + (l) * PH_L + (k))
constexpr int PH_END = 1 + 2 * PH_L;

__device__ __forceinline__ void unpack8(const u32x4 v, float (&f)[8]) {
    f[0] = __uint_as_float(v.x << 16); f[1] = __uint_as_float(v.x & 0xffff0000u); f[2] = __uint_as_float(v.y << 16); f[3] = __uint_as_float(v.y & 0xffff0000u);
    f[4] = __uint_as_float(v.z << 16); f[5] = __uint_as_float(v.z & 0xffff0000u); f[6] = __uint_as_float(v.w << 16); f[7] = __uint_as_float(v.w & 0xffff0000u); }
__device__ __forceinline__ u32x4 pack8(const float (&f)[8]) { u32x4 w; w.x = pg8::cvt_pk_bf16(f[0], f[1]); w.y = pg8::cvt_pk_bf16(f[2], f[3]); w.z = pg8::cvt_pk_bf16(f[4], f[5]); w.w = pg8::cvt_pk_bf16(f[6], f[7]); return w; }
struct MEpiH { static constexpr bool PERM = true, AFTER_DRAIN = false; static constexpr int SEG = 0; bf16_t* H; float* BA;
    __device__ __forceinline__ void operator()(const f32x4 (&acc)[2][2][4][2], const pg8::Unit& u, int wr, int wc, int fr0, int fq0) const {
        int fr = fr0, fq = fq0; asm volatile("" : "+v"(fr), "+v"(fq));
        const int row0 = u.pm * 256 + wr * 64 + fr;
#pragma unroll
        for (int bj = 0; bj < 2; ++bj) {
            const int wcol = u.pn * 256 + bj * 128 + wc * 32, col0 = wcol + 8 * fq;
            const bool plain = (wcol + 32 <= C_ZPOOL) || (wcol >= C_Q && wcol + 32 <= C_ZMLA) || (wcol >= C_QKV && wcol + 32 <= C_ZDN);
            const int act = ((col0 >= C_ZPOOL && col0 < C_Q) || (col0 >= C_ZMLA && col0 < C_QKV) || (col0 >= C_ZDN && col0 < C_BETA)) ? 1 : (col0 >= C_GATE ? 2 : 0);
            const bool isba = (col0 == C_BETA) || (col0 == C_ALPHA);
#pragma unroll
            for (int ai = 0; ai < 2; ++ai)
#pragma unroll
                for (int m = 0; m < 4; ++m) { const int row = row0 + ai * 128 + m * 16; f32x4 v0 = acc[ai][bj][m][0], v1 = acc[ai][bj][m][1];
                    if (!plain) {
                        if (isba) { float* b = BA + (size_t)row * 16 + (col0 - C_BETA); *(f32x4*)b = v0; *(f32x4*)(b + 4) = v1; }
#pragma unroll
                        for (int e = 0; e < 4; ++e) { const float s0 = sigmoidf_(v0[e]), s1 = sigmoidf_(v1[e]);
                            v0[e] = act == 0 ? v0[e] : (act == 1 ? v0[e] * s0 : s0); v1[e] = act == 0 ? v1[e] : (act == 1 ? v1[e] * s1 : s1); }
                    }
                    u32x4 w; w.x = pg8::cvt_pk_bf16(v0[0], v0[1]); w.y = pg8::cvt_pk_bf16(v0[2], v0[3]); w.z = pg8::cvt_pk_bf16(v1[0], v1[1]); w.w = pg8::cvt_pk_bf16(v1[2], v1[3]);
                    *(u32x4*)(H + (size_t)row * IN_WP + col0) = w; }
        }
    } };
struct MEpiQ { static constexpr bool PERM = true, AFTER_DRAIN = false; static constexpr int SEG = 0; bf16_t* Q; const float2* tab;
    __device__ __forceinline__ void operator()(const f32x4 (&acc)[2][2][4][2], const pg8::Unit& u, int wr, int wc, int fr0, int fq0) const {
        int fr = fr0, fq = fq0; asm volatile("" : "+v"(fr), "+v"(fq));
        const int row0 = u.pm * 256 + wr * 64 + fr;
#pragma unroll
        for (int bj = 0; bj < 2; ++bj) {
            const int wcol = u.pn * 256 + bj * 128 + wc * 32, col0 = wcol + 8 * fq;
            const bool rope = (wcol % 96) == 64;
#pragma unroll
            for (int ai = 0; ai < 2; ++ai)
#pragma unroll
                for (int m = 0; m < 4; ++m) { const int row = row0 + ai * 128 + m * 16; f32x4 v0 = acc[ai][bj][m][0], v1 = acc[ai][bj][m][1];
                    if (rope) { const int p = row < TP ? (row & (SEQ - 1)) : SEQ + ((row - TP) & 7); const float2* tp = tab + p * 16 + (fq & 1) * 8; const bool hi = fq >= 2;
#pragma unroll
                        for (int e = 0; e < 4; ++e) { const float o0 = __shfl_xor(v0[e], 32), o1 = __shfl_xor(v1[e], 32); const float2 c0 = tp[e], c1 = tp[4 + e];
                            v0[e] = hi ? (v0[e] * c0.x + o0 * c0.y) : (v0[e] * c0.x - o0 * c0.y); v1[e] = hi ? (v1[e] * c1.x + o1 * c1.y) : (v1[e] * c1.x - o1 * c1.y); } }
                    u32x4 w; w.x = pg8::cvt_pk_bf16(v0[0], v0[1]); w.y = pg8::cvt_pk_bf16(v0[2], v0[3]); w.z = pg8::cvt_pk_bf16(v1[0], v1[1]); w.w = pg8::cvt_pk_bf16(v1[2], v1[3]);
                    *(u32x4*)(Q + (size_t)row * 768 + col0) = w; if (m == 3) asm volatile("" ::: "memory"); }
        }
    } };
struct MEpiKV { static constexpr bool PERM = true, AFTER_DRAIN = false; static constexpr int SEG = 0; bf16_t* Kn; bf16_t* V;
    __device__ __forceinline__ void operator()(const f32x4 (&acc)[2][2][4][2], const pg8::Unit& u, int wr, int wc, int fr0, int fq0) const {
        int fr = fr0, fq = fq0; asm volatile("" : "+v"(fr), "+v"(fq));
        const int row0 = u.pm * 256 + wr * 64 + fr; bf16_t* base = u.pn < 2 ? Kn : V; const int cb = (u.pn & 1) * 256;
#pragma unroll
        for (int bj = 0; bj < 2; ++bj) { const int col0 = cb + bj * 128 + wc * 32 + 8 * fq;
#pragma unroll
            for (int ai = 0; ai < 2; ++ai)
#pragma unroll
                for (int m = 0; m < 4; ++m) { const int row = row0 + ai * 128 + m * 16; const f32x4 v0 = acc[ai][bj][m][0], v1 = acc[ai][bj][m][1];
                    u32x4 w; w.x = pg8::cvt_pk_bf16(v0[0], v0[1]); w.y = pg8::cvt_pk_bf16(v0[2], v0[3]); w.z = pg8::cvt_pk_bf16(v1[0], v1[1]); w.w = pg8::cvt_pk_bf16(v1[2], v1[3]);
                    *(u32x4*)(base + (size_t)row * 512 + col0) = w; } }
    } };
template <int BR> struct MEpiMerge { static constexpr bool PERM = true, AFTER_DRAIN = false; static constexpr int SEG = 0; const bf16_t* H; float* mf; bf16_t* mb;
    __device__ __forceinline__ void operator()(const f32x4 (&acc)[2][2][4][2], const pg8::Unit& u, int wr, int wc, int fr0, int fq0) const {
        int fr = fr0, fq = fq0; asm volatile("" : "+v"(fr), "+v"(fq));
        const int row0 = u.pm * 256 + wr * 64 + fr;
#pragma unroll
        for (int bj = 0; bj < 2; ++bj) { const int col0 = u.pn * 256 + bj * 128 + wc * 32 + 8 * fq;
#pragma unroll
            for (int ai = 0; ai < 2; ++ai)
#pragma unroll
                for (int m = 0; m < 4; ++m) { const int row = row0 + ai * 128 + m * 16; f32x4 v0 = acc[ai][bj][m][0], v1 = acc[ai][bj][m][1];
                    const u32x4 g = *(const u32x4*)(H + (size_t)row * IN_WP + C_GATE + BR * 1024 + col0);
                    v0[0] *= __uint_as_float(g.x << 16); v0[1] *= __uint_as_float(g.x & 0xffff0000u); v0[2] *= __uint_as_float(g.y << 16); v0[3] *= __uint_as_float(g.y & 0xffff0000u);
                    v1[0] *= __uint_as_float(g.z << 16); v1[1] *= __uint_as_float(g.z & 0xffff0000u); v1[2] *= __uint_as_float(g.w << 16); v1[3] *= __uint_as_float(g.w & 0xffff0000u);
                    float* mp = mf + (size_t)row * 1024 + col0;
                    if (BR > 0) { v0 += *(const f32x4*)mp; v1 += *(const f32x4*)(mp + 4); }
                    if (BR < 2) { *(f32x4*)mp = v0; *(f32x4*)(mp + 4) = v1; }
                    else { u32x4 w; w.x = pg8::cvt_pk_bf16(v0[0], v0[1]); w.y = pg8::cvt_pk_bf16(v0[2], v0[3]); w.z = pg8::cvt_pk_bf16(v1[0], v1[1]); w.w = pg8::cvt_pk_bf16(v1[2], v1[3]);
                        *(u32x4*)(mb + (size_t)row * 1024 + col0) = w; } asm volatile("" ::: "memory"); } }
    } };
struct MEpiRes { static constexpr bool PERM = false, AFTER_DRAIN = false; static constexpr int SEG = 0; const float* xp; const float* xs; float* xo;
    __device__ __forceinline__ void operator()(const f32x4 (&acc)[2][2][4][2], const pg8::Unit& u, int wr, int wc, int fr0, int fq0) const {
        int fr = fr0, fq = fq0; asm volatile("" : "+v"(fr), "+v"(fq));
        const int row0 = u.pm * 256 + wr * 64 + fr, col0 = u.pn * 256 + wc * 32 + 4 * fq;
#pragma unroll
        for (int ai = 0; ai < 2; ++ai)
#pragma unroll
            for (int m = 0; m < 4; ++m) { const int row = row0 + ai * 128 + m * 16; const float* xr = row < TP ? xp + (size_t)row * 1024 : xs + (size_t)(row - TP) * 1024; float* orow = xo + (size_t)row * 1024;
#pragma unroll
                for (int bj = 0; bj < 2; ++bj)
#pragma unroll
                    for (int n = 0; n < 2; ++n) { const int c = col0 + bj * 128 + n * 16; *(f32x4*)(orow + c) = *(const f32x4*)(xr + c) + acc[ai][bj][m][n]; } }
    } };

template <int NSEG, class Epi>
__device__ __forceinline__ void tail_gemm(const bf16_t* __restrict__ A, int lda, const bf16_t* __restrict__ Bt, int K, int N, const Epi& epi, LAS unsigned char* lds) {
    int tid = threadIdx.x; asm volatile("" : "+v"(tid));
    const int lane = tid & 63, wave = __builtin_amdgcn_readfirstlane(tid >> 6), rt = wave & 3, kh = wave >> 2, n = lane & 15, q = lane >> 4;
    const int ntile = 4 * (N / 16), kseg = K / NSEG, khalf = kseg / 2;
    LAS f32x4* red = (LAS f32x4*)lds;
    for (int tile = blockIdx.x; tile < ntile; tile += gridDim.x) {
        const int r0 = 64 * (tile & 3) + 16 * rt, c0 = 16 * (tile >> 2);
        const bf16_t* ap = A + (size_t)(r0 + n) * lda + 8 * q; const bf16_t* bp = Bt + (size_t)(c0 + n) * K + 8 * q;
        f32x4 acc[NSEG];
#pragma unroll
        for (int sg = 0; sg < NSEG; ++sg) { acc[sg] = (f32x4){0.f, 0.f, 0.f, 0.f};
            const int kb = sg * kseg + kh * khalf;
#pragma unroll 4
            for (int k = 0; k < khalf; k += 32) acc[sg] = __builtin_amdgcn_mfma_f32_16x16x32_bf16(*(const bf16x8_t*)(ap + kb + k), *(const bf16x8_t*)(bp + kb + k), acc[sg], 0, 0, 0); }
        __syncthreads();
        if (kh == 1) {
#pragma unroll
            for (int sg = 0; sg < NSEG; ++sg) red[(rt * NSEG + sg) * 64 + lane] = acc[sg]; }
        __syncthreads();
        if (kh == 0) {
#pragma unroll
            for (int sg = 0; sg < NSEG; ++sg) acc[sg] += red[(rt * NSEG + sg) * 64 + lane];
#pragma unroll
            for (int e = 0; e < 4; ++e) { float v[NSEG];
#pragma unroll
                for (int sg = 0; sg < NSEG; ++sg) v[sg] = acc[sg][e];
                epi(r0 + 4 * q + e, c0 + n, v); } }
    }
    __syncthreads();
}
struct TEpiMerge { const bf16_t* H; bf16_t* mb;
    __device__ __forceinline__ void operator()(int row, int col, const float (&v)[3]) const { const size_t t = (size_t)TP + row; const bf16_t* g = H + t * IN_WP + C_GATE + col;
        mb[t * 1024 + col] = f2bf(bf2f(g[0]) * v[0] + bf2f(g[1024]) * v[1] + bf2f(g[2048]) * v[2]); } };
struct TEpiRes { const float* xs; float* xo;
    __device__ __forceinline__ void operator()(int row, int col, const float (&v)[1]) const { xo[((size_t)TP + row) * 1024 + col] = xs[(size_t)row * 1024 + col] + v[0]; } };
struct MEpiMergeS { static constexpr bool PERM = true, AFTER_DRAIN = false; static constexpr int SEG = 3; const bf16_t* H; bf16_t* mb;
    __device__ __forceinline__ void mid(f32x4 (&acc)[2][2][4][2], const pg8::Unit& u, int wr, int wc, int fr0, int fq0, int seg, float keep) const {
        int fr = fr0, fq = fq0; asm volatile("" : "+v"(fr), "+v"(fq));
        const int row0 = u.pm * 256 + wr * 64 + fr;
#pragma unroll
        for (int bj = 0; bj < 2; ++bj) { const int col0 = u.pn * 256 + bj * 128 + wc * 32 + 8 * fq;
#pragma unroll
            for (int ai = 0; ai < 2; ++ai) {
                u32x4 ga[4], gb[4];
#pragma unroll
                for (int m = 0; m < 4; ++m) { const bf16_t* gp = H + (size_t)(row0 + ai * 128 + m * 16) * IN_WP + C_GATE + (seg - 1) * 1024 + col0; ga[m] = *(const u32x4*)gp; gb[m] = *(const u32x4*)(gp + 1024); }
#pragma unroll
                for (int m = 0; m < 4; ++m) { float a[8], b[8]; unpack8(ga[m], a); unpack8(gb[m], b);
#pragma unroll
                    for (int e = 0; e < 4; ++e) { acc[ai][bj][m][0][e] *= keep * a[e] * __builtin_amdgcn_rcpf(fmaxf(b[e], 1e-30f)); acc[ai][bj][m][1][e] *= keep * a[4 + e] * __builtin_amdgcn_rcpf(fmaxf(b[4 + e], 1e-30f)); } }
                asm volatile("" ::: "memory"); } }
    }
    __device__ __forceinline__ void operator()(const f32x4 (&acc)[2][2][4][2], const pg8::Unit& u, int wr, int wc, int fr0, int fq0) const {
        int fr = fr0, fq = fq0; asm volatile("" : "+v"(fr), "+v"(fq));
        const int row0 = u.pm * 256 + wr * 64 + fr;
#pragma unroll
        for (int bj = 0; bj < 2; ++bj) { const int col0 = u.pn * 256 + bj * 128 + wc * 32 + 8 * fq;
#pragma unroll
            for (int ai = 0; ai < 2; ++ai) {
                u32x4 gg[4];
#pragma unroll
                for (int m = 0; m < 4; ++m) gg[m] = *(const u32x4*)(H + (size_t)(row0 + ai * 128 + m * 16) * IN_WP + C_GATE + 2048 + col0);
#pragma unroll
                for (int m = 0; m < 4; ++m) { const int row = row0 + ai * 128 + m * 16; float g[8]; unpack8(gg[m], g);
                    const f32x4 v0 = acc[ai][bj][m][0], v1 = acc[ai][bj][m][1];
                    u32x4 w; w.x = pg8::cvt_pk_bf16(v0[0] * g[0], v0[1] * g[1]); w.y = pg8::cvt_pk_bf16(v0[2] * g[2], v0[3] * g[3]); w.z = pg8::cvt_pk_bf16(v1[0] * g[4], v1[1] * g[5]); w.w = pg8::cvt_pk_bf16(v1[2] * g[6], v1[3] * g[7]);
                    *(u32x4*)(mb + (size_t)row * 1024 + col0) = w; }
                asm volatile("" ::: "memory"); } }
    } };

__device__ __forceinline__ void ph_tr(const float* __restrict__ src, bf16_t* __restrict__ dst, int K, int N, int Npad, LAS float* tile, int rot, int ldd = 0) {
    if (ldd == 0) ldd = K;
    int tid = threadIdx.x; asm volatile("" : "+v"(tid)); const int G = gridDim.x; const int tn = Npad / 64, tk = K / 32, nt = tn * tk;
    const int first = (blockIdx.x + G - (rot % G)) % G;
    const bool al4 = (N & 3) == 0;
    for (int t = first; t < nt; t += G) {
        const int n0 = (t % tn) * 64, k0 = (t / tn) * 32;
        { const int k = tid >> 4, n4 = (tid & 15) * 4, n = n0 + n4; f32x4 v = (f32x4){0.f, 0.f, 0.f, 0.f};
          const float* sp = src + (size_t)(k0 + k) * N + n;
          if (al4 && n + 3 < N) v = *(const f32x4*)sp; else {
#pragma unroll
              for (int e = 0; e < 4; ++e) if (n + e < N) v[e] = sp[e]; }
#pragma unroll
          for (int e = 0; e < 4; ++e) tile[k * 65 + n4 + e] = v[e]; }
        __syncthreads();
        if (tid < 256) { const int n = tid >> 2, kq = (tid & 3) * 8; float f[8];
#pragma unroll
            for (int j = 0; j < 8; ++j) f[j] = tile[(kq + j) * 65 + n];
            *(u32x4*)(dst + (size_t)(n0 + n) * ldd + k0 + kq) = pack8(f); }
        __syncthreads();
    }
}
__device__ __forceinline__ void ph_rope_tab(float2* tab) {
    for (int idx = blockIdx.x * NTHR + threadIdx.x; idx < (SEQ + DEC_SEQ) * 16; idx += gridDim.x * NTHR) {
        const int p = idx >> 4, i = idx & 15; const int pos = p < SEQ ? p : PAST_LEN + (p - SEQ);
        const float inv = powf(10000.0f, -(float)i / 16.0f); const float ang = (float)pos * inv;
        const double rev = (double)ang * 0.15915494309189533576888; const float f = (float)(rev - floor(rev));
        tab[idx] = make_float2(__builtin_amdgcn_cosf(f), __builtin_amdgcn_sinf(f)); }
}
__device__ __forceinline__ void ph_rmsnorm(const float* __restrict__ xp, const float* __restrict__ xs, const float* __restrict__ g, bf16_t* __restrict__ xn, float* __restrict__ yp, float* __restrict__ ys) {
    int tid_o = threadIdx.x; asm volatile("" : "+v"(tid_o)); int lane = tid_o & 63, wave = tid_o >> 6;
    for (int t = blockIdx.x * 8 + wave; t < TT; t += gridDim.x * 8) {
        const float* x = t < TP ? xp + (size_t)t * 1024 : xs + (size_t)(t - TP) * 1024;
        f32x4 v[4]; float ss = 0.f;
#pragma unroll
        for (int i = 0; i < 4; ++i) { v[i] = *(const f32x4*)(x + i * 256 + lane * 4); ss += v[i][0] * v[i][0] + v[i][1] * v[i][1] + v[i][2] * v[i][2] + v[i][3] * v[i][3]; }
        ss = wave_sum(ss); const float r = rsqrtf(ss * (1.0f / 1024.0f) + EPS);
#pragma unroll
        for (int i = 0; i < 4; ++i) { const int c = i * 256 + lane * 4; const f32x4 gg = *(const f32x4*)(g + c); const f32x4 o = v[i] * r * gg;
            if (xn) { u32x2 w; w.x = pg8::cvt_pk_bf16(o[0], o[1]); w.y = pg8::cvt_pk_bf16(o[2], o[3]); *(u32x2*)(xn + (size_t)t * 1024 + c) = w; }
            else { float* y = t < TP ? yp + (size_t)t * 1024 : ys + (size_t)(t - TP) * 1024; *(f32x4*)(y + c) = o; } }
    }
}

constexpr int TK_RS = 1040;
__device__ __forceinline__ void tok8(KP p, int l, int tbase, int iseq0, bool smp, int sq, int lane) {
    const bf16_t* __restrict__ H = p->H; float* __restrict__ out = p->out;
    { const float* qg = p->q_norm_g + l * 384; const float* kvg = p->kv_norm_g + l * 256;
      u32x4 rq[8], rk[8];
#pragma unroll
      for (int e = 0; e < 8; ++e) { const bf16_t* h = H + (size_t)(tbase + e) * IN_WP;
          rq[e] = lane < 48 ? *(const u32x4*)(h + C_Q + lane * 8) : (u32x4){0u, 0u, 0u, 0u}; rk[e] = lane < 32 ? *(const u32x4*)(h + C_KV + lane * 8) : (u32x4){0u, 0u, 0u, 0u}; }
      f32x4 gq0 = (f32x4){0.f, 0.f, 0.f, 0.f}, gq1 = gq0, gk0 = gq0, gk1 = gq0;
      if (lane < 48) { gq0 = *(const f32x4*)(qg + lane * 8); gq1 = *(const f32x4*)(qg + lane * 8 + 4); }
      if (lane < 32) { gk0 = *(const f32x4*)(kvg + lane * 8); gk1 = *(const f32x4*)(kvg + lane * 8 + 4); }
#pragma unroll
      for (int e = 0; e < 8; ++e) { const int t = tbase + e; float q[8], kv[8]; unpack8(rq[e], q); unpack8(rk[e], kv); float s1 = 0.f, s2 = 0.f;
#pragma unroll
          for (int j = 0; j < 8; ++j) { s1 += q[j] * q[j]; s2 += kv[j] * kv[j]; }
          s1 = wave_sum(s1); s2 = wave_sum(s2); const float r1 = rsqrtf(s1 * (1.0f / 384.0f) + EPS), r2 = rsqrtf(s2 * (1.0f / 256.0f) + EPS);
#pragma unroll
          for (int j = 0; j < 4; ++j) { q[j] *= r1 * gq0[j]; q[4 + j] *= r1 * gq1[j]; kv[j] *= r2 * gk0[j]; kv[4 + j] *= r2 * gk1[j]; }
          if (lane < 48) *(u32x4*)(p->cq + (size_t)t * 384 + lane * 8) = pack8(q);
          if (lane < 32) { float* okv = (smp ? out + O_SKV + ((size_t)l * TS + (t - TP)) * 256 : out + O_PKV + ((size_t)l * TP + t) * 256) + lane * 8;
              *(f32x4*)okv = (f32x4){kv[0], kv[1], kv[2], kv[3]}; *(f32x4*)(okv + 4) = (f32x4){kv[4], kv[5], kv[6], kv[7]};
              *(u32x4*)(p->ckv + (size_t)t * 256 + lane * 8) = pack8(kv); } }
#pragma unroll
      for (int ps = 0; ps < 2; ++ps) { const int e = (lane >> 4) + 4 * ps, j = lane & 15, t = tbase + e; const bf16_t* h = H + (size_t)t * IN_WP;
          const float x1 = bf2f(h[C_KR + j]), x2 = bf2f(h[C_KR + 16 + j]); const float2 cs = p->tab[((smp ? SEQ : 0) + iseq0 + e) * 16 + j];
          const float o1 = x1 * cs.x - x2 * cs.y, o2 = x2 * cs.x + x1 * cs.y; float* okr = smp ? out + O_SKR + ((size_t)l * TS + (t - TP)) * 32 : out + O_PKR + ((size_t)l * TP + t) * 32;
          okr[j] = o1; okr[16 + j] = o2; p->Kr[(size_t)t * 32 + j] = f2bf(o1); p->Kr[(size_t)t * 32 + 16 + j] = f2bf(o2); } }
    { const float* conv_w = p->conv_w + (size_t)l * 4 * 1536; const bool last = smp || (iseq0 == SEQ - 8);
#pragma unroll 1
      for (int pi = 0; pi < 3; ++pi) { const int c0 = (pi * 64 + lane) * 8;
          u32x4 rows[11];
#pragma unroll
          for (int j = 0; j < 11; ++j) { const int u = iseq0 - 3 + j;
              if (u >= 0) rows[j] = *(const u32x4*)(H + (size_t)(tbase - 3 + j) * IN_WP + C_QKV + c0);
              else if (smp) { const float* sc = p->state_conv + (((size_t)l * DEC_BATCH + sq) * 3 + (u + 3)) * 1536 + c0; const f32x4 a = *(const f32x4*)sc, b = *(const f32x4*)(sc + 4);
                  rows[j].x = pg8::cvt_pk_bf16(a[0], a[1]); rows[j].y = pg8::cvt_pk_bf16(a[2], a[3]); rows[j].z = pg8::cvt_pk_bf16(b[0], b[1]); rows[j].w = pg8::cvt_pk_bf16(b[2], b[3]); }
              else rows[j] = (u32x4){0u, 0u, 0u, 0u}; }
          f32x4 w0[4], w1[4];
#pragma unroll
          for (int j = 0; j < 4; ++j) { w0[j] = *(const f32x4*)(conv_w + j * 1536 + c0); w1[j] = *(const f32x4*)(conv_w + j * 1536 + c0 + 4); }
          bf16_t* dst = pi == 0 ? p->qd : (pi == 1 ? p->kd : p->vd);
#pragma unroll
          for (int e = 0; e < 8; ++e) { float y[8];
#pragma unroll
              for (int k = 0; k < 8; ++k) y[k] = 0.f;
#pragma unroll
              for (int j = 0; j < 4; ++j) { float x[8]; unpack8(rows[e + j], x);
#pragma unroll
                  for (int k = 0; k < 4; ++k) { y[k] += x[k] * w0[j][k]; y[4 + k] += x[4 + k] * w1[j][k]; } }
              float ss = 0.f;
#pragma unroll
              for (int k = 0; k < 8; ++k) { y[k] = siluf_(y[k]); ss += y[k] * y[k]; }
              if (pi < 2) { ss += __shfl_xor(ss, 1); ss += __shfl_xor(ss, 2); ss += __shfl_xor(ss, 4); const float rn = rsqrtf(ss + EPS) * (pi == 0 ? 0.125f : 1.0f);
#pragma unroll
                  for (int k = 0; k < 8; ++k) y[k] *= rn; }
              *(u32x4*)(dst + (size_t)(tbase + e) * 512 + lane * 8) = pack8(y); }
          if (last) {
#pragma unroll
              for (int rr = 0; rr < 3; ++rr) { float x[8]; unpack8(rows[8 + rr], x);
                  float* oc = (smp ? out + O_SCONV + (((size_t)l * DEC_BATCH + sq) * 3 + rr) * 1536 : out + O_PCONV + (((size_t)l * 8 + (tbase >> 11)) * 3 + rr) * 1536) + c0;
                  *(f32x4*)oc = (f32x4){x[0], x[1], x[2], x[3]}; *(f32x4*)(oc + 4) = (f32x4){x[4], x[5], x[6], x[7]}; } } } }
    { const int t = tbase + (lane >> 3), hd = lane & 7; const float bb = sigmoidf_(p->BA[(size_t)t * 16 + hd]); const float x = p->BA[(size_t)t * 16 + 8 + hd] + p->dt_bias[l * 8 + hd];
      const float sp = x > 20.f ? x : log1pf(expf(x)); const float gg = -expf(p->a_log[l * 8 + hd]) * sp;
      p->bg[(size_t)t * 16 + hd] = bb; p->bg[(size_t)t * 16 + 8 + hd] = gg; }
}
__device__ __forceinline__ void ph_tok(KP p, int l, LAS unsigned char* lds) {
    int tid = threadIdx.x; asm volatile("" : "+v"(tid)); const int pmask = p->pad;
    const int lane = tid & 63, wave = __builtin_amdgcn_readfirstlane(tid >> 6), r = lane & 31, hh = lane >> 5;
    const bf16_t* __restrict__ H = p->H; float* __restrict__ out = p->out;
    for (int tile = blockIdx.x; tile < TP / 64 + 8; tile += gridDim.x) {
        const bool smp = tile >= TP / 64; const int s0 = smp ? (tile - TP / 64) * 4 : 0;
        const int t0 = smp ? TP + s0 * 8 : tile * 64, i0 = smp ? 0 : (t0 & (SEQ - 1)), b = t0 >> 11;
        __syncthreads();
        if (!smp) {
            u32x4 v[10];
#pragma unroll
            for (int i = 0; i < 10; ++i) { const int c = tid + NTHR * i, row = c >> 6, ch16 = c & 63; v[i] = (u32x4){0u, 0u, 0u, 0u};
                if (c < 79 * 64 && i0 - 15 + row >= 0) v[i] = *(const u32x4*)(H + (size_t)(t0 - 15 + row) * IN_WP + C_POOL + ch16 * 8); }
#pragma unroll
            for (int i = 0; i < 10; ++i) { const int c = tid + NTHR * i, row = c >> 6, ch16 = c & 63; if (c < 79 * 64) *(LAS u32x4*)(lds + row * TK_RS + ch16 * 16) = v[i]; }
        } else {
            for (int c = tid; c < 92 * 64; c += NTHR) { const int row = c >> 6, ch16 = c & 63, sq = row / 23, j = row - sq * 23; u32x4 v;
                if (j >= 15) v = *(const u32x4*)(H + (size_t)(t0 + sq * 8 + (j - 15)) * IN_WP + C_POOL + ch16 * 8);
                else { const float* sp = p->state_pool + (((size_t)l * DEC_BATCH + s0 + sq) * 15 + j) * 512 + ch16 * 8; const f32x4 a = *(const f32x4*)sp, bq = *(const f32x4*)(sp + 4);
                    v.x = pg8::cvt_pk_bf16(a[0], a[1]); v.y = pg8::cvt_pk_bf16(a[2], a[3]); v.z = pg8::cvt_pk_bf16(bq[0], bq[1]); v.w = pg8::cvt_pk_bf16(bq[2], bq[3]);
                    if (j >= 8) { float* so = out + O_SPOOL + (((size_t)l * DEC_BATCH + s0 + sq) * 15 + (j - 8)) * 512 + ch16 * 8; *(f32x4*)so = a; *(f32x4*)(so + 4) = bq; } }
                *(LAS u32x4*)(lds + row * TK_RS + ch16 * 16) = v; }
        }
        __syncthreads();
        if ((pmask & 8192) && !(smp && (wave & 1))) { const int g = wave >> 1, th = wave & 1, w = 2 << g, tk = 32 * th + r;
          const int brow = smp ? (tk >> 3) * 23 + 15 + (tk & 7) : 15 + tk; const float inv = 1.0f / (float)(smp ? w : min(i0 + tk + 1, w));
          const bf16_t* mixT = p->PmixT + ((size_t)l * 4 + g) * 128 * 128;
          f32x16 acc[4];
#pragma unroll
          for (int nt = 0; nt < 4; ++nt)
#pragma unroll
              for (int e = 0; e < 16; ++e) acc[nt][e] = 0.f;
#pragma unroll 2
          for (int ks = 0; ks < 8; ++ks) {
              const LAS unsigned char* base = lds + brow * TK_RS + (128 * g + 16 * ks + 8 * hh) * 2;
              float cur[8], sum[8]; unpack8(*(const LAS u32x4*)base, cur);
#pragma unroll
              for (int e = 0; e < 8; ++e) sum[e] = cur[e];
              for (int k = 1; k < w; ++k) { float x[8]; unpack8(*(const LAS u32x4*)(base - k * TK_RS), x);
#pragma unroll
                  for (int e = 0; e < 8; ++e) sum[e] += x[e]; }
#pragma unroll
              for (int e = 0; e < 8; ++e) sum[e] = sum[e] * inv - cur[e];
              union { u32x4 u; bf16x8_t v; } bfr; bfr.u = pack8(sum);
#pragma unroll
              for (int nt = 0; nt < 4; ++nt) { const bf16x8_t a = *(const bf16x8_t*)(mixT + (size_t)(32 * nt + r) * 128 + 16 * ks + 8 * hh);
                  acc[nt] = __builtin_amdgcn_mfma_f32_32x32x16_bf16(a, bfr.v, acc[nt], 0, 0, 0); } }
          const size_t t = (size_t)t0 + tk; const float* scl = p->pool_scale + l * 512 + 128 * g;
#pragma unroll
          for (int nt = 0; nt < 4; ++nt)
#pragma unroll
              for (int gg = 0; gg < 4; ++gg) { const int dd0 = 32 * nt + 8 * gg + 4 * hh; const u32x2 z = *(const u32x2*)(H + t * IN_WP + C_ZPOOL + 128 * g + dd0); const f32x4 sc = *(const f32x4*)(scl + dd0);
                  float v0 = acc[nt][4 * gg + 0] * sc[0] * __uint_as_float(z.x << 16), v1 = acc[nt][4 * gg + 1] * sc[1] * __uint_as_float(z.x & 0xffff0000u);
                  float v2 = acc[nt][4 * gg + 2] * sc[2] * __uint_as_float(z.y << 16), v3 = acc[nt][4 * gg + 3] * sc[3] * __uint_as_float(z.y & 0xffff0000u);
                  u32x2 o; o.x = pg8::cvt_pk_bf16(v0, v1); o.y = pg8::cvt_pk_bf16(v2, v3); *(u32x2*)(p->ya + t * 1536 + 128 * g + dd0) = o; } }
        if (!smp) { if (i0 == SEQ - 64) { for (int c = tid; c < 15 * 512; c += NTHR) { const int rr = c >> 9, ch = c & 511;
              out[O_PPOOL + (((size_t)l * 8 + b) * 15 + rr) * 512 + ch] = bf2f(*(const LAS bf16_t*)(lds + (15 + 49 + rr) * TK_RS + ch * 2)); } } }
        else { for (int c = tid; c < 4 * 8 * 512; c += NTHR) { const int sq = c >> 12, i = (c >> 9) & 7, ch = c & 511;
              out[O_SPOOL + (((size_t)l * DEC_BATCH + s0 + sq) * 15 + 7 + i) * 512 + ch] = bf2f(*(const LAS bf16_t*)(lds + (sq * 23 + 15 + i) * TK_RS + ch * 2)); } }
        if (pmask & 16384) { if (!smp) tok8(p, l, t0 + wave * 8, i0 + wave * 8, false, 0, lane);
        else if (wave < 4) tok8(p, l, t0 + wave * 8, 0, true, s0 + wave, lane); }
    }
    __syncthreads();
}

__device__ __forceinline__ void wu_delta(KP p, int l, int sq, int h, int dv) {
    int row0, L; float* so; float S[64];
    if (sq < 8) { row0 = sq * SEQ; L = SEQ; so = p->out + O_PDELTA + (((size_t)l * 8 + sq) * 8 + h) * 4096;
#pragma unroll
        for (int k = 0; k < 64; ++k) S[k] = 0.f; }
    else { const int s = sq - 8; row0 = TP + s * 8; L = DEC_SEQ; so = p->out + O_SDELTA + (((size_t)l * DEC_BATCH + s) * 8 + h) * 4096;
        const float* s0 = p->state_delta + (((size_t)l * DEC_BATCH + s) * 8 + h) * 4096;
#pragma unroll
        for (int k = 0; k < 64; ++k) S[k] = s0[k * 64 + dv]; }
    const float gn = p->dn_norm_g[l * 64 + dv];
    for (int i = 0; i < L; ++i) {
        const size_t t = (size_t)row0 + i; const u32x4* kp = (const u32x4*)(p->kd + t * 512 + h * 64); const u32x4* qp = (const u32x4*)(p->qd + t * 512 + h * 64);
        const float b = p->bg[t * 16 + h], a = __expf(p->bg[t * 16 + 8 + h]); const float v = bf2f(p->vd[t * 512 + h * 64 + dv]);
        u32x4 kk[8];
#pragma unroll
        for (int c = 0; c < 8; ++c) kk[c] = kp[c];
        float ks = 0.f;
#pragma unroll
        for (int c = 0; c < 8; ++c)
#pragma unroll
            for (int e = 0; e < 4; ++e) { const unsigned w = kk[c][e]; ks += __uint_as_float(w << 16) * S[c * 8 + 2 * e] + __uint_as_float(w & 0xffff0000u) * S[c * 8 + 2 * e + 1]; }
        const float vn = b * (v - a * ks); float o = 0.f;
#pragma unroll
        for (int c = 0; c < 8; ++c) { const u32x4 qv = qp[c];
#pragma unroll
            for (int e = 0; e < 4; ++e) { const unsigned w = kk[c][e], wq = qv[e]; const int k0 = c * 8 + 2 * e;
                S[k0] = a * S[k0] + __uint_as_float(w << 16) * vn; o += __uint_as_float(wq << 16) * S[k0];
                S[k0 + 1] = a * S[k0 + 1] + __uint_as_float(w & 0xffff0000u) * vn; o += __uint_as_float(wq & 0xffff0000u) * S[k0 + 1]; }
            asm volatile("" ::: "memory"); }
        const float ss = wave_sum(o * o); const float y = o * rsqrtf(ss * (1.0f / 64.0f) + EPS) * gn;
        p->yc[t * 1536 + h * 64 + dv] = f2bf(y * bf2f(p->H[t * IN_WP + C_ZDN + h * 64 + dv]));
    }
#pragma unroll
    for (int k = 0; k < 64; ++k) so[k * 64 + dv] = S[k];
}
__device__ __forceinline__ int sig_inv(int rho) { return (rho & 32) | ((rho & 12) << 1) | ((rho & 16) >> 2) | (rho & 3); }
constexpr int DPRE_LDS = 64 * 64 * 4 + 512;
constexpr int DST = 72;
__device__ __forceinline__ void dpre_flush(const LAS bf16_t* St, bf16_t* gdst, int lane) {
    asm volatile("s_waitcnt lgkmcnt(0)" ::: "memory");
#pragma unroll
    for (int it = 0; it < 8; ++it) { const int row = (lane >> 3) + 8 * it, chunk = lane & 7; *(u32x4*)(gdst + row * 64 + chunk * 8) = *(const LAS u32x4*)(St + row * DST + chunk * 8); }
    asm volatile("s_waitcnt lgkmcnt(0)" ::: "memory");
}
__device__ __forceinline__ void ph_delta_pre(KP p, LAS unsigned char* lds) {
    int tid_o = threadIdx.x; asm volatile("" : "+v"(tid_o)); int lane = tid_o & 63, wave = tid_o >> 6;
    wave = __builtin_amdgcn_readfirstlane(wave);
    LAS float* Am = (LAS float*)(lds + wave * DPRE_LDS); LAS float* gcs = Am + 4096; LAS float* bts = gcs + 64; LAS bf16_t* St = (LAS bf16_t*)Am;
    for (int unit = wave * gridDim.x + blockIdx.x; unit < 2048; unit += gridDim.x * 8) {
        { int t_ = threadIdx.x; asm volatile("" : "+v"(t_)); lane = t_ & 63; }
        const int r = lane & 31, hh = lane >> 5;
        const int bh = unit >> 5, ch = unit & 31, b = bh >> 3, h = bh & 7;
        const size_t t0 = (size_t)b * SEQ + ch * 64;
        bf16_t* op = p->DOP + (size_t)unit * 4 * 4096; float* up = p->DU + (size_t)unit * 4096;
        const bf16_t* kdb = p->kd + t0 * 512 + h * 64; const bf16_t* qdb = p->qd + t0 * 512 + h * 64; const bf16_t* vdb = p->vd + t0 * 512 + h * 64;
        const float* bgb = p->bg + t0 * 16 + h;
        const float beta = bgb[lane * 16]; float gc = bgb[lane * 16 + 8];
#pragma unroll
        for (int d = 1; d < 64; d <<= 1) { const float x = __shfl_up(gc, d); if (lane >= d) gc += x; }
        const float gl = __shfl(gc, 63); const float egc = __expf(gc);
        gcs[lane] = gc; bts[lane] = beta;
        if (lane == 0) p->DG[unit] = __expf(gl);
        bf16x8_t kf[2][4], qf[2][4];
        { const int voff = r * 512 + 8 * hh;
#pragma unroll
          for (int rb = 0; rb < 2; ++rb)
#pragma unroll
            for (int ks = 0; ks < 4; ++ks) { kf[rb][ks] = *(const bf16x8_t*)(kdb + (32 * rb * 512 + 16 * ks) + voff); qf[rb][ks] = *(const bf16x8_t*)(qdb + (32 * rb * 512 + 16 * ks) + voff); } }
        {
#pragma unroll
            for (int rb = 0; rb < 2; ++rb) { const float sc = __expf(gl - __shfl(gc, 32 * rb + r)); const int pos = sig_inv(32 * rb + r);
#pragma unroll
                for (int ks = 0; ks < 4; ++ks)
#pragma unroll
                    for (int jj = 0; jj < 8; ++jj) St[(16 * ks + 8 * hh + jj) * DST + pos] = f2bf(bf2f((bf16_t)kf[rb][ks][jj]) * sc); }
            dpre_flush(St, op + 3 * 4096, lane);
#pragma unroll
            for (int rb = 0; rb < 2; ++rb) { const float sc = __shfl(egc, 32 * rb + r);
#pragma unroll
                for (int ks = 0; ks < 4; ++ks)
#pragma unroll
                    for (int jj = 0; jj < 8; ++jj) St[(32 * rb + r) * DST + sig_inv(16 * ks + 8 * hh + jj)] = f2bf(bf2f((bf16_t)qf[rb][ks][jj]) * sc); }
            dpre_flush(St, op + 1 * 4096, lane);
        }
        float xu[64];
        {
#pragma unroll
            for (int it = 0; it < 8; ++it) { const int row = (lane >> 3) + 8 * it, chunk = lane & 7; *(LAS u32x4*)(St + row * DST + chunk * 8) = *(const u32x4*)(vdb + row * 512 + chunk * 8); }
            asm volatile("s_waitcnt lgkmcnt(0)" ::: "memory");
            const int beta_i = __float_as_int(beta);
#pragma unroll
            for (int i = 0; i < 64; ++i) xu[i] = __int_as_float(__builtin_amdgcn_readlane(beta_i, i)) * bf2f(St[i * DST + lane]);
            asm volatile("s_waitcnt lgkmcnt(0)" ::: "memory");
        }
        {
            const float gcj0 = __shfl(gc, r), gcj1 = __shfl(gc, 32 + r);
            const int p0 = sig_inv(r), p1 = sig_inv(32 + r);
            { f32x16 t00, t10, t11;
#pragma unroll
              for (int e = 0; e < 16; ++e) { t00[e] = 0.f; t10[e] = 0.f; t11[e] = 0.f; }
#pragma unroll
              for (int ks = 0; ks < 4; ++ks) {
                  t00 = __builtin_amdgcn_mfma_f32_32x32x16_bf16(qf[0][ks], kf[0][ks], t00, 0, 0, 0);
                  t10 = __builtin_amdgcn_mfma_f32_32x32x16_bf16(qf[1][ks], kf[0][ks], t10, 0, 0, 0);
                  t11 = __builtin_amdgcn_mfma_f32_32x32x16_bf16(qf[1][ks], kf[1][ks], t11, 0, 0, 0); }
#pragma unroll
              for (int e = 0; e < 16; ++e) { const int il = (e & 3) + 8 * (e >> 2) + 4 * hh;
                  { const int i = il, j = r; St[i * DST + p0] = f2bf(j <= i ? t00[e] * __expf(fminf(gcs[i] - gcj0, 0.f)) : 0.f); St[i * DST + p1] = 0; }
                  { const int i = 32 + il; St[i * DST + p0] = f2bf(t10[e] * __expf(fminf(gcs[i] - gcj0, 0.f))); }
                  { const int i = 32 + il, j = 32 + r; St[i * DST + p1] = f2bf(j <= i ? t11[e] * __expf(fminf(gcs[i] - gcj1, 0.f)) : 0.f); } }
              dpre_flush(St, op + 2 * 4096, lane); }
            { f32x16 t00, t10, t11;
#pragma unroll
              for (int e = 0; e < 16; ++e) { t00[e] = 0.f; t10[e] = 0.f; t11[e] = 0.f; }
#pragma unroll
              for (int ks = 0; ks < 4; ++ks) {
                  t00 = __builtin_amdgcn_mfma_f32_32x32x16_bf16(kf[0][ks], kf[0][ks], t00, 0, 0, 0);
                  t10 = __builtin_amdgcn_mfma_f32_32x32x16_bf16(kf[1][ks], kf[0][ks], t10, 0, 0, 0);
                  t11 = __builtin_amdgcn_mfma_f32_32x32x16_bf16(kf[1][ks], kf[1][ks], t11, 0, 0, 0); }
#pragma unroll
              for (int e = 0; e < 16; ++e) { const int il = (e & 3) + 8 * (e >> 2) + 4 * hh;
                  { const int i = il, j = r; Am[i * 64 + j] = j < i ? bts[i] * t00[e] * __expf(fminf(gcs[i] - gcj0, 0.f)) : 0.f; }
                  { const int i = 32 + il, j = r; Am[i * 64 + j] = bts[i] * t10[e] * __expf(fminf(gcs[i] - gcj0, 0.f)); }
                  { const int i = 32 + il, j = 32 + r; Am[i * 64 + j] = j < i ? bts[i] * t11[e] * __expf(fminf(gcs[i] - gcj1, 0.f)) : 0.f; } } }
        }
        asm volatile("s_waitcnt lgkmcnt(0)" ::: "memory");
        {
            int c; { int t_ = threadIdx.x; asm volatile("" : "+v"(t_)); c = t_ & 63; } const int pc = sig_inv(c);
            const int beta_i = __float_as_int(beta), egc_i = __float_as_int(egc);
#pragma unroll
            for (int i = 1; i < 64; ++i) { float au = xu[i];
#pragma unroll
                for (int j4 = 0; j4 < i; j4 += 4) { const f32x4 a = *(const LAS f32x4*)(Am + i * 64 + j4);
#pragma unroll
                    for (int e = 0; e < 4; ++e) if (j4 + e < i) au -= a[e] * xu[j4 + e]; }
                xu[i] = au; }
#pragma unroll
            for (int i = 0; i < 64; ++i) (up + i * 64)[c] = xu[i];
            asm volatile("" ::: "memory");
            { float w[64];
#pragma unroll
              for (int i = 0; i < 64; ++i) w[i] = __int_as_float(__builtin_amdgcn_readlane(beta_i, i)) * __int_as_float(__builtin_amdgcn_readlane(egc_i, i)) * bf2f((kdb + i * 512)[c]);
#pragma unroll
              for (int i = 1; i < 64; ++i) { float aw = w[i];
#pragma unroll
                  for (int j4 = 0; j4 < i; j4 += 4) { const f32x4 a = *(const LAS f32x4*)(Am + i * 64 + j4);
#pragma unroll
                      for (int e = 0; e < 4; ++e) if (j4 + e < i) aw -= a[e] * w[j4 + e]; }
                  w[i] = aw; }
              asm volatile("s_waitcnt lgkmcnt(0)" ::: "memory");
#pragma unroll
              for (int i = 0; i < 64; ++i) St[i * DST + pc] = f2bf(-w[i]); }
            dpre_flush(St, op, lane);
        }
    }
}
__device__ __forceinline__ void st_rows2(bf16_t* row0, bf16_t* row1, unsigned pos, float a, float b, bool even) {
    const float x = even ? b : a;
    const float y = __int_as_float(__builtin_amdgcn_mov_dpp(__float_as_int(x), 0xB1, 0xF, 0xF, true));
    const unsigned w = even ? pg8::cvt_pk_bf16(a, y) : pg8::cvt_pk_bf16(y, b);
    bf16_t* dst = even ? row0 + pos : row1 + (pos - 1u);
    *(unsigned*)dst = w;
}
__device__ __forceinline__ bf16x8_t pack_b(const f32x4& lo, const f32x4& hi) { union { u32x4 u; bf16x8_t v; } x;
    x.u.x = pg8::cvt_pk_bf16(lo[0], lo[1]); x.u.y = pg8::cvt_pk_bf16(lo[2], lo[3]); x.u.z = pg8::cvt_pk_bf16(hi[0], hi[1]); x.u.w = pg8::cvt_pk_bf16(hi[2], hi[3]); return x.v; }
__device__ __forceinline__ void wu_scan(KP p, int l, int bh, int slice, int lane) {
    const int n = lane & 15, q = lane >> 4, n0 = slice * 16, b = bh >> 3, h = bh & 7;
    f32x4 S[4];
#pragma unroll
    for (int t = 0; t < 4; ++t) S[t] = (f32x4){0.f, 0.f, 0.f, 0.f};
    const int foff = n * 64 + 8 * q;
    for (int ch = 0; ch < 32; ++ch) {
        const size_t unit = (size_t)bh * 32 + ch;
        const bf16_t* op = p->DOP + unit * 4 * 4096 + foff; const float* up = p->DU + unit * 4096 + n0 + n;
        const float eg = p->DG[unit];
        f32x4 vn[4]; bf16x8_t wf[4][2], gf[4][2], kf[4][2], tf[4][2];
#pragma unroll
        for (int mt = 0; mt < 4; ++mt) {
#pragma unroll
            for (int e = 0; e < 4; ++e) vn[mt][e] = up[(16 * mt + 4 * q + e) * 64];
#pragma unroll
            for (int ks = 0; ks < 2; ++ks) { const int o = mt * 1024 + ks * 32;
                wf[mt][ks] = *(const bf16x8_t*)(op + o); gf[mt][ks] = *(const bf16x8_t*)(op + 4096 + o);
                kf[mt][ks] = *(const bf16x8_t*)(op + 2 * 4096 + o); tf[mt][ks] = *(const bf16x8_t*)(op + 3 * 4096 + o); } }
        const bf16x8_t sb0 = pack_b(S[0], S[1]), sb1 = pack_b(S[2], S[3]);
        f32x4 o[4];
#pragma unroll
        for (int mt = 0; mt < 4; ++mt) {
            vn[mt] = __builtin_amdgcn_mfma_f32_16x16x32_bf16(wf[mt][0], sb0, vn[mt], 0, 0, 0);
            vn[mt] = __builtin_amdgcn_mfma_f32_16x16x32_bf16(wf[mt][1], sb1, vn[mt], 0, 0, 0);
            o[mt] = __builtin_amdgcn_mfma_f32_16x16x32_bf16(gf[mt][0], sb0, (f32x4){0.f, 0.f, 0.f, 0.f}, 0, 0, 0);
            o[mt] = __builtin_amdgcn_mfma_f32_16x16x32_bf16(gf[mt][1], sb1, o[mt], 0, 0, 0);
        }
        const bf16x8_t vb0 = pack_b(vn[0], vn[1]), vb1 = pack_b(vn[2], vn[3]);
#pragma unroll
        for (int mt = 0; mt < 4; ++mt) {
            o[mt] = __builtin_amdgcn_mfma_f32_16x16x32_bf16(kf[mt][0], vb0, o[mt], 0, 0, 0);
            if (mt >= 2) o[mt] = __builtin_amdgcn_mfma_f32_16x16x32_bf16(kf[mt][1], vb1, o[mt], 0, 0, 0);
            S[mt] = S[mt] * eg;
            S[mt] = __builtin_amdgcn_mfma_f32_16x16x32_bf16(tf[mt][0], vb0, S[mt], 0, 0, 0);
            S[mt] = __builtin_amdgcn_mfma_f32_16x16x32_bf16(tf[mt][1], vb1, S[mt], 0, 0, 0);
        }
        bf16_t* yo = p->yc + ((size_t)b * SEQ + ch * 64) * 1536 + h * 64 + n0;
#pragma unroll
        for (int mt = 0; mt < 4; ++mt)
#pragma unroll
            for (int e = 0; e < 4; e += 2) st_rows2(yo + (size_t)(16 * mt + 4 * q + e) * 1536, yo + (size_t)(16 * mt + 4 * q + e + 1) * 1536, (unsigned)n, o[mt][e], o[mt][e + 1], (lane & 1) == 0);
    }
    float* so = p->out + O_PDELTA + (((size_t)l * 8 + b) * 8 + h) * 4096 + n0 + n;
#pragma unroll
    for (int t = 0; t < 4; ++t)
#pragma unroll
        for (int e = 0; e < 4; ++e) so[(16 * t + 4 * q + e) * 64] = S[t][e];
}
__device__ __forceinline__ void ph_delta_fin(KP p, int l) {
    int tid_o = threadIdx.x; asm volatile("" : "+v"(tid_o)); int lane = tid_o & 63, wave = tid_o >> 6;
    const int h = lane >> 3, d0 = (lane & 7) * 8;
    for (int t = blockIdx.x * 8 + wave; t < TP; t += gridDim.x * 8) {
        bf16_t* yp = p->yc + (size_t)t * 1536 + h * 64 + d0; const u32x4 raw = *(const u32x4*)yp; const u32x4 gz = *(const u32x4*)(p->H + (size_t)t * IN_WP + C_ZDN + h * 64 + d0);
        float v[8]; v[0] = __uint_as_float(raw.x << 16); v[1] = __uint_as_float(raw.x & 0xffff0000u); v[2] = __uint_as_float(raw.y << 16); v[3] = __uint_as_float(raw.y & 0xffff0000u);
        v[4] = __uint_as_float(raw.z << 16); v[5] = __uint_as_float(raw.z & 0xffff0000u); v[6] = __uint_as_float(raw.w << 16); v[7] = __uint_as_float(raw.w & 0xffff0000u);
        float z[8]; z[0] = __uint_as_float(gz.x << 16); z[1] = __uint_as_float(gz.x & 0xffff0000u); z[2] = __uint_as_float(gz.y << 16); z[3] = __uint_as_float(gz.y & 0xffff0000u);
        z[4] = __uint_as_float(gz.z << 16); z[5] = __uint_as_float(gz.z & 0xffff0000u); z[6] = __uint_as_float(gz.w << 16); z[7] = __uint_as_float(gz.w & 0xffff0000u);
        float ss = 0.f;
#pragma unroll
        for (int e = 0; e < 8; ++e) ss += v[e] * v[e];
        ss += __shfl_xor(ss, 1); ss += __shfl_xor(ss, 2); ss += __shfl_xor(ss, 4);
        const float rs = rsqrtf(ss * (1.0f / 64.0f) + EPS);
#pragma unroll
        for (int e = 0; e < 8; ++e) v[e] = v[e] * rs * p->dn_norm_g[l * 64 + d0 + e] * z[e];
        u32x4 w; w.x = pg8::cvt_pk_bf16(v[0], v[1]); w.y = pg8::cvt_pk_bf16(v[2], v[3]); w.z = pg8::cvt_pk_bf16(v[4], v[5]); w.w = pg8::cvt_pk_bf16(v[6], v[7]);
        *(u32x4*)yp = w;
    }
}

__device__ __forceinline__ void ph_att_waves(KP p, int l) {
    int tid_o = threadIdx.x; asm volatile("" : "+v"(tid_o)); int lane = tid_o & 63, wave = tid_o >> 6;
    wave = __builtin_amdgcn_readfirstlane(wave);
    const int G = gridDim.x, NW = G * 8, gw = wave * G + blockIdx.x;
    for (int d = gw; d < 256; d += NW) wu_scan(p, l, d >> 2, d & 3, lane);
    for (int d = NW - 1 - gw; d < 256; d += NW) wu_delta(p, l, 8 + (d >> 3), d & 7, lane);
}
__device__ __forceinline__ void ph_fin(KP p, int l, LAS unsigned char* lds) {
    int tid_o = threadIdx.x; asm volatile("" : "+v"(tid_o)); int lane = tid_o & 63, wave = tid_o >> 6;
    LAS float* ol = (LAS float*)(lds + wave * 1024);
    const float* w_uv = p->w_uv + (size_t)l * 256 * 512;
    const int cq = lane >> 4, d4 = lane & 15;
    for (int u = blockIdx.x * 8 + wave; u < TS * 8; u += gridDim.x * 8) {
        const int ts = u >> 3, h = u & 7, s = ts >> 3, r = (ts & 7) * 8 + h;
        const float* pb = p->part + ((size_t)s * SA_CH * 64 + r) * 258;
        float mc = -1e30f, lc = 0.f;
        if (lane < SA_CH) { mc = pb[(size_t)lane * 64 * 258 + 256]; lc = pb[(size_t)lane * 64 * 258 + 257]; }
        float M = mc;
#pragma unroll
        for (int o = 1; o < 8; o <<= 1) M = fmaxf(M, __shfl_xor(M, o));
        const float wc = lane < SA_CH ? __expf(mc - M) : 0.f; float L = lc * wc;
#pragma unroll
        for (int o = 1; o < 8; o <<= 1) L += __shfl_xor(L, o);
        const float iL = 1.0f / __int_as_float(__builtin_amdgcn_readlane(__float_as_int(L), 0));
        f32x4 acc = (f32x4){0.f, 0.f, 0.f, 0.f};
#pragma unroll
        for (int ch = 0; ch < SA_CH; ++ch) { const float w = __int_as_float(__builtin_amdgcn_readlane(__float_as_int(wc), ch)); const float* pp = pb + (size_t)ch * 64 * 258 + 4 * lane;
            const f32x2 a0 = *(const f32x2*)pp, a1 = *(const f32x2*)(pp + 2); acc[0] += w * a0[0]; acc[1] += w * a0[1]; acc[2] += w * a1[0]; acc[3] += w * a1[1]; }
        *(LAS f32x4*)(ol + 4 * lane) = acc * iL;
        asm volatile("s_waitcnt lgkmcnt(0)" ::: "memory");
        f32x4 o = (f32x4){0.f, 0.f, 0.f, 0.f}; const float* wp = w_uv + (size_t)(cq * 64) * 512 + h * 64 + 4 * d4;
#pragma unroll 16
        for (int c = 0; c < 64; ++c) { const f32x4 wv = *(const f32x4*)(wp + (size_t)c * 512); const float x = ol[cq * 64 + c]; o += wv * x; }
#pragma unroll
        for (int e = 0; e < 4; ++e) { o[e] += __shfl_xor(o[e], 16); o[e] += __shfl_xor(o[e], 32); }
        if (cq == 0) { const int t = TP + ts; const u32x2 gz = *(const u32x2*)(p->H + (size_t)t * IN_WP + C_ZMLA + h * 64 + 4 * d4);
            u32x2 w; w.x = pg8::cvt_pk_bf16(o[0] * __uint_as_float(gz.x << 16), o[1] * __uint_as_float(gz.x & 0xffff0000u)); w.y = pg8::cvt_pk_bf16(o[2] * __uint_as_float(gz.y << 16), o[3] * __uint_as_float(gz.y & 0xffff0000u));
            *(u32x2*)(p->yb + (size_t)t * 1536 + h * 64 + 4 * d4) = w; }
        asm volatile("s_waitcnt lgkmcnt(0)" ::: "memory");
    }
}

constexpr int SA_QS = 592, SA_KS = 592, SA_PS = 272;
constexpr int SA_OFF_Q = 0, SA_OFF_K = 64 * SA_QS, SA_OFF_P = SA_OFF_K + 128 * SA_KS, SA_OFF_M = SA_OFF_P + 64 * SA_PS, SA_OFF_L = SA_OFF_M + 1024, SA_LDS = SA_OFF_L + 1024;
typedef short s16x4 __attribute__((ext_vector_type(4)));
__device__ __forceinline__ void sa_unit(KP p, int l, int s, int ch, LAS unsigned char* lds, int tid) {
    const int lane = tid & 63, wave = __builtin_amdgcn_readfirstlane(tid >> 6), r = lane & 31, hh = lane >> 5;
    const int qb = wave & 1, kb = wave >> 1, cg = wave >> 1;
    LAS unsigned char* Qs = lds + SA_OFF_Q; LAS unsigned char* Kt = lds + SA_OFF_K; LAS unsigned char* Pt = lds + SA_OFF_P;
    LAS float* mloc = (LAS float*)(lds + SA_OFF_M); LAS float* lred = (LAS float*)(lds + SA_OFF_L);
    __syncthreads();
    { const float* w_uk = p->w_uk + (size_t)l * 256 * 512; const bf16_t* Qg = p->Q + (size_t)(TP + s * 8) * 768;
      const int c = tid & 255, h2 = tid >> 8;
      for (int h = h2 * 4; h < h2 * 4 + 4; ++h) { float acc[8];
#pragma unroll
          for (int i = 0; i < 8; ++i) acc[i] = 0.f;
          const float* wr_ = w_uk + (size_t)c * 512 + h * 64;
          for (int d = 0; d < 64; d += 4) { const f32x4 wv = *(const f32x4*)(wr_ + d);
#pragma unroll
              for (int i = 0; i < 8; ++i) { const bf16_t* q = Qg + i * 768 + h * 96 + d;
                  acc[i] += bf2f(q[0]) * wv[0] + bf2f(q[1]) * wv[1] + bf2f(q[2]) * wv[2] + bf2f(q[3]) * wv[3]; } }
#pragma unroll
          for (int i = 0; i < 8; ++i) *(LAS bf16_t*)(Qs + (i * 8 + h) * SA_QS + c * 2) = f2bf(acc[i]); }
      for (int e = tid; e < 64 * 32; e += NTHR) { const int rr = e >> 5, j = e & 31; *(LAS bf16_t*)(Qs + rr * SA_QS + (256 + j) * 2) = Qg[(rr >> 3) * 768 + (rr & 7) * 96 + 64 + j]; } }
    const int* pt = p->page_table + s * N_PAGES + ch * 16;
    const float* ckv_base = p->cache_kv + (size_t)l * N_POOL * PAGE * 256; const float* ckr_base = p->cache_kr + (size_t)l * N_POOL * PAGE * 32;
    f32x4 rk[16], rr2[2];
    { const int page = pt[0]; const float* kvp = ckv_base + (size_t)page * PAGE * 256; const float* krp = ckr_base + (size_t)page * PAGE * 32;
#pragma unroll
      for (int i = 0; i < 16; ++i) rk[i] = __builtin_nontemporal_load((const f32x4*)(kvp + (size_t)(tid + 512 * i) * 4));
#pragma unroll
      for (int i = 0; i < 2; ++i) rr2[i] = __builtin_nontemporal_load((const f32x4*)(krp + (size_t)(tid + 512 * i) * 4)); }
    f32x16 o0, o1;
#pragma unroll
    for (int e = 0; e < 16; ++e) { o0[e] = 0.f; o1[e] = 0.f; }
    float m = -1e30f, lw = 0.f;
    const int li = lane & 15, g1 = (lane >> 4) & 1;
    const int trOff = (8 * hh + (li >> 2)) * SA_KS + (16 * g1 + 4 * (li & 3)) * 2;
    const int ntile = ch == 7 ? 17 : 16;
    for (int t = 0; t < ntile; ++t) {
        __syncthreads();
        if (t < 16) {
#pragma unroll
            for (int i = 0; i < 16; ++i) { const int ci = tid + 512 * i, key = ci >> 6, c4 = ci & 63; u32x2 w; w.x = pg8::cvt_pk_bf16(rk[i][0], rk[i][1]); w.y = pg8::cvt_pk_bf16(rk[i][2], rk[i][3]);
                *(LAS u32x2*)(Kt + key * SA_KS + c4 * 8) = w; }
#pragma unroll
            for (int i = 0; i < 2; ++i) { const int ci = tid + 512 * i, key = ci >> 3, c4 = ci & 7; u32x2 w; w.x = pg8::cvt_pk_bf16(rr2[i][0], rr2[i][1]); w.y = pg8::cvt_pk_bf16(rr2[i][2], rr2[i][3]);
                *(LAS u32x2*)(Kt + key * SA_KS + 512 + c4 * 8) = w; }
        } else {
            for (int e = tid; e < 128 * 36; e += NTHR) { const int key = e / 36, c16 = e - key * 36; u32x4 v = (u32x4){0u, 0u, 0u, 0u};
                if (key < 8) v = c16 < 32 ? *(const u32x4*)(p->ckv + ((size_t)TP + s * 8 + key) * 256 + c16 * 8) : *(const u32x4*)(p->Kr + ((size_t)TP + s * 8 + key) * 32 + (c16 - 32) * 8);
                *(LAS u32x4*)(Kt + key * SA_KS + c16 * 16) = v; }
        }
        __syncthreads();
        if (t + 1 < 16) { const int page = pt[t + 1]; const float* kvp = ckv_base + (size_t)page * PAGE * 256; const float* krp = ckr_base + (size_t)page * PAGE * 32;
#pragma unroll
            for (int i = 0; i < 16; ++i) rk[i] = __builtin_nontemporal_load((const f32x4*)(kvp + (size_t)(tid + 512 * i) * 4));
#pragma unroll
            for (int i = 0; i < 2; ++i) rr2[i] = __builtin_nontemporal_load((const f32x4*)(krp + (size_t)(tid + 512 * i) * 4)); }
        f32x16 sa;
#pragma unroll
        for (int e = 0; e < 16; ++e) sa[e] = 0.f;
        { const LAS unsigned char* ka = Kt + (32 * kb + r) * SA_KS + 16 * hh; const LAS unsigned char* qa = Qs + (32 * qb + r) * SA_QS + 16 * hh;
#pragma unroll
          for (int ks = 0; ks < 18; ++ks) sa = __builtin_amdgcn_mfma_f32_32x32x16_bf16(*(const LAS bf16x8_t*)(ka + ks * 32), *(const LAS bf16x8_t*)(qa + ks * 32), sa, 0, 0, 0); }
        if (t == 16) { const int itok = (32 * qb + r) >> 3;
#pragma unroll
            for (int e = 0; e < 16; ++e) { const int key = 32 * kb + (e & 3) + 8 * (e >> 2) + 4 * hh; if (key > itok) sa[e] = -1e30f; } }
        float tm = sa[0];
#pragma unroll
        for (int e = 1; e < 16; ++e) tm = fmaxf(tm, sa[e]);
        tm = fmaxf(tm, __shfl_xor(tm, 32));
        if (hh == 0) mloc[kb * 64 + 32 * qb + r] = tm;
        __syncthreads();
        { const int q = 32 * qb + r; const float tmx = fmaxf(fmaxf(mloc[q], mloc[64 + q]), fmaxf(mloc[128 + q], mloc[192 + q]));
          const float mn = fmaxf(m, tmx), al = __builtin_amdgcn_exp2f((m - mn) * ATT_C), mc = mn * ATT_C; m = mn;
          float ps = 0.f;
#pragma unroll
          for (int e = 0; e < 16; ++e) { sa[e] = __builtin_amdgcn_exp2f(sa[e] * ATT_C - mc); ps += sa[e]; }
          lw = lw * al + ps;
#pragma unroll
          for (int g4 = 0; g4 < 4; ++g4) { u32x2 w; w.x = pg8::cvt_pk_bf16(sa[4 * g4], sa[4 * g4 + 1]); w.y = pg8::cvt_pk_bf16(sa[4 * g4 + 2], sa[4 * g4 + 3]);
              *(LAS u32x2*)(Pt + q * SA_PS + (32 * kb + 8 * g4 + 4 * hh) * 2) = w; }
#pragma unroll
          for (int e = 0; e < 16; ++e) { o0[e] *= al; o1[e] *= al; } }
        __syncthreads();
        { const LAS unsigned char* pa = Pt + (32 * qb + r) * SA_PS + 16 * hh; const LAS unsigned char* va = Kt + trOff + (64 * cg) * 2;
#pragma unroll
          for (int ks = 0; ks < 8; ++ks) { const bf16x8_t pb = *(const LAS bf16x8_t*)(pa + ks * 32);
              union { struct { s16x4 lo, hi; } h; bf16x8_t v; } a0, a1;
              a0.h.lo = __builtin_amdgcn_ds_read_tr16_b64_v4i16((LAS s16x4*)(va + ks * 16 * SA_KS)); a0.h.hi = __builtin_amdgcn_ds_read_tr16_b64_v4i16((LAS s16x4*)(va + ks * 16 * SA_KS + 4 * SA_KS));
              a1.h.lo = __builtin_amdgcn_ds_read_tr16_b64_v4i16((LAS s16x4*)(va + ks * 16 * SA_KS + 64)); a1.h.hi = __builtin_amdgcn_ds_read_tr16_b64_v4i16((LAS s16x4*)(va + ks * 16 * SA_KS + 4 * SA_KS + 64));
              o0 = __builtin_amdgcn_mfma_f32_32x32x16_bf16(a0.v, pb, o0, 0, 0, 0);
              o1 = __builtin_amdgcn_mfma_f32_32x32x16_bf16(a1.v, pb, o1, 0, 0, 0); } }
    }
    lw += __shfl_xor(lw, 32);
    if (hh == 0) lred[kb * 64 + 32 * qb + r] = lw;
    __syncthreads();
    { const int q = 32 * qb + r; float* pp = p->part + (((size_t)s * SA_CH + ch) * 64 + q) * 258;
#pragma unroll
      for (int cb2 = 0; cb2 < 2; ++cb2)
#pragma unroll
          for (int g4 = 0; g4 < 4; ++g4) { const int c = 32 * (2 * cg + cb2) + 8 * g4 + 4 * hh; f32x4 v;
#pragma unroll
              for (int e = 0; e < 4; ++e) v[e] = cb2 == 0 ? o0[4 * g4 + e] : o1[4 * g4 + e];
              *(f32x2*)(pp + c) = (f32x2){v[0], v[1]}; *(f32x2*)(pp + c + 2) = (f32x2){v[2], v[3]}; }
      if (cg == 0 && hh == 0) { pp[256] = m * MLA_SCALE; pp[257] = lred[q] + lred[64 + q] + lred[128 + q] + lred[192 + q]; } }
}
__device__ __forceinline__ void ph_attn_s2(KP p, int l, LAS unsigned char* lds) {
    int tid = threadIdx.x; asm volatile("" : "+v"(tid));
    for (int u = blockIdx.x; u < DEC_BATCH * 8; u += gridDim.x) sa_unit(p, l, u >> 3, u & 7, lds, tid);
    __syncthreads();
}

constexpr int ATT_KS = 208, ATT_VS = 144, ATT_KB = 64 * ATT_KS, ATT_VB = 64 * ATT_VS, ATT_STAGE = ATT_KB + ATT_VB;
__device__ __forceinline__ void attn_unit(KP p, int b, int h, int qblk, LAS unsigned char* lds, int tid, int wave, int lane) {
    const int r = lane & 31, hh = lane >> 5;
    const int q0 = qblk * 256 + wave * 32;
    const size_t trow0 = (size_t)b * SEQ;
    bf16x8_t qf[6];
    { const bf16_t* qp = p->Q + (trow0 + q0 + r) * 768 + h * 96 + 8 * hh;
#pragma unroll
      for (int ks = 0; ks < 6; ++ks) qf[ks] = *(const bf16x8_t*)(qp + 16 * ks); }
    f32x16 o0, o1;
#pragma unroll
    for (int e = 0; e < 16; ++e) { o0[e] = 0.f; o1[e] = 0.f; }
    float m = -1e30f, lsum = 0.f;
    const int ntile = qblk * 4 + 4;
    const int cA = tid, keyA = cA / 12, partA = cA - keyA * 12; const int cB = 512 + (tid & 255), keyB = cB / 12, partB = cB - keyB * 12; const bool hasB = tid < 256;
    const bf16_t* gA = partA < 8 ? p->Kn + (trow0 + keyA) * 512 + h * 64 + partA * 8 : p->Kr + (trow0 + keyA) * 32 + (partA - 8) * 8; const int stepA = partA < 8 ? 64 * 512 : 64 * 32;
    const bf16_t* gB = partB < 8 ? p->Kn + (trow0 + keyB) * 512 + h * 64 + partB * 8 : p->Kr + (trow0 + keyB) * 32 + (partB - 8) * 8; const int stepB = partB < 8 ? 64 * 512 : 64 * 32;
    const bf16_t* gV = p->Vt + (size_t)(h * 64 + (tid >> 3)) * TP + trow0 + (tid & 7) * 8;
    const int lA = keyA * ATT_KS + partA * 16, lB = keyB * ATT_KS + partB * 16, lV = ATT_KB + (tid >> 3) * ATT_VS + (tid & 7) * 16;
    const int pr_ = (r & 0x13) | ((r & 4) << 1) | ((r & 8) >> 1);
    const int kOff = pr_ * ATT_KS + 16 * hh, vOff = ATT_KB + r * ATT_VS + 16 * hh;
    u32x4 rA = *(const u32x4*)gA, rB = hasB ? *(const u32x4*)gB : (u32x4){0u, 0u, 0u, 0u}, rV = *(const u32x4*)gV;
    for (int kt = 0; kt < ntile; ++kt) {
        LAS unsigned char* st = lds + (kt & 1) * ATT_STAGE;
        *(LAS u32x4*)(st + lA) = rA; if (hasB) *(LAS u32x4*)(st + lB) = rB; *(LAS u32x4*)(st + lV) = rV;
        __syncthreads();
        if (kt + 1 < ntile) { gA += stepA; gB += stepB; gV += 64; rA = *(const u32x4*)gA; if (hasB) rB = *(const u32x4*)gB; rV = *(const u32x4*)gV; }
        if (kt * 64 <= q0 + 31) {
            f32x16 s0, s1;
#pragma unroll
            for (int e = 0; e < 16; ++e) { s0[e] = 0.f; s1[e] = 0.f; }
#pragma unroll
            for (int ks = 0; ks < 6; ++ks) {
                const bf16x8_t a0 = *(const LAS bf16x8_t*)(st + kOff + ks * 32), a1 = *(const LAS bf16x8_t*)(st + kOff + 32 * ATT_KS + ks * 32);
                s0 = __builtin_amdgcn_mfma_f32_32x32x16_bf16(a0, qf[ks], s0, 0, 0, 0);
                s1 = __builtin_amdgcn_mfma_f32_32x32x16_bf16(a1, qf[ks], s1, 0, 0, 0);
            }
            if (kt * 64 + 63 > q0) {
                const int qrel = q0 + r - kt * 64;
#pragma unroll
                for (int e = 0; e < 16; ++e) { const int kl = (e & 3) + 4 * ((e >> 2) & 1) + 8 * hh + 16 * ((e >> 3) & 1);
                    if (kl > qrel) s0[e] = -1e30f; if (kl + 32 > qrel) s1[e] = -1e30f; }
            }
            float tm = fmaxf(s0[0], s1[0]);
#pragma unroll
            for (int e = 1; e < 16; ++e) tm = fmaxf(tm, fmaxf(s0[e], s1[e]));
            tm = fmaxf(tm, __shfl_xor(tm, 32));
            const float mn = fmaxf(m, tm), al = __builtin_amdgcn_exp2f((m - mn) * ATT_C), mc = mn * ATT_C; m = mn;
            float ps = 0.f;
#pragma unroll
            for (int e = 0; e < 16; ++e) { s0[e] = __builtin_amdgcn_exp2f(s0[e] * ATT_C - mc); s1[e] = __builtin_amdgcn_exp2f(s1[e] * ATT_C - mc); ps += s0[e] + s1[e]; }
            lsum = lsum * al + ps;
#pragma unroll
            for (int e = 0; e < 16; ++e) { o0[e] *= al; o1[e] *= al; }
#pragma unroll
            for (int kb = 0; kb < 2; ++kb)
#pragma unroll
                for (int sp = 0; sp < 2; ++sp) {
                    union { u32x4 u; bf16x8_t v; } pb;
                    if (kb == 0) { pb.u.x = pg8::cvt_pk_bf16(s0[8 * sp + 0], s0[8 * sp + 1]); pb.u.y = pg8::cvt_pk_bf16(s0[8 * sp + 2], s0[8 * sp + 3]); pb.u.z = pg8::cvt_pk_bf16(s0[8 * sp + 4], s0[8 * sp + 5]); pb.u.w = pg8::cvt_pk_bf16(s0[8 * sp + 6], s0[8 * sp + 7]); }
                    else         { pb.u.x = pg8::cvt_pk_bf16(s1[8 * sp + 0], s1[8 * sp + 1]); pb.u.y = pg8::cvt_pk_bf16(s1[8 * sp + 2], s1[8 * sp + 3]); pb.u.z = pg8::cvt_pk_bf16(s1[8 * sp + 4], s1[8 * sp + 5]); pb.u.w = pg8::cvt_pk_bf16(s1[8 * sp + 6], s1[8 * sp + 7]); }
                    const int ko = (32 * kb + 16 * sp) * 2;
                    const bf16x8_t v0 = *(const LAS bf16x8_t*)(st + vOff + ko), v1 = *(const LAS bf16x8_t*)(st + vOff + 32 * ATT_VS + ko);
                    o0 = __builtin_amdgcn_mfma_f32_32x32x16_bf16(v0, pb.v, o0, 0, 0, 0);
                    o1 = __builtin_amdgcn_mfma_f32_32x32x16_bf16(v1, pb.v, o1, 0, 0, 0);
                }
        }
    }
    lsum += __shfl_xor(lsum, 32);
    const float il = 1.0f / lsum;
    const size_t t = trow0 + q0 + r;
#pragma unroll
    for (int db = 0; db < 2; ++db)
#pragma unroll
        for (int g = 0; g < 4; ++g) { const int d0 = 32 * db + 8 * g + 4 * hh;
            const u32x2 gz = *(const u32x2*)(p->H + t * IN_WP + C_ZMLA + h * 64 + d0);
            float v[4];
#pragma unroll
            for (int e = 0; e < 4; ++e) v[e] = (db == 0 ? o0[4 * g + e] : o1[4 * g + e]) * il;
            v[0] *= __uint_as_float(gz.x << 16); v[1] *= __uint_as_float(gz.x & 0xffff0000u); v[2] *= __uint_as_float(gz.y << 16); v[3] *= __uint_as_float(gz.y & 0xffff0000u);
            u32x2 w; w.x = pg8::cvt_pk_bf16(v[0], v[1]); w.y = pg8::cvt_pk_bf16(v[2], v[3]);
            *(u32x2*)(p->yb + t * 1536 + h * 64 + d0) = w; }
}
__device__ __forceinline__ void ph_attn_p(KP p, LAS unsigned char* lds) {
    int tid = threadIdx.x; asm volatile("" : "+v"(tid));
    const int lane = tid & 63, wave = __builtin_amdgcn_readfirstlane(tid >> 6);
    for (int pi = blockIdx.x; pi < 256; pi += gridDim.x) {
        const int xcd = pi & 7, k = pi >> 3, bh = xcd * 8 + (k >> 2), pr = k & 3;
        attn_unit(p, bh >> 3, bh & 7, 7 - pr, lds, tid, wave, lane);
        attn_unit(p, bh >> 3, bh & 7, pr, lds, tid, wave, lane);
    }
    __syncthreads();
}
struct MEpiVt { static constexpr bool PERM = true, AFTER_DRAIN = false; static constexpr int SEG = 0; bf16_t* O; int ldc; int pad_;
    __device__ __forceinline__ void operator()(const f32x4 (&acc)[2][2][4][2], const pg8::Unit& u, int wr, int wc, int fr0, int fq0) const {
        int fr = fr0, fq = fq0; asm volatile("" : "+v"(fr), "+v"(fq));
        const int row0 = u.pm * 256 + wr * 64 + fr;
#pragma unroll
        for (int bj = 0; bj < 2; ++bj) { const int col0 = u.pn * 256 + bj * 128 + wc * 32 + 8 * fq;
#pragma unroll
            for (int ai = 0; ai < 2; ++ai)
#pragma unroll
                for (int m = 0; m < 4; ++m) { const int row = row0 + ai * 128 + m * 16; const f32x4 v0 = acc[ai][bj][m][0], v1 = acc[ai][bj][m][1];
                    u32x4 w; w.x = pg8::cvt_pk_bf16(v0[0], v0[1]); w.y = pg8::cvt_pk_bf16(v0[2], v0[3]); w.z = pg8::cvt_pk_bf16(v1[0], v1[1]); w.w = pg8::cvt_pk_bf16(v1[2], v1[3]);
                    *(u32x4*)(O + (size_t)row * ldc + col0) = w; } }
    } };


__global__ void __launch_bounds__(NTHR, 2) k_mega(Params p_unused) {
    const KP kp0 = (KP)__builtin_amdgcn_kernarg_segment_ptr();
#define PP() ({ KP q_ = kp0; asm volatile("" : "+s"(q_)); q_; })
    KP p = PP();
    extern __shared__ __attribute__((aligned(16))) unsigned char lds_raw[];
    LAS unsigned char* lds = (LAS unsigned char*)lds_raw;
    volatile LAS unsigned* misc = (volatile LAS unsigned*)(lds + LDS_MISC);
    for (int u = threadIdx.x; u < 64; u += NTHR) misc[u] = 0u;
    __syncthreads();
    const int lo = p->ph_lo, hi = p->ph_hi;
    XcdBarrier bar; bar.bar = p->bar + p->li * XCD_BAR_WORDS; bar.x = 0; bar.st = nullptr;
    if (hi - lo > 1) bar = xcd_barrier_post(p->bar + p->li * XCD_BAR_WORDS, misc + 8);
#define IN(k) (lo <= (k) && (k) < hi)
#define SEAM(k) do { if (IN(k) && IN((k) + 1)) xcd_barrier(bar); } while (0)

    if (IN(PH_PRO)) {
        LAS float* tile = (LAS float*)lds;
        for (int l = 0; l < 2; ++l) {
            KP p = PP();
            ph_tr(p->w_in + (size_t)l * 1024 * IN_W, p->WinT + (size_t)l * IN_WP * 1024, 1024, IN_W, IN_WP, tile, 0);
            ph_tr(p->w_uq + (size_t)l * 384 * 768, p->WuqT + (size_t)l * 768 * 384, 384, 768, 768, tile, 0);
            ph_tr(p->w_uk + (size_t)l * 256 * 512, p->WkvT + (size_t)l * 1024 * 256, 256, 512, 512, tile, 144);
            ph_tr(p->w_uv + (size_t)l * 256 * 512, p->WkvT + (size_t)l * 1024 * 256 + (size_t)512 * 256, 256, 512, 512, tile, 208);
            ph_tr(p->w_br0 + (size_t)l * 512 * 1024, p->WbrT + (size_t)l * 1024 * 1536 + 0 * 512, 512, 1024, 1024, tile, 0, 1536);
            ph_tr(p->w_br1 + (size_t)l * 512 * 1024, p->WbrT + (size_t)l * 1024 * 1536 + 1 * 512, 512, 1024, 1024, tile, 0, 1536);
            ph_tr(p->w_br2 + (size_t)l * 512 * 1024, p->WbrT + (size_t)l * 1024 * 1536 + 2 * 512, 512, 1024, 1024, tile, 0, 1536);
            ph_tr(p->w_out + (size_t)l * 1024 * 1024, p->WoutT + (size_t)l * 1024 * 1024, 1024, 1024, 1024, tile, 0);
            for (int g = 0; g < 4; ++g) ph_tr(p->pool_mix + ((size_t)l * 4 + g) * 128 * 128, p->PmixT + ((size_t)l * 4 + g) * 128 * 128, 128, 128, 128, tile, 64 + 8 * g);
        }
        { KP p = PP(); ph_rope_tab(p->tab); ph_rmsnorm(p->x_prompt, p->x_sample, p->norm_g, p->xn, nullptr, nullptr); }
    }
    SEAM(PH_PRO);
    for (int l = 0; l < 2; ++l) {
        int G = gridDim.x, bid = blockIdx.x; asm volatile("" : "+s"(G), "+s"(bid));
        if (IN(PHID(l, PH_GIN))) { KP p = PP();
            pg8::Gemm g{p->xn, p->WinT + (size_t)l * IN_WP * 1024, TT, IN_WP, 1024, 0}; pg8::StaticOrder S; S.init(TT, IN_WP, G, bid);
            MEpiH E{p->H, p->BA}; pg8::gemm_phase<MEpiH, pg8::StaticOrder, false>(lds, g, S, E, nullptr);
        }
        SEAM(PHID(l, PH_GIN));
        if (IN(PHID(l, PH_TOK))) ph_tok(PP(), l, lds);
        SEAM(PHID(l, PH_TOK));
        if (IN(PHID(l, PH_GQ)) && (PP()->pad & 16)) { KP p = PP();
            pg8::Gemm g{p->cq, p->WuqT + (size_t)l * 768 * 384, TT, 768, 384, 0}; pg8::StaticOrder S; S.init(TT, 768, G, bid);
            MEpiQ E{p->Q, p->tab}; pg8::gemm_phase<MEpiQ, pg8::StaticOrder, false>(lds, g, S, E, nullptr);
        }
        if (IN(PHID(l, PH_GQ)) && (PP()->pad & 32)) { KP p = PP();
            pg8::Gemm g{p->ckv, p->WkvT + (size_t)l * 1024 * 256, TP, 512, 256, 0}; pg8::StaticOrder S; S.init(TP, 512, G / 2, bid < G / 2 ? bid : G);
            MEpiKV E{p->Kn, p->V}; pg8::gemm_phase<MEpiKV, pg8::StaticOrder, false>(lds, g, S, E, nullptr);
        }
        if (IN(PHID(l, PH_GQ)) && (PP()->pad & 32)) { KP p = PP();
            pg8::Gemm g{p->WkvT + (size_t)l * 1024 * 256 + (size_t)512 * 256, p->ckv, 512, TP, 256, 0}; pg8::StaticOrder S; S.init(512, TP, G / 2, bid >= G / 2 ? bid - G / 2 : G);
            MEpiVt E{p->Vt, TP, 0}; pg8::gemm_phase<MEpiVt, pg8::StaticOrder, false>(lds, g, S, E, nullptr);
        }
        if (IN(PHID(l, PH_GQ)) && (PP()->pad & 64)) ph_delta_pre(PP(), lds);
        SEAM(PHID(l, PH_GQ));
        if (IN(PHID(l, PH_ATT))) { const int am = PP()->pad;
            if (am & 1) ph_attn_s2(PP(), l, lds); if (am & 4) ph_attn_p(PP(), lds); if (am & 8) ph_att_waves(PP(), l); }
        SEAM(PHID(l, PH_ATT));
        if (IN(PHID(l, PH_FIN))) { const int fm = PP()->pad; if (fm & 128) ph_fin(PP(), l, lds); if (fm & 256) ph_delta_fin(PP(), l); }
        SEAM(PHID(l, PH_FIN));
        if (IN(PHID(l, PH_MERGE)) && (PP()->pad & 512)) { KP p = PP();
            pg8::Gemm g{p->ya, p->WbrT + (size_t)l * 1024 * 1536, TP, 1024, 512, 1536}; pg8::SegOrder<3> S; S.init(TP, 1024, G, bid);
            MEpiMergeS E{p->H, p->mb}; pg8::gemm_phase<MEpiMergeS, pg8::SegOrder<3>, false>(lds, g, S, E, nullptr);
        }
        if (IN(PHID(l, PH_MERGE)) && (PP()->pad & 1024)) { KP p = PP(); TEpiMerge E{p->H, p->mb}; tail_gemm<3, TEpiMerge>(p->ya + (size_t)TP * 1536, 1536, p->WbrT + (size_t)l * 1024 * 1536, 1536, 1024, E, lds); }
        SEAM(PHID(l, PH_MERGE));
        if (IN(PHID(l, PH_OUT)) && (PP()->pad & 2048)) { KP p = PP();
            const float* xp = l == 0 ? p->x_prompt : p->xres; const float* xs = l == 0 ? p->x_sample : p->xres + (size_t)TP * 1024;
            pg8::Gemm g{p->mb, p->WoutT + (size_t)l * 1024 * 1024, TP, 1024, 1024, 0}; pg8::StaticOrder S; S.init(TP, 1024, G, bid);
            MEpiRes E{xp, xs, p->xres}; pg8::gemm_phase<MEpiRes, pg8::StaticOrder, false>(lds, g, S, E, nullptr);
        }
        if (IN(PHID(l, PH_OUT)) && (PP()->pad & 4096)) { KP p = PP(); TEpiRes E{l == 0 ? p->x_sample : p->xres + (size_t)TP * 1024, p->xres}; tail_gemm<1, TEpiRes>(p->mb + (size_t)TP * 1024, 1024, p->WoutT + (size_t)l * 1024 * 1024, 1024, 1024, E, lds); }
        SEAM(PHID(l, PH_OUT));
        if (IN(PHID(l, PH_NORM))) { KP p = PP();
            if (l == 0) ph_rmsnorm(p->xres, p->xres + (size_t)TP * 1024, p->norm_g + 1024, p->xn, nullptr, nullptr);
            else ph_rmsnorm(p->xres, p->xres + (size_t)TP * 1024, p->final_norm_g, nullptr, p->out + O_YP, p->out + O_YS);
        }
        SEAM(PHID(l, PH_NORM));
    }
#undef IN
#undef SEAM
}

static inline size_t al256(size_t x) { return (x + 255) & ~(size_t)255; }
extern "C" void kernel_launch(void* const* d_in, const int* in_sizes, int n_in, void* d_out, int out_size, void* d_ws, size_t ws_size, hipStream_t stream) {
    static int grid = 0;
    if (grid == 0) {
        int dev = 0, cus = 0; (void)hipGetDevice(&dev); (void)hipDeviceGetAttribute(&cus, hipDeviceAttributeMultiprocessorCount, dev);
        (void)hipFuncSetAttribute((const void*)k_mega, hipFuncAttributeMaxDynamicSharedMemorySize, LDS_BYTES);
        int per_cu = 0; (void)hipOccupancyMaxActiveBlocksPerMultiprocessor(&per_cu, (const void*)k_mega, NTHR, LDS_BYTES); (void)hipGetLastError();
        grid = cus > 0 ? cus : 256;
    }
    Params p{};
    p.x_prompt = (const float*)d_in[0]; p.x_sample = (const float*)d_in[1]; p.cache_kv = (const float*)d_in[2]; p.cache_kr = (const float*)d_in[3];
    p.state_pool = (const float*)d_in[4]; p.state_conv = (const float*)d_in[5]; p.state_delta = (const float*)d_in[6]; p.page_table = (const int*)d_in[7];
    p.norm_g = (const float*)d_in[8]; p.w_in = (const float*)d_in[9]; p.pool_mix = (const float*)d_in[10]; p.pool_scale = (const float*)d_in[11];
    p.q_norm_g = (const float*)d_in[12]; p.w_uq = (const float*)d_in[13]; p.kv_norm_g = (const float*)d_in[14]; p.w_uk = (const float*)d_in[15];
    p.w_uv = (const float*)d_in[16]; p.conv_w = (const float*)d_in[17]; p.a_log = (const float*)d_in[18]; p.dt_bias = (const float*)d_in[19];
    p.dn_norm_g = (const float*)d_in[20]; p.w_br0 = (const float*)d_in[21]; p.w_br1 = (const float*)d_in[22]; p.w_br2 = (const float*)d_in[23];
    p.w_out = (const float*)d_in[24]; p.final_norm_g = (const float*)d_in[25];
    p.out = (float*)d_out;
    char* w = (char*)d_ws; size_t off = 0;
    auto take = [&](size_t bytes) { char* q = w + off; off += al256(bytes); return q; };
    const size_t BAR_BYTES = (size_t)16 * XCD_BAR_WORDS * 4;
    p.bar = (unsigned*)take(BAR_BYTES);
    p.WinT = (bf16_t*)take((size_t)2 * IN_WP * 1024 * 2);
    p.WuqT = (bf16_t*)take((size_t)2 * 768 * 384 * 2);
    p.WkvT = (bf16_t*)take((size_t)2 * 1024 * 256 * 2);
    p.WbrT = (bf16_t*)take((size_t)2 * 3 * 1024 * 512 * 2);
    p.WoutT = (bf16_t*)take((size_t)2 * 1024 * 1024 * 2);
    p.PmixT = (bf16_t*)take((size_t)2 * 4 * 128 * 128 * 2);
    p.tab = (float2*)take((size_t)(SEQ + DEC_SEQ) * 16 * 8);
    p.xres = (float*)take((size_t)TT * 1024 * 4);
    p.xn = (bf16_t*)take((size_t)TT * 1024 * 2);
    p.H = (bf16_t*)take((size_t)TT * IN_WP * 2);
    p.BA = (float*)take((size_t)TT * 16 * 4);
    p.cq = (bf16_t*)take((size_t)TT * 384 * 2);
    p.ckv = (bf16_t*)take((size_t)TT * 256 * 2);
    p.Kr = (bf16_t*)take((size_t)TT * 32 * 2);
    p.Q = (bf16_t*)take((size_t)TT * 768 * 2);
    bf16_t* Qlat = (bf16_t*)take((size_t)TS * 8 * 288 * 2);
    p.Kn = (bf16_t*)take((size_t)TP * 512 * 2);
    p.V = (bf16_t*)take((size_t)TP * 512 * 2);
    p.Vt = (bf16_t*)take((size_t)512 * TP * 2);
    p.qd = (bf16_t*)take((size_t)TT * 512 * 2);
    p.kd = (bf16_t*)take((size_t)TT * 512 * 2);
    p.vd = (bf16_t*)take((size_t)TT * 512 * 2);
    p.bg = (float*)take((size_t)TT * 16 * 4);
    p.ya = (bf16_t*)take((size_t)TT * 1536 * 2); p.yb = p.ya + 512; p.yc = p.ya + 1024;
    p.mf = (float*)take((size_t)TT * 1024 * 4);
    p.mb = (bf16_t*)take((size_t)TT * 1024 * 2);
    p.part = (float*)take((size_t)DEC_BATCH * SA_CH * 64 * 258 * 4);
    p.DOP = (bf16_t*)take((size_t)2048 * 4 * 4096 * 2);
    p.DU = (float*)take((size_t)2048 * 4096 * 4);
    p.DG = (float*)take((size_t)2048 * 4);

    (void)hipMemsetAsync(p.bar, 0, BAR_BYTES, stream);
    p.ph_lo = 0; p.ph_hi = PH_END; p.li = 0; p.pad = 0x7fff;
    hipLaunchKernelGGL(k_mega, dim3(grid), dim3(NTHR), LDS_BYTES, stream, p);
#if defined(PROBE_REP) && PROBE_REP > 0
    for (int i = 0; i < PROBE_REP; ++i) { Params q = p; q.ph_lo = PROBE_LO; q.ph_hi = PROBE_HI; q.li = 1 + i; q.pad = PROBE_MASK; hipLaunchKernelGGL(k_mega, dim3(grid), dim3(NTHR), LDS_BYTES, stream, q); }
#endif
}
```

```cpp
#include <hip/hip_runtime.h>
#include <stdint.h>

typedef unsigned short bf16_t;

#define D_MODEL 1024
#define TP 16384
#define TS 256
#define TT (TP + TS)
#define SEQ 2048
#define DEC_SEQ 8
#define DEC_BATCH 32
#define PAST_LEN 16384
#define PAGE 128
#define N_PAGES 128
#define N_POOL 5120
#define IN_W 7344
#define IN_WP 7424
#define C_POOL 0
#define C_ZPOOL 512
#define C_Q 1024
#define C_KV 1408
#define C_KR 1664
#define C_ZMLA 1696
#define C_QKV 2208
#define C_ZDN 3744
#define C_BETA 4256
#define C_ALPHA 4264
#define C_GATE 4272
#define EPS 1e-6f
#define MLA_SCALE 0.10206207261596577f
#define ATT_C 0.14724444831554004f

#define O_YP 0
#define O_YS (O_YP + 16777216)
#define O_PKV (O_YS + 262144)
#define O_PKR (O_PKV + 8388608)
#define O_PPOOL (O_PKR + 1048576)
#define O_PCONV (O_PPOOL + 122880)
#define O_PDELTA (O_PCONV + 73728)
#define O_SKV (O_PDELTA + 524288)
#define O_SKR (O_SKV + 131072)
#define O_SPOOL (O_SKR + 16384)
#define O_SCONV (O_SPOOL + 491520)
#define O_SDELTA (O_SCONV + 294912)
#define O_END (O_SDELTA + 2097152)

__device__ __forceinline__ float bf2f(bf16_t b) { return __uint_as_float(((unsigned)b) << 16); }
__device__ __forceinline__ bf16_t f2bf(float f) { unsigned u = __float_as_uint(f); u += 0x7FFFu + ((u >> 16) & 1u); return (bf16_t)(u >> 16); }
__device__ __forceinline__ float sigmoidf_(float v) { return __builtin_amdgcn_rcpf(1.0f + __builtin_amdgcn_exp2f(-1.4426950408889634f * v)); }
__device__ __forceinline__ float siluf_(float v) { return v * __builtin_amdgcn_rcpf(1.0f + __builtin_amdgcn_exp2f(-1.4426950408889634f * v)); }
__device__ __forceinline__ float wave_sum(float v) {
#pragma unroll
    for (int o = 32; o >= 1; o >>= 1) v += __shfl_xor(v, o);
    return v;
}

#define SA_CH 8
namespace pg8 {
#define PG8_LAS __attribute__((address_space(3)))
typedef unsigned short bf16_t;
typedef short bf16x8 __attribute__((ext_vector_type(8)));
typedef float f32x4 __attribute__((ext_vector_type(4)));
typedef unsigned u32x4 __attribute__((ext_vector_type(4)));
constexpr int BM = 256, BK = 64, HALF = 128, HTB = HALF * BK * 2  , STAGE_BYTES = 8 * HTB, NXCD = 8, WGM = 8;

__host__ __device__ __forceinline__ int lds_byte(int r, int c) { const int st = (r >> 4) * 2 + (c >> 5), rr = r & 15, cc = c & 31, ob = rr * 64 + cc * 2; return st * 1024 + (ob ^ (((ob >> 9) & 1) << 5)); }
__host__ __device__ __forceinline__ void stage_rc(int b, int& R, int& C) { const int st = b / 1024, sb = b % 1024, swz = sb ^ (((sb >> 9) & 1) << 5); R = (st >> 1) * 16 + swz / 64; C = (st & 1) * 32 + (swz % 64) / 2; }
__host__ __device__ __forceinline__ int perm32(int rho) { const int n = rho >> 4, i = rho & 15; return 8 * (i >> 2) + 4 * n + (i & 3); }

struct Unit { int pm, pn, sg; };
struct Gemm { const bf16_t* A; const bf16_t* Bt; int M, N, K; int ld; };

struct StaticOrder {
    int nM, nN, nwg, G, c;
    __host__ __device__ void init(int M, int N, int G_, int c_) { nM = M / BM; nN = N / BM; nwg = nM * nN; G = G_; c = c_; }
    __host__ __device__ bool next(int i, Unit& u) const {
        const long L = (long)i * G + c; if (L >= nwg) return false;
        int wgid = (int)L; { const int q = nwg / NXCD, r = nwg % NXCD, xcd = wgid % NXCD, off = wgid / NXCD; wgid = (xcd < r ? xcd * (q + 1) : r * (q + 1) + (xcd - r) * q) + off; }
        const int nig = WGM * nN, gid = wgid / nig, fm = gid * WGM, gsz = (nM - fm) < WGM ? (nM - fm) : WGM;
        u.pm = fm + ((wgid % nig) % gsz); u.pn = (wgid % nig) / gsz; u.sg = 0; return true;
    }
    __device__ __forceinline__ void a_ready(const Unit&) const {}
    __device__ __forceinline__ void done(const Unit&) const {}
};
template <int NSEG> struct SegOrder : StaticOrder {
    __host__ __device__ bool next(int i, Unit& u) const { const bool ok = StaticOrder::next(i / NSEG, u); u.sg = i % NSEG; return ok; }
};
typedef __bf16 bf16n2 __attribute__((ext_vector_type(2)));
__device__ __forceinline__ unsigned cvt_pk_bf16(float lo, float hi) { typedef float f2_ __attribute__((ext_vector_type(2))); const f2_ v = {lo, hi}; return __builtin_bit_cast(unsigned, __builtin_convertvector(v, bf16n2)); }
typedef float f32x2 __attribute__((ext_vector_type(2)));
template <class Epi, class Sched, bool STAMP = false>
__device__ __forceinline__ void gemm_phase(PG8_LAS unsigned char* lds, const Gemm g, const Sched& S, const Epi& E, unsigned long long* stamps) {
    int tid_ = threadIdx.x; asm volatile("" : "+v"(tid_));
    const int tid = tid_, wid = __builtin_amdgcn_readfirstlane(tid >> 6), lane = tid & 63, wr = wid >> 2, wc = wid & 3, fr = lane & 15, fq = lane >> 4;
    int K_ = g.K; asm volatile("" : "+s"(K_));
    int LD_ = g.ld ? g.ld : g.K; asm volatile("" : "+s"(LD_));
    const int K = K_, nt = K / BK, LD = LD_;
    int ts_lo = 0, ts_hi = 0, nts = 0; const unsigned long long rt_entry = STAMP ? (unsigned long long)wall_clock64() : 0ull;
#define PG8_STAMP() do { if (STAMP && wid == 0 && nts < 64) { const unsigned long long _c = (unsigned long long)clock64(); \
        ts_lo = (lane == nts) ? (int)(unsigned)_c : ts_lo; ts_hi = (lane == nts) ? (int)(unsigned)(_c >> 32) : ts_hi; ++nts; } } while (0)
    PG8_STAMP();
    unsigned voffA[2], voffB[2];
#pragma unroll
    for (int i = 0; i < 2; ++i) { int R, C; stage_rc(tid * 16 + i * 8192, R, C); const int Rb = Epi::PERM ? ((R & ~31) + perm32(R & 31)) : R;
        voffA[i] = (unsigned)(R * LD + C) * 2u; voffB[i] = (unsigned)(Rb * LD + C) * 2u; }
    const size_t kstep = (size_t)(BK * 2);
    const size_t hstep = (size_t)HALF * LD * 2;
    const size_t tstep = 2 * hstep;
    const unsigned ldsw = (unsigned)wid * 1024u;
    const int aoff = lds_byte(wr * 64 + fr, fq * 8), boff = lds_byte(wc * 32 + fr, fq * 8);
#define PG8_SA(b, h) (((b) * 2 + (h)) * HTB)
#define PG8_SB(b, h) ((4 + (b) * 2 + (h)) * HTB)
#define PG8_STAGE(bufoff, gbase, voff) do { _Pragma("unroll") for (int _i = 0; _i < 2; ++_i) \
        __builtin_amdgcn_global_load_lds((const unsigned*)((const char*)(gbase) + (voff)[_i]), (PG8_LAS unsigned*)(lds + (bufoff) + ldsw + _i * 8192), 16, 0, 0); } while (0)
#define PG8_LDA(dst, b, h) do { _Pragma("unroll") for (int m = 0; m < 4; ++m) _Pragma("unroll") for (int k = 0; k < 2; ++k) dst[m][k] = *(const PG8_LAS bf16x8*)(lds + PG8_SA(b, h) + aoff + m * 2048 + k * 1024); } while (0)
#define PG8_LDB(dst, b, h) do { _Pragma("unroll") for (int n = 0; n < 2; ++n) _Pragma("unroll") for (int k = 0; k < 2; ++k) dst[n][k] = *(const PG8_LAS bf16x8*)(lds + PG8_SB(b, h) + boff + n * 2048 + k * 1024); } while (0)
#define PG8_MMA(ai, bj, At, Bt) do { __builtin_amdgcn_s_setprio(1); _Pragma("unroll") for (int m = 0; m < 4; ++m) _Pragma("unroll") for (int n = 0; n < 2; ++n) _Pragma("unroll") for (int k = 0; k < 2; ++k) \
        acc[ai][bj][m][n] = __builtin_amdgcn_mfma_f32_16x16x32_bf16(Bt[n][k], At[m][k], acc[ai][bj][m][n], 0, 0, 0); __builtin_amdgcn_s_setprio(0); } while (0)
#define PG8_WAIT_V(n) asm volatile("s_waitcnt vmcnt(" #n ")" ::: "memory")
#define PG8_WAIT_L(n) asm volatile("s_waitcnt lgkmcnt(" #n ")" ::: "memory")
#define PG8_BAR __builtin_amdgcn_s_barrier()
#define PG8_SCHED __builtin_amdgcn_sched_barrier(0)
    Unit cur, nxt; int ui = 0;
    if (!S.next(0, cur)) return;
    f32x4 acc[2][2][4][2];
#pragma unroll
    for (int a = 0; a < 2; ++a)
#pragma unroll
        for (int b = 0; b < 2; ++b)
#pragma unroll
            for (int m = 0; m < 4; ++m)
#pragma unroll
                for (int n = 0; n < 2; ++n) acc[a][b][m][n] = (f32x4){0.f, 0.f, 0.f, 0.f};
    bf16x8 At[4][2], B0[2][2], B1[2][2];
    const size_t sstep = (size_t)K * 2;
    const char* cA = (const char*)g.A + (size_t)cur.pm * tstep + cur.sg * sstep; const char* cB = (const char*)g.Bt + (size_t)cur.pn * tstep + cur.sg * sstep;
    S.a_ready(cur);
    PG8_STAGE(PG8_SB(0, 0), cB, voffB); PG8_STAGE(PG8_SA(0, 0), cA, voffA); PG8_STAGE(PG8_SB(0, 1), cB + hstep, voffB); PG8_STAGE(PG8_SA(0, 1), cA + hstep, voffA);
    if (wr == 1) PG8_BAR;
    PG8_WAIT_V(4); PG8_BAR;
    PG8_STAGE(PG8_SB(1, 0), cB + kstep, voffB); PG8_STAGE(PG8_SA(1, 0), cA + kstep, voffA); PG8_STAGE(PG8_SB(1, 1), cB + hstep + kstep, voffB);
    PG8_WAIT_V(6); PG8_BAR;
    PG8_STAMP();
    for (;;) {
        const bool has_next = S.next(ui + 1, nxt);
        const char* nA = has_next ? (const char*)g.A + (size_t)nxt.pm * tstep + nxt.sg * sstep : cA; const char* nB = has_next ? (const char*)g.Bt + (size_t)nxt.pn * tstep + nxt.sg * sstep : cB;
_Pragma("nounroll")
        for (int t = 0; t < nt; t += 2) {
            const bool last = (t == nt - 2);
            const char* a1 = cA + (size_t)(t + 1) * kstep;
            const char* a2 = last ? nA : cA + (size_t)(t + 2) * kstep; const char* b2 = last ? nB : cB + (size_t)(t + 2) * kstep;
            const char* a3 = a2 + kstep; const char* b3 = b2 + kstep;
            if (last && has_next) S.a_ready(nxt);
            PG8_LDB(B0, 0, 0); PG8_SCHED; PG8_LDA(At, 0, 0); PG8_STAGE(PG8_SA(1, 1), a1 + hstep, voffA);
            PG8_WAIT_L(8); PG8_BAR; PG8_WAIT_L(0); PG8_MMA(0, 0, At, B0); PG8_BAR; PG8_SCHED;
            PG8_LDB(B1, 0, 1); PG8_STAGE(PG8_SB(0, 0), b2, voffB);
            PG8_BAR; PG8_WAIT_L(0); PG8_MMA(0, 1, At, B1); PG8_BAR;
            PG8_LDA(At, 0, 1); PG8_STAGE(PG8_SA(0, 0), a2, voffA);
            PG8_BAR; PG8_WAIT_L(0); PG8_MMA(1, 0, At, B0); PG8_BAR; PG8_SCHED;
            PG8_STAGE(PG8_SB(0, 1), b2 + hstep, voffB);
            PG8_WAIT_V(6); PG8_BAR; PG8_MMA(1, 1, At, B1); PG8_BAR;
            PG8_LDB(B0, 1, 0); PG8_SCHED; PG8_LDA(At, 1, 0); PG8_STAGE(PG8_SA(0, 1), a2 + hstep, voffA);
            PG8_WAIT_L(8); PG8_BAR; PG8_WAIT_L(0); PG8_MMA(0, 0, At, B0); PG8_BAR; PG8_SCHED;
            PG8_LDB(B1, 1, 1); PG8_STAGE(PG8_SB(1, 0), b3, voffB);
            PG8_BAR; PG8_WAIT_L(0); PG8_MMA(0, 1, At, B1); PG8_BAR;
            PG8_LDA(At, 1, 1); PG8_STAGE(PG8_SA(1, 0), a3, voffA);
            PG8_BAR; PG8_WAIT_L(0); PG8_MMA(1, 0, At, B0); PG8_BAR; PG8_SCHED;
            PG8_STAGE(PG8_SB(1, 1), b3 + hstep, voffB);
            PG8_WAIT_V(6); PG8_BAR; PG8_MMA(1, 1, At, B1); PG8_BAR;
        }
        PG8_STAMP();
        bool fin_ = true; if constexpr (Epi::SEG > 0) fin_ = (cur.sg == Epi::SEG - 1);
        if constexpr (!Epi::AFTER_DRAIN) { if (fin_) { E(acc, cur, wr, wc, fr, fq); S.done(cur); } }
        if constexpr (Epi::SEG > 0) E.mid(acc, cur, wr, wc, fr, fq, fin_ ? 1 : cur.sg + 1, fin_ ? 0.f : 1.f);
        PG8_STAMP();
        if (!has_next) break;
        if constexpr (Epi::SEG == 0)
#pragma unroll
        for (int a = 0; a < 2; ++a)
#pragma unroll
            for (int b = 0; b < 2; ++b)
#pragma unroll
                for (int m = 0; m < 4; ++m)
#pragma unroll
                    for (int n = 0; n < 2; ++n) acc[a][b][m][n] = (f32x4){0.f, 0.f, 0.f, 0.f};
        cur = nxt; cA = nA; cB = nB; ++ui;
    }
    PG8_WAIT_V(0);
    if (wr == 0) PG8_BAR;
    PG8_BAR;
    if constexpr (Epi::AFTER_DRAIN) { E.fused(acc, cur, wr, wc, fr, fq, lds, wid, lane); S.done(cur); }
    PG8_STAMP();
    if (STAMP && wid == 0) { stamps[lane] = lane < nts ? (((unsigned long long)(unsigned)ts_hi << 32) | (unsigned)ts_lo) : 0ull;
        if (lane == 62) stamps[62] = rt_entry; if (lane == 63) stamps[63] = (unsigned long long)wall_clock64(); }
#undef PG8_STAMP
#undef PG8_SA
#undef PG8_SB
#undef PG8_STAGE
#undef PG8_LDA
#undef PG8_LDB
#undef PG8_MMA
#undef PG8_WAIT_V
#undef PG8_WAIT_L
#undef PG8_BAR
#undef PG8_SCHED
}

}
#define XB_TMO      128
#define XB_XCNT(j)  (256  + 64 * (j))
#define XB_XSUB(j)  (1280 + 64 * (j))
#define XB_XGEN(j)  (2304 + 64 * (j))
#define XB_TOP      3328
#define XB_TOPGEN   3392
#define XCD_BAR_WORDS 3456
#define XB_SPIN_CAP (1u << 18)
#define LAS __attribute__((address_space(3)))

__device__ __forceinline__ unsigned xb_ld(unsigned* p)              { return __hip_atomic_load(p, __ATOMIC_RELAXED, __HIP_MEMORY_SCOPE_AGENT); }
__device__ __forceinline__ unsigned xb_add(unsigned* p, unsigned v) { return __hip_atomic_fetch_add(p, v, __ATOMIC_RELAXED, __HIP_MEMORY_SCOPE_AGENT); }
__device__ __forceinline__ unsigned xb_xcc_id() { return (unsigned)__builtin_amdgcn_s_getreg((3 << 11) | 20) & 0xFu; }
#define XB_SPIN(cond, bar) do { unsigned _sp = 0; while (cond) { __builtin_amdgcn_s_sleep(1); \
    if ((++_sp & 255u) == 0u) { if (xb_ld(&(bar)[XB_TMO])) break; if (_sp > XB_SPIN_CAP) { atomicAdd(&(bar)[XB_TMO], 1u); break; } } } } while (0)

struct XcdBarrier {
    unsigned* bar; unsigned x;
    volatile LAS unsigned* st;
};

__device__ __forceinline__ XcdBarrier xcd_barrier_post(unsigned* bar, volatile LAS unsigned* st) {
    XcdBarrier b; b.bar = bar; b.x = xb_xcc_id(); b.st = st;
    if (threadIdx.x == 0) (void)xb_add(&bar[XB_XCNT(b.x)], 1u);
    return b;
}
__device__ __forceinline__ void xcd_barrier_complete(unsigned* bar, unsigned x, unsigned& nloc, unsigned& nx) {
    const unsigned G = gridDim.x * gridDim.y * gridDim.z;
    unsigned sum, cnt, mine, sp = 0u;
    for (;;) {
        sum = 0u; cnt = 0u; mine = 0u;
#pragma unroll
        for (unsigned j = 0; j < 16; ++j) { const unsigned c = xb_ld(&bar[XB_XCNT(j)]); sum += c; cnt += (c > 0u) ? 1u : 0u; mine = (j == x) ? c : mine; }
        if (sum == G) break;
        __builtin_amdgcn_s_sleep(1);
        if ((++sp & 255u) == 0u) { if (xb_ld(&bar[XB_TMO])) break; if (sp > XB_SPIN_CAP) { atomicAdd(&bar[XB_TMO], 1u); break; } }
    }
    nloc = mine > 0u ? mine : 1u; nx = cnt > 0u ? cnt : 1u;
}

__device__ __forceinline__ void xcd_barrier(const XcdBarrier& b) {
    asm volatile("s_waitcnt vmcnt(0)" ::: "memory");
    __syncthreads();
    if (threadIdx.x == 0) {
        unsigned* bar = b.bar;
        __builtin_amdgcn_s_waitcnt(0);
        unsigned nloc = b.st[0], nx = b.st[1];
        if (nloc == 0u) { xcd_barrier_complete(bar, b.x, nloc, nx); b.st[0] = nloc; b.st[1] = nx; }
        const unsigned old = xb_add(&bar[XB_XSUB(b.x)], 1u);
        const unsigned gen = old / nloc;
        if (old + 1u == (gen + 1u) * nloc) {
            __builtin_amdgcn_fence(__ATOMIC_RELEASE, "agent");
            asm volatile("s_waitcnt vmcnt(0)" ::: "memory");
            const unsigned og = xb_add(&bar[XB_TOP], 1u);
            const unsigned tg = og / nx;
            if (og + 1u == (tg + 1u) * nx) xb_add(&bar[XB_TOPGEN], 1u);
            else XB_SPIN(xb_ld(&bar[XB_TOPGEN]) == tg, bar);
            __builtin_amdgcn_fence(__ATOMIC_ACQUIRE, "agent");
            xb_add(&bar[XB_XGEN(b.x)], 1u);
            asm volatile("s_waitcnt vmcnt(0)" ::: "memory");
        } else {
            XB_SPIN(xb_ld(&bar[XB_XGEN(b.x)]) == gen, bar);
            __builtin_amdgcn_fence(__ATOMIC_ACQUIRE, "agent");
            asm volatile("s_waitcnt vmcnt(0)" ::: "memory");
        }
    }
    __syncthreads();
}


#define LAS __attribute__((address_space(3)))
typedef float f32x4 __attribute__((ext_vector_type(4)));
typedef unsigned u32x4 __attribute__((ext_vector_type(4)));
typedef unsigned u32x2 __attribute__((ext_vector_type(2)));
typedef float f32x2 __attribute__((ext_vector_type(2)));
typedef short bf16x8_t __attribute__((ext_vector_type(8)));
typedef float f32x16 __attribute__((ext_vector_type(16)));
constexpr int NTHR = 512;
constexpr int LDS_BYTES = 147456;
constexpr int LDS_MISC = LDS_BYTES - 256;


#if defined(TPROBE)
#define TP_DECL unsigned tp_t0 = 0
#define TP_ON(id) do { if (TPROBE == (id)) tp_t0 = (unsigned)__builtin_amdgcn_s_memrealtime(); } while (0)
#define TP_OFF(id) do { if (TPROBE == (id)) { const unsigned d_ = (unsigned)__builtin_amdgcn_s_memrealtime() - tp_t0; int tq_ = threadIdx.x; asm volatile("" : "+v"(tq_)); if (blockIdx.x == 0 && tq_ == 0) *(volatile LAS unsigned*)(lds + LDS_MISC + 128) += d_; } } while (0)
#define TP_OFFW(id, T) do { if (TPROBE == (id)) { const unsigned d_ = (unsigned)__builtin_amdgcn_s_memrealtime() - tp_t0; int tq_ = threadIdx.x; asm volatile("" : "+v"(tq_)); if (blockIdx.x == 0 && tq_ == (T)) *(volatile LAS unsigned*)(unsigned)(LDS_MISC + 128) += d_; } } while (0)
#define TP_COMMIT(lds_)
#else
#define TP_OFFW(id, T)
#define TP_DECL
#define TP_ON(id)
#define TP_OFF(id)
#define TP_COMMIT(lds_)
#endif
struct Params {
    const float *x_prompt, *x_sample, *cache_kv, *cache_kr, *state_pool, *state_conv, *state_delta; const int* page_table;
    const float *norm_g, *w_in, *pool_mix, *pool_scale, *q_norm_g, *w_uq, *kv_norm_g, *w_uk, *w_uv, *conv_w, *a_log, *dt_bias, *dn_norm_g, *w_br0, *w_br1, *w_br2, *w_out, *final_norm_g;
    float* out;
    bf16_t *WinT, *WuqT, *WkvT, *WbrT, *WoutT, *PmixT, *WukB; float2* tab;
    float* xres; bf16_t* xn; bf16_t* H; float* BA; bf16_t *cq, *ckv, *Kr, *Q, *Kn, *V, *Vt, *qd, *kd, *vd; float* bg; bf16_t *ya, *yb, *yc; float* mf; bf16_t* mb; float* part; bf16_t* DOP; float* DU; float* DG;
    unsigned* bar;
    int ph_lo, ph_hi, li, pad;
};

typedef const __attribute__((address_space(4))) Params* KP;

constexpr int PH_PRO = 0;
constexpr int PH_L = 8;
constexpr int PH_GIN = 0, PH_TOK = 1, PH_GQ = 2, PH_ATT = 3, PH_FIN = 4, PH_MERGE = 5, PH_OUT = 6, PH_NORM = 7;
#define PHID(l, k) (1 + (l) * PH_L + (k))
constexpr int PH_END = 1 + 2 * PH_L;

__device__ __forceinline__ void unpack8(const u32x4 v, float (&f)[8]) {
    f[0] = __uint_as_float(v.x << 16); f[1] = __uint_as_float(v.x & 0xffff0000u); f[2] = __uint_as_float(v.y << 16); f[3] = __uint_as_float(v.y & 0xffff0000u);
    f[4] = __uint_as_float(v.z << 16); f[5] = __uint_as_float(v.z & 0xffff0000u); f[6] = __uint_as_float(v.w << 16); f[7] = __uint_as_float(v.w & 0xffff0000u); }
__device__ __forceinline__ u32x4 pack8(const float (&f)[8]) { u32x4 w; w.x = pg8::cvt_pk_bf16(f[0], f[1]); w.y = pg8::cvt_pk_bf16(f[2], f[3]); w.z = pg8::cvt_pk_bf16(f[4], f[5]); w.w = pg8::cvt_pk_bf16(f[6], f[7]); return w; }
struct MEpiH { static constexpr bool PERM = true, AFTER_DRAIN = false; static constexpr int SEG = 0; bf16_t* H; float* BA;
    __device__ __forceinline__ void operator()(const f32x4 (&acc)[2][2][4][2], const pg8::Unit& u, int wr, int wc, int fr0, int fq0) const {
        int fr = fr0, fq = fq0; asm volatile("" : "+v"(fr), "+v"(fq));
        const int row0 = u.pm * 256 + wr * 64 + fr;
#pragma unroll
        for (int bj = 0; bj < 2; ++bj) {
            const int wcol = u.pn * 256 + bj * 128 + wc * 32, col0 = wcol + 8 * fq;
            const bool plain = (wcol + 32 <= C_ZPOOL) || (wcol >= C_Q && wcol + 32 <= C_ZMLA) || (wcol >= C_QKV && wcol + 32 <= C_ZDN);
            const int act = ((col0 >= C_ZPOOL && col0 < C_Q) || (col0 >= C_ZMLA && col0 < C_QKV) || (col0 >= C_ZDN && col0 < C_BETA)) ? 1 : (col0 >= C_GATE ? 2 : 0);
            const bool isba = (col0 == C_BETA) || (col0 == C_ALPHA);
#pragma unroll
            for (int ai = 0; ai < 2; ++ai)
#pragma unroll
                for (int m = 0; m < 4; ++m) { const int row = row0 + ai * 128 + m * 16; f32x4 v0 = acc[ai][bj][m][0], v1 = acc[ai][bj][m][1];
                    if (!plain) {
                        if (isba) { float* b = BA + (size_t)row * 16 + (col0 - C_BETA); *(f32x4*)b = v0; *(f32x4*)(b + 4) = v1; }
#pragma unroll
                        for (int e = 0; e < 4; ++e) { const float s0 = sigmoidf_(v0[e]), s1 = sigmoidf_(v1[e]);
                            v0[e] = act == 0 ? v0[e] : (act == 1 ? v0[e] * s0 : s0); v1[e] = act == 0 ? v1[e] : (act == 1 ? v1[e] * s1 : s1); }
                    }
                    u32x4 w; w.x = pg8::cvt_pk_bf16(v0[0], v0[1]); w.y = pg8::cvt_pk_bf16(v0[2], v0[3]); w.z = pg8::cvt_pk_bf16(v1[0], v1[1]); w.w = pg8::cvt_pk_bf16(v1[2], v1[3]);
                    *(u32x4*)(H + (size_t)row * IN_WP + col0) = w; }
        }
    } };
struct MEpiQ { static constexpr bool PERM = true, AFTER_DRAIN = false; static constexpr int SEG = 0; bf16_t* Q; const float2* tab;
    __device__ __forceinline__ void operator()(const f32x4 (&acc)[2][2][4][2], const pg8::Unit& u, int wr, int wc, int fr0, int fq0) const {
        int fr = fr0, fq = fq0; asm volatile("" : "+v"(fr), "+v"(fq));
        const int row0 = u.pm * 256 + wr * 64 + fr;
#pragma unroll
        for (int bj = 0; bj < 2; ++bj) {
            const int wcol = u.pn * 256 + bj * 128 + wc * 32, col0 = wcol + 8 * fq;
            const bool rope = (wcol % 96) == 64;
#pragma unroll
            for (int ai = 0; ai < 2; ++ai)
#pragma unroll
                for (int m = 0; m < 4; ++m) { const int row = row0 + ai * 128 + m * 16; f32x4 v0 = acc[ai][bj][m][0], v1 = acc[ai][bj][m][1];
                    if (rope) { const int p = row < TP ? (row & (SEQ - 1)) : SEQ + ((row - TP) & 7); const float2* tp = tab + p * 16 + (fq & 1) * 8; const bool hi = fq >= 2;
#pragma unroll
                        for (int e = 0; e < 4; ++e) { const float o0 = __shfl_xor(v0[e], 32), o1 = __shfl_xor(v1[e], 32); const float2 c0 = tp[e], c1 = tp[4 + e];
                            v0[e] = hi ? (v0[e] * c0.x + o0 * c0.y) : (v0[e] * c0.x - o0 * c0.y); v1[e] = hi ? (v1[e] * c1.x + o1 * c1.y) : (v1[e] * c1.x - o1 * c1.y); } }
                    u32x4 w; w.x = pg8::cvt_pk_bf16(v0[0], v0[1]); w.y = pg8::cvt_pk_bf16(v0[2], v0[3]); w.z = pg8::cvt_pk_bf16(v1[0], v1[1]); w.w = pg8::cvt_pk_bf16(v1[2], v1[3]);
                    *(u32x4*)(Q + (size_t)row * 768 + col0) = w; if (m == 3) asm volatile("" ::: "memory"); }
        }
    } };
struct MEpiKV { static constexpr bool PERM = true, AFTER_DRAIN = false; static constexpr int SEG = 0; bf16_t* Kn; bf16_t* V;
    __device__ __forceinline__ void operator()(const f32x4 (&acc)[2][2][4][2], const pg8::Unit& u, int wr, int wc, int fr0, int fq0) const {
        int fr = fr0, fq = fq0; asm volatile("" : "+v"(fr), "+v"(fq));
        const int row0 = u.pm * 256 + wr * 64 + fr; bf16_t* base = u.pn < 2 ? Kn : V; const int cb = (u.pn & 1) * 256;
#pragma unroll
        for (int bj = 0; bj < 2; ++bj) { const int col0 = cb + bj * 128 + wc * 32 + 8 * fq;
#pragma unroll
            for (int ai = 0; ai < 2; ++ai)
#pragma unroll
                for (int m = 0; m < 4; ++m) { const int row = row0 + ai * 128 + m * 16; const f32x4 v0 = acc[ai][bj][m][0], v1 = acc[ai][bj][m][1];
                    u32x4 w; w.x = pg8::cvt_pk_bf16(v0[0], v0[1]); w.y = pg8::cvt_pk_bf16(v0[2], v0[3]); w.z = pg8::cvt_pk_bf16(v1[0], v1[1]); w.w = pg8::cvt_pk_bf16(v1[2], v1[3]);
                    *(u32x4*)(base + (size_t)row * 512 + col0) = w; } }
    } };
template <int BR> struct MEpiMerge { static constexpr bool PERM = true, AFTER_DRAIN = false; static constexpr int SEG = 0; const bf16_t* H; float* mf; bf16_t* mb;
    __device__ __forceinline__ void operator()(const f32x4 (&acc)[2][2][4][2], const pg8::Unit& u, int wr, int wc, int fr0, int fq0) const {
        int fr = fr0, fq = fq0; asm volatile("" : "+v"(fr), "+v"(fq));
        const int row0 = u.pm * 256 + wr * 64 + fr;
#pragma unroll
        for (int bj = 0; bj < 2; ++bj) { const int col0 = u.pn * 256 + bj * 128 + wc * 32 + 8 * fq;
#pragma unroll
            for (int ai = 0; ai < 2; ++ai)
#pragma unroll
                for (int m = 0; m < 4; ++m) { const int row = row0 + ai * 128 + m * 16; f32x4 v0 = acc[ai][bj][m][0], v1 = acc[ai][bj][m][1];
                    const u32x4 g = *(const u32x4*)(H + (size_t)row * IN_WP + C_GATE + BR * 1024 + col0);
                    v0[0] *= __uint_as_float(g.x << 16); v0[1] *= __uint_as_float(g.x & 0xffff0000u); v0[2] *= __uint_as_float(g.y << 16); v0[3] *= __uint_as_float(g.y & 0xffff0000u);
                    v1[0] *= __uint_as_float(g.z << 16); v1[1] *= __uint_as_float(g.z & 0xffff0000u); v1[2] *= __uint_as_float(g.w << 16); v1[3] *= __uint_as_float(g.w & 0xffff0000u);
                    float* mp = mf + (size_t)row * 1024 + col0;
                    if (BR > 0) { v0 += *(const f32x4*)mp; v1 += *(const f32x4*)(mp + 4); }
                    if (BR < 2) { *(f32x4*)mp = v0; *(f32x4*)(mp + 4) = v1; }
                    else { u32x4 w; w.x = pg8::cvt_pk_bf16(v0[0], v0[1]); w.y = pg8::cvt_pk_bf16(v0[2], v0[3]); w.z = pg8::cvt_pk_bf16(v1[0], v1[1]); w.w = pg8::cvt_pk_bf16(v1[2], v1[3]);
                        *(u32x4*)(mb + (size_t)row * 1024 + col0) = w; } asm volatile("" ::: "memory"); } }
    } };
struct MEpiRes { static constexpr bool PERM = false, AFTER_DRAIN = false; static constexpr int SEG = 0; const float* xp; const float* xs; float* xo;
    __device__ __forceinline__ void operator()(const f32x4 (&acc)[2][2][4][2], const pg8::Unit& u, int wr, int wc, int fr0, int fq0) const {
        int fr = fr0, fq = fq0; asm volatile("" : "+v"(fr), "+v"(fq));
        const int row0 = u.pm * 256 + wr * 64 + fr, col0 = u.pn * 256 + wc * 32 + 4 * fq;
#pragma unroll
        for (int ai = 0; ai < 2; ++ai)
#pragma unroll
            for (int m = 0; m < 4; ++m) { const int row = row0 + ai * 128 + m * 16; const float* xr = row < TP ? xp + (size_t)row * 1024 : xs + (size_t)(row - TP) * 1024; float* orow = xo + (size_t)row * 1024;
#pragma unroll
                for (int bj = 0; bj < 2; ++bj)
#pragma unroll
                    for (int n = 0; n < 2; ++n) { const int c = col0 + bj * 128 + n * 16; *(f32x4*)(orow + c) = *(const f32x4*)(xr + c) + acc[ai][bj][m][n]; } }
    } };

template <int NSEG, class Epi>
__device__ __forceinline__ void tail_gemm(const bf16_t* __restrict__ A, int lda, const bf16_t* __restrict__ Bt, int K, int N, const Epi& epi, LAS unsigned char* lds) {
    int tid = threadIdx.x; asm volatile("" : "+v"(tid));
    const int lane = tid & 63, wave = __builtin_amdgcn_readfirstlane(tid >> 6), rt = wave & 3, kh = wave >> 2, n = lane & 15, q = lane >> 4;
    const int ntile = 4 * (N / 16), kseg = K / NSEG, khalf = kseg / 2;
    LAS f32x4* red = (LAS f32x4*)lds;
    for (int tile = blockIdx.x; tile < ntile; tile += gridDim.x) {
        const int r0 = 64 * (tile & 3) + 16 * rt, c0 = 16 * (tile >> 2);
        const bf16_t* ap = A + (size_t)(r0 + n) * lda + 8 * q; const bf16_t* bp = Bt + (size_t)(c0 + n) * K + 8 * q;
        f32x4 acc[NSEG];
#pragma unroll
        for (int sg = 0; sg < NSEG; ++sg) { acc[sg] = (f32x4){0.f, 0.f, 0.f, 0.f};
            const int kb = sg * kseg + kh * khalf;
#pragma unroll 4
            for (int k = 0; k < khalf; k += 32) acc[sg] = __builtin_amdgcn_mfma_f32_16x16x32_bf16(*(const bf16x8_t*)(ap + kb + k), *(const bf16x8_t*)(bp + kb + k), acc[sg], 0, 0, 0); }
        __syncthreads();
        if (kh == 1) {
#pragma unroll
            for (int sg = 0; sg < NSEG; ++sg) red[(rt * NSEG + sg) * 64 + lane] = acc[sg]; }
        __syncthreads();
        if (kh == 0) {
#pragma unroll
            for (int sg = 0; sg < NSEG; ++sg) acc[sg] += red[(rt * NSEG + sg) * 64 + lane];
#pragma unroll
            for (int e = 0; e < 4; ++e) { float v[NSEG];
#pragma unroll
                for (int sg = 0; sg < NSEG; ++sg) v[sg] = acc[sg][e];
                epi(r0 + 4 * q + e, c0 + n, v); } }
    }
    __syncthreads();
}
struct TEpiMerge { const bf16_t* H; bf16_t* mb;
    __device__ __forceinline__ void operator()(int row, int col, const float (&v)[3]) const { const size_t t = (size_t)TP + row; const bf16_t* g = H + t * IN_WP + C_GATE + col;
        mb[t * 1024 + col] = f2bf(bf2f(g[0]) * v[0] + bf2f(g[1024]) * v[1] + bf2f(g[2048]) * v[2]); } };
struct TEpiRes { const float* xs; float* xo;
    __device__ __forceinline__ void operator()(int row, int col, const float (&v)[1]) const { xo[((size_t)TP + row) * 1024 + col] = xs[(size_t)row * 1024 + col] + v[0]; } };
struct MEpiMergeS { static constexpr bool PERM = true, AFTER_DRAIN = false; static constexpr int SEG = 3; const bf16_t* H; bf16_t* mb;
    __device__ __forceinline__ void mid(f32x4 (&acc)[2][2][4][2], const pg8::Unit& u, int wr, int wc, int fr0, int fq0, int seg, float keep) const {
        int fr = fr0, fq = fq0; asm volatile("" : "+v"(fr), "+v"(fq));
        const int row0 = u.pm * 256 + wr * 64 + fr;
#pragma unroll
        for (int bj = 0; bj < 2; ++bj) { const int col0 = u.pn * 256 + bj * 128 + wc * 32 + 8 * fq;
#pragma unroll
            for (int ai = 0; ai < 2; ++ai) {
                u32x4 ga[4], gb[4];
#pragma unroll
                for (int m = 0; m < 4; ++m) { const bf16_t* gp = H + (size_t)(row0 + ai * 128 + m * 16) * IN_WP + C_GATE + (seg - 1) * 1024 + col0; ga[m] = *(const u32x4*)gp; gb[m] = *(const u32x4*)(gp + 1024); }
#pragma unroll
                for (int m = 0; m < 4; ++m) { float a[8], b[8]; unpack8(ga[m], a); unpack8(gb[m], b);
#pragma unroll
                    for (int e = 0; e < 4; ++e) { acc[ai][bj][m][0][e] *= keep * a[e] * __builtin_amdgcn_rcpf(fmaxf(b[e], 1e-30f)); acc[ai][bj][m][1][e] *= keep * a[4 + e] * __builtin_amdgcn_rcpf(fmaxf(b[4 + e], 1e-30f)); } }
                asm volatile("" ::: "memory"); } }
    }
    __device__ __forceinline__ void operator()(const f32x4 (&acc)[2][2][4][2], const pg8::Unit& u, int wr, int wc, int fr0, int fq0) const {
        int fr = fr0, fq = fq0; asm volatile("" : "+v"(fr), "+v"(fq));
        const int row0 = u.pm * 256 + wr * 64 + fr;
#pragma unroll
        for (int bj = 0; bj < 2; ++bj) { const int col0 = u.pn * 256 + bj * 128 + wc * 32 + 8 * fq;
#pragma unroll
            for (int ai = 0; ai < 2; ++ai) {
                u32x4 gg[4];
#pragma unroll
                for (int m = 0; m < 4; ++m) gg[m] = *(const u32x4*)(H + (size_t)(row0 + ai * 128 + m * 16) * IN_WP + C_GATE + 2048 + col0);
#pragma unroll
                for (int m = 0; m < 4; ++m) { const int row = row0 + ai * 128 + m * 16; float g[8]; unpack8(gg[m], g);
                    const f32x4 v0 = acc[ai][bj][m][0], v1 = acc[ai][bj][m][1];
                    u32x4 w; w.x = pg8::cvt_pk_bf16(v0[0] * g[0], v0[1] * g[1]); w.y = pg8::cvt_pk_bf16(v0[2] * g[2], v0[3] * g[3]); w.z = pg8::cvt_pk_bf16(v1[0] * g[4], v1[1] * g[5]); w.w = pg8::cvt_pk_bf16(v1[2] * g[6], v1[3] * g[7]);
                    *(u32x4*)(mb + (size_t)row * 1024 + col0) = w; }
                asm volatile("" ::: "memory"); } }
    } };

__device__ __forceinline__ void ph_tr(const float* __restrict__ src, bf16_t* __restrict__ dst, int K, int N, int Npad, LAS float* tile, int rot, int ldd = 0) {
    if (ldd == 0) ldd = K;
    int tid = threadIdx.x; asm volatile("" : "+v"(tid)); const int G = gridDim.x; const int tn = Npad / 64, tk = K / 32, nt = tn * tk;
    const int first = (blockIdx.x + G - (rot % G)) % G;
    const bool al4 = (N & 3) == 0;
    for (int t = first; t < nt; t += G) {
        const int n0 = (t % tn) * 64, k0 = (t / tn) * 32;
        { const int k = tid >> 4, n4 = (tid & 15) * 4, n = n0 + n4; f32x4 v = (f32x4){0.f, 0.f, 0.f, 0.f};
          const float* sp = src + (size_t)(k0 + k) * N + n;
          if (al4 && n + 3 < N) v = *(const f32x4*)sp; else {
#pragma unroll
              for (int e = 0; e < 4; ++e) if (n + e < N) v[e] = sp[e]; }
#pragma unroll
          for (int e = 0; e < 4; ++e) tile[k * 65 + n4 + e] = v[e]; }
        __syncthreads();
        if (tid < 256) { const int n = tid >> 2, kq = (tid & 3) * 8; float f[8];
#pragma unroll
            for (int j = 0; j < 8; ++j) f[j] = tile[(kq + j) * 65 + n];
            *(u32x4*)(dst + (size_t)(n0 + n) * ldd + k0 + kq) = pack8(f); }
        __syncthreads();
    }
}
__device__ __forceinline__ void ph_rope_tab(float2* tab) {
    for (int idx = blockIdx.x * NTHR + threadIdx.x; idx < (SEQ + DEC_SEQ) * 16; idx += gridDim.x * NTHR) {
        const int p = idx >> 4, i = idx & 15; const int pos = p < SEQ ? p : PAST_LEN + (p - SEQ);
        const float inv = powf(10000.0f, -(float)i / 16.0f); const float ang = (float)pos * inv;
        const double rev = (double)ang * 0.15915494309189533576888; const float f = (float)(rev - floor(rev));
        tab[idx] = make_float2(__builtin_amdgcn_cosf(f), __builtin_amdgcn_sinf(f)); }
}
__device__ __forceinline__ void ph_rmsnorm(const float* __restrict__ xp, const float* __restrict__ xs, const float* __restrict__ g, bf16_t* __restrict__ xn, float* __restrict__ yp, float* __restrict__ ys) {
    int tid_o = threadIdx.x; asm volatile("" : "+v"(tid_o)); int lane = tid_o & 63, wave = tid_o >> 6;
    for (int t = blockIdx.x * 8 + wave; t < TT; t += gridDim.x * 8) {
        const float* x = t < TP ? xp + (size_t)t * 1024 : xs + (size_t)(t - TP) * 1024;
        f32x4 v[4]; float ss = 0.f;
#pragma unroll
        for (int i = 0; i < 4; ++i) { v[i] = *(const f32x4*)(x + i * 256 + lane * 4); ss += v[i][0] * v[i][0] + v[i][1] * v[i][1] + v[i][2] * v[i][2] + v[i][3] * v[i][3]; }
        ss = wave_sum(ss); const float r = rsqrtf(ss * (1.0f / 1024.0f) + EPS);
#pragma unroll
        for (int i = 0; i < 4; ++i) { const int c = i * 256 + lane * 4; const f32x4 gg = *(const f32x4*)(g + c); const f32x4 o = v[i] * r * gg;
            if (xn) { u32x2 w; w.x = pg8::cvt_pk_bf16(o[0], o[1]); w.y = pg8::cvt_pk_bf16(o[2], o[3]); *(u32x2*)(xn + (size_t)t * 1024 + c) = w; }
            else { float* y = t < TP ? yp + (size_t)t * 1024 : ys + (size_t)(t - TP) * 1024; *(f32x4*)(y + c) = o; } }
    }
}

constexpr int TK_RS = 1040;
__device__ __forceinline__ void tok8(KP p, int l, int tbase, int iseq0, bool smp, int sq, int lane) {
    const bf16_t* __restrict__ H = p->H; float* __restrict__ out = p->out;
    { const float* qg = p->q_norm_g + l * 384; const float* kvg = p->kv_norm_g + l * 256;
      u32x4 rq[8], rk[8];
#pragma unroll
      for (int e = 0; e < 8; ++e) { const bf16_t* h = H + (size_t)(tbase + e) * IN_WP;
          rq[e] = lane < 48 ? *(const u32x4*)(h + C_Q + lane * 8) : (u32x4){0u, 0u, 0u, 0u}; rk[e] = lane < 32 ? *(const u32x4*)(h + C_KV + lane * 8) : (u32x4){0u, 0u, 0u, 0u}; }
      f32x4 gq0 = (f32x4){0.f, 0.f, 0.f, 0.f}, gq1 = gq0, gk0 = gq0, gk1 = gq0;
      if (lane < 48) { gq0 = *(const f32x4*)(qg + lane * 8); gq1 = *(const f32x4*)(qg + lane * 8 + 4); }
      if (lane < 32) { gk0 = *(const f32x4*)(kvg + lane * 8); gk1 = *(const f32x4*)(kvg + lane * 8 + 4); }
#pragma unroll
      for (int e = 0; e < 8; ++e) { const int t = tbase + e; float q[8], kv[8]; unpack8(rq[e], q); unpack8(rk[e], kv); float s1 = 0.f, s2 = 0.f;
#pragma unroll
          for (int j = 0; j < 8; ++j) { s1 += q[j] * q[j]; s2 += kv[j] * kv[j]; }
          s1 = wave_sum(s1); s2 = wave_sum(s2); const float r1 = rsqrtf(s1 * (1.0f / 384.0f) + EPS), r2 = rsqrtf(s2 * (1.0f / 256.0f) + EPS);
#pragma unroll
          for (int j = 0; j < 4; ++j) { q[j] *= r1 * gq0[j]; q[4 + j] *= r1 * gq1[j]; kv[j] *= r2 * gk0[j]; kv[4 + j] *= r2 * gk1[j]; }
          if (lane < 48) *(u32x4*)(p->cq + (size_t)t * 384 + lane * 8) = pack8(q);
          if (lane < 32) { float* okv = (smp ? out + O_SKV + ((size_t)l * TS + (t - TP)) * 256 : out + O_PKV + ((size_t)l * TP + t) * 256) + lane * 8;
              *(f32x4*)okv = (f32x4){kv[0], kv[1], kv[2], kv[3]}; *(f32x4*)(okv + 4) = (f32x4){kv[4], kv[5], kv[6], kv[7]};
              *(u32x4*)(p->ckv + (size_t)t * 256 + lane * 8) = pack8(kv); } }
#pragma unroll
      for (int ps = 0; ps < 2; ++ps) { const int e = (lane >> 4) + 4 * ps, j = lane & 15, t = tbase + e; const bf16_t* h = H + (size_t)t * IN_WP;
          const float x1 = bf2f(h[C_KR + j]), x2 = bf2f(h[C_KR + 16 + j]); const float2 cs = p->tab[((smp ? SEQ : 0) + iseq0 + e) * 16 + j];
          const float o1 = x1 * cs.x - x2 * cs.y, o2 = x2 * cs.x + x1 * cs.y; float* okr = smp ? out + O_SKR + ((size_t)l * TS + (t - TP)) * 32 : out + O_PKR + ((size_t)l * TP + t) * 32;
          okr[j] = o1; okr[16 + j] = o2; p->Kr[(size_t)t * 32 + j] = f2bf(o1); p->Kr[(size_t)t * 32 + 16 + j] = f2bf(o2); } }
    { const float* conv_w = p->conv_w + (size_t)l * 4 * 1536; const bool last = smp || (iseq0 == SEQ - 8);
#pragma unroll 1
      for (int pi = 0; pi < 3; ++pi) { const int c0 = (pi * 64 + lane) * 8;
          u32x4 rows[11];
#pragma unroll
          for (int j = 0; j < 11; ++j) { const int u = iseq0 - 3 + j;
              if (u >= 0) rows[j] = *(const u32x4*)(H + (size_t)(tbase - 3 + j) * IN_WP + C_QKV + c0);
              else if (smp) { const float* sc = p->state_conv + (((size_t)l * DEC_BATCH + sq) * 3 + (u + 3)) * 1536 + c0; const f32x4 a = *(const f32x4*)sc, b = *(const f32x4*)(sc + 4);
                  rows[j].x = pg8::cvt_pk_bf16(a[0], a[1]); rows[j].y = pg8::cvt_pk_bf16(a[2], a[3]); rows[j].z = pg8::cvt_pk_bf16(b[0], b[1]); rows[j].w = pg8::cvt_pk_bf16(b[2], b[3]); }
              else rows[j] = (u32x4){0u, 0u, 0u, 0u}; }
          f32x4 w0[4], w1[4];
#pragma unroll
          for (int j = 0; j < 4; ++j) { w0[j] = *(const f32x4*)(conv_w + j * 1536 + c0); w1[j] = *(const f32x4*)(conv_w + j * 1536 + c0 + 4); }
          bf16_t* dst = pi == 0 ? p->qd : (pi == 1 ? p->kd : p->vd);
#pragma unroll
          for (int e = 0; e < 8; ++e) { float y[8];
#pragma unroll
              for (int k = 0; k < 8; ++k) y[k] = 0.f;
#pragma unroll
              for (int j = 0; j < 4; ++j) { float x[8]; unpack8(rows[e + j], x);
#pragma unroll
                  for (int k = 0; k < 4; ++k) { y[k] += x[k] * w0[j][k]; y[4 + k] += x[4 + k] * w1[j][k]; } }
              float ss = 0.f;
#pragma unroll
              for (int k = 0; k < 8; ++k) { y[k] = siluf_(y[k]); ss += y[k] * y[k]; }
              if (pi < 2) { ss += __shfl_xor(ss, 1); ss += __shfl_xor(ss, 2); ss += __shfl_xor(ss, 4); const float rn = rsqrtf(ss + EPS) * (pi == 0 ? 0.125f : 1.0f);
#pragma unroll
                  for (int k = 0; k < 8; ++k) y[k] *= rn; }
              *(u32x4*)(dst + (size_t)(tbase + e) * 512 + lane * 8) = pack8(y); }
          if (last) {
#pragma unroll
              for (int rr = 0; rr < 3; ++rr) { float x[8]; unpack8(rows[8 + rr], x);
                  float* oc = (smp ? out + O_SCONV + (((size_t)l * DEC_BATCH + sq) * 3 + rr) * 1536 : out + O_PCONV + (((size_t)l * 8 + (tbase >> 11)) * 3 + rr) * 1536) + c0;
                  *(f32x4*)oc = (f32x4){x[0], x[1], x[2], x[3]}; *(f32x4*)(oc + 4) = (f32x4){x[4], x[5], x[6], x[7]}; } } } }
    { const int t = tbase + (lane >> 3), hd = lane & 7; const float bb = sigmoidf_(p->BA[(size_t)t * 16 + hd]); const float x = p->BA[(size_t)t * 16 + 8 + hd] + p->dt_bias[l * 8 + hd];
      const float sp = x > 20.f ? x : log1pf(expf(x)); const float gg = -expf(p->a_log[l * 8 + hd]) * sp;
      p->bg[(size_t)t * 16 + hd] = bb; p->bg[(size_t)t * 16 + 8 + hd] = gg; }
}
__device__ __forceinline__ void ph_tok(KP p, int l, LAS unsigned char* lds) {
    int tid = threadIdx.x; asm volatile("" : "+v"(tid)); const int pmask = p->pad;
    const int lane = tid & 63, wave = __builtin_amdgcn_readfirstlane(tid >> 6), r = lane & 31, hh = lane >> 5;
    const bf16_t* __restrict__ H = p->H; float* __restrict__ out = p->out;
    for (int tile = blockIdx.x; tile < TP / 64 + 8; tile += gridDim.x) {
        const bool smp = tile >= TP / 64; const int s0 = smp ? (tile - TP / 64) * 4 : 0;
        const int t0 = smp ? TP + s0 * 8 : tile * 64, i0 = smp ? 0 : (t0 & (SEQ - 1)), b = t0 >> 11;
        __syncthreads();
        if (!smp) {
            u32x4 v[10];
#pragma unroll
            for (int i = 0; i < 10; ++i) { const int c = tid + NTHR * i, row = c >> 6, ch16 = c & 63; v[i] = (u32x4){0u, 0u, 0u, 0u};
                if (c < 79 * 64 && i0 - 15 + row >= 0) v[i] = *(const u32x4*)(H + (size_t)(t0 - 15 + row) * IN_WP + C_POOL + ch16 * 8); }
#pragma unroll
            for (int i = 0; i < 10; ++i) { const int c = tid + NTHR * i, row = c >> 6, ch16 = c & 63; if (c < 79 * 64) *(LAS u32x4*)(lds + row * TK_RS + ch16 * 16) = v[i]; }
        } else {
            for (int c = tid; c < 92 * 64; c += NTHR) { const int row = c >> 6, ch16 = c & 63, sq = row / 23, j = row - sq * 23; u32x4 v;
                if (j >= 15) v = *(const u32x4*)(H + (size_t)(t0 + sq * 8 + (j - 15)) * IN_WP + C_POOL + ch16 * 8);
                else { const float* sp = p->state_pool + (((size_t)l * DEC_BATCH + s0 + sq) * 15 + j) * 512 + ch16 * 8; const f32x4 a = *(const f32x4*)sp, bq = *(const f32x4*)(sp + 4);
                    v.x = pg8::cvt_pk_bf16(a[0], a[1]); v.y = pg8::cvt_pk_bf16(a[2], a[3]); v.z = pg8::cvt_pk_bf16(bq[0], bq[1]); v.w = pg8::cvt_pk_bf16(bq[2], bq[3]);
                    if (j >= 8) { float* so = out + O_SPOOL + (((size_t)l * DEC_BATCH + s0 + sq) * 15 + (j - 8)) * 512 + ch16 * 8; *(f32x4*)so = a; *(f32x4*)(so + 4) = bq; } }
                *(LAS u32x4*)(lds + row * TK_RS + ch16 * 16) = v; }
        }
        __syncthreads();
        if ((pmask & 8192) && !(smp && (wave & 1))) { const int g = wave >> 1, th = wave & 1, w = 2 << g, tk = 32 * th + r;
          const int brow = smp ? (tk >> 3) * 23 + 15 + (tk & 7) : 15 + tk; const float inv = 1.0f / (float)(smp ? w : min(i0 + tk + 1, w));
          const bf16_t* mixT = p->PmixT + ((size_t)l * 4 + g) * 128 * 128;
          f32x16 acc[4];
#pragma unroll
          for (int nt = 0; nt < 4; ++nt)
#pragma unroll
              for (int e = 0; e < 16; ++e) acc[nt][e] = 0.f;
#pragma unroll 2
          for (int ks = 0; ks < 8; ++ks) {
              const LAS unsigned char* base = lds + brow * TK_RS + (128 * g + 16 * ks + 8 * hh) * 2;
              float cur[8], sum[8]; unpack8(*(const LAS u32x4*)base, cur);
#pragma unroll
              for (int e = 0; e < 8; ++e) sum[e] = cur[e];
              for (int k = 1; k < w; ++k) { float x[8]; unpack8(*(const LAS u32x4*)(base - k * TK_RS), x);
#pragma unroll
                  for (int e = 0; e < 8; ++e) sum[e] += x[e]; }
#pragma unroll
              for (int e = 0; e < 8; ++e) sum[e] = sum[e] * inv - cur[e];
              union { u32x4 u; bf16x8_t v; } bfr; bfr.u = pack8(sum);
#pragma unroll
              for (int nt = 0; nt < 4; ++nt) { const bf16x8_t a = *(const bf16x8_t*)(mixT + (size_t)(32 * nt + r) * 128 + 16 * ks + 8 * hh);
                  acc[nt] = __builtin_amdgcn_mfma_f32_32x32x16_bf16(a, bfr.v, acc[nt], 0, 0, 0); } }
          const size_t t = (size_t)t0 + tk; const float* scl = p->pool_scale + l * 512 + 128 * g;
#pragma unroll
          for (int nt = 0; nt < 4; ++nt)
#pragma unroll
              for (int gg = 0; gg < 4; ++gg) { const int dd0 = 32 * nt + 8 * gg + 4 * hh; const u32x2 z = *(const u32x2*)(H + t * IN_WP + C_ZPOOL + 128 * g + dd0); const f32x4 sc = *(const f32x4*)(scl + dd0);
                  float v0 = acc[nt][4 * gg + 0] * sc[0] * __uint_as_float(z.x << 16), v1 = acc[nt][4 * gg + 1] * sc[1] * __uint_as_float(z.x & 0xffff0000u);
                  float v2 = acc[nt][4 * gg + 2] * sc[2] * __uint_as_float(z.y << 16), v3 = acc[nt][4 * gg + 3] * sc[3] * __uint_as_float(z.y & 0xffff0000u);
                  u32x2 o; o.x = pg8::cvt_pk_bf16(v0, v1); o.y = pg8::cvt_pk_bf16(v2, v3); *(u32x2*)(p->ya + t * 1536 + 128 * g + dd0) = o; } }
        if (!smp) { if (i0 == SEQ - 64) { for (int c = tid; c < 15 * 512; c += NTHR) { const int rr = c >> 9, ch = c & 511;
              out[O_PPOOL + (((size_t)l * 8 + b) * 15 + rr) * 512 + ch] = bf2f(*(const LAS bf16_t*)(lds + (15 + 49 + rr) * TK_RS + ch * 2)); } } }
        else { for (int c = tid; c < 4 * 8 * 512; c += NTHR) { const int sq = c >> 12, i = (c >> 9) & 7, ch = c & 511;
              out[O_SPOOL + (((size_t)l * DEC_BATCH + s0 + sq) * 15 + 7 + i) * 512 + ch] = bf2f(*(const LAS bf16_t*)(lds + (sq * 23 + 15 + i) * TK_RS + ch * 2)); } }
        if (pmask & 16384) { if (!smp) tok8(p, l, t0 + wave * 8, i0 + wave * 8, false, 0, lane);
        else if (wave < 4) tok8(p, l, t0 + wave * 8, 0, true, s0 + wave, lane); }
    }
    __syncthreads();
}

__device__ __forceinline__ void wu_delta(KP p, int l, int sq, int h, int dv) {
    int row0, L; float* so; float S[64];
    if (sq < 8) { row0 = sq * SEQ; L = SEQ; so = p->out + O_PDELTA + (((size_t)l * 8 + sq) * 8 + h) * 4096;
#pragma unroll
        for (int k = 0; k < 64; ++k) S[k] = 0.f; }
    else { const int s = sq - 8; row0 = TP + s * 8; L = DEC_SEQ; so = p->out + O_SDELTA + (((size_t)l * DEC_BATCH + s) * 8 + h) * 4096;
        const float* s0 = p->state_delta + (((size_t)l * DEC_BATCH + s) * 8 + h) * 4096;
#pragma unroll
        for (int k = 0; k < 64; ++k) S[k] = s0[k * 64 + dv]; }
    const float gn = p->dn_norm_g[l * 64 + dv];
    for (int i = 0; i < L; ++i) {
        const size_t t = (size_t)row0 + i; const u32x4* kp = (const u32x4*)(p->kd + t * 512 + h * 64); const u32x4* qp = (const u32x4*)(p->qd + t * 512 + h * 64);
        const float b = p->bg[t * 16 + h], a = __expf(p->bg[t * 16 + 8 + h]); const float v = bf2f(p->vd[t * 512 + h * 64 + dv]);
        u32x4 kk[8];
#pragma unroll
        for (int c = 0; c < 8; ++c) kk[c] = kp[c];
        float ks = 0.f;
#pragma unroll
        for (int c = 0; c < 8; ++c)
#pragma unroll
            for (int e = 0; e < 4; ++e) { const unsigned w = kk[c][e]; ks += __uint_as_float(w << 16) * S[c * 8 + 2 * e] + __uint_as_float(w & 0xffff0000u) * S[c * 8 + 2 * e + 1]; }
        const float vn = b * (v - a * ks); float o = 0.f;
#pragma unroll
        for (int c = 0; c < 8; ++c) { const u32x4 qv = qp[c];
#pragma unroll
            for (int e = 0; e < 4; ++e) { const unsigned w = kk[c][e], wq = qv[e]; const int k0 = c * 8 + 2 * e;
                S[k0] = a * S[k0] + __uint_as_float(w << 16) * vn; o += __uint_as_float(wq << 16) * S[k0];
                S[k0 + 1] = a * S[k0 + 1] + __uint_as_float(w & 0xffff0000u) * vn; o += __uint_as_float(wq & 0xffff0000u) * S[k0 + 1]; }
            asm volatile("" ::: "memory"); }
        const float ss = wave_sum(o * o); const float y = o * rsqrtf(ss * (1.0f / 64.0f) + EPS) * gn;
        p->yc[t * 1536 + h * 64 + dv] = f2bf(y * bf2f(p->H[t * IN_WP + C_ZDN + h * 64 + dv]));
    }
#pragma unroll
    for (int k = 0; k < 64; ++k) so[k * 64 + dv] = S[k];
}
__device__ __forceinline__ int sig_inv(int rho) { return (rho & 32) | ((rho & 12) << 1) | ((rho & 16) >> 2) | (rho & 3); }
constexpr int DPRE_LDS = 64 * 64 * 4 + 512;
constexpr int DST = 72;
__device__ __forceinline__ void dpre_flush(const LAS bf16_t* St, bf16_t* gdst, int lane) {
    asm volatile("s_waitcnt lgkmcnt(0)" ::: "memory");
#pragma unroll
    for (int it = 0; it < 8; ++it) { const int row = (lane >> 3) + 8 * it, chunk = lane & 7; *(u32x4*)(gdst + row * 64 + chunk * 8) = *(const LAS u32x4*)(St + row * DST + chunk * 8); }
    asm volatile("s_waitcnt lgkmcnt(0)" ::: "memory");
}
__device__ __forceinline__ void ph_delta_pre(KP p, LAS unsigned char* lds) {
    int tid_o = threadIdx.x; asm volatile("" : "+v"(tid_o)); int lane = tid_o & 63, wave = tid_o >> 6;
    wave = __builtin_amdgcn_readfirstlane(wave);
    LAS float* Am = (LAS float*)(lds + wave * DPRE_LDS); LAS float* gcs = Am + 4096; LAS float* bts = gcs + 64; LAS bf16_t* St = (LAS bf16_t*)Am;
    for (int unit = wave * gridDim.x + blockIdx.x; unit < 2048; unit += gridDim.x * 8) {
        { int t_ = threadIdx.x; asm volatile("" : "+v"(t_)); lane = t_ & 63; }
        const int r = lane & 31, hh = lane >> 5;
        const int bh = unit >> 5, ch = unit & 31, b = bh >> 3, h = bh & 7;
        const size_t t0 = (size_t)b * SEQ + ch * 64;
        bf16_t* op = p->DOP + (size_t)unit * 4 * 4096; float* up = p->DU + (size_t)unit * 4096;
        const bf16_t* kdb = p->kd + t0 * 512 + h * 64; const bf16_t* qdb = p->qd + t0 * 512 + h * 64; const bf16_t* vdb = p->vd + t0 * 512 + h * 64;
        const float* bgb = p->bg + t0 * 16 + h;
        const float beta = bgb[lane * 16]; float gc = bgb[lane * 16 + 8];
#pragma unroll
        for (int d = 1; d < 64; d <<= 1) { const float x = __shfl_up(gc, d); if (lane >= d) gc += x; }
        const float gl = __shfl(gc, 63); const float egc = __expf(gc);
        gcs[lane] = gc; bts[lane] = beta;
        if (lane == 0) p->DG[unit] = __expf(gl);
        bf16x8_t kf[2][4], qf[2][4];
        { const int voff = r * 512 + 8 * hh;
#pragma unroll
          for (int rb = 0; rb < 2; ++rb)
#pragma unroll
            for (int ks = 0; ks < 4; ++ks) { kf[rb][ks] = *(const bf16x8_t*)(kdb + (32 * rb * 512 + 16 * ks) + voff); qf[rb][ks] = *(const bf16x8_t*)(qdb + (32 * rb * 512 + 16 * ks) + voff); } }
        {
#pragma unroll
            for (int rb = 0; rb < 2; ++rb) { const float sc = __expf(gl - __shfl(gc, 32 * rb + r)); const int pos = sig_inv(32 * rb + r);
#pragma unroll
                for (int ks = 0; ks < 4; ++ks)
#pragma unroll
                    for (int jj = 0; jj < 8; ++jj) St[(16 * ks + 8 * hh + jj) * DST + pos] = f2bf(bf2f((bf16_t)kf[rb][ks][jj]) * sc); }
            dpre_flush(St, op + 3 * 4096, lane);
#pragma unroll
            for (int rb = 0; rb < 2; ++rb) { const float sc = __shfl(egc, 32 * rb + r);
#pragma unroll
                for (int ks = 0; ks < 4; ++ks)
#pragma unroll
                    for (int jj = 0; jj < 8; ++jj) St[(32 * rb + r) * DST + sig_inv(16 * ks + 8 * hh + jj)] = f2bf(bf2f((bf16_t)qf[rb][ks][jj]) * sc); }
            dpre_flush(St, op + 1 * 4096, lane);
        }
        float xu[64];
        {
#pragma unroll
            for (int it = 0; it < 8; ++it) { const int row = (lane >> 3) + 8 * it, chunk = lane & 7; *(LAS u32x4*)(St + row * DST + chunk * 8) = *(const u32x4*)(vdb + row * 512 + chunk * 8); }
            asm volatile("s_waitcnt lgkmcnt(0)" ::: "memory");
            const int beta_i = __float_as_int(beta);
#pragma unroll
            for (int i = 0; i < 64; ++i) xu[i] = __int_as_float(__builtin_amdgcn_readlane(beta_i, i)) * bf2f(St[i * DST + lane]);
            asm volatile("s_waitcnt lgkmcnt(0)" ::: "memory");
        }
        {
            const float gcj0 = __shfl(gc, r), gcj1 = __shfl(gc, 32 + r);
            const int p0 = sig_inv(r), p1 = sig_inv(32 + r);
            { f32x16 t00, t10, t11;
#pragma unroll
              for (int e = 0; e < 16; ++e) { t00[e] = 0.f; t10[e] = 0.f; t11[e] = 0.f; }
#pragma unroll
              for (int ks = 0; ks < 4; ++ks) {
                  t00 = __builtin_amdgcn_mfma_f32_32x32x16_bf16(qf[0][ks], kf[0][ks], t00, 0, 0, 0);
                  t10 = __builtin_amdgcn_mfma_f32_32x32x16_bf16(qf[1][ks], kf[0][ks], t10, 0, 0, 0);
                  t11 = __builtin_amdgcn_mfma_f32_32x32x16_bf16(qf[1][ks], kf[1][ks], t11, 0, 0, 0); }
#pragma unroll
              for (int e = 0; e < 16; ++e) { const int il = (e & 3) + 8 * (e >> 2) + 4 * hh;
                  { const int i = il, j = r; St[i * DST + p0] = f2bf(j <= i ? t00[e] * __expf(fminf(gcs[i] - gcj0, 0.f)) : 0.f); St[i * DST + p1] = 0; }
                  { const int i = 32 + il; St[i * DST + p0] = f2bf(t10[e] * __expf(fminf(gcs[i] - gcj0, 0.f))); }
                  { const int i = 32 + il, j = 32 + r; St[i * DST + p1] = f2bf(j <= i ? t11[e] * __expf(fminf(gcs[i] - gcj1, 0.f)) : 0.f); } }
              dpre_flush(St, op + 2 * 4096, lane); }
            { f32x16 t00, t10, t11;
#pragma unroll
              for (int e = 0; e < 16; ++e) { t00[e] = 0.f; t10[e] = 0.f; t11[e] = 0.f; }
#pragma unroll
              for (int ks = 0; ks < 4; ++ks) {
                  t00 = __builtin_amdgcn_mfma_f32_32x32x16_bf16(kf[0][ks], kf[0][ks], t00, 0, 0, 0);
                  t10 = __builtin_amdgcn_mfma_f32_32x32x16_bf16(kf[1][ks], kf[0][ks], t10, 0, 0, 0);
                  t11 = __builtin_amdgcn_mfma_f32_32x32x16_bf16(kf[1][ks], kf[1][ks], t11, 0, 0, 0); }
#pragma unroll
              for (int e = 0; e < 16; ++e) { const int il = (e & 3) + 8 * (e >> 2) + 4 * hh;
                  { const int i = il, j = r; Am[i * 64 + j] = j < i ? bts[i] * t00[e] * __expf(fminf(gcs[i] - gcj0, 0.f)) : 0.f; }
                  { const int i = 32 + il, j = r; Am[i * 64 + j] = bts[i] * t10[e] * __expf(fminf(gcs[i] - gcj0, 0.f)); }
                  { const int i = 32 + il, j = 32 + r; Am[i * 64 + j] = j < i ? bts[i] * t11[e] * __expf(fminf(gcs[i] - gcj1, 0.f)) : 0.f; } } }
        }
        asm volatile("s_waitcnt lgkmcnt(0)" ::: "memory");
        {
            int c; { int t_ = threadIdx.x; asm volatile("" : "+v"(t_)); c = t_ & 63; } const int pc = sig_inv(c);
            const int beta_i = __float_as_int(beta), egc_i = __float_as_int(egc);
#pragma unroll
            for (int i = 1; i < 64; ++i) { float au = xu[i];
#pragma unroll
                for (int j4 = 0; j4 < i; j4 += 4) { const f32x4 a = *(const LAS f32x4*)(Am + i * 64 + j4);
#pragma unroll
                    for (int e = 0; e < 4; ++e) if (j4 + e < i) au -= a[e] * xu[j4 + e]; }
                xu[i] = au; }
#pragma unroll
            for (int i = 0; i < 64; ++i) (up + i * 64)[c] = xu[i];
            asm volatile("" ::: "memory");
            { float w[64];
#pragma unroll
              for (int i = 0; i < 64; ++i) w[i] = __int_as_float(__builtin_amdgcn_readlane(beta_i, i)) * __int_as_float(__builtin_amdgcn_readlane(egc_i, i)) * bf2f((kdb + i * 512)[c]);
#pragma unroll
              for (int i = 1; i < 64; ++i) { float aw = w[i];
#pragma unroll
                  for (int j4 = 0; j4 < i; j4 += 4) { const f32x4 a = *(const LAS f32x4*)(Am + i * 64 + j4);
#pragma unroll
                      for (int e = 0; e < 4; ++e) if (j4 + e < i) aw -= a[e] * w[j4 + e]; }
                  w[i] = aw; }
              asm volatile("s_waitcnt lgkmcnt(0)" ::: "memory");
#pragma unroll
              for (int i = 0; i < 64; ++i) St[i * DST + pc] = f2bf(-w[i]); }
            dpre_flush(St, op, lane);
        }
    }
}
__device__ __forceinline__ void st_rows2(bf16_t* row0, bf16_t* row1, unsigned pos, float a, float b, bool even) {
    const float x = even ? b : a;
    const float y = __int_as_float(__builtin_amdgcn_mov_dpp(__float_as_int(x), 0xB1, 0xF, 0xF, true));
    const unsigned w = even ? pg8::cvt_pk_bf16(a, y) : pg8::cvt_pk_bf16(y, b);
    bf16_t* dst = even ? row0 + pos : row1 + (pos - 1u);
    *(unsigned*)dst = w;
}
__device__ __forceinline__ bf16x8_t pack_b(const f32x4& lo, const f32x4& hi) { union { u32x4 u; bf16x8_t v; } x;
    x.u.x = pg8::cvt_pk_bf16(lo[0], lo[1]); x.u.y = pg8::cvt_pk_bf16(lo[2], lo[3]); x.u.z = pg8::cvt_pk_bf16(hi[0], hi[1]); x.u.w = pg8::cvt_pk_bf16(hi[2], hi[3]); return x.v; }
__device__ __forceinline__ void wu_scan(KP p, int l, int bh, int slice, int lane) {
    const int n = lane & 15, q = lane >> 4, n0 = slice * 16, b = bh >> 3, h = bh & 7;
    f32x4 S[4];
#pragma unroll
    for (int t = 0; t < 4; ++t) S[t] = (f32x4){0.f, 0.f, 0.f, 0.f};
    const int foff = n * 64 + 8 * q;
    for (int ch = 0; ch < 32; ++ch) {
        const size_t unit = (size_t)bh * 32 + ch;
        const bf16_t* op = p->DOP + unit * 4 * 4096 + foff; const float* up = p->DU + unit * 4096 + n0 + n;
        const float eg = p->DG[unit];
        f32x4 vn[4]; bf16x8_t wf[4][2], gf[4][2], kf[4][2], tf[4][2];
#pragma unroll
        for (int mt = 0; mt < 4; ++mt) {
#pragma unroll
            for (int e = 0; e < 4; ++e) vn[mt][e] = up[(16 * mt + 4 * q + e) * 64];
#pragma unroll
            for (int ks = 0; ks < 2; ++ks) { const int o = mt * 1024 + ks * 32;
                wf[mt][ks] = *(const bf16x8_t*)(op + o); gf[mt][ks] = *(const bf16x8_t*)(op + 4096 + o);
                kf[mt][ks] = *(const bf16x8_t*)(op + 2 * 4096 + o); tf[mt][ks] = *(const bf16x8_t*)(op + 3 * 4096 + o); } }
        const bf16x8_t sb0 = pack_b(S[0], S[1]), sb1 = pack_b(S[2], S[3]);
        f32x4 o[4];
#pragma unroll
        for (int mt = 0; mt < 4; ++mt) {
            vn[mt] = __builtin_amdgcn_mfma_f32_16x16x32_bf16(wf[mt][0], sb0, vn[mt], 0, 0, 0);
            vn[mt] = __builtin_amdgcn_mfma_f32_16x16x32_bf16(wf[mt][1], sb1, vn[mt], 0, 0, 0);
            o[mt] = __builtin_amdgcn_mfma_f32_16x16x32_bf16(gf[mt][0], sb0, (f32x4){0.f, 0.f, 0.f, 0.f}, 0, 0, 0);
            o[mt] = __builtin_amdgcn_mfma_f32_16x16x32_bf16(gf[mt][1], sb1, o[mt], 0, 0, 0);
        }
        const bf16x8_t vb0 = pack_b(vn[0], vn[1]), vb1 = pack_b(vn[2], vn[3]);
#pragma unroll
        for (int mt = 0; mt < 4; ++mt) {
            o[mt] = __builtin_amdgcn_mfma_f32_16x16x32_bf16(kf[mt][0], vb0, o[mt], 0, 0, 0);
            if (mt >= 2) o[mt] = __builtin_amdgcn_mfma_f32_16x16x32_bf16(kf[mt][1], vb1, o[mt], 0, 0, 0);
            S[mt] = S[mt] * eg;
            S[mt] = __builtin_amdgcn_mfma_f32_16x16x32_bf16(tf[mt][0], vb0, S[mt], 0, 0, 0);
            S[mt] = __builtin_amdgcn_mfma_f32_16x16x32_bf16(tf[mt][1], vb1, S[mt], 0, 0, 0);
        }
        bf16_t* yo = p->yc + ((size_t)b * SEQ + ch * 64) * 1536 + h * 64 + n0;
#pragma unroll
        for (int mt = 0; mt < 4; ++mt)
#pragma unroll
            for (int e = 0; e < 4; e += 2) st_rows2(yo + (size_t)(16 * mt + 4 * q + e) * 1536, yo + (size_t)(16 * mt + 4 * q + e + 1) * 1536, (unsigned)n, o[mt][e], o[mt][e + 1], (lane & 1) == 0);
    }
    float* so = p->out + O_PDELTA + (((size_t)l * 8 + b) * 8 + h) * 4096 + n0 + n;
#pragma unroll
    for (int t = 0; t < 4; ++t)
#pragma unroll
        for (int e = 0; e < 4; ++e) so[(16 * t + 4 * q + e) * 64] = S[t][e];
}
__device__ __forceinline__ void ph_delta_fin(KP p, int l) {
    int tid_o = threadIdx.x; asm volatile("" : "+v"(tid_o)); int lane = tid_o & 63, wave = tid_o >> 6;
    const int h = lane >> 3, d0 = (lane & 7) * 8;
    for (int t = blockIdx.x * 8 + wave; t < TP; t += gridDim.x * 8) {
        bf16_t* yp = p->yc + (size_t)t * 1536 + h * 64 + d0; const u32x4 raw = *(const u32x4*)yp; const u32x4 gz = *(const u32x4*)(p->H + (size_t)t * IN_WP + C_ZDN + h * 64 + d0);
        float v[8]; v[0] = __uint_as_float(raw.x << 16); v[1] = __uint_as_float(raw.x & 0xffff0000u); v[2] = __uint_as_float(raw.y << 16); v[3] = __uint_as_float(raw.y & 0xffff0000u);
        v[4] = __uint_as_float(raw.z << 16); v[5] = __uint_as_float(raw.z & 0xffff0000u); v[6] = __uint_as_float(raw.w << 16); v[7] = __uint_as_float(raw.w & 0xffff0000u);
        float z[8]; z[0] = __uint_as_float(gz.x << 16); z[1] = __uint_as_float(gz.x & 0xffff0000u); z[2] = __uint_as_float(gz.y << 16); z[3] = __uint_as_float(gz.y & 0xffff0000u);
        z[4] = __uint_as_float(gz.z << 16); z[5] = __uint_as_float(gz.z & 0xffff0000u); z[6] = __uint_as_float(gz.w << 16); z[7] = __uint_as_float(gz.w & 0xffff0000u);
        float ss = 0.f;
#pragma unroll
        for (int e = 0; e < 8; ++e) ss += v[e] * v[e];
        ss += __shfl_xor(ss, 1); ss += __shfl_xor(ss, 2); ss += __shfl_xor(ss, 4);
        const float rs = rsqrtf(ss * (1.0f / 64.0f) + EPS);
#pragma unroll
        for (int e = 0; e < 8; ++e) v[e] = v[e] * rs * p->dn_norm_g[l * 64 + d0 + e] * z[e];
        u32x4 w; w.x = pg8::cvt_pk_bf16(v[0], v[1]); w.y = pg8::cvt_pk_bf16(v[2], v[3]); w.z = pg8::cvt_pk_bf16(v[4], v[5]); w.w = pg8::cvt_pk_bf16(v[6], v[7]);
        *(u32x4*)yp = w;
    }
}

__device__ __forceinline__ void ph_att_waves(KP p, int l) {
    int tid_o = threadIdx.x; asm volatile("" : "+v"(tid_o)); int lane = tid_o & 63, wave = tid_o >> 6;
    wave = __builtin_amdgcn_readfirstlane(wave);
    const int G = gridDim.x, NW = G * 8, gw = wave * G + blockIdx.x;
    TP_DECL; TP_ON(20); TP_ON(21);
    for (int d = gw; d < 256; d += NW) wu_scan(p, l, d >> 2, d & 3, lane);
    if (wave == 0) TP_OFFW(20, 0);
    for (int d = NW - 1 - gw; d < 256; d += NW) wu_delta(p, l, 8 + (d >> 3), d & 7, lane);
    if (wave == 7) TP_OFFW(21, 448);
}
__device__ __forceinline__ void ph_fin(KP p, int l, LAS unsigned char* lds) {
    int tid_o = threadIdx.x; asm volatile("" : "+v"(tid_o)); int lane = tid_o & 63, wave = tid_o >> 6;
    LAS float* ol = (LAS float*)(lds + wave * 1024);
    const float* w_uv = p->w_uv + (size_t)l * 256 * 512;
    const int cq = lane >> 4, d4 = lane & 15;
    for (int u = blockIdx.x * 8 + wave; u < TS * 8; u += gridDim.x * 8) {
        const int ts = u >> 3, h = u & 7, s = ts >> 3, r = (ts & 7) * 8 + h;
        const float* pb = p->part + ((size_t)s * SA_CH * 64 + r) * 258;
        float mc = -1e30f, lc = 0.f;
        if (lane < SA_CH) { mc = pb[(size_t)lane * 64 * 258 + 256]; lc = pb[(size_t)lane * 64 * 258 + 257]; }
        float M = mc;
#pragma unroll
        for (int o = 1; o < 8; o <<= 1) M = fmaxf(M, __shfl_xor(M, o));
        const float wc = lane < SA_CH ? __expf(mc - M) : 0.f; float L = lc * wc;
#pragma unroll
        for (int o = 1; o < 8; o <<= 1) L += __shfl_xor(L, o);
        const float iL = 1.0f / __int_as_float(__builtin_amdgcn_readlane(__float_as_int(L), 0));
        f32x4 acc = (f32x4){0.f, 0.f, 0.f, 0.f};
#pragma unroll
        for (int ch = 0; ch < SA_CH; ++ch) { const float w = __int_as_float(__builtin_amdgcn_readlane(__float_as_int(wc), ch)); const float* pp = pb + (size_t)ch * 64 * 258 + 4 * lane;
            const f32x2 a0 = *(const f32x2*)pp, a1 = *(const f32x2*)(pp + 2); acc[0] += w * a0[0]; acc[1] += w * a0[1]; acc[2] += w * a1[0]; acc[3] += w * a1[1]; }
        *(LAS f32x4*)(ol + 4 * lane) = acc * iL;
        asm volatile("s_waitcnt lgkmcnt(0)" ::: "memory");
        f32x4 o = (f32x4){0.f, 0.f, 0.f, 0.f}; const float* wp = w_uv + (size_t)(cq * 64) * 512 + h * 64 + 4 * d4;
#pragma unroll 16
        for (int c = 0; c < 64; ++c) { const f32x4 wv = *(const f32x4*)(wp + (size_t)c * 512); const float x = ol[cq * 64 + c]; o += wv * x; }
#pragma unroll
        for (int e = 0; e < 4; ++e) { o[e] += __shfl_xor(o[e], 16); o[e] += __shfl_xor(o[e], 32); }
        if (cq == 0) { const int t = TP + ts; const u32x2 gz = *(const u32x2*)(p->H + (size_t)t * IN_WP + C_ZMLA + h * 64 + 4 * d4);
            u32x2 w; w.x = pg8::cvt_pk_bf16(o[0] * __uint_as_float(gz.x << 16), o[1] * __uint_as_float(gz.x & 0xffff0000u)); w.y = pg8::cvt_pk_bf16(o[2] * __uint_as_float(gz.y << 16), o[3] * __uint_as_float(gz.y & 0xffff0000u));
            *(u32x2*)(p->yb + (size_t)t * 1536 + h * 64 + 4 * d4) = w; }
        asm volatile("s_waitcnt lgkmcnt(0)" ::: "memory");
    }
}

constexpr int SA_QS = 592, SA_KS = 592, SA_PS = 272;
constexpr int SA_OFF_Q = 0, SA_OFF_K = 64 * SA_QS, SA_OFF_P = SA_OFF_K + 128 * SA_KS, SA_OFF_M = SA_OFF_P + 64 * SA_PS, SA_OFF_L = SA_OFF_M + 1024, SA_LDS = SA_OFF_L + 1024;
typedef short s16x4 __attribute__((ext_vector_type(4)));
__device__ __forceinline__ void sa_unit(KP p, int l, int s, int ch, LAS unsigned char* lds, int tid) {
    const int lane = tid & 63, wave = __builtin_amdgcn_readfirstlane(tid >> 6), r = lane & 31, hh = lane >> 5;
    const int qb = wave & 1, kb = wave >> 1, cg = wave >> 1;
    LAS unsigned char* Qs = lds + SA_OFF_Q; LAS unsigned char* Kt = lds + SA_OFF_K; LAS unsigned char* Pt = lds + SA_OFF_P;
    LAS float* mloc = (LAS float*)(lds + SA_OFF_M); LAS float* lred = (LAS float*)(lds + SA_OFF_L);
    TP_DECL; TP_ON(10); TP_ON(11);
    __syncthreads();
    { const bf16_t* wb = p->WukB + (size_t)l * 256 * 512 + (size_t)r * 512 + wave * 64 + 8 * hh; const bf16_t* Qg = p->Q + (size_t)(TP + s * 8) * 768;
      bf16x8_t qv[4];
#pragma unroll
      for (int ks = 0; ks < 4; ++ks) { u32x4 z = (u32x4){0u, 0u, 0u, 0u}; if (r < 8) z = *(const u32x4*)(Qg + r * 768 + wave * 96 + ks * 16 + 8 * hh); union { u32x4 u; bf16x8_t v; } x; x.u = z; qv[ks] = x.v; }
#pragma unroll
      for (int cb = 0; cb < 8; ++cb) { f32x16 acc;
#pragma unroll
          for (int e = 0; e < 16; ++e) acc[e] = 0.f;
#pragma unroll
          for (int ks = 0; ks < 4; ++ks) acc = __builtin_amdgcn_mfma_f32_32x32x16_bf16(*(const bf16x8_t*)(wb + (size_t)(32 * cb) * 512 + ks * 16), qv[ks], acc, 0, 0, 0);
          if (r < 8) {
#pragma unroll
              for (int g4 = 0; g4 < 4; ++g4) { u32x2 w; w.x = pg8::cvt_pk_bf16(acc[4 * g4], acc[4 * g4 + 1]); w.y = pg8::cvt_pk_bf16(acc[4 * g4 + 2], acc[4 * g4 + 3]);
                  *(LAS u32x2*)(Qs + (r * 8 + wave) * SA_QS + (32 * cb + 8 * g4 + 4 * hh) * 2) = w; } } }
      for (int e = tid; e < 64 * 32; e += NTHR) { const int rr = e >> 5, j = e & 31; *(LAS bf16_t*)(Qs + rr * SA_QS + (256 + j) * 2) = Qg[(rr >> 3) * 768 + (rr & 7) * 96 + 64 + j]; } }
    TP_OFF(11);
    const int* pt = p->page_table + s * N_PAGES + ch * 16;
    const float* ckv_base = p->cache_kv + (size_t)l * N_POOL * PAGE * 256; const float* ckr_base = p->cache_kr + (size_t)l * N_POOL * PAGE * 32;
    f32x4 rk[16], rr2[2];
    { const int page = pt[0]; const float* kvp = ckv_base + (size_t)page * PAGE * 256; const float* krp = ckr_base + (size_t)page * PAGE * 32;
#pragma unroll
      for (int i = 0; i < 16; ++i) rk[i] = __builtin_nontemporal_load((const f32x4*)(kvp + (size_t)(tid + 512 * i) * 4));
#pragma unroll
      for (int i = 0; i < 2; ++i) rr2[i] = __builtin_nontemporal_load((const f32x4*)(krp + (size_t)(tid + 512 * i) * 4)); }
    f32x16 o0, o1;
#pragma unroll
    for (int e = 0; e < 16; ++e) { o0[e] = 0.f; o1[e] = 0.f; }
    float m = -1e30f, lw = 0.f;
    const int li = lane & 15, g1 = (lane >> 4) & 1;
    const int trOff = (8 * hh + (li >> 2)) * SA_KS + (16 * g1 + 4 * (li & 3)) * 2;
    const int ntile = ch == 7 ? 17 : 16;
    for (int t = 0; t < ntile; ++t) {
        TP_ON(12); TP_ON(16);
        __syncthreads();
        TP_OFF(16);
        if (t < 16) {
#pragma unroll
            for (int i = 0; i < 16; ++i) { const int ci = tid + 512 * i, key = ci >> 6, c4 = ci & 63; u32x2 w; w.x = pg8::cvt_pk_bf16(rk[i][0], rk[i][1]); w.y = pg8::cvt_pk_bf16(rk[i][2], rk[i][3]);
                *(LAS u32x2*)(Kt + key * SA_KS + c4 * 8) = w; }
#pragma unroll
            for (int i = 0; i < 2; ++i) { const int ci = tid + 512 * i, key = ci >> 3, c4 = ci & 7; u32x2 w; w.x = pg8::cvt_pk_bf16(rr2[i][0], rr2[i][1]); w.y = pg8::cvt_pk_bf16(rr2[i][2], rr2[i][3]);
                *(LAS u32x2*)(Kt + key * SA_KS + 512 + c4 * 8) = w; }
        } else {
            for (int e = tid; e < 128 * 36; e += NTHR) { const int key = e / 36, c16 = e - key * 36; u32x4 v = (u32x4){0u, 0u, 0u, 0u};
                if (key < 8) v = c16 < 32 ? *(const u32x4*)(p->ckv + ((size_t)TP + s * 8 + key) * 256 + c16 * 8) : *(const u32x4*)(p->Kr + ((size_t)TP + s * 8 + key) * 32 + (c16 - 32) * 8);
                *(LAS u32x4*)(Kt + key * SA_KS + c16 * 16) = v; }
        }
        TP_ON(17); __syncthreads(); TP_OFF(17);
        TP_OFF(12); TP_ON(13);
        if (t + 1 < 16) { const int page = pt[t + 1]; const float* kvp = ckv_base + (size_t)page * PAGE * 256; const float* krp = ckr_base + (size_t)page * PAGE * 32;
#pragma unroll
            for (int i = 0; i < 16; ++i) rk[i] = __builtin_nontemporal_load((const f32x4*)(kvp + (size_t)(tid + 512 * i) * 4));
#pragma unroll
            for (int i = 0; i < 2; ++i) rr2[i] = __builtin_nontemporal_load((const f32x4*)(krp + (size_t)(tid + 512 * i) * 4)); }
        f32x16 sa;
#pragma unroll
        for (int e = 0; e < 16; ++e) sa[e] = 0.f;
        { const LAS unsigned char* ka = Kt + (32 * kb + r) * SA_KS + 16 * hh; const LAS unsigned char* qa = Qs + (32 * qb + r) * SA_QS + 16 * hh;
#pragma unroll
          for (int ks = 0; ks < 18; ++ks) sa = __builtin_amdgcn_mfma_f32_32x32x16_bf16(*(const LAS bf16x8_t*)(ka + ks * 32), *(const LAS bf16x8_t*)(qa + ks * 32), sa, 0, 0, 0); }
        if (t == 16) { const int itok = (32 * qb + r) >> 3;
#pragma unroll
            for (int e = 0; e < 16; ++e) { const int key = 32 * kb + (e & 3) + 8 * (e >> 2) + 4 * hh; if (key > itok) sa[e] = -1e30f; } }
        float tm = sa[0];
#pragma unroll
        for (int e = 1; e < 16; ++e) tm = fmaxf(tm, sa[e]);
        tm = fmaxf(tm, __shfl_xor(tm, 32));
        if (hh == 0) mloc[kb * 64 + 32 * qb + r] = tm;
        __syncthreads();
        TP_OFF(13); TP_ON(14);
        { const int q = 32 * qb + r; const float tmx = fmaxf(fmaxf(mloc[q], mloc[64 + q]), fmaxf(mloc[128 + q], mloc[192 + q]));
          const float mn = fmaxf(m, tmx), al = __builtin_amdgcn_exp2f((m - mn) * ATT_C), mc = mn * ATT_C; m = mn;
          float ps = 0.f;
#pragma unroll
          for (int e = 0; e < 16; ++e) { sa[e] = __builtin_amdgcn_exp2f(sa[e] * ATT_C - mc); ps += sa[e]; }
          lw = lw * al + ps;
#pragma unroll
          for (int g4 = 0; g4 < 4; ++g4) { u32x2 w; w.x = pg8::cvt_pk_bf16(sa[4 * g4], sa[4 * g4 + 1]); w.y = pg8::cvt_pk_bf16(sa[4 * g4 + 2], sa[4 * g4 + 3]);
              *(LAS u32x2*)(Pt + q * SA_PS + (32 * kb + 8 * g4 + 4 * hh) * 2) = w; }
#pragma unroll
          for (int e = 0; e < 16; ++e) { o0[e] *= al; o1[e] *= al; } }
        __syncthreads();
        TP_OFF(14); TP_ON(15);
        { const LAS unsigned char* pa = Pt + (32 * qb + r) * SA_PS + 16 * hh; const LAS unsigned char* va = Kt + trOff + (64 * cg) * 2;
#pragma unroll
          for (int ks = 0; ks < 8; ++ks) { const bf16x8_t pb = *(const LAS bf16x8_t*)(pa + ks * 32);
              union { struct { s16x4 lo, hi; } h; bf16x8_t v; } a0, a1;
              a0.h.lo = __builtin_amdgcn_ds_read_tr16_b64_v4i16((LAS s16x4*)(va + ks * 16 * SA_KS)); a0.h.hi = __builtin_amdgcn_ds_read_tr16_b64_v4i16((LAS s16x4*)(va + ks * 16 * SA_KS + 4 * SA_KS));
              a1.h.lo = __builtin_amdgcn_ds_read_tr16_b64_v4i16((LAS s16x4*)(va + ks * 16 * SA_KS + 64)); a1.h.hi = __builtin_amdgcn_ds_read_tr16_b64_v4i16((LAS s16x4*)(va + ks * 16 * SA_KS + 4 * SA_KS + 64));
              o0 = __builtin_amdgcn_mfma_f32_32x32x16_bf16(a0.v, pb, o0, 0, 0, 0);
              o1 = __builtin_amdgcn_mfma_f32_32x32x16_bf16(a1.v, pb, o1, 0, 0, 0); } }
        TP_OFF(15);
    }
    lw += __shfl_xor(lw, 32);
    if (hh == 0) lred[kb * 64 + 32 * qb + r] = lw;
    __syncthreads();
    { const int q = 32 * qb + r; float* pp = p->part + (((size_t)s * SA_CH + ch) * 64 + q) * 258;
#pragma unroll
      for (int cb2 = 0; cb2 < 2; ++cb2)
#pragma unroll
          for (int g4 = 0; g4 < 4; ++g4) { const int c = 32 * (2 * cg + cb2) + 8 * g4 + 4 * hh; f32x4 v;
#pragma unroll
              for (int e = 0; e < 4; ++e) v[e] = cb2 == 0 ? o0[4 * g4 + e] : o1[4 * g4 + e];
              *(f32x2*)(pp + c) = (f32x2){v[0], v[1]}; *(f32x2*)(pp + c + 2) = (f32x2){v[2], v[3]}; }
      if (cg == 0 && hh == 0) { pp[256] = m * MLA_SCALE; pp[257] = lred[q] + lred[64 + q] + lred[128 + q] + lred[192 + q]; } }
    TP_OFF(10);
}
__device__ __forceinline__ void ph_attn_s2(KP p, int l, LAS unsigned char* lds) {
    int tid = threadIdx.x; asm volatile("" : "+v"(tid));
    for (int u = blockIdx.x; u < DEC_BATCH * 8; u += gridDim.x) sa_unit(p, l, u >> 3, u & 7, lds, tid);
    __syncthreads();
}

constexpr int ATT_KS = 208, ATT_VS = 144, ATT_KB = 64 * ATT_KS, ATT_VB = 64 * ATT_VS, ATT_STAGE = ATT_KB + ATT_VB;
__device__ __forceinline__ void attn_unit(KP p, int b, int h, int qblk, LAS unsigned char* lds, int tid, int wave, int lane) {
    const int r = lane & 31, hh = lane >> 5;
    const int q0 = qblk * 256 + wave * 32;
    const size_t trow0 = (size_t)b * SEQ;
    bf16x8_t qf[6];
    { const bf16_t* qp = p->Q + (trow0 + q0 + r) * 768 + h * 96 + 8 * hh;
#pragma unroll
      for (int ks = 0; ks < 6; ++ks) qf[ks] = *(const bf16x8_t*)(qp + 16 * ks); }
    f32x16 o0, o1;
#pragma unroll
    for (int e = 0; e < 16; ++e) { o0[e] = 0.f; o1[e] = 0.f; }
    float m = -1e30f, lsum = 0.f;
    const int ntile = qblk * 4 + 4;
    const int cA = tid, keyA = cA / 12, partA = cA - keyA * 12; const int cB = 512 + (tid & 255), keyB = cB / 12, partB = cB - keyB * 12; const bool hasB = tid < 256;
    const bf16_t* gA = partA < 8 ? p->Kn + (trow0 + keyA) * 512 + h * 64 + partA * 8 : p->Kr + (trow0 + keyA) * 32 + (partA - 8) * 8; const int stepA = partA < 8 ? 64 * 512 : 64 * 32;
    const bf16_t* gB = partB < 8 ? p->Kn + (trow0 + keyB) * 512 + h * 64 + partB * 8 : p->Kr + (trow0 + keyB) * 32 + (partB - 8) * 8; const int stepB = partB < 8 ? 64 * 512 : 64 * 32;
    const bf16_t* gV = p->Vt + (size_t)(h * 64 + (tid >> 3)) * TP + trow0 + (tid & 7) * 8;
    const int lA = keyA * ATT_KS + partA * 16, lB = keyB * ATT_KS + partB * 16, lV = ATT_KB + (tid >> 3) * ATT_VS + (tid & 7) * 16;
    const int pr_ = (r & 0x13) | ((r & 4) << 1) | ((r & 8) >> 1);
    const int kOff = pr_ * ATT_KS + 16 * hh, vOff = ATT_KB + r * ATT_VS + 16 * hh;
#define ATT_COMPUTE() do { \
        if (kt * 64 <= q0 + 31) { \
            f32x16 s0, s1; TP_ON(2); \
_Pragma("unroll") \
            for (int e = 0; e < 16; ++e) { s0[e] = 0.f; s1[e] = 0.f; } \
_Pragma("unroll") \
            for (int ks = 0; ks < 6; ++ks) { \
                const bf16x8_t a0 = *(const LAS bf16x8_t*)(st + kOff + ks * 32), a1 = *(const LAS bf16x8_t*)(st + kOff + 32 * ATT_KS + ks * 32); \
                s0 = __builtin_amdgcn_mfma_f32_32x32x16_bf16(a0, qf[ks], s0, 0, 0, 0); \
                s1 = __builtin_amdgcn_mfma_f32_32x32x16_bf16(a1, qf[ks], s1, 0, 0, 0); \
            } \
            TP_OFF(2); TP_ON(3); if (kt * 64 + 63 > q0) { \
                const int qrel = q0 + r - kt * 64; \
_Pragma("unroll") \
                for (int e = 0; e < 16; ++e) { const int kl = (e & 3) + 4 * ((e >> 2) & 1) + 8 * hh + 16 * ((e >> 3) & 1); \
                    if (kl > qrel) s0[e] = -1e30f; if (kl + 32 > qrel) s1[e] = -1e30f; } \
            } \
            float tm = fmaxf(s0[0], s1[0]); \
_Pragma("unroll") \
            for (int e = 1; e < 16; ++e) tm = fmaxf(tm, fmaxf(s0[e], s1[e])); \
            tm = fmaxf(tm, __shfl_xor(tm, 32)); \
            const float mn = fmaxf(m, tm), al = __builtin_amdgcn_exp2f((m - mn) * ATT_C), mc = mn * ATT_C; m = mn; \
            float ps = 0.f; \
_Pragma("unroll") \
            for (int e = 0; e < 16; ++e) { s0[e] = __builtin_amdgcn_exp2f(s0[e] * ATT_C - mc); s1[e] = __builtin_amdgcn_exp2f(s1[e] * ATT_C - mc); ps += s0[e] + s1[e]; } \
            lsum = lsum * al + ps; \
_Pragma("unroll") \
            for (int e = 0; e < 16; ++e) { o0[e] *= al; o1[e] *= al; } \
            TP_OFF(3); TP_ON(4); \
_Pragma("unroll") \
            for (int kb = 0; kb < 2; ++kb) \
_Pragma("unroll") \
                for (int sp = 0; sp < 2; ++sp) { \
                    union { u32x4 u; bf16x8_t v; } pb; \
                    if (kb == 0) { pb.u.x = pg8::cvt_pk_bf16(s0[8 * sp + 0], s0[8 * sp + 1]); pb.u.y = pg8::cvt_pk_bf16(s0[8 * sp + 2], s0[8 * sp + 3]); pb.u.z = pg8::cvt_pk_bf16(s0[8 * sp + 4], s0[8 * sp + 5]); pb.u.w = pg8::cvt_pk_bf16(s0[8 * sp + 6], s0[8 * sp + 7]); } \
                    else         { pb.u.x = pg8::cvt_pk_bf16(s1[8 * sp + 0], s1[8 * sp + 1]); pb.u.y = pg8::cvt_pk_bf16(s1[8 * sp + 2], s1[8 * sp + 3]); pb.u.z = pg8::cvt_pk_bf16(s1[8 * sp + 4], s1[8 * sp + 5]); pb.u.w = pg8::cvt_pk_bf16(s1[8 * sp + 6], s1[8 * sp + 7]); } \
                    const int ko = (32 * kb + 16 * sp) * 2; \
                    const bf16x8_t v0 = *(const LAS bf16x8_t*)(st + vOff + ko), v1 = *(const LAS bf16x8_t*)(st + vOff + 32 * ATT_VS + ko); \
                    o0 = __builtin_amdgcn_mfma_f32_32x32x16_bf16(v0, pb.v, o0, 0, 0, 0); \
                    o1 = __builtin_amdgcn_mfma_f32_32x32x16_bf16(v1, pb.v, o1, 0, 0, 0); \
                } \
            TP_OFF(4); \
        } \
    } while (0)
    u32x4 rA = *(const u32x4*)gA, rB = hasB ? *(const u32x4*)gB : (u32x4){0u, 0u, 0u, 0u}, rV = *(const u32x4*)gV;
    gA += stepA; gB += stepB; gV += 64;
    u32x4 sA = *(const u32x4*)gA, sB = hasB ? *(const u32x4*)gB : (u32x4){0u, 0u, 0u, 0u}, sV = *(const u32x4*)gV;
#define ATT_TILE(RA, RB, RV) do { \
        LAS unsigned char* st = lds + (kt & 1) * ATT_STAGE; TP_ON(1); \
        *(LAS u32x4*)(st + lA) = RA; if (hasB) *(LAS u32x4*)(st + lB) = RB; *(LAS u32x4*)(st + lV) = RV; \
        __syncthreads(); \
        if (kt + 2 < ntile) { gA += stepA; gB += stepB; gV += 64; RA = *(const u32x4*)gA; if (hasB) RB = *(const u32x4*)gB; RV = *(const u32x4*)gV; } \
        TP_OFF(1); ATT_COMPUTE(); } while (0)
    TP_DECL; TP_ON(5);
    for (int kt = 0; kt < ntile; kt += 2) { ATT_TILE(rA, rB, rV); ++kt; ATT_TILE(sA, sB, sV); --kt; }
    TP_OFF(5);
#undef ATT_TILE
#undef ATT_COMPUTE
    TP_COMMIT(lds);
    lsum += __shfl_xor(lsum, 32);
    const float il = 1.0f / lsum;
    const size_t t = trow0 + q0 + r;
#pragma unroll
    for (int db = 0; db < 2; ++db)
#pragma unroll
        for (int g = 0; g < 4; ++g) { const int d0 = 32 * db + 8 * g + 4 * hh;
            const u32x2 gz = *(const u32x2*)(p->H + t * IN_WP + C_ZMLA + h * 64 + d0);
            float v[4];
#pragma unroll
            for (int e = 0; e < 4; ++e) v[e] = (db == 0 ? o0[4 * g + e] : o1[4 * g + e]) * il;
            v[0] *= __uint_as_float(gz.x << 16); v[1] *= __uint_as_float(gz.x & 0xffff0000u); v[2] *= __uint_as_float(gz.y << 16); v[3] *= __uint_as_float(gz.y & 0xffff0000u);
            u32x2 w; w.x = pg8::cvt_pk_bf16(v[0], v[1]); w.y = pg8::cvt_pk_bf16(v[2], v[3]);
            *(u32x2*)(p->yb + t * 1536 + h * 64 + d0) = w; }
}
__device__ __forceinline__ void ph_attn_p(KP p, LAS unsigned char* lds) {
    int tid = threadIdx.x; asm volatile("" : "+v"(tid));
    const int lane = tid & 63, wave = __builtin_amdgcn_readfirstlane(tid >> 6);
    for (int pi = blockIdx.x; pi < 256; pi += gridDim.x) {
        const int xcd = pi & 7, k = pi >> 3, bh = xcd * 8 + (k >> 2), pr = k & 3;
        attn_unit(p, bh >> 3, bh & 7, 7 - pr, lds, tid, wave, lane);
        attn_unit(p, bh >> 3, bh & 7, pr, lds, tid, wave, lane);
    }
    __syncthreads();
}
struct MEpiVt { static constexpr bool PERM = true, AFTER_DRAIN = false; static constexpr int SEG = 0; bf16_t* O; int ldc; int pad_;
    __device__ __forceinline__ void operator()(const f32x4 (&acc)[2][2][4][2], const pg8::Unit& u, int wr, int wc, int fr0, int fq0) const {
        int fr = fr0, fq = fq0; asm volatile("" : "+v"(fr), "+v"(fq));
        const int row0 = u.pm * 256 + wr * 64 + fr;
#pragma unroll
        for (int bj = 0; bj < 2; ++bj) { const int col0 = u.pn * 256 + bj * 128 + wc * 32 + 8 * fq;
#pragma unroll
            for (int ai = 0; ai < 2; ++ai)
#pragma unroll
                for (int m = 0; m < 4; ++m) { const int row = row0 + ai * 128 + m * 16; const f32x4 v0 = acc[ai][bj][m][0], v1 = acc[ai][bj][m][1];
                    u32x4 w; w.x = pg8::cvt_pk_bf16(v0[0], v0[1]); w.y = pg8::cvt_pk_bf16(v0[2], v0[3]); w.z = pg8::cvt_pk_bf16(v1[0], v1[1]); w.w = pg8::cvt_pk_bf16(v1[2], v1[3]);
                    *(u32x4*)(O + (size_t)row * ldc + col0) = w; } }
    } };


__global__ void __launch_bounds__(NTHR, 2) k_mega(Params p_unused) {
    const KP kp0 = (KP)__builtin_amdgcn_kernarg_segment_ptr();
#define PP() ({ KP q_ = kp0; asm volatile("" : "+s"(q_)); q_; })
    KP p = PP();
    extern __shared__ __attribute__((aligned(16))) unsigned char lds_raw[];
    LAS unsigned char* lds = (LAS unsigned char*)lds_raw;
    volatile LAS unsigned* misc = (volatile LAS unsigned*)(lds + LDS_MISC);
    for (int u = threadIdx.x; u < 64; u += NTHR) misc[u] = 0u;
    __syncthreads();
    const int lo = p->ph_lo, hi = p->ph_hi;
    XcdBarrier bar; bar.bar = p->bar + p->li * XCD_BAR_WORDS; bar.x = 0; bar.st = nullptr;
    if (hi - lo > 1) bar = xcd_barrier_post(p->bar + p->li * XCD_BAR_WORDS, misc + 8);
#define IN(k) (lo <= (k) && (k) < hi)
#define SEAM(k) do { if (IN(k) && IN((k) + 1)) xcd_barrier(bar); } while (0)

    if (IN(PH_PRO)) {
        LAS float* tile = (LAS float*)lds;
        for (int l = 0; l < 2; ++l) {
            KP p = PP();
            ph_tr(p->w_in + (size_t)l * 1024 * IN_W, p->WinT + (size_t)l * IN_WP * 1024, 1024, IN_W, IN_WP, tile, 0);
            ph_tr(p->w_uq + (size_t)l * 384 * 768, p->WuqT + (size_t)l * 768 * 384, 384, 768, 768, tile, 0);
            ph_tr(p->w_uk + (size_t)l * 256 * 512, p->WkvT + (size_t)l * 1024 * 256, 256, 512, 512, tile, 144);
            ph_tr(p->w_uv + (size_t)l * 256 * 512, p->WkvT + (size_t)l * 1024 * 256 + (size_t)512 * 256, 256, 512, 512, tile, 208);
            ph_tr(p->w_br0 + (size_t)l * 512 * 1024, p->WbrT + (size_t)l * 1024 * 1536 + 0 * 512, 512, 1024, 1024, tile, 0, 1536);
            ph_tr(p->w_br1 + (size_t)l * 512 * 1024, p->WbrT + (size_t)l * 1024 * 1536 + 1 * 512, 512, 1024, 1024, tile, 0, 1536);
            ph_tr(p->w_br2 + (size_t)l * 512 * 1024, p->WbrT + (size_t)l * 1024 * 1536 + 2 * 512, 512, 1024, 1024, tile, 0, 1536);
            ph_tr(p->w_out + (size_t)l * 1024 * 1024, p->WoutT + (size_t)l * 1024 * 1024, 1024, 1024, 1024, tile, 0);
            for (int g = 0; g < 4; ++g) ph_tr(p->pool_mix + ((size_t)l * 4 + g) * 128 * 128, p->PmixT + ((size_t)l * 4 + g) * 128 * 128, 128, 128, 128, tile, 64 + 8 * g);
        }
        { KP p = PP(); const float* src = p->w_uk; bf16_t* dst = p->WukB;
          for (int i = (blockIdx.x * NTHR + threadIdx.x) * 8; i < 2 * 256 * 512; i += gridDim.x * NTHR * 8) { const f32x4 a = *(const f32x4*)(src + i), b = *(const f32x4*)(src + i + 4);
              u32x4 w; w.x = pg8::cvt_pk_bf16(a[0], a[1]); w.y = pg8::cvt_pk_bf16(a[2], a[3]); w.z = pg8::cvt_pk_bf16(b[0], b[1]); w.w = pg8::cvt_pk_bf16(b[2], b[3]); *(u32x4*)(dst + i) = w; } }
        { KP p = PP(); ph_rope_tab(p->tab); ph_rmsnorm(p->x_prompt, p->x_sample, p->norm_g, p->xn, nullptr, nullptr); }
    }
    SEAM(PH_PRO);
    for (int l = 0; l < 2; ++l) {
        int G = gridDim.x, bid = blockIdx.x; asm volatile("" : "+s"(G), "+s"(bid));
        if (IN(PHID(l, PH_GIN))) { KP p = PP();
            pg8::Gemm g{p->xn, p->WinT + (size_t)l * IN_WP * 1024, TT, IN_WP, 1024, 0}; pg8::StaticOrder S; S.init(TT, IN_WP, G, bid);
            MEpiH E{p->H, p->BA}; pg8::gemm_phase<MEpiH, pg8::StaticOrder, false>(lds, g, S, E, nullptr);
        }
        SEAM(PHID(l, PH_GIN));
        if (IN(PHID(l, PH_TOK))) ph_tok(PP(), l, lds);
        SEAM(PHID(l, PH_TOK));
        if (IN(PHID(l, PH_GQ)) && (PP()->pad & 16)) { KP p = PP();
            pg8::Gemm g{p->cq, p->WuqT + (size_t)l * 768 * 384, TT, 768, 384, 0}; pg8::StaticOrder S; S.init(TT, 768, G, bid);
            MEpiQ E{p->Q, p->tab}; pg8::gemm_phase<MEpiQ, pg8::StaticOrder, false>(lds, g, S, E, nullptr);
        }
        if (IN(PHID(l, PH_GQ)) && (PP()->pad & 32)) { KP p = PP();
            pg8::Gemm g{p->ckv, p->WkvT + (size_t)l * 1024 * 256, TP, 512, 256, 0}; pg8::StaticOrder S; S.init(TP, 512, G / 2, bid < G / 2 ? bid : G);
            MEpiKV E{p->Kn, p->V}; pg8::gemm_phase<MEpiKV, pg8::StaticOrder, false>(lds, g, S, E, nullptr);
        }
        if (IN(PHID(l, PH_GQ)) && (PP()->pad & 32)) { KP p = PP();
            pg8::Gemm g{p->WkvT + (size_t)l * 1024 * 256 + (size_t)512 * 256, p->ckv, 512, TP, 256, 0}; pg8::StaticOrder S; S.init(512, TP, G / 2, bid >= G / 2 ? bid - G / 2 : G);
            MEpiVt E{p->Vt, TP, 0}; pg8::gemm_phase<MEpiVt, pg8::StaticOrder, false>(lds, g, S, E, nullptr);
        }
        if (IN(PHID(l, PH_GQ)) && (PP()->pad & 64)) ph_delta_pre(PP(), lds);
        SEAM(PHID(l, PH_GQ));
        if (IN(PHID(l, PH_ATT))) { const int am = PP()->pad;
            if (am & 1) ph_attn_s2(PP(), l, lds); if (am & 4) ph_attn_p(PP(), lds); if (am & 8) ph_att_waves(PP(), l); }
        SEAM(PHID(l, PH_ATT));
        if (IN(PHID(l, PH_FIN))) { const int fm = PP()->pad; if (fm & 128) ph_fin(PP(), l, lds); if (fm & 256) ph_delta_fin(PP(), l); }
        SEAM(PHID(l, PH_FIN));
        if (IN(PHID(l, PH_MERGE)) && (PP()->pad & 512)) { KP p = PP();
            pg8::Gemm g{p->ya, p->WbrT + (size_t)l * 1024 * 1536, TP, 1024, 512, 1536}; pg8::SegOrder<3> S; S.init(TP, 1024, G, bid);
            MEpiMergeS E{p->H, p->mb}; pg8::gemm_phase<MEpiMergeS, pg8::SegOrder<3>, false>(lds, g, S, E, nullptr);
        }
        if (IN(PHID(l, PH_MERGE)) && (PP()->pad & 1024)) { KP p = PP(); TEpiMerge E{p->H, p->mb}; tail_gemm<3, TEpiMerge>(p->ya + (size_t)TP * 1536, 1536, p->WbrT + (size_t)l * 1024 * 1536, 1536, 1024, E, lds); }
        SEAM(PHID(l, PH_MERGE));
        if (IN(PHID(l, PH_OUT)) && (PP()->pad & 2048)) { KP p = PP();
            const float* xp = l == 0 ? p->x_prompt : p->xres; const float* xs = l == 0 ? p->x_sample : p->xres + (size_t)TP * 1024;
            pg8::Gemm g{p->mb, p->WoutT + (size_t)l * 1024 * 1024, TP, 1024, 1024, 0}; pg8::StaticOrder S; S.init(TP, 1024, G, bid);
            MEpiRes E{xp, xs, p->xres}; pg8::gemm_phase<MEpiRes, pg8::StaticOrder, false>(lds, g, S, E, nullptr);
        }
        if (IN(PHID(l, PH_OUT)) && (PP()->pad & 4096)) { KP p = PP(); TEpiRes E{l == 0 ? p->x_sample : p->xres + (size_t)TP * 1024, p->xres}; tail_gemm<1, TEpiRes>(p->mb + (size_t)TP * 1024, 1024, p->WoutT + (size_t)l * 1024 * 1024, 1024, 1024, E, lds); }
        SEAM(PHID(l, PH_OUT));
        if (IN(PHID(l, PH_NORM))) { KP p = PP();
            if (l == 0) ph_rmsnorm(p->xres, p->xres + (size_t)TP * 1024, p->norm_g + 1024, p->xn, nullptr, nullptr);
            else ph_rmsnorm(p->xres, p->xres + (size_t)TP * 1024, p->final_norm_g, nullptr, p->out + O_YP, p->out + O_YS);
        }
        SEAM(PHID(l, PH_NORM));
    }
#if defined(TPROBE)
    { int te_ = threadIdx.x; asm volatile("" : "+v"(te_)); if (blockIdx.x == 0 && te_ == 0 && PP()->ph_lo == 0) { const unsigned long long w = (unsigned long long)*(volatile LAS unsigned*)(lds + LDS_MISC + 128) * 8ull, t0 = __builtin_amdgcn_s_memrealtime();
        while (__builtin_amdgcn_s_memrealtime() - t0 < w) __builtin_amdgcn_s_sleep(8); } }
#endif
#undef IN
#undef SEAM
}

static inline size_t al256(size_t x) { return (x + 255) & ~(size_t)255; }
extern "C" void kernel_launch(void* const* d_in, const int* in_sizes, int n_in, void* d_out, int out_size, void* d_ws, size_t ws_size, hipStream_t stream) {
    static int grid = 0;
    if (grid == 0) {
        int dev = 0, cus = 0; (void)hipGetDevice(&dev); (void)hipDeviceGetAttribute(&cus, hipDeviceAttributeMultiprocessorCount, dev);
        (void)hipFuncSetAttribute((const void*)k_mega, hipFuncAttributeMaxDynamicSharedMemorySize, LDS_BYTES);
        int per_cu = 0; (void)hipOccupancyMaxActiveBlocksPerMultiprocessor(&per_cu, (const void*)k_mega, NTHR, LDS_BYTES); (void)hipGetLastError();
        grid = cus > 0 ? cus : 256;
    }
    Params p{};
    p.x_prompt = (const float*)d_in[0]; p.x_sample = (const float*)d_in[1]; p.cache_kv = (const float*)d_in[2]; p.cache_kr = (const float*)d_in[3];
    p.state_pool = (const float*)d_in[4]; p.state_conv = (const float*)d_in[5]; p.state_delta = (const float*)d_in[6]; p.page_table = (const int*)d_in[7];
    p.norm_g = (const float*)d_in[8]; p.w_in = (const float*)d_in[9]; p.pool_mix = (const float*)d_in[10]; p.pool_scale = (const float*)d_in[11];
    p.q_norm_g = (const float*)d_in[12]; p.w_uq = (const float*)d_in[13]; p.kv_norm_g = (const float*)d_in[14]; p.w_uk = (const float*)d_in[15];
    p.w_uv = (const float*)d_in[16]; p.conv_w = (const float*)d_in[17]; p.a_log = (const float*)d_in[18]; p.dt_bias = (const float*)d_in[19];
    p.dn_norm_g = (const float*)d_in[20]; p.w_br0 = (const float*)d_in[21]; p.w_br1 = (const float*)d_in[22]; p.w_br2 = (const float*)d_in[23];
    p.w_out = (const float*)d_in[24]; p.final_norm_g = (const float*)d_in[25];
    p.out = (float*)d_out;
    char* w = (char*)d_ws; size_t off = 0;
    auto take = [&](size_t bytes) { char* q = w + off; off += al256(bytes); return q; };
    const size_t BAR_BYTES = (size_t)16 * XCD_BAR_WORDS * 4;
    p.bar = (unsigned*)take(BAR_BYTES);
    p.WinT = (bf16_t*)take((size_t)2 * IN_WP * 1024 * 2);
    p.WuqT = (bf16_t*)take((size_t)2 * 768 * 384 * 2);
    p.WkvT = (bf16_t*)take((size_t)2 * 1024 * 256 * 2);
    p.WbrT = (bf16_t*)take((size_t)2 * 3 * 1024 * 512 * 2);
    p.WoutT = (bf16_t*)take((size_t)2 * 1024 * 1024 * 2);
    p.PmixT = (bf16_t*)take((size_t)2 * 4 * 128 * 128 * 2);
    p.WukB = (bf16_t*)take((size_t)2 * 256 * 512 * 2);
    p.tab = (float2*)take((size_t)(SEQ + DEC_SEQ) * 16 * 8);
    p.xres = (float*)take((size_t)TT * 1024 * 4);
    p.xn = (bf16_t*)take((size_t)TT * 1024 * 2);
    p.H = (bf16_t*)take((size_t)TT * IN_WP * 2);
    p.BA = (float*)take((size_t)TT * 16 * 4);
    p.cq = (bf16_t*)take((size_t)TT * 384 * 2);
    p.ckv = (bf16_t*)take((size_t)TT * 256 * 2);
    p.Kr = (bf16_t*)take((size_t)TT * 32 * 2);
    p.Q = (bf16_t*)take((size_t)TT * 768 * 2);
    bf16_t* Qlat = (bf16_t*)take((size_t)TS * 8 * 288 * 2);
    p.Kn = (bf16_t*)take((size_t)TP * 512 * 2);
    p.V = (bf16_t*)take((size_t)TP * 512 * 2);
    p.Vt = (bf16_t*)take((size_t)512 * TP * 2);
    p.qd = (bf16_t*)take((size_t)TT * 512 * 2);
    p.kd = (bf16_t*)take((size_t)TT * 512 * 2);
    p.vd = (bf16_t*)take((size_t)TT * 512 * 2);
    p.bg = (float*)take((size_t)TT * 16 * 4);
    p.ya = (bf16_t*)take((size_t)TT * 1536 * 2); p.yb = p.ya + 512; p.yc = p.ya + 1024;
    p.mf = (float*)take((size_t)TT * 1024 * 4);
    p.mb = (bf16_t*)take((size_t)TT * 1024 * 2);
    p.part = (float*)take((size_t)DEC_BATCH * SA_CH * 64 * 258 * 4);
    p.DOP = (bf16_t*)take((size_t)2048 * 4 * 4096 * 2);
    p.DU = (float*)take((size_t)2048 * 4096 * 4);
    p.DG = (float*)take((size_t)2048 * 4);

    (void)hipMemsetAsync(p.bar, 0, BAR_BYTES, stream);
    p.ph_lo = 0; p.ph_hi = PH_END; p.li = 0; p.pad = 0x7fff;
    hipLaunchKernelGGL(k_mega, dim3(grid), dim3(NTHR), LDS_BYTES, stream, p);
#if defined(PROBE_REP) && PROBE_REP > 0
    for (int i = 0; i < PROBE_REP; ++i) { Params q = p; q.ph_lo = PROBE_LO; q.ph_hi = PROBE_HI; q.li = 1 + i; q.pad = PROBE_MASK; hipLaunchKernelGGL(k_mega, dim3(grid), dim3(NTHR), LDS_BYTES, stream, q); }
#endif
}
```

```cpp
#include <hip/hip_runtime.h>
#include <stdint.h>

typedef unsigned short bf16_t;

#define D_MODEL 1024
#define TP 16384
#define TS 256
#define TT (TP + TS)
#define SEQ 2048
#define DEC_SEQ 8
#define DEC_BATCH 32
#define PAST_LEN 16384
#define PAGE 128
#define N_PAGES 128
#define N_POOL 5120
#define IN_W 7344
#define IN_WP 7424
#define C_POOL 0
#define C_ZPOOL 512
#define C_Q 1024
#define C_KV 1408
#define C_KR 1664
#define C_ZMLA 1696
#define C_QKV 2208
#define C_ZDN 3744
#define C_BETA 4256
#define C_ALPHA 4264
#define C_GATE 4272
#define EPS 1e-6f
#define MLA_SCALE 0.10206207261596577f
#define ATT_C 0.14724444831554004f

#define O_YP 0
#define O_YS (O_YP + 16777216)
#define O_PKV (O_YS + 262144)
#define O_PKR (O_PKV + 8388608)
#define O_PPOOL (O_PKR + 1048576)
#define O_PCONV (O_PPOOL + 122880)
#define O_PDELTA (O_PCONV + 73728)
#define O_SKV (O_PDELTA + 524288)
#define O_SKR (O_SKV + 131072)
#define O_SPOOL (O_SKR + 16384)
#define O_SCONV (O_SPOOL + 491520)
#define O_SDELTA (O_SCONV + 294912)
#define O_END (O_SDELTA + 2097152)

__device__ __forceinline__ float bf2f(bf16_t b) { return __uint_as_float(((unsigned)b) << 16); }
__device__ __forceinline__ bf16_t f2bf(float f) { unsigned u = __float_as_uint(f); u += 0x7FFFu + ((u >> 16) & 1u); return (bf16_t)(u >> 16); }
__device__ __forceinline__ float sigmoidf_(float v) { return __builtin_amdgcn_rcpf(1.0f + __builtin_amdgcn_exp2f(-1.4426950408889634f * v)); }
__device__ __forceinline__ float siluf_(float v) { return v * __builtin_amdgcn_rcpf(1.0f + __builtin_amdgcn_exp2f(-1.4426950408889634f * v)); }
__device__ __forceinline__ float wave_sum(float v) {
#pragma unroll
    for (int o = 32; o >= 1; o >>= 1) v += __shfl_xor(v, o);
    return v;
}

#define SA_CH 8
namespace pg8 {
#define PG8_LAS __attribute__((address_space(3)))
typedef unsigned short bf16_t;
typedef short bf16x8 __attribute__((ext_vector_type(8)));
typedef float f32x4 __attribute__((ext_vector_type(4)));
typedef unsigned u32x4 __attribute__((ext_vector_type(4)));
constexpr int BM = 256, BK = 64, HALF = 128, HTB = HALF * BK * 2  , STAGE_BYTES = 8 * HTB, NXCD = 8, WGM = 8;

__host__ __device__ __forceinline__ int lds_byte(int r, int c) { const int st = (r >> 4) * 2 + (c >> 5), rr = r & 15, cc = c & 31, ob = rr * 64 + cc * 2; return st * 1024 + (ob ^ (((ob >> 9) & 1) << 5)); }
__host__ __device__ __forceinline__ void stage_rc(int b, int& R, int& C) { const int st = b / 1024, sb = b % 1024, swz = sb ^ (((sb >> 9) & 1) << 5); R = (st >> 1) * 16 + swz / 64; C = (st & 1) * 32 + (swz % 64) / 2; }
__host__ __device__ __forceinline__ int perm32(int rho) { const int n = rho >> 4, i = rho & 15; return 8 * (i >> 2) + 4 * n + (i & 3); }

struct Unit { int pm, pn, sg; };
struct Gemm { const bf16_t* A; const bf16_t* Bt; int M, N, K; int ld; };

struct StaticOrder {
    int nM, nN, nwg, G, c;
    __host__ __device__ void init(int M, int N, int G_, int c_) { nM = M / BM; nN = N / BM; nwg = nM * nN; G = G_; c = c_; }
    __host__ __device__ bool next(int i, Unit& u) const {
        const long L = (long)i * G + c; if (L >= nwg) return false;
        int wgid = (int)L; { const int q = nwg / NXCD, r = nwg % NXCD, xcd = wgid % NXCD, off = wgid / NXCD; wgid = (xcd < r ? xcd * (q + 1) : r * (q + 1) + (xcd - r) * q) + off; }
        const int nig = WGM * nN, gid = wgid / nig, fm = gid * WGM, gsz = (nM - fm) < WGM ? (nM - fm) : WGM;
        u.pm = fm + ((wgid % nig) % gsz); u.pn = (wgid % nig) / gsz; u.sg = 0; return true;
    }
    __device__ __forceinline__ void a_ready(const Unit&) const {}
    __device__ __forceinline__ void done(const Unit&) const {}
};
template <int NSEG> struct SegOrder : StaticOrder {
    __host__ __device__ bool next(int i, Unit& u) const { const bool ok = StaticOrder::next(i / NSEG, u); u.sg = i % NSEG; return ok; }
};
typedef __bf16 bf16n2 __attribute__((ext_vector_type(2)));
__device__ __forceinline__ unsigned cvt_pk_bf16(float lo, float hi) { typedef float f2_ __attribute__((ext_vector_type(2))); const f2_ v = {lo, hi}; return __builtin_bit_cast(unsigned, __builtin_convertvector(v, bf16n2)); }
typedef float f32x2 __attribute__((ext_vector_type(2)));
template <class Epi, class Sched, bool STAMP = false>
__device__ __forceinline__ void gemm_phase(PG8_LAS unsigned char* lds, const Gemm g, const Sched& S, const Epi& E, unsigned long long* stamps) {
    int tid_ = threadIdx.x; asm volatile("" : "+v"(tid_));
    const int tid = tid_, wid = __builtin_amdgcn_readfirstlane(tid >> 6), lane = tid & 63, wr = wid >> 2, wc = wid & 3, fr = lane & 15, fq = lane >> 4;
    int K_ = g.K; asm volatile("" : "+s"(K_));
    int LD_ = g.ld ? g.ld : g.K; asm volatile("" : "+s"(LD_));
    const int K = K_, nt = K / BK, LD = LD_;
    int ts_lo = 0, ts_hi = 0, nts = 0; const unsigned long long rt_entry = STAMP ? (unsigned long long)wall_clock64() : 0ull;
#define PG8_STAMP() do { if (STAMP && wid == 0 && nts < 64) { const unsigned long long _c = (unsigned long long)clock64(); \
        ts_lo = (lane == nts) ? (int)(unsigned)_c : ts_lo; ts_hi = (lane == nts) ? (int)(unsigned)(_c >> 32) : ts_hi; ++nts; } } while (0)
    PG8_STAMP();
    unsigned voffA[2], voffB[2];
#pragma unroll
    for (int i = 0; i < 2; ++i) { int R, C; stage_rc(tid * 16 + i * 8192, R, C); const int Rb = Epi::PERM ? ((R & ~31) + perm32(R & 31)) : R;
        voffA[i] = (unsigned)(R * LD + C) * 2u; voffB[i] = (unsigned)(Rb * LD + C) * 2u; }
    const size_t kstep = (size_t)(BK * 2);
    const size_t hstep = (size_t)HALF * LD * 2;
    const size_t tstep = 2 * hstep;
    const unsigned ldsw = (unsigned)wid * 1024u;
    const int aoff = lds_byte(wr * 64 + fr, fq * 8), boff = lds_byte(wc * 32 + fr, fq * 8);
#define PG8_SA(b, h) (((b) * 2 + (h)) * HTB)
#define PG8_SB(b, h) ((4 + (b) * 2 + (h)) * HTB)
#define PG8_STAGE(bufoff, gbase, voff) do { _Pragma("unroll") for (int _i = 0; _i < 2; ++_i) \
        __builtin_amdgcn_global_load_lds((const unsigned*)((const char*)(gbase) + (voff)[_i]), (PG8_LAS unsigned*)(lds + (bufoff) + ldsw + _i * 8192), 16, 0, 0); } while (0)
#define PG8_LDA(dst, b, h) do { _Pragma("unroll") for (int m = 0; m < 4; ++m) _Pragma("unroll") for (int k = 0; k < 2; ++k) dst[m][k] = *(const PG8_LAS bf16x8*)(lds + PG8_SA(b, h) + aoff + m * 2048 + k * 1024); } while (0)
#define PG8_LDB(dst, b, h) do { _Pragma("unroll") for (int n = 0; n < 2; ++n) _Pragma("unroll") for (int k = 0; k < 2; ++k) dst[n][k] = *(const PG8_LAS bf16x8*)(lds + PG8_SB(b, h) + boff + n * 2048 + k * 1024); } while (0)
#define PG8_MMA(ai, bj, At, Bt) do { __builtin_amdgcn_s_setprio(1); _Pragma("unroll") for (int m = 0; m < 4; ++m) _Pragma("unroll") for (int n = 0; n < 2; ++n) _Pragma("unroll") for (int k = 0; k < 2; ++k) \
        acc[ai][bj][m][n] = __builtin_amdgcn_mfma_f32_16x16x32_bf16(Bt[n][k], At[m][k], acc[ai][bj][m][n], 0, 0, 0); __builtin_amdgcn_s_setprio(0); } while (0)
#define PG8_WAIT_V(n) asm volatile("s_waitcnt vmcnt(" #n ")" ::: "memory")
#define PG8_WAIT_L(n) asm volatile("s_waitcnt lgkmcnt(" #n ")" ::: "memory")
#define PG8_BAR __builtin_amdgcn_s_barrier()
#define PG8_SCHED __builtin_amdgcn_sched_barrier(0)
    Unit cur, nxt; int ui = 0;
    if (!S.next(0, cur)) return;
    f32x4 acc[2][2][4][2];
#pragma unroll
    for (int a = 0; a < 2; ++a)
#pragma unroll
        for (int b = 0; b < 2; ++b)
#pragma unroll
            for (int m = 0; m < 4; ++m)
#pragma unroll
                for (int n = 0; n < 2; ++n) acc[a][b][m][n] = (f32x4){0.f, 0.f, 0.f, 0.f};
    bf16x8 At[4][2], B0[2][2], B1[2][2];
    const size_t sstep = (size_t)K * 2;
    const char* cA = (const char*)g.A + (size_t)cur.pm * tstep + cur.sg * sstep; const char* cB = (const char*)g.Bt + (size_t)cur.pn * tstep + cur.sg * sstep;
    S.a_ready(cur);
    PG8_STAGE(PG8_SB(0, 0), cB, voffB); PG8_STAGE(PG8_SA(0, 0), cA, voffA); PG8_STAGE(PG8_SB(0, 1), cB + hstep, voffB); PG8_STAGE(PG8_SA(0, 1), cA + hstep, voffA);
    if (wr == 1) PG8_BAR;
    PG8_WAIT_V(4); PG8_BAR;
    PG8_STAGE(PG8_SB(1, 0), cB + kstep, voffB); PG8_STAGE(PG8_SA(1, 0), cA + kstep, voffA); PG8_STAGE(PG8_SB(1, 1), cB + hstep + kstep, voffB);
    PG8_WAIT_V(6); PG8_BAR;
    PG8_STAMP();
    for (;;) {
        const bool has_next = S.next(ui + 1, nxt);
        const char* nA = has_next ? (const char*)g.A + (size_t)nxt.pm * tstep + nxt.sg * sstep : cA; const char* nB = has_next ? (const char*)g.Bt + (size_t)nxt.pn * tstep + nxt.sg * sstep : cB;
_Pragma("nounroll")
        for (int t = 0; t < nt; t += 2) {
            const bool last = (t == nt - 2);
            const char* a1 = cA + (size_t)(t + 1) * kstep;
            const char* a2 = last ? nA : cA + (size_t)(t + 2) * kstep; const char* b2 = last ? nB : cB + (size_t)(t + 2) * kstep;
            const char* a3 = a2 + kstep; const char* b3 = b2 + kstep;
            if (last && has_next) S.a_ready(nxt);
            PG8_LDB(B0, 0, 0); PG8_SCHED; PG8_LDA(At, 0, 0); PG8_STAGE(PG8_SA(1, 1), a1 + hstep, voffA);
            PG8_WAIT_L(8); PG8_BAR; PG8_WAIT_L(0); PG8_MMA(0, 0, At, B0); PG8_BAR; PG8_SCHED;
            PG8_LDB(B1, 0, 1); PG8_STAGE(PG8_SB(0, 0), b2, voffB);
            PG8_BAR; PG8_WAIT_L(0); PG8_MMA(0, 1, At, B1); PG8_BAR;
            PG8_LDA(At, 0, 1); PG8_STAGE(PG8_SA(0, 0), a2, voffA);
            PG8_BAR; PG8_WAIT_L(0); PG8_MMA(1, 0, At, B0); PG8_BAR; PG8_SCHED;
            PG8_STAGE(PG8_SB(0, 1), b2 + hstep, voffB);
            PG8_WAIT_V(6); PG8_BAR; PG8_MMA(1, 1, At, B1); PG8_BAR;
            PG8_LDB(B0, 1, 0); PG8_SCHED; PG8_LDA(At, 1, 0); PG8_STAGE(PG8_SA(0, 1), a2 + hstep, voffA);
            PG8_WAIT_L(8); PG8_BAR; PG8_WAIT_L(0); PG8_MMA(0, 0, At, B0); PG8_BAR; PG8_SCHED;
            PG8_LDB(B1, 1, 1); PG8_STAGE(PG8_SB(1, 0), b3, voffB);
            PG8_BAR; PG8_WAIT_L(0); PG8_MMA(0, 1, At, B1); PG8_BAR;
            PG8_LDA(At, 1, 1); PG8_STAGE(PG8_SA(1, 0), a3, voffA);
            PG8_BAR; PG8_WAIT_L(0); PG8_MMA(1, 0, At, B0); PG8_BAR; PG8_SCHED;
            PG8_STAGE(PG8_SB(1, 1), b3 + hstep, voffB);
            PG8_WAIT_V(6); PG8_BAR; PG8_MMA(1, 1, At, B1); PG8_BAR;
        }
        PG8_STAMP();
        bool fin_ = true; if constexpr (Epi::SEG > 0) fin_ = (cur.sg == Epi::SEG - 1);
        if constexpr (!Epi::AFTER_DRAIN) { if (fin_) { E(acc, cur, wr, wc, fr, fq); S.done(cur); } }
        if constexpr (Epi::SEG > 0) E.mid(acc, cur, wr, wc, fr, fq, fin_ ? 1 : cur.sg + 1, fin_ ? 0.f : 1.f);
        PG8_STAMP();
        if (!has_next) break;
        if constexpr (Epi::SEG == 0)
#pragma unroll
        for (int a = 0; a < 2; ++a)
#pragma unroll
            for (int b = 0; b < 2; ++b)
#pragma unroll
                for (int m = 0; m < 4; ++m)
#pragma unroll
                    for (int n = 0; n < 2; ++n) acc[a][b][m][n] = (f32x4){0.f, 0.f, 0.f, 0.f};
        cur = nxt; cA = nA; cB = nB; ++ui;
    }
    PG8_WAIT_V(0);
    if (wr == 0) PG8_BAR;
    PG8_BAR;
    if constexpr (Epi::AFTER_DRAIN) { E.fused(acc, cur, wr, wc, fr, fq, lds, wid, lane); S.done(cur); }
    PG8_STAMP();
    if (STAMP && wid == 0) { stamps[lane] = lane < nts ? (((unsigned long long)(unsigned)ts_hi << 32) | (unsigned)ts_lo) : 0ull;
        if (lane == 62) stamps[62] = rt_entry; if (lane == 63) stamps[63] = (unsigned long long)wall_clock64(); }
#undef PG8_STAMP
#undef PG8_SA
#undef PG8_SB
#undef PG8_STAGE
#undef PG8_LDA
#undef PG8_LDB
#undef PG8_MMA
#undef PG8_WAIT_V
#undef PG8_WAIT_L
#undef PG8_BAR
#undef PG8_SCHED
}

}
#define XB_TMO      128
#define XB_XCNT(j)  (256  + 64 * (j))
#define XB_XSUB(j)  (1280 + 64 * (j))
#define XB_XGEN(j)  (2304 + 64 * (j))
#define XB_TOP      3328
#define XB_TOPGEN   3392
#define XCD_BAR_WORDS 3456
#define XB_SPIN_CAP (1u << 18)
#define LAS __attribute__((address_space(3)))

__device__ __forceinline__ unsigned xb_ld(unsigned* p)              { return __hip_atomic_load(p, __ATOMIC_RELAXED, __HIP_MEMORY_SCOPE_AGENT); }
__device__ __forceinline__ unsigned xb_add(unsigned* p, unsigned v) { return __hip_atomic_fetch_add(p, v, __ATOMIC_RELAXED, __HIP_MEMORY_SCOPE_AGENT); }
__device__ __forceinline__ unsigned xb_xcc_id() { return (unsigned)__builtin_amdgcn_s_getreg((3 << 11) | 20) & 0xFu; }
#define XB_SPIN(cond, bar) do { unsigned _sp = 0; while (cond) { __builtin_amdgcn_s_sleep(1); \
    if ((++_sp & 255u) == 0u) { if (xb_ld(&(bar)[XB_TMO])) break; if (_sp > XB_SPIN_CAP) { atomicAdd(&(bar)[XB_TMO], 1u); break; } } } } while (0)

struct XcdBarrier {
    unsigned* bar; unsigned x;
    volatile LAS unsigned* st;
};

__device__ __forceinline__ XcdBarrier xcd_barrier_post(unsigned* bar, volatile LAS unsigned* st) {
    XcdBarrier b; b.bar = bar; b.x = xb_xcc_id(); b.st = st;
    if (threadIdx.x == 0) (void)xb_add(&bar[XB_XCNT(b.x)], 1u);
    return b;
}
__device__ __forceinline__ void xcd_barrier_complete(unsigned* bar, unsigned x, unsigned& nloc, unsigned& nx) {
    const unsigned G = gridDim.x * gridDim.y * gridDim.z;
    unsigned sum, cnt, mine, sp = 0u;
    for (;;) {
        sum = 0u; cnt = 0u; mine = 0u;
#pragma unroll
        for (unsigned j = 0; j < 16; ++j) { const unsigned c = xb_ld(&bar[XB_XCNT(j)]); sum += c; cnt += (c > 0u) ? 1u : 0u; mine = (j == x) ? c : mine; }
        if (sum == G) break;
        __builtin_amdgcn_s_sleep(1);
        if ((++sp & 255u) == 0u) { if (xb_ld(&bar[XB_TMO])) break; if (sp > XB_SPIN_CAP) { atomicAdd(&bar[XB_TMO], 1u); break; } }
    }
    nloc = mine > 0u ? mine : 1u; nx = cnt > 0u ? cnt : 1u;
}

__device__ __forceinline__ void xcd_barrier(const XcdBarrier& b) {
    asm volatile("s_waitcnt vmcnt(0)" ::: "memory");
    __syncthreads();
    if (threadIdx.x == 0) {
        unsigned* bar = b.bar;
        __builtin_amdgcn_s_waitcnt(0);
        unsigned nloc = b.st[0], nx = b.st[1];
        if (nloc == 0u) { xcd_barrier_complete(bar, b.x, nloc, nx); b.st[0] = nloc; b.st[1] = nx; }
        const unsigned old = xb_add(&bar[XB_XSUB(b.x)], 1u);
        const unsigned gen = old / nloc;
        if (old + 1u == (gen + 1u) * nloc) {
            __builtin_amdgcn_fence(__ATOMIC_RELEASE, "agent");
            asm volatile("s_waitcnt vmcnt(0)" ::: "memory");
            const unsigned og = xb_add(&bar[XB_TOP], 1u);
            const unsigned tg = og / nx;
            if (og + 1u == (tg + 1u) * nx) xb_add(&bar[XB_TOPGEN], 1u);
            else XB_SPIN(xb_ld(&bar[XB_TOPGEN]) == tg, bar);
            __builtin_amdgcn_fence(__ATOMIC_ACQUIRE, "agent");
            xb_add(&bar[XB_XGEN(b.x)], 1u);
            asm volatile("s_waitcnt vmcnt(0)" ::: "memory");
        } else {
            XB_SPIN(xb_ld(&bar[XB_XGEN(b.x)]) == gen, bar);
            __builtin_amdgcn_fence(__ATOMIC_ACQUIRE, "agent");
            asm volatile("s_waitcnt vmcnt(0)" ::: "memory");
        }
    }
    __syncthreads();
}


#define LAS __attribute__((address_space(3)))
typedef float f32x4 __attribute__((ext_vector_type(4)));
typedef unsigned u32x4 __attribute__((ext_vector_type(4)));
typedef unsigned u32x2 __attribute__((ext_vector_type(2)));
typedef float f32x2 __attribute__((ext_vector_type(2)));
typedef short bf16x8_t __attribute__((ext_vector_type(8)));
typedef float f32x16 __attribute__((ext_vector_type(16)));
constexpr int NTHR = 512;
constexpr int LDS_BYTES = 147456;
constexpr int LDS_MISC = LDS_BYTES - 256;


#if defined(TPROBE)
#define TP_DECL unsigned tp_t0 = 0
#define TP_ON(id) do { if (TPROBE == (id)) tp_t0 = (unsigned)__builtin_amdgcn_s_memrealtime(); } while (0)
#define TP_OFF(id) do { if (TPROBE == (id)) { const unsigned d_ = (unsigned)__builtin_amdgcn_s_memrealtime() - tp_t0; int tq_ = threadIdx.x; asm volatile("" : "+v"(tq_)); if (blockIdx.x == 0 && tq_ == 0) *(volatile LAS unsigned*)(lds + LDS_MISC + 128) += d_; } } while (0)
#define TP_OFFW(id, T) do { if (TPROBE == (id)) { const unsigned d_ = (unsigned)__builtin_amdgcn_s_memrealtime() - tp_t0; int tq_ = threadIdx.x; asm volatile("" : "+v"(tq_)); if (blockIdx.x == 0 && tq_ == (T)) *(volatile LAS unsigned*)(unsigned)(LDS_MISC + 128) += d_; } } while (0)
#define TP_COMMIT(lds_)
#else
#define TP_OFFW(id, T)
#define TP_DECL
#define TP_ON(id)
#define TP_OFF(id)
#define TP_COMMIT(lds_)
#endif
struct Params {
    const float *x_prompt, *x_sample, *cache_kv, *cache_kr, *state_pool, *state_conv, *state_delta; const int* page_table;
    const float *norm_g, *w_in, *pool_mix, *pool_scale, *q_norm_g, *w_uq, *kv_norm_g, *w_uk, *w_uv, *conv_w, *a_log, *dt_bias, *dn_norm_g, *w_br0, *w_br1, *w_br2, *w_out, *final_norm_g;
    float* out;
    bf16_t *WinT, *WuqT, *WkvT, *WbrT, *WoutT, *PmixT, *WukB; float2* tab;
    float* xres; bf16_t* xn; bf16_t* H; float* BA; bf16_t *cq, *ckv, *Kr, *Q, *Kn, *V, *Vt, *qd, *kd, *vd; float* bg; bf16_t *ya, *yb, *yc; float* mf; bf16_t* mb; float* part; bf16_t* DOP; float* DU; float* DG;
    unsigned* bar;
    int ph_lo, ph_hi, li, pad;
};

typedef const __attribute__((address_space(4))) Params* KP;

constexpr int PH_PRO = 0;
constexpr int PH_L = 8;
constexpr int PH_GIN = 0, PH_TOK = 1, PH_GQ = 2, PH_ATT = 3, PH_FIN = 4, PH_MERGE = 5, PH_OUT = 6, PH_NORM = 7;
#define PHID(l, k) (1 + (l) * PH_L + (k))
constexpr int PH_END = 1 + 2 * PH_L;

__device__ __forceinline__ void unpack8(const u32x4 v, float (&f)[8]) {
    f[0] = __uint_as_float(v.x << 16); f[1] = __uint_as_float(v.x & 0xffff0000u); f[2] = __uint_as_float(v.y << 16); f[3] = __uint_as_float(v.y & 0xffff0000u);
    f[4] = __uint_as_float(v.z << 16); f[5] = __uint_as_float(v.z & 0xffff0000u); f[6] = __uint_as_float(v.w << 16); f[7] = __uint_as_float(v.w & 0xffff0000u); }
__device__ __forceinline__ u32x4 pack8(const float (&f)[8]) { u32x4 w; w.x = pg8::cvt_pk_bf16(f[0], f[1]); w.y = pg8::cvt_pk_bf16(f[2], f[3]); w.z = pg8::cvt_pk_bf16(f[4], f[5]); w.w = pg8::cvt_pk_bf16(f[6], f[7]); return w; }
struct MEpiH { static constexpr bool PERM = true, AFTER_DRAIN = false; static constexpr int SEG = 0; bf16_t* H; float* BA;
    __device__ __forceinline__ void operator()(const f32x4 (&acc)[2][2][4][2], const pg8::Unit& u, int wr, int wc, int fr0, int fq0) const {
        int fr = fr0, fq = fq0; asm volatile("" : "+v"(fr), "+v"(fq));
        const int row0 = u.pm * 256 + wr * 64 + fr;
#pragma unroll
        for (int bj = 0; bj < 2; ++bj) {
            const int wcol = u.pn * 256 + bj * 128 + wc * 32, col0 = wcol + 8 * fq;
            const bool plain = (wcol + 32 <= C_ZPOOL) || (wcol >= C_Q && wcol + 32 <= C_ZMLA) || (wcol >= C_QKV && wcol + 32 <= C_ZDN);
            const int act = ((col0 >= C_ZPOOL && col0 < C_Q) || (col0 >= C_ZMLA && col0 < C_QKV) || (col0 >= C_ZDN && col0 < C_BETA)) ? 1 : (col0 >= C_GATE ? 2 : 0);
            const bool isba = (col0 == C_BETA) || (col0 == C_ALPHA);
#pragma unroll
            for (int ai = 0; ai < 2; ++ai)
#pragma unroll
                for (int m = 0; m < 4; ++m) { const int row = row0 + ai * 128 + m * 16; f32x4 v0 = acc[ai][bj][m][0], v1 = acc[ai][bj][m][1];
                    if (!plain) {
                        if (isba) { float* b = BA + (size_t)row * 16 + (col0 - C_BETA); *(f32x4*)b = v0; *(f32x4*)(b + 4) = v1; }
#pragma unroll
                        for (int e = 0; e < 4; ++e) { const float s0 = sigmoidf_(v0[e]), s1 = sigmoidf_(v1[e]);
                            v0[e] = act == 0 ? v0[e] : (act == 1 ? v0[e] * s0 : s0); v1[e] = act == 0 ? v1[e] : (act == 1 ? v1[e] * s1 : s1); }
                    }
                    u32x4 w; w.x = pg8::cvt_pk_bf16(v0[0], v0[1]); w.y = pg8::cvt_pk_bf16(v0[2], v0[3]); w.z = pg8::cvt_pk_bf16(v1[0], v1[1]); w.w = pg8::cvt_pk_bf16(v1[2], v1[3]);
                    *(u32x4*)(H + (size_t)row * IN_WP + col0) = w; }
        }
    } };
struct MEpiQ { static constexpr bool PERM = true, AFTER_DRAIN = false; static constexpr int SEG = 0; bf16_t* Q; const float2* tab;
    __device__ __forceinline__ void operator()(const f32x4 (&acc)[2][2][4][2], const pg8::Unit& u, int wr, int wc, int fr0, int fq0) const {
        int fr = fr0, fq = fq0; asm volatile("" : "+v"(fr), "+v"(fq));
        const int row0 = u.pm * 256 + wr * 64 + fr;
#pragma unroll
        for (int bj = 0; bj < 2; ++bj) {
            const int wcol = u.pn * 256 + bj * 128 + wc * 32, col0 = wcol + 8 * fq;
            const bool rope = (wcol % 96) == 64;
#pragma unroll
            for (int ai = 0; ai < 2; ++ai)
#pragma unroll
                for (int m = 0; m < 4; ++m) { const int row = row0 + ai * 128 + m * 16; f32x4 v0 = acc[ai][bj][m][0], v1 = acc[ai][bj][m][1];
                    if (rope) { const int p = row < TP ? (row & (SEQ - 1)) : SEQ + ((row - TP) & 7); const float2* tp = tab + p * 16 + (fq & 1) * 8; const bool hi = fq >= 2;
#pragma unroll
                        for (int e = 0; e < 4; ++e) { const float o0 = __shfl_xor(v0[e], 32), o1 = __shfl_xor(v1[e], 32); const float2 c0 = tp[e], c1 = tp[4 + e];
                            v0[e] = hi ? (v0[e] * c0.x + o0 * c0.y) : (v0[e] * c0.x - o0 * c0.y); v1[e] = hi ? (v1[e] * c1.x + o1 * c1.y) : (v1[e] * c1.x - o1 * c1.y); } }
                    u32x4 w; w.x = pg8::cvt_pk_bf16(v0[0], v0[1]); w.y = pg8::cvt_pk_bf16(v0[2], v0[3]); w.z = pg8::cvt_pk_bf16(v1[0], v1[1]); w.w = pg8::cvt_pk_bf16(v1[2], v1[3]);
                    *(u32x4*)(Q + (size_t)row * 768 + col0) = w; if (m == 3) asm volatile("" ::: "memory"); }
        }
    } };
struct MEpiKV { static constexpr bool PERM = true, AFTER_DRAIN = false; static constexpr int SEG = 0; bf16_t* Kn; bf16_t* V;
    __device__ __forceinline__ void operator()(const f32x4 (&acc)[2][2][4][2], const pg8::Unit& u, int wr, int wc, int fr0, int fq0) const {
        int fr = fr0, fq = fq0; asm volatile("" : "+v"(fr), "+v"(fq));
        const int row0 = u.pm * 256 + wr * 64 + fr; bf16_t* base = u.pn < 2 ? Kn : V; const int cb = (u.pn & 1) * 256;
#pragma unroll
        for (int bj = 0; bj < 2; ++bj) { const int col0 = cb + bj * 128 + wc * 32 + 8 * fq;
#pragma unroll
            for (int ai = 0; ai < 2; ++ai)
#pragma unroll
                for (int m = 0; m < 4; ++m) { const int row = row0 + ai * 128 + m * 16; const f32x4 v0 = acc[ai][bj][m][0], v1 = acc[ai][bj][m][1];
                    u32x4 w; w.x = pg8::cvt_pk_bf16(v0[0], v0[1]); w.y = pg8::cvt_pk_bf16(v0[2], v0[3]); w.z = pg8::cvt_pk_bf16(v1[0], v1[1]); w.w = pg8::cvt_pk_bf16(v1[2], v1[3]);
                    *(u32x4*)(base + (size_t)row * 512 + col0) = w; } }
    } };
template <int BR> struct MEpiMerge { static constexpr bool PERM = true, AFTER_DRAIN = false; static constexpr int SEG = 0; const bf16_t* H; float* mf; bf16_t* mb;
    __device__ __forceinline__ void operator()(const f32x4 (&acc)[2][2][4][2], const pg8::Unit& u, int wr, int wc, int fr0, int fq0) const {
        int fr = fr0, fq = fq0; asm volatile("" : "+v"(fr), "+v"(fq));
        const int row0 = u.pm * 256 + wr * 64 + fr;
#pragma unroll
        for (int bj = 0; bj < 2; ++bj) { const int col0 = u.pn * 256 + bj * 128 + wc * 32 + 8 * fq;
#pragma unroll
            for (int ai = 0; ai < 2; ++ai)
#pragma unroll
                for (int m = 0; m < 4; ++m) { const int row = row0 + ai * 128 + m * 16; f32x4 v0 = acc[ai][bj][m][0], v1 = acc[ai][bj][m][1];
                    const u32x4 g = *(const u32x4*)(H + (size_t)row * IN_WP + C_GATE + BR * 1024 + col0);
                    v0[0] *= __uint_as_float(g.x << 16); v0[1] *= __uint_as_float(g.x & 0xffff0000u); v0[2] *= __uint_as_float(g.y << 16); v0[3] *= __uint_as_float(g.y & 0xffff0000u);
                    v1[0] *= __uint_as_float(g.z << 16); v1[1] *= __uint_as_float(g.z & 0xffff0000u); v1[2] *= __uint_as_float(g.w << 16); v1[3] *= __uint_as_float(g.w & 0xffff0000u);
                    float* mp = mf + (size_t)row * 1024 + col0;
                    if (BR > 0) { v0 += *(const f32x4*)mp; v1 += *(const f32x4*)(mp + 4); }
                    if (BR < 2) { *(f32x4*)mp = v0; *(f32x4*)(mp + 4) = v1; }
                    else { u32x4 w; w.x = pg8::cvt_pk_bf16(v0[0], v0[1]); w.y = pg8::cvt_pk_bf16(v0[2], v0[3]); w.z = pg8::cvt_pk_bf16(v1[0], v1[1]); w.w = pg8::cvt_pk_bf16(v1[2], v1[3]);
                        *(u32x4*)(mb + (size_t)row * 1024 + col0) = w; } asm volatile("" ::: "memory"); } }
    } };
struct MEpiRes { static constexpr bool PERM = false, AFTER_DRAIN = false; static constexpr int SEG = 0; const float* xp; const float* xs; float* xo;
    __device__ __forceinline__ void operator()(const f32x4 (&acc)[2][2][4][2], const pg8::Unit& u, int wr, int wc, int fr0, int fq0) const {
        int fr = fr0, fq = fq0; asm volatile("" : "+v"(fr), "+v"(fq));
        const int row0 = u.pm * 256 + wr * 64 + fr, col0 = u.pn * 256 + wc * 32 + 4 * fq;
#pragma unroll
        for (int ai = 0; ai < 2; ++ai)
#pragma unroll
            for (int m = 0; m < 4; ++m) { const int row = row0 + ai * 128 + m * 16; const float* xr = row < TP ? xp + (size_t)row * 1024 : xs + (size_t)(row - TP) * 1024; float* orow = xo + (size_t)row * 1024;
#pragma unroll
                for (int bj = 0; bj < 2; ++bj)
#pragma unroll
                    for (int n = 0; n < 2; ++n) { const int c = col0 + bj * 128 + n * 16; *(f32x4*)(orow + c) = *(const f32x4*)(xr + c) + acc[ai][bj][m][n]; } }
    } };

template <int NSEG, class Epi>
__device__ __forceinline__ void tail_gemm(const bf16_t* __restrict__ A, int lda, const bf16_t* __restrict__ Bt, int K, int N, const Epi& epi, LAS unsigned char* lds) {
    int tid = threadIdx.x; asm volatile("" : "+v"(tid));
    const int lane = tid & 63, wave = __builtin_amdgcn_readfirstlane(tid >> 6), rt = wave & 3, kh = wave >> 2, n = lane & 15, q = lane >> 4;
    const int ntile = 4 * (N / 16), kseg = K / NSEG, khalf = kseg / 2;
    LAS f32x4* red = (LAS f32x4*)lds;
    for (int tile = blockIdx.x; tile < ntile; tile += gridDim.x) {
        const int r0 = 64 * (tile & 3) + 16 * rt, c0 = 16 * (tile >> 2);
        const bf16_t* ap = A + (size_t)(r0 + n) * lda + 8 * q; const bf16_t* bp = Bt + (size_t)(c0 + n) * K + 8 * q;
        f32x4 acc[NSEG];
#pragma unroll
        for (int sg = 0; sg < NSEG; ++sg) { acc[sg] = (f32x4){0.f, 0.f, 0.f, 0.f};
            const int kb = sg * kseg + kh * khalf;
#pragma unroll 4
            for (int k = 0; k < khalf; k += 32) acc[sg] = __builtin_amdgcn_mfma_f32_16x16x32_bf16(*(const bf16x8_t*)(ap + kb + k), *(const bf16x8_t*)(bp + kb + k), acc[sg], 0, 0, 0); }
        __syncthreads();
        if (kh == 1) {
#pragma unroll
            for (int sg = 0; sg < NSEG; ++sg) red[(rt * NSEG + sg) * 64 + lane] = acc[sg]; }
        __syncthreads();
        if (kh == 0) {
#pragma unroll
            for (int sg = 0; sg < NSEG; ++sg) acc[sg] += red[(rt * NSEG + sg) * 64 + lane];
#pragma unroll
            for (int e = 0; e < 4; ++e) { float v[NSEG];
#pragma unroll
                for (int sg = 0; sg < NSEG; ++sg) v[sg] = acc[sg][e];
                epi(r0 + 4 * q + e, c0 + n, v); } }
    }
    __syncthreads();
}
struct TEpiMerge { const bf16_t* H; bf16_t* mb;
    __device__ __forceinline__ void operator()(int row, int col, const float (&v)[3]) const { const size_t t = (size_t)TP + row; const bf16_t* g = H + t * IN_WP + C_GATE + col;
        mb[t * 1024 + col] = f2bf(bf2f(g[0]) * v[0] + bf2f(g[1024]) * v[1] + bf2f(g[2048]) * v[2]); } };
struct TEpiRes { const float* xs; float* xo;
    __device__ __forceinline__ void operator()(int row, int col, const float (&v)[1]) const { xo[((size_t)TP + row) * 1024 + col] = xs[(size_t)row * 1024 + col] + v[0]; } };
struct MEpiMergeS { static constexpr bool PERM = true, AFTER_DRAIN = false; static constexpr int SEG = 3; const bf16_t* H; bf16_t* mb;
    __device__ __forceinline__ void mid(f32x4 (&acc)[2][2][4][2], const pg8::Unit& u, int wr, int wc, int fr0, int fq0, int seg, float keep) const {
        int fr = fr0, fq = fq0; asm volatile("" : "+v"(fr), "+v"(fq));
        const int row0 = u.pm * 256 + wr * 64 + fr;
#pragma unroll
        for (int bj = 0; bj < 2; ++bj) { const int col0 = u.pn * 256 + bj * 128 + wc * 32 + 8 * fq;
#pragma unroll
            for (int ai = 0; ai < 2; ++ai) {
                u32x4 ga[4], gb[4];
#pragma unroll
                for (int m = 0; m < 4; ++m) { const bf16_t* gp = H + (size_t)(row0 + ai * 128 + m * 16) * IN_WP + C_GATE + (seg - 1) * 1024 + col0; ga[m] = *(const u32x4*)gp; gb[m] = *(const u32x4*)(gp + 1024); }
#pragma unroll
                for (int m = 0; m < 4; ++m) { float a[8], b[8]; unpack8(ga[m], a); unpack8(gb[m], b);
#pragma unroll
                    for (int e = 0; e < 4; ++e) { acc[ai][bj][m][0][e] *= keep * a[e] * __builtin_amdgcn_rcpf(fmaxf(b[e], 1e-30f)); acc[ai][bj][m][1][e] *= keep * a[4 + e] * __builtin_amdgcn_rcpf(fmaxf(b[4 + e], 1e-30f)); } }
                asm volatile("" ::: "memory"); } }
    }
    __device__ __forceinline__ void operator()(const f32x4 (&acc)[2][2][4][2], const pg8::Unit& u, int wr, int wc, int fr0, int fq0) const {
        int fr = fr0, fq = fq0; asm volatile("" : "+v"(fr), "+v"(fq));
        const int row0 = u.pm * 256 + wr * 64 + fr;
#pragma unroll
        for (int bj = 0; bj < 2; ++bj) { const int col0 = u.pn * 256 + bj * 128 + wc * 32 + 8 * fq;
#pragma unroll
            for (int ai = 0; ai < 2; ++ai) {
                u32x4 gg[4];
#pragma unroll
                for (int m = 0; m < 4; ++m) gg[m] = *(const u32x4*)(H + (size_t)(row0 + ai * 128 + m * 16) * IN_WP + C_GATE + 2048 + col0);
#pragma unroll
                for (int m = 0; m < 4; ++m) { const int row = row0 + ai * 128 + m * 16; float g[8]; unpack8(gg[m], g);
                    const f32x4 v0 = acc[ai][bj][m][0], v1 = acc[ai][bj][m][1];
                    u32x4 w; w.x = pg8::cvt_pk_bf16(v0[0] * g[0], v0[1] * g[1]); w.y = pg8::cvt_pk_bf16(v0[2] * g[2], v0[3] * g[3]); w.z = pg8::cvt_pk_bf16(v1[0] * g[4], v1[1] * g[5]); w.w = pg8::cvt_pk_bf16(v1[2] * g[6], v1[3] * g[7]);
                    *(u32x4*)(mb + (size_t)row * 1024 + col0) = w; }
                asm volatile("" ::: "memory"); } }
    } };

__device__ __forceinline__ void ph_tr(const float* __restrict__ src, bf16_t* __restrict__ dst, int K, int N, int Npad, LAS float* tile, int rot, int ldd = 0) {
    if (ldd == 0) ldd = K;
    int tid = threadIdx.x; asm volatile("" : "+v"(tid)); const int G = gridDim.x; const int tn = Npad / 64, tk = K / 32, nt = tn * tk;
    const int first = (blockIdx.x + G - (rot % G)) % G;
    const bool al4 = (N & 3) == 0;
    for (int t = first; t < nt; t += G) {
        const int n0 = (t % tn) * 64, k0 = (t / tn) * 32;
        { const int k = tid >> 4, n4 = (tid & 15) * 4, n = n0 + n4; f32x4 v = (f32x4){0.f, 0.f, 0.f, 0.f};
          const float* sp = src + (size_t)(k0 + k) * N + n;
          if (al4 && n + 3 < N) v = *(const f32x4*)sp; else {
#pragma unroll
              for (int e = 0; e < 4; ++e) if (n + e < N) v[e] = sp[e]; }
#pragma unroll
          for (int e = 0; e < 4; ++e) tile[k * 65 + n4 + e] = v[e]; }
        __syncthreads();
        if (tid < 256) { const int n = tid >> 2, kq = (tid & 3) * 8; float f[8];
#pragma unroll
            for (int j = 0; j < 8; ++j) f[j] = tile[(kq + j) * 65 + n];
            *(u32x4*)(dst + (size_t)(n0 + n) * ldd + k0 + kq) = pack8(f); }
        __syncthreads();
    }
}
__device__ __forceinline__ void ph_rope_tab(float2* tab) {
    for (int idx = blockIdx.x * NTHR + threadIdx.x; idx < (SEQ + DEC_SEQ) * 16; idx += gridDim.x * NTHR) {
        const int p = idx >> 4, i = idx & 15; const int pos = p < SEQ ? p : PAST_LEN + (p - SEQ);
        const float inv = powf(10000.0f, -(float)i / 16.0f); const float ang = (float)pos * inv;
        const double rev = (double)ang * 0.15915494309189533576888; const float f = (float)(rev - floor(rev));
        tab[idx] = make_float2(__builtin_amdgcn_cosf(f), __builtin_amdgcn_sinf(f)); }
}
__device__ __forceinline__ void ph_rmsnorm(const float* __restrict__ xp, const float* __restrict__ xs, const float* __restrict__ g, bf16_t* __restrict__ xn, float* __restrict__ yp, float* __restrict__ ys) {
    int tid_o = threadIdx.x; asm volatile("" : "+v"(tid_o)); int lane = tid_o & 63, wave = tid_o >> 6;
    for (int t = blockIdx.x * 8 + wave; t < TT; t += gridDim.x * 8) {
        const float* x = t < TP ? xp + (size_t)t * 1024 : xs + (size_t)(t - TP) * 1024;
        f32x4 v[4]; float ss = 0.f;
#pragma unroll
        for (int i = 0; i < 4; ++i) { v[i] = *(const f32x4*)(x + i * 256 + lane * 4); ss += v[i][0] * v[i][0] + v[i][1] * v[i][1] + v[i][2] * v[i][2] + v[i][3] * v[i][3]; }
        ss = wave_sum(ss); const float r = rsqrtf(ss * (1.0f / 1024.0f) + EPS);
#pragma unroll
        for (int i = 0; i < 4; ++i) { const int c = i * 256 + lane * 4; const f32x4 gg = *(const f32x4*)(g + c); const f32x4 o = v[i] * r * gg;
            if (xn) { u32x2 w; w.x = pg8::cvt_pk_bf16(o[0], o[1]); w.y = pg8::cvt_pk_bf16(o[2], o[3]); *(u32x2*)(xn + (size_t)t * 1024 + c) = w; }
            else { float* y = t < TP ? yp + (size_t)t * 1024 : ys + (size_t)(t - TP) * 1024; *(f32x4*)(y + c) = o; } }
    }
}

constexpr int TK_RS = 1040;
__device__ __forceinline__ void tok8(KP p, int l, int tbase, int iseq0, bool smp, int sq, int lane) {
    const bf16_t* __restrict__ H = p->H; float* __restrict__ out = p->out;
    { const float* qg = p->q_norm_g + l * 384; const float* kvg = p->kv_norm_g + l * 256;
      u32x4 rq[8], rk[8];
#pragma unroll
      for (int e = 0; e < 8; ++e) { const bf16_t* h = H + (size_t)(tbase + e) * IN_WP;
          rq[e] = lane < 48 ? *(const u32x4*)(h + C_Q + lane * 8) : (u32x4){0u, 0u, 0u, 0u}; rk[e] = lane < 32 ? *(const u32x4*)(h + C_KV + lane * 8) : (u32x4){0u, 0u, 0u, 0u}; }
      f32x4 gq0 = (f32x4){0.f, 0.f, 0.f, 0.f}, gq1 = gq0, gk0 = gq0, gk1 = gq0;
      if (lane < 48) { gq0 = *(const f32x4*)(qg + lane * 8); gq1 = *(const f32x4*)(qg + lane * 8 + 4); }
      if (lane < 32) { gk0 = *(const f32x4*)(kvg + lane * 8); gk1 = *(const f32x4*)(kvg + lane * 8 + 4); }
#pragma unroll
      for (int e = 0; e < 8; ++e) { const int t = tbase + e; float q[8], kv[8]; unpack8(rq[e], q); unpack8(rk[e], kv); float s1 = 0.f, s2 = 0.f;
#pragma unroll
          for (int j = 0; j < 8; ++j) { s1 += q[j] * q[j]; s2 += kv[j] * kv[j]; }
          s1 = wave_sum(s1); s2 = wave_sum(s2); const float r1 = rsqrtf(s1 * (1.0f / 384.0f) + EPS), r2 = rsqrtf(s2 * (1.0f / 256.0f) + EPS);
#pragma unroll
          for (int j = 0; j < 4; ++j) { q[j] *= r1 * gq0[j]; q[4 + j] *= r1 * gq1[j]; kv[j] *= r2 * gk0[j]; kv[4 + j] *= r2 * gk1[j]; }
          if (lane < 48) *(u32x4*)(p->cq + (size_t)t * 384 + lane * 8) = pack8(q);
          if (lane < 32) { float* okv = (smp ? out + O_SKV + ((size_t)l * TS + (t - TP)) * 256 : out + O_PKV + ((size_t)l * TP + t) * 256) + lane * 8;
              *(f32x4*)okv = (f32x4){kv[0], kv[1], kv[2], kv[3]}; *(f32x4*)(okv + 4) = (f32x4){kv[4], kv[5], kv[6], kv[7]};
              *(u32x4*)(p->ckv + (size_t)t * 256 + lane * 8) = pack8(kv); } }
#pragma unroll
      for (int ps = 0; ps < 2; ++ps) { const int e = (lane >> 4) + 4 * ps, j = lane & 15, t = tbase + e; const bf16_t* h = H + (size_t)t * IN_WP;
          const float x1 = bf2f(h[C_KR + j]), x2 = bf2f(h[C_KR + 16 + j]); const float2 cs = p->tab[((smp ? SEQ : 0) + iseq0 + e) * 16 + j];
          const float o1 = x1 * cs.x - x2 * cs.y, o2 = x2 * cs.x + x1 * cs.y; float* okr = smp ? out + O_SKR + ((size_t)l * TS + (t - TP)) * 32 : out + O_PKR + ((size_t)l * TP + t) * 32;
          okr[j] = o1; okr[16 + j] = o2; p->Kr[(size_t)t * 32 + j] = f2bf(o1); p->Kr[(size_t)t * 32 + 16 + j] = f2bf(o2); } }
    { const float* conv_w = p->conv_w + (size_t)l * 4 * 1536; const bool last = smp || (iseq0 == SEQ - 8);
#pragma unroll 1
      for (int pi = 0; pi < 3; ++pi) { const int c0 = (pi * 64 + lane) * 8;
          u32x4 rows[11];
#pragma unroll
          for (int j = 0; j < 11; ++j) { const int u = iseq0 - 3 + j;
              if (u >= 0) rows[j] = *(const u32x4*)(H + (size_t)(tbase - 3 + j) * IN_WP + C_QKV + c0);
              else if (smp) { const float* sc = p->state_conv + (((size_t)l * DEC_BATCH + sq) * 3 + (u + 3)) * 1536 + c0; const f32x4 a = *(const f32x4*)sc, b = *(const f32x4*)(sc + 4);
                  rows[j].x = pg8::cvt_pk_bf16(a[0], a[1]); rows[j].y = pg8::cvt_pk_bf16(a[2], a[3]); rows[j].z = pg8::cvt_pk_bf16(b[0], b[1]); rows[j].w = pg8::cvt_pk_bf16(b[2], b[3]); }
              else rows[j] = (u32x4){0u, 0u, 0u, 0u}; }
          f32x4 w0[4], w1[4];
#pragma unroll
          for (int j = 0; j < 4; ++j) { w0[j] = *(const f32x4*)(conv_w + j * 1536 + c0); w1[j] = *(const f32x4*)(conv_w + j * 1536 + c0 + 4); }
          bf16_t* dst = pi == 0 ? p->qd : (pi == 1 ? p->kd : p->vd);
#pragma unroll
          for (int e = 0; e < 8; ++e) { float y[8];
#pragma unroll
              for (int k = 0; k < 8; ++k) y[k] = 0.f;
#pragma unroll
              for (int j = 0; j < 4; ++j) { float x[8]; unpack8(rows[e + j], x);
#pragma unroll
                  for (int k = 0; k < 4; ++k) { y[k] += x[k] * w0[j][k]; y[4 + k] += x[4 + k] * w1[j][k]; } }
              float ss = 0.f;
#pragma unroll
              for (int k = 0; k < 8; ++k) { y[k] = siluf_(y[k]); ss += y[k] * y[k]; }
              if (pi < 2) { ss += __shfl_xor(ss, 1); ss += __shfl_xor(ss, 2); ss += __shfl_xor(ss, 4); const float rn = rsqrtf(ss + EPS) * (pi == 0 ? 0.125f : 1.0f);
#pragma unroll
                  for (int k = 0; k < 8; ++k) y[k] *= rn; }
              *(u32x4*)(dst + (size_t)(tbase + e) * 512 + lane * 8) = pack8(y); }
          if (last) {
#pragma unroll
              for (int rr = 0; rr < 3; ++rr) { float x[8]; unpack8(rows[8 + rr], x);
                  float* oc = (smp ? out + O_SCONV + (((size_t)l * DEC_BATCH + sq) * 3 + rr) * 1536 : out + O_PCONV + (((size_t)l * 8 + (tbase >> 11)) * 3 + rr) * 1536) + c0;
                  *(f32x4*)oc = (f32x4){x[0], x[1], x[2], x[3]}; *(f32x4*)(oc + 4) = (f32x4){x[4], x[5], x[6], x[7]}; } } } }
    { const int t = tbase + (lane >> 3), hd = lane & 7; const float bb = sigmoidf_(p->BA[(size_t)t * 16 + hd]); const float x = p->BA[(size_t)t * 16 + 8 + hd] + p->dt_bias[l * 8 + hd];
      const float sp = x > 20.f ? x : log1pf(expf(x)); const float gg = -expf(p->a_log[l * 8 + hd]) * sp;
      p->bg[(size_t)t * 16 + hd] = bb; p->bg[(size_t)t * 16 + 8 + hd] = gg; }
}
__device__ __forceinline__ void ph_tok(KP p, int l, LAS unsigned char* lds) {
    int tid = threadIdx.x; asm volatile("" : "+v"(tid)); const int pmask = p->pad;
    const int lane = tid & 63, wave = __builtin_amdgcn_readfirstlane(tid >> 6), r = lane & 31, hh = lane >> 5;
    const bf16_t* __restrict__ H = p->H; float* __restrict__ out = p->out;
    for (int tile = blockIdx.x; tile < TP / 64 + 8; tile += gridDim.x) {
        const bool smp = tile >= TP / 64; const int s0 = smp ? (tile - TP / 64) * 4 : 0;
        const int t0 = smp ? TP + s0 * 8 : tile * 64, i0 = smp ? 0 : (t0 & (SEQ - 1)), b = t0 >> 11;
        __syncthreads();
        if (!smp) {
            u32x4 v[10];
#pragma unroll
            for (int i = 0; i < 10; ++i) { const int c = tid + NTHR * i, row = c >> 6, ch16 = c & 63; v[i] = (u32x4){0u, 0u, 0u, 0u};
                if (c < 79 * 64 && i0 - 15 + row >= 0) v[i] = *(const u32x4*)(H + (size_t)(t0 - 15 + row) * IN_WP + C_POOL + ch16 * 8); }
#pragma unroll
            for (int i = 0; i < 10; ++i) { const int c = tid + NTHR * i, row = c >> 6, ch16 = c & 63; if (c < 79 * 64) *(LAS u32x4*)(lds + row * TK_RS + ch16 * 16) = v[i]; }
        } else {
            for (int c = tid; c < 92 * 64; c += NTHR) { const int row = c >> 6, ch16 = c & 63, sq = row / 23, j = row - sq * 23; u32x4 v;
                if (j >= 15) v = *(const u32x4*)(H + (size_t)(t0 + sq * 8 + (j - 15)) * IN_WP + C_POOL + ch16 * 8);
                else { const float* sp = p->state_pool + (((size_t)l * DEC_BATCH + s0 + sq) * 15 + j) * 512 + ch16 * 8; const f32x4 a = *(const f32x4*)sp, bq = *(const f32x4*)(sp + 4);
                    v.x = pg8::cvt_pk_bf16(a[0], a[1]); v.y = pg8::cvt_pk_bf16(a[2], a[3]); v.z = pg8::cvt_pk_bf16(bq[0], bq[1]); v.w = pg8::cvt_pk_bf16(bq[2], bq[3]);
                    if (j >= 8) { float* so = out + O_SPOOL + (((size_t)l * DEC_BATCH + s0 + sq) * 15 + (j - 8)) * 512 + ch16 * 8; *(f32x4*)so = a; *(f32x4*)(so + 4) = bq; } }
                *(LAS u32x4*)(lds + row * TK_RS + ch16 * 16) = v; }
        }
        __syncthreads();
        if ((pmask & 8192) && !(smp && (wave & 1))) { const int g = wave >> 1, th = wave & 1, w = 2 << g, tk = 32 * th + r;
          const int brow = smp ? (tk >> 3) * 23 + 15 + (tk & 7) : 15 + tk; const float inv = 1.0f / (float)(smp ? w : min(i0 + tk + 1, w));
          const bf16_t* mixT = p->PmixT + ((size_t)l * 4 + g) * 128 * 128;
          f32x16 acc[4];
#pragma unroll
          for (int nt = 0; nt < 4; ++nt)
#pragma unroll
              for (int e = 0; e < 16; ++e) acc[nt][e] = 0.f;
#pragma unroll 2
          for (int ks = 0; ks < 8; ++ks) {
              const LAS unsigned char* base = lds + brow * TK_RS + (128 * g + 16 * ks + 8 * hh) * 2;
              float cur[8], sum[8]; unpack8(*(const LAS u32x4*)base, cur);
#pragma unroll
              for (int e = 0; e < 8; ++e) sum[e] = cur[e];
              for (int k = 1; k < w; ++k) { float x[8]; unpack8(*(const LAS u32x4*)(base - k * TK_RS), x);
#pragma unroll
                  for (int e = 0; e < 8; ++e) sum[e] += x[e]; }
#pragma unroll
              for (int e = 0; e < 8; ++e) sum[e] = sum[e] * inv - cur[e];
              union { u32x4 u; bf16x8_t v; } bfr; bfr.u = pack8(sum);
#pragma unroll
              for (int nt = 0; nt < 4; ++nt) { const bf16x8_t a = *(const bf16x8_t*)(mixT + (size_t)(32 * nt + r) * 128 + 16 * ks + 8 * hh);
                  acc[nt] = __builtin_amdgcn_mfma_f32_32x32x16_bf16(a, bfr.v, acc[nt], 0, 0, 0); } }
          const size_t t = (size_t)t0 + tk; const float* scl = p->pool_scale + l * 512 + 128 * g;
#pragma unroll
          for (int nt = 0; nt < 4; ++nt)
#pragma unroll
              for (int gg = 0; gg < 4; ++gg) { const int dd0 = 32 * nt + 8 * gg + 4 * hh; const u32x2 z = *(const u32x2*)(H + t * IN_WP + C_ZPOOL + 128 * g + dd0); const f32x4 sc = *(const f32x4*)(scl + dd0);
                  float v0 = acc[nt][4 * gg + 0] * sc[0] * __uint_as_float(z.x << 16), v1 = acc[nt][4 * gg + 1] * sc[1] * __uint_as_float(z.x & 0xffff0000u);
                  float v2 = acc[nt][4 * gg + 2] * sc[2] * __uint_as_float(z.y << 16), v3 = acc[nt][4 * gg + 3] * sc[3] * __uint_as_float(z.y & 0xffff0000u);
                  u32x2 o; o.x = pg8::cvt_pk_bf16(v0, v1); o.y = pg8::cvt_pk_bf16(v2, v3); *(u32x2*)(p->ya + t * 1536 + 128 * g + dd0) = o; } }
        if (!smp) { if (i0 == SEQ - 64) { for (int c = tid; c < 15 * 512; c += NTHR) { const int rr = c >> 9, ch = c & 511;
              out[O_PPOOL + (((size_t)l * 8 + b) * 15 + rr) * 512 + ch] = bf2f(*(const LAS bf16_t*)(lds + (15 + 49 + rr) * TK_RS + ch * 2)); } } }
        else { for (int c = tid; c < 4 * 8 * 512; c += NTHR) { const int sq = c >> 12, i = (c >> 9) & 7, ch = c & 511;
              out[O_SPOOL + (((size_t)l * DEC_BATCH + s0 + sq) * 15 + 7 + i) * 512 + ch] = bf2f(*(const LAS bf16_t*)(lds + (sq * 23 + 15 + i) * TK_RS + ch * 2)); } }
        if (pmask & 16384) { if (!smp) tok8(p, l, t0 + wave * 8, i0 + wave * 8, false, 0, lane);
        else if (wave < 4) tok8(p, l, t0 + wave * 8, 0, true, s0 + wave, lane); }
    }
    __syncthreads();
}

template <bool SYNC> __device__ __forceinline__ void wu_delta(KP p, int l, int s, int h, int lane, LAS unsigned char* wl) {
    asm volatile("" : "+v"(lane)); int dv = lane;
    const size_t row0 = (size_t)TP + s * 8;
    float* so = p->out + O_SDELTA + (((size_t)l * DEC_BATCH + s) * 8 + h) * 4096;
    const float* s0 = p->state_delta + (((size_t)l * DEC_BATCH + s) * 8 + h) * 4096;
    { const size_t t = row0 + (lane >> 3); const int part = lane & 7;
      const u32x4 kv = *(const u32x4*)(p->kd + t * 512 + h * 64 + part * 8), qv = *(const u32x4*)(p->qd + t * 512 + h * 64 + part * 8);
      *(LAS u32x4*)(wl + lane * 16) = kv; *(LAS u32x4*)(wl + 1024 + lane * 16) = qv; }
    float vv[8], zz[8];
#pragma unroll
    for (int i = 0; i < 8; ++i) { vv[i] = bf2f(p->vd[(row0 + i) * 512 + h * 64 + dv]); zz[i] = bf2f(p->H[(row0 + i) * IN_WP + C_ZDN + h * 64 + dv]); }
    float bl = 0.f, al = 0.f;
    if (lane < 8) { bl = p->bg[(row0 + lane) * 16 + h]; al = __expf(p->bg[(row0 + lane) * 16 + 8 + h]); }
    float S[64];
#pragma unroll
    for (int k = 0; k < 64; ++k) S[k] = s0[k * 64 + dv];
    const float gn = p->dn_norm_g[l * 64 + dv];
    if (SYNC) __builtin_amdgcn_s_barrier();
#pragma unroll
    for (int i = 0; i < 8; ++i) {
        asm volatile("" ::: "memory");
        const float b = __int_as_float(__builtin_amdgcn_readlane(__float_as_int(bl), i)), a = __int_as_float(__builtin_amdgcn_readlane(__float_as_int(al), i));
        u32x4 kk[8];
#pragma unroll
        for (int c = 0; c < 8; ++c) kk[c] = *(const LAS u32x4*)(wl + i * 128 + c * 16);
        float ks = 0.f;
#pragma unroll
        for (int c = 0; c < 8; ++c)
#pragma unroll
            for (int e = 0; e < 4; ++e) { const unsigned w = kk[c][e]; ks += __uint_as_float(w << 16) * S[c * 8 + 2 * e] + __uint_as_float(w & 0xffff0000u) * S[c * 8 + 2 * e + 1]; }
        const float vn = b * (vv[i] - a * ks); float o = 0.f;
#pragma unroll
        for (int c = 0; c < 8; ++c) { const u32x4 qv = *(const LAS u32x4*)(wl + 1024 + i * 128 + c * 16);
#pragma unroll
            for (int e = 0; e < 4; ++e) { const unsigned w = kk[c][e], wq = qv[e]; const int k0 = c * 8 + 2 * e;
                S[k0] = a * S[k0] + __uint_as_float(w << 16) * vn; o += __uint_as_float(wq << 16) * S[k0];
                S[k0 + 1] = a * S[k0 + 1] + __uint_as_float(w & 0xffff0000u) * vn; o += __uint_as_float(wq & 0xffff0000u) * S[k0 + 1]; }
            asm volatile("" ::: "memory"); }
        const float ss = wave_sum(o * o); const float y = o * rsqrtf(ss * (1.0f / 64.0f) + EPS) * gn;
        p->yc[(row0 + i) * 1536 + h * 64 + dv] = f2bf(y * zz[i]);
        if (SYNC) {
#pragma unroll
            for (int k = 0; k < 8; ++k) __builtin_amdgcn_s_barrier(); }
    }
#pragma unroll
    for (int k = 0; k < 64; ++k) so[k * 64 + dv] = S[k];
}
__device__ __forceinline__ int sig_inv(int rho) { return (rho & 32) | ((rho & 12) << 1) | ((rho & 16) >> 2) | (rho & 3); }
constexpr int DPRE_LDS = 64 * 64 * 4 + 512;
constexpr int DST = 72;
__device__ __forceinline__ void dpre_flush(const LAS bf16_t* St, bf16_t* gdst, int lane) {
    asm volatile("s_waitcnt lgkmcnt(0)" ::: "memory");
#pragma unroll
    for (int it = 0; it < 8; ++it) { const int row = (lane >> 3) + 8 * it, chunk = lane & 7; *(u32x4*)(gdst + row * 64 + chunk * 8) = *(const LAS u32x4*)(St + row * DST + chunk * 8); }
    asm volatile("s_waitcnt lgkmcnt(0)" ::: "memory");
}
__device__ __forceinline__ void ph_delta_pre(KP p, LAS unsigned char* lds) {
    int tid_o = threadIdx.x; asm volatile("" : "+v"(tid_o)); int lane = tid_o & 63, wave = tid_o >> 6;
    wave = __builtin_amdgcn_readfirstlane(wave);
    LAS float* Am = (LAS float*)(lds + wave * DPRE_LDS); LAS float* gcs = Am + 4096; LAS float* bts = gcs + 64; LAS bf16_t* St = (LAS bf16_t*)Am;
    for (int unit = wave * gridDim.x + blockIdx.x; unit < 2048; unit += gridDim.x * 8) {
        { int t_ = threadIdx.x; asm volatile("" : "+v"(t_)); lane = t_ & 63; }
        const int r = lane & 31, hh = lane >> 5;
        const int bh = unit >> 5, ch = unit & 31, b = bh >> 3, h = bh & 7;
        const size_t t0 = (size_t)b * SEQ + ch * 64;
        bf16_t* op = p->DOP + (size_t)unit * 4 * 4096; float* up = p->DU + (size_t)unit * 4096;
        const bf16_t* kdb = p->kd + t0 * 512 + h * 64; const bf16_t* qdb = p->qd + t0 * 512 + h * 64; const bf16_t* vdb = p->vd + t0 * 512 + h * 64;
        const float* bgb = p->bg + t0 * 16 + h;
        const float beta = bgb[lane * 16]; float gc = bgb[lane * 16 + 8];
#pragma unroll
        for (int d = 1; d < 64; d <<= 1) { const float x = __shfl_up(gc, d); if (lane >= d) gc += x; }
        const float gl = __shfl(gc, 63); const float egc = __expf(gc);
        gcs[lane] = gc; bts[lane] = beta;
        if (lane == 0) p->DG[unit] = __expf(gl);
        bf16x8_t kf[2][4], qf[2][4];
        { const int voff = r * 512 + 8 * hh;
#pragma unroll
          for (int rb = 0; rb < 2; ++rb)
#pragma unroll
            for (int ks = 0; ks < 4; ++ks) { kf[rb][ks] = *(const bf16x8_t*)(kdb + (32 * rb * 512 + 16 * ks) + voff); qf[rb][ks] = *(const bf16x8_t*)(qdb + (32 * rb * 512 + 16 * ks) + voff); } }
        {
#pragma unroll
            for (int rb = 0; rb < 2; ++rb) { const float sc = __expf(gl - __shfl(gc, 32 * rb + r)); const int pos = sig_inv(32 * rb + r);
#pragma unroll
                for (int ks = 0; ks < 4; ++ks)
#pragma unroll
                    for (int jj = 0; jj < 8; ++jj) St[(16 * ks + 8 * hh + jj) * DST + pos] = f2bf(bf2f((bf16_t)kf[rb][ks][jj]) * sc); }
            dpre_flush(St, op + 3 * 4096, lane);
#pragma unroll
            for (int rb = 0; rb < 2; ++rb) { const float sc = __shfl(egc, 32 * rb + r);
#pragma unroll
                for (int ks = 0; ks < 4; ++ks)
#pragma unroll
                    for (int jj = 0; jj < 8; ++jj) St[(32 * rb + r) * DST + sig_inv(16 * ks + 8 * hh + jj)] = f2bf(bf2f((bf16_t)qf[rb][ks][jj]) * sc); }
            dpre_flush(St, op + 1 * 4096, lane);
        }
        float xu[64];
        {
#pragma unroll
            for (int it = 0; it < 8; ++it) { const int row = (lane >> 3) + 8 * it, chunk = lane & 7; *(LAS u32x4*)(St + row * DST + chunk * 8) = *(const u32x4*)(vdb + row * 512 + chunk * 8); }
            asm volatile("s_waitcnt lgkmcnt(0)" ::: "memory");
            const int beta_i = __float_as_int(beta);
#pragma unroll
            for (int i = 0; i < 64; ++i) xu[i] = __int_as_float(__builtin_amdgcn_readlane(beta_i, i)) * bf2f(St[i * DST + lane]);
            asm volatile("s_waitcnt lgkmcnt(0)" ::: "memory");
        }
        {
            const float gcj0 = __shfl(gc, r), gcj1 = __shfl(gc, 32 + r);
            const int p0 = sig_inv(r), p1 = sig_inv(32 + r);
            { f32x16 t00, t10, t11;
#pragma unroll
              for (int e = 0; e < 16; ++e) { t00[e] = 0.f; t10[e] = 0.f; t11[e] = 0.f; }
#pragma unroll
              for (int ks = 0; ks < 4; ++ks) {
                  t00 = __builtin_amdgcn_mfma_f32_32x32x16_bf16(qf[0][ks], kf[0][ks], t00, 0, 0, 0);
                  t10 = __builtin_amdgcn_mfma_f32_32x32x16_bf16(qf[1][ks], kf[0][ks], t10, 0, 0, 0);
                  t11 = __builtin_amdgcn_mfma_f32_32x32x16_bf16(qf[1][ks], kf[1][ks], t11, 0, 0, 0); }
#pragma unroll
              for (int e = 0; e < 16; ++e) { const int il = (e & 3) + 8 * (e >> 2) + 4 * hh;
                  { const int i = il, j = r; St[i * DST + p0] = f2bf(j <= i ? t00[e] * __expf(fminf(gcs[i] - gcj0, 0.f)) : 0.f); St[i * DST + p1] = 0; }
                  { const int i = 32 + il; St[i * DST + p0] = f2bf(t10[e] * __expf(fminf(gcs[i] - gcj0, 0.f))); }
                  { const int i = 32 + il, j = 32 + r; St[i * DST + p1] = f2bf(j <= i ? t11[e] * __expf(fminf(gcs[i] - gcj1, 0.f)) : 0.f); } }
              dpre_flush(St, op + 2 * 4096, lane); }
            { f32x16 t00, t10, t11;
#pragma unroll
              for (int e = 0; e < 16; ++e) { t00[e] = 0.f; t10[e] = 0.f; t11[e] = 0.f; }
#pragma unroll
              for (int ks = 0; ks < 4; ++ks) {
                  t00 = __builtin_amdgcn_mfma_f32_32x32x16_bf16(kf[0][ks], kf[0][ks], t00, 0, 0, 0);
                  t10 = __builtin_amdgcn_mfma_f32_32x32x16_bf16(kf[1][ks], kf[0][ks], t10, 0, 0, 0);
                  t11 = __builtin_amdgcn_mfma_f32_32x32x16_bf16(kf[1][ks], kf[1][ks], t11, 0, 0, 0); }
#pragma unroll
              for (int e = 0; e < 16; ++e) { const int il = (e & 3) + 8 * (e >> 2) + 4 * hh;
                  { const int i = il, j = r; Am[i * 64 + j] = j < i ? bts[i] * t00[e] * __expf(fminf(gcs[i] - gcj0, 0.f)) : 0.f; }
                  { const int i = 32 + il, j = r; Am[i * 64 + j] = bts[i] * t10[e] * __expf(fminf(gcs[i] - gcj0, 0.f)); }
                  { const int i = 32 + il, j = 32 + r; Am[i * 64 + j] = j < i ? bts[i] * t11[e] * __expf(fminf(gcs[i] - gcj1, 0.f)) : 0.f; } } }
        }
        asm volatile("s_waitcnt lgkmcnt(0)" ::: "memory");
        {
            int c; { int t_ = threadIdx.x; asm volatile("" : "+v"(t_)); c = t_ & 63; } const int pc = sig_inv(c);
            const int beta_i = __float_as_int(beta), egc_i = __float_as_int(egc);
#pragma unroll
            for (int i = 1; i < 64; ++i) { float au = xu[i];
#pragma unroll
                for (int j4 = 0; j4 < i; j4 += 4) { const f32x4 a = *(const LAS f32x4*)(Am + i * 64 + j4);
#pragma unroll
                    for (int e = 0; e < 4; ++e) if (j4 + e < i) au -= a[e] * xu[j4 + e]; }
                xu[i] = au; }
#pragma unroll
            for (int k = 0; k < 16; ++k)
                *(f32x4*)(up + ((((c >> 4) * 4 + (k >> 2)) * 64 + (k & 3) * 16 + (c & 15)) << 2)) = (f32x4){xu[4 * k], xu[4 * k + 1], xu[4 * k + 2], xu[4 * k + 3]};
            asm volatile("" ::: "memory");
            { float w[64];
#pragma unroll
              for (int i = 0; i < 64; ++i) w[i] = __int_as_float(__builtin_amdgcn_readlane(beta_i, i)) * __int_as_float(__builtin_amdgcn_readlane(egc_i, i)) * bf2f((kdb + i * 512)[c]);
#pragma unroll
              for (int i = 1; i < 64; ++i) { float aw = w[i];
#pragma unroll
                  for (int j4 = 0; j4 < i; j4 += 4) { const f32x4 a = *(const LAS f32x4*)(Am + i * 64 + j4);
#pragma unroll
                      for (int e = 0; e < 4; ++e) if (j4 + e < i) aw -= a[e] * w[j4 + e]; }
                  w[i] = aw; }
              asm volatile("s_waitcnt lgkmcnt(0)" ::: "memory");
#pragma unroll
              for (int i = 0; i < 64; ++i) St[i * DST + pc] = f2bf(-w[i]); }
            dpre_flush(St, op, lane);
        }
    }
}
__device__ __forceinline__ void st_rows2(bf16_t* row0, bf16_t* row1, unsigned pos, float a, float b, bool even) {
    const float x = even ? b : a;
    const float y = __int_as_float(__builtin_amdgcn_mov_dpp(__float_as_int(x), 0xB1, 0xF, 0xF, true));
    const unsigned w = even ? pg8::cvt_pk_bf16(a, y) : pg8::cvt_pk_bf16(y, b);
    bf16_t* dst = even ? row0 + pos : row1 + (pos - 1u);
    *(unsigned*)dst = w;
}
constexpr int BSS = 144, BS_NBAR = 65;
struct BsSet { bf16x8_t w0, w1, g0, g1, k0, k1, t0, t1; f32x4 u; };
__device__ __forceinline__ void bs_load(BsSet& c, const bf16_t* op, const float* up) {
    c.w0 = *(const bf16x8_t*)(op); c.w1 = *(const bf16x8_t*)(op + 32); c.g0 = *(const bf16x8_t*)(op + 4096); c.g1 = *(const bf16x8_t*)(op + 4096 + 32);
    c.k0 = *(const bf16x8_t*)(op + 8192); c.k1 = *(const bf16x8_t*)(op + 8192 + 32); c.t0 = *(const bf16x8_t*)(op + 12288); c.t1 = *(const bf16x8_t*)(op + 12288 + 32);
    c.u = *(const f32x4*)up;
}
__device__ __forceinline__ u32x2 pack_h(const f32x4& v) { u32x2 w; w.x = pg8::cvt_pk_bf16(v[0], v[1]); w.y = pg8::cvt_pk_bf16(v[2], v[3]); return w; }
__device__ __forceinline__ void bs_step(BsSet& c, f32x4& S, float eg, LAS unsigned char* SB, LAS unsigned char* VB, int rd, int wr, bool hik, bf16_t* yo, unsigned n, bool even, const bf16_t* opn, const float* upn) {
    const bf16x8_t sb0 = *(const LAS bf16x8_t*)(SB + rd), sb1 = *(const LAS bf16x8_t*)(SB + rd + 64);
    f32x4 vn = __builtin_amdgcn_mfma_f32_16x16x32_bf16(c.w0, sb0, c.u, 0, 0, 0); vn = __builtin_amdgcn_mfma_f32_16x16x32_bf16(c.w1, sb1, vn, 0, 0, 0);
    f32x4 o = __builtin_amdgcn_mfma_f32_16x16x32_bf16(c.g0, sb0, (f32x4){0.f, 0.f, 0.f, 0.f}, 0, 0, 0); o = __builtin_amdgcn_mfma_f32_16x16x32_bf16(c.g1, sb1, o, 0, 0, 0);
    *(LAS u32x2*)(VB + wr) = pack_h(vn);
    __syncthreads();
    const bf16x8_t vb0 = *(const LAS bf16x8_t*)(VB + rd), vb1 = *(const LAS bf16x8_t*)(VB + rd + 64);
    o = __builtin_amdgcn_mfma_f32_16x16x32_bf16(c.k0, vb0, o, 0, 0, 0);
    if (hik) o = __builtin_amdgcn_mfma_f32_16x16x32_bf16(c.k1, vb1, o, 0, 0, 0);
    S = S * eg;
    S = __builtin_amdgcn_mfma_f32_16x16x32_bf16(c.t0, vb0, S, 0, 0, 0); S = __builtin_amdgcn_mfma_f32_16x16x32_bf16(c.t1, vb1, S, 0, 0, 0);
    *(LAS u32x2*)(SB + wr) = pack_h(S);
    bs_load(c, opn, upn);
#pragma unroll
    for (int e = 0; e < 4; e += 2) st_rows2(yo + (size_t)e * 1536, yo + (size_t)(e + 1) * 1536, n, o[e], o[e + 1], even);
    __syncthreads();
}
__device__ __forceinline__ void slice_scan(KP p, int l, int unit, LAS unsigned char* lds, int lane, int mt) {
    asm volatile("" : "+v"(lane));
    const int n = lane & 15, q = lane >> 4, bh = unit >> 2, slice = unit & 3, b = bh >> 3, h = bh & 7;
    LAS unsigned char* SB = lds; LAS unsigned char* VB = lds + 16 * BSS;
    const int pos0 = ((mt & 2) << 4) + 8 * q + ((mt & 1) << 2);
    const int wr = n * BSS + pos0 * 2, rd = n * BSS + 16 * q;
    const bf16_t* op0 = p->DOP + (size_t)bh * 32 * 4 * 4096 + mt * 1024 + n * 64 + 8 * q;
    const float* up0 = p->DU + (size_t)bh * 32 * 4096 + ((slice * 4 + mt) * 64 + lane) * 4;
    const float egv = p->DG[bh * 32 + (lane & 31)];
    bf16_t* yo0 = p->yc + ((size_t)b * SEQ + 16 * mt + 4 * q) * 1536 + h * 64 + 16 * slice;
    __builtin_amdgcn_s_waitcnt(0);
    BsSet st[4];
#pragma unroll
    for (int i = 0; i < 4; ++i) bs_load(st[i], op0 + (size_t)i * 16384, up0 + (size_t)i * 4096);
    f32x4 S = (f32x4){0.f, 0.f, 0.f, 0.f};
    { unsigned z = 0u; asm volatile("" : "+v"(z)); *(LAS u32x2*)(SB + wr) = (u32x2){z, z}; }
    __syncthreads();
    const bool hik = mt >= 2, even = (lane & 1) == 0;
#pragma unroll 1
    for (int ch = 0; ch < 32; ch += 4) {
#pragma unroll
        for (int i = 0; i < 4; ++i) { const int cn = ch + i + 4 < 32 ? ch + i + 4 : 31;
            const float eg = __int_as_float(__builtin_amdgcn_readlane(__float_as_int(egv), ch + i));
            bs_step(st[i], S, eg, SB, VB, rd, wr, hik, yo0 + (size_t)(ch + i) * 64 * 1536, (unsigned)n, even, op0 + (size_t)cn * 16384, up0 + (size_t)cn * 4096); }
    }
    float* so = p->out + O_PDELTA + (((size_t)l * 8 + b) * 8 + h) * 4096 + (16 * mt + 4 * q) * 64 + 16 * slice + n;
#pragma unroll
    for (int e = 0; e < 4; ++e) so[e * 64] = S[e];
}
__device__ __forceinline__ void ph_delta_fin(KP p, int l) {
    int tid_o = threadIdx.x; asm volatile("" : "+v"(tid_o)); int lane = tid_o & 63, wave = tid_o >> 6;
    const int h = lane >> 3, d0 = (lane & 7) * 8;
    for (int t = blockIdx.x * 8 + wave; t < TP; t += gridDim.x * 8) {
        bf16_t* yp = p->yc + (size_t)t * 1536 + h * 64 + d0; const u32x4 raw = *(const u32x4*)yp; const u32x4 gz = *(const u32x4*)(p->H + (size_t)t * IN_WP + C_ZDN + h * 64 + d0);
        float v[8]; v[0] = __uint_as_float(raw.x << 16); v[1] = __uint_as_float(raw.x & 0xffff0000u); v[2] = __uint_as_float(raw.y << 16); v[3] = __uint_as_float(raw.y & 0xffff0000u);
        v[4] = __uint_as_float(raw.z << 16); v[5] = __uint_as_float(raw.z & 0xffff0000u); v[6] = __uint_as_float(raw.w << 16); v[7] = __uint_as_float(raw.w & 0xffff0000u);
        float z[8]; z[0] = __uint_as_float(gz.x << 16); z[1] = __uint_as_float(gz.x & 0xffff0000u); z[2] = __uint_as_float(gz.y << 16); z[3] = __uint_as_float(gz.y & 0xffff0000u);
        z[4] = __uint_as_float(gz.z << 16); z[5] = __uint_as_float(gz.z & 0xffff0000u); z[6] = __uint_as_float(gz.w << 16); z[7] = __uint_as_float(gz.w & 0xffff0000u);
        float ss = 0.f;
#pragma unroll
        for (int e = 0; e < 8; ++e) ss += v[e] * v[e];
        ss += __shfl_xor(ss, 1); ss += __shfl_xor(ss, 2); ss += __shfl_xor(ss, 4);
        const float rs = rsqrtf(ss * (1.0f / 64.0f) + EPS);
#pragma unroll
        for (int e = 0; e < 8; ++e) v[e] = v[e] * rs * p->dn_norm_g[l * 64 + d0 + e] * z[e];
        u32x4 w; w.x = pg8::cvt_pk_bf16(v[0], v[1]); w.y = pg8::cvt_pk_bf16(v[2], v[3]); w.z = pg8::cvt_pk_bf16(v[4], v[5]); w.w = pg8::cvt_pk_bf16(v[6], v[7]);
        *(u32x4*)yp = w;
    }
}

__device__ __forceinline__ void ph_att_waves(KP p, int l, LAS unsigned char* lds) {
    int tid_o = threadIdx.x; asm volatile("" : "+v"(tid_o)); int lane = tid_o & 63, wave = tid_o >> 6;
    wave = __builtin_amdgcn_readfirstlane(wave);
    const int G = gridDim.x;
    TP_DECL; TP_ON(20);
    for (int u = blockIdx.x; u < 256; u += G) {
        if (wave < 4) slice_scan(p, l, u, lds, lane, wave);
        else if (wave == 4) wu_delta<true>(p, l, u >> 3, u & 7, lane, lds + 32768);
        else { for (int k = 0; k < BS_NBAR; ++k) __builtin_amdgcn_s_barrier(); }
    }
    if (wave == 0) TP_OFFW(20, 0);
}
__device__ __forceinline__ void ph_fin(KP p, int l, LAS unsigned char* lds) {
    int tid_o = threadIdx.x; asm volatile("" : "+v"(tid_o)); int lane = tid_o & 63, wave = tid_o >> 6;
    LAS float* ol = (LAS float*)(lds + wave * 1024);
    const float* w_uv = p->w_uv + (size_t)l * 256 * 512;
    const int cq = lane >> 4, d4 = lane & 15;
    for (int u = blockIdx.x * 8 + wave; u < TS * 8; u += gridDim.x * 8) {
        const int ts = u >> 3, h = u & 7, s = ts >> 3, r = (ts & 7) * 8 + h;
        const float* pb = p->part + ((size_t)s * SA_CH * 64 + r) * 258;
        float mc = -1e30f, lc = 0.f;
        if (lane < SA_CH) { mc = pb[(size_t)lane * 64 * 258 + 256]; lc = pb[(size_t)lane * 64 * 258 + 257]; }
        float M = mc;
#pragma unroll
        for (int o = 1; o < 8; o <<= 1) M = fmaxf(M, __shfl_xor(M, o));
        const float wc = lane < SA_CH ? __expf(mc - M) : 0.f; float L = lc * wc;
#pragma unroll
        for (int o = 1; o < 8; o <<= 1) L += __shfl_xor(L, o);
        const float iL = 1.0f / __int_as_float(__builtin_amdgcn_readlane(__float_as_int(L), 0));
        f32x4 acc = (f32x4){0.f, 0.f, 0.f, 0.f};
#pragma unroll
        for (int ch = 0; ch < SA_CH; ++ch) { const float w = __int_as_float(__builtin_amdgcn_readlane(__float_as_int(wc), ch)); const float* pp = pb + (size_t)ch * 64 * 258 + 4 * lane;
            const f32x2 a0 = *(const f32x2*)pp, a1 = *(const f32x2*)(pp + 2); acc[0] += w * a0[0]; acc[1] += w * a0[1]; acc[2] += w * a1[0]; acc[3] += w * a1[1]; }
        *(LAS f32x4*)(ol + 4 * lane) = acc * iL;
        asm volatile("s_waitcnt lgkmcnt(0)" ::: "memory");
        f32x4 o = (f32x4){0.f, 0.f, 0.f, 0.f}; const float* wp = w_uv + (size_t)(cq * 64) * 512 + h * 64 + 4 * d4;
#pragma unroll 16
        for (int c = 0; c < 64; ++c) { const f32x4 wv = *(const f32x4*)(wp + (size_t)c * 512); const float x = ol[cq * 64 + c]; o += wv * x; }
#pragma unroll
        for (int e = 0; e < 4; ++e) { o[e] += __shfl_xor(o[e], 16); o[e] += __shfl_xor(o[e], 32); }
        if (cq == 0) { const int t = TP + ts; const u32x2 gz = *(const u32x2*)(p->H + (size_t)t * IN_WP + C_ZMLA + h * 64 + 4 * d4);
            u32x2 w; w.x = pg8::cvt_pk_bf16(o[0] * __uint_as_float(gz.x << 16), o[1] * __uint_as_float(gz.x & 0xffff0000u)); w.y = pg8::cvt_pk_bf16(o[2] * __uint_as_float(gz.y << 16), o[3] * __uint_as_float(gz.y & 0xffff0000u));
            *(u32x2*)(p->yb + (size_t)t * 1536 + h * 64 + 4 * d4) = w; }
        asm volatile("s_waitcnt lgkmcnt(0)" ::: "memory");
    }
}

constexpr int SA_QS = 592, SA_KS = 592, SA_PS = 272;
constexpr int SA_OFF_Q = 0, SA_OFF_K = 64 * SA_QS, SA_OFF_P = SA_OFF_K + 128 * SA_KS, SA_OFF_M = SA_OFF_P + 64 * SA_PS, SA_OFF_L = SA_OFF_M + 1024, SA_LDS = SA_OFF_L + 1024;
typedef short s16x4 __attribute__((ext_vector_type(4)));
__device__ __forceinline__ void sa_unit(KP p, int l, int s, int ch, LAS unsigned char* lds, int tid) {
    const int lane = tid & 63, wave = __builtin_amdgcn_readfirstlane(tid >> 6), r = lane & 31, hh = lane >> 5;
    const int qb = wave & 1, kb = wave >> 1, cg = wave >> 1;
    LAS unsigned char* Qs = lds + SA_OFF_Q; LAS unsigned char* Kt = lds + SA_OFF_K; LAS unsigned char* Pt = lds + SA_OFF_P;
    LAS float* mloc = (LAS float*)(lds + SA_OFF_M); LAS float* lred = (LAS float*)(lds + SA_OFF_L);
    TP_DECL; TP_ON(10); TP_ON(11);
    __syncthreads();
    { const bf16_t* wb = p->WukB + (size_t)l * 256 * 512 + (size_t)r * 512 + wave * 64 + 8 * hh; const bf16_t* Qg = p->Q + (size_t)(TP + s * 8) * 768;
      bf16x8_t qv[4];
#pragma unroll
      for (int ks = 0; ks < 4; ++ks) { u32x4 z = (u32x4){0u, 0u, 0u, 0u}; if (r < 8) z = *(const u32x4*)(Qg + r * 768 + wave * 96 + ks * 16 + 8 * hh); union { u32x4 u; bf16x8_t v; } x; x.u = z; qv[ks] = x.v; }
#pragma unroll
      for (int cb = 0; cb < 8; ++cb) { f32x16 acc;
#pragma unroll
          for (int e = 0; e < 16; ++e) acc[e] = 0.f;
#pragma unroll
          for (int ks = 0; ks < 4; ++ks) acc = __builtin_amdgcn_mfma_f32_32x32x16_bf16(*(const bf16x8_t*)(wb + (size_t)(32 * cb) * 512 + ks * 16), qv[ks], acc, 0, 0, 0);
          if (r < 8) {
#pragma unroll
              for (int g4 = 0; g4 < 4; ++g4) { u32x2 w; w.x = pg8::cvt_pk_bf16(acc[4 * g4], acc[4 * g4 + 1]); w.y = pg8::cvt_pk_bf16(acc[4 * g4 + 2], acc[4 * g4 + 3]);
                  *(LAS u32x2*)(Qs + (r * 8 + wave) * SA_QS + (32 * cb + 8 * g4 + 4 * hh) * 2) = w; } } }
      for (int e = tid; e < 64 * 32; e += NTHR) { const int rr = e >> 5, j = e & 31; *(LAS bf16_t*)(Qs + rr * SA_QS + (256 + j) * 2) = Qg[(rr >> 3) * 768 + (rr & 7) * 96 + 64 + j]; } }
    TP_OFF(11);
    const int* pt = p->page_table + s * N_PAGES + ch * 16;
    const float* ckv_base = p->cache_kv + (size_t)l * N_POOL * PAGE * 256; const float* ckr_base = p->cache_kr + (size_t)l * N_POOL * PAGE * 32;
    f32x4 rk[16], rr2[2];
    { const int page = pt[0]; const float* kvp = ckv_base + (size_t)page * PAGE * 256; const float* krp = ckr_base + (size_t)page * PAGE * 32;
#pragma unroll
      for (int i = 0; i < 16; ++i) rk[i] = __builtin_nontemporal_load((const f32x4*)(kvp + (size_t)(tid + 512 * i) * 4));
#pragma unroll
      for (int i = 0; i < 2; ++i) rr2[i] = __builtin_nontemporal_load((const f32x4*)(krp + (size_t)(tid + 512 * i) * 4)); }
    f32x16 o0, o1;
#pragma unroll
    for (int e = 0; e < 16; ++e) { o0[e] = 0.f; o1[e] = 0.f; }
    float m = -1e30f, lw = 0.f;
    const int li = lane & 15, g1 = (lane >> 4) & 1;
    const int trOff = (8 * hh + (li >> 2)) * SA_KS + (16 * g1 + 4 * (li & 3)) * 2;
    const int ntile = ch == 7 ? 17 : 16;
    for (int t = 0; t < ntile; ++t) {
        TP_ON(12); TP_ON(16);
        __syncthreads();
        TP_OFF(16);
        if (t < 16) {
#pragma unroll
            for (int i = 0; i < 16; ++i) { const int ci = tid + 512 * i, key = ci >> 6, c4 = ci & 63; u32x2 w; w.x = pg8::cvt_pk_bf16(rk[i][0], rk[i][1]); w.y = pg8::cvt_pk_bf16(rk[i][2], rk[i][3]);
                *(LAS u32x2*)(Kt + key * SA_KS + c4 * 8) = w; }
#pragma unroll
            for (int i = 0; i < 2; ++i) { const int ci = tid + 512 * i, key = ci >> 3, c4 = ci & 7; u32x2 w; w.x = pg8::cvt_pk_bf16(rr2[i][0], rr2[i][1]); w.y = pg8::cvt_pk_bf16(rr2[i][2], rr2[i][3]);
                *(LAS u32x2*)(Kt + key * SA_KS + 512 + c4 * 8) = w; }
        } else {
            for (int e = tid; e < 128 * 36; e += NTHR) { const int key = e / 36, c16 = e - key * 36; u32x4 v = (u32x4){0u, 0u, 0u, 0u};
                if (key < 8) v = c16 < 32 ? *(const u32x4*)(p->ckv + ((size_t)TP + s * 8 + key) * 256 + c16 * 8) : *(const u32x4*)(p->Kr + ((size_t)TP + s * 8 + key) * 32 + (c16 - 32) * 8);
                *(LAS u32x4*)(Kt + key * SA_KS + c16 * 16) = v; }
        }
        TP_ON(17); __syncthreads(); TP_OFF(17);
        TP_OFF(12); TP_ON(13);
        if (t + 1 < 16) { const int page = pt[t + 1]; const float* kvp = ckv_base + (size_t)page * PAGE * 256; const float* krp = ckr_base + (size_t)page * PAGE * 32;
#pragma unroll
            for (int i = 0; i < 16; ++i) rk[i] = __builtin_nontemporal_load((const f32x4*)(kvp + (size_t)(tid + 512 * i) * 4));
#pragma unroll
            for (int i = 0; i < 2; ++i) rr2[i] = __builtin_nontemporal_load((const f32x4*)(krp + (size_t)(tid + 512 * i) * 4)); }
        f32x16 sa;
#pragma unroll
        for (int e = 0; e < 16; ++e) sa[e] = 0.f;
        { const LAS unsigned char* ka = Kt + (32 * kb + r) * SA_KS + 16 * hh; const LAS unsigned char* qa = Qs + (32 * qb + r) * SA_QS + 16 * hh;
#pragma unroll
          for (int ks = 0; ks < 18; ++ks) sa = __builtin_amdgcn_mfma_f32_32x32x16_bf16(*(const LAS bf16x8_t*)(ka + ks * 32), *(const LAS bf16x8_t*)(qa + ks * 32), sa, 0, 0, 0); }
        if (t == 16) { const int itok = (32 * qb + r) >> 3;
#pragma unroll
            for (int e = 0; e < 16; ++e) { const int key = 32 * kb + (e & 3) + 8 * (e >> 2) + 4 * hh; if (key > itok) sa[e] = -1e30f; } }
        float tm = sa[0];
#pragma unroll
        for (int e = 1; e < 16; ++e) tm = fmaxf(tm, sa[e]);
        tm = fmaxf(tm, __shfl_xor(tm, 32));
        if (hh == 0) mloc[kb * 64 + 32 * qb + r] = tm;
        __syncthreads();
        TP_OFF(13); TP_ON(14);
        { const int q = 32 * qb + r; const float tmx = fmaxf(fmaxf(mloc[q], mloc[64 + q]), fmaxf(mloc[128 + q], mloc[192 + q]));
          const float mn = fmaxf(m, tmx), al = __builtin_amdgcn_exp2f((m - mn) * ATT_C), mc = mn * ATT_C; m = mn;
          float ps = 0.f;
#pragma unroll
          for (int e = 0; e < 16; ++e) { sa[e] = __builtin_amdgcn_exp2f(sa[e] * ATT_C - mc); ps += sa[e]; }
          lw = lw * al + ps;
#pragma unroll
          for (int g4 = 0; g4 < 4; ++g4) { u32x2 w; w.x = pg8::cvt_pk_bf16(sa[4 * g4], sa[4 * g4 + 1]); w.y = pg8::cvt_pk_bf16(sa[4 * g4 + 2], sa[4 * g4 + 3]);
              *(LAS u32x2*)(Pt + q * SA_PS + (32 * kb + 8 * g4 + 4 * hh) * 2) = w; }
#pragma unroll
          for (int e = 0; e < 16; ++e) { o0[e] *= al; o1[e] *= al; } }
        __syncthreads();
        TP_OFF(14); TP_ON(15);
        { const LAS unsigned char* pa = Pt + (32 * qb + r) * SA_PS + 16 * hh; const LAS unsigned char* va = Kt + trOff + (64 * cg) * 2;
#pragma unroll
          for (int ks = 0; ks < 8; ++ks) { const bf16x8_t pb = *(const LAS bf16x8_t*)(pa + ks * 32);
              union { struct { s16x4 lo, hi; } h; bf16x8_t v; } a0, a1;
              a0.h.lo = __builtin_amdgcn_ds_read_tr16_b64_v4i16((LAS s16x4*)(va + ks * 16 * SA_KS)); a0.h.hi = __builtin_amdgcn_ds_read_tr16_b64_v4i16((LAS s16x4*)(va + ks * 16 * SA_KS + 4 * SA_KS));
              a1.h.lo = __builtin_amdgcn_ds_read_tr16_b64_v4i16((LAS s16x4*)(va + ks * 16 * SA_KS + 64)); a1.h.hi = __builtin_amdgcn_ds_read_tr16_b64_v4i16((LAS s16x4*)(va + ks * 16 * SA_KS + 4 * SA_KS + 64));
              o0 = __builtin_amdgcn_mfma_f32_32x32x16_bf16(a0.v, pb, o0, 0, 0, 0);
              o1 = __builtin_amdgcn_mfma_f32_32x32x16_bf16(a1.v, pb, o1, 0, 0, 0); } }
        TP_OFF(15);
    }
    lw += __shfl_xor(lw, 32);
    if (hh == 0) lred[kb * 64 + 32 * qb + r] = lw;
    __syncthreads();
    { const int q = 32 * qb + r; float* pp = p->part + (((size_t)s * SA_CH + ch) * 64 + q) * 258;
#pragma unroll
      for (int cb2 = 0; cb2 < 2; ++cb2)
#pragma unroll
          for (int g4 = 0; g4 < 4; ++g4) { const int c = 32 * (2 * cg + cb2) + 8 * g4 + 4 * hh; f32x4 v;
#pragma unroll
              for (int e = 0; e < 4; ++e) v[e] = cb2 == 0 ? o0[4 * g4 + e] : o1[4 * g4 + e];
              *(f32x2*)(pp + c) = (f32x2){v[0], v[1]}; *(f32x2*)(pp + c + 2) = (f32x2){v[2], v[3]}; }
      if (cg == 0 && hh == 0) { pp[256] = m * MLA_SCALE; pp[257] = lred[q] + lred[64 + q] + lred[128 + q] + lred[192 + q]; } }
    TP_OFF(10);
}
__device__ __forceinline__ void ph_attn_s2(KP p, int l, LAS unsigned char* lds) {
    int tid = threadIdx.x; asm volatile("" : "+v"(tid));
    for (int u = blockIdx.x; u < DEC_BATCH * 8; u += gridDim.x) sa_unit(p, l, u >> 3, u & 7, lds, tid);
    __syncthreads();
}

constexpr int ATT_KS = 208, ATT_VS = 144, ATT_KB = 64 * ATT_KS, ATT_VB = 64 * ATT_VS, ATT_STAGE = ATT_KB + ATT_VB;
__device__ __forceinline__ void attn_unit(KP p, int b, int h, int qblk, LAS unsigned char* lds, int tid, int wave, int lane) {
    const int r = lane & 31, hh = lane >> 5;
    const int q0 = qblk * 256 + wave * 32;
    __builtin_amdgcn_s_waitcnt(0);
    const size_t trow0 = (size_t)b * SEQ;
    bf16x8_t qf[6];
    { const bf16_t* qp = p->Q + (trow0 + q0 + r) * 768 + h * 96 + 8 * hh;
#pragma unroll
      for (int ks = 0; ks < 6; ++ks) qf[ks] = *(const bf16x8_t*)(qp + 16 * ks); }
    f32x16 o0, o1;
#pragma unroll
    for (int e = 0; e < 16; ++e) { o0[e] = 0.f; o1[e] = 0.f; }
    float m = -1e30f, lsum = 0.f;
    const int ntile = qblk * 4 + 4;
    const int cA = tid, keyA = cA / 12, partA = cA - keyA * 12; const int cB = 512 + (tid & 255), keyB = cB / 12, partB = cB - keyB * 12; const bool hasB = tid < 256;
    const bf16_t* gA = partA < 8 ? p->Kn + (trow0 + keyA) * 512 + h * 64 + partA * 8 : p->Kr + (trow0 + keyA) * 32 + (partA - 8) * 8; const int stepA = partA < 8 ? 64 * 512 : 64 * 32;
    const bf16_t* gB = !hasB ? gA : partB < 8 ? p->Kn + (trow0 + keyB) * 512 + h * 64 + partB * 8 : p->Kr + (trow0 + keyB) * 32 + (partB - 8) * 8; const int stepB = !hasB ? stepA : partB < 8 ? 64 * 512 : 64 * 32;
    const bf16_t* gV = p->Vt + (size_t)(h * 64 + (tid >> 3)) * TP + trow0 + (tid & 7) * 8;
    const int lA = keyA * ATT_KS + partA * 16, lB = hasB ? keyB * ATT_KS + partB * 16 : (tid & 63) * ATT_KS + 192, lV = ATT_KB + (tid >> 3) * ATT_VS + (tid & 7) * 16;
    const int pr_ = (r & 0x13) | ((r & 4) << 1) | ((r & 8) >> 1);
    const int kOff = pr_ * ATT_KS + 16 * hh, vOff = ATT_KB + r * ATT_VS + 16 * hh;
#define ATT_COMPUTE() do { \
        if (kt * 64 <= q0 + 31) { \
            f32x16 s0, s1; TP_ON(2); \
_Pragma("unroll") \
            for (int e = 0; e < 16; ++e) { s0[e] = 0.f; s1[e] = 0.f; } \
_Pragma("unroll") \
            for (int ks = 0; ks < 6; ++ks) { \
                const bf16x8_t a0 = *(const LAS bf16x8_t*)(st + kOff + ks * 32), a1 = *(const LAS bf16x8_t*)(st + kOff + 32 * ATT_KS + ks * 32); \
                s0 = __builtin_amdgcn_mfma_f32_32x32x16_bf16(a0, qf[ks], s0, 0, 0, 0); \
                s1 = __builtin_amdgcn_mfma_f32_32x32x16_bf16(a1, qf[ks], s1, 0, 0, 0); \
            } \
            TP_OFF(2); TP_ON(3); if (kt * 64 + 63 > q0) { \
                const int qrel = q0 + r - kt * 64; \
_Pragma("unroll") \
                for (int e = 0; e < 16; ++e) { const int kl = (e & 3) + 4 * ((e >> 2) & 1) + 8 * hh + 16 * ((e >> 3) & 1); \
                    if (kl > qrel) s0[e] = -1e30f; if (kl + 32 > qrel) s1[e] = -1e30f; } \
            } \
            float tm = fmaxf(s0[0], s1[0]); \
_Pragma("unroll") \
            for (int e = 1; e < 16; ++e) tm = fmaxf(tm, fmaxf(s0[e], s1[e])); \
            tm = fmaxf(tm, __shfl_xor(tm, 32)); \
            const float mn = fmaxf(m, tm), al = __builtin_amdgcn_exp2f((m - mn) * ATT_C), mc = mn * ATT_C; m = mn; \
            float ps = 0.f; \
_Pragma("unroll") \
            for (int e = 0; e < 16; ++e) { s0[e] = __builtin_amdgcn_exp2f(s0[e] * ATT_C - mc); s1[e] = __builtin_amdgcn_exp2f(s1[e] * ATT_C - mc); ps += s0[e] + s1[e]; } \
            lsum = lsum * al + ps; \
_Pragma("unroll") \
            for (int e = 0; e < 16; ++e) { o0[e] *= al; o1[e] *= al; } \
            TP_OFF(3); TP_ON(4); \
_Pragma("unroll") \
            for (int kb = 0; kb < 2; ++kb) \
_Pragma("unroll") \
                for (int sp = 0; sp < 2; ++sp) { \
                    union { u32x4 u; bf16x8_t v; } pb; \
                    if (kb == 0) { pb.u.x = pg8::cvt_pk_bf16(s0[8 * sp + 0], s0[8 * sp + 1]); pb.u.y = pg8::cvt_pk_bf16(s0[8 * sp + 2], s0[8 * sp + 3]); pb.u.z = pg8::cvt_pk_bf16(s0[8 * sp + 4], s0[8 * sp + 5]); pb.u.w = pg8::cvt_pk_bf16(s0[8 * sp + 6], s0[8 * sp + 7]); } \
                    else         { pb.u.x = pg8::cvt_pk_bf16(s1[8 * sp + 0], s1[8 * sp + 1]); pb.u.y = pg8::cvt_pk_bf16(s1[8 * sp + 2], s1[8 * sp + 3]); pb.u.z = pg8::cvt_pk_bf16(s1[8 * sp + 4], s1[8 * sp + 5]); pb.u.w = pg8::cvt_pk_bf16(s1[8 * sp + 6], s1[8 * sp + 7]); } \
                    const int ko = (32 * kb + 16 * sp) * 2; \
                    const bf16x8_t v0 = *(const LAS bf16x8_t*)(st + vOff + ko), v1 = *(const LAS bf16x8_t*)(st + vOff + 32 * ATT_VS + ko); \
                    o0 = __builtin_amdgcn_mfma_f32_32x32x16_bf16(v0, pb.v, o0, 0, 0, 0); \
                    o1 = __builtin_amdgcn_mfma_f32_32x32x16_bf16(v1, pb.v, o1, 0, 0, 0); \
                } \
            TP_OFF(4); \
        } \
    } while (0)
    u32x4 rA = *(const u32x4*)gA, rB = *(const u32x4*)gB, rV = *(const u32x4*)gV;
    gA += stepA; gB += stepB; gV += 64;
    __builtin_amdgcn_sched_barrier(0);
    u32x4 sA = *(const u32x4*)gA, sB = *(const u32x4*)gB, sV = *(const u32x4*)gV;
    __builtin_amdgcn_sched_barrier(0);
#define ATT_TILE(RA, RB, RV) do { \
        LAS unsigned char* st = lds + (kt & 1) * ATT_STAGE; TP_ON(1); \
        *(LAS u32x4*)(st + lA) = RA; *(LAS u32x4*)(st + lB) = RB; *(LAS u32x4*)(st + lV) = RV; \
        __syncthreads(); \
        { const int adv = kt + 2 < ntile ? 1 : 0; gA += adv * stepA; gB += adv * stepB; gV += adv * 64; RA = *(const u32x4*)gA; RB = *(const u32x4*)gB; RV = *(const u32x4*)gV; } \
        TP_OFF(1); ATT_COMPUTE(); } while (0)
    TP_DECL; TP_ON(5);
    for (int kt = 0; kt < ntile; kt += 2) { ATT_TILE(rA, rB, rV); ++kt; ATT_TILE(sA, sB, sV); --kt; }
    TP_OFF(5);
#undef ATT_TILE
#undef ATT_COMPUTE
    TP_COMMIT(lds);
    lsum += __shfl_xor(lsum, 32);
    const float il = 1.0f / lsum;
    const size_t t = trow0 + q0 + r;
    u32x2 gzv[2][4];
#pragma unroll
    for (int db = 0; db < 2; ++db)
#pragma unroll
        for (int g = 0; g < 4; ++g) gzv[db][g] = *(const u32x2*)(p->H + t * IN_WP + C_ZMLA + h * 64 + 32 * db + 8 * g + 4 * hh);
#pragma unroll
    for (int db = 0; db < 2; ++db)
#pragma unroll
        for (int g = 0; g < 4; ++g) { const int d0 = 32 * db + 8 * g + 4 * hh;
            const u32x2 gz = gzv[db][g];
            float v[4];
#pragma unroll
            for (int e = 0; e < 4; ++e) v[e] = (db == 0 ? o0[4 * g + e] : o1[4 * g + e]) * il;
            v[0] *= __uint_as_float(gz.x << 16); v[1] *= __uint_as_float(gz.x & 0xffff0000u); v[2] *= __uint_as_float(gz.y << 16); v[3] *= __uint_as_float(gz.y & 0xffff0000u);
            u32x2 w; w.x = pg8::cvt_pk_bf16(v[0], v[1]); w.y = pg8::cvt_pk_bf16(v[2], v[3]);
            *(u32x2*)(p->yb + t * 1536 + h * 64 + d0) = w; }
}
__device__ __forceinline__ void ph_attn_p(KP p, LAS unsigned char* lds) {
    int tid = threadIdx.x; asm volatile("" : "+v"(tid));
    const int lane = tid & 63, wave = __builtin_amdgcn_readfirstlane(tid >> 6);
    for (int pi = blockIdx.x; pi < 256; pi += gridDim.x) {
        const int xcd = pi & 7, k = pi >> 3, bh = xcd * 8 + (k >> 2), pr = k & 3;
#pragma unroll 1
        for (int uu = 0; uu < 2; ++uu) attn_unit(p, bh >> 3, bh & 7, uu == 0 ? 7 - pr : pr, lds, tid, wave, lane);
    }
    __syncthreads();
}
struct MEpiVt { static constexpr bool PERM = true, AFTER_DRAIN = false; static constexpr int SEG = 0; bf16_t* O; int ldc; int pad_;
    __device__ __forceinline__ void operator()(const f32x4 (&acc)[2][2][4][2], const pg8::Unit& u, int wr, int wc, int fr0, int fq0) const {
        int fr = fr0, fq = fq0; asm volatile("" : "+v"(fr), "+v"(fq));
        const int row0 = u.pm * 256 + wr * 64 + fr;
#pragma unroll
        for (int bj = 0; bj < 2; ++bj) { const int col0 = u.pn * 256 + bj * 128 + wc * 32 + 8 * fq;
#pragma unroll
            for (int ai = 0; ai < 2; ++ai)
#pragma unroll
                for (int m = 0; m < 4; ++m) { const int row = row0 + ai * 128 + m * 16; const f32x4 v0 = acc[ai][bj][m][0], v1 = acc[ai][bj][m][1];
                    u32x4 w; w.x = pg8::cvt_pk_bf16(v0[0], v0[1]); w.y = pg8::cvt_pk_bf16(v0[2], v0[3]); w.z = pg8::cvt_pk_bf16(v1[0], v1[1]); w.w = pg8::cvt_pk_bf16(v1[2], v1[3]);
                    *(u32x4*)(O + (size_t)row * ldc + col0) = w; } }
    } };


__global__ void __launch_bounds__(NTHR, 2) k_mega(Params p_unused) {
    const KP kp0 = (KP)__builtin_amdgcn_kernarg_segment_ptr();
#define PP() ({ KP q_ = kp0; asm volatile("" : "+s"(q_)); q_; })
    KP p = PP();
    extern __shared__ __attribute__((aligned(16))) unsigned char lds_raw[];
    LAS unsigned char* lds = (LAS unsigned char*)lds_raw;
    volatile LAS unsigned* misc = (volatile LAS unsigned*)(lds + LDS_MISC);
    for (int u = threadIdx.x; u < 64; u += NTHR) misc[u] = 0u;
    __syncthreads();
    const int lo = p->ph_lo, hi = p->ph_hi;
    XcdBarrier bar; bar.bar = p->bar + p->li * XCD_BAR_WORDS; bar.x = 0; bar.st = nullptr;
    if (hi - lo > 1) bar = xcd_barrier_post(p->bar + p->li * XCD_BAR_WORDS, misc + 8);
#define IN(k) (lo <= (k) && (k) < hi)
#define SEAM(k) do { if (IN(k) && IN((k) + 1)) xcd_barrier(bar); } while (0)

    if (IN(PH_PRO)) {
        LAS float* tile = (LAS float*)lds;
        for (int l = 0; l < 2; ++l) {
            KP p = PP();
            ph_tr(p->w_in + (size_t)l * 1024 * IN_W, p->WinT + (size_t)l * IN_WP * 1024, 1024, IN_W, IN_WP, tile, 0);
            ph_tr(p->w_uq + (size_t)l * 384 * 768, p->WuqT + (size_t)l * 768 * 384, 384, 768, 768, tile, 0);
            ph_tr(p->w_uk + (size_t)l * 256 * 512, p->WkvT + (size_t)l * 1024 * 256, 256, 512, 512, tile, 144);
            ph_tr(p->w_uv + (size_t)l * 256 * 512, p->WkvT + (size_t)l * 1024 * 256 + (size_t)512 * 256, 256, 512, 512, tile, 208);
            ph_tr(p->w_br0 + (size_t)l * 512 * 1024, p->WbrT + (size_t)l * 1024 * 1536 + 0 * 512, 512, 1024, 1024, tile, 0, 1536);
            ph_tr(p->w_br1 + (size_t)l * 512 * 1024, p->WbrT + (size_t)l * 1024 * 1536 + 1 * 512, 512, 1024, 1024, tile, 0, 1536);
            ph_tr(p->w_br2 + (size_t)l * 512 * 1024, p->WbrT + (size_t)l * 1024 * 1536 + 2 * 512, 512, 1024, 1024, tile, 0, 1536);
            ph_tr(p->w_out + (size_t)l * 1024 * 1024, p->WoutT + (size_t)l * 1024 * 1024, 1024, 1024, 1024, tile, 0);
            for (int g = 0; g < 4; ++g) ph_tr(p->pool_mix + ((size_t)l * 4 + g) * 128 * 128, p->PmixT + ((size_t)l * 4 + g) * 128 * 128, 128, 128, 128, tile, 64 + 8 * g);
        }
        { KP p = PP(); const float* src = p->w_uk; bf16_t* dst = p->WukB;
          for (int i = (blockIdx.x * NTHR + threadIdx.x) * 8; i < 2 * 256 * 512; i += gridDim.x * NTHR * 8) { const f32x4 a = *(const f32x4*)(src + i), b = *(const f32x4*)(src + i + 4);
              u32x4 w; w.x = pg8::cvt_pk_bf16(a[0], a[1]); w.y = pg8::cvt_pk_bf16(a[2], a[3]); w.z = pg8::cvt_pk_bf16(b[0], b[1]); w.w = pg8::cvt_pk_bf16(b[2], b[3]); *(u32x4*)(dst + i) = w; } }
        { KP p = PP(); ph_rope_tab(p->tab); ph_rmsnorm(p->x_prompt, p->x_sample, p->norm_g, p->xn, nullptr, nullptr); }
    }
    SEAM(PH_PRO);
    for (int l = 0; l < 2; ++l) {
        int G = gridDim.x, bid = blockIdx.x; asm volatile("" : "+s"(G), "+s"(bid));
        if (IN(PHID(l, PH_GIN))) { KP p = PP();
            pg8::Gemm g{p->xn, p->WinT + (size_t)l * IN_WP * 1024, TT, IN_WP, 1024, 0}; pg8::StaticOrder S; S.init(TT, IN_WP, G, bid);
            MEpiH E{p->H, p->BA}; pg8::gemm_phase<MEpiH, pg8::StaticOrder, false>(lds, g, S, E, nullptr);
        }
        SEAM(PHID(l, PH_GIN));
        if (IN(PHID(l, PH_TOK))) ph_tok(PP(), l, lds);
        SEAM(PHID(l, PH_TOK));
        if (IN(PHID(l, PH_GQ)) && (PP()->pad & 16)) { KP p = PP();
            pg8::Gemm g{p->cq, p->WuqT + (size_t)l * 768 * 384, TT, 768, 384, 0}; pg8::StaticOrder S; S.init(TT, 768, G, bid);
            MEpiQ E{p->Q, p->tab}; pg8::gemm_phase<MEpiQ, pg8::StaticOrder, false>(lds, g, S, E, nullptr);
        }
        if (IN(PHID(l, PH_GQ)) && (PP()->pad & 32)) { KP p = PP();
            pg8::Gemm g{p->ckv, p->WkvT + (size_t)l * 1024 * 256, TP, 512, 256, 0}; pg8::StaticOrder S; S.init(TP, 512, G / 2, bid < G / 2 ? bid : G);
            MEpiKV E{p->Kn, p->V}; pg8::gemm_phase<MEpiKV, pg8::StaticOrder, false>(lds, g, S, E, nullptr);
        }
        if (IN(PHID(l, PH_GQ)) && (PP()->pad & 32)) { KP p = PP();
            pg8::Gemm g{p->WkvT + (size_t)l * 1024 * 256 + (size_t)512 * 256, p->ckv, 512, TP, 256, 0}; pg8::StaticOrder S; S.init(512, TP, G / 2, bid >= G / 2 ? bid - G / 2 : G);
            MEpiVt E{p->Vt, TP, 0}; pg8::gemm_phase<MEpiVt, pg8::StaticOrder, false>(lds, g, S, E, nullptr);
        }
        if (IN(PHID(l, PH_GQ)) && (PP()->pad & 64)) ph_delta_pre(PP(), lds);
        SEAM(PHID(l, PH_GQ));
        if (IN(PHID(l, PH_ATT))) { const int am = PP()->pad;
            if (am & 1) ph_attn_s2(PP(), l, lds); if (am & 4) ph_attn_p(PP(), lds); if (am & 8) ph_att_waves(PP(), l, lds); }
        SEAM(PHID(l, PH_ATT));
        if (IN(PHID(l, PH_FIN))) { const int fm = PP()->pad; if (fm & 128) ph_fin(PP(), l, lds); if (fm & 256) ph_delta_fin(PP(), l); }
        SEAM(PHID(l, PH_FIN));
        if (IN(PHID(l, PH_MERGE)) && (PP()->pad & 512)) { KP p = PP();
            pg8::Gemm g{p->ya, p->WbrT + (size_t)l * 1024 * 1536, TP, 1024, 512, 1536}; pg8::SegOrder<3> S; S.init(TP, 1024, G, bid);
            MEpiMergeS E{p->H, p->mb}; pg8::gemm_phase<MEpiMergeS, pg8::SegOrder<3>, false>(lds, g, S, E, nullptr);
        }
        if (IN(PHID(l, PH_MERGE)) && (PP()->pad & 1024)) { KP p = PP(); TEpiMerge E{p->H, p->mb}; tail_gemm<3, TEpiMerge>(p->ya + (size_t)TP * 1536, 1536, p->WbrT + (size_t)l * 1024 * 1536, 1536, 1024, E, lds); }
        SEAM(PHID(l, PH_MERGE));
        if (IN(PHID(l, PH_OUT)) && (PP()->pad & 2048)) { KP p = PP();
            const float* xp = l == 0 ? p->x_prompt : p->xres; const float* xs = l == 0 ? p->x_sample : p->xres + (size_t)TP * 1024;
            pg8::Gemm g{p->mb, p->WoutT + (size_t)l * 1024 * 1024, TP, 1024, 1024, 0}; pg8::StaticOrder S; S.init(TP, 1024, G, bid);
            MEpiRes E{xp, xs, p->xres}; pg8::gemm_phase<MEpiRes, pg8::StaticOrder, false>(lds, g, S, E, nullptr);
        }
        if (IN(PHID(l, PH_OUT)) && (PP()->pad & 4096)) { KP p = PP(); TEpiRes E{l == 0 ? p->x_sample : p->xres + (size_t)TP * 1024, p->xres}; tail_gemm<1, TEpiRes>(p->mb + (size_t)TP * 1024, 1024, p->WoutT + (size_t)l * 1024 * 1024, 1024, 1024, E, lds); }
        SEAM(PHID(l, PH_OUT));
        if (IN(PHID(l, PH_NORM))) { KP p = PP();
            if (l == 0) ph_rmsnorm(p->xres, p->xres + (size_t)TP * 1024, p->norm_g + 1024, p->xn, nullptr, nullptr);
            else ph_rmsnorm(p->xres, p->xres + (size_t)TP * 1024, p->final_norm_g, nullptr, p->out + O_YP, p->out + O_YS);
        }
        SEAM(PHID(l, PH_NORM));
    }
#if defined(TPROBE)
    { int te_ = threadIdx.x; asm volatile("" : "+v"(te_)); if (blockIdx.x == 0 && te_ == 0 && PP()->ph_lo == 0) { const unsigned long long w = (unsigned long long)*(volatile LAS unsigned*)(lds + LDS_MISC + 128) * 8ull, t0 = __builtin_amdgcn_s_memrealtime();
        while (__builtin_amdgcn_s_memrealtime() - t0 < w) __builtin_amdgcn_s_sleep(8); } }
#endif
#undef IN
#undef SEAM
}

static inline size_t al256(size_t x) { return (x + 255) & ~(size_t)255; }
extern "C" void kernel_launch(void* const* d_in, const int* in_sizes, int n_in, void* d_out, int out_size, void* d_ws, size_t ws_size, hipStream_t stream) {
    static int grid = 0;
    if (grid == 0) {
        int dev = 0, cus = 0; (void)hipGetDevice(&dev); (void)hipDeviceGetAttribute(&cus, hipDeviceAttributeMultiprocessorCount, dev);
        (void)hipFuncSetAttribute((const void*)k_mega, hipFuncAttributeMaxDynamicSharedMemorySize, LDS_BYTES);
        int per_cu = 0; (void)hipOccupancyMaxActiveBlocksPerMultiprocessor(&per_cu, (const void*)k_mega, NTHR, LDS_BYTES); (void)hipGetLastError();
        grid = cus > 0 ? cus : 256;
    }
    Params p{};
    p.x_prompt = (const float*)d_in[0]; p.x_sample = (const float*)d_in[1]; p.cache_kv = (const float*)d_in[2]; p.cache_kr = (const float*)d_in[3];
    p.state_pool = (const float*)d_in[4]; p.state_conv = (const float*)d_in[5]; p.state_delta = (const float*)d_in[6]; p.page_table = (const int*)d_in[7];
    p.norm_g = (const float*)d_in[8]; p.w_in = (const float*)d_in[9]; p.pool_mix = (const float*)d_in[10]; p.pool_scale = (const float*)d_in[11];
    p.q_norm_g = (const float*)d_in[12]; p.w_uq = (const float*)d_in[13]; p.kv_norm_g = (const float*)d_in[14]; p.w_uk = (const float*)d_in[15];
    p.w_uv = (const float*)d_in[16]; p.conv_w = (const float*)d_in[17]; p.a_log = (const float*)d_in[18]; p.dt_bias = (const float*)d_in[19];
    p.dn_norm_g = (const float*)d_in[20]; p.w_br0 = (const float*)d_in[21]; p.w_br1 = (const float*)d_in[22]; p.w_br2 = (const float*)d_in[23];
    p.w_out = (const float*)d_in[24]; p.final_norm_g = (const float*)d_in[25];
    p.out = (float*)d_out;
    char* w = (char*)d_ws; size_t off = 0;
    auto take = [&](size_t bytes) { char* q = w + off; off += al256(bytes); return q; };
    const size_t BAR_BYTES = (size_t)16 * XCD_BAR_WORDS * 4;
    p.bar = (unsigned*)take(BAR_BYTES);
    p.WinT = (bf16_t*)take((size_t)2 * IN_WP * 1024 * 2);
    p.WuqT = (bf16_t*)take((size_t)2 * 768 * 384 * 2);
    p.WkvT = (bf16_t*)take((size_t)2 * 1024 * 256 * 2);
    p.WbrT = (bf16_t*)take((size_t)2 * 3 * 1024 * 512 * 2);
    p.WoutT = (bf16_t*)take((size_t)2 * 1024 * 1024 * 2);
    p.PmixT = (bf16_t*)take((size_t)2 * 4 * 128 * 128 * 2);
    p.WukB = (bf16_t*)take((size_t)2 * 256 * 512 * 2);
    p.tab = (float2*)take((size_t)(SEQ + DEC_SEQ) * 16 * 8);
    p.xres = (float*)take((size_t)TT * 1024 * 4);
    p.xn = (bf16_t*)take((size_t)TT * 1024 * 2);
    p.H = (bf16_t*)take((size_t)TT * IN_WP * 2);
    p.BA = (float*)take((size_t)TT * 16 * 4);
    p.cq = (bf16_t*)take((size_t)TT * 384 * 2);
    p.ckv = (bf16_t*)take((size_t)TT * 256 * 2);
    p.Kr = (bf16_t*)take((size_t)TT * 32 * 2);
    p.Q = (bf16_t*)take((size_t)TT * 768 * 2);
    bf16_t* Qlat = (bf16_t*)take((size_t)TS * 8 * 288 * 2);
    p.Kn = (bf16_t*)take((size_t)TP * 512 * 2);
    p.V = (bf16_t*)take((size_t)TP * 512 * 2);
    p.Vt = (bf16_t*)take((size_t)512 * TP * 2);
    p.qd = (bf16_t*)take((size_t)TT * 512 * 2);
    p.kd = (bf16_t*)take((size_t)TT * 512 * 2);
    p.vd = (bf16_t*)take((size_t)TT * 512 * 2);
    p.bg = (float*)take((size_t)TT * 16 * 4);
    p.ya = (bf16_t*)take((size_t)TT * 1536 * 2); p.yb = p.ya + 512; p.yc = p.ya + 1024;
    p.mf = (float*)take((size_t)TT * 1024 * 4);
    p.mb = (bf16_t*)take((size_t)TT * 1024 * 2);
    p.part = (float*)take((size_t)DEC_BATCH * SA_CH * 64 * 258 * 4);
    p.DOP = (bf16_t*)take((size_t)2048 * 4 * 4096 * 2);
    p.DU = (float*)take((size_t)2048 * 4096 * 4);
    p.DG = (float*)take((size_t)2048 * 4);

    (void)hipMemsetAsync(p.bar, 0, BAR_BYTES, stream);
    p.ph_lo = 0; p.ph_hi = PH_END; p.li = 0; p.pad = 0x7fff;
    hipLaunchKernelGGL(k_mega, dim3(grid), dim3(NTHR), LDS_BYTES, stream, p);
#if defined(PROBE_REP) && PROBE_REP > 0
    for (int i = 0; i < PROBE_REP; ++i) { Params q = p; q.ph_lo = PROBE_LO; q.ph_hi = PROBE_HI; q.li = 1 + i; q.pad = PROBE_MASK; hipLaunchKernelGGL(k_mega, dim3(grid), dim3(NTHR), LDS_BYTES, stream, q); }
#endif
}
```

```cpp
#include <hip/hip_runtime.h>
#include <stdint.h>

typedef unsigned short bf16_t;

#define D_MODEL 1024
#define TP 16384
#define TS 256
#define TT (TP + TS)
#define SEQ 2048
#define DEC_SEQ 8
#define DEC_BATCH 32
#define PAST_LEN 16384
#define PAGE 128
#define N_PAGES 128
#define N_POOL 5120
#define IN_W 7344
#define IN_WP 7424
#define C_POOL 0
#define C_ZPOOL 512
#define C_Q 1024
#define C_KV 1408
#define C_KR 1664
#define C_ZMLA 1696
#define C_QKV 2208
#define C_ZDN 3744
#define C_BETA 4256
#define C_ALPHA 4264
#define C_GATE 4272
#define EPS 1e-6f
#define MLA_SCALE 0.10206207261596577f
#define ATT_C 0.14724444831554004f

#define O_YP 0
#define O_YS (O_YP + 16777216)
#define O_PKV (O_YS + 262144)
#define O_PKR (O_PKV + 8388608)
#define O_PPOOL (O_PKR + 1048576)
#define O_PCONV (O_PPOOL + 122880)
#define O_PDELTA (O_PCONV + 73728)
#define O_SKV (O_PDELTA + 524288)
#define O_SKR (O_SKV + 131072)
#define O_SPOOL (O_SKR + 16384)
#define O_SCONV (O_SPOOL + 491520)
#define O_SDELTA (O_SCONV + 294912)
#define O_END (O_SDELTA + 2097152)

__device__ __forceinline__ float bf2f(bf16_t b) { return __uint_as_float(((unsigned)b) << 16); }
__device__ __forceinline__ bf16_t f2bf(float f) { unsigned u = __float_as_uint(f); u += 0x7FFFu + ((u >> 16) & 1u); return (bf16_t)(u >> 16); }
__device__ __forceinline__ float sigmoidf_(float v) { return __builtin_amdgcn_rcpf(1.0f + __builtin_amdgcn_exp2f(-1.4426950408889634f * v)); }
__device__ __forceinline__ float siluf_(float v) { return v * __builtin_amdgcn_rcpf(1.0f + __builtin_amdgcn_exp2f(-1.4426950408889634f * v)); }
__device__ __forceinline__ float wave_sum(float v) {
#pragma unroll
    for (int o = 32; o >= 1; o >>= 1) v += __shfl_xor(v, o);
    return v;
}

#define SA_CH 8
namespace pg8 {
#define PG8_LAS __attribute__((address_space(3)))
typedef unsigned short bf16_t;
typedef short bf16x8 __attribute__((ext_vector_type(8)));
typedef float f32x4 __attribute__((ext_vector_type(4)));
typedef unsigned u32x4 __attribute__((ext_vector_type(4)));
constexpr int BM = 256, BK = 64, HALF = 128, HTB = HALF * BK * 2  , STAGE_BYTES = 8 * HTB, NXCD = 8, WGM = 8;

__host__ __device__ __forceinline__ int lds_byte(int r, int c) { const int st = (r >> 4) * 2 + (c >> 5), rr = r & 15, cc = c & 31, ob = rr * 64 + cc * 2; return st * 1024 + (ob ^ (((ob >> 9) & 1) << 5)); }
__host__ __device__ __forceinline__ void stage_rc(int b, int& R, int& C) { const int st = b / 1024, sb = b % 1024, swz = sb ^ (((sb >> 9) & 1) << 5); R = (st >> 1) * 16 + swz / 64; C = (st & 1) * 32 + (swz % 64) / 2; }
__host__ __device__ __forceinline__ int perm32(int rho) { const int n = rho >> 4, i = rho & 15; return 8 * (i >> 2) + 4 * n + (i & 3); }

struct Unit { int pm, pn, sg; };
struct Gemm { const bf16_t* A; const bf16_t* Bt; int M, N, K; int ld; };

struct StaticOrder {
    int nM, nN, nwg, G, c;
    __host__ __device__ void init(int M, int N, int G_, int c_) { nM = M / BM; nN = N / BM; nwg = nM * nN; G = G_; c = c_; }
    __host__ __device__ bool next(int i, Unit& u) const {
        const long L = (long)i * G + c; if (L >= nwg) return false;
        int wgid = (int)L; { const int q = nwg / NXCD, r = nwg % NXCD, xcd = wgid % NXCD, off = wgid / NXCD; wgid = (xcd < r ? xcd * (q + 1) : r * (q + 1) + (xcd - r) * q) + off; }
        const int nig = WGM * nN, gid = wgid / nig, fm = gid * WGM, gsz = (nM - fm) < WGM ? (nM - fm) : WGM;
        u.pm = fm + ((wgid % nig) % gsz); u.pn = (wgid % nig) / gsz; u.sg = 0; return true;
    }
    __device__ __forceinline__ void a_ready(const Unit&) const {}
    __device__ __forceinline__ void done(const Unit&) const {}
};
template <int NSEG> struct SegOrder : StaticOrder {
    __host__ __device__ bool next(int i, Unit& u) const { const bool ok = StaticOrder::next(i / NSEG, u); u.sg = i % NSEG; return ok; }
};
typedef __bf16 bf16n2 __attribute__((ext_vector_type(2)));
__device__ __forceinline__ unsigned cvt_pk_bf16(float lo, float hi) { typedef float f2_ __attribute__((ext_vector_type(2))); const f2_ v = {lo, hi}; return __builtin_bit_cast(unsigned, __builtin_convertvector(v, bf16n2)); }
typedef float f32x2 __attribute__((ext_vector_type(2)));
template <class Epi, class Sched, bool STAMP = false>
__device__ __forceinline__ void gemm_phase(PG8_LAS unsigned char* lds, const Gemm g, const Sched& S, const Epi& E, unsigned long long* stamps) {
    int tid_ = threadIdx.x; asm volatile("" : "+v"(tid_));
    const int tid = tid_, wid = __builtin_amdgcn_readfirstlane(tid >> 6), lane = tid & 63, wr = wid >> 2, wc = wid & 3, fr = lane & 15, fq = lane >> 4;
    int K_ = g.K; asm volatile("" : "+s"(K_));
    int LD_ = g.ld ? g.ld : g.K; asm volatile("" : "+s"(LD_));
    const int K = K_, nt = K / BK, LD = LD_;
    int ts_lo = 0, ts_hi = 0, nts = 0; const unsigned long long rt_entry = STAMP ? (unsigned long long)wall_clock64() : 0ull;
#define PG8_STAMP() do { if (STAMP && wid == 0 && nts < 64) { const unsigned long long _c = (unsigned long long)clock64(); \
        ts_lo = (lane == nts) ? (int)(unsigned)_c : ts_lo; ts_hi = (lane == nts) ? (int)(unsigned)(_c >> 32) : ts_hi; ++nts; } } while (0)
    PG8_STAMP();
    unsigned voffA[2], voffB[2];
#pragma unroll
    for (int i = 0; i < 2; ++i) { int R, C; stage_rc(tid * 16 + i * 8192, R, C); const int Rb = Epi::PERM ? ((R & ~31) + perm32(R & 31)) : R;
        voffA[i] = (unsigned)(R * LD + C) * 2u; voffB[i] = (unsigned)(Rb * LD + C) * 2u; }
    const size_t kstep = (size_t)(BK * 2);
    const size_t hstep = (size_t)HALF * LD * 2;
    const size_t tstep = 2 * hstep;
    const unsigned ldsw = (unsigned)wid * 1024u;
    const int aoff = lds_byte(wr * 64 + fr, fq * 8), boff = lds_byte(wc * 32 + fr, fq * 8);
#define PG8_SA(b, h) (((b) * 2 + (h)) * HTB)
#define PG8_SB(b, h) ((4 + (b) * 2 + (h)) * HTB)
#define PG8_STAGE(bufoff, gbase, voff) do { _Pragma("unroll") for (int _i = 0; _i < 2; ++_i) \
        __builtin_amdgcn_global_load_lds((const unsigned*)((const char*)(gbase) + (voff)[_i]), (PG8_LAS unsigned*)(lds + (bufoff) + ldsw + _i * 8192), 16, 0, 0); } while (0)
#define PG8_LDA(dst, b, h) do { _Pragma("unroll") for (int m = 0; m < 4; ++m) _Pragma("unroll") for (int k = 0; k < 2; ++k) dst[m][k] = *(const PG8_LAS bf16x8*)(lds + PG8_SA(b, h) + aoff + m * 2048 + k * 1024); } while (0)
#define PG8_LDB(dst, b, h) do { _Pragma("unroll") for (int n = 0; n < 2; ++n) _Pragma("unroll") for (int k = 0; k < 2; ++k) dst[n][k] = *(const PG8_LAS bf16x8*)(lds + PG8_SB(b, h) + boff + n * 2048 + k * 1024); } while (0)
#define PG8_MMA(ai, bj, At, Bt) do { __builtin_amdgcn_s_setprio(1); _Pragma("unroll") for (int m = 0; m < 4; ++m) _Pragma("unroll") for (int n = 0; n < 2; ++n) _Pragma("unroll") for (int k = 0; k < 2; ++k) \
        acc[ai][bj][m][n] = __builtin_amdgcn_mfma_f32_16x16x32_bf16(Bt[n][k], At[m][k], acc[ai][bj][m][n], 0, 0, 0); __builtin_amdgcn_s_setprio(0); } while (0)
#define PG8_WAIT_V(n) asm volatile("s_waitcnt vmcnt(" #n ")" ::: "memory")
#define PG8_WAIT_L(n) asm volatile("s_waitcnt lgkmcnt(" #n ")" ::: "memory")
#define PG8_BAR __builtin_amdgcn_s_barrier()
#define PG8_SCHED __builtin_amdgcn_sched_barrier(0)
    Unit cur, nxt; int ui = 0;
    if (!S.next(0, cur)) return;
    f32x4 acc[2][2][4][2];
#pragma unroll
    for (int a = 0; a < 2; ++a)
#pragma unroll
        for (int b = 0; b < 2; ++b)
#pragma unroll
            for (int m = 0; m < 4; ++m)
#pragma unroll
                for (int n = 0; n < 2; ++n) acc[a][b][m][n] = (f32x4){0.f, 0.f, 0.f, 0.f};
    bf16x8 At[4][2], B0[2][2], B1[2][2];
    const size_t sstep = (size_t)K * 2;
    const char* cA = (const char*)g.A + (size_t)cur.pm * tstep + cur.sg * sstep; const char* cB = (const char*)g.Bt + (size_t)cur.pn * tstep + cur.sg * sstep;
    S.a_ready(cur);
    PG8_STAGE(PG8_SB(0, 0), cB, voffB); PG8_STAGE(PG8_SA(0, 0), cA, voffA); PG8_STAGE(PG8_SB(0, 1), cB + hstep, voffB); PG8_STAGE(PG8_SA(0, 1), cA + hstep, voffA);
    if (wr == 1) PG8_BAR;
    PG8_WAIT_V(4); PG8_BAR;
    PG8_STAGE(PG8_SB(1, 0), cB + kstep, voffB); PG8_STAGE(PG8_SA(1, 0), cA + kstep, voffA); PG8_STAGE(PG8_SB(1, 1), cB + hstep + kstep, voffB);
    PG8_WAIT_V(6); PG8_BAR;
    PG8_STAMP();
    for (;;) {
        const bool has_next = S.next(ui + 1, nxt);
        const char* nA = has_next ? (const char*)g.A + (size_t)nxt.pm * tstep + nxt.sg * sstep : cA; const char* nB = has_next ? (const char*)g.Bt + (size_t)nxt.pn * tstep + nxt.sg * sstep : cB;
_Pragma("nounroll")
        for (int t = 0; t < nt; t += 2) {
            const bool last = (t == nt - 2);
            const char* a1 = cA + (size_t)(t + 1) * kstep;
            const char* a2 = last ? nA : cA + (size_t)(t + 2) * kstep; const char* b2 = last ? nB : cB + (size_t)(t + 2) * kstep;
            const char* a3 = a2 + kstep; const char* b3 = b2 + kstep;
            if (last && has_next) S.a_ready(nxt);
            PG8_LDB(B0, 0, 0); PG8_SCHED; PG8_LDA(At, 0, 0); PG8_STAGE(PG8_SA(1, 1), a1 + hstep, voffA);
            PG8_WAIT_L(8); PG8_BAR; PG8_WAIT_L(0); PG8_MMA(0, 0, At, B0); PG8_BAR; PG8_SCHED;
            PG8_LDB(B1, 0, 1); PG8_STAGE(PG8_SB(0, 0), b2, voffB);
            PG8_BAR; PG8_WAIT_L(0); PG8_MMA(0, 1, At, B1); PG8_BAR;
            PG8_LDA(At, 0, 1); PG8_STAGE(PG8_SA(0, 0), a2, voffA);
            PG8_BAR; PG8_WAIT_L(0); PG8_MMA(1, 0, At, B0); PG8_BAR; PG8_SCHED;
            PG8_STAGE(PG8_SB(0, 1), b2 + hstep, voffB);
            PG8_WAIT_V(6); PG8_BAR; PG8_MMA(1, 1, At, B1); PG8_BAR;
            PG8_LDB(B0, 1, 0); PG8_SCHED; PG8_LDA(At, 1, 0); PG8_STAGE(PG8_SA(0, 1), a2 + hstep, voffA);
            PG8_WAIT_L(8); PG8_BAR; PG8_WAIT_L(0); PG8_MMA(0, 0, At, B0); PG8_BAR; PG8_SCHED;
            PG8_LDB(B1, 1, 1); PG8_STAGE(PG8_SB(1, 0), b3, voffB);
            PG8_BAR; PG8_WAIT_L(0); PG8_MMA(0, 1, At, B1); PG8_BAR;
            PG8_LDA(At, 1, 1); PG8_STAGE(PG8_SA(1, 0), a3, voffA);
            PG8_BAR; PG8_WAIT_L(0); PG8_MMA(1, 0, At, B0); PG8_BAR; PG8_SCHED;
            PG8_STAGE(PG8_SB(1, 1), b3 + hstep, voffB);
            PG8_WAIT_V(6); PG8_BAR; PG8_MMA(1, 1, At, B1); PG8_BAR;
        }
        PG8_STAMP();
        bool fin_ = true; if constexpr (Epi::SEG > 0) fin_ = (cur.sg == Epi::SEG - 1);
        if constexpr (!Epi::AFTER_DRAIN) { if (fin_) { E(acc, cur, wr, wc, fr, fq); S.done(cur); } }
        if constexpr (Epi::SEG > 0) E.mid(acc, cur, wr, wc, fr, fq, fin_ ? 1 : cur.sg + 1, fin_ ? 0.f : 1.f);
        PG8_STAMP();
        if (!has_next) break;
        if constexpr (Epi::SEG == 0)
#pragma unroll
        for (int a = 0; a < 2; ++a)
#pragma unroll
            for (int b = 0; b < 2; ++b)
#pragma unroll
                for (int m = 0; m < 4; ++m)
#pragma unroll
                    for (int n = 0; n < 2; ++n) acc[a][b][m][n] = (f32x4){0.f, 0.f, 0.f, 0.f};
        cur = nxt; cA = nA; cB = nB; ++ui;
    }
    PG8_WAIT_V(0);
    if (wr == 0) PG8_BAR;
    PG8_BAR;
    if constexpr (Epi::AFTER_DRAIN) { E.fused(acc, cur, wr, wc, fr, fq, lds, wid, lane); S.done(cur); }
    PG8_STAMP();
    if (STAMP && wid == 0) { stamps[lane] = lane < nts ? (((unsigned long long)(unsigned)ts_hi << 32) | (unsigned)ts_lo) : 0ull;
        if (lane == 62) stamps[62] = rt_entry; if (lane == 63) stamps[63] = (unsigned long long)wall_clock64(); }
#undef PG8_STAMP
#undef PG8_SA
#undef PG8_SB
#undef PG8_STAGE
#undef PG8_LDA
#undef PG8_LDB
#undef PG8_MMA
#undef PG8_WAIT_V
#undef PG8_WAIT_L
#undef PG8_BAR
#undef PG8_SCHED
}

}
#define XB_TMO      128
#define XB_XCNT(j)  (256  + 64 * (j))
#define XB_XSUB(j)  (1280 + 64 * (j))
#define XB_XGEN(j)  (2304 + 64 * (j))
#define XB_TOP      3328
#define XB_TOPGEN   3392
#define XCD_BAR_WORDS 3456
#define XB_SPIN_CAP (1u << 18)
#define LAS __attribute__((address_space(3)))

__device__ __forceinline__ unsigned xb_ld(unsigned* p)              { return __hip_atomic_load(p, __ATOMIC_RELAXED, __HIP_MEMORY_SCOPE_AGENT); }
__device__ __forceinline__ unsigned xb_add(unsigned* p, unsigned v) { return __hip_atomic_fetch_add(p, v, __ATOMIC_RELAXED, __HIP_MEMORY_SCOPE_AGENT); }
__device__ __forceinline__ unsigned xb_xcc_id() { return (unsigned)__builtin_amdgcn_s_getreg((3 << 11) | 20) & 0xFu; }
#define XB_SPIN(cond, bar) do { unsigned _sp = 0; while (cond) { __builtin_amdgcn_s_sleep(1); \
    if ((++_sp & 255u) == 0u) { if (xb_ld(&(bar)[XB_TMO])) break; if (_sp > XB_SPIN_CAP) { atomicAdd(&(bar)[XB_TMO], 1u); break; } } } } while (0)

struct XcdBarrier {
    unsigned* bar; unsigned x;
    volatile LAS unsigned* st;
};

__device__ __forceinline__ XcdBarrier xcd_barrier_post(unsigned* bar, volatile LAS unsigned* st) {
    XcdBarrier b; b.bar = bar; b.x = xb_xcc_id(); b.st = st;
    if (threadIdx.x == 0) (void)xb_add(&bar[XB_XCNT(b.x)], 1u);
    return b;
}
__device__ __forceinline__ void xcd_barrier_complete(unsigned* bar, unsigned x, unsigned& nloc, unsigned& nx) {
    const unsigned G = gridDim.x * gridDim.y * gridDim.z;
    unsigned sum, cnt, mine, sp = 0u;
    for (;;) {
        sum = 0u; cnt = 0u; mine = 0u;
#pragma unroll
        for (unsigned j = 0; j < 16; ++j) { const unsigned c = xb_ld(&bar[XB_XCNT(j)]); sum += c; cnt += (c > 0u) ? 1u : 0u; mine = (j == x) ? c : mine; }
        if (sum == G) break;
        __builtin_amdgcn_s_sleep(1);
        if ((++sp & 255u) == 0u) { if (xb_ld(&bar[XB_TMO])) break; if (sp > XB_SPIN_CAP) { atomicAdd(&bar[XB_TMO], 1u); break; } }
    }
    nloc = mine > 0u ? mine : 1u; nx = cnt > 0u ? cnt : 1u;
}

__device__ __forceinline__ void xcd_barrier(const XcdBarrier& b) {
    asm volatile("s_waitcnt vmcnt(0)" ::: "memory");
    __syncthreads();
    if (threadIdx.x == 0) {
        unsigned* bar = b.bar;
        __builtin_amdgcn_s_waitcnt(0);
        unsigned nloc = b.st[0], nx = b.st[1];
        if (nloc == 0u) { xcd_barrier_complete(bar, b.x, nloc, nx); b.st[0] = nloc; b.st[1] = nx; }
        const unsigned old = xb_add(&bar[XB_XSUB(b.x)], 1u);
        const unsigned gen = old / nloc;
        if (old + 1u == (gen + 1u) * nloc) {
            __builtin_amdgcn_fence(__ATOMIC_RELEASE, "agent");
            asm volatile("s_waitcnt vmcnt(0)" ::: "memory");
            const unsigned og = xb_add(&bar[XB_TOP], 1u);
            const unsigned tg = og / nx;
            if (og + 1u == (tg + 1u) * nx) xb_add(&bar[XB_TOPGEN], 1u);
            else XB_SPIN(xb_ld(&bar[XB_TOPGEN]) == tg, bar);
            __builtin_amdgcn_fence(__ATOMIC_ACQUIRE, "agent");
            xb_add(&bar[XB_XGEN(b.x)], 1u);
            asm volatile("s_waitcnt vmcnt(0)" ::: "memory");
        } else {
            XB_SPIN(xb_ld(&bar[XB_XGEN(b.x)]) == gen, bar);
            __builtin_amdgcn_fence(__ATOMIC_ACQUIRE, "agent");
            asm volatile("s_waitcnt vmcnt(0)" ::: "memory");
        }
    }
    __syncthreads();
}


#define LAS __attribute__((address_space(3)))
typedef float f32x4 __attribute__((ext_vector_type(4)));
typedef unsigned u32x4 __attribute__((ext_vector_type(4)));
typedef unsigned u32x2 __attribute__((ext_vector_type(2)));
typedef float f32x2 __attribute__((ext_vector_type(2)));
typedef short bf16x8_t __attribute__((ext_vector_type(8)));
typedef float f32x16 __attribute__((ext_vector_type(16)));
constexpr int NTHR = 512;
constexpr int LDS_BYTES = 147456;
constexpr int LDS_MISC = LDS_BYTES - 256;


#if defined(TPROBE)
#define TP_DECL unsigned tp_t0 = 0
#define TP_ON(id) do { if (TPROBE == (id)) tp_t0 = (unsigned)__builtin_amdgcn_s_memrealtime(); } while (0)
#define TP_OFF(id) do { if (TPROBE == (id)) { const unsigned d_ = (unsigned)__builtin_amdgcn_s_memrealtime() - tp_t0; int tq_ = threadIdx.x; asm volatile("" : "+v"(tq_)); if (blockIdx.x == 0 && tq_ == 0) *(volatile LAS unsigned*)(lds + LDS_MISC + 128) += d_; } } while (0)
#define TP_OFFW(id, T) do { if (TPROBE == (id)) { const unsigned d_ = (unsigned)__builtin_amdgcn_s_memrealtime() - tp_t0; int tq_ = threadIdx.x; asm volatile("" : "+v"(tq_)); if (blockIdx.x == 0 && tq_ == (T)) *(volatile LAS unsigned*)(unsigned)(LDS_MISC + 128) += d_; } } while (0)
#define TP_COMMIT(lds_)
#else
#define TP_OFFW(id, T)
#define TP_DECL
#define TP_ON(id)
#define TP_OFF(id)
#define TP_COMMIT(lds_)
#endif
struct Params {
    const float *x_prompt, *x_sample, *cache_kv, *cache_kr, *state_pool, *state_conv, *state_delta; const int* page_table;
    const float *norm_g, *w_in, *pool_mix, *pool_scale, *q_norm_g, *w_uq, *kv_norm_g, *w_uk, *w_uv, *conv_w, *a_log, *dt_bias, *dn_norm_g, *w_br0, *w_br1, *w_br2, *w_out, *final_norm_g;
    float* out;
    bf16_t *WinT, *WuqT, *WkvT, *WbrT, *WoutT, *PmixT, *WukB; float2* tab;
    float* xres; bf16_t* xn; bf16_t* H; float* BA; bf16_t *cq, *ckv, *Kr, *Q, *Kn, *V, *Vt, *qd, *kd, *vd; float* bg; bf16_t *ya, *yb, *yc; float* mf; bf16_t* mb; float* part; bf16_t* DOP; float* DU; float* DG;
    unsigned* bar;
    int ph_lo, ph_hi, li, pad;
};

typedef const __attribute__((address_space(4))) Params* KP;

constexpr int PH_PRO = 0;
constexpr int PH_L = 8;
constexpr int PH_GIN = 0, PH_TOK = 1, PH_GQ = 2, PH_ATT = 3, PH_FIN = 4, PH_MERGE = 5, PH_OUT = 6, PH_NORM = 7;
#define PHID(l, k) (1 + (l) * PH_L + (k))
constexpr int PH_END = 1 + 2 * PH_L;

__device__ __forceinline__ void unpack8(const u32x4 v, float (&f)[8]) {
    f[0] = __uint_as_float(v.x << 16); f[1] = __uint_as_float(v.x & 0xffff0000u); f[2] = __uint_as_float(v.y << 16); f[3] = __uint_as_float(v.y & 0xffff0000u);
    f[4] = __uint_as_float(v.z << 16); f[5] = __uint_as_float(v.z & 0xffff0000u); f[6] = __uint_as_float(v.w << 16); f[7] = __uint_as_float(v.w & 0xffff0000u); }
__device__ __forceinline__ u32x4 pack8(const float (&f)[8]) { u32x4 w; w.x = pg8::cvt_pk_bf16(f[0], f[1]); w.y = pg8::cvt_pk_bf16(f[2], f[3]); w.z = pg8::cvt_pk_bf16(f[4], f[5]); w.w = pg8::cvt_pk_bf16(f[6], f[7]); return w; }
struct MEpiH { static constexpr bool PERM = true, AFTER_DRAIN = false; static constexpr int SEG = 0; bf16_t* H; float* BA;
    __device__ __forceinline__ void operator()(const f32x4 (&acc)[2][2][4][2], const pg8::Unit& u, int wr, int wc, int fr0, int fq0) const {
        int fr = fr0, fq = fq0; asm volatile("" : "+v"(fr), "+v"(fq));
        const int row0 = u.pm * 256 + wr * 64 + fr;
#pragma unroll
        for (int bj = 0; bj < 2; ++bj) {
            const int wcol = u.pn * 256 + bj * 128 + wc * 32, col0 = wcol + 8 * fq;
            const bool plain = (wcol + 32 <= C_ZPOOL) || (wcol >= C_Q && wcol + 32 <= C_ZMLA) || (wcol >= C_QKV && wcol + 32 <= C_ZDN);
            const int act = ((col0 >= C_ZPOOL && col0 < C_Q) || (col0 >= C_ZMLA && col0 < C_QKV) || (col0 >= C_ZDN && col0 < C_BETA)) ? 1 : (col0 >= C_GATE ? 2 : 0);
            const bool isba = (col0 == C_BETA) || (col0 == C_ALPHA);
#pragma unroll
            for (int ai = 0; ai < 2; ++ai)
#pragma unroll
                for (int m = 0; m < 4; ++m) { const int row = row0 + ai * 128 + m * 16; f32x4 v0 = acc[ai][bj][m][0], v1 = acc[ai][bj][m][1];
                    if (!plain) {
                        if (isba) { float* b = BA + (size_t)row * 16 + (col0 - C_BETA); *(f32x4*)b = v0; *(f32x4*)(b + 4) = v1; }
#pragma unroll
                        for (int e = 0; e < 4; ++e) { const float s0 = sigmoidf_(v0[e]), s1 = sigmoidf_(v1[e]);
                            v0[e] = act == 0 ? v0[e] : (act == 1 ? v0[e] * s0 : s0); v1[e] = act == 0 ? v1[e] : (act == 1 ? v1[e] * s1 : s1); }
                    }
                    u32x4 w; w.x = pg8::cvt_pk_bf16(v0[0], v0[1]); w.y = pg8::cvt_pk_bf16(v0[2], v0[3]); w.z = pg8::cvt_pk_bf16(v1[0], v1[1]); w.w = pg8::cvt_pk_bf16(v1[2], v1[3]);
                    *(u32x4*)(H + (size_t)row * IN_WP + col0) = w; }
        }
    } };
struct MEpiQ { static constexpr bool PERM = true, AFTER_DRAIN = false; static constexpr int SEG = 0; bf16_t* Q; const float2* tab;
    __device__ __forceinline__ void operator()(const f32x4 (&acc)[2][2][4][2], const pg8::Unit& u, int wr, int wc, int fr0, int fq0) const {
        int fr = fr0, fq = fq0; asm volatile("" : "+v"(fr), "+v"(fq));
        const int row0 = u.pm * 256 + wr * 64 + fr;
#pragma unroll
        for (int bj = 0; bj < 2; ++bj) {
            const int wcol = u.pn * 256 + bj * 128 + wc * 32, col0 = wcol + 8 * fq;
            const bool rope = (wcol % 96) == 64;
#pragma unroll
            for (int ai = 0; ai < 2; ++ai)
#pragma unroll
                for (int m = 0; m < 4; ++m) { const int row = row0 + ai * 128 + m * 16; f32x4 v0 = acc[ai][bj][m][0], v1 = acc[ai][bj][m][1];
                    if (rope) { const int p = row < TP ? (row & (SEQ - 1)) : SEQ + ((row - TP) & 7); const float2* tp = tab + p * 16 + (fq & 1) * 8; const bool hi = fq >= 2;
#pragma unroll
                        for (int e = 0; e < 4; ++e) { const float o0 = __shfl_xor(v0[e], 32), o1 = __shfl_xor(v1[e], 32); const float2 c0 = tp[e], c1 = tp[4 + e];
                            v0[e] = hi ? (v0[e] * c0.x + o0 * c0.y) : (v0[e] * c0.x - o0 * c0.y); v1[e] = hi ? (v1[e] * c1.x + o1 * c1.y) : (v1[e] * c1.x - o1 * c1.y); } }
                    u32x4 w; w.x = pg8::cvt_pk_bf16(v0[0], v0[1]); w.y = pg8::cvt_pk_bf16(v0[2], v0[3]); w.z = pg8::cvt_pk_bf16(v1[0], v1[1]); w.w = pg8::cvt_pk_bf16(v1[2], v1[3]);
                    *(u32x4*)(Q + (size_t)row * 768 + col0) = w; if (m == 3) asm volatile("" ::: "memory"); }
        }
    } };
struct MEpiKV { static constexpr bool PERM = true, AFTER_DRAIN = false; static constexpr int SEG = 0; bf16_t* Kn; bf16_t* V;
    __device__ __forceinline__ void operator()(const f32x4 (&acc)[2][2][4][2], const pg8::Unit& u, int wr, int wc, int fr0, int fq0) const {
        int fr = fr0, fq = fq0; asm volatile("" : "+v"(fr), "+v"(fq));
        const int row0 = u.pm * 256 + wr * 64 + fr; bf16_t* base = u.pn < 2 ? Kn : V; const int cb = (u.pn & 1) * 256;
#pragma unroll
        for (int bj = 0; bj < 2; ++bj) { const int col0 = cb + bj * 128 + wc * 32 + 8 * fq;
#pragma unroll
            for (int ai = 0; ai < 2; ++ai)
#pragma unroll
                for (int m = 0; m < 4; ++m) { const int row = row0 + ai * 128 + m * 16; const f32x4 v0 = acc[ai][bj][m][0], v1 = acc[ai][bj][m][1];
                    u32x4 w; w.x = pg8::cvt_pk_bf16(v0[0], v0[1]); w.y = pg8::cvt_pk_bf16(v0[2], v0[3]); w.z = pg8::cvt_pk_bf16(v1[0], v1[1]); w.w = pg8::cvt_pk_bf16(v1[2], v1[3]);
                    *(u32x4*)(base + (size_t)row * 512 + col0) = w; } }
    } };
template <int BR> struct MEpiMerge { static constexpr bool PERM = true, AFTER_DRAIN = false; static constexpr int SEG = 0; const bf16_t* H; float* mf; bf16_t* mb;
    __device__ __forceinline__ void operator()(const f32x4 (&acc)[2][2][4][2], const pg8::Unit& u, int wr, int wc, int fr0, int fq0) const {
        int fr = fr0, fq = fq0; asm volatile("" : "+v"(fr), "+v"(fq));
        const int row0 = u.pm * 256 + wr * 64 + fr;
#pragma unroll
        for (int bj = 0; bj < 2; ++bj) { const int col0 = u.pn * 256 + bj * 128 + wc * 32 + 8 * fq;
#pragma unroll
            for (int ai = 0; ai < 2; ++ai)
#pragma unroll
                for (int m = 0; m < 4; ++m) { const int row = row0 + ai * 128 + m * 16; f32x4 v0 = acc[ai][bj][m][0], v1 = acc[ai][bj][m][1];
                    const u32x4 g = *(const u32x4*)(H + (size_t)row * IN_WP + C_GATE + BR * 1024 + col0);
                    v0[0] *= __uint_as_float(g.x << 16); v0[1] *= __uint_as_float(g.x & 0xffff0000u); v0[2] *= __uint_as_float(g.y << 16); v0[3] *= __uint_as_float(g.y & 0xffff0000u);
                    v1[0] *= __uint_as_float(g.z << 16); v1[1] *= __uint_as_float(g.z & 0xffff0000u); v1[2] *= __uint_as_float(g.w << 16); v1[3] *= __uint_as_float(g.w & 0xffff0000u);
                    float* mp = mf + (size_t)row * 1024 + col0;
                    if (BR > 0) { v0 += *(const f32x4*)mp; v1 += *(const f32x4*)(mp + 4); }
                    if (BR < 2) { *(f32x4*)mp = v0; *(f32x4*)(mp + 4) = v1; }
                    else { u32x4 w; w.x = pg8::cvt_pk_bf16(v0[0], v0[1]); w.y = pg8::cvt_pk_bf16(v0[2], v0[3]); w.z = pg8::cvt_pk_bf16(v1[0], v1[1]); w.w = pg8::cvt_pk_bf16(v1[2], v1[3]);
                        *(u32x4*)(mb + (size_t)row * 1024 + col0) = w; } asm volatile("" ::: "memory"); } }
    } };
struct MEpiRes { static constexpr bool PERM = false, AFTER_DRAIN = false; static constexpr int SEG = 0; const float* xp; const float* xs; float* xo;
    __device__ __forceinline__ void operator()(const f32x4 (&acc)[2][2][4][2], const pg8::Unit& u, int wr, int wc, int fr0, int fq0) const {
        int fr = fr0, fq = fq0; asm volatile("" : "+v"(fr), "+v"(fq));
        const int row0 = u.pm * 256 + wr * 64 + fr, col0 = u.pn * 256 + wc * 32 + 4 * fq;
#pragma unroll
        for (int ai = 0; ai < 2; ++ai)
#pragma unroll
            for (int m2 = 0; m2 < 4; m2 += 2) {
                f32x4 xv[2][2][2];
#pragma unroll
                for (int mm = 0; mm < 2; ++mm) { const int row = row0 + ai * 128 + (m2 + mm) * 16; const float* xr = row < TP ? xp + (size_t)row * 1024 : xs + (size_t)(row - TP) * 1024;
#pragma unroll
                    for (int bj = 0; bj < 2; ++bj)
#pragma unroll
                        for (int n = 0; n < 2; ++n) xv[mm][bj][n] = *(const f32x4*)(xr + col0 + bj * 128 + n * 16); }
#pragma unroll
                for (int mm = 0; mm < 2; ++mm) { const int row = row0 + ai * 128 + (m2 + mm) * 16; float* orow = xo + (size_t)row * 1024;
#pragma unroll
                    for (int bj = 0; bj < 2; ++bj)
#pragma unroll
                        for (int n = 0; n < 2; ++n) *(f32x4*)(orow + col0 + bj * 128 + n * 16) = xv[mm][bj][n] + acc[ai][bj][m2 + mm][n]; }
                asm volatile("" ::: "memory"); }
    } };

template <int NSEG, class Epi>
__device__ __forceinline__ void tail_gemm(const bf16_t* __restrict__ A, int lda, const bf16_t* __restrict__ Bt, int K, int N, const Epi& epi, LAS unsigned char* lds) {
    int tid = threadIdx.x; asm volatile("" : "+v"(tid));
    const int lane = tid & 63, wave = __builtin_amdgcn_readfirstlane(tid >> 6), rt = wave & 3, kh = wave >> 2, n = lane & 15, q = lane >> 4;
    const int ntile = 4 * (N / 16), kseg = K / NSEG, khalf = kseg / 2;
    LAS f32x4* red = (LAS f32x4*)lds;
    for (int tile = blockIdx.x; tile < ntile; tile += gridDim.x) {
        const int r0 = 64 * (tile & 3) + 16 * rt, c0 = 16 * (tile >> 2);
        const bf16_t* ap = A + (size_t)(r0 + n) * lda + 8 * q; const bf16_t* bp = Bt + (size_t)(c0 + n) * K + 8 * q;
        f32x4 acc[NSEG];
#pragma unroll
        for (int sg = 0; sg < NSEG; ++sg) { acc[sg] = (f32x4){0.f, 0.f, 0.f, 0.f};
            const int kb = sg * kseg + kh * khalf;
#pragma unroll 4
            for (int k = 0; k < khalf; k += 32) acc[sg] = __builtin_amdgcn_mfma_f32_16x16x32_bf16(*(const bf16x8_t*)(ap + kb + k), *(const bf16x8_t*)(bp + kb + k), acc[sg], 0, 0, 0); }
        __syncthreads();
        if (kh == 1) {
#pragma unroll
            for (int sg = 0; sg < NSEG; ++sg) red[(rt * NSEG + sg) * 64 + lane] = acc[sg]; }
        __syncthreads();
        if (kh == 0) {
#pragma unroll
            for (int sg = 0; sg < NSEG; ++sg) acc[sg] += red[(rt * NSEG + sg) * 64 + lane];
#pragma unroll
            for (int e = 0; e < 4; ++e) { float v[NSEG];
#pragma unroll
                for (int sg = 0; sg < NSEG; ++sg) v[sg] = acc[sg][e];
                epi(r0 + 4 * q + e, c0 + n, v); } }
    }
    __syncthreads();
}
struct TEpiMerge { const bf16_t* H; bf16_t* mb;
    __device__ __forceinline__ void operator()(int row, int col, const float (&v)[3]) const { const size_t t = (size_t)TP + row; const bf16_t* g = H + t * IN_WP + C_GATE + col;
        mb[t * 1024 + col] = f2bf(bf2f(g[0]) * v[0] + bf2f(g[1024]) * v[1] + bf2f(g[2048]) * v[2]); } };
struct TEpiRes { const float* xs; float* xo;
    __device__ __forceinline__ void operator()(int row, int col, const float (&v)[1]) const { xo[((size_t)TP + row) * 1024 + col] = xs[(size_t)row * 1024 + col] + v[0]; } };
struct MEpiMergeS { static constexpr bool PERM = true, AFTER_DRAIN = false; static constexpr int SEG = 3; const bf16_t* H; bf16_t* mb;
    __device__ __forceinline__ void mid(f32x4 (&acc)[2][2][4][2], const pg8::Unit& u, int wr, int wc, int fr0, int fq0, int seg, float keep) const {
        int fr = fr0, fq = fq0; asm volatile("" : "+v"(fr), "+v"(fq));
        const int row0 = u.pm * 256 + wr * 64 + fr;
#pragma unroll
        for (int bj = 0; bj < 2; ++bj) { const int col0 = u.pn * 256 + bj * 128 + wc * 32 + 8 * fq;
#pragma unroll
            for (int ai = 0; ai < 2; ++ai) {
                u32x4 ga[4], gb[4];
#pragma unroll
                for (int m = 0; m < 4; ++m) { const bf16_t* gp = H + (size_t)(row0 + ai * 128 + m * 16) * IN_WP + C_GATE + (seg - 1) * 1024 + col0; ga[m] = *(const u32x4*)gp; gb[m] = *(const u32x4*)(gp + 1024); }
#pragma unroll
                for (int m = 0; m < 4; ++m) { float a[8], b[8]; unpack8(ga[m], a); unpack8(gb[m], b);
#pragma unroll
                    for (int e = 0; e < 4; ++e) { acc[ai][bj][m][0][e] *= keep * a[e] * __builtin_amdgcn_rcpf(fmaxf(b[e], 1e-30f)); acc[ai][bj][m][1][e] *= keep * a[4 + e] * __builtin_amdgcn_rcpf(fmaxf(b[4 + e], 1e-30f)); } }
                asm volatile("" ::: "memory"); } }
    }
    __device__ __forceinline__ void operator()(const f32x4 (&acc)[2][2][4][2], const pg8::Unit& u, int wr, int wc, int fr0, int fq0) const {
        int fr = fr0, fq = fq0; asm volatile("" : "+v"(fr), "+v"(fq));
        const int row0 = u.pm * 256 + wr * 64 + fr;
#pragma unroll
        for (int bj = 0; bj < 2; ++bj) { const int col0 = u.pn * 256 + bj * 128 + wc * 32 + 8 * fq;
#pragma unroll
            for (int ai = 0; ai < 2; ++ai) {
                u32x4 gg[4];
#pragma unroll
                for (int m = 0; m < 4; ++m) gg[m] = *(const u32x4*)(H + (size_t)(row0 + ai * 128 + m * 16) * IN_WP + C_GATE + 2048 + col0);
#pragma unroll
                for (int m = 0; m < 4; ++m) { const int row = row0 + ai * 128 + m * 16; float g[8]; unpack8(gg[m], g);
                    const f32x4 v0 = acc[ai][bj][m][0], v1 = acc[ai][bj][m][1];
                    u32x4 w; w.x = pg8::cvt_pk_bf16(v0[0] * g[0], v0[1] * g[1]); w.y = pg8::cvt_pk_bf16(v0[2] * g[2], v0[3] * g[3]); w.z = pg8::cvt_pk_bf16(v1[0] * g[4], v1[1] * g[5]); w.w = pg8::cvt_pk_bf16(v1[2] * g[6], v1[3] * g[7]);
                    *(u32x4*)(mb + (size_t)row * 1024 + col0) = w; }
                asm volatile("" ::: "memory"); } }
    } };

__device__ __forceinline__ void ph_tr(const float* __restrict__ src, bf16_t* __restrict__ dst, int K, int N, int Npad, LAS float* tile, int rot, int ldd = 0) {
    if (ldd == 0) ldd = K;
    int tid = threadIdx.x; asm volatile("" : "+v"(tid)); const int G = gridDim.x; const int tn = Npad / 64, tk = K / 32, nt = tn * tk;
    const int first = (blockIdx.x + G - (rot % G)) % G;
    const bool al4 = (N & 3) == 0;
    for (int t = first; t < nt; t += G) {
        const int n0 = (t % tn) * 64, k0 = (t / tn) * 32;
        { const int k = tid >> 4, n4 = (tid & 15) * 4, n = n0 + n4; f32x4 v = (f32x4){0.f, 0.f, 0.f, 0.f};
          const float* sp = src + (size_t)(k0 + k) * N + n;
          if (al4 && n + 3 < N) v = *(const f32x4*)sp; else {
#pragma unroll
              for (int e = 0; e < 4; ++e) if (n + e < N) v[e] = sp[e]; }
#pragma unroll
          for (int e = 0; e < 4; ++e) tile[k * 65 + n4 + e] = v[e]; }
        __syncthreads();
        if (tid < 256) { const int n = tid >> 2, kq = (tid & 3) * 8; float f[8];
#pragma unroll
            for (int j = 0; j < 8; ++j) f[j] = tile[(kq + j) * 65 + n];
            *(u32x4*)(dst + (size_t)(n0 + n) * ldd + k0 + kq) = pack8(f); }
        __syncthreads();
    }
}
__device__ __forceinline__ void ph_rope_tab(float2* tab) {
    for (int idx = blockIdx.x * NTHR + threadIdx.x; idx < (SEQ + DEC_SEQ) * 16; idx += gridDim.x * NTHR) {
        const int p = idx >> 4, i = idx & 15; const int pos = p < SEQ ? p : PAST_LEN + (p - SEQ);
        const float inv = powf(10000.0f, -(float)i / 16.0f); const float ang = (float)pos * inv;
        const double rev = (double)ang * 0.15915494309189533576888; const float f = (float)(rev - floor(rev));
        tab[idx] = make_float2(__builtin_amdgcn_cosf(f), __builtin_amdgcn_sinf(f)); }
}
__device__ __forceinline__ void ph_rmsnorm(const float* __restrict__ xp, const float* __restrict__ xs, const float* __restrict__ g, bf16_t* __restrict__ xn, float* __restrict__ yp, float* __restrict__ ys) {
    int tid_o = threadIdx.x; asm volatile("" : "+v"(tid_o)); int lane = tid_o & 63, wave = tid_o >> 6;
    for (int t = blockIdx.x * 8 + wave; t < TT; t += gridDim.x * 8) {
        const float* x = t < TP ? xp + (size_t)t * 1024 : xs + (size_t)(t - TP) * 1024;
        f32x4 v[4]; float ss = 0.f;
#pragma unroll
        for (int i = 0; i < 4; ++i) { v[i] = *(const f32x4*)(x + i * 256 + lane * 4); ss += v[i][0] * v[i][0] + v[i][1] * v[i][1] + v[i][2] * v[i][2] + v[i][3] * v[i][3]; }
        ss = wave_sum(ss); const float r = rsqrtf(ss * (1.0f / 1024.0f) + EPS);
#pragma unroll
        for (int i = 0; i < 4; ++i) { const int c = i * 256 + lane * 4; const f32x4 gg = *(const f32x4*)(g + c); const f32x4 o = v[i] * r * gg;
            if (xn) { u32x2 w; w.x = pg8::cvt_pk_bf16(o[0], o[1]); w.y = pg8::cvt_pk_bf16(o[2], o[3]); *(u32x2*)(xn + (size_t)t * 1024 + c) = w; }
            else { float* y = t < TP ? yp + (size_t)t * 1024 : ys + (size_t)(t - TP) * 1024; *(f32x4*)(y + c) = o; } }
    }
}

constexpr int TK_RS = 1040;
struct ConvIn { u32x4 rows[11]; f32x4 sa[3], sb[3]; f32x4 w0[4], w1[4]; };
__device__ __forceinline__ void conv_load(ConvIn& c, KP p, const bf16_t* __restrict__ H, int l, int tbase, int iseq0, bool smp, int sq, int lane, int pi) {
    const int c0 = (pi * 64 + lane) * 8; const float* conv_w = p->conv_w + (size_t)l * 4 * 1536;
#pragma unroll
    for (int j = 0; j < 11; ++j) {
        if (j >= 3 || iseq0 - 3 + j >= 0) c.rows[j] = *(const u32x4*)(H + (size_t)(tbase - 3 + j) * IN_WP + C_QKV + c0);
        else if (smp) { const float* sc = p->state_conv + (((size_t)l * DEC_BATCH + sq) * 3 + j) * 1536 + c0; c.sa[j] = *(const f32x4*)sc; c.sb[j] = *(const f32x4*)(sc + 4); }
        else c.rows[j] = (u32x4){0u, 0u, 0u, 0u}; }
#pragma unroll
    for (int j = 0; j < 4; ++j) { c.w0[j] = *(const f32x4*)(conv_w + j * 1536 + c0); c.w1[j] = *(const f32x4*)(conv_w + j * 1536 + c0 + 4); }
}
__device__ __forceinline__ void conv_compute(ConvIn& c, KP p, float* __restrict__ out, int l, int tbase, int iseq0, bool smp, int sq, int lane, int pi) {
    const int c0 = (pi * 64 + lane) * 8; const bool last = smp || (iseq0 == SEQ - 8);
    if (smp) {
#pragma unroll
        for (int j = 0; j < 3; ++j) { const f32x4 a = c.sa[j], b = c.sb[j]; c.rows[j].x = pg8::cvt_pk_bf16(a[0], a[1]); c.rows[j].y = pg8::cvt_pk_bf16(a[2], a[3]); c.rows[j].z = pg8::cvt_pk_bf16(b[0], b[1]); c.rows[j].w = pg8::cvt_pk_bf16(b[2], b[3]); } }
    bf16_t* dst = pi == 0 ? p->qd : (pi == 1 ? p->kd : p->vd);
#pragma unroll
    for (int e = 0; e < 8; ++e) { float y[8];
#pragma unroll
        for (int k = 0; k < 8; ++k) y[k] = 0.f;
#pragma unroll
        for (int j = 0; j < 4; ++j) { float x[8]; unpack8(c.rows[e + j], x);
#pragma unroll
            for (int k = 0; k < 4; ++k) { y[k] += x[k] * c.w0[j][k]; y[4 + k] += x[4 + k] * c.w1[j][k]; } }
        float ss = 0.f;
#pragma unroll
        for (int k = 0; k < 8; ++k) { y[k] = siluf_(y[k]); ss += y[k] * y[k]; }
        if (pi < 2) { ss += __shfl_xor(ss, 1); ss += __shfl_xor(ss, 2); ss += __shfl_xor(ss, 4); const float rn = rsqrtf(ss + EPS) * (pi == 0 ? 0.125f : 1.0f);
#pragma unroll
            for (int k = 0; k < 8; ++k) y[k] *= rn; }
        *(u32x4*)(dst + (size_t)(tbase + e) * 512 + lane * 8) = pack8(y); }
    if (last) {
#pragma unroll
        for (int rr = 0; rr < 3; ++rr) { float x[8]; unpack8(c.rows[8 + rr], x);
            float* oc = (smp ? out + O_SCONV + (((size_t)l * DEC_BATCH + sq) * 3 + rr) * 1536 : out + O_PCONV + (((size_t)l * 8 + (tbase >> 11)) * 3 + rr) * 1536) + c0;
            *(f32x4*)oc = (f32x4){x[0], x[1], x[2], x[3]}; *(f32x4*)(oc + 4) = (f32x4){x[4], x[5], x[6], x[7]}; } }
}
__device__ __forceinline__ void tok8(KP p, int l, int tbase, int iseq0, bool smp, int sq, int lane) {
    asm volatile("" : "+v"(lane));
    const bf16_t* __restrict__ H = p->H; float* __restrict__ out = p->out;
    __builtin_amdgcn_s_waitcnt(0);
    const float* qg = p->q_norm_g + l * 384; const float* kvg = p->kv_norm_g + l * 256;
    u32x4 rq[8], rk[8];
#pragma unroll
    for (int e = 0; e < 8; ++e) { const bf16_t* h = H + (size_t)(tbase + e) * IN_WP;
        rq[e] = lane < 48 ? *(const u32x4*)(h + C_Q + lane * 8) : (u32x4){0u, 0u, 0u, 0u}; rk[e] = lane < 32 ? *(const u32x4*)(h + C_KV + lane * 8) : (u32x4){0u, 0u, 0u, 0u}; }
    f32x4 gq0 = (f32x4){0.f, 0.f, 0.f, 0.f}, gq1 = gq0, gk0 = gq0, gk1 = gq0;
    if (lane < 48) { gq0 = *(const f32x4*)(qg + lane * 8); gq1 = *(const f32x4*)(qg + lane * 8 + 4); }
    if (lane < 32) { gk0 = *(const f32x4*)(kvg + lane * 8); gk1 = *(const f32x4*)(kvg + lane * 8 + 4); }
    ConvIn A, B;
    conv_load(A, p, H, l, tbase, iseq0, smp, sq, lane, 0);
#pragma unroll
    for (int e = 0; e < 8; ++e) { const int t = tbase + e; float q[8], kv[8]; unpack8(rq[e], q); unpack8(rk[e], kv); float s1 = 0.f, s2 = 0.f;
#pragma unroll
        for (int j = 0; j < 8; ++j) { s1 += q[j] * q[j]; s2 += kv[j] * kv[j]; }
        s1 = wave_sum(s1); s2 = wave_sum(s2); const float r1 = rsqrtf(s1 * (1.0f / 384.0f) + EPS), r2 = rsqrtf(s2 * (1.0f / 256.0f) + EPS);
#pragma unroll
        for (int j = 0; j < 4; ++j) { q[j] *= r1 * gq0[j]; q[4 + j] *= r1 * gq1[j]; kv[j] *= r2 * gk0[j]; kv[4 + j] *= r2 * gk1[j]; }
        if (lane < 48) *(u32x4*)(p->cq + (size_t)t * 384 + lane * 8) = pack8(q);
        if (lane < 32) { float* okv = (smp ? out + O_SKV + ((size_t)l * TS + (t - TP)) * 256 : out + O_PKV + ((size_t)l * TP + t) * 256) + lane * 8;
            *(f32x4*)okv = (f32x4){kv[0], kv[1], kv[2], kv[3]}; *(f32x4*)(okv + 4) = (f32x4){kv[4], kv[5], kv[6], kv[7]};
            *(u32x4*)(p->ckv + (size_t)t * 256 + lane * 8) = pack8(kv); } }
    conv_load(B, p, H, l, tbase, iseq0, smp, sq, lane, 1);
    conv_compute(A, p, out, l, tbase, iseq0, smp, sq, lane, 0);
    conv_load(A, p, H, l, tbase, iseq0, smp, sq, lane, 2);
    float kx1[2], kx2[2]; float2 kcs[2];
#pragma unroll
    for (int ps = 0; ps < 2; ++ps) { const int e = (lane >> 4) + 4 * ps, j = lane & 15; const bf16_t* h = H + (size_t)(tbase + e) * IN_WP;
        kx1[ps] = bf2f(h[C_KR + j]); kx2[ps] = bf2f(h[C_KR + 16 + j]); kcs[ps] = p->tab[((smp ? SEQ : 0) + iseq0 + e) * 16 + j]; }
    const int tc = tbase + (lane >> 3), hd = lane & 7;
    const float ba0 = p->BA[(size_t)tc * 16 + hd], ba1 = p->BA[(size_t)tc * 16 + 8 + hd], dtb = p->dt_bias[l * 8 + hd], alg = p->a_log[l * 8 + hd];
    conv_compute(B, p, out, l, tbase, iseq0, smp, sq, lane, 1);
    conv_compute(A, p, out, l, tbase, iseq0, smp, sq, lane, 2);
#pragma unroll
    for (int ps = 0; ps < 2; ++ps) { const int e = (lane >> 4) + 4 * ps, j = lane & 15, t = tbase + e; const float x1 = kx1[ps], x2 = kx2[ps]; const float2 cs = kcs[ps];
        const float o1 = x1 * cs.x - x2 * cs.y, o2 = x2 * cs.x + x1 * cs.y; float* okr = smp ? out + O_SKR + ((size_t)l * TS + (t - TP)) * 32 : out + O_PKR + ((size_t)l * TP + t) * 32;
        okr[j] = o1; okr[16 + j] = o2; p->Kr[(size_t)t * 32 + j] = f2bf(o1); p->Kr[(size_t)t * 32 + 16 + j] = f2bf(o2); }
    { const float bb = sigmoidf_(ba0); const float x = ba1 + dtb;
      const float sp = x > 20.f ? x : log1pf(expf(x)); const float gg = -expf(alg) * sp;
      p->bg[(size_t)tc * 16 + hd] = bb; p->bg[(size_t)tc * 16 + 8 + hd] = gg; }
}
__device__ __forceinline__ void ph_tok(KP p, int l, LAS unsigned char* lds) {
    for (int tile = blockIdx.x; tile < TP / 64 + 8; tile += gridDim.x) {
        int tid = threadIdx.x; asm volatile("" : "+v"(tid)); const int pmask = p->pad;
        const int lane = tid & 63, wave = __builtin_amdgcn_readfirstlane(tid >> 6), r = lane & 31, hh = lane >> 5;
        const bf16_t* __restrict__ H = p->H; float* __restrict__ out = p->out;
        const bool smp = tile >= TP / 64; const int s0 = smp ? (tile - TP / 64) * 4 : 0;
        const int t0 = smp ? TP + s0 * 8 : tile * 64, i0 = smp ? 0 : (t0 & (SEQ - 1)), b = t0 >> 11;
        TP_DECL; TP_ON(50); TP_ON(51); TP_ON(52); TP_ON(55);
        __syncthreads();
        if (!smp) {
            u32x4 v[10];
#pragma unroll
            for (int i = 0; i < 10; ++i) { const int c = tid + NTHR * i, row = c >> 6, ch16 = c & 63; v[i] = (u32x4){0u, 0u, 0u, 0u};
                if (c < 79 * 64 && i0 - 15 + row >= 0) v[i] = *(const u32x4*)(H + (size_t)(t0 - 15 + row) * IN_WP + C_POOL + ch16 * 8); }
#pragma unroll
            for (int i = 0; i < 10; ++i) { const int c = tid + NTHR * i, row = c >> 6, ch16 = c & 63; if (c < 79 * 64) *(LAS u32x4*)(lds + row * TK_RS + ch16 * 16) = v[i]; }
        } else {
            int tq = tid; asm volatile("" : "+v"(tq));
            f32x4 va[12], vb[12];
#pragma unroll
            for (int i = 0; i < 12; ++i) { const int c = tq + NTHR * i, row = c >> 6, ch16 = c & 63, sq = row / 23, j = row - sq * 23; va[i] = (f32x4){0.f, 0.f, 0.f, 0.f}; vb[i] = va[i];
                if (c < 92 * 64) {
                    if (j >= 15) { const u32x4 v = *(const u32x4*)(H + (size_t)(t0 + sq * 8 + (j - 15)) * IN_WP + C_POOL + ch16 * 8); va[i] = __builtin_bit_cast(f32x4, v); }
                    else { const float* sp = p->state_pool + (((size_t)l * DEC_BATCH + s0 + sq) * 15 + j) * 512 + ch16 * 8; va[i] = *(const f32x4*)sp; vb[i] = *(const f32x4*)(sp + 4); } } }
#pragma unroll
            for (int i = 0; i < 12; ++i) { const int c = tq + NTHR * i, row = c >> 6, ch16 = c & 63, sq = row / 23, j = row - sq * 23;
                if (c < 92 * 64) { u32x4 v = __builtin_bit_cast(u32x4, va[i]);
                    if (j < 15) { const f32x4 a = va[i], bq = vb[i];
                        v.x = pg8::cvt_pk_bf16(a[0], a[1]); v.y = pg8::cvt_pk_bf16(a[2], a[3]); v.z = pg8::cvt_pk_bf16(bq[0], bq[1]); v.w = pg8::cvt_pk_bf16(bq[2], bq[3]);
                        if (j >= 8) { float* so = out + O_SPOOL + (((size_t)l * DEC_BATCH + s0 + sq) * 15 + (j - 8)) * 512 + ch16 * 8; *(f32x4*)so = a; *(f32x4*)(so + 4) = bq; } }
                    *(LAS u32x4*)(lds + row * TK_RS + ch16 * 16) = v; } }
        }
        __syncthreads();
        if (smp) TP_OFF(52); else TP_OFF(55);
        if (smp) TP_ON(53); else TP_ON(56);
        if (smp && (wave & 1) && (pmask & 16384)) tok8(p, l, t0 + (wave >> 1) * 8, 0, true, s0 + (wave >> 1), lane);
        if ((pmask & 8192) && !(smp && (wave & 1))) { const int g = wave >> 1, th = wave & 1, w = 2 << g, tk = 32 * th + r;
          const int brow = smp ? (tk >> 3) * 23 + 15 + (tk & 7) : 15 + tk; const float inv = 1.0f / (float)(smp ? w : min(i0 + tk + 1, w));
          const bf16_t* mixT = p->PmixT + ((size_t)l * 4 + g) * 128 * 128;
          f32x16 acc[4];
#pragma unroll
          for (int nt = 0; nt < 4; ++nt)
#pragma unroll
              for (int e = 0; e < 16; ++e) acc[nt][e] = 0.f;
          const size_t t = (size_t)t0 + tk; const float* scl = p->pool_scale + l * 512 + 128 * g;
          u32x2 zv[16];
#pragma unroll
          for (int nt = 0; nt < 4; ++nt)
#pragma unroll
              for (int gg = 0; gg < 4; ++gg) { const int dd0 = 32 * nt + 8 * gg + 4 * hh; zv[4 * nt + gg] = *(const u32x2*)(H + t * IN_WP + C_ZPOOL + 128 * g + dd0); }
#pragma unroll 2
          for (int ks = 0; ks < 8; ++ks) {
              const LAS unsigned char* base = lds + brow * TK_RS + (128 * g + 16 * ks + 8 * hh) * 2;
              float cur[8], sum[8]; unpack8(*(const LAS u32x4*)base, cur);
#pragma unroll
              for (int e = 0; e < 8; ++e) sum[e] = cur[e];
              for (int k = 1; k < w; ++k) { float x[8]; unpack8(*(const LAS u32x4*)(base - k * TK_RS), x);
#pragma unroll
                  for (int e = 0; e < 8; ++e) sum[e] += x[e]; }
#pragma unroll
              for (int e = 0; e < 8; ++e) sum[e] = sum[e] * inv - cur[e];
              union { u32x4 u; bf16x8_t v; } bfr; bfr.u = pack8(sum);
#pragma unroll
              for (int nt = 0; nt < 4; ++nt) { const bf16x8_t a = *(const bf16x8_t*)(mixT + (size_t)(32 * nt + r) * 128 + 16 * ks + 8 * hh);
                  acc[nt] = __builtin_amdgcn_mfma_f32_32x32x16_bf16(a, bfr.v, acc[nt], 0, 0, 0); } }
          f32x4 scv[16];
#pragma unroll
          for (int nt = 0; nt < 4; ++nt)
#pragma unroll
              for (int gg = 0; gg < 4; ++gg) scv[4 * nt + gg] = *(const f32x4*)(scl + 32 * nt + 8 * gg + 4 * hh);
#pragma unroll
          for (int nt = 0; nt < 4; ++nt)
#pragma unroll
              for (int gg = 0; gg < 4; ++gg) { const int dd0 = 32 * nt + 8 * gg + 4 * hh; const u32x2 z = zv[4 * nt + gg]; const f32x4 sc = scv[4 * nt + gg];
                  float v0 = acc[nt][4 * gg + 0] * sc[0] * __uint_as_float(z.x << 16), v1 = acc[nt][4 * gg + 1] * sc[1] * __uint_as_float(z.x & 0xffff0000u);
                  float v2 = acc[nt][4 * gg + 2] * sc[2] * __uint_as_float(z.y << 16), v3 = acc[nt][4 * gg + 3] * sc[3] * __uint_as_float(z.y & 0xffff0000u);
                  u32x2 o; o.x = pg8::cvt_pk_bf16(v0, v1); o.y = pg8::cvt_pk_bf16(v2, v3); *(u32x2*)(p->ya + t * 1536 + 128 * g + dd0) = o; } }
        if (!smp) { if (i0 == SEQ - 64) { for (int c = tid; c < 15 * 512; c += NTHR) { const int rr = c >> 9, ch = c & 511;
              out[O_PPOOL + (((size_t)l * 8 + b) * 15 + rr) * 512 + ch] = bf2f(*(const LAS bf16_t*)(lds + (15 + 49 + rr) * TK_RS + ch * 2)); } } }
        else { for (int c = tid; c < 4 * 8 * 512; c += NTHR) { const int sq = c >> 12, i = (c >> 9) & 7, ch = c & 511;
              out[O_SPOOL + (((size_t)l * DEC_BATCH + s0 + sq) * 15 + 7 + i) * 512 + ch] = bf2f(*(const LAS bf16_t*)(lds + (sq * 23 + 15 + i) * TK_RS + ch * 2)); } }
        if (smp) TP_OFF(53); else TP_OFF(56);
        if (smp) TP_ON(54); else TP_ON(57);
        if ((pmask & 16384) && !smp) tok8(p, l, t0 + wave * 8, i0 + wave * 8, false, 0, lane);
        if (smp) { TP_OFF(51); TP_OFF(54); } else { TP_OFF(50); TP_OFF(57); }
    }
    __syncthreads();
}

template <bool SYNC> __device__ __forceinline__ void wu_delta(KP p, int l, int s, int h, int lane, LAS unsigned char* wl) {
    asm volatile("" : "+v"(lane)); int dv = lane;
    const size_t row0 = (size_t)TP + s * 8;
    float* so = p->out + O_SDELTA + (((size_t)l * DEC_BATCH + s) * 8 + h) * 4096;
    const float* s0 = p->state_delta + (((size_t)l * DEC_BATCH + s) * 8 + h) * 4096;
    { const size_t t = row0 + (lane >> 3); const int part = lane & 7;
      const u32x4 kv = *(const u32x4*)(p->kd + t * 512 + h * 64 + part * 8), qv = *(const u32x4*)(p->qd + t * 512 + h * 64 + part * 8);
      *(LAS u32x4*)(wl + lane * 16) = kv; *(LAS u32x4*)(wl + 1024 + lane * 16) = qv; }
    float vv[8], zz[8];
#pragma unroll
    for (int i = 0; i < 8; ++i) { vv[i] = bf2f(p->vd[(row0 + i) * 512 + h * 64 + dv]); zz[i] = bf2f(p->H[(row0 + i) * IN_WP + C_ZDN + h * 64 + dv]); }
    float bl = 0.f, al = 0.f;
    if (lane < 8) { bl = p->bg[(row0 + lane) * 16 + h]; al = __expf(p->bg[(row0 + lane) * 16 + 8 + h]); }
    float S[64];
#pragma unroll
    for (int k = 0; k < 64; ++k) S[k] = s0[k * 64 + dv];
    const float gn = p->dn_norm_g[l * 64 + dv];
    if (SYNC) __builtin_amdgcn_s_barrier();
#pragma unroll
    for (int i = 0; i < 8; ++i) {
        asm volatile("" ::: "memory");
        const float b = __int_as_float(__builtin_amdgcn_readlane(__float_as_int(bl), i)), a = __int_as_float(__builtin_amdgcn_readlane(__float_as_int(al), i));
        u32x4 kk[8];
#pragma unroll
        for (int c = 0; c < 8; ++c) kk[c] = *(const LAS u32x4*)(wl + i * 128 + c * 16);
        float ks = 0.f;
#pragma unroll
        for (int c = 0; c < 8; ++c)
#pragma unroll
            for (int e = 0; e < 4; ++e) { const unsigned w = kk[c][e]; ks += __uint_as_float(w << 16) * S[c * 8 + 2 * e] + __uint_as_float(w & 0xffff0000u) * S[c * 8 + 2 * e + 1]; }
        const float vn = b * (vv[i] - a * ks); float o = 0.f;
#pragma unroll
        for (int c = 0; c < 8; ++c) { const u32x4 qv = *(const LAS u32x4*)(wl + 1024 + i * 128 + c * 16);
#pragma unroll
            for (int e = 0; e < 4; ++e) { const unsigned w = kk[c][e], wq = qv[e]; const int k0 = c * 8 + 2 * e;
                S[k0] = a * S[k0] + __uint_as_float(w << 16) * vn; o += __uint_as_float(wq << 16) * S[k0];
                S[k0 + 1] = a * S[k0 + 1] + __uint_as_float(w & 0xffff0000u) * vn; o += __uint_as_float(wq & 0xffff0000u) * S[k0 + 1]; }
            asm volatile("" ::: "memory"); }
        const float ss = wave_sum(o * o); const float y = o * rsqrtf(ss * (1.0f / 64.0f) + EPS) * gn;
        p->yc[(row0 + i) * 1536 + h * 64 + dv] = f2bf(y * zz[i]);
        if (SYNC) {
#pragma unroll
            for (int k = 0; k < 8; ++k) __builtin_amdgcn_s_barrier(); }
    }
#pragma unroll
    for (int k = 0; k < 64; ++k) so[k * 64 + dv] = S[k];
}
__device__ __forceinline__ int sig_inv(int rho) { return (rho & 32) | ((rho & 12) << 1) | ((rho & 16) >> 2) | (rho & 3); }
constexpr int DPRE_LDS = 64 * 64 * 4 + 512;
constexpr int DST = 72;
__device__ __forceinline__ void dpre_flush(const LAS bf16_t* St, bf16_t* gdst, int lane) {
    asm volatile("s_waitcnt lgkmcnt(0)" ::: "memory");
#pragma unroll
    for (int it = 0; it < 8; ++it) { const int row = 16 * (it >> 1) + (lane & 15), chunk = 4 * (it & 1) + (lane >> 4); *(u32x4*)(gdst + (it * 64 + lane) * 8) = *(const LAS u32x4*)(St + row * DST + chunk * 8); }
    asm volatile("s_waitcnt lgkmcnt(0)" ::: "memory");
}
__device__ __forceinline__ void ph_delta_pre(KP p, LAS unsigned char* lds) {
    int tid_o = threadIdx.x; asm volatile("" : "+v"(tid_o)); int lane = tid_o & 63, wave = tid_o >> 6;
    wave = __builtin_amdgcn_readfirstlane(wave);
    LAS float* Am = (LAS float*)(lds + wave * DPRE_LDS); LAS float* gcs = Am + 4096; LAS float* bts = gcs + 64; LAS bf16_t* St = (LAS bf16_t*)Am;
    for (int unit = wave * gridDim.x + blockIdx.x; unit < 2048; unit += gridDim.x * 8) {
        { int t_ = threadIdx.x; asm volatile("" : "+v"(t_)); lane = t_ & 63; }
        const int r = lane & 31, hh = lane >> 5;
        const int bh = unit >> 5, ch = unit & 31, b = bh >> 3, h = bh & 7;
        const size_t t0 = (size_t)b * SEQ + ch * 64;
        bf16_t* op = p->DOP + (size_t)unit * 4 * 4096; float* up = p->DU + (size_t)unit * 4096;
        const bf16_t* kdb = p->kd + t0 * 512 + h * 64; const bf16_t* qdb = p->qd + t0 * 512 + h * 64; const bf16_t* vdb = p->vd + t0 * 512 + h * 64;
        const float* bgb = p->bg + t0 * 16 + h;
        const float beta = bgb[lane * 16]; float gc = bgb[lane * 16 + 8];
#pragma unroll
        for (int d = 1; d < 64; d <<= 1) { const float x = __shfl_up(gc, d); if (lane >= d) gc += x; }
        const float gl = __shfl(gc, 63); const float egc = __expf(gc);
        gcs[lane] = gc; bts[lane] = beta;
        if (lane == 0) p->DG[unit] = __expf(gl);
        bf16x8_t kf[2][4], qf[2][4];
        { const int voff = r * 512 + 8 * hh;
#pragma unroll
          for (int rb = 0; rb < 2; ++rb)
#pragma unroll
            for (int ks = 0; ks < 4; ++ks) { kf[rb][ks] = *(const bf16x8_t*)(kdb + (32 * rb * 512 + 16 * ks) + voff); qf[rb][ks] = *(const bf16x8_t*)(qdb + (32 * rb * 512 + 16 * ks) + voff); } }
        {
#pragma unroll
            for (int rb = 0; rb < 2; ++rb) { const float sc = __expf(gl - __shfl(gc, 32 * rb + r)); const int pos = sig_inv(32 * rb + r);
#pragma unroll
                for (int ks = 0; ks < 4; ++ks)
#pragma unroll
                    for (int jj = 0; jj < 8; ++jj) St[(16 * ks + 8 * hh + jj) * DST + pos] = f2bf(bf2f((bf16_t)kf[rb][ks][jj]) * sc); }
            dpre_flush(St, op + 3 * 4096, lane);
#pragma unroll
            for (int rb = 0; rb < 2; ++rb) { const float sc = __shfl(egc, 32 * rb + r);
#pragma unroll
                for (int ks = 0; ks < 4; ++ks)
#pragma unroll
                    for (int jj = 0; jj < 8; ++jj) St[(32 * rb + r) * DST + sig_inv(16 * ks + 8 * hh + jj)] = f2bf(bf2f((bf16_t)qf[rb][ks][jj]) * sc); }
            dpre_flush(St, op + 1 * 4096, lane);
        }
        float xu[64];
        {
#pragma unroll
            for (int it = 0; it < 8; ++it) { const int row = (lane >> 3) + 8 * it, chunk = lane & 7; *(LAS u32x4*)(St + row * DST + chunk * 8) = *(const u32x4*)(vdb + row * 512 + chunk * 8); }
            asm volatile("s_waitcnt lgkmcnt(0)" ::: "memory");
            const int beta_i = __float_as_int(beta);
#pragma unroll
            for (int i = 0; i < 64; ++i) xu[i] = __int_as_float(__builtin_amdgcn_readlane(beta_i, i)) * bf2f(St[i * DST + lane]);
            asm volatile("s_waitcnt lgkmcnt(0)" ::: "memory");
        }
        {
            const float gcj0 = __shfl(gc, r), gcj1 = __shfl(gc, 32 + r);
            const int p0 = sig_inv(r), p1 = sig_inv(32 + r);
            { f32x16 t00, t10, t11;
#pragma unroll
              for (int e = 0; e < 16; ++e) { t00[e] = 0.f; t10[e] = 0.f; t11[e] = 0.f; }
#pragma unroll
              for (int ks = 0; ks < 4; ++ks) {
                  t00 = __builtin_amdgcn_mfma_f32_32x32x16_bf16(qf[0][ks], kf[0][ks], t00, 0, 0, 0);
                  t10 = __builtin_amdgcn_mfma_f32_32x32x16_bf16(qf[1][ks], kf[0][ks], t10, 0, 0, 0);
                  t11 = __builtin_amdgcn_mfma_f32_32x32x16_bf16(qf[1][ks], kf[1][ks], t11, 0, 0, 0); }
#pragma unroll
              for (int e = 0; e < 16; ++e) { const int il = (e & 3) + 8 * (e >> 2) + 4 * hh;
                  { const int i = il, j = r; St[i * DST + p0] = f2bf(j <= i ? t00[e] * __expf(fminf(gcs[i] - gcj0, 0.f)) : 0.f); St[i * DST + p1] = 0; }
                  { const int i = 32 + il; St[i * DST + p0] = f2bf(t10[e] * __expf(fminf(gcs[i] - gcj0, 0.f))); }
                  { const int i = 32 + il, j = 32 + r; St[i * DST + p1] = f2bf(j <= i ? t11[e] * __expf(fminf(gcs[i] - gcj1, 0.f)) : 0.f); } }
              dpre_flush(St, op + 2 * 4096, lane); }
            { f32x16 t00, t10, t11;
#pragma unroll
              for (int e = 0; e < 16; ++e) { t00[e] = 0.f; t10[e] = 0.f; t11[e] = 0.f; }
#pragma unroll
              for (int ks = 0; ks < 4; ++ks) {
                  t00 = __builtin_amdgcn_mfma_f32_32x32x16_bf16(kf[0][ks], kf[0][ks], t00, 0, 0, 0);
                  t10 = __builtin_amdgcn_mfma_f32_32x32x16_bf16(kf[1][ks], kf[0][ks], t10, 0, 0, 0);
                  t11 = __builtin_amdgcn_mfma_f32_32x32x16_bf16(kf[1][ks], kf[1][ks], t11, 0, 0, 0); }
#pragma unroll
              for (int e = 0; e < 16; ++e) { const int il = (e & 3) + 8 * (e >> 2) + 4 * hh;
                  { const int i = il, j = r; Am[i * 64 + j] = j < i ? bts[i] * t00[e] * __expf(fminf(gcs[i] - gcj0, 0.f)) : 0.f; }
                  { const int i = 32 + il, j = r; Am[i * 64 + j] = bts[i] * t10[e] * __expf(fminf(gcs[i] - gcj0, 0.f)); }
                  { const int i = 32 + il, j = 32 + r; Am[i * 64 + j] = j < i ? bts[i] * t11[e] * __expf(fminf(gcs[i] - gcj1, 0.f)) : 0.f; } } }
        }
        asm volatile("s_waitcnt lgkmcnt(0)" ::: "memory");
        {
            int c; { int t_ = threadIdx.x; asm volatile("" : "+v"(t_)); c = t_ & 63; } const int pc = sig_inv(c);
            const int beta_i = __float_as_int(beta), egc_i = __float_as_int(egc);
#pragma unroll
            for (int i = 1; i < 64; ++i) { float au = xu[i];
#pragma unroll
                for (int j4 = 0; j4 < i; j4 += 4) { const f32x4 a = *(const LAS f32x4*)(Am + i * 64 + j4);
#pragma unroll
                    for (int e = 0; e < 4; ++e) if (j4 + e < i) au -= a[e] * xu[j4 + e]; }
                xu[i] = au; }
#pragma unroll
            for (int k = 0; k < 16; ++k)
                *(f32x4*)(up + ((((c >> 4) * 4 + (k >> 2)) * 64 + (k & 3) * 16 + (c & 15)) << 2)) = (f32x4){xu[4 * k], xu[4 * k + 1], xu[4 * k + 2], xu[4 * k + 3]};
            asm volatile("" ::: "memory");
            { float w[64];
#pragma unroll
              for (int i = 0; i < 64; ++i) w[i] = __int_as_float(__builtin_amdgcn_readlane(beta_i, i)) * __int_as_float(__builtin_amdgcn_readlane(egc_i, i)) * bf2f((kdb + i * 512)[c]);
#pragma unroll
              for (int i = 1; i < 64; ++i) { float aw = w[i];
#pragma unroll
                  for (int j4 = 0; j4 < i; j4 += 4) { const f32x4 a = *(const LAS f32x4*)(Am + i * 64 + j4);
#pragma unroll
                      for (int e = 0; e < 4; ++e) if (j4 + e < i) aw -= a[e] * w[j4 + e]; }
                  w[i] = aw; }
              asm volatile("s_waitcnt lgkmcnt(0)" ::: "memory");
#pragma unroll
              for (int i = 0; i < 64; ++i) St[i * DST + pc] = f2bf(-w[i]); }
            dpre_flush(St, op, lane);
        }
    }
}
__device__ __forceinline__ void st_rows2(bf16_t* row0, bf16_t* row1, unsigned pos, float a, float b, bool even) {
    const float x = even ? b : a;
    const float y = __int_as_float(__builtin_amdgcn_mov_dpp(__float_as_int(x), 0xB1, 0xF, 0xF, true));
    const unsigned w = even ? pg8::cvt_pk_bf16(a, y) : pg8::cvt_pk_bf16(y, b);
    bf16_t* dst = even ? row0 + pos : row1 + (pos - 1u);
    *(unsigned*)dst = w;
}
constexpr int BSS = 144, BS_NBAR = 65;
struct BsSet { bf16x8_t w0, w1, g0, g1, k0, k1, t0, t1; f32x4 u; };
__device__ __forceinline__ void bs_load(BsSet& c, const bf16_t* op, const float* up) {
    c.w0 = *(const bf16x8_t*)(op); c.w1 = *(const bf16x8_t*)(op + 512); c.g0 = *(const bf16x8_t*)(op + 4096); c.g1 = *(const bf16x8_t*)(op + 4096 + 512);
    c.k0 = *(const bf16x8_t*)(op + 8192); c.k1 = *(const bf16x8_t*)(op + 8192 + 512); c.t0 = *(const bf16x8_t*)(op + 12288); c.t1 = *(const bf16x8_t*)(op + 12288 + 512);
    c.u = *(const f32x4*)up;
}
__device__ __forceinline__ u32x2 pack_h(const f32x4& v) { u32x2 w; w.x = pg8::cvt_pk_bf16(v[0], v[1]); w.y = pg8::cvt_pk_bf16(v[2], v[3]); return w; }
__device__ __forceinline__ void bs_step(BsSet& c, f32x4& S, float eg, LAS unsigned char* SB, LAS unsigned char* VB, int rd, int wr, bool hik, bf16_t* yo, unsigned n, bool even, const bf16_t* opn, const float* upn) {
    TP_DECL; TP_ON(30);
    const bf16x8_t sb0 = *(const LAS bf16x8_t*)(SB + rd), sb1 = *(const LAS bf16x8_t*)(SB + rd + 64);
    f32x4 vn = __builtin_amdgcn_mfma_f32_16x16x32_bf16(c.w0, sb0, c.u, 0, 0, 0); vn = __builtin_amdgcn_mfma_f32_16x16x32_bf16(c.w1, sb1, vn, 0, 0, 0);
    f32x4 o = __builtin_amdgcn_mfma_f32_16x16x32_bf16(c.g0, sb0, (f32x4){0.f, 0.f, 0.f, 0.f}, 0, 0, 0); o = __builtin_amdgcn_mfma_f32_16x16x32_bf16(c.g1, sb1, o, 0, 0, 0);
    *(LAS u32x2*)(VB + wr) = pack_h(vn);
    TP_ON(36); __syncthreads();
    TP_OFFW(36, 0); TP_OFFW(30, 0); TP_ON(31);
    const bf16x8_t vb0 = *(const LAS bf16x8_t*)(VB + rd), vb1 = *(const LAS bf16x8_t*)(VB + rd + 64);
    o = __builtin_amdgcn_mfma_f32_16x16x32_bf16(c.k0, vb0, o, 0, 0, 0);
    if (hik) o = __builtin_amdgcn_mfma_f32_16x16x32_bf16(c.k1, vb1, o, 0, 0, 0);
    S = S * eg;
    S = __builtin_amdgcn_mfma_f32_16x16x32_bf16(c.t0, vb0, S, 0, 0, 0); S = __builtin_amdgcn_mfma_f32_16x16x32_bf16(c.t1, vb1, S, 0, 0, 0);
    *(LAS u32x2*)(SB + wr) = pack_h(S);
    TP_OFFW(31, 0); TP_ON(33);
    bs_load(c, opn, upn);
    TP_OFFW(33, 0); TP_ON(34);
#pragma unroll
    for (int e = 0; e < 4; e += 2) st_rows2(yo + (size_t)e * 1536, yo + (size_t)(e + 1) * 1536, n, o[e], o[e + 1], even);
    TP_OFFW(34, 0); TP_ON(35);
    __syncthreads();
    TP_OFFW(35, 0);
}
__device__ __forceinline__ void slice_scan(KP p, int l, int unit, LAS unsigned char* lds, int lane, int mt) {
    asm volatile("" : "+v"(lane));
    const int n = lane & 15, q = lane >> 4, bh = unit >> 2, slice = unit & 3, b = bh >> 3, h = bh & 7;
    LAS unsigned char* SB = lds; LAS unsigned char* VB = lds + 16 * BSS;
    const int pos0 = ((mt & 2) << 4) + 8 * q + ((mt & 1) << 2);
    const int wr = n * BSS + pos0 * 2, rd = n * BSS + 16 * q;
    const bf16_t* op0 = p->DOP + (size_t)bh * 32 * 4 * 4096 + mt * 1024 + lane * 8;
    const float* up0 = p->DU + (size_t)bh * 32 * 4096 + ((slice * 4 + mt) * 64 + lane) * 4;
    const float egv = p->DG[bh * 32 + (lane & 31)];
    bf16_t* yo0 = p->yc + ((size_t)b * SEQ + 16 * mt + 4 * q) * 1536 + h * 64 + 16 * slice;
    __builtin_amdgcn_s_waitcnt(0);
    BsSet st[4];
#pragma unroll
    for (int i = 0; i < 4; ++i) bs_load(st[i], op0 + (size_t)i * 16384, up0 + (size_t)i * 4096);
    f32x4 S = (f32x4){0.f, 0.f, 0.f, 0.f};
    { unsigned z = 0u; asm volatile("" : "+v"(z)); *(LAS u32x2*)(SB + wr) = (u32x2){z, z}; }
    __syncthreads();
    const bool hik = mt >= 2, even = (lane & 1) == 0;
#pragma unroll 1
    for (int ch = 0; ch < 32; ch += 4) {
#pragma unroll
        for (int i = 0; i < 4; ++i) { const int cn = ch + i + 4 < 32 ? ch + i + 4 : 31;
            const float eg = __int_as_float(__builtin_amdgcn_readlane(__float_as_int(egv), ch + i));
            bs_step(st[i], S, eg, SB, VB, rd, wr, hik, yo0 + (size_t)(ch + i) * 64 * 1536, (unsigned)n, even, op0 + (size_t)cn * 16384, up0 + (size_t)cn * 4096); }
    }
    float* so = p->out + O_PDELTA + (((size_t)l * 8 + b) * 8 + h) * 4096 + (16 * mt + 4 * q) * 64 + 16 * slice + n;
#pragma unroll
    for (int e = 0; e < 4; ++e) so[e * 64] = S[e];
}
__device__ __forceinline__ void ph_delta_fin(KP p, int l) {
    int tid_o = threadIdx.x; asm volatile("" : "+v"(tid_o)); int lane = tid_o & 63, wave = tid_o >> 6;
    const int h = lane >> 3, d0 = (lane & 7) * 8;
    for (int t = blockIdx.x * 8 + wave; t < TP; t += gridDim.x * 8) {
        bf16_t* yp = p->yc + (size_t)t * 1536 + h * 64 + d0; const u32x4 raw = *(const u32x4*)yp; const u32x4 gz = *(const u32x4*)(p->H + (size_t)t * IN_WP + C_ZDN + h * 64 + d0);
        float v[8]; v[0] = __uint_as_float(raw.x << 16); v[1] = __uint_as_float(raw.x & 0xffff0000u); v[2] = __uint_as_float(raw.y << 16); v[3] = __uint_as_float(raw.y & 0xffff0000u);
        v[4] = __uint_as_float(raw.z << 16); v[5] = __uint_as_float(raw.z & 0xffff0000u); v[6] = __uint_as_float(raw.w << 16); v[7] = __uint_as_float(raw.w & 0xffff0000u);
        float z[8]; z[0] = __uint_as_float(gz.x << 16); z[1] = __uint_as_float(gz.x & 0xffff0000u); z[2] = __uint_as_float(gz.y << 16); z[3] = __uint_as_float(gz.y & 0xffff0000u);
        z[4] = __uint_as_float(gz.z << 16); z[5] = __uint_as_float(gz.z & 0xffff0000u); z[6] = __uint_as_float(gz.w << 16); z[7] = __uint_as_float(gz.w & 0xffff0000u);
        float ss = 0.f;
#pragma unroll
        for (int e = 0; e < 8; ++e) ss += v[e] * v[e];
        ss += __shfl_xor(ss, 1); ss += __shfl_xor(ss, 2); ss += __shfl_xor(ss, 4);
        const float rs = rsqrtf(ss * (1.0f / 64.0f) + EPS);
#pragma unroll
        for (int e = 0; e < 8; ++e) v[e] = v[e] * rs * p->dn_norm_g[l * 64 + d0 + e] * z[e];
        u32x4 w; w.x = pg8::cvt_pk_bf16(v[0], v[1]); w.y = pg8::cvt_pk_bf16(v[2], v[3]); w.z = pg8::cvt_pk_bf16(v[4], v[5]); w.w = pg8::cvt_pk_bf16(v[6], v[7]);
        *(u32x4*)yp = w;
    }
}

__device__ __forceinline__ void ph_att_waves(KP p, int l, LAS unsigned char* lds) {
    int tid_o = threadIdx.x; asm volatile("" : "+v"(tid_o)); int lane = tid_o & 63, wave = tid_o >> 6;
    wave = __builtin_amdgcn_readfirstlane(wave);
    const int G = gridDim.x;
    TP_DECL; TP_ON(20); TP_ON(22);
    for (int ub = blockIdx.x; ub < 256; ub += G) { const int u = ((ub & 7) << 5) | (ub >> 3);
        if (wave < 4) slice_scan(p, l, u, lds, lane, wave);
#if defined(TPROBE) && TPROBE == 22
        else if (wave == 4) { for (int k = 0; k < BS_NBAR; ++k) __builtin_amdgcn_s_barrier(); wu_delta<false>(p, l, u >> 3, u & 7, lane, lds + 32768); }
#else
        else if (wave == 4) wu_delta<true>(p, l, u >> 3, u & 7, lane, lds + 32768);
#endif
        else { for (int k = 0; k < BS_NBAR; ++k) __builtin_amdgcn_s_barrier(); }
    }
    if (wave == 0) { TP_OFFW(20, 0); TP_OFFW(22, 0); }
}
__device__ __forceinline__ void ph_fin(KP p, int l, LAS unsigned char* lds) {
    int tid_o = threadIdx.x; asm volatile("" : "+v"(tid_o)); int lane = tid_o & 63, wave = tid_o >> 6;
    LAS float* ol = (LAS float*)(lds + wave * 1024);
    const float* w_uv = p->w_uv + (size_t)l * 256 * 512;
    const int cq = lane >> 4, d4 = lane & 15;
    for (int u = blockIdx.x * 8 + wave; u < TS * 8; u += gridDim.x * 8) {
        const int ts = u >> 3, h = u & 7, s = ts >> 3, r = (ts & 7) * 8 + h;
        const float* pb = p->part + ((size_t)s * SA_CH * 64 + r) * 258;
        float mc = -1e30f, lc = 0.f;
        if (lane < SA_CH) { mc = pb[(size_t)lane * 64 * 258 + 256]; lc = pb[(size_t)lane * 64 * 258 + 257]; }
        float M = mc;
#pragma unroll
        for (int o = 1; o < 8; o <<= 1) M = fmaxf(M, __shfl_xor(M, o));
        const float wc = lane < SA_CH ? __expf(mc - M) : 0.f; float L = lc * wc;
#pragma unroll
        for (int o = 1; o < 8; o <<= 1) L += __shfl_xor(L, o);
        const float iL = 1.0f / __int_as_float(__builtin_amdgcn_readlane(__float_as_int(L), 0));
        f32x4 acc = (f32x4){0.f, 0.f, 0.f, 0.f};
#pragma unroll
        for (int ch = 0; ch < SA_CH; ++ch) { const float w = __int_as_float(__builtin_amdgcn_readlane(__float_as_int(wc), ch)); const float* pp = pb + (size_t)ch * 64 * 258 + 4 * lane;
            const f32x2 a0 = *(const f32x2*)pp, a1 = *(const f32x2*)(pp + 2); acc[0] += w * a0[0]; acc[1] += w * a0[1]; acc[2] += w * a1[0]; acc[3] += w * a1[1]; }
        *(LAS f32x4*)(ol + 4 * lane) = acc * iL;
        asm volatile("s_waitcnt lgkmcnt(0)" ::: "memory");
        f32x4 o = (f32x4){0.f, 0.f, 0.f, 0.f}; const float* wp = w_uv + (size_t)(cq * 64) * 512 + h * 64 + 4 * d4;
#pragma unroll 16
        for (int c = 0; c < 64; ++c) { const f32x4 wv = *(const f32x4*)(wp + (size_t)c * 512); const float x = ol[cq * 64 + c]; o += wv * x; }
#pragma unroll
        for (int e = 0; e < 4; ++e) { o[e] += __shfl_xor(o[e], 16); o[e] += __shfl_xor(o[e], 32); }
        if (cq == 0) { const int t = TP + ts; const u32x2 gz = *(const u32x2*)(p->H + (size_t)t * IN_WP + C_ZMLA + h * 64 + 4 * d4);
            u32x2 w; w.x = pg8::cvt_pk_bf16(o[0] * __uint_as_float(gz.x << 16), o[1] * __uint_as_float(gz.x & 0xffff0000u)); w.y = pg8::cvt_pk_bf16(o[2] * __uint_as_float(gz.y << 16), o[3] * __uint_as_float(gz.y & 0xffff0000u));
            *(u32x2*)(p->yb + (size_t)t * 1536 + h * 64 + 4 * d4) = w; }
        asm volatile("s_waitcnt lgkmcnt(0)" ::: "memory");
    }
}

constexpr int SA_QS = 592, SA_KS = 592, SA_PS = 272;
constexpr int SA_OFF_Q = 0, SA_OFF_K = 64 * SA_QS, SA_OFF_P = SA_OFF_K + 128 * SA_KS, SA_OFF_M = SA_OFF_P + 64 * SA_PS, SA_OFF_L = SA_OFF_M + 1024, SA_LDS = SA_OFF_L + 1024;
typedef short s16x4 __attribute__((ext_vector_type(4)));
__device__ __forceinline__ void sa_unit(KP p, int l, int s, int ch, LAS unsigned char* lds, int tid) {
    const int lane = tid & 63, wave = __builtin_amdgcn_readfirstlane(tid >> 6), r = lane & 31, hh = lane >> 5;
    const int qb = wave & 1, kb = wave >> 1, cg = wave >> 1;
    LAS unsigned char* Qs = lds + SA_OFF_Q; LAS unsigned char* Kt = lds + SA_OFF_K; LAS unsigned char* Pt = lds + SA_OFF_P;
    LAS float* mloc = (LAS float*)(lds + SA_OFF_M); LAS float* lred = (LAS float*)(lds + SA_OFF_L);
    TP_DECL; TP_ON(10); TP_ON(11);
    __syncthreads();
    { const bf16_t* wb = p->WukB + (size_t)l * 256 * 512 + (size_t)r * 512 + wave * 64 + 8 * hh; const bf16_t* Qg = p->Q + (size_t)(TP + s * 8) * 768;
      bf16x8_t qv[4];
#pragma unroll
      for (int ks = 0; ks < 4; ++ks) { u32x4 z = (u32x4){0u, 0u, 0u, 0u}; if (r < 8) z = *(const u32x4*)(Qg + r * 768 + wave * 96 + ks * 16 + 8 * hh); union { u32x4 u; bf16x8_t v; } x; x.u = z; qv[ks] = x.v; }
#pragma unroll
      for (int cb = 0; cb < 8; ++cb) { f32x16 acc;
#pragma unroll
          for (int e = 0; e < 16; ++e) acc[e] = 0.f;
#pragma unroll
          for (int ks = 0; ks < 4; ++ks) acc = __builtin_amdgcn_mfma_f32_32x32x16_bf16(*(const bf16x8_t*)(wb + (size_t)(32 * cb) * 512 + ks * 16), qv[ks], acc, 0, 0, 0);
          if (r < 8) {
#pragma unroll
              for (int g4 = 0; g4 < 4; ++g4) { u32x2 w; w.x = pg8::cvt_pk_bf16(acc[4 * g4], acc[4 * g4 + 1]); w.y = pg8::cvt_pk_bf16(acc[4 * g4 + 2], acc[4 * g4 + 3]);
                  *(LAS u32x2*)(Qs + (r * 8 + wave) * SA_QS + (32 * cb + 8 * g4 + 4 * hh) * 2) = w; } } }
      for (int e = tid; e < 64 * 32; e += NTHR) { const int rr = e >> 5, j = e & 31; *(LAS bf16_t*)(Qs + rr * SA_QS + (256 + j) * 2) = Qg[(rr >> 3) * 768 + (rr & 7) * 96 + 64 + j]; } }
    TP_OFF(11);
    const int* pt = p->page_table + s * N_PAGES + ch * 16;
    const float* ckv_base = p->cache_kv + (size_t)l * N_POOL * PAGE * 256; const float* ckr_base = p->cache_kr + (size_t)l * N_POOL * PAGE * 32;
    f32x4 rk[16], rr2[2];
    { const int page = pt[0]; const float* kvp = ckv_base + (size_t)page * PAGE * 256; const float* krp = ckr_base + (size_t)page * PAGE * 32;
#pragma unroll
      for (int i = 0; i < 16; ++i) rk[i] = __builtin_nontemporal_load((const f32x4*)(kvp + (size_t)(tid + 512 * i) * 4));
#pragma unroll
      for (int i = 0; i < 2; ++i) rr2[i] = __builtin_nontemporal_load((const f32x4*)(krp + (size_t)(tid + 512 * i) * 4)); }
    f32x16 o0, o1;
#pragma unroll
    for (int e = 0; e < 16; ++e) { o0[e] = 0.f; o1[e] = 0.f; }
    float m = -1e30f, lw = 0.f;
    const int li = lane & 15, g1 = (lane >> 4) & 1;
    const int trOff = (8 * hh + (li >> 2)) * SA_KS + (16 * g1 + 4 * (li & 3)) * 2;
    const int ntile = ch == 7 ? 17 : 16;
    for (int t = 0; t < ntile; ++t) {
        TP_ON(12); TP_ON(16);
        __syncthreads();
        TP_OFF(16);
        if (t < 16) {
#pragma unroll
            for (int i = 0; i < 16; ++i) { const int ci = tid + 512 * i, key = ci >> 6, c4 = ci & 63; u32x2 w; w.x = pg8::cvt_pk_bf16(rk[i][0], rk[i][1]); w.y = pg8::cvt_pk_bf16(rk[i][2], rk[i][3]);
                *(LAS u32x2*)(Kt + key * SA_KS + c4 * 8) = w; }
#pragma unroll
            for (int i = 0; i < 2; ++i) { const int ci = tid + 512 * i, key = ci >> 3, c4 = ci & 7; u32x2 w; w.x = pg8::cvt_pk_bf16(rr2[i][0], rr2[i][1]); w.y = pg8::cvt_pk_bf16(rr2[i][2], rr2[i][3]);
                *(LAS u32x2*)(Kt + key * SA_KS + 512 + c4 * 8) = w; }
        } else {
            for (int e = tid; e < 128 * 36; e += NTHR) { const int key = e / 36, c16 = e - key * 36; u32x4 v = (u32x4){0u, 0u, 0u, 0u};
                if (key < 8) v = c16 < 32 ? *(const u32x4*)(p->ckv + ((size_t)TP + s * 8 + key) * 256 + c16 * 8) : *(const u32x4*)(p->Kr + ((size_t)TP + s * 8 + key) * 32 + (c16 - 32) * 8);
                *(LAS u32x4*)(Kt + key * SA_KS + c16 * 16) = v; }
        }
        TP_ON(17); __syncthreads(); TP_OFF(17);
        TP_OFF(12); TP_ON(13);
        if (t + 1 < 16) { const int page = pt[t + 1]; const float* kvp = ckv_base + (size_t)page * PAGE * 256; const float* krp = ckr_base + (size_t)page * PAGE * 32;
#pragma unroll
            for (int i = 0; i < 16; ++i) rk[i] = __builtin_nontemporal_load((const f32x4*)(kvp + (size_t)(tid + 512 * i) * 4));
#pragma unroll
            for (int i = 0; i < 2; ++i) rr2[i] = __builtin_nontemporal_load((const f32x4*)(krp + (size_t)(tid + 512 * i) * 4)); }
        f32x16 sa;
#pragma unroll
        for (int e = 0; e < 16; ++e) sa[e] = 0.f;
        { const LAS unsigned char* ka = Kt + (32 * kb + r) * SA_KS + 16 * hh; const LAS unsigned char* qa = Qs + (32 * qb + r) * SA_QS + 16 * hh;
#pragma unroll
          for (int ks = 0; ks < 18; ++ks) sa = __builtin_amdgcn_mfma_f32_32x32x16_bf16(*(const LAS bf16x8_t*)(ka + ks * 32), *(const LAS bf16x8_t*)(qa + ks * 32), sa, 0, 0, 0); }
        if (t == 16) { const int itok = (32 * qb + r) >> 3;
#pragma unroll
            for (int e = 0; e < 16; ++e) { const int key = 32 * kb + (e & 3) + 8 * (e >> 2) + 4 * hh; if (key > itok) sa[e] = -1e30f; } }
        float tm = sa[0];
#pragma unroll
        for (int e = 1; e < 16; ++e) tm = fmaxf(tm, sa[e]);
        tm = fmaxf(tm, __shfl_xor(tm, 32));
        if (hh == 0) mloc[kb * 64 + 32 * qb + r] = tm;
        __syncthreads();
        TP_OFF(13); TP_ON(14);
        { const int q = 32 * qb + r; const float tmx = fmaxf(fmaxf(mloc[q], mloc[64 + q]), fmaxf(mloc[128 + q], mloc[192 + q]));
          const float mn = fmaxf(m, tmx), al = __builtin_amdgcn_exp2f((m - mn) * ATT_C), mc = mn * ATT_C; m = mn;
          float ps = 0.f;
#pragma unroll
          for (int e = 0; e < 16; ++e) { sa[e] = __builtin_amdgcn_exp2f(sa[e] * ATT_C - mc); ps += sa[e]; }
          lw = lw * al + ps;
#pragma unroll
          for (int g4 = 0; g4 < 4; ++g4) { u32x2 w; w.x = pg8::cvt_pk_bf16(sa[4 * g4], sa[4 * g4 + 1]); w.y = pg8::cvt_pk_bf16(sa[4 * g4 + 2], sa[4 * g4 + 3]);
              *(LAS u32x2*)(Pt + q * SA_PS + (32 * kb + 8 * g4 + 4 * hh) * 2) = w; }
#pragma unroll
          for (int e = 0; e < 16; ++e) { o0[e] *= al; o1[e] *= al; } }
        __syncthreads();
        TP_OFF(14); TP_ON(15);
        { const LAS unsigned char* pa = Pt + (32 * qb + r) * SA_PS + 16 * hh; const LAS unsigned char* va = Kt + trOff + (64 * cg) * 2;
#pragma unroll
          for (int ks = 0; ks < 8; ++ks) { const bf16x8_t pb = *(const LAS bf16x8_t*)(pa + ks * 32);
              union { struct { s16x4 lo, hi; } h; bf16x8_t v; } a0, a1;
              a0.h.lo = __builtin_amdgcn_ds_read_tr16_b64_v4i16((LAS s16x4*)(va + ks * 16 * SA_KS)); a0.h.hi = __builtin_amdgcn_ds_read_tr16_b64_v4i16((LAS s16x4*)(va + ks * 16 * SA_KS + 4 * SA_KS));
              a1.h.lo = __builtin_amdgcn_ds_read_tr16_b64_v4i16((LAS s16x4*)(va + ks * 16 * SA_KS + 64)); a1.h.hi = __builtin_amdgcn_ds_read_tr16_b64_v4i16((LAS s16x4*)(va + ks * 16 * SA_KS + 4 * SA_KS + 64));
              o0 = __builtin_amdgcn_mfma_f32_32x32x16_bf16(a0.v, pb, o0, 0, 0, 0);
              o1 = __builtin_amdgcn_mfma_f32_32x32x16_bf16(a1.v, pb, o1, 0, 0, 0); } }
        TP_OFF(15);
    }
    lw += __shfl_xor(lw, 32);
    if (hh == 0) lred[kb * 64 + 32 * qb + r] = lw;
    __syncthreads();
    { const int q = 32 * qb + r; float* pp = p->part + (((size_t)s * SA_CH + ch) * 64 + q) * 258;
#pragma unroll
      for (int cb2 = 0; cb2 < 2; ++cb2)
#pragma unroll
          for (int g4 = 0; g4 < 4; ++g4) { const int c = 32 * (2 * cg + cb2) + 8 * g4 + 4 * hh; f32x4 v;
#pragma unroll
              for (int e = 0; e < 4; ++e) v[e] = cb2 == 0 ? o0[4 * g4 + e] : o1[4 * g4 + e];
              *(f32x2*)(pp + c) = (f32x2){v[0], v[1]}; *(f32x2*)(pp + c + 2) = (f32x2){v[2], v[3]}; }
      if (cg == 0 && hh == 0) { pp[256] = m * MLA_SCALE; pp[257] = lred[q] + lred[64 + q] + lred[128 + q] + lred[192 + q]; } }
    TP_OFF(10);
}
__device__ __forceinline__ void ph_attn_s2(KP p, int l, LAS unsigned char* lds) {
    int tid = threadIdx.x; asm volatile("" : "+v"(tid));
    for (int u = blockIdx.x; u < DEC_BATCH * 8; u += gridDim.x) sa_unit(p, l, u >> 3, u & 7, lds, tid);
    __syncthreads();
}

constexpr int ATT_KS = 208, ATT_VS = 144, ATT_KB = 64 * ATT_KS, ATT_VB = 64 * ATT_VS, ATT_STAGE = ATT_KB + ATT_VB;
__device__ __forceinline__ void attn_unit(KP p, int b, int h, int qblk, LAS unsigned char* lds, int tid, int wave, int lane) {
    const int r = lane & 31, hh = lane >> 5;
    const int q0 = qblk * 256 + wave * 32;
    __builtin_amdgcn_s_waitcnt(0);
    const size_t trow0 = (size_t)b * SEQ;
    bf16x8_t qf[6];
    { const bf16_t* qp = p->Q + (trow0 + q0 + r) * 768 + h * 96 + 8 * hh;
#pragma unroll
      for (int ks = 0; ks < 6; ++ks) qf[ks] = *(const bf16x8_t*)(qp + 16 * ks); }
    f32x16 o0, o1;
#pragma unroll
    for (int e = 0; e < 16; ++e) { o0[e] = 0.f; o1[e] = 0.f; }
    float m = -1e30f, lsum = 0.f;
    const int ntile = qblk * 4 + 4;
    const int cA = tid, keyA = cA / 12, partA = cA - keyA * 12; const int cB = 512 + (tid & 255), keyB = cB / 12, partB = cB - keyB * 12; const bool hasB = tid < 256;
    const bf16_t* gA = partA < 8 ? p->Kn + (trow0 + keyA) * 512 + h * 64 + partA * 8 : p->Kr + (trow0 + keyA) * 32 + (partA - 8) * 8; const int stepA = partA < 8 ? 64 * 512 : 64 * 32;
    const bf16_t* gB = !hasB ? gA : partB < 8 ? p->Kn + (trow0 + keyB) * 512 + h * 64 + partB * 8 : p->Kr + (trow0 + keyB) * 32 + (partB - 8) * 8; const int stepB = !hasB ? stepA : partB < 8 ? 64 * 512 : 64 * 32;
    const bf16_t* gV = p->Vt + (size_t)(h * 64 + (tid >> 3)) * TP + trow0 + (tid & 7) * 8;
    const int lA = keyA * ATT_KS + partA * 16, lB = hasB ? keyB * ATT_KS + partB * 16 : (tid & 63) * ATT_KS + 192, lV = ATT_KB + (tid >> 3) * ATT_VS + (tid & 7) * 16;
    const int pr_ = (r & 0x13) | ((r & 4) << 1) | ((r & 8) >> 1);
    const int kOff = pr_ * ATT_KS + 16 * hh, vOff = ATT_KB + r * ATT_VS + 16 * hh;
#define ATT_COMPUTE() do { \
        if (kt * 64 <= q0 + 31) { \
            f32x16 s0, s1; TP_ON(2); \
_Pragma("unroll") \
            for (int e = 0; e < 16; ++e) { s0[e] = 0.f; s1[e] = 0.f; } \
_Pragma("unroll") \
            for (int ks = 0; ks < 6; ++ks) { \
                const bf16x8_t a0 = *(const LAS bf16x8_t*)(st + kOff + ks * 32), a1 = *(const LAS bf16x8_t*)(st + kOff + 32 * ATT_KS + ks * 32); \
                s0 = __builtin_amdgcn_mfma_f32_32x32x16_bf16(a0, qf[ks], s0, 0, 0, 0); \
                s1 = __builtin_amdgcn_mfma_f32_32x32x16_bf16(a1, qf[ks], s1, 0, 0, 0); \
            } \
            TP_OFF(2); TP_ON(3); if (kt * 64 + 63 > q0) { \
                const int qrel = q0 + r - kt * 64; \
_Pragma("unroll") \
                for (int e = 0; e < 16; ++e) { const int kl = (e & 3) + 4 * ((e >> 2) & 1) + 8 * hh + 16 * ((e >> 3) & 1); \
                    if (kl > qrel) s0[e] = -1e30f; if (kl + 32 > qrel) s1[e] = -1e30f; } \
            } \
            float tm = fmaxf(s0[0], s1[0]); \
_Pragma("unroll") \
            for (int e = 1; e < 16; ++e) tm = fmaxf(tm, fmaxf(s0[e], s1[e])); \
            tm = fmaxf(tm, __shfl_xor(tm, 32)); \
            const float mn = fmaxf(m, tm), al = __builtin_amdgcn_exp2f((m - mn) * ATT_C), mc = mn * ATT_C; m = mn; \
            float ps = 0.f; \
_Pragma("unroll") \
            for (int e = 0; e < 16; ++e) { s0[e] = __builtin_amdgcn_exp2f(s0[e] * ATT_C - mc); s1[e] = __builtin_amdgcn_exp2f(s1[e] * ATT_C - mc); ps += s0[e] + s1[e]; } \
            lsum = lsum * al + ps; \
_Pragma("unroll") \
            for (int e = 0; e < 16; ++e) { o0[e] *= al; o1[e] *= al; } \
            TP_OFF(3); TP_ON(4); \
_Pragma("unroll") \
            for (int kb = 0; kb < 2; ++kb) \
_Pragma("unroll") \
                for (int sp = 0; sp < 2; ++sp) { \
                    union { u32x4 u; bf16x8_t v; } pb; \
                    if (kb == 0) { pb.u.x = pg8::cvt_pk_bf16(s0[8 * sp + 0], s0[8 * sp + 1]); pb.u.y = pg8::cvt_pk_bf16(s0[8 * sp + 2], s0[8 * sp + 3]); pb.u.z = pg8::cvt_pk_bf16(s0[8 * sp + 4], s0[8 * sp + 5]); pb.u.w = pg8::cvt_pk_bf16(s0[8 * sp + 6], s0[8 * sp + 7]); } \
                    else         { pb.u.x = pg8::cvt_pk_bf16(s1[8 * sp + 0], s1[8 * sp + 1]); pb.u.y = pg8::cvt_pk_bf16(s1[8 * sp + 2], s1[8 * sp + 3]); pb.u.z = pg8::cvt_pk_bf16(s1[8 * sp + 4], s1[8 * sp + 5]); pb.u.w = pg8::cvt_pk_bf16(s1[8 * sp + 6], s1[8 * sp + 7]); } \
                    const int ko = (32 * kb + 16 * sp) * 2; \
                    const bf16x8_t v0 = *(const LAS bf16x8_t*)(st + vOff + ko), v1 = *(const LAS bf16x8_t*)(st + vOff + 32 * ATT_VS + ko); \
                    o0 = __builtin_amdgcn_mfma_f32_32x32x16_bf16(v0, pb.v, o0, 0, 0, 0); \
                    o1 = __builtin_amdgcn_mfma_f32_32x32x16_bf16(v1, pb.v, o1, 0, 0, 0); \
                } \
            TP_OFF(4); \
        } \
    } while (0)
    u32x4 rA = *(const u32x4*)gA, rB = *(const u32x4*)gB, rV = *(const u32x4*)gV;
    gA += stepA; gB += stepB; gV += 64;
    __builtin_amdgcn_sched_barrier(0);
    u32x4 sA = *(const u32x4*)gA, sB = *(const u32x4*)gB, sV = *(const u32x4*)gV;
    __builtin_amdgcn_sched_barrier(0);
#define ATT_TILE(RA, RB, RV) do { \
        LAS unsigned char* st = lds + (kt & 1) * ATT_STAGE; TP_ON(1); \
        *(LAS u32x4*)(st + lA) = RA; *(LAS u32x4*)(st + lB) = RB; *(LAS u32x4*)(st + lV) = RV; \
        __syncthreads(); \
        { const int adv = kt + 2 < ntile ? 1 : 0; gA += adv * stepA; gB += adv * stepB; gV += adv * 64; RA = *(const u32x4*)gA; RB = *(const u32x4*)gB; RV = *(const u32x4*)gV; } \
        TP_OFF(1); ATT_COMPUTE(); } while (0)
    TP_DECL; TP_ON(5);
    for (int kt = 0; kt < ntile; kt += 2) { ATT_TILE(rA, rB, rV); ++kt; ATT_TILE(sA, sB, sV); --kt; }
    TP_OFF(5);
#undef ATT_TILE
#undef ATT_COMPUTE
    TP_COMMIT(lds);
    lsum += __shfl_xor(lsum, 32);
    const float il = 1.0f / lsum;
    const size_t t = trow0 + q0 + r;
    u32x2 gzv[2][4];
#pragma unroll
    for (int db = 0; db < 2; ++db)
#pragma unroll
        for (int g = 0; g < 4; ++g) gzv[db][g] = *(const u32x2*)(p->H + t * IN_WP + C_ZMLA + h * 64 + 32 * db + 8 * g + 4 * hh);
#pragma unroll
    for (int db = 0; db < 2; ++db)
#pragma unroll
        for (int g = 0; g < 4; ++g) { const int d0 = 32 * db + 8 * g + 4 * hh;
            const u32x2 gz = gzv[db][g];
            float v[4];
#pragma unroll
            for (int e = 0; e < 4; ++e) v[e] = (db == 0 ? o0[4 * g + e] : o1[4 * g + e]) * il;
            v[0] *= __uint_as_float(gz.x << 16); v[1] *= __uint_as_float(gz.x & 0xffff0000u); v[2] *= __uint_as_float(gz.y << 16); v[3] *= __uint_as_float(gz.y & 0xffff0000u);
            u32x2 w; w.x = pg8::cvt_pk_bf16(v[0], v[1]); w.y = pg8::cvt_pk_bf16(v[2], v[3]);
            *(u32x2*)(p->yb + t * 1536 + h * 64 + d0) = w; }
}
__device__ __forceinline__ void ph_attn_p(KP p, LAS unsigned char* lds) {
    int tid = threadIdx.x; asm volatile("" : "+v"(tid));
    const int lane = tid & 63, wave = __builtin_amdgcn_readfirstlane(tid >> 6);
    for (int pi = blockIdx.x; pi < 256; pi += gridDim.x) {
        const int xcd = pi & 7, k = pi >> 3, bh = xcd * 8 + (k >> 2), pr = k & 3;
#pragma unroll 1
        for (int uu = 0; uu < 2; ++uu) attn_unit(p, bh >> 3, bh & 7, uu == 0 ? 7 - pr : pr, lds, tid, wave, lane);
    }
    __syncthreads();
}
struct MEpiVt { static constexpr bool PERM = true, AFTER_DRAIN = false; static constexpr int SEG = 0; bf16_t* O; int ldc; int pad_;
    __device__ __forceinline__ void operator()(const f32x4 (&acc)[2][2][4][2], const pg8::Unit& u, int wr, int wc, int fr0, int fq0) const {
        int fr = fr0, fq = fq0; asm volatile("" : "+v"(fr), "+v"(fq));
        const int row0 = u.pm * 256 + wr * 64 + fr;
#pragma unroll
        for (int bj = 0; bj < 2; ++bj) { const int col0 = u.pn * 256 + bj * 128 + wc * 32 + 8 * fq;
#pragma unroll
            for (int ai = 0; ai < 2; ++ai)
#pragma unroll
                for (int m = 0; m < 4; ++m) { const int row = row0 + ai * 128 + m * 16; const f32x4 v0 = acc[ai][bj][m][0], v1 = acc[ai][bj][m][1];
                    u32x4 w; w.x = pg8::cvt_pk_bf16(v0[0], v0[1]); w.y = pg8::cvt_pk_bf16(v0[2], v0[3]); w.z = pg8::cvt_pk_bf16(v1[0], v1[1]); w.w = pg8::cvt_pk_bf16(v1[2], v1[3]);
                    *(u32x4*)(O + (size_t)row * ldc + col0) = w; } }
    } };


__global__ void __launch_bounds__(NTHR, 2) k_mega(Params p_unused) {
    const KP kp0 = (KP)__builtin_amdgcn_kernarg_segment_ptr();
#define PP() ({ KP q_ = kp0; asm volatile("" : "+s"(q_)); q_; })
    KP p = PP();
    extern __shared__ __attribute__((aligned(16))) unsigned char lds_raw[];
    LAS unsigned char* lds = (LAS unsigned char*)lds_raw;
    volatile LAS unsigned* misc = (volatile LAS unsigned*)(lds + LDS_MISC);
    for (int u = threadIdx.x; u < 64; u += NTHR) misc[u] = 0u;
    __syncthreads();
    const int lo = p->ph_lo, hi = p->ph_hi;
    XcdBarrier bar; bar.bar = p->bar + p->li * XCD_BAR_WORDS; bar.x = 0; bar.st = nullptr;
    if (hi - lo > 1) bar = xcd_barrier_post(p->bar + p->li * XCD_BAR_WORDS, misc + 8);
#define IN(k) (lo <= (k) && (k) < hi)
#define SEAM(k) do { if (IN(k) && IN((k) + 1)) xcd_barrier(bar); } while (0)

    if (IN(PH_PRO)) {
        LAS float* tile = (LAS float*)lds;
        for (int l = 0; l < 2; ++l) {
            KP p = PP();
            ph_tr(p->w_in + (size_t)l * 1024 * IN_W, p->WinT + (size_t)l * IN_WP * 1024, 1024, IN_W, IN_WP, tile, 0);
            ph_tr(p->w_uq + (size_t)l * 384 * 768, p->WuqT + (size_t)l * 768 * 384, 384, 768, 768, tile, 0);
            ph_tr(p->w_uk + (size_t)l * 256 * 512, p->WkvT + (size_t)l * 1024 * 256, 256, 512, 512, tile, 144);
            ph_tr(p->w_uv + (size_t)l * 256 * 512, p->WkvT + (size_t)l * 1024 * 256 + (size_t)512 * 256, 256, 512, 512, tile, 208);
            ph_tr(p->w_br0 + (size_t)l * 512 * 1024, p->WbrT + (size_t)l * 1024 * 1536 + 0 * 512, 512, 1024, 1024, tile, 0, 1536);
            ph_tr(p->w_br1 + (size_t)l * 512 * 1024, p->WbrT + (size_t)l * 1024 * 1536 + 1 * 512, 512, 1024, 1024, tile, 0, 1536);
            ph_tr(p->w_br2 + (size_t)l * 512 * 1024, p->WbrT + (size_t)l * 1024 * 1536 + 2 * 512, 512, 1024, 1024, tile, 0, 1536);
            ph_tr(p->w_out + (size_t)l * 1024 * 1024, p->WoutT + (size_t)l * 1024 * 1024, 1024, 1024, 1024, tile, 0);
            for (int g = 0; g < 4; ++g) ph_tr(p->pool_mix + ((size_t)l * 4 + g) * 128 * 128, p->PmixT + ((size_t)l * 4 + g) * 128 * 128, 128, 128, 128, tile, 64 + 8 * g);
        }
        { KP p = PP(); const float* src = p->w_uk; bf16_t* dst = p->WukB;
          for (int i = (blockIdx.x * NTHR + threadIdx.x) * 8; i < 2 * 256 * 512; i += gridDim.x * NTHR * 8) { const f32x4 a = *(const f32x4*)(src + i), b = *(const f32x4*)(src + i + 4);
              u32x4 w; w.x = pg8::cvt_pk_bf16(a[0], a[1]); w.y = pg8::cvt_pk_bf16(a[2], a[3]); w.z = pg8::cvt_pk_bf16(b[0], b[1]); w.w = pg8::cvt_pk_bf16(b[2], b[3]); *(u32x4*)(dst + i) = w; } }
#if defined(TPROBE) && TPROBE == 40
        { KP p = PP(); int t_ = threadIdx.x; asm volatile("" : "+v"(t_)); if (t_ == 0) __hip_atomic_store(p->bar + 12 * XCD_BAR_WORDS + blockIdx.x, xb_xcc_id() + 1u, __ATOMIC_RELAXED, __HIP_MEMORY_SCOPE_AGENT); }
#endif
        { KP p = PP(); ph_rope_tab(p->tab); ph_rmsnorm(p->x_prompt, p->x_sample, p->norm_g, p->xn, nullptr, nullptr); }
    }
    SEAM(PH_PRO);
    for (int l = 0; l < 2; ++l) {
        int G = gridDim.x, bid = blockIdx.x; asm volatile("" : "+s"(G), "+s"(bid));
        if (IN(PHID(l, PH_GIN))) { KP p = PP();
            pg8::Gemm g{p->xn, p->WinT + (size_t)l * IN_WP * 1024, TT, IN_WP, 1024, 0}; pg8::StaticOrder S; S.init(TT, IN_WP, G, bid);
            MEpiH E{p->H, p->BA}; pg8::gemm_phase<MEpiH, pg8::StaticOrder, false>(lds, g, S, E, nullptr);
        }
        SEAM(PHID(l, PH_GIN));
        if (IN(PHID(l, PH_TOK))) ph_tok(PP(), l, lds);
        SEAM(PHID(l, PH_TOK));
        if (IN(PHID(l, PH_GQ)) && (PP()->pad & 16)) { KP p = PP();
            pg8::Gemm g{p->cq, p->WuqT + (size_t)l * 768 * 384, TT, 768, 384, 0}; pg8::StaticOrder S; S.init(TT, 768, G, bid);
            MEpiQ E{p->Q, p->tab}; pg8::gemm_phase<MEpiQ, pg8::StaticOrder, false>(lds, g, S, E, nullptr);
        }
        if (IN(PHID(l, PH_GQ)) && (PP()->pad & 32)) { KP p = PP();
            pg8::Gemm g{p->ckv, p->WkvT + (size_t)l * 1024 * 256, TP, 512, 256, 0}; pg8::StaticOrder S; S.init(TP, 512, G / 2, bid < G / 2 ? bid : G);
            MEpiKV E{p->Kn, p->V}; pg8::gemm_phase<MEpiKV, pg8::StaticOrder, false>(lds, g, S, E, nullptr);
        }
        if (IN(PHID(l, PH_GQ)) && (PP()->pad & 32)) { KP p = PP();
            pg8::Gemm g{p->WkvT + (size_t)l * 1024 * 256 + (size_t)512 * 256, p->ckv, 512, TP, 256, 0}; pg8::StaticOrder S; S.init(512, TP, G / 2, bid >= G / 2 ? bid - G / 2 : G);
            MEpiVt E{p->Vt, TP, 0}; pg8::gemm_phase<MEpiVt, pg8::StaticOrder, false>(lds, g, S, E, nullptr);
        }
        if (IN(PHID(l, PH_GQ)) && (PP()->pad & 64)) ph_delta_pre(PP(), lds);
        SEAM(PHID(l, PH_GQ));
        if (IN(PHID(l, PH_ATT))) { const int am = PP()->pad;
            if (am & 1) ph_attn_s2(PP(), l, lds); if (am & 4) ph_attn_p(PP(), lds); if (am & 8) ph_att_waves(PP(), l, lds); }
        SEAM(PHID(l, PH_ATT));
        if (IN(PHID(l, PH_FIN))) { const int fm = PP()->pad; if (fm & 128) ph_fin(PP(), l, lds); if (fm & 256) ph_delta_fin(PP(), l); }
        SEAM(PHID(l, PH_FIN));
        if (IN(PHID(l, PH_MERGE)) && (PP()->pad & 512)) { KP p = PP();
            pg8::Gemm g{p->ya, p->WbrT + (size_t)l * 1024 * 1536, TP, 1024, 512, 1536}; pg8::SegOrder<3> S; S.init(TP, 1024, G, bid);
            MEpiMergeS E{p->H, p->mb}; pg8::gemm_phase<MEpiMergeS, pg8::SegOrder<3>, false>(lds, g, S, E, nullptr);
        }
        if (IN(PHID(l, PH_MERGE)) && (PP()->pad & 1024)) { KP p = PP(); TEpiMerge E{p->H, p->mb}; tail_gemm<3, TEpiMerge>(p->ya + (size_t)TP * 1536, 1536, p->WbrT + (size_t)l * 1024 * 1536, 1536, 1024, E, lds); }
        SEAM(PHID(l, PH_MERGE));
        if (IN(PHID(l, PH_OUT)) && (PP()->pad & 2048)) { KP p = PP();
            const float* xp = l == 0 ? p->x_prompt : p->xres; const float* xs = l == 0 ? p->x_sample : p->xres + (size_t)TP * 1024;
            pg8::Gemm g{p->mb, p->WoutT + (size_t)l * 1024 * 1024, TP, 1024, 1024, 0}; pg8::StaticOrder S; S.init(TP, 1024, G, bid);
            MEpiRes E{xp, xs, p->xres}; pg8::gemm_phase<MEpiRes, pg8::StaticOrder, false>(lds, g, S, E, nullptr);
        }
        if (IN(PHID(l, PH_OUT)) && (PP()->pad & 4096)) { KP p = PP(); TEpiRes E{l == 0 ? p->x_sample : p->xres + (size_t)TP * 1024, p->xres}; tail_gemm<1, TEpiRes>(p->mb + (size_t)TP * 1024, 1024, p->WoutT + (size_t)l * 1024 * 1024, 1024, 1024, E, lds); }
        SEAM(PHID(l, PH_OUT));
        if (IN(PHID(l, PH_NORM))) { KP p = PP();
            if (l == 0) ph_rmsnorm(p->xres, p->xres + (size_t)TP * 1024, p->norm_g + 1024, p->xn, nullptr, nullptr);
            else ph_rmsnorm(p->xres, p->xres + (size_t)TP * 1024, p->final_norm_g, nullptr, p->out + O_YP, p->out + O_YS);
        }
        SEAM(PHID(l, PH_NORM));
    }
#if defined(TPROBE)
    { int te_ = threadIdx.x; asm volatile("" : "+v"(te_)); if (blockIdx.x == 0 && te_ == 0 && PP()->ph_lo == 0) { unsigned long long w = (unsigned long long)*(volatile LAS unsigned*)(lds + LDS_MISC + 128) * 8ull; const unsigned long long t0 = __builtin_amdgcn_s_memrealtime();
#if TPROBE == 40
        { unsigned* xt = PP()->bar + 12 * XCD_BAR_WORDS; unsigned m = 0; for (int b = 0; b < 256; ++b) m += (xb_ld(xt + b) == xb_ld(xt + (b & 7)) && xb_ld(xt + b) != 0u) ? 1u : 0u; w += (unsigned long long)m * 100ull; }
#endif
        while (__builtin_amdgcn_s_memrealtime() - t0 < w) __builtin_amdgcn_s_sleep(8); } }
#endif
#undef IN
#undef SEAM
}

static inline size_t al256(size_t x) { return (x + 255) & ~(size_t)255; }
extern "C" void kernel_launch(void* const* d_in, const int* in_sizes, int n_in, void* d_out, int out_size, void* d_ws, size_t ws_size, hipStream_t stream) {
    static int grid = 0;
    if (grid == 0) {
        int dev = 0, cus = 0; (void)hipGetDevice(&dev); (void)hipDeviceGetAttribute(&cus, hipDeviceAttributeMultiprocessorCount, dev);
        (void)hipFuncSetAttribute((const void*)k_mega, hipFuncAttributeMaxDynamicSharedMemorySize, LDS_BYTES);
        int per_cu = 0; (void)hipOccupancyMaxActiveBlocksPerMultiprocessor(&per_cu, (const void*)k_mega, NTHR, LDS_BYTES); (void)hipGetLastError();
        grid = cus > 0 ? cus : 256;
    }
    Params p{};
    p.x_prompt = (const float*)d_in[0]; p.x_sample = (const float*)d_in[1]; p.cache_kv = (const float*)d_in[2]; p.cache_kr = (const float*)d_in[3];
    p.state_pool = (const float*)d_in[4]; p.state_conv = (const float*)d_in[5]; p.state_delta = (const float*)d_in[6]; p.page_table = (const int*)d_in[7];
    p.norm_g = (const float*)d_in[8]; p.w_in = (const float*)d_in[9]; p.pool_mix = (const float*)d_in[10]; p.pool_scale = (const float*)d_in[11];
    p.q_norm_g = (const float*)d_in[12]; p.w_uq = (const float*)d_in[13]; p.kv_norm_g = (const float*)d_in[14]; p.w_uk = (const float*)d_in[15];
    p.w_uv = (const float*)d_in[16]; p.conv_w = (const float*)d_in[17]; p.a_log = (const float*)d_in[18]; p.dt_bias = (const float*)d_in[19];
    p.dn_norm_g = (const float*)d_in[20]; p.w_br0 = (const float*)d_in[21]; p.w_br1 = (const float*)d_in[22]; p.w_br2 = (const float*)d_in[23];
    p.w_out = (const float*)d_in[24]; p.final_norm_g = (const float*)d_in[25];
    p.out = (float*)d_out;
    char* w = (char*)d_ws; size_t off = 0;
    auto take = [&](size_t bytes) { char* q = w + off; off += al256(bytes); return q; };
    const size_t BAR_BYTES = (size_t)16 * XCD_BAR_WORDS * 4;
    p.bar = (unsigned*)take(BAR_BYTES);
    p.WinT = (bf16_t*)take((size_t)2 * IN_WP * 1024 * 2);
    p.WuqT = (bf16_t*)take((size_t)2 * 768 * 384 * 2);
    p.WkvT = (bf16_t*)take((size_t)2 * 1024 * 256 * 2);
    p.WbrT = (bf16_t*)take((size_t)2 * 3 * 1024 * 512 * 2);
    p.WoutT = (bf16_t*)take((size_t)2 * 1024 * 1024 * 2);
    p.PmixT = (bf16_t*)take((size_t)2 * 4 * 128 * 128 * 2);
    p.WukB = (bf16_t*)take((size_t)2 * 256 * 512 * 2);
    p.tab = (float2*)take((size_t)(SEQ + DEC_SEQ) * 16 * 8);
    p.xres = (float*)take((size_t)TT * 1024 * 4);
    p.xn = (bf16_t*)take((size_t)TT * 1024 * 2);
    p.H = (bf16_t*)take((size_t)TT * IN_WP * 2);
    p.BA = (float*)take((size_t)TT * 16 * 4);
    p.cq = (bf16_t*)take((size_t)TT * 384 * 2);
    p.ckv = (bf16_t*)take((size_t)TT * 256 * 2);
    p.Kr = (bf16_t*)take((size_t)TT * 32 * 2);
    p.Q = (bf16_t*)take((size_t)TT * 768 * 2);
    bf16_t* Qlat = (bf16_t*)take((size_t)TS * 8 * 288 * 2);
    p.Kn = (bf16_t*)take((size_t)TP * 512 * 2);
    p.V = (bf16_t*)take((size_t)TP * 512 * 2);
    p.Vt = (bf16_t*)take((size_t)512 * TP * 2);
    p.qd = (bf16_t*)take((size_t)TT * 512 * 2);
    p.kd = (bf16_t*)take((size_t)TT * 512 * 2);
    p.vd = (bf16_t*)take((size_t)TT * 512 * 2);
    p.bg = (float*)take((size_t)TT * 16 * 4);
    p.ya = (bf16_t*)take((size_t)TT * 1536 * 2); p.yb = p.ya + 512; p.yc = p.ya + 1024;
    p.mf = (float*)take((size_t)TT * 1024 * 4);
    p.mb = (bf16_t*)take((size_t)TT * 1024 * 2);
    p.part = (float*)take((size_t)DEC_BATCH * SA_CH * 64 * 258 * 4);
    p.DOP = (bf16_t*)take((size_t)2048 * 4 * 4096 * 2);
    p.DU = (float*)take((size_t)2048 * 4096 * 4);
    p.DG = (float*)take((size_t)2048 * 4);

    (void)hipMemsetAsync(p.bar, 0, BAR_BYTES, stream);
    p.ph_lo = 0; p.ph_hi = PH_END; p.li = 0; p.pad = 0x7fff;
    hipLaunchKernelGGL(k_mega, dim3(grid), dim3(NTHR), LDS_BYTES, stream, p);
#if defined(PROBE_REP) && PROBE_REP > 0
    for (int i = 0; i < PROBE_REP; ++i) { Params q = p; q.ph_lo = PROBE_LO; q.ph_hi = PROBE_HI; q.li = 1 + i; q.pad = PROBE_MASK; hipLaunchKernelGGL(k_mega, dim3(grid), dim3(NTHR), LDS_BYTES, stream, q); }
#endif
}
```

```cpp
#include <hip/hip_runtime.h>
#include <stdint.h>

typedef unsigned short bf16_t;

#define D_MODEL 1024
#define TP 16384
#define TS 256
#define TT (TP + TS)
#define SEQ 2048
#define DEC_SEQ 8
#define DEC_BATCH 32
#define PAST_LEN 16384
#define PAGE 128
#define N_PAGES 128
#define N_POOL 5120
#define IN_W 7344
#define IN_WP 7424
#define C_POOL 0
#define C_ZPOOL 512
#define C_Q 1024
#define C_KV 1408
#define C_KR 1664
#define C_ZMLA 1696
#define C_QKV 2208
#define C_ZDN 3744
#define C_BETA 4256
#define C_ALPHA 4264
#define C_GATE 4272
#define EPS 1e-6f
#define MLA_SCALE 0.10206207261596577f
#define ATT_C 0.14724444831554004f

#define O_YP 0
#define O_YS (O_YP + 16777216)
#define O_PKV (O_YS + 262144)
#define O_PKR (O_PKV + 8388608)
#define O_PPOOL (O_PKR + 1048576)
#define O_PCONV (O_PPOOL + 122880)
#define O_PDELTA (O_PCONV + 73728)
#define O_SKV (O_PDELTA + 524288)
#define O_SKR (O_SKV + 131072)
#define O_SPOOL (O_SKR + 16384)
#define O_SCONV (O_SPOOL + 491520)
#define O_SDELTA (O_SCONV + 294912)
#define O_END (O_SDELTA + 2097152)

__device__ __forceinline__ float bf2f(bf16_t b) { return __uint_as_float(((unsigned)b) << 16); }
__device__ __forceinline__ bf16_t f2bf(float f) { unsigned u = __float_as_uint(f); u += 0x7FFFu + ((u >> 16) & 1u); return (bf16_t)(u >> 16); }
__device__ __forceinline__ float sigmoidf_(float v) { return __builtin_amdgcn_rcpf(1.0f + __builtin_amdgcn_exp2f(-1.4426950408889634f * v)); }
__device__ __forceinline__ float siluf_(float v) { return v * __builtin_amdgcn_rcpf(1.0f + __builtin_amdgcn_exp2f(-1.4426950408889634f * v)); }
__device__ __forceinline__ float wave_sum(float v) {
#pragma unroll
    for (int o = 32; o >= 1; o >>= 1) v += __shfl_xor(v, o);
    return v;
}

#define SA_CH 8
namespace pg8 {
#define PG8_LAS __attribute__((address_space(3)))
typedef unsigned short bf16_t;
typedef short bf16x8 __attribute__((ext_vector_type(8)));
typedef float f32x4 __attribute__((ext_vector_type(4)));
typedef unsigned u32x4 __attribute__((ext_vector_type(4)));
constexpr int BM = 256, BK = 64, HALF = 128, HTB = HALF * BK * 2  , STAGE_BYTES = 8 * HTB, NXCD = 8, WGM = 8;

__host__ __device__ __forceinline__ int lds_byte(int r, int c) { const int st = (r >> 4) * 2 + (c >> 5), rr = r & 15, cc = c & 31, ob = rr * 64 + cc * 2; return st * 1024 + (ob ^ (((ob >> 9) & 1) << 5)); }
__host__ __device__ __forceinline__ void stage_rc(int b, int& R, int& C) { const int st = b / 1024, sb = b % 1024, swz = sb ^ (((sb >> 9) & 1) << 5); R = (st >> 1) * 16 + swz / 64; C = (st & 1) * 32 + (swz % 64) / 2; }
__host__ __device__ __forceinline__ int perm32(int rho) { const int n = rho >> 4, i = rho & 15; return 8 * (i >> 2) + 4 * n + (i & 3); }

struct Unit { int pm, pn, sg; };
struct Gemm { const bf16_t* A; const bf16_t* Bt; int M, N, K; int ld; };

struct StaticOrder {
    int nM, nN, nwg, G, c;
    __host__ __device__ void init(int M, int N, int G_, int c_) { nM = M / BM; nN = N / BM; nwg = nM * nN; G = G_; c = c_; }
    __host__ __device__ bool next(int i, Unit& u) const {
        const long L = (long)i * G + c; if (L >= nwg) return false;
        int wgid = (int)L; { const int q = nwg / NXCD, r = nwg % NXCD, xcd = wgid % NXCD, off = wgid / NXCD; wgid = (xcd < r ? xcd * (q + 1) : r * (q + 1) + (xcd - r) * q) + off; }
        const int nig = WGM * nN, gid = wgid / nig, fm = gid * WGM, gsz = (nM - fm) < WGM ? (nM - fm) : WGM;
        u.pm = fm + ((wgid % nig) % gsz); u.pn = (wgid % nig) / gsz; u.sg = 0; return true;
    }
    __device__ __forceinline__ void a_ready(const Unit&) const {}
    __device__ __forceinline__ void done(const Unit&) const {}
};
struct GinOrder : StaticOrder {
    unsigned* cnt;
    __device__ bool next(int i, Unit& u) const {
        const long L0 = (long)i * G + c; if (L0 >= nwg) return false;
        int wgid = nwg - 1 - (int)L0; { const int q = nwg / NXCD, r = nwg % NXCD, xcd = wgid % NXCD, off = wgid / NXCD; wgid = (xcd < r ? xcd * (q + 1) : r * (q + 1) + (xcd - r) * q) + off; }
        const int nig = WGM * nN, gid = wgid / nig, fm = gid * WGM, gsz = (nM - fm) < WGM ? (nM - fm) : WGM;
        u.pm = fm + ((wgid % nig) % gsz); u.pn = (wgid % nig) / gsz; u.sg = 0; return true;
    }
    __device__ __forceinline__ void done(const Unit& u) const {
        if (u.pm == nM - 1) {
            asm volatile("s_waitcnt vmcnt(0)" ::: "memory");
            if (__builtin_amdgcn_mbcnt_hi(~0u, __builtin_amdgcn_mbcnt_lo(~0u, 0u)) == 0u) __hip_atomic_fetch_add(cnt, 1u, __ATOMIC_RELAXED, __HIP_MEMORY_SCOPE_AGENT);
        }
    }
};
template <int NSEG> struct SegOrder : StaticOrder {
    __host__ __device__ bool next(int i, Unit& u) const { const bool ok = StaticOrder::next(i / NSEG, u); u.sg = i % NSEG; return ok; }
};
typedef __bf16 bf16n2 __attribute__((ext_vector_type(2)));
__device__ __forceinline__ unsigned cvt_pk_bf16(float lo, float hi) { typedef float f2_ __attribute__((ext_vector_type(2))); const f2_ v = {lo, hi}; return __builtin_bit_cast(unsigned, __builtin_convertvector(v, bf16n2)); }
typedef float f32x2 __attribute__((ext_vector_type(2)));
template <class Epi, class Sched, bool STAMP = false>
__device__ __forceinline__ void gemm_phase(PG8_LAS unsigned char* lds, const Gemm g, const Sched& S, const Epi& E, unsigned long long* stamps) {
    int tid_ = threadIdx.x; asm volatile("" : "+v"(tid_));
    const int tid = tid_, wid = __builtin_amdgcn_readfirstlane(tid >> 6), lane = tid & 63, wr = wid >> 2, wc = wid & 3, fr = lane & 15, fq = lane >> 4;
    int K_ = g.K; asm volatile("" : "+s"(K_));
    int LD_ = g.ld ? g.ld : g.K; asm volatile("" : "+s"(LD_));
    const int K = K_, nt = K / BK, LD = LD_;
    int ts_lo = 0, ts_hi = 0, nts = 0; const unsigned long long rt_entry = STAMP ? (unsigned long long)wall_clock64() : 0ull;
#define PG8_STAMP() do { if (STAMP && wid == 0 && nts < 64) { const unsigned long long _c = (unsigned long long)clock64(); \
        ts_lo = (lane == nts) ? (int)(unsigned)_c : ts_lo; ts_hi = (lane == nts) ? (int)(unsigned)(_c >> 32) : ts_hi; ++nts; } } while (0)
    PG8_STAMP();
    unsigned voffA[2], voffB[2];
#pragma unroll
    for (int i = 0; i < 2; ++i) { int R, C; stage_rc(tid * 16 + i * 8192, R, C); const int Rb = Epi::PERM ? ((R & ~31) + perm32(R & 31)) : R;
        voffA[i] = (unsigned)(R * LD + C) * 2u; voffB[i] = (unsigned)(Rb * LD + C) * 2u; }
    const size_t kstep = (size_t)(BK * 2);
    const size_t hstep = (size_t)HALF * LD * 2;
    const size_t tstep = 2 * hstep;
    const unsigned ldsw = (unsigned)wid * 1024u;
    const int aoff = lds_byte(wr * 64 + fr, fq * 8), boff = lds_byte(wc * 32 + fr, fq * 8);
#define PG8_SA(b, h) (((b) * 2 + (h)) * HTB)
#define PG8_SB(b, h) ((4 + (b) * 2 + (h)) * HTB)
#define PG8_STAGE(bufoff, gbase, voff) do { _Pragma("unroll") for (int _i = 0; _i < 2; ++_i) \
        __builtin_amdgcn_global_load_lds((const unsigned*)((const char*)(gbase) + (voff)[_i]), (PG8_LAS unsigned*)(lds + (bufoff) + ldsw + _i * 8192), 16, 0, 0); } while (0)
#define PG8_LDA(dst, b, h) do { _Pragma("unroll") for (int m = 0; m < 4; ++m) _Pragma("unroll") for (int k = 0; k < 2; ++k) dst[m][k] = *(const PG8_LAS bf16x8*)(lds + PG8_SA(b, h) + aoff + m * 2048 + k * 1024); } while (0)
#define PG8_LDB(dst, b, h) do { _Pragma("unroll") for (int n = 0; n < 2; ++n) _Pragma("unroll") for (int k = 0; k < 2; ++k) dst[n][k] = *(const PG8_LAS bf16x8*)(lds + PG8_SB(b, h) + boff + n * 2048 + k * 1024); } while (0)
#define PG8_MMA(ai, bj, At, Bt) do { __builtin_amdgcn_s_setprio(1); _Pragma("unroll") for (int m = 0; m < 4; ++m) _Pragma("unroll") for (int n = 0; n < 2; ++n) _Pragma("unroll") for (int k = 0; k < 2; ++k) \
        acc[ai][bj][m][n] = __builtin_amdgcn_mfma_f32_16x16x32_bf16(Bt[n][k], At[m][k], acc[ai][bj][m][n], 0, 0, 0); __builtin_amdgcn_s_setprio(0); } while (0)
#define PG8_WAIT_V(n) asm volatile("s_waitcnt vmcnt(" #n ")" ::: "memory")
#define PG8_WAIT_L(n) asm volatile("s_waitcnt lgkmcnt(" #n ")" ::: "memory")
#define PG8_BAR __builtin_amdgcn_s_barrier()
#define PG8_SCHED __builtin_amdgcn_sched_barrier(0)
    Unit cur, nxt; int ui = 0;
    if (!S.next(0, cur)) return;
    f32x4 acc[2][2][4][2];
#pragma unroll
    for (int a = 0; a < 2; ++a)
#pragma unroll
        for (int b = 0; b < 2; ++b)
#pragma unroll
            for (int m = 0; m < 4; ++m)
#pragma unroll
                for (int n = 0; n < 2; ++n) acc[a][b][m][n] = (f32x4){0.f, 0.f, 0.f, 0.f};
    bf16x8 At[4][2], B0[2][2], B1[2][2];
    const size_t sstep = (size_t)K * 2;
    const char* cA = (const char*)g.A + (size_t)cur.pm * tstep + cur.sg * sstep; const char* cB = (const char*)g.Bt + (size_t)cur.pn * tstep + cur.sg * sstep;
    S.a_ready(cur);
    PG8_STAGE(PG8_SB(0, 0), cB, voffB); PG8_STAGE(PG8_SA(0, 0), cA, voffA); PG8_STAGE(PG8_SB(0, 1), cB + hstep, voffB); PG8_STAGE(PG8_SA(0, 1), cA + hstep, voffA);
    if (wr == 1) PG8_BAR;
    PG8_WAIT_V(4); PG8_BAR;
    PG8_STAGE(PG8_SB(1, 0), cB + kstep, voffB); PG8_STAGE(PG8_SA(1, 0), cA + kstep, voffA); PG8_STAGE(PG8_SB(1, 1), cB + hstep + kstep, voffB);
    PG8_WAIT_V(6); PG8_BAR;
    PG8_STAMP();
    for (;;) {
        const bool has_next = S.next(ui + 1, nxt);
        const char* nA = has_next ? (const char*)g.A + (size_t)nxt.pm * tstep + nxt.sg * sstep : cA; const char* nB = has_next ? (const char*)g.Bt + (size_t)nxt.pn * tstep + nxt.sg * sstep : cB;
_Pragma("nounroll")
        for (int t = 0; t < nt; t += 2) {
            const bool last = (t == nt - 2);
            const char* a1 = cA + (size_t)(t + 1) * kstep;
            const char* a2 = last ? nA : cA + (size_t)(t + 2) * kstep; const char* b2 = last ? nB : cB + (size_t)(t + 2) * kstep;
            const char* a3 = a2 + kstep; const char* b3 = b2 + kstep;
            if (last && has_next) S.a_ready(nxt);
            PG8_LDB(B0, 0, 0); PG8_SCHED; PG8_LDA(At, 0, 0); PG8_STAGE(PG8_SA(1, 1), a1 + hstep, voffA);
            PG8_WAIT_L(8); PG8_BAR; PG8_WAIT_L(0); PG8_MMA(0, 0, At, B0); PG8_BAR; PG8_SCHED;
            PG8_LDB(B1, 0, 1); PG8_STAGE(PG8_SB(0, 0), b2, voffB);
            PG8_BAR; PG8_WAIT_L(0); PG8_MMA(0, 1, At, B1); PG8_BAR;
            PG8_LDA(At, 0, 1); PG8_STAGE(PG8_SA(0, 0), a2, voffA);
            PG8_BAR; PG8_WAIT_L(0); PG8_MMA(1, 0, At, B0); PG8_BAR; PG8_SCHED;
            PG8_STAGE(PG8_SB(0, 1), b2 + hstep, voffB);
            PG8_WAIT_V(6); PG8_BAR; PG8_MMA(1, 1, At, B1); PG8_BAR;
            PG8_LDB(B0, 1, 0); PG8_SCHED; PG8_LDA(At, 1, 0); PG8_STAGE(PG8_SA(0, 1), a2 + hstep, voffA);
            PG8_WAIT_L(8); PG8_BAR; PG8_WAIT_L(0); PG8_MMA(0, 0, At, B0); PG8_BAR; PG8_SCHED;
            PG8_LDB(B1, 1, 1); PG8_STAGE(PG8_SB(1, 0), b3, voffB);
            PG8_BAR; PG8_WAIT_L(0); PG8_MMA(0, 1, At, B1); PG8_BAR;
            PG8_LDA(At, 1, 1); PG8_STAGE(PG8_SA(1, 0), a3, voffA);
            PG8_BAR; PG8_WAIT_L(0); PG8_MMA(1, 0, At, B0); PG8_BAR; PG8_SCHED;
            PG8_STAGE(PG8_SB(1, 1), b3 + hstep, voffB);
            PG8_WAIT_V(6); PG8_BAR; PG8_MMA(1, 1, At, B1); PG8_BAR;
        }
        PG8_STAMP();
        bool fin_ = true; if constexpr (Epi::SEG > 0) fin_ = (cur.sg == Epi::SEG - 1);
        if constexpr (!Epi::AFTER_DRAIN) { if (fin_) { E(acc, cur, wr, wc, fr, fq); S.done(cur); } }
        if constexpr (Epi::SEG > 0) E.mid(acc, cur, wr, wc, fr, fq, fin_ ? 1 : cur.sg + 1, fin_ ? 0.f : 1.f);
        PG8_STAMP();
        if (!has_next) break;
        if constexpr (Epi::SEG == 0)
#pragma unroll
        for (int a = 0; a < 2; ++a)
#pragma unroll
            for (int b = 0; b < 2; ++b)
#pragma unroll
                for (int m = 0; m < 4; ++m)
#pragma unroll
                    for (int n = 0; n < 2; ++n) acc[a][b][m][n] = (f32x4){0.f, 0.f, 0.f, 0.f};
        cur = nxt; cA = nA; cB = nB; ++ui;
    }
    PG8_WAIT_V(0);
    if (wr == 0) PG8_BAR;
    PG8_BAR;
    if constexpr (Epi::AFTER_DRAIN) { E.fused(acc, cur, wr, wc, fr, fq, lds, wid, lane); S.done(cur); }
    PG8_STAMP();
    if (STAMP && wid == 0) { stamps[lane] = lane < nts ? (((unsigned long long)(unsigned)ts_hi << 32) | (unsigned)ts_lo) : 0ull;
        if (lane == 62) stamps[62] = rt_entry; if (lane == 63) stamps[63] = (unsigned long long)wall_clock64(); }
#undef PG8_STAMP
#undef PG8_SA
#undef PG8_SB
#undef PG8_STAGE
#undef PG8_LDA
#undef PG8_LDB
#undef PG8_MMA
#undef PG8_WAIT_V
#undef PG8_WAIT_L
#undef PG8_BAR
#undef PG8_SCHED
}

}
#define XB_TMO      128
#define XB_XCNT(j)  (256  + 64 * (j))
#define XB_XSUB(j)  (1280 + 64 * (j))
#define XB_XGEN(j)  (2304 + 64 * (j))
#define XB_TOP      3328
#define XB_TOPGEN   3392
#define XCD_BAR_WORDS 3456
#define XB_SPIN_CAP (1u << 18)
#define LAS __attribute__((address_space(3)))

__device__ __forceinline__ unsigned xb_ld(unsigned* p)              { return __hip_atomic_load(p, __ATOMIC_RELAXED, __HIP_MEMORY_SCOPE_AGENT); }
__device__ __forceinline__ unsigned xb_add(unsigned* p, unsigned v) { return __hip_atomic_fetch_add(p, v, __ATOMIC_RELAXED, __HIP_MEMORY_SCOPE_AGENT); }
__device__ __forceinline__ unsigned xb_xcc_id() { return (unsigned)__builtin_amdgcn_s_getreg((3 << 11) | 20) & 0xFu; }
#define XB_SPIN(cond, bar) do { unsigned _sp = 0; while (cond) { __builtin_amdgcn_s_sleep(1); \
    if ((++_sp & 255u) == 0u) { if (xb_ld(&(bar)[XB_TMO])) break; if (_sp > XB_SPIN_CAP) { atomicAdd(&(bar)[XB_TMO], 1u); break; } } } } while (0)

struct XcdBarrier {
    unsigned* bar; unsigned x;
    volatile LAS unsigned* st;
};

__device__ __forceinline__ XcdBarrier xcd_barrier_post(unsigned* bar, volatile LAS unsigned* st) {
    XcdBarrier b; b.bar = bar; b.x = xb_xcc_id(); b.st = st;
    if (threadIdx.x == 0) (void)xb_add(&bar[XB_XCNT(b.x)], 1u);
    return b;
}
__device__ __forceinline__ void xcd_barrier_complete(unsigned* bar, unsigned x, unsigned& nloc, unsigned& nx) {
    const unsigned G = gridDim.x * gridDim.y * gridDim.z;
    unsigned sum, cnt, mine, sp = 0u;
    for (;;) {
        sum = 0u; cnt = 0u; mine = 0u;
#pragma unroll
        for (unsigned j = 0; j < 16; ++j) { const unsigned c = xb_ld(&bar[XB_XCNT(j)]); sum += c; cnt += (c > 0u) ? 1u : 0u; mine = (j == x) ? c : mine; }
        if (sum == G) break;
        __builtin_amdgcn_s_sleep(1);
        if ((++sp & 255u) == 0u) { if (xb_ld(&bar[XB_TMO])) break; if (sp > XB_SPIN_CAP) { atomicAdd(&bar[XB_TMO], 1u); break; } }
    }
    nloc = mine > 0u ? mine : 1u; nx = cnt > 0u ? cnt : 1u;
}

__device__ __forceinline__ void xcd_barrier(const XcdBarrier& b) {
    asm volatile("s_waitcnt vmcnt(0)" ::: "memory");
    __syncthreads();
    if (threadIdx.x == 0) {
        unsigned* bar = b.bar;
        __builtin_amdgcn_s_waitcnt(0);
        unsigned nloc = b.st[0], nx = b.st[1];
        if (nloc == 0u) { xcd_barrier_complete(bar, b.x, nloc, nx); b.st[0] = nloc; b.st[1] = nx; }
        const unsigned old = xb_add(&bar[XB_XSUB(b.x)], 1u);
        const unsigned gen = old / nloc;
        if (old + 1u == (gen + 1u) * nloc) {
            __builtin_amdgcn_fence(__ATOMIC_RELEASE, "agent");
            asm volatile("s_waitcnt vmcnt(0)" ::: "memory");
            const unsigned og = xb_add(&bar[XB_TOP], 1u);
            const unsigned tg = og / nx;
            if (og + 1u == (tg + 1u) * nx) xb_add(&bar[XB_TOPGEN], 1u);
            else XB_SPIN(xb_ld(&bar[XB_TOPGEN]) == tg, bar);
            __builtin_amdgcn_fence(__ATOMIC_ACQUIRE, "agent");
            xb_add(&bar[XB_XGEN(b.x)], 1u);
            asm volatile("s_waitcnt vmcnt(0)" ::: "memory");
        } else {
            XB_SPIN(xb_ld(&bar[XB_XGEN(b.x)]) == gen, bar);
            __builtin_amdgcn_fence(__ATOMIC_ACQUIRE, "agent");
            asm volatile("s_waitcnt vmcnt(0)" ::: "memory");
        }
    }
    __syncthreads();
}


#define LAS __attribute__((address_space(3)))
typedef float f32x4 __attribute__((ext_vector_type(4)));
typedef unsigned u32x4 __attribute__((ext_vector_type(4)));
typedef unsigned u32x2 __attribute__((ext_vector_type(2)));
typedef float f32x2 __attribute__((ext_vector_type(2)));
typedef short bf16x8_t __attribute__((ext_vector_type(8)));
typedef float f32x16 __attribute__((ext_vector_type(16)));
constexpr int NTHR = 512;
constexpr int LDS_BYTES = 147456;
constexpr int LDS_MISC = LDS_BYTES - 256;


#if defined(TPROBE)
#define TP_DECL unsigned tp_t0 = 0
#define TP_ON(id) do { if (TPROBE == (id)) tp_t0 = (unsigned)__builtin_amdgcn_s_memrealtime(); } while (0)
#define TP_OFF(id) do { if (TPROBE == (id)) { const unsigned d_ = (unsigned)__builtin_amdgcn_s_memrealtime() - tp_t0; int tq_ = threadIdx.x; asm volatile("" : "+v"(tq_)); if (blockIdx.x == 0 && tq_ == 0) *(volatile LAS unsigned*)(lds + LDS_MISC + 128) += d_; } } while (0)
#define TP_OFFW(id, T) do { if (TPROBE == (id)) { const unsigned d_ = (unsigned)__builtin_amdgcn_s_memrealtime() - tp_t0; int tq_ = threadIdx.x; asm volatile("" : "+v"(tq_)); if (blockIdx.x == 0 && tq_ == (T)) *(volatile LAS unsigned*)(unsigned)(LDS_MISC + 128) += d_; } } while (0)
#define TP_COMMIT(lds_)
#else
#define TP_OFFW(id, T)
#define TP_DECL
#define TP_ON(id)
#define TP_OFF(id)
#define TP_COMMIT(lds_)
#endif
struct Params {
    const float *x_prompt, *x_sample, *cache_kv, *cache_kr, *state_pool, *state_conv, *state_delta; const int* page_table;
    const float *norm_g, *w_in, *pool_mix, *pool_scale, *q_norm_g, *w_uq, *kv_norm_g, *w_uk, *w_uv, *conv_w, *a_log, *dt_bias, *dn_norm_g, *w_br0, *w_br1, *w_br2, *w_out, *final_norm_g;
    float* out;
    bf16_t *WinT, *WuqT, *WkvT, *WbrT, *WoutT, *PmixT, *WukB; float2* tab;
    float* xres; bf16_t* xn; bf16_t* H; float* BA; bf16_t *cq, *ckv, *Kr, *Q, *Kn, *V, *Vt, *qd, *kd, *vd; float* bg; bf16_t *ya, *yb, *yc; float* mf; bf16_t* mb; float* part; bf16_t* DOP; float* DU; float* DG;
    unsigned* bar;
    int ph_lo, ph_hi, li, pad;
};

typedef const __attribute__((address_space(4))) Params* KP;

constexpr int PH_PRO = 0;
constexpr int PH_L = 8;
constexpr int PH_GIN = 0, PH_TOK = 1, PH_GQ = 2, PH_ATT = 3, PH_FIN = 4, PH_MERGE = 5, PH_OUT = 6, PH_NORM = 7;
#define PHID(l, k) (1 + (l) * PH_L + (k))
constexpr int PH_END = 1 + 2 * PH_L;

__device__ __forceinline__ void unpack8(const u32x4 v, float (&f)[8]) {
    f[0] = __uint_as_float(v.x << 16); f[1] = __uint_as_float(v.x & 0xffff0000u); f[2] = __uint_as_float(v.y << 16); f[3] = __uint_as_float(v.y & 0xffff0000u);
    f[4] = __uint_as_float(v.z << 16); f[5] = __uint_as_float(v.z & 0xffff0000u); f[6] = __uint_as_float(v.w << 16); f[7] = __uint_as_float(v.w & 0xffff0000u); }
__device__ __forceinline__ u32x4 pack8(const float (&f)[8]) { u32x4 w; w.x = pg8::cvt_pk_bf16(f[0], f[1]); w.y = pg8::cvt_pk_bf16(f[2], f[3]); w.z = pg8::cvt_pk_bf16(f[4], f[5]); w.w = pg8::cvt_pk_bf16(f[6], f[7]); return w; }
__device__ __forceinline__ void st16(void* ptr, u32x4 w, bool wt) { if (wt) asm volatile("global_store_dwordx4 %0, %1, off sc1" :: "v"(ptr), "v"(w) : "memory"); else *(u32x4*)ptr = w; }
struct MEpiH { static constexpr bool PERM = true, AFTER_DRAIN = false; static constexpr int SEG = 0; bf16_t* H; float* BA;
    __device__ __forceinline__ void operator()(const f32x4 (&acc)[2][2][4][2], const pg8::Unit& u, int wr, int wc, int fr0, int fq0) const {
        int fr = fr0, fq = fq0; asm volatile("" : "+v"(fr), "+v"(fq));
        const int row0 = u.pm * 256 + wr * 64 + fr; const bool wt = u.pm == TT / 256 - 1;
#pragma unroll
        for (int bj = 0; bj < 2; ++bj) {
            const int wcol = u.pn * 256 + bj * 128 + wc * 32, col0 = wcol + 8 * fq;
            const bool plain = (wcol + 32 <= C_ZPOOL) || (wcol >= C_Q && wcol + 32 <= C_ZMLA) || (wcol >= C_QKV && wcol + 32 <= C_ZDN);
            const int act = ((col0 >= C_ZPOOL && col0 < C_Q) || (col0 >= C_ZMLA && col0 < C_QKV) || (col0 >= C_ZDN && col0 < C_BETA)) ? 1 : (col0 >= C_GATE ? 2 : 0);
            const bool isba = (col0 == C_BETA) || (col0 == C_ALPHA);
#pragma unroll
            for (int ai = 0; ai < 2; ++ai)
#pragma unroll
                for (int m = 0; m < 4; ++m) { const int row = row0 + ai * 128 + m * 16; f32x4 v0 = acc[ai][bj][m][0], v1 = acc[ai][bj][m][1];
                    if (!plain) {
                        if (isba) { float* b = BA + (size_t)row * 16 + (col0 - C_BETA); st16(b, __builtin_bit_cast(u32x4, v0), wt); st16(b + 4, __builtin_bit_cast(u32x4, v1), wt); }
#pragma unroll
                        for (int e = 0; e < 4; ++e) { const float s0 = sigmoidf_(v0[e]), s1 = sigmoidf_(v1[e]);
                            v0[e] = act == 0 ? v0[e] : (act == 1 ? v0[e] * s0 : s0); v1[e] = act == 0 ? v1[e] : (act == 1 ? v1[e] * s1 : s1); }
                    }
                    u32x4 w; w.x = pg8::cvt_pk_bf16(v0[0], v0[1]); w.y = pg8::cvt_pk_bf16(v0[2], v0[3]); w.z = pg8::cvt_pk_bf16(v1[0], v1[1]); w.w = pg8::cvt_pk_bf16(v1[2], v1[3]);
                    st16(H + (size_t)row * IN_WP + col0, w, wt); }
        }
    } };
struct MEpiQ { static constexpr bool PERM = true, AFTER_DRAIN = false; static constexpr int SEG = 0; bf16_t* Q; const float2* tab;
    __device__ __forceinline__ void operator()(const f32x4 (&acc)[2][2][4][2], const pg8::Unit& u, int wr, int wc, int fr0, int fq0) const {
        int fr = fr0, fq = fq0; asm volatile("" : "+v"(fr), "+v"(fq));
        const int row0 = u.pm * 256 + wr * 64 + fr;
#pragma unroll
        for (int bj = 0; bj < 2; ++bj) {
            const int wcol = u.pn * 256 + bj * 128 + wc * 32, col0 = wcol + 8 * fq;
            const bool rope = (wcol % 96) == 64;
#pragma unroll
            for (int ai = 0; ai < 2; ++ai)
#pragma unroll
                for (int m = 0; m < 4; ++m) { const int row = row0 + ai * 128 + m * 16; f32x4 v0 = acc[ai][bj][m][0], v1 = acc[ai][bj][m][1];
                    if (rope) { const int p = row < TP ? (row & (SEQ - 1)) : SEQ + ((row - TP) & 7); const float2* tp = tab + p * 16 + (fq & 1) * 8; const bool hi = fq >= 2;
#pragma unroll
                        for (int e = 0; e < 4; ++e) { const float o0 = __shfl_xor(v0[e], 32), o1 = __shfl_xor(v1[e], 32); const float2 c0 = tp[e], c1 = tp[4 + e];
                            v0[e] = hi ? (v0[e] * c0.x + o0 * c0.y) : (v0[e] * c0.x - o0 * c0.y); v1[e] = hi ? (v1[e] * c1.x + o1 * c1.y) : (v1[e] * c1.x - o1 * c1.y); } }
                    u32x4 w; w.x = pg8::cvt_pk_bf16(v0[0], v0[1]); w.y = pg8::cvt_pk_bf16(v0[2], v0[3]); w.z = pg8::cvt_pk_bf16(v1[0], v1[1]); w.w = pg8::cvt_pk_bf16(v1[2], v1[3]);
                    *(u32x4*)(Q + (size_t)row * 768 + col0) = w; if (m == 3) asm volatile("" ::: "memory"); }
        }
    } };
struct MEpiKV { static constexpr bool PERM = true, AFTER_DRAIN = false; static constexpr int SEG = 0; bf16_t* Kn; bf16_t* V;
    __device__ __forceinline__ void operator()(const f32x4 (&acc)[2][2][4][2], const pg8::Unit& u, int wr, int wc, int fr0, int fq0) const {
        int fr = fr0, fq = fq0; asm volatile("" : "+v"(fr), "+v"(fq));
        const int row0 = u.pm * 256 + wr * 64 + fr; bf16_t* base = u.pn < 2 ? Kn : V; const int cb = (u.pn & 1) * 256;
#pragma unroll
        for (int bj = 0; bj < 2; ++bj) { const int col0 = cb + bj * 128 + wc * 32 + 8 * fq;
#pragma unroll
            for (int ai = 0; ai < 2; ++ai)
#pragma unroll
                for (int m = 0; m < 4; ++m) { const int row = row0 + ai * 128 + m * 16; const f32x4 v0 = acc[ai][bj][m][0], v1 = acc[ai][bj][m][1];
                    u32x4 w; w.x = pg8::cvt_pk_bf16(v0[0], v0[1]); w.y = pg8::cvt_pk_bf16(v0[2], v0[3]); w.z = pg8::cvt_pk_bf16(v1[0], v1[1]); w.w = pg8::cvt_pk_bf16(v1[2], v1[3]);
                    *(u32x4*)(base + (size_t)row * 512 + col0) = w; } }
    } };
template <int BR> struct MEpiMerge { static constexpr bool PERM = true, AFTER_DRAIN = false; static constexpr int SEG = 0; const bf16_t* H; float* mf; bf16_t* mb;
    __device__ __forceinline__ void operator()(const f32x4 (&acc)[2][2][4][2], const pg8::Unit& u, int wr, int wc, int fr0, int fq0) const {
        int fr = fr0, fq = fq0; asm volatile("" : "+v"(fr), "+v"(fq));
        const int row0 = u.pm * 256 + wr * 64 + fr;
#pragma unroll
        for (int bj = 0; bj < 2; ++bj) { const int col0 = u.pn * 256 + bj * 128 + wc * 32 + 8 * fq;
#pragma unroll
            for (int ai = 0; ai < 2; ++ai)
#pragma unroll
                for (int m = 0; m < 4; ++m) { const int row = row0 + ai * 128 + m * 16; f32x4 v0 = acc[ai][bj][m][0], v1 = acc[ai][bj][m][1];
                    const u32x4 g = *(const u32x4*)(H + (size_t)row * IN_WP + C_GATE + BR * 1024 + col0);
                    v0[0] *= __uint_as_float(g.x << 16); v0[1] *= __uint_as_float(g.x & 0xffff0000u); v0[2] *= __uint_as_float(g.y << 16); v0[3] *= __uint_as_float(g.y & 0xffff0000u);
                    v1[0] *= __uint_as_float(g.z << 16); v1[1] *= __uint_as_float(g.z & 0xffff0000u); v1[2] *= __uint_as_float(g.w << 16); v1[3] *= __uint_as_float(g.w & 0xffff0000u);
                    float* mp = mf + (size_t)row * 1024 + col0;
                    if (BR > 0) { v0 += *(const f32x4*)mp; v1 += *(const f32x4*)(mp + 4); }
                    if (BR < 2) { *(f32x4*)mp = v0; *(f32x4*)(mp + 4) = v1; }
                    else { u32x4 w; w.x = pg8::cvt_pk_bf16(v0[0], v0[1]); w.y = pg8::cvt_pk_bf16(v0[2], v0[3]); w.z = pg8::cvt_pk_bf16(v1[0], v1[1]); w.w = pg8::cvt_pk_bf16(v1[2], v1[3]);
                        *(u32x4*)(mb + (size_t)row * 1024 + col0) = w; } asm volatile("" ::: "memory"); } }
    } };
struct MEpiRes { static constexpr bool PERM = false, AFTER_DRAIN = false; static constexpr int SEG = 0; const float* xp; const float* xs; float* xo;
    __device__ __forceinline__ void operator()(const f32x4 (&acc)[2][2][4][2], const pg8::Unit& u, int wr, int wc, int fr0, int fq0) const {
        int fr = fr0, fq = fq0; asm volatile("" : "+v"(fr), "+v"(fq));
        const int row0 = u.pm * 256 + wr * 64 + fr, col0 = u.pn * 256 + wc * 32 + 4 * fq;
#pragma unroll
        for (int ai = 0; ai < 2; ++ai)
#pragma unroll
            for (int m2 = 0; m2 < 4; m2 += 2) {
                f32x4 xv[2][2][2];
#pragma unroll
                for (int mm = 0; mm < 2; ++mm) { const int row = row0 + ai * 128 + (m2 + mm) * 16; const float* xr = row < TP ? xp + (size_t)row * 1024 : xs + (size_t)(row - TP) * 1024;
#pragma unroll
                    for (int bj = 0; bj < 2; ++bj)
#pragma unroll
                        for (int n = 0; n < 2; ++n) xv[mm][bj][n] = *(const f32x4*)(xr + col0 + bj * 128 + n * 16); }
#pragma unroll
                for (int mm = 0; mm < 2; ++mm) { const int row = row0 + ai * 128 + (m2 + mm) * 16; float* orow = xo + (size_t)row * 1024;
#pragma unroll
                    for (int bj = 0; bj < 2; ++bj)
#pragma unroll
                        for (int n = 0; n < 2; ++n) *(f32x4*)(orow + col0 + bj * 128 + n * 16) = xv[mm][bj][n] + acc[ai][bj][m2 + mm][n]; }
                asm volatile("" ::: "memory"); }
    } };

template <int NSEG, class Epi>
__device__ __forceinline__ void tail_gemm(const bf16_t* __restrict__ A, int lda, const bf16_t* __restrict__ Bt, int K, int N, const Epi& epi, LAS unsigned char* lds) {
    int tid = threadIdx.x; asm volatile("" : "+v"(tid));
    const int lane = tid & 63, wave = __builtin_amdgcn_readfirstlane(tid >> 6), rt = wave & 3, kh = wave >> 2, n = lane & 15, q = lane >> 4;
    const int ntile = 4 * (N / 16), kseg = K / NSEG, khalf = kseg / 2;
    LAS f32x4* red = (LAS f32x4*)lds;
    for (int tile = blockIdx.x; tile < ntile; tile += gridDim.x) {
        const int r0 = 64 * (tile & 3) + 16 * rt, c0 = 16 * (tile >> 2);
        const bf16_t* ap = A + (size_t)(r0 + n) * lda + 8 * q; const bf16_t* bp = Bt + (size_t)(c0 + n) * K + 8 * q;
        f32x4 acc[NSEG];
#pragma unroll
        for (int sg = 0; sg < NSEG; ++sg) { acc[sg] = (f32x4){0.f, 0.f, 0.f, 0.f};
            const int kb = sg * kseg + kh * khalf;
#pragma unroll 4
            for (int k = 0; k < khalf; k += 32) acc[sg] = __builtin_amdgcn_mfma_f32_16x16x32_bf16(*(const bf16x8_t*)(ap + kb + k), *(const bf16x8_t*)(bp + kb + k), acc[sg], 0, 0, 0); }
        __syncthreads();
        if (kh == 1) {
#pragma unroll
            for (int sg = 0; sg < NSEG; ++sg) red[(rt * NSEG + sg) * 64 + lane] = acc[sg]; }
        __syncthreads();
        if (kh == 0) {
#pragma unroll
            for (int sg = 0; sg < NSEG; ++sg) acc[sg] += red[(rt * NSEG + sg) * 64 + lane];
#pragma unroll
            for (int e = 0; e < 4; ++e) { float v[NSEG];
#pragma unroll
                for (int sg = 0; sg < NSEG; ++sg) v[sg] = acc[sg][e];
                epi(r0 + 4 * q + e, c0 + n, v); } }
    }
    __syncthreads();
}
struct TEpiMerge { const bf16_t* H; bf16_t* mb;
    __device__ __forceinline__ void operator()(int row, int col, const float (&v)[3]) const { const size_t t = (size_t)TP + row; const bf16_t* g = H + t * IN_WP + C_GATE + col;
        mb[t * 1024 + col] = f2bf(bf2f(g[0]) * v[0] + bf2f(g[1024]) * v[1] + bf2f(g[2048]) * v[2]); } };
struct TEpiRes { const float* xs; float* xo;
    __device__ __forceinline__ void operator()(int row, int col, const float (&v)[1]) const { xo[((size_t)TP + row) * 1024 + col] = xs[(size_t)row * 1024 + col] + v[0]; } };
struct MEpiMergeS { static constexpr bool PERM = true, AFTER_DRAIN = false; static constexpr int SEG = 3; const bf16_t* H; bf16_t* mb;
    __device__ __forceinline__ void mid(f32x4 (&acc)[2][2][4][2], const pg8::Unit& u, int wr, int wc, int fr0, int fq0, int seg, float keep) const {
        int fr = fr0, fq = fq0; asm volatile("" : "+v"(fr), "+v"(fq));
        const int row0 = u.pm * 256 + wr * 64 + fr;
#pragma unroll
        for (int bj = 0; bj < 2; ++bj) { const int col0 = u.pn * 256 + bj * 128 + wc * 32 + 8 * fq;
#pragma unroll
            for (int ai = 0; ai < 2; ++ai) {
                u32x4 ga[4], gb[4];
#pragma unroll
                for (int m = 0; m < 4; ++m) { const bf16_t* gp = H + (size_t)(row0 + ai * 128 + m * 16) * IN_WP + C_GATE + (seg - 1) * 1024 + col0; ga[m] = *(const u32x4*)gp; gb[m] = *(const u32x4*)(gp + 1024); }
#pragma unroll
                for (int m = 0; m < 4; ++m) { float a[8], b[8]; unpack8(ga[m], a); unpack8(gb[m], b);
#pragma unroll
                    for (int e = 0; e < 4; ++e) { acc[ai][bj][m][0][e] *= keep * a[e] * __builtin_amdgcn_rcpf(fmaxf(b[e], 1e-30f)); acc[ai][bj][m][1][e] *= keep * a[4 + e] * __builtin_amdgcn_rcpf(fmaxf(b[4 + e], 1e-30f)); } }
                asm volatile("" ::: "memory"); } }
    }
    __device__ __forceinline__ void operator()(const f32x4 (&acc)[2][2][4][2], const pg8::Unit& u, int wr, int wc, int fr0, int fq0) const {
        int fr = fr0, fq = fq0; asm volatile("" : "+v"(fr), "+v"(fq));
        const int row0 = u.pm * 256 + wr * 64 + fr;
#pragma unroll
        for (int bj = 0; bj < 2; ++bj) { const int col0 = u.pn * 256 + bj * 128 + wc * 32 + 8 * fq;
#pragma unroll
            for (int ai = 0; ai < 2; ++ai) {
                u32x4 gg[4];
#pragma unroll
                for (int m = 0; m < 4; ++m) gg[m] = *(const u32x4*)(H + (size_t)(row0 + ai * 128 + m * 16) * IN_WP + C_GATE + 2048 + col0);
#pragma unroll
                for (int m = 0; m < 4; ++m) { const int row = row0 + ai * 128 + m * 16; float g[8]; unpack8(gg[m], g);
                    const f32x4 v0 = acc[ai][bj][m][0], v1 = acc[ai][bj][m][1];
                    u32x4 w; w.x = pg8::cvt_pk_bf16(v0[0] * g[0], v0[1] * g[1]); w.y = pg8::cvt_pk_bf16(v0[2] * g[2], v0[3] * g[3]); w.z = pg8::cvt_pk_bf16(v1[0] * g[4], v1[1] * g[5]); w.w = pg8::cvt_pk_bf16(v1[2] * g[6], v1[3] * g[7]);
                    *(u32x4*)(mb + (size_t)row * 1024 + col0) = w; }
                asm volatile("" ::: "memory"); } }
    } };

__device__ __forceinline__ void ph_tr(const float* __restrict__ src, bf16_t* __restrict__ dst, int K, int N, int Npad, LAS float* tile, int rot, int ldd = 0) {
    if (ldd == 0) ldd = K;
    int tid = threadIdx.x; asm volatile("" : "+v"(tid)); const int G = gridDim.x; const int tn = Npad / 64, tk = K / 32, nt = tn * tk;
    const int first = (blockIdx.x + G - (rot % G)) % G;
    const bool al4 = (N & 3) == 0;
    for (int t = first; t < nt; t += G) {
        const int n0 = (t % tn) * 64, k0 = (t / tn) * 32;
        { const int k = tid >> 4, n4 = (tid & 15) * 4, n = n0 + n4; f32x4 v = (f32x4){0.f, 0.f, 0.f, 0.f};
          const float* sp = src + (size_t)(k0 + k) * N + n;
          if (al4 && n + 3 < N) v = *(const f32x4*)sp; else {
#pragma unroll
              for (int e = 0; e < 4; ++e) if (n + e < N) v[e] = sp[e]; }
#pragma unroll
          for (int e = 0; e < 4; ++e) tile[k * 65 + n4 + e] = v[e]; }
        __syncthreads();
        if (tid < 256) { const int n = tid >> 2, kq = (tid & 3) * 8; float f[8];
#pragma unroll
            for (int j = 0; j < 8; ++j) f[j] = tile[(kq + j) * 65 + n];
            *(u32x4*)(dst + (size_t)(n0 + n) * ldd + k0 + kq) = pack8(f); }
        __syncthreads();
    }
}
__device__ __forceinline__ void ph_rope_tab(float2* tab) {
    for (int idx = blockIdx.x * NTHR + threadIdx.x; idx < (SEQ + DEC_SEQ) * 16; idx += gridDim.x * NTHR) {
        const int p = idx >> 4, i = idx & 15; const int pos = p < SEQ ? p : PAST_LEN + (p - SEQ);
        const float inv = powf(10000.0f, -(float)i / 16.0f); const float ang = (float)pos * inv;
        const double rev = (double)ang * 0.15915494309189533576888; const float f = (float)(rev - floor(rev));
        tab[idx] = make_float2(__builtin_amdgcn_cosf(f), __builtin_amdgcn_sinf(f)); }
}
__device__ __forceinline__ void ph_rmsnorm(const float* __restrict__ xp, const float* __restrict__ xs, const float* __restrict__ g, bf16_t* __restrict__ xn, float* __restrict__ yp, float* __restrict__ ys) {
    int tid_o = threadIdx.x; asm volatile("" : "+v"(tid_o)); int lane = tid_o & 63, wave = tid_o >> 6;
    const int stride = gridDim.x * 8;
    f32x4 gg[4];
#pragma unroll
    for (int i = 0; i < 4; ++i) gg[i] = *(const f32x4*)(g + i * 256 + lane * 4);
    for (int t0 = blockIdx.x * 8 + wave; t0 < TT; t0 += 4 * stride) {
        f32x4 v[4][4];
#pragma unroll
        for (int j = 0; j < 4; ++j) { const int t = t0 + j * stride; const int tc = t < TT ? t : t0; const float* x = tc < TP ? xp + (size_t)tc * 1024 : xs + (size_t)(tc - TP) * 1024;
#pragma unroll
            for (int i = 0; i < 4; ++i) v[j][i] = *(const f32x4*)(x + i * 256 + lane * 4); }
#pragma unroll
        for (int j = 0; j < 4; ++j) { const int t = t0 + j * stride; if (t >= TT) break;
            float ss = 0.f;
#pragma unroll
            for (int i = 0; i < 4; ++i) ss += v[j][i][0] * v[j][i][0] + v[j][i][1] * v[j][i][1] + v[j][i][2] * v[j][i][2] + v[j][i][3] * v[j][i][3];
            ss = wave_sum(ss); const float r = rsqrtf(ss * (1.0f / 1024.0f) + EPS);
#pragma unroll
            for (int i = 0; i < 4; ++i) { const int c = i * 256 + lane * 4; const f32x4 o = v[j][i] * r * gg[i];
                if (xn) { u32x2 w; w.x = pg8::cvt_pk_bf16(o[0], o[1]); w.y = pg8::cvt_pk_bf16(o[2], o[3]); *(u32x2*)(xn + (size_t)t * 1024 + c) = w; }
                else { float* y = t < TP ? yp + (size_t)t * 1024 : ys + (size_t)(t - TP) * 1024; *(f32x4*)(y + c) = o; } } }
    }
}

constexpr int TK_RS = 1040;
struct ConvIn { u32x4 rows[11]; f32x4 sa[3], sb[3]; f32x4 w0[4], w1[4]; };
__device__ __forceinline__ void conv_load(ConvIn& c, KP p, const bf16_t* __restrict__ H, int l, int tbase, int iseq0, bool smp, int sq, int lane, int pi) {
    const int c0 = (pi * 64 + lane) * 8; const float* conv_w = p->conv_w + (size_t)l * 4 * 1536;
#pragma unroll
    for (int j = 0; j < 11; ++j) {
        if (j >= 3 || iseq0 - 3 + j >= 0) c.rows[j] = *(const u32x4*)(H + (size_t)(tbase - 3 + j) * IN_WP + C_QKV + c0);
        else if (smp) { const float* sc = p->state_conv + (((size_t)l * DEC_BATCH + sq) * 3 + j) * 1536 + c0; c.sa[j] = *(const f32x4*)sc; c.sb[j] = *(const f32x4*)(sc + 4); }
        else c.rows[j] = (u32x4){0u, 0u, 0u, 0u}; }
#pragma unroll
    for (int j = 0; j < 4; ++j) { c.w0[j] = *(const f32x4*)(conv_w + j * 1536 + c0); c.w1[j] = *(const f32x4*)(conv_w + j * 1536 + c0 + 4); }
}
__device__ __forceinline__ void conv_compute(ConvIn& c, KP p, float* __restrict__ out, int l, int tbase, int iseq0, bool smp, int sq, int lane, int pi) {
    const int c0 = (pi * 64 + lane) * 8; const bool last = smp || (iseq0 == SEQ - 8);
    if (smp) {
#pragma unroll
        for (int j = 0; j < 3; ++j) { const f32x4 a = c.sa[j], b = c.sb[j]; c.rows[j].x = pg8::cvt_pk_bf16(a[0], a[1]); c.rows[j].y = pg8::cvt_pk_bf16(a[2], a[3]); c.rows[j].z = pg8::cvt_pk_bf16(b[0], b[1]); c.rows[j].w = pg8::cvt_pk_bf16(b[2], b[3]); } }
    bf16_t* dst = pi == 0 ? p->qd : (pi == 1 ? p->kd : p->vd);
#pragma unroll
    for (int e = 0; e < 8; ++e) { float y[8];
#pragma unroll
        for (int k = 0; k < 8; ++k) y[k] = 0.f;
#pragma unroll
        for (int j = 0; j < 4; ++j) { float x[8]; unpack8(c.rows[e + j], x);
#pragma unroll
            for (int k = 0; k < 4; ++k) { y[k] += x[k] * c.w0[j][k]; y[4 + k] += x[4 + k] * c.w1[j][k]; } }
        float ss = 0.f;
#pragma unroll
        for (int k = 0; k < 8; ++k) { y[k] = siluf_(y[k]); ss += y[k] * y[k]; }
        if (pi < 2) { ss += __shfl_xor(ss, 1); ss += __shfl_xor(ss, 2); ss += __shfl_xor(ss, 4); const float rn = rsqrtf(ss + EPS) * (pi == 0 ? 0.125f : 1.0f);
#pragma unroll
            for (int k = 0; k < 8; ++k) y[k] *= rn; }
        *(u32x4*)(dst + (size_t)(tbase + e) * 512 + lane * 8) = pack8(y); }
    if (last) {
#pragma unroll
        for (int rr = 0; rr < 3; ++rr) { float x[8]; unpack8(c.rows[8 + rr], x);
            float* oc = (smp ? out + O_SCONV + (((size_t)l * DEC_BATCH + sq) * 3 + rr) * 1536 : out + O_PCONV + (((size_t)l * 8 + (tbase >> 11)) * 3 + rr) * 1536) + c0;
            *(f32x4*)oc = (f32x4){x[0], x[1], x[2], x[3]}; *(f32x4*)(oc + 4) = (f32x4){x[4], x[5], x[6], x[7]}; } }
}
__device__ __forceinline__ void tok8(KP p, int l, int tbase, int iseq0, bool smp, int sq, int lane) {
    asm volatile("" : "+v"(lane));
    const bf16_t* __restrict__ H = p->H; float* __restrict__ out = p->out;
    __builtin_amdgcn_s_waitcnt(0);
    const float* qg = p->q_norm_g + l * 384; const float* kvg = p->kv_norm_g + l * 256;
    u32x4 rq[8], rk[8];
#pragma unroll
    for (int e = 0; e < 8; ++e) { const bf16_t* h = H + (size_t)(tbase + e) * IN_WP;
        rq[e] = lane < 48 ? *(const u32x4*)(h + C_Q + lane * 8) : (u32x4){0u, 0u, 0u, 0u}; rk[e] = lane < 32 ? *(const u32x4*)(h + C_KV + lane * 8) : (u32x4){0u, 0u, 0u, 0u}; }
    f32x4 gq0 = (f32x4){0.f, 0.f, 0.f, 0.f}, gq1 = gq0, gk0 = gq0, gk1 = gq0;
    if (lane < 48) { gq0 = *(const f32x4*)(qg + lane * 8); gq1 = *(const f32x4*)(qg + lane * 8 + 4); }
    if (lane < 32) { gk0 = *(const f32x4*)(kvg + lane * 8); gk1 = *(const f32x4*)(kvg + lane * 8 + 4); }
    ConvIn A, B;
    conv_load(A, p, H, l, tbase, iseq0, smp, sq, lane, 0);
#pragma unroll
    for (int e = 0; e < 8; ++e) { const int t = tbase + e; float q[8], kv[8]; unpack8(rq[e], q); unpack8(rk[e], kv); float s1 = 0.f, s2 = 0.f;
#pragma unroll
        for (int j = 0; j < 8; ++j) { s1 += q[j] * q[j]; s2 += kv[j] * kv[j]; }
        s1 = wave_sum(s1); s2 = wave_sum(s2); const float r1 = rsqrtf(s1 * (1.0f / 384.0f) + EPS), r2 = rsqrtf(s2 * (1.0f / 256.0f) + EPS);
#pragma unroll
        for (int j = 0; j < 4; ++j) { q[j] *= r1 * gq0[j]; q[4 + j] *= r1 * gq1[j]; kv[j] *= r2 * gk0[j]; kv[4 + j] *= r2 * gk1[j]; }
        if (lane < 48) *(u32x4*)(p->cq + (size_t)t * 384 + lane * 8) = pack8(q);
        if (lane < 32) { float* okv = (smp ? out + O_SKV + ((size_t)l * TS + (t - TP)) * 256 : out + O_PKV + ((size_t)l * TP + t) * 256) + lane * 8;
            *(f32x4*)okv = (f32x4){kv[0], kv[1], kv[2], kv[3]}; *(f32x4*)(okv + 4) = (f32x4){kv[4], kv[5], kv[6], kv[7]};
            *(u32x4*)(p->ckv + (size_t)t * 256 + lane * 8) = pack8(kv); } }
    conv_load(B, p, H, l, tbase, iseq0, smp, sq, lane, 1);
    conv_compute(A, p, out, l, tbase, iseq0, smp, sq, lane, 0);
    conv_load(A, p, H, l, tbase, iseq0, smp, sq, lane, 2);
    float kx1[2], kx2[2]; float2 kcs[2];
#pragma unroll
    for (int ps = 0; ps < 2; ++ps) { const int e = (lane >> 4) + 4 * ps, j = lane & 15; const bf16_t* h = H + (size_t)(tbase + e) * IN_WP;
        kx1[ps] = bf2f(h[C_KR + j]); kx2[ps] = bf2f(h[C_KR + 16 + j]); kcs[ps] = p->tab[((smp ? SEQ : 0) + iseq0 + e) * 16 + j]; }
    const int tc = tbase + (lane >> 3), hd = lane & 7;
    const float ba0 = p->BA[(size_t)tc * 16 + hd], ba1 = p->BA[(size_t)tc * 16 + 8 + hd], dtb = p->dt_bias[l * 8 + hd], alg = p->a_log[l * 8 + hd];
    conv_compute(B, p, out, l, tbase, iseq0, smp, sq, lane, 1);
    conv_compute(A, p, out, l, tbase, iseq0, smp, sq, lane, 2);
#pragma unroll
    for (int ps = 0; ps < 2; ++ps) { const int e = (lane >> 4) + 4 * ps, j = lane & 15, t = tbase + e; const float x1 = kx1[ps], x2 = kx2[ps]; const float2 cs = kcs[ps];
        const float o1 = x1 * cs.x - x2 * cs.y, o2 = x2 * cs.x + x1 * cs.y; float* okr = smp ? out + O_SKR + ((size_t)l * TS + (t - TP)) * 32 : out + O_PKR + ((size_t)l * TP + t) * 32;
        okr[j] = o1; okr[16 + j] = o2; p->Kr[(size_t)t * 32 + j] = f2bf(o1); p->Kr[(size_t)t * 32 + 16 + j] = f2bf(o2); }
    { const float bb = sigmoidf_(ba0); const float x = ba1 + dtb;
      const float sp = x > 20.f ? x : log1pf(expf(x)); const float gg = -expf(alg) * sp;
      p->bg[(size_t)tc * 16 + hd] = bb; p->bg[(size_t)tc * 16 + 8 + hd] = gg; }
}
template <bool SMP> __device__ __forceinline__ void tok_tile(KP p, int l, int tile, LAS unsigned char* lds) {
    {
        int tid = threadIdx.x; asm volatile("" : "+v"(tid)); const int pmask = p->pad;
        const int lane = tid & 63, wave = __builtin_amdgcn_readfirstlane(tid >> 6), r = lane & 31, hh = lane >> 5;
        const bf16_t* __restrict__ H = p->H; float* __restrict__ out = p->out;
        const bool smp = SMP; const int s0 = smp ? (tile - TP / 64) * 4 : 0;
        const int t0 = smp ? TP + s0 * 8 : tile * 64, i0 = smp ? 0 : (t0 & (SEQ - 1)), b = t0 >> 11;
        TP_DECL; TP_ON(50); TP_ON(51); TP_ON(52); TP_ON(55);
        __syncthreads();
        if (!smp) {
            u32x4 v[10];
#pragma unroll
            for (int i = 0; i < 10; ++i) { const int c = tid + NTHR * i, row = c >> 6, ch16 = c & 63; v[i] = (u32x4){0u, 0u, 0u, 0u};
                if (c < 79 * 64 && i0 - 15 + row >= 0) v[i] = *(const u32x4*)(H + (size_t)(t0 - 15 + row) * IN_WP + C_POOL + ch16 * 8); }
#pragma unroll
            for (int i = 0; i < 10; ++i) { const int c = tid + NTHR * i, row = c >> 6, ch16 = c & 63; if (c < 79 * 64) *(LAS u32x4*)(lds + row * TK_RS + ch16 * 16) = v[i]; }
        } else {
            int tq = tid; asm volatile("" : "+v"(tq));
            f32x4 va[12], vb[12];
#pragma unroll
            for (int i = 0; i < 12; ++i) { const int c = tq + NTHR * i, row = c >> 6, ch16 = c & 63, sq = row / 23, j = row - sq * 23; va[i] = (f32x4){0.f, 0.f, 0.f, 0.f}; vb[i] = va[i];
                if (c < 92 * 64) {
                    if (j >= 15) { const u32x4 v = *(const u32x4*)(H + (size_t)(t0 + sq * 8 + (j - 15)) * IN_WP + C_POOL + ch16 * 8); va[i] = __builtin_bit_cast(f32x4, v); }
                    else { const float* sp = p->state_pool + (((size_t)l * DEC_BATCH + s0 + sq) * 15 + j) * 512 + ch16 * 8; va[i] = *(const f32x4*)sp; vb[i] = *(const f32x4*)(sp + 4); } } }
#pragma unroll
            for (int i = 0; i < 12; ++i) { const int c = tq + NTHR * i, row = c >> 6, ch16 = c & 63, sq = row / 23, j = row - sq * 23;
                if (c < 92 * 64) { u32x4 v = __builtin_bit_cast(u32x4, va[i]);
                    if (j < 15) { const f32x4 a = va[i], bq = vb[i];
                        v.x = pg8::cvt_pk_bf16(a[0], a[1]); v.y = pg8::cvt_pk_bf16(a[2], a[3]); v.z = pg8::cvt_pk_bf16(bq[0], bq[1]); v.w = pg8::cvt_pk_bf16(bq[2], bq[3]);
                        if (j >= 8) { float* so = out + O_SPOOL + (((size_t)l * DEC_BATCH + s0 + sq) * 15 + (j - 8)) * 512 + ch16 * 8; *(f32x4*)so = a; *(f32x4*)(so + 4) = bq; } }
                    *(LAS u32x4*)(lds + row * TK_RS + ch16 * 16) = v; } }
        }
        __syncthreads();
        if (smp) TP_OFF(52); else TP_OFF(55);
        if (smp) TP_ON(53); else TP_ON(56);
        if (smp && (wave & 1) && (pmask & 16384)) tok8(p, l, t0 + (wave >> 1) * 8, 0, true, s0 + (wave >> 1), lane);
        if ((pmask & 8192) && !(smp && (wave & 1))) { const int g = wave >> 1, th = wave & 1, w = 2 << g, tk = 32 * th + r;
          const int brow = smp ? (tk >> 3) * 23 + 15 + (tk & 7) : 15 + tk; const float inv = 1.0f / (float)(smp ? w : min(i0 + tk + 1, w));
          const bf16_t* mixT = p->PmixT + ((size_t)l * 4 + g) * 128 * 128;
          f32x16 acc[4];
#pragma unroll
          for (int nt = 0; nt < 4; ++nt)
#pragma unroll
              for (int e = 0; e < 16; ++e) acc[nt][e] = 0.f;
          const size_t t = (size_t)t0 + tk; const float* scl = p->pool_scale + l * 512 + 128 * g;
          u32x2 zv[16];
#pragma unroll
          for (int nt = 0; nt < 4; ++nt)
#pragma unroll
              for (int gg = 0; gg < 4; ++gg) { const int dd0 = 32 * nt + 8 * gg + 4 * hh; zv[4 * nt + gg] = *(const u32x2*)(H + t * IN_WP + C_ZPOOL + 128 * g + dd0); }
#pragma unroll 2
          for (int ks = 0; ks < 8; ++ks) {
              const LAS unsigned char* base = lds + brow * TK_RS + (128 * g + 16 * ks + 8 * hh) * 2;
              float cur[8], sum[8]; unpack8(*(const LAS u32x4*)base, cur);
#pragma unroll
              for (int e = 0; e < 8; ++e) sum[e] = cur[e];
              for (int k = 1; k < w; ++k) { float x[8]; unpack8(*(const LAS u32x4*)(base - k * TK_RS), x);
#pragma unroll
                  for (int e = 0; e < 8; ++e) sum[e] += x[e]; }
#pragma unroll
              for (int e = 0; e < 8; ++e) sum[e] = sum[e] * inv - cur[e];
              union { u32x4 u; bf16x8_t v; } bfr; bfr.u = pack8(sum);
#pragma unroll
              for (int nt = 0; nt < 4; ++nt) { const bf16x8_t a = *(const bf16x8_t*)(mixT + (size_t)(32 * nt + r) * 128 + 16 * ks + 8 * hh);
                  acc[nt] = __builtin_amdgcn_mfma_f32_32x32x16_bf16(a, bfr.v, acc[nt], 0, 0, 0); } }
          f32x4 scv[16];
#pragma unroll
          for (int nt = 0; nt < 4; ++nt)
#pragma unroll
              for (int gg = 0; gg < 4; ++gg) scv[4 * nt + gg] = *(const f32x4*)(scl + 32 * nt + 8 * gg + 4 * hh);
#pragma unroll
          for (int nt = 0; nt < 4; ++nt)
#pragma unroll
              for (int gg = 0; gg < 4; ++gg) { const int dd0 = 32 * nt + 8 * gg + 4 * hh; const u32x2 z = zv[4 * nt + gg]; const f32x4 sc = scv[4 * nt + gg];
                  float v0 = acc[nt][4 * gg + 0] * sc[0] * __uint_as_float(z.x << 16), v1 = acc[nt][4 * gg + 1] * sc[1] * __uint_as_float(z.x & 0xffff0000u);
                  float v2 = acc[nt][4 * gg + 2] * sc[2] * __uint_as_float(z.y << 16), v3 = acc[nt][4 * gg + 3] * sc[3] * __uint_as_float(z.y & 0xffff0000u);
                  u32x2 o; o.x = pg8::cvt_pk_bf16(v0, v1); o.y = pg8::cvt_pk_bf16(v2, v3); *(u32x2*)(p->ya + t * 1536 + 128 * g + dd0) = o; } }
        if (!smp) { if (i0 == SEQ - 64) { for (int c = tid; c < 15 * 512; c += NTHR) { const int rr = c >> 9, ch = c & 511;
              out[O_PPOOL + (((size_t)l * 8 + b) * 15 + rr) * 512 + ch] = bf2f(*(const LAS bf16_t*)(lds + (15 + 49 + rr) * TK_RS + ch * 2)); } } }
        else { for (int c = tid; c < 4 * 8 * 512; c += NTHR) { const int sq = c >> 12, i = (c >> 9) & 7, ch = c & 511;
              out[O_SPOOL + (((size_t)l * DEC_BATCH + s0 + sq) * 15 + 7 + i) * 512 + ch] = bf2f(*(const LAS bf16_t*)(lds + (sq * 23 + 15 + i) * TK_RS + ch * 2)); } }
        if (smp) TP_OFF(53); else TP_OFF(56);
        if (smp) TP_ON(54); else TP_ON(57);
        if ((pmask & 16384) && !smp) tok8(p, l, t0 + wave * 8, i0 + wave * 8, false, 0, lane);
        if (smp) { TP_OFF(51); TP_OFF(54); } else { TP_OFF(50); TP_OFF(57); }
    }
}
__device__ __forceinline__ void ph_tok(KP p, int l, LAS unsigned char* lds) {
    for (int tile = blockIdx.x; tile < TP / 64; tile += gridDim.x) tok_tile<false>(p, l, tile, lds);
    __syncthreads();
}

template <bool SYNC> __device__ __forceinline__ void wu_delta(KP p, int l, int s, int h, int lane, LAS unsigned char* wl) {
    asm volatile("" : "+v"(lane)); int dv = lane;
    const size_t row0 = (size_t)TP + s * 8;
    float* so = p->out + O_SDELTA + (((size_t)l * DEC_BATCH + s) * 8 + h) * 4096;
    const float* s0 = p->state_delta + (((size_t)l * DEC_BATCH + s) * 8 + h) * 4096;
    { const size_t t = row0 + (lane >> 3); const int part = lane & 7;
      const u32x4 kv = *(const u32x4*)(p->kd + t * 512 + h * 64 + part * 8), qv = *(const u32x4*)(p->qd + t * 512 + h * 64 + part * 8);
      *(LAS u32x4*)(wl + lane * 16) = kv; *(LAS u32x4*)(wl + 1024 + lane * 16) = qv; }
    float vv[8], zz[8];
#pragma unroll
    for (int i = 0; i < 8; ++i) { vv[i] = bf2f(p->vd[(row0 + i) * 512 + h * 64 + dv]); zz[i] = bf2f(p->H[(row0 + i) * IN_WP + C_ZDN + h * 64 + dv]); }
    float bl = 0.f, al = 0.f;
    if (lane < 8) { bl = p->bg[(row0 + lane) * 16 + h]; al = __expf(p->bg[(row0 + lane) * 16 + 8 + h]); }
    float S[64];
#pragma unroll
    for (int k = 0; k < 64; ++k) S[k] = s0[k * 64 + dv];
    const float gn = p->dn_norm_g[l * 64 + dv];
    if (SYNC) __builtin_amdgcn_s_barrier();
#pragma unroll
    for (int i = 0; i < 8; ++i) {
        asm volatile("" ::: "memory");
        const float b = __int_as_float(__builtin_amdgcn_readlane(__float_as_int(bl), i)), a = __int_as_float(__builtin_amdgcn_readlane(__float_as_int(al), i));
        u32x4 kk[8];
#pragma unroll
        for (int c = 0; c < 8; ++c) kk[c] = *(const LAS u32x4*)(wl + i * 128 + c * 16);
        float ks = 0.f;
#pragma unroll
        for (int c = 0; c < 8; ++c)
#pragma unroll
            for (int e = 0; e < 4; ++e) { const unsigned w = kk[c][e]; ks += __uint_as_float(w << 16) * S[c * 8 + 2 * e] + __uint_as_float(w & 0xffff0000u) * S[c * 8 + 2 * e + 1]; }
        const float vn = b * (vv[i] - a * ks); float o = 0.f;
#pragma unroll
        for (int c = 0; c < 8; ++c) { const u32x4 qv = *(const LAS u32x4*)(wl + 1024 + i * 128 + c * 16);
#pragma unroll
            for (int e = 0; e < 4; ++e) { const unsigned w = kk[c][e], wq = qv[e]; const int k0 = c * 8 + 2 * e;
                S[k0] = a * S[k0] + __uint_as_float(w << 16) * vn; o += __uint_as_float(wq << 16) * S[k0];
                S[k0 + 1] = a * S[k0 + 1] + __uint_as_float(w & 0xffff0000u) * vn; o += __uint_as_float(wq & 0xffff0000u) * S[k0 + 1]; }
            asm volatile("" ::: "memory"); }
        const float ss = wave_sum(o * o); const float y = o * rsqrtf(ss * (1.0f / 64.0f) + EPS) * gn;
        p->yc[(row0 + i) * 1536 + h * 64 + dv] = f2bf(y * zz[i]);
        if (SYNC) {
#pragma unroll
            for (int k = 0; k < 8; ++k) __builtin_amdgcn_s_barrier(); }
    }
#pragma unroll
    for (int k = 0; k < 64; ++k) so[k * 64 + dv] = S[k];
}
__device__ __forceinline__ int sig_inv(int rho) { return (rho & 32) | ((rho & 12) << 1) | ((rho & 16) >> 2) | (rho & 3); }
constexpr int DPRE_LDS = 64 * 64 * 4 + 512;
constexpr int DST = 72;
__device__ __forceinline__ void dpre_flush(const LAS bf16_t* St, bf16_t* gdst, int lane) {
    asm volatile("s_waitcnt lgkmcnt(0)" ::: "memory");
#pragma unroll
    for (int it = 0; it < 8; ++it) { const int row = 16 * (it >> 1) + (lane & 15), chunk = 4 * (it & 1) + (lane >> 4); *(u32x4*)(gdst + (it * 64 + lane) * 8) = *(const LAS u32x4*)(St + row * DST + chunk * 8); }
    asm volatile("s_waitcnt lgkmcnt(0)" ::: "memory");
}
__device__ __forceinline__ void ph_delta_pre(KP p, LAS unsigned char* lds) {
    int tid_o = threadIdx.x; asm volatile("" : "+v"(tid_o)); int lane = tid_o & 63, wave = tid_o >> 6;
    wave = __builtin_amdgcn_readfirstlane(wave);
    LAS float* Am = (LAS float*)(lds + wave * DPRE_LDS); LAS float* gcs = Am + 4096; LAS float* bts = gcs + 64; LAS bf16_t* St = (LAS bf16_t*)Am;
    for (int unit = wave * gridDim.x + blockIdx.x; unit < 2048; unit += gridDim.x * 8) {
        { int t_ = threadIdx.x; asm volatile("" : "+v"(t_)); lane = t_ & 63; }
        const int r = lane & 31, hh = lane >> 5;
        const int bh = unit >> 5, ch = unit & 31, b = bh >> 3, h = bh & 7;
        const size_t t0 = (size_t)b * SEQ + ch * 64;
        bf16_t* op = p->DOP + (size_t)unit * 4 * 4096; float* up = p->DU + (size_t)unit * 4096;
        const bf16_t* kdb = p->kd + t0 * 512 + h * 64; const bf16_t* qdb = p->qd + t0 * 512 + h * 64; const bf16_t* vdb = p->vd + t0 * 512 + h * 64;
        const float* bgb = p->bg + t0 * 16 + h;
        const float beta = bgb[lane * 16]; float gc = bgb[lane * 16 + 8];
#pragma unroll
        for (int d = 1; d < 64; d <<= 1) { const float x = __shfl_up(gc, d); if (lane >= d) gc += x; }
        const float gl = __shfl(gc, 63); const float egc = __expf(gc);
        gcs[lane] = gc; bts[lane] = beta;
        if (lane == 0) p->DG[unit] = __expf(gl);
        bf16x8_t kf[2][4], qf[2][4];
        { const int voff = r * 512 + 8 * hh;
#pragma unroll
          for (int rb = 0; rb < 2; ++rb)
#pragma unroll
            for (int ks = 0; ks < 4; ++ks) { kf[rb][ks] = *(const bf16x8_t*)(kdb + (32 * rb * 512 + 16 * ks) + voff); qf[rb][ks] = *(const bf16x8_t*)(qdb + (32 * rb * 512 + 16 * ks) + voff); } }
        {
#pragma unroll
            for (int rb = 0; rb < 2; ++rb) { const float sc = __expf(gl - __shfl(gc, 32 * rb + r)); const int pos = sig_inv(32 * rb + r);
#pragma unroll
                for (int ks = 0; ks < 4; ++ks)
#pragma unroll
                    for (int jj = 0; jj < 8; ++jj) St[(16 * ks + 8 * hh + jj) * DST + pos] = f2bf(bf2f((bf16_t)kf[rb][ks][jj]) * sc); }
            dpre_flush(St, op + 3 * 4096, lane);
#pragma unroll
            for (int rb = 0; rb < 2; ++rb) { const float sc = __shfl(egc, 32 * rb + r);
#pragma unroll
                for (int ks = 0; ks < 4; ++ks)
#pragma unroll
                    for (int jj = 0; jj < 8; ++jj) St[(32 * rb + r) * DST + sig_inv(16 * ks + 8 * hh + jj)] = f2bf(bf2f((bf16_t)qf[rb][ks][jj]) * sc); }
            dpre_flush(St, op + 1 * 4096, lane);
        }
        float xu[64];
        {
#pragma unroll
            for (int it = 0; it < 8; ++it) { const int row = (lane >> 3) + 8 * it, chunk = lane & 7; *(LAS u32x4*)(St + row * DST + chunk * 8) = *(const u32x4*)(vdb + row * 512 + chunk * 8); }
            asm volatile("s_waitcnt lgkmcnt(0)" ::: "memory");
            const int beta_i = __float_as_int(beta);
#pragma unroll
            for (int i = 0; i < 64; ++i) xu[i] = __int_as_float(__builtin_amdgcn_readlane(beta_i, i)) * bf2f(St[i * DST + lane]);
            asm volatile("s_waitcnt lgkmcnt(0)" ::: "memory");
        }
        {
            const float gcj0 = __shfl(gc, r), gcj1 = __shfl(gc, 32 + r);
            const int p0 = sig_inv(r), p1 = sig_inv(32 + r);
            { f32x16 t00, t10, t11;
#pragma unroll
              for (int e = 0; e < 16; ++e) { t00[e] = 0.f; t10[e] = 0.f; t11[e] = 0.f; }
#pragma unroll
              for (int ks = 0; ks < 4; ++ks) {
                  t00 = __builtin_amdgcn_mfma_f32_32x32x16_bf16(qf[0][ks], kf[0][ks], t00, 0, 0, 0);
                  t10 = __builtin_amdgcn_mfma_f32_32x32x16_bf16(qf[1][ks], kf[0][ks], t10, 0, 0, 0);
                  t11 = __builtin_amdgcn_mfma_f32_32x32x16_bf16(qf[1][ks], kf[1][ks], t11, 0, 0, 0); }
#pragma unroll
              for (int e = 0; e < 16; ++e) { const int il = (e & 3) + 8 * (e >> 2) + 4 * hh;
                  { const int i = il, j = r; St[i * DST + p0] = f2bf(j <= i ? t00[e] * __expf(fminf(gcs[i] - gcj0, 0.f)) : 0.f); St[i * DST + p1] = 0; }
                  { const int i = 32 + il; St[i * DST + p0] = f2bf(t10[e] * __expf(fminf(gcs[i] - gcj0, 0.f))); }
                  { const int i = 32 + il, j = 32 + r; St[i * DST + p1] = f2bf(j <= i ? t11[e] * __expf(fminf(gcs[i] - gcj1, 0.f)) : 0.f); } }
              dpre_flush(St, op + 2 * 4096, lane); }
            { f32x16 t00, t10, t11;
#pragma unroll
              for (int e = 0; e < 16; ++e) { t00[e] = 0.f; t10[e] = 0.f; t11[e] = 0.f; }
#pragma unroll
              for (int ks = 0; ks < 4; ++ks) {
                  t00 = __builtin_amdgcn_mfma_f32_32x32x16_bf16(kf[0][ks], kf[0][ks], t00, 0, 0, 0);
                  t10 = __builtin_amdgcn_mfma_f32_32x32x16_bf16(kf[1][ks], kf[0][ks], t10, 0, 0, 0);
                  t11 = __builtin_amdgcn_mfma_f32_32x32x16_bf16(kf[1][ks], kf[1][ks], t11, 0, 0, 0); }
#pragma unroll
              for (int e = 0; e < 16; ++e) { const int il = (e & 3) + 8 * (e >> 2) + 4 * hh;
                  { const int i = il, j = r; Am[i * 64 + j] = j < i ? bts[i] * t00[e] * __expf(fminf(gcs[i] - gcj0, 0.f)) : 0.f; }
                  { const int i = 32 + il, j = r; Am[i * 64 + j] = bts[i] * t10[e] * __expf(fminf(gcs[i] - gcj0, 0.f)); }
                  { const int i = 32 + il, j = 32 + r; Am[i * 64 + j] = j < i ? bts[i] * t11[e] * __expf(fminf(gcs[i] - gcj1, 0.f)) : 0.f; } } }
        }
        asm volatile("s_waitcnt lgkmcnt(0)" ::: "memory");
        {
            int c; { int t_ = threadIdx.x; asm volatile("" : "+v"(t_)); c = t_ & 63; } const int pc = sig_inv(c);
            const int beta_i = __float_as_int(beta), egc_i = __float_as_int(egc);
#pragma unroll
            for (int i = 1; i < 64; ++i) { float au = xu[i];
#pragma unroll
                for (int j4 = 0; j4 < i; j4 += 4) { const f32x4 a = *(const LAS f32x4*)(Am + i * 64 + j4);
#pragma unroll
                    for (int e = 0; e < 4; ++e) if (j4 + e < i) au -= a[e] * xu[j4 + e]; }
                xu[i] = au; }
#pragma unroll
            for (int k = 0; k < 16; ++k)
                *(f32x4*)(up + ((((c >> 4) * 4 + (k >> 2)) * 64 + (k & 3) * 16 + (c & 15)) << 2)) = (f32x4){xu[4 * k], xu[4 * k + 1], xu[4 * k + 2], xu[4 * k + 3]};
            asm volatile("" ::: "memory");
            { float w[64];
#pragma unroll
              for (int i = 0; i < 64; ++i) w[i] = __int_as_float(__builtin_amdgcn_readlane(beta_i, i)) * __int_as_float(__builtin_amdgcn_readlane(egc_i, i)) * bf2f((kdb + i * 512)[c]);
#pragma unroll
              for (int i = 1; i < 64; ++i) { float aw = w[i];
#pragma unroll
                  for (int j4 = 0; j4 < i; j4 += 4) { const f32x4 a = *(const LAS f32x4*)(Am + i * 64 + j4);
#pragma unroll
                      for (int e = 0; e < 4; ++e) if (j4 + e < i) aw -= a[e] * w[j4 + e]; }
                  w[i] = aw; }
              asm volatile("s_waitcnt lgkmcnt(0)" ::: "memory");
#pragma unroll
              for (int i = 0; i < 64; ++i) St[i * DST + pc] = f2bf(-w[i]); }
            dpre_flush(St, op, lane);
        }
    }
}
__device__ __forceinline__ void st_rows2(bf16_t* row0, bf16_t* row1, unsigned pos, float a, float b, bool even) {
    const float x = even ? b : a;
    const float y = __int_as_float(__builtin_amdgcn_mov_dpp(__float_as_int(x), 0xB1, 0xF, 0xF, true));
    const unsigned w = even ? pg8::cvt_pk_bf16(a, y) : pg8::cvt_pk_bf16(y, b);
    bf16_t* dst = even ? row0 + pos : row1 + (pos - 1u);
    *(unsigned*)dst = w;
}
constexpr int BSS = 144, BS_NBAR = 65;
struct BsSet { bf16x8_t w0, w1, g0, g1, k0, k1, t0, t1; f32x4 u; };
__device__ __forceinline__ void bs_load(BsSet& c, const bf16_t* op, const float* up) {
    c.w0 = *(const bf16x8_t*)(op); c.w1 = *(const bf16x8_t*)(op + 512); c.g0 = *(const bf16x8_t*)(op + 4096); c.g1 = *(const bf16x8_t*)(op + 4096 + 512);
    c.k0 = *(const bf16x8_t*)(op + 8192); c.k1 = *(const bf16x8_t*)(op + 8192 + 512); c.t0 = *(const bf16x8_t*)(op + 12288); c.t1 = *(const bf16x8_t*)(op + 12288 + 512);
    c.u = *(const f32x4*)up;
}
__device__ __forceinline__ u32x2 pack_h(const f32x4& v) { u32x2 w; w.x = pg8::cvt_pk_bf16(v[0], v[1]); w.y = pg8::cvt_pk_bf16(v[2], v[3]); return w; }
__device__ __forceinline__ void bs_step(BsSet& c, f32x4& S, float eg, LAS unsigned char* SB, LAS unsigned char* VB, int rd, int wr, bool hik, bf16_t* yo, unsigned n, bool even, const bf16_t* opn, const float* upn) {
    TP_DECL; TP_ON(30);
    const bf16x8_t sb0 = *(const LAS bf16x8_t*)(SB + rd), sb1 = *(const LAS bf16x8_t*)(SB + rd + 64);
    f32x4 vn = __builtin_amdgcn_mfma_f32_16x16x32_bf16(c.w0, sb0, c.u, 0, 0, 0); vn = __builtin_amdgcn_mfma_f32_16x16x32_bf16(c.w1, sb1, vn, 0, 0, 0);
    f32x4 o = __builtin_amdgcn_mfma_f32_16x16x32_bf16(c.g0, sb0, (f32x4){0.f, 0.f, 0.f, 0.f}, 0, 0, 0); o = __builtin_amdgcn_mfma_f32_16x16x32_bf16(c.g1, sb1, o, 0, 0, 0);
    *(LAS u32x2*)(VB + wr) = pack_h(vn);
    TP_ON(36); __syncthreads();
    TP_OFFW(36, 0); TP_OFFW(30, 0); TP_ON(31);
    const bf16x8_t vb0 = *(const LAS bf16x8_t*)(VB + rd), vb1 = *(const LAS bf16x8_t*)(VB + rd + 64);
    o = __builtin_amdgcn_mfma_f32_16x16x32_bf16(c.k0, vb0, o, 0, 0, 0);
    if (hik) o = __builtin_amdgcn_mfma_f32_16x16x32_bf16(c.k1, vb1, o, 0, 0, 0);
    S = S * eg;
    S = __builtin_amdgcn_mfma_f32_16x16x32_bf16(c.t0, vb0, S, 0, 0, 0); S = __builtin_amdgcn_mfma_f32_16x16x32_bf16(c.t1, vb1, S, 0, 0, 0);
    *(LAS u32x2*)(SB + wr) = pack_h(S);
    TP_OFFW(31, 0); TP_ON(33);
    bs_load(c, opn, upn);
    TP_OFFW(33, 0); TP_ON(34);
#pragma unroll
    for (int e = 0; e < 4; e += 2) st_rows2(yo + (size_t)e * 1536, yo + (size_t)(e + 1) * 1536, n, o[e], o[e + 1], even);
    TP_OFFW(34, 0); TP_ON(35);
    __syncthreads();
    TP_OFFW(35, 0);
}
__device__ __forceinline__ void slice_scan(KP p, int l, int unit, LAS unsigned char* lds, int lane, int mt) {
    asm volatile("" : "+v"(lane));
    const int n = lane & 15, q = lane >> 4, bh = unit >> 2, slice = unit & 3, b = bh >> 3, h = bh & 7;
    LAS unsigned char* SB = lds; LAS unsigned char* VB = lds + 16 * BSS;
    const int pos0 = ((mt & 2) << 4) + 8 * q + ((mt & 1) << 2);
    const int wr = n * BSS + pos0 * 2, rd = n * BSS + 16 * q;
    const bf16_t* op0 = p->DOP + (size_t)bh * 32 * 4 * 4096 + mt * 1024 + lane * 8;
    const float* up0 = p->DU + (size_t)bh * 32 * 4096 + ((slice * 4 + mt) * 64 + lane) * 4;
    const float egv = p->DG[bh * 32 + (lane & 31)];
    bf16_t* yo0 = p->yc + ((size_t)b * SEQ + 16 * mt + 4 * q) * 1536 + h * 64 + 16 * slice;
    __builtin_amdgcn_s_waitcnt(0);
    BsSet st[4];
#pragma unroll
    for (int i = 0; i < 4; ++i) bs_load(st[i], op0 + (size_t)i * 16384, up0 + (size_t)i * 4096);
    f32x4 S = (f32x4){0.f, 0.f, 0.f, 0.f};
    { unsigned z = 0u; asm volatile("" : "+v"(z)); *(LAS u32x2*)(SB + wr) = (u32x2){z, z}; }
    __syncthreads();
    const bool hik = mt >= 2, even = (lane & 1) == 0;
#pragma unroll 1
    for (int ch = 0; ch < 32; ch += 4) {
#pragma unroll
        for (int i = 0; i < 4; ++i) { const int cn = ch + i + 4 < 32 ? ch + i + 4 : 31;
            const float eg = __int_as_float(__builtin_amdgcn_readlane(__float_as_int(egv), ch + i));
            bs_step(st[i], S, eg, SB, VB, rd, wr, hik, yo0 + (size_t)(ch + i) * 64 * 1536, (unsigned)n, even, op0 + (size_t)cn * 16384, up0 + (size_t)cn * 4096); }
    }
    float* so = p->out + O_PDELTA + (((size_t)l * 8 + b) * 8 + h) * 4096 + (16 * mt + 4 * q) * 64 + 16 * slice + n;
#pragma unroll
    for (int e = 0; e < 4; ++e) so[e * 64] = S[e];
}
__device__ __forceinline__ void ph_delta_fin(KP p, int l) {
    int tid_o = threadIdx.x; asm volatile("" : "+v"(tid_o)); int lane = tid_o & 63, wave = tid_o >> 6;
    const int h = lane >> 3, d0 = (lane & 7) * 8;
    const int stride = gridDim.x * 8;
    float gn[8];
#pragma unroll
    for (int e = 0; e < 8; ++e) gn[e] = p->dn_norm_g[l * 64 + d0 + e];
    for (int t0 = blockIdx.x * 8 + wave; t0 < TP; t0 += 4 * stride) {
        u32x4 rawv[4], gzv[4];
#pragma unroll
        for (int j = 0; j < 4; ++j) { const int t = t0 + j * stride < TP ? t0 + j * stride : t0; rawv[j] = *(const u32x4*)(p->yc + (size_t)t * 1536 + h * 64 + d0); gzv[j] = *(const u32x4*)(p->H + (size_t)t * IN_WP + C_ZDN + h * 64 + d0); }
#pragma unroll
        for (int j = 0; j < 4; ++j) { const int t = t0 + j * stride; if (t >= TP) break;
            float v[8], z[8]; unpack8(rawv[j], v); unpack8(gzv[j], z);
            float ss = 0.f;
#pragma unroll
            for (int e = 0; e < 8; ++e) ss += v[e] * v[e];
            ss += __shfl_xor(ss, 1); ss += __shfl_xor(ss, 2); ss += __shfl_xor(ss, 4);
            const float rs = rsqrtf(ss * (1.0f / 64.0f) + EPS);
#pragma unroll
            for (int e = 0; e < 8; ++e) v[e] = v[e] * rs * gn[e] * z[e];
            *(u32x4*)(p->yc + (size_t)t * 1536 + h * 64 + d0) = pack8(v); }
    }
}

__device__ __forceinline__ void ph_att_waves(KP p, int l, LAS unsigned char* lds) {
    int tid_o = threadIdx.x; asm volatile("" : "+v"(tid_o)); int lane = tid_o & 63, wave = tid_o >> 6;
    wave = __builtin_amdgcn_readfirstlane(wave);
    const int G = gridDim.x;
    TP_DECL; TP_ON(20); TP_ON(22);
    for (int ub = blockIdx.x; ub < 256; ub += G) { const int u = ((ub & 7) << 5) | (ub >> 3);
        if (wave < 4) slice_scan(p, l, u, lds, lane, wave);
#if defined(TPROBE) && TPROBE == 22
        else if (wave == 4) { for (int k = 0; k < BS_NBAR; ++k) __builtin_amdgcn_s_barrier(); wu_delta<false>(p, l, u >> 3, u & 7, lane, lds + 32768); }
#else
        else if (wave == 4) wu_delta<true>(p, l, u >> 3, u & 7, lane, lds + 32768);
#endif
        else { for (int k = 0; k < BS_NBAR; ++k) __builtin_amdgcn_s_barrier(); }
    }
    if (wave == 0) { TP_OFFW(20, 0); TP_OFFW(22, 0); }
}
__device__ __forceinline__ void ph_fin(KP p, int l, LAS unsigned char* lds) {
    int tid_o = threadIdx.x; asm volatile("" : "+v"(tid_o)); int lane = tid_o & 63, wave = tid_o >> 6;
    LAS float* ol = (LAS float*)(lds + wave * 1024);
    const float* w_uv = p->w_uv + (size_t)l * 256 * 512;
    const int cq = lane >> 4, d4 = lane & 15;
    for (int u = blockIdx.x * 8 + wave; u < TS * 8; u += gridDim.x * 8) {
        const int ts = u >> 3, h = u & 7, s = ts >> 3, r = (ts & 7) * 8 + h;
        const float* pb = p->part + ((size_t)s * SA_CH * 64 + r) * 258;
        float mc = -1e30f, lc = 0.f;
        if (lane < SA_CH) { mc = pb[(size_t)lane * 64 * 258 + 256]; lc = pb[(size_t)lane * 64 * 258 + 257]; }
        float M = mc;
#pragma unroll
        for (int o = 1; o < 8; o <<= 1) M = fmaxf(M, __shfl_xor(M, o));
        const float wc = lane < SA_CH ? __expf(mc - M) : 0.f; float L = lc * wc;
#pragma unroll
        for (int o = 1; o < 8; o <<= 1) L += __shfl_xor(L, o);
        const float iL = 1.0f / __int_as_float(__builtin_amdgcn_readlane(__float_as_int(L), 0));
        f32x4 acc = (f32x4){0.f, 0.f, 0.f, 0.f};
#pragma unroll
        for (int ch = 0; ch < SA_CH; ++ch) { const float w = __int_as_float(__builtin_amdgcn_readlane(__float_as_int(wc), ch)); const float* pp = pb + (size_t)ch * 64 * 258 + 4 * lane;
            const f32x2 a0 = *(const f32x2*)pp, a1 = *(const f32x2*)(pp + 2); acc[0] += w * a0[0]; acc[1] += w * a0[1]; acc[2] += w * a1[0]; acc[3] += w * a1[1]; }
        *(LAS f32x4*)(ol + 4 * lane) = acc * iL;
        asm volatile("s_waitcnt lgkmcnt(0)" ::: "memory");
        f32x4 o = (f32x4){0.f, 0.f, 0.f, 0.f}; const float* wp = w_uv + (size_t)(cq * 64) * 512 + h * 64 + 4 * d4;
#pragma unroll 16
        for (int c = 0; c < 64; ++c) { const f32x4 wv = *(const f32x4*)(wp + (size_t)c * 512); const float x = ol[cq * 64 + c]; o += wv * x; }
#pragma unroll
        for (int e = 0; e < 4; ++e) { o[e] += __shfl_xor(o[e], 16); o[e] += __shfl_xor(o[e], 32); }
        if (cq == 0) { const int t = TP + ts; const u32x2 gz = *(const u32x2*)(p->H + (size_t)t * IN_WP + C_ZMLA + h * 64 + 4 * d4);
            u32x2 w; w.x = pg8::cvt_pk_bf16(o[0] * __uint_as_float(gz.x << 16), o[1] * __uint_as_float(gz.x & 0xffff0000u)); w.y = pg8::cvt_pk_bf16(o[2] * __uint_as_float(gz.y << 16), o[3] * __uint_as_float(gz.y & 0xffff0000u));
            *(u32x2*)(p->yb + (size_t)t * 1536 + h * 64 + 4 * d4) = w; }
        asm volatile("s_waitcnt lgkmcnt(0)" ::: "memory");
    }
}

constexpr int SA_QS = 592, SA_KS = 592, SA_PS = 272;
constexpr int SA_OFF_Q = 0, SA_OFF_K = 64 * SA_QS, SA_OFF_P = SA_OFF_K + 128 * SA_KS, SA_OFF_M = SA_OFF_P + 64 * SA_PS, SA_OFF_L = SA_OFF_M + 1024, SA_LDS = SA_OFF_L + 1024;
typedef short s16x4 __attribute__((ext_vector_type(4)));
__device__ __forceinline__ void sa_unit(KP p, int l, int s, int ch, LAS unsigned char* lds, int tid) {
    const int lane = tid & 63, wave = __builtin_amdgcn_readfirstlane(tid >> 6), r = lane & 31, hh = lane >> 5;
    const int qb = wave & 1, kb = wave >> 1, cg = wave >> 1;
    LAS unsigned char* Qs = lds + SA_OFF_Q; LAS unsigned char* Kt = lds + SA_OFF_K; LAS unsigned char* Pt = lds + SA_OFF_P;
    LAS float* mloc = (LAS float*)(lds + SA_OFF_M); LAS float* lred = (LAS float*)(lds + SA_OFF_L);
    TP_DECL; TP_ON(10); TP_ON(11);
    __syncthreads();
    { const bf16_t* wb = p->WukB + (size_t)l * 256 * 512 + (size_t)r * 512 + wave * 64 + 8 * hh; const bf16_t* Qg = p->Q + (size_t)(TP + s * 8) * 768;
      bf16x8_t qv[4];
#pragma unroll
      for (int ks = 0; ks < 4; ++ks) { u32x4 z = (u32x4){0u, 0u, 0u, 0u}; if (r < 8) z = *(const u32x4*)(Qg + r * 768 + wave * 96 + ks * 16 + 8 * hh); union { u32x4 u; bf16x8_t v; } x; x.u = z; qv[ks] = x.v; }
#pragma unroll
      for (int cb = 0; cb < 8; ++cb) { f32x16 acc;
#pragma unroll
          for (int e = 0; e < 16; ++e) acc[e] = 0.f;
#pragma unroll
          for (int ks = 0; ks < 4; ++ks) acc = __builtin_amdgcn_mfma_f32_32x32x16_bf16(*(const bf16x8_t*)(wb + (size_t)(32 * cb) * 512 + ks * 16), qv[ks], acc, 0, 0, 0);
          if (r < 8) {
#pragma unroll
              for (int g4 = 0; g4 < 4; ++g4) { u32x2 w; w.x = pg8::cvt_pk_bf16(acc[4 * g4], acc[4 * g4 + 1]); w.y = pg8::cvt_pk_bf16(acc[4 * g4 + 2], acc[4 * g4 + 3]);
                  *(LAS u32x2*)(Qs + (r * 8 + wave) * SA_QS + (32 * cb + 8 * g4 + 4 * hh) * 2) = w; } } }
      for (int e = tid; e < 64 * 32; e += NTHR) { const int rr = e >> 5, j = e & 31; *(LAS bf16_t*)(Qs + rr * SA_QS + (256 + j) * 2) = Qg[(rr >> 3) * 768 + (rr & 7) * 96 + 64 + j]; } }
    TP_OFF(11);
    const int* pt = p->page_table + s * N_PAGES + ch * 16;
    const float* ckv_base = p->cache_kv + (size_t)l * N_POOL * PAGE * 256; const float* ckr_base = p->cache_kr + (size_t)l * N_POOL * PAGE * 32;
    f32x4 rk[16], rr2[2];
    { const int page = pt[0]; const float* kvp = ckv_base + (size_t)page * PAGE * 256; const float* krp = ckr_base + (size_t)page * PAGE * 32;
#pragma unroll
      for (int i = 0; i < 16; ++i) rk[i] = __builtin_nontemporal_load((const f32x4*)(kvp + (size_t)(tid + 512 * i) * 4));
#pragma unroll
      for (int i = 0; i < 2; ++i) rr2[i] = __builtin_nontemporal_load((const f32x4*)(krp + (size_t)(tid + 512 * i) * 4)); }
    f32x16 o0, o1;
#pragma unroll
    for (int e = 0; e < 16; ++e) { o0[e] = 0.f; o1[e] = 0.f; }
    float m = -1e30f, lw = 0.f;
    const int li = lane & 15, g1 = (lane >> 4) & 1;
    const int trOff = (8 * hh + (li >> 2)) * SA_KS + (16 * g1 + 4 * (li & 3)) * 2;
    const int ntile = ch == 7 ? 17 : 16;
    for (int t = 0; t < ntile; ++t) {
        TP_ON(12); TP_ON(16);
        __syncthreads();
        TP_OFF(16);
        if (t < 16) {
#pragma unroll
            for (int i = 0; i < 16; ++i) { const int ci = tid + 512 * i, key = ci >> 6, c4 = ci & 63; u32x2 w; w.x = pg8::cvt_pk_bf16(rk[i][0], rk[i][1]); w.y = pg8::cvt_pk_bf16(rk[i][2], rk[i][3]);
                *(LAS u32x2*)(Kt + key * SA_KS + c4 * 8) = w; }
#pragma unroll
            for (int i = 0; i < 2; ++i) { const int ci = tid + 512 * i, key = ci >> 3, c4 = ci & 7; u32x2 w; w.x = pg8::cvt_pk_bf16(rr2[i][0], rr2[i][1]); w.y = pg8::cvt_pk_bf16(rr2[i][2], rr2[i][3]);
                *(LAS u32x2*)(Kt + key * SA_KS + 512 + c4 * 8) = w; }
        } else {
            for (int e = tid; e < 128 * 36; e += NTHR) { const int key = e / 36, c16 = e - key * 36; u32x4 v = (u32x4){0u, 0u, 0u, 0u};
                if (key < 8) v = c16 < 32 ? *(const u32x4*)(p->ckv + ((size_t)TP + s * 8 + key) * 256 + c16 * 8) : *(const u32x4*)(p->Kr + ((size_t)TP + s * 8 + key) * 32 + (c16 - 32) * 8);
                *(LAS u32x4*)(Kt + key * SA_KS + c16 * 16) = v; }
        }
        TP_ON(17); __syncthreads(); TP_OFF(17);
        TP_OFF(12); TP_ON(13);
        if (t + 1 < 16) { const int page = pt[t + 1]; const float* kvp = ckv_base + (size_t)page * PAGE * 256; const float* krp = ckr_base + (size_t)page * PAGE * 32;
#pragma unroll
            for (int i = 0; i < 16; ++i) rk[i] = __builtin_nontemporal_load((const f32x4*)(kvp + (size_t)(tid + 512 * i) * 4));
#pragma unroll
            for (int i = 0; i < 2; ++i) rr2[i] = __builtin_nontemporal_load((const f32x4*)(krp + (size_t)(tid + 512 * i) * 4)); }
        f32x16 sa;
#pragma unroll
        for (int e = 0; e < 16; ++e) sa[e] = 0.f;
        { const LAS unsigned char* ka = Kt + (32 * kb + r) * SA_KS + 16 * hh; const LAS unsigned char* qa = Qs + (32 * qb + r) * SA_QS + 16 * hh;
#pragma unroll
          for (int ks = 0; ks < 18; ++ks) sa = __builtin_amdgcn_mfma_f32_32x32x16_bf16(*(const LAS bf16x8_t*)(ka + ks * 32), *(const LAS bf16x8_t*)(qa + ks * 32), sa, 0, 0, 0); }
        if (t == 16) { const int itok = (32 * qb + r) >> 3;
#pragma unroll
            for (int e = 0; e < 16; ++e) { const int key = 32 * kb + (e & 3) + 8 * (e >> 2) + 4 * hh; if (key > itok) sa[e] = -1e30f; } }
        float tm = sa[0];
#pragma unroll
        for (int e = 1; e < 16; ++e) tm = fmaxf(tm, sa[e]);
        tm = fmaxf(tm, __shfl_xor(tm, 32));
        if (hh == 0) mloc[kb * 64 + 32 * qb + r] = tm;
        __syncthreads();
        TP_OFF(13); TP_ON(14);
        { const int q = 32 * qb + r; const float tmx = fmaxf(fmaxf(mloc[q], mloc[64 + q]), fmaxf(mloc[128 + q], mloc[192 + q]));
          const float mn = fmaxf(m, tmx), al = __builtin_amdgcn_exp2f((m - mn) * ATT_C), mc = mn * ATT_C; m = mn;
          float ps = 0.f;
#pragma unroll
          for (int e = 0; e < 16; ++e) { sa[e] = __builtin_amdgcn_exp2f(sa[e] * ATT_C - mc); ps += sa[e]; }
          lw = lw * al + ps;
#pragma unroll
          for (int g4 = 0; g4 < 4; ++g4) { u32x2 w; w.x = pg8::cvt_pk_bf16(sa[4 * g4], sa[4 * g4 + 1]); w.y = pg8::cvt_pk_bf16(sa[4 * g4 + 2], sa[4 * g4 + 3]);
              *(LAS u32x2*)(Pt + q * SA_PS + (32 * kb + 8 * g4 + 4 * hh) * 2) = w; }
#pragma unroll
          for (int e = 0; e < 16; ++e) { o0[e] *= al; o1[e] *= al; } }
        __syncthreads();
        TP_OFF(14); TP_ON(15);
        { const LAS unsigned char* pa = Pt + (32 * qb + r) * SA_PS + 16 * hh; const LAS unsigned char* va = Kt + trOff + (64 * cg) * 2;
#pragma unroll
          for (int ks = 0; ks < 8; ++ks) { const bf16x8_t pb = *(const LAS bf16x8_t*)(pa + ks * 32);
              union { struct { s16x4 lo, hi; } h; bf16x8_t v; } a0, a1;
              a0.h.lo = __builtin_amdgcn_ds_read_tr16_b64_v4i16((LAS s16x4*)(va + ks * 16 * SA_KS)); a0.h.hi = __builtin_amdgcn_ds_read_tr16_b64_v4i16((LAS s16x4*)(va + ks * 16 * SA_KS + 4 * SA_KS));
              a1.h.lo = __builtin_amdgcn_ds_read_tr16_b64_v4i16((LAS s16x4*)(va + ks * 16 * SA_KS + 64)); a1.h.hi = __builtin_amdgcn_ds_read_tr16_b64_v4i16((LAS s16x4*)(va + ks * 16 * SA_KS + 4 * SA_KS + 64));
              o0 = __builtin_amdgcn_mfma_f32_32x32x16_bf16(a0.v, pb, o0, 0, 0, 0);
              o1 = __builtin_amdgcn_mfma_f32_32x32x16_bf16(a1.v, pb, o1, 0, 0, 0); } }
        TP_OFF(15);
    }
    lw += __shfl_xor(lw, 32);
    if (hh == 0) lred[kb * 64 + 32 * qb + r] = lw;
    __syncthreads();
    { const int q = 32 * qb + r; float* pp = p->part + (((size_t)s * SA_CH + ch) * 64 + q) * 258;
#pragma unroll
      for (int cb2 = 0; cb2 < 2; ++cb2)
#pragma unroll
          for (int g4 = 0; g4 < 4; ++g4) { const int c = 32 * (2 * cg + cb2) + 8 * g4 + 4 * hh; f32x4 v;
#pragma unroll
              for (int e = 0; e < 4; ++e) v[e] = cb2 == 0 ? o0[4 * g4 + e] : o1[4 * g4 + e];
              *(f32x2*)(pp + c) = (f32x2){v[0], v[1]}; *(f32x2*)(pp + c + 2) = (f32x2){v[2], v[3]}; }
      if (cg == 0 && hh == 0) { pp[256] = m * MLA_SCALE; pp[257] = lred[q] + lred[64 + q] + lred[128 + q] + lred[192 + q]; } }
    TP_OFF(10);
}
__device__ __forceinline__ void ph_attn_s2(KP p, int l, LAS unsigned char* lds) {
    int tid = threadIdx.x; asm volatile("" : "+v"(tid));
    for (int u = blockIdx.x; u < DEC_BATCH * 8; u += gridDim.x) sa_unit(p, l, u >> 3, u & 7, lds, tid);
    __syncthreads();
}

constexpr int ATT_KS = 208, ATT_VS = 144, ATT_KB = 64 * ATT_KS, ATT_VB = 64 * ATT_VS, ATT_STAGE = ATT_KB + ATT_VB;
__device__ __forceinline__ void attn_unit(KP p, int b, int h, int qblk, LAS unsigned char* lds, int tid, int wave, int lane) {
    const int r = lane & 31, hh = lane >> 5;
    const int q0 = qblk * 256 + wave * 32;
    __builtin_amdgcn_s_waitcnt(0);
    const size_t trow0 = (size_t)b * SEQ;
    bf16x8_t qf[6];
    { const bf16_t* qp = p->Q + (trow0 + q0 + r) * 768 + h * 96 + 8 * hh;
#pragma unroll
      for (int ks = 0; ks < 6; ++ks) qf[ks] = *(const bf16x8_t*)(qp + 16 * ks); }
    f32x16 o0, o1;
#pragma unroll
    for (int e = 0; e < 16; ++e) { o0[e] = 0.f; o1[e] = 0.f; }
    float m = -1e30f, lsum = 0.f;
    const int ntile = qblk * 4 + 4;
    const int cA = tid, keyA = cA / 12, partA = cA - keyA * 12; const int cB = 512 + (tid & 255), keyB = cB / 12, partB = cB - keyB * 12; const bool hasB = tid < 256;
    const bf16_t* gA = partA < 8 ? p->Kn + (trow0 + keyA) * 512 + h * 64 + partA * 8 : p->Kr + (trow0 + keyA) * 32 + (partA - 8) * 8; const int stepA = partA < 8 ? 64 * 512 : 64 * 32;
    const bf16_t* gB = !hasB ? gA : partB < 8 ? p->Kn + (trow0 + keyB) * 512 + h * 64 + partB * 8 : p->Kr + (trow0 + keyB) * 32 + (partB - 8) * 8; const int stepB = !hasB ? stepA : partB < 8 ? 64 * 512 : 64 * 32;
    const bf16_t* gV = p->Vt + (size_t)(h * 64 + (tid >> 3)) * TP + trow0 + (tid & 7) * 8;
    const int lA = keyA * ATT_KS + partA * 16, lB = hasB ? keyB * ATT_KS + partB * 16 : (tid & 63) * ATT_KS + 192, lV = ATT_KB + (tid >> 3) * ATT_VS + (tid & 7) * 16;
    const int pr_ = (r & 0x13) | ((r & 4) << 1) | ((r & 8) >> 1);
    const int kOff = pr_ * ATT_KS + 16 * hh, vOff = ATT_KB + r * ATT_VS + 16 * hh;
#define ATT_COMPUTE() do { \
        if (kt * 64 <= q0 + 31) { \
            f32x16 s0, s1; TP_ON(2); \
_Pragma("unroll") \
            for (int e = 0; e < 16; ++e) { s0[e] = 0.f; s1[e] = 0.f; } \
_Pragma("unroll") \
            for (int ks = 0; ks < 6; ++ks) { \
                const bf16x8_t a0 = *(const LAS bf16x8_t*)(st + kOff + ks * 32), a1 = *(const LAS bf16x8_t*)(st + kOff + 32 * ATT_KS + ks * 32); \
                s0 = __builtin_amdgcn_mfma_f32_32x32x16_bf16(a0, qf[ks], s0, 0, 0, 0); \
                s1 = __builtin_amdgcn_mfma_f32_32x32x16_bf16(a1, qf[ks], s1, 0, 0, 0); \
            } \
            TP_OFF(2); TP_ON(3); if (kt * 64 + 63 > q0) { \
                const int qrel = q0 + r - kt * 64; \
_Pragma("unroll") \
                for (int e = 0; e < 16; ++e) { const int kl = (e & 3) + 4 * ((e >> 2) & 1) + 8 * hh + 16 * ((e >> 3) & 1); \
                    if (kl > qrel) s0[e] = -1e30f; if (kl + 32 > qrel) s1[e] = -1e30f; } \
            } \
            float tm = fmaxf(s0[0], s1[0]); \
_Pragma("unroll") \
            for (int e = 1; e < 16; ++e) tm = fmaxf(tm, fmaxf(s0[e], s1[e])); \
            tm = fmaxf(tm, __shfl_xor(tm, 32)); \
            const float mn = fmaxf(m, tm), al = __builtin_amdgcn_exp2f((m - mn) * ATT_C), mc = mn * ATT_C; m = mn; \
            float ps = 0.f; \
_Pragma("unroll") \
            for (int e = 0; e < 16; ++e) { s0[e] = __builtin_amdgcn_exp2f(s0[e] * ATT_C - mc); s1[e] = __builtin_amdgcn_exp2f(s1[e] * ATT_C - mc); ps += s0[e] + s1[e]; } \
            lsum = lsum * al + ps; \
_Pragma("unroll") \
            for (int e = 0; e < 16; ++e) { o0[e] *= al; o1[e] *= al; } \
            TP_OFF(3); TP_ON(4); \
_Pragma("unroll") \
            for (int kb = 0; kb < 2; ++kb) \
_Pragma("unroll") \
                for (int sp = 0; sp < 2; ++sp) { \
                    union { u32x4 u; bf16x8_t v; } pb; \
                    if (kb == 0) { pb.u.x = pg8::cvt_pk_bf16(s0[8 * sp + 0], s0[8 * sp + 1]); pb.u.y = pg8::cvt_pk_bf16(s0[8 * sp + 2], s0[8 * sp + 3]); pb.u.z = pg8::cvt_pk_bf16(s0[8 * sp + 4], s0[8 * sp + 5]); pb.u.w = pg8::cvt_pk_bf16(s0[8 * sp + 6], s0[8 * sp + 7]); } \
                    else         { pb.u.x = pg8::cvt_pk_bf16(s1[8 * sp + 0], s1[8 * sp + 1]); pb.u.y = pg8::cvt_pk_bf16(s1[8 * sp + 2], s1[8 * sp + 3]); pb.u.z = pg8::cvt_pk_bf16(s1[8 * sp + 4], s1[8 * sp + 5]); pb.u.w = pg8::cvt_pk_bf16(s1[8 * sp + 6], s1[8 * sp + 7]); } \
                    const int ko = (32 * kb + 16 * sp) * 2; \
                    const bf16x8_t v0 = *(const LAS bf16x8_t*)(st + vOff + ko), v1 = *(const LAS bf16x8_t*)(st + vOff + 32 * ATT_VS + ko); \
                    o0 = __builtin_amdgcn_mfma_f32_32x32x16_bf16(v0, pb.v, o0, 0, 0, 0); \
                    o1 = __builtin_amdgcn_mfma_f32_32x32x16_bf16(v1, pb.v, o1, 0, 0, 0); \
                } \
            TP_OFF(4); \
        } \
    } while (0)
    u32x4 rA = *(const u32x4*)gA, rB = *(const u32x4*)gB, rV = *(const u32x4*)gV;
    gA += stepA; gB += stepB; gV += 64;
    __builtin_amdgcn_sched_barrier(0);
    u32x4 sA = *(const u32x4*)gA, sB = *(const u32x4*)gB, sV = *(const u32x4*)gV;
    __builtin_amdgcn_sched_barrier(0);
#define ATT_TILE(RA, RB, RV) do { \
        LAS unsigned char* st = lds + (kt & 1) * ATT_STAGE; TP_ON(1); \
        *(LAS u32x4*)(st + lA) = RA; *(LAS u32x4*)(st + lB) = RB; *(LAS u32x4*)(st + lV) = RV; \
        __syncthreads(); \
        { const int adv = kt + 2 < ntile ? 1 : 0; gA += adv * stepA; gB += adv * stepB; gV += adv * 64; RA = *(const u32x4*)gA; RB = *(const u32x4*)gB; RV = *(const u32x4*)gV; } \
        TP_OFF(1); ATT_COMPUTE(); } while (0)
    TP_DECL; TP_ON(5);
    for (int kt = 0; kt < ntile; kt += 2) { ATT_TILE(rA, rB, rV); ++kt; ATT_TILE(sA, sB, sV); --kt; }
    TP_OFF(5);
#undef ATT_TILE
#undef ATT_COMPUTE
    TP_COMMIT(lds);
    lsum += __shfl_xor(lsum, 32);
    const float il = 1.0f / lsum;
    const size_t t = trow0 + q0 + r;
    u32x2 gzv[2][4];
#pragma unroll
    for (int db = 0; db < 2; ++db)
#pragma unroll
        for (int g = 0; g < 4; ++g) gzv[db][g] = *(const u32x2*)(p->H + t * IN_WP + C_ZMLA + h * 64 + 32 * db + 8 * g + 4 * hh);
#pragma unroll
    for (int db = 0; db < 2; ++db)
#pragma unroll
        for (int g = 0; g < 4; ++g) { const int d0 = 32 * db + 8 * g + 4 * hh;
            const u32x2 gz = gzv[db][g];
            float v[4];
#pragma unroll
            for (int e = 0; e < 4; ++e) v[e] = (db == 0 ? o0[4 * g + e] : o1[4 * g + e]) * il;
            v[0] *= __uint_as_float(gz.x << 16); v[1] *= __uint_as_float(gz.x & 0xffff0000u); v[2] *= __uint_as_float(gz.y << 16); v[3] *= __uint_as_float(gz.y & 0xffff0000u);
            u32x2 w; w.x = pg8::cvt_pk_bf16(v[0], v[1]); w.y = pg8::cvt_pk_bf16(v[2], v[3]);
            *(u32x2*)(p->yb + t * 1536 + h * 64 + d0) = w; }
}
__device__ __forceinline__ void ph_attn_p(KP p, LAS unsigned char* lds) {
    int tid = threadIdx.x; asm volatile("" : "+v"(tid));
    const int lane = tid & 63, wave = __builtin_amdgcn_readfirstlane(tid >> 6);
    for (int pi = blockIdx.x; pi < 256; pi += gridDim.x) {
        const int xcd = pi & 7, k = pi >> 3, bh = xcd * 8 + (k >> 2), pr = k & 3;
#pragma unroll 1
        for (int uu = 0; uu < 2; ++uu) attn_unit(p, bh >> 3, bh & 7, uu == 0 ? 7 - pr : pr, lds, tid, wave, lane);
    }
    __syncthreads();
}
struct MEpiVt { static constexpr bool PERM = true, AFTER_DRAIN = false; static constexpr int SEG = 0; bf16_t* O; int ldc; int pad_;
    __device__ __forceinline__ void operator()(const f32x4 (&acc)[2][2][4][2], const pg8::Unit& u, int wr, int wc, int fr0, int fq0) const {
        int fr = fr0, fq = fq0; asm volatile("" : "+v"(fr), "+v"(fq));
        const int row0 = u.pm * 256 + wr * 64 + fr;
#pragma unroll
        for (int bj = 0; bj < 2; ++bj) { const int col0 = u.pn * 256 + bj * 128 + wc * 32 + 8 * fq;
#pragma unroll
            for (int ai = 0; ai < 2; ++ai)
#pragma unroll
                for (int m = 0; m < 4; ++m) { const int row = row0 + ai * 128 + m * 16; const f32x4 v0 = acc[ai][bj][m][0], v1 = acc[ai][bj][m][1];
                    u32x4 w; w.x = pg8::cvt_pk_bf16(v0[0], v0[1]); w.y = pg8::cvt_pk_bf16(v0[2], v0[3]); w.z = pg8::cvt_pk_bf16(v1[0], v1[1]); w.w = pg8::cvt_pk_bf16(v1[2], v1[3]);
                    *(u32x4*)(O + (size_t)row * ldc + col0) = w; } }
    } };


__global__ void __launch_bounds__(NTHR, 2) k_mega(Params p_unused) {
    const KP kp0 = (KP)__builtin_amdgcn_kernarg_segment_ptr();
#define PP() ({ KP q_ = kp0; asm volatile("" : "+s"(q_)); q_; })
    KP p = PP();
    extern __shared__ __attribute__((aligned(16))) unsigned char lds_raw[];
    LAS unsigned char* lds = (LAS unsigned char*)lds_raw;
    volatile LAS unsigned* misc = (volatile LAS unsigned*)(lds + LDS_MISC);
    for (int u = threadIdx.x; u < 64; u += NTHR) misc[u] = 0u;
    __syncthreads();
    const int lo = p->ph_lo, hi = p->ph_hi;
    XcdBarrier bar; bar.bar = p->bar + p->li * XCD_BAR_WORDS; bar.x = 0; bar.st = nullptr;
    if (hi - lo > 1) bar = xcd_barrier_post(p->bar + p->li * XCD_BAR_WORDS, misc + 8);
#define IN(k) (lo <= (k) && (k) < hi)
#define SEAM(k) do { if (IN(k) && IN((k) + 1)) xcd_barrier(bar); } while (0)

    if (IN(PH_PRO)) {
        LAS float* tile = (LAS float*)lds;
        for (int l = 0; l < 2; ++l) {
            KP p = PP();
            ph_tr(p->w_in + (size_t)l * 1024 * IN_W, p->WinT + (size_t)l * IN_WP * 1024, 1024, IN_W, IN_WP, tile, 0);
            ph_tr(p->w_uq + (size_t)l * 384 * 768, p->WuqT + (size_t)l * 768 * 384, 384, 768, 768, tile, 0);
            ph_tr(p->w_uk + (size_t)l * 256 * 512, p->WkvT + (size_t)l * 1024 * 256, 256, 512, 512, tile, 144);
            ph_tr(p->w_uv + (size_t)l * 256 * 512, p->WkvT + (size_t)l * 1024 * 256 + (size_t)512 * 256, 256, 512, 512, tile, 208);
            ph_tr(p->w_br0 + (size_t)l * 512 * 1024, p->WbrT + (size_t)l * 1024 * 1536 + 0 * 512, 512, 1024, 1024, tile, 0, 1536);
            ph_tr(p->w_br1 + (size_t)l * 512 * 1024, p->WbrT + (size_t)l * 1024 * 1536 + 1 * 512, 512, 1024, 1024, tile, 0, 1536);
            ph_tr(p->w_br2 + (size_t)l * 512 * 1024, p->WbrT + (size_t)l * 1024 * 1536 + 2 * 512, 512, 1024, 1024, tile, 0, 1536);
            ph_tr(p->w_out + (size_t)l * 1024 * 1024, p->WoutT + (size_t)l * 1024 * 1024, 1024, 1024, 1024, tile, 0);
            for (int g = 0; g < 4; ++g) ph_tr(p->pool_mix + ((size_t)l * 4 + g) * 128 * 128, p->PmixT + ((size_t)l * 4 + g) * 128 * 128, 128, 128, 128, tile, 64 + 8 * g);
        }
        { KP p = PP(); const float* src = p->w_uk; bf16_t* dst = p->WukB;
          for (int i = (blockIdx.x * NTHR + threadIdx.x) * 8; i < 2 * 256 * 512; i += gridDim.x * NTHR * 8) { const f32x4 a = *(const f32x4*)(src + i), b = *(const f32x4*)(src + i + 4);
              u32x4 w; w.x = pg8::cvt_pk_bf16(a[0], a[1]); w.y = pg8::cvt_pk_bf16(a[2], a[3]); w.z = pg8::cvt_pk_bf16(b[0], b[1]); w.w = pg8::cvt_pk_bf16(b[2], b[3]); *(u32x4*)(dst + i) = w; } }
#if defined(TPROBE) && TPROBE == 40
        { KP p = PP(); int t_ = threadIdx.x; asm volatile("" : "+v"(t_)); if (t_ == 0) __hip_atomic_store(p->bar + 12 * XCD_BAR_WORDS + blockIdx.x, xb_xcc_id() + 1u, __ATOMIC_RELAXED, __HIP_MEMORY_SCOPE_AGENT); }
#endif
        { KP p = PP(); ph_rope_tab(p->tab); ph_rmsnorm(p->x_prompt, p->x_sample, p->norm_g, p->xn, nullptr, nullptr); }
    }
    SEAM(PH_PRO);
    for (int l = 0; l < 2; ++l) {
        int G = gridDim.x, bid = blockIdx.x; asm volatile("" : "+s"(G), "+s"(bid));
        if (IN(PHID(l, PH_GIN))) { KP p = PP();
            unsigned* cnt = p->bar + 12 * XCD_BAR_WORDS + 512 + l * 64;
            pg8::Gemm g{p->xn, p->WinT + (size_t)l * IN_WP * 1024, TT, IN_WP, 1024, 0}; pg8::GinOrder S; S.init(TT, IN_WP, G, bid); S.cnt = cnt;
            MEpiH E{p->H, p->BA}; pg8::gemm_phase<MEpiH, pg8::GinOrder, false>(lds, g, S, E, nullptr);
            for (int j = 0; j < 8; ++j) if ((G - 1 - j % G + G) % G == bid) { KP p = PP();
                __syncthreads();
                { int t_ = threadIdx.x; asm volatile("" : "+v"(t_)); if (t_ == 0) { unsigned* bb = p->bar + p->li * XCD_BAR_WORDS; XB_SPIN(xb_ld(cnt) < (unsigned)(IN_WP / 256 * 8), bb); } }
                __syncthreads();
                __builtin_amdgcn_fence(__ATOMIC_ACQUIRE, "agent"); asm volatile("s_waitcnt vmcnt(0)" ::: "memory");
                __syncthreads();
                tok_tile<true>(PP(), l, TP / 64 + j, lds); }
        }
        SEAM(PHID(l, PH_GIN));
        if (IN(PHID(l, PH_TOK))) ph_tok(PP(), l, lds);
        SEAM(PHID(l, PH_TOK));
        if (IN(PHID(l, PH_GQ)) && (PP()->pad & 16)) { KP p = PP();
            pg8::Gemm g{p->cq, p->WuqT + (size_t)l * 768 * 384, TT, 768, 384, 0}; pg8::StaticOrder S; S.init(TT, 768, G, bid);
            MEpiQ E{p->Q, p->tab}; pg8::gemm_phase<MEpiQ, pg8::StaticOrder, false>(lds, g, S, E, nullptr);
        }
        if (IN(PHID(l, PH_GQ)) && (PP()->pad & 32)) { KP p = PP();
            pg8::Gemm g{p->ckv, p->WkvT + (size_t)l * 1024 * 256, TP, 512, 256, 0}; pg8::StaticOrder S; S.init(TP, 512, G / 2, bid < G / 2 ? bid : G);
            MEpiKV E{p->Kn, p->V}; pg8::gemm_phase<MEpiKV, pg8::StaticOrder, false>(lds, g, S, E, nullptr);
        }
        if (IN(PHID(l, PH_GQ)) && (PP()->pad & 32)) { KP p = PP();
            pg8::Gemm g{p->WkvT + (size_t)l * 1024 * 256 + (size_t)512 * 256, p->ckv, 512, TP, 256, 0}; pg8::StaticOrder S; S.init(512, TP, G / 2, bid >= G / 2 ? bid - G / 2 : G);
            MEpiVt E{p->Vt, TP, 0}; pg8::gemm_phase<MEpiVt, pg8::StaticOrder, false>(lds, g, S, E, nullptr);
        }
        if (IN(PHID(l, PH_GQ)) && (PP()->pad & 64)) ph_delta_pre(PP(), lds);
        SEAM(PHID(l, PH_GQ));
        if (IN(PHID(l, PH_ATT))) { const int am = PP()->pad;
            if (am & 1) ph_attn_s2(PP(), l, lds); if (am & 4) ph_attn_p(PP(), lds); if (am & 8) ph_att_waves(PP(), l, lds); }
        SEAM(PHID(l, PH_ATT));
        if (IN(PHID(l, PH_FIN))) { const int fm = PP()->pad; if (fm & 128) ph_fin(PP(), l, lds); if (fm & 256) ph_delta_fin(PP(), l); }
        SEAM(PHID(l, PH_FIN));
        if (IN(PHID(l, PH_MERGE)) && (PP()->pad & 512)) { KP p = PP();
            pg8::Gemm g{p->ya, p->WbrT + (size_t)l * 1024 * 1536, TP, 1024, 512, 1536}; pg8::SegOrder<3> S; S.init(TP, 1024, G, bid);
            MEpiMergeS E{p->H, p->mb}; pg8::gemm_phase<MEpiMergeS, pg8::SegOrder<3>, false>(lds, g, S, E, nullptr);
        }
        if (IN(PHID(l, PH_MERGE)) && (PP()->pad & 1024)) { KP p = PP(); TEpiMerge E{p->H, p->mb}; tail_gemm<3, TEpiMerge>(p->ya + (size_t)TP * 1536, 1536, p->WbrT + (size_t)l * 1024 * 1536, 1536, 1024, E, lds); }
        SEAM(PHID(l, PH_MERGE));
        if (IN(PHID(l, PH_OUT)) && (PP()->pad & 2048)) { KP p = PP();
            const float* xp = l == 0 ? p->x_prompt : p->xres; const float* xs = l == 0 ? p->x_sample : p->xres + (size_t)TP * 1024;
            pg8::Gemm g{p->mb, p->WoutT + (size_t)l * 1024 * 1024, TP, 1024, 1024, 0}; pg8::StaticOrder S; S.init(TP, 1024, G, bid);
            MEpiRes E{xp, xs, p->xres}; pg8::gemm_phase<MEpiRes, pg8::StaticOrder, false>(lds, g, S, E, nullptr);
        }
        if (IN(PHID(l, PH_OUT)) && (PP()->pad & 4096)) { KP p = PP(); TEpiRes E{l == 0 ? p->x_sample : p->xres + (size_t)TP * 1024, p->xres}; tail_gemm<1, TEpiRes>(p->mb + (size_t)TP * 1024, 1024, p->WoutT + (size_t)l * 1024 * 1024, 1024, 1024, E, lds); }
        SEAM(PHID(l, PH_OUT));
        if (IN(PHID(l, PH_NORM))) { KP p = PP();
            if (l == 0) ph_rmsnorm(p->xres, p->xres + (size_t)TP * 1024, p->norm_g + 1024, p->xn, nullptr, nullptr);
            else ph_rmsnorm(p->xres, p->xres + (size_t)TP * 1024, p->final_norm_g, nullptr, p->out + O_YP, p->out + O_YS);
        }
        SEAM(PHID(l, PH_NORM));
    }
#if defined(TPROBE)
    { int te_ = threadIdx.x; asm volatile("" : "+v"(te_)); if (blockIdx.x == 0 && te_ == 0 && PP()->ph_lo == 0) { unsigned long long w = (unsigned long long)*(volatile LAS unsigned*)(lds + LDS_MISC + 128) * 8ull; const unsigned long long t0 = __builtin_amdgcn_s_memrealtime();
#if TPROBE == 40
        { unsigned* xt = PP()->bar + 12 * XCD_BAR_WORDS; unsigned m = 0; for (int b = 0; b < 256; ++b) m += (xb_ld(xt + b) == xb_ld(xt + (b & 7)) && xb_ld(xt + b) != 0u) ? 1u : 0u; w += (unsigned long long)m * 100ull; }
#endif
        while (__builtin_amdgcn_s_memrealtime() - t0 < w) __builtin_amdgcn_s_sleep(8); } }
#endif
#undef IN
#undef SEAM
}

static inline size_t al256(size_t x) { return (x + 255) & ~(size_t)255; }
extern "C" void kernel_launch(void* const* d_in, const int* in_sizes, int n_in, void* d_out, int out_size, void* d_ws, size_t ws_size, hipStream_t stream) {
    static int grid = 0;
    if (grid == 0) {
        int dev = 0, cus = 0; (void)hipGetDevice(&dev); (void)hipDeviceGetAttribute(&cus, hipDeviceAttributeMultiprocessorCount, dev);
        (void)hipFuncSetAttribute((const void*)k_mega, hipFuncAttributeMaxDynamicSharedMemorySize, LDS_BYTES);
        int per_cu = 0; (void)hipOccupancyMaxActiveBlocksPerMultiprocessor(&per_cu, (const void*)k_mega, NTHR, LDS_BYTES); (void)hipGetLastError();
        grid = cus > 0 ? cus : 256;
    }
    Params p{};
    p.x_prompt = (const float*)d_in[0]; p.x_sample = (const float*)d_in[1]; p.cache_kv = (const float*)d_in[2]; p.cache_kr = (const float*)d_in[3];
    p.state_pool = (const float*)d_in[4]; p.state_conv = (const float*)d_in[5]; p.state_delta = (const float*)d_in[6]; p.page_table = (const int*)d_in[7];
    p.norm_g = (const float*)d_in[8]; p.w_in = (const float*)d_in[9]; p.pool_mix = (const float*)d_in[10]; p.pool_scale = (const float*)d_in[11];
    p.q_norm_g = (const float*)d_in[12]; p.w_uq = (const float*)d_in[13]; p.kv_norm_g = (const float*)d_in[14]; p.w_uk = (const float*)d_in[15];
    p.w_uv = (const float*)d_in[16]; p.conv_w = (const float*)d_in[17]; p.a_log = (const float*)d_in[18]; p.dt_bias = (const float*)d_in[19];
    p.dn_norm_g = (const float*)d_in[20]; p.w_br0 = (const float*)d_in[21]; p.w_br1 = (const float*)d_in[22]; p.w_br2 = (const float*)d_in[23];
    p.w_out = (const float*)d_in[24]; p.final_norm_g = (const float*)d_in[25];
    p.out = (float*)d_out;
    char* w = (char*)d_ws; size_t off = 0;
    auto take = [&](size_t bytes) { char* q = w + off; off += al256(bytes); return q; };
    const size_t BAR_BYTES = (size_t)16 * XCD_BAR_WORDS * 4;
    p.bar = (unsigned*)take(BAR_BYTES);
    p.WinT = (bf16_t*)take((size_t)2 * IN_WP * 1024 * 2);
    p.WuqT = (bf16_t*)take((size_t)2 * 768 * 384 * 2);
    p.WkvT = (bf16_t*)take((size_t)2 * 1024 * 256 * 2);
    p.WbrT = (bf16_t*)take((size_t)2 * 3 * 1024 * 512 * 2);
    p.WoutT = (bf16_t*)take((size_t)2 * 1024 * 1024 * 2);
    p.PmixT = (bf16_t*)take((size_t)2 * 4 * 128 * 128 * 2);
    p.WukB = (bf16_t*)take((size_t)2 * 256 * 512 * 2);
    p.tab = (float2*)take((size_t)(SEQ + DEC_SEQ) * 16 * 8);
    p.xres = (float*)take((size_t)TT * 1024 * 4);
    p.xn = (bf16_t*)take((size_t)TT * 1024 * 2);
    p.H = (bf16_t*)take((size_t)TT * IN_WP * 2);
    p.BA = (float*)take((size_t)TT * 16 * 4);
    p.cq = (bf16_t*)take((size_t)TT * 384 * 2);
    p.ckv = (bf16_t*)take((size_t)TT * 256 * 2);
    p.Kr = (bf16_t*)take((size_t)TT * 32 * 2);
    p.Q = (bf16_t*)take((size_t)TT * 768 * 2);
    bf16_t* Qlat = (bf16_t*)take((size_t)TS * 8 * 288 * 2);
    p.Kn = (bf16_t*)take((size_t)TP * 512 * 2);
    p.V = (bf16_t*)take((size_t)TP * 512 * 2);
    p.Vt = (bf16_t*)take((size_t)512 * TP * 2);
    p.qd = (bf16_t*)take((size_t)TT * 512 * 2);
    p.kd = (bf16_t*)take((size_t)TT * 512 * 2);
    p.vd = (bf16_t*)take((size_t)TT * 512 * 2);
    p.bg = (float*)take((size_t)TT * 16 * 4);
    p.ya = (bf16_t*)take((size_t)TT * 1536 * 2); p.yb = p.ya + 512; p.yc = p.ya + 1024;
    p.mf = (float*)take((size_t)TT * 1024 * 4);
    p.mb = (bf16_t*)take((size_t)TT * 1024 * 2);
    p.part = (float*)take((size_t)DEC_BATCH * SA_CH * 64 * 258 * 4);
    p.DOP = (bf16_t*)take((size_t)2048 * 4 * 4096 * 2);
    p.DU = (float*)take((size_t)2048 * 4096 * 4);
    p.DG = (float*)take((size_t)2048 * 4);

    (void)hipMemsetAsync(p.bar, 0, BAR_BYTES, stream);
    p.ph_lo = 0; p.ph_hi = PH_END; p.li = 0; p.pad = 0x7fff;
    hipLaunchKernelGGL(k_mega, dim3(grid), dim3(NTHR), LDS_BYTES, stream, p);
#if defined(PROBE_REP) && PROBE_REP > 0
    for (int i = 0; i < PROBE_REP; ++i) { Params q = p; q.ph_lo = PROBE_LO; q.ph_hi = PROBE_HI; q.li = 1 + i; q.pad = PROBE_MASK; hipLaunchKernelGGL(k_mega, dim3(grid), dim3(NTHR), LDS_BYTES, stream, q); }
#endif
}
```

```cpp
#include <hip/hip_runtime.h>
#include <stdint.h>

typedef unsigned short bf16_t;

#if defined(TPROBE)
#define TP_DECL unsigned tp_t0 = 0
#define TP_ON(id) do { if (TPROBE == (id)) tp_t0 = (unsigned)__builtin_amdgcn_s_memrealtime(); } while (0)
#define TP_OFF(id) do { if (TPROBE == (id)) { const unsigned d_ = (unsigned)__builtin_amdgcn_s_memrealtime() - tp_t0; int tq_ = threadIdx.x; asm volatile("" : "+v"(tq_)); if (blockIdx.x == 0 && tq_ == 0) *(volatile __attribute__((address_space(3))) unsigned*)(unsigned)(147456 - 256 + 128) += d_; } } while (0)
#define TP_OFFW(id, T) do { if (TPROBE == (id)) { const unsigned d_ = (unsigned)__builtin_amdgcn_s_memrealtime() - tp_t0; int tq_ = threadIdx.x; asm volatile("" : "+v"(tq_)); if (blockIdx.x == 0 && tq_ == (T)) *(volatile __attribute__((address_space(3))) unsigned*)(unsigned)(147456 - 256 + 128) += d_; } } while (0)
#define TP_COMMIT(lds_)
#else
#define TP_OFFW(id, T)
#define TP_DECL
#define TP_ON(id)
#define TP_OFF(id)
#define TP_COMMIT(lds_)
#endif


#define D_MODEL 1024
#define TP 16384
#define TS 256
#define TT (TP + TS)
#define SEQ 2048
#define DEC_SEQ 8
#define DEC_BATCH 32
#define PAST_LEN 16384
#define PAGE 128
#define N_PAGES 128
#define N_POOL 5120
#define IN_W 7344
#define IN_WP 7424
#define C_POOL 0
#define C_ZPOOL 512
#define C_Q 1024
#define C_KV 1408
#define C_KR 1664
#define C_ZMLA 1696
#define C_QKV 2208
#define C_ZDN 3744
#define C_BETA 4256
#define C_ALPHA 4264
#define C_GATE 4272
#define EPS 1e-6f
#define MLA_SCALE 0.10206207261596577f
#define ATT_C 0.14724444831554004f

#define O_YP 0
#define O_YS (O_YP + 16777216)
#define O_PKV (O_YS + 262144)
#define O_PKR (O_PKV + 8388608)
#define O_PPOOL (O_PKR + 1048576)
#define O_PCONV (O_PPOOL + 122880)
#define O_PDELTA (O_PCONV + 73728)
#define O_SKV (O_PDELTA + 524288)
#define O_SKR (O_SKV + 131072)
#define O_SPOOL (O_SKR + 16384)
#define O_SCONV (O_SPOOL + 491520)
#define O_SDELTA (O_SCONV + 294912)
#define O_END (O_SDELTA + 2097152)

__device__ __forceinline__ float bf2f(bf16_t b) { return __uint_as_float(((unsigned)b) << 16); }
__device__ __forceinline__ bf16_t f2bf(float f) { unsigned u = __float_as_uint(f); u += 0x7FFFu + ((u >> 16) & 1u); return (bf16_t)(u >> 16); }
__device__ __forceinline__ float sigmoidf_(float v) { return __builtin_amdgcn_rcpf(1.0f + __builtin_amdgcn_exp2f(-1.4426950408889634f * v)); }
__device__ __forceinline__ float siluf_(float v) { return v * __builtin_amdgcn_rcpf(1.0f + __builtin_amdgcn_exp2f(-1.4426950408889634f * v)); }
__device__ __forceinline__ float wave_sum(float v) {
#pragma unroll
    for (int o = 32; o >= 1; o >>= 1) v += __shfl_xor(v, o);
    return v;
}

#define SA_CH 8
namespace pg8 {
#define PG8_LAS __attribute__((address_space(3)))
typedef unsigned short bf16_t;
typedef short bf16x8 __attribute__((ext_vector_type(8)));
typedef float f32x4 __attribute__((ext_vector_type(4)));
typedef unsigned u32x4 __attribute__((ext_vector_type(4)));
constexpr int BM = 256, BK = 64, HALF = 128, HTB = HALF * BK * 2  , STAGE_BYTES = 8 * HTB, NXCD = 8, WGM = 8;

__host__ __device__ __forceinline__ int lds_byte(int r, int c) { const int st = (r >> 4) * 2 + (c >> 5), rr = r & 15, cc = c & 31, ob = rr * 64 + cc * 2; return st * 1024 + (ob ^ (((ob >> 9) & 1) << 5)); }
__host__ __device__ __forceinline__ void stage_rc(int b, int& R, int& C) { const int st = b / 1024, sb = b % 1024, swz = sb ^ (((sb >> 9) & 1) << 5); R = (st >> 1) * 16 + swz / 64; C = (st & 1) * 32 + (swz % 64) / 2; }
__host__ __device__ __forceinline__ int perm32(int rho) { const int n = rho >> 4, i = rho & 15; return 8 * (i >> 2) + 4 * n + (i & 3); }

struct Unit { int pm, pn, sg; };
struct Gemm { const bf16_t* A; const bf16_t* Bt; int M, N, K; int ld; };

struct StaticOrder {
    int nM, nN, nwg, G, c;
    __host__ __device__ void init(int M, int N, int G_, int c_) { nM = M / BM; nN = N / BM; nwg = nM * nN; G = G_; c = c_; }
    __host__ __device__ bool next(int i, Unit& u) const {
        const long L = (long)i * G + c; if (L >= nwg) return false;
        int wgid = (int)L; { const int q = nwg / NXCD, r = nwg % NXCD, xcd = wgid % NXCD, off = wgid / NXCD; wgid = (xcd < r ? xcd * (q + 1) : r * (q + 1) + (xcd - r) * q) + off; }
        const int nig = WGM * nN, gid = wgid / nig, fm = gid * WGM, gsz = (nM - fm) < WGM ? (nM - fm) : WGM;
        u.pm = fm + ((wgid % nig) % gsz); u.pn = (wgid % nig) / gsz; u.sg = 0; return true;
    }
    __device__ __forceinline__ void a_ready(const Unit&) const {}
    __device__ __forceinline__ void done(const Unit&) const {}
};
struct GinOrder : StaticOrder {
    unsigned* cnt;
    __device__ bool next(int i, Unit& u) const {
        const long L0 = (long)i * G + c; if (L0 >= nwg) return false;
        int wgid = nwg - 1 - (int)L0; { const int q = nwg / NXCD, r = nwg % NXCD, xcd = wgid % NXCD, off = wgid / NXCD; wgid = (xcd < r ? xcd * (q + 1) : r * (q + 1) + (xcd - r) * q) + off; }
        const int nig = WGM * nN, gid = wgid / nig, fm = gid * WGM, gsz = (nM - fm) < WGM ? (nM - fm) : WGM;
        u.pm = fm + ((wgid % nig) % gsz); u.pn = (wgid % nig) / gsz; u.sg = 0; return true;
    }
    __device__ __forceinline__ void done(const Unit& u) const {
        if (u.pm == nM - 1) {
            asm volatile("s_waitcnt vmcnt(0)" ::: "memory");
            if (__builtin_amdgcn_mbcnt_hi(~0u, __builtin_amdgcn_mbcnt_lo(~0u, 0u)) == 0u) __hip_atomic_fetch_add(cnt, 1u, __ATOMIC_RELAXED, __HIP_MEMORY_SCOPE_AGENT);
        }
    }
};
template <int NSEG> struct SegOrder : StaticOrder {
    __host__ __device__ bool next(int i, Unit& u) const { const bool ok = StaticOrder::next(i / NSEG, u); u.sg = i % NSEG; return ok; }
};
typedef __bf16 bf16n2 __attribute__((ext_vector_type(2)));
__device__ __forceinline__ unsigned cvt_pk_bf16(float lo, float hi) { typedef float f2_ __attribute__((ext_vector_type(2))); const f2_ v = {lo, hi}; return __builtin_bit_cast(unsigned, __builtin_convertvector(v, bf16n2)); }
typedef float f32x2 __attribute__((ext_vector_type(2)));
template <class Epi, class Sched, bool STAMP = false>
__device__ __forceinline__ void gemm_phase(PG8_LAS unsigned char* lds, const Gemm g, const Sched& S, const Epi& E, unsigned long long* stamps) {
    int tid_ = threadIdx.x; asm volatile("" : "+v"(tid_));
    const int tid = tid_, wid = __builtin_amdgcn_readfirstlane(tid >> 6), lane = tid & 63, wr = wid >> 2, wc = wid & 3, fr = lane & 15, fq = lane >> 4;
    int K_ = g.K; asm volatile("" : "+s"(K_));
    int LD_ = g.ld ? g.ld : g.K; asm volatile("" : "+s"(LD_));
    const int K = K_, nt = K / BK, LD = LD_;
    int ts_lo = 0, ts_hi = 0, nts = 0; const unsigned long long rt_entry = STAMP ? (unsigned long long)wall_clock64() : 0ull;
#define PG8_STAMP() do { if (STAMP && wid == 0 && nts < 64) { const unsigned long long _c = (unsigned long long)clock64(); \
        ts_lo = (lane == nts) ? (int)(unsigned)_c : ts_lo; ts_hi = (lane == nts) ? (int)(unsigned)(_c >> 32) : ts_hi; ++nts; } } while (0)
    PG8_STAMP();
    unsigned voffA[2], voffB[2];
#pragma unroll
    for (int i = 0; i < 2; ++i) { int R, C; stage_rc(tid * 16 + i * 8192, R, C); const int Rb = Epi::PERM ? ((R & ~31) + perm32(R & 31)) : R;
        voffA[i] = (unsigned)(R * LD + C) * 2u; voffB[i] = (unsigned)(Rb * LD + C) * 2u; }
    const size_t kstep = (size_t)(BK * 2);
    const size_t hstep = (size_t)HALF * LD * 2;
    const size_t tstep = 2 * hstep;
    const unsigned ldsw = (unsigned)wid * 1024u;
    const int aoff = lds_byte(wr * 64 + fr, fq * 8), boff = lds_byte(wc * 32 + fr, fq * 8);
#define PG8_SA(b, h) (((b) * 2 + (h)) * HTB)
#define PG8_SB(b, h) ((4 + (b) * 2 + (h)) * HTB)
#define PG8_STAGE(bufoff, gbase, voff) do { _Pragma("unroll") for (int _i = 0; _i < 2; ++_i) \
        __builtin_amdgcn_global_load_lds((const unsigned*)((const char*)(gbase) + (voff)[_i]), (PG8_LAS unsigned*)(lds + (bufoff) + ldsw + _i * 8192), 16, 0, 0); } while (0)
#define PG8_LDA(dst, b, h) do { _Pragma("unroll") for (int m = 0; m < 4; ++m) _Pragma("unroll") for (int k = 0; k < 2; ++k) dst[m][k] = *(const PG8_LAS bf16x8*)(lds + PG8_SA(b, h) + aoff + m * 2048 + k * 1024); } while (0)
#define PG8_LDB(dst, b, h) do { _Pragma("unroll") for (int n = 0; n < 2; ++n) _Pragma("unroll") for (int k = 0; k < 2; ++k) dst[n][k] = *(const PG8_LAS bf16x8*)(lds + PG8_SB(b, h) + boff + n * 2048 + k * 1024); } while (0)
#define PG8_MMA(ai, bj, At, Bt) do { __builtin_amdgcn_s_setprio(1); _Pragma("unroll") for (int m = 0; m < 4; ++m) _Pragma("unroll") for (int n = 0; n < 2; ++n) _Pragma("unroll") for (int k = 0; k < 2; ++k) \
        acc[ai][bj][m][n] = __builtin_amdgcn_mfma_f32_16x16x32_bf16(Bt[n][k], At[m][k], acc[ai][bj][m][n], 0, 0, 0); __builtin_amdgcn_s_setprio(0); } while (0)
#define PG8_WAIT_V(n) asm volatile("s_waitcnt vmcnt(" #n ")" ::: "memory")
#define PG8_WAIT_L(n) asm volatile("s_waitcnt lgkmcnt(" #n ")" ::: "memory")
#define PG8_BAR __builtin_amdgcn_s_barrier()
#define PG8_SCHED __builtin_amdgcn_sched_barrier(0)
    Unit cur, nxt; int ui = 0;
    TP_DECL; if constexpr (Epi::SEG > 0) { TP_ON(62); }
    if (!S.next(0, cur)) return;
    f32x4 acc[2][2][4][2];
#pragma unroll
    for (int a = 0; a < 2; ++a)
#pragma unroll
        for (int b = 0; b < 2; ++b)
#pragma unroll
            for (int m = 0; m < 4; ++m)
#pragma unroll
                for (int n = 0; n < 2; ++n) acc[a][b][m][n] = (f32x4){0.f, 0.f, 0.f, 0.f};
    bf16x8 At[4][2], B0[2][2], B1[2][2];
    const size_t sstep = (size_t)K * 2;
    const char* cA = (const char*)g.A + (size_t)cur.pm * tstep + cur.sg * sstep; const char* cB = (const char*)g.Bt + (size_t)cur.pn * tstep + cur.sg * sstep;
    S.a_ready(cur);
    PG8_STAGE(PG8_SB(0, 0), cB, voffB); PG8_STAGE(PG8_SA(0, 0), cA, voffA); PG8_STAGE(PG8_SB(0, 1), cB + hstep, voffB); PG8_STAGE(PG8_SA(0, 1), cA + hstep, voffA);
    if (wr == 1) PG8_BAR;
    PG8_WAIT_V(4); PG8_BAR;
    PG8_STAGE(PG8_SB(1, 0), cB + kstep, voffB); PG8_STAGE(PG8_SA(1, 0), cA + kstep, voffA); PG8_STAGE(PG8_SB(1, 1), cB + hstep + kstep, voffB);
    PG8_WAIT_V(6); PG8_BAR;
    PG8_STAMP();
    for (;;) {
        const bool has_next = S.next(ui + 1, nxt);
        const char* nA = has_next ? (const char*)g.A + (size_t)nxt.pm * tstep + nxt.sg * sstep : cA; const char* nB = has_next ? (const char*)g.Bt + (size_t)nxt.pn * tstep + nxt.sg * sstep : cB;
_Pragma("nounroll")
        for (int t = 0; t < nt; t += 2) {
            const bool last = (t == nt - 2);
            const char* a1 = cA + (size_t)(t + 1) * kstep;
            const char* a2 = last ? nA : cA + (size_t)(t + 2) * kstep; const char* b2 = last ? nB : cB + (size_t)(t + 2) * kstep;
            const char* a3 = a2 + kstep; const char* b3 = b2 + kstep;
            if (last && has_next) S.a_ready(nxt);
            PG8_LDB(B0, 0, 0); PG8_SCHED; PG8_LDA(At, 0, 0); PG8_STAGE(PG8_SA(1, 1), a1 + hstep, voffA);
            PG8_WAIT_L(8); PG8_BAR; PG8_WAIT_L(0); PG8_MMA(0, 0, At, B0); PG8_BAR; PG8_SCHED;
            PG8_LDB(B1, 0, 1); PG8_STAGE(PG8_SB(0, 0), b2, voffB);
            PG8_BAR; PG8_WAIT_L(0); PG8_MMA(0, 1, At, B1); PG8_BAR;
            PG8_LDA(At, 0, 1); PG8_STAGE(PG8_SA(0, 0), a2, voffA);
            PG8_BAR; PG8_WAIT_L(0); PG8_MMA(1, 0, At, B0); PG8_BAR; PG8_SCHED;
            PG8_STAGE(PG8_SB(0, 1), b2 + hstep, voffB);
            PG8_WAIT_V(6); PG8_BAR; PG8_MMA(1, 1, At, B1); PG8_BAR;
            PG8_LDB(B0, 1, 0); PG8_SCHED; PG8_LDA(At, 1, 0); PG8_STAGE(PG8_SA(0, 1), a2 + hstep, voffA);
            PG8_WAIT_L(8); PG8_BAR; PG8_WAIT_L(0); PG8_MMA(0, 0, At, B0); PG8_BAR; PG8_SCHED;
            PG8_LDB(B1, 1, 1); PG8_STAGE(PG8_SB(1, 0), b3, voffB);
            PG8_BAR; PG8_WAIT_L(0); PG8_MMA(0, 1, At, B1); PG8_BAR;
            PG8_LDA(At, 1, 1); PG8_STAGE(PG8_SA(1, 0), a3, voffA);
            PG8_BAR; PG8_WAIT_L(0); PG8_MMA(1, 0, At, B0); PG8_BAR; PG8_SCHED;
            PG8_STAGE(PG8_SB(1, 1), b3 + hstep, voffB);
            PG8_WAIT_V(6); PG8_BAR; PG8_MMA(1, 1, At, B1); PG8_BAR;
        }
        PG8_STAMP();
        bool fin_ = true; if constexpr (Epi::SEG > 0) fin_ = (cur.sg == Epi::SEG - 1);
        if constexpr (Epi::SEG > 0) { TP_ON(60); }
        if constexpr (!Epi::AFTER_DRAIN) { if (fin_) { E(acc, cur, wr, wc, fr, fq); S.done(cur); } }
        if constexpr (Epi::SEG > 0) { TP_OFFW(60, 0); TP_ON(61); }
        if constexpr (Epi::SEG > 0) if (!(fin_ && !has_next)) E.mid(acc, cur, wr, wc, fr, fq, fin_ ? 1 : cur.sg + 1, fin_ ? 0.f : 1.f);
        if constexpr (Epi::SEG > 0) { TP_OFFW(61, 0); }
        PG8_STAMP();
        if (!has_next) break;
        if constexpr (Epi::SEG == 0)
#pragma unroll
        for (int a = 0; a < 2; ++a)
#pragma unroll
            for (int b = 0; b < 2; ++b)
#pragma unroll
                for (int m = 0; m < 4; ++m)
#pragma unroll
                    for (int n = 0; n < 2; ++n) acc[a][b][m][n] = (f32x4){0.f, 0.f, 0.f, 0.f};
        cur = nxt; cA = nA; cB = nB; ++ui;
    }
    PG8_WAIT_V(0);
    if (wr == 0) PG8_BAR;
    PG8_BAR;
    if constexpr (Epi::AFTER_DRAIN) { E.fused(acc, cur, wr, wc, fr, fq, lds, wid, lane); S.done(cur); }
    if constexpr (Epi::SEG > 0) { TP_OFFW(62, 0); }
    PG8_STAMP();
    if (STAMP && wid == 0) { stamps[lane] = lane < nts ? (((unsigned long long)(unsigned)ts_hi << 32) | (unsigned)ts_lo) : 0ull;
        if (lane == 62) stamps[62] = rt_entry; if (lane == 63) stamps[63] = (unsigned long long)wall_clock64(); }
#undef PG8_STAMP
#undef PG8_SA
#undef PG8_SB
#undef PG8_STAGE
#undef PG8_LDA
#undef PG8_LDB
#undef PG8_MMA
#undef PG8_WAIT_V
#undef PG8_WAIT_L
#undef PG8_BAR
#undef PG8_SCHED
}

}
#define XB_TMO      128
#define XB_XCNT(j)  (256  + 64 * (j))
#define XB_XSUB(j)  (1280 + 64 * (j))
#define XB_XGEN(j)  (2304 + 64 * (j))
#define XB_TOP      3328
#define XB_TOPGEN   3392
#define XCD_BAR_WORDS 3456
#define XB_SPIN_CAP (1u << 18)
#define LAS __attribute__((address_space(3)))

__device__ __forceinline__ unsigned xb_ld(unsigned* p)              { return __hip_atomic_load(p, __ATOMIC_RELAXED, __HIP_MEMORY_SCOPE_AGENT); }
__device__ __forceinline__ unsigned xb_add(unsigned* p, unsigned v) { return __hip_atomic_fetch_add(p, v, __ATOMIC_RELAXED, __HIP_MEMORY_SCOPE_AGENT); }
__device__ __forceinline__ unsigned xb_xcc_id() { return (unsigned)__builtin_amdgcn_s_getreg((3 << 11) | 20) & 0xFu; }
#define XB_SPIN(cond, bar) do { unsigned _sp = 0; while (cond) { __builtin_amdgcn_s_sleep(1); \
    if ((++_sp & 255u) == 0u) { if (xb_ld(&(bar)[XB_TMO])) break; if (_sp > XB_SPIN_CAP) { atomicAdd(&(bar)[XB_TMO], 1u); break; } } } } while (0)

struct XcdBarrier {
    unsigned* bar; unsigned x;
    volatile LAS unsigned* st;
};

__device__ __forceinline__ XcdBarrier xcd_barrier_post(unsigned* bar, volatile LAS unsigned* st) {
    XcdBarrier b; b.bar = bar; b.x = xb_xcc_id(); b.st = st;
    if (threadIdx.x == 0) (void)xb_add(&bar[XB_XCNT(b.x)], 1u);
    return b;
}
__device__ __forceinline__ void xcd_barrier_complete(unsigned* bar, unsigned x, unsigned& nloc, unsigned& nx) {
    const unsigned G = gridDim.x * gridDim.y * gridDim.z;
    unsigned sum, cnt, mine, sp = 0u;
    for (;;) {
        sum = 0u; cnt = 0u; mine = 0u;
#pragma unroll
        for (unsigned j = 0; j < 16; ++j) { const unsigned c = xb_ld(&bar[XB_XCNT(j)]); sum += c; cnt += (c > 0u) ? 1u : 0u; mine = (j == x) ? c : mine; }
        if (sum == G) break;
        __builtin_amdgcn_s_sleep(1);
        if ((++sp & 255u) == 0u) { if (xb_ld(&bar[XB_TMO])) break; if (sp > XB_SPIN_CAP) { atomicAdd(&bar[XB_TMO], 1u); break; } }
    }
    nloc = mine > 0u ? mine : 1u; nx = cnt > 0u ? cnt : 1u;
}

__device__ __forceinline__ void xcd_barrier(const XcdBarrier& b) {
    asm volatile("s_waitcnt vmcnt(0)" ::: "memory");
    __syncthreads();
    if (threadIdx.x == 0) {
        unsigned* bar = b.bar;
        __builtin_amdgcn_s_waitcnt(0);
        unsigned nloc = b.st[0], nx = b.st[1];
        if (nloc == 0u) { xcd_barrier_complete(bar, b.x, nloc, nx); b.st[0] = nloc; b.st[1] = nx; }
        const unsigned old = xb_add(&bar[XB_XSUB(b.x)], 1u);
        const unsigned gen = old / nloc;
        if (old + 1u == (gen + 1u) * nloc) {
            __builtin_amdgcn_fence(__ATOMIC_RELEASE, "agent");
            asm volatile("s_waitcnt vmcnt(0)" ::: "memory");
            const unsigned og = xb_add(&bar[XB_TOP], 1u);
            const unsigned tg = og / nx;
            if (og + 1u == (tg + 1u) * nx) xb_add(&bar[XB_TOPGEN], 1u);
            else XB_SPIN(xb_ld(&bar[XB_TOPGEN]) == tg, bar);
            __builtin_amdgcn_fence(__ATOMIC_ACQUIRE, "agent");
            xb_add(&bar[XB_XGEN(b.x)], 1u);
            asm volatile("s_waitcnt vmcnt(0)" ::: "memory");
        } else {
            XB_SPIN(xb_ld(&bar[XB_XGEN(b.x)]) == gen, bar);
            __builtin_amdgcn_fence(__ATOMIC_ACQUIRE, "agent");
            asm volatile("s_waitcnt vmcnt(0)" ::: "memory");
        }
    }
    __syncthreads();
}


#define LAS __attribute__((address_space(3)))
typedef float f32x4 __attribute__((ext_vector_type(4)));
typedef unsigned u32x4 __attribute__((ext_vector_type(4)));
typedef unsigned u32x2 __attribute__((ext_vector_type(2)));
typedef float f32x2 __attribute__((ext_vector_type(2)));
typedef short bf16x8_t __attribute__((ext_vector_type(8)));
typedef float f32x16 __attribute__((ext_vector_type(16)));
constexpr int NTHR = 512;
constexpr int LDS_BYTES = 147456;
constexpr int LDS_MISC = LDS_BYTES - 256;


struct Params {
    const float *x_prompt, *x_sample, *cache_kv, *cache_kr, *state_pool, *state_conv, *state_delta; const int* page_table;
    const float *norm_g, *w_in, *pool_mix, *pool_scale, *q_norm_g, *w_uq, *kv_norm_g, *w_uk, *w_uv, *conv_w, *a_log, *dt_bias, *dn_norm_g, *w_br0, *w_br1, *w_br2, *w_out, *final_norm_g;
    float* out;
    bf16_t *WinT, *WuqT, *WkvT, *WbrT, *WoutT, *PmixT, *WukB; float2* tab;
    float* xres; bf16_t* xn; bf16_t* H; float* BA; bf16_t *cq, *ckv, *Kr, *Q, *Kn, *V, *Vt, *qd, *kd, *vd; float* bg; bf16_t *ya, *yb, *yc; float* mf; bf16_t* mb; float* part; bf16_t* DOP; float* DU; float* DG;
    unsigned* bar;
    int ph_lo, ph_hi, li, pad;
};

typedef const __attribute__((address_space(4))) Params* KP;

constexpr int PH_PRO = 0;
constexpr int PH_L = 8;
constexpr int PH_GIN = 0, PH_TOK = 1, PH_GQ = 2, PH_ATT = 3, PH_FIN = 4, PH_MERGE = 5, PH_OUT = 6, PH_NORM = 7;
#define PHID(l, k) (1 + (l) * PH_L + (k))
constexpr int PH_END = 1 + 2 * PH_L;

__device__ __forceinline__ void unpack8(const u32x4 v, float (&f)[8]) {
    f[0] = __uint_as_float(v.x << 16); f[1] = __uint_as_float(v.x & 0xffff0000u); f[2] = __uint_as_float(v.y << 16); f[3] = __uint_as_float(v.y & 0xffff0000u);
    f[4] = __uint_as_float(v.z << 16); f[5] = __uint_as_float(v.z & 0xffff0000u); f[6] = __uint_as_float(v.w << 16); f[7] = __uint_as_float(v.w & 0xffff0000u); }
__device__ __forceinline__ u32x4 pack8(const float (&f)[8]) { u32x4 w; w.x = pg8::cvt_pk_bf16(f[0], f[1]); w.y = pg8::cvt_pk_bf16(f[2], f[3]); w.z = pg8::cvt_pk_bf16(f[4], f[5]); w.w = pg8::cvt_pk_bf16(f[6], f[7]); return w; }
__device__ __forceinline__ void st16(void* ptr, u32x4 w, bool wt) { if (wt) asm volatile("global_store_dwordx4 %0, %1, off sc1" :: "v"(ptr), "v"(w) : "memory"); else *(u32x4*)ptr = w; }
struct MEpiH { static constexpr bool PERM = true, AFTER_DRAIN = false; static constexpr int SEG = 0; bf16_t* H; float* BA;
    __device__ __forceinline__ void operator()(const f32x4 (&acc)[2][2][4][2], const pg8::Unit& u, int wr, int wc, int fr0, int fq0) const {
        int fr = fr0, fq = fq0; asm volatile("" : "+v"(fr), "+v"(fq));
        const int row0 = u.pm * 256 + wr * 64 + fr; const bool wt = u.pm == TT / 256 - 1;
#pragma unroll
        for (int bj = 0; bj < 2; ++bj) {
            const int wcol = u.pn * 256 + bj * 128 + wc * 32, col0 = wcol + 8 * fq;
            const bool plain = (wcol + 32 <= C_ZPOOL) || (wcol >= C_Q && wcol + 32 <= C_ZMLA) || (wcol >= C_QKV && wcol + 32 <= C_ZDN);
            const int act = ((col0 >= C_ZPOOL && col0 < C_Q) || (col0 >= C_ZMLA && col0 < C_QKV) || (col0 >= C_ZDN && col0 < C_BETA)) ? 1 : (col0 >= C_GATE ? 2 : 0);
            const bool isba = (col0 == C_BETA) || (col0 == C_ALPHA);
#pragma unroll
            for (int ai = 0; ai < 2; ++ai)
#pragma unroll
                for (int m = 0; m < 4; ++m) { const int row = row0 + ai * 128 + m * 16; f32x4 v0 = acc[ai][bj][m][0], v1 = acc[ai][bj][m][1];
                    if (!plain) {
                        if (isba) { float* b = BA + (size_t)row * 16 + (col0 - C_BETA); st16(b, __builtin_bit_cast(u32x4, v0), wt); st16(b + 4, __builtin_bit_cast(u32x4, v1), wt); }
#pragma unroll
                        for (int e = 0; e < 4; ++e) { const float s0 = sigmoidf_(v0[e]), s1 = sigmoidf_(v1[e]);
                            v0[e] = act == 0 ? v0[e] : (act == 1 ? v0[e] * s0 : s0); v1[e] = act == 0 ? v1[e] : (act == 1 ? v1[e] * s1 : s1); }
                    }
                    u32x4 w; w.x = pg8::cvt_pk_bf16(v0[0], v0[1]); w.y = pg8::cvt_pk_bf16(v0[2], v0[3]); w.z = pg8::cvt_pk_bf16(v1[0], v1[1]); w.w = pg8::cvt_pk_bf16(v1[2], v1[3]);
                    st16(H + (size_t)row * IN_WP + col0, w, wt); }
        }
    } };
struct MEpiQ { static constexpr bool PERM = true, AFTER_DRAIN = false; static constexpr int SEG = 0; bf16_t* Q; const float2* tab;
    __device__ __forceinline__ void operator()(const f32x4 (&acc)[2][2][4][2], const pg8::Unit& u, int wr, int wc, int fr0, int fq0) const {
        int fr = fr0, fq = fq0; asm volatile("" : "+v"(fr), "+v"(fq));
        const int row0 = u.pm * 256 + wr * 64 + fr;
#pragma unroll
        for (int bj = 0; bj < 2; ++bj) {
            const int wcol = u.pn * 256 + bj * 128 + wc * 32, col0 = wcol + 8 * fq;
            const bool rope = (wcol % 96) == 64;
#pragma unroll
            for (int ai = 0; ai < 2; ++ai)
#pragma unroll
                for (int m = 0; m < 4; ++m) { const int row = row0 + ai * 128 + m * 16; f32x4 v0 = acc[ai][bj][m][0], v1 = acc[ai][bj][m][1];
                    if (rope) { const int p = row < TP ? (row & (SEQ - 1)) : SEQ + ((row - TP) & 7); const float2* tp = tab + p * 16 + (fq & 1) * 8; const bool hi = fq >= 2;
#pragma unroll
                        for (int e = 0; e < 4; ++e) { const float o0 = __shfl_xor(v0[e], 32), o1 = __shfl_xor(v1[e], 32); const float2 c0 = tp[e], c1 = tp[4 + e];
                            v0[e] = hi ? (v0[e] * c0.x + o0 * c0.y) : (v0[e] * c0.x - o0 * c0.y); v1[e] = hi ? (v1[e] * c1.x + o1 * c1.y) : (v1[e] * c1.x - o1 * c1.y); } }
                    u32x4 w; w.x = pg8::cvt_pk_bf16(v0[0], v0[1]); w.y = pg8::cvt_pk_bf16(v0[2], v0[3]); w.z = pg8::cvt_pk_bf16(v1[0], v1[1]); w.w = pg8::cvt_pk_bf16(v1[2], v1[3]);
                    *(u32x4*)(Q + (size_t)row * 768 + col0) = w; if (m == 3) asm volatile("" ::: "memory"); }
        }
    } };
struct MEpiKV { static constexpr bool PERM = true, AFTER_DRAIN = false; static constexpr int SEG = 0; bf16_t* Kn; bf16_t* V;
    __device__ __forceinline__ void operator()(const f32x4 (&acc)[2][2][4][2], const pg8::Unit& u, int wr, int wc, int fr0, int fq0) const {
        int fr = fr0, fq = fq0; asm volatile("" : "+v"(fr), "+v"(fq));
        const int row0 = u.pm * 256 + wr * 64 + fr; bf16_t* base = u.pn < 2 ? Kn : V; const int cb = (u.pn & 1) * 256;
#pragma unroll
        for (int bj = 0; bj < 2; ++bj) { const int col0 = cb + bj * 128 + wc * 32 + 8 * fq;
#pragma unroll
            for (int ai = 0; ai < 2; ++ai)
#pragma unroll
                for (int m = 0; m < 4; ++m) { const int row = row0 + ai * 128 + m * 16; const f32x4 v0 = acc[ai][bj][m][0], v1 = acc[ai][bj][m][1];
                    u32x4 w; w.x = pg8::cvt_pk_bf16(v0[0], v0[1]); w.y = pg8::cvt_pk_bf16(v0[2], v0[3]); w.z = pg8::cvt_pk_bf16(v1[0], v1[1]); w.w = pg8::cvt_pk_bf16(v1[2], v1[3]);
                    *(u32x4*)(base + (size_t)row * 512 + col0) = w; } }
    } };
template <int BR> struct MEpiMerge { static constexpr bool PERM = true, AFTER_DRAIN = false; static constexpr int SEG = 0; const bf16_t* H; float* mf; bf16_t* mb;
    __device__ __forceinline__ void operator()(const f32x4 (&acc)[2][2][4][2], const pg8::Unit& u, int wr, int wc, int fr0, int fq0) const {
        int fr = fr0, fq = fq0; asm volatile("" : "+v"(fr), "+v"(fq));
        const int row0 = u.pm * 256 + wr * 64 + fr;
#pragma unroll
        for (int bj = 0; bj < 2; ++bj) { const int col0 = u.pn * 256 + bj * 128 + wc * 32 + 8 * fq;
#pragma unroll
            for (int ai = 0; ai < 2; ++ai)
#pragma unroll
                for (int m = 0; m < 4; ++m) { const int row = row0 + ai * 128 + m * 16; f32x4 v0 = acc[ai][bj][m][0], v1 = acc[ai][bj][m][1];
                    const u32x4 g = *(const u32x4*)(H + (size_t)row * IN_WP + C_GATE + BR * 1024 + col0);
                    v0[0] *= __uint_as_float(g.x << 16); v0[1] *= __uint_as_float(g.x & 0xffff0000u); v0[2] *= __uint_as_float(g.y << 16); v0[3] *= __uint_as_float(g.y & 0xffff0000u);
                    v1[0] *= __uint_as_float(g.z << 16); v1[1] *= __uint_as_float(g.z & 0xffff0000u); v1[2] *= __uint_as_float(g.w << 16); v1[3] *= __uint_as_float(g.w & 0xffff0000u);
                    float* mp = mf + (size_t)row * 1024 + col0;
                    if (BR > 0) { v0 += *(const f32x4*)mp; v1 += *(const f32x4*)(mp + 4); }
                    if (BR < 2) { *(f32x4*)mp = v0; *(f32x4*)(mp + 4) = v1; }
                    else { u32x4 w; w.x = pg8::cvt_pk_bf16(v0[0], v0[1]); w.y = pg8::cvt_pk_bf16(v0[2], v0[3]); w.z = pg8::cvt_pk_bf16(v1[0], v1[1]); w.w = pg8::cvt_pk_bf16(v1[2], v1[3]);
                        *(u32x4*)(mb + (size_t)row * 1024 + col0) = w; } asm volatile("" ::: "memory"); } }
    } };
struct MEpiRes { static constexpr bool PERM = false, AFTER_DRAIN = false; static constexpr int SEG = 0; const float* xp; const float* xs; float* xo;
    __device__ __forceinline__ void operator()(const f32x4 (&acc)[2][2][4][2], const pg8::Unit& u, int wr, int wc, int fr0, int fq0) const {
        int fr = fr0, fq = fq0; asm volatile("" : "+v"(fr), "+v"(fq));
        const int row0 = u.pm * 256 + wr * 64 + fr, col0 = u.pn * 256 + wc * 32 + 4 * fq;
#pragma unroll
        for (int ai = 0; ai < 2; ++ai)
#pragma unroll
            for (int m2 = 0; m2 < 4; m2 += 2) {
                f32x4 xv[2][2][2];
#pragma unroll
                for (int mm = 0; mm < 2; ++mm) { const int row = row0 + ai * 128 + (m2 + mm) * 16; const float* xr = row < TP ? xp + (size_t)row * 1024 : xs + (size_t)(row - TP) * 1024;
#pragma unroll
                    for (int bj = 0; bj < 2; ++bj)
#pragma unroll
                        for (int n = 0; n < 2; ++n) xv[mm][bj][n] = *(const f32x4*)(xr + col0 + bj * 128 + n * 16); }
#pragma unroll
                for (int mm = 0; mm < 2; ++mm) { const int row = row0 + ai * 128 + (m2 + mm) * 16; float* orow = xo + (size_t)row * 1024;
#pragma unroll
                    for (int bj = 0; bj < 2; ++bj)
#pragma unroll
                        for (int n = 0; n < 2; ++n) *(f32x4*)(orow + col0 + bj * 128 + n * 16) = xv[mm][bj][n] + acc[ai][bj][m2 + mm][n]; }
                asm volatile("" ::: "memory"); }
    } };

template <int NSEG, class Epi>
__device__ __forceinline__ void tail_gemm(const bf16_t* __restrict__ A, int lda, const bf16_t* __restrict__ Bt, int K, int N, const Epi& epi, LAS unsigned char* lds) {
    int tid = threadIdx.x; asm volatile("" : "+v"(tid));
    const int lane = tid & 63, wave = __builtin_amdgcn_readfirstlane(tid >> 6), rt = wave & 3, kh = wave >> 2, n = lane & 15, q = lane >> 4;
    const int ntile = 4 * (N / 16), kseg = K / NSEG, khalf = kseg / 2;
    LAS f32x4* red = (LAS f32x4*)lds;
    for (int tile = blockIdx.x; tile < ntile; tile += gridDim.x) {
        const int r0 = 64 * (tile & 3) + 16 * rt, c0 = 16 * (tile >> 2);
        const bf16_t* ap = A + (size_t)(r0 + n) * lda + 8 * q; const bf16_t* bp = Bt + (size_t)(c0 + n) * K + 8 * q;
        f32x4 acc[NSEG];
#pragma unroll
        for (int sg = 0; sg < NSEG; ++sg) { acc[sg] = (f32x4){0.f, 0.f, 0.f, 0.f};
            const int kb = sg * kseg + kh * khalf;
#pragma unroll 4
            for (int k = 0; k < khalf; k += 32) acc[sg] = __builtin_amdgcn_mfma_f32_16x16x32_bf16(*(const bf16x8_t*)(ap + kb + k), *(const bf16x8_t*)(bp + kb + k), acc[sg], 0, 0, 0); }
        __syncthreads();
        if (kh == 1) {
#pragma unroll
            for (int sg = 0; sg < NSEG; ++sg) red[(rt * NSEG + sg) * 64 + lane] = acc[sg]; }
        __syncthreads();
        if (kh == 0) {
#pragma unroll
            for (int sg = 0; sg < NSEG; ++sg) acc[sg] += red[(rt * NSEG + sg) * 64 + lane];
#pragma unroll
            for (int e = 0; e < 4; ++e) { float v[NSEG];
#pragma unroll
                for (int sg = 0; sg < NSEG; ++sg) v[sg] = acc[sg][e];
                epi(r0 + 4 * q + e, c0 + n, v); } }
    }
    __syncthreads();
}
struct TEpiMerge { const bf16_t* H; bf16_t* mb;
    __device__ __forceinline__ void operator()(int row, int col, const float (&v)[3]) const { const size_t t = (size_t)TP + row; const bf16_t* g = H + t * IN_WP + C_GATE + col;
        mb[t * 1024 + col] = f2bf(bf2f(g[0]) * v[0] + bf2f(g[1024]) * v[1] + bf2f(g[2048]) * v[2]); } };
struct TEpiRes { const float* xs; float* xo;
    __device__ __forceinline__ void operator()(int row, int col, const float (&v)[1]) const { xo[((size_t)TP + row) * 1024 + col] = xs[(size_t)row * 1024 + col] + v[0]; } };
struct MEpiMergeS { static constexpr bool PERM = true, AFTER_DRAIN = false; static constexpr int SEG = 3; const bf16_t* H; bf16_t* mb;
    __device__ __forceinline__ void mid(f32x4 (&acc)[2][2][4][2], const pg8::Unit& u, int wr, int wc, int fr0, int fq0, int seg, float keep) const {
        int fr = fr0, fq = fq0; asm volatile("" : "+v"(fr), "+v"(fq));
        const int row0 = u.pm * 256 + wr * 64 + fr;
        const size_t rs = keep != 0.f ? (size_t)IN_WP : 0; const bf16_t* gbase = keep != 0.f ? H + (size_t)row0 * IN_WP + C_GATE + (seg - 1) * 1024 + u.pn * 256 + wc * 32 + 8 * fq : H;
        const int cs = keep != 0.f ? 128 : 0;
        u32x4 ga[2][4], gb[2][4];
#pragma unroll
        for (int m = 0; m < 4; ++m) { const bf16_t* gp = gbase + (size_t)(m * 16) * rs; ga[0][m] = *(const u32x4*)gp; gb[0][m] = *(const u32x4*)(gp + 1024); }
#pragma unroll
        for (int k = 0; k < 4; ++k) { const int bj = k >> 1, ai = k & 1;
            if (k + 1 < 4) { const int bjn = (k + 1) >> 1, ain = (k + 1) & 1;
#pragma unroll
                for (int m = 0; m < 4; ++m) { const bf16_t* gp = gbase + (size_t)(ain * 128 + m * 16) * rs + bjn * cs; ga[(k + 1) & 1][m] = *(const u32x4*)gp; gb[(k + 1) & 1][m] = *(const u32x4*)(gp + 1024); } }
#pragma unroll
            for (int m = 0; m < 4; ++m) { float a[8], b[8]; unpack8(ga[k & 1][m], a); unpack8(gb[k & 1][m], b);
#pragma unroll
                for (int e = 0; e < 4; ++e) { acc[ai][bj][m][0][e] *= keep * a[e] * __builtin_amdgcn_rcpf(fmaxf(b[e], 1e-30f)); acc[ai][bj][m][1][e] *= keep * a[4 + e] * __builtin_amdgcn_rcpf(fmaxf(b[4 + e], 1e-30f)); } }
            asm volatile("" ::: "memory"); }
    }
    __device__ __forceinline__ void operator()(const f32x4 (&acc)[2][2][4][2], const pg8::Unit& u, int wr, int wc, int fr0, int fq0) const {
        int fr = fr0, fq = fq0; asm volatile("" : "+v"(fr), "+v"(fq));
        const int row0 = u.pm * 256 + wr * 64 + fr;
#pragma unroll
        for (int bj = 0; bj < 2; ++bj) { const int col0 = u.pn * 256 + bj * 128 + wc * 32 + 8 * fq;
#pragma unroll
            for (int ai = 0; ai < 2; ++ai) {
                u32x4 gg[4];
#pragma unroll
                for (int m = 0; m < 4; ++m) gg[m] = *(const u32x4*)(H + (size_t)(row0 + ai * 128 + m * 16) * IN_WP + C_GATE + 2048 + col0);
#pragma unroll
                for (int m = 0; m < 4; ++m) { const int row = row0 + ai * 128 + m * 16; float g[8]; unpack8(gg[m], g);
                    const f32x4 v0 = acc[ai][bj][m][0], v1 = acc[ai][bj][m][1];
                    u32x4 w; w.x = pg8::cvt_pk_bf16(v0[0] * g[0], v0[1] * g[1]); w.y = pg8::cvt_pk_bf16(v0[2] * g[2], v0[3] * g[3]); w.z = pg8::cvt_pk_bf16(v1[0] * g[4], v1[1] * g[5]); w.w = pg8::cvt_pk_bf16(v1[2] * g[6], v1[3] * g[7]);
                    *(u32x4*)(mb + (size_t)row * 1024 + col0) = w; }
                asm volatile("" ::: "memory"); } }
    } };

__device__ __forceinline__ void ph_tr(const float* __restrict__ src, bf16_t* __restrict__ dst, int K, int N, int Npad, LAS float* tile, int rot, int ldd = 0) {
    if (ldd == 0) ldd = K;
    int tid = threadIdx.x; asm volatile("" : "+v"(tid)); const int G = gridDim.x; const int tn = Npad / 64, tk = K / 32, nt = tn * tk;
    const int first = (blockIdx.x + G - (rot % G)) % G;
    const bool al4 = (N & 3) == 0;
    for (int t = first; t < nt; t += G) {
        const int n0 = (t % tn) * 64, k0 = (t / tn) * 32;
        { const int k = tid >> 4, n4 = (tid & 15) * 4, n = n0 + n4; f32x4 v = (f32x4){0.f, 0.f, 0.f, 0.f};
          const float* sp = src + (size_t)(k0 + k) * N + n;
          if (al4 && n + 3 < N) v = *(const f32x4*)sp; else {
#pragma unroll
              for (int e = 0; e < 4; ++e) if (n + e < N) v[e] = sp[e]; }
#pragma unroll
          for (int e = 0; e < 4; ++e) tile[k * 65 + n4 + e] = v[e]; }
        __syncthreads();
        if (tid < 256) { const int n = tid >> 2, kq = (tid & 3) * 8; float f[8];
#pragma unroll
            for (int j = 0; j < 8; ++j) f[j] = tile[(kq + j) * 65 + n];
            *(u32x4*)(dst + (size_t)(n0 + n) * ldd + k0 + kq) = pack8(f); }
        __syncthreads();
    }
}
__device__ __forceinline__ void ph_rope_tab(float2* tab) {
    for (int idx = blockIdx.x * NTHR + threadIdx.x; idx < (SEQ + DEC_SEQ) * 16; idx += gridDim.x * NTHR) {
        const int p = idx >> 4, i = idx & 15; const int pos = p < SEQ ? p : PAST_LEN + (p - SEQ);
        const float inv = powf(10000.0f, -(float)i / 16.0f); const float ang = (float)pos * inv;
        const double rev = (double)ang * 0.15915494309189533576888; const float f = (float)(rev - floor(rev));
        tab[idx] = make_float2(__builtin_amdgcn_cosf(f), __builtin_amdgcn_sinf(f)); }
}
__device__ __forceinline__ void ph_rmsnorm(const float* __restrict__ xp, const float* __restrict__ xs, const float* __restrict__ g, bf16_t* __restrict__ xn, float* __restrict__ yp, float* __restrict__ ys) {
    int tid_o = threadIdx.x; asm volatile("" : "+v"(tid_o)); int lane = tid_o & 63, wave = tid_o >> 6;
    const int stride = gridDim.x * 8;
    f32x4 gg[4];
#pragma unroll
    for (int i = 0; i < 4; ++i) gg[i] = *(const f32x4*)(g + i * 256 + lane * 4);
    for (int t0 = blockIdx.x * 8 + wave; t0 < TT; t0 += 4 * stride) {
        f32x4 v[4][4];
#pragma unroll
        for (int j = 0; j < 4; ++j) { const int t = t0 + j * stride; const int tc = t < TT ? t : t0; const float* x = tc < TP ? xp + (size_t)tc * 1024 : xs + (size_t)(tc - TP) * 1024;
#pragma unroll
            for (int i = 0; i < 4; ++i) v[j][i] = *(const f32x4*)(x + i * 256 + lane * 4); }
#pragma unroll
        for (int j = 0; j < 4; ++j) { const int t = t0 + j * stride; if (t >= TT) break;
            float ss = 0.f;
#pragma unroll
            for (int i = 0; i < 4; ++i) ss += v[j][i][0] * v[j][i][0] + v[j][i][1] * v[j][i][1] + v[j][i][2] * v[j][i][2] + v[j][i][3] * v[j][i][3];
            ss = wave_sum(ss); const float r = rsqrtf(ss * (1.0f / 1024.0f) + EPS);
#pragma unroll
            for (int i = 0; i < 4; ++i) { const int c = i * 256 + lane * 4; const f32x4 o = v[j][i] * r * gg[i];
                if (xn) { u32x2 w; w.x = pg8::cvt_pk_bf16(o[0], o[1]); w.y = pg8::cvt_pk_bf16(o[2], o[3]); *(u32x2*)(xn + (size_t)t * 1024 + c) = w; }
                else { float* y = t < TP ? yp + (size_t)t * 1024 : ys + (size_t)(t - TP) * 1024; *(f32x4*)(y + c) = o; } } }
    }
}

constexpr int TK_RS = 1040;
struct ConvIn { u32x4 rows[11]; f32x4 sa[3], sb[3]; f32x4 w0[4], w1[4]; };
__device__ __forceinline__ void conv_load(ConvIn& c, KP p, const bf16_t* __restrict__ H, int l, int tbase, int iseq0, bool smp, int sq, int lane, int pi) {
    const int c0 = (pi * 64 + lane) * 8; const float* conv_w = p->conv_w + (size_t)l * 4 * 1536;
#pragma unroll
    for (int j = 0; j < 11; ++j) {
        if (j >= 3 || iseq0 - 3 + j >= 0) c.rows[j] = *(const u32x4*)(H + (size_t)(tbase - 3 + j) * IN_WP + C_QKV + c0);
        else if (smp) { const float* sc = p->state_conv + (((size_t)l * DEC_BATCH + sq) * 3 + j) * 1536 + c0; c.sa[j] = *(const f32x4*)sc; c.sb[j] = *(const f32x4*)(sc + 4); }
        else c.rows[j] = (u32x4){0u, 0u, 0u, 0u}; }
#pragma unroll
    for (int j = 0; j < 4; ++j) { c.w0[j] = *(const f32x4*)(conv_w + j * 1536 + c0); c.w1[j] = *(const f32x4*)(conv_w + j * 1536 + c0 + 4); }
}
__device__ __forceinline__ void conv_compute(ConvIn& c, KP p, float* __restrict__ out, int l, int tbase, int iseq0, bool smp, int sq, int lane, int pi) {
    const int c0 = (pi * 64 + lane) * 8; const bool last = smp || (iseq0 == SEQ - 8);
    if (smp) {
#pragma unroll
        for (int j = 0; j < 3; ++j) { const f32x4 a = c.sa[j], b = c.sb[j]; c.rows[j].x = pg8::cvt_pk_bf16(a[0], a[1]); c.rows[j].y = pg8::cvt_pk_bf16(a[2], a[3]); c.rows[j].z = pg8::cvt_pk_bf16(b[0], b[1]); c.rows[j].w = pg8::cvt_pk_bf16(b[2], b[3]); } }
    bf16_t* dst = pi == 0 ? p->qd : (pi == 1 ? p->kd : p->vd);
#pragma unroll
    for (int e = 0; e < 8; ++e) { float y[8];
#pragma unroll
        for (int k = 0; k < 8; ++k) y[k] = 0.f;
#pragma unroll
        for (int j = 0; j < 4; ++j) { float x[8]; unpack8(c.rows[e + j], x);
#pragma unroll
            for (int k = 0; k < 4; ++k) { y[k] += x[k] * c.w0[j][k]; y[4 + k] += x[4 + k] * c.w1[j][k]; } }
        float ss = 0.f;
#pragma unroll
        for (int k = 0; k < 8; ++k) { y[k] = siluf_(y[k]); ss += y[k] * y[k]; }
        if (pi < 2) { ss += __shfl_xor(ss, 1); ss += __shfl_xor(ss, 2); ss += __shfl_xor(ss, 4); const float rn = rsqrtf(ss + EPS) * (pi == 0 ? 0.125f : 1.0f);
#pragma unroll
            for (int k = 0; k < 8; ++k) y[k] *= rn; }
        *(u32x4*)(dst + (size_t)(tbase + e) * 512 + lane * 8) = pack8(y); }
    if (last) {
#pragma unroll
        for (int rr = 0; rr < 3; ++rr) { float x[8]; unpack8(c.rows[8 + rr], x);
            float* oc = (smp ? out + O_SCONV + (((size_t)l * DEC_BATCH + sq) * 3 + rr) * 1536 : out + O_PCONV + (((size_t)l * 8 + (tbase >> 11)) * 3 + rr) * 1536) + c0;
            *(f32x4*)oc = (f32x4){x[0], x[1], x[2], x[3]}; *(f32x4*)(oc + 4) = (f32x4){x[4], x[5], x[6], x[7]}; } }
}
__device__ __forceinline__ void tok8(KP p, int l, int tbase, int iseq0, bool smp, int sq, int lane) {
    asm volatile("" : "+v"(lane));
    const bf16_t* __restrict__ H = p->H; float* __restrict__ out = p->out;
    __builtin_amdgcn_s_waitcnt(0);
    const float* qg = p->q_norm_g + l * 384; const float* kvg = p->kv_norm_g + l * 256;
    u32x4 rq[8], rk[8];
#pragma unroll
    for (int e = 0; e < 8; ++e) { const bf16_t* h = H + (size_t)(tbase + e) * IN_WP;
        rq[e] = lane < 48 ? *(const u32x4*)(h + C_Q + lane * 8) : (u32x4){0u, 0u, 0u, 0u}; rk[e] = lane < 32 ? *(const u32x4*)(h + C_KV + lane * 8) : (u32x4){0u, 0u, 0u, 0u}; }
    f32x4 gq0 = (f32x4){0.f, 0.f, 0.f, 0.f}, gq1 = gq0, gk0 = gq0, gk1 = gq0;
    if (lane < 48) { gq0 = *(const f32x4*)(qg + lane * 8); gq1 = *(const f32x4*)(qg + lane * 8 + 4); }
    if (lane < 32) { gk0 = *(const f32x4*)(kvg + lane * 8); gk1 = *(const f32x4*)(kvg + lane * 8 + 4); }
    ConvIn A, B;
    conv_load(A, p, H, l, tbase, iseq0, smp, sq, lane, 0);
#pragma unroll
    for (int e = 0; e < 8; ++e) { const int t = tbase + e; float q[8], kv[8]; unpack8(rq[e], q); unpack8(rk[e], kv); float s1 = 0.f, s2 = 0.f;
#pragma unroll
        for (int j = 0; j < 8; ++j) { s1 += q[j] * q[j]; s2 += kv[j] * kv[j]; }
        s1 = wave_sum(s1); s2 = wave_sum(s2); const float r1 = rsqrtf(s1 * (1.0f / 384.0f) + EPS), r2 = rsqrtf(s2 * (1.0f / 256.0f) + EPS);
#pragma unroll
        for (int j = 0; j < 4; ++j) { q[j] *= r1 * gq0[j]; q[4 + j] *= r1 * gq1[j]; kv[j] *= r2 * gk0[j]; kv[4 + j] *= r2 * gk1[j]; }
        if (lane < 48) *(u32x4*)(p->cq + (size_t)t * 384 + lane * 8) = pack8(q);
        if (lane < 32) { float* okv = (smp ? out + O_SKV + ((size_t)l * TS + (t - TP)) * 256 : out + O_PKV + ((size_t)l * TP + t) * 256) + lane * 8;
            *(f32x4*)okv = (f32x4){kv[0], kv[1], kv[2], kv[3]}; *(f32x4*)(okv + 4) = (f32x4){kv[4], kv[5], kv[6], kv[7]};
            *(u32x4*)(p->ckv + (size_t)t * 256 + lane * 8) = pack8(kv); } }
    conv_load(B, p, H, l, tbase, iseq0, smp, sq, lane, 1);
    conv_compute(A, p, out, l, tbase, iseq0, smp, sq, lane, 0);
    conv_load(A, p, H, l, tbase, iseq0, smp, sq, lane, 2);
    float kx1[2], kx2[2]; float2 kcs[2];
#pragma unroll
    for (int ps = 0; ps < 2; ++ps) { const int e = (lane >> 4) + 4 * ps, j = lane & 15; const bf16_t* h = H + (size_t)(tbase + e) * IN_WP;
        kx1[ps] = bf2f(h[C_KR + j]); kx2[ps] = bf2f(h[C_KR + 16 + j]); kcs[ps] = p->tab[((smp ? SEQ : 0) + iseq0 + e) * 16 + j]; }
    const int tc = tbase + (lane >> 3), hd = lane & 7;
    const float ba0 = p->BA[(size_t)tc * 16 + hd], ba1 = p->BA[(size_t)tc * 16 + 8 + hd], dtb = p->dt_bias[l * 8 + hd], alg = p->a_log[l * 8 + hd];
    conv_compute(B, p, out, l, tbase, iseq0, smp, sq, lane, 1);
    conv_compute(A, p, out, l, tbase, iseq0, smp, sq, lane, 2);
#pragma unroll
    for (int ps = 0; ps < 2; ++ps) { const int e = (lane >> 4) + 4 * ps, j = lane & 15, t = tbase + e; const float x1 = kx1[ps], x2 = kx2[ps]; const float2 cs = kcs[ps];
        const float o1 = x1 * cs.x - x2 * cs.y, o2 = x2 * cs.x + x1 * cs.y; float* okr = smp ? out + O_SKR + ((size_t)l * TS + (t - TP)) * 32 : out + O_PKR + ((size_t)l * TP + t) * 32;
        okr[j] = o1; okr[16 + j] = o2; p->Kr[(size_t)t * 32 + j] = f2bf(o1); p->Kr[(size_t)t * 32 + 16 + j] = f2bf(o2); }
    { const float bb = sigmoidf_(ba0); const float x = ba1 + dtb;
      const float sp = x > 20.f ? x : log1pf(expf(x)); const float gg = -expf(alg) * sp;
      p->bg[(size_t)tc * 16 + hd] = bb; p->bg[(size_t)tc * 16 + 8 + hd] = gg; }
}
template <bool SMP> __device__ __forceinline__ void tok_tile(KP p, int l, int tile, LAS unsigned char* lds) {
    {
        int tid = threadIdx.x; asm volatile("" : "+v"(tid)); const int pmask = p->pad;
        const int lane = tid & 63, wave = __builtin_amdgcn_readfirstlane(tid >> 6), r = lane & 31, hh = lane >> 5;
        const bf16_t* __restrict__ H = p->H; float* __restrict__ out = p->out;
        const bool smp = SMP; const int s0 = smp ? (tile - TP / 64) * 4 : 0;
        const int t0 = smp ? TP + s0 * 8 : tile * 64, i0 = smp ? 0 : (t0 & (SEQ - 1)), b = t0 >> 11;
        TP_DECL; TP_ON(50); TP_ON(51); TP_ON(52); TP_ON(55);
        __syncthreads();
        if (!smp) {
            u32x4 v[10];
#pragma unroll
            for (int i = 0; i < 10; ++i) { const int c = tid + NTHR * i, row = c >> 6, ch16 = c & 63; v[i] = (u32x4){0u, 0u, 0u, 0u};
                if (c < 79 * 64 && i0 - 15 + row >= 0) v[i] = *(const u32x4*)(H + (size_t)(t0 - 15 + row) * IN_WP + C_POOL + ch16 * 8); }
#pragma unroll
            for (int i = 0; i < 10; ++i) { const int c = tid + NTHR * i, row = c >> 6, ch16 = c & 63; if (c < 79 * 64) *(LAS u32x4*)(lds + row * TK_RS + ch16 * 16) = v[i]; }
        } else {
            int tq = tid; asm volatile("" : "+v"(tq));
            f32x4 va[12], vb[12];
#pragma unroll
            for (int i = 0; i < 12; ++i) { const int c = tq + NTHR * i, row = c >> 6, ch16 = c & 63, sq = row / 23, j = row - sq * 23; va[i] = (f32x4){0.f, 0.f, 0.f, 0.f}; vb[i] = va[i];
                if (c < 92 * 64) {
                    if (j >= 15) { const u32x4 v = *(const u32x4*)(H + (size_t)(t0 + sq * 8 + (j - 15)) * IN_WP + C_POOL + ch16 * 8); va[i] = __builtin_bit_cast(f32x4, v); }
                    else { const float* sp = p->state_pool + (((size_t)l * DEC_BATCH + s0 + sq) * 15 + j) * 512 + ch16 * 8; va[i] = *(const f32x4*)sp; vb[i] = *(const f32x4*)(sp + 4); } } }
#pragma unroll
            for (int i = 0; i < 12; ++i) { const int c = tq + NTHR * i, row = c >> 6, ch16 = c & 63, sq = row / 23, j = row - sq * 23;
                if (c < 92 * 64) { u32x4 v = __builtin_bit_cast(u32x4, va[i]);
                    if (j < 15) { const f32x4 a = va[i], bq = vb[i];
                        v.x = pg8::cvt_pk_bf16(a[0], a[1]); v.y = pg8::cvt_pk_bf16(a[2], a[3]); v.z = pg8::cvt_pk_bf16(bq[0], bq[1]); v.w = pg8::cvt_pk_bf16(bq[2], bq[3]);
                        if (j >= 8) { float* so = out + O_SPOOL + (((size_t)l * DEC_BATCH + s0 + sq) * 15 + (j - 8)) * 512 + ch16 * 8; *(f32x4*)so = a; *(f32x4*)(so + 4) = bq; } }
                    *(LAS u32x4*)(lds + row * TK_RS + ch16 * 16) = v; } }
        }
        __syncthreads();
        if (smp) TP_OFF(52); else TP_OFF(55);
        if (smp) TP_ON(53); else TP_ON(56);
        if (smp && (wave & 1) && (pmask & 16384)) tok8(p, l, t0 + (wave >> 1) * 8, 0, true, s0 + (wave >> 1), lane);
        if ((pmask & 8192) && !(smp && (wave & 1))) { const int g = wave >> 1, th = wave & 1, w = 2 << g, tk = 32 * th + r;
          const int brow = smp ? (tk >> 3) * 23 + 15 + (tk & 7) : 15 + tk; const float inv = 1.0f / (float)(smp ? w : min(i0 + tk + 1, w));
          const bf16_t* mixT = p->PmixT + ((size_t)l * 4 + g) * 128 * 128;
          f32x16 acc[4];
#pragma unroll
          for (int nt = 0; nt < 4; ++nt)
#pragma unroll
              for (int e = 0; e < 16; ++e) acc[nt][e] = 0.f;
          const size_t t = (size_t)t0 + tk; const float* scl = p->pool_scale + l * 512 + 128 * g;
          u32x2 zv[16];
#pragma unroll
          for (int nt = 0; nt < 4; ++nt)
#pragma unroll
              for (int gg = 0; gg < 4; ++gg) { const int dd0 = 32 * nt + 8 * gg + 4 * hh; zv[4 * nt + gg] = *(const u32x2*)(H + t * IN_WP + C_ZPOOL + 128 * g + dd0); }
#pragma unroll 2
          for (int ks = 0; ks < 8; ++ks) {
              const LAS unsigned char* base = lds + brow * TK_RS + (128 * g + 16 * ks + 8 * hh) * 2;
              float cur[8], sum[8]; unpack8(*(const LAS u32x4*)base, cur);
#pragma unroll
              for (int e = 0; e < 8; ++e) sum[e] = cur[e];
              for (int k = 1; k < w; ++k) { float x[8]; unpack8(*(const LAS u32x4*)(base - k * TK_RS), x);
#pragma unroll
                  for (int e = 0; e < 8; ++e) sum[e] += x[e]; }
#pragma unroll
              for (int e = 0; e < 8; ++e) sum[e] = sum[e] * inv - cur[e];
              union { u32x4 u; bf16x8_t v; } bfr; bfr.u = pack8(sum);
#pragma unroll
              for (int nt = 0; nt < 4; ++nt) { const bf16x8_t a = *(const bf16x8_t*)(mixT + (size_t)(32 * nt + r) * 128 + 16 * ks + 8 * hh);
                  acc[nt] = __builtin_amdgcn_mfma_f32_32x32x16_bf16(a, bfr.v, acc[nt], 0, 0, 0); } }
          f32x4 scv[16];
#pragma unroll
          for (int nt = 0; nt < 4; ++nt)
#pragma unroll
              for (int gg = 0; gg < 4; ++gg) scv[4 * nt + gg] = *(const f32x4*)(scl + 32 * nt + 8 * gg + 4 * hh);
#pragma unroll
          for (int nt = 0; nt < 4; ++nt)
#pragma unroll
              for (int gg = 0; gg < 4; ++gg) { const int dd0 = 32 * nt + 8 * gg + 4 * hh; const u32x2 z = zv[4 * nt + gg]; const f32x4 sc = scv[4 * nt + gg];
                  float v0 = acc[nt][4 * gg + 0] * sc[0] * __uint_as_float(z.x << 16), v1 = acc[nt][4 * gg + 1] * sc[1] * __uint_as_float(z.x & 0xffff0000u);
                  float v2 = acc[nt][4 * gg + 2] * sc[2] * __uint_as_float(z.y << 16), v3 = acc[nt][4 * gg + 3] * sc[3] * __uint_as_float(z.y & 0xffff0000u);
                  u32x2 o; o.x = pg8::cvt_pk_bf16(v0, v1); o.y = pg8::cvt_pk_bf16(v2, v3); *(u32x2*)(p->ya + t * 1536 + 128 * g + dd0) = o; } }
        if (!smp) { if (i0 == SEQ - 64) { for (int c = tid; c < 15 * 512; c += NTHR) { const int rr = c >> 9, ch = c & 511;
              out[O_PPOOL + (((size_t)l * 8 + b) * 15 + rr) * 512 + ch] = bf2f(*(const LAS bf16_t*)(lds + (15 + 49 + rr) * TK_RS + ch * 2)); } } }
        else { for (int c = tid; c < 4 * 8 * 512; c += NTHR) { const int sq = c >> 12, i = (c >> 9) & 7, ch = c & 511;
              out[O_SPOOL + (((size_t)l * DEC_BATCH + s0 + sq) * 15 + 7 + i) * 512 + ch] = bf2f(*(const LAS bf16_t*)(lds + (sq * 23 + 15 + i) * TK_RS + ch * 2)); } }
        if (smp) TP_OFF(53); else TP_OFF(56);
        if (smp) TP_ON(54); else TP_ON(57);
        if ((pmask & 16384) && !smp) tok8(p, l, t0 + wave * 8, i0 + wave * 8, false, 0, lane);
        if (smp) { TP_OFF(51); TP_OFF(54); } else { TP_OFF(50); TP_OFF(57); }
    }
}
__device__ __forceinline__ void ph_tok(KP p, int l, LAS unsigned char* lds) {
    for (int tile = blockIdx.x; tile < TP / 64; tile += gridDim.x) tok_tile<false>(p, l, tile, lds);
    __syncthreads();
}

template <bool SYNC> __device__ __forceinline__ void wu_delta(KP p, int l, int s, int h, int lane, LAS unsigned char* wl) {
    asm volatile("" : "+v"(lane)); int dv = lane;
    const size_t row0 = (size_t)TP + s * 8;
    float* so = p->out + O_SDELTA + (((size_t)l * DEC_BATCH + s) * 8 + h) * 4096;
    const float* s0 = p->state_delta + (((size_t)l * DEC_BATCH + s) * 8 + h) * 4096;
    { const size_t t = row0 + (lane >> 3); const int part = lane & 7;
      const u32x4 kv = *(const u32x4*)(p->kd + t * 512 + h * 64 + part * 8), qv = *(const u32x4*)(p->qd + t * 512 + h * 64 + part * 8);
      *(LAS u32x4*)(wl + lane * 16) = kv; *(LAS u32x4*)(wl + 1024 + lane * 16) = qv; }
    float vv[8], zz[8];
#pragma unroll
    for (int i = 0; i < 8; ++i) { vv[i] = bf2f(p->vd[(row0 + i) * 512 + h * 64 + dv]); zz[i] = bf2f(p->H[(row0 + i) * IN_WP + C_ZDN + h * 64 + dv]); }
    float bl = 0.f, al = 0.f;
    if (lane < 8) { bl = p->bg[(row0 + lane) * 16 + h]; al = __expf(p->bg[(row0 + lane) * 16 + 8 + h]); }
    float S[64];
#pragma unroll
    for (int k = 0; k < 64; ++k) S[k] = s0[k * 64 + dv];
    const float gn = p->dn_norm_g[l * 64 + dv];
    if (SYNC) __builtin_amdgcn_s_barrier();
#pragma unroll
    for (int i = 0; i < 8; ++i) {
        asm volatile("" ::: "memory");
        const float b = __int_as_float(__builtin_amdgcn_readlane(__float_as_int(bl), i)), a = __int_as_float(__builtin_amdgcn_readlane(__float_as_int(al), i));
        u32x4 kk[8];
#pragma unroll
        for (int c = 0; c < 8; ++c) kk[c] = *(const LAS u32x4*)(wl + i * 128 + c * 16);
        float ks = 0.f;
#pragma unroll
        for (int c = 0; c < 8; ++c)
#pragma unroll
            for (int e = 0; e < 4; ++e) { const unsigned w = kk[c][e]; ks += __uint_as_float(w << 16) * S[c * 8 + 2 * e] + __uint_as_float(w & 0xffff0000u) * S[c * 8 + 2 * e + 1]; }
        const float vn = b * (vv[i] - a * ks); float o = 0.f;
#pragma unroll
        for (int c = 0; c < 8; ++c) { const u32x4 qv = *(const LAS u32x4*)(wl + 1024 + i * 128 + c * 16);
#pragma unroll
            for (int e = 0; e < 4; ++e) { const unsigned w = kk[c][e], wq = qv[e]; const int k0 = c * 8 + 2 * e;
                S[k0] = a * S[k0] + __uint_as_float(w << 16) * vn; o += __uint_as_float(wq << 16) * S[k0];
                S[k0 + 1] = a * S[k0 + 1] + __uint_as_float(w & 0xffff0000u) * vn; o += __uint_as_float(wq & 0xffff0000u) * S[k0 + 1]; }
            asm volatile("" ::: "memory"); }
        const float ss = wave_sum(o * o); const float y = o * rsqrtf(ss * (1.0f / 64.0f) + EPS) * gn;
        p->yc[(row0 + i) * 1536 + h * 64 + dv] = f2bf(y * zz[i]);
        if (SYNC) {
#pragma unroll
            for (int k = 0; k < 8; ++k) __builtin_amdgcn_s_barrier(); }
    }
#pragma unroll
    for (int k = 0; k < 64; ++k) so[k * 64 + dv] = S[k];
}
__device__ __forceinline__ int sig_inv(int rho) { return (rho & 32) | ((rho & 12) << 1) | ((rho & 16) >> 2) | (rho & 3); }
constexpr int DPRE_LDS = 64 * 64 * 4 + 512;
constexpr int DST = 72;
__device__ __forceinline__ void dpre_flush(const LAS bf16_t* St, bf16_t* gdst, int lane) {
    asm volatile("s_waitcnt lgkmcnt(0)" ::: "memory");
#pragma unroll
    for (int it = 0; it < 8; ++it) { const int row = 16 * (it >> 1) + (lane & 15), chunk = 4 * (it & 1) + (lane >> 4); *(u32x4*)(gdst + (it * 64 + lane) * 8) = *(const LAS u32x4*)(St + row * DST + chunk * 8); }
    asm volatile("s_waitcnt lgkmcnt(0)" ::: "memory");
}
__device__ __forceinline__ void ph_delta_pre(KP p, LAS unsigned char* lds) {
    int tid_o = threadIdx.x; asm volatile("" : "+v"(tid_o)); int lane = tid_o & 63, wave = tid_o >> 6;
    wave = __builtin_amdgcn_readfirstlane(wave);
    LAS float* Am = (LAS float*)(lds + wave * DPRE_LDS); LAS float* gcs = Am + 4096; LAS float* bts = gcs + 64; LAS bf16_t* St = (LAS bf16_t*)Am;
    for (int unit = wave * gridDim.x + blockIdx.x; unit < 2048; unit += gridDim.x * 8) {
        { int t_ = threadIdx.x; asm volatile("" : "+v"(t_)); lane = t_ & 63; }
        const int r = lane & 31, hh = lane >> 5;
        const int bh = unit >> 5, ch = unit & 31, b = bh >> 3, h = bh & 7;
        const size_t t0 = (size_t)b * SEQ + ch * 64;
        bf16_t* op = p->DOP + (size_t)unit * 4 * 4096; float* up = p->DU + (size_t)unit * 4096;
        const bf16_t* kdb = p->kd + t0 * 512 + h * 64; const bf16_t* qdb = p->qd + t0 * 512 + h * 64; const bf16_t* vdb = p->vd + t0 * 512 + h * 64;
        const float* bgb = p->bg + t0 * 16 + h;
        const float beta = bgb[lane * 16]; float gc = bgb[lane * 16 + 8];
#pragma unroll
        for (int d = 1; d < 64; d <<= 1) { const float x = __shfl_up(gc, d); if (lane >= d) gc += x; }
        const float gl = __shfl(gc, 63); const float egc = __expf(gc);
        gcs[lane] = gc; bts[lane] = beta;
        if (lane == 0) p->DG[unit] = __expf(gl);
        bf16x8_t kf[2][4], qf[2][4];
        { const int voff = r * 512 + 8 * hh;
#pragma unroll
          for (int rb = 0; rb < 2; ++rb)
#pragma unroll
            for (int ks = 0; ks < 4; ++ks) { kf[rb][ks] = *(const bf16x8_t*)(kdb + (32 * rb * 512 + 16 * ks) + voff); qf[rb][ks] = *(const bf16x8_t*)(qdb + (32 * rb * 512 + 16 * ks) + voff); } }
        {
#pragma unroll
            for (int rb = 0; rb < 2; ++rb) { const float sc = __expf(gl - __shfl(gc, 32 * rb + r)); const int pos = sig_inv(32 * rb + r);
#pragma unroll
                for (int ks = 0; ks < 4; ++ks)
#pragma unroll
                    for (int jj = 0; jj < 8; ++jj) St[(16 * ks + 8 * hh + jj) * DST + pos] = f2bf(bf2f((bf16_t)kf[rb][ks][jj]) * sc); }
            dpre_flush(St, op + 3 * 4096, lane);
#pragma unroll
            for (int rb = 0; rb < 2; ++rb) { const float sc = __shfl(egc, 32 * rb + r);
#pragma unroll
                for (int ks = 0; ks < 4; ++ks)
#pragma unroll
                    for (int jj = 0; jj < 8; ++jj) St[(32 * rb + r) * DST + sig_inv(16 * ks + 8 * hh + jj)] = f2bf(bf2f((bf16_t)qf[rb][ks][jj]) * sc); }
            dpre_flush(St, op + 1 * 4096, lane);
        }
        float xu[64];
        {
#pragma unroll
            for (int it = 0; it < 8; ++it) { const int row = (lane >> 3) + 8 * it, chunk = lane & 7; *(LAS u32x4*)(St + row * DST + chunk * 8) = *(const u32x4*)(vdb + row * 512 + chunk * 8); }
            asm volatile("s_waitcnt lgkmcnt(0)" ::: "memory");
            const int beta_i = __float_as_int(beta);
#pragma unroll
            for (int i = 0; i < 64; ++i) xu[i] = __int_as_float(__builtin_amdgcn_readlane(beta_i, i)) * bf2f(St[i * DST + lane]);
            asm volatile("s_waitcnt lgkmcnt(0)" ::: "memory");
        }
        {
            const float gcj0 = __shfl(gc, r), gcj1 = __shfl(gc, 32 + r);
            const int p0 = sig_inv(r), p1 = sig_inv(32 + r);
            { f32x16 t00, t10, t11;
#pragma unroll
              for (int e = 0; e < 16; ++e) { t00[e] = 0.f; t10[e] = 0.f; t11[e] = 0.f; }
#pragma unroll
              for (int ks = 0; ks < 4; ++ks) {
                  t00 = __builtin_amdgcn_mfma_f32_32x32x16_bf16(qf[0][ks], kf[0][ks], t00, 0, 0, 0);
                  t10 = __builtin_amdgcn_mfma_f32_32x32x16_bf16(qf[1][ks], kf[0][ks], t10, 0, 0, 0);
                  t11 = __builtin_amdgcn_mfma_f32_32x32x16_bf16(qf[1][ks], kf[1][ks], t11, 0, 0, 0); }
#pragma unroll
              for (int e = 0; e < 16; ++e) { const int il = (e & 3) + 8 * (e >> 2) + 4 * hh;
                  { const int i = il, j = r; St[i * DST + p0] = f2bf(j <= i ? t00[e] * __expf(fminf(gcs[i] - gcj0, 0.f)) : 0.f); St[i * DST + p1] = 0; }
                  { const int i = 32 + il; St[i * DST + p0] = f2bf(t10[e] * __expf(fminf(gcs[i] - gcj0, 0.f))); }
                  { const int i = 32 + il, j = 32 + r; St[i * DST + p1] = f2bf(j <= i ? t11[e] * __expf(fminf(gcs[i] - gcj1, 0.f)) : 0.f); } }
              dpre_flush(St, op + 2 * 4096, lane); }
            { f32x16 t00, t10, t11;
#pragma unroll
              for (int e = 0; e < 16; ++e) { t00[e] = 0.f; t10[e] = 0.f; t11[e] = 0.f; }
#pragma unroll
              for (int ks = 0; ks < 4; ++ks) {
                  t00 = __builtin_amdgcn_mfma_f32_32x32x16_bf16(kf[0][ks], kf[0][ks], t00, 0, 0, 0);
                  t10 = __builtin_amdgcn_mfma_f32_32x32x16_bf16(kf[1][ks], kf[0][ks], t10, 0, 0, 0);
                  t11 = __builtin_amdgcn_mfma_f32_32x32x16_bf16(kf[1][ks], kf[1][ks], t11, 0, 0, 0); }
#pragma unroll
              for (int e = 0; e < 16; ++e) { const int il = (e & 3) + 8 * (e >> 2) + 4 * hh;
                  { const int i = il, j = r; Am[i * 64 + j] = j < i ? bts[i] * t00[e] * __expf(fminf(gcs[i] - gcj0, 0.f)) : 0.f; }
                  { const int i = 32 + il, j = r; Am[i * 64 + j] = bts[i] * t10[e] * __expf(fminf(gcs[i] - gcj0, 0.f)); }
                  { const int i = 32 + il, j = 32 + r; Am[i * 64 + j] = j < i ? bts[i] * t11[e] * __expf(fminf(gcs[i] - gcj1, 0.f)) : 0.f; } } }
        }
        asm volatile("s_waitcnt lgkmcnt(0)" ::: "memory");
        {
            int c; { int t_ = threadIdx.x; asm volatile("" : "+v"(t_)); c = t_ & 63; } const int pc = sig_inv(c);
            const int beta_i = __float_as_int(beta), egc_i = __float_as_int(egc);
#pragma unroll
            for (int i = 1; i < 64; ++i) { float au = xu[i];
#pragma unroll
                for (int j4 = 0; j4 < i; j4 += 4) { const f32x4 a = *(const LAS f32x4*)(Am + i * 64 + j4);
#pragma unroll
                    for (int e = 0; e < 4; ++e) if (j4 + e < i) au -= a[e] * xu[j4 + e]; }
                xu[i] = au; }
#pragma unroll
            for (int k = 0; k < 16; ++k)
                *(f32x4*)(up + ((((c >> 4) * 4 + (k >> 2)) * 64 + (k & 3) * 16 + (c & 15)) << 2)) = (f32x4){xu[4 * k], xu[4 * k + 1], xu[4 * k + 2], xu[4 * k + 3]};
            asm volatile("" ::: "memory");
            { float w[64];
#pragma unroll
              for (int i = 0; i < 64; ++i) w[i] = __int_as_float(__builtin_amdgcn_readlane(beta_i, i)) * __int_as_float(__builtin_amdgcn_readlane(egc_i, i)) * bf2f((kdb + i * 512)[c]);
#pragma unroll
              for (int i = 1; i < 64; ++i) { float aw = w[i];
#pragma unroll
                  for (int j4 = 0; j4 < i; j4 += 4) { const f32x4 a = *(const LAS f32x4*)(Am + i * 64 + j4);
#pragma unroll
                      for (int e = 0; e < 4; ++e) if (j4 + e < i) aw -= a[e] * w[j4 + e]; }
                  w[i] = aw; }
              asm volatile("s_waitcnt lgkmcnt(0)" ::: "memory");
#pragma unroll
              for (int i = 0; i < 64; ++i) St[i * DST + pc] = f2bf(-w[i]); }
            dpre_flush(St, op, lane);
        }
    }
}
__device__ __forceinline__ void st_rows2(bf16_t* row0, bf16_t* row1, unsigned pos, float a, float b, bool even) {
    const float x = even ? b : a;
    const float y = __int_as_float(__builtin_amdgcn_mov_dpp(__float_as_int(x), 0xB1, 0xF, 0xF, true));
    const unsigned w = even ? pg8::cvt_pk_bf16(a, y) : pg8::cvt_pk_bf16(y, b);
    bf16_t* dst = even ? row0 + pos : row1 + (pos - 1u);
    *(unsigned*)dst = w;
}
constexpr int BSS = 144, BS_NBAR = 65;
struct BsSet { bf16x8_t w0, w1, g0, g1, k0, k1, t0, t1; f32x4 u; };
__device__ __forceinline__ void bs_load(BsSet& c, const bf16_t* op, const float* up) {
    c.w0 = *(const bf16x8_t*)(op); c.w1 = *(const bf16x8_t*)(op + 512); c.g0 = *(const bf16x8_t*)(op + 4096); c.g1 = *(const bf16x8_t*)(op + 4096 + 512);
    c.k0 = *(const bf16x8_t*)(op + 8192); c.k1 = *(const bf16x8_t*)(op + 8192 + 512); c.t0 = *(const bf16x8_t*)(op + 12288); c.t1 = *(const bf16x8_t*)(op + 12288 + 512);
    c.u = *(const f32x4*)up;
}
__device__ __forceinline__ u32x2 pack_h(const f32x4& v) { u32x2 w; w.x = pg8::cvt_pk_bf16(v[0], v[1]); w.y = pg8::cvt_pk_bf16(v[2], v[3]); return w; }
__device__ __forceinline__ void bs_step(BsSet& c, f32x4& S, float eg, LAS unsigned char* SB, LAS unsigned char* VB, int rd, int wr, bool hik, bf16_t* yo, unsigned n, bool even, const bf16_t* opn, const float* upn) {
    TP_DECL; TP_ON(30);
    const bf16x8_t sb0 = *(const LAS bf16x8_t*)(SB + rd), sb1 = *(const LAS bf16x8_t*)(SB + rd + 64);
    f32x4 vn = __builtin_amdgcn_mfma_f32_16x16x32_bf16(c.w0, sb0, c.u, 0, 0, 0); vn = __builtin_amdgcn_mfma_f32_16x16x32_bf16(c.w1, sb1, vn, 0, 0, 0);
    f32x4 o = __builtin_amdgcn_mfma_f32_16x16x32_bf16(c.g0, sb0, (f32x4){0.f, 0.f, 0.f, 0.f}, 0, 0, 0); o = __builtin_amdgcn_mfma_f32_16x16x32_bf16(c.g1, sb1, o, 0, 0, 0);
    *(LAS u32x2*)(VB + wr) = pack_h(vn);
    TP_ON(36); __syncthreads();
    TP_OFFW(36, 0); TP_OFFW(30, 0); TP_ON(31);
    const bf16x8_t vb0 = *(const LAS bf16x8_t*)(VB + rd), vb1 = *(const LAS bf16x8_t*)(VB + rd + 64);
    o = __builtin_amdgcn_mfma_f32_16x16x32_bf16(c.k0, vb0, o, 0, 0, 0);
    if (hik) o = __builtin_amdgcn_mfma_f32_16x16x32_bf16(c.k1, vb1, o, 0, 0, 0);
    S = S * eg;
    S = __builtin_amdgcn_mfma_f32_16x16x32_bf16(c.t0, vb0, S, 0, 0, 0); S = __builtin_amdgcn_mfma_f32_16x16x32_bf16(c.t1, vb1, S, 0, 0, 0);
    *(LAS u32x2*)(SB + wr) = pack_h(S);
    TP_OFFW(31, 0); TP_ON(33);
    bs_load(c, opn, upn);
    TP_OFFW(33, 0); TP_ON(34);
#pragma unroll
    for (int e = 0; e < 4; e += 2) st_rows2(yo + (size_t)e * 1536, yo + (size_t)(e + 1) * 1536, n, o[e], o[e + 1], even);
    TP_OFFW(34, 0); TP_ON(35);
    __syncthreads();
    TP_OFFW(35, 0);
}
__device__ __forceinline__ void slice_scan(KP p, int l, int unit, LAS unsigned char* lds, int lane, int mt) {
    asm volatile("" : "+v"(lane));
    const int n = lane & 15, q = lane >> 4, bh = unit >> 2, slice = unit & 3, b = bh >> 3, h = bh & 7;
    LAS unsigned char* SB = lds; LAS unsigned char* VB = lds + 16 * BSS;
    const int pos0 = ((mt & 2) << 4) + 8 * q + ((mt & 1) << 2);
    const int wr = n * BSS + pos0 * 2, rd = n * BSS + 16 * q;
    const bf16_t* op0 = p->DOP + (size_t)bh * 32 * 4 * 4096 + mt * 1024 + lane * 8;
    const float* up0 = p->DU + (size_t)bh * 32 * 4096 + ((slice * 4 + mt) * 64 + lane) * 4;
    const float egv = p->DG[bh * 32 + (lane & 31)];
    bf16_t* yo0 = p->yc + ((size_t)b * SEQ + 16 * mt + 4 * q) * 1536 + h * 64 + 16 * slice;
    __builtin_amdgcn_s_waitcnt(0);
    BsSet st[4];
#pragma unroll
    for (int i = 0; i < 4; ++i) bs_load(st[i], op0 + (size_t)i * 16384, up0 + (size_t)i * 4096);
    f32x4 S = (f32x4){0.f, 0.f, 0.f, 0.f};
    { unsigned z = 0u; asm volatile("" : "+v"(z)); *(LAS u32x2*)(SB + wr) = (u32x2){z, z}; }
    __syncthreads();
    const bool hik = mt >= 2, even = (lane & 1) == 0;
#pragma unroll 1
    for (int ch = 0; ch < 32; ch += 4) {
#pragma unroll
        for (int i = 0; i < 4; ++i) { const int cn = ch + i + 4 < 32 ? ch + i + 4 : 31;
            const float eg = __int_as_float(__builtin_amdgcn_readlane(__float_as_int(egv), ch + i));
            bs_step(st[i], S, eg, SB, VB, rd, wr, hik, yo0 + (size_t)(ch + i) * 64 * 1536, (unsigned)n, even, op0 + (size_t)cn * 16384, up0 + (size_t)cn * 4096); }
    }
    float* so = p->out + O_PDELTA + (((size_t)l * 8 + b) * 8 + h) * 4096 + (16 * mt + 4 * q) * 64 + 16 * slice + n;
#pragma unroll
    for (int e = 0; e < 4; ++e) so[e * 64] = S[e];
}
__device__ __forceinline__ void ph_delta_fin(KP p, int l) {
    int tid_o = threadIdx.x; asm volatile("" : "+v"(tid_o)); int lane = tid_o & 63, wave = tid_o >> 6;
    const int h = lane >> 3, d0 = (lane & 7) * 8;
    const int stride = gridDim.x * 8;
    float gn[8];
#pragma unroll
    for (int e = 0; e < 8; ++e) gn[e] = p->dn_norm_g[l * 64 + d0 + e];
    for (int t0 = blockIdx.x * 8 + wave; t0 < TP; t0 += 4 * stride) {
        u32x4 rawv[4], gzv[4];
#pragma unroll
        for (int j = 0; j < 4; ++j) { const int t = t0 + j * stride < TP ? t0 + j * stride : t0; rawv[j] = *(const u32x4*)(p->yc + (size_t)t * 1536 + h * 64 + d0); gzv[j] = *(const u32x4*)(p->H + (size_t)t * IN_WP + C_ZDN + h * 64 + d0); }
#pragma unroll
        for (int j = 0; j < 4; ++j) { const int t = t0 + j * stride; if (t >= TP) break;
            float v[8], z[8]; unpack8(rawv[j], v); unpack8(gzv[j], z);
            float ss = 0.f;
#pragma unroll
            for (int e = 0; e < 8; ++e) ss += v[e] * v[e];
            ss += __shfl_xor(ss, 1); ss += __shfl_xor(ss, 2); ss += __shfl_xor(ss, 4);
            const float rs = rsqrtf(ss * (1.0f / 64.0f) + EPS);
#pragma unroll
            for (int e = 0; e < 8; ++e) v[e] = v[e] * rs * gn[e] * z[e];
            *(u32x4*)(p->yc + (size_t)t * 1536 + h * 64 + d0) = pack8(v); }
    }
}

__device__ __forceinline__ void ph_att_waves(KP p, int l, LAS unsigned char* lds) {
    int tid_o = threadIdx.x; asm volatile("" : "+v"(tid_o)); int lane = tid_o & 63, wave = tid_o >> 6;
    wave = __builtin_amdgcn_readfirstlane(wave);
    const int G = gridDim.x;
    TP_DECL; TP_ON(20); TP_ON(22);
    for (int ub = blockIdx.x; ub < 256; ub += G) { const int u = ((ub & 7) << 5) | (ub >> 3);
        if (wave < 4) slice_scan(p, l, u, lds, lane, wave);
#if defined(TPROBE) && TPROBE == 22
        else if (wave == 4) { for (int k = 0; k < BS_NBAR; ++k) __builtin_amdgcn_s_barrier(); wu_delta<false>(p, l, u >> 3, u & 7, lane, lds + 32768); }
#else
        else if (wave == 4) wu_delta<true>(p, l, u >> 3, u & 7, lane, lds + 32768);
#endif
        else { for (int k = 0; k < BS_NBAR; ++k) __builtin_amdgcn_s_barrier(); }
    }
    if (wave == 0) { TP_OFFW(20, 0); TP_OFFW(22, 0); }
}
__device__ __forceinline__ void ph_fin(KP p, int l, LAS unsigned char* lds) {
    int tid_o = threadIdx.x; asm volatile("" : "+v"(tid_o)); int lane = tid_o & 63, wave = tid_o >> 6;
    LAS float* ol = (LAS float*)(lds + wave * 1024);
    const float* w_uv = p->w_uv + (size_t)l * 256 * 512;
    const int cq = lane >> 4, d4 = lane & 15;
    for (int u = blockIdx.x * 8 + wave; u < TS * 8; u += gridDim.x * 8) {
        const int ts = u >> 3, h = u & 7, s = ts >> 3, r = (ts & 7) * 8 + h;
        const float* pb = p->part + ((size_t)s * SA_CH * 64 + r) * 258;
        float mc = -1e30f, lc = 0.f;
        if (lane < SA_CH) { mc = pb[(size_t)lane * 64 * 258 + 256]; lc = pb[(size_t)lane * 64 * 258 + 257]; }
        float M = mc;
#pragma unroll
        for (int o = 1; o < 8; o <<= 1) M = fmaxf(M, __shfl_xor(M, o));
        const float wc = lane < SA_CH ? __expf(mc - M) : 0.f; float L = lc * wc;
#pragma unroll
        for (int o = 1; o < 8; o <<= 1) L += __shfl_xor(L, o);
        const float iL = 1.0f / __int_as_float(__builtin_amdgcn_readlane(__float_as_int(L), 0));
        f32x4 acc = (f32x4){0.f, 0.f, 0.f, 0.f};
#pragma unroll
        for (int ch = 0; ch < SA_CH; ++ch) { const float w = __int_as_float(__builtin_amdgcn_readlane(__float_as_int(wc), ch)); const float* pp = pb + (size_t)ch * 64 * 258 + 4 * lane;
            const f32x2 a0 = *(const f32x2*)pp, a1 = *(const f32x2*)(pp + 2); acc[0] += w * a0[0]; acc[1] += w * a0[1]; acc[2] += w * a1[0]; acc[3] += w * a1[1]; }
        *(LAS f32x4*)(ol + 4 * lane) = acc * iL;
        asm volatile("s_waitcnt lgkmcnt(0)" ::: "memory");
        f32x4 o = (f32x4){0.f, 0.f, 0.f, 0.f}; const float* wp = w_uv + (size_t)(cq * 64) * 512 + h * 64 + 4 * d4;
#pragma unroll 16
        for (int c = 0; c < 64; ++c) { const f32x4 wv = *(const f32x4*)(wp + (size_t)c * 512); const float x = ol[cq * 64 + c]; o += wv * x; }
#pragma unroll
        for (int e = 0; e < 4; ++e) { o[e] += __shfl_xor(o[e], 16); o[e] += __shfl_xor(o[e], 32); }
        if (cq == 0) { const int t = TP + ts; const u32x2 gz = *(const u32x2*)(p->H + (size_t)t * IN_WP + C_ZMLA + h * 64 + 4 * d4);
            u32x2 w; w.x = pg8::cvt_pk_bf16(o[0] * __uint_as_float(gz.x << 16), o[1] * __uint_as_float(gz.x & 0xffff0000u)); w.y = pg8::cvt_pk_bf16(o[2] * __uint_as_float(gz.y << 16), o[3] * __uint_as_float(gz.y & 0xffff0000u));
            *(u32x2*)(p->yb + (size_t)t * 1536 + h * 64 + 4 * d4) = w; }
        asm volatile("s_waitcnt lgkmcnt(0)" ::: "memory");
    }
}

constexpr int SA_QS = 592, SA_KS = 592, SA_PS = 272;
constexpr int SA_OFF_Q = 0, SA_OFF_K = 64 * SA_QS, SA_OFF_P = SA_OFF_K + 128 * SA_KS, SA_OFF_M = SA_OFF_P + 64 * SA_PS, SA_OFF_L = SA_OFF_M + 1024, SA_LDS = SA_OFF_L + 1024;
typedef short s16x4 __attribute__((ext_vector_type(4)));
__device__ __forceinline__ void sa_unit(KP p, int l, int s, int ch, LAS unsigned char* lds, int tid) {
    const int lane = tid & 63, wave = __builtin_amdgcn_readfirstlane(tid >> 6), r = lane & 31, hh = lane >> 5;
    const int qb = wave & 1, kb = wave >> 1, cg = wave >> 1;
    LAS unsigned char* Qs = lds + SA_OFF_Q; LAS unsigned char* Kt = lds + SA_OFF_K; LAS unsigned char* Pt = lds + SA_OFF_P;
    LAS float* mloc = (LAS float*)(lds + SA_OFF_M); LAS float* lred = (LAS float*)(lds + SA_OFF_L);
    TP_DECL; TP_ON(10); TP_ON(11);
    __syncthreads();
    { const bf16_t* wb = p->WukB + (size_t)l * 256 * 512 + (size_t)r * 512 + wave * 64 + 8 * hh; const bf16_t* Qg = p->Q + (size_t)(TP + s * 8) * 768;
      bf16x8_t qv[4];
#pragma unroll
      for (int ks = 0; ks < 4; ++ks) { u32x4 z = (u32x4){0u, 0u, 0u, 0u}; if (r < 8) z = *(const u32x4*)(Qg + r * 768 + wave * 96 + ks * 16 + 8 * hh); union { u32x4 u; bf16x8_t v; } x; x.u = z; qv[ks] = x.v; }
#pragma unroll
      for (int cb = 0; cb < 8; ++cb) { f32x16 acc;
#pragma unroll
          for (int e = 0; e < 16; ++e) acc[e] = 0.f;
#pragma unroll
          for (int ks = 0; ks < 4; ++ks) acc = __builtin_amdgcn_mfma_f32_32x32x16_bf16(*(const bf16x8_t*)(wb + (size_t)(32 * cb) * 512 + ks * 16), qv[ks], acc, 0, 0, 0);
          if (r < 8) {
#pragma unroll
              for (int g4 = 0; g4 < 4; ++g4) { u32x2 w; w.x = pg8::cvt_pk_bf16(acc[4 * g4], acc[4 * g4 + 1]); w.y = pg8::cvt_pk_bf16(acc[4 * g4 + 2], acc[4 * g4 + 3]);
                  *(LAS u32x2*)(Qs + (r * 8 + wave) * SA_QS + (32 * cb + 8 * g4 + 4 * hh) * 2) = w; } } }
      for (int e = tid; e < 64 * 32; e += NTHR) { const int rr = e >> 5, j = e & 31; *(LAS bf16_t*)(Qs + rr * SA_QS + (256 + j) * 2) = Qg[(rr >> 3) * 768 + (rr & 7) * 96 + 64 + j]; } }
    TP_OFF(11);
    const int* pt = p->page_table + s * N_PAGES + ch * 16;
    const float* ckv_base = p->cache_kv + (size_t)l * N_POOL * PAGE * 256; const float* ckr_base = p->cache_kr + (size_t)l * N_POOL * PAGE * 32;
    f32x4 rk[16], rr2[2];
    { const int page = pt[0]; const float* kvp = ckv_base + (size_t)page * PAGE * 256; const float* krp = ckr_base + (size_t)page * PAGE * 32;
#pragma unroll
      for (int i = 0; i < 16; ++i) rk[i] = __builtin_nontemporal_load((const f32x4*)(kvp + (size_t)(tid + 512 * i) * 4));
#pragma unroll
      for (int i = 0; i < 2; ++i) rr2[i] = __builtin_nontemporal_load((const f32x4*)(krp + (size_t)(tid + 512 * i) * 4)); }
    f32x16 o0, o1;
#pragma unroll
    for (int e = 0; e < 16; ++e) { o0[e] = 0.f; o1[e] = 0.f; }
    float m = -1e30f, lw = 0.f;
    const int li = lane & 15, g1 = (lane >> 4) & 1;
    const int trOff = (8 * hh + (li >> 2)) * SA_KS + (16 * g1 + 4 * (li & 3)) * 2;
    const int ntile = ch == 7 ? 17 : 16;
    for (int t = 0; t < ntile; ++t) {
        TP_ON(12); TP_ON(16);
        __syncthreads();
        TP_OFF(16);
        if (t < 16) {
#pragma unroll
            for (int i = 0; i < 16; ++i) { const int ci = tid + 512 * i, key = ci >> 6, c4 = ci & 63; u32x2 w; w.x = pg8::cvt_pk_bf16(rk[i][0], rk[i][1]); w.y = pg8::cvt_pk_bf16(rk[i][2], rk[i][3]);
                *(LAS u32x2*)(Kt + key * SA_KS + c4 * 8) = w; }
#pragma unroll
            for (int i = 0; i < 2; ++i) { const int ci = tid + 512 * i, key = ci >> 3, c4 = ci & 7; u32x2 w; w.x = pg8::cvt_pk_bf16(rr2[i][0], rr2[i][1]); w.y = pg8::cvt_pk_bf16(rr2[i][2], rr2[i][3]);
                *(LAS u32x2*)(Kt + key * SA_KS + 512 + c4 * 8) = w; }
        } else {
            for (int e = tid; e < 128 * 36; e += NTHR) { const int key = e / 36, c16 = e - key * 36; u32x4 v = (u32x4){0u, 0u, 0u, 0u};
                if (key < 8) v = c16 < 32 ? *(const u32x4*)(p->ckv + ((size_t)TP + s * 8 + key) * 256 + c16 * 8) : *(const u32x4*)(p->Kr + ((size_t)TP + s * 8 + key) * 32 + (c16 - 32) * 8);
                *(LAS u32x4*)(Kt + key * SA_KS + c16 * 16) = v; }
        }
        TP_ON(17); __syncthreads(); TP_OFF(17);
        TP_OFF(12); TP_ON(13);
        if (t + 1 < 16) { const int page = pt[t + 1]; const float* kvp = ckv_base + (size_t)page * PAGE * 256; const float* krp = ckr_base + (size_t)page * PAGE * 32;
#pragma unroll
            for (int i = 0; i < 16; ++i) rk[i] = __builtin_nontemporal_load((const f32x4*)(kvp + (size_t)(tid + 512 * i) * 4));
#pragma unroll
            for (int i = 0; i < 2; ++i) rr2[i] = __builtin_nontemporal_load((const f32x4*)(krp + (size_t)(tid + 512 * i) * 4)); }
        f32x16 sa;
#pragma unroll
        for (int e = 0; e < 16; ++e) sa[e] = 0.f;
        { const LAS unsigned char* ka = Kt + (32 * kb + r) * SA_KS + 16 * hh; const LAS unsigned char* qa = Qs + (32 * qb + r) * SA_QS + 16 * hh;
#pragma unroll
          for (int ks = 0; ks < 18; ++ks) sa = __builtin_amdgcn_mfma_f32_32x32x16_bf16(*(const LAS bf16x8_t*)(ka + ks * 32), *(const LAS bf16x8_t*)(qa + ks * 32), sa, 0, 0, 0); }
        if (t == 16) { const int itok = (32 * qb + r) >> 3;
#pragma unroll
            for (int e = 0; e < 16; ++e) { const int key = 32 * kb + (e & 3) + 8 * (e >> 2) + 4 * hh; if (key > itok) sa[e] = -1e30f; } }
        float tm = sa[0];
#pragma unroll
        for (int e = 1; e < 16; ++e) tm = fmaxf(tm, sa[e]);
        tm = fmaxf(tm, __shfl_xor(tm, 32));
        if (hh == 0) mloc[kb * 64 + 32 * qb + r] = tm;
        __syncthreads();
        TP_OFF(13); TP_ON(14);
        { const int q = 32 * qb + r; const float tmx = fmaxf(fmaxf(mloc[q], mloc[64 + q]), fmaxf(mloc[128 + q], mloc[192 + q]));
          const float mn = fmaxf(m, tmx), al = __builtin_amdgcn_exp2f((m - mn) * ATT_C), mc = mn * ATT_C; m = mn;
          float ps = 0.f;
#pragma unroll
          for (int e = 0; e < 16; ++e) { sa[e] = __builtin_amdgcn_exp2f(sa[e] * ATT_C - mc); ps += sa[e]; }
          lw = lw * al + ps;
#pragma unroll
          for (int g4 = 0; g4 < 4; ++g4) { u32x2 w; w.x = pg8::cvt_pk_bf16(sa[4 * g4], sa[4 * g4 + 1]); w.y = pg8::cvt_pk_bf16(sa[4 * g4 + 2], sa[4 * g4 + 3]);
              *(LAS u32x2*)(Pt + q * SA_PS + (32 * kb + 8 * g4 + 4 * hh) * 2) = w; }
#pragma unroll
          for (int e = 0; e < 16; ++e) { o0[e] *= al; o1[e] *= al; } }
        __syncthreads();
        TP_OFF(14); TP_ON(15);
        { const LAS unsigned char* pa = Pt + (32 * qb + r) * SA_PS + 16 * hh; const LAS unsigned char* va = Kt + trOff + (64 * cg) * 2;
#pragma unroll
          for (int ks = 0; ks < 8; ++ks) { const bf16x8_t pb = *(const LAS bf16x8_t*)(pa + ks * 32);
              union { struct { s16x4 lo, hi; } h; bf16x8_t v; } a0, a1;
              a0.h.lo = __builtin_amdgcn_ds_read_tr16_b64_v4i16((LAS s16x4*)(va + ks * 16 * SA_KS)); a0.h.hi = __builtin_amdgcn_ds_read_tr16_b64_v4i16((LAS s16x4*)(va + ks * 16 * SA_KS + 4 * SA_KS));
              a1.h.lo = __builtin_amdgcn_ds_read_tr16_b64_v4i16((LAS s16x4*)(va + ks * 16 * SA_KS + 64)); a1.h.hi = __builtin_amdgcn_ds_read_tr16_b64_v4i16((LAS s16x4*)(va + ks * 16 * SA_KS + 4 * SA_KS + 64));
              o0 = __builtin_amdgcn_mfma_f32_32x32x16_bf16(a0.v, pb, o0, 0, 0, 0);
              o1 = __builtin_amdgcn_mfma_f32_32x32x16_bf16(a1.v, pb, o1, 0, 0, 0); } }
        TP_OFF(15);
    }
    lw += __shfl_xor(lw, 32);
    if (hh == 0) lred[kb * 64 + 32 * qb + r] = lw;
    __syncthreads();
    { const int q = 32 * qb + r; float* pp = p->part + (((size_t)s * SA_CH + ch) * 64 + q) * 258;
#pragma unroll
      for (int cb2 = 0; cb2 < 2; ++cb2)
#pragma unroll
          for (int g4 = 0; g4 < 4; ++g4) { const int c = 32 * (2 * cg + cb2) + 8 * g4 + 4 * hh; f32x4 v;
#pragma unroll
              for (int e = 0; e < 4; ++e) v[e] = cb2 == 0 ? o0[4 * g4 + e] : o1[4 * g4 + e];
              *(f32x2*)(pp + c) = (f32x2){v[0], v[1]}; *(f32x2*)(pp + c + 2) = (f32x2){v[2], v[3]}; }
      if (cg == 0 && hh == 0) { pp[256] = m * MLA_SCALE; pp[257] = lred[q] + lred[64 + q] + lred[128 + q] + lred[192 + q]; } }
    TP_OFF(10);
}
__device__ __forceinline__ void ph_attn_s2(KP p, int l, LAS unsigned char* lds) {
    int tid = threadIdx.x; asm volatile("" : "+v"(tid));
    for (int u = blockIdx.x; u < DEC_BATCH * 8; u += gridDim.x) sa_unit(p, l, u >> 3, u & 7, lds, tid);
    __syncthreads();
}

constexpr int ATT_KS = 208, ATT_VS = 144, ATT_KB = 64 * ATT_KS, ATT_VB = 64 * ATT_VS, ATT_STAGE = ATT_KB + ATT_VB;
__device__ __forceinline__ void attn_unit(KP p, int b, int h, int qblk, LAS unsigned char* lds, int tid, int wave, int lane) {
    const int r = lane & 31, hh = lane >> 5;
    const int q0 = qblk * 256 + wave * 32;
    __builtin_amdgcn_s_waitcnt(0);
    const size_t trow0 = (size_t)b * SEQ;
    bf16x8_t qf[6];
    { const bf16_t* qp = p->Q + (trow0 + q0 + r) * 768 + h * 96 + 8 * hh;
#pragma unroll
      for (int ks = 0; ks < 6; ++ks) qf[ks] = *(const bf16x8_t*)(qp + 16 * ks); }
    f32x16 o0, o1;
#pragma unroll
    for (int e = 0; e < 16; ++e) { o0[e] = 0.f; o1[e] = 0.f; }
    float m = -1e30f, lsum = 0.f;
    const int ntile = qblk * 4 + 4;
    const int cA = tid, keyA = cA / 12, partA = cA - keyA * 12; const int cB = 512 + (tid & 255), keyB = cB / 12, partB = cB - keyB * 12; const bool hasB = tid < 256;
    const bf16_t* gA = partA < 8 ? p->Kn + (trow0 + keyA) * 512 + h * 64 + partA * 8 : p->Kr + (trow0 + keyA) * 32 + (partA - 8) * 8; const int stepA = partA < 8 ? 64 * 512 : 64 * 32;
    const bf16_t* gB = !hasB ? gA : partB < 8 ? p->Kn + (trow0 + keyB) * 512 + h * 64 + partB * 8 : p->Kr + (trow0 + keyB) * 32 + (partB - 8) * 8; const int stepB = !hasB ? stepA : partB < 8 ? 64 * 512 : 64 * 32;
    const bf16_t* gV = p->Vt + (size_t)(h * 64 + (tid >> 3)) * TP + trow0 + (tid & 7) * 8;
    const int lA = keyA * ATT_KS + partA * 16, lB = hasB ? keyB * ATT_KS + partB * 16 : (tid & 63) * ATT_KS + 192, lV = ATT_KB + (tid >> 3) * ATT_VS + (tid & 7) * 16;
    const int pr_ = (r & 0x13) | ((r & 4) << 1) | ((r & 8) >> 1);
    const int kOff = pr_ * ATT_KS + 16 * hh, vOff = ATT_KB + r * ATT_VS + 16 * hh;
#define ATT_COMPUTE() do { \
        if (kt * 64 <= q0 + 31) { \
            f32x16 s0, s1; TP_ON(2); \
_Pragma("unroll") \
            for (int e = 0; e < 16; ++e) { s0[e] = 0.f; s1[e] = 0.f; } \
_Pragma("unroll") \
            for (int ks = 0; ks < 6; ++ks) { \
                const bf16x8_t a0 = *(const LAS bf16x8_t*)(st + kOff + ks * 32), a1 = *(const LAS bf16x8_t*)(st + kOff + 32 * ATT_KS + ks * 32); \
                s0 = __builtin_amdgcn_mfma_f32_32x32x16_bf16(a0, qf[ks], s0, 0, 0, 0); \
                s1 = __builtin_amdgcn_mfma_f32_32x32x16_bf16(a1, qf[ks], s1, 0, 0, 0); \
            } \
            TP_OFF(2); TP_ON(3); if (kt * 64 + 63 > q0) { \
                const int qrel = q0 + r - kt * 64; \
_Pragma("unroll") \
                for (int e = 0; e < 16; ++e) { const int kl = (e & 3) + 4 * ((e >> 2) & 1) + 8 * hh + 16 * ((e >> 3) & 1); \
                    if (kl > qrel) s0[e] = -1e30f; if (kl + 32 > qrel) s1[e] = -1e30f; } \
            } \
            float tm = fmaxf(s0[0], s1[0]); \
_Pragma("unroll") \
            for (int e = 1; e < 16; ++e) tm = fmaxf(tm, fmaxf(s0[e], s1[e])); \
            tm = fmaxf(tm, __shfl_xor(tm, 32)); \
            const float mn = fmaxf(m, tm), al = __builtin_amdgcn_exp2f((m - mn) * ATT_C), mc = mn * ATT_C; m = mn; \
            float ps = 0.f; \
_Pragma("unroll") \
            for (int e = 0; e < 16; ++e) { s0[e] = __builtin_amdgcn_exp2f(s0[e] * ATT_C - mc); s1[e] = __builtin_amdgcn_exp2f(s1[e] * ATT_C - mc); ps += s0[e] + s1[e]; } \
            lsum = lsum * al + ps; \
_Pragma("unroll") \
            for (int e = 0; e < 16; ++e) { o0[e] *= al; o1[e] *= al; } \
            TP_OFF(3); TP_ON(4); \
_Pragma("unroll") \
            for (int kb = 0; kb < 2; ++kb) \
_Pragma("unroll") \
                for (int sp = 0; sp < 2; ++sp) { \
                    union { u32x4 u; bf16x8_t v; } pb; \
                    if (kb == 0) { pb.u.x = pg8::cvt_pk_bf16(s0[8 * sp + 0], s0[8 * sp + 1]); pb.u.y = pg8::cvt_pk_bf16(s0[8 * sp + 2], s0[8 * sp + 3]); pb.u.z = pg8::cvt_pk_bf16(s0[8 * sp + 4], s0[8 * sp + 5]); pb.u.w = pg8::cvt_pk_bf16(s0[8 * sp + 6], s0[8 * sp + 7]); } \
                    else         { pb.u.x = pg8::cvt_pk_bf16(s1[8 * sp + 0], s1[8 * sp + 1]); pb.u.y = pg8::cvt_pk_bf16(s1[8 * sp + 2], s1[8 * sp + 3]); pb.u.z = pg8::cvt_pk_bf16(s1[8 * sp + 4], s1[8 * sp + 5]); pb.u.w = pg8::cvt_pk_bf16(s1[8 * sp + 6], s1[8 * sp + 7]); } \
                    const int ko = (32 * kb + 16 * sp) * 2; \
                    const bf16x8_t v0 = *(const LAS bf16x8_t*)(st + vOff + ko), v1 = *(const LAS bf16x8_t*)(st + vOff + 32 * ATT_VS + ko); \
                    o0 = __builtin_amdgcn_mfma_f32_32x32x16_bf16(v0, pb.v, o0, 0, 0, 0); \
                    o1 = __builtin_amdgcn_mfma_f32_32x32x16_bf16(v1, pb.v, o1, 0, 0, 0); \
                } \
            TP_OFF(4); \
        } \
    } while (0)
    u32x4 rA = *(const u32x4*)gA, rB = *(const u32x4*)gB, rV = *(const u32x4*)gV;
    gA += stepA; gB += stepB; gV += 64;
    __builtin_amdgcn_sched_barrier(0);
    u32x4 sA = *(const u32x4*)gA, sB = *(const u32x4*)gB, sV = *(const u32x4*)gV;
    __builtin_amdgcn_sched_barrier(0);
#define ATT_TILE(RA, RB, RV) do { \
        LAS unsigned char* st = lds + (kt & 1) * ATT_STAGE; TP_ON(1); \
        *(LAS u32x4*)(st + lA) = RA; *(LAS u32x4*)(st + lB) = RB; *(LAS u32x4*)(st + lV) = RV; \
        __syncthreads(); \
        { const int adv = kt + 2 < ntile ? 1 : 0; gA += adv * stepA; gB += adv * stepB; gV += adv * 64; RA = *(const u32x4*)gA; RB = *(const u32x4*)gB; RV = *(const u32x4*)gV; } \
        TP_OFF(1); ATT_COMPUTE(); } while (0)
    TP_DECL; TP_ON(5);
    for (int kt = 0; kt < ntile; kt += 2) { ATT_TILE(rA, rB, rV); ++kt; ATT_TILE(sA, sB, sV); --kt; }
    TP_OFF(5);
#undef ATT_TILE
#undef ATT_COMPUTE
    TP_COMMIT(lds);
    lsum += __shfl_xor(lsum, 32);
    const float il = 1.0f / lsum;
    const size_t t = trow0 + q0 + r;
    u32x2 gzv[2][4];
#pragma unroll
    for (int db = 0; db < 2; ++db)
#pragma unroll
        for (int g = 0; g < 4; ++g) gzv[db][g] = *(const u32x2*)(p->H + t * IN_WP + C_ZMLA + h * 64 + 32 * db + 8 * g + 4 * hh);
#pragma unroll
    for (int db = 0; db < 2; ++db)
#pragma unroll
        for (int g = 0; g < 4; ++g) { const int d0 = 32 * db + 8 * g + 4 * hh;
            const u32x2 gz = gzv[db][g];
            float v[4];
#pragma unroll
            for (int e = 0; e < 4; ++e) v[e] = (db == 0 ? o0[4 * g + e] : o1[4 * g + e]) * il;
            v[0] *= __uint_as_float(gz.x << 16); v[1] *= __uint_as_float(gz.x & 0xffff0000u); v[2] *= __uint_as_float(gz.y << 16); v[3] *= __uint_as_float(gz.y & 0xffff0000u);
            u32x2 w; w.x = pg8::cvt_pk_bf16(v[0], v[1]); w.y = pg8::cvt_pk_bf16(v[2], v[3]);
            *(u32x2*)(p->yb + t * 1536 + h * 64 + d0) = w; }
}
__device__ __forceinline__ void ph_attn_p(KP p, LAS unsigned char* lds) {
    int tid = threadIdx.x; asm volatile("" : "+v"(tid));
    const int lane = tid & 63, wave = __builtin_amdgcn_readfirstlane(tid >> 6);
    for (int pi = blockIdx.x; pi < 256; pi += gridDim.x) {
        const int xcd = pi & 7, k = pi >> 3, bh = xcd * 8 + (k >> 2), pr = k & 3;
#pragma unroll 1
        for (int uu = 0; uu < 2; ++uu) attn_unit(p, bh >> 3, bh & 7, uu == 0 ? 7 - pr : pr, lds, tid, wave, lane);
    }
    __syncthreads();
}
struct MEpiVt { static constexpr bool PERM = true, AFTER_DRAIN = false; static constexpr int SEG = 0; bf16_t* O; int ldc; int pad_;
    __device__ __forceinline__ void operator()(const f32x4 (&acc)[2][2][4][2], const pg8::Unit& u, int wr, int wc, int fr0, int fq0) const {
        int fr = fr0, fq = fq0; asm volatile("" : "+v"(fr), "+v"(fq));
        const int row0 = u.pm * 256 + wr * 64 + fr;
#pragma unroll
        for (int bj = 0; bj < 2; ++bj) { const int col0 = u.pn * 256 + bj * 128 + wc * 32 + 8 * fq;
#pragma unroll
            for (int ai = 0; ai < 2; ++ai)
#pragma unroll
                for (int m = 0; m < 4; ++m) { const int row = row0 + ai * 128 + m * 16; const f32x4 v0 = acc[ai][bj][m][0], v1 = acc[ai][bj][m][1];
                    u32x4 w; w.x = pg8::cvt_pk_bf16(v0[0], v0[1]); w.y = pg8::cvt_pk_bf16(v0[2], v0[3]); w.z = pg8::cvt_pk_bf16(v1[0], v1[1]); w.w = pg8::cvt_pk_bf16(v1[2], v1[3]);
                    *(u32x4*)(O + (size_t)row * ldc + col0) = w; } }
    } };


__global__ void __launch_bounds__(NTHR, 2) k_mega(Params p_unused) {
    const KP kp0 = (KP)__builtin_amdgcn_kernarg_segment_ptr();
#define PP() ({ KP q_ = kp0; asm volatile("" : "+s"(q_)); q_; })
    KP p = PP();
    extern __shared__ __attribute__((aligned(16))) unsigned char lds_raw[];
    LAS unsigned char* lds = (LAS unsigned char*)lds_raw;
    volatile LAS unsigned* misc = (volatile LAS unsigned*)(lds + LDS_MISC);
    for (int u = threadIdx.x; u < 64; u += NTHR) misc[u] = 0u;
    __syncthreads();
    const int lo = p->ph_lo, hi = p->ph_hi;
    XcdBarrier bar; bar.bar = p->bar + p->li * XCD_BAR_WORDS; bar.x = 0; bar.st = nullptr;
    if (hi - lo > 1) bar = xcd_barrier_post(p->bar + p->li * XCD_BAR_WORDS, misc + 8);
#define IN(k) (lo <= (k) && (k) < hi)
#define SEAM(k) do { if (IN(k) && IN((k) + 1)) xcd_barrier(bar); } while (0)

    if (IN(PH_PRO)) {
        LAS float* tile = (LAS float*)lds;
        for (int l = 0; l < 2; ++l) {
            KP p = PP();
            ph_tr(p->w_in + (size_t)l * 1024 * IN_W, p->WinT + (size_t)l * IN_WP * 1024, 1024, IN_W, IN_WP, tile, 0);
            ph_tr(p->w_uq + (size_t)l * 384 * 768, p->WuqT + (size_t)l * 768 * 384, 384, 768, 768, tile, 0);
            ph_tr(p->w_uk + (size_t)l * 256 * 512, p->WkvT + (size_t)l * 1024 * 256, 256, 512, 512, tile, 144);
            ph_tr(p->w_uv + (size_t)l * 256 * 512, p->WkvT + (size_t)l * 1024 * 256 + (size_t)512 * 256, 256, 512, 512, tile, 208);
            ph_tr(p->w_br0 + (size_t)l * 512 * 1024, p->WbrT + (size_t)l * 1024 * 1536 + 0 * 512, 512, 1024, 1024, tile, 0, 1536);
            ph_tr(p->w_br1 + (size_t)l * 512 * 1024, p->WbrT + (size_t)l * 1024 * 1536 + 1 * 512, 512, 1024, 1024, tile, 0, 1536);
            ph_tr(p->w_br2 + (size_t)l * 512 * 1024, p->WbrT + (size_t)l * 1024 * 1536 + 2 * 512, 512, 1024, 1024, tile, 0, 1536);
            ph_tr(p->w_out + (size_t)l * 1024 * 1024, p->WoutT + (size_t)l * 1024 * 1024, 1024, 1024, 1024, tile, 0);
            for (int g = 0; g < 4; ++g) ph_tr(p->pool_mix + ((size_t)l * 4 + g) * 128 * 128, p->PmixT + ((size_t)l * 4 + g) * 128 * 128, 128, 128, 128, tile, 64 + 8 * g);
        }
        { KP p = PP(); const float* src = p->w_uk; bf16_t* dst = p->WukB;
          for (int i = (blockIdx.x * NTHR + threadIdx.x) * 8; i < 2 * 256 * 512; i += gridDim.x * NTHR * 8) { const f32x4 a = *(const f32x4*)(src + i), b = *(const f32x4*)(src + i + 4);
              u32x4 w; w.x = pg8::cvt_pk_bf16(a[0], a[1]); w.y = pg8::cvt_pk_bf16(a[2], a[3]); w.z = pg8::cvt_pk_bf16(b[0], b[1]); w.w = pg8::cvt_pk_bf16(b[2], b[3]); *(u32x4*)(dst + i) = w; } }
#if defined(TPROBE) && TPROBE == 40
        { KP p = PP(); int t_ = threadIdx.x; asm volatile("" : "+v"(t_)); if (t_ == 0) __hip_atomic_store(p->bar + 12 * XCD_BAR_WORDS + blockIdx.x, xb_xcc_id() + 1u, __ATOMIC_RELAXED, __HIP_MEMORY_SCOPE_AGENT); }
#endif
        { KP p = PP(); ph_rope_tab(p->tab); ph_rmsnorm(p->x_prompt, p->x_sample, p->norm_g, p->xn, nullptr, nullptr); }
    }
    SEAM(PH_PRO);
    for (int l = 0; l < 2; ++l) {
        int G = gridDim.x, bid = blockIdx.x; asm volatile("" : "+s"(G), "+s"(bid));
        if (IN(PHID(l, PH_GIN))) { KP p = PP();
            unsigned* cnt = p->bar + 12 * XCD_BAR_WORDS + 512 + l * 64;
            pg8::Gemm g{p->xn, p->WinT + (size_t)l * IN_WP * 1024, TT, IN_WP, 1024, 0}; pg8::GinOrder S; S.init(TT, IN_WP, G, bid); S.cnt = cnt;
            MEpiH E{p->H, p->BA}; pg8::gemm_phase<MEpiH, pg8::GinOrder, false>(lds, g, S, E, nullptr);
            for (int j = 0; j < 8; ++j) if ((G - 1 - j % G + G) % G == bid) { KP p = PP();
                __syncthreads();
                { int t_ = threadIdx.x; asm volatile("" : "+v"(t_)); if (t_ == 0) { unsigned* bb = p->bar + p->li * XCD_BAR_WORDS; XB_SPIN(xb_ld(cnt) < (unsigned)(IN_WP / 256 * 8), bb); } }
                __syncthreads();
                __builtin_amdgcn_fence(__ATOMIC_ACQUIRE, "agent"); asm volatile("s_waitcnt vmcnt(0)" ::: "memory");
                __syncthreads();
                tok_tile<true>(PP(), l, TP / 64 + j, lds); }
        }
        SEAM(PHID(l, PH_GIN));
        if (IN(PHID(l, PH_TOK))) ph_tok(PP(), l, lds);
        SEAM(PHID(l, PH_TOK));
        if (IN(PHID(l, PH_GQ)) && (PP()->pad & 16)) { KP p = PP();
            pg8::Gemm g{p->cq, p->WuqT + (size_t)l * 768 * 384, TT, 768, 384, 0}; pg8::StaticOrder S; S.init(TT, 768, G, bid);
            MEpiQ E{p->Q, p->tab}; pg8::gemm_phase<MEpiQ, pg8::StaticOrder, false>(lds, g, S, E, nullptr);
        }
        if (IN(PHID(l, PH_GQ)) && (PP()->pad & 32)) { KP p = PP();
            pg8::Gemm g{p->ckv, p->WkvT + (size_t)l * 1024 * 256, TP, 512, 256, 0}; pg8::StaticOrder S; S.init(TP, 512, G / 2, bid < G / 2 ? bid : G);
            MEpiKV E{p->Kn, p->V}; pg8::gemm_phase<MEpiKV, pg8::StaticOrder, false>(lds, g, S, E, nullptr);
        }
        if (IN(PHID(l, PH_GQ)) && (PP()->pad & 32)) { KP p = PP();
            pg8::Gemm g{p->WkvT + (size_t)l * 1024 * 256 + (size_t)512 * 256, p->ckv, 512, TP, 256, 0}; pg8::StaticOrder S; S.init(512, TP, G / 2, bid >= G / 2 ? bid - G / 2 : G);
            MEpiVt E{p->Vt, TP, 0}; pg8::gemm_phase<MEpiVt, pg8::StaticOrder, false>(lds, g, S, E, nullptr);
        }
        if (IN(PHID(l, PH_GQ)) && (PP()->pad & 64)) ph_delta_pre(PP(), lds);
        SEAM(PHID(l, PH_GQ));
        if (IN(PHID(l, PH_ATT))) { const int am = PP()->pad;
            if (am & 1) ph_attn_s2(PP(), l, lds); if (am & 4) ph_attn_p(PP(), lds); if (am & 8) ph_att_waves(PP(), l, lds); }
        SEAM(PHID(l, PH_ATT));
        if (IN(PHID(l, PH_FIN))) { const int fm = PP()->pad; if (fm & 128) ph_fin(PP(), l, lds); if (fm & 256) ph_delta_fin(PP(), l); }
        SEAM(PHID(l, PH_FIN));
        if (IN(PHID(l, PH_MERGE)) && (PP()->pad & 512)) { KP p = PP();
            pg8::Gemm g{p->ya, p->WbrT + (size_t)l * 1024 * 1536, TP, 1024, 512, 1536}; pg8::SegOrder<3> S; S.init(TP, 1024, G, bid);
            MEpiMergeS E{p->H, p->mb}; pg8::gemm_phase<MEpiMergeS, pg8::SegOrder<3>, false>(lds, g, S, E, nullptr);
        }
        if (IN(PHID(l, PH_MERGE)) && (PP()->pad & 1024)) { KP p = PP(); TEpiMerge E{p->H, p->mb}; tail_gemm<3, TEpiMerge>(p->ya + (size_t)TP * 1536, 1536, p->WbrT + (size_t)l * 1024 * 1536, 1536, 1024, E, lds); }
        SEAM(PHID(l, PH_MERGE));
        if (IN(PHID(l, PH_OUT)) && (PP()->pad & 2048)) { KP p = PP();
            const float* xp = l == 0 ? p->x_prompt : p->xres; const float* xs = l == 0 ? p->x_sample : p->xres + (size_t)TP * 1024;
            pg8::Gemm g{p->mb, p->WoutT + (size_t)l * 1024 * 1024, TP, 1024, 1024, 0}; pg8::StaticOrder S; S.init(TP, 1024, G, bid);
            MEpiRes E{xp, xs, p->xres}; pg8::gemm_phase<MEpiRes, pg8::StaticOrder, false>(lds, g, S, E, nullptr);
        }
        if (IN(PHID(l, PH_OUT)) && (PP()->pad & 4096)) { KP p = PP(); TEpiRes E{l == 0 ? p->x_sample : p->xres + (size_t)TP * 1024, p->xres}; tail_gemm<1, TEpiRes>(p->mb + (size_t)TP * 1024, 1024, p->WoutT + (size_t)l * 1024 * 1024, 1024, 1024, E, lds); }
        SEAM(PHID(l, PH_OUT));
        if (IN(PHID(l, PH_NORM))) { KP p = PP();
            if (l == 0) ph_rmsnorm(p->xres, p->xres + (size_t)TP * 1024, p->norm_g + 1024, p->xn, nullptr, nullptr);
            else ph_rmsnorm(p->xres, p->xres + (size_t)TP * 1024, p->final_norm_g, nullptr, p->out + O_YP, p->out + O_YS);
        }
        SEAM(PHID(l, PH_NORM));
    }
#if defined(TPROBE)
    { int te_ = threadIdx.x; asm volatile("" : "+v"(te_)); if (blockIdx.x == 0 && te_ == 0 && PP()->ph_lo == 0) { unsigned long long w = (unsigned long long)*(volatile LAS unsigned*)(lds + LDS_MISC + 128) * 8ull; const unsigned long long t0 = __builtin_amdgcn_s_memrealtime();
#if TPROBE == 40
        { unsigned* xt = PP()->bar + 12 * XCD_BAR_WORDS; unsigned m = 0; for (int b = 0; b < 256; ++b) m += (xb_ld(xt + b) == xb_ld(xt + (b & 7)) && xb_ld(xt + b) != 0u) ? 1u : 0u; w += (unsigned long long)m * 100ull; }
#endif
        while (__builtin_amdgcn_s_memrealtime() - t0 < w) __builtin_amdgcn_s_sleep(8); } }
#endif
#undef IN
#undef SEAM
}

static inline size_t al256(size_t x) { return (x + 255) & ~(size_t)255; }
extern "C" void kernel_launch(void* const* d_in, const int* in_sizes, int n_in, void* d_out, int out_size, void* d_ws, size_t ws_size, hipStream_t stream) {
    static int grid = 0;
    if (grid == 0) {
        int dev = 0, cus = 0; (void)hipGetDevice(&dev); (void)hipDeviceGetAttribute(&cus, hipDeviceAttributeMultiprocessorCount, dev);
        (void)hipFuncSetAttribute((const void*)k_mega, hipFuncAttributeMaxDynamicSharedMemorySize, LDS_BYTES);
        int per_cu = 0; (void)hipOccupancyMaxActiveBlocksPerMultiprocessor(&per_cu, (const void*)k_mega, NTHR, LDS_BYTES); (void)hipGetLastError();
        grid = cus > 0 ? cus : 256;
    }
    Params p{};
    p.x_prompt = (const float*)d_in[0]; p.x_sample = (const float*)d_in[1]; p.cache_kv = (const float*)d_in[2]; p.cache_kr = (const float*)d_in[3];
    p.state_pool = (const float*)d_in[4]; p.state_conv = (const float*)d_in[5]; p.state_delta = (const float*)d_in[6]; p.page_table = (const int*)d_in[7];
    p.norm_g = (const float*)d_in[8]; p.w_in = (const float*)d_in[9]; p.pool_mix = (const float*)d_in[10]; p.pool_scale = (const float*)d_in[11];
    p.q_norm_g = (const float*)d_in[12]; p.w_uq = (const float*)d_in[13]; p.kv_norm_g = (const float*)d_in[14]; p.w_uk = (const float*)d_in[15];
    p.w_uv = (const float*)d_in[16]; p.conv_w = (const float*)d_in[17]; p.a_log = (const float*)d_in[18]; p.dt_bias = (const float*)d_in[19];
    p.dn_norm_g = (const float*)d_in[20]; p.w_br0 = (const float*)d_in[21]; p.w_br1 = (const float*)d_in[22]; p.w_br2 = (const float*)d_in[23];
    p.w_out = (const float*)d_in[24]; p.final_norm_g = (const float*)d_in[25];
    p.out = (float*)d_out;
    char* w = (char*)d_ws; size_t off = 0;
    auto take = [&](size_t bytes) { char* q = w + off; off += al256(bytes); return q; };
    const size_t BAR_BYTES = (size_t)16 * XCD_BAR_WORDS * 4;
    p.bar = (unsigned*)take(BAR_BYTES);
    p.WinT = (bf16_t*)take((size_t)2 * IN_WP * 1024 * 2);
    p.WuqT = (bf16_t*)take((size_t)2 * 768 * 384 * 2);
    p.WkvT = (bf16_t*)take((size_t)2 * 1024 * 256 * 2);
    p.WbrT = (bf16_t*)take((size_t)2 * 3 * 1024 * 512 * 2);
    p.WoutT = (bf16_t*)take((size_t)2 * 1024 * 1024 * 2);
    p.PmixT = (bf16_t*)take((size_t)2 * 4 * 128 * 128 * 2);
    p.WukB = (bf16_t*)take((size_t)2 * 256 * 512 * 2);
    p.tab = (float2*)take((size_t)(SEQ + DEC_SEQ) * 16 * 8);
    p.xres = (float*)take((size_t)TT * 1024 * 4);
    p.xn = (bf16_t*)take((size_t)TT * 1024 * 2);
    p.H = (bf16_t*)take((size_t)TT * IN_WP * 2);
    p.BA = (float*)take((size_t)TT * 16 * 4);
    p.cq = (bf16_t*)take((size_t)TT * 384 * 2);
    p.ckv = (bf16_t*)take((size_t)TT * 256 * 2);
    p.Kr = (bf16_t*)take((size_t)TT * 32 * 2);
    p.Q = (bf16_t*)take((size_t)TT * 768 * 2);
    bf16_t* Qlat = (bf16_t*)take((size_t)TS * 8 * 288 * 2);
    p.Kn = (bf16_t*)take((size_t)TP * 512 * 2);
    p.V = (bf16_t*)take((size_t)TP * 512 * 2);
    p.Vt = (bf16_t*)take((size_t)512 * TP * 2);
    p.qd = (bf16_t*)take((size_t)TT * 512 * 2);
    p.kd = (bf16_t*)take((size_t)TT * 512 * 2);
    p.vd = (bf16_t*)take((size_t)TT * 512 * 2);
    p.bg = (float*)take((size_t)TT * 16 * 4);
    p.ya = (bf16_t*)take((size_t)TT * 1536 * 2); p.yb = p.ya + 512; p.yc = p.ya + 1024;
    p.mf = (float*)take((size_t)TT * 1024 * 4);
    p.mb = (bf16_t*)take((size_t)TT * 1024 * 2);
    p.part = (float*)take((size_t)DEC_BATCH * SA_CH * 64 * 258 * 4);
    p.DOP = (bf16_t*)take((size_t)2048 * 4 * 4096 * 2);
    p.DU = (float*)take((size_t)2048 * 4096 * 4);
    p.DG = (float*)take((size_t)2048 * 4);

    (void)hipMemsetAsync(p.bar, 0, BAR_BYTES, stream);
    p.ph_lo = 0; p.ph_hi = PH_END; p.li = 0; p.pad = 0x7fff;
    hipLaunchKernelGGL(k_mega, dim3(grid), dim3(NTHR), LDS_BYTES, stream, p);
#if defined(PROBE_REP) && PROBE_REP > 0
    for (int i = 0; i < PROBE_REP; ++i) { Params q = p; q.ph_lo = PROBE_LO; q.ph_hi = PROBE_HI; q.li = 1 + i; q.pad = PROBE_MASK; hipLaunchKernelGGL(k_mega, dim3(grid), dim3(NTHR), LDS_BYTES, stream, q); }
#endif
}
```
